# Optimizing an MI355X kernel written in HIP

```python
import jax
import jax.numpy as jnp
from jax import lax
import numpy as np

D_MODEL = 2048
BATCH = 32
SEQ = 256
DEPTH = 4
DEC_BATCH = 4
DEC_SEQ = 4096
PAST_LEN = 512

GRID_W = 64
N_DIR = 2
D_MIX = D_MODEL
GROUP_W = D_MIX // 4
S5_CH = 16
S5_GROUPS = GROUP_W // S5_CH
S5_P = 64
MLSTM_HEADS = 4
MLSTM_DH = GROUP_W // MLSTM_HEADS
RET_HEADS = 4
RET_DH = GROUP_W // RET_HEADS
SSD_HEADS = 8
SSD_P = GROUP_W // SSD_HEADS
SSD_GROUPS = 2
SSD_HPG = SSD_HEADS // SSD_GROUPS
SSD_N = 128
SSD_CONV = 5
SSD_XBC = GROUP_W + 2 * SSD_GROUPS * SSD_N
D_FF = 4 * D_MODEL
CHUNK = 128
EPS = 1e-6
ROPE_BASE = 10000.0
IN_SIZES = (GROUP_W,
            GROUP_W, GROUP_W, GROUP_W, GROUP_W, N_DIR * MLSTM_HEADS, N_DIR * MLSTM_HEADS,
            GROUP_W, GROUP_W, GROUP_W, GROUP_W,
            GROUP_W, SSD_XBC, N_DIR * SSD_HEADS)
D_IN = 10 * GROUP_W + 2 * N_DIR * MLSTM_HEADS + SSD_XBC + N_DIR * SSD_HEADS

kernel_name = 'hymba_parallel_ssm_flow_backbone'


def _f32(a):
    return a.astype(jnp.float32)


def _rmsnorm(x, g):
    xf = _f32(x)
    y = xf * lax.rsqrt(jnp.mean(xf * xf, axis=-1, keepdims=True) + EPS)
    return (y * _f32(g)).astype(x.dtype)


def _head_rmsnorm(y, g):
    y = y * lax.rsqrt(jnp.mean(y * y, axis=-1, keepdims=True) + EPS)
    return y.reshape(y.shape[0], y.shape[1], -1) * _f32(g)


def _flip(a):
    return a[:, ::-1]


def _chunks(a):
    b, l = a.shape[0], a.shape[1]
    return jnp.moveaxis(a.reshape(b, l // CHUNK, CHUNK, *a.shape[2:]), 1, 0)


def _unchunks(a):
    a = jnp.moveaxis(a, 0, 1)
    return a.reshape(a.shape[0], -1, *a.shape[3:])


def _causal():
    return jnp.tril(jnp.ones((CHUNK, CHUNK), dtype=bool))


def _split_cols(proj):
    out, start = [], 0
    for size in IN_SIZES:
        out.append(proj[..., start:start + size])
        start += size
    return out


def _rope_2d(a, n_rows):
    rows = jnp.repeat(jnp.arange(n_rows, dtype=jnp.float32), GRID_W)
    cols = jnp.tile(jnp.arange(GRID_W, dtype=jnp.float32), n_rows)
    quarter = RET_DH // 4
    freqs = ROPE_BASE ** (-jnp.arange(quarter, dtype=jnp.float32) / quarter)
    ang = jnp.concatenate([rows[:, None] * freqs, cols[:, None] * freqs], axis=-1)
    cos = jnp.cos(ang)[None, :, None, :]
    sin = jnp.sin(ang)[None, :, None, :]
    a1, a2 = a[..., :RET_DH // 2], a[..., RET_DH // 2:]
    return jnp.concatenate([a1 * cos - a2 * sin, a1 * sin + a2 * cos], axis=-1)


def _dwconv_centred(x, w, b):
    pad = (w.shape[0] - 1) // 2
    out = lax.conv_general_dilated(x, w[:, None, :], window_strides=(1,), padding=[(pad, pad)],
                                   dimension_numbers=('NWC', 'WIO', 'NWC'),
                                   feature_group_count=x.shape[-1])
    return out + b


def _s5_scan(bu, lam_bar, h0):
    bu = bu.at[:, 0].add(lam_bar * h0)
    a = jnp.broadcast_to(lam_bar, (1,) + bu.shape[1:])

    def combine(e1, e2):
        a1, b1 = e1
        a2, b2 = e2
        return a1 * a2, a2 * b1 + b2

    _, h = lax.associative_scan(combine, (a, bu), axis=1)
    return h


def _s5_mixer(u, st_re, st_im, p):
    bsz, seq = u.shape[0], u.shape[1]
    uc = u.reshape(bsz, seq, S5_GROUPS, S5_CH).astype(jnp.complex64)
    h0 = lax.complex(st_re, st_im)
    y = _f32(p['s5_d']) * u
    finals = []
    for di in range(N_DIR):
        lam = lax.complex(_f32(p['s5_lambda_re'][di]), _f32(p['s5_lambda_im'][di]))
        dt = jnp.exp(_f32(p['s5_log_dt'][di]))[:, None]
        lam_bar = jnp.exp(lam * dt)
        b_bar = ((lam_bar - 1) / lam)[..., None] * lax.complex(_f32(p['s5_b_re'][di]), _f32(p['s5_b_im'][di]))
        c_mat = lax.complex(_f32(p['s5_c_re'][di]), _f32(p['s5_c_im'][di]))
        src = uc if di == 0 else _flip(uc)
        h = _s5_scan(jnp.einsum('blgc,gpc->blgp', src, b_bar), lam_bar, h0[:, di])
        finals.append(h[:, -1])
        yd = jnp.einsum('blgp,gcp->blgc', h, c_mat).real.reshape(bsz, seq, GROUP_W)
        y = y + (yd if di == 0 else _flip(yd))
    y = jax.nn.gelu(y)
    y = y * jax.nn.sigmoid(y @ _f32(p['s5_w_glu']))
    fin = jnp.stack(finals, axis=1)
    return y, (fin.real, fin.imag)


def _mlstm_scan(q, k, v, ig, lf, c0, n0, m0):
    mask = _causal()[None, :, :, None]

    def step(carry, inp):
        cm, nm, mm = carry
        qc, kc, vc, ic, fc = inp
        b = jnp.cumsum(fc, axis=1)
        dmat = jnp.where(mask, b[:, :, None] - b[:, None, :] + ic[:, None, :], -jnp.inf)
        m_inter = b + mm[:, None]
        m_t = jnp.maximum(m_inter, dmat.max(axis=2))
        s = jnp.einsum('bthd,bshd->btsh', qc, kc) * jnp.exp(dmat - m_t[:, :, None])
        w_inter = jnp.exp(m_inter - m_t)
        num = jnp.einsum('btsh,bshe->bthe', s, vc) + w_inter[..., None] * jnp.einsum('bthd,bhde->bthe', qc, cm)
        den = s.sum(axis=2) + w_inter * jnp.einsum('bthd,bhd->bth', qc, nm)
        h = num / jnp.maximum(jnp.abs(den), jnp.exp(-m_t))[..., None]
        g = b[:, -1:] - b + ic
        m_new = jnp.maximum(b[:, -1] + mm, g.max(axis=1))
        w_s = jnp.exp(g - m_new[:, None])
        decay_old = jnp.exp(b[:, -1] + mm - m_new)
        c_new = decay_old[..., None, None] * cm + jnp.einsum('bsh,bshd,bshe->bhde', w_s, kc, vc)
        n_new = decay_old[..., None] * nm + jnp.einsum('bsh,bshd->bhd', w_s, kc)
        return (c_new, n_new, m_new), h

    carry, h = lax.scan(step, (c0, n0, m0), tuple(_chunks(a) for a in (q, k, v, ig, lf)))
    return _unchunks(h), carry


def _mlstm_mixer(q, k, v, o, i_pre, f_pre, c0, n0, m0, p):
    bsz, seq = q.shape[0], q.shape[1]
    q, k, v = (a.reshape(bsz, seq, MLSTM_HEADS, MLSTM_DH) for a in (q, k, v))
    k = k * MLSTM_DH ** -0.5
    ig = i_pre.reshape(bsz, seq, N_DIR, MLSTM_HEADS) + _f32(p['mlstm_i_bias'])
    lf = jax.nn.log_sigmoid(f_pre.reshape(bsz, seq, N_DIR, MLSTM_HEADS) + _f32(p['mlstm_f_bias']))
    h_sum = 0.0
    cs, ns, ms = [], [], []
    for di in range(N_DIR):
        seqs = (q, k, v, ig[:, :, di], lf[:, :, di])
        if di == 1:
            seqs = tuple(_flip(a) for a in seqs)
        h, (c1, n1, m1) = _mlstm_scan(*seqs, c0[:, di], n0[:, di], m0[:, di])
        h_sum = h_sum + (h if di == 0 else _flip(h))
        cs.append(c1)
        ns.append(n1)
        ms.append(m1)
    y = jax.nn.sigmoid(o) * _head_rmsnorm(h_sum, p['mlstm_norm'])
    return y, (jnp.stack(cs, axis=1), jnp.stack(ns, axis=1), jnp.stack(ms, axis=1))


def _ret_scan(q, k, v, log_gamma, s0):
    idx = jnp.arange(CHUNK, dtype=jnp.float32)
    mask = _causal()
    diff = jnp.where(mask, idx[:, None] - idx[None, :], 0.0)
    dmat = jnp.where(mask[..., None], jnp.exp(diff[..., None] * log_gamma), 0.0)
    q_decay = jnp.exp((idx[:, None] + 1.0) * log_gamma)
    k_decay = jnp.exp((CHUNK - 1.0 - idx[:, None]) * log_gamma)
    chunk_decay = jnp.exp(CHUNK * log_gamma)

    def step(s, inp):
        qc, kc, vc = inp
        att = jnp.einsum('bthd,bshd->btsh', qc, kc) * dmat
        y = jnp.einsum('btsh,bshe->bthe', att, vc) + q_decay[:, :, None] * jnp.einsum('bthd,bhde->bthe', qc, s)
        s = chunk_decay[:, None, None] * s + jnp.einsum('bshd,sh,bshe->bhde', kc, k_decay, vc)
        return s, y

    s1, y = lax.scan(step, s0, tuple(_chunks(a) for a in (q, k, v)))
    return _unchunks(y), s1


def _ret_mixer(q, k, v, g, s0, p, n_rows):
    bsz, seq = q.shape[0], q.shape[1]
    q, k, v = (a.reshape(bsz, seq, RET_HEADS, RET_DH) for a in (q, k, v))
    if n_rows is not None:
        q = _rope_2d(q, n_rows)
        k = _rope_2d(k, n_rows)
    k = k * RET_DH ** -0.5
    log_gamma = -jnp.exp(_f32(p['ret_log_rate']))
    y_sum = 0.0
    finals = []
    for di in range(N_DIR):
        seqs = (q, k, v) if di == 0 else (_flip(q), _flip(k), _flip(v))
        y, s1 = _ret_scan(*seqs, log_gamma[di], s0[:, di])
        y_sum = y_sum + (y if di == 0 else _flip(y))
        finals.append(s1)
    y = _head_rmsnorm(y_sum, p['ret_norm']) * jax.nn.silu(g)
    return y, jnp.stack(finals, axis=1)


def _ssd_scan(xs, bm, cm, dt, a, h0):
    mask = _causal()[None, :, :, None, None]

    def step(h, inp):
        xc, bc, cc, dtc, ac = inp
        cum = jnp.cumsum(ac, axis=1)
        decay = jnp.exp(jnp.where(mask, cum[:, :, None] - cum[:, None, :], -jnp.inf))
        cb = jnp.einsum('btgn,bsgn->btsg', cc, bc)
        y = jnp.einsum('btsg,btsgr,bsgrp->btgrp', cb, decay, dtc[..., None] * xc)
        y = y + jnp.exp(cum)[..., None] * jnp.einsum('btgn,bgrpn->btgrp', cc, h)
        w = jnp.exp(cum[:, -1:] - cum) * dtc
        h = jnp.exp(cum[:, -1])[..., None, None] * h + jnp.einsum('bsgn,bsgr,bsgrp->bgrpn', bc, w, xc)
        return h, y

    h1, y = lax.scan(step, h0, tuple(_chunks(t) for t in (xs, bm, cm, dt, a)))
    return _unchunks(y), h1


def _ssd_mixer(z, xbc, dt_pre, h0, p):
    bsz, seq = z.shape[0], z.shape[1]
    xbc = jax.nn.silu(_dwconv_centred(xbc, _f32(p['ssd_conv_w']), _f32(p['ssd_conv_b'])))
    xs = xbc[..., :GROUP_W].reshape(bsz, seq, SSD_GROUPS, SSD_HPG, SSD_P)
    bm = xbc[..., GROUP_W:GROUP_W + SSD_GROUPS * SSD_N].reshape(bsz, seq, SSD_GROUPS, SSD_N)
    cm = xbc[..., GROUP_W + SSD_GROUPS * SSD_N:].reshape(bsz, seq, SSD_GROUPS, SSD_N)
    dt = jax.nn.softplus(dt_pre.reshape(bsz, seq, N_DIR, SSD_GROUPS, SSD_HPG)
                         + _f32(p['ssd_dt_bias']).reshape(N_DIR, SSD_GROUPS, SSD_HPG))
    a_rate = -jnp.exp(_f32(p['ssd_a_log'])).reshape(N_DIR, SSD_GROUPS, SSD_HPG)
    h0 = h0.reshape(bsz, N_DIR, SSD_GROUPS, SSD_HPG, SSD_P, SSD_N)
    y = _f32(p['ssd_d']).reshape(SSD_GROUPS, SSD_HPG, 1) * xs
    finals = []
    for di in range(N_DIR):
        seqs = (xs, bm, cm, dt[:, :, di], dt[:, :, di] * a_rate[di])
        if di == 1:
            seqs = tuple(_flip(t) for t in seqs)
        yd, h1 = _ssd_scan(*seqs, h0[:, di])
        y = y + (yd if di == 0 else _flip(yd))
        finals.append(h1.reshape(bsz, SSD_HEADS, SSD_P, SSD_N))
    y = y.reshape(bsz, seq, GROUP_W) * jax.nn.silu(z)
    y = y * lax.rsqrt(jnp.mean(y * y, axis=-1, keepdims=True) + EPS) * _f32(p['ssd_norm'])
    return y, jnp.stack(finals, axis=1)


def _layer(x, mod, state, p, n_rows):
    sh1, sc1, g1, sh2, sc2, g2 = jnp.split(mod[:, None, :], 6, axis=-1)
    h = _rmsnorm(x, p['norm1']) * (1 + sc1) + sh1
    proj = _f32(h @ p['w_in'])
    (s5_u, m_q, m_k, m_v, m_o, m_i, m_f, r_q, r_k, r_v, r_g, d_z, d_xbc, d_dt) = _split_cols(proj)
    s5_re, s5_im, m_c, m_n, m_m, r_s, d_h = (_f32(s) for s in state)
    y_a, (s5_re, s5_im) = _s5_mixer(s5_u, s5_re, s5_im, p)
    y_b, (m_c, m_n, m_m) = _mlstm_mixer(m_q, m_k, m_v, m_o, m_i, m_f, m_c, m_n, m_m, p)
    y_c, r_s = _ret_mixer(r_q, r_k, r_v, r_g, r_s, p, n_rows)
    y_d, d_h = _ssd_mixer(d_z, d_xbc, d_dt, d_h, p)
    y = jnp.concatenate([y_a, y_b, y_c, y_d], axis=-1).astype(x.dtype) @ p['w_out']
    x = x + g1 * y
    h2 = _rmsnorm(x, p['norm2']) * (1 + sc2) + sh2
    x = x + g2 * (jnp.square(jax.nn.relu(h2 @ p['w_mlp1'])) @ p['w_mlp2'])
    return x, (s5_re, s5_im, m_c, m_n, m_m, r_s, d_h)


def setup_inputs(seed: int = 0) -> dict:
    key = jax.random.key(seed)
    it = iter(jax.random.split(key, 48))

    def nrm(shape, scale):
        return jax.random.normal(next(it), shape, jnp.float32) * scale

    def unif(shape, lo, hi):
        return jax.random.uniform(next(it), shape, jnp.float32, lo, hi)

    L2 = (DEPTH, N_DIR)
    s5_im0 = jnp.pi * jnp.arange(S5_P, dtype=jnp.float32)
    ret_gamma = 1.0 - 2.0 ** (-5.0 - jnp.arange(RET_HEADS, dtype=jnp.float32))
    ssd_dt = jnp.exp(unif(L2 + (SSD_HEADS,), float(np.log(1e-3)), float(np.log(1e-1))))
    return {
        'x_prompt': nrm((BATCH, SEQ, D_MODEL), 1.0),
        'x_sample': nrm((DEC_BATCH, DEC_SEQ, D_MODEL), 1.0),
        'c': nrm((DEC_BATCH, D_MODEL), 1.0),
        'state_s5_re': nrm((DEC_BATCH, DEPTH, N_DIR, S5_GROUPS, S5_P), 0.1),
        'state_s5_im': nrm((DEC_BATCH, DEPTH, N_DIR, S5_GROUPS, S5_P), 0.1),
        'state_mlstm_c': nrm((DEC_BATCH, DEPTH, N_DIR, MLSTM_HEADS, MLSTM_DH, MLSTM_DH), 0.1),
        'state_mlstm_n': nrm((DEC_BATCH, DEPTH, N_DIR, MLSTM_HEADS, MLSTM_DH), 0.1),
        'state_mlstm_m': nrm((DEC_BATCH, DEPTH, N_DIR, MLSTM_HEADS), 1.0),
        'state_ret': nrm((DEC_BATCH, DEPTH, N_DIR, RET_HEADS, RET_DH, RET_DH), 0.1),
        'state_ssd': nrm((DEC_BATCH, DEPTH, N_DIR, SSD_HEADS, SSD_P, SSD_N), 0.1),
        'c_ctx': nrm((D_MODEL,), 1.0),
        'norm1': 1.0 + nrm((DEPTH, D_MODEL), 0.01),
        'w_ada': nrm((DEPTH, D_MODEL, 6 * D_MODEL), 0.5 * D_MODEL ** -0.5),
        'b_ada': nrm((DEPTH, 6 * D_MODEL), 0.01),
        'w_in': nrm((DEPTH, D_MODEL, D_IN), D_MODEL ** -0.5),
        's5_lambda_re': -0.5 + nrm(L2 + (S5_GROUPS, S5_P), 0.01),
        's5_lambda_im': s5_im0 + nrm(L2 + (S5_GROUPS, S5_P), 0.01),
        's5_log_dt': unif(L2 + (S5_GROUPS,), float(np.log(1e-3)), float(np.log(1e-1))),
        's5_b_re': nrm(L2 + (S5_GROUPS, S5_P, S5_CH), (2 * S5_CH) ** -0.5),
        's5_b_im': nrm(L2 + (S5_GROUPS, S5_P, S5_CH), (2 * S5_CH) ** -0.5),
        's5_c_re': nrm(L2 + (S5_GROUPS, S5_CH, S5_P), (2 * S5_P) ** -0.5),
        's5_c_im': nrm(L2 + (S5_GROUPS, S5_CH, S5_P), (2 * S5_P) ** -0.5),
        's5_d': nrm((DEPTH, GROUP_W), 1.0),
        's5_w_glu': nrm((DEPTH, GROUP_W, GROUP_W), GROUP_W ** -0.5),
        'mlstm_i_bias': nrm(L2 + (MLSTM_HEADS,), 0.1),
        'mlstm_f_bias': jnp.linspace(3.0, 6.0, MLSTM_HEADS) + nrm(L2 + (MLSTM_HEADS,), 0.1),
        'mlstm_norm': 1.0 + nrm((DEPTH, GROUP_W), 0.01),
        'ret_log_rate': jnp.log(-jnp.log(ret_gamma)) + nrm(L2 + (RET_HEADS,), 0.01),
        'ret_norm': 1.0 + nrm((DEPTH, GROUP_W), 0.01),
        'ssd_conv_w': nrm((DEPTH, SSD_CONV, SSD_XBC), SSD_CONV ** -0.5),
        'ssd_conv_b': nrm((DEPTH, SSD_XBC), 0.01),
        'ssd_dt_bias': ssd_dt + jnp.log(-jnp.expm1(-ssd_dt)),
        'ssd_a_log': jnp.log(unif(L2 + (SSD_HEADS,), 1.0, 16.0)),
        'ssd_d': 1.0 + nrm((DEPTH, SSD_HEADS), 0.01),
        'ssd_norm': 1.0 + nrm((DEPTH, GROUP_W), 0.01),
        'w_out': nrm((DEPTH, D_MIX, D_MODEL), D_MIX ** -0.5),
        'norm2': 1.0 + nrm((DEPTH, D_MODEL), 0.01),
        'w_mlp1': nrm((DEPTH, D_MODEL, D_FF), D_MODEL ** -0.5),
        'w_mlp2': nrm((DEPTH, D_FF, D_MODEL), D_FF ** -0.5),
        'final_norm': 1.0 + nrm((D_MODEL,), 0.01),
    }


def reference(x_prompt, x_sample, c, state_s5_re, state_s5_im, state_mlstm_c, state_mlstm_n,
              state_mlstm_m, state_ret, state_ssd, c_ctx, norm1, w_ada, b_ada, w_in,
              s5_lambda_re, s5_lambda_im, s5_log_dt, s5_b_re, s5_b_im, s5_c_re, s5_c_im, s5_d,
              s5_w_glu, mlstm_i_bias, mlstm_f_bias, mlstm_norm, ret_log_rate, ret_norm,
              ssd_conv_w, ssd_conv_b, ssd_dt_bias, ssd_a_log, ssd_d, ssd_norm, w_out, norm2,
              w_mlp1, w_mlp2, final_norm):
    n_rows = x_sample.shape[1] // GRID_W
    bp = x_prompt.shape[0]
    f32 = jnp.float32
    zero_state = (jnp.zeros((bp, N_DIR, S5_GROUPS, S5_P), f32),
                  jnp.zeros((bp, N_DIR, S5_GROUPS, S5_P), f32),
                  jnp.zeros((bp, N_DIR, MLSTM_HEADS, MLSTM_DH, MLSTM_DH), f32),
                  jnp.zeros((bp, N_DIR, MLSTM_HEADS, MLSTM_DH), f32),
                  jnp.zeros((bp, N_DIR, MLSTM_HEADS), f32),
                  jnp.zeros((bp, N_DIR, RET_HEADS, RET_DH, RET_DH), f32),
                  jnp.zeros((bp, N_DIR, SSD_HEADS, SSD_P, SSD_N), f32))
    x_ctx, x_lat = x_prompt, x_sample
    ctx_states = []
    for l in range(DEPTH):
        p = {'norm1': norm1[l], 'w_in': w_in[l],
             's5_lambda_re': s5_lambda_re[l], 's5_lambda_im': s5_lambda_im[l], 's5_log_dt': s5_log_dt[l],
             's5_b_re': s5_b_re[l], 's5_b_im': s5_b_im[l], 's5_c_re': s5_c_re[l], 's5_c_im': s5_c_im[l],
             's5_d': s5_d[l], 's5_w_glu': s5_w_glu[l],
             'mlstm_i_bias': mlstm_i_bias[l], 'mlstm_f_bias': mlstm_f_bias[l], 'mlstm_norm': mlstm_norm[l],
             'ret_log_rate': ret_log_rate[l], 'ret_norm': ret_norm[l],
             'ssd_conv_w': ssd_conv_w[l], 'ssd_conv_b': ssd_conv_b[l], 'ssd_dt_bias': ssd_dt_bias[l],
             'ssd_a_log': ssd_a_log[l], 'ssd_d': ssd_d[l], 'ssd_norm': ssd_norm[l],
             'w_out': w_out[l], 'norm2': norm2[l], 'w_mlp1': w_mlp1[l], 'w_mlp2': w_mlp2[l]}
        mod_ctx = jax.nn.silu(c_ctx)[None] @ w_ada[l] + b_ada[l]
        mod_lat = jax.nn.silu(c) @ w_ada[l] + b_ada[l]
        x_ctx, st = _layer(x_ctx, mod_ctx, zero_state, p, None)
        ctx_states.append(st)
        cache_l = (state_s5_re[:, l], state_s5_im[:, l], state_mlstm_c[:, l], state_mlstm_n[:, l],
                   state_mlstm_m[:, l], state_ret[:, l], state_ssd[:, l])
        x_lat, _ = _layer(x_lat, mod_lat, cache_l, p, n_rows)
    y_prompt = _rmsnorm(x_ctx, final_norm)
    y_sample = _rmsnorm(x_lat, final_norm)
    new_s5_re = jnp.stack([s[0] for s in ctx_states], axis=1)
    new_s5_im = jnp.stack([s[1] for s in ctx_states], axis=1)
    new_mlstm_c = jnp.stack([s[2] for s in ctx_states], axis=1)
    new_mlstm_n = jnp.stack([s[3] for s in ctx_states], axis=1)
    new_mlstm_m = jnp.stack([s[4] for s in ctx_states], axis=1)
    new_ret = jnp.stack([s[5] for s in ctx_states], axis=1)
    new_ssd = jnp.stack([s[6] for s in ctx_states], axis=1)
    return (y_prompt, y_sample, new_s5_re, new_s5_im, new_mlstm_c, new_mlstm_n, new_mlstm_m, new_ret, new_ssd)
```

```cpp
#include <hip/hip_runtime.h>
#include <cstdio>
#include <cstdint>
namespace pg8 {
#define PG8_LAS __attribute__((address_space(3)))
typedef unsigned short bf16_t;
typedef short bf16x8 __attribute__((ext_vector_type(8)));
typedef float f32x4 __attribute__((ext_vector_type(4)));
typedef unsigned u32x4 __attribute__((ext_vector_type(4)));
constexpr int BM = 256, BK = 64, HALF = 128, HTB = HALF * BK * 2  , STAGE_BYTES = 8 * HTB, NXCD = 8, WGM = 8;

__host__ __device__ __forceinline__ int lds_byte(int r, int c) { const int st = (r >> 4) * 2 + (c >> 5), rr = r & 15, cc = c & 31, ob = rr * 64 + cc * 2; return st * 1024 + (ob ^ (((ob >> 9) & 1) << 5)); }
__host__ __device__ __forceinline__ void stage_rc(int b, int& R, int& C) { const int st = b / 1024, sb = b % 1024, swz = sb ^ (((sb >> 9) & 1) << 5); R = (st >> 1) * 16 + swz / 64; C = (st & 1) * 32 + (swz % 64) / 2; }
__host__ __device__ __forceinline__ int perm32(int rho) { const int n = rho >> 4, i = rho & 15; return 8 * (i >> 2) + 4 * n + (i & 3); }

struct Unit { int pm, pn; };
struct Gemm { const bf16_t* A; const bf16_t* Bt; int M, N, K; };

struct StaticOrder {
    int nM, nN, nwg, G, c;
    __host__ __device__ void init(int M, int N, int G_, int c_) { nM = M / BM; nN = N / BM; nwg = nM * nN; G = G_; c = c_; }
    __host__ __device__ bool next(int i, Unit& u) const {
        const long L = (long)i * G + c; if (L >= nwg) return false;
        int wgid = (int)L; { const int q = nwg / NXCD, r = nwg % NXCD, xcd = wgid % NXCD, off = wgid / NXCD; wgid = (xcd < r ? xcd * (q + 1) : r * (q + 1) + (xcd - r) * q) + off; }
        const int nig = WGM * nN, gid = wgid / nig, fm = gid * WGM, gsz = (nM - fm) < WGM ? (nM - fm) : WGM;
        u.pm = fm + ((wgid % nig) % gsz); u.pn = (wgid % nig) / gsz; return true;
    }
    __device__ __forceinline__ void a_ready(const Unit&) const {}
    __device__ __forceinline__ void done(const Unit&) const {}
};

__device__ __forceinline__ unsigned cvt_pk_bf16(float lo, float hi) { unsigned r; asm volatile("v_cvt_pk_bf16_f32 %0, %1, %2" : "=v"(r) : "v"(lo), "v"(hi)); return r; }
typedef float f32x2 __attribute__((ext_vector_type(2)));
template <class Epi, class Sched, bool ALIGN_EPI = false, bool SP2 = false>
__device__ __forceinline__ void gemm_phase(PG8_LAS unsigned char* lds, const Gemm g, const Sched& S, const Epi& E) {
    int tid_ = threadIdx.x; asm volatile("" : "+v"(tid_));
    const int tid = tid_, wid = __builtin_amdgcn_readfirstlane(tid >> 6), lane = tid & 63, wr = wid >> 2, wc = wid & 3, fr = lane & 15, fq = lane >> 4;
    const int K = g.K, nt = K / BK;
    unsigned voffA[2], voffB[2];
#pragma unroll
    for (int i = 0; i < 2; ++i) { int R, C; stage_rc(tid * 16 + i * 8192, R, C); const int Rb = Epi::PERM ? ((R & ~31) + perm32(R & 31)) : R;
        voffA[i] = (unsigned)(R * K + C) * 2u; voffB[i] = (unsigned)(Rb * K + C) * 2u; }
    const size_t kstep = (size_t)(BK * 2);
    const size_t hstep = (size_t)HALF * K * 2;
    const size_t tstep = 2 * hstep;
    const unsigned ldsw = (unsigned)wid * 1024u;
    const int aoff = lds_byte(wr * 64 + fr, fq * 8), boff = lds_byte(wc * 32 + fr, fq * 8);
#define PG8_SA(b, h) (((b) * 2 + (h)) * HTB)
#define PG8_SB(b, h) ((4 + (b) * 2 + (h)) * HTB)
#define PG8_STAGE(bufoff, gbase, voff) do { _Pragma("unroll") for (int _i = 0; _i < 2; ++_i) \
        __builtin_amdgcn_global_load_lds((const unsigned*)((const char*)(gbase) + (voff)[_i]), (PG8_LAS unsigned*)(lds + (bufoff) + ldsw + _i * 8192), 16, 0, 0); } while (0)
#define PG8_LDA(dst, b, h) do { _Pragma("unroll") for (int m = 0; m < 4; ++m) _Pragma("unroll") for (int k = 0; k < 2; ++k) dst[m][k] = *(const PG8_LAS bf16x8*)(lds + PG8_SA(b, h) + aoff + m * 2048 + k * 1024); } while (0)
#define PG8_LDB(dst, b, h) do { _Pragma("unroll") for (int n = 0; n < 2; ++n) _Pragma("unroll") for (int k = 0; k < 2; ++k) dst[n][k] = *(const PG8_LAS bf16x8*)(lds + PG8_SB(b, h) + boff + n * 2048 + k * 1024); } while (0)
#define PG8_MMA(ai, bj, At, Bt) do { __builtin_amdgcn_s_setprio(1); _Pragma("unroll") for (int m = 0; m < 4; ++m) _Pragma("unroll") for (int n = 0; n < 2; ++n) _Pragma("unroll") for (int k = 0; k < 2; ++k) \
        acc[ai][bj][m][n] = __builtin_amdgcn_mfma_f32_16x16x32_bf16(Bt[n][k], At[m][k], acc[ai][bj][m][n], 0, 0, 0); __builtin_amdgcn_s_setprio(0); } while (0)
#define PG8_WAIT_V(n) asm volatile("s_waitcnt vmcnt(" #n ")" ::: "memory")
#define PG8_WAIT_L(n) asm volatile("s_waitcnt lgkmcnt(" #n ")" ::: "memory")
#define PG8_BAR __builtin_amdgcn_s_barrier()
#define PG8_SCHED __builtin_amdgcn_sched_barrier(0)
    Unit cur, nxt; int ui = 0;
    if (!S.next(0, cur)) return;
    f32x4 acc[2][2][4][2];
#pragma unroll
    for (int a = 0; a < 2; ++a)
#pragma unroll
        for (int b = 0; b < 2; ++b)
#pragma unroll
            for (int m = 0; m < 4; ++m)
#pragma unroll
                for (int n = 0; n < 2; ++n) acc[a][b][m][n] = (f32x4){0.f, 0.f, 0.f, 0.f};
    bf16x8 At[4][2], B0[2][2], B1[2][2];
    const char* cA = (const char*)g.A + (size_t)cur.pm * tstep; const char* cB = (const char*)g.Bt + (size_t)cur.pn * tstep;
    S.a_ready(cur);
    if constexpr (SP2) {
        PG8_STAGE(PG8_SB(0, 0), cB, voffB); PG8_STAGE(PG8_SB(0, 1), cB + hstep, voffB); PG8_STAGE(PG8_SA(0, 0), cA, voffA); PG8_STAGE(PG8_SA(0, 1), cA + hstep, voffA);
        if (wr == 1) PG8_BAR;
        PG8_WAIT_V(2); PG8_BAR;
        PG8_STAGE(PG8_SB(1, 0), cB + kstep, voffB); PG8_STAGE(PG8_SA(1, 0), cA + kstep, voffA); PG8_STAGE(PG8_SB(1, 1), cB + hstep + kstep, voffB);
        PG8_WAIT_V(6); PG8_BAR;
    } else {
        PG8_STAGE(PG8_SB(0, 0), cB, voffB); PG8_STAGE(PG8_SA(0, 0), cA, voffA); PG8_STAGE(PG8_SB(0, 1), cB + hstep, voffB); PG8_STAGE(PG8_SA(0, 1), cA + hstep, voffA);
        if (wr == 1) PG8_BAR;
        PG8_WAIT_V(4); PG8_BAR;
        PG8_STAGE(PG8_SB(1, 0), cB + kstep, voffB); PG8_STAGE(PG8_SA(1, 0), cA + kstep, voffA); PG8_STAGE(PG8_SB(1, 1), cB + hstep + kstep, voffB);
        PG8_WAIT_V(6); PG8_BAR;
    }
    for (;;) {
        const bool has_next = S.next(ui + 1, nxt);
        const char* nA = has_next ? (const char*)g.A + (size_t)nxt.pm * tstep : cA; const char* nB = has_next ? (const char*)g.Bt + (size_t)nxt.pn * tstep : cB;
        for (int t = 0; t < nt; t += 2) {
            const bool last = (t == nt - 2);
            const char* a1 = cA + (size_t)(t + 1) * kstep;
            const char* a2 = last ? nA : cA + (size_t)(t + 2) * kstep; const char* b2 = last ? nB : cB + (size_t)(t + 2) * kstep;
            const char* a3 = a2 + kstep; const char* b3 = b2 + kstep;
            if (last && has_next) S.a_ready(nxt);
            if constexpr (SP2) {
            PG8_LDB(B0, 0, 0); PG8_LDB(B1, 0, 1); PG8_SCHED; PG8_LDA(At, 0, 0); PG8_STAGE(PG8_SA(1, 1), a1 + hstep, voffA);
            PG8_WAIT_V(8); PG8_WAIT_L(0); PG8_BAR; PG8_MMA(0, 0, At, B0); PG8_MMA(0, 1, At, B1); PG8_BAR; PG8_SCHED;
            PG8_LDA(At, 0, 1); PG8_STAGE(PG8_SB(0, 0), b2, voffB); PG8_STAGE(PG8_SB(0, 1), b2 + hstep, voffB); PG8_STAGE(PG8_SA(0, 0), a2, voffA);
            PG8_WAIT_V(8); PG8_WAIT_L(0); PG8_BAR; PG8_MMA(1, 0, At, B0); PG8_MMA(1, 1, At, B1); PG8_BAR; PG8_SCHED;
            PG8_LDB(B0, 1, 0); PG8_LDB(B1, 1, 1); PG8_SCHED; PG8_LDA(At, 1, 0); PG8_STAGE(PG8_SA(0, 1), a2 + hstep, voffA);
            PG8_WAIT_V(8); PG8_WAIT_L(0); PG8_BAR; PG8_MMA(0, 0, At, B0); PG8_MMA(0, 1, At, B1); PG8_BAR; PG8_SCHED;
            PG8_LDA(At, 1, 1); PG8_STAGE(PG8_SB(1, 0), b3, voffB); PG8_STAGE(PG8_SB(1, 1), b3 + hstep, voffB); PG8_STAGE(PG8_SA(1, 0), a3, voffA);
            PG8_WAIT_V(8); PG8_WAIT_L(0); PG8_BAR; PG8_MMA(1, 0, At, B0); PG8_MMA(1, 1, At, B1); PG8_BAR; PG8_SCHED;
            } else {
            PG8_LDB(B0, 0, 0); PG8_SCHED; PG8_LDA(At, 0, 0); PG8_STAGE(PG8_SA(1, 1), a1 + hstep, voffA);
            PG8_WAIT_L(8); PG8_BAR; PG8_WAIT_L(0); PG8_MMA(0, 0, At, B0); PG8_BAR; PG8_SCHED;
            PG8_LDB(B1, 0, 1); PG8_STAGE(PG8_SB(0, 0), b2, voffB);
            PG8_BAR; PG8_WAIT_L(0); PG8_MMA(0, 1, At, B1); PG8_BAR;
            PG8_LDA(At, 0, 1); PG8_STAGE(PG8_SA(0, 0), a2, voffA);
            PG8_BAR; PG8_WAIT_L(0); PG8_MMA(1, 0, At, B0); PG8_BAR; PG8_SCHED;
            PG8_STAGE(PG8_SB(0, 1), b2 + hstep, voffB);
            PG8_WAIT_V(6); PG8_BAR; PG8_MMA(1, 1, At, B1); PG8_BAR;
            PG8_LDB(B0, 1, 0); PG8_SCHED; PG8_LDA(At, 1, 0); PG8_STAGE(PG8_SA(0, 1), a2 + hstep, voffA);
            PG8_WAIT_L(8); PG8_BAR; PG8_WAIT_L(0); PG8_MMA(0, 0, At, B0); PG8_BAR; PG8_SCHED;
            PG8_LDB(B1, 1, 1); PG8_STAGE(PG8_SB(1, 0), b3, voffB);
            PG8_BAR; PG8_WAIT_L(0); PG8_MMA(0, 1, At, B1); PG8_BAR;
            PG8_LDA(At, 1, 1); PG8_STAGE(PG8_SA(1, 0), a3, voffA);
            PG8_BAR; PG8_WAIT_L(0); PG8_MMA(1, 0, At, B0); PG8_BAR; PG8_SCHED;
            PG8_STAGE(PG8_SB(1, 1), b3 + hstep, voffB);
            PG8_WAIT_V(6); PG8_BAR; PG8_MMA(1, 1, At, B1); PG8_BAR;
            }
        }
        if constexpr (ALIGN_EPI) { if (wr == 0) PG8_BAR; }
        if constexpr (!Epi::AFTER_DRAIN) { E(acc, cur, wr, wc, fr, fq); S.done(cur); }
        if (!has_next) break;
#pragma unroll
        for (int a = 0; a < 2; ++a)
#pragma unroll
            for (int b = 0; b < 2; ++b)
#pragma unroll
                for (int m = 0; m < 4; ++m)
#pragma unroll
                    for (int n = 0; n < 2; ++n) acc[a][b][m][n] = (f32x4){0.f, 0.f, 0.f, 0.f};
        cur = nxt; cA = nA; cB = nB; ++ui;
        if constexpr (ALIGN_EPI) { if (wr == 1) PG8_BAR; }
    }
    PG8_WAIT_V(0);
    if constexpr (!ALIGN_EPI) { if (wr == 0) PG8_BAR; }
    PG8_BAR;
    if constexpr (Epi::AFTER_DRAIN) { E.fused(acc, cur, wr, wc, fr, fq, lds, wid, lane); S.done(cur); }
#undef PG8_SA
#undef PG8_SB
#undef PG8_STAGE
#undef PG8_LDA
#undef PG8_LDB
#undef PG8_MMA
#undef PG8_WAIT_V
#undef PG8_WAIT_L
#undef PG8_BAR
#undef PG8_SCHED
}
}
#define GAS __attribute__((address_space(1)))
#define LAS __attribute__((address_space(3)))
typedef unsigned short bf16;
typedef unsigned v4u __attribute__((ext_vector_type(4)));
typedef float f32x4 __attribute__((ext_vector_type(4)));
typedef short bf16x8 __attribute__((ext_vector_type(8)));
typedef GAS unsigned gu32;
typedef GAS unsigned long long gu64;
#define RLX_AGENT __ATOMIC_RELAXED, __HIP_MEMORY_SCOPE_AGENT
#define LDS_WAIT() asm volatile("s_waitcnt lgkmcnt(0)" ::: "memory")
#define VM_WAIT() asm volatile("s_waitcnt vmcnt(0)" ::: "memory")
__device__ __forceinline__ unsigned long long rt() { return __builtin_amdgcn_s_memrealtime(); }
__device__ __forceinline__ unsigned f2bf(float f) { unsigned u = __builtin_bit_cast(unsigned, f); return (u + 0x7fffu + ((u >> 16) & 1u)) >> 16; }
__device__ __forceinline__ unsigned pk2(float lo, float hi) { return f2bf(lo) | (f2bf(hi) << 16); }
#define XB_TMO      128
#define XB_XCNT(j)  (256  + 64 * (j))
#define XB_XSUB(j)  (1280 + 64 * (j))
#define XB_XGEN(j)  (2304 + 64 * (j))
#define XB_TOP      3328
#define XB_TOPGEN   3392
#define XCD_BAR_WORDS 3456
#define XB_SPIN_CAP (1u << 18)

__device__ __forceinline__ unsigned xb_ld(unsigned* p)              { return __hip_atomic_load(p, __ATOMIC_RELAXED, __HIP_MEMORY_SCOPE_AGENT); }
__device__ __forceinline__ unsigned xb_add(unsigned* p, unsigned v) { return __hip_atomic_fetch_add(p, v, __ATOMIC_RELAXED, __HIP_MEMORY_SCOPE_AGENT); }
__device__ __forceinline__ unsigned xb_xcc_id() { return (unsigned)__builtin_amdgcn_s_getreg((3 << 11) | 20) & 0xFu; }
#define XB_SPIN(cond, bar) do { unsigned _sp = 0; while (cond) { __builtin_amdgcn_s_sleep(1); \
    if ((++_sp & 255u) == 0u) { if (xb_ld(&(bar)[XB_TMO])) break; if (_sp > XB_SPIN_CAP) { atomicAdd(&(bar)[XB_TMO], 1u); break; } } } } while (0)

struct XcdBarrier {
    unsigned* bar; unsigned x;
    volatile LAS unsigned* st;
};

__device__ __forceinline__ XcdBarrier xcd_barrier_post(unsigned* bar, volatile LAS unsigned* st) {
    XcdBarrier b; b.bar = bar; b.x = xb_xcc_id(); b.st = st;
    if (threadIdx.x == 0) (void)xb_add(&bar[XB_XCNT(b.x)], 1u);
    return b;
}
__device__ __forceinline__ void xcd_barrier_complete(unsigned* bar, unsigned x, unsigned& nloc, unsigned& nx) {
    const unsigned G = gridDim.x * gridDim.y * gridDim.z;
    unsigned sum, cnt, mine, sp = 0u;
    for (;;) {
        sum = 0u; cnt = 0u; mine = 0u;
#pragma unroll
        for (unsigned j = 0; j < 16; ++j) { const unsigned c = xb_ld(&bar[XB_XCNT(j)]); sum += c; cnt += (c > 0u) ? 1u : 0u; mine = (j == x) ? c : mine; }
        if (sum == G) break;
        __builtin_amdgcn_s_sleep(1);
        if ((++sp & 255u) == 0u) { if (xb_ld(&bar[XB_TMO])) break; if (sp > XB_SPIN_CAP) { atomicAdd(&bar[XB_TMO], 1u); break; } }
    }
    nloc = mine > 0u ? mine : 1u; nx = cnt > 0u ? cnt : 1u;
}

__device__ __forceinline__ void xcd_barrier(const XcdBarrier& b) {
    asm volatile("s_waitcnt vmcnt(0)" ::: "memory");
    __syncthreads();
    if (threadIdx.x == 0) {
        unsigned* bar = b.bar;
        __builtin_amdgcn_s_waitcnt(0);
        unsigned nloc = b.st[0], nx = b.st[1];
        if (nloc == 0u) { xcd_barrier_complete(bar, b.x, nloc, nx); b.st[0] = nloc; b.st[1] = nx; }
        const unsigned old = xb_add(&bar[XB_XSUB(b.x)], 1u);
        const unsigned gen = old / nloc;
        if (old + 1u == (gen + 1u) * nloc) {
            __builtin_amdgcn_fence(__ATOMIC_RELEASE, "agent");
            asm volatile("s_waitcnt vmcnt(0)" ::: "memory");
            const unsigned og = xb_add(&bar[XB_TOP], 1u);
            const unsigned tg = og / nx;
            if (og + 1u == (tg + 1u) * nx) xb_add(&bar[XB_TOPGEN], 1u);
            else XB_SPIN(xb_ld(&bar[XB_TOPGEN]) == tg, bar);
            __builtin_amdgcn_fence(__ATOMIC_ACQUIRE, "agent");
            xb_add(&bar[XB_XGEN(b.x)], 1u);
            asm volatile("s_waitcnt vmcnt(0)" ::: "memory");
        } else {
            XB_SPIN(xb_ld(&bar[XB_XGEN(b.x)]) == gen, bar);
            __builtin_amdgcn_fence(__ATOMIC_ACQUIRE, "agent");
            asm volatile("s_waitcnt vmcnt(0)" ::: "memory");
        }
    }
    __syncthreads();
}
constexpr int NWAVES = 8, NT = 512;
constexpr int D = 2048, NLAYER = 4;
constexpr int MC = 32 * 256, ML = 4 * 4096, M = MC + ML;
constexpr int DIN = 6176, NPROJ = 6144, NPAD = 6400, DFF = 8192, GWID = 512;
constexpr int NCP = M / 128;
constexpr float EPS = 1e-6f;
constexpr int PC_S5U = 0, PC_MQ = 512, PC_MK = 1024, PC_MV = 1536, PC_MO = 2048, PC_RQ = 2560, PC_RK = 3072, PC_RV = 3584, PC_RG = 4096, PC_DZ = 4608, PC_DX = 5120, PC_DB = 5632, PC_DC = 5888;
enum { I_XP = 0, I_XS, I_C, I_SS5R, I_SS5I, I_SMC, I_SMN, I_SMM, I_SRET, I_SSSD, I_CCTX, I_NORM1, I_WADA, I_BADA, I_WIN, I_S5LR, I_S5LI, I_S5DT, I_S5BR, I_S5BI, I_S5CR, I_S5CI, I_S5D, I_S5GLU,
       I_MIB, I_MFB, I_MNORM, I_RRATE, I_RNORM, I_CONVW, I_CONVB, I_DTB, I_ALOG, I_SSDD, I_SNORM, I_WOUT, I_NORM2, I_WM1, I_WM2, I_FNORM, N_IN };
constexpr size_t O_YP = 0, O_YS = (size_t)MC * D, O_S5R = (size_t)M * D, O_S5I = O_S5R + 524288, O_MC = O_S5I + 524288, O_MN = O_MC + 16777216, O_MM = O_MN + 131072, O_RET = O_MM + 1024, O_SSD = O_RET + 16777216, O_END = O_SSD + 16777216;

constexpr size_t MiB = 1u << 20;
constexpr size_t WS_CTL = 0, CTL_ZERO_BYTES = 1 * MiB;
constexpr size_t WS_MOD = 1 * MiB;
constexpr size_t WS_S5T = 2 * MiB;
constexpr size_t WS_ROPE = 5 * MiB;
constexpr size_t WS_GATES = 6 * MiB;
constexpr size_t WS_MLNLOC = 9 * MiB;
constexpr size_t WS_MLNIN = 10 * MiB;
constexpr size_t WS_MLSC = 11 * MiB;
constexpr size_t WS_MLMIN = 11 * MiB + 65536;
constexpr size_t WS_SDSC = 11 * MiB + 131072;
constexpr size_t WS_S5LOC = 12 * MiB;
constexpr size_t WS_WGT = 20 * MiB;
constexpr size_t WS_W1T = 22 * MiB;
constexpr size_t WS_WOT = 122 * MiB;
constexpr size_t WS_WM1T = 154 * MiB;
constexpr size_t WS_WM2T = 282 * MiB;
constexpr size_t WS_H = 410 * MiB;
constexpr size_t WS_Y = 506 * MiB;
constexpr size_t WS_YA = 602 * MiB;
constexpr size_t WS_MLCIN = 626 * MiB;
constexpr size_t WS_RTIN = 674 * MiB;
constexpr size_t WS_SDIN = 722 * MiB;
constexpr size_t WS_PROJ = 770 * MiB;
constexpr size_t WS_MLCLOC = 1058 * MiB;
constexpr size_t WS_HID = 770 * MiB;
constexpr size_t WS_RTLOC = 1154 * MiB;
constexpr size_t WS_SDLOC = 1250 * MiB;
constexpr size_t WS_END = 1346 * MiB;
constexpr int CW_TMO = 0, CW_BAR = 4096;

constexpr int LDT = 272;
constexpr int TS = 128 * LDT;
constexpr int LDX = 144;
constexpr int TSX = 128 * LDX;
constexpr int SCAL_OFF = 4 * TS;
constexpr int MISC_OFF = 163840 - 256;
constexpr int LDS_BYTES = 163840;
#define SCA(i) ((LAS float*)(F.lds + SCAL_OFF + (i) * 512))
typedef float f32x16 __attribute__((ext_vector_type(16)));
typedef float f32x2 __attribute__((ext_vector_type(2)));
typedef short s16x4 __attribute__((ext_vector_type(4)));
typedef unsigned u32x2 __attribute__((ext_vector_type(2)));
struct Args { const float* in[N_IN]; float* out; unsigned char* ws; int ph_lo, ph_hi; };
struct Frame {
    LAS unsigned char* lds;
    float* out; unsigned char* ws;
    int tid, lane, wave, G, bid;
};
typedef const __attribute__((address_space(4))) Args KArgs;
__device__ __forceinline__ KArgs* kargs() { KArgs* p = (KArgs*)__builtin_amdgcn_kernarg_segment_ptr(); asm volatile("" : "+s"(p)); return p; }
__device__ __forceinline__ Frame fresh(const Frame& F) { Frame R = F; unsigned long long l = (unsigned long long)(size_t)R.lds; unsigned ll = (unsigned)l; asm volatile("" : "+s"(ll), "+s"(R.out), "+s"(R.ws), "+s"(R.wave), "+s"(R.G), "+s"(R.bid), "+v"(R.tid), "+v"(R.lane)); R.lds = (LAS unsigned char*)(size_t)ll; return R; }
#define INP(i) (A.in[i])
#define WSP(T, off) ((T*)(F.ws + (off)))
__device__ __forceinline__ float bf2f(unsigned short b) { return __uint_as_float((unsigned)b << 16); }
__device__ __forceinline__ float bflo(unsigned w) { return __uint_as_float(w << 16); }
__device__ __forceinline__ float bfhi(unsigned w) { return __uint_as_float(w & 0xffff0000u); }
__device__ __forceinline__ float sigmoidf_(float x) { return 1.f / (1.f + __expf(-x)); }
__device__ __forceinline__ float siluf_(float x) { return x * sigmoidf_(x); }
__device__ __forceinline__ float wave_sum(float v) {
#pragma unroll
    for (int o = 1; o < 64; o <<= 1) v += __shfl_xor(v, o);
    return v;
}
__device__ __forceinline__ float wave_max(float v) {
#pragma unroll
    for (int o = 1; o < 64; o <<= 1) v = fmaxf(v, __shfl_xor(v, o));
    return v;
}
template <bool MAX> __device__ __forceinline__ void wave_scan128(const LAS float* in, LAS float* out, int lane, bool rev, float init) {
    const int i0 = rev ? 127 - 2 * lane : 2 * lane, i1 = rev ? i0 - 1 : i0 + 1;
    float e0 = in[i0], e1 = in[i1];
    if (lane == 0) e0 = MAX ? fmaxf(e0, init) : e0 + init;
    float inc = MAX ? fmaxf(e0, e1) : e0 + e1;
#pragma unroll
    for (int o = 1; o < 64; o <<= 1) { const float t = __shfl_up(inc, o); if (lane >= o) inc = MAX ? fmaxf(inc, t) : inc + t; }
    float exc = __shfl_up(inc, 1);
    const float o0 = (lane == 0) ? e0 : (MAX ? fmaxf(exc, e0) : exc + e0);
    out[i0] = o0; out[i1] = inc;
}
__device__ __forceinline__ s16x4 lds_tr(const LAS unsigned char* p) {
    typedef short v4i16_t __attribute__((ext_vector_type(4)));
    return __builtin_bit_cast(s16x4, __builtin_amdgcn_ds_read_tr16_b64_v4i16((LAS v4i16_t*)p));
}
__device__ __forceinline__ bf16x8 frag_row(const LAS unsigned char* base, int ld, int r0, int k0, int lane) {
    return *(const LAS bf16x8*)(base + (r0 + (lane & 31)) * ld + (k0 + 8 * (lane >> 5)) * 2);
}
__device__ __forceinline__ bf16x8 frag_tr(const LAS unsigned char* base, int ld, int k0, int c0, int lane) {
    const int h = lane >> 5, blk = (lane >> 4) & 1, q = (lane & 15) >> 2, p = lane & 3;
    const LAS unsigned char* a = base + (k0 + 8 * h + q) * ld + (c0 + 16 * blk + 4 * p) * 2;
    const s16x4 lo = lds_tr(a), hi = lds_tr(a + 4 * ld);
    return (bf16x8){lo[0], lo[1], lo[2], lo[3], hi[0], hi[1], hi[2], hi[3]};
}
#define MFMA32(a, b, c) __builtin_amdgcn_mfma_f32_32x32x16_bf16((a), (b), (c), 0, 0, 0)
#define ZERO16 ((f32x16){0.f,0.f,0.f,0.f,0.f,0.f,0.f,0.f,0.f,0.f,0.f,0.f,0.f,0.f,0.f,0.f})
__device__ __forceinline__ int crow(int i, int hh) { return (i & 3) + 8 * (i >> 2) + 4 * hh; }

__device__ __forceinline__ const float* x_in_row(const Frame& F, KArgs& A, int l, int r) {
    if (l == 0) return r < MC ? INP(I_XP) + (size_t)r * D : INP(I_XS) + (size_t)(r - MC) * D;
    return F.out + (size_t)r * D;
}
__device__ __forceinline__ int mod_row(int r) { return r < MC ? 0 : 1 + (r - MC) / 4096; }
__device__ __forceinline__ const float* mod_ptr(const Frame& F, int l, int mrow, int part) { return WSP(const float, WS_MOD) + ((size_t)(l * 5 + mrow) * 6 + part) * D; }
struct Seq { int cp0, nch, c, b, lat; };
__device__ __forceinline__ Seq seq_of(int cp) { Seq s; if (cp < 64) { s.lat = 0; s.b = cp >> 1; s.cp0 = cp & ~1; s.nch = 2; s.c = cp & 1; } else { s.lat = 1; s.b = (cp - 64) >> 5; s.cp0 = 64 + (s.b << 5); s.nch = 32; s.c = (cp - 64) & 31; } return s; }
__device__ __forceinline__ int w1_newcol(int n) { return n < 2560 ? n : (n < 2576 ? n - 2560 + 6144 : (n < 6160 ? n - 16 : n)); }
template <bool MAPW1> __device__ __forceinline__ void p0_transpose_item(const float* W, int K, int N, bf16* WT, LAS float* scr, int item, int lane) {
    const int nblk = N / 32, kb = item / nblk, nb = item % nblk, k0 = 64 * kb, n0 = 32 * nb;
#pragma unroll 8
    for (int i = 0; i < 32; ++i) { const int kk = 2 * i + (lane >> 5); scr[kk * 33 + (lane & 31)] = W[(size_t)(k0 + kk) * N + n0 + (lane & 31)]; }
    LDS_WAIT(); asm volatile("" ::: "memory");
    const int c = lane & 7;
#pragma unroll
    for (int j = 0; j < 4; ++j) { const int n = (lane >> 3) + 8 * j; const LAS float* s = scr + (8 * c) * 33 + n;
        v4u o; o.x = pk2(s[0 * 33], s[1 * 33]); o.y = pk2(s[2 * 33], s[3 * 33]); o.z = pk2(s[4 * 33], s[5 * 33]); o.w = pk2(s[6 * 33], s[7 * 33]);
        const int nr = MAPW1 ? w1_newcol(n0 + n) : (n0 + n);
        *(GAS v4u*)(WT + (size_t)nr * K + k0 + 8 * c) = o; }
    LDS_WAIT(); asm volatile("" ::: "memory");
}
constexpr int S5T_STRIDE = 9216;
__device__ __forceinline__ unsigned char* s5tab(const Frame& F, int l, int d, int g) { return F.ws + WS_S5T + (size_t)((l * 2 + d) * 32 + g) * S5T_STRIDE; }

__device__ __forceinline__ void p0_prologue(Frame& F, KArgs& A) {
    {
        LAS float* scr = (LAS float*)(F.lds + F.wave * 16384);
        const int gw = F.bid * NWAVES + F.wave, NGW = F.G * NWAVES;
        constexpr int I_1 = (D / 64) * (DIN / 32), I_G = (GWID / 64) * (GWID / 32), I_O = (D / 64) * (D / 32), I_M1 = (D / 64) * (DFF / 32), I_M2 = (DFF / 64) * (D / 32);
        constexpr int PER_L = I_1 + I_G + I_O + I_M1 + I_M2;
        for (int it = gw; it < NLAYER * PER_L; it += NGW) {
            const int l = it / PER_L; int r = it % PER_L;
            if (r < I_1) { p0_transpose_item<true>(INP(I_WIN) + (size_t)l * D * DIN, D, DIN, WSP(bf16, WS_W1T) + (size_t)l * NPAD * D, scr, r, F.lane); continue; } r -= I_1;
            if (r < I_G) { p0_transpose_item<false>(INP(I_S5GLU) + (size_t)l * GWID * GWID, GWID, GWID, WSP(bf16, WS_WGT) + (size_t)l * GWID * GWID, scr, r, F.lane); continue; } r -= I_G;
            if (r < I_O) { p0_transpose_item<false>(INP(I_WOUT) + (size_t)l * D * D, D, D, WSP(bf16, WS_WOT) + (size_t)l * D * D, scr, r, F.lane); continue; } r -= I_O;
            if (r < I_M1) { p0_transpose_item<false>(INP(I_WM1) + (size_t)l * D * DFF, D, DFF, WSP(bf16, WS_WM1T) + (size_t)l * DFF * D, scr, r, F.lane); continue; } r -= I_M1;
            p0_transpose_item<false>(INP(I_WM2) + (size_t)l * DFF * D, DFF, D, WSP(bf16, WS_WM2T) + (size_t)l * D * DFF, scr, r, F.lane);
        }
        const int gt = F.bid * NT + F.tid, NGT = F.G * NT;
        for (int i = gt; i < NLAYER * 224 * 256; i += NGT) { const int l = i / (224 * 256), r = i % (224 * 256);
            *(GAS v4u*)(WSP(bf16, WS_W1T) + ((size_t)l * NPAD + DIN) * D + (size_t)r * 8) = (v4u){0u, 0u, 0u, 0u}; }
        for (int i = gt; i < NLAYER * 2 * 32 * 64; i += NGT) {
            const int p = i & 63, g = (i >> 6) & 31, d = (i >> 11) & 1, l = i >> 12;
            const int ldg = (l * 2 + d) * 32 + g;
            const double lre = INP(I_S5LR)[ldg * 64 + p], lim = INP(I_S5LI)[ldg * 64 + p], dt = exp((double)INP(I_S5DT)[ldg]);
            const double er = exp(lre * dt), br = er * cos(lim * dt), bi = er * sin(lim * dt);
            const double e128 = exp(128.0 * lre * dt), b128r = e128 * cos(128.0 * lim * dt), b128i = e128 * sin(128.0 * lim * dt);
            const double nr = br - 1.0, ni = bi, den = lre * lre + lim * lim;
            const double cr = (nr * lre + ni * lim) / den, ci = (ni * lre - nr * lim) / den;
            unsigned char* tb = s5tab(F, l, d, g);
            float* lam = (float*)tb; lam[2 * p] = (float)br; lam[2 * p + 1] = (float)bi;
            float* l128 = (float*)(tb + 512); l128[2 * p] = (float)b128r; l128[2 * p + 1] = (float)b128i;
            bf16* bb = (bf16*)(tb + 1024); bf16* ct = (bf16*)(tb + 5120);
            for (int c = 0; c < 16; ++c) {
                const double Br = INP(I_S5BR)[(size_t)(ldg * 64 + p) * 16 + c], Bi = INP(I_S5BI)[(size_t)(ldg * 64 + p) * 16 + c];
                bb[p * 16 + c] = (bf16)f2bf((float)(cr * Br - ci * Bi));
                bb[(64 + p) * 16 + c] = (bf16)f2bf((float)(cr * Bi + ci * Br));
                ct[c * 128 + p] = (bf16)f2bf(INP(I_S5CR)[(size_t)(ldg * 16 + c) * 64 + p]);
                ct[c * 128 + 64 + p] = (bf16)f2bf(-INP(I_S5CI)[(size_t)(ldg * 16 + c) * 64 + p]);
            }
        }
        for (int i = gt; i < 64 * 32; i += NGT) { const int pos = i >> 5, k = i & 31; const double f = pow(10000.0, -(double)k / 32.0), a = pos * f;
            WSP(f32x2, WS_ROPE)[i] = (f32x2){(float)cos(a), (float)sin(a)}; }
    }
    __syncthreads();
    {
        LAS float* sc = (LAS float*)F.lds;
        LAS float* red = (LAS float*)(F.lds + 65536);
        for (int i = F.tid; i < 5 * D; i += NT) { const int r = i / D, k = i % D; const float v = r == 0 ? INP(I_CCTX)[k] : INP(I_C)[(r - 1) * D + k]; sc[i] = siluf_(v); }
        __syncthreads();
        for (int it = F.bid; it < NLAYER * 96; it += F.G) {
            const int l = it / 96, c0 = (it % 96) * 128;
            const float* W = INP(I_WADA) + (size_t)l * D * (6 * D);
            float acc[5][4];
#pragma unroll
            for (int r = 0; r < 5; ++r)
#pragma unroll
                for (int j = 0; j < 4; ++j) acc[r][j] = 0.f;
            const int cl = F.lane & 31, kp = F.lane >> 5;
#pragma unroll 4
            for (int kk = 0; kk < 128; ++kk) {
                const int k = F.wave * 256 + 2 * kk + kp;
                const f32x4 w = *(const f32x4*)(W + (size_t)k * (6 * D) + c0 + 4 * cl);
#pragma unroll
                for (int r = 0; r < 5; ++r) { const float s = sc[r * D + k]; acc[r][0] += s * w.x; acc[r][1] += s * w.y; acc[r][2] += s * w.z; acc[r][3] += s * w.w; }
            }
#pragma unroll
            for (int r = 0; r < 5; ++r)
#pragma unroll
                for (int j = 0; j < 4; ++j) { acc[r][j] += __shfl_xor(acc[r][j], 32); }
            if (kp == 0) {
#pragma unroll
                for (int r = 0; r < 5; ++r)
#pragma unroll
                    for (int j = 0; j < 4; ++j) red[(F.wave * 5 + r) * 128 + 4 * cl + j] = acc[r][j];
            }
            __syncthreads();
            for (int i = F.tid; i < 5 * 128; i += NT) { const int r = i >> 7, j = i & 127; float s = 0.f;
#pragma unroll
                for (int w = 0; w < 8; ++w) s += red[(w * 5 + r) * 128 + j];
                WSP(float, WS_MOD)[(size_t)(l * 5 + r) * (6 * D) + c0 + j] = s + INP(I_BADA)[(size_t)l * (6 * D) + c0 + j]; }
            __syncthreads();
        }
    }
}

__device__ __forceinline__ void norm_phase(Frame& F, KArgs& A, int l, int which  ) {
    const int gw = F.bid * NWAVES + F.wave, NGW = F.G * NWAVES;
    const float* gain = (which == 0 ? INP(I_NORM1) : INP(I_NORM2)) + (size_t)l * D;
    for (int m = gw; m < M; m += NGW) {
        const float* xr = (which == 0) ? x_in_row(F, A, l, m) : F.out + (size_t)m * D;
        const int mr = mod_row(m);
        const float* sh = mod_ptr(F, l, mr, which == 0 ? 0 : 3); const float* scp = mod_ptr(F, l, mr, which == 0 ? 1 : 4);
        f32x4 v[8]; float s = 0.f;
#pragma unroll
        for (int j = 0; j < 8; ++j) { v[j] = *(const f32x4*)(xr + 4 * F.lane + 256 * j); s += (v[j].x * v[j].x + v[j].y * v[j].y) + (v[j].z * v[j].z + v[j].w * v[j].w); }
        const float rstd = rsqrtf(wave_sum(s) * (1.f / D) + EPS);
        bf16* orow = WSP(bf16, WS_H) + (size_t)m * D;
#pragma unroll
        for (int j = 0; j < 8; ++j) { const int c = 4 * F.lane + 256 * j;
            const f32x4 g4 = *(const f32x4*)(gain + c), s4 = *(const f32x4*)(scp + c), h4 = *(const f32x4*)(sh + c);
            const float o0 = v[j].x * rstd * g4.x * (1.f + s4.x) + h4.x, o1 = v[j].y * rstd * g4.y * (1.f + s4.y) + h4.y, o2 = v[j].z * rstd * g4.z * (1.f + s4.z) + h4.z, o3 = v[j].w * rstd * g4.w * (1.f + s4.w) + h4.w;
            *(u32x2*)(orow + c) = (u32x2){pk2(o0, o1), pk2(o2, o3)}; }
    }
}
__device__ __forceinline__ void final_norm_phase(Frame& F, KArgs& A) {
    const int gw = F.bid * NWAVES + F.wave, NGW = F.G * NWAVES;
    const float* gain = INP(I_FNORM);
    for (int m = gw; m < M; m += NGW) {
        float* xr = F.out + (size_t)m * D;
        f32x4 v[8]; float s = 0.f;
#pragma unroll
        for (int j = 0; j < 8; ++j) { v[j] = *(const f32x4*)(xr + 4 * F.lane + 256 * j); s += (v[j].x * v[j].x + v[j].y * v[j].y) + (v[j].z * v[j].z + v[j].w * v[j].w); }
        const float rstd = rsqrtf(wave_sum(s) * (1.f / D) + EPS);
#pragma unroll
        for (int j = 0; j < 8; ++j) { const int c = 4 * F.lane + 256 * j; const f32x4 g4 = *(const f32x4*)(gain + c);
            *(f32x4*)(xr + c) = (f32x4){v[j].x * rstd * g4.x, v[j].y * rstd * g4.y, v[j].z * rstd * g4.z, v[j].w * rstd * g4.w}; }
    }
}
namespace epi {
using pg8::Unit; using pg8::f32x4; using pg8::u32x4; using pg8::bf16_t; using pg8::cvt_pk_bf16;
constexpr int BMq = 256, HALFq = 128;
struct EpiProj {
    static constexpr bool PERM = true, AFTER_DRAIN = false;
    bf16_t* P; float* G;
    __device__ __forceinline__ void operator()(const f32x4 (&acc)[2][2][4][2], const Unit& u, int wr, int wc, int fr, int fq) const {
        const int row0 = u.pm * BMq + wr * 64 + fr;
        if (u.pn < 24) {
            const int col0 = u.pn * BMq + wc * 32 + 8 * fq;
#pragma unroll
            for (int ai = 0; ai < 2; ++ai)
#pragma unroll
                for (int m = 0; m < 4; ++m) { bf16_t* rowp = P + (size_t)(row0 + ai * HALFq + m * 16) * NPROJ + col0;
#pragma unroll
                    for (int bj = 0; bj < 2; ++bj) { const f32x4 v0 = acc[ai][bj][m][0], v1 = acc[ai][bj][m][1];
                        u32x4 w; w.x = cvt_pk_bf16(v0[0], v0[1]); w.y = cvt_pk_bf16(v0[2], v0[3]); w.z = cvt_pk_bf16(v1[0], v1[1]); w.w = cvt_pk_bf16(v1[2], v1[3]);
                        *(u32x4*)(rowp + bj * HALFq) = w; } }
        } else if (wc == 0) {
#pragma unroll
            for (int ai = 0; ai < 2; ++ai)
#pragma unroll
                for (int m = 0; m < 4; ++m) { float* g = G + (size_t)(row0 + ai * HALFq + m * 16) * 32 + 8 * fq;
                    *(f32x4*)g = acc[ai][0][m][0]; *(f32x4*)(g + 4) = acc[ai][0][m][1]; }
        }
    }
};
struct EpiGlu {
    static constexpr bool PERM = true, AFTER_DRAIN = false;
    const bf16_t* YA; bf16_t* Y;
    __device__ __forceinline__ void operator()(const f32x4 (&acc)[2][2][4][2], const Unit& u, int wr, int wc, int fr, int fq) const {
        const int row0 = u.pm * BMq + wr * 64 + fr, col0 = u.pn * BMq + wc * 32 + 8 * fq;
#pragma unroll
        for (int ai = 0; ai < 2; ++ai)
#pragma unroll
            for (int m = 0; m < 4; ++m) { const int r = row0 + ai * HALFq + m * 16;
#pragma unroll
                for (int bj = 0; bj < 2; ++bj) { const f32x4 v0 = acc[ai][bj][m][0], v1 = acc[ai][bj][m][1];
                    const u32x4 a = *(const u32x4*)(YA + (size_t)r * GWID + col0 + bj * HALFq);
                    float y[8] = {bflo(a.x), bfhi(a.x), bflo(a.y), bfhi(a.y), bflo(a.z), bfhi(a.z), bflo(a.w), bfhi(a.w)};
                    const float g[8] = {v0[0], v0[1], v0[2], v0[3], v1[0], v1[1], v1[2], v1[3]};
#pragma unroll
                    for (int k = 0; k < 8; ++k) y[k] = y[k] * sigmoidf_(g[k]);
                    u32x4 w; w.x = cvt_pk_bf16(y[0], y[1]); w.y = cvt_pk_bf16(y[2], y[3]); w.z = cvt_pk_bf16(y[4], y[5]); w.w = cvt_pk_bf16(y[6], y[7]);
                    *(u32x4*)(Y + (size_t)r * D + col0 + bj * HALFq) = w; } }
    }
};
struct EpiRes {
    static constexpr bool PERM = false, AFTER_DRAIN = false;
    const float* xp; const float* xs; float* X; const float* gate0; int first;
    __device__ __forceinline__ void operator()(const f32x4 (&acc)[2][2][4][2], const Unit& u, int wr, int wc, int fr, int fq) const {
        const int rowt = u.pm * BMq, col0 = u.pn * BMq + wc * 32 + 4 * fq;
        const int mrow = rowt < MC ? 0 : 1 + (rowt - MC) / 4096;
        const float* gate = gate0 + (size_t)mrow * (6 * D);
        const float* base = first ? (rowt < MC ? xp + (size_t)rowt * D : xs + (size_t)(rowt - MC) * D) : X + (size_t)rowt * D;
        float* outp = X + (size_t)rowt * D;
#pragma unroll
        for (int bj = 0; bj < 2; ++bj)
#pragma unroll
            for (int n = 0; n < 2; ++n) { const int c = col0 + bj * HALFq + n * 16; const f32x4 gv = *(const f32x4*)(gate + c);
#pragma unroll
                for (int ai = 0; ai < 2; ++ai)
#pragma unroll
                    for (int m = 0; m < 4; ++m) { const size_t off = (size_t)(wr * 64 + fr + ai * HALFq + m * 16) * D + c;
                        const f32x4 b = *(const f32x4*)(base + off); *(f32x4*)(outp + off) = b + gv * acc[ai][bj][m][n]; } }
    }
};
struct EpiRelu2 {
    static constexpr bool PERM = true, AFTER_DRAIN = false;
    bf16_t* O;
    __device__ __forceinline__ void operator()(const f32x4 (&acc)[2][2][4][2], const Unit& u, int wr, int wc, int fr, int fq) const {
        const int row0 = u.pm * BMq + wr * 64 + fr, col0 = u.pn * BMq + wc * 32 + 8 * fq;
#pragma unroll
        for (int ai = 0; ai < 2; ++ai)
#pragma unroll
            for (int m = 0; m < 4; ++m) { bf16_t* rowp = O + (size_t)(row0 + ai * HALFq + m * 16) * DFF + col0;
#pragma unroll
                for (int bj = 0; bj < 2; ++bj) { f32x4 v0 = acc[ai][bj][m][0], v1 = acc[ai][bj][m][1];
#pragma unroll
                    for (int k = 0; k < 4; ++k) { const float a = fmaxf(v0[k], 0.f), b = fmaxf(v1[k], 0.f); v0[k] = a * a; v1[k] = b * b; }
                    u32x4 w; w.x = cvt_pk_bf16(v0[0], v0[1]); w.y = cvt_pk_bf16(v0[2], v0[3]); w.z = cvt_pk_bf16(v1[0], v1[1]); w.w = cvt_pk_bf16(v1[2], v1[3]);
                    *(u32x4*)(rowp + bj * HALFq) = w; } }
    }
};
}
__device__ __forceinline__ float logsigmoidf_(float x) { return x >= 0.f ? -log1pf(expf(-x)) : x - log1pf(expf(x)); }
__device__ __forceinline__ float softplusf_(float x) { return fmaxf(x, 0.f) + log1pf(expf(-fabsf(x))); }
__device__ __forceinline__ void unpack8(const v4u a, float (&x)[8]) { x[0] = bflo(a.x); x[1] = bfhi(a.x); x[2] = bflo(a.y); x[3] = bfhi(a.y); x[4] = bflo(a.z); x[5] = bfhi(a.z); x[6] = bflo(a.w); x[7] = bfhi(a.w); }
__device__ __forceinline__ v4u pack8(const float (&x)[8], float w) { v4u o; o.x = pk2(x[0] * w, x[1] * w); o.y = pk2(x[2] * w, x[3] * w); o.z = pk2(x[4] * w, x[5] * w); o.w = pk2(x[6] * w, x[7] * w); return o; }
__device__ __forceinline__ void load_tile128(Frame& F, LAS unsigned char* dst, const bf16* src) {
#pragma unroll
    for (int it = 0; it < 4; ++it) { const int i = F.tid + NT * it, r = i >> 4, c = i & 15;
        *(LAS v4u*)(dst + r * LDT + c * 16) = *(const v4u*)(src + (size_t)r * NPROJ + c * 8); }
}
template <int NDST> __device__ __forceinline__ void load_qk(Frame& F, LAS unsigned char* dst0, LAS unsigned char* dst1, const bf16* src, const LAS float* w0, const LAS float* w1, float scale, bool rope, int tpos0) {
#pragma unroll
    for (int it = 0; it < 2; ++it) {
        const int i = F.tid + NT * it, r = i >> 3, c = i & 7;
        float x1[8], x2[8];
        unpack8(*(const v4u*)(src + (size_t)r * NPROJ + c * 8), x1); unpack8(*(const v4u*)(src + (size_t)r * NPROJ + 64 + c * 8), x2);
        if (rope) {
            const int tp = tpos0 + r, pos = c < 4 ? (tp >> 6) : (tp & 63);
            const f32x2* rt = WSP(const f32x2, WS_ROPE) + pos * 32 + ((8 * c) & 31);
#pragma unroll
            for (int j = 0; j < 8; ++j) { const f32x2 cs = rt[j]; const float a = x1[j], b = x2[j]; x1[j] = a * cs.x - b * cs.y; x2[j] = a * cs.y + b * cs.x; }
        }
        const float s0 = scale * (w0 ? w0[r] : 1.f);
        *(LAS v4u*)(dst0 + r * LDT + c * 16) = pack8(x1, s0); *(LAS v4u*)(dst0 + r * LDT + 128 + c * 16) = pack8(x2, s0);
        if (NDST == 2) { const float s1 = scale * w1[r];
            *(LAS v4u*)(dst1 + r * LDT + c * 16) = pack8(x1, s1); *(LAS v4u*)(dst1 + r * LDT + 128 + c * 16) = pack8(x2, s1); }
    }
}
template <int NDST> __device__ __forceinline__ void load_conv(Frame& F, KArgs& A, int l, LAS unsigned char* dst0, LAS unsigned char* dst1, int ldd, int ch0, int nc8, int row0, int seq_lo, int seq_hi,
                                                               const LAS float* w0, const LAS float* w1) {
    const bf16* P = WSP(const bf16, WS_PROJ) + PC_DX + ch0;
    const float* cw = INP(I_CONVW) + (size_t)l * 5 * 1024 + ch0; const float* cb = INP(I_CONVB) + (size_t)l * 1024 + ch0;
    for (int i = F.tid; i < 128 * nc8; i += NT) {
        const int r = i / nc8, c = i % nc8, row = row0 + r;
        float acc[8];
        { const f32x4 b0 = *(const f32x4*)(cb + 8 * c), b1 = *(const f32x4*)(cb + 8 * c + 4); acc[0] = b0.x; acc[1] = b0.y; acc[2] = b0.z; acc[3] = b0.w; acc[4] = b1.x; acc[5] = b1.y; acc[6] = b1.z; acc[7] = b1.w; }
#pragma unroll
        for (int k = 0; k < 5; ++k) { const int rr = row + k - 2;
            if (rr >= seq_lo && rr < seq_hi) { float x[8]; unpack8(*(const v4u*)(P + (size_t)rr * NPROJ + 8 * c), x);
                const f32x4 w0v = *(const f32x4*)(cw + k * 1024 + 8 * c), w1v = *(const f32x4*)(cw + k * 1024 + 8 * c + 4);
                acc[0] += x[0] * w0v.x; acc[1] += x[1] * w0v.y; acc[2] += x[2] * w0v.z; acc[3] += x[3] * w0v.w; acc[4] += x[4] * w1v.x; acc[5] += x[5] * w1v.y; acc[6] += x[6] * w1v.z; acc[7] += x[7] * w1v.w; } }
#pragma unroll
        for (int j = 0; j < 8; ++j) acc[j] = siluf_(acc[j]);
        *(LAS v4u*)(dst0 + r * ldd + c * 16) = pack8(acc, w0 ? w0[r] : 1.f);
        if (NDST == 2) *(LAS v4u*)(dst1 + r * ldd + c * 16) = pack8(acc, w1[r]);
    }
}
__device__ __forceinline__ void kv_state_mfma(Frame& F, const LAS unsigned char* TKf, const LAS unsigned char* TKb, const LAS unsigned char* TV, float* outF, float* outB) {
    const int dvb = F.wave >> 1, dkb0 = (F.wave & 1) * 2, hh = F.lane >> 5;
    f32x16 acc[2][2] = {{ZERO16, ZERO16}, {ZERO16, ZERO16}};
#pragma unroll 1
    for (int ks = 0; ks < 8; ++ks) {
        const bf16x8 a = frag_tr(TV, LDT, 16 * ks, 32 * dvb, F.lane);
#pragma unroll
        for (int j = 0; j < 2; ++j) { acc[0][j] = MFMA32(a, frag_tr(TKf, LDT, 16 * ks, 32 * (dkb0 + j), F.lane), acc[0][j]); acc[1][j] = MFMA32(a, frag_tr(TKb, LDT, 16 * ks, 32 * (dkb0 + j), F.lane), acc[1][j]); }
    }
#pragma unroll
    for (int j = 0; j < 2; ++j)
#pragma unroll
        for (int i = 0; i < 16; ++i) { const int o = (32 * dvb + crow(i, hh)) * 128 + 32 * (dkb0 + j) + (F.lane & 31); outF[o] = acc[0][j][i]; outB[o] = acc[1][j][i]; }
}
__device__ __forceinline__ void qkT_mfma(Frame& F, const LAS unsigned char* TQ, const LAS unsigned char* TK, f32x16 (&qk)[2]) {
    const int tb = F.wave >> 1, sb0 = (F.wave & 1) * 2;
    qk[0] = ZERO16; qk[1] = ZERO16;
#pragma unroll 1
    for (int ks = 0; ks < 8; ++ks) { const bf16x8 bq = frag_row(TQ, LDT, 32 * tb, 16 * ks, F.lane);
#pragma unroll
        for (int j = 0; j < 2; ++j) qk[j] = MFMA32(frag_row(TK, LDT, 32 * (sb0 + j), 16 * ks, F.lane), bq, qk[j]); }
}
__device__ __forceinline__ void pv_mfma(Frame& F, const LAS unsigned char* TP, const LAS unsigned char* TV, f32x16 (&o)[2]) {
    const int tb = F.wave >> 1, eb0 = (F.wave & 1) * 2;
#pragma unroll 1
    for (int ks = 0; ks < 8; ++ks) { const bf16x8 ap = frag_row(TP, LDT, 32 * tb, 16 * ks, F.lane);
#pragma unroll
        for (int j = 0; j < 2; ++j) o[j] = MFMA32(ap, frag_tr(TV, LDT, 16 * ks, 32 * (eb0 + j), F.lane), o[j]); }
}
__device__ __forceinline__ void qs_mfma(Frame& F, const LAS unsigned char* TQ, const bf16* ST, f32x16 (&o)[2]) {
    const int tb = F.wave >> 1, eb0 = (F.wave & 1) * 2, hh = F.lane >> 5;
#pragma unroll 1
    for (int ks = 0; ks < 8; ++ks) { const bf16x8 aq = frag_row(TQ, LDT, 32 * tb, 16 * ks, F.lane);
#pragma unroll
        for (int j = 0; j < 2; ++j) { const bf16x8 b = *(const bf16x8*)(ST + (size_t)(32 * (eb0 + j) + (F.lane & 31)) * 128 + 16 * ks + 8 * hh); o[j] = MFMA32(aq, b, o[j]); } }
}
__device__ __forceinline__ void hs_to_lds(Frame& F, LAS unsigned char* HS, const f32x16 (&hs)[2]) {
    const int tb = F.wave >> 1, eb0 = (F.wave & 1) * 2, hh = F.lane >> 5;
#pragma unroll
    for (int j = 0; j < 2; ++j)
#pragma unroll
        for (int i = 0; i < 16; ++i) *(LAS float*)(HS + (32 * tb + crow(i, hh)) * 528 + (32 * (eb0 + j) + (F.lane & 31)) * 4) = hs[j][i];
}
template <int GATE> __device__ __forceinline__ void head_out(Frame& F, const LAS unsigned char* HS, const float* gain, const bf16* gsrc  , bf16* ydst  ) {
    const int t = F.tid >> 2, seg = F.tid & 3;
    float v[32]; float ss = 0.f;
#pragma unroll
    for (int k = 0; k < 8; ++k) { const f32x4 x = *(const LAS f32x4*)(HS + t * 528 + (32 * seg + 4 * k) * 4); v[4 * k] = x.x; v[4 * k + 1] = x.y; v[4 * k + 2] = x.z; v[4 * k + 3] = x.w; ss += (x.x * x.x + x.y * x.y) + (x.z * x.z + x.w * x.w); }
    ss += __shfl_xor(ss, 1); ss += __shfl_xor(ss, 2);
    const float r = rsqrtf(ss * (1.f / 128.f) + EPS);
#pragma unroll
    for (int k = 0; k < 4; ++k) { float g[8]; unpack8(*(const v4u*)(gsrc + (size_t)t * NPROJ + 32 * seg + 8 * k), g); float o[8];
#pragma unroll
        for (int j = 0; j < 8; ++j) { const float gg = GATE == 0 ? sigmoidf_(g[j]) : siluf_(g[j]); o[j] = v[8 * k + j] * r * gain[32 * seg + 8 * k + j] * gg; }
        *(v4u*)(ydst + (size_t)t * D + 32 * seg + 8 * k) = pack8(o, 1.f); }
}

__device__ __forceinline__ void mlstm_gates(Frame& F, KArgs& A, int l, int cp, int h) {
    if (F.tid < 128) { const float* g = WSP(const float, WS_GATES) + (size_t)(cp * 128 + F.tid) * 32;
        SCA(0)[F.tid] = g[h] + INP(I_MIB)[(l * 2 + 0) * 4 + h]; SCA(1)[F.tid] = g[4 + h] + INP(I_MIB)[(l * 2 + 1) * 4 + h];
        SCA(2)[F.tid] = logsigmoidf_(g[8 + h] + INP(I_MFB)[(l * 2 + 0) * 4 + h]); SCA(3)[F.tid] = logsigmoidf_(g[12 + h] + INP(I_MFB)[(l * 2 + 1) * 4 + h]); }
    __syncthreads();
    if (F.wave == 0) wave_scan128<false>(SCA(2), SCA(4), F.lane, false, 0.f);
    if (F.wave == 1) wave_scan128<false>(SCA(3), SCA(5), F.lane, true, 0.f);
    __syncthreads();
}
__device__ __forceinline__ void mlstm_local_item(Frame F, KArgs& A, int l, int cp, int h) {
    mlstm_gates(F, A, l, cp, h);
    if (F.wave < 2) { const int d = F.wave; const LAS float* bc = SCA(4 + d); const LAS float* ig = SCA(d); const float tot = d == 0 ? bc[127] : bc[0];
        const int s0 = 2 * F.lane; const float g0 = tot - bc[s0] + ig[s0], g1 = tot - bc[s0 + 1] + ig[s0 + 1];
        const float mx = wave_max(fmaxf(g0, g1));
        SCA(6 + d)[s0] = expf(g0 - mx); SCA(6 + d)[s0 + 1] = expf(g1 - mx);
        if (F.lane == 0) { float* sc = WSP(float, WS_MLSC) + ((cp * 2 + d) * 4 + h) * 2; sc[0] = tot; sc[1] = mx; } }
    __syncthreads();
    const bf16* P = WSP(const bf16, WS_PROJ) + (size_t)cp * 128 * NPROJ;
    load_qk<2>(F, F.lds, F.lds + TS, P + PC_MK + h * 128, SCA(6), SCA(7), 0.08838834764831845f, false, 0);
    load_tile128(F, F.lds + 2 * TS, P + PC_MV + h * 128);
    __syncthreads();
    kv_state_mfma(F, F.lds, F.lds + TS, F.lds + 2 * TS, WSP(float, WS_MLCLOC) + (size_t)((cp * 2 + 0) * 4 + h) * 16384, WSP(float, WS_MLCLOC) + (size_t)((cp * 2 + 1) * 4 + h) * 16384);
    if (F.tid < 256) { const int d = F.tid >> 7, dk = F.tid & 127; const LAS unsigned char* T = F.lds + d * TS; float s = 0.f;
        for (int r = 0; r < 128; ++r) s += bf2f(*(const LAS unsigned short*)(T + r * LDT + dk * 2));
        WSP(float, WS_MLNLOC)[((cp * 2 + d) * 4 + h) * 128 + dk] = s; }
    __syncthreads();
}
__device__ __forceinline__ void mlstm_out_item(Frame F, KArgs& A, int l, int cp, int h) {
    mlstm_gates(F, A, l, cp, h);
    const float min_f = WSP(const float, WS_MLMIN)[(cp * 2 + 0) * 4 + h], min_b = WSP(const float, WS_MLMIN)[(cp * 2 + 1) * 4 + h];
    if (F.tid < 256) { const int d = F.tid >> 7, s = F.tid & 127; SCA(6 + d)[s] = SCA(d)[s] - SCA(4 + d)[s]; }
    __syncthreads();
    if (F.wave == 0) wave_scan128<true>(SCA(6), SCA(8), F.lane, false, min_f);
    if (F.wave == 1) wave_scan128<true>(SCA(7), SCA(9), F.lane, true, min_b);
    const bf16* P = WSP(const bf16, WS_PROJ) + (size_t)cp * 128 * NPROJ;
    LAS unsigned char* TQ = F.lds; LAS unsigned char* TK = F.lds + TS; LAS unsigned char* TV = F.lds + 2 * TS; LAS unsigned char* TP = F.lds + 3 * TS;
    load_tile128(F, TQ, P + PC_MQ + h * 128);
    load_qk<1>(F, TK, nullptr, P + PC_MK + h * 128, nullptr, nullptr, 0.08838834764831845f, false, 0);
    load_tile128(F, TV, P + PC_MV + h * 128);
    __syncthreads();
    f32x16 hs[2] = {ZERO16, ZERO16};
    const int tb = F.wave >> 1, sb0 = (F.wave & 1) * 2, hh = F.lane >> 5, t = 32 * tb + (F.lane & 31);
#pragma unroll 1
    for (int d = 0; d < 2; ++d) {
        const LAS float* av = SCA(6 + d); const float Mt = SCA(8 + d)[t]; const float m_in = d == 0 ? min_f : min_b;
        if (F.tid < 128) SCA(12)[F.tid] = WSP(const float, WS_MLNIN)[((cp * 2 + d) * 4 + h) * 128 + F.tid];
        f32x16 qk[2]; qkT_mfma(F, TQ, TK, qk);
#pragma unroll
        for (int j = 0; j < 2; ++j)
#pragma unroll
            for (int i4 = 0; i4 < 4; ++i4) { const int sb = 32 * (sb0 + j) + 8 * i4 + 4 * hh; float p[4];
#pragma unroll
                for (int i = 0; i < 4; ++i) { const int s = sb + i; const bool ok = d == 0 ? (s <= t) : (s >= t); p[i] = ok ? qk[j][4 * i4 + i] * __expf(av[s] - Mt) : 0.f; }
                *(LAS u32x2*)(TP + t * LDT + sb * 2) = (u32x2){pk2(p[0], p[1]), pk2(p[2], p[3])}; }
        __syncthreads();
        if (F.tid < 128) { const int tt = F.tid; float ds = 0.f, qn = 0.f;
#pragma unroll 4
            for (int k = 0; k < 16; ++k) { float x[8]; unpack8(*(const LAS v4u*)(TP + tt * LDT + 16 * k), x); float q[8]; unpack8(*(const LAS v4u*)(TQ + tt * LDT + 16 * k), q);
#pragma unroll
                for (int j = 0; j < 8; ++j) { ds += x[j]; qn += q[j] * SCA(12)[8 * k + j]; } }
            const float Mtt = SCA(8 + d)[tt], wint = expf(m_in - Mtt), den = ds + wint * qn, dd = fmaxf(fabsf(den), expf(-(SCA(4 + d)[tt] + Mtt)));
            SCA(10)[tt] = wint / dd; SCA(11)[tt] = 1.f / dd; }
        { f32x16 num[2] = {ZERO16, ZERO16};
          pv_mfma(F, TP, TV, num);
          __syncthreads();
#pragma unroll
          for (int j = 0; j < 2; ++j)
#pragma unroll
            for (int i = 0; i < 16; ++i) hs[j][i] += SCA(11)[32 * tb + crow(i, hh)] * num[j][i]; }
        { f32x16 qc[2] = {ZERO16, ZERO16};
          qs_mfma(F, TQ, WSP(const bf16, WS_MLCIN) + (size_t)((cp * 2 + d) * 4 + h) * 16384, qc);
#pragma unroll
          for (int j = 0; j < 2; ++j)
#pragma unroll
            for (int i = 0; i < 16; ++i) hs[j][i] += SCA(10)[32 * tb + crow(i, hh)] * qc[j][i]; }
    }
    __syncthreads();
    hs_to_lds(F, F.lds, hs);
    __syncthreads();
    head_out<0>(F, F.lds, INP(I_MNORM) + (size_t)l * GWID + h * 128, P + PC_MO + h * 128, WSP(bf16, WS_Y) + (size_t)cp * 128 * D + 512 + h * 128);
    __syncthreads();
}

__device__ __forceinline__ void ret_local_item(Frame F, KArgs& A, int l, int cp, int h) {
    const float lgf = -expf(INP(I_RRATE)[(l * 2 + 0) * 4 + h]), lgb = -expf(INP(I_RRATE)[(l * 2 + 1) * 4 + h]);
    if (F.tid < 128) { SCA(6)[F.tid] = expf((127.f - (float)F.tid) * lgf); SCA(7)[F.tid] = expf((float)F.tid * lgb); }
    __syncthreads();
    const Seq sq = seq_of(cp);
    const bf16* P = WSP(const bf16, WS_PROJ) + (size_t)cp * 128 * NPROJ;
    load_qk<2>(F, F.lds, F.lds + TS, P + PC_RK + h * 128, SCA(6), SCA(7), 0.08838834764831845f, sq.lat != 0, sq.c * 128);
    load_tile128(F, F.lds + 2 * TS, P + PC_RV + h * 128);
    __syncthreads();
    kv_state_mfma(F, F.lds, F.lds + TS, F.lds + 2 * TS, WSP(float, WS_RTLOC) + (size_t)((cp * 2 + 0) * 4 + h) * 16384, WSP(float, WS_RTLOC) + (size_t)((cp * 2 + 1) * 4 + h) * 16384);
    __syncthreads();
}
__device__ __forceinline__ void ret_out_item(Frame F, KArgs& A, int l, int cp, int h) {
    const float lgf = -expf(INP(I_RRATE)[(l * 2 + 0) * 4 + h]), lgb = -expf(INP(I_RRATE)[(l * 2 + 1) * 4 + h]);
    if (F.tid < 128) { SCA(10)[F.tid] = expf(((float)F.tid + 1.f) * lgf); SCA(11)[F.tid] = expf((128.f - (float)F.tid) * lgb); }
    const Seq sq = seq_of(cp);
    const bf16* P = WSP(const bf16, WS_PROJ) + (size_t)cp * 128 * NPROJ;
    LAS unsigned char* TQ = F.lds; LAS unsigned char* TK = F.lds + TS; LAS unsigned char* TV = F.lds + 2 * TS; LAS unsigned char* TP = F.lds + 3 * TS;
    load_qk<1>(F, TQ, nullptr, P + PC_RQ + h * 128, nullptr, nullptr, 1.f, sq.lat != 0, sq.c * 128);
    load_qk<1>(F, TK, nullptr, P + PC_RK + h * 128, nullptr, nullptr, 0.08838834764831845f, sq.lat != 0, sq.c * 128);
    load_tile128(F, TV, P + PC_RV + h * 128);
    __syncthreads();
    f32x16 qk[2]; qkT_mfma(F, TQ, TK, qk);
    const int tb = F.wave >> 1, sb0 = (F.wave & 1) * 2, hh = F.lane >> 5, t = 32 * tb + (F.lane & 31);
#pragma unroll
    for (int j = 0; j < 2; ++j)
#pragma unroll
        for (int i4 = 0; i4 < 4; ++i4) { const int sb = 32 * (sb0 + j) + 8 * i4 + 4 * hh; float p[4];
#pragma unroll
            for (int i = 0; i < 4; ++i) { const int s = sb + i; const float df = (float)(t - s);
                const float dm = (s <= t ? __expf(df * lgf) : 0.f) + (s >= t ? __expf(-df * lgb) : 0.f); p[i] = qk[j][4 * i4 + i] * dm; }
            *(LAS u32x2*)(TP + t * LDT + sb * 2) = (u32x2){pk2(p[0], p[1]), pk2(p[2], p[3])}; }
    __syncthreads();
    f32x16 y[2] = {ZERO16, ZERO16};
    pv_mfma(F, TP, TV, y);
#pragma unroll 1
    for (int d = 0; d < 2; ++d) { f32x16 qs[2] = {ZERO16, ZERO16};
        qs_mfma(F, TQ, WSP(const bf16, WS_RTIN) + (size_t)((cp * 2 + d) * 4 + h) * 16384, qs);
#pragma unroll
        for (int j = 0; j < 2; ++j)
#pragma unroll
            for (int i = 0; i < 16; ++i) y[j][i] += SCA(10 + d)[32 * tb + crow(i, hh)] * qs[j][i]; }
    __syncthreads();
    hs_to_lds(F, F.lds, y);
    __syncthreads();
    head_out<1>(F, F.lds, INP(I_RNORM) + (size_t)l * GWID + h * 128, P + PC_RG + h * 128, WSP(bf16, WS_Y) + (size_t)cp * 128 * D + 1024 + h * 128);
    __syncthreads();
}
template <bool WMODE> __device__ __forceinline__ float ssd_scalars(Frame& F, KArgs& A, int l, int cp, int g) {
    const int d = F.wave >> 2, rr = F.wave & 3, head = g * 4 + rr;
    const float bias = INP(I_DTB)[(l * 2 + d) * 8 + head], arate = -expf(INP(I_ALOG)[(l * 2 + d) * 8 + head]);
    const float* gp = WSP(const float, WS_GATES) + (size_t)(cp * 128) * 32 + 16 + d * 8 + head;
    const int i0 = d ? 127 - 2 * F.lane : 2 * F.lane, i1 = d ? i0 - 1 : i0 + 1;
    const float dt0 = softplusf_(gp[(size_t)i0 * 32] + bias), dt1 = softplusf_(gp[(size_t)i1 * 32] + bias);
    const float a0 = dt0 * arate, a1 = dt1 * arate;
    float inc = a0 + a1;
#pragma unroll
    for (int o = 1; o < 64; o <<= 1) { const float t = __shfl_up(inc, o); if (F.lane >= o) inc += t; }
    const float c1 = inc, c0 = inc - a1, tot = __shfl(inc, 63);
    LAS float* cum = SCA(16 + d * 4 + rr); LAS float* dtw = SCA(24 + d * 4 + rr);
    cum[i0] = c0; cum[i1] = c1;
    if (WMODE) { dtw[i0] = expf(tot - c0) * dt0; dtw[i1] = expf(tot - c1) * dt1; } else { dtw[i0] = dt0; dtw[i1] = dt1; }
    return tot;
}
__device__ __forceinline__ void seq_bounds(int cp, int& lo, int& hi) { if (cp < 64) { lo = (cp >> 1) * 256; hi = lo + 256; } else { lo = MC + ((cp - 64) >> 5) * 4096; hi = lo + 4096; } }
__device__ __forceinline__ void ssd_local_item(Frame F, KArgs& A, int l, int cp, int g) {
    const float tot = ssd_scalars<true>(F, A, l, cp, g);
    if (F.lane == 0) WSP(float, WS_SDSC)[(cp * 2 + (F.wave >> 2)) * 8 + g * 4 + (F.wave & 3)] = tot;
    int lo, hi; seq_bounds(cp, lo, hi);
    LAS unsigned char* TB = F.lds;
    load_conv<1>(F, A, l, TB, nullptr, LDT, 512 + g * 128, 16, cp * 128, lo, hi, nullptr, nullptr);
    __syncthreads();
#pragma unroll 1
    for (int hr = 0; hr < 2; ++hr) {
#pragma unroll 1
        for (int r2 = 0; r2 < 2; ++r2) { const int rr = hr * 2 + r2;
            load_conv<2>(F, A, l, F.lds + TS + (r2 * 2 + 0) * TSX, F.lds + TS + (r2 * 2 + 1) * TSX, LDX, g * 256 + rr * 64, 8, cp * 128, lo, hi, SCA(24 + 0 * 4 + rr), SCA(24 + 1 * 4 + rr)); }
        __syncthreads();
        const int r2 = F.wave >> 2, d = (F.wave >> 1) & 1, pb = F.wave & 1, hh = F.lane >> 5, head = g * 4 + hr * 2 + r2;
        const LAS unsigned char* TX = F.lds + TS + (r2 * 2 + d) * TSX;
        f32x16 acc[4] = {ZERO16, ZERO16, ZERO16, ZERO16};
#pragma unroll 1
        for (int ks = 0; ks < 8; ++ks) { const bf16x8 a = frag_tr(TX, LDX, 16 * ks, 32 * pb, F.lane);
#pragma unroll
            for (int nb = 0; nb < 4; ++nb) acc[nb] = MFMA32(a, frag_tr(TB, LDT, 16 * ks, 32 * nb, F.lane), acc[nb]); }
        float* o = WSP(float, WS_SDLOC) + (size_t)((cp * 2 + d) * 8 + head) * 8192;
#pragma unroll
        for (int nb = 0; nb < 4; ++nb)
#pragma unroll
            for (int i = 0; i < 16; ++i) o[(32 * pb + crow(i, hh)) * 128 + 32 * nb + (F.lane & 31)] = acc[nb][i];
        __syncthreads();
    }
}
__device__ __forceinline__ void ssd_out_item(Frame F, KArgs& A, int l, int cp) {
    int lo, hi; seq_bounds(cp, lo, hi);
    LAS unsigned char* TC = F.lds; LAS unsigned char* TB = F.lds + TS; LAS unsigned char* TP = F.lds + 2 * TS; LAS unsigned char* TX = F.lds + 3 * TS;
    LAS float* SSQ = SCA(14);
    if (F.tid < 128) SSQ[F.tid] = 0.f;
    const int tb = F.wave >> 1, sb0 = (F.wave & 1) * 2, pb = F.wave & 1, hh = F.lane >> 5, t = 32 * tb + (F.lane & 31);
    const bf16* Pz = WSP(const bf16, WS_PROJ) + (size_t)cp * 128 * NPROJ + PC_DZ;
    bf16* Yd = WSP(bf16, WS_Y) + (size_t)cp * 128 * D + 1536;
#pragma unroll 1
    for (int g = 0; g < 2; ++g) {
        (void)ssd_scalars<false>(F, A, l, cp, g);
        load_conv<1>(F, A, l, TC, nullptr, LDT, 768 + g * 128, 16, cp * 128, lo, hi, nullptr, nullptr);
        load_conv<1>(F, A, l, TB, nullptr, LDT, 512 + g * 128, 16, cp * 128, lo, hi, nullptr, nullptr);
        __syncthreads();
        f32x16 cb[2] = {ZERO16, ZERO16};
#pragma unroll 1
        for (int ks = 0; ks < 8; ++ks) { const bf16x8 bq = frag_row(TC, LDT, 32 * tb, 16 * ks, F.lane);
#pragma unroll
            for (int j = 0; j < 2; ++j) cb[j] = MFMA32(frag_row(TB, LDT, 32 * (sb0 + j), 16 * ks, F.lane), bq, cb[j]); }
#pragma unroll 1
        for (int rr = 0; rr < 4; ++rr) {
            const int head = g * 4 + rr;
            load_conv<1>(F, A, l, TX, nullptr, LDX, g * 256 + rr * 64, 8, cp * 128, lo, hi, nullptr, nullptr);
            f32x16 y = ZERO16;
#pragma unroll 1
            for (int d = 0; d < 2; ++d) {
                const LAS float* cum = SCA(16 + d * 4 + rr); const LAS float* dtv = SCA(24 + d * 4 + rr); const float ct = cum[t];
#pragma unroll
                for (int j = 0; j < 2; ++j)
#pragma unroll
                    for (int i4 = 0; i4 < 4; ++i4) { const int sb = 32 * (sb0 + j) + 8 * i4 + 4 * hh; float p[4];
#pragma unroll
                        for (int i = 0; i < 4; ++i) { const int s = sb + i; const bool ok = d == 0 ? (s <= t) : (s >= t); p[i] = ok ? cb[j][4 * i4 + i] * __expf(ct - cum[s]) * dtv[s] : 0.f; }
                        *(LAS u32x2*)(TP + t * LDT + sb * 2) = (u32x2){pk2(p[0], p[1]), pk2(p[2], p[3])}; }
                __syncthreads();
                f32x16 pv = ZERO16, ch = ZERO16;
                const bf16* hin = WSP(const bf16, WS_SDIN) + (size_t)((cp * 2 + d) * 8 + head) * 8192;
#pragma unroll 1
                for (int ks = 0; ks < 8; ++ks) {
                    pv = MFMA32(frag_row(TP, LDT, 32 * tb, 16 * ks, F.lane), frag_tr(TX, LDX, 16 * ks, 32 * pb, F.lane), pv);
                    const bf16x8 bh = *(const bf16x8*)(hin + (size_t)(32 * pb + (F.lane & 31)) * 128 + 16 * ks + 8 * hh);
                    ch = MFMA32(frag_row(TC, LDT, 32 * tb, 16 * ks, F.lane), bh, ch); }
#pragma unroll
                for (int i = 0; i < 16; ++i) y[i] += pv[i] + __expf(cum[32 * tb + crow(i, hh)]) * ch[i];
                __syncthreads();
            }
#pragma unroll
            for (int i = 0; i < 16; ++i) *(LAS float*)(TP + (32 * tb + crow(i, hh)) * LDT + (32 * pb + (F.lane & 31)) * 4) = y[i];
            __syncthreads();
            { const int tt = F.tid >> 2, seg = F.tid & 3; const float Dh = INP(I_SSDD)[l * 8 + head];
                float z[16], x[16], o[16]; float ss = 0.f;
                { float t8[8]; unpack8(*(const v4u*)(Pz + (size_t)tt * NPROJ + head * 64 + 16 * seg), t8); for (int j = 0; j < 8; ++j) z[j] = t8[j];
                  unpack8(*(const v4u*)(Pz + (size_t)tt * NPROJ + head * 64 + 16 * seg + 8), t8); for (int j = 0; j < 8; ++j) z[8 + j] = t8[j];
                  unpack8(*(const LAS v4u*)(TX + tt * LDX + 32 * seg), t8); for (int j = 0; j < 8; ++j) x[j] = t8[j];
                  unpack8(*(const LAS v4u*)(TX + tt * LDX + 32 * seg + 16), t8); for (int j = 0; j < 8; ++j) x[8 + j] = t8[j]; }
#pragma unroll
                for (int k = 0; k < 4; ++k) { const f32x4 yv = *(const LAS f32x4*)(TP + tt * LDT + (16 * seg + 4 * k) * 4);
                    const float yy[4] = {yv.x, yv.y, yv.z, yv.w};
#pragma unroll
                    for (int j = 0; j < 4; ++j) { const float v = (yy[j] + Dh * x[4 * k + j]) * siluf_(z[4 * k + j]); o[4 * k + j] = v; ss += v * v; } }
                ss += __shfl_xor(ss, 1); ss += __shfl_xor(ss, 2);
                if (seg == 0) SSQ[tt] += ss;
                float o0[8], o1[8];
#pragma unroll
                for (int j = 0; j < 8; ++j) { o0[j] = o[j]; o1[j] = o[8 + j]; }
                *(v4u*)(Yd + (size_t)tt * D + head * 64 + 16 * seg) = pack8(o0, 1.f); *(v4u*)(Yd + (size_t)tt * D + head * 64 + 16 * seg + 8) = pack8(o1, 1.f); }
            __syncthreads();
        }
    }
    __builtin_amdgcn_fence(__ATOMIC_RELEASE, "workgroup"); asm volatile("s_waitcnt vmcnt(0)" ::: "memory"); __syncthreads(); __builtin_amdgcn_fence(__ATOMIC_ACQUIRE, "workgroup");
    { const int tt = F.tid >> 2, seg = F.tid & 3; const float r = rsqrtf(SSQ[tt] * (1.f / 512.f) + EPS); const float* gn = INP(I_SNORM) + (size_t)l * GWID + 128 * seg;
#pragma unroll 4
        for (int k = 0; k < 16; ++k) { bf16* p = Yd + (size_t)tt * D + 128 * seg + 8 * k; float v[8];
            unpack8(__builtin_nontemporal_load((const v4u*)p), v);
#pragma unroll
            for (int j = 0; j < 8; ++j) v[j] = v[j] * r * gn[8 * k + j];
            *(v4u*)p = pack8(v, 1.f); } }
    __syncthreads();
}
template <int PASS> __device__ __forceinline__ void s5_item(Frame F, KArgs& A, int l, int cp, int gq) {
    const Seq sq = seq_of(cp);
    const int g = gq * 8 + F.wave, p = F.lane, hh = F.lane >> 5;
    LAS unsigned char* TU = F.lds; LAS unsigned char* BU = F.lds + TS + F.wave * 8704;
    load_tile128(F, TU, WSP(const bf16, WS_PROJ) + (size_t)cp * 128 * NPROJ + PC_S5U + gq * 128);
    __syncthreads();
    typedef float f32x4v __attribute__((ext_vector_type(4)));
    f32x4v yacc[4][2];
    if (PASS == 1) {
#pragma unroll
        for (int a = 0; a < 4; ++a) { yacc[a][0] = (f32x4v){0.f, 0.f, 0.f, 0.f}; yacc[a][1] = (f32x4v){0.f, 0.f, 0.f, 0.f}; } }
#pragma unroll
    for (int d = 0; d < 2; ++d) {
        const unsigned char* tab = s5tab(F, l, d, g);
        const float lr = ((const float*)tab)[2 * p], li = ((const float*)tab)[2 * p + 1];
        float hr = 0.f, hi = 0.f;
        if (PASS == 1) {
            if (sq.lat) { const size_t o = (size_t)(((sq.b * 4 + l) * 2 + d) * 32 + g) * 64 + p; hr = INP(I_SS5R)[o]; hi = INP(I_SS5I)[o]; }
            const float l8r = ((const float*)(tab + 512))[2 * p], l8i = ((const float*)(tab + 512))[2 * p + 1];
            const int n = d == 0 ? sq.c : sq.nch - 1 - sq.c;
            for (int k = 0; k < n; ++k) { const int cc = d == 0 ? k : sq.nch - 1 - k;
                const f32x2 e = *(const f32x2*)(WSP(const float, WS_S5LOC) + ((size_t)(((sq.cp0 + cc) * 2 + d) * 32 + g) * 64 + p) * 2);
                const float nr = l8r * hr - l8i * hi + e.x, ni = l8r * hi + l8i * hr + e.y; hr = nr; hi = ni; }
        }
        const bf16* bb = (const bf16*)(tab + 1024); const bf16* ct = (const bf16*)(tab + 5120);
#pragma unroll
        for (int tbi = 0; tbi < 4; ++tbi) {
            const int tb = d == 0 ? tbi : 3 - tbi;
            const bf16x8 bu = frag_row(TU, LDT, 32 * tb, 16 * F.wave, F.lane);
#pragma unroll
            for (int nb = 0; nb < 4; ++nb) {
                const bf16x8 a = *(const bf16x8*)(bb + (size_t)(32 * nb + (F.lane & 31)) * 16 + 8 * hh);
                const f32x16 acc = MFMA32(a, bu, ZERO16);
#pragma unroll
                for (int i4 = 0; i4 < 4; ++i4) *(LAS u32x2*)(BU + (F.lane & 31) * LDT + (32 * nb + 8 * i4 + 4 * hh) * 2) = (u32x2){pk2(acc[4 * i4], acc[4 * i4 + 1]), pk2(acc[4 * i4 + 2], acc[4 * i4 + 3])};
            }
            asm volatile("s_waitcnt lgkmcnt(0)" ::: "memory");
#pragma unroll 4
            for (int st = 0; st < 32; ++st) { const int tl = d == 0 ? st : 31 - st;
                LAS unsigned short* pr = (LAS unsigned short*)(BU + tl * LDT + p * 2); LAS unsigned short* pi = pr + 64;
                const float br = bf2f(*pr), bi = bf2f(*pi);
                const float nr = lr * hr - li * hi + br, ni = lr * hi + li * hr + bi; hr = nr; hi = ni;
                if (PASS == 1) { *pr = (unsigned short)f2bf(hr); *pi = (unsigned short)f2bf(hi); } }
            if (PASS == 1) {
                asm volatile("s_waitcnt lgkmcnt(0)" ::: "memory");
                typedef short v8s __attribute__((ext_vector_type(8)));
                const int r16 = F.lane & 15, g4 = F.lane >> 4;
#pragma unroll
                for (int ks = 0; ks < 4; ++ks) { const v8s bc = *(const v8s*)(ct + r16 * 128 + 32 * ks + 8 * g4);
#pragma unroll
                    for (int ts = 0; ts < 2; ++ts) { const v8s ah = *(const LAS v8s*)(BU + (16 * ts + r16) * LDT + (32 * ks + 8 * g4) * 2);
                        yacc[tb][ts] = __builtin_amdgcn_mfma_f32_16x16x32_bf16(ah, bc, yacc[tb][ts], 0, 0, 0); } }
                asm volatile("s_waitcnt lgkmcnt(0)" ::: "memory");
            }
        }
        if (PASS == 0) { *(f32x2*)(WSP(float, WS_S5LOC) + ((size_t)((cp * 2 + d) * 32 + g) * 64 + p) * 2) = (f32x2){hr, hi}; }
        else if (!sq.lat && ((d == 0 && sq.c == sq.nch - 1) || (d == 1 && sq.c == 0))) { const size_t o = (size_t)(((sq.b * 4 + l) * 2 + d) * 32 + g) * 64 + p; F.out[O_S5R + o] = hr; F.out[O_S5I + o] = hi; }
    }
    if (PASS == 1) {
        const int r16 = F.lane & 15, g4 = F.lane >> 4; const float Dc = INP(I_S5D)[(size_t)l * GWID + g * 16 + r16];
#pragma unroll
        for (int tb = 0; tb < 4; ++tb)
#pragma unroll
            for (int ts = 0; ts < 2; ++ts)
#pragma unroll
                for (int i = 0; i < 4; ++i) { const int t = 32 * tb + 16 * ts + 4 * g4 + i; LAS unsigned short* up = (LAS unsigned short*)(TU + t * LDT + (16 * F.wave + r16) * 2);
                    const float x = yacc[tb][ts][i] + Dc * bf2f(*up);
                    const float ge = 0.5f * x * (1.f + tanhf(0.7978845608028654f * (x + 0.044715f * x * x * x)));
                    *up = (unsigned short)f2bf(ge); }
        __syncthreads();
        bf16* ya = WSP(bf16, WS_YA) + (size_t)cp * 128 * GWID + gq * 128;
#pragma unroll
        for (int it = 0; it < 4; ++it) { const int i = F.tid + NT * it, r = i >> 4, c = i & 15; *(v4u*)(ya + (size_t)r * GWID + c * 8) = *(const LAS v4u*)(TU + r * LDT + c * 16); }
    }
    __syncthreads();
}

__device__ __forceinline__ void carry_unit(Frame F, KArgs& A, int l, int u) {
    const int sd = u / 96, rem = u % 96, sidx = sd >> 1, d = sd & 1;
    const int lat = sidx < 4, b = lat ? sidx : sidx - 4, nch = lat ? 32 : 2, cp0 = lat ? 64 + 32 * b : 2 * b;
    int type, head, slice;
    if (rem < 32) { type = 0; head = rem >> 3; slice = rem & 7; } else if (rem < 64) { type = 1; head = (rem - 32) >> 3; slice = (rem - 32) & 7; } else { type = 2; head = (rem - 64) >> 2; slice = (rem - 64) & 3; }
    const int e0 = slice * 2048 + F.tid * 4;
    const int nh = type == 2 ? 8 : 4, esz = type == 2 ? 8192 : 16384;
    const float* loc = type == 0 ? WSP(const float, WS_MLCLOC) : (type == 1 ? WSP(const float, WS_RTLOC) : WSP(const float, WS_SDLOC));
    bf16* inb = type == 0 ? WSP(bf16, WS_MLCIN) : (type == 1 ? WSP(bf16, WS_RTIN) : WSP(bf16, WS_SDIN));
    float v[4] = {0.f, 0.f, 0.f, 0.f}, nv[4] = {0.f, 0.f, 0.f, 0.f}, m = 0.f;
    const bool do_n = (type == 0 && slice == 0 && F.tid < 32);
    if (lat) {
        if (type == 2) { const f32x4 s = *(const f32x4*)(INP(I_SSSD) + (size_t)(((b * 4 + l) * 2 + d) * 8 + head) * 8192 + e0); v[0] = s.x; v[1] = s.y; v[2] = s.z; v[3] = s.w; }
        else { const float* s = (type == 0 ? INP(I_SMC) : INP(I_SRET)) + (size_t)(((b * 4 + l) * 2 + d) * 4 + head) * 16384; const int dv = e0 >> 7, dk = e0 & 127;
#pragma unroll
            for (int j = 0; j < 4; ++j) v[j] = s[(dk + j) * 128 + dv]; }
        if (type == 0) { m = INP(I_SMM)[((b * 4 + l) * 2 + d) * 4 + head];
            if (do_n) { const f32x4 s = *(const f32x4*)(INP(I_SMN) + (size_t)(((b * 4 + l) * 2 + d) * 4 + head) * 128 + F.tid * 4); nv[0] = s.x; nv[1] = s.y; nv[2] = s.z; nv[3] = s.w; } }
    }
    const float rdec = type == 1 ? expf(-128.f * expf(INP(I_RRATE)[(l * 2 + d) * 4 + head])) : 1.f;
#pragma unroll 1
    for (int ci = 0; ci < nch; ++ci) {
        const int cp = cp0 + (d == 0 ? ci : nch - 1 - ci);
        const size_t so = (size_t)((cp * 2 + d) * nh + head) * esz + e0;
        *(u32x2*)(inb + so) = (u32x2){pk2(v[0], v[1]), pk2(v[2], v[3])};
        float dec, wl = 1.f;
        if (type == 0) {
            const float* sc = WSP(const float, WS_MLSC) + ((cp * 2 + d) * 4 + head) * 2; const float Bt = sc[0], ml = sc[1];
            if (slice == 0 && F.tid == 0) WSP(float, WS_MLMIN)[(cp * 2 + d) * 4 + head] = m;
            if (do_n) *(f32x4*)(WSP(float, WS_MLNIN) + ((cp * 2 + d) * 4 + head) * 128 + F.tid * 4) = (f32x4){nv[0], nv[1], nv[2], nv[3]};
            const float mn = fmaxf(Bt + m, ml); dec = expf(Bt + m - mn); wl = expf(ml - mn); m = mn;
            if (do_n) { const f32x4 ln = *(const f32x4*)(WSP(const float, WS_MLNLOC) + ((cp * 2 + d) * 4 + head) * 128 + F.tid * 4); nv[0] = dec * nv[0] + wl * ln.x; nv[1] = dec * nv[1] + wl * ln.y; nv[2] = dec * nv[2] + wl * ln.z; nv[3] = dec * nv[3] + wl * ln.w; }
        } else if (type == 1) dec = rdec;
        else dec = expf(WSP(const float, WS_SDSC)[(cp * 2 + d) * 8 + head]);
        const f32x4 lc = *(const f32x4*)(loc + so);
        v[0] = dec * v[0] + wl * lc.x; v[1] = dec * v[1] + wl * lc.y; v[2] = dec * v[2] + wl * lc.z; v[3] = dec * v[3] + wl * lc.w;
    }
    if (!lat) {
        if (type == 2) *(f32x4*)(F.out + O_SSD + (size_t)(((b * 4 + l) * 2 + d) * 8 + head) * 8192 + e0) = (f32x4){v[0], v[1], v[2], v[3]};
        else {
            LAS float* tr = (LAS float*)F.lds;
            const int dvl = F.tid >> 5, dk = (F.tid & 31) * 4;
#pragma unroll
            for (int j = 0; j < 4; ++j) tr[dvl * 129 + dk + j] = v[j];
            __syncthreads();
            const int dk2 = F.tid >> 2, q = F.tid & 3;
            float* o = F.out + (type == 0 ? O_MC : O_RET) + (size_t)(((b * 4 + l) * 2 + d) * 4 + head) * 16384 + (size_t)dk2 * 128 + slice * 16 + 4 * q;
            *(f32x4*)o = (f32x4){tr[(4 * q) * 129 + dk2], tr[(4 * q + 1) * 129 + dk2], tr[(4 * q + 2) * 129 + dk2], tr[(4 * q + 3) * 129 + dk2]};
            if (type == 0) { if (do_n) *(f32x4*)(F.out + O_MN + (size_t)(((b * 4 + l) * 2 + d) * 4 + head) * 128 + F.tid * 4) = (f32x4){nv[0], nv[1], nv[2], nv[3]};
                if (slice == 0 && F.tid == 0) F.out[O_MM + ((b * 4 + l) * 2 + d) * 4 + head] = m; }
            __syncthreads();
        }
    }
}
constexpr int N_PHASES = 2 + 9 * NLAYER;
__global__ void __launch_bounds__(NT, 2) hymba_fwd(Args A) {
    extern __shared__ __attribute__((aligned(16))) unsigned char lds_raw[];
    Frame F0;
    F0.lds = (LAS unsigned char*)lds_raw;
    F0.tid = threadIdx.x; F0.lane = F0.tid & 63; F0.wave = __builtin_amdgcn_readfirstlane(F0.tid >> 6);
    F0.G = gridDim.x; F0.bid = blockIdx.x; F0.out = A.out; F0.ws = A.ws;
    volatile LAS unsigned* MISC = (volatile LAS unsigned*)(F0.lds + MISC_OFF);
    if (F0.tid < 64) MISC[F0.tid] = 0u;
    __syncthreads();
    unsigned* barw = (unsigned*)(F0.ws + WS_CTL) + CW_BAR;
    XcdBarrier bar = xcd_barrier_post(barw, MISC + 8);
    const int lo = A.ph_lo, hi = A.ph_hi;
#define KA (*kargs())
#define IN(k) (lo <= (k) && (k) < hi)
#define SEAM(k) do { if (IN(k) && IN((k) + 1)) xcd_barrier(bar); } while (0)

    if (IN(0)) { Frame F = fresh(F0); p0_prologue(F, KA); } SEAM(0);

#pragma unroll 1
    for (int l = 0; l < NLAYER; ++l) {
        const int pb = 1 + 9 * l;
        if (IN(pb + 0)) { Frame F = fresh(F0); norm_phase(F, KA, l, 0); } SEAM(pb + 0);
        if (IN(pb + 1)) { Frame F = fresh(F0);
            pg8::Gemm g{WSP(const pg8::bf16_t, WS_H), WSP(const pg8::bf16_t, WS_W1T) + (size_t)l * NPAD * D, M, NPAD, D}; pg8::StaticOrder S; S.init(M, NPAD, F.G, F.bid);
            epi::EpiProj E{WSP(pg8::bf16_t, WS_PROJ), WSP(float, WS_GATES)};
            pg8::gemm_phase<epi::EpiProj, pg8::StaticOrder, true, true>(F.lds, g, S, E);
        } SEAM(pb + 1);
        if (IN(pb + 2)) { Frame F = fresh(F0);
            for (int it = F.bid; it < 384 + 768 + 768 + 768; it += F.G) {
                if (it < 384) ssd_local_item(fresh(F), KA, l, it >> 1, it & 1);
                else if (it < 1152) mlstm_local_item(fresh(F), KA, l, (it - 384) >> 2, (it - 384) & 3);
                else if (it < 1920) ret_local_item(fresh(F), KA, l, (it - 1152) >> 2, (it - 1152) & 3);
                else s5_item<0>(fresh(F), KA, l, (it - 1920) >> 2, (it - 1920) & 3);
            }
        } SEAM(pb + 2);
        if (IN(pb + 3)) { Frame F = fresh(F0);
            for (int it = F.bid; it < 768 + 768 + 6144; it += F.G) {
                if (it < 768) carry_unit(fresh(F), KA, l, it);
                else if (it < 1536) s5_item<1>(fresh(F), KA, l, (it - 768) >> 2, (it - 768) & 3);
                else carry_unit(fresh(F), KA, l, it - 768);
            }
        } SEAM(pb + 3);
        if (IN(pb + 4)) { Frame F = fresh(F0);
            for (int it = F.bid; it < 192 + 768 + 768; it += F.G) {
                if (it < 192) ssd_out_item(fresh(F), KA, l, it);
                else if (it < 960) mlstm_out_item(fresh(F), KA, l, (it - 192) >> 2, (it - 192) & 3);
                else ret_out_item(fresh(F), KA, l, (it - 960) >> 2, (it - 960) & 3);
            }
            pg8::Gemm g{WSP(const pg8::bf16_t, WS_YA), WSP(const pg8::bf16_t, WS_WGT) + (size_t)l * GWID * GWID, M, GWID, GWID}; pg8::StaticOrder S; S.init(M, GWID, F.G, F.bid);
            epi::EpiGlu E{WSP(const pg8::bf16_t, WS_YA), WSP(pg8::bf16_t, WS_Y)};
            pg8::gemm_phase<epi::EpiGlu, pg8::StaticOrder, true, true>(F.lds, g, S, E);
        } SEAM(pb + 4);
        if (IN(pb + 5)) { Frame F = fresh(F0);
            pg8::Gemm g{WSP(const pg8::bf16_t, WS_Y), WSP(const pg8::bf16_t, WS_WOT) + (size_t)l * D * D, M, D, D}; pg8::StaticOrder S; S.init(M, D, F.G, F.bid);
            KArgs& A_ = KA; epi::EpiRes E{A_.in[I_XP], A_.in[I_XS], F.out, WSP(const float, WS_MOD) + (size_t)(l * 5) * (6 * D) + 2 * D, l == 0 ? 1 : 0};
            pg8::gemm_phase<epi::EpiRes, pg8::StaticOrder, true, true>(F.lds, g, S, E);
        } SEAM(pb + 5);
        if (IN(pb + 6)) { Frame F = fresh(F0); norm_phase(F, KA, l, 1); } SEAM(pb + 6);
        if (IN(pb + 7)) { Frame F = fresh(F0);
            pg8::Gemm g{WSP(const pg8::bf16_t, WS_H), WSP(const pg8::bf16_t, WS_WM1T) + (size_t)l * DFF * D, M, DFF, D}; pg8::StaticOrder S; S.init(M, DFF, F.G, F.bid);
            epi::EpiRelu2 E{WSP(pg8::bf16_t, WS_HID)};
            pg8::gemm_phase<epi::EpiRelu2, pg8::StaticOrder, true, true>(F.lds, g, S, E);
        } SEAM(pb + 7);
        if (IN(pb + 8)) { Frame F = fresh(F0);
            pg8::Gemm g{WSP(const pg8::bf16_t, WS_HID), WSP(const pg8::bf16_t, WS_WM2T) + (size_t)l * D * DFF, M, D, DFF}; pg8::StaticOrder S; S.init(M, D, F.G, F.bid);
            KArgs& A_ = KA; epi::EpiRes E{A_.in[I_XP], A_.in[I_XS], F.out, WSP(const float, WS_MOD) + (size_t)(l * 5) * (6 * D) + 5 * D, 0};
            pg8::gemm_phase<epi::EpiRes, pg8::StaticOrder, true, true>(F.lds, g, S, E);
        } SEAM(pb + 8);
    }
    if (IN(N_PHASES - 1)) { Frame F = fresh(F0); final_norm_phase(F, KA); }
#undef IN
#undef SEAM
}

#ifndef MK_LAUNCH_PER_PHASE
#define MK_LAUNCH_PER_PHASE 1
#endif
extern "C" void kernel_launch(void* const* d_in, const int* in_sizes, int n_in, void* d_out, int out_size, void* d_ws, size_t ws_size, hipStream_t stream) {
    static int grid = 0;
    if (grid == 0) {
        if (n_in != N_IN || (size_t)out_size != O_END || ws_size < WS_END) { fprintf(stderr, "kernel_launch: shape mismatch: n_in %d out %d ws %zu (need %zu)\n", n_in, out_size, ws_size, (size_t)WS_END); grid = -1; return; }
        int dev = 0, cus = 0, per_cu = 0;
        if (hipGetDevice(&dev) != hipSuccess || hipDeviceGetAttribute(&cus, hipDeviceAttributeMultiprocessorCount, dev) != hipSuccess) { grid = -1; return; }
        if (hipFuncSetAttribute((const void*)hymba_fwd, hipFuncAttributeMaxDynamicSharedMemorySize, LDS_BYTES) != hipSuccess) { fprintf(stderr, "kernel_launch: hipFuncSetAttribute failed\n"); grid = -1; return; }
        if (hipOccupancyMaxActiveBlocksPerMultiprocessor(&per_cu, (const void*)hymba_fwd, NT, LDS_BYTES) != hipSuccess || per_cu < 1) fprintf(stderr, "kernel_launch: occupancy query says %d\n", per_cu);
        (void)hipGetLastError();
        grid = cus;
    }
    if (grid < 0) return;
    (void)hipMemsetAsync((char*)d_ws + WS_CTL, 0, CTL_ZERO_BYTES, stream);
    Args a{};
    for (int i = 0; i < N_IN; ++i) a.in[i] = (const float*)d_in[i];
    a.out = (float*)d_out; a.ws = (unsigned char*)d_ws;
#if MK_LAUNCH_PER_PHASE
    for (int p = 0; p < N_PHASES; ++p) { a.ph_lo = p; a.ph_hi = p + 1; hipLaunchKernelGGL(hymba_fwd, dim3(grid), dim3(NT), LDS_BYTES, stream, a); }
#else
    a.ph_lo = 0; a.ph_hi = N_PHASES;
    hipLaunchKernelGGL(hymba_fwd, dim3(grid), dim3(NT), LDS_BYTES, stream, a);
#endif
    const hipError_t le = hipPeekAtLastError();
    if (le != hipSuccess) fprintf(stderr, "kernel_launch: launch failed: %s\n", hipGetErrorName(le));
}
```

```cpp
#include <hip/hip_runtime.h>
#include <cstdio>
#include <cstdint>
namespace pg8 {
#define PG8_LAS __attribute__((address_space(3)))
typedef unsigned short bf16_t;
typedef short bf16x8 __attribute__((ext_vector_type(8)));
typedef float f32x4 __attribute__((ext_vector_type(4)));
typedef unsigned u32x4 __attribute__((ext_vector_type(4)));
constexpr int BM = 256, BK = 64, HALF = 128, HTB = HALF * BK * 2  , STAGE_BYTES = 8 * HTB, NXCD = 8, WGM = 8;

__host__ __device__ __forceinline__ int lds_byte(int r, int c) { const int st = (r >> 4) * 2 + (c >> 5), rr = r & 15, cc = c & 31, ob = rr * 64 + cc * 2; return st * 1024 + (ob ^ (((ob >> 9) & 1) << 5)); }
__host__ __device__ __forceinline__ void stage_rc(int b, int& R, int& C) { const int st = b / 1024, sb = b % 1024, swz = sb ^ (((sb >> 9) & 1) << 5); R = (st >> 1) * 16 + swz / 64; C = (st & 1) * 32 + (swz % 64) / 2; }
__host__ __device__ __forceinline__ int perm32(int rho) { const int n = rho >> 4, i = rho & 15; return 8 * (i >> 2) + 4 * n + (i & 3); }

struct Unit { int pm, pn; };
struct Gemm { const bf16_t* A; const bf16_t* Bt; int M, N, K; };

struct StaticOrder {
    int nM, nN, nwg, G, c;
    __host__ __device__ void init(int M, int N, int G_, int c_) { nM = M / BM; nN = N / BM; nwg = nM * nN; G = G_; c = c_; }
    __host__ __device__ bool next(int i, Unit& u) const {
        const long L = (long)i * G + c; if (L >= nwg) return false;
        int wgid = (int)L; { const int q = nwg / NXCD, r = nwg % NXCD, xcd = wgid % NXCD, off = wgid / NXCD; wgid = (xcd < r ? xcd * (q + 1) : r * (q + 1) + (xcd - r) * q) + off; }
        const int nig = WGM * nN, gid = wgid / nig, fm = gid * WGM, gsz = (nM - fm) < WGM ? (nM - fm) : WGM;
        u.pm = fm + ((wgid % nig) % gsz); u.pn = (wgid % nig) / gsz; return true;
    }
    __device__ __forceinline__ void a_ready(const Unit&) const {}
    __device__ __forceinline__ void done(const Unit&) const {}
};

__device__ __forceinline__ unsigned cvt_pk_bf16(float lo, float hi) { unsigned r; asm volatile("v_cvt_pk_bf16_f32 %0, %1, %2" : "=v"(r) : "v"(lo), "v"(hi)); return r; }
typedef float f32x2 __attribute__((ext_vector_type(2)));
template <class Epi, class Sched, bool ALIGN_EPI = false, bool SP2 = false>
__device__ __forceinline__ void gemm_phase(PG8_LAS unsigned char* lds, const Gemm g, const Sched& S, const Epi& E) {
    int tid_ = threadIdx.x; asm volatile("" : "+v"(tid_));
    const int tid = tid_, wid = __builtin_amdgcn_readfirstlane(tid >> 6), lane = tid & 63, wr = wid >> 2, wc = wid & 3, fr = lane & 15, fq = lane >> 4;
    const int K = g.K, nt = K / BK;
    unsigned voffA[2], voffB[2];
#pragma unroll
    for (int i = 0; i < 2; ++i) { int R, C; stage_rc(tid * 16 + i * 8192, R, C); const int Rb = Epi::PERM ? ((R & ~31) + perm32(R & 31)) : R;
        voffA[i] = (unsigned)(R * K + C) * 2u; voffB[i] = (unsigned)(Rb * K + C) * 2u; }
    const size_t kstep = (size_t)(BK * 2);
    const size_t hstep = (size_t)HALF * K * 2;
    const size_t tstep = 2 * hstep;
    const unsigned ldsw = (unsigned)wid * 1024u;
    const int aoff = lds_byte(wr * 64 + fr, fq * 8), boff = lds_byte(wc * 32 + fr, fq * 8);
#define PG8_SA(b, h) (((b) * 2 + (h)) * HTB)
#define PG8_SB(b, h) ((4 + (b) * 2 + (h)) * HTB)
#define PG8_STAGE(bufoff, gbase, voff) do { _Pragma("unroll") for (int _i = 0; _i < 2; ++_i) \
        __builtin_amdgcn_global_load_lds((const unsigned*)((const char*)(gbase) + (voff)[_i]), (PG8_LAS unsigned*)(lds + (bufoff) + ldsw + _i * 8192), 16, 0, 0); } while (0)
#define PG8_LDA(dst, b, h) do { _Pragma("unroll") for (int m = 0; m < 4; ++m) _Pragma("unroll") for (int k = 0; k < 2; ++k) dst[m][k] = *(const PG8_LAS bf16x8*)(lds + PG8_SA(b, h) + aoff + m * 2048 + k * 1024); } while (0)
#define PG8_LDB(dst, b, h) do { _Pragma("unroll") for (int n = 0; n < 2; ++n) _Pragma("unroll") for (int k = 0; k < 2; ++k) dst[n][k] = *(const PG8_LAS bf16x8*)(lds + PG8_SB(b, h) + boff + n * 2048 + k * 1024); } while (0)
#define PG8_MMA(ai, bj, At, Bt) do { __builtin_amdgcn_s_setprio(1); _Pragma("unroll") for (int m = 0; m < 4; ++m) _Pragma("unroll") for (int n = 0; n < 2; ++n) _Pragma("unroll") for (int k = 0; k < 2; ++k) \
        acc[ai][bj][m][n] = __builtin_amdgcn_mfma_f32_16x16x32_bf16(Bt[n][k], At[m][k], acc[ai][bj][m][n], 0, 0, 0); __builtin_amdgcn_s_setprio(0); } while (0)
#define PG8_WAIT_V(n) asm volatile("s_waitcnt vmcnt(" #n ")" ::: "memory")
#define PG8_WAIT_L(n) asm volatile("s_waitcnt lgkmcnt(" #n ")" ::: "memory")
#define PG8_BAR __builtin_amdgcn_s_barrier()
#define PG8_SCHED __builtin_amdgcn_sched_barrier(0)
    Unit cur, nxt; int ui = 0;
    if (!S.next(0, cur)) return;
    f32x4 acc[2][2][4][2];
#pragma unroll
    for (int a = 0; a < 2; ++a)
#pragma unroll
        for (int b = 0; b < 2; ++b)
#pragma unroll
            for (int m = 0; m < 4; ++m)
#pragma unroll
                for (int n = 0; n < 2; ++n) acc[a][b][m][n] = (f32x4){0.f, 0.f, 0.f, 0.f};
    bf16x8 At[4][2], B0[2][2], B1[2][2];
    const char* cA = (const char*)g.A + (size_t)cur.pm * tstep; const char* cB = (const char*)g.Bt + (size_t)cur.pn * tstep;
    S.a_ready(cur);
    if constexpr (SP2) {
        PG8_STAGE(PG8_SB(0, 0), cB, voffB); PG8_STAGE(PG8_SB(0, 1), cB + hstep, voffB); PG8_STAGE(PG8_SA(0, 0), cA, voffA); PG8_STAGE(PG8_SA(0, 1), cA + hstep, voffA);
        if (wr == 1) PG8_BAR;
        PG8_WAIT_V(2); PG8_BAR;
        PG8_STAGE(PG8_SB(1, 0), cB + kstep, voffB); PG8_STAGE(PG8_SA(1, 0), cA + kstep, voffA); PG8_STAGE(PG8_SB(1, 1), cB + hstep + kstep, voffB);
        PG8_WAIT_V(6); PG8_BAR;
    } else {
        PG8_STAGE(PG8_SB(0, 0), cB, voffB); PG8_STAGE(PG8_SA(0, 0), cA, voffA); PG8_STAGE(PG8_SB(0, 1), cB + hstep, voffB); PG8_STAGE(PG8_SA(0, 1), cA + hstep, voffA);
        if (wr == 1) PG8_BAR;
        PG8_WAIT_V(4); PG8_BAR;
        PG8_STAGE(PG8_SB(1, 0), cB + kstep, voffB); PG8_STAGE(PG8_SA(1, 0), cA + kstep, voffA); PG8_STAGE(PG8_SB(1, 1), cB + hstep + kstep, voffB);
        PG8_WAIT_V(6); PG8_BAR;
    }
    for (;;) {
        const bool has_next = S.next(ui + 1, nxt);
        const char* nA = has_next ? (const char*)g.A + (size_t)nxt.pm * tstep : cA; const char* nB = has_next ? (const char*)g.Bt + (size_t)nxt.pn * tstep : cB;
        for (int t = 0; t < nt; t += 2) {
            const bool last = (t == nt - 2);
            const char* a1 = cA + (size_t)(t + 1) * kstep;
            const char* a2 = last ? nA : cA + (size_t)(t + 2) * kstep; const char* b2 = last ? nB : cB + (size_t)(t + 2) * kstep;
            const char* a3 = a2 + kstep; const char* b3 = b2 + kstep;
            if (last && has_next) S.a_ready(nxt);
            if constexpr (SP2) {
            PG8_LDB(B0, 0, 0); PG8_LDB(B1, 0, 1); PG8_SCHED; PG8_LDA(At, 0, 0); PG8_STAGE(PG8_SA(1, 1), a1 + hstep, voffA);
            PG8_WAIT_V(8); PG8_WAIT_L(0); PG8_BAR; PG8_MMA(0, 0, At, B0); PG8_MMA(0, 1, At, B1); PG8_BAR; PG8_SCHED;
            PG8_LDA(At, 0, 1); PG8_STAGE(PG8_SB(0, 0), b2, voffB); PG8_STAGE(PG8_SB(0, 1), b2 + hstep, voffB); PG8_STAGE(PG8_SA(0, 0), a2, voffA);
            PG8_WAIT_V(8); PG8_WAIT_L(0); PG8_BAR; PG8_MMA(1, 0, At, B0); PG8_MMA(1, 1, At, B1); PG8_BAR; PG8_SCHED;
            PG8_LDB(B0, 1, 0); PG8_LDB(B1, 1, 1); PG8_SCHED; PG8_LDA(At, 1, 0); PG8_STAGE(PG8_SA(0, 1), a2 + hstep, voffA);
            PG8_WAIT_V(8); PG8_WAIT_L(0); PG8_BAR; PG8_MMA(0, 0, At, B0); PG8_MMA(0, 1, At, B1); PG8_BAR; PG8_SCHED;
            PG8_LDA(At, 1, 1); PG8_STAGE(PG8_SB(1, 0), b3, voffB); PG8_STAGE(PG8_SB(1, 1), b3 + hstep, voffB); PG8_STAGE(PG8_SA(1, 0), a3, voffA);
            PG8_WAIT_V(8); PG8_WAIT_L(0); PG8_BAR; PG8_MMA(1, 0, At, B0); PG8_MMA(1, 1, At, B1); PG8_BAR; PG8_SCHED;
            } else {
            PG8_LDB(B0, 0, 0); PG8_SCHED; PG8_LDA(At, 0, 0); PG8_STAGE(PG8_SA(1, 1), a1 + hstep, voffA);
            PG8_WAIT_L(8); PG8_BAR; PG8_WAIT_L(0); PG8_MMA(0, 0, At, B0); PG8_BAR; PG8_SCHED;
            PG8_LDB(B1, 0, 1); PG8_STAGE(PG8_SB(0, 0), b2, voffB);
            PG8_BAR; PG8_WAIT_L(0); PG8_MMA(0, 1, At, B1); PG8_BAR;
            PG8_LDA(At, 0, 1); PG8_STAGE(PG8_SA(0, 0), a2, voffA);
            PG8_BAR; PG8_WAIT_L(0); PG8_MMA(1, 0, At, B0); PG8_BAR; PG8_SCHED;
            PG8_STAGE(PG8_SB(0, 1), b2 + hstep, voffB);
            PG8_WAIT_V(6); PG8_BAR; PG8_MMA(1, 1, At, B1); PG8_BAR;
            PG8_LDB(B0, 1, 0); PG8_SCHED; PG8_LDA(At, 1, 0); PG8_STAGE(PG8_SA(0, 1), a2 + hstep, voffA);
            PG8_WAIT_L(8); PG8_BAR; PG8_WAIT_L(0); PG8_MMA(0, 0, At, B0); PG8_BAR; PG8_SCHED;
            PG8_LDB(B1, 1, 1); PG8_STAGE(PG8_SB(1, 0), b3, voffB);
            PG8_BAR; PG8_WAIT_L(0); PG8_MMA(0, 1, At, B1); PG8_BAR;
            PG8_LDA(At, 1, 1); PG8_STAGE(PG8_SA(1, 0), a3, voffA);
            PG8_BAR; PG8_WAIT_L(0); PG8_MMA(1, 0, At, B0); PG8_BAR; PG8_SCHED;
            PG8_STAGE(PG8_SB(1, 1), b3 + hstep, voffB);
            PG8_WAIT_V(6); PG8_BAR; PG8_MMA(1, 1, At, B1); PG8_BAR;
            }
        }
        if constexpr (ALIGN_EPI) { if (wr == 0) PG8_BAR; }
        if constexpr (!Epi::AFTER_DRAIN) { E(acc, cur, wr, wc, fr, fq); S.done(cur); }
        if (!has_next) break;
#pragma unroll
        for (int a = 0; a < 2; ++a)
#pragma unroll
            for (int b = 0; b < 2; ++b)
#pragma unroll
                for (int m = 0; m < 4; ++m)
#pragma unroll
                    for (int n = 0; n < 2; ++n) acc[a][b][m][n] = (f32x4){0.f, 0.f, 0.f, 0.f};
        cur = nxt; cA = nA; cB = nB; ++ui;
        if constexpr (ALIGN_EPI) { if (wr == 1) PG8_BAR; }
    }
    PG8_WAIT_V(0);
    if constexpr (!ALIGN_EPI) { if (wr == 0) PG8_BAR; }
    PG8_BAR;
    if constexpr (Epi::AFTER_DRAIN) { E.fused(acc, cur, wr, wc, fr, fq, lds, wid, lane); S.done(cur); }
#undef PG8_SA
#undef PG8_SB
#undef PG8_STAGE
#undef PG8_LDA
#undef PG8_LDB
#undef PG8_MMA
#undef PG8_WAIT_V
#undef PG8_WAIT_L
#undef PG8_BAR
#undef PG8_SCHED
}
}
#define GAS __attribute__((address_space(1)))
#define LAS __attribute__((address_space(3)))
typedef unsigned short bf16;
typedef unsigned v4u __attribute__((ext_vector_type(4)));
typedef float f32x4 __attribute__((ext_vector_type(4)));
typedef short bf16x8 __attribute__((ext_vector_type(8)));
typedef GAS unsigned gu32;
typedef GAS unsigned long long gu64;
#define RLX_AGENT __ATOMIC_RELAXED, __HIP_MEMORY_SCOPE_AGENT
#define LDS_WAIT() asm volatile("s_waitcnt lgkmcnt(0)" ::: "memory")
#define VM_WAIT() asm volatile("s_waitcnt vmcnt(0)" ::: "memory")
__device__ __forceinline__ unsigned long long rt() { return __builtin_amdgcn_s_memrealtime(); }
__device__ __forceinline__ unsigned f2bf(float f) { unsigned u = __builtin_bit_cast(unsigned, f); return (u + 0x7fffu + ((u >> 16) & 1u)) >> 16; }
__device__ __forceinline__ unsigned pk2(float lo, float hi) { return f2bf(lo) | (f2bf(hi) << 16); }
#define XB_TMO      128
#define XB_XCNT(j)  (256  + 64 * (j))
#define XB_XSUB(j)  (1280 + 64 * (j))
#define XB_XGEN(j)  (2304 + 64 * (j))
#define XB_TOP      3328
#define XB_TOPGEN   3392
#define XCD_BAR_WORDS 3456
#define XB_SPIN_CAP (1u << 18)

__device__ __forceinline__ unsigned xb_ld(unsigned* p)              { return __hip_atomic_load(p, __ATOMIC_RELAXED, __HIP_MEMORY_SCOPE_AGENT); }
__device__ __forceinline__ unsigned xb_add(unsigned* p, unsigned v) { return __hip_atomic_fetch_add(p, v, __ATOMIC_RELAXED, __HIP_MEMORY_SCOPE_AGENT); }
__device__ __forceinline__ unsigned xb_xcc_id() { return (unsigned)__builtin_amdgcn_s_getreg((3 << 11) | 20) & 0xFu; }
#define XB_SPIN(cond, bar) do { unsigned _sp = 0; while (cond) { __builtin_amdgcn_s_sleep(1); \
    if ((++_sp & 255u) == 0u) { if (xb_ld(&(bar)[XB_TMO])) break; if (_sp > XB_SPIN_CAP) { atomicAdd(&(bar)[XB_TMO], 1u); break; } } } } while (0)

struct XcdBarrier {
    unsigned* bar; unsigned x;
    volatile LAS unsigned* st;
};

__device__ __forceinline__ XcdBarrier xcd_barrier_post(unsigned* bar, volatile LAS unsigned* st) {
    XcdBarrier b; b.bar = bar; b.x = xb_xcc_id(); b.st = st;
    if (threadIdx.x == 0) (void)xb_add(&bar[XB_XCNT(b.x)], 1u);
    return b;
}
__device__ __forceinline__ void xcd_barrier_complete(unsigned* bar, unsigned x, unsigned& nloc, unsigned& nx) {
    const unsigned G = gridDim.x * gridDim.y * gridDim.z;
    unsigned sum, cnt, mine, sp = 0u;
    for (;;) {
        sum = 0u; cnt = 0u; mine = 0u;
#pragma unroll
        for (unsigned j = 0; j < 16; ++j) { const unsigned c = xb_ld(&bar[XB_XCNT(j)]); sum += c; cnt += (c > 0u) ? 1u : 0u; mine = (j == x) ? c : mine; }
        if (sum == G) break;
        __builtin_amdgcn_s_sleep(1);
        if ((++sp & 255u) == 0u) { if (xb_ld(&bar[XB_TMO])) break; if (sp > XB_SPIN_CAP) { atomicAdd(&bar[XB_TMO], 1u); break; } }
    }
    nloc = mine > 0u ? mine : 1u; nx = cnt > 0u ? cnt : 1u;
}

__device__ __forceinline__ void xcd_barrier(const XcdBarrier& b) {
    asm volatile("s_waitcnt vmcnt(0)" ::: "memory");
    __syncthreads();
    if (threadIdx.x == 0) {
        unsigned* bar = b.bar;
        __builtin_amdgcn_s_waitcnt(0);
        unsigned nloc = b.st[0], nx = b.st[1];
        if (nloc == 0u) { xcd_barrier_complete(bar, b.x, nloc, nx); b.st[0] = nloc; b.st[1] = nx; }
        const unsigned old = xb_add(&bar[XB_XSUB(b.x)], 1u);
        const unsigned gen = old / nloc;
        if (old + 1u == (gen + 1u) * nloc) {
            __builtin_amdgcn_fence(__ATOMIC_RELEASE, "agent");
            asm volatile("s_waitcnt vmcnt(0)" ::: "memory");
            const unsigned og = xb_add(&bar[XB_TOP], 1u);
            const unsigned tg = og / nx;
            if (og + 1u == (tg + 1u) * nx) xb_add(&bar[XB_TOPGEN], 1u);
            else XB_SPIN(xb_ld(&bar[XB_TOPGEN]) == tg, bar);
            __builtin_amdgcn_fence(__ATOMIC_ACQUIRE, "agent");
            xb_add(&bar[XB_XGEN(b.x)], 1u);
            asm volatile("s_waitcnt vmcnt(0)" ::: "memory");
        } else {
            XB_SPIN(xb_ld(&bar[XB_XGEN(b.x)]) == gen, bar);
            __builtin_amdgcn_fence(__ATOMIC_ACQUIRE, "agent");
            asm volatile("s_waitcnt vmcnt(0)" ::: "memory");
        }
    }
    __syncthreads();
}
constexpr int NWAVES = 8, NT = 512;
constexpr int D = 2048, NLAYER = 4;
constexpr int MC = 32 * 256, ML = 4 * 4096, M = MC + ML;
constexpr int DIN = 6176, NPROJ = 6144, NPAD = 6400, DFF = 8192, GWID = 512;
constexpr int NCP = M / 128;
constexpr float EPS = 1e-6f;
constexpr int PC_S5U = 0, PC_MQ = 512, PC_MK = 1024, PC_MV = 1536, PC_MO = 2048, PC_RQ = 2560, PC_RK = 3072, PC_RV = 3584, PC_RG = 4096, PC_DZ = 4608, PC_DX = 5120, PC_DB = 5632, PC_DC = 5888;
enum { I_XP = 0, I_XS, I_C, I_SS5R, I_SS5I, I_SMC, I_SMN, I_SMM, I_SRET, I_SSSD, I_CCTX, I_NORM1, I_WADA, I_BADA, I_WIN, I_S5LR, I_S5LI, I_S5DT, I_S5BR, I_S5BI, I_S5CR, I_S5CI, I_S5D, I_S5GLU,
       I_MIB, I_MFB, I_MNORM, I_RRATE, I_RNORM, I_CONVW, I_CONVB, I_DTB, I_ALOG, I_SSDD, I_SNORM, I_WOUT, I_NORM2, I_WM1, I_WM2, I_FNORM, N_IN };
constexpr size_t O_YP = 0, O_YS = (size_t)MC * D, O_S5R = (size_t)M * D, O_S5I = O_S5R + 524288, O_MC = O_S5I + 524288, O_MN = O_MC + 16777216, O_MM = O_MN + 131072, O_RET = O_MM + 1024, O_SSD = O_RET + 16777216, O_END = O_SSD + 16777216;

constexpr size_t MiB = 1u << 20;
constexpr size_t WS_CTL = 0, CTL_ZERO_BYTES = 1 * MiB;
constexpr size_t WS_MOD = 1 * MiB;
constexpr size_t WS_S5T = 2 * MiB;
constexpr size_t WS_ROPE = 5 * MiB;
constexpr size_t WS_GATES = 6 * MiB;
constexpr size_t WS_MLNLOC = 9 * MiB;
constexpr size_t WS_MLNIN = 10 * MiB;
constexpr size_t WS_MLSC = 11 * MiB;
constexpr size_t WS_MLMIN = 11 * MiB + 65536;
constexpr size_t WS_SDSC = 11 * MiB + 131072;
constexpr size_t WS_S5LOC = 12 * MiB;
constexpr size_t WS_WGT = 20 * MiB;
constexpr size_t WS_W1T = 22 * MiB;
constexpr size_t WS_WOT = 122 * MiB;
constexpr size_t WS_WM1T = 154 * MiB;
constexpr size_t WS_WM2T = 282 * MiB;
constexpr size_t WS_H = 410 * MiB;
constexpr size_t WS_Y = 506 * MiB;
constexpr size_t WS_YA = 602 * MiB;
constexpr size_t WS_MLCIN = 626 * MiB;
constexpr size_t WS_RTIN = 674 * MiB;
constexpr size_t WS_SDIN = 722 * MiB;
constexpr size_t WS_PROJ = 770 * MiB;
constexpr size_t WS_MLCLOC = 1058 * MiB;
constexpr size_t WS_HID = 770 * MiB;
constexpr size_t WS_RTLOC = 1154 * MiB;
constexpr size_t WS_SDLOC = 1250 * MiB;
constexpr size_t WS_END = 1346 * MiB;
constexpr int CW_TMO = 0, CW_BAR = 4096;

constexpr int LDT = 272;
constexpr int TS = 128 * LDT;
constexpr int LDX = 144;
constexpr int TSX = 128 * LDX;
constexpr int SCAL_OFF = 4 * TS;
constexpr int MISC_OFF = 163840 - 256;
constexpr int LDS_BYTES = 163840;
#define SCA(i) ((LAS float*)(F.lds + SCAL_OFF + (i) * 512))
typedef float f32x16 __attribute__((ext_vector_type(16)));
typedef float f32x2 __attribute__((ext_vector_type(2)));
typedef short s16x4 __attribute__((ext_vector_type(4)));
typedef unsigned u32x2 __attribute__((ext_vector_type(2)));
struct Args { const float* in[N_IN]; float* out; unsigned char* ws; int ph_lo, ph_hi; };
struct Frame {
    LAS unsigned char* lds;
    float* out; unsigned char* ws;
    int tid, lane, wave, G, bid;
};
typedef const __attribute__((address_space(4))) Args KArgs;
__device__ __forceinline__ KArgs* kargs() { KArgs* p = (KArgs*)__builtin_amdgcn_kernarg_segment_ptr(); asm volatile("" : "+s"(p)); return p; }
__device__ __forceinline__ Frame fresh(const Frame& F) { Frame R = F; unsigned long long l = (unsigned long long)(size_t)R.lds; unsigned ll = (unsigned)l; asm volatile("" : "+s"(ll), "+s"(R.out), "+s"(R.ws), "+s"(R.wave), "+s"(R.G), "+s"(R.bid), "+v"(R.tid), "+v"(R.lane)); R.lds = (LAS unsigned char*)(size_t)ll; return R; }
#define INP(i) (A.in[i])
#define WSP(T, off) ((T*)(F.ws + (off)))
__device__ __forceinline__ float bf2f(unsigned short b) { return __uint_as_float((unsigned)b << 16); }
__device__ __forceinline__ float bflo(unsigned w) { return __uint_as_float(w << 16); }
__device__ __forceinline__ float bfhi(unsigned w) { return __uint_as_float(w & 0xffff0000u); }
__device__ __forceinline__ float sigmoidf_(float x) { return 1.f / (1.f + __expf(-x)); }
__device__ __forceinline__ float siluf_(float x) { return x * sigmoidf_(x); }
__device__ __forceinline__ float wave_sum(float v) {
#pragma unroll
    for (int o = 1; o < 64; o <<= 1) v += __shfl_xor(v, o);
    return v;
}
__device__ __forceinline__ float wave_max(float v) {
#pragma unroll
    for (int o = 1; o < 64; o <<= 1) v = fmaxf(v, __shfl_xor(v, o));
    return v;
}
template <bool MAX> __device__ __forceinline__ void wave_scan128(const LAS float* in, LAS float* out, int lane, bool rev, float init) {
    const int i0 = rev ? 127 - 2 * lane : 2 * lane, i1 = rev ? i0 - 1 : i0 + 1;
    float e0 = in[i0], e1 = in[i1];
    if (lane == 0) e0 = MAX ? fmaxf(e0, init) : e0 + init;
    float inc = MAX ? fmaxf(e0, e1) : e0 + e1;
#pragma unroll
    for (int o = 1; o < 64; o <<= 1) { const float t = __shfl_up(inc, o); if (lane >= o) inc = MAX ? fmaxf(inc, t) : inc + t; }
    float exc = __shfl_up(inc, 1);
    const float o0 = (lane == 0) ? e0 : (MAX ? fmaxf(exc, e0) : exc + e0);
    out[i0] = o0; out[i1] = inc;
}
__device__ __forceinline__ s16x4 lds_tr(const LAS unsigned char* p) {
    typedef short v4i16_t __attribute__((ext_vector_type(4)));
    return __builtin_bit_cast(s16x4, __builtin_amdgcn_ds_read_tr16_b64_v4i16((LAS v4i16_t*)p));
}
__device__ __forceinline__ bf16x8 frag_row(const LAS unsigned char* base, int ld, int r0, int k0, int lane) {
    return *(const LAS bf16x8*)(base + (r0 + (lane & 31)) * ld + (k0 + 8 * (lane >> 5)) * 2);
}
__device__ __forceinline__ bf16x8 frag_tr(const LAS unsigned char* base, int ld, int k0, int c0, int lane) {
    const int h = lane >> 5, blk = (lane >> 4) & 1, q = (lane & 15) >> 2, p = lane & 3;
    const LAS unsigned char* a = base + (k0 + 8 * h + q) * ld + (c0 + 16 * blk + 4 * p) * 2;
    const s16x4 lo = lds_tr(a), hi = lds_tr(a + 4 * ld);
    return (bf16x8){lo[0], lo[1], lo[2], lo[3], hi[0], hi[1], hi[2], hi[3]};
}
#define MFMA32(a, b, c) __builtin_amdgcn_mfma_f32_32x32x16_bf16((a), (b), (c), 0, 0, 0)
#define ZERO16 ((f32x16){0.f,0.f,0.f,0.f,0.f,0.f,0.f,0.f,0.f,0.f,0.f,0.f,0.f,0.f,0.f,0.f})
__device__ __forceinline__ int crow(int i, int hh) { return (i & 3) + 8 * (i >> 2) + 4 * hh; }

__device__ __forceinline__ const float* x_in_row(const Frame& F, KArgs& A, int l, int r) {
    if (l == 0) return r < MC ? INP(I_XP) + (size_t)r * D : INP(I_XS) + (size_t)(r - MC) * D;
    return F.out + (size_t)r * D;
}
__device__ __forceinline__ int mod_row(int r) { return r < MC ? 0 : 1 + (r - MC) / 4096; }
__device__ __forceinline__ const float* mod_ptr(const Frame& F, int l, int mrow, int part) { return WSP(const float, WS_MOD) + ((size_t)(l * 5 + mrow) * 6 + part) * D; }
struct Seq { int cp0, nch, c, b, lat; };
__device__ __forceinline__ Seq seq_of(int cp) { Seq s; if (cp < 64) { s.lat = 0; s.b = cp >> 1; s.cp0 = cp & ~1; s.nch = 2; s.c = cp & 1; } else { s.lat = 1; s.b = (cp - 64) >> 5; s.cp0 = 64 + (s.b << 5); s.nch = 32; s.c = (cp - 64) & 31; } return s; }
__device__ __forceinline__ int w1_newcol(int n) { return n < 2560 ? n : (n < 2576 ? n - 2560 + 6144 : (n < 6160 ? n - 16 : n)); }
template <bool MAPW1> __device__ __forceinline__ void p0_transpose_item(const float* W, int K, int N, bf16* WT, LAS float* scr, int item, int lane) {
    const int nblk = N / 32, kb = item / nblk, nb = item % nblk, k0 = 64 * kb, n0 = 32 * nb;
#pragma unroll 8
    for (int i = 0; i < 32; ++i) { const int kk = 2 * i + (lane >> 5); scr[kk * 33 + (lane & 31)] = W[(size_t)(k0 + kk) * N + n0 + (lane & 31)]; }
    LDS_WAIT(); asm volatile("" ::: "memory");
    const int c = lane & 7;
#pragma unroll
    for (int j = 0; j < 4; ++j) { const int n = (lane >> 3) + 8 * j; const LAS float* s = scr + (8 * c) * 33 + n;
        v4u o; o.x = pk2(s[0 * 33], s[1 * 33]); o.y = pk2(s[2 * 33], s[3 * 33]); o.z = pk2(s[4 * 33], s[5 * 33]); o.w = pk2(s[6 * 33], s[7 * 33]);
        const int nr = MAPW1 ? w1_newcol(n0 + n) : (n0 + n);
        *(GAS v4u*)(WT + (size_t)nr * K + k0 + 8 * c) = o; }
    LDS_WAIT(); asm volatile("" ::: "memory");
}
constexpr int S5T_STRIDE = 9216;
__device__ __forceinline__ unsigned char* s5tab(const Frame& F, int l, int d, int g) { return F.ws + WS_S5T + (size_t)((l * 2 + d) * 32 + g) * S5T_STRIDE; }

__device__ __forceinline__ void p0_prologue(Frame& F, KArgs& A) {
    {
        LAS float* scr = (LAS float*)(F.lds + F.wave * 16384);
        const int gw = F.bid * NWAVES + F.wave, NGW = F.G * NWAVES;
        constexpr int I_1 = (D / 64) * (DIN / 32), I_G = (GWID / 64) * (GWID / 32), I_O = (D / 64) * (D / 32), I_M1 = (D / 64) * (DFF / 32), I_M2 = (DFF / 64) * (D / 32);
        constexpr int PER_L = I_1 + I_G + I_O + I_M1 + I_M2;
        for (int it = gw; it < NLAYER * PER_L; it += NGW) {
            const int l = it / PER_L; int r = it % PER_L;
            if (r < I_1) { p0_transpose_item<true>(INP(I_WIN) + (size_t)l * D * DIN, D, DIN, WSP(bf16, WS_W1T) + (size_t)l * NPAD * D, scr, r, F.lane); continue; } r -= I_1;
            if (r < I_G) { p0_transpose_item<false>(INP(I_S5GLU) + (size_t)l * GWID * GWID, GWID, GWID, WSP(bf16, WS_WGT) + (size_t)l * GWID * GWID, scr, r, F.lane); continue; } r -= I_G;
            if (r < I_O) { p0_transpose_item<false>(INP(I_WOUT) + (size_t)l * D * D, D, D, WSP(bf16, WS_WOT) + (size_t)l * D * D, scr, r, F.lane); continue; } r -= I_O;
            if (r < I_M1) { p0_transpose_item<false>(INP(I_WM1) + (size_t)l * D * DFF, D, DFF, WSP(bf16, WS_WM1T) + (size_t)l * DFF * D, scr, r, F.lane); continue; } r -= I_M1;
            p0_transpose_item<false>(INP(I_WM2) + (size_t)l * DFF * D, DFF, D, WSP(bf16, WS_WM2T) + (size_t)l * D * DFF, scr, r, F.lane);
        }
        const int gt = F.bid * NT + F.tid, NGT = F.G * NT;
        for (int i = gt; i < NLAYER * 224 * 256; i += NGT) { const int l = i / (224 * 256), r = i % (224 * 256);
            *(GAS v4u*)(WSP(bf16, WS_W1T) + ((size_t)l * NPAD + DIN) * D + (size_t)r * 8) = (v4u){0u, 0u, 0u, 0u}; }
        for (int i = gt; i < NLAYER * 2 * 32 * 64; i += NGT) {
            const int p = i & 63, g = (i >> 6) & 31, d = (i >> 11) & 1, l = i >> 12;
            const int ldg = (l * 2 + d) * 32 + g;
            const double lre = INP(I_S5LR)[ldg * 64 + p], lim = INP(I_S5LI)[ldg * 64 + p], dt = exp((double)INP(I_S5DT)[ldg]);
            const double er = exp(lre * dt), br = er * cos(lim * dt), bi = er * sin(lim * dt);
            const double e128 = exp(128.0 * lre * dt), b128r = e128 * cos(128.0 * lim * dt), b128i = e128 * sin(128.0 * lim * dt);
            const double nr = br - 1.0, ni = bi, den = lre * lre + lim * lim;
            const double cr = (nr * lre + ni * lim) / den, ci = (ni * lre - nr * lim) / den;
            unsigned char* tb = s5tab(F, l, d, g);
            float* lam = (float*)tb; lam[2 * p] = (float)br; lam[2 * p + 1] = (float)bi;
            float* l128 = (float*)(tb + 512); l128[2 * p] = (float)b128r; l128[2 * p + 1] = (float)b128i;
            bf16* bb = (bf16*)(tb + 1024); bf16* ct = (bf16*)(tb + 5120);
            for (int c = 0; c < 16; ++c) {
                const double Br = INP(I_S5BR)[(size_t)(ldg * 64 + p) * 16 + c], Bi = INP(I_S5BI)[(size_t)(ldg * 64 + p) * 16 + c];
                bb[p * 16 + c] = (bf16)f2bf((float)(cr * Br - ci * Bi));
                bb[(64 + p) * 16 + c] = (bf16)f2bf((float)(cr * Bi + ci * Br));
                ct[c * 128 + p] = (bf16)f2bf(INP(I_S5CR)[(size_t)(ldg * 16 + c) * 64 + p]);
                ct[c * 128 + 64 + p] = (bf16)f2bf(-INP(I_S5CI)[(size_t)(ldg * 16 + c) * 64 + p]);
            }
        }
        for (int i = gt; i < 64 * 32; i += NGT) { const int pos = i >> 5, k = i & 31; const double f = pow(10000.0, -(double)k / 32.0), a = pos * f;
            WSP(f32x2, WS_ROPE)[i] = (f32x2){(float)cos(a), (float)sin(a)}; }
    }
    __syncthreads();
    {
        LAS float* sc = (LAS float*)F.lds;
        LAS float* red = (LAS float*)(F.lds + 65536);
        for (int i = F.tid; i < 5 * D; i += NT) { const int r = i / D, k = i % D; const float v = r == 0 ? INP(I_CCTX)[k] : INP(I_C)[(r - 1) * D + k]; sc[i] = siluf_(v); }
        __syncthreads();
        for (int it = F.bid; it < NLAYER * 96; it += F.G) {
            const int l = it / 96, c0 = (it % 96) * 128;
            const float* W = INP(I_WADA) + (size_t)l * D * (6 * D);
            float acc[5][4];
#pragma unroll
            for (int r = 0; r < 5; ++r)
#pragma unroll
                for (int j = 0; j < 4; ++j) acc[r][j] = 0.f;
            const int cl = F.lane & 31, kp = F.lane >> 5;
#pragma unroll 4
            for (int kk = 0; kk < 128; ++kk) {
                const int k = F.wave * 256 + 2 * kk + kp;
                const f32x4 w = *(const f32x4*)(W + (size_t)k * (6 * D) + c0 + 4 * cl);
#pragma unroll
                for (int r = 0; r < 5; ++r) { const float s = sc[r * D + k]; acc[r][0] += s * w.x; acc[r][1] += s * w.y; acc[r][2] += s * w.z; acc[r][3] += s * w.w; }
            }
#pragma unroll
            for (int r = 0; r < 5; ++r)
#pragma unroll
                for (int j = 0; j < 4; ++j) { acc[r][j] += __shfl_xor(acc[r][j], 32); }
            if (kp == 0) {
#pragma unroll
                for (int r = 0; r < 5; ++r)
#pragma unroll
                    for (int j = 0; j < 4; ++j) red[(F.wave * 5 + r) * 128 + 4 * cl + j] = acc[r][j];
            }
            __syncthreads();
            for (int i = F.tid; i < 5 * 128; i += NT) { const int r = i >> 7, j = i & 127; float s = 0.f;
#pragma unroll
                for (int w = 0; w < 8; ++w) s += red[(w * 5 + r) * 128 + j];
                WSP(float, WS_MOD)[(size_t)(l * 5 + r) * (6 * D) + c0 + j] = s + INP(I_BADA)[(size_t)l * (6 * D) + c0 + j]; }
            __syncthreads();
        }
    }
}

__device__ __forceinline__ void norm_phase(Frame& F, KArgs& A, int l, int which  ) {
    const int gw = F.bid * NWAVES + F.wave, NGW = F.G * NWAVES;
    const float* gain = (which == 0 ? INP(I_NORM1) : INP(I_NORM2)) + (size_t)l * D;
    for (int m = gw; m < M; m += NGW) {
        const float* xr = (which == 0) ? x_in_row(F, A, l, m) : F.out + (size_t)m * D;
        const int mr = mod_row(m);
        const float* sh = mod_ptr(F, l, mr, which == 0 ? 0 : 3); const float* scp = mod_ptr(F, l, mr, which == 0 ? 1 : 4);
        f32x4 v[8]; float s = 0.f;
#pragma unroll
        for (int j = 0; j < 8; ++j) { v[j] = *(const f32x4*)(xr + 4 * F.lane + 256 * j); s += (v[j].x * v[j].x + v[j].y * v[j].y) + (v[j].z * v[j].z + v[j].w * v[j].w); }
        const float rstd = rsqrtf(wave_sum(s) * (1.f / D) + EPS);
        bf16* orow = WSP(bf16, WS_H) + (size_t)m * D;
#pragma unroll
        for (int j = 0; j < 8; ++j) { const int c = 4 * F.lane + 256 * j;
            const f32x4 g4 = *(const f32x4*)(gain + c), s4 = *(const f32x4*)(scp + c), h4 = *(const f32x4*)(sh + c);
            const float o0 = v[j].x * rstd * g4.x * (1.f + s4.x) + h4.x, o1 = v[j].y * rstd * g4.y * (1.f + s4.y) + h4.y, o2 = v[j].z * rstd * g4.z * (1.f + s4.z) + h4.z, o3 = v[j].w * rstd * g4.w * (1.f + s4.w) + h4.w;
            *(u32x2*)(orow + c) = (u32x2){pk2(o0, o1), pk2(o2, o3)}; }
    }
}
__device__ __forceinline__ void final_norm_phase(Frame& F, KArgs& A) {
    const int gw = F.bid * NWAVES + F.wave, NGW = F.G * NWAVES;
    const float* gain = INP(I_FNORM);
    for (int m = gw; m < M; m += NGW) {
        float* xr = F.out + (size_t)m * D;
        f32x4 v[8]; float s = 0.f;
#pragma unroll
        for (int j = 0; j < 8; ++j) { v[j] = *(const f32x4*)(xr + 4 * F.lane + 256 * j); s += (v[j].x * v[j].x + v[j].y * v[j].y) + (v[j].z * v[j].z + v[j].w * v[j].w); }
        const float rstd = rsqrtf(wave_sum(s) * (1.f / D) + EPS);
#pragma unroll
        for (int j = 0; j < 8; ++j) { const int c = 4 * F.lane + 256 * j; const f32x4 g4 = *(const f32x4*)(gain + c);
            *(f32x4*)(xr + c) = (f32x4){v[j].x * rstd * g4.x, v[j].y * rstd * g4.y, v[j].z * rstd * g4.z, v[j].w * rstd * g4.w}; }
    }
}
namespace epi {
using pg8::Unit; using pg8::f32x4; using pg8::u32x4; using pg8::bf16_t; using pg8::cvt_pk_bf16;
constexpr int BMq = 256, HALFq = 128;
struct EpiProj {
    static constexpr bool PERM = true, AFTER_DRAIN = false;
    bf16_t* P; float* G;
    __device__ __forceinline__ void operator()(const f32x4 (&acc)[2][2][4][2], const Unit& u, int wr, int wc, int fr, int fq) const {
        const int row0 = u.pm * BMq + wr * 64 + fr;
        if (u.pn < 24) {
            const int col0 = u.pn * BMq + wc * 32 + 8 * fq;
#pragma unroll
            for (int ai = 0; ai < 2; ++ai)
#pragma unroll
                for (int m = 0; m < 4; ++m) { bf16_t* rowp = P + (size_t)(row0 + ai * HALFq + m * 16) * NPROJ + col0;
#pragma unroll
                    for (int bj = 0; bj < 2; ++bj) { const f32x4 v0 = acc[ai][bj][m][0], v1 = acc[ai][bj][m][1];
                        u32x4 w; w.x = cvt_pk_bf16(v0[0], v0[1]); w.y = cvt_pk_bf16(v0[2], v0[3]); w.z = cvt_pk_bf16(v1[0], v1[1]); w.w = cvt_pk_bf16(v1[2], v1[3]);
                        *(u32x4*)(rowp + bj * HALFq) = w; } }
        } else if (wc == 0) {
#pragma unroll
            for (int ai = 0; ai < 2; ++ai)
#pragma unroll
                for (int m = 0; m < 4; ++m) { float* g = G + (size_t)(row0 + ai * HALFq + m * 16) * 32 + 8 * fq;
                    *(f32x4*)g = acc[ai][0][m][0]; *(f32x4*)(g + 4) = acc[ai][0][m][1]; }
        }
    }
};
struct EpiGlu {
    static constexpr bool PERM = true, AFTER_DRAIN = false;
    const bf16_t* YA; bf16_t* Y;
    __device__ __forceinline__ void operator()(const f32x4 (&acc)[2][2][4][2], const Unit& u, int wr, int wc, int fr, int fq) const {
        const int row0 = u.pm * BMq + wr * 64 + fr, col0 = u.pn * BMq + wc * 32 + 8 * fq;
#pragma unroll
        for (int ai = 0; ai < 2; ++ai)
#pragma unroll
            for (int m = 0; m < 4; ++m) { const int r = row0 + ai * HALFq + m * 16;
#pragma unroll
                for (int bj = 0; bj < 2; ++bj) { const f32x4 v0 = acc[ai][bj][m][0], v1 = acc[ai][bj][m][1];
                    const u32x4 a = *(const u32x4*)(YA + (size_t)r * GWID + col0 + bj * HALFq);
                    float y[8] = {bflo(a.x), bfhi(a.x), bflo(a.y), bfhi(a.y), bflo(a.z), bfhi(a.z), bflo(a.w), bfhi(a.w)};
                    const float g[8] = {v0[0], v0[1], v0[2], v0[3], v1[0], v1[1], v1[2], v1[3]};
#pragma unroll
                    for (int k = 0; k < 8; ++k) y[k] = y[k] * sigmoidf_(g[k]);
                    u32x4 w; w.x = cvt_pk_bf16(y[0], y[1]); w.y = cvt_pk_bf16(y[2], y[3]); w.z = cvt_pk_bf16(y[4], y[5]); w.w = cvt_pk_bf16(y[6], y[7]);
                    *(u32x4*)(Y + (size_t)r * D + col0 + bj * HALFq) = w; } }
    }
};
struct EpiRes {
    static constexpr bool PERM = false, AFTER_DRAIN = false;
    const float* xp; const float* xs; float* X; const float* gate0; int first;
    __device__ __forceinline__ void operator()(const f32x4 (&acc)[2][2][4][2], const Unit& u, int wr, int wc, int fr, int fq) const {
        const int rowt = u.pm * BMq, col0 = u.pn * BMq + wc * 32 + 4 * fq;
        const int mrow = rowt < MC ? 0 : 1 + (rowt - MC) / 4096;
        const float* gate = gate0 + (size_t)mrow * (6 * D);
        const float* base = first ? (rowt < MC ? xp + (size_t)rowt * D : xs + (size_t)(rowt - MC) * D) : X + (size_t)rowt * D;
        float* outp = X + (size_t)rowt * D;
#pragma unroll
        for (int bj = 0; bj < 2; ++bj)
#pragma unroll
            for (int n = 0; n < 2; ++n) { const int c = col0 + bj * HALFq + n * 16; const f32x4 gv = *(const f32x4*)(gate + c);
#pragma unroll
                for (int ai = 0; ai < 2; ++ai)
#pragma unroll
                    for (int m = 0; m < 4; ++m) { const size_t off = (size_t)(wr * 64 + fr + ai * HALFq + m * 16) * D + c;
                        const f32x4 b = *(const f32x4*)(base + off); *(f32x4*)(outp + off) = b + gv * acc[ai][bj][m][n]; } }
    }
};
struct EpiRelu2 {
    static constexpr bool PERM = true, AFTER_DRAIN = false;
    bf16_t* O;
    __device__ __forceinline__ void operator()(const f32x4 (&acc)[2][2][4][2], const Unit& u, int wr, int wc, int fr, int fq) const {
        const int row0 = u.pm * BMq + wr * 64 + fr, col0 = u.pn * BMq + wc * 32 + 8 * fq;
#pragma unroll
        for (int ai = 0; ai < 2; ++ai)
#pragma unroll
            for (int m = 0; m < 4; ++m) { bf16_t* rowp = O + (size_t)(row0 + ai * HALFq + m * 16) * DFF + col0;
#pragma unroll
                for (int bj = 0; bj < 2; ++bj) { f32x4 v0 = acc[ai][bj][m][0], v1 = acc[ai][bj][m][1];
#pragma unroll
                    for (int k = 0; k < 4; ++k) { const float a = fmaxf(v0[k], 0.f), b = fmaxf(v1[k], 0.f); v0[k] = a * a; v1[k] = b * b; }
                    u32x4 w; w.x = cvt_pk_bf16(v0[0], v0[1]); w.y = cvt_pk_bf16(v0[2], v0[3]); w.z = cvt_pk_bf16(v1[0], v1[1]); w.w = cvt_pk_bf16(v1[2], v1[3]);
                    *(u32x4*)(rowp + bj * HALFq) = w; } }
    }
};
}
__device__ __forceinline__ float logsigmoidf_(float x) { return x >= 0.f ? -log1pf(expf(-x)) : x - log1pf(expf(x)); }
__device__ __forceinline__ float softplusf_(float x) { return fmaxf(x, 0.f) + log1pf(expf(-fabsf(x))); }
__device__ __forceinline__ void unpack8(const v4u a, float (&x)[8]) { x[0] = bflo(a.x); x[1] = bfhi(a.x); x[2] = bflo(a.y); x[3] = bfhi(a.y); x[4] = bflo(a.z); x[5] = bfhi(a.z); x[6] = bflo(a.w); x[7] = bfhi(a.w); }
__device__ __forceinline__ v4u pack8(const float (&x)[8], float w) { v4u o; o.x = pk2(x[0] * w, x[1] * w); o.y = pk2(x[2] * w, x[3] * w); o.z = pk2(x[4] * w, x[5] * w); o.w = pk2(x[6] * w, x[7] * w); return o; }
__device__ __forceinline__ void load_tile128(Frame& F, LAS unsigned char* dst, const bf16* src) {
#pragma unroll
    for (int it = 0; it < 4; ++it) { const int i = F.tid + NT * it, r = i >> 4, c = i & 15;
        *(LAS v4u*)(dst + r * LDT + c * 16) = *(const v4u*)(src + (size_t)r * NPROJ + c * 8); }
}
template <int NDST> __device__ __forceinline__ void load_qk(Frame& F, LAS unsigned char* dst0, LAS unsigned char* dst1, const bf16* src, const LAS float* w0, const LAS float* w1, float scale, bool rope, int tpos0) {
#pragma unroll
    for (int it = 0; it < 2; ++it) {
        const int i = F.tid + NT * it, r = i >> 3, c = i & 7;
        float x1[8], x2[8];
        unpack8(*(const v4u*)(src + (size_t)r * NPROJ + c * 8), x1); unpack8(*(const v4u*)(src + (size_t)r * NPROJ + 64 + c * 8), x2);
        if (rope) {
            const int tp = tpos0 + r, pos = c < 4 ? (tp >> 6) : (tp & 63);
            const f32x2* rt = WSP(const f32x2, WS_ROPE) + pos * 32 + ((8 * c) & 31);
#pragma unroll
            for (int j = 0; j < 8; ++j) { const f32x2 cs = rt[j]; const float a = x1[j], b = x2[j]; x1[j] = a * cs.x - b * cs.y; x2[j] = a * cs.y + b * cs.x; }
        }
        const float s0 = scale * (w0 ? w0[r] : 1.f);
        *(LAS v4u*)(dst0 + r * LDT + c * 16) = pack8(x1, s0); *(LAS v4u*)(dst0 + r * LDT + 128 + c * 16) = pack8(x2, s0);
        if (NDST == 2) { const float s1 = scale * w1[r];
            *(LAS v4u*)(dst1 + r * LDT + c * 16) = pack8(x1, s1); *(LAS v4u*)(dst1 + r * LDT + 128 + c * 16) = pack8(x2, s1); }
    }
}
template <int NDST> __device__ __forceinline__ void load_conv(Frame& F, KArgs& A, int l, LAS unsigned char* dst0, LAS unsigned char* dst1, int ldd, int ch0, int nc8, int row0, int seq_lo, int seq_hi,
                                                               const LAS float* w0, const LAS float* w1) {
    const bf16* P = WSP(const bf16, WS_PROJ) + PC_DX + ch0;
    const float* cw = INP(I_CONVW) + (size_t)l * 5 * 1024 + ch0; const float* cb = INP(I_CONVB) + (size_t)l * 1024 + ch0;
    for (int i = F.tid; i < 128 * nc8; i += NT) {
        const int r = i / nc8, c = i % nc8, row = row0 + r;
        float acc[8];
        { const f32x4 b0 = *(const f32x4*)(cb + 8 * c), b1 = *(const f32x4*)(cb + 8 * c + 4); acc[0] = b0.x; acc[1] = b0.y; acc[2] = b0.z; acc[3] = b0.w; acc[4] = b1.x; acc[5] = b1.y; acc[6] = b1.z; acc[7] = b1.w; }
#pragma unroll
        for (int k = 0; k < 5; ++k) { const int rr = row + k - 2;
            if (rr >= seq_lo && rr < seq_hi) { float x[8]; unpack8(*(const v4u*)(P + (size_t)rr * NPROJ + 8 * c), x);
                const f32x4 w0v = *(const f32x4*)(cw + k * 1024 + 8 * c), w1v = *(const f32x4*)(cw + k * 1024 + 8 * c + 4);
                acc[0] += x[0] * w0v.x; acc[1] += x[1] * w0v.y; acc[2] += x[2] * w0v.z; acc[3] += x[3] * w0v.w; acc[4] += x[4] * w1v.x; acc[5] += x[5] * w1v.y; acc[6] += x[6] * w1v.z; acc[7] += x[7] * w1v.w; } }
#pragma unroll
        for (int j = 0; j < 8; ++j) acc[j] = siluf_(acc[j]);
        *(LAS v4u*)(dst0 + r * ldd + c * 16) = pack8(acc, w0 ? w0[r] : 1.f);
        if (NDST == 2) *(LAS v4u*)(dst1 + r * ldd + c * 16) = pack8(acc, w1[r]);
    }
}
__device__ __forceinline__ void kv_state_mfma(Frame& F, const LAS unsigned char* TKf, const LAS unsigned char* TKb, const LAS unsigned char* TV, float* outF, float* outB) {
    const int dvb = F.wave >> 1, dkb0 = (F.wave & 1) * 2, hh = F.lane >> 5;
    f32x16 acc[2][2] = {{ZERO16, ZERO16}, {ZERO16, ZERO16}};
#pragma unroll 1
    for (int ks = 0; ks < 8; ++ks) {
        const bf16x8 a = frag_tr(TV, LDT, 16 * ks, 32 * dvb, F.lane);
#pragma unroll
        for (int j = 0; j < 2; ++j) { acc[0][j] = MFMA32(a, frag_tr(TKf, LDT, 16 * ks, 32 * (dkb0 + j), F.lane), acc[0][j]); acc[1][j] = MFMA32(a, frag_tr(TKb, LDT, 16 * ks, 32 * (dkb0 + j), F.lane), acc[1][j]); }
    }
#pragma unroll
    for (int j = 0; j < 2; ++j)
#pragma unroll
        for (int i = 0; i < 16; ++i) { const int o = (32 * dvb + crow(i, hh)) * 128 + 32 * (dkb0 + j) + (F.lane & 31); outF[o] = acc[0][j][i]; outB[o] = acc[1][j][i]; }
}
__device__ __forceinline__ void qkT_mfma(Frame& F, const LAS unsigned char* TQ, const LAS unsigned char* TK, f32x16 (&qk)[2]) {
    const int tb = F.wave >> 1, sb0 = (F.wave & 1) * 2;
    qk[0] = ZERO16; qk[1] = ZERO16;
#pragma unroll 1
    for (int ks = 0; ks < 8; ++ks) { const bf16x8 bq = frag_row(TQ, LDT, 32 * tb, 16 * ks, F.lane);
#pragma unroll
        for (int j = 0; j < 2; ++j) qk[j] = MFMA32(frag_row(TK, LDT, 32 * (sb0 + j), 16 * ks, F.lane), bq, qk[j]); }
}
__device__ __forceinline__ void pv_mfma(Frame& F, const LAS unsigned char* TP, const LAS unsigned char* TV, f32x16 (&o)[2]) {
    const int tb = F.wave >> 1, eb0 = (F.wave & 1) * 2;
#pragma unroll 1
    for (int ks = 0; ks < 8; ++ks) { const bf16x8 ap = frag_row(TP, LDT, 32 * tb, 16 * ks, F.lane);
#pragma unroll
        for (int j = 0; j < 2; ++j) o[j] = MFMA32(ap, frag_tr(TV, LDT, 16 * ks, 32 * (eb0 + j), F.lane), o[j]); }
}
__device__ __forceinline__ void qs_mfma(Frame& F, const LAS unsigned char* TQ, const bf16* ST, f32x16 (&o)[2]) {
    const int tb = F.wave >> 1, eb0 = (F.wave & 1) * 2, hh = F.lane >> 5;
#pragma unroll 1
    for (int ks = 0; ks < 8; ++ks) { const bf16x8 aq = frag_row(TQ, LDT, 32 * tb, 16 * ks, F.lane);
#pragma unroll
        for (int j = 0; j < 2; ++j) { const bf16x8 b = *(const bf16x8*)(ST + (size_t)(32 * (eb0 + j) + (F.lane & 31)) * 128 + 16 * ks + 8 * hh); o[j] = MFMA32(aq, b, o[j]); } }
}
__device__ __forceinline__ void hs_to_lds(Frame& F, LAS unsigned char* HS, const f32x16 (&hs)[2]) {
    const int tb = F.wave >> 1, eb0 = (F.wave & 1) * 2, hh = F.lane >> 5;
#pragma unroll
    for (int j = 0; j < 2; ++j)
#pragma unroll
        for (int i = 0; i < 16; ++i) *(LAS float*)(HS + (32 * tb + crow(i, hh)) * 528 + (32 * (eb0 + j) + (F.lane & 31)) * 4) = hs[j][i];
}
template <int GATE> __device__ __forceinline__ void head_out(Frame& F, const LAS unsigned char* HS, const float* gain, const bf16* gsrc  , bf16* ydst  ) {
    const int t = F.tid >> 2, seg = F.tid & 3;
    float v[32]; float ss = 0.f;
#pragma unroll
    for (int k = 0; k < 8; ++k) { const f32x4 x = *(const LAS f32x4*)(HS + t * 528 + (32 * seg + 4 * k) * 4); v[4 * k] = x.x; v[4 * k + 1] = x.y; v[4 * k + 2] = x.z; v[4 * k + 3] = x.w; ss += (x.x * x.x + x.y * x.y) + (x.z * x.z + x.w * x.w); }
    ss += __shfl_xor(ss, 1); ss += __shfl_xor(ss, 2);
    const float r = rsqrtf(ss * (1.f / 128.f) + EPS);
#pragma unroll
    for (int k = 0; k < 4; ++k) { float g[8]; unpack8(*(const v4u*)(gsrc + (size_t)t * NPROJ + 32 * seg + 8 * k), g); float o[8];
#pragma unroll
        for (int j = 0; j < 8; ++j) { const float gg = GATE == 0 ? sigmoidf_(g[j]) : siluf_(g[j]); o[j] = v[8 * k + j] * r * gain[32 * seg + 8 * k + j] * gg; }
        *(v4u*)(ydst + (size_t)t * D + 32 * seg + 8 * k) = pack8(o, 1.f); }
}

__device__ __forceinline__ void mlstm_gates(Frame& F, KArgs& A, int l, int cp, int h) {
    if (F.tid < 128) { const float* g = WSP(const float, WS_GATES) + (size_t)(cp * 128 + F.tid) * 32;
        SCA(0)[F.tid] = g[h] + INP(I_MIB)[(l * 2 + 0) * 4 + h]; SCA(1)[F.tid] = g[4 + h] + INP(I_MIB)[(l * 2 + 1) * 4 + h];
        SCA(2)[F.tid] = logsigmoidf_(g[8 + h] + INP(I_MFB)[(l * 2 + 0) * 4 + h]); SCA(3)[F.tid] = logsigmoidf_(g[12 + h] + INP(I_MFB)[(l * 2 + 1) * 4 + h]); }
    __syncthreads();
    if (F.wave == 0) wave_scan128<false>(SCA(2), SCA(4), F.lane, false, 0.f);
    if (F.wave == 1) wave_scan128<false>(SCA(3), SCA(5), F.lane, true, 0.f);
    __syncthreads();
}
__device__ __forceinline__ void mlstm_local_item(Frame F, KArgs& A, int l, int cp, int h) {
    mlstm_gates(F, A, l, cp, h);
    if (F.wave < 2) { const int d = F.wave; const LAS float* bc = SCA(4 + d); const LAS float* ig = SCA(d); const float tot = d == 0 ? bc[127] : bc[0];
        const int s0 = 2 * F.lane; const float g0 = tot - bc[s0] + ig[s0], g1 = tot - bc[s0 + 1] + ig[s0 + 1];
        const float mx = wave_max(fmaxf(g0, g1));
        SCA(6 + d)[s0] = expf(g0 - mx); SCA(6 + d)[s0 + 1] = expf(g1 - mx);
        if (F.lane == 0) { float* sc = WSP(float, WS_MLSC) + ((cp * 2 + d) * 4 + h) * 2; sc[0] = tot; sc[1] = mx; } }
    __syncthreads();
    const bf16* P = WSP(const bf16, WS_PROJ) + (size_t)cp * 128 * NPROJ;
    load_qk<2>(F, F.lds, F.lds + TS, P + PC_MK + h * 128, SCA(6), SCA(7), 0.08838834764831845f, false, 0);
    load_tile128(F, F.lds + 2 * TS, P + PC_MV + h * 128);
    __syncthreads();
    kv_state_mfma(F, F.lds, F.lds + TS, F.lds + 2 * TS, WSP(float, WS_MLCLOC) + (size_t)((cp * 2 + 0) * 4 + h) * 16384, WSP(float, WS_MLCLOC) + (size_t)((cp * 2 + 1) * 4 + h) * 16384);
    if (F.tid < 256) { const int d = F.tid >> 7, dk = F.tid & 127; const LAS unsigned char* T = F.lds + d * TS; float s = 0.f;
        for (int r = 0; r < 128; ++r) s += bf2f(*(const LAS unsigned short*)(T + r * LDT + dk * 2));
        WSP(float, WS_MLNLOC)[((cp * 2 + d) * 4 + h) * 128 + dk] = s; }
    __syncthreads();
}
__device__ __forceinline__ void mlstm_out_item(Frame F, KArgs& A, int l, int cp, int h) {
    mlstm_gates(F, A, l, cp, h);
    const float min_f = WSP(const float, WS_MLMIN)[(cp * 2 + 0) * 4 + h], min_b = WSP(const float, WS_MLMIN)[(cp * 2 + 1) * 4 + h];
    if (F.tid < 256) { const int d = F.tid >> 7, s = F.tid & 127; SCA(6 + d)[s] = SCA(d)[s] - SCA(4 + d)[s]; }
    __syncthreads();
    if (F.wave == 0) wave_scan128<true>(SCA(6), SCA(8), F.lane, false, min_f);
    if (F.wave == 1) wave_scan128<true>(SCA(7), SCA(9), F.lane, true, min_b);
    const bf16* P = WSP(const bf16, WS_PROJ) + (size_t)cp * 128 * NPROJ;
    LAS unsigned char* TQ = F.lds; LAS unsigned char* TK = F.lds + TS; LAS unsigned char* TV = F.lds + 2 * TS; LAS unsigned char* TP = F.lds + 3 * TS;
    load_tile128(F, TQ, P + PC_MQ + h * 128);
    load_qk<1>(F, TK, nullptr, P + PC_MK + h * 128, nullptr, nullptr, 0.08838834764831845f, false, 0);
    load_tile128(F, TV, P + PC_MV + h * 128);
    __syncthreads();
    f32x16 hs[2] = {ZERO16, ZERO16};
    const int tb = F.wave >> 1, sb0 = (F.wave & 1) * 2, hh = F.lane >> 5, t = 32 * tb + (F.lane & 31);
#pragma unroll 1
    for (int d = 0; d < 2; ++d) {
        const LAS float* av = SCA(6 + d); const float Mt = SCA(8 + d)[t]; const float m_in = d == 0 ? min_f : min_b;
        if (F.tid < 128) SCA(12)[F.tid] = WSP(const float, WS_MLNIN)[((cp * 2 + d) * 4 + h) * 128 + F.tid];
        f32x16 qk[2]; qkT_mfma(F, TQ, TK, qk);
#pragma unroll
        for (int j = 0; j < 2; ++j)
#pragma unroll
            for (int i4 = 0; i4 < 4; ++i4) { const int sb = 32 * (sb0 + j) + 8 * i4 + 4 * hh; float p[4];
#pragma unroll
                for (int i = 0; i < 4; ++i) { const int s = sb + i; const bool ok = d == 0 ? (s <= t) : (s >= t); p[i] = ok ? qk[j][4 * i4 + i] * __expf(av[s] - Mt) : 0.f; }
                *(LAS u32x2*)(TP + t * LDT + sb * 2) = (u32x2){pk2(p[0], p[1]), pk2(p[2], p[3])}; }
        __syncthreads();
        if (F.tid < 128) { const int tt = F.tid; float ds = 0.f, qn = 0.f;
#pragma unroll 4
            for (int k = 0; k < 16; ++k) { float x[8]; unpack8(*(const LAS v4u*)(TP + tt * LDT + 16 * k), x); float q[8]; unpack8(*(const LAS v4u*)(TQ + tt * LDT + 16 * k), q);
#pragma unroll
                for (int j = 0; j < 8; ++j) { ds += x[j]; qn += q[j] * SCA(12)[8 * k + j]; } }
            const float Mtt = SCA(8 + d)[tt], wint = expf(m_in - Mtt), den = ds + wint * qn, dd = fmaxf(fabsf(den), expf(-(SCA(4 + d)[tt] + Mtt)));
            SCA(10)[tt] = wint / dd; SCA(11)[tt] = 1.f / dd; }
        { f32x16 num[2] = {ZERO16, ZERO16};
          pv_mfma(F, TP, TV, num);
          __syncthreads();
#pragma unroll
          for (int j = 0; j < 2; ++j)
#pragma unroll
            for (int i = 0; i < 16; ++i) hs[j][i] += SCA(11)[32 * tb + crow(i, hh)] * num[j][i]; }
        { f32x16 qc[2] = {ZERO16, ZERO16};
          qs_mfma(F, TQ, WSP(const bf16, WS_MLCIN) + (size_t)((cp * 2 + d) * 4 + h) * 16384, qc);
#pragma unroll
          for (int j = 0; j < 2; ++j)
#pragma unroll
            for (int i = 0; i < 16; ++i) hs[j][i] += SCA(10)[32 * tb + crow(i, hh)] * qc[j][i]; }
    }
    __syncthreads();
    hs_to_lds(F, F.lds, hs);
    __syncthreads();
    head_out<0>(F, F.lds, INP(I_MNORM) + (size_t)l * GWID + h * 128, P + PC_MO + h * 128, WSP(bf16, WS_Y) + (size_t)cp * 128 * D + 512 + h * 128);
    __syncthreads();
}

__device__ __forceinline__ void ret_local_item(Frame F, KArgs& A, int l, int cp, int h) {
    const float lgf = -expf(INP(I_RRATE)[(l * 2 + 0) * 4 + h]), lgb = -expf(INP(I_RRATE)[(l * 2 + 1) * 4 + h]);
    if (F.tid < 128) { SCA(6)[F.tid] = expf((127.f - (float)F.tid) * lgf); SCA(7)[F.tid] = expf((float)F.tid * lgb); }
    __syncthreads();
    const Seq sq = seq_of(cp);
    const bf16* P = WSP(const bf16, WS_PROJ) + (size_t)cp * 128 * NPROJ;
    load_qk<2>(F, F.lds, F.lds + TS, P + PC_RK + h * 128, SCA(6), SCA(7), 0.08838834764831845f, sq.lat != 0, sq.c * 128);
    load_tile128(F, F.lds + 2 * TS, P + PC_RV + h * 128);
    __syncthreads();
    kv_state_mfma(F, F.lds, F.lds + TS, F.lds + 2 * TS, WSP(float, WS_RTLOC) + (size_t)((cp * 2 + 0) * 4 + h) * 16384, WSP(float, WS_RTLOC) + (size_t)((cp * 2 + 1) * 4 + h) * 16384);
    __syncthreads();
}
__device__ __forceinline__ void ret_out_item(Frame F, KArgs& A, int l, int cp, int h) {
    const float lgf = -expf(INP(I_RRATE)[(l * 2 + 0) * 4 + h]), lgb = -expf(INP(I_RRATE)[(l * 2 + 1) * 4 + h]);
    if (F.tid < 128) { SCA(10)[F.tid] = expf(((float)F.tid + 1.f) * lgf); SCA(11)[F.tid] = expf((128.f - (float)F.tid) * lgb); }
    const Seq sq = seq_of(cp);
    const bf16* P = WSP(const bf16, WS_PROJ) + (size_t)cp * 128 * NPROJ;
    LAS unsigned char* TQ = F.lds; LAS unsigned char* TK = F.lds + TS; LAS unsigned char* TV = F.lds + 2 * TS; LAS unsigned char* TP = F.lds + 3 * TS;
    load_qk<1>(F, TQ, nullptr, P + PC_RQ + h * 128, nullptr, nullptr, 1.f, sq.lat != 0, sq.c * 128);
    load_qk<1>(F, TK, nullptr, P + PC_RK + h * 128, nullptr, nullptr, 0.08838834764831845f, sq.lat != 0, sq.c * 128);
    load_tile128(F, TV, P + PC_RV + h * 128);
    __syncthreads();
    f32x16 qk[2]; qkT_mfma(F, TQ, TK, qk);
    const int tb = F.wave >> 1, sb0 = (F.wave & 1) * 2, hh = F.lane >> 5, t = 32 * tb + (F.lane & 31);
#pragma unroll
    for (int j = 0; j < 2; ++j)
#pragma unroll
        for (int i4 = 0; i4 < 4; ++i4) { const int sb = 32 * (sb0 + j) + 8 * i4 + 4 * hh; float p[4];
#pragma unroll
            for (int i = 0; i < 4; ++i) { const int s = sb + i; const float df = (float)(t - s);
                const float dm = (s <= t ? __expf(df * lgf) : 0.f) + (s >= t ? __expf(-df * lgb) : 0.f); p[i] = qk[j][4 * i4 + i] * dm; }
            *(LAS u32x2*)(TP + t * LDT + sb * 2) = (u32x2){pk2(p[0], p[1]), pk2(p[2], p[3])}; }
    __syncthreads();
    f32x16 y[2] = {ZERO16, ZERO16};
    pv_mfma(F, TP, TV, y);
#pragma unroll 1
    for (int d = 0; d < 2; ++d) { f32x16 qs[2] = {ZERO16, ZERO16};
        qs_mfma(F, TQ, WSP(const bf16, WS_RTIN) + (size_t)((cp * 2 + d) * 4 + h) * 16384, qs);
#pragma unroll
        for (int j = 0; j < 2; ++j)
#pragma unroll
            for (int i = 0; i < 16; ++i) y[j][i] += SCA(10 + d)[32 * tb + crow(i, hh)] * qs[j][i]; }
    __syncthreads();
    hs_to_lds(F, F.lds, y);
    __syncthreads();
    head_out<1>(F, F.lds, INP(I_RNORM) + (size_t)l * GWID + h * 128, P + PC_RG + h * 128, WSP(bf16, WS_Y) + (size_t)cp * 128 * D + 1024 + h * 128);
    __syncthreads();
}
template <bool WMODE> __device__ __forceinline__ float ssd_scalars(Frame& F, KArgs& A, int l, int cp, int g) {
    const int d = F.wave >> 2, rr = F.wave & 3, head = g * 4 + rr;
    const float bias = INP(I_DTB)[(l * 2 + d) * 8 + head], arate = -expf(INP(I_ALOG)[(l * 2 + d) * 8 + head]);
    const float* gp = WSP(const float, WS_GATES) + (size_t)(cp * 128) * 32 + 16 + d * 8 + head;
    const int i0 = d ? 127 - 2 * F.lane : 2 * F.lane, i1 = d ? i0 - 1 : i0 + 1;
    const float dt0 = softplusf_(gp[(size_t)i0 * 32] + bias), dt1 = softplusf_(gp[(size_t)i1 * 32] + bias);
    const float a0 = dt0 * arate, a1 = dt1 * arate;
    float inc = a0 + a1;
#pragma unroll
    for (int o = 1; o < 64; o <<= 1) { const float t = __shfl_up(inc, o); if (F.lane >= o) inc += t; }
    const float c1 = inc, c0 = inc - a1, tot = __shfl(inc, 63);
    LAS float* cum = SCA(16 + d * 4 + rr); LAS float* dtw = SCA(24 + d * 4 + rr);
    cum[i0] = c0; cum[i1] = c1;
    if (WMODE) { dtw[i0] = expf(tot - c0) * dt0; dtw[i1] = expf(tot - c1) * dt1; } else { dtw[i0] = dt0; dtw[i1] = dt1; }
    return tot;
}
__device__ __forceinline__ void seq_bounds(int cp, int& lo, int& hi) { if (cp < 64) { lo = (cp >> 1) * 256; hi = lo + 256; } else { lo = MC + ((cp - 64) >> 5) * 4096; hi = lo + 4096; } }
__device__ __forceinline__ void ssd_local_item(Frame F, KArgs& A, int l, int cp, int g) {
    const float tot = ssd_scalars<true>(F, A, l, cp, g);
    if (F.lane == 0) WSP(float, WS_SDSC)[(cp * 2 + (F.wave >> 2)) * 8 + g * 4 + (F.wave & 3)] = tot;
    int lo, hi; seq_bounds(cp, lo, hi);
    LAS unsigned char* TB = F.lds;
    load_conv<1>(F, A, l, TB, nullptr, LDT, 512 + g * 128, 16, cp * 128, lo, hi, nullptr, nullptr);
    __syncthreads();
#pragma unroll 1
    for (int hr = 0; hr < 2; ++hr) {
#pragma unroll 1
        for (int r2 = 0; r2 < 2; ++r2) { const int rr = hr * 2 + r2;
            load_conv<2>(F, A, l, F.lds + TS + (r2 * 2 + 0) * TSX, F.lds + TS + (r2 * 2 + 1) * TSX, LDX, g * 256 + rr * 64, 8, cp * 128, lo, hi, SCA(24 + 0 * 4 + rr), SCA(24 + 1 * 4 + rr)); }
        __syncthreads();
        const int r2 = F.wave >> 2, d = (F.wave >> 1) & 1, pb = F.wave & 1, hh = F.lane >> 5, head = g * 4 + hr * 2 + r2;
        const LAS unsigned char* TX = F.lds + TS + (r2 * 2 + d) * TSX;
        f32x16 acc[4] = {ZERO16, ZERO16, ZERO16, ZERO16};
#pragma unroll 1
        for (int ks = 0; ks < 8; ++ks) { const bf16x8 a = frag_tr(TX, LDX, 16 * ks, 32 * pb, F.lane);
#pragma unroll
            for (int nb = 0; nb < 4; ++nb) acc[nb] = MFMA32(a, frag_tr(TB, LDT, 16 * ks, 32 * nb, F.lane), acc[nb]); }
        float* o = WSP(float, WS_SDLOC) + (size_t)((cp * 2 + d) * 8 + head) * 8192;
#pragma unroll
        for (int nb = 0; nb < 4; ++nb)
#pragma unroll
            for (int i = 0; i < 16; ++i) o[(32 * pb + crow(i, hh)) * 128 + 32 * nb + (F.lane & 31)] = acc[nb][i];
        __syncthreads();
    }
}
__device__ __forceinline__ void ssd_out_item(Frame F, KArgs& A, int l, int cp) {
    int lo, hi; seq_bounds(cp, lo, hi);
    LAS unsigned char* TC = F.lds; LAS unsigned char* TB = F.lds + TS; LAS unsigned char* TP = F.lds + 2 * TS; LAS unsigned char* TX = F.lds + 3 * TS;
    LAS float* SSQ = SCA(14);
    if (F.tid < 128) SSQ[F.tid] = 0.f;
    const int tb = F.wave >> 1, sb0 = (F.wave & 1) * 2, pb = F.wave & 1, hh = F.lane >> 5, t = 32 * tb + (F.lane & 31);
    const bf16* Pz = WSP(const bf16, WS_PROJ) + (size_t)cp * 128 * NPROJ + PC_DZ;
    bf16* Yd = WSP(bf16, WS_Y) + (size_t)cp * 128 * D + 1536;
#pragma unroll 1
    for (int g = 0; g < 2; ++g) {
        (void)ssd_scalars<false>(F, A, l, cp, g);
        load_conv<1>(F, A, l, TC, nullptr, LDT, 768 + g * 128, 16, cp * 128, lo, hi, nullptr, nullptr);
        load_conv<1>(F, A, l, TB, nullptr, LDT, 512 + g * 128, 16, cp * 128, lo, hi, nullptr, nullptr);
        __syncthreads();
        f32x16 cb[2] = {ZERO16, ZERO16};
#pragma unroll 1
        for (int ks = 0; ks < 8; ++ks) { const bf16x8 bq = frag_row(TC, LDT, 32 * tb, 16 * ks, F.lane);
#pragma unroll
            for (int j = 0; j < 2; ++j) cb[j] = MFMA32(frag_row(TB, LDT, 32 * (sb0 + j), 16 * ks, F.lane), bq, cb[j]); }
#pragma unroll 1
        for (int rr = 0; rr < 4; ++rr) {
            const int head = g * 4 + rr;
            load_conv<1>(F, A, l, TX, nullptr, LDX, g * 256 + rr * 64, 8, cp * 128, lo, hi, nullptr, nullptr);
            f32x16 y = ZERO16;
#pragma unroll 1
            for (int d = 0; d < 2; ++d) {
                const LAS float* cum = SCA(16 + d * 4 + rr); const LAS float* dtv = SCA(24 + d * 4 + rr); const float ct = cum[t];
#pragma unroll
                for (int j = 0; j < 2; ++j)
#pragma unroll
                    for (int i4 = 0; i4 < 4; ++i4) { const int sb = 32 * (sb0 + j) + 8 * i4 + 4 * hh; float p[4];
#pragma unroll
                        for (int i = 0; i < 4; ++i) { const int s = sb + i; const bool ok = d == 0 ? (s <= t) : (s >= t); p[i] = ok ? cb[j][4 * i4 + i] * __expf(ct - cum[s]) * dtv[s] : 0.f; }
                        *(LAS u32x2*)(TP + t * LDT + sb * 2) = (u32x2){pk2(p[0], p[1]), pk2(p[2], p[3])}; }
                __syncthreads();
                f32x16 pv = ZERO16, ch = ZERO16;
                const bf16* hin = WSP(const bf16, WS_SDIN) + (size_t)((cp * 2 + d) * 8 + head) * 8192;
#pragma unroll 1
                for (int ks = 0; ks < 8; ++ks) {
                    pv = MFMA32(frag_row(TP, LDT, 32 * tb, 16 * ks, F.lane), frag_tr(TX, LDX, 16 * ks, 32 * pb, F.lane), pv);
                    const bf16x8 bh = *(const bf16x8*)(hin + (size_t)(32 * pb + (F.lane & 31)) * 128 + 16 * ks + 8 * hh);
                    ch = MFMA32(frag_row(TC, LDT, 32 * tb, 16 * ks, F.lane), bh, ch); }
#pragma unroll
                for (int i = 0; i < 16; ++i) y[i] += pv[i] + __expf(cum[32 * tb + crow(i, hh)]) * ch[i];
                __syncthreads();
            }
#pragma unroll
            for (int i = 0; i < 16; ++i) *(LAS float*)(TP + (32 * tb + crow(i, hh)) * LDT + (32 * pb + (F.lane & 31)) * 4) = y[i];
            __syncthreads();
            { const int tt = F.tid >> 2, seg = F.tid & 3; const float Dh = INP(I_SSDD)[l * 8 + head];
                float z[16], x[16], o[16]; float ss = 0.f;
                { float t8[8]; unpack8(*(const v4u*)(Pz + (size_t)tt * NPROJ + head * 64 + 16 * seg), t8); for (int j = 0; j < 8; ++j) z[j] = t8[j];
                  unpack8(*(const v4u*)(Pz + (size_t)tt * NPROJ + head * 64 + 16 * seg + 8), t8); for (int j = 0; j < 8; ++j) z[8 + j] = t8[j];
                  unpack8(*(const LAS v4u*)(TX + tt * LDX + 32 * seg), t8); for (int j = 0; j < 8; ++j) x[j] = t8[j];
                  unpack8(*(const LAS v4u*)(TX + tt * LDX + 32 * seg + 16), t8); for (int j = 0; j < 8; ++j) x[8 + j] = t8[j]; }
#pragma unroll
                for (int k = 0; k < 4; ++k) { const f32x4 yv = *(const LAS f32x4*)(TP + tt * LDT + (16 * seg + 4 * k) * 4);
                    const float yy[4] = {yv.x, yv.y, yv.z, yv.w};
#pragma unroll
                    for (int j = 0; j < 4; ++j) { const float v = (yy[j] + Dh * x[4 * k + j]) * siluf_(z[4 * k + j]); o[4 * k + j] = v; ss += v * v; } }
                ss += __shfl_xor(ss, 1); ss += __shfl_xor(ss, 2);
                if (seg == 0) SSQ[tt] += ss;
                float o0[8], o1[8];
#pragma unroll
                for (int j = 0; j < 8; ++j) { o0[j] = o[j]; o1[j] = o[8 + j]; }
                *(v4u*)(Yd + (size_t)tt * D + head * 64 + 16 * seg) = pack8(o0, 1.f); *(v4u*)(Yd + (size_t)tt * D + head * 64 + 16 * seg + 8) = pack8(o1, 1.f); }
            __syncthreads();
        }
    }
    __builtin_amdgcn_fence(__ATOMIC_RELEASE, "workgroup"); asm volatile("s_waitcnt vmcnt(0)" ::: "memory"); __syncthreads(); __builtin_amdgcn_fence(__ATOMIC_ACQUIRE, "workgroup");
    { const int tt = F.tid >> 2, seg = F.tid & 3; const float r = rsqrtf(SSQ[tt] * (1.f / 512.f) + EPS); const float* gn = INP(I_SNORM) + (size_t)l * GWID + 128 * seg;
#pragma unroll 4
        for (int k = 0; k < 16; ++k) { bf16* p = Yd + (size_t)tt * D + 128 * seg + 8 * k; float v[8];
            unpack8(__builtin_nontemporal_load((const v4u*)p), v);
#pragma unroll
            for (int j = 0; j < 8; ++j) v[j] = v[j] * r * gn[8 * k + j];
            *(v4u*)p = pack8(v, 1.f); } }
    __syncthreads();
}
template <int PASS> __device__ __forceinline__ void s5_item(Frame F, KArgs& A, int l, int cp, int gq) {
    const Seq sq = seq_of(cp);
    const int g = gq * 8 + F.wave, p = F.lane, hh = F.lane >> 5;
    LAS unsigned char* TU = F.lds; LAS unsigned char* BU = F.lds + TS + F.wave * 8704;
    load_tile128(F, TU, WSP(const bf16, WS_PROJ) + (size_t)cp * 128 * NPROJ + PC_S5U + gq * 128);
    __syncthreads();
    typedef float f32x4v __attribute__((ext_vector_type(4)));
    f32x4v yacc[4][2];
    if (PASS == 1) {
#pragma unroll
        for (int a = 0; a < 4; ++a) { yacc[a][0] = (f32x4v){0.f, 0.f, 0.f, 0.f}; yacc[a][1] = (f32x4v){0.f, 0.f, 0.f, 0.f}; } }
#pragma unroll
    for (int d = 0; d < 2; ++d) {
        const unsigned char* tab = s5tab(F, l, d, g);
        const float lr = ((const float*)tab)[2 * p], li = ((const float*)tab)[2 * p + 1];
        float hr = 0.f, hi = 0.f;
        if (PASS == 1) {
            if (sq.lat) { const size_t o = (size_t)(((sq.b * 4 + l) * 2 + d) * 32 + g) * 64 + p; hr = INP(I_SS5R)[o]; hi = INP(I_SS5I)[o]; }
            const float l8r = ((const float*)(tab + 512))[2 * p], l8i = ((const float*)(tab + 512))[2 * p + 1];
            const int n = d == 0 ? sq.c : sq.nch - 1 - sq.c;
            for (int k = 0; k < n; ++k) { const int cc = d == 0 ? k : sq.nch - 1 - k;
                const f32x2 e = *(const f32x2*)(WSP(const float, WS_S5LOC) + ((size_t)(((sq.cp0 + cc) * 2 + d) * 32 + g) * 64 + p) * 2);
                const float nr = l8r * hr - l8i * hi + e.x, ni = l8r * hi + l8i * hr + e.y; hr = nr; hi = ni; }
        }
        const bf16* bb = (const bf16*)(tab + 1024); const bf16* ct = (const bf16*)(tab + 5120);
#pragma unroll
        for (int tbi = 0; tbi < 4; ++tbi) {
            const int tb = d == 0 ? tbi : 3 - tbi;
            const bf16x8 bu = frag_row(TU, LDT, 32 * tb, 16 * F.wave, F.lane);
#pragma unroll
            for (int nb = 0; nb < 4; ++nb) {
                const bf16x8 a = *(const bf16x8*)(bb + (size_t)(32 * nb + (F.lane & 31)) * 16 + 8 * hh);
                const f32x16 acc = MFMA32(a, bu, ZERO16);
#pragma unroll
                for (int i4 = 0; i4 < 4; ++i4) *(LAS u32x2*)(BU + (F.lane & 31) * LDT + (32 * nb + 8 * i4 + 4 * hh) * 2) = (u32x2){pk2(acc[4 * i4], acc[4 * i4 + 1]), pk2(acc[4 * i4 + 2], acc[4 * i4 + 3])};
            }
            asm volatile("s_waitcnt lgkmcnt(0)" ::: "memory");
#pragma unroll 4
            for (int st = 0; st < 32; ++st) { const int tl = d == 0 ? st : 31 - st;
                LAS unsigned short* pr = (LAS unsigned short*)(BU + tl * LDT + p * 2); LAS unsigned short* pi = pr + 64;
                const float br = bf2f(*pr), bi = bf2f(*pi);
                const float nr = lr * hr - li * hi + br, ni = lr * hi + li * hr + bi; hr = nr; hi = ni;
                if (PASS == 1) { *pr = (unsigned short)f2bf(hr); *pi = (unsigned short)f2bf(hi); } }
            if (PASS == 1) {
                asm volatile("s_waitcnt lgkmcnt(0)" ::: "memory");
                typedef short v8s __attribute__((ext_vector_type(8)));
                const int r16 = F.lane & 15, g4 = F.lane >> 4;
#pragma unroll
                for (int ks = 0; ks < 4; ++ks) { const v8s bc = *(const v8s*)(ct + r16 * 128 + 32 * ks + 8 * g4);
#pragma unroll
                    for (int ts = 0; ts < 2; ++ts) { const v8s ah = *(const LAS v8s*)(BU + (16 * ts + r16) * LDT + (32 * ks + 8 * g4) * 2);
                        yacc[tb][ts] = __builtin_amdgcn_mfma_f32_16x16x32_bf16(ah, bc, yacc[tb][ts], 0, 0, 0); } }
                asm volatile("s_waitcnt lgkmcnt(0)" ::: "memory");
            }
        }
        if (PASS == 0) { *(f32x2*)(WSP(float, WS_S5LOC) + ((size_t)((cp * 2 + d) * 32 + g) * 64 + p) * 2) = (f32x2){hr, hi}; }
        else if (!sq.lat && ((d == 0 && sq.c == sq.nch - 1) || (d == 1 && sq.c == 0))) { const size_t o = (size_t)(((sq.b * 4 + l) * 2 + d) * 32 + g) * 64 + p; F.out[O_S5R + o] = hr; F.out[O_S5I + o] = hi; }
    }
    if (PASS == 1) {
        const int r16 = F.lane & 15, g4 = F.lane >> 4; const float Dc = INP(I_S5D)[(size_t)l * GWID + g * 16 + r16];
#pragma unroll
        for (int tb = 0; tb < 4; ++tb)
#pragma unroll
            for (int ts = 0; ts < 2; ++ts)
#pragma unroll
                for (int i = 0; i < 4; ++i) { const int t = 32 * tb + 16 * ts + 4 * g4 + i; LAS unsigned short* up = (LAS unsigned short*)(TU + t * LDT + (16 * F.wave + r16) * 2);
                    const float x = yacc[tb][ts][i] + Dc * bf2f(*up);
                    const float ge = 0.5f * x * (1.f + tanhf(0.7978845608028654f * (x + 0.044715f * x * x * x)));
                    *up = (unsigned short)f2bf(ge); }
        __syncthreads();
        bf16* ya = WSP(bf16, WS_YA) + (size_t)cp * 128 * GWID + gq * 128;
#pragma unroll
        for (int it = 0; it < 4; ++it) { const int i = F.tid + NT * it, r = i >> 4, c = i & 15; *(v4u*)(ya + (size_t)r * GWID + c * 8) = *(const LAS v4u*)(TU + r * LDT + c * 16); }
    }
    __syncthreads();
}

__device__ __forceinline__ void carry_unit(Frame F, KArgs& A, int l, int u) {
    const int sd = u / 96, rem = u % 96, sidx = sd >> 1, d = sd & 1;
    const int lat = sidx < 4, b = lat ? sidx : sidx - 4, nch = lat ? 32 : 2, cp0 = lat ? 64 + 32 * b : 2 * b;
    int type, head, slice;
    if (rem < 32) { type = 0; head = rem >> 3; slice = rem & 7; } else if (rem < 64) { type = 1; head = (rem - 32) >> 3; slice = (rem - 32) & 7; } else { type = 2; head = (rem - 64) >> 2; slice = (rem - 64) & 3; }
    const int e0 = slice * 2048 + F.tid * 4;
    const int nh = type == 2 ? 8 : 4, esz = type == 2 ? 8192 : 16384;
    const float* loc = type == 0 ? WSP(const float, WS_MLCLOC) : (type == 1 ? WSP(const float, WS_RTLOC) : WSP(const float, WS_SDLOC));
    bf16* inb = type == 0 ? WSP(bf16, WS_MLCIN) : (type == 1 ? WSP(bf16, WS_RTIN) : WSP(bf16, WS_SDIN));
    float v[4] = {0.f, 0.f, 0.f, 0.f}, nv[4] = {0.f, 0.f, 0.f, 0.f}, m = 0.f;
    const bool do_n = (type == 0 && slice == 0 && F.tid < 32);
    if (lat) {
        if (type == 2) { const f32x4 s = *(const f32x4*)(INP(I_SSSD) + (size_t)(((b * 4 + l) * 2 + d) * 8 + head) * 8192 + e0); v[0] = s.x; v[1] = s.y; v[2] = s.z; v[3] = s.w; }
        else { const float* s = (type == 0 ? INP(I_SMC) : INP(I_SRET)) + (size_t)(((b * 4 + l) * 2 + d) * 4 + head) * 16384; const int dv = e0 >> 7, dk = e0 & 127;
#pragma unroll
            for (int j = 0; j < 4; ++j) v[j] = s[(dk + j) * 128 + dv]; }
        if (type == 0) { m = INP(I_SMM)[((b * 4 + l) * 2 + d) * 4 + head];
            if (do_n) { const f32x4 s = *(const f32x4*)(INP(I_SMN) + (size_t)(((b * 4 + l) * 2 + d) * 4 + head) * 128 + F.tid * 4); nv[0] = s.x; nv[1] = s.y; nv[2] = s.z; nv[3] = s.w; } }
    }
    const float rdec = type == 1 ? expf(-128.f * expf(INP(I_RRATE)[(l * 2 + d) * 4 + head])) : 1.f;
#pragma unroll 1
    for (int ci = 0; ci < nch; ++ci) {
        const int cp = cp0 + (d == 0 ? ci : nch - 1 - ci);
        const size_t so = (size_t)((cp * 2 + d) * nh + head) * esz + e0;
        *(u32x2*)(inb + so) = (u32x2){pk2(v[0], v[1]), pk2(v[2], v[3])};
        float dec, wl = 1.f;
        if (type == 0) {
            const float* sc = WSP(const float, WS_MLSC) + ((cp * 2 + d) * 4 + head) * 2; const float Bt = sc[0], ml = sc[1];
            if (slice == 0 && F.tid == 0) WSP(float, WS_MLMIN)[(cp * 2 + d) * 4 + head] = m;
            if (do_n) *(f32x4*)(WSP(float, WS_MLNIN) + ((cp * 2 + d) * 4 + head) * 128 + F.tid * 4) = (f32x4){nv[0], nv[1], nv[2], nv[3]};
            const float mn = fmaxf(Bt + m, ml); dec = expf(Bt + m - mn); wl = expf(ml - mn); m = mn;
            if (do_n) { const f32x4 ln = *(const f32x4*)(WSP(const float, WS_MLNLOC) + ((cp * 2 + d) * 4 + head) * 128 + F.tid * 4); nv[0] = dec * nv[0] + wl * ln.x; nv[1] = dec * nv[1] + wl * ln.y; nv[2] = dec * nv[2] + wl * ln.z; nv[3] = dec * nv[3] + wl * ln.w; }
        } else if (type == 1) dec = rdec;
        else dec = expf(WSP(const float, WS_SDSC)[(cp * 2 + d) * 8 + head]);
        const f32x4 lc = *(const f32x4*)(loc + so);
        v[0] = dec * v[0] + wl * lc.x; v[1] = dec * v[1] + wl * lc.y; v[2] = dec * v[2] + wl * lc.z; v[3] = dec * v[3] + wl * lc.w;
    }
    if (!lat) {
        if (type == 2) *(f32x4*)(F.out + O_SSD + (size_t)(((b * 4 + l) * 2 + d) * 8 + head) * 8192 + e0) = (f32x4){v[0], v[1], v[2], v[3]};
        else {
            LAS float* tr = (LAS float*)F.lds;
            const int dvl = F.tid >> 5, dk = (F.tid & 31) * 4;
#pragma unroll
            for (int j = 0; j < 4; ++j) tr[dvl * 129 + dk + j] = v[j];
            __syncthreads();
            const int dk2 = F.tid >> 2, q = F.tid & 3;
            float* o = F.out + (type == 0 ? O_MC : O_RET) + (size_t)(((b * 4 + l) * 2 + d) * 4 + head) * 16384 + (size_t)dk2 * 128 + slice * 16 + 4 * q;
            *(f32x4*)o = (f32x4){tr[(4 * q) * 129 + dk2], tr[(4 * q + 1) * 129 + dk2], tr[(4 * q + 2) * 129 + dk2], tr[(4 * q + 3) * 129 + dk2]};
            if (type == 0) { if (do_n) *(f32x4*)(F.out + O_MN + (size_t)(((b * 4 + l) * 2 + d) * 4 + head) * 128 + F.tid * 4) = (f32x4){nv[0], nv[1], nv[2], nv[3]};
                if (slice == 0 && F.tid == 0) F.out[O_MM + ((b * 4 + l) * 2 + d) * 4 + head] = m; }
            __syncthreads();
        }
    }
}
constexpr int N_PHASES = 2 + 9 * NLAYER;
__global__ void __launch_bounds__(NT, 2) hymba_fwd(Args A) {
    extern __shared__ __attribute__((aligned(16))) unsigned char lds_raw[];
    Frame F0;
    F0.lds = (LAS unsigned char*)lds_raw;
    F0.tid = threadIdx.x; F0.lane = F0.tid & 63; F0.wave = __builtin_amdgcn_readfirstlane(F0.tid >> 6);
    F0.G = gridDim.x; F0.bid = blockIdx.x; F0.out = A.out; F0.ws = A.ws;
    volatile LAS unsigned* MISC = (volatile LAS unsigned*)(F0.lds + MISC_OFF);
    if (F0.tid < 64) MISC[F0.tid] = 0u;
    __syncthreads();
    unsigned* barw = (unsigned*)(F0.ws + WS_CTL) + CW_BAR;
    XcdBarrier bar = xcd_barrier_post(barw, MISC + 8);
    const int lo = A.ph_lo, hi = A.ph_hi;
#define KA (*kargs())
#define IN(k) (lo <= (k) && (k) < hi)
#define SEAM(k) do { if (IN(k) && IN((k) + 1)) xcd_barrier(bar); } while (0)

    if (IN(0)) { Frame F = fresh(F0); p0_prologue(F, KA); } SEAM(0);

#pragma unroll 1
    for (int l = 0; l < NLAYER; ++l) {
        const int pb = 1 + 9 * l;
        if (IN(pb + 0)) { Frame F = fresh(F0); norm_phase(F, KA, l, 0); } SEAM(pb + 0);
        if (IN(pb + 1)) { Frame F = fresh(F0);
            pg8::Gemm g{WSP(const pg8::bf16_t, WS_H), WSP(const pg8::bf16_t, WS_W1T) + (size_t)l * NPAD * D, M, NPAD, D}; pg8::StaticOrder S; S.init(M, NPAD, F.G, F.bid);
            epi::EpiProj E{WSP(pg8::bf16_t, WS_PROJ), WSP(float, WS_GATES)};
            pg8::gemm_phase<epi::EpiProj, pg8::StaticOrder, true, true>(F.lds, g, S, E);
        } SEAM(pb + 1);
        if (IN(pb + 2)) { Frame F = fresh(F0);
            for (int it = F.bid; it < 384 + 768 + 768 + 768; it += F.G) {
                if (it < 384) ssd_local_item(fresh(F), KA, l, it >> 1, it & 1);
                else if (it < 1152) mlstm_local_item(fresh(F), KA, l, (it - 384) >> 2, (it - 384) & 3);
                else if (it < 1920) ret_local_item(fresh(F), KA, l, (it - 1152) >> 2, (it - 1152) & 3);
                else s5_item<0>(fresh(F), KA, l, (it - 1920) >> 2, (it - 1920) & 3);
            }
        } SEAM(pb + 2);
        if (IN(pb + 3)) { Frame F = fresh(F0);
            for (int it = F.bid; it < 768 + 768 + 6144; it += F.G) {
                if (it < 768) carry_unit(fresh(F), KA, l, it);
                else if (it < 1536) s5_item<1>(fresh(F), KA, l, (it - 768) >> 2, (it - 768) & 3);
                else carry_unit(fresh(F), KA, l, it - 768);
            }
        } SEAM(pb + 3);
        if (IN(pb + 4)) { Frame F = fresh(F0);
            for (int it = F.bid; it < 192 + 768 + 768; it += F.G) {
                if (it < 192) ssd_out_item(fresh(F), KA, l, it);
                else if (it < 960) mlstm_out_item(fresh(F), KA, l, (it - 192) >> 2, (it - 192) & 3);
                else ret_out_item(fresh(F), KA, l, (it - 960) >> 2, (it - 960) & 3);
            }
            pg8::Gemm g{WSP(const pg8::bf16_t, WS_YA), WSP(const pg8::bf16_t, WS_WGT) + (size_t)l * GWID * GWID, M, GWID, GWID}; pg8::StaticOrder S; S.init(M, GWID, F.G, F.bid);
            epi::EpiGlu E{WSP(const pg8::bf16_t, WS_YA), WSP(pg8::bf16_t, WS_Y)};
            pg8::gemm_phase<epi::EpiGlu, pg8::StaticOrder, true, true>(F.lds, g, S, E);
        } SEAM(pb + 4);
        if (IN(pb + 5)) { Frame F = fresh(F0);
            pg8::Gemm g{WSP(const pg8::bf16_t, WS_Y), WSP(const pg8::bf16_t, WS_WOT) + (size_t)l * D * D, M, D, D}; pg8::StaticOrder S; S.init(M, D, F.G, F.bid);
            KArgs& A_ = KA; epi::EpiRes E{A_.in[I_XP], A_.in[I_XS], F.out, WSP(const float, WS_MOD) + (size_t)(l * 5) * (6 * D) + 2 * D, l == 0 ? 1 : 0};
            pg8::gemm_phase<epi::EpiRes, pg8::StaticOrder, true, true>(F.lds, g, S, E);
        } SEAM(pb + 5);
        if (IN(pb + 6)) { Frame F = fresh(F0); norm_phase(F, KA, l, 1); } SEAM(pb + 6);
        if (IN(pb + 7)) { Frame F = fresh(F0);
            pg8::Gemm g{WSP(const pg8::bf16_t, WS_H), WSP(const pg8::bf16_t, WS_WM1T) + (size_t)l * DFF * D, M, DFF, D}; pg8::StaticOrder S; S.init(M, DFF, F.G, F.bid);
            epi::EpiRelu2 E{WSP(pg8::bf16_t, WS_HID)};
            pg8::gemm_phase<epi::EpiRelu2, pg8::StaticOrder, true, true>(F.lds, g, S, E);
        } SEAM(pb + 7);
        if (IN(pb + 8)) { Frame F = fresh(F0);
            pg8::Gemm g{WSP(const pg8::bf16_t, WS_HID), WSP(const pg8::bf16_t, WS_WM2T) + (size_t)l * D * DFF, M, D, DFF}; pg8::StaticOrder S; S.init(M, D, F.G, F.bid);
            KArgs& A_ = KA; epi::EpiRes E{A_.in[I_XP], A_.in[I_XS], F.out, WSP(const float, WS_MOD) + (size_t)(l * 5) * (6 * D) + 5 * D, 0};
            pg8::gemm_phase<epi::EpiRes, pg8::StaticOrder, true, true>(F.lds, g, S, E);
        } SEAM(pb + 8);
    }
    if (IN(N_PHASES - 1)) { Frame F = fresh(F0); final_norm_phase(F, KA); }
#undef IN
#undef SEAM
}

#ifndef MK_LAUNCH_PER_PHASE
#define MK_LAUNCH_PER_PHASE 0
#endif
extern "C" void kernel_launch(void* const* d_in, const int* in_sizes, int n_in, void* d_out, int out_size, void* d_ws, size_t ws_size, hipStream_t stream) {
    static int grid = 0;
    if (grid == 0) {
        if (n_in != N_IN || (size_t)out_size != O_END || ws_size < WS_END) { fprintf(stderr, "kernel_launch: shape mismatch: n_in %d out %d ws %zu (need %zu)\n", n_in, out_size, ws_size, (size_t)WS_END); grid = -1; return; }
        int dev = 0, cus = 0, per_cu = 0;
        if (hipGetDevice(&dev) != hipSuccess || hipDeviceGetAttribute(&cus, hipDeviceAttributeMultiprocessorCount, dev) != hipSuccess) { grid = -1; return; }
        if (hipFuncSetAttribute((const void*)hymba_fwd, hipFuncAttributeMaxDynamicSharedMemorySize, LDS_BYTES) != hipSuccess) { fprintf(stderr, "kernel_launch: hipFuncSetAttribute failed\n"); grid = -1; return; }
        if (hipOccupancyMaxActiveBlocksPerMultiprocessor(&per_cu, (const void*)hymba_fwd, NT, LDS_BYTES) != hipSuccess || per_cu < 1) fprintf(stderr, "kernel_launch: occupancy query says %d\n", per_cu);
        (void)hipGetLastError();
        grid = cus;
    }
    if (grid < 0) return;
    (void)hipMemsetAsync((char*)d_ws + WS_CTL, 0, CTL_ZERO_BYTES, stream);
    Args a{};
    for (int i = 0; i < N_IN; ++i) a.in[i] = (const float*)d_in[i];
    a.out = (float*)d_out; a.ws = (unsigned char*)d_ws;
#if MK_LAUNCH_PER_PHASE
    for (int p = 0; p < N_PHASES; ++p) { a.ph_lo = p; a.ph_hi = p + 1; hipLaunchKernelGGL(hymba_fwd, dim3(grid), dim3(NT), LDS_BYTES, stream, a); }
#else
    a.ph_lo = 0; a.ph_hi = N_PHASES;
    hipLaunchKernelGGL(hymba_fwd, dim3(grid), dim3(NT), LDS_BYTES, stream, a);
#endif
    const hipError_t le = hipPeekAtLastError();
    if (le != hipSuccess) fprintf(stderr, "kernel_launch: launch failed: %s\n", hipGetErrorName(le));
}
```

```cpp
#include <hip/hip_runtime.h>
#include <cstdio>
#include <cstdint>
namespace pg8 {
#define PG8_LAS __attribute__((address_space(3)))
typedef unsigned short bf16_t;
typedef short bf16x8 __attribute__((ext_vector_type(8)));
typedef float f32x4 __attribute__((ext_vector_type(4)));
typedef unsigned u32x4 __attribute__((ext_vector_type(4)));
constexpr int BM = 256, BK = 64, HALF = 128, HTB = HALF * BK * 2  , STAGE_BYTES = 8 * HTB, NXCD = 8, WGM = 8;

__host__ __device__ __forceinline__ int lds_byte(int r, int c) { const int st = (r >> 4) * 2 + (c >> 5), rr = r & 15, cc = c & 31, ob = rr * 64 + cc * 2; return st * 1024 + (ob ^ (((ob >> 9) & 1) << 5)); }
__host__ __device__ __forceinline__ void stage_rc(int b, int& R, int& C) { const int st = b / 1024, sb = b % 1024, swz = sb ^ (((sb >> 9) & 1) << 5); R = (st >> 1) * 16 + swz / 64; C = (st & 1) * 32 + (swz % 64) / 2; }
__host__ __device__ __forceinline__ int perm32(int rho) { const int n = rho >> 4, i = rho & 15; return 8 * (i >> 2) + 4 * n + (i & 3); }

struct Unit { int pm, pn; };
struct Gemm { const bf16_t* A; const bf16_t* Bt; int M, N, K; };

struct StaticOrder {
    int nM, nN, nwg, G, c;
    __host__ __device__ void init(int M, int N, int G_, int c_) { nM = M / BM; nN = N / BM; nwg = nM * nN; G = G_; c = c_; }
    __host__ __device__ bool next(int i, Unit& u) const {
        const long L = (long)i * G + c; if (L >= nwg) return false;
        int wgid = (int)L; { const int q = nwg / NXCD, r = nwg % NXCD, xcd = wgid % NXCD, off = wgid / NXCD; wgid = (xcd < r ? xcd * (q + 1) : r * (q + 1) + (xcd - r) * q) + off; }
        const int nig = WGM * nN, gid = wgid / nig, fm = gid * WGM, gsz = (nM - fm) < WGM ? (nM - fm) : WGM;
        u.pm = fm + ((wgid % nig) % gsz); u.pn = (wgid % nig) / gsz; return true;
    }
    __device__ __forceinline__ void a_ready(const Unit&) const {}
    __device__ __forceinline__ void done(const Unit&) const {}
};

__device__ __forceinline__ unsigned cvt_pk_bf16(float lo, float hi) { unsigned r; asm volatile("v_cvt_pk_bf16_f32 %0, %1, %2" : "=v"(r) : "v"(lo), "v"(hi)); return r; }
typedef float f32x2 __attribute__((ext_vector_type(2)));
template <class Epi, class Sched, bool ALIGN_EPI = false, bool SP2 = false>
__device__ __forceinline__ void gemm_phase(PG8_LAS unsigned char* lds, const Gemm g, const Sched& S, const Epi& E) {
    int tid_ = threadIdx.x; asm volatile("" : "+v"(tid_));
    const int tid = tid_, wid = __builtin_amdgcn_readfirstlane(tid >> 6), lane = tid & 63, wr = wid >> 2, wc = wid & 3, fr = lane & 15, fq = lane >> 4;
    const int K = g.K, nt = K / BK;
    unsigned voffA[2], voffB[2];
#pragma unroll
    for (int i = 0; i < 2; ++i) { int R, C; stage_rc(tid * 16 + i * 8192, R, C); const int Rb = Epi::PERM ? ((R & ~31) + perm32(R & 31)) : R;
        voffA[i] = (unsigned)(R * K + C) * 2u; voffB[i] = (unsigned)(Rb * K + C) * 2u; }
    const size_t kstep = (size_t)(BK * 2);
    const size_t hstep = (size_t)HALF * K * 2;
    const size_t tstep = 2 * hstep;
    const unsigned ldsw = (unsigned)wid * 1024u;
    const int aoff = lds_byte(wr * 64 + fr, fq * 8), boff = lds_byte(wc * 32 + fr, fq * 8);
#define PG8_SA(b, h) (((b) * 2 + (h)) * HTB)
#define PG8_SB(b, h) ((4 + (b) * 2 + (h)) * HTB)
#define PG8_STAGE(bufoff, gbase, voff) do { _Pragma("unroll") for (int _i = 0; _i < 2; ++_i) \
        __builtin_amdgcn_global_load_lds((const unsigned*)((const char*)(gbase) + (voff)[_i]), (PG8_LAS unsigned*)(lds + (bufoff) + ldsw + _i * 8192), 16, 0, 0); } while (0)
#define PG8_LDA(dst, b, h) do { _Pragma("unroll") for (int m = 0; m < 4; ++m) _Pragma("unroll") for (int k = 0; k < 2; ++k) dst[m][k] = *(const PG8_LAS bf16x8*)(lds + PG8_SA(b, h) + aoff + m * 2048 + k * 1024); } while (0)
#define PG8_LDB(dst, b, h) do { _Pragma("unroll") for (int n = 0; n < 2; ++n) _Pragma("unroll") for (int k = 0; k < 2; ++k) dst[n][k] = *(const PG8_LAS bf16x8*)(lds + PG8_SB(b, h) + boff + n * 2048 + k * 1024); } while (0)
#define PG8_MMA(ai, bj, At, Bt) do { __builtin_amdgcn_s_setprio(1); _Pragma("unroll") for (int m = 0; m < 4; ++m) _Pragma("unroll") for (int n = 0; n < 2; ++n) _Pragma("unroll") for (int k = 0; k < 2; ++k) \
        acc[ai][bj][m][n] = __builtin_amdgcn_mfma_f32_16x16x32_bf16(Bt[n][k], At[m][k], acc[ai][bj][m][n], 0, 0, 0); __builtin_amdgcn_s_setprio(0); } while (0)
#define PG8_WAIT_V(n) asm volatile("s_waitcnt vmcnt(" #n ")" ::: "memory")
#define PG8_WAIT_L(n) asm volatile("s_waitcnt lgkmcnt(" #n ")" ::: "memory")
#define PG8_BAR __builtin_amdgcn_s_barrier()
#define PG8_SCHED __builtin_amdgcn_sched_barrier(0)
    Unit cur, nxt; int ui = 0;
    if (!S.next(0, cur)) return;
    f32x4 acc[2][2][4][2];
#pragma unroll
    for (int a = 0; a < 2; ++a)
#pragma unroll
        for (int b = 0; b < 2; ++b)
#pragma unroll
            for (int m = 0; m < 4; ++m)
#pragma unroll
                for (int n = 0; n < 2; ++n) acc[a][b][m][n] = (f32x4){0.f, 0.f, 0.f, 0.f};
    bf16x8 At[4][2], B0[2][2], B1[2][2];
    const char* cA = (const char*)g.A + (size_t)cur.pm * tstep; const char* cB = (const char*)g.Bt + (size_t)cur.pn * tstep;
    S.a_ready(cur);
    if constexpr (SP2) {
        PG8_STAGE(PG8_SB(0, 0), cB, voffB); PG8_STAGE(PG8_SB(0, 1), cB + hstep, voffB); PG8_STAGE(PG8_SA(0, 0), cA, voffA); PG8_STAGE(PG8_SA(0, 1), cA + hstep, voffA);
        if (wr == 1) PG8_BAR;
        PG8_WAIT_V(2); PG8_BAR;
        PG8_STAGE(PG8_SB(1, 0), cB + kstep, voffB); PG8_STAGE(PG8_SA(1, 0), cA + kstep, voffA); PG8_STAGE(PG8_SB(1, 1), cB + hstep + kstep, voffB);
        PG8_WAIT_V(6); PG8_BAR;
    } else {
        PG8_STAGE(PG8_SB(0, 0), cB, voffB); PG8_STAGE(PG8_SA(0, 0), cA, voffA); PG8_STAGE(PG8_SB(0, 1), cB + hstep, voffB); PG8_STAGE(PG8_SA(0, 1), cA + hstep, voffA);
        if (wr == 1) PG8_BAR;
        PG8_WAIT_V(4); PG8_BAR;
        PG8_STAGE(PG8_SB(1, 0), cB + kstep, voffB); PG8_STAGE(PG8_SA(1, 0), cA + kstep, voffA); PG8_STAGE(PG8_SB(1, 1), cB + hstep + kstep, voffB);
        PG8_WAIT_V(6); PG8_BAR;
    }
    for (;;) {
        const bool has_next = S.next(ui + 1, nxt);
        const char* nA = has_next ? (const char*)g.A + (size_t)nxt.pm * tstep : cA; const char* nB = has_next ? (const char*)g.Bt + (size_t)nxt.pn * tstep : cB;
        for (int t = 0; t < nt; t += 2) {
            const bool last = (t == nt - 2);
            const char* a1 = cA + (size_t)(t + 1) * kstep;
            const char* a2 = last ? nA : cA + (size_t)(t + 2) * kstep; const char* b2 = last ? nB : cB + (size_t)(t + 2) * kstep;
            const char* a3 = a2 + kstep; const char* b3 = b2 + kstep;
            if (last && has_next) S.a_ready(nxt);
            if constexpr (SP2) {
            PG8_LDB(B0, 0, 0); PG8_LDB(B1, 0, 1); PG8_SCHED; PG8_LDA(At, 0, 0); PG8_STAGE(PG8_SA(1, 1), a1 + hstep, voffA);
            PG8_WAIT_V(8); PG8_WAIT_L(0); PG8_BAR; PG8_MMA(0, 0, At, B0); PG8_MMA(0, 1, At, B1); PG8_BAR; PG8_SCHED;
            PG8_LDA(At, 0, 1); PG8_STAGE(PG8_SB(0, 0), b2, voffB); PG8_STAGE(PG8_SB(0, 1), b2 + hstep, voffB); PG8_STAGE(PG8_SA(0, 0), a2, voffA);
            PG8_WAIT_V(8); PG8_WAIT_L(0); PG8_BAR; PG8_MMA(1, 0, At, B0); PG8_MMA(1, 1, At, B1); PG8_BAR; PG8_SCHED;
            PG8_LDB(B0, 1, 0); PG8_LDB(B1, 1, 1); PG8_SCHED; PG8_LDA(At, 1, 0); PG8_STAGE(PG8_SA(0, 1), a2 + hstep, voffA);
            PG8_WAIT_V(8); PG8_WAIT_L(0); PG8_BAR; PG8_MMA(0, 0, At, B0); PG8_MMA(0, 1, At, B1); PG8_BAR; PG8_SCHED;
            PG8_LDA(At, 1, 1); PG8_STAGE(PG8_SB(1, 0), b3, voffB); PG8_STAGE(PG8_SB(1, 1), b3 + hstep, voffB); PG8_STAGE(PG8_SA(1, 0), a3, voffA);
            PG8_WAIT_V(8); PG8_WAIT_L(0); PG8_BAR; PG8_MMA(1, 0, At, B0); PG8_MMA(1, 1, At, B1); PG8_BAR; PG8_SCHED;
            } else {
            PG8_LDB(B0, 0, 0); PG8_SCHED; PG8_LDA(At, 0, 0); PG8_STAGE(PG8_SA(1, 1), a1 + hstep, voffA);
            PG8_WAIT_L(8); PG8_BAR; PG8_WAIT_L(0); PG8_MMA(0, 0, At, B0); PG8_BAR; PG8_SCHED;
            PG8_LDB(B1, 0, 1); PG8_STAGE(PG8_SB(0, 0), b2, voffB);
            PG8_BAR; PG8_WAIT_L(0); PG8_MMA(0, 1, At, B1); PG8_BAR;
            PG8_LDA(At, 0, 1); PG8_STAGE(PG8_SA(0, 0), a2, voffA);
            PG8_BAR; PG8_WAIT_L(0); PG8_MMA(1, 0, At, B0); PG8_BAR; PG8_SCHED;
            PG8_STAGE(PG8_SB(0, 1), b2 + hstep, voffB);
            PG8_WAIT_V(6); PG8_BAR; PG8_MMA(1, 1, At, B1); PG8_BAR;
            PG8_LDB(B0, 1, 0); PG8_SCHED; PG8_LDA(At, 1, 0); PG8_STAGE(PG8_SA(0, 1), a2 + hstep, voffA);
            PG8_WAIT_L(8); PG8_BAR; PG8_WAIT_L(0); PG8_MMA(0, 0, At, B0); PG8_BAR; PG8_SCHED;
            PG8_LDB(B1, 1, 1); PG8_STAGE(PG8_SB(1, 0), b3, voffB);
            PG8_BAR; PG8_WAIT_L(0); PG8_MMA(0, 1, At, B1); PG8_BAR;
            PG8_LDA(At, 1, 1); PG8_STAGE(PG8_SA(1, 0), a3, voffA);
            PG8_BAR; PG8_WAIT_L(0); PG8_MMA(1, 0, At, B0); PG8_BAR; PG8_SCHED;
            PG8_STAGE(PG8_SB(1, 1), b3 + hstep, voffB);
            PG8_WAIT_V(6); PG8_BAR; PG8_MMA(1, 1, At, B1); PG8_BAR;
            }
        }
        if constexpr (ALIGN_EPI) { if (wr == 0) PG8_BAR; }
        if constexpr (!Epi::AFTER_DRAIN) { E(acc, cur, wr, wc, fr, fq); S.done(cur); }
        if (!has_next) break;
#pragma unroll
        for (int a = 0; a < 2; ++a)
#pragma unroll
            for (int b = 0; b < 2; ++b)
#pragma unroll
                for (int m = 0; m < 4; ++m)
#pragma unroll
                    for (int n = 0; n < 2; ++n) acc[a][b][m][n] = (f32x4){0.f, 0.f, 0.f, 0.f};
        cur = nxt; cA = nA; cB = nB; ++ui;
        if constexpr (ALIGN_EPI) { if (wr == 1) PG8_BAR; }
    }
    PG8_WAIT_V(0);
    if constexpr (!ALIGN_EPI) { if (wr == 0) PG8_BAR; }
    PG8_BAR;
    if constexpr (Epi::AFTER_DRAIN) { E.fused(acc, cur, wr, wc, fr, fq, lds, wid, lane); S.done(cur); }
#undef PG8_SA
#undef PG8_SB
#undef PG8_STAGE
#undef PG8_LDA
#undef PG8_LDB
#undef PG8_MMA
#undef PG8_WAIT_V
#undef PG8_WAIT_L
#undef PG8_BAR
#undef PG8_SCHED
}
}
#define GAS __attribute__((address_space(1)))
#define LAS __attribute__((address_space(3)))
typedef unsigned short bf16;
typedef unsigned v4u __attribute__((ext_vector_type(4)));
typedef float f32x4 __attribute__((ext_vector_type(4)));
typedef short bf16x8 __attribute__((ext_vector_type(8)));
typedef GAS unsigned gu32;
typedef GAS unsigned long long gu64;
#define RLX_AGENT __ATOMIC_RELAXED, __HIP_MEMORY_SCOPE_AGENT
#define LDS_WAIT() asm volatile("s_waitcnt lgkmcnt(0)" ::: "memory")
#define VM_WAIT() asm volatile("s_waitcnt vmcnt(0)" ::: "memory")
__device__ __forceinline__ unsigned long long rt() { return __builtin_amdgcn_s_memrealtime(); }
__device__ __forceinline__ unsigned f2bf(float f) { unsigned u = __builtin_bit_cast(unsigned, f); return (u + 0x7fffu + ((u >> 16) & 1u)) >> 16; }
__device__ __forceinline__ unsigned pk2(float lo, float hi) { return f2bf(lo) | (f2bf(hi) << 16); }
#define XB_TMO      128
#define XB_XCNT(j)  (256  + 64 * (j))
#define XB_XSUB(j)  (1280 + 64 * (j))
#define XB_XGEN(j)  (2304 + 64 * (j))
#define XB_TOP      3328
#define XB_TOPGEN   3392
#define XCD_BAR_WORDS 3456
#define XB_SPIN_CAP (1u << 18)

__device__ __forceinline__ unsigned xb_ld(unsigned* p)              { return __hip_atomic_load(p, __ATOMIC_RELAXED, __HIP_MEMORY_SCOPE_AGENT); }
__device__ __forceinline__ unsigned xb_add(unsigned* p, unsigned v) { return __hip_atomic_fetch_add(p, v, __ATOMIC_RELAXED, __HIP_MEMORY_SCOPE_AGENT); }
__device__ __forceinline__ unsigned xb_xcc_id() { return (unsigned)__builtin_amdgcn_s_getreg((3 << 11) | 20) & 0xFu; }
#define XB_SPIN(cond, bar) do { unsigned _sp = 0; while (cond) { __builtin_amdgcn_s_sleep(1); \
    if ((++_sp & 255u) == 0u) { if (xb_ld(&(bar)[XB_TMO])) break; if (_sp > XB_SPIN_CAP) { atomicAdd(&(bar)[XB_TMO], 1u); break; } } } } while (0)

struct XcdBarrier {
    unsigned* bar; unsigned x;
    volatile LAS unsigned* st;
};

__device__ __forceinline__ XcdBarrier xcd_barrier_post(unsigned* bar, volatile LAS unsigned* st) {
    XcdBarrier b; b.bar = bar; b.x = xb_xcc_id(); b.st = st;
    if (threadIdx.x == 0) (void)xb_add(&bar[XB_XCNT(b.x)], 1u);
    return b;
}
__device__ __forceinline__ void xcd_barrier_complete(unsigned* bar, unsigned x, unsigned& nloc, unsigned& nx) {
    const unsigned G = gridDim.x * gridDim.y * gridDim.z;
    unsigned sum, cnt, mine, sp = 0u;
    for (;;) {
        sum = 0u; cnt = 0u; mine = 0u;
#pragma unroll
        for (unsigned j = 0; j < 16; ++j) { const unsigned c = xb_ld(&bar[XB_XCNT(j)]); sum += c; cnt += (c > 0u) ? 1u : 0u; mine = (j == x) ? c : mine; }
        if (sum == G) break;
        __builtin_amdgcn_s_sleep(1);
        if ((++sp & 255u) == 0u) { if (xb_ld(&bar[XB_TMO])) break; if (sp > XB_SPIN_CAP) { atomicAdd(&bar[XB_TMO], 1u); break; } }
    }
    nloc = mine > 0u ? mine : 1u; nx = cnt > 0u ? cnt : 1u;
}

__device__ __forceinline__ void xcd_barrier(const XcdBarrier& b) {
    asm volatile("s_waitcnt vmcnt(0)" ::: "memory");
    __syncthreads();
    if (threadIdx.x == 0) {
        unsigned* bar = b.bar;
        __builtin_amdgcn_s_waitcnt(0);
        unsigned nloc = b.st[0], nx = b.st[1];
        if (nloc == 0u) { xcd_barrier_complete(bar, b.x, nloc, nx); b.st[0] = nloc; b.st[1] = nx; }
        const unsigned old = xb_add(&bar[XB_XSUB(b.x)], 1u);
        const unsigned gen = old / nloc;
        if (old + 1u == (gen + 1u) * nloc) {
            __builtin_amdgcn_fence(__ATOMIC_RELEASE, "agent");
            asm volatile("s_waitcnt vmcnt(0)" ::: "memory");
            const unsigned og = xb_add(&bar[XB_TOP], 1u);
            const unsigned tg = og / nx;
            if (og + 1u == (tg + 1u) * nx) xb_add(&bar[XB_TOPGEN], 1u);
            else XB_SPIN(xb_ld(&bar[XB_TOPGEN]) == tg, bar);
            __builtin_amdgcn_fence(__ATOMIC_ACQUIRE, "agent");
            xb_add(&bar[XB_XGEN(b.x)], 1u);
            asm volatile("s_waitcnt vmcnt(0)" ::: "memory");
        } else {
            XB_SPIN(xb_ld(&bar[XB_XGEN(b.x)]) == gen, bar);
            __builtin_amdgcn_fence(__ATOMIC_ACQUIRE, "agent");
            asm volatile("s_waitcnt vmcnt(0)" ::: "memory");
        }
    }
    __syncthreads();
}
constexpr int NWAVES = 8, NT = 512;
constexpr int D = 2048, NLAYER = 4;
constexpr int MC = 32 * 256, ML = 4 * 4096, M = MC + ML;
constexpr int DIN = 6176, NPROJ = 6144, NPAD = 6400, DFF = 8192, GWID = 512;
constexpr int NCP = M / 128;
constexpr float EPS = 1e-6f;
constexpr int PC_S5U = 0, PC_MQ = 512, PC_MK = 1024, PC_MV = 1536, PC_MO = 2048, PC_RQ = 2560, PC_RK = 3072, PC_RV = 3584, PC_RG = 4096, PC_DZ = 4608, PC_DX = 5120, PC_DB = 5632, PC_DC = 5888;
enum { I_XP = 0, I_XS, I_C, I_SS5R, I_SS5I, I_SMC, I_SMN, I_SMM, I_SRET, I_SSSD, I_CCTX, I_NORM1, I_WADA, I_BADA, I_WIN, I_S5LR, I_S5LI, I_S5DT, I_S5BR, I_S5BI, I_S5CR, I_S5CI, I_S5D, I_S5GLU,
       I_MIB, I_MFB, I_MNORM, I_RRATE, I_RNORM, I_CONVW, I_CONVB, I_DTB, I_ALOG, I_SSDD, I_SNORM, I_WOUT, I_NORM2, I_WM1, I_WM2, I_FNORM, N_IN };
constexpr size_t O_YP = 0, O_YS = (size_t)MC * D, O_S5R = (size_t)M * D, O_S5I = O_S5R + 524288, O_MC = O_S5I + 524288, O_MN = O_MC + 16777216, O_MM = O_MN + 131072, O_RET = O_MM + 1024, O_SSD = O_RET + 16777216, O_END = O_SSD + 16777216;

constexpr size_t MiB = 1u << 20;
constexpr size_t WS_CTL = 0, CTL_ZERO_BYTES = 1 * MiB;
constexpr size_t WS_MOD = 1 * MiB;
constexpr size_t WS_S5T = 2 * MiB;
constexpr size_t WS_ROPE = 5 * MiB;
constexpr size_t WS_GATES = 6 * MiB;
constexpr size_t WS_MLNLOC = 9 * MiB;
constexpr size_t WS_MLNIN = 10 * MiB;
constexpr size_t WS_MLSC = 11 * MiB;
constexpr size_t WS_MLMIN = 11 * MiB + 65536;
constexpr size_t WS_SDSC = 11 * MiB + 131072;
constexpr size_t WS_SSQA = 11 * MiB + 262144;
constexpr size_t WS_SSQB = 11 * MiB + 393216;
constexpr size_t WS_SHW1 = 18 * MiB;
constexpr size_t WS_SHW2 = 19 * MiB;
constexpr size_t WS_S5LOC = 12 * MiB;
constexpr size_t WS_WGT = 20 * MiB;
constexpr size_t WS_W1T = 22 * MiB;
constexpr size_t WS_WOT = 122 * MiB;
constexpr size_t WS_WM1T = 154 * MiB;
constexpr size_t WS_WM2T = 282 * MiB;
constexpr size_t WS_H = 410 * MiB;
constexpr size_t WS_Y = 506 * MiB;
constexpr size_t WS_YA = 602 * MiB;
constexpr size_t WS_MLCIN = 626 * MiB;
constexpr size_t WS_RTIN = 674 * MiB;
constexpr size_t WS_SDIN = 722 * MiB;
constexpr size_t WS_PROJ = 770 * MiB;
constexpr size_t WS_MLCLOC = 1058 * MiB;
constexpr size_t WS_HID = 770 * MiB;
constexpr size_t WS_RTLOC = 1154 * MiB;
constexpr size_t WS_SDLOC = 1250 * MiB;
constexpr size_t WS_END = 1346 * MiB;
constexpr int CW_TMO = 0, CW_BAR = 4096;

constexpr int LDT = 272;
constexpr int TS = 128 * LDT;
constexpr int LDX = 144;
constexpr int TSX = 128 * LDX;
constexpr int SCAL_OFF = 4 * TS;
constexpr int MISC_OFF = 163840 - 256;
constexpr int LDS_BYTES = 163840;
#define SCA(i) ((LAS float*)(F.lds + SCAL_OFF + (i) * 512))
typedef float f32x16 __attribute__((ext_vector_type(16)));
typedef float f32x2 __attribute__((ext_vector_type(2)));
typedef short s16x4 __attribute__((ext_vector_type(4)));
typedef unsigned u32x2 __attribute__((ext_vector_type(2)));
struct Args { const float* in[N_IN]; float* out; unsigned char* ws; int ph_lo, ph_hi; };
struct Frame {
    LAS unsigned char* lds;
    float* out; unsigned char* ws;
    int tid, lane, wave, G, bid;
};
typedef const __attribute__((address_space(4))) Args KArgs;
__device__ __forceinline__ KArgs* kargs() { KArgs* p = (KArgs*)__builtin_amdgcn_kernarg_segment_ptr(); asm volatile("" : "+s"(p)); return p; }
__device__ __forceinline__ Frame fresh(const Frame& F) { Frame R = F; unsigned long long l = (unsigned long long)(size_t)R.lds; unsigned ll = (unsigned)l; asm volatile("" : "+s"(ll), "+s"(R.wave), "+s"(R.G), "+s"(R.bid), "+v"(R.tid), "+v"(R.lane)); R.lds = (LAS unsigned char*)(size_t)ll; KArgs* ka = kargs(); R.out = (float*)(GAS float*)ka->out; R.ws = (unsigned char*)(GAS unsigned char*)ka->ws; return R; }
#define INP(i) ((const float*)(const GAS float*)(A.in[i]))
#define WSP(T, off) ((T*)(F.ws + (off)))
__device__ __forceinline__ float bf2f(unsigned short b) { return __uint_as_float((unsigned)b << 16); }
__device__ __forceinline__ float bflo(unsigned w) { return __uint_as_float(w << 16); }
__device__ __forceinline__ float bfhi(unsigned w) { return __uint_as_float(w & 0xffff0000u); }
__device__ __forceinline__ void unpack8(const v4u a, float (&x)[8]) { x[0] = bflo(a.x); x[1] = bfhi(a.x); x[2] = bflo(a.y); x[3] = bfhi(a.y); x[4] = bflo(a.z); x[5] = bfhi(a.z); x[6] = bflo(a.w); x[7] = bfhi(a.w); }
__device__ __forceinline__ v4u pack8(const float (&x)[8], float w) { v4u o; o.x = pk2(x[0] * w, x[1] * w); o.y = pk2(x[2] * w, x[3] * w); o.z = pk2(x[4] * w, x[5] * w); o.w = pk2(x[6] * w, x[7] * w); return o; }
__device__ __forceinline__ float sigmoidf_(float x) { return 1.f / (1.f + __expf(-x)); }
__device__ __forceinline__ float siluf_(float x) { return x * sigmoidf_(x); }
__device__ __forceinline__ float wave_sum(float v) {
#pragma unroll
    for (int o = 1; o < 64; o <<= 1) v += __shfl_xor(v, o);
    return v;
}
__device__ __forceinline__ float wave_max(float v) {
#pragma unroll
    for (int o = 1; o < 64; o <<= 1) v = fmaxf(v, __shfl_xor(v, o));
    return v;
}
template <bool MAX> __device__ __forceinline__ void wave_scan128(const LAS float* in, LAS float* out, int lane, bool rev, float init) {
    const int i0 = rev ? 127 - 2 * lane : 2 * lane, i1 = rev ? i0 - 1 : i0 + 1;
    float e0 = in[i0], e1 = in[i1];
    if (lane == 0) e0 = MAX ? fmaxf(e0, init) : e0 + init;
    float inc = MAX ? fmaxf(e0, e1) : e0 + e1;
#pragma unroll
    for (int o = 1; o < 64; o <<= 1) { const float t = __shfl_up(inc, o); if (lane >= o) inc = MAX ? fmaxf(inc, t) : inc + t; }
    float exc = __shfl_up(inc, 1);
    const float o0 = (lane == 0) ? e0 : (MAX ? fmaxf(exc, e0) : exc + e0);
    out[i0] = o0; out[i1] = inc;
}
__device__ __forceinline__ s16x4 lds_tr(const LAS unsigned char* p) {
    typedef short v4i16_t __attribute__((ext_vector_type(4)));
    return __builtin_bit_cast(s16x4, __builtin_amdgcn_ds_read_tr16_b64_v4i16((LAS v4i16_t*)p));
}
__device__ __forceinline__ bf16x8 frag_row(const LAS unsigned char* base, int ld, int r0, int k0, int lane) {
    return *(const LAS bf16x8*)(base + (r0 + (lane & 31)) * ld + (k0 + 8 * (lane >> 5)) * 2);
}
__device__ __forceinline__ bf16x8 frag_tr(const LAS unsigned char* base, int ld, int k0, int c0, int lane) {
    const int h = lane >> 5, blk = (lane >> 4) & 1, q = (lane & 15) >> 2, p = lane & 3;
    const LAS unsigned char* a = base + (k0 + 8 * h + q) * ld + (c0 + 16 * blk + 4 * p) * 2;
    const s16x4 lo = lds_tr(a), hi = lds_tr(a + 4 * ld);
    return (bf16x8){lo[0], lo[1], lo[2], lo[3], hi[0], hi[1], hi[2], hi[3]};
}
#define MFMA32(a, b, c) __builtin_amdgcn_mfma_f32_32x32x16_bf16((a), (b), (c), 0, 0, 0)
#define ZERO16 ((f32x16){0.f,0.f,0.f,0.f,0.f,0.f,0.f,0.f,0.f,0.f,0.f,0.f,0.f,0.f,0.f,0.f})
__device__ __forceinline__ int crow(int i, int hh) { return (i & 3) + 8 * (i >> 2) + 4 * hh; }

__device__ __forceinline__ const float* x_in_row(const Frame& F, KArgs& A, int l, int r) {
    if (l == 0) return r < MC ? INP(I_XP) + (size_t)r * D : INP(I_XS) + (size_t)(r - MC) * D;
    return F.out + (size_t)r * D;
}
__device__ __forceinline__ int mod_row(int r) { return r < MC ? 0 : 1 + (r - MC) / 4096; }
__device__ __forceinline__ const float* mod_ptr(const Frame& F, int l, int mrow, int part) { return WSP(const float, WS_MOD) + ((size_t)(l * 5 + mrow) * 6 + part) * D; }
struct Seq { int cp0, nch, c, b, lat; };
__device__ __forceinline__ Seq seq_of(int cp) { Seq s; if (cp < 64) { s.lat = 0; s.b = cp >> 1; s.cp0 = cp & ~1; s.nch = 2; s.c = cp & 1; } else { s.lat = 1; s.b = (cp - 64) >> 5; s.cp0 = 64 + (s.b << 5); s.nch = 32; s.c = (cp - 64) & 31; } return s; }
__device__ __forceinline__ int w1_newcol(int n) { return n < 2560 ? n : (n < 2576 ? n - 2560 + 6144 : (n < 6160 ? n - 16 : n)); }
template <bool MAPW1> __device__ __forceinline__ void p0_transpose_item(const float* W, int K, int N, bf16* WT, LAS float* scr, int item, int lane) {
    const int nblk = N / 32, kb = item / nblk, nb = item % nblk, k0 = 64 * kb, n0 = 32 * nb;
#pragma unroll 8
    for (int i = 0; i < 32; ++i) { const int kk = 2 * i + (lane >> 5); scr[kk * 33 + (lane & 31)] = W[(size_t)(k0 + kk) * N + n0 + (lane & 31)]; }
    LDS_WAIT(); asm volatile("" ::: "memory");
    const int c = lane & 7;
#pragma unroll
    for (int j = 0; j < 4; ++j) { const int n = (lane >> 3) + 8 * j; const LAS float* s = scr + (8 * c) * 33 + n;
        v4u o; o.x = pk2(s[0 * 33], s[1 * 33]); o.y = pk2(s[2 * 33], s[3 * 33]); o.z = pk2(s[4 * 33], s[5 * 33]); o.w = pk2(s[6 * 33], s[7 * 33]);
        const int nr = MAPW1 ? w1_newcol(n0 + n) : (n0 + n);
        *(GAS v4u*)(WT + (size_t)nr * K + k0 + 8 * c) = o; }
    LDS_WAIT(); asm volatile("" ::: "memory");
}
constexpr int S5T_STRIDE = 9216;
__device__ __forceinline__ unsigned char* s5tab(const Frame& F, int l, int d, int g) { return F.ws + WS_S5T + (size_t)((l * 2 + d) * 32 + g) * S5T_STRIDE; }

__device__ __forceinline__ void p0_prologue(Frame& F, KArgs& A) {
    {
        LAS float* scr = (LAS float*)(F.lds + F.wave * 16384);
        const int gw = F.bid * NWAVES + F.wave, NGW = F.G * NWAVES;
        constexpr int I_1 = (D / 64) * (DIN / 32), I_G = (GWID / 64) * (GWID / 32), I_O = (D / 64) * (D / 32), I_M1 = (D / 64) * (DFF / 32), I_M2 = (DFF / 64) * (D / 32);
        constexpr int PER_L = I_1 + I_G + I_O + I_M1 + I_M2;
        for (int it = gw; it < NLAYER * PER_L; it += NGW) {
            const int l = it / PER_L; int r = it % PER_L;
            if (r < I_1) { p0_transpose_item<true>(INP(I_WIN) + (size_t)l * D * DIN, D, DIN, WSP(bf16, WS_W1T) + (size_t)l * NPAD * D, scr, r, F.lane); continue; } r -= I_1;
            if (r < I_G) { p0_transpose_item<false>(INP(I_S5GLU) + (size_t)l * GWID * GWID, GWID, GWID, WSP(bf16, WS_WGT) + (size_t)l * GWID * GWID, scr, r, F.lane); continue; } r -= I_G;
            if (r < I_O) { p0_transpose_item<false>(INP(I_WOUT) + (size_t)l * D * D, D, D, WSP(bf16, WS_WOT) + (size_t)l * D * D, scr, r, F.lane); continue; } r -= I_O;
            if (r < I_M1) { p0_transpose_item<false>(INP(I_WM1) + (size_t)l * D * DFF, D, DFF, WSP(bf16, WS_WM1T) + (size_t)l * DFF * D, scr, r, F.lane); continue; } r -= I_M1;
            p0_transpose_item<false>(INP(I_WM2) + (size_t)l * DFF * D, DFF, D, WSP(bf16, WS_WM2T) + (size_t)l * D * DFF, scr, r, F.lane);
        }
        const int gt = F.bid * NT + F.tid, NGT = F.G * NT;
        for (int i = gt; i < NLAYER * 224 * 256; i += NGT) { const int l = i / (224 * 256), r = i % (224 * 256);
            *(GAS v4u*)(WSP(bf16, WS_W1T) + ((size_t)l * NPAD + DIN) * D + (size_t)r * 8) = (v4u){0u, 0u, 0u, 0u}; }
        for (int i = gt; i < NLAYER * 2 * 32 * 64; i += NGT) {
            const int p = i & 63, g = (i >> 6) & 31, d = (i >> 11) & 1, l = i >> 12;
            const int ldg = (l * 2 + d) * 32 + g;
            const double lre = INP(I_S5LR)[ldg * 64 + p], lim = INP(I_S5LI)[ldg * 64 + p], dt = exp((double)INP(I_S5DT)[ldg]);
            const double er = exp(lre * dt), br = er * cos(lim * dt), bi = er * sin(lim * dt);
            const double e128 = exp(128.0 * lre * dt), b128r = e128 * cos(128.0 * lim * dt), b128i = e128 * sin(128.0 * lim * dt);
            const double nr = br - 1.0, ni = bi, den = lre * lre + lim * lim;
            const double cr = (nr * lre + ni * lim) / den, ci = (ni * lre - nr * lim) / den;
            unsigned char* tb = s5tab(F, l, d, g);
            float* lam = (float*)tb; lam[2 * p] = (float)br; lam[2 * p + 1] = (float)bi;
            float* l128 = (float*)(tb + 512); l128[2 * p] = (float)b128r; l128[2 * p + 1] = (float)b128i;
            bf16* bb = (bf16*)(tb + 1024); bf16* ct = (bf16*)(tb + 5120);
            for (int c = 0; c < 16; ++c) {
                const double Br = INP(I_S5BR)[(size_t)(ldg * 64 + p) * 16 + c], Bi = INP(I_S5BI)[(size_t)(ldg * 64 + p) * 16 + c];
                bb[p * 16 + c] = (bf16)f2bf((float)(cr * Br - ci * Bi));
                bb[(64 + p) * 16 + c] = (bf16)f2bf((float)(cr * Bi + ci * Br));
                ct[c * 128 + p] = (bf16)f2bf(INP(I_S5CR)[(size_t)(ldg * 16 + c) * 64 + p]);
                ct[c * 128 + 64 + p] = (bf16)f2bf(-INP(I_S5CI)[(size_t)(ldg * 16 + c) * 64 + p]);
            }
        }
        for (int i = gt; i < 64 * 32; i += NGT) { const int pos = i >> 5, k = i & 31; const double f = pow(10000.0, -(double)k / 32.0), a = pos * f;
            WSP(f32x2, WS_ROPE)[i] = (f32x2){(float)cos(a), (float)sin(a)}; }
    }
    __syncthreads();
    {
        LAS float* sc = (LAS float*)F.lds;
        LAS float* red = (LAS float*)(F.lds + 65536);
        for (int i = F.tid; i < 5 * D; i += NT) { const int r = i / D, k = i % D; const float v = r == 0 ? INP(I_CCTX)[k] : INP(I_C)[(r - 1) * D + k]; sc[i] = siluf_(v); }
        __syncthreads();
        for (int it = F.bid; it < NLAYER * 96; it += F.G) {
            const int l = it / 96, c0 = (it % 96) * 128;
            const float* W = INP(I_WADA) + (size_t)l * D * (6 * D);
            float acc[5][4];
#pragma unroll
            for (int r = 0; r < 5; ++r)
#pragma unroll
                for (int j = 0; j < 4; ++j) acc[r][j] = 0.f;
            const int cl = F.lane & 31, kp = F.lane >> 5;
#pragma unroll 4
            for (int kk = 0; kk < 128; ++kk) {
                const int k = F.wave * 256 + 2 * kk + kp;
                const f32x4 w = *(const f32x4*)(W + (size_t)k * (6 * D) + c0 + 4 * cl);
#pragma unroll
                for (int r = 0; r < 5; ++r) { const float s = sc[r * D + k]; acc[r][0] += s * w.x; acc[r][1] += s * w.y; acc[r][2] += s * w.z; acc[r][3] += s * w.w; }
            }
#pragma unroll
            for (int r = 0; r < 5; ++r)
#pragma unroll
                for (int j = 0; j < 4; ++j) { acc[r][j] += __shfl_xor(acc[r][j], 32); }
            if (kp == 0) {
#pragma unroll
                for (int r = 0; r < 5; ++r)
#pragma unroll
                    for (int j = 0; j < 4; ++j) red[(F.wave * 5 + r) * 128 + 4 * cl + j] = acc[r][j];
            }
            __syncthreads();
            for (int i = F.tid; i < 5 * 128; i += NT) { const int r = i >> 7, j = i & 127; float s = 0.f;
#pragma unroll
                for (int w = 0; w < 8; ++w) s += red[(w * 5 + r) * 128 + j];
                WSP(float, WS_MOD)[(size_t)(l * 5 + r) * (6 * D) + c0 + j] = s + INP(I_BADA)[(size_t)l * (6 * D) + c0 + j]; }
            __syncthreads();
        }
    }
}

__device__ __forceinline__ void norm0_phase(Frame& F, KArgs& A) {
    const int gw = F.bid * NWAVES + F.wave, NGW = F.G * NWAVES;
    const float* gain = INP(I_NORM1);
    for (int m = gw; m < M; m += NGW) {
        const float* xr = x_in_row(F, A, 0, m);
        const float* scp = mod_ptr(F, 0, mod_row(m), 1);
        f32x4 v[8]; float s = 0.f;
#pragma unroll
        for (int j = 0; j < 8; ++j) { v[j] = *(const f32x4*)(xr + 4 * F.lane + 256 * j); s += (v[j].x * v[j].x + v[j].y * v[j].y) + (v[j].z * v[j].z + v[j].w * v[j].w); }
        s = wave_sum(s);
        if (F.lane == 0) WSP(float, WS_SSQB)[m] = s;
        bf16* orow = WSP(bf16, WS_H) + (size_t)m * D;
#pragma unroll
        for (int j = 0; j < 8; ++j) { const int c = 4 * F.lane + 256 * j;
            const f32x4 g4 = *(const f32x4*)(gain + c), s4 = *(const f32x4*)(scp + c);
            *(u32x2*)(orow + c) = (u32x2){pk2(v[j].x * g4.x * (1.f + s4.x), v[j].y * g4.y * (1.f + s4.y)), pk2(v[j].z * g4.z * (1.f + s4.z), v[j].w * g4.w * (1.f + s4.w))}; }
    }
}
__device__ __forceinline__ void shw_phase(Frame& F) {
    LAS float* sh = (LAS float*)F.lds;
    const int gw = F.bid * NWAVES + F.wave, NGW = F.G * NWAVES;
    for (int grp = 0; grp < 2 * NLAYER; ++grp) {
        const int l = grp >> 1, which = grp & 1;
        __syncthreads();
        for (int i = F.tid; i < 5 * D; i += NT) sh[i] = WSP(const float, WS_MOD)[((size_t)(l * 5 + i / D) * 6 + (which ? 3 : 0)) * D + (i % D)];
        __syncthreads();
        const int N = which ? DFF : DIN, NS = which ? DFF : NPAD;
        const bf16* Wt = which ? WSP(const bf16, WS_WM1T) + (size_t)l * DFF * D : WSP(const bf16, WS_W1T) + (size_t)l * NPAD * D;
        float* o = which ? WSP(float, WS_SHW2) + (size_t)l * 5 * DFF : WSP(float, WS_SHW1) + (size_t)l * 5 * NPAD;
        for (int n = gw; n < N; n += NGW) {
            float acc[5] = {0.f, 0.f, 0.f, 0.f, 0.f};
#pragma unroll
            for (int j = 0; j < 4; ++j) { const int k = 8 * F.lane + 512 * j; float w[8]; unpack8(*(const v4u*)(Wt + (size_t)n * D + k), w);
#pragma unroll
                for (int r = 0; r < 5; ++r) { const f32x4 a0 = *(const LAS f32x4*)(sh + r * D + k), a1 = *(const LAS f32x4*)(sh + r * D + k + 4);
                    acc[r] += (w[0] * a0.x + w[1] * a0.y) + (w[2] * a0.z + w[3] * a0.w) + (w[4] * a1.x + w[5] * a1.y) + (w[6] * a1.z + w[7] * a1.w); } }
#pragma unroll
            for (int r = 0; r < 5; ++r) { const float s = wave_sum(acc[r]); if (F.lane == 0) o[(size_t)r * NS + n] = s; }
        }
    }
    __syncthreads();
}
__device__ __forceinline__ void final_norm_phase(Frame& F, KArgs& A) {
    const int gw = F.bid * NWAVES + F.wave, NGW = F.G * NWAVES;
    const float* gain = INP(I_FNORM);
    for (int m = gw; m < M; m += NGW) {
        float* xr = F.out + (size_t)m * D;
        f32x4 v[8]; float s = 0.f;
#pragma unroll
        for (int j = 0; j < 8; ++j) { v[j] = *(const f32x4*)(xr + 4 * F.lane + 256 * j); s += (v[j].x * v[j].x + v[j].y * v[j].y) + (v[j].z * v[j].z + v[j].w * v[j].w); }
        const float rstd = rsqrtf(wave_sum(s) * (1.f / D) + EPS);
#pragma unroll
        for (int j = 0; j < 8; ++j) { const int c = 4 * F.lane + 256 * j; const f32x4 g4 = *(const f32x4*)(gain + c);
            *(f32x4*)(xr + c) = (f32x4){v[j].x * rstd * g4.x, v[j].y * rstd * g4.y, v[j].z * rstd * g4.z, v[j].w * rstd * g4.w}; }
    }
}
namespace epi {
using pg8::Unit; using pg8::f32x4; using pg8::u32x4; using pg8::bf16_t; using pg8::cvt_pk_bf16;
constexpr int BMq = 256, HALFq = 128;
struct EpiProj {
    static constexpr bool PERM = true, AFTER_DRAIN = false;
    bf16_t* P; float* G; const float* ssq; const float* shw0;
    __device__ __forceinline__ void operator()(const f32x4 (&acc)[2][2][4][2], const Unit& u, int wr, int wc, int fr, int fq) const {
        const int row0 = u.pm * BMq + wr * 64 + fr, rowt = u.pm * BMq;
        const float* shw = shw0 + (size_t)(rowt < MC ? 0 : 1 + (rowt - MC) / 4096) * NPAD + u.pn * BMq + wc * 32 + 8 * fq;
        if (u.pn < 24) {
            const int col0 = u.pn * BMq + wc * 32 + 8 * fq;
            f32x4 sh[2][2];
#pragma unroll
            for (int bj = 0; bj < 2; ++bj) { sh[bj][0] = *(const f32x4*)(shw + bj * HALFq); sh[bj][1] = *(const f32x4*)(shw + bj * HALFq + 4); }
#pragma unroll
            for (int ai = 0; ai < 2; ++ai)
#pragma unroll
                for (int m = 0; m < 4; ++m) { const int r = row0 + ai * HALFq + m * 16; bf16_t* rowp = P + (size_t)r * NPROJ + col0; const float rs = rsqrtf(ssq[r] * (1.f / D) + EPS);
#pragma unroll
                    for (int bj = 0; bj < 2; ++bj) { const f32x4 v0 = acc[ai][bj][m][0] * rs + sh[bj][0], v1 = acc[ai][bj][m][1] * rs + sh[bj][1];
                        u32x4 w; w.x = cvt_pk_bf16(v0[0], v0[1]); w.y = cvt_pk_bf16(v0[2], v0[3]); w.z = cvt_pk_bf16(v1[0], v1[1]); w.w = cvt_pk_bf16(v1[2], v1[3]);
                        *(u32x4*)(rowp + bj * HALFq) = w; } }
        } else if (wc == 0) {
#pragma unroll
            for (int ai = 0; ai < 2; ++ai)
#pragma unroll
                for (int m = 0; m < 4; ++m) { const int r = row0 + ai * HALFq + m * 16; float* g = G + (size_t)r * 32 + 8 * fq; const float rs = rsqrtf(ssq[r] * (1.f / D) + EPS);
                    *(f32x4*)g = acc[ai][0][m][0] * rs + *(const f32x4*)shw; *(f32x4*)(g + 4) = acc[ai][0][m][1] * rs + *(const f32x4*)(shw + 4); }
        }
    }
};
struct EpiGlu {
    static constexpr bool PERM = true, AFTER_DRAIN = false;
    const bf16_t* YA; bf16_t* Y;
    __device__ __forceinline__ void operator()(const f32x4 (&acc)[2][2][4][2], const Unit& u, int wr, int wc, int fr, int fq) const {
        const int row0 = u.pm * BMq + wr * 64 + fr, col0 = u.pn * BMq + wc * 32 + 8 * fq;
#pragma unroll
        for (int ai = 0; ai < 2; ++ai)
#pragma unroll
            for (int m = 0; m < 4; ++m) { const int r = row0 + ai * HALFq + m * 16;
#pragma unroll
                for (int bj = 0; bj < 2; ++bj) { const f32x4 v0 = acc[ai][bj][m][0], v1 = acc[ai][bj][m][1];
                    const u32x4 a = *(const u32x4*)(YA + (size_t)r * GWID + col0 + bj * HALFq);
                    float y[8] = {bflo(a.x), bfhi(a.x), bflo(a.y), bfhi(a.y), bflo(a.z), bfhi(a.z), bflo(a.w), bfhi(a.w)};
                    const float g[8] = {v0[0], v0[1], v0[2], v0[3], v1[0], v1[1], v1[2], v1[3]};
#pragma unroll
                    for (int k = 0; k < 8; ++k) y[k] = y[k] * sigmoidf_(g[k]);
                    u32x4 w; w.x = cvt_pk_bf16(y[0], y[1]); w.y = cvt_pk_bf16(y[2], y[3]); w.z = cvt_pk_bf16(y[4], y[5]); w.w = cvt_pk_bf16(y[6], y[7]);
                    *(u32x4*)(Y + (size_t)r * D + col0 + bj * HALFq) = w; } }
    }
};
struct EpiRes {
    static constexpr bool PERM = true, AFTER_DRAIN = false;
    const float* xp; const float* xs; float* X; const float* gate0; int first;
    int NEXT; bf16_t* XA; float* ssq; const float* gn; const float* scn0;
    __device__ __forceinline__ void operator()(const f32x4 (&acc)[2][2][4][2], const Unit& u, int wr, int wc, int fr, int fq) const {
        const int rowt = u.pm * BMq, col0 = u.pn * BMq + wc * 32 + 8 * fq;
        const int mrow = rowt < MC ? 0 : 1 + (rowt - MC) / 4096;
        const float* gate = gate0 + (size_t)mrow * (6 * D);
        const float* base = first ? (rowt < MC ? xp + (size_t)rowt * D : xs + (size_t)(rowt - MC) * D) : X + (size_t)rowt * D;
        float* outp = X + (size_t)rowt * D;
        float ss[2][4];
#pragma unroll
        for (int ai = 0; ai < 2; ++ai)
#pragma unroll
            for (int m = 0; m < 4; ++m) ss[ai][m] = 0.f;
#pragma unroll
        for (int bj = 0; bj < 2; ++bj) { const int c = col0 + bj * HALFq; const f32x4 g0 = *(const f32x4*)(gate + c), g1 = *(const f32x4*)(gate + c + 4);
            f32x4 a0 = (f32x4){0.f, 0.f, 0.f, 0.f}, a1 = a0;
            if (NEXT) { const float* scn = scn0 + (size_t)mrow * (6 * D); a0 = *(const f32x4*)(gn + c) * (*(const f32x4*)(scn + c) + 1.f); a1 = *(const f32x4*)(gn + c + 4) * (*(const f32x4*)(scn + c + 4) + 1.f); }
#pragma unroll
            for (int ai = 0; ai < 2; ++ai)
#pragma unroll
                for (int m = 0; m < 4; ++m) { const size_t off = (size_t)(wr * 64 + fr + ai * HALFq + m * 16) * D + c;
                    const f32x4 x0 = *(const f32x4*)(base + off) + g0 * acc[ai][bj][m][0], x1 = *(const f32x4*)(base + off + 4) + g1 * acc[ai][bj][m][1];
                    *(f32x4*)(outp + off) = x0; *(f32x4*)(outp + off + 4) = x1;
                    if (NEXT) { ss[ai][m] += (x0[0] * x0[0] + x0[1] * x0[1]) + (x0[2] * x0[2] + x0[3] * x0[3]) + (x1[0] * x1[0] + x1[1] * x1[1]) + (x1[2] * x1[2] + x1[3] * x1[3]);
                        const f32x4 y0 = x0 * a0, y1 = x1 * a1; u32x4 w; w.x = cvt_pk_bf16(y0[0], y0[1]); w.y = cvt_pk_bf16(y0[2], y0[3]); w.z = cvt_pk_bf16(y1[0], y1[1]); w.w = cvt_pk_bf16(y1[2], y1[3]);
                        *(u32x4*)(XA + (size_t)rowt * D + off) = w; } } }
        if (NEXT) {
#pragma unroll
            for (int ai = 0; ai < 2; ++ai)
#pragma unroll
                for (int m = 0; m < 4; ++m) { float s = ss[ai][m]; s += __shfl_xor(s, 16); s += __shfl_xor(s, 32);
                    if (fq == 0) unsafeAtomicAdd(ssq + rowt + wr * 64 + fr + ai * HALFq + m * 16, s); }
        }
    }
};
struct EpiRelu2 {
    static constexpr bool PERM = true, AFTER_DRAIN = false;
    bf16_t* O; const float* ssq; const float* shw0;
    __device__ __forceinline__ void operator()(const f32x4 (&acc)[2][2][4][2], const Unit& u, int wr, int wc, int fr, int fq) const {
        const int row0 = u.pm * BMq + wr * 64 + fr, col0 = u.pn * BMq + wc * 32 + 8 * fq, rowt = u.pm * BMq;
        const float* shw = shw0 + (size_t)(rowt < MC ? 0 : 1 + (rowt - MC) / 4096) * DFF + col0;
        f32x4 sh[2][2];
#pragma unroll
        for (int bj = 0; bj < 2; ++bj) { sh[bj][0] = *(const f32x4*)(shw + bj * HALFq); sh[bj][1] = *(const f32x4*)(shw + bj * HALFq + 4); }
#pragma unroll
        for (int ai = 0; ai < 2; ++ai)
#pragma unroll
            for (int m = 0; m < 4; ++m) { const int r = row0 + ai * HALFq + m * 16; bf16_t* rowp = O + (size_t)r * DFF + col0; const float rs = rsqrtf(ssq[r] * (1.f / D) + EPS);
#pragma unroll
                for (int bj = 0; bj < 2; ++bj) { f32x4 v0 = acc[ai][bj][m][0] * rs + sh[bj][0], v1 = acc[ai][bj][m][1] * rs + sh[bj][1];
#pragma unroll
                    for (int k = 0; k < 4; ++k) { const float a = fmaxf(v0[k], 0.f), b = fmaxf(v1[k], 0.f); v0[k] = a * a; v1[k] = b * b; }
                    u32x4 w; w.x = cvt_pk_bf16(v0[0], v0[1]); w.y = cvt_pk_bf16(v0[2], v0[3]); w.z = cvt_pk_bf16(v1[0], v1[1]); w.w = cvt_pk_bf16(v1[2], v1[3]);
                    *(u32x4*)(rowp + bj * HALFq) = w; } }
    }
};
}
__device__ __forceinline__ float logsigmoidf_(float x) { return x >= 0.f ? -log1pf(expf(-x)) : x - log1pf(expf(x)); }
__device__ __forceinline__ float softplusf_(float x) { return fmaxf(x, 0.f) + log1pf(expf(-fabsf(x))); }
__device__ __forceinline__ void load_tile128(Frame& F, LAS unsigned char* dst, const bf16* src) {
#pragma unroll
    for (int it = 0; it < 4; ++it) { const int i = F.tid + NT * it, r = i >> 4, c = i & 15;
        *(LAS v4u*)(dst + r * LDT + c * 16) = *(const v4u*)(src + (size_t)r * NPROJ + c * 8); }
}
template <int NDST> __device__ __forceinline__ void load_qk(Frame& F, LAS unsigned char* dst0, LAS unsigned char* dst1, const bf16* src, const LAS float* w0, const LAS float* w1, float scale, bool rope, int tpos0) {
#pragma unroll
    for (int it = 0; it < 2; ++it) {
        const int i = F.tid + NT * it, r = i >> 3, c = i & 7;
        float x1[8], x2[8];
        unpack8(*(const v4u*)(src + (size_t)r * NPROJ + c * 8), x1); unpack8(*(const v4u*)(src + (size_t)r * NPROJ + 64 + c * 8), x2);
        if (rope) {
            const int tp = tpos0 + r, pos = c < 4 ? (tp >> 6) : (tp & 63);
            const f32x2* rt = WSP(const f32x2, WS_ROPE) + pos * 32 + ((8 * c) & 31);
#pragma unroll
            for (int j = 0; j < 8; ++j) { const f32x2 cs = rt[j]; const float a = x1[j], b = x2[j]; x1[j] = a * cs.x - b * cs.y; x2[j] = a * cs.y + b * cs.x; }
        }
        const float s0 = scale * (w0 ? w0[r] : 1.f);
        *(LAS v4u*)(dst0 + r * LDT + c * 16) = pack8(x1, s0); *(LAS v4u*)(dst0 + r * LDT + 128 + c * 16) = pack8(x2, s0);
        if (NDST == 2) { const float s1 = scale * w1[r];
            *(LAS v4u*)(dst1 + r * LDT + c * 16) = pack8(x1, s1); *(LAS v4u*)(dst1 + r * LDT + 128 + c * 16) = pack8(x2, s1); }
    }
}
template <int NDST> __device__ __forceinline__ void load_conv(Frame& F, KArgs& A, int l, LAS unsigned char* dst0, LAS unsigned char* dst1, int ldd, int ch0, int nc8, int row0, int seq_lo, int seq_hi,
                                                               const LAS float* w0, const LAS float* w1) {
    const bf16* P = WSP(const bf16, WS_PROJ) + PC_DX + ch0;
    const float* cw = INP(I_CONVW) + (size_t)l * 5 * 1024 + ch0; const float* cb = INP(I_CONVB) + (size_t)l * 1024 + ch0;
    for (int i = F.tid; i < 128 * nc8; i += NT) {
        const int r = i / nc8, c = i % nc8, row = row0 + r;
        float acc[8];
        { const f32x4 b0 = *(const f32x4*)(cb + 8 * c), b1 = *(const f32x4*)(cb + 8 * c + 4); acc[0] = b0.x; acc[1] = b0.y; acc[2] = b0.z; acc[3] = b0.w; acc[4] = b1.x; acc[5] = b1.y; acc[6] = b1.z; acc[7] = b1.w; }
#pragma unroll
        for (int k = 0; k < 5; ++k) { const int rr = row + k - 2;
            if (rr >= seq_lo && rr < seq_hi) { float x[8]; unpack8(*(const v4u*)(P + (size_t)rr * NPROJ + 8 * c), x);
                const f32x4 w0v = *(const f32x4*)(cw + k * 1024 + 8 * c), w1v = *(const f32x4*)(cw + k * 1024 + 8 * c + 4);
                acc[0] += x[0] * w0v.x; acc[1] += x[1] * w0v.y; acc[2] += x[2] * w0v.z; acc[3] += x[3] * w0v.w; acc[4] += x[4] * w1v.x; acc[5] += x[5] * w1v.y; acc[6] += x[6] * w1v.z; acc[7] += x[7] * w1v.w; } }
#pragma unroll
        for (int j = 0; j < 8; ++j) acc[j] = siluf_(acc[j]);
        *(LAS v4u*)(dst0 + r * ldd + c * 16) = pack8(acc, w0 ? w0[r] : 1.f);
        if (NDST == 2) *(LAS v4u*)(dst1 + r * ldd + c * 16) = pack8(acc, w1[r]);
    }
}
__device__ __forceinline__ void kv_state_mfma(Frame& F, const LAS unsigned char* TKf, const LAS unsigned char* TKb, const LAS unsigned char* TV, float* outF, float* outB) {
    const int dvb = F.wave >> 1, dkb0 = (F.wave & 1) * 2, hh = F.lane >> 5;
    f32x16 acc[2][2] = {{ZERO16, ZERO16}, {ZERO16, ZERO16}};
#pragma unroll 1
    for (int ks = 0; ks < 8; ++ks) {
        const bf16x8 a = frag_tr(TV, LDT, 16 * ks, 32 * dvb, F.lane);
#pragma unroll
        for (int j = 0; j < 2; ++j) { acc[0][j] = MFMA32(a, frag_tr(TKf, LDT, 16 * ks, 32 * (dkb0 + j), F.lane), acc[0][j]); acc[1][j] = MFMA32(a, frag_tr(TKb, LDT, 16 * ks, 32 * (dkb0 + j), F.lane), acc[1][j]); }
    }
#pragma unroll
    for (int j = 0; j < 2; ++j)
#pragma unroll
        for (int i = 0; i < 16; ++i) { const int o = (32 * dvb + crow(i, hh)) * 128 + 32 * (dkb0 + j) + (F.lane & 31); outF[o] = acc[0][j][i]; outB[o] = acc[1][j][i]; }
}
__device__ __forceinline__ void qkT_mfma(Frame& F, const LAS unsigned char* TQ, const LAS unsigned char* TK, f32x16 (&qk)[2]) {
    const int tb = F.wave >> 1, sb0 = (F.wave & 1) * 2;
    qk[0] = ZERO16; qk[1] = ZERO16;
#pragma unroll 1
    for (int ks = 0; ks < 8; ++ks) { const bf16x8 bq = frag_row(TQ, LDT, 32 * tb, 16 * ks, F.lane);
#pragma unroll
        for (int j = 0; j < 2; ++j) qk[j] = MFMA32(frag_row(TK, LDT, 32 * (sb0 + j), 16 * ks, F.lane), bq, qk[j]); }
}
__device__ __forceinline__ void pv_mfma(Frame& F, const LAS unsigned char* TP, const LAS unsigned char* TV, f32x16 (&o)[2]) {
    const int tb = F.wave >> 1, eb0 = (F.wave & 1) * 2;
#pragma unroll 1
    for (int ks = 0; ks < 8; ++ks) { const bf16x8 ap = frag_row(TP, LDT, 32 * tb, 16 * ks, F.lane);
#pragma unroll
        for (int j = 0; j < 2; ++j) o[j] = MFMA32(ap, frag_tr(TV, LDT, 16 * ks, 32 * (eb0 + j), F.lane), o[j]); }
}
__device__ __forceinline__ void qs_prefetch(Frame& F, const bf16* ST, bf16x8 (&b)[2][8]) {
    const int eb0 = (F.wave & 1) * 2, hh = F.lane >> 5;
#pragma unroll
    for (int j = 0; j < 2; ++j)
#pragma unroll
        for (int ks = 0; ks < 8; ++ks) b[j][ks] = *(const bf16x8*)(ST + (size_t)(32 * (eb0 + j) + (F.lane & 31)) * 128 + 16 * ks + 8 * hh);
}
__device__ __forceinline__ void qs_mfma(Frame& F, const LAS unsigned char* TQ, const bf16x8 (&b)[2][8], f32x16 (&o)[2]) {
    const int tb = F.wave >> 1;
#pragma unroll
    for (int ks = 0; ks < 8; ++ks) { const bf16x8 aq = frag_row(TQ, LDT, 32 * tb, 16 * ks, F.lane);
#pragma unroll
        for (int j = 0; j < 2; ++j) o[j] = MFMA32(aq, b[j][ks], o[j]); }
}
__device__ __forceinline__ void hs_to_lds(Frame& F, LAS unsigned char* HS, const f32x16 (&hs)[2]) {
    const int tb = F.wave >> 1, eb0 = (F.wave & 1) * 2, hh = F.lane >> 5;
#pragma unroll
    for (int j = 0; j < 2; ++j)
#pragma unroll
        for (int i = 0; i < 16; ++i) *(LAS float*)(HS + (32 * tb + crow(i, hh)) * 528 + (32 * (eb0 + j) + (F.lane & 31)) * 4) = hs[j][i];
}
template <int GATE> __device__ __forceinline__ void head_out(Frame& F, const LAS unsigned char* HS, const float* gain, const bf16* gsrc  , bf16* ydst  ) {
    const int t = F.tid >> 2, seg = F.tid & 3;
    float v[32]; float ss = 0.f;
#pragma unroll
    for (int k = 0; k < 8; ++k) { const f32x4 x = *(const LAS f32x4*)(HS + t * 528 + (32 * seg + 4 * k) * 4); v[4 * k] = x.x; v[4 * k + 1] = x.y; v[4 * k + 2] = x.z; v[4 * k + 3] = x.w; ss += (x.x * x.x + x.y * x.y) + (x.z * x.z + x.w * x.w); }
    ss += __shfl_xor(ss, 1); ss += __shfl_xor(ss, 2);
    const float r = rsqrtf(ss * (1.f / 128.f) + EPS);
#pragma unroll
    for (int k = 0; k < 4; ++k) { float g[8]; unpack8(*(const v4u*)(gsrc + (size_t)t * NPROJ + 32 * seg + 8 * k), g); float o[8];
#pragma unroll
        for (int j = 0; j < 8; ++j) { const float gg = GATE == 0 ? sigmoidf_(g[j]) : siluf_(g[j]); o[j] = v[8 * k + j] * r * gain[32 * seg + 8 * k + j] * gg; }
        *(v4u*)(ydst + (size_t)t * D + 32 * seg + 8 * k) = pack8(o, 1.f); }
}

__device__ __forceinline__ void mlstm_gates(Frame& F, KArgs& A, int l, int cp, int h) {
    if (F.tid < 128) { const float* g = WSP(const float, WS_GATES) + (size_t)(cp * 128 + F.tid) * 32;
        SCA(0)[F.tid] = g[h] + INP(I_MIB)[(l * 2 + 0) * 4 + h]; SCA(1)[F.tid] = g[4 + h] + INP(I_MIB)[(l * 2 + 1) * 4 + h];
        SCA(2)[F.tid] = logsigmoidf_(g[8 + h] + INP(I_MFB)[(l * 2 + 0) * 4 + h]); SCA(3)[F.tid] = logsigmoidf_(g[12 + h] + INP(I_MFB)[(l * 2 + 1) * 4 + h]); }
    __syncthreads();
    if (F.wave == 0) wave_scan128<false>(SCA(2), SCA(4), F.lane, false, 0.f);
    if (F.wave == 1) wave_scan128<false>(SCA(3), SCA(5), F.lane, true, 0.f);
    __syncthreads();
}
__device__ __forceinline__ void mlstm_local_item(Frame F, KArgs& A, int l, int cp, int h) {
    mlstm_gates(F, A, l, cp, h);
    if (F.wave < 2) { const int d = F.wave; const LAS float* bc = SCA(4 + d); const LAS float* ig = SCA(d); const float tot = d == 0 ? bc[127] : bc[0];
        const int s0 = 2 * F.lane; const float g0 = tot - bc[s0] + ig[s0], g1 = tot - bc[s0 + 1] + ig[s0 + 1];
        const float mx = wave_max(fmaxf(g0, g1));
        SCA(6 + d)[s0] = expf(g0 - mx); SCA(6 + d)[s0 + 1] = expf(g1 - mx);
        if (F.lane == 0) { float* sc = WSP(float, WS_MLSC) + ((cp * 2 + d) * 4 + h) * 2; sc[0] = tot; sc[1] = mx; } }
    __syncthreads();
    const bf16* P = WSP(const bf16, WS_PROJ) + (size_t)cp * 128 * NPROJ;
    load_qk<2>(F, F.lds, F.lds + TS, P + PC_MK + h * 128, SCA(6), SCA(7), 0.08838834764831845f, false, 0);
    load_tile128(F, F.lds + 2 * TS, P + PC_MV + h * 128);
    __syncthreads();
    kv_state_mfma(F, F.lds, F.lds + TS, F.lds + 2 * TS, WSP(float, WS_MLCLOC) + (size_t)((cp * 2 + 0) * 4 + h) * 16384, WSP(float, WS_MLCLOC) + (size_t)((cp * 2 + 1) * 4 + h) * 16384);
    if (F.tid < 256) { const int d = F.tid >> 7, dk = F.tid & 127; const LAS unsigned char* T = F.lds + d * TS; float s = 0.f;
        for (int r = 0; r < 128; ++r) s += bf2f(*(const LAS unsigned short*)(T + r * LDT + dk * 2));
        WSP(float, WS_MLNLOC)[((cp * 2 + d) * 4 + h) * 128 + dk] = s; }
    __syncthreads();
}
__device__ __forceinline__ void mlstm_out_item(Frame F, KArgs& A, int l, int cp, int h) {
    mlstm_gates(F, A, l, cp, h);
    const float min_f = WSP(const float, WS_MLMIN)[(cp * 2 + 0) * 4 + h], min_b = WSP(const float, WS_MLMIN)[(cp * 2 + 1) * 4 + h];
    if (F.tid < 256) { const int d = F.tid >> 7, s = F.tid & 127; SCA(6 + d)[s] = SCA(d)[s] - SCA(4 + d)[s]; }
    __syncthreads();
    if (F.wave == 0) wave_scan128<true>(SCA(6), SCA(8), F.lane, false, min_f);
    if (F.wave == 1) wave_scan128<true>(SCA(7), SCA(9), F.lane, true, min_b);
    const bf16* P = WSP(const bf16, WS_PROJ) + (size_t)cp * 128 * NPROJ;
    LAS unsigned char* TQ = F.lds; LAS unsigned char* TK = F.lds + TS; LAS unsigned char* TV = F.lds + 2 * TS; LAS unsigned char* TP = F.lds + 3 * TS;
    load_tile128(F, TQ, P + PC_MQ + h * 128);
    load_qk<1>(F, TK, nullptr, P + PC_MK + h * 128, nullptr, nullptr, 0.08838834764831845f, false, 0);
    load_tile128(F, TV, P + PC_MV + h * 128);
    __syncthreads();
    f32x16 hs[2] = {ZERO16, ZERO16};
    const int tb = F.wave >> 1, sb0 = (F.wave & 1) * 2, hh = F.lane >> 5, t = 32 * tb + (F.lane & 31);
#pragma unroll 1
    for (int d = 0; d < 2; ++d) {
        const LAS float* av = SCA(6 + d); const float Mt = SCA(8 + d)[t]; const float m_in = d == 0 ? min_f : min_b;
        if (F.tid < 128) SCA(12)[F.tid] = WSP(const float, WS_MLNIN)[((cp * 2 + d) * 4 + h) * 128 + F.tid];
        f32x16 qk[2]; qkT_mfma(F, TQ, TK, qk);
#pragma unroll
        for (int j = 0; j < 2; ++j)
#pragma unroll
            for (int i4 = 0; i4 < 4; ++i4) { const int sb = 32 * (sb0 + j) + 8 * i4 + 4 * hh; float p[4];
#pragma unroll
                for (int i = 0; i < 4; ++i) { const int s = sb + i; const bool ok = d == 0 ? (s <= t) : (s >= t); p[i] = ok ? qk[j][4 * i4 + i] * __expf(av[s] - Mt) : 0.f; }
                *(LAS u32x2*)(TP + t * LDT + sb * 2) = (u32x2){pk2(p[0], p[1]), pk2(p[2], p[3])}; }
        bf16x8 bst[2][8]; qs_prefetch(F, WSP(const bf16, WS_MLCIN) + (size_t)((cp * 2 + d) * 4 + h) * 16384, bst);
        __syncthreads();
        if (F.tid < 128) { const int tt = F.tid; float ds = 0.f, qn = 0.f;
#pragma unroll 4
            for (int k = 0; k < 16; ++k) { float x[8]; unpack8(*(const LAS v4u*)(TP + tt * LDT + 16 * k), x); float q[8]; unpack8(*(const LAS v4u*)(TQ + tt * LDT + 16 * k), q);
#pragma unroll
                for (int j = 0; j < 8; ++j) { ds += x[j]; qn += q[j] * SCA(12)[8 * k + j]; } }
            const float Mtt = SCA(8 + d)[tt], wint = expf(m_in - Mtt), den = ds + wint * qn, dd = fmaxf(fabsf(den), expf(-(SCA(4 + d)[tt] + Mtt)));
            SCA(10)[tt] = wint / dd; SCA(11)[tt] = 1.f / dd; }
        { f32x16 num[2] = {ZERO16, ZERO16};
          pv_mfma(F, TP, TV, num);
          __syncthreads();
#pragma unroll
          for (int j = 0; j < 2; ++j)
#pragma unroll
            for (int i = 0; i < 16; ++i) hs[j][i] += SCA(11)[32 * tb + crow(i, hh)] * num[j][i]; }
        { f32x16 qc[2] = {ZERO16, ZERO16};
          qs_mfma(F, TQ, bst, qc);
#pragma unroll
          for (int j = 0; j < 2; ++j)
#pragma unroll
            for (int i = 0; i < 16; ++i) hs[j][i] += SCA(10)[32 * tb + crow(i, hh)] * qc[j][i]; }
    }
    __syncthreads();
    hs_to_lds(F, F.lds, hs);
    __syncthreads();
    head_out<0>(F, F.lds, INP(I_MNORM) + (size_t)l * GWID + h * 128, P + PC_MO + h * 128, WSP(bf16, WS_Y) + (size_t)cp * 128 * D + 512 + h * 128);
    __syncthreads();
}

__device__ __forceinline__ void ret_local_item(Frame F, KArgs& A, int l, int cp, int h) {
    const float lgf = -expf(INP(I_RRATE)[(l * 2 + 0) * 4 + h]), lgb = -expf(INP(I_RRATE)[(l * 2 + 1) * 4 + h]);
    if (F.tid < 128) { SCA(6)[F.tid] = expf((127.f - (float)F.tid) * lgf); SCA(7)[F.tid] = expf((float)F.tid * lgb); }
    __syncthreads();
    const Seq sq = seq_of(cp);
    const bf16* P = WSP(const bf16, WS_PROJ) + (size_t)cp * 128 * NPROJ;
    load_qk<2>(F, F.lds, F.lds + TS, P + PC_RK + h * 128, SCA(6), SCA(7), 0.08838834764831845f, sq.lat != 0, sq.c * 128);
    load_tile128(F, F.lds + 2 * TS, P + PC_RV + h * 128);
    __syncthreads();
    kv_state_mfma(F, F.lds, F.lds + TS, F.lds + 2 * TS, WSP(float, WS_RTLOC) + (size_t)((cp * 2 + 0) * 4 + h) * 16384, WSP(float, WS_RTLOC) + (size_t)((cp * 2 + 1) * 4 + h) * 16384);
    __syncthreads();
}
__device__ __forceinline__ void ret_out_item(Frame F, KArgs& A, int l, int cp, int h) {
    const float lgf = -expf(INP(I_RRATE)[(l * 2 + 0) * 4 + h]), lgb = -expf(INP(I_RRATE)[(l * 2 + 1) * 4 + h]);
    if (F.tid < 128) { SCA(10)[F.tid] = expf(((float)F.tid + 1.f) * lgf); SCA(11)[F.tid] = expf((128.f - (float)F.tid) * lgb); }
    const Seq sq = seq_of(cp);
    const bf16* P = WSP(const bf16, WS_PROJ) + (size_t)cp * 128 * NPROJ;
    LAS unsigned char* TQ = F.lds; LAS unsigned char* TK = F.lds + TS; LAS unsigned char* TV = F.lds + 2 * TS; LAS unsigned char* TP = F.lds + 3 * TS;
    load_qk<1>(F, TQ, nullptr, P + PC_RQ + h * 128, nullptr, nullptr, 1.f, sq.lat != 0, sq.c * 128);
    load_qk<1>(F, TK, nullptr, P + PC_RK + h * 128, nullptr, nullptr, 0.08838834764831845f, sq.lat != 0, sq.c * 128);
    load_tile128(F, TV, P + PC_RV + h * 128);
    __syncthreads();
    f32x16 qk[2]; qkT_mfma(F, TQ, TK, qk);
    const int tb = F.wave >> 1, sb0 = (F.wave & 1) * 2, hh = F.lane >> 5, t = 32 * tb + (F.lane & 31);
#pragma unroll
    for (int j = 0; j < 2; ++j)
#pragma unroll
        for (int i4 = 0; i4 < 4; ++i4) { const int sb = 32 * (sb0 + j) + 8 * i4 + 4 * hh; float p[4];
#pragma unroll
            for (int i = 0; i < 4; ++i) { const int s = sb + i; const float df = (float)(t - s);
                const float dm = (s <= t ? __expf(df * lgf) : 0.f) + (s >= t ? __expf(-df * lgb) : 0.f); p[i] = qk[j][4 * i4 + i] * dm; }
            *(LAS u32x2*)(TP + t * LDT + sb * 2) = (u32x2){pk2(p[0], p[1]), pk2(p[2], p[3])}; }
    __syncthreads();
    f32x16 y[2] = {ZERO16, ZERO16};
    pv_mfma(F, TP, TV, y);
#pragma unroll 1
    for (int d = 0; d < 2; ++d) { f32x16 qs[2] = {ZERO16, ZERO16};
        bf16x8 bst[2][8]; qs_prefetch(F, WSP(const bf16, WS_RTIN) + (size_t)((cp * 2 + d) * 4 + h) * 16384, bst);
        qs_mfma(F, TQ, bst, qs);
#pragma unroll
        for (int j = 0; j < 2; ++j)
#pragma unroll
            for (int i = 0; i < 16; ++i) y[j][i] += SCA(10 + d)[32 * tb + crow(i, hh)] * qs[j][i]; }
    __syncthreads();
    hs_to_lds(F, F.lds, y);
    __syncthreads();
    head_out<1>(F, F.lds, INP(I_RNORM) + (size_t)l * GWID + h * 128, P + PC_RG + h * 128, WSP(bf16, WS_Y) + (size_t)cp * 128 * D + 1024 + h * 128);
    __syncthreads();
}
template <bool WMODE> __device__ __forceinline__ float ssd_scalars(Frame& F, KArgs& A, int l, int cp, int g) {
    const int d = F.wave >> 2, rr = F.wave & 3, head = g * 4 + rr;
    const float bias = INP(I_DTB)[(l * 2 + d) * 8 + head], arate = -expf(INP(I_ALOG)[(l * 2 + d) * 8 + head]);
    const float* gp = WSP(const float, WS_GATES) + (size_t)(cp * 128) * 32 + 16 + d * 8 + head;
    const int i0 = d ? 127 - 2 * F.lane : 2 * F.lane, i1 = d ? i0 - 1 : i0 + 1;
    const float dt0 = softplusf_(gp[(size_t)i0 * 32] + bias), dt1 = softplusf_(gp[(size_t)i1 * 32] + bias);
    const float a0 = dt0 * arate, a1 = dt1 * arate;
    float inc = a0 + a1;
#pragma unroll
    for (int o = 1; o < 64; o <<= 1) { const float t = __shfl_up(inc, o); if (F.lane >= o) inc += t; }
    const float c1 = inc, c0 = inc - a1, tot = __shfl(inc, 63);
    LAS float* cum = SCA(16 + d * 4 + rr); LAS float* dtw = SCA(24 + d * 4 + rr);
    cum[i0] = c0; cum[i1] = c1;
    if (WMODE) { dtw[i0] = expf(tot - c0) * dt0; dtw[i1] = expf(tot - c1) * dt1; } else { dtw[i0] = dt0; dtw[i1] = dt1; }
    return tot;
}
__device__ __forceinline__ void seq_bounds(int cp, int& lo, int& hi) { if (cp < 64) { lo = (cp >> 1) * 256; hi = lo + 256; } else { lo = MC + ((cp - 64) >> 5) * 4096; hi = lo + 4096; } }
__device__ __forceinline__ void ssd_local_item(Frame F, KArgs& A, int l, int cp, int g) {
    const float tot = ssd_scalars<true>(F, A, l, cp, g);
    if (F.lane == 0) WSP(float, WS_SDSC)[(cp * 2 + (F.wave >> 2)) * 8 + g * 4 + (F.wave & 3)] = tot;
    int lo, hi; seq_bounds(cp, lo, hi);
    LAS unsigned char* TB = F.lds;
    load_conv<1>(F, A, l, TB, nullptr, LDT, 512 + g * 128, 16, cp * 128, lo, hi, nullptr, nullptr);
    __syncthreads();
#pragma unroll 1
    for (int hr = 0; hr < 2; ++hr) {
#pragma unroll 1
        for (int r2 = 0; r2 < 2; ++r2) { const int rr = hr * 2 + r2;
            load_conv<2>(F, A, l, F.lds + TS + (r2 * 2 + 0) * TSX, F.lds + TS + (r2 * 2 + 1) * TSX, LDX, g * 256 + rr * 64, 8, cp * 128, lo, hi, SCA(24 + 0 * 4 + rr), SCA(24 + 1 * 4 + rr)); }
        __syncthreads();
        const int r2 = F.wave >> 2, d = (F.wave >> 1) & 1, pb = F.wave & 1, hh = F.lane >> 5, head = g * 4 + hr * 2 + r2;
        const LAS unsigned char* TX = F.lds + TS + (r2 * 2 + d) * TSX;
        f32x16 acc[4] = {ZERO16, ZERO16, ZERO16, ZERO16};
#pragma unroll 1
        for (int ks = 0; ks < 8; ++ks) { const bf16x8 a = frag_tr(TX, LDX, 16 * ks, 32 * pb, F.lane);
#pragma unroll
            for (int nb = 0; nb < 4; ++nb) acc[nb] = MFMA32(a, frag_tr(TB, LDT, 16 * ks, 32 * nb, F.lane), acc[nb]); }
        float* o = WSP(float, WS_SDLOC) + (size_t)((cp * 2 + d) * 8 + head) * 8192;
#pragma unroll
        for (int nb = 0; nb < 4; ++nb)
#pragma unroll
            for (int i = 0; i < 16; ++i) o[(32 * pb + crow(i, hh)) * 128 + 32 * nb + (F.lane & 31)] = acc[nb][i];
        __syncthreads();
    }
}
__device__ __forceinline__ void ssd_out_item(Frame F, KArgs& A, int l, int cp) {
    int lo, hi; seq_bounds(cp, lo, hi);
    LAS unsigned char* TC = F.lds; LAS unsigned char* TB = F.lds + TS; LAS unsigned char* TP = F.lds + 2 * TS; LAS unsigned char* TX = F.lds + 3 * TS;
    LAS float* SSQ = SCA(14);
    if (F.tid < 128) SSQ[F.tid] = 0.f;
    const int tb = F.wave >> 1, sb0 = (F.wave & 1) * 2, pb = F.wave & 1, hh = F.lane >> 5, t = 32 * tb + (F.lane & 31);
    const bf16* Pz = WSP(const bf16, WS_PROJ) + (size_t)cp * 128 * NPROJ + PC_DZ;
    bf16* Yd = WSP(bf16, WS_Y) + (size_t)cp * 128 * D + 1536;
#pragma unroll 1
    for (int g = 0; g < 2; ++g) {
        (void)ssd_scalars<false>(F, A, l, cp, g);
        load_conv<1>(F, A, l, TC, nullptr, LDT, 768 + g * 128, 16, cp * 128, lo, hi, nullptr, nullptr);
        load_conv<1>(F, A, l, TB, nullptr, LDT, 512 + g * 128, 16, cp * 128, lo, hi, nullptr, nullptr);
        __syncthreads();
        f32x16 cb[2] = {ZERO16, ZERO16};
#pragma unroll 1
        for (int ks = 0; ks < 8; ++ks) { const bf16x8 bq = frag_row(TC, LDT, 32 * tb, 16 * ks, F.lane);
#pragma unroll
            for (int j = 0; j < 2; ++j) cb[j] = MFMA32(frag_row(TB, LDT, 32 * (sb0 + j), 16 * ks, F.lane), bq, cb[j]); }
#pragma unroll 1
        for (int rr = 0; rr < 4; ++rr) {
            const int head = g * 4 + rr;
            load_conv<1>(F, A, l, TX, nullptr, LDX, g * 256 + rr * 64, 8, cp * 128, lo, hi, nullptr, nullptr);
            f32x16 y = ZERO16;
#pragma unroll 1
            for (int d = 0; d < 2; ++d) {
                const LAS float* cum = SCA(16 + d * 4 + rr); const LAS float* dtv = SCA(24 + d * 4 + rr); const float ct = cum[t];
#pragma unroll
                for (int j = 0; j < 2; ++j)
#pragma unroll
                    for (int i4 = 0; i4 < 4; ++i4) { const int sb = 32 * (sb0 + j) + 8 * i4 + 4 * hh; float p[4];
#pragma unroll
                        for (int i = 0; i < 4; ++i) { const int s = sb + i; const bool ok = d == 0 ? (s <= t) : (s >= t); p[i] = ok ? cb[j][4 * i4 + i] * __expf(ct - cum[s]) * dtv[s] : 0.f; }
                        *(LAS u32x2*)(TP + t * LDT + sb * 2) = (u32x2){pk2(p[0], p[1]), pk2(p[2], p[3])}; }
                bf16x8 bh[8];
                { const bf16* hin = WSP(const bf16, WS_SDIN) + (size_t)((cp * 2 + d) * 8 + head) * 8192;
#pragma unroll
                  for (int ks = 0; ks < 8; ++ks) bh[ks] = *(const bf16x8*)(hin + (size_t)(32 * pb + (F.lane & 31)) * 128 + 16 * ks + 8 * hh); }
                __syncthreads();
                f32x16 pv = ZERO16, ch = ZERO16;
#pragma unroll 2
                for (int ks = 0; ks < 8; ++ks)
                    pv = MFMA32(frag_row(TP, LDT, 32 * tb, 16 * ks, F.lane), frag_tr(TX, LDX, 16 * ks, 32 * pb, F.lane), pv);
#pragma unroll
                for (int ks = 0; ks < 8; ++ks) ch = MFMA32(frag_row(TC, LDT, 32 * tb, 16 * ks, F.lane), bh[ks], ch);
#pragma unroll
                for (int i = 0; i < 16; ++i) y[i] += pv[i] + __expf(cum[32 * tb + crow(i, hh)]) * ch[i];
                __syncthreads();
            }
#pragma unroll
            for (int i = 0; i < 16; ++i) *(LAS float*)(TP + (32 * tb + crow(i, hh)) * LDT + (32 * pb + (F.lane & 31)) * 4) = y[i];
            __syncthreads();
            { const int tt = F.tid >> 2, seg = F.tid & 3; const float Dh = INP(I_SSDD)[l * 8 + head];
                float z[16], x[16], o[16]; float ss = 0.f;
                { float t8[8]; unpack8(*(const v4u*)(Pz + (size_t)tt * NPROJ + head * 64 + 16 * seg), t8); for (int j = 0; j < 8; ++j) z[j] = t8[j];
                  unpack8(*(const v4u*)(Pz + (size_t)tt * NPROJ + head * 64 + 16 * seg + 8), t8); for (int j = 0; j < 8; ++j) z[8 + j] = t8[j];
                  unpack8(*(const LAS v4u*)(TX + tt * LDX + 32 * seg), t8); for (int j = 0; j < 8; ++j) x[j] = t8[j];
                  unpack8(*(const LAS v4u*)(TX + tt * LDX + 32 * seg + 16), t8); for (int j = 0; j < 8; ++j) x[8 + j] = t8[j]; }
#pragma unroll
                for (int k = 0; k < 4; ++k) { const f32x4 yv = *(const LAS f32x4*)(TP + tt * LDT + (16 * seg + 4 * k) * 4);
                    const float yy[4] = {yv.x, yv.y, yv.z, yv.w};
#pragma unroll
                    for (int j = 0; j < 4; ++j) { const float v = (yy[j] + Dh * x[4 * k + j]) * siluf_(z[4 * k + j]); o[4 * k + j] = v; ss += v * v; } }
                ss += __shfl_xor(ss, 1); ss += __shfl_xor(ss, 2);
                if (seg == 0) SSQ[tt] += ss;
                float o0[8], o1[8];
#pragma unroll
                for (int j = 0; j < 8; ++j) { o0[j] = o[j]; o1[j] = o[8 + j]; }
                *(v4u*)(Yd + (size_t)tt * D + head * 64 + 16 * seg) = pack8(o0, 1.f); *(v4u*)(Yd + (size_t)tt * D + head * 64 + 16 * seg + 8) = pack8(o1, 1.f); }
            __syncthreads();
        }
    }
    __builtin_amdgcn_fence(__ATOMIC_RELEASE, "workgroup"); asm volatile("s_waitcnt vmcnt(0)" ::: "memory"); __syncthreads(); __builtin_amdgcn_fence(__ATOMIC_ACQUIRE, "workgroup");
    { const int tt = F.tid >> 2, seg = F.tid & 3; const float r = rsqrtf(SSQ[tt] * (1.f / 512.f) + EPS); const float* gn = INP(I_SNORM) + (size_t)l * GWID + 128 * seg;
#pragma unroll 4
        for (int k = 0; k < 16; ++k) { bf16* p = Yd + (size_t)tt * D + 128 * seg + 8 * k; float v[8];
            unpack8(__builtin_nontemporal_load((const v4u*)p), v);
#pragma unroll
            for (int j = 0; j < 8; ++j) v[j] = v[j] * r * gn[8 * k + j];
            *(v4u*)p = pack8(v, 1.f); } }
    __syncthreads();
}
template <int PASS> __device__ __forceinline__ void s5_item(Frame F, KArgs& A, int l, int cp, int gq) {
    const Seq sq = seq_of(cp);
    const int g = gq * 8 + F.wave, p = F.lane, hh = F.lane >> 5;
    LAS unsigned char* TU = F.lds; LAS unsigned char* BU = F.lds + TS + F.wave * 8704;
    load_tile128(F, TU, WSP(const bf16, WS_PROJ) + (size_t)cp * 128 * NPROJ + PC_S5U + gq * 128);
    __syncthreads();
    typedef float f32x4v __attribute__((ext_vector_type(4)));
    f32x4v yacc[4][2];
    if (PASS == 1) {
#pragma unroll
        for (int a = 0; a < 4; ++a) { yacc[a][0] = (f32x4v){0.f, 0.f, 0.f, 0.f}; yacc[a][1] = (f32x4v){0.f, 0.f, 0.f, 0.f}; } }
#pragma unroll 1
    for (int d = 0; d < 2; ++d) {
        const unsigned char* tab = s5tab(F, l, d, g);
        const float lr = ((const float*)tab)[2 * p], li = ((const float*)tab)[2 * p + 1];
        float hr = 0.f, hi = 0.f;
        if (PASS == 1) {
            if (sq.lat) { const size_t o = (size_t)(((sq.b * 4 + l) * 2 + d) * 32 + g) * 64 + p; hr = INP(I_SS5R)[o]; hi = INP(I_SS5I)[o]; }
            const float l8r = ((const float*)(tab + 512))[2 * p], l8i = ((const float*)(tab + 512))[2 * p + 1];
            const int n = d == 0 ? sq.c : sq.nch - 1 - sq.c;
            for (int k0 = 0; k0 < n; k0 += 8) {
                f32x2 e[8];
#pragma unroll
                for (int j = 0; j < 8; ++j) { const int k = (k0 + j < n) ? k0 + j : n - 1, cc = d == 0 ? k : sq.nch - 1 - k;
                    e[j] = *(const f32x2*)(WSP(const float, WS_S5LOC) + ((size_t)(((sq.cp0 + cc) * 2 + d) * 32 + g) * 64 + p) * 2); }
#pragma unroll
                for (int j = 0; j < 8; ++j) if (k0 + j < n) { const float nr = l8r * hr - l8i * hi + e[j].x, ni = l8r * hi + l8i * hr + e[j].y; hr = nr; hi = ni; }
            }
        }
        const bf16* bb = (const bf16*)(tab + 1024); const bf16* ct = (const bf16*)(tab + 5120);
#pragma unroll 1
        for (int tbi = 0; tbi < 4; ++tbi) {
            const int tb = d == 0 ? tbi : 3 - tbi;
            const bf16x8 bu = frag_row(TU, LDT, 32 * tb, 16 * F.wave, F.lane);
#pragma unroll
            for (int nb = 0; nb < 4; ++nb) {
                const bf16x8 a = *(const bf16x8*)(bb + (size_t)(32 * nb + (F.lane & 31)) * 16 + 8 * hh);
                const f32x16 acc = MFMA32(a, bu, ZERO16);
#pragma unroll
                for (int i4 = 0; i4 < 4; ++i4) *(LAS u32x2*)(BU + (F.lane & 31) * LDT + (32 * nb + 8 * i4 + 4 * hh) * 2) = (u32x2){pk2(acc[4 * i4], acc[4 * i4 + 1]), pk2(acc[4 * i4 + 2], acc[4 * i4 + 3])};
            }
            asm volatile("s_waitcnt lgkmcnt(0)" ::: "memory");
#pragma unroll 4
            for (int st = 0; st < 32; ++st) { const int tl = d == 0 ? st : 31 - st;
                LAS unsigned short* pr = (LAS unsigned short*)(BU + tl * LDT + p * 2); LAS unsigned short* pi = pr + 64;
                const float br = bf2f(*pr), bi = bf2f(*pi);
                const float nr = lr * hr - li * hi + br, ni = lr * hi + li * hr + bi; hr = nr; hi = ni;
                if (PASS == 1) { *pr = (unsigned short)f2bf(hr); *pi = (unsigned short)f2bf(hi); } }
            if (PASS == 1) {
                asm volatile("s_waitcnt lgkmcnt(0)" ::: "memory");
                typedef short v8s __attribute__((ext_vector_type(8)));
                const int r16 = F.lane & 15, g4 = F.lane >> 4;
                f32x4v y0 = (f32x4v){0.f, 0.f, 0.f, 0.f}, y1 = y0;
#pragma unroll
                for (int ks = 0; ks < 4; ++ks) { const v8s bc = *(const v8s*)(ct + r16 * 128 + 32 * ks + 8 * g4);
                    y0 = __builtin_amdgcn_mfma_f32_16x16x32_bf16(*(const LAS v8s*)(BU + r16 * LDT + (32 * ks + 8 * g4) * 2), bc, y0, 0, 0, 0);
                    y1 = __builtin_amdgcn_mfma_f32_16x16x32_bf16(*(const LAS v8s*)(BU + (16 + r16) * LDT + (32 * ks + 8 * g4) * 2), bc, y1, 0, 0, 0); }
                if (tb == 0) { yacc[0][0] += y0; yacc[0][1] += y1; } else if (tb == 1) { yacc[1][0] += y0; yacc[1][1] += y1; } else if (tb == 2) { yacc[2][0] += y0; yacc[2][1] += y1; } else { yacc[3][0] += y0; yacc[3][1] += y1; }
                asm volatile("s_waitcnt lgkmcnt(0)" ::: "memory");
            }
        }
        if (PASS == 0) { *(f32x2*)(WSP(float, WS_S5LOC) + ((size_t)((cp * 2 + d) * 32 + g) * 64 + p) * 2) = (f32x2){hr, hi}; }
        else if (!sq.lat && ((d == 0 && sq.c == sq.nch - 1) || (d == 1 && sq.c == 0))) { const size_t o = (size_t)(((sq.b * 4 + l) * 2 + d) * 32 + g) * 64 + p; F.out[O_S5R + o] = hr; F.out[O_S5I + o] = hi; }
    }
    if (PASS == 1) {
        const int r16 = F.lane & 15, g4 = F.lane >> 4; const float Dc = INP(I_S5D)[(size_t)l * GWID + g * 16 + r16];
#pragma unroll
        for (int tb = 0; tb < 4; ++tb)
#pragma unroll
            for (int ts = 0; ts < 2; ++ts)
#pragma unroll
                for (int i = 0; i < 4; ++i) { const int t = 32 * tb + 16 * ts + 4 * g4 + i; LAS unsigned short* up = (LAS unsigned short*)(TU + t * LDT + (16 * F.wave + r16) * 2);
                    const float x = yacc[tb][ts][i] + Dc * bf2f(*up);
                    const float ge = 0.5f * x * (1.f + tanhf(0.7978845608028654f * (x + 0.044715f * x * x * x)));
                    *up = (unsigned short)f2bf(ge); }
        __syncthreads();
        bf16* ya = WSP(bf16, WS_YA) + (size_t)cp * 128 * GWID + gq * 128;
#pragma unroll
        for (int it = 0; it < 4; ++it) { const int i = F.tid + NT * it, r = i >> 4, c = i & 15; *(v4u*)(ya + (size_t)r * GWID + c * 8) = *(const LAS v4u*)(TU + r * LDT + c * 16); }
    }
    __syncthreads();
}

template <bool LAT> __device__ __forceinline__ void carry_unit(Frame F, KArgs& A, int l, int u) {
    const int sd = u / 96, rem = u % 96, sidx = sd >> 1, d = sd & 1;
    constexpr int lat = LAT ? 1 : 0, nch = LAT ? 32 : 2, NB = LAT ? 8 : 2;
    const int b = LAT ? sidx : sidx - 4, cp0 = LAT ? 64 + 32 * b : 2 * b;
    int type, head, slice;
    if (rem < 32) { type = 0; head = rem >> 3; slice = rem & 7; } else if (rem < 64) { type = 1; head = (rem - 32) >> 3; slice = (rem - 32) & 7; } else { type = 2; head = (rem - 64) >> 2; slice = (rem - 64) & 3; }
    const int e0 = slice * 2048 + F.tid * 4;
    const int nh = type == 2 ? 8 : 4, esz = type == 2 ? 8192 : 16384;
    const float* loc = type == 0 ? WSP(const float, WS_MLCLOC) : (type == 1 ? WSP(const float, WS_RTLOC) : WSP(const float, WS_SDLOC));
    bf16* inb = type == 0 ? WSP(bf16, WS_MLCIN) : (type == 1 ? WSP(bf16, WS_RTIN) : WSP(bf16, WS_SDIN));
    float zf = 0.f; asm volatile("" : "+v"(zf));
    float v[4] = {zf, zf, zf, zf}, nv[4] = {zf, zf, zf, zf}, m = 0.f;
    const bool do_n = (type == 0 && slice == 0 && F.tid < 32);
    if (LAT) {
        if (type == 2) { const f32x4 s = *(const f32x4*)(INP(I_SSSD) + (size_t)(((b * 4 + l) * 2 + d) * 8 + head) * 8192 + e0); v[0] = s.x; v[1] = s.y; v[2] = s.z; v[3] = s.w; }
        else { const float* s = (type == 0 ? INP(I_SMC) : INP(I_SRET)) + (size_t)(((b * 4 + l) * 2 + d) * 4 + head) * 16384; const int dv = e0 >> 7, dk = e0 & 127;
#pragma unroll
            for (int j = 0; j < 4; ++j) v[j] = s[(dk + j) * 128 + dv]; }
        if (type == 0) { m = INP(I_SMM)[((b * 4 + l) * 2 + d) * 4 + head];
            if (do_n) { const f32x4 s = *(const f32x4*)(INP(I_SMN) + (size_t)(((b * 4 + l) * 2 + d) * 4 + head) * 128 + F.tid * 4); nv[0] = s.x; nv[1] = s.y; nv[2] = s.z; nv[3] = s.w; } }
    }
    const float rdec = type == 1 ? expf(-128.f * expf(INP(I_RRATE)[(l * 2 + d) * 4 + head])) : 1.f;
#pragma unroll 1
    for (int ci0 = 0; ci0 < nch; ci0 += NB) {
        f32x4 lc[NB], ln[NB]; float s0[NB], s1[NB];
#pragma unroll
        for (int j = 0; j < NB; ++j) { ln[j] = (f32x4){zf, zf, zf, zf}; s0[j] = zf; s1[j] = zf; }
#pragma unroll
        for (int j = 0; j < NB; ++j) {
            const int ci = ci0 + j, cp = cp0 + (d == 0 ? ci : nch - 1 - ci);
            lc[j] = *(const f32x4*)(loc + (size_t)((cp * 2 + d) * nh + head) * esz + e0);
            if (type == 0) { const float* sc = WSP(const float, WS_MLSC) + ((cp * 2 + d) * 4 + head) * 2; s0[j] = sc[0]; s1[j] = sc[1];
                if (do_n) ln[j] = *(const f32x4*)(WSP(const float, WS_MLNLOC) + ((cp * 2 + d) * 4 + head) * 128 + F.tid * 4); }
            else if (type == 2) s0[j] = WSP(const float, WS_SDSC)[(cp * 2 + d) * 8 + head];
        }
#pragma unroll
        for (int j = 0; j < NB; ++j) {
            const int ci = ci0 + j, cp = cp0 + (d == 0 ? ci : nch - 1 - ci);
            const size_t so = (size_t)((cp * 2 + d) * nh + head) * esz + e0;
            *(u32x2*)(inb + so) = (u32x2){pk2(v[0], v[1]), pk2(v[2], v[3])};
            float dec, wl = 1.f;
            if (type == 0) {
                const float Bt = s0[j], ml = s1[j];
                if (slice == 0 && F.tid == 0) WSP(float, WS_MLMIN)[(cp * 2 + d) * 4 + head] = m;
                if (do_n) *(f32x4*)(WSP(float, WS_MLNIN) + ((cp * 2 + d) * 4 + head) * 128 + F.tid * 4) = (f32x4){nv[0], nv[1], nv[2], nv[3]};
                const float mn = fmaxf(Bt + m, ml); dec = expf(Bt + m - mn); wl = expf(ml - mn); m = mn;
                if (do_n) { nv[0] = dec * nv[0] + wl * ln[j].x; nv[1] = dec * nv[1] + wl * ln[j].y; nv[2] = dec * nv[2] + wl * ln[j].z; nv[3] = dec * nv[3] + wl * ln[j].w; }
            } else if (type == 1) dec = rdec;
            else dec = expf(s0[j]);
            v[0] = dec * v[0] + wl * lc[j].x; v[1] = dec * v[1] + wl * lc[j].y; v[2] = dec * v[2] + wl * lc[j].z; v[3] = dec * v[3] + wl * lc[j].w;
        }
    }
    if (!lat) {
        if (type == 2) *(f32x4*)(F.out + O_SSD + (size_t)(((b * 4 + l) * 2 + d) * 8 + head) * 8192 + e0) = (f32x4){v[0], v[1], v[2], v[3]};
        else {
            LAS float* tr = (LAS float*)F.lds;
            const int dvl = F.tid >> 5, dk = (F.tid & 31) * 4;
#pragma unroll
            for (int j = 0; j < 4; ++j) tr[dvl * 129 + dk + j] = v[j];
            __syncthreads();
            const int dk2 = F.tid >> 2, q = F.tid & 3;
            float* o = F.out + (type == 0 ? O_MC : O_RET) + (size_t)(((b * 4 + l) * 2 + d) * 4 + head) * 16384 + (size_t)dk2 * 128 + slice * 16 + 4 * q;
            *(f32x4*)o = (f32x4){tr[(4 * q) * 129 + dk2], tr[(4 * q + 1) * 129 + dk2], tr[(4 * q + 2) * 129 + dk2], tr[(4 * q + 3) * 129 + dk2]};
            if (type == 0) { if (do_n) *(f32x4*)(F.out + O_MN + (size_t)(((b * 4 + l) * 2 + d) * 4 + head) * 128 + F.tid * 4) = (f32x4){nv[0], nv[1], nv[2], nv[3]};
                if (slice == 0 && F.tid == 0) F.out[O_MM + ((b * 4 + l) * 2 + d) * 4 + head] = m; }
            __syncthreads();
        }
    }
}
#ifndef PROBE_ITEM
#define PROBE_ITEM -1
#endif
#define PR(t) ((PROBE_ITEM == (t) || PROBE_ITEM == 100 + ((t) < 4 ? 2 : ((t) < 7 ? 3 : 4))) ? 2 : 1)
#ifndef PROBE_REPEAT
#define PROBE_REPEAT -1
#endif
constexpr int N_PHASES = 2 + 9 * NLAYER;
__global__ void __launch_bounds__(NT, 2) hymba_fwd(Args A) {
    extern __shared__ __attribute__((aligned(16))) unsigned char lds_raw[];
    Frame F0;
    F0.lds = (LAS unsigned char*)lds_raw;
    F0.tid = threadIdx.x; F0.lane = F0.tid & 63; F0.wave = __builtin_amdgcn_readfirstlane(F0.tid >> 6);
    F0.G = gridDim.x; F0.bid = blockIdx.x; F0.out = A.out; F0.ws = A.ws;
    volatile LAS unsigned* MISC = (volatile LAS unsigned*)(F0.lds + MISC_OFF);
    if (F0.tid < 64) MISC[F0.tid] = 0u;
    __syncthreads();
    unsigned* barw = (unsigned*)(F0.ws + WS_CTL) + CW_BAR;
    XcdBarrier bar = xcd_barrier_post(barw, MISC + 8);
    const int lo = A.ph_lo, hi = A.ph_hi;
#define KA (*kargs())
#define IN(k) (lo <= (k) && (k) < hi)
#define SEAM(k) do { if (IN(k) && IN((k) + 1)) xcd_barrier(bar); } while (0)

    if (IN(0)) { Frame F = fresh(F0); p0_prologue(F, KA); } SEAM(0);

#pragma unroll 1
    for (int l = 0; l < NLAYER; ++l) {
        const int pb = 1 + 9 * l;
        if (l == 0) { if (IN(pb + 0)) { Frame F = fresh(F0); norm0_phase(F, KA); shw_phase(F); } SEAM(pb + 0); }
        if (IN(pb + 1)) for (int rep_ = 0; rep_ < (PROBE_REPEAT == 1 ? 2 : 1); ++rep_) { Frame F = fresh(F0);
            pg8::Gemm g{WSP(const pg8::bf16_t, WS_H), WSP(const pg8::bf16_t, WS_W1T) + (size_t)l * NPAD * D, M, NPAD, D}; pg8::StaticOrder S; S.init(M, NPAD, F.G, F.bid);
            for (int i = F.bid * NT + F.tid; i < M; i += F.G * NT) WSP(float, WS_SSQA)[i] = 0.f;
            epi::EpiProj E{WSP(pg8::bf16_t, WS_PROJ), WSP(float, WS_GATES), WSP(const float, WS_SSQB), WSP(const float, WS_SHW1) + (size_t)l * 5 * NPAD};
            pg8::gemm_phase<epi::EpiProj, pg8::StaticOrder, true, true>(F.lds, g, S, E);
        } SEAM(pb + 1);
        if (IN(pb + 2)) { Frame F = fresh(F0);
            for (int itx = F.bid; itx < PR(0) * 384 + PR(1) * 768 + PR(2) * 768 + PR(3) * 768; itx += F.G) {
                int it = itx; if (PR(0) > 1 && it >= 384) it -= 384; if (PR(1) > 1 && it >= 1152) it -= 768; if (PR(2) > 1 && it >= 1920) it -= 768; if (PR(3) > 1 && it >= 2688) it -= 768;
                if (it < 384) ssd_local_item(fresh(F), KA, l, it >> 1, it & 1);
                else if (it < 1152) mlstm_local_item(fresh(F), KA, l, (it - 384) >> 2, (it - 384) & 3);
                else if (it < 1920) ret_local_item(fresh(F), KA, l, (it - 1152) >> 2, (it - 1152) & 3);
                else s5_item<0>(fresh(F), KA, l, (it - 1920) >> 2, (it - 1920) & 3);
            }
        } SEAM(pb + 2);
        if (IN(pb + 3)) { Frame F = fresh(F0);
            for (int itx = F.bid; itx < PR(4) * 768 + PR(5) * 768 + PR(6) * 6144; itx += F.G) {
                int it = itx; if (PR(4) > 1 && it >= 768) it -= 768; if (PR(5) > 1 && it >= 1536) it -= 768; if (PR(6) > 1 && it >= 7680) it -= 6144;
                if (it < 768) carry_unit<true>(fresh(F), KA, l, it);
                else if (it < 1536) s5_item<1>(fresh(F), KA, l, (it - 768) >> 2, (it - 768) & 3);
                else carry_unit<false>(fresh(F), KA, l, it - 768);
            }
        } SEAM(pb + 3);
        if (IN(pb + 4)) { Frame F = fresh(F0);
            for (int i = F.bid * NT + F.tid; i < M; i += F.G * NT) WSP(float, WS_SSQB)[i] = 0.f;
            for (int itx = F.bid; itx < PR(7) * 192 + PR(8) * 768 + PR(9) * 768; itx += F.G) {
                int it = itx; if (PR(7) > 1 && it >= 192) it -= 192; if (PR(8) > 1 && it >= 960) it -= 768; if (PR(9) > 1 && it >= 1728) it -= 768;
                if (it < 192) ssd_out_item(fresh(F), KA, l, it);
                else if (it < 960) mlstm_out_item(fresh(F), KA, l, (it - 192) >> 2, (it - 192) & 3);
                else ret_out_item(fresh(F), KA, l, (it - 960) >> 2, (it - 960) & 3);
            }
            pg8::Gemm g{WSP(const pg8::bf16_t, WS_YA), WSP(const pg8::bf16_t, WS_WGT) + (size_t)l * GWID * GWID, M, GWID, GWID}; pg8::StaticOrder S; S.init(M, GWID, F.G, F.bid);
            epi::EpiGlu E{WSP(const pg8::bf16_t, WS_YA), WSP(pg8::bf16_t, WS_Y)};
            pg8::gemm_phase<epi::EpiGlu, pg8::StaticOrder, true, true>(F.lds, g, S, E);
        } SEAM(pb + 4);
        if (IN(pb + 5)) { Frame F = fresh(F0);
            pg8::Gemm g{WSP(const pg8::bf16_t, WS_Y), WSP(const pg8::bf16_t, WS_WOT) + (size_t)l * D * D, M, D, D}; pg8::StaticOrder S; S.init(M, D, F.G, F.bid);
            KArgs& A_ = KA; epi::EpiRes E{(const float*)(const GAS float*)A_.in[I_XP], (const float*)(const GAS float*)A_.in[I_XS], F.out, WSP(const float, WS_MOD) + (size_t)(l * 5) * (6 * D) + 2 * D, l == 0 ? 1 : 0,
                          1, WSP(pg8::bf16_t, WS_H), WSP(float, WS_SSQA), (const float*)(const GAS float*)A_.in[I_NORM2] + (size_t)l * D, WSP(const float, WS_MOD) + (size_t)(l * 5) * (6 * D) + 4 * D};
            pg8::gemm_phase<epi::EpiRes, pg8::StaticOrder, true, true>(F.lds, g, S, E);
        } SEAM(pb + 5);
        if (IN(pb + 7)) for (int rep_ = 0; rep_ < (PROBE_REPEAT == 7 ? 2 : 1); ++rep_) { Frame F = fresh(F0);
            pg8::Gemm g{WSP(const pg8::bf16_t, WS_H), WSP(const pg8::bf16_t, WS_WM1T) + (size_t)l * DFF * D, M, DFF, D}; pg8::StaticOrder S; S.init(M, DFF, F.G, F.bid);
            epi::EpiRelu2 E{WSP(pg8::bf16_t, WS_HID), WSP(const float, WS_SSQA), WSP(const float, WS_SHW2) + (size_t)l * 5 * DFF};
            pg8::gemm_phase<epi::EpiRelu2, pg8::StaticOrder, true, true>(F.lds, g, S, E);
        } SEAM(pb + 7);
        if (IN(pb + 8)) { Frame F = fresh(F0);
            pg8::Gemm g{WSP(const pg8::bf16_t, WS_HID), WSP(const pg8::bf16_t, WS_WM2T) + (size_t)l * D * DFF, M, D, DFF}; pg8::StaticOrder S; S.init(M, D, F.G, F.bid);
            KArgs& A_ = KA; epi::EpiRes E{(const float*)(const GAS float*)A_.in[I_XP], (const float*)(const GAS float*)A_.in[I_XS], F.out, WSP(const float, WS_MOD) + (size_t)(l * 5) * (6 * D) + 5 * D, 0,
                          l < NLAYER - 1 ? 1 : 0, WSP(pg8::bf16_t, WS_H), WSP(float, WS_SSQB), (const float*)(const GAS float*)A_.in[I_NORM1] + (size_t)(l + 1) * D, WSP(const float, WS_MOD) + (size_t)((l + 1) * 5) * (6 * D) + 1 * D};
            pg8::gemm_phase<epi::EpiRes, pg8::StaticOrder, true, true>(F.lds, g, S, E);
        } SEAM(pb + 8);
    }
    if (IN(N_PHASES - 1)) { Frame F = fresh(F0); final_norm_phase(F, KA); }
#undef IN
#undef SEAM
}

#ifndef MK_LAUNCH_PER_PHASE
#define MK_LAUNCH_PER_PHASE 0
#endif
extern "C" void kernel_launch(void* const* d_in, const int* in_sizes, int n_in, void* d_out, int out_size, void* d_ws, size_t ws_size, hipStream_t stream) {
    static int grid = 0;
    if (grid == 0) {
        if (n_in != N_IN || (size_t)out_size != O_END || ws_size < WS_END) { fprintf(stderr, "kernel_launch: shape mismatch: n_in %d out %d ws %zu (need %zu)\n", n_in, out_size, ws_size, (size_t)WS_END); grid = -1; return; }
        int dev = 0, cus = 0, per_cu = 0;
        if (hipGetDevice(&dev) != hipSuccess || hipDeviceGetAttribute(&cus, hipDeviceAttributeMultiprocessorCount, dev) != hipSuccess) { grid = -1; return; }
        if (hipFuncSetAttribute((const void*)hymba_fwd, hipFuncAttributeMaxDynamicSharedMemorySize, LDS_BYTES) != hipSuccess) { fprintf(stderr, "kernel_launch: hipFuncSetAttribute failed\n"); grid = -1; return; }
        if (hipOccupancyMaxActiveBlocksPerMultiprocessor(&per_cu, (const void*)hymba_fwd, NT, LDS_BYTES) != hipSuccess || per_cu < 1) fprintf(stderr, "kernel_launch: occupancy query says %d\n", per_cu);
        (void)hipGetLastError();
        grid = cus;
    }
    if (grid < 0) return;
    (void)hipMemsetAsync((char*)d_ws + WS_CTL, 0, CTL_ZERO_BYTES, stream);
    Args a{};
    for (int i = 0; i < N_IN; ++i) a.in[i] = (const float*)d_in[i];
    a.out = (float*)d_out; a.ws = (unsigned char*)d_ws;
#if MK_LAUNCH_PER_PHASE
    for (int p = 0; p < N_PHASES; ++p) { a.ph_lo = p; a.ph_hi = p + 1; hipLaunchKernelGGL(hymba_fwd, dim3(grid), dim3(NT), LDS_BYTES, stream, a); }
#else
    a.ph_lo = 0; a.ph_hi = N_PHASES;
    hipLaunchKernelGGL(hymba_fwd, dim3(grid), dim3(NT), LDS_BYTES, stream, a);
#endif
    const hipError_t le = hipPeekAtLastError();
    if (le != hipSuccess) fprintf(stderr, "kernel_launch: launch failed: %s\n", hipGetErrorName(le));
}
```

```cpp
#include <hip/hip_runtime.h>
#include <cstdio>
#include <cstdint>
namespace pg8 {
#define PG8_LAS __attribute__((address_space(3)))
typedef unsigned short bf16_t;
typedef short bf16x8 __attribute__((ext_vector_type(8)));
typedef float f32x4 __attribute__((ext_vector_type(4)));
typedef unsigned u32x4 __attribute__((ext_vector_type(4)));
constexpr int BM = 256, BK = 64, HALF = 128, HTB = HALF * BK * 2  , STAGE_BYTES = 8 * HTB, NXCD = 8, WGM = 8;

__host__ __device__ __forceinline__ int lds_byte(int r, int c) { const int st = (r >> 4) * 2 + (c >> 5), rr = r & 15, cc = c & 31, ob = rr * 64 + cc * 2; return st * 1024 + (ob ^ (((ob >> 9) & 1) << 5)); }
__host__ __device__ __forceinline__ void stage_rc(int b, int& R, int& C) { const int st = b / 1024, sb = b % 1024, swz = sb ^ (((sb >> 9) & 1) << 5); R = (st >> 1) * 16 + swz / 64; C = (st & 1) * 32 + (swz % 64) / 2; }
__host__ __device__ __forceinline__ int perm32(int rho) { const int n = rho >> 4, i = rho & 15; return 8 * (i >> 2) + 4 * n + (i & 3); }

struct Unit { int pm, pn; };
struct Gemm { const bf16_t* A; const bf16_t* Bt; int M, N, K; };

struct StaticOrder {
    int nM, nN, nwg, G, c;
    __host__ __device__ void init(int M, int N, int G_, int c_) { nM = M / BM; nN = N / BM; nwg = nM * nN; G = G_; c = c_; }
    __host__ __device__ bool next(int i, Unit& u) const {
        const long L = (long)i * G + c; if (L >= nwg) return false;
        int wgid = (int)L; { const int q = nwg / NXCD, r = nwg % NXCD, xcd = wgid % NXCD, off = wgid / NXCD; wgid = (xcd < r ? xcd * (q + 1) : r * (q + 1) + (xcd - r) * q) + off; }
        const int nig = WGM * nN, gid = wgid / nig, fm = gid * WGM, gsz = (nM - fm) < WGM ? (nM - fm) : WGM;
        u.pm = fm + ((wgid % nig) % gsz); u.pn = (wgid % nig) / gsz; return true;
    }
    __device__ __forceinline__ void a_ready(const Unit&) const {}
    __device__ __forceinline__ void done(const Unit&) const {}
};

__device__ __forceinline__ unsigned cvt_pk_bf16(float lo, float hi) { unsigned r; asm volatile("v_cvt_pk_bf16_f32 %0, %1, %2" : "=v"(r) : "v"(lo), "v"(hi)); return r; }
typedef float f32x2 __attribute__((ext_vector_type(2)));
template <class Epi, class Sched, bool ALIGN_EPI = false, bool SP2 = false>
__device__ __forceinline__ void gemm_phase(PG8_LAS unsigned char* lds, const Gemm g, const Sched& S, const Epi& E) {
    int tid_ = threadIdx.x; asm volatile("" : "+v"(tid_));
    const int tid = tid_, wid = __builtin_amdgcn_readfirstlane(tid >> 6), lane = tid & 63, wr = wid >> 2, wc = wid & 3, fr = lane & 15, fq = lane >> 4;
    const int K = g.K, nt = K / BK;
    unsigned voffA[2], voffB[2];
#pragma unroll
    for (int i = 0; i < 2; ++i) { int R, C; stage_rc(tid * 16 + i * 8192, R, C); const int Rb = Epi::PERM ? ((R & ~31) + perm32(R & 31)) : R;
        voffA[i] = (unsigned)(R * K + C) * 2u; voffB[i] = (unsigned)(Rb * K + C) * 2u; }
    const size_t kstep = (size_t)(BK * 2);
    const size_t hstep = (size_t)HALF * K * 2;
    const size_t tstep = 2 * hstep;
    const unsigned ldsw = (unsigned)wid * 1024u;
    const int aoff = lds_byte(wr * 64 + fr, fq * 8), boff = lds_byte(wc * 32 + fr, fq * 8);
#define PG8_SA(b, h) (((b) * 2 + (h)) * HTB)
#define PG8_SB(b, h) ((4 + (b) * 2 + (h)) * HTB)
#define PG8_STAGE(bufoff, gbase, voff) do { _Pragma("unroll") for (int _i = 0; _i < 2; ++_i) \
        __builtin_amdgcn_global_load_lds((const unsigned*)((const char*)(gbase) + (voff)[_i]), (PG8_LAS unsigned*)(lds + (bufoff) + ldsw + _i * 8192), 16, 0, 0); } while (0)
#define PG8_LDA(dst, b, h) do { _Pragma("unroll") for (int m = 0; m < 4; ++m) _Pragma("unroll") for (int k = 0; k < 2; ++k) dst[m][k] = *(const PG8_LAS bf16x8*)(lds + PG8_SA(b, h) + aoff + m * 2048 + k * 1024); } while (0)
#define PG8_LDB(dst, b, h) do { _Pragma("unroll") for (int n = 0; n < 2; ++n) _Pragma("unroll") for (int k = 0; k < 2; ++k) dst[n][k] = *(const PG8_LAS bf16x8*)(lds + PG8_SB(b, h) + boff + n * 2048 + k * 1024); } while (0)
#define PG8_MMA(ai, bj, At, Bt) do { __builtin_amdgcn_s_setprio(1); _Pragma("unroll") for (int m = 0; m < 4; ++m) _Pragma("unroll") for (int n = 0; n < 2; ++n) _Pragma("unroll") for (int k = 0; k < 2; ++k) \
        acc[ai][bj][m][n] = __builtin_amdgcn_mfma_f32_16x16x32_bf16(Bt[n][k], At[m][k], acc[ai][bj][m][n], 0, 0, 0); __builtin_amdgcn_s_setprio(0); } while (0)
#define PG8_WAIT_V(n) asm volatile("s_waitcnt vmcnt(" #n ")" ::: "memory")
#define PG8_WAIT_L(n) asm volatile("s_waitcnt lgkmcnt(" #n ")" ::: "memory")
#define PG8_BAR __builtin_amdgcn_s_barrier()
#define PG8_SCHED __builtin_amdgcn_sched_barrier(0)
    Unit cur, nxt; int ui = 0;
    if (!S.next(0, cur)) return;
    f32x4 acc[2][2][4][2];
#pragma unroll
    for (int a = 0; a < 2; ++a)
#pragma unroll
        for (int b = 0; b < 2; ++b)
#pragma unroll
            for (int m = 0; m < 4; ++m)
#pragma unroll
                for (int n = 0; n < 2; ++n) acc[a][b][m][n] = (f32x4){0.f, 0.f, 0.f, 0.f};
    bf16x8 At[4][2], B0[2][2], B1[2][2];
    const char* cA = (const char*)g.A + (size_t)cur.pm * tstep; const char* cB = (const char*)g.Bt + (size_t)cur.pn * tstep;
    S.a_ready(cur);
    if constexpr (SP2) {
        PG8_STAGE(PG8_SB(0, 0), cB, voffB); PG8_STAGE(PG8_SB(0, 1), cB + hstep, voffB); PG8_STAGE(PG8_SA(0, 0), cA, voffA); PG8_STAGE(PG8_SA(0, 1), cA + hstep, voffA);
        if (wr == 1) PG8_BAR;
        PG8_WAIT_V(2); PG8_BAR;
        PG8_STAGE(PG8_SB(1, 0), cB + kstep, voffB); PG8_STAGE(PG8_SA(1, 0), cA + kstep, voffA); PG8_STAGE(PG8_SB(1, 1), cB + hstep + kstep, voffB);
        PG8_WAIT_V(6); PG8_BAR;
    } else {
        PG8_STAGE(PG8_SB(0, 0), cB, voffB); PG8_STAGE(PG8_SA(0, 0), cA, voffA); PG8_STAGE(PG8_SB(0, 1), cB + hstep, voffB); PG8_STAGE(PG8_SA(0, 1), cA + hstep, voffA);
        if (wr == 1) PG8_BAR;
        PG8_WAIT_V(4); PG8_BAR;
        PG8_STAGE(PG8_SB(1, 0), cB + kstep, voffB); PG8_STAGE(PG8_SA(1, 0), cA + kstep, voffA); PG8_STAGE(PG8_SB(1, 1), cB + hstep + kstep, voffB);
        PG8_WAIT_V(6); PG8_BAR;
    }
    for (;;) {
        const bool has_next = S.next(ui + 1, nxt);
        const char* nA = has_next ? (const char*)g.A + (size_t)nxt.pm * tstep : cA; const char* nB = has_next ? (const char*)g.Bt + (size_t)nxt.pn * tstep : cB;
        for (int t = 0; t < nt; t += 2) {
            const bool last = (t == nt - 2);
            const char* a1 = cA + (size_t)(t + 1) * kstep;
            const char* a2 = last ? nA : cA + (size_t)(t + 2) * kstep; const char* b2 = last ? nB : cB + (size_t)(t + 2) * kstep;
            const char* a3 = a2 + kstep; const char* b3 = b2 + kstep;
            if (last && has_next) S.a_ready(nxt);
            if constexpr (SP2) {
            PG8_LDB(B0, 0, 0); PG8_LDB(B1, 0, 1); PG8_SCHED; PG8_LDA(At, 0, 0); PG8_STAGE(PG8_SA(1, 1), a1 + hstep, voffA);
            PG8_WAIT_V(8); PG8_WAIT_L(0); PG8_BAR; PG8_MMA(0, 0, At, B0); PG8_MMA(0, 1, At, B1); PG8_BAR; PG8_SCHED;
            PG8_LDA(At, 0, 1); PG8_STAGE(PG8_SB(0, 0), b2, voffB); PG8_STAGE(PG8_SB(0, 1), b2 + hstep, voffB); PG8_STAGE(PG8_SA(0, 0), a2, voffA);
            PG8_WAIT_V(8); PG8_WAIT_L(0); PG8_BAR; PG8_MMA(1, 0, At, B0); PG8_MMA(1, 1, At, B1); PG8_BAR; PG8_SCHED;
            PG8_LDB(B0, 1, 0); PG8_LDB(B1, 1, 1); PG8_SCHED; PG8_LDA(At, 1, 0); PG8_STAGE(PG8_SA(0, 1), a2 + hstep, voffA);
            PG8_WAIT_V(8); PG8_WAIT_L(0); PG8_BAR; PG8_MMA(0, 0, At, B0); PG8_MMA(0, 1, At, B1); PG8_BAR; PG8_SCHED;
            PG8_LDA(At, 1, 1); PG8_STAGE(PG8_SB(1, 0), b3, voffB); PG8_STAGE(PG8_SB(1, 1), b3 + hstep, voffB); PG8_STAGE(PG8_SA(1, 0), a3, voffA);
            PG8_WAIT_V(8); PG8_WAIT_L(0); PG8_BAR; PG8_MMA(1, 0, At, B0); PG8_MMA(1, 1, At, B1); PG8_BAR; PG8_SCHED;
            } else {
            PG8_LDB(B0, 0, 0); PG8_SCHED; PG8_LDA(At, 0, 0); PG8_STAGE(PG8_SA(1, 1), a1 + hstep, voffA);
            PG8_WAIT_L(8); PG8_BAR; PG8_WAIT_L(0); PG8_MMA(0, 0, At, B0); PG8_BAR; PG8_SCHED;
            PG8_LDB(B1, 0, 1); PG8_STAGE(PG8_SB(0, 0), b2, voffB);
            PG8_BAR; PG8_WAIT_L(0); PG8_MMA(0, 1, At, B1); PG8_BAR;
            PG8_LDA(At, 0, 1); PG8_STAGE(PG8_SA(0, 0), a2, voffA);
            PG8_BAR; PG8_WAIT_L(0); PG8_MMA(1, 0, At, B0); PG8_BAR; PG8_SCHED;
            PG8_STAGE(PG8_SB(0, 1), b2 + hstep, voffB);
            PG8_WAIT_V(6); PG8_BAR; PG8_MMA(1, 1, At, B1); PG8_BAR;
            PG8_LDB(B0, 1, 0); PG8_SCHED; PG8_LDA(At, 1, 0); PG8_STAGE(PG8_SA(0, 1), a2 + hstep, voffA);
            PG8_WAIT_L(8); PG8_BAR; PG8_WAIT_L(0); PG8_MMA(0, 0, At, B0); PG8_BAR; PG8_SCHED;
            PG8_LDB(B1, 1, 1); PG8_STAGE(PG8_SB(1, 0), b3, voffB);
            PG8_BAR; PG8_WAIT_L(0); PG8_MMA(0, 1, At, B1); PG8_BAR;
            PG8_LDA(At, 1, 1); PG8_STAGE(PG8_SA(1, 0), a3, voffA);
            PG8_BAR; PG8_WAIT_L(0); PG8_MMA(1, 0, At, B0); PG8_BAR; PG8_SCHED;
            PG8_STAGE(PG8_SB(1, 1), b3 + hstep, voffB);
            PG8_WAIT_V(6); PG8_BAR; PG8_MMA(1, 1, At, B1); PG8_BAR;
            }
        }
        if constexpr (ALIGN_EPI) { if (wr == 0) PG8_BAR; }
        if constexpr (!Epi::AFTER_DRAIN) { E(acc, cur, wr, wc, fr, fq); S.done(cur); }
        if (!has_next) break;
#pragma unroll
        for (int a = 0; a < 2; ++a)
#pragma unroll
            for (int b = 0; b < 2; ++b)
#pragma unroll
                for (int m = 0; m < 4; ++m)
#pragma unroll
                    for (int n = 0; n < 2; ++n) acc[a][b][m][n] = (f32x4){0.f, 0.f, 0.f, 0.f};
        cur = nxt; cA = nA; cB = nB; ++ui;
        if constexpr (ALIGN_EPI) { if (wr == 1) PG8_BAR; }
    }
    PG8_WAIT_V(0);
    if constexpr (!ALIGN_EPI) { if (wr == 0) PG8_BAR; }
    PG8_BAR;
    if constexpr (Epi::AFTER_DRAIN) { E.fused(acc, cur, wr, wc, fr, fq, lds, wid, lane); S.done(cur); }
#undef PG8_SA
#undef PG8_SB
#undef PG8_STAGE
#undef PG8_LDA
#undef PG8_LDB
#undef PG8_MMA
#undef PG8_WAIT_V
#undef PG8_WAIT_L
#undef PG8_BAR
#undef PG8_SCHED
}
}
#define GAS __attribute__((address_space(1)))
#define LAS __attribute__((address_space(3)))
typedef unsigned short bf16;
typedef unsigned v4u __attribute__((ext_vector_type(4)));
typedef float f32x4 __attribute__((ext_vector_type(4)));
typedef short bf16x8 __attribute__((ext_vector_type(8)));
typedef GAS unsigned gu32;
typedef GAS unsigned long long gu64;
#define RLX_AGENT __ATOMIC_RELAXED, __HIP_MEMORY_SCOPE_AGENT
#define LDS_WAIT() asm volatile("s_waitcnt lgkmcnt(0)" ::: "memory")
#define VM_WAIT() asm volatile("s_waitcnt vmcnt(0)" ::: "memory")
__device__ __forceinline__ unsigned long long rt() { return __builtin_amdgcn_s_memrealtime(); }
__device__ __forceinline__ unsigned f2bf(float f) { unsigned u = __builtin_bit_cast(unsigned, f); return (u + 0x7fffu + ((u >> 16) & 1u)) >> 16; }
__device__ __forceinline__ unsigned pk2(float lo, float hi) { return f2bf(lo) | (f2bf(hi) << 16); }
#define XB_TMO      128
#define XB_XCNT(j)  (256  + 64 * (j))
#define XB_XSUB(j)  (1280 + 64 * (j))
#define XB_XGEN(j)  (2304 + 64 * (j))
#define XB_TOP      3328
#define XB_TOPGEN   3392
#define XCD_BAR_WORDS 3456
#define XB_SPIN_CAP (1u << 18)

__device__ __forceinline__ unsigned xb_ld(unsigned* p)              { return __hip_atomic_load(p, __ATOMIC_RELAXED, __HIP_MEMORY_SCOPE_AGENT); }
__device__ __forceinline__ unsigned xb_add(unsigned* p, unsigned v) { return __hip_atomic_fetch_add(p, v, __ATOMIC_RELAXED, __HIP_MEMORY_SCOPE_AGENT); }
__device__ __forceinline__ unsigned xb_xcc_id() { return (unsigned)__builtin_amdgcn_s_getreg((3 << 11) | 20) & 0xFu; }
#define XB_SPIN(cond, bar) do { unsigned _sp = 0; while (cond) { __builtin_amdgcn_s_sleep(1); \
    if ((++_sp & 255u) == 0u) { if (xb_ld(&(bar)[XB_TMO])) break; if (_sp > XB_SPIN_CAP) { atomicAdd(&(bar)[XB_TMO], 1u); break; } } } } while (0)

struct XcdBarrier {
    unsigned* bar; unsigned x;
    volatile LAS unsigned* st;
};

__device__ __forceinline__ XcdBarrier xcd_barrier_post(unsigned* bar, volatile LAS unsigned* st) {
    XcdBarrier b; b.bar = bar; b.x = xb_xcc_id(); b.st = st;
    if (threadIdx.x == 0) (void)xb_add(&bar[XB_XCNT(b.x)], 1u);
    return b;
}
__device__ __forceinline__ void xcd_barrier_complete(unsigned* bar, unsigned x, unsigned& nloc, unsigned& nx) {
    const unsigned G = gridDim.x * gridDim.y * gridDim.z;
    unsigned sum, cnt, mine, sp = 0u;
    for (;;) {
        sum = 0u; cnt = 0u; mine = 0u;
#pragma unroll
        for (unsigned j = 0; j < 16; ++j) { const unsigned c = xb_ld(&bar[XB_XCNT(j)]); sum += c; cnt += (c > 0u) ? 1u : 0u; mine = (j == x) ? c : mine; }
        if (sum == G) break;
        __builtin_amdgcn_s_sleep(1);
        if ((++sp & 255u) == 0u) { if (xb_ld(&bar[XB_TMO])) break; if (sp > XB_SPIN_CAP) { atomicAdd(&bar[XB_TMO], 1u); break; } }
    }
    nloc = mine > 0u ? mine : 1u; nx = cnt > 0u ? cnt : 1u;
}

__device__ __forceinline__ void xcd_barrier(const XcdBarrier& b) {
    asm volatile("s_waitcnt vmcnt(0)" ::: "memory");
    __syncthreads();
    if (threadIdx.x == 0) {
        unsigned* bar = b.bar;
        __builtin_amdgcn_s_waitcnt(0);
        unsigned nloc = b.st[0], nx = b.st[1];
        if (nloc == 0u) { xcd_barrier_complete(bar, b.x, nloc, nx); b.st[0] = nloc; b.st[1] = nx; }
        const unsigned old = xb_add(&bar[XB_XSUB(b.x)], 1u);
        const unsigned gen = old / nloc;
        if (old + 1u == (gen + 1u) * nloc) {
            __builtin_amdgcn_fence(__ATOMIC_RELEASE, "agent");
            asm volatile("s_waitcnt vmcnt(0)" ::: "memory");
            const unsigned og = xb_add(&bar[XB_TOP], 1u);
            const unsigned tg = og / nx;
            if (og + 1u == (tg + 1u) * nx) xb_add(&bar[XB_TOPGEN], 1u);
            else XB_SPIN(xb_ld(&bar[XB_TOPGEN]) == tg, bar);
            __builtin_amdgcn_fence(__ATOMIC_ACQUIRE, "agent");
            xb_add(&bar[XB_XGEN(b.x)], 1u);
            asm volatile("s_waitcnt vmcnt(0)" ::: "memory");
        } else {
            XB_SPIN(xb_ld(&bar[XB_XGEN(b.x)]) == gen, bar);
            __builtin_amdgcn_fence(__ATOMIC_ACQUIRE, "agent");
            asm volatile("s_waitcnt vmcnt(0)" ::: "memory");
        }
    }
    __syncthreads();
}
constexpr int NWAVES = 8, NT = 512;
constexpr int D = 2048, NLAYER = 4;
constexpr int MC = 32 * 256, ML = 4 * 4096, M = MC + ML;
constexpr int DIN = 6176, NPROJ = 6144, NPAD = 6400, DFF = 8192, GWID = 512;
constexpr int NCP = M / 128;
constexpr float EPS = 1e-6f;
constexpr int PC_S5U = 0, PC_MQ = 512, PC_MK = 1024, PC_MV = 1536, PC_MO = 2048, PC_RQ = 2560, PC_RK = 3072, PC_RV = 3584, PC_RG = 4096, PC_DZ = 4608, PC_DX = 5120, PC_DB = 5632, PC_DC = 5888;
enum { I_XP = 0, I_XS, I_C, I_SS5R, I_SS5I, I_SMC, I_SMN, I_SMM, I_SRET, I_SSSD, I_CCTX, I_NORM1, I_WADA, I_BADA, I_WIN, I_S5LR, I_S5LI, I_S5DT, I_S5BR, I_S5BI, I_S5CR, I_S5CI, I_S5D, I_S5GLU,
       I_MIB, I_MFB, I_MNORM, I_RRATE, I_RNORM, I_CONVW, I_CONVB, I_DTB, I_ALOG, I_SSDD, I_SNORM, I_WOUT, I_NORM2, I_WM1, I_WM2, I_FNORM, N_IN };
constexpr size_t O_YP = 0, O_YS = (size_t)MC * D, O_S5R = (size_t)M * D, O_S5I = O_S5R + 524288, O_MC = O_S5I + 524288, O_MN = O_MC + 16777216, O_MM = O_MN + 131072, O_RET = O_MM + 1024, O_SSD = O_RET + 16777216, O_END = O_SSD + 16777216;

constexpr size_t MiB = 1u << 20;
constexpr size_t WS_CTL = 0, CTL_ZERO_BYTES = 1 * MiB;
constexpr size_t WS_MOD = 1 * MiB;
constexpr size_t WS_S5T = 2 * MiB;
constexpr size_t WS_ROPE = 5 * MiB;
constexpr size_t WS_GATES = 6 * MiB;
constexpr size_t WS_MLNLOC = 9 * MiB;
constexpr size_t WS_MLNIN = 10 * MiB;
constexpr size_t WS_MLSC = 11 * MiB;
constexpr size_t WS_MLMIN = 11 * MiB + 65536;
constexpr size_t WS_SDSC = 11 * MiB + 131072;
constexpr size_t WS_SSQA = 5 * MiB + 65536;
constexpr size_t WS_SSQB = 11 * MiB + 262144;
constexpr size_t WS_SHW1 = 18 * MiB;
constexpr size_t WS_SHW2 = 19 * MiB;
constexpr size_t WS_S5LOC = 12 * MiB;
constexpr size_t WS_WGT = 20 * MiB;
constexpr size_t WS_W1T = 22 * MiB;
constexpr size_t WS_WOT = 122 * MiB;
constexpr size_t WS_WM1T = 154 * MiB;
constexpr size_t WS_WM2T = 282 * MiB;
constexpr size_t WS_H = 410 * MiB;
constexpr size_t WS_Y = 506 * MiB;
constexpr size_t WS_YA = 602 * MiB;
constexpr size_t WS_MLCIN = 626 * MiB;
constexpr size_t WS_RTIN = 674 * MiB;
constexpr size_t WS_SDIN = 722 * MiB;
constexpr size_t WS_PROJ = 770 * MiB;
constexpr size_t WS_MLCLOC = 1058 * MiB;
constexpr size_t WS_HID = 770 * MiB;
constexpr size_t WS_RTLOC = 1106 * MiB;
constexpr size_t WS_SDLOC = 1154 * MiB;
constexpr size_t WS_XBCC = 1202 * MiB;
constexpr size_t WS_END = 1250 * MiB;
constexpr int CW_TMO = 0, CW_BAR = 4096;

constexpr int LDT = 272;
constexpr int TS = 128 * LDT;
constexpr int LDX = 144;
constexpr int TSX = 128 * LDX;
constexpr int SCAL_OFF = 4 * TS;
constexpr int MISC_OFF = 163840 - 256;
constexpr int LDS_BYTES = 163840;
#define SCA(i) ((LAS float*)(F.lds + SCAL_OFF + (i) * 512))
typedef float f32x16 __attribute__((ext_vector_type(16)));
typedef float f32x2 __attribute__((ext_vector_type(2)));
typedef short s16x4 __attribute__((ext_vector_type(4)));
typedef unsigned u32x2 __attribute__((ext_vector_type(2)));
struct Args { const float* in[N_IN]; float* out; unsigned char* ws; int ph_lo, ph_hi; };
struct Frame {
    LAS unsigned char* lds;
    float* out; unsigned char* ws;
    int tid, lane, wave, G, bid;
};
typedef const __attribute__((address_space(4))) Args KArgs;
__device__ __forceinline__ KArgs* kargs() { KArgs* p = (KArgs*)__builtin_amdgcn_kernarg_segment_ptr(); asm volatile("" : "+s"(p)); return p; }
__device__ __forceinline__ Frame fresh(const Frame& F) { Frame R = F; unsigned long long l = (unsigned long long)(size_t)R.lds; unsigned ll = (unsigned)l; asm volatile("" : "+s"(ll), "+s"(R.wave), "+s"(R.G), "+s"(R.bid), "+v"(R.tid)); R.lane = R.tid & 63; R.lds = (LAS unsigned char*)(size_t)ll; KArgs* ka = kargs(); R.out = (float*)(GAS float*)ka->out; R.ws = (unsigned char*)(GAS unsigned char*)ka->ws; return R; }
#define INP(i) ((const float*)(const GAS float*)(A.in[i]))
#define BAR() __syncthreads()
#define WSP(T, off) ((T*)(F.ws + (off)))
__device__ __forceinline__ float bf2f(unsigned short b) { return __uint_as_float((unsigned)b << 16); }
__device__ __forceinline__ float bflo(unsigned w) { return __uint_as_float(w << 16); }
__device__ __forceinline__ float bfhi(unsigned w) { return __uint_as_float(w & 0xffff0000u); }
__device__ __forceinline__ void unpack8(const v4u a, float (&x)[8]) { x[0] = bflo(a.x); x[1] = bfhi(a.x); x[2] = bflo(a.y); x[3] = bfhi(a.y); x[4] = bflo(a.z); x[5] = bfhi(a.z); x[6] = bflo(a.w); x[7] = bfhi(a.w); }
__device__ __forceinline__ v4u pack8(const float (&x)[8], float w) { v4u o; o.x = pk2(x[0] * w, x[1] * w); o.y = pk2(x[2] * w, x[3] * w); o.z = pk2(x[4] * w, x[5] * w); o.w = pk2(x[6] * w, x[7] * w); return o; }
__device__ __forceinline__ float sigmoidf_(float x) { return 1.f / (1.f + __expf(-x)); }
__device__ __forceinline__ float siluf_(float x) { return x * sigmoidf_(x); }
__device__ __forceinline__ float wave_sum(float v) {
#pragma unroll
    for (int o = 1; o < 64; o <<= 1) v += __shfl_xor(v, o);
    return v;
}
__device__ __forceinline__ float wave_max(float v) {
#pragma unroll
    for (int o = 1; o < 64; o <<= 1) v = fmaxf(v, __shfl_xor(v, o));
    return v;
}
template <bool MAX> __device__ __forceinline__ void wave_scan128(const LAS float* in, LAS float* out, int lane, bool rev, float init) {
    const int i0 = rev ? 127 - 2 * lane : 2 * lane, i1 = rev ? i0 - 1 : i0 + 1;
    float e0 = in[i0], e1 = in[i1];
    if (lane == 0) e0 = MAX ? fmaxf(e0, init) : e0 + init;
    float inc = MAX ? fmaxf(e0, e1) : e0 + e1;
#pragma unroll
    for (int o = 1; o < 64; o <<= 1) { const float t = __shfl_up(inc, o); if (lane >= o) inc = MAX ? fmaxf(inc, t) : inc + t; }
    float exc = __shfl_up(inc, 1);
    const float o0 = (lane == 0) ? e0 : (MAX ? fmaxf(exc, e0) : exc + e0);
    out[i0] = o0; out[i1] = inc;
}
__device__ __forceinline__ s16x4 lds_tr(const LAS unsigned char* p) {
    typedef short v4i16_t __attribute__((ext_vector_type(4)));
    return __builtin_bit_cast(s16x4, __builtin_amdgcn_ds_read_tr16_b64_v4i16((LAS v4i16_t*)p));
}
__device__ __forceinline__ bf16x8 frag_row(const LAS unsigned char* base, int ld, int r0, int k0, int lane) {
    return *(const LAS bf16x8*)(base + (r0 + (lane & 31)) * ld + (k0 + 8 * (lane >> 5)) * 2);
}
__device__ __forceinline__ bf16x8 frag_tr(const LAS unsigned char* base, int ld, int k0, int c0, int lane) {
    const int h = lane >> 5, blk = (lane >> 4) & 1, q = (lane & 15) >> 2, p = lane & 3;
    const LAS unsigned char* a = base + (k0 + 8 * h + q) * ld + (c0 + 16 * blk + 4 * p) * 2;
    const s16x4 lo = lds_tr(a), hi = lds_tr(a + 4 * ld);
    return (bf16x8){lo[0], lo[1], lo[2], lo[3], hi[0], hi[1], hi[2], hi[3]};
}
#define MFMA32(a, b, c) __builtin_amdgcn_mfma_f32_32x32x16_bf16((a), (b), (c), 0, 0, 0)
#define ZERO16 ((f32x16){0.f,0.f,0.f,0.f,0.f,0.f,0.f,0.f,0.f,0.f,0.f,0.f,0.f,0.f,0.f,0.f})
__device__ __forceinline__ int crow(int i, int hh) { return (i & 3) + 8 * (i >> 2) + 4 * hh; }

__device__ __forceinline__ const float* x_in_row(const Frame& F, KArgs& A, int l, int r) {
    if (l == 0) return r < MC ? INP(I_XP) + (size_t)r * D : INP(I_XS) + (size_t)(r - MC) * D;
    return F.out + (size_t)r * D;
}
__device__ __forceinline__ int mod_row(int r) { return r < MC ? 0 : 1 + (r - MC) / 4096; }
__device__ __forceinline__ const float* mod_ptr(const Frame& F, int l, int mrow, int part) { return WSP(const float, WS_MOD) + ((size_t)(l * 5 + mrow) * 6 + part) * D; }
struct Seq { int cp0, nch, c, b, lat; };
__device__ __forceinline__ Seq seq_of(int cp) { Seq s; if (cp < 64) { s.lat = 0; s.b = cp >> 1; s.cp0 = cp & ~1; s.nch = 2; s.c = cp & 1; } else { s.lat = 1; s.b = (cp - 64) >> 5; s.cp0 = 64 + (s.b << 5); s.nch = 32; s.c = (cp - 64) & 31; } return s; }
__device__ __forceinline__ int w1_newcol(int n) { return n < 2560 ? n : (n < 2576 ? n - 2560 + 6144 : (n < 6160 ? n - 16 : n)); }
template <bool MAPW1> __device__ __forceinline__ void p0_transpose_item(const float* W, int K, int N, bf16* WT, LAS float* scr, int item, int lane) {
    const int nblk = N / 32, kb = item / nblk, nb = item % nblk, k0 = 64 * kb, n0 = 32 * nb;
#pragma unroll 8
    for (int i = 0; i < 32; ++i) { const int kk = 2 * i + (lane >> 5); scr[kk * 33 + (lane & 31)] = W[(size_t)(k0 + kk) * N + n0 + (lane & 31)]; }
    LDS_WAIT(); asm volatile("" ::: "memory");
    const int c = lane & 7;
#pragma unroll
    for (int j = 0; j < 4; ++j) { const int n = (lane >> 3) + 8 * j; const LAS float* s = scr + (8 * c) * 33 + n;
        v4u o; o.x = pk2(s[0 * 33], s[1 * 33]); o.y = pk2(s[2 * 33], s[3 * 33]); o.z = pk2(s[4 * 33], s[5 * 33]); o.w = pk2(s[6 * 33], s[7 * 33]);
        const int nr = MAPW1 ? w1_newcol(n0 + n) : (n0 + n);
        *(GAS v4u*)(WT + (size_t)nr * K + k0 + 8 * c) = o; }
    LDS_WAIT(); asm volatile("" ::: "memory");
}
constexpr int S5T_STRIDE = 9216;
__device__ __forceinline__ unsigned char* s5tab(const Frame& F, int l, int d, int g) { return F.ws + WS_S5T + (size_t)((l * 2 + d) * 32 + g) * S5T_STRIDE; }

__device__ __forceinline__ void p0_prologue(Frame& F, KArgs& A) {
    {
        LAS float* scr = (LAS float*)(F.lds + F.wave * 16384);
        const int gw = F.bid * NWAVES + F.wave, NGW = F.G * NWAVES;
        constexpr int I_1 = (D / 64) * (DIN / 32), I_G = (GWID / 64) * (GWID / 32), I_O = (D / 64) * (D / 32), I_M1 = (D / 64) * (DFF / 32), I_M2 = (DFF / 64) * (D / 32);
        constexpr int PER_L = I_1 + I_G + I_O + I_M1 + I_M2;
        for (int it = gw; it < NLAYER * PER_L; it += NGW) {
            const int l = it / PER_L; int r = it % PER_L;
            if (r < I_1) { p0_transpose_item<true>(INP(I_WIN) + (size_t)l * D * DIN, D, DIN, WSP(bf16, WS_W1T) + (size_t)l * NPAD * D, scr, r, F.lane); continue; } r -= I_1;
            if (r < I_G) { p0_transpose_item<false>(INP(I_S5GLU) + (size_t)l * GWID * GWID, GWID, GWID, WSP(bf16, WS_WGT) + (size_t)l * GWID * GWID, scr, r, F.lane); continue; } r -= I_G;
            if (r < I_O) { p0_transpose_item<false>(INP(I_WOUT) + (size_t)l * D * D, D, D, WSP(bf16, WS_WOT) + (size_t)l * D * D, scr, r, F.lane); continue; } r -= I_O;
            if (r < I_M1) { p0_transpose_item<false>(INP(I_WM1) + (size_t)l * D * DFF, D, DFF, WSP(bf16, WS_WM1T) + (size_t)l * DFF * D, scr, r, F.lane); continue; } r -= I_M1;
            p0_transpose_item<false>(INP(I_WM2) + (size_t)l * DFF * D, DFF, D, WSP(bf16, WS_WM2T) + (size_t)l * D * DFF, scr, r, F.lane);
        }
        const int gt = F.bid * NT + F.tid, NGT = F.G * NT;
        for (int i = gt; i < NLAYER * 224 * 256; i += NGT) { const int l = i / (224 * 256), r = i % (224 * 256);
            *(GAS v4u*)(WSP(bf16, WS_W1T) + ((size_t)l * NPAD + DIN) * D + (size_t)r * 8) = (v4u){0u, 0u, 0u, 0u}; }
        for (int i = gt; i < NLAYER * 2 * 32 * 64; i += NGT) {
            const int p = i & 63, g = (i >> 6) & 31, d = (i >> 11) & 1, l = i >> 12;
            const int ldg = (l * 2 + d) * 32 + g;
            const double lre = INP(I_S5LR)[ldg * 64 + p], lim = INP(I_S5LI)[ldg * 64 + p], dt = exp((double)INP(I_S5DT)[ldg]);
            const double er = exp(lre * dt), br = er * cos(lim * dt), bi = er * sin(lim * dt);
            const double e128 = exp(128.0 * lre * dt), b128r = e128 * cos(128.0 * lim * dt), b128i = e128 * sin(128.0 * lim * dt);
            const double nr = br - 1.0, ni = bi, den = lre * lre + lim * lim;
            const double cr = (nr * lre + ni * lim) / den, ci = (ni * lre - nr * lim) / den;
            unsigned char* tb = s5tab(F, l, d, g);
            float* lam = (float*)tb; lam[2 * p] = (float)br; lam[2 * p + 1] = (float)bi;
            float* l128 = (float*)(tb + 512); l128[2 * p] = (float)b128r; l128[2 * p + 1] = (float)b128i;
            bf16* bb = (bf16*)(tb + 1024); bf16* ct = (bf16*)(tb + 5120);
            for (int c = 0; c < 16; ++c) {
                const double Br = INP(I_S5BR)[(size_t)(ldg * 64 + p) * 16 + c], Bi = INP(I_S5BI)[(size_t)(ldg * 64 + p) * 16 + c];
                bb[(2 * p) * 16 + c] = (bf16)f2bf((float)(cr * Br - ci * Bi));
                bb[(2 * p + 1) * 16 + c] = (bf16)f2bf((float)(cr * Bi + ci * Br));
                ct[c * 128 + 2 * p] = (bf16)f2bf(INP(I_S5CR)[(size_t)(ldg * 16 + c) * 64 + p]);
                ct[c * 128 + 2 * p + 1] = (bf16)f2bf(-INP(I_S5CI)[(size_t)(ldg * 16 + c) * 64 + p]);
            }
        }
        for (int i = gt; i < 64 * 32; i += NGT) { const int pos = i >> 5, k = i & 31; const double f = pow(10000.0, -(double)k / 32.0), a = pos * f;
            WSP(f32x2, WS_ROPE)[i] = (f32x2){(float)cos(a), (float)sin(a)}; }
    }
    __syncthreads();
    {
        LAS float* sc = (LAS float*)F.lds;
        LAS float* red = (LAS float*)(F.lds + 65536);
        for (int i = F.tid; i < 5 * D; i += NT) { const int r = i / D, k = i % D; const float v = r == 0 ? INP(I_CCTX)[k] : INP(I_C)[(r - 1) * D + k]; sc[i] = siluf_(v); }
        __syncthreads();
        for (int it = F.bid; it < NLAYER * 96; it += F.G) {
            const int l = it / 96, c0 = (it % 96) * 128;
            const float* W = INP(I_WADA) + (size_t)l * D * (6 * D);
            float acc[5][4];
#pragma unroll
            for (int r = 0; r < 5; ++r)
#pragma unroll
                for (int j = 0; j < 4; ++j) acc[r][j] = 0.f;
            const int cl = F.lane & 31, kp = F.lane >> 5;
#pragma unroll 4
            for (int kk = 0; kk < 128; ++kk) {
                const int k = F.wave * 256 + 2 * kk + kp;
                const f32x4 w = *(const f32x4*)(W + (size_t)k * (6 * D) + c0 + 4 * cl);
#pragma unroll
                for (int r = 0; r < 5; ++r) { const float s = sc[r * D + k]; acc[r][0] += s * w.x; acc[r][1] += s * w.y; acc[r][2] += s * w.z; acc[r][3] += s * w.w; }
            }
#pragma unroll
            for (int r = 0; r < 5; ++r)
#pragma unroll
                for (int j = 0; j < 4; ++j) { acc[r][j] += __shfl_xor(acc[r][j], 32); }
            if (kp == 0) {
#pragma unroll
                for (int r = 0; r < 5; ++r)
#pragma unroll
                    for (int j = 0; j < 4; ++j) red[(F.wave * 5 + r) * 128 + 4 * cl + j] = acc[r][j];
            }
            __syncthreads();
            for (int i = F.tid; i < 5 * 128; i += NT) { const int r = i >> 7, j = i & 127; float s = 0.f;
#pragma unroll
                for (int w = 0; w < 8; ++w) s += red[(w * 5 + r) * 128 + j];
                WSP(float, WS_MOD)[(size_t)(l * 5 + r) * (6 * D) + c0 + j] = s + INP(I_BADA)[(size_t)l * (6 * D) + c0 + j]; }
            __syncthreads();
        }
    }
}

__device__ __forceinline__ void norm0_phase(Frame& F, KArgs& A) {
    const int gw = F.bid * NWAVES + F.wave, NGW = F.G * NWAVES;
    const float* gain = INP(I_NORM1);
    for (int m = gw; m < M; m += NGW) {
        const float* xr = x_in_row(F, A, 0, m);
        const float* scp = mod_ptr(F, 0, mod_row(m), 1);
        f32x4 v[8]; float s = 0.f;
#pragma unroll
        for (int j = 0; j < 8; ++j) { v[j] = *(const f32x4*)(xr + 4 * F.lane + 256 * j); s += (v[j].x * v[j].x + v[j].y * v[j].y) + (v[j].z * v[j].z + v[j].w * v[j].w); }
        s = wave_sum(s);
        if (F.lane < 8) WSP(float, WS_SSQB)[(size_t)m * 8 + F.lane] = F.lane == 0 ? s : 0.f;
        bf16* orow = WSP(bf16, WS_H) + (size_t)m * D;
#pragma unroll
        for (int j = 0; j < 8; ++j) { const int c = 4 * F.lane + 256 * j;
            const f32x4 g4 = *(const f32x4*)(gain + c), s4 = *(const f32x4*)(scp + c);
            *(u32x2*)(orow + c) = (u32x2){pk2(v[j].x * g4.x * (1.f + s4.x), v[j].y * g4.y * (1.f + s4.y)), pk2(v[j].z * g4.z * (1.f + s4.z), v[j].w * g4.w * (1.f + s4.w))}; }
    }
}
__device__ __forceinline__ void shw_phase(Frame& F) {
    LAS float* sh = (LAS float*)F.lds;
    const int gw = F.bid * NWAVES + F.wave, NGW = F.G * NWAVES;
    for (int grp = 0; grp < 2 * NLAYER; ++grp) {
        const int l = grp >> 1, which = grp & 1;
        __syncthreads();
        for (int i = F.tid; i < 5 * D; i += NT) sh[i] = WSP(const float, WS_MOD)[((size_t)(l * 5 + i / D) * 6 + (which ? 3 : 0)) * D + (i % D)];
        __syncthreads();
        const int N = which ? DFF : DIN, NS = which ? DFF : NPAD;
        const bf16* Wt = which ? WSP(const bf16, WS_WM1T) + (size_t)l * DFF * D : WSP(const bf16, WS_W1T) + (size_t)l * NPAD * D;
        float* o = which ? WSP(float, WS_SHW2) + (size_t)l * 5 * DFF : WSP(float, WS_SHW1) + (size_t)l * 5 * NPAD;
        for (int n = gw; n < N; n += NGW) {
            float acc[5] = {0.f, 0.f, 0.f, 0.f, 0.f};
#pragma unroll
            for (int j = 0; j < 4; ++j) { const int k = 8 * F.lane + 512 * j; float w[8]; unpack8(*(const v4u*)(Wt + (size_t)n * D + k), w);
#pragma unroll
                for (int r = 0; r < 5; ++r) { const f32x4 a0 = *(const LAS f32x4*)(sh + r * D + k), a1 = *(const LAS f32x4*)(sh + r * D + k + 4);
                    acc[r] += (w[0] * a0.x + w[1] * a0.y) + (w[2] * a0.z + w[3] * a0.w) + (w[4] * a1.x + w[5] * a1.y) + (w[6] * a1.z + w[7] * a1.w); } }
#pragma unroll
            for (int r = 0; r < 5; ++r) { const float s = wave_sum(acc[r]); if (F.lane == 0) o[(size_t)r * NS + n] = s; }
        }
    }
    __syncthreads();
}
__device__ __forceinline__ void final_norm_phase(Frame& F, KArgs& A) {
    const int gw = F.bid * NWAVES + F.wave, NGW = F.G * NWAVES;
    const float* gain = INP(I_FNORM);
    for (int m = gw; m < M; m += NGW) {
        float* xr = F.out + (size_t)m * D;
        f32x4 v[8]; float s = 0.f;
#pragma unroll
        for (int j = 0; j < 8; ++j) { v[j] = *(const f32x4*)(xr + 4 * F.lane + 256 * j); s += (v[j].x * v[j].x + v[j].y * v[j].y) + (v[j].z * v[j].z + v[j].w * v[j].w); }
        const float rstd = rsqrtf(wave_sum(s) * (1.f / D) + EPS);
#pragma unroll
        for (int j = 0; j < 8; ++j) { const int c = 4 * F.lane + 256 * j; const f32x4 g4 = *(const f32x4*)(gain + c);
            *(f32x4*)(xr + c) = (f32x4){v[j].x * rstd * g4.x, v[j].y * rstd * g4.y, v[j].z * rstd * g4.z, v[j].w * rstd * g4.w}; }
    }
}
namespace epi {
__device__ __forceinline__ float rstd_of(const float* part, int r) { const pg8::f32x4 a = *(const pg8::f32x4*)(part + (size_t)r * 8), b = *(const pg8::f32x4*)(part + (size_t)r * 8 + 4);
    return rsqrtf((((a[0] + a[1]) + (a[2] + a[3])) + ((b[0] + b[1]) + (b[2] + b[3]))) * (1.f / D) + EPS); }
using pg8::Unit; using pg8::f32x4; using pg8::u32x4; using pg8::bf16_t; using pg8::cvt_pk_bf16;
constexpr int BMq = 256, HALFq = 128;
struct EpiProj {
    static constexpr bool PERM = true, AFTER_DRAIN = false;
    bf16_t* P; float* G; const float* ssq; const float* shw0;
    __device__ __forceinline__ void operator()(const f32x4 (&acc)[2][2][4][2], const Unit& u, int wr, int wc, int fr, int fq) const {
        const int row0 = u.pm * BMq + wr * 64 + fr, rowt = u.pm * BMq;
        const float* shw = shw0 + (size_t)(rowt < MC ? 0 : 1 + (rowt - MC) / 4096) * NPAD + u.pn * BMq + wc * 32 + 8 * fq;
        if (u.pn < 24) {
            const int col0 = u.pn * BMq + wc * 32 + 8 * fq;
            f32x4 sh[2][2];
#pragma unroll
            for (int bj = 0; bj < 2; ++bj) { sh[bj][0] = *(const f32x4*)(shw + bj * HALFq); sh[bj][1] = *(const f32x4*)(shw + bj * HALFq + 4); }
#pragma unroll
            for (int ai = 0; ai < 2; ++ai)
#pragma unroll
                for (int m = 0; m < 4; ++m) { const int r = row0 + ai * HALFq + m * 16; bf16_t* rowp = P + (size_t)r * NPROJ + col0; const float rs = rstd_of(ssq, r);
#pragma unroll
                    for (int bj = 0; bj < 2; ++bj) { const f32x4 v0 = acc[ai][bj][m][0] * rs + sh[bj][0], v1 = acc[ai][bj][m][1] * rs + sh[bj][1];
                        u32x4 w; w.x = cvt_pk_bf16(v0[0], v0[1]); w.y = cvt_pk_bf16(v0[2], v0[3]); w.z = cvt_pk_bf16(v1[0], v1[1]); w.w = cvt_pk_bf16(v1[2], v1[3]);
                        *(u32x4*)(rowp + bj * HALFq) = w; } }
        } else if (wc == 0) {
#pragma unroll
            for (int ai = 0; ai < 2; ++ai)
#pragma unroll
                for (int m = 0; m < 4; ++m) { const int r = row0 + ai * HALFq + m * 16; float* g = G + (size_t)r * 32 + 8 * fq; const float rs = rstd_of(ssq, r);
                    *(f32x4*)g = acc[ai][0][m][0] * rs + *(const f32x4*)shw; *(f32x4*)(g + 4) = acc[ai][0][m][1] * rs + *(const f32x4*)(shw + 4); }
        }
    }
};
struct EpiGlu {
    static constexpr bool PERM = true, AFTER_DRAIN = false;
    const bf16_t* YA; bf16_t* Y;
    __device__ __forceinline__ void operator()(const f32x4 (&acc)[2][2][4][2], const Unit& u, int wr, int wc, int fr, int fq) const {
        const int row0 = u.pm * BMq + wr * 64 + fr, col0 = u.pn * BMq + wc * 32 + 8 * fq;
#pragma unroll
        for (int ai = 0; ai < 2; ++ai)
#pragma unroll
            for (int m = 0; m < 4; ++m) { const int r = row0 + ai * HALFq + m * 16;
#pragma unroll
                for (int bj = 0; bj < 2; ++bj) { const f32x4 v0 = acc[ai][bj][m][0], v1 = acc[ai][bj][m][1];
                    const u32x4 a = *(const u32x4*)(YA + (size_t)r * GWID + col0 + bj * HALFq);
                    float y[8] = {bflo(a.x), bfhi(a.x), bflo(a.y), bfhi(a.y), bflo(a.z), bfhi(a.z), bflo(a.w), bfhi(a.w)};
                    const float g[8] = {v0[0], v0[1], v0[2], v0[3], v1[0], v1[1], v1[2], v1[3]};
#pragma unroll
                    for (int k = 0; k < 8; ++k) y[k] = y[k] * sigmoidf_(g[k]);
                    u32x4 w; w.x = cvt_pk_bf16(y[0], y[1]); w.y = cvt_pk_bf16(y[2], y[3]); w.z = cvt_pk_bf16(y[4], y[5]); w.w = cvt_pk_bf16(y[6], y[7]);
                    *(u32x4*)(Y + (size_t)r * D + col0 + bj * HALFq) = w; } }
    }
};
struct EpiRes {
    static constexpr bool PERM = true, AFTER_DRAIN = false;
    const float* xp; const float* xs; float* X; const float* gate0; int first;
    int NEXT; bf16_t* XA; float* ssq; const float* gn; const float* scn0; PG8_LAS unsigned char* scr;
    __device__ __forceinline__ void operator()(const f32x4 (&acc)[2][2][4][2], const Unit& u, int wr, int wc, int fr, int fq) const {
        const int rowt = u.pm * BMq, col0 = u.pn * BMq + wc * 32 + 8 * fq;
        const int mrow = rowt < MC ? 0 : 1 + (rowt - MC) / 4096;
        const float* gate = gate0 + (size_t)mrow * (6 * D);
        const float* base = first ? (rowt < MC ? xp + (size_t)rowt * D : xs + (size_t)(rowt - MC) * D) : X + (size_t)rowt * D;
        float* outp = X + (size_t)rowt * D;
        float ss[2][4];
#pragma unroll
        for (int ai = 0; ai < 2; ++ai)
#pragma unroll
            for (int m = 0; m < 4; ++m) ss[ai][m] = 0.f;
#pragma unroll
        for (int bj = 0; bj < 2; ++bj) { const int c = col0 + bj * HALFq; const f32x4 g0 = *(const f32x4*)(gate + c), g1 = *(const f32x4*)(gate + c + 4);
            f32x4 a0 = (f32x4){0.f, 0.f, 0.f, 0.f}, a1 = a0;
            if (NEXT) { const float* scn = scn0 + (size_t)mrow * (6 * D); a0 = *(const f32x4*)(gn + c) * (*(const f32x4*)(scn + c) + 1.f); a1 = *(const f32x4*)(gn + c + 4) * (*(const f32x4*)(scn + c + 4) + 1.f); }
#pragma unroll
            for (int ai = 0; ai < 2; ++ai)
#pragma unroll
                for (int m = 0; m < 4; ++m) { const size_t off = (size_t)(wr * 64 + fr + ai * HALFq + m * 16) * D + c;
                    const f32x4 x0 = *(const f32x4*)(base + off) + g0 * acc[ai][bj][m][0], x1 = *(const f32x4*)(base + off + 4) + g1 * acc[ai][bj][m][1];
                    *(f32x4*)(outp + off) = x0; *(f32x4*)(outp + off + 4) = x1;
                    if (NEXT) { ss[ai][m] += (x0[0] * x0[0] + x0[1] * x0[1]) + (x0[2] * x0[2] + x0[3] * x0[3]) + (x1[0] * x1[0] + x1[1] * x1[1]) + (x1[2] * x1[2] + x1[3] * x1[3]);
                        const f32x4 y0 = x0 * a0, y1 = x1 * a1; u32x4 w; w.x = cvt_pk_bf16(y0[0], y0[1]); w.y = cvt_pk_bf16(y0[2], y0[3]); w.z = cvt_pk_bf16(y1[0], y1[1]); w.w = cvt_pk_bf16(y1[2], y1[3]);
                        *(u32x4*)(XA + (size_t)rowt * D + off) = w; } } }
        if (NEXT) {
            PG8_LAS float* P4 = (PG8_LAS float*)scr;
#pragma unroll
            for (int ai = 0; ai < 2; ++ai)
#pragma unroll
                for (int m = 0; m < 4; ++m) { float s = ss[ai][m]; s += __shfl_xor(s, 16); s += __shfl_xor(s, 32);
                    if (fq == 0) P4[(ai * HALFq + wr * 64 + m * 16 + fr) * 4 + wc] = s; }
            asm volatile("s_waitcnt lgkmcnt(0)\n\ts_barrier" ::: "memory");
            { const int tid = (wr * 4 + wc) * 64 + fq * 16 + fr;
              if (tid < 256) { const f32x4 p = *(const PG8_LAS f32x4*)(P4 + tid * 4); ssq[(size_t)(rowt + tid) * 8 + u.pn] = (p[0] + p[1]) + (p[2] + p[3]); } }
            asm volatile("s_waitcnt lgkmcnt(0)\n\ts_barrier" ::: "memory");
        }
    }
};
struct EpiRelu2 {
    static constexpr bool PERM = true, AFTER_DRAIN = false;
    bf16_t* O; const float* ssq; const float* shw0;
    __device__ __forceinline__ void operator()(const f32x4 (&acc)[2][2][4][2], const Unit& u, int wr, int wc, int fr, int fq) const {
        const int row0 = u.pm * BMq + wr * 64 + fr, col0 = u.pn * BMq + wc * 32 + 8 * fq, rowt = u.pm * BMq;
        const float* shw = shw0 + (size_t)(rowt < MC ? 0 : 1 + (rowt - MC) / 4096) * DFF + col0;
        f32x4 sh[2][2];
#pragma unroll
        for (int bj = 0; bj < 2; ++bj) { sh[bj][0] = *(const f32x4*)(shw + bj * HALFq); sh[bj][1] = *(const f32x4*)(shw + bj * HALFq + 4); }
#pragma unroll
        for (int ai = 0; ai < 2; ++ai)
#pragma unroll
            for (int m = 0; m < 4; ++m) { const int r = row0 + ai * HALFq + m * 16; bf16_t* rowp = O + (size_t)r * DFF + col0; const float rs = rstd_of(ssq, r);
#pragma unroll
                for (int bj = 0; bj < 2; ++bj) { f32x4 v0 = acc[ai][bj][m][0] * rs + sh[bj][0], v1 = acc[ai][bj][m][1] * rs + sh[bj][1];
#pragma unroll
                    for (int k = 0; k < 4; ++k) { const float a = fmaxf(v0[k], 0.f), b = fmaxf(v1[k], 0.f); v0[k] = a * a; v1[k] = b * b; }
                    u32x4 w; w.x = cvt_pk_bf16(v0[0], v0[1]); w.y = cvt_pk_bf16(v0[2], v0[3]); w.z = cvt_pk_bf16(v1[0], v1[1]); w.w = cvt_pk_bf16(v1[2], v1[3]);
                    *(u32x4*)(rowp + bj * HALFq) = w; } }
    }
};
}
__device__ __forceinline__ float logsigmoidf_(float x) { return fminf(x, 0.f) - __logf(1.f + __expf(-fabsf(x))); }
__device__ __forceinline__ float softplusf_(float x) { return fmaxf(x, 0.f) + __logf(1.f + __expf(-fabsf(x))); }
__device__ __forceinline__ void load_tile128(Frame& F, LAS unsigned char* dst, const bf16* src) {
#pragma unroll
    for (int it = 0; it < 4; ++it) { const int i = F.tid + NT * it, r = i >> 4, c = i & 15;
        *(LAS v4u*)(dst + r * LDT + c * 16) = *(const v4u*)(src + (size_t)r * NPROJ + c * 8); }
}
template <int NDST> __device__ __forceinline__ void load_qk(Frame& F, LAS unsigned char* dst0, LAS unsigned char* dst1, const bf16* src, const LAS float* w0, const LAS float* w1, float scale, bool rope, int tpos0) {
#pragma unroll
    for (int it = 0; it < 2; ++it) {
        const int i = F.tid + NT * it, r = i >> 3, c = i & 7;
        float x1[8], x2[8];
        unpack8(*(const v4u*)(src + (size_t)r * NPROJ + c * 8), x1); unpack8(*(const v4u*)(src + (size_t)r * NPROJ + 64 + c * 8), x2);
        if (rope) {
            const int tp = tpos0 + r, pos = c < 4 ? (tp >> 6) : (tp & 63);
            const f32x2* rt = WSP(const f32x2, WS_ROPE) + pos * 32 + ((8 * c) & 31);
#pragma unroll
            for (int j = 0; j < 8; ++j) { const f32x2 cs = rt[j]; const float a = x1[j], b = x2[j]; x1[j] = a * cs.x - b * cs.y; x2[j] = a * cs.y + b * cs.x; }
        }
        const float s0 = scale * (w0 ? w0[r] : 1.f);
        *(LAS v4u*)(dst0 + r * LDT + c * 16) = pack8(x1, s0); *(LAS v4u*)(dst0 + r * LDT + 128 + c * 16) = pack8(x2, s0);
        if (NDST == 2) { const float s1 = scale * w1[r];
            *(LAS v4u*)(dst1 + r * LDT + c * 16) = pack8(x1, s1); *(LAS v4u*)(dst1 + r * LDT + 128 + c * 16) = pack8(x2, s1); }
    }
}
template <int NDST> __device__ __forceinline__ void load_conv(Frame& F, KArgs& A, int l, LAS unsigned char* dst0, LAS unsigned char* dst1, int ldd, int ch0, int nc8, int row0, int seq_lo, int seq_hi,
                                                               const LAS float* w0, const LAS float* w1, bool to_global) {
    const bf16* P = WSP(const bf16, WS_PROJ) + PC_DX + ch0;
    const float* cw = INP(I_CONVW) + (size_t)l * 5 * 1024 + ch0; const float* cb = INP(I_CONVB) + (size_t)l * 1024 + ch0;
    for (int i = F.tid; i < 128 * nc8; i += NT) {
        const int r = i / nc8, c = i % nc8, row = row0 + r;
        float acc[8];
        { const f32x4 b0 = *(const f32x4*)(cb + 8 * c), b1 = *(const f32x4*)(cb + 8 * c + 4); acc[0] = b0.x; acc[1] = b0.y; acc[2] = b0.z; acc[3] = b0.w; acc[4] = b1.x; acc[5] = b1.y; acc[6] = b1.z; acc[7] = b1.w; }
#pragma unroll
        for (int k = 0; k < 5; ++k) { const int rr = row + k - 2;
            if (rr >= seq_lo && rr < seq_hi) { float x[8]; unpack8(*(const v4u*)(P + (size_t)rr * NPROJ + 8 * c), x);
                const f32x4 w0v = *(const f32x4*)(cw + k * 1024 + 8 * c), w1v = *(const f32x4*)(cw + k * 1024 + 8 * c + 4);
                acc[0] += x[0] * w0v.x; acc[1] += x[1] * w0v.y; acc[2] += x[2] * w0v.z; acc[3] += x[3] * w0v.w; acc[4] += x[4] * w1v.x; acc[5] += x[5] * w1v.y; acc[6] += x[6] * w1v.z; acc[7] += x[7] * w1v.w; } }
#pragma unroll
        for (int j = 0; j < 8; ++j) acc[j] = siluf_(acc[j]);
        if (to_global) *(v4u*)(WSP(bf16, WS_XBCC) + (size_t)row * 1024 + ch0 + 8 * c) = pack8(acc, 1.f);
        if (NDST >= 1) *(LAS v4u*)(dst0 + r * ldd + c * 16) = pack8(acc, w0 ? w0[r] : 1.f);
        if (NDST == 2) *(LAS v4u*)(dst1 + r * ldd + c * 16) = pack8(acc, w1[r]);
    }
}
__device__ __forceinline__ void load_xbcc(Frame& F, LAS unsigned char* dst, int ldd, int ch0, int nc8, int row0) {
    const bf16* P = WSP(const bf16, WS_XBCC) + (size_t)row0 * 1024 + ch0;
    for (int i = F.tid; i < 128 * nc8; i += NT) { const int r = i / nc8, c = i % nc8; *(LAS v4u*)(dst + r * ldd + c * 16) = *(const v4u*)(P + (size_t)r * 1024 + 8 * c); }
}
__device__ __forceinline__ void kv_state_mfma(Frame& F, const LAS unsigned char* TKf, const LAS unsigned char* TKb, const LAS unsigned char* TV, bf16* outF, bf16* outB) {
    const int dvb = F.wave >> 1, dkb0 = (F.wave & 1) * 2, hh = F.lane >> 5;
    f32x16 acc[2][2] = {{ZERO16, ZERO16}, {ZERO16, ZERO16}};
#pragma unroll 1
    for (int ks = 0; ks < 8; ++ks) {
        const bf16x8 a = frag_tr(TV, LDT, 16 * ks, 32 * dvb, F.lane);
#pragma unroll
        for (int j = 0; j < 2; ++j) { acc[0][j] = MFMA32(a, frag_tr(TKf, LDT, 16 * ks, 32 * (dkb0 + j), F.lane), acc[0][j]); acc[1][j] = MFMA32(a, frag_tr(TKb, LDT, 16 * ks, 32 * (dkb0 + j), F.lane), acc[1][j]); }
    }
#pragma unroll
    for (int j = 0; j < 2; ++j)
#pragma unroll
        for (int i = 0; i < 16; ++i) { const int o = (32 * dvb + crow(i, hh)) * 128 + 32 * (dkb0 + j) + (F.lane & 31); outF[o] = (bf16)f2bf(acc[0][j][i]); outB[o] = (bf16)f2bf(acc[1][j][i]); }
}
__device__ __forceinline__ void qkT_mfma(Frame& F, const LAS unsigned char* TQ, const LAS unsigned char* TK, f32x16 (&qk)[2]) {
    const int tb = F.wave >> 1, sb0 = (F.wave & 1) * 2;
    qk[0] = ZERO16; qk[1] = ZERO16;
#pragma unroll 1
    for (int ks = 0; ks < 8; ++ks) { const bf16x8 bq = frag_row(TQ, LDT, 32 * tb, 16 * ks, F.lane);
#pragma unroll
        for (int j = 0; j < 2; ++j) qk[j] = MFMA32(frag_row(TK, LDT, 32 * (sb0 + j), 16 * ks, F.lane), bq, qk[j]); }
}
__device__ __forceinline__ void pv_mfma(Frame& F, const LAS unsigned char* TP, const LAS unsigned char* TV, f32x16 (&o)[2]) {
    const int tb = F.wave >> 1, eb0 = (F.wave & 1) * 2;
#pragma unroll 1
    for (int ks = 0; ks < 8; ++ks) { const bf16x8 ap = frag_row(TP, LDT, 32 * tb, 16 * ks, F.lane);
#pragma unroll
        for (int j = 0; j < 2; ++j) o[j] = MFMA32(ap, frag_tr(TV, LDT, 16 * ks, 32 * (eb0 + j), F.lane), o[j]); }
}
__device__ __forceinline__ void qs_prefetch(Frame& F, const bf16* ST, bf16x8 (&b)[2][8]) {
    const int eb0 = (F.wave & 1) * 2, hh = F.lane >> 5;
#pragma unroll
    for (int j = 0; j < 2; ++j)
#pragma unroll
        for (int ks = 0; ks < 8; ++ks) b[j][ks] = *(const bf16x8*)(ST + (size_t)(32 * (eb0 + j) + (F.lane & 31)) * 128 + 16 * ks + 8 * hh);
}
__device__ __forceinline__ void qs_mfma(Frame& F, const LAS unsigned char* TQ, const bf16x8 (&b)[2][8], f32x16 (&o)[2]) {
    const int tb = F.wave >> 1;
#pragma unroll
    for (int ks = 0; ks < 8; ++ks) { const bf16x8 aq = frag_row(TQ, LDT, 32 * tb, 16 * ks, F.lane);
#pragma unroll
        for (int j = 0; j < 2; ++j) o[j] = MFMA32(aq, b[j][ks], o[j]); }
}
__device__ __forceinline__ void hs_to_lds(Frame& F, LAS unsigned char* HS, const f32x16 (&hs)[2]) {
    const int tb = F.wave >> 1, eb0 = (F.wave & 1) * 2, hh = F.lane >> 5;
#pragma unroll
    for (int j = 0; j < 2; ++j)
#pragma unroll
        for (int i = 0; i < 16; ++i) *(LAS float*)(HS + (32 * tb + crow(i, hh)) * 528 + (32 * (eb0 + j) + (F.lane & 31)) * 4) = hs[j][i];
}
template <int GATE> __device__ __forceinline__ void head_out(Frame& F, const LAS unsigned char* HS, const float* gain, const bf16* gsrc  , bf16* ydst  ) {
    const int t = F.tid >> 2, seg = F.tid & 3;
    float v[32]; float ss = 0.f;
#pragma unroll
    for (int k = 0; k < 8; ++k) { const f32x4 x = *(const LAS f32x4*)(HS + t * 528 + (32 * seg + 4 * k) * 4); v[4 * k] = x.x; v[4 * k + 1] = x.y; v[4 * k + 2] = x.z; v[4 * k + 3] = x.w; ss += (x.x * x.x + x.y * x.y) + (x.z * x.z + x.w * x.w); }
    ss += __shfl_xor(ss, 1); ss += __shfl_xor(ss, 2);
    const float r = rsqrtf(ss * (1.f / 128.f) + EPS);
#pragma unroll
    for (int k = 0; k < 4; ++k) { float g[8]; unpack8(*(const v4u*)(gsrc + (size_t)t * NPROJ + 32 * seg + 8 * k), g); float o[8];
#pragma unroll
        for (int j = 0; j < 8; ++j) { const float gg = GATE == 0 ? sigmoidf_(g[j]) : siluf_(g[j]); o[j] = v[8 * k + j] * r * gain[32 * seg + 8 * k + j] * gg; }
        *(v4u*)(ydst + (size_t)t * D + 32 * seg + 8 * k) = pack8(o, 1.f); }
}

__device__ __forceinline__ void mlstm_gates(Frame& F, KArgs& A, int l, int cp, int h) {
    if (F.tid < 128) { const float* g = WSP(const float, WS_GATES) + (size_t)(cp * 128 + F.tid) * 32;
        SCA(0)[F.tid] = g[h] + INP(I_MIB)[(l * 2 + 0) * 4 + h]; SCA(1)[F.tid] = g[4 + h] + INP(I_MIB)[(l * 2 + 1) * 4 + h];
        SCA(2)[F.tid] = logsigmoidf_(g[8 + h] + INP(I_MFB)[(l * 2 + 0) * 4 + h]); SCA(3)[F.tid] = logsigmoidf_(g[12 + h] + INP(I_MFB)[(l * 2 + 1) * 4 + h]); }
    BAR();
    if (F.wave == 0) wave_scan128<false>(SCA(2), SCA(4), F.lane, false, 0.f);
    if (F.wave == 1) wave_scan128<false>(SCA(3), SCA(5), F.lane, true, 0.f);
    BAR();
}
__device__ __forceinline__ void mlstm_local_item(Frame F, KArgs& A, int l, int cp, int h) {
    mlstm_gates(F, A, l, cp, h);
    if (F.wave < 2) { const int d = F.wave; const LAS float* bc = SCA(4 + d); const LAS float* ig = SCA(d); const float tot = d == 0 ? bc[127] : bc[0];
        const int s0 = 2 * F.lane; const float g0 = tot - bc[s0] + ig[s0], g1 = tot - bc[s0 + 1] + ig[s0 + 1];
        const float mx = wave_max(fmaxf(g0, g1));
        SCA(6 + d)[s0] = __expf(g0 - mx); SCA(6 + d)[s0 + 1] = __expf(g1 - mx);
        if (F.lane == 0) { float* sc = WSP(float, WS_MLSC) + ((cp * 2 + d) * 4 + h) * 2; sc[0] = tot; sc[1] = mx; } }
    BAR();
    const bf16* P = WSP(const bf16, WS_PROJ) + (size_t)cp * 128 * NPROJ;
    load_qk<2>(F, F.lds, F.lds + TS, P + PC_MK + h * 128, SCA(6), SCA(7), 0.08838834764831845f, false, 0);
    load_tile128(F, F.lds + 2 * TS, P + PC_MV + h * 128);
    BAR();
    kv_state_mfma(F, F.lds, F.lds + TS, F.lds + 2 * TS, WSP(bf16, WS_MLCLOC) + (size_t)((cp * 2 + 0) * 4 + h) * 16384, WSP(bf16, WS_MLCLOC) + (size_t)((cp * 2 + 1) * 4 + h) * 16384);
    if (F.tid < 256) { const int d = F.tid >> 7, dk = F.tid & 127; const LAS unsigned char* T = F.lds + d * TS; float s = 0.f;
        for (int r = 0; r < 128; ++r) s += bf2f(*(const LAS unsigned short*)(T + r * LDT + dk * 2));
        WSP(float, WS_MLNLOC)[((cp * 2 + d) * 4 + h) * 128 + dk] = s; }
    BAR();
}
__device__ __forceinline__ void mlstm_out_item(Frame F, KArgs& A, int l, int cp, int h) {
    const Seq sq = seq_of(cp);
    mlstm_gates(F, A, l, cp, h);
    const float min_f = WSP(const float, WS_MLMIN)[(cp * 2 + 0) * 4 + h], min_b = WSP(const float, WS_MLMIN)[(cp * 2 + 1) * 4 + h];
    if (F.tid < 256) { const int d = F.tid >> 7, s = F.tid & 127; SCA(6 + d)[s] = SCA(d)[s] - SCA(4 + d)[s]; }
    BAR();
    if (F.wave == 0) wave_scan128<true>(SCA(6), SCA(8), F.lane, false, min_f);
    if (F.wave == 1) wave_scan128<true>(SCA(7), SCA(9), F.lane, true, min_b);
    const bf16* P = WSP(const bf16, WS_PROJ) + (size_t)cp * 128 * NPROJ;
    LAS unsigned char* TQ = F.lds; LAS unsigned char* TK = F.lds + TS; LAS unsigned char* TV = F.lds + 2 * TS; LAS unsigned char* TP = F.lds + 3 * TS;
    load_tile128(F, TQ, P + PC_MQ + h * 128);
    load_qk<1>(F, TK, nullptr, P + PC_MK + h * 128, nullptr, nullptr, 0.08838834764831845f, false, 0);
    load_tile128(F, TV, P + PC_MV + h * 128);
    BAR();
    f32x16 hs[2] = {ZERO16, ZERO16};
    const int tb = F.wave >> 1, sb0 = (F.wave & 1) * 2, hh = F.lane >> 5, t = 32 * tb + (F.lane & 31);
#pragma unroll 1
    for (int d = 0; d < 2; ++d) {
        const LAS float* av = SCA(6 + d); const float Mt = SCA(8 + d)[t]; const float m_in = d == 0 ? min_f : min_b;
        if (F.tid < 128) SCA(12)[F.tid] = WSP(const float, WS_MLNIN)[((cp * 2 + d) * 4 + h) * 128 + F.tid];
        f32x16 qk[2]; qkT_mfma(F, TQ, TK, qk);
#pragma unroll
        for (int j = 0; j < 2; ++j)
#pragma unroll
            for (int i4 = 0; i4 < 4; ++i4) { const int sb = 32 * (sb0 + j) + 8 * i4 + 4 * hh; float p[4];
#pragma unroll
                for (int i = 0; i < 4; ++i) { const int s = sb + i; const bool ok = d == 0 ? (s <= t) : (s >= t); p[i] = ok ? qk[j][4 * i4 + i] * __expf(av[s] - Mt) : 0.f; }
                *(LAS u32x2*)(TP + t * LDT + sb * 2) = (u32x2){pk2(p[0], p[1]), pk2(p[2], p[3])}; }
        const bool has_state = sq.lat || (d == 0 ? sq.c > 0 : sq.c < sq.nch - 1);
        bf16x8 bst[2][8]; if (has_state) qs_prefetch(F, WSP(const bf16, WS_MLCIN) + (size_t)((cp * 2 + d) * 4 + h) * 16384, bst);
        BAR();
        if (F.tid < 128) { const int tt = F.tid; float ds = 0.f, qn = 0.f;
#pragma unroll 4
            for (int k = 0; k < 16; ++k) { float x[8]; unpack8(*(const LAS v4u*)(TP + tt * LDT + 16 * k), x); float q[8]; unpack8(*(const LAS v4u*)(TQ + tt * LDT + 16 * k), q);
#pragma unroll
                for (int j = 0; j < 8; ++j) { ds += x[j]; qn += q[j] * SCA(12)[8 * k + j]; } }
            const float Mtt = SCA(8 + d)[tt], wint = __expf(m_in - Mtt), den = ds + wint * qn, dd = fmaxf(fabsf(den), __expf(-(SCA(4 + d)[tt] + Mtt)));
            SCA(10)[tt] = wint / dd; SCA(11)[tt] = 1.f / dd; }
        { f32x16 num[2] = {ZERO16, ZERO16};
          pv_mfma(F, TP, TV, num);
          BAR();
#pragma unroll
          for (int j = 0; j < 2; ++j)
#pragma unroll
            for (int i = 0; i < 16; ++i) hs[j][i] += SCA(11)[32 * tb + crow(i, hh)] * num[j][i]; }
        if (has_state) { f32x16 qc[2] = {ZERO16, ZERO16};
          qs_mfma(F, TQ, bst, qc);
#pragma unroll
          for (int j = 0; j < 2; ++j)
#pragma unroll
            for (int i = 0; i < 16; ++i) hs[j][i] += SCA(10)[32 * tb + crow(i, hh)] * qc[j][i]; }
    }
    BAR();
    hs_to_lds(F, F.lds, hs);
    BAR();
    head_out<0>(F, F.lds, INP(I_MNORM) + (size_t)l * GWID + h * 128, P + PC_MO + h * 128, WSP(bf16, WS_Y) + (size_t)cp * 128 * D + 512 + h * 128);
    BAR();
}

__device__ __forceinline__ void ret_local_item(Frame F, KArgs& A, int l, int cp, int h) {
    const float lgf = -__expf(INP(I_RRATE)[(l * 2 + 0) * 4 + h]), lgb = -__expf(INP(I_RRATE)[(l * 2 + 1) * 4 + h]);
    if (F.tid < 128) { SCA(6)[F.tid] = __expf((127.f - (float)F.tid) * lgf); SCA(7)[F.tid] = __expf((float)F.tid * lgb); }
    BAR();
    const Seq sq = seq_of(cp);
    const bf16* P = WSP(const bf16, WS_PROJ) + (size_t)cp * 128 * NPROJ;
    load_qk<2>(F, F.lds, F.lds + TS, P + PC_RK + h * 128, SCA(6), SCA(7), 0.08838834764831845f, sq.lat != 0, sq.c * 128);
    load_tile128(F, F.lds + 2 * TS, P + PC_RV + h * 128);
    BAR();
    kv_state_mfma(F, F.lds, F.lds + TS, F.lds + 2 * TS, WSP(bf16, WS_RTLOC) + (size_t)((cp * 2 + 0) * 4 + h) * 16384, WSP(bf16, WS_RTLOC) + (size_t)((cp * 2 + 1) * 4 + h) * 16384);
    BAR();
}
__device__ __forceinline__ void ret_out_item(Frame F, KArgs& A, int l, int cp, int h) {
    const float lgf = -__expf(INP(I_RRATE)[(l * 2 + 0) * 4 + h]), lgb = -__expf(INP(I_RRATE)[(l * 2 + 1) * 4 + h]);
    if (F.tid < 128) { SCA(10)[F.tid] = __expf(((float)F.tid + 1.f) * lgf); SCA(11)[F.tid] = __expf((128.f - (float)F.tid) * lgb); }
    const Seq sq = seq_of(cp);
    const bf16* P = WSP(const bf16, WS_PROJ) + (size_t)cp * 128 * NPROJ;
    LAS unsigned char* TQ = F.lds; LAS unsigned char* TK = F.lds + TS; LAS unsigned char* TV = F.lds + 2 * TS; LAS unsigned char* TP = F.lds + 3 * TS;
    load_qk<1>(F, TQ, nullptr, P + PC_RQ + h * 128, nullptr, nullptr, 1.f, sq.lat != 0, sq.c * 128);
    load_qk<1>(F, TK, nullptr, P + PC_RK + h * 128, nullptr, nullptr, 0.08838834764831845f, sq.lat != 0, sq.c * 128);
    load_tile128(F, TV, P + PC_RV + h * 128);
    BAR();
    f32x16 qk[2]; qkT_mfma(F, TQ, TK, qk);
    const int tb = F.wave >> 1, sb0 = (F.wave & 1) * 2, hh = F.lane >> 5, t = 32 * tb + (F.lane & 31);
#pragma unroll
    for (int j = 0; j < 2; ++j)
#pragma unroll
        for (int i4 = 0; i4 < 4; ++i4) { const int sb = 32 * (sb0 + j) + 8 * i4 + 4 * hh; float p[4];
#pragma unroll
            for (int i = 0; i < 4; ++i) { const int s = sb + i; const float df = (float)(t - s);
                const float dm = (s <= t ? __expf(df * lgf) : 0.f) + (s >= t ? __expf(-df * lgb) : 0.f); p[i] = qk[j][4 * i4 + i] * dm; }
            *(LAS u32x2*)(TP + t * LDT + sb * 2) = (u32x2){pk2(p[0], p[1]), pk2(p[2], p[3])}; }
    BAR();
    f32x16 y[2] = {ZERO16, ZERO16};
    pv_mfma(F, TP, TV, y);
#pragma unroll 1
    for (int d = 0; d < 2; ++d) { f32x16 qs[2] = {ZERO16, ZERO16};
        if (!sq.lat && (d == 0 ? sq.c == 0 : sq.c == sq.nch - 1)) continue;
        bf16x8 bst[2][8]; qs_prefetch(F, WSP(const bf16, WS_RTIN) + (size_t)((cp * 2 + d) * 4 + h) * 16384, bst);
        qs_mfma(F, TQ, bst, qs);
#pragma unroll
        for (int j = 0; j < 2; ++j)
#pragma unroll
            for (int i = 0; i < 16; ++i) y[j][i] += SCA(10 + d)[32 * tb + crow(i, hh)] * qs[j][i]; }
    BAR();
    hs_to_lds(F, F.lds, y);
    BAR();
    head_out<1>(F, F.lds, INP(I_RNORM) + (size_t)l * GWID + h * 128, P + PC_RG + h * 128, WSP(bf16, WS_Y) + (size_t)cp * 128 * D + 1024 + h * 128);
    BAR();
}
template <bool WMODE> __device__ __forceinline__ float ssd_scalars(Frame& F, KArgs& A, int l, int cp, int g) {
    const int d = F.wave >> 2, rr = F.wave & 3, head = g * 4 + rr;
    const float bias = INP(I_DTB)[(l * 2 + d) * 8 + head], arate = -__expf(INP(I_ALOG)[(l * 2 + d) * 8 + head]);
    const float* gp = WSP(const float, WS_GATES) + (size_t)(cp * 128) * 32 + 16 + d * 8 + head;
    const int i0 = d ? 127 - 2 * F.lane : 2 * F.lane, i1 = d ? i0 - 1 : i0 + 1;
    const float dt0 = softplusf_(gp[(size_t)i0 * 32] + bias), dt1 = softplusf_(gp[(size_t)i1 * 32] + bias);
    const float a0 = dt0 * arate, a1 = dt1 * arate;
    float inc = a0 + a1;
#pragma unroll
    for (int o = 1; o < 64; o <<= 1) { const float t = __shfl_up(inc, o); if (F.lane >= o) inc += t; }
    const float c1 = inc, c0 = inc - a1, tot = __shfl(inc, 63);
    LAS float* cum = SCA(16 + d * 4 + rr); LAS float* dtw = SCA(24 + d * 4 + rr);
    cum[i0] = c0; cum[i1] = c1;
    if (WMODE) { dtw[i0] = __expf(tot - c0) * dt0; dtw[i1] = __expf(tot - c1) * dt1; } else { dtw[i0] = dt0; dtw[i1] = dt1; }
    return tot;
}
__device__ __forceinline__ void seq_bounds(int cp, int& lo, int& hi) { if (cp < 64) { lo = (cp >> 1) * 256; hi = lo + 256; } else { lo = MC + ((cp - 64) >> 5) * 4096; hi = lo + 4096; } }
__device__ __forceinline__ void ssd_local_item(Frame F, KArgs& A, int l, int cp, int g) {
    const float tot = ssd_scalars<true>(F, A, l, cp, g);
    if (F.lane == 0) WSP(float, WS_SDSC)[(cp * 2 + (F.wave >> 2)) * 8 + g * 4 + (F.wave & 3)] = tot;
    int lo, hi; seq_bounds(cp, lo, hi);
    LAS unsigned char* TB = F.lds;
    load_conv<1>(F, A, l, TB, nullptr, LDT, 512 + g * 128, 16, cp * 128, lo, hi, nullptr, nullptr, true);
    load_conv<0>(F, A, l, nullptr, nullptr, LDT, 768 + g * 128, 16, cp * 128, lo, hi, nullptr, nullptr, true);
    BAR();
#pragma unroll 1
    for (int hr = 0; hr < 2; ++hr) {
#pragma unroll 1
        for (int r2 = 0; r2 < 2; ++r2) { const int rr = hr * 2 + r2;
            load_conv<2>(F, A, l, F.lds + TS + (r2 * 2 + 0) * TSX, F.lds + TS + (r2 * 2 + 1) * TSX, LDX, g * 256 + rr * 64, 8, cp * 128, lo, hi, SCA(24 + 0 * 4 + rr), SCA(24 + 1 * 4 + rr), true); }
        BAR();
        const int r2 = F.wave >> 2, d = (F.wave >> 1) & 1, pb = F.wave & 1, hh = F.lane >> 5, head = g * 4 + hr * 2 + r2;
        const LAS unsigned char* TX = F.lds + TS + (r2 * 2 + d) * TSX;
        f32x16 acc[4] = {ZERO16, ZERO16, ZERO16, ZERO16};
#pragma unroll 1
        for (int ks = 0; ks < 8; ++ks) { const bf16x8 a = frag_tr(TX, LDX, 16 * ks, 32 * pb, F.lane);
#pragma unroll
            for (int nb = 0; nb < 4; ++nb) acc[nb] = MFMA32(a, frag_tr(TB, LDT, 16 * ks, 32 * nb, F.lane), acc[nb]); }
        bf16* o = WSP(bf16, WS_SDLOC) + (size_t)((cp * 2 + d) * 8 + head) * 8192;
#pragma unroll
        for (int nb = 0; nb < 4; ++nb)
#pragma unroll
            for (int i = 0; i < 16; ++i) o[(32 * pb + crow(i, hh)) * 128 + 32 * nb + (F.lane & 31)] = (bf16)f2bf(acc[nb][i]);
        BAR();
    }
}
__device__ __forceinline__ void ssd_out_item(Frame F, KArgs& A, int l, int cp, bf16* Ybase) {
    const Seq sq = seq_of(cp);
    LAS unsigned char* TC = F.lds; LAS unsigned char* TB = F.lds + TS; LAS unsigned char* TP = F.lds + 2 * TS; LAS unsigned char* TX = F.lds + 3 * TS;
    LAS float* SSQ = SCA(14);
    if (F.tid < 128) SSQ[F.tid] = 0.f;
    const int tb = F.wave >> 1, sb0 = (F.wave & 1) * 2, pb = F.wave & 1, hh = F.lane >> 5, t = 32 * tb + (F.lane & 31);
    const bf16* Pz = WSP(const bf16, WS_PROJ) + (size_t)cp * 128 * NPROJ + PC_DZ;
    bf16* Yd = Ybase + (size_t)cp * 128 * D + 1536;
#pragma unroll 1
    for (int g = 0; g < 2; ++g) {
        (void)ssd_scalars<false>(F, A, l, cp, g);
        load_xbcc(F, TC, LDT, 768 + g * 128, 16, cp * 128);
        load_xbcc(F, TB, LDT, 512 + g * 128, 16, cp * 128);
        BAR();
        f32x16 cb[2] = {ZERO16, ZERO16};
#pragma unroll 1
        for (int ks = 0; ks < 8; ++ks) { const bf16x8 bq = frag_row(TC, LDT, 32 * tb, 16 * ks, F.lane);
#pragma unroll
            for (int j = 0; j < 2; ++j) cb[j] = MFMA32(frag_row(TB, LDT, 32 * (sb0 + j), 16 * ks, F.lane), bq, cb[j]); }
#pragma unroll 1
        for (int rr = 0; rr < 4; ++rr) {
            const int head = g * 4 + rr;
            load_xbcc(F, TX, LDX, g * 256 + rr * 64, 8, cp * 128);
            f32x16 y = ZERO16;
#pragma unroll 1
            for (int d = 0; d < 2; ++d) {
                const LAS float* cum = SCA(16 + d * 4 + rr); const LAS float* dtv = SCA(24 + d * 4 + rr); const float ct = cum[t];
#pragma unroll
                for (int j = 0; j < 2; ++j)
#pragma unroll
                    for (int i4 = 0; i4 < 4; ++i4) { const int sb = 32 * (sb0 + j) + 8 * i4 + 4 * hh; float p[4];
#pragma unroll
                        for (int i = 0; i < 4; ++i) { const int s = sb + i; const bool ok = d == 0 ? (s <= t) : (s >= t); p[i] = ok ? cb[j][4 * i4 + i] * __expf(ct - cum[s]) * dtv[s] : 0.f; }
                        *(LAS u32x2*)(TP + t * LDT + sb * 2) = (u32x2){pk2(p[0], p[1]), pk2(p[2], p[3])}; }
                const bool has_state = sq.lat || (d == 0 ? sq.c > 0 : sq.c < sq.nch - 1);
                bf16x8 bh[8];
                if (has_state) { const bf16* hin = WSP(const bf16, WS_SDIN) + (size_t)((cp * 2 + d) * 8 + head) * 8192;
#pragma unroll
                  for (int ks = 0; ks < 8; ++ks) bh[ks] = *(const bf16x8*)(hin + (size_t)(32 * pb + (F.lane & 31)) * 128 + 16 * ks + 8 * hh); }
                BAR();
                f32x16 pv = ZERO16, ch = ZERO16;
#pragma unroll 2
                for (int ks = 0; ks < 8; ++ks)
                    pv = MFMA32(frag_row(TP, LDT, 32 * tb, 16 * ks, F.lane), frag_tr(TX, LDX, 16 * ks, 32 * pb, F.lane), pv);
                if (has_state) {
#pragma unroll
                    for (int ks = 0; ks < 8; ++ks) ch = MFMA32(frag_row(TC, LDT, 32 * tb, 16 * ks, F.lane), bh[ks], ch); }
#pragma unroll
                for (int i = 0; i < 16; ++i) y[i] += pv[i] + __expf(cum[32 * tb + crow(i, hh)]) * ch[i];
                BAR();
            }
#pragma unroll
            for (int i = 0; i < 16; ++i) *(LAS float*)(TP + (32 * tb + crow(i, hh)) * LDT + (32 * pb + (F.lane & 31)) * 4) = y[i];
            BAR();
            { const int tt = F.tid >> 2, seg = F.tid & 3; const float Dh = INP(I_SSDD)[l * 8 + head];
                float z[16], x[16], o[16]; float ss = 0.f;
                { float t8[8]; unpack8(*(const v4u*)(Pz + (size_t)tt * NPROJ + head * 64 + 16 * seg), t8); for (int j = 0; j < 8; ++j) z[j] = t8[j];
                  unpack8(*(const v4u*)(Pz + (size_t)tt * NPROJ + head * 64 + 16 * seg + 8), t8); for (int j = 0; j < 8; ++j) z[8 + j] = t8[j];
                  unpack8(*(const LAS v4u*)(TX + tt * LDX + 32 * seg), t8); for (int j = 0; j < 8; ++j) x[j] = t8[j];
                  unpack8(*(const LAS v4u*)(TX + tt * LDX + 32 * seg + 16), t8); for (int j = 0; j < 8; ++j) x[8 + j] = t8[j]; }
#pragma unroll
                for (int k = 0; k < 4; ++k) { const f32x4 yv = *(const LAS f32x4*)(TP + tt * LDT + (16 * seg + 4 * k) * 4);
                    const float yy[4] = {yv.x, yv.y, yv.z, yv.w};
#pragma unroll
                    for (int j = 0; j < 4; ++j) { const float v = (yy[j] + Dh * x[4 * k + j]) * siluf_(z[4 * k + j]); o[4 * k + j] = v; ss += v * v; } }
                ss += __shfl_xor(ss, 1); ss += __shfl_xor(ss, 2);
                if (seg == 0) SSQ[tt] += ss;
                float o0[8], o1[8];
#pragma unroll
                for (int j = 0; j < 8; ++j) { o0[j] = o[j]; o1[j] = o[8 + j]; }
                *(v4u*)(Yd + (size_t)tt * D + head * 64 + 16 * seg) = pack8(o0, 1.f); *(v4u*)(Yd + (size_t)tt * D + head * 64 + 16 * seg + 8) = pack8(o1, 1.f); }
            BAR();
        }
    }
    __builtin_amdgcn_fence(__ATOMIC_RELEASE, "workgroup"); asm volatile("s_waitcnt vmcnt(0)" ::: "memory"); __syncthreads(); __builtin_amdgcn_fence(__ATOMIC_ACQUIRE, "workgroup");
    { const int tt = F.tid >> 2, seg = F.tid & 3; const float r = rsqrtf(SSQ[tt] * (1.f / 512.f) + EPS); const float* gn = INP(I_SNORM) + (size_t)l * GWID + 128 * seg;
#pragma unroll 4
        for (int k = 0; k < 16; ++k) { bf16* p = Yd + (size_t)tt * D + 128 * seg + 8 * k; float v[8];
            unpack8(__builtin_nontemporal_load((const v4u*)p), v);
#pragma unroll
            for (int j = 0; j < 8; ++j) v[j] = v[j] * r * gn[8 * k + j];
            *(v4u*)p = pack8(v, 1.f); } }
    BAR();
}
template <int PASS> __device__ __forceinline__ void s5_item(Frame F, KArgs& A, int l, int cp, int gq) {
    const Seq sq = seq_of(cp);
    const int g = gq * 8 + F.wave, p = F.lane, hh = F.lane >> 5;
    LAS unsigned char* TU = F.lds; LAS unsigned char* BU = F.lds + TS + F.wave * 8704;
    load_tile128(F, TU, WSP(const bf16, WS_PROJ) + (size_t)cp * 128 * NPROJ + PC_S5U + gq * 128);
    BAR();
    typedef float f32x4v __attribute__((ext_vector_type(4)));
    f32x4v yacc[4][2];
    if (PASS == 1) {
#pragma unroll
        for (int a = 0; a < 4; ++a) { yacc[a][0] = (f32x4v){0.f, 0.f, 0.f, 0.f}; yacc[a][1] = (f32x4v){0.f, 0.f, 0.f, 0.f}; } }
#pragma unroll 1
    for (int d = 0; d < 2; ++d) {
        const unsigned char* tab = s5tab(F, l, d, g);
        const float lr = ((const float*)tab)[2 * p], li = ((const float*)tab)[2 * p + 1];
        float hr = 0.f, hi = 0.f;
        if (PASS == 1) {
            if (sq.lat) { const size_t o = (size_t)(((sq.b * 4 + l) * 2 + d) * 32 + g) * 64 + p; hr = INP(I_SS5R)[o]; hi = INP(I_SS5I)[o]; }
            const float l8r = ((const float*)(tab + 512))[2 * p], l8i = ((const float*)(tab + 512))[2 * p + 1];
            const int n = d == 0 ? sq.c : sq.nch - 1 - sq.c;
            for (int k0 = 0; k0 < n; k0 += 8) {
                f32x2 e[8];
#pragma unroll
                for (int j = 0; j < 8; ++j) { const int k = (k0 + j < n) ? k0 + j : n - 1, cc = d == 0 ? k : sq.nch - 1 - k;
                    e[j] = *(const f32x2*)(WSP(const float, WS_S5LOC) + ((size_t)(((sq.cp0 + cc) * 2 + d) * 32 + g) * 64 + p) * 2); }
#pragma unroll
                for (int j = 0; j < 8; ++j) if (k0 + j < n) { const float nr = l8r * hr - l8i * hi + e[j].x, ni = l8r * hi + l8i * hr + e[j].y; hr = nr; hi = ni; }
            }
        }
        const bf16* bb = (const bf16*)(tab + 1024); const bf16* ct = (const bf16*)(tab + 5120);
        typedef short v8s __attribute__((ext_vector_type(8)));
        const int r16 = F.lane & 15, g4 = F.lane >> 4;
        bf16x8 bbf[4]; v8s ctf[4];
#pragma unroll
        for (int nb = 0; nb < 4; ++nb) bbf[nb] = *(const bf16x8*)(bb + (size_t)(32 * nb + (F.lane & 31)) * 16 + 8 * hh);
        if (PASS == 1) {
#pragma unroll
            for (int ks = 0; ks < 4; ++ks) ctf[ks] = *(const v8s*)(ct + r16 * 128 + 32 * ks + 8 * g4); }
#pragma unroll 1
        for (int tbi = 0; tbi < 4; ++tbi) {
            const int tb = d == 0 ? tbi : 3 - tbi;
            const bf16x8 bu = frag_row(TU, LDT, 32 * tb, 16 * F.wave, F.lane);
#pragma unroll
            for (int nb = 0; nb < 4; ++nb) {
                const f32x16 acc = MFMA32(bbf[nb], bu, ZERO16);
#pragma unroll
                for (int i4 = 0; i4 < 4; ++i4) *(LAS u32x2*)(BU + (F.lane & 31) * LDT + (32 * nb + 8 * i4 + 4 * hh) * 2) = (u32x2){pk2(acc[4 * i4], acc[4 * i4 + 1]), pk2(acc[4 * i4 + 2], acc[4 * i4 + 3])};
            }
            asm volatile("s_waitcnt lgkmcnt(0)" ::: "memory");
            unsigned w[32];
#pragma unroll
            for (int st = 0; st < 32; ++st) { const int tl = d == 0 ? st : 31 - st; w[st] = *(const LAS unsigned*)(BU + tl * LDT + p * 4); }
#pragma unroll
            for (int st = 0; st < 32; ++st) { const float br = bflo(w[st]), bi = bfhi(w[st]);
                const float nr = lr * hr - li * hi + br, ni = lr * hi + li * hr + bi; hr = nr; hi = ni;
                if (PASS == 1) w[st] = pk2(hr, hi); }
            if (PASS == 1) {
#pragma unroll
                for (int st = 0; st < 32; ++st) { const int tl = d == 0 ? st : 31 - st; *(LAS unsigned*)(BU + tl * LDT + p * 4) = w[st]; }
                asm volatile("s_waitcnt lgkmcnt(0)" ::: "memory");
                f32x4v y0 = (f32x4v){0.f, 0.f, 0.f, 0.f}, y1 = y0;
#pragma unroll
                for (int ks = 0; ks < 4; ++ks) {
                    y0 = __builtin_amdgcn_mfma_f32_16x16x32_bf16(*(const LAS v8s*)(BU + r16 * LDT + (32 * ks + 8 * g4) * 2), ctf[ks], y0, 0, 0, 0);
                    y1 = __builtin_amdgcn_mfma_f32_16x16x32_bf16(*(const LAS v8s*)(BU + (16 + r16) * LDT + (32 * ks + 8 * g4) * 2), ctf[ks], y1, 0, 0, 0); }
                if (tb == 0) { yacc[0][0] += y0; yacc[0][1] += y1; } else if (tb == 1) { yacc[1][0] += y0; yacc[1][1] += y1; } else if (tb == 2) { yacc[2][0] += y0; yacc[2][1] += y1; } else { yacc[3][0] += y0; yacc[3][1] += y1; }
                asm volatile("s_waitcnt lgkmcnt(0)" ::: "memory");
            }
        }
        if (PASS == 0) { *(f32x2*)(WSP(float, WS_S5LOC) + ((size_t)((cp * 2 + d) * 32 + g) * 64 + p) * 2) = (f32x2){hr, hi}; }
        else if (!sq.lat && ((d == 0 && sq.c == sq.nch - 1) || (d == 1 && sq.c == 0))) { const size_t o = (size_t)(((sq.b * 4 + l) * 2 + d) * 32 + g) * 64 + p; F.out[O_S5R + o] = hr; F.out[O_S5I + o] = hi; }
    }
    if (PASS == 1) {
        const int r16 = F.lane & 15, g4 = F.lane >> 4; const float Dc = INP(I_S5D)[(size_t)l * GWID + g * 16 + r16];
#pragma unroll
        for (int tb = 0; tb < 4; ++tb)
#pragma unroll
            for (int ts = 0; ts < 2; ++ts)
#pragma unroll
                for (int i = 0; i < 4; ++i) { const int t = 32 * tb + 16 * ts + 4 * g4 + i; LAS unsigned short* up = (LAS unsigned short*)(TU + t * LDT + (16 * F.wave + r16) * 2);
                    const float x = yacc[tb][ts][i] + Dc * bf2f(*up);
                    const float u2 = 1.5957691216057308f * (x + 0.044715f * x * x * x); const float ge = x - x / (1.f + __expf(u2));
                    *up = (unsigned short)f2bf(ge); }
        BAR();
        bf16* ya = WSP(bf16, WS_YA) + (size_t)cp * 128 * GWID + gq * 128;
#pragma unroll
        for (int it = 0; it < 4; ++it) { const int i = F.tid + NT * it, r = i >> 4, c = i & 15; *(v4u*)(ya + (size_t)r * GWID + c * 8) = *(const LAS v4u*)(TU + r * LDT + c * 16); }
    }
    BAR();
}

template <bool LAT> __device__ __forceinline__ void carry_unit(Frame F, KArgs& A, int l, int u) {
    const int sd = u / 96, rem = u % 96, sidx = sd >> 1, d = sd & 1;
    constexpr int lat = LAT ? 1 : 0, nch = LAT ? 32 : 2, NB = LAT ? 8 : 2;
    const int b = LAT ? sidx : sidx - 4, cp0 = LAT ? 64 + 32 * b : 2 * b;
    int type, head, slice;
    if (rem < 32) { type = 0; head = rem >> 3; slice = rem & 7; } else if (rem < 64) { type = 1; head = (rem - 32) >> 3; slice = (rem - 32) & 7; } else { type = 2; head = (rem - 64) >> 2; slice = (rem - 64) & 3; }
    const int e0 = slice * 2048 + F.tid * 4;
    const int nh = type == 2 ? 8 : 4, esz = type == 2 ? 8192 : 16384;
    const bf16* loc = type == 0 ? WSP(const bf16, WS_MLCLOC) : (type == 1 ? WSP(const bf16, WS_RTLOC) : WSP(const bf16, WS_SDLOC));
    bf16* inb = type == 0 ? WSP(bf16, WS_MLCIN) : (type == 1 ? WSP(bf16, WS_RTIN) : WSP(bf16, WS_SDIN));
    float zf = 0.f; asm volatile("" : "+v"(zf));
    float v[4] = {zf, zf, zf, zf}, nv[4] = {zf, zf, zf, zf}, m = 0.f;
    const bool do_n = (type == 0 && slice == 0 && F.tid < 32);
    if (LAT) {
        if (type == 2) { const f32x4 s = *(const f32x4*)(INP(I_SSSD) + (size_t)(((b * 4 + l) * 2 + d) * 8 + head) * 8192 + e0); v[0] = s.x; v[1] = s.y; v[2] = s.z; v[3] = s.w; }
        else { const float* s = (type == 0 ? INP(I_SMC) : INP(I_SRET)) + (size_t)(((b * 4 + l) * 2 + d) * 4 + head) * 16384; const int dv = e0 >> 7, dk = e0 & 127;
#pragma unroll
            for (int j = 0; j < 4; ++j) v[j] = s[(dk + j) * 128 + dv]; }
        if (type == 0) { m = INP(I_SMM)[((b * 4 + l) * 2 + d) * 4 + head];
            if (do_n) { const f32x4 s = *(const f32x4*)(INP(I_SMN) + (size_t)(((b * 4 + l) * 2 + d) * 4 + head) * 128 + F.tid * 4); nv[0] = s.x; nv[1] = s.y; nv[2] = s.z; nv[3] = s.w; } }
    }
    const float rdec = type == 1 ? __expf(-128.f * __expf(INP(I_RRATE)[(l * 2 + d) * 4 + head])) : 1.f;
#pragma unroll 1
    for (int ci0 = 0; ci0 < nch; ci0 += NB) {
        u32x2 lc[NB]; f32x4 ln[NB]; float s0[NB], s1[NB];
#pragma unroll
        for (int j = 0; j < NB; ++j) { ln[j] = (f32x4){zf, zf, zf, zf}; s0[j] = zf; s1[j] = zf; }
#pragma unroll
        for (int j = 0; j < NB; ++j) {
            const int ci = ci0 + j, cp = cp0 + (d == 0 ? ci : nch - 1 - ci);
            lc[j] = *(const u32x2*)(loc + (size_t)((cp * 2 + d) * nh + head) * esz + e0);
            if (type == 0) { const float* sc = WSP(const float, WS_MLSC) + ((cp * 2 + d) * 4 + head) * 2; s0[j] = sc[0]; s1[j] = sc[1];
                if (do_n) ln[j] = *(const f32x4*)(WSP(const float, WS_MLNLOC) + ((cp * 2 + d) * 4 + head) * 128 + F.tid * 4); }
            else if (type == 2) s0[j] = WSP(const float, WS_SDSC)[(cp * 2 + d) * 8 + head];
        }
#pragma unroll
        for (int j = 0; j < NB; ++j) {
            const int ci = ci0 + j, cp = cp0 + (d == 0 ? ci : nch - 1 - ci);
            const size_t so = (size_t)((cp * 2 + d) * nh + head) * esz + e0;
            if (LAT || ci > 0) *(u32x2*)(inb + so) = (u32x2){pk2(v[0], v[1]), pk2(v[2], v[3])};
            float dec, wl = 1.f;
            if (type == 0) {
                const float Bt = s0[j], ml = s1[j];
                if (slice == 0 && F.tid == 0) WSP(float, WS_MLMIN)[(cp * 2 + d) * 4 + head] = m;
                if (do_n) *(f32x4*)(WSP(float, WS_MLNIN) + ((cp * 2 + d) * 4 + head) * 128 + F.tid * 4) = (f32x4){nv[0], nv[1], nv[2], nv[3]};
                const float mn = fmaxf(Bt + m, ml); dec = __expf(Bt + m - mn); wl = __expf(ml - mn); m = mn;
                if (do_n) { nv[0] = dec * nv[0] + wl * ln[j].x; nv[1] = dec * nv[1] + wl * ln[j].y; nv[2] = dec * nv[2] + wl * ln[j].z; nv[3] = dec * nv[3] + wl * ln[j].w; }
            } else if (type == 1) dec = rdec;
            else dec = __expf(s0[j]);
            v[0] = dec * v[0] + wl * bflo(lc[j].x); v[1] = dec * v[1] + wl * bfhi(lc[j].x); v[2] = dec * v[2] + wl * bflo(lc[j].y); v[3] = dec * v[3] + wl * bfhi(lc[j].y);
        }
    }
    if (!lat) {
        if (type == 2) *(f32x4*)(F.out + O_SSD + (size_t)(((b * 4 + l) * 2 + d) * 8 + head) * 8192 + e0) = (f32x4){v[0], v[1], v[2], v[3]};
        else {
            LAS float* tr = (LAS float*)F.lds;
            const int dvl = F.tid >> 5, dk = (F.tid & 31) * 4;
#pragma unroll
            for (int j = 0; j < 4; ++j) tr[dvl * 129 + dk + j] = v[j];
            BAR();
            const int dk2 = F.tid >> 2, q = F.tid & 3;
            float* o = F.out + (type == 0 ? O_MC : O_RET) + (size_t)(((b * 4 + l) * 2 + d) * 4 + head) * 16384 + (size_t)dk2 * 128 + slice * 16 + 4 * q;
            *(f32x4*)o = (f32x4){tr[(4 * q) * 129 + dk2], tr[(4 * q + 1) * 129 + dk2], tr[(4 * q + 2) * 129 + dk2], tr[(4 * q + 3) * 129 + dk2]};
            if (type == 0) { if (do_n) *(f32x4*)(F.out + O_MN + (size_t)(((b * 4 + l) * 2 + d) * 4 + head) * 128 + F.tid * 4) = (f32x4){nv[0], nv[1], nv[2], nv[3]};
                if (slice == 0 && F.tid == 0) F.out[O_MM + ((b * 4 + l) * 2 + d) * 4 + head] = m; }
            BAR();
        }
    }
}
constexpr int CW_Q = 16384;
struct OneUnit { pg8::Unit u; __device__ __forceinline__ bool next(int i, pg8::Unit& o) const { if (i) return false; o = u; return true; }
    __device__ __forceinline__ void a_ready(const pg8::Unit&) const {} __device__ __forceinline__ void done(const pg8::Unit&) const {} };
#define QUEUE_LOOP(F0_, qidx, total, ...) do { \
    unsigned* qc_ = (unsigned*)(F0_.ws + WS_CTL) + CW_Q + 64 * (qidx); volatile LAS int* qs_ = (volatile LAS int*)(F0_.lds + MISC_OFF + 64); \
    if (F0_.tid == 0) qs_[0] = (int)__hip_atomic_fetch_add(qc_, 1u, __ATOMIC_RELAXED, __HIP_MEMORY_SCOPE_AGENT); \
    __syncthreads(); \
    int it = qs_[0], par_ = 1; \
    while (it < (total)) { \
        int nx_ = 0; if (F0_.tid == 0) nx_ = (int)__hip_atomic_fetch_add(qc_, 1u, __ATOMIC_RELAXED, __HIP_MEMORY_SCOPE_AGENT); \
        { __VA_ARGS__ } \
        if (F0_.tid == 0) qs_[par_] = nx_; \
        __syncthreads(); \
        it = qs_[par_]; par_ ^= 1; \
    } } while (0)
#ifndef PROBE_ITEM
#define PROBE_ITEM -1
#endif
#define PR(t) (PROBE_ITEM == (t) ? 2 : 1)
#define QSPLIT(NT_, C0, C1, C2, C3, T0) int ty_ = 0, loc_ = it, dup_ = 0; { const int cnt_[4] = {C0, C1, C2, C3}; \
    _Pragma("unroll") for (int j_ = 0; j_ < NT_; ++j_) { const int span_ = cnt_[j_] * PR(T0 + j_); if (ty_ == j_) { if (loc_ >= span_) { loc_ -= span_; ty_ = j_ + 1; } else { dup_ = loc_ / cnt_[j_]; loc_ = loc_ % cnt_[j_]; } } } }
#ifndef PROBE_REPEAT
#define PROBE_REPEAT -1
#endif
constexpr int N_PHASES = 2 + 9 * NLAYER;
__global__ void __launch_bounds__(NT, 2) hymba_fwd(Args A) {
    extern __shared__ __attribute__((aligned(16))) unsigned char lds_raw[];
    Frame F0;
    F0.lds = (LAS unsigned char*)lds_raw;
    F0.tid = threadIdx.x; F0.lane = 0; F0.wave = __builtin_amdgcn_readfirstlane(F0.tid >> 6);
    F0.G = gridDim.x; F0.bid = blockIdx.x; F0.out = A.out; F0.ws = A.ws;
    volatile LAS unsigned* MISC = (volatile LAS unsigned*)(F0.lds + MISC_OFF);
    if (F0.tid < 64) MISC[F0.tid] = 0u;
    __syncthreads();
    unsigned* barw = (unsigned*)(F0.ws + WS_CTL) + CW_BAR;
    XcdBarrier bar = xcd_barrier_post(barw, MISC + 8);
    const int lo = A.ph_lo, hi = A.ph_hi;
#define KA (*kargs())
#define IN(k) (lo <= (k) && (k) < hi)
#define SEAM(k) do { if (IN(k) && IN((k) + 1)) xcd_barrier(bar); } while (0)

    if (IN(0)) for (int rep_ = 0; rep_ < (PROBE_REPEAT == 100 ? 2 : 1); ++rep_) { Frame F = fresh(F0); p0_prologue(F, KA); } SEAM(0);

#pragma unroll 1
    for (int l = 0; l < NLAYER; ++l) {
        const int pb = 1 + 9 * l;
        if (l == 0) { if (IN(pb + 0)) { Frame F = fresh(F0); norm0_phase(F, KA); shw_phase(F); } SEAM(pb + 0); }
        if (IN(pb + 1)) for (int rep_ = 0; rep_ < (PROBE_REPEAT == 1 ? 2 : 1); ++rep_) { Frame F = fresh(F0);
            pg8::Gemm g{WSP(const pg8::bf16_t, WS_H), WSP(const pg8::bf16_t, WS_W1T) + (size_t)l * NPAD * D, M, NPAD, D}; pg8::StaticOrder S; S.init(M, NPAD, F.G, F.bid);
            epi::EpiProj E{WSP(pg8::bf16_t, WS_PROJ), WSP(float, WS_GATES), WSP(const float, WS_SSQB), WSP(const float, WS_SHW1) + (size_t)l * 5 * NPAD};
            pg8::gemm_phase<epi::EpiProj, pg8::StaticOrder, true, true>(F.lds, g, S, E);
        } SEAM(pb + 1);
        if (IN(pb + 2)) { Frame F = fresh(F0);
            QUEUE_LOOP(F, l * 3 + 0, 384 * PR(0) + 768 * PR(1) + 768 * PR(2) + 768 * PR(3), {
                QSPLIT(4, 384, 768, 768, 768, 0);
                if (ty_ == 0) ssd_local_item(fresh(F), KA, l, loc_ >> 1, loc_ & 1);
                else if (ty_ == 1) mlstm_local_item(fresh(F), KA, l, loc_ >> 2, loc_ & 3);
                else if (ty_ == 2) ret_local_item(fresh(F), KA, l, loc_ >> 2, loc_ & 3);
                else s5_item<0>(fresh(F), KA, l, loc_ >> 2, loc_ & 3);
            });
        } SEAM(pb + 2);
        if (IN(pb + 3)) { Frame F = fresh(F0);
            QUEUE_LOOP(F, l * 3 + 1, 768 * PR(4) + 768 * PR(5) + 768 * PR(6), {
                QSPLIT(3, 768, 768, 768, 0, 4);
                if (ty_ == 0) carry_unit<true>(fresh(F), KA, l, loc_);
                else if (ty_ == 1) s5_item<1>(fresh(F), KA, l, loc_ >> 2, loc_ & 3);
                else { for (int j = 0; j < 8; ++j) carry_unit<false>(fresh(F), KA, l, 768 + loc_ * 8 + j); }
            });
        } SEAM(pb + 3);
        if (IN(pb + 4)) { Frame F = fresh(F0);
            QUEUE_LOOP(F, l * 3 + 2, 192 * PR(7) + 192 * PR(8) + 768 * PR(9) + 768 * PR(10), {
                QSPLIT(4, 192, 192, 768, 768, 7);
                if (ty_ == 0) ssd_out_item(fresh(F), KA, l, loc_, dup_ ? WSP(bf16, WS_MLCLOC) : WSP(bf16, WS_Y));
                else if (ty_ == 1) { Frame Fg = fresh(F);
                    pg8::Gemm g{WSP(const pg8::bf16_t, WS_YA), WSP(const pg8::bf16_t, WS_WGT) + (size_t)l * GWID * GWID, M, GWID, GWID}; OneUnit S; S.u.pm = loc_ >> 1; S.u.pn = loc_ & 1;
                    epi::EpiGlu E{WSP(const pg8::bf16_t, WS_YA), WSP(pg8::bf16_t, WS_Y)};
                    pg8::gemm_phase<epi::EpiGlu, OneUnit, false, true>(Fg.lds, g, S, E); __syncthreads(); }
                else if (ty_ == 2) mlstm_out_item(fresh(F), KA, l, loc_ >> 2, loc_ & 3);
                else ret_out_item(fresh(F), KA, l, loc_ >> 2, loc_ & 3);
            });
        } SEAM(pb + 4);
        if (IN(pb + 5)) { Frame F = fresh(F0);
            pg8::Gemm g{WSP(const pg8::bf16_t, WS_Y), WSP(const pg8::bf16_t, WS_WOT) + (size_t)l * D * D, M, D, D}; pg8::StaticOrder S; S.init(M, D, F.G, F.bid);
            KArgs& A_ = KA; epi::EpiRes E{(const float*)(const GAS float*)A_.in[I_XP], (const float*)(const GAS float*)A_.in[I_XS], F.out, WSP(const float, WS_MOD) + (size_t)(l * 5) * (6 * D) + 2 * D, l == 0 ? 1 : 0,
                          1, WSP(pg8::bf16_t, WS_H), WSP(float, WS_SSQA), (const float*)(const GAS float*)A_.in[I_NORM2] + (size_t)l * D, WSP(const float, WS_MOD) + (size_t)(l * 5) * (6 * D) + 4 * D, F.lds + 131072};
            pg8::gemm_phase<epi::EpiRes, pg8::StaticOrder, true, true>(F.lds, g, S, E);
        } SEAM(pb + 5);
        if (IN(pb + 7)) for (int rep_ = 0; rep_ < (PROBE_REPEAT == 7 ? 2 : 1); ++rep_) { Frame F = fresh(F0);
            pg8::Gemm g{WSP(const pg8::bf16_t, WS_H), WSP(const pg8::bf16_t, WS_WM1T) + (size_t)l * DFF * D, M, DFF, D}; pg8::StaticOrder S; S.init(M, DFF, F.G, F.bid);
            epi::EpiRelu2 E{WSP(pg8::bf16_t, WS_HID), WSP(const float, WS_SSQA), WSP(const float, WS_SHW2) + (size_t)l * 5 * DFF};
            pg8::gemm_phase<epi::EpiRelu2, pg8::StaticOrder, true, true>(F.lds, g, S, E);
        } SEAM(pb + 7);
        if (IN(pb + 8)) { Frame F = fresh(F0);
            pg8::Gemm g{WSP(const pg8::bf16_t, WS_HID), WSP(const pg8::bf16_t, WS_WM2T) + (size_t)l * D * DFF, M, D, DFF}; pg8::StaticOrder S; S.init(M, D, F.G, F.bid);
            KArgs& A_ = KA; epi::EpiRes E{(const float*)(const GAS float*)A_.in[I_XP], (const float*)(const GAS float*)A_.in[I_XS], F.out, WSP(const float, WS_MOD) + (size_t)(l * 5) * (6 * D) + 5 * D, 0,
                          l < NLAYER - 1 ? 1 : 0, WSP(pg8::bf16_t, WS_H), WSP(float, WS_SSQB), (const float*)(const GAS float*)A_.in[I_NORM1] + (size_t)(l + 1) * D, WSP(const float, WS_MOD) + (size_t)((l + 1) * 5) * (6 * D) + 1 * D, F.lds + 131072};
            pg8::gemm_phase<epi::EpiRes, pg8::StaticOrder, true, true>(F.lds, g, S, E);
        } SEAM(pb + 8);
    }
    if (IN(N_PHASES - 1)) { Frame F = fresh(F0); final_norm_phase(F, KA); }
#undef IN
#undef SEAM
}

#ifndef MK_LAUNCH_PER_PHASE
#define MK_LAUNCH_PER_PHASE 0
#endif
extern "C" void kernel_launch(void* const* d_in, const int* in_sizes, int n_in, void* d_out, int out_size, void* d_ws, size_t ws_size, hipStream_t stream) {
    static int grid = 0;
    if (grid == 0) {
        if (n_in != N_IN || (size_t)out_size != O_END || ws_size < WS_END) { fprintf(stderr, "kernel_launch: shape mismatch: n_in %d out %d ws %zu (need %zu)\n", n_in, out_size, ws_size, (size_t)WS_END); grid = -1; return; }
        int dev = 0, cus = 0, per_cu = 0;
        if (hipGetDevice(&dev) != hipSuccess || hipDeviceGetAttribute(&cus, hipDeviceAttributeMultiprocessorCount, dev) != hipSuccess) { grid = -1; return; }
        if (hipFuncSetAttribute((const void*)hymba_fwd, hipFuncAttributeMaxDynamicSharedMemorySize, LDS_BYTES) != hipSuccess) { fprintf(stderr, "kernel_launch: hipFuncSetAttribute failed\n"); grid = -1; return; }
        if (hipOccupancyMaxActiveBlocksPerMultiprocessor(&per_cu, (const void*)hymba_fwd, NT, LDS_BYTES) != hipSuccess || per_cu < 1) fprintf(stderr, "kernel_launch: occupancy query says %d\n", per_cu);
        (void)hipGetLastError();
        grid = cus;
    }
    if (grid < 0) return;
    (void)hipMemsetAsync((char*)d_ws + WS_CTL, 0, CTL_ZERO_BYTES, stream);
    Args a{};
    for (int i = 0; i < N_IN; ++i) a.in[i] = (const float*)d_in[i];
    a.out = (float*)d_out; a.ws = (unsigned char*)d_ws;
#if MK_LAUNCH_PER_PHASE
    for (int p = 0; p < N_PHASES; ++p) { a.ph_lo = p; a.ph_hi = p + 1; hipLaunchKernelGGL(hymba_fwd, dim3(grid), dim3(NT), LDS_BYTES, stream, a); }
#else
    a.ph_lo = 0; a.ph_hi = N_PHASES;
    hipLaunchKernelGGL(hymba_fwd, dim3(grid), dim3(NT), LDS_BYTES, stream, a);
#endif
    const hipError_t le = hipPeekAtLastError();
    if (le != hipSuccess) fprintf(stderr, "kernel_launch: launch failed: %s\n", hipGetErrorName(le));
}
```

```cpp
#include <hip/hip_runtime.h>
#include <cstdio>
#include <cstdint>
namespace pg8 {
#define PG8_LAS __attribute__((address_space(3)))
typedef unsigned short bf16_t;
typedef short bf16x8 __attribute__((ext_vector_type(8)));
typedef float f32x4 __attribute__((ext_vector_type(4)));
typedef unsigned u32x4 __attribute__((ext_vector_type(4)));
constexpr int BM = 256, BK = 64, HALF = 128, HTB = HALF * BK * 2  , STAGE_BYTES = 8 * HTB, NXCD = 8, WGM = 8;

__host__ __device__ __forceinline__ int lds_byte(int r, int c) { const int st = (r >> 4) * 2 + (c >> 5), rr = r & 15, cc = c & 31, ob = rr * 64 + cc * 2; return st * 1024 + (ob ^ (((ob >> 9) & 1) << 5)); }
__host__ __device__ __forceinline__ void stage_rc(int b, int& R, int& C) { const int st = b / 1024, sb = b % 1024, swz = sb ^ (((sb >> 9) & 1) << 5); R = (st >> 1) * 16 + swz / 64; C = (st & 1) * 32 + (swz % 64) / 2; }
__host__ __device__ __forceinline__ int perm32(int rho) { const int n = rho >> 4, i = rho & 15; return 8 * (i >> 2) + 4 * n + (i & 3); }

struct Unit { int pm, pn; };
struct Gemm { const bf16_t* A; const bf16_t* Bt; int M, N, K; };

struct StaticOrder {
    int nM, nN, nwg, G, c;
    __host__ __device__ void init(int M, int N, int G_, int c_) { nM = M / BM; nN = N / BM; nwg = nM * nN; G = G_; c = c_; }
    __host__ __device__ bool next(int i, Unit& u) const {
        const long L = (long)i * G + c; if (L >= nwg) return false;
        int wgid = (int)L; { const int q = nwg / NXCD, r = nwg % NXCD, xcd = wgid % NXCD, off = wgid / NXCD; wgid = (xcd < r ? xcd * (q + 1) : r * (q + 1) + (xcd - r) * q) + off; }
        const int nig = WGM * nN, gid = wgid / nig, fm = gid * WGM, gsz = (nM - fm) < WGM ? (nM - fm) : WGM;
        u.pm = fm + ((wgid % nig) % gsz); u.pn = (wgid % nig) / gsz; return true;
    }
    __device__ __forceinline__ void a_ready(const Unit&) const {}
    __device__ __forceinline__ void done(const Unit&) const {}
};

__device__ __forceinline__ unsigned cvt_pk_bf16(float lo, float hi) { unsigned r; asm volatile("v_cvt_pk_bf16_f32 %0, %1, %2" : "=v"(r) : "v"(lo), "v"(hi)); return r; }
typedef float f32x2 __attribute__((ext_vector_type(2)));
template <class Epi, class Sched, bool ALIGN_EPI = false, bool SP2 = false>
__device__ __forceinline__ void gemm_phase(PG8_LAS unsigned char* lds, const Gemm g, const Sched& S, const Epi& E) {
    int tid_ = threadIdx.x; asm volatile("" : "+v"(tid_));
    const int tid = tid_, wid = __builtin_amdgcn_readfirstlane(tid >> 6), lane = tid & 63, wr = wid >> 2, wc = wid & 3, fr = lane & 15, fq = lane >> 4;
    const int K = g.K, nt = K / BK;
    unsigned voffA[2], voffB[2];
#pragma unroll
    for (int i = 0; i < 2; ++i) { int R, C; stage_rc(tid * 16 + i * 8192, R, C); const int Rb = Epi::PERM ? ((R & ~31) + perm32(R & 31)) : R;
        voffA[i] = (unsigned)(R * K + C) * 2u; voffB[i] = (unsigned)(Rb * K + C) * 2u; }
    const size_t kstep = (size_t)(BK * 2);
    const size_t hstep = (size_t)HALF * K * 2;
    const size_t tstep = 2 * hstep;
    const unsigned ldsw = (unsigned)wid * 1024u;
    const int aoff = lds_byte(wr * 64 + fr, fq * 8), boff = lds_byte(wc * 32 + fr, fq * 8);
#define PG8_SA(b, h) (((b) * 2 + (h)) * HTB)
#define PG8_SB(b, h) ((4 + (b) * 2 + (h)) * HTB)
#define PG8_STAGE(bufoff, gbase, voff) do { _Pragma("unroll") for (int _i = 0; _i < 2; ++_i) \
        __builtin_amdgcn_global_load_lds((const unsigned*)((const char*)(gbase) + (voff)[_i]), (PG8_LAS unsigned*)(lds + (bufoff) + ldsw + _i * 8192), 16, 0, 0); } while (0)
#define PG8_LDA(dst, b, h) do { _Pragma("unroll") for (int m = 0; m < 4; ++m) _Pragma("unroll") for (int k = 0; k < 2; ++k) dst[m][k] = *(const PG8_LAS bf16x8*)(lds + PG8_SA(b, h) + aoff + m * 2048 + k * 1024); } while (0)
#define PG8_LDB(dst, b, h) do { _Pragma("unroll") for (int n = 0; n < 2; ++n) _Pragma("unroll") for (int k = 0; k < 2; ++k) dst[n][k] = *(const PG8_LAS bf16x8*)(lds + PG8_SB(b, h) + boff + n * 2048 + k * 1024); } while (0)
#define PG8_MMA(ai, bj, At, Bt) do { __builtin_amdgcn_s_setprio(1); _Pragma("unroll") for (int m = 0; m < 4; ++m) _Pragma("unroll") for (int n = 0; n < 2; ++n) _Pragma("unroll") for (int k = 0; k < 2; ++k) \
        acc[ai][bj][m][n] = __builtin_amdgcn_mfma_f32_16x16x32_bf16(Bt[n][k], At[m][k], acc[ai][bj][m][n], 0, 0, 0); __builtin_amdgcn_s_setprio(0); } while (0)
#define PG8_WAIT_V(n) asm volatile("s_waitcnt vmcnt(" #n ")" ::: "memory")
#define PG8_WAIT_L(n) asm volatile("s_waitcnt lgkmcnt(" #n ")" ::: "memory")
#define PG8_BAR __builtin_amdgcn_s_barrier()
#define PG8_SCHED __builtin_amdgcn_sched_barrier(0)
    Unit cur, nxt; int ui = 0;
    if (!S.next(0, cur)) return;
    f32x4 acc[2][2][4][2];
#pragma unroll
    for (int a = 0; a < 2; ++a)
#pragma unroll
        for (int b = 0; b < 2; ++b)
#pragma unroll
            for (int m = 0; m < 4; ++m)
#pragma unroll
                for (int n = 0; n < 2; ++n) acc[a][b][m][n] = (f32x4){0.f, 0.f, 0.f, 0.f};
    bf16x8 At[4][2], B0[2][2], B1[2][2];
    const char* cA = (const char*)g.A + (size_t)cur.pm * tstep; const char* cB = (const char*)g.Bt + (size_t)cur.pn * tstep;
    S.a_ready(cur);
    if constexpr (SP2) {
        PG8_STAGE(PG8_SB(0, 0), cB, voffB); PG8_STAGE(PG8_SB(0, 1), cB + hstep, voffB); PG8_STAGE(PG8_SA(0, 0), cA, voffA); PG8_STAGE(PG8_SA(0, 1), cA + hstep, voffA);
        if (wr == 1) PG8_BAR;
        PG8_WAIT_V(2); PG8_BAR;
        PG8_STAGE(PG8_SB(1, 0), cB + kstep, voffB); PG8_STAGE(PG8_SA(1, 0), cA + kstep, voffA); PG8_STAGE(PG8_SB(1, 1), cB + hstep + kstep, voffB);
        PG8_WAIT_V(6); PG8_BAR;
    } else {
        PG8_STAGE(PG8_SB(0, 0), cB, voffB); PG8_STAGE(PG8_SA(0, 0), cA, voffA); PG8_STAGE(PG8_SB(0, 1), cB + hstep, voffB); PG8_STAGE(PG8_SA(0, 1), cA + hstep, voffA);
        if (wr == 1) PG8_BAR;
        PG8_WAIT_V(4); PG8_BAR;
        PG8_STAGE(PG8_SB(1, 0), cB + kstep, voffB); PG8_STAGE(PG8_SA(1, 0), cA + kstep, voffA); PG8_STAGE(PG8_SB(1, 1), cB + hstep + kstep, voffB);
        PG8_WAIT_V(6); PG8_BAR;
    }
    for (;;) {
        const bool has_next = S.next(ui + 1, nxt);
        const char* nA = has_next ? (const char*)g.A + (size_t)nxt.pm * tstep : cA; const char* nB = has_next ? (const char*)g.Bt + (size_t)nxt.pn * tstep : cB;
        for (int t = 0; t < nt; t += 2) {
            const bool last = (t == nt - 2);
            const char* a1 = cA + (size_t)(t + 1) * kstep;
            const char* a2 = last ? nA : cA + (size_t)(t + 2) * kstep; const char* b2 = last ? nB : cB + (size_t)(t + 2) * kstep;
            const char* a3 = a2 + kstep; const char* b3 = b2 + kstep;
            if (last && has_next) S.a_ready(nxt);
            if constexpr (SP2) {
            PG8_LDB(B0, 0, 0); PG8_LDB(B1, 0, 1); PG8_SCHED; PG8_LDA(At, 0, 0); PG8_STAGE(PG8_SA(1, 1), a1 + hstep, voffA);
            PG8_WAIT_V(8); PG8_WAIT_L(0); PG8_BAR; PG8_MMA(0, 0, At, B0); PG8_MMA(0, 1, At, B1); PG8_BAR; PG8_SCHED;
            PG8_LDA(At, 0, 1); PG8_STAGE(PG8_SB(0, 0), b2, voffB); PG8_STAGE(PG8_SB(0, 1), b2 + hstep, voffB); PG8_STAGE(PG8_SA(0, 0), a2, voffA);
            PG8_WAIT_V(8); PG8_WAIT_L(0); PG8_BAR; PG8_MMA(1, 0, At, B0); PG8_MMA(1, 1, At, B1); PG8_BAR; PG8_SCHED;
            PG8_LDB(B0, 1, 0); PG8_LDB(B1, 1, 1); PG8_SCHED; PG8_LDA(At, 1, 0); PG8_STAGE(PG8_SA(0, 1), a2 + hstep, voffA);
            PG8_WAIT_V(8); PG8_WAIT_L(0); PG8_BAR; PG8_MMA(0, 0, At, B0); PG8_MMA(0, 1, At, B1); PG8_BAR; PG8_SCHED;
            PG8_LDA(At, 1, 1); PG8_STAGE(PG8_SB(1, 0), b3, voffB); PG8_STAGE(PG8_SB(1, 1), b3 + hstep, voffB); PG8_STAGE(PG8_SA(1, 0), a3, voffA);
            PG8_WAIT_V(8); PG8_WAIT_L(0); PG8_BAR; PG8_MMA(1, 0, At, B0); PG8_MMA(1, 1, At, B1); PG8_BAR; PG8_SCHED;
            } else {
            PG8_LDB(B0, 0, 0); PG8_SCHED; PG8_LDA(At, 0, 0); PG8_STAGE(PG8_SA(1, 1), a1 + hstep, voffA);
            PG8_WAIT_L(8); PG8_BAR; PG8_WAIT_L(0); PG8_MMA(0, 0, At, B0); PG8_BAR; PG8_SCHED;
            PG8_LDB(B1, 0, 1); PG8_STAGE(PG8_SB(0, 0), b2, voffB);
            PG8_BAR; PG8_WAIT_L(0); PG8_MMA(0, 1, At, B1); PG8_BAR;
            PG8_LDA(At, 0, 1); PG8_STAGE(PG8_SA(0, 0), a2, voffA);
            PG8_BAR; PG8_WAIT_L(0); PG8_MMA(1, 0, At, B0); PG8_BAR; PG8_SCHED;
            PG8_STAGE(PG8_SB(0, 1), b2 + hstep, voffB);
            PG8_WAIT_V(6); PG8_BAR; PG8_MMA(1, 1, At, B1); PG8_BAR;
            PG8_LDB(B0, 1, 0); PG8_SCHED; PG8_LDA(At, 1, 0); PG8_STAGE(PG8_SA(0, 1), a2 + hstep, voffA);
            PG8_WAIT_L(8); PG8_BAR; PG8_WAIT_L(0); PG8_MMA(0, 0, At, B0); PG8_BAR; PG8_SCHED;
            PG8_LDB(B1, 1, 1); PG8_STAGE(PG8_SB(1, 0), b3, voffB);
            PG8_BAR; PG8_WAIT_L(0); PG8_MMA(0, 1, At, B1); PG8_BAR;
            PG8_LDA(At, 1, 1); PG8_STAGE(PG8_SA(1, 0), a3, voffA);
            PG8_BAR; PG8_WAIT_L(0); PG8_MMA(1, 0, At, B0); PG8_BAR; PG8_SCHED;
            PG8_STAGE(PG8_SB(1, 1), b3 + hstep, voffB);
            PG8_WAIT_V(6); PG8_BAR; PG8_MMA(1, 1, At, B1); PG8_BAR;
            }
        }
        if constexpr (ALIGN_EPI) { if (wr == 0) PG8_BAR; }
        if constexpr (!Epi::AFTER_DRAIN) { E(acc, cur, wr, wc, fr, fq); S.done(cur); }
        if (!has_next) break;
#pragma unroll
        for (int a = 0; a < 2; ++a)
#pragma unroll
            for (int b = 0; b < 2; ++b)
#pragma unroll
                for (int m = 0; m < 4; ++m)
#pragma unroll
                    for (int n = 0; n < 2; ++n) acc[a][b][m][n] = (f32x4){0.f, 0.f, 0.f, 0.f};
        cur = nxt; cA = nA; cB = nB; ++ui;
        if constexpr (ALIGN_EPI) { if (wr == 1) PG8_BAR; }
    }
    PG8_WAIT_V(0);
    if constexpr (!ALIGN_EPI) { if (wr == 0) PG8_BAR; }
    PG8_BAR;
    if constexpr (Epi::AFTER_DRAIN) { E.fused(acc, cur, wr, wc, fr, fq, lds, wid, lane); S.done(cur); }
#undef PG8_SA
#undef PG8_SB
#undef PG8_STAGE
#undef PG8_LDA
#undef PG8_LDB
#undef PG8_MMA
#undef PG8_WAIT_V
#undef PG8_WAIT_L
#undef PG8_BAR
#undef PG8_SCHED
}
}
#define GAS __attribute__((address_space(1)))
#define LAS __attribute__((address_space(3)))
typedef unsigned short bf16;
typedef unsigned v4u __attribute__((ext_vector_type(4)));
typedef float f32x4 __attribute__((ext_vector_type(4)));
typedef short bf16x8 __attribute__((ext_vector_type(8)));
typedef GAS unsigned gu32;
typedef GAS unsigned long long gu64;
#define RLX_AGENT __ATOMIC_RELAXED, __HIP_MEMORY_SCOPE_AGENT
#define LDS_WAIT() asm volatile("s_waitcnt lgkmcnt(0)" ::: "memory")
#define VM_WAIT() asm volatile("s_waitcnt vmcnt(0)" ::: "memory")
__device__ __forceinline__ unsigned long long rt() { return __builtin_amdgcn_s_memrealtime(); }
__device__ __forceinline__ unsigned f2bf(float f) { unsigned u = __builtin_bit_cast(unsigned, f); return (u + 0x7fffu + ((u >> 16) & 1u)) >> 16; }
__device__ __forceinline__ unsigned pk2(float lo, float hi) { return f2bf(lo) | (f2bf(hi) << 16); }
#define XB_TMO      128
#define XB_XCNT(j)  (256  + 64 * (j))
#define XB_XSUB(j)  (1280 + 64 * (j))
#define XB_XGEN(j)  (2304 + 64 * (j))
#define XB_TOP      3328
#define XB_TOPGEN   3392
#define XCD_BAR_WORDS 3456
#define XB_SPIN_CAP (1u << 18)

__device__ __forceinline__ unsigned xb_ld(unsigned* p)              { return __hip_atomic_load(p, __ATOMIC_RELAXED, __HIP_MEMORY_SCOPE_AGENT); }
__device__ __forceinline__ unsigned xb_add(unsigned* p, unsigned v) { return __hip_atomic_fetch_add(p, v, __ATOMIC_RELAXED, __HIP_MEMORY_SCOPE_AGENT); }
__device__ __forceinline__ unsigned xb_xcc_id() { return (unsigned)__builtin_amdgcn_s_getreg((3 << 11) | 20) & 0xFu; }
#define XB_SPIN(cond, bar) do { unsigned _sp = 0; while (cond) { __builtin_amdgcn_s_sleep(1); \
    if ((++_sp & 255u) == 0u) { if (xb_ld(&(bar)[XB_TMO])) break; if (_sp > XB_SPIN_CAP) { atomicAdd(&(bar)[XB_TMO], 1u); break; } } } } while (0)

struct XcdBarrier {
    unsigned* bar; unsigned x;
    volatile LAS unsigned* st;
};

__device__ __forceinline__ XcdBarrier xcd_barrier_post(unsigned* bar, volatile LAS unsigned* st) {
    XcdBarrier b; b.bar = bar; b.x = xb_xcc_id(); b.st = st;
    if (threadIdx.x == 0) (void)xb_add(&bar[XB_XCNT(b.x)], 1u);
    return b;
}
__device__ __forceinline__ void xcd_barrier_complete(unsigned* bar, unsigned x, unsigned& nloc, unsigned& nx) {
    const unsigned G = gridDim.x * gridDim.y * gridDim.z;
    unsigned sum, cnt, mine, sp = 0u;
    for (;;) {
        sum = 0u; cnt = 0u; mine = 0u;
#pragma unroll
        for (unsigned j = 0; j < 16; ++j) { const unsigned c = xb_ld(&bar[XB_XCNT(j)]); sum += c; cnt += (c > 0u) ? 1u : 0u; mine = (j == x) ? c : mine; }
        if (sum == G) break;
        __builtin_amdgcn_s_sleep(1);
        if ((++sp & 255u) == 0u) { if (xb_ld(&bar[XB_TMO])) break; if (sp > XB_SPIN_CAP) { atomicAdd(&bar[XB_TMO], 1u); break; } }
    }
    nloc = mine > 0u ? mine : 1u; nx = cnt > 0u ? cnt : 1u;
}

__device__ __forceinline__ void xcd_barrier(const XcdBarrier& b) {
    asm volatile("s_waitcnt vmcnt(0)" ::: "memory");
    __syncthreads();
    if (threadIdx.x == 0) {
        unsigned* bar = b.bar;
        __builtin_amdgcn_s_waitcnt(0);
        unsigned nloc = b.st[0], nx = b.st[1];
        if (nloc == 0u) { xcd_barrier_complete(bar, b.x, nloc, nx); b.st[0] = nloc; b.st[1] = nx; }
        const unsigned old = xb_add(&bar[XB_XSUB(b.x)], 1u);
        const unsigned gen = old / nloc;
        if (old + 1u == (gen + 1u) * nloc) {
            __builtin_amdgcn_fence(__ATOMIC_RELEASE, "agent");
            asm volatile("s_waitcnt vmcnt(0)" ::: "memory");
            const unsigned og = xb_add(&bar[XB_TOP], 1u);
            const unsigned tg = og / nx;
            if (og + 1u == (tg + 1u) * nx) xb_add(&bar[XB_TOPGEN], 1u);
            else XB_SPIN(xb_ld(&bar[XB_TOPGEN]) == tg, bar);
            __builtin_amdgcn_fence(__ATOMIC_ACQUIRE, "agent");
            xb_add(&bar[XB_XGEN(b.x)], 1u);
            asm volatile("s_waitcnt vmcnt(0)" ::: "memory");
        } else {
            XB_SPIN(xb_ld(&bar[XB_XGEN(b.x)]) == gen, bar);
            __builtin_amdgcn_fence(__ATOMIC_ACQUIRE, "agent");
            asm volatile("s_waitcnt vmcnt(0)" ::: "memory");
        }
    }
    __syncthreads();
}
constexpr int NWAVES = 8, NT = 512;
constexpr int D = 2048, NLAYER = 4;
constexpr int MC = 32 * 256, ML = 4 * 4096, M = MC + ML;
constexpr int DIN = 6176, NPROJ = 6144, NPAD = 6400, DFF = 8192, GWID = 512;
constexpr int NCP = M / 128;
constexpr float EPS = 1e-6f;
constexpr int PC_S5U = 0, PC_MQ = 512, PC_MK = 1024, PC_MV = 1536, PC_MO = 2048, PC_RQ = 2560, PC_RK = 3072, PC_RV = 3584, PC_RG = 4096, PC_DZ = 4608, PC_DX = 5120, PC_DB = 5632, PC_DC = 5888;
enum { I_XP = 0, I_XS, I_C, I_SS5R, I_SS5I, I_SMC, I_SMN, I_SMM, I_SRET, I_SSSD, I_CCTX, I_NORM1, I_WADA, I_BADA, I_WIN, I_S5LR, I_S5LI, I_S5DT, I_S5BR, I_S5BI, I_S5CR, I_S5CI, I_S5D, I_S5GLU,
       I_MIB, I_MFB, I_MNORM, I_RRATE, I_RNORM, I_CONVW, I_CONVB, I_DTB, I_ALOG, I_SSDD, I_SNORM, I_WOUT, I_NORM2, I_WM1, I_WM2, I_FNORM, N_IN };
constexpr size_t O_YP = 0, O_YS = (size_t)MC * D, O_S5R = (size_t)M * D, O_S5I = O_S5R + 524288, O_MC = O_S5I + 524288, O_MN = O_MC + 16777216, O_MM = O_MN + 131072, O_RET = O_MM + 1024, O_SSD = O_RET + 16777216, O_END = O_SSD + 16777216;

constexpr size_t MiB = 1u << 20;
constexpr size_t WS_CTL = 0, CTL_ZERO_BYTES = 1 * MiB;
constexpr size_t WS_MOD = 1 * MiB;
constexpr size_t WS_S5T = 2 * MiB;
constexpr size_t WS_ROPE = 5 * MiB;
constexpr size_t WS_GATES = 6 * MiB;
constexpr size_t WS_MLNLOC = 9 * MiB;
constexpr size_t WS_MLNIN = 10 * MiB;
constexpr size_t WS_MLSC = 11 * MiB;
constexpr size_t WS_MLMIN = 11 * MiB + 65536;
constexpr size_t WS_SDSC = 11 * MiB + 131072;
constexpr size_t WS_SSQA = 5 * MiB + 65536;
constexpr size_t WS_SSQB = 11 * MiB + 262144;
constexpr size_t WS_SHW1 = 18 * MiB;
constexpr size_t WS_SHW2 = 19 * MiB;
constexpr size_t WS_S5LOC = 12 * MiB;
constexpr size_t WS_WGT = 20 * MiB;
constexpr size_t WS_W1T = 22 * MiB;
constexpr size_t WS_WOT = 122 * MiB;
constexpr size_t WS_WM1T = 154 * MiB;
constexpr size_t WS_WM2T = 282 * MiB;
constexpr size_t WS_H = 410 * MiB;
constexpr size_t WS_Y = 506 * MiB;
constexpr size_t WS_YA = 602 * MiB;
constexpr size_t WS_MLCIN = 626 * MiB;
constexpr size_t WS_RTIN = 674 * MiB;
constexpr size_t WS_SDIN = 722 * MiB;
constexpr size_t WS_PROJ = 770 * MiB;
constexpr size_t WS_MLCLOC = 1058 * MiB;
constexpr size_t WS_HID = 770 * MiB;
constexpr size_t WS_RTLOC = 1106 * MiB;
constexpr size_t WS_SDLOC = 1154 * MiB;
constexpr size_t WS_XBCC = 1202 * MiB;
constexpr size_t WS_XB = 1250 * MiB;
constexpr size_t WS_END = 1346 * MiB;
constexpr int CW_TMO = 0, CW_BAR = 4096;

constexpr int LDT = 272;
constexpr int TS = 128 * LDT;
constexpr int LDX = 144;
constexpr int TSX = 128 * LDX;
constexpr int SCAL_OFF = 4 * TS;
constexpr int MISC_OFF = 163840 - 256;
constexpr int LDS_BYTES = 163840;
#define SCA(i) ((LAS float*)(F.lds + SCAL_OFF + (i) * 512))
typedef float f32x16 __attribute__((ext_vector_type(16)));
typedef float f32x2 __attribute__((ext_vector_type(2)));
typedef short s16x4 __attribute__((ext_vector_type(4)));
typedef unsigned u32x2 __attribute__((ext_vector_type(2)));
struct Args { const float* in[N_IN]; float* out; unsigned char* ws; int ph_lo, ph_hi; };
struct Frame {
    LAS unsigned char* lds;
    float* out; unsigned char* ws;
    int tid, lane, wave, G, bid;
};
typedef const __attribute__((address_space(4))) Args KArgs;
__device__ __forceinline__ KArgs* kargs() { KArgs* p = (KArgs*)__builtin_amdgcn_kernarg_segment_ptr(); asm volatile("" : "+s"(p)); return p; }
__device__ __forceinline__ Frame fresh(const Frame& F) { Frame R = F; unsigned long long l = (unsigned long long)(size_t)R.lds; unsigned ll = (unsigned)l; asm volatile("" : "+s"(ll), "+s"(R.wave), "+s"(R.G), "+s"(R.bid), "+v"(R.tid)); R.lane = R.tid & 63; R.lds = (LAS unsigned char*)(size_t)ll; KArgs* ka = kargs(); R.out = (float*)(GAS float*)ka->out; R.ws = (unsigned char*)(GAS unsigned char*)ka->ws; return R; }
#define INP(i) ((const float*)(const GAS float*)(A.in[i]))
#define BAR() __syncthreads()
#define WSP(T, off) ((T*)(F.ws + (off)))
__device__ __forceinline__ float bf2f(unsigned short b) { return __uint_as_float((unsigned)b << 16); }
__device__ __forceinline__ float bflo(unsigned w) { return __uint_as_float(w << 16); }
__device__ __forceinline__ float bfhi(unsigned w) { return __uint_as_float(w & 0xffff0000u); }
__device__ __forceinline__ void unpack8(const v4u a, float (&x)[8]) { x[0] = bflo(a.x); x[1] = bfhi(a.x); x[2] = bflo(a.y); x[3] = bfhi(a.y); x[4] = bflo(a.z); x[5] = bfhi(a.z); x[6] = bflo(a.w); x[7] = bfhi(a.w); }
__device__ __forceinline__ v4u pack8(const float (&x)[8], float w) { v4u o; o.x = pk2(x[0] * w, x[1] * w); o.y = pk2(x[2] * w, x[3] * w); o.z = pk2(x[4] * w, x[5] * w); o.w = pk2(x[6] * w, x[7] * w); return o; }
__device__ __forceinline__ float sigmoidf_(float x) { return 1.f / (1.f + __expf(-x)); }
__device__ __forceinline__ float siluf_(float x) { return x * sigmoidf_(x); }
__device__ __forceinline__ float wave_sum(float v) {
#pragma unroll
    for (int o = 1; o < 64; o <<= 1) v += __shfl_xor(v, o);
    return v;
}
__device__ __forceinline__ float wave_max(float v) {
#pragma unroll
    for (int o = 1; o < 64; o <<= 1) v = fmaxf(v, __shfl_xor(v, o));
    return v;
}
template <bool MAX> __device__ __forceinline__ void wave_scan128(const LAS float* in, LAS float* out, int lane, bool rev, float init) {
    const int i0 = rev ? 127 - 2 * lane : 2 * lane, i1 = rev ? i0 - 1 : i0 + 1;
    float e0 = in[i0], e1 = in[i1];
    if (lane == 0) e0 = MAX ? fmaxf(e0, init) : e0 + init;
    float inc = MAX ? fmaxf(e0, e1) : e0 + e1;
#pragma unroll
    for (int o = 1; o < 64; o <<= 1) { const float t = __shfl_up(inc, o); if (lane >= o) inc = MAX ? fmaxf(inc, t) : inc + t; }
    float exc = __shfl_up(inc, 1);
    const float o0 = (lane == 0) ? e0 : (MAX ? fmaxf(exc, e0) : exc + e0);
    out[i0] = o0; out[i1] = inc;
}
__device__ __forceinline__ s16x4 lds_tr(const LAS unsigned char* p) {
    typedef short v4i16_t __attribute__((ext_vector_type(4)));
    return __builtin_bit_cast(s16x4, __builtin_amdgcn_ds_read_tr16_b64_v4i16((LAS v4i16_t*)p));
}
__device__ __forceinline__ bf16x8 frag_row(const LAS unsigned char* base, int ld, int r0, int k0, int lane) {
    return *(const LAS bf16x8*)(base + (r0 + (lane & 31)) * ld + (k0 + 8 * (lane >> 5)) * 2);
}
__device__ __forceinline__ bf16x8 frag_tr(const LAS unsigned char* base, int ld, int k0, int c0, int lane) {
    const int h = lane >> 5, blk = (lane >> 4) & 1, q = (lane & 15) >> 2, p = lane & 3;
    const LAS unsigned char* a = base + (k0 + 8 * h + q) * ld + (c0 + 16 * blk + 4 * p) * 2;
    const s16x4 lo = lds_tr(a), hi = lds_tr(a + 4 * ld);
    return (bf16x8){lo[0], lo[1], lo[2], lo[3], hi[0], hi[1], hi[2], hi[3]};
}
#define MFMA32(a, b, c) __builtin_amdgcn_mfma_f32_32x32x16_bf16((a), (b), (c), 0, 0, 0)
#define ZERO16 ((f32x16){0.f,0.f,0.f,0.f,0.f,0.f,0.f,0.f,0.f,0.f,0.f,0.f,0.f,0.f,0.f,0.f})
__device__ __forceinline__ int crow(int i, int hh) { return (i & 3) + 8 * (i >> 2) + 4 * hh; }

__device__ __forceinline__ const float* x_in_row(const Frame& F, KArgs& A, int l, int r) {
    if (l == 0) return r < MC ? INP(I_XP) + (size_t)r * D : INP(I_XS) + (size_t)(r - MC) * D;
    return F.out + (size_t)r * D;
}
__device__ __forceinline__ int mod_row(int r) { return r < MC ? 0 : 1 + (r - MC) / 4096; }
__device__ __forceinline__ const float* mod_ptr(const Frame& F, int l, int mrow, int part) { return WSP(const float, WS_MOD) + ((size_t)(l * 5 + mrow) * 6 + part) * D; }
struct Seq { int cp0, nch, c, b, lat; };
__device__ __forceinline__ Seq seq_of(int cp) { Seq s; if (cp < 64) { s.lat = 0; s.b = cp >> 1; s.cp0 = cp & ~1; s.nch = 2; s.c = cp & 1; } else { s.lat = 1; s.b = (cp - 64) >> 5; s.cp0 = 64 + (s.b << 5); s.nch = 32; s.c = (cp - 64) & 31; } return s; }
__device__ __forceinline__ int w1_newcol(int n) { return n < 2560 ? n : (n < 2576 ? n - 2560 + 6144 : (n < 6160 ? n - 16 : n)); }
template <bool MAPW1> __device__ __forceinline__ void p0_transpose_item(const float* W, int K, int N, bf16* WT, LAS float* scr, int item, int lane) {
    const int nblk = N / 32, kb = item / nblk, nb = item % nblk, k0 = 64 * kb, n0 = 32 * nb;
#pragma unroll 8
    for (int i = 0; i < 32; ++i) { const int kk = 2 * i + (lane >> 5); scr[kk * 33 + (lane & 31)] = W[(size_t)(k0 + kk) * N + n0 + (lane & 31)]; }
    LDS_WAIT(); asm volatile("" ::: "memory");
    const int c = lane & 7;
#pragma unroll
    for (int j = 0; j < 4; ++j) { const int n = (lane >> 3) + 8 * j; const LAS float* s = scr + (8 * c) * 33 + n;
        v4u o; o.x = pk2(s[0 * 33], s[1 * 33]); o.y = pk2(s[2 * 33], s[3 * 33]); o.z = pk2(s[4 * 33], s[5 * 33]); o.w = pk2(s[6 * 33], s[7 * 33]);
        const int nr = MAPW1 ? w1_newcol(n0 + n) : (n0 + n);
        *(GAS v4u*)(WT + (size_t)nr * K + k0 + 8 * c) = o; }
    LDS_WAIT(); asm volatile("" ::: "memory");
}
constexpr int S5T_STRIDE = 9216;
__device__ __forceinline__ unsigned char* s5tab(const Frame& F, int l, int d, int g) { return F.ws + WS_S5T + (size_t)((l * 2 + d) * 32 + g) * S5T_STRIDE; }

__device__ __forceinline__ void p0_prologue(Frame& F, KArgs& A) {
    {
        LAS float* scr = (LAS float*)(F.lds + F.wave * 16384);
        const int gw = F.bid * NWAVES + F.wave, NGW = F.G * NWAVES;
        constexpr int I_1 = (D / 64) * (DIN / 32), I_G = (GWID / 64) * (GWID / 32), I_O = (D / 64) * (D / 32), I_M1 = (D / 64) * (DFF / 32), I_M2 = (DFF / 64) * (D / 32);
        constexpr int PER_L = I_1 + I_G + I_O + I_M1 + I_M2;
        for (int it = gw; it < NLAYER * PER_L; it += NGW) {
            const int l = it / PER_L; int r = it % PER_L;
            if (r < I_1) { p0_transpose_item<true>(INP(I_WIN) + (size_t)l * D * DIN, D, DIN, WSP(bf16, WS_W1T) + (size_t)l * NPAD * D, scr, r, F.lane); continue; } r -= I_1;
            if (r < I_G) { p0_transpose_item<false>(INP(I_S5GLU) + (size_t)l * GWID * GWID, GWID, GWID, WSP(bf16, WS_WGT) + (size_t)l * GWID * GWID, scr, r, F.lane); continue; } r -= I_G;
            if (r < I_O) { p0_transpose_item<false>(INP(I_WOUT) + (size_t)l * D * D, D, D, WSP(bf16, WS_WOT) + (size_t)l * D * D, scr, r, F.lane); continue; } r -= I_O;
            if (r < I_M1) { p0_transpose_item<false>(INP(I_WM1) + (size_t)l * D * DFF, D, DFF, WSP(bf16, WS_WM1T) + (size_t)l * DFF * D, scr, r, F.lane); continue; } r -= I_M1;
            p0_transpose_item<false>(INP(I_WM2) + (size_t)l * DFF * D, DFF, D, WSP(bf16, WS_WM2T) + (size_t)l * D * DFF, scr, r, F.lane);
        }
        const int gt = F.bid * NT + F.tid, NGT = F.G * NT;
        for (int i = gt; i < NLAYER * 224 * 256; i += NGT) { const int l = i / (224 * 256), r = i % (224 * 256);
            *(GAS v4u*)(WSP(bf16, WS_W1T) + ((size_t)l * NPAD + DIN) * D + (size_t)r * 8) = (v4u){0u, 0u, 0u, 0u}; }
        for (int i = gt; i < NLAYER * 2 * 32 * 64; i += NGT) {
            const int p = i & 63, g = (i >> 6) & 31, d = (i >> 11) & 1, l = i >> 12;
            const int ldg = (l * 2 + d) * 32 + g;
            const double lre = INP(I_S5LR)[ldg * 64 + p], lim = INP(I_S5LI)[ldg * 64 + p], dt = exp((double)INP(I_S5DT)[ldg]);
            const double er = exp(lre * dt), br = er * cos(lim * dt), bi = er * sin(lim * dt);
            const double e128 = exp(128.0 * lre * dt), b128r = e128 * cos(128.0 * lim * dt), b128i = e128 * sin(128.0 * lim * dt);
            const double nr = br - 1.0, ni = bi, den = lre * lre + lim * lim;
            const double cr = (nr * lre + ni * lim) / den, ci = (ni * lre - nr * lim) / den;
            unsigned char* tb = s5tab(F, l, d, g);
            float* lam = (float*)tb; lam[2 * p] = (float)br; lam[2 * p + 1] = (float)bi;
            float* l128 = (float*)(tb + 512); l128[2 * p] = (float)b128r; l128[2 * p + 1] = (float)b128i;
            bf16* bb = (bf16*)(tb + 1024); bf16* ct = (bf16*)(tb + 5120);
            for (int c = 0; c < 16; ++c) {
                const double Br = INP(I_S5BR)[(size_t)(ldg * 64 + p) * 16 + c], Bi = INP(I_S5BI)[(size_t)(ldg * 64 + p) * 16 + c];
                bb[(2 * p) * 16 + c] = (bf16)f2bf((float)(cr * Br - ci * Bi));
                bb[(2 * p + 1) * 16 + c] = (bf16)f2bf((float)(cr * Bi + ci * Br));
                ct[c * 128 + 2 * p] = (bf16)f2bf(INP(I_S5CR)[(size_t)(ldg * 16 + c) * 64 + p]);
                ct[c * 128 + 2 * p + 1] = (bf16)f2bf(-INP(I_S5CI)[(size_t)(ldg * 16 + c) * 64 + p]);
            }
        }
        for (int i = gt; i < 64 * 32; i += NGT) { const int pos = i >> 5, k = i & 31; const double f = pow(10000.0, -(double)k / 32.0), a = pos * f;
            WSP(f32x2, WS_ROPE)[i] = (f32x2){(float)cos(a), (float)sin(a)}; }
    }
    __syncthreads();
    {
        LAS float* sc = (LAS float*)F.lds;
        LAS float* red = (LAS float*)(F.lds + 65536);
        for (int i = F.tid; i < 5 * D; i += NT) { const int r = i / D, k = i % D; const float v = r == 0 ? INP(I_CCTX)[k] : INP(I_C)[(r - 1) * D + k]; sc[i] = siluf_(v); }
        __syncthreads();
        for (int it = F.bid; it < NLAYER * 96; it += F.G) {
            const int l = it / 96, c0 = (it % 96) * 128;
            const float* W = INP(I_WADA) + (size_t)l * D * (6 * D);
            float acc[5][4];
#pragma unroll
            for (int r = 0; r < 5; ++r)
#pragma unroll
                for (int j = 0; j < 4; ++j) acc[r][j] = 0.f;
            const int cl = F.lane & 31, kp = F.lane >> 5;
#pragma unroll 4
            for (int kk = 0; kk < 128; ++kk) {
                const int k = F.wave * 256 + 2 * kk + kp;
                const f32x4 w = *(const f32x4*)(W + (size_t)k * (6 * D) + c0 + 4 * cl);
#pragma unroll
                for (int r = 0; r < 5; ++r) { const float s = sc[r * D + k]; acc[r][0] += s * w.x; acc[r][1] += s * w.y; acc[r][2] += s * w.z; acc[r][3] += s * w.w; }
            }
#pragma unroll
            for (int r = 0; r < 5; ++r)
#pragma unroll
                for (int j = 0; j < 4; ++j) { acc[r][j] += __shfl_xor(acc[r][j], 32); }
            if (kp == 0) {
#pragma unroll
                for (int r = 0; r < 5; ++r)
#pragma unroll
                    for (int j = 0; j < 4; ++j) red[(F.wave * 5 + r) * 128 + 4 * cl + j] = acc[r][j];
            }
            __syncthreads();
            for (int i = F.tid; i < 5 * 128; i += NT) { const int r = i >> 7, j = i & 127; float s = 0.f;
#pragma unroll
                for (int w = 0; w < 8; ++w) s += red[(w * 5 + r) * 128 + j];
                WSP(float, WS_MOD)[(size_t)(l * 5 + r) * (6 * D) + c0 + j] = s + INP(I_BADA)[(size_t)l * (6 * D) + c0 + j]; }
            __syncthreads();
        }
    }
}

__device__ __forceinline__ void norm0_phase(Frame& F, KArgs& A) {
    const int gw = F.bid * NWAVES + F.wave, NGW = F.G * NWAVES;
    const float* gain = INP(I_NORM1);
    for (int m = gw; m < M; m += NGW) {
        const float* xr = x_in_row(F, A, 0, m);
        const float* scp = mod_ptr(F, 0, mod_row(m), 1);
        f32x4 v[8]; float s = 0.f;
#pragma unroll
        for (int j = 0; j < 8; ++j) { v[j] = *(const f32x4*)(xr + 4 * F.lane + 256 * j); s += (v[j].x * v[j].x + v[j].y * v[j].y) + (v[j].z * v[j].z + v[j].w * v[j].w); }
        s = wave_sum(s);
        if (F.lane < 8) WSP(float, WS_SSQB)[(size_t)m * 8 + F.lane] = F.lane == 0 ? s : 0.f;
        bf16* orow = WSP(bf16, WS_H) + (size_t)m * D;
#pragma unroll
        for (int j = 0; j < 8; ++j) { const int c = 4 * F.lane + 256 * j;
            const f32x4 g4 = *(const f32x4*)(gain + c), s4 = *(const f32x4*)(scp + c);
            *(u32x2*)(orow + c) = (u32x2){pk2(v[j].x * g4.x * (1.f + s4.x), v[j].y * g4.y * (1.f + s4.y)), pk2(v[j].z * g4.z * (1.f + s4.z), v[j].w * g4.w * (1.f + s4.w))}; }
    }
}
__device__ __forceinline__ void shw_phase(Frame& F) {
    LAS float* sh = (LAS float*)F.lds;
    const int gw = F.bid * NWAVES + F.wave, NGW = F.G * NWAVES;
    for (int grp = 0; grp < 2 * NLAYER; ++grp) {
        const int l = grp >> 1, which = grp & 1;
        __syncthreads();
        for (int i = F.tid; i < 5 * D; i += NT) sh[i] = WSP(const float, WS_MOD)[((size_t)(l * 5 + i / D) * 6 + (which ? 3 : 0)) * D + (i % D)];
        __syncthreads();
        const int N = which ? DFF : DIN, NS = which ? DFF : NPAD;
        const bf16* Wt = which ? WSP(const bf16, WS_WM1T) + (size_t)l * DFF * D : WSP(const bf16, WS_W1T) + (size_t)l * NPAD * D;
        float* o = which ? WSP(float, WS_SHW2) + (size_t)l * 5 * DFF : WSP(float, WS_SHW1) + (size_t)l * 5 * NPAD;
        for (int n = gw; n < N; n += NGW) {
            float acc[5] = {0.f, 0.f, 0.f, 0.f, 0.f};
#pragma unroll
            for (int j = 0; j < 4; ++j) { const int k = 8 * F.lane + 512 * j; float w[8]; unpack8(*(const v4u*)(Wt + (size_t)n * D + k), w);
#pragma unroll
                for (int r = 0; r < 5; ++r) { const f32x4 a0 = *(const LAS f32x4*)(sh + r * D + k), a1 = *(const LAS f32x4*)(sh + r * D + k + 4);
                    acc[r] += (w[0] * a0.x + w[1] * a0.y) + (w[2] * a0.z + w[3] * a0.w) + (w[4] * a1.x + w[5] * a1.y) + (w[6] * a1.z + w[7] * a1.w); } }
#pragma unroll
            for (int r = 0; r < 5; ++r) { const float s = wave_sum(acc[r]); if (F.lane == 0) o[(size_t)r * NS + n] = s; }
        }
    }
    __syncthreads();
}
__device__ __forceinline__ void final_norm_phase(Frame& F, KArgs& A) {
    const int gw = F.bid * NWAVES + F.wave, NGW = F.G * NWAVES;
    const float* gain = INP(I_FNORM);
    for (int m = gw; m < M; m += NGW) {
        const bf16* xr = WSP(const bf16, WS_XB) + (size_t)m * D; float* orow = F.out + (size_t)m * D;
        float v[4][8]; float s = 0.f;
#pragma unroll
        for (int j = 0; j < 4; ++j) { unpack8(*(const v4u*)(xr + 8 * F.lane + 512 * j), v[j]);
#pragma unroll
            for (int k = 0; k < 8; ++k) s += v[j][k] * v[j][k]; }
        const float rstd = rsqrtf(wave_sum(s) * (1.f / D) + EPS);
#pragma unroll
        for (int j = 0; j < 4; ++j) { const int c = 8 * F.lane + 512 * j; const f32x4 g0 = *(const f32x4*)(gain + c), g1 = *(const f32x4*)(gain + c + 4);
            *(f32x4*)(orow + c) = (f32x4){v[j][0] * rstd * g0.x, v[j][1] * rstd * g0.y, v[j][2] * rstd * g0.z, v[j][3] * rstd * g0.w};
            *(f32x4*)(orow + c + 4) = (f32x4){v[j][4] * rstd * g1.x, v[j][5] * rstd * g1.y, v[j][6] * rstd * g1.z, v[j][7] * rstd * g1.w}; }
    }
}

__device__ __forceinline__ void gates_phase(Frame& F, int l) {
    const bf16* XA = WSP(const bf16, WS_H); const bf16* Wg = WSP(const bf16, WS_W1T) + ((size_t)l * NPAD + NPROJ) * D;
    const float* shw = WSP(const float, WS_SHW1) + (size_t)l * 5 * NPAD + NPROJ;
    const int hh = F.lane >> 5, r = F.lane & 31, k0 = F.wave * 256;
    LAS float* red = (LAS float*)F.lds;
    bf16x8 bw[16];
#pragma unroll
    for (int ks = 0; ks < 16; ++ks) bw[ks] = *(const bf16x8*)(Wg + (size_t)r * D + k0 + 16 * ks + 8 * hh);
    for (int rb = F.bid; rb < M / 32; rb += F.G) {
        f32x16 acc = ZERO16;
#pragma unroll
        for (int half = 0; half < 2; ++half) { bf16x8 a[8];
#pragma unroll
            for (int j = 0; j < 8; ++j) a[j] = *(const bf16x8*)(XA + (size_t)(32 * rb + r) * D + k0 + 16 * (8 * half + j) + 8 * hh);
#pragma unroll
            for (int j = 0; j < 8; ++j) acc = MFMA32(a[j], bw[8 * half + j], acc); }
#pragma unroll
        for (int i = 0; i < 16; ++i) red[(F.wave * 32 + crow(i, hh)) * 33 + r] = acc[i];
        BAR();
#pragma unroll
        for (int q = 0; q < 2; ++q) { const int idx = F.tid * 2 + q, row = idx >> 5, col = idx & 31; float s = 0.f;
#pragma unroll
            for (int w = 0; w < 8; ++w) s += red[(w * 32 + row) * 33 + col];
            const int grow = 32 * rb + row; const float* part = WSP(const float, WS_SSQB) + (size_t)grow * 8;
            const float ssq = ((part[0] + part[1]) + (part[2] + part[3])) + ((part[4] + part[5]) + (part[6] + part[7]));
            WSP(float, WS_GATES)[(size_t)grow * 32 + col] = s * rsqrtf(ssq * (1.f / D) + EPS) + shw[(size_t)mod_row(grow) * NPAD + col]; }
        BAR();
    }
}
namespace epi {
__device__ __forceinline__ float rstd_of(const float* part, int r) { const pg8::f32x4 a = *(const pg8::f32x4*)(part + (size_t)r * 8), b = *(const pg8::f32x4*)(part + (size_t)r * 8 + 4);
    return rsqrtf((((a[0] + a[1]) + (a[2] + a[3])) + ((b[0] + b[1]) + (b[2] + b[3]))) * (1.f / D) + EPS); }
using pg8::Unit; using pg8::f32x4; using pg8::u32x4; using pg8::bf16_t; using pg8::cvt_pk_bf16;
constexpr int BMq = 256, HALFq = 128;
struct EpiProj {
    static constexpr bool PERM = true, AFTER_DRAIN = false;
    bf16_t* P; const float* ssq; const float* shw0;
    __device__ __forceinline__ void operator()(const f32x4 (&acc)[2][2][4][2], const Unit& u, int wr, int wc, int fr_, int fq) const {
        int fr = fr_; asm volatile("" : "+v"(fr));
        const int row0 = u.pm * BMq + wr * 64 + fr, rowt = u.pm * BMq, col0 = u.pn * BMq + wc * 32 + 8 * fq;
        const float* shw = shw0 + (size_t)(rowt < MC ? 0 : 1 + (rowt - MC) / 4096) * NPAD + col0;
        f32x4 sh[2][2];
#pragma unroll
        for (int bj = 0; bj < 2; ++bj) { sh[bj][0] = *(const f32x4*)(shw + bj * HALFq); sh[bj][1] = *(const f32x4*)(shw + bj * HALFq + 4); }
#pragma unroll
        for (int ai = 0; ai < 2; ++ai)
#pragma unroll
            for (int m = 0; m < 4; ++m) { const int r = row0 + ai * HALFq + m * 16; bf16_t* rowp = P + (size_t)r * NPROJ + col0; const float rs = rstd_of(ssq, r);
#pragma unroll
                for (int bj = 0; bj < 2; ++bj) { const f32x4 v0 = acc[ai][bj][m][0] * rs + sh[bj][0], v1 = acc[ai][bj][m][1] * rs + sh[bj][1];
                    u32x4 w; w.x = cvt_pk_bf16(v0[0], v0[1]); w.y = cvt_pk_bf16(v0[2], v0[3]); w.z = cvt_pk_bf16(v1[0], v1[1]); w.w = cvt_pk_bf16(v1[2], v1[3]);
                    *(u32x4*)(rowp + bj * HALFq) = w; } }
    }
};
struct EpiGlu {
    static constexpr bool PERM = true, AFTER_DRAIN = false;
    const bf16_t* YA; bf16_t* Y;
    __device__ __forceinline__ void operator()(const f32x4 (&acc)[2][2][4][2], const Unit& u, int wr, int wc, int fr_, int fq) const {
        int fr = fr_; asm volatile("" : "+v"(fr));
        const int row0 = u.pm * BMq + wr * 64 + fr, col0 = u.pn * BMq + wc * 32 + 8 * fq;
#pragma unroll
        for (int ai = 0; ai < 2; ++ai)
#pragma unroll
            for (int m = 0; m < 4; ++m) { const int r = row0 + ai * HALFq + m * 16;
#pragma unroll
                for (int bj = 0; bj < 2; ++bj) { const f32x4 v0 = acc[ai][bj][m][0], v1 = acc[ai][bj][m][1];
                    const u32x4 a = *(const u32x4*)(YA + (size_t)r * GWID + col0 + bj * HALFq);
                    float y[8] = {bflo(a.x), bfhi(a.x), bflo(a.y), bfhi(a.y), bflo(a.z), bfhi(a.z), bflo(a.w), bfhi(a.w)};
                    const float g[8] = {v0[0], v0[1], v0[2], v0[3], v1[0], v1[1], v1[2], v1[3]};
#pragma unroll
                    for (int k = 0; k < 8; ++k) y[k] = y[k] * sigmoidf_(g[k]);
                    u32x4 w; w.x = cvt_pk_bf16(y[0], y[1]); w.y = cvt_pk_bf16(y[2], y[3]); w.z = cvt_pk_bf16(y[4], y[5]); w.w = cvt_pk_bf16(y[6], y[7]);
                    *(u32x4*)(Y + (size_t)r * D + col0 + bj * HALFq) = w; } }
    }
};
struct EpiRes {
    static constexpr bool PERM = true, AFTER_DRAIN = false;
    const float* xp; const float* xs; bf16_t* XB; const float* gate0; int first;
    int NEXT; bf16_t* XA; float* ssq; const float* gn; const float* scn0; PG8_LAS unsigned char* scr;
    __device__ __forceinline__ void operator()(const f32x4 (&acc)[2][2][4][2], const Unit& u, int wr, int wc, int fr_, int fq) const {
        int fr = fr_; asm volatile("" : "+v"(fr));
        const int rowt = u.pm * BMq, col0 = u.pn * BMq + wc * 32 + 8 * fq;
        const int mrow = rowt < MC ? 0 : 1 + (rowt - MC) / 4096;
        const float* gate = gate0 + (size_t)mrow * (6 * D);
        const float* basef = rowt < MC ? xp + (size_t)rowt * D : xs + (size_t)(rowt - MC) * D;
        bf16_t* xb = XB + (size_t)rowt * D;
        float ss[2][4];
#pragma unroll
        for (int ai = 0; ai < 2; ++ai)
#pragma unroll
            for (int m = 0; m < 4; ++m) ss[ai][m] = 0.f;
#pragma unroll
        for (int bj = 0; bj < 2; ++bj) { const int c = col0 + bj * HALFq; const f32x4 g0 = *(const f32x4*)(gate + c), g1 = *(const f32x4*)(gate + c + 4);
            f32x4 a0 = (f32x4){0.f, 0.f, 0.f, 0.f}, a1 = a0;
            if (NEXT) { const float* scn = scn0 + (size_t)mrow * (6 * D); a0 = *(const f32x4*)(gn + c) * (*(const f32x4*)(scn + c) + 1.f); a1 = *(const f32x4*)(gn + c + 4) * (*(const f32x4*)(scn + c + 4) + 1.f); }
#pragma unroll
            for (int ai = 0; ai < 2; ++ai)
#pragma unroll
                for (int m = 0; m < 4; ++m) { const size_t off = (size_t)(wr * 64 + fr + ai * HALFq + m * 16) * D + c;
                    f32x4 b0, b1;
                    if (first) { b0 = *(const f32x4*)(basef + off); b1 = *(const f32x4*)(basef + off + 4); }
                    else { const u32x4 w = *(const u32x4*)(xb + off); b0 = (f32x4){bflo(w.x), bfhi(w.x), bflo(w.y), bfhi(w.y)}; b1 = (f32x4){bflo(w.z), bfhi(w.z), bflo(w.w), bfhi(w.w)}; }
                    const f32x4 x0 = b0 + g0 * acc[ai][bj][m][0], x1 = b1 + g1 * acc[ai][bj][m][1];
                    u32x4 xw; xw.x = cvt_pk_bf16(x0[0], x0[1]); xw.y = cvt_pk_bf16(x0[2], x0[3]); xw.z = cvt_pk_bf16(x1[0], x1[1]); xw.w = cvt_pk_bf16(x1[2], x1[3]);
                    *(u32x4*)(xb + off) = xw;
                    if (NEXT) { const f32x4 r0 = (f32x4){bflo(xw.x), bfhi(xw.x), bflo(xw.y), bfhi(xw.y)}, r1 = (f32x4){bflo(xw.z), bfhi(xw.z), bflo(xw.w), bfhi(xw.w)};
                        ss[ai][m] += (r0[0] * r0[0] + r0[1] * r0[1]) + (r0[2] * r0[2] + r0[3] * r0[3]) + (r1[0] * r1[0] + r1[1] * r1[1]) + (r1[2] * r1[2] + r1[3] * r1[3]);
                        const f32x4 y0 = r0 * a0, y1 = r1 * a1; u32x4 w; w.x = cvt_pk_bf16(y0[0], y0[1]); w.y = cvt_pk_bf16(y0[2], y0[3]); w.z = cvt_pk_bf16(y1[0], y1[1]); w.w = cvt_pk_bf16(y1[2], y1[3]);
                        *(u32x4*)(XA + (size_t)rowt * D + off) = w; }
                    if (m & 1) asm volatile("" ::: "memory"); } }
        if (NEXT) {
            PG8_LAS float* P4 = (PG8_LAS float*)scr;
#pragma unroll
            for (int ai = 0; ai < 2; ++ai)
#pragma unroll
                for (int m = 0; m < 4; ++m) { float s = ss[ai][m]; s += __shfl_xor(s, 16); s += __shfl_xor(s, 32);
                    if (fq == 0) P4[(ai * HALFq + wr * 64 + m * 16 + fr) * 4 + wc] = s; }
            asm volatile("s_waitcnt lgkmcnt(0)\n\ts_barrier" ::: "memory");
            { const int tid = (wr * 4 + wc) * 64 + fq * 16 + fr;
              if (tid < 256) { const f32x4 p = *(const PG8_LAS f32x4*)(P4 + tid * 4); ssq[(size_t)(rowt + tid) * 8 + u.pn] = (p[0] + p[1]) + (p[2] + p[3]); } }
            asm volatile("s_waitcnt lgkmcnt(0)\n\ts_barrier" ::: "memory");
        }
    }
};
struct EpiRelu2 {
    static constexpr bool PERM = true, AFTER_DRAIN = false;
    bf16_t* O; const float* ssq; const float* shw0;
    __device__ __forceinline__ void operator()(const f32x4 (&acc)[2][2][4][2], const Unit& u, int wr, int wc, int fr_, int fq) const {
        int fr = fr_; asm volatile("" : "+v"(fr));
        const int row0 = u.pm * BMq + wr * 64 + fr, col0 = u.pn * BMq + wc * 32 + 8 * fq, rowt = u.pm * BMq;
        const float* shw = shw0 + (size_t)(rowt < MC ? 0 : 1 + (rowt - MC) / 4096) * DFF + col0;
        f32x4 sh[2][2];
#pragma unroll
        for (int bj = 0; bj < 2; ++bj) { sh[bj][0] = *(const f32x4*)(shw + bj * HALFq); sh[bj][1] = *(const f32x4*)(shw + bj * HALFq + 4); }
#pragma unroll
        for (int ai = 0; ai < 2; ++ai)
#pragma unroll
            for (int m = 0; m < 4; ++m) { const int r = row0 + ai * HALFq + m * 16; bf16_t* rowp = O + (size_t)r * DFF + col0; const float rs = rstd_of(ssq, r);
#pragma unroll
                for (int bj = 0; bj < 2; ++bj) { f32x4 v0 = acc[ai][bj][m][0] * rs + sh[bj][0], v1 = acc[ai][bj][m][1] * rs + sh[bj][1];
#pragma unroll
                    for (int k = 0; k < 4; ++k) { const float a = fmaxf(v0[k], 0.f), b = fmaxf(v1[k], 0.f); v0[k] = a * a; v1[k] = b * b; }
                    u32x4 w; w.x = cvt_pk_bf16(v0[0], v0[1]); w.y = cvt_pk_bf16(v0[2], v0[3]); w.z = cvt_pk_bf16(v1[0], v1[1]); w.w = cvt_pk_bf16(v1[2], v1[3]);
                    *(u32x4*)(rowp + bj * HALFq) = w; } }
    }
};
}
__device__ __forceinline__ float logsigmoidf_(float x) { return fminf(x, 0.f) - __logf(1.f + __expf(-fabsf(x))); }
__device__ __forceinline__ float softplusf_(float x) { return fmaxf(x, 0.f) + __logf(1.f + __expf(-fabsf(x))); }
__device__ __forceinline__ void load_tile128(Frame& F, LAS unsigned char* dst, const bf16* src) {
#pragma unroll
    for (int it = 0; it < 4; ++it) { const int i = F.tid + NT * it, r = i >> 4, c = i & 15;
        *(LAS v4u*)(dst + r * LDT + c * 16) = *(const v4u*)(src + (size_t)r * NPROJ + c * 8); }
}
template <int NDST> __device__ __forceinline__ void load_qk(Frame& F, LAS unsigned char* dst0, LAS unsigned char* dst1, const bf16* src, const LAS float* w0, const LAS float* w1, float scale, bool rope, int tpos0) {
#pragma unroll
    for (int it = 0; it < 2; ++it) {
        const int i = F.tid + NT * it, r = i >> 3, c = i & 7;
        float x1[8], x2[8];
        unpack8(*(const v4u*)(src + (size_t)r * NPROJ + c * 8), x1); unpack8(*(const v4u*)(src + (size_t)r * NPROJ + 64 + c * 8), x2);
        if (rope) {
            const int tp = tpos0 + r, pos = c < 4 ? (tp >> 6) : (tp & 63);
            const f32x2* rt = WSP(const f32x2, WS_ROPE) + pos * 32 + ((8 * c) & 31);
#pragma unroll
            for (int j = 0; j < 8; ++j) { const f32x2 cs = rt[j]; const float a = x1[j], b = x2[j]; x1[j] = a * cs.x - b * cs.y; x2[j] = a * cs.y + b * cs.x; }
        }
        const float s0 = scale * (w0 ? w0[r] : 1.f);
        *(LAS v4u*)(dst0 + r * LDT + c * 16) = pack8(x1, s0); *(LAS v4u*)(dst0 + r * LDT + 128 + c * 16) = pack8(x2, s0);
        if (NDST == 2) { const float s1 = scale * w1[r];
            *(LAS v4u*)(dst1 + r * LDT + c * 16) = pack8(x1, s1); *(LAS v4u*)(dst1 + r * LDT + 128 + c * 16) = pack8(x2, s1); }
    }
}
template <int NDST> __device__ __forceinline__ void load_conv(Frame& F, KArgs& A, int l, LAS unsigned char* dst0, LAS unsigned char* dst1, int ldd, int ch0, int nc8, int row0, int seq_lo, int seq_hi,
                                                               const LAS float* w0, const LAS float* w1, bool to_global) {
    const bf16* P = WSP(const bf16, WS_PROJ) + PC_DX + ch0;
    const float* cw = INP(I_CONVW) + (size_t)l * 5 * 1024 + ch0; const float* cb = INP(I_CONVB) + (size_t)l * 1024 + ch0;
    for (int i = F.tid; i < 128 * nc8; i += NT) {
        const int r = i / nc8, c = i % nc8, row = row0 + r;
        float acc[8];
        { const f32x4 b0 = *(const f32x4*)(cb + 8 * c), b1 = *(const f32x4*)(cb + 8 * c + 4); acc[0] = b0.x; acc[1] = b0.y; acc[2] = b0.z; acc[3] = b0.w; acc[4] = b1.x; acc[5] = b1.y; acc[6] = b1.z; acc[7] = b1.w; }
#pragma unroll
        for (int k = 0; k < 5; ++k) { const int rr = row + k - 2;
            if (rr >= seq_lo && rr < seq_hi) { float x[8]; unpack8(*(const v4u*)(P + (size_t)rr * NPROJ + 8 * c), x);
                const f32x4 w0v = *(const f32x4*)(cw + k * 1024 + 8 * c), w1v = *(const f32x4*)(cw + k * 1024 + 8 * c + 4);
                acc[0] += x[0] * w0v.x; acc[1] += x[1] * w0v.y; acc[2] += x[2] * w0v.z; acc[3] += x[3] * w0v.w; acc[4] += x[4] * w1v.x; acc[5] += x[5] * w1v.y; acc[6] += x[6] * w1v.z; acc[7] += x[7] * w1v.w; } }
#pragma unroll
        for (int j = 0; j < 8; ++j) acc[j] = siluf_(acc[j]);
        if (to_global) *(v4u*)(WSP(bf16, WS_XBCC) + (size_t)row * 1024 + ch0 + 8 * c) = pack8(acc, 1.f);
        if (NDST >= 1) *(LAS v4u*)(dst0 + r * ldd + c * 16) = pack8(acc, w0 ? w0[r] : 1.f);
        if (NDST == 2) *(LAS v4u*)(dst1 + r * ldd + c * 16) = pack8(acc, w1[r]);
    }
}
__device__ __forceinline__ void load_xbcc(Frame& F, LAS unsigned char* dst, int ldd, int ch0, int nc8, int row0) {
    const bf16* P = WSP(const bf16, WS_XBCC) + (size_t)row0 * 1024 + ch0;
    for (int i = F.tid; i < 128 * nc8; i += NT) { const int r = i / nc8, c = i % nc8; *(LAS v4u*)(dst + r * ldd + c * 16) = *(const v4u*)(P + (size_t)r * 1024 + 8 * c); }
}
__device__ __forceinline__ void kv_state_mfma(Frame& F, const LAS unsigned char* TKf, const LAS unsigned char* TKb, const LAS unsigned char* TV, bf16* outF, bf16* outB) {
    const int dvb = F.wave >> 1, dkb0 = (F.wave & 1) * 2, hh = F.lane >> 5;
    f32x16 acc[2][2] = {{ZERO16, ZERO16}, {ZERO16, ZERO16}};
#pragma unroll 1
    for (int ks = 0; ks < 8; ++ks) {
        const bf16x8 a = frag_tr(TV, LDT, 16 * ks, 32 * dvb, F.lane);
#pragma unroll
        for (int j = 0; j < 2; ++j) { acc[0][j] = MFMA32(a, frag_tr(TKf, LDT, 16 * ks, 32 * (dkb0 + j), F.lane), acc[0][j]); acc[1][j] = MFMA32(a, frag_tr(TKb, LDT, 16 * ks, 32 * (dkb0 + j), F.lane), acc[1][j]); }
    }
#pragma unroll
    for (int j = 0; j < 2; ++j)
#pragma unroll
        for (int i = 0; i < 16; ++i) { const int o = (32 * dvb + crow(i, hh)) * 128 + 32 * (dkb0 + j) + (F.lane & 31); outF[o] = (bf16)f2bf(acc[0][j][i]); outB[o] = (bf16)f2bf(acc[1][j][i]); }
}
__device__ __forceinline__ void qkT_mfma(Frame& F, const LAS unsigned char* TQ, const LAS unsigned char* TK, f32x16 (&qk)[2]) {
    const int tb = F.wave >> 1, sb0 = (F.wave & 1) * 2;
    qk[0] = ZERO16; qk[1] = ZERO16;
#pragma unroll 1
    for (int ks = 0; ks < 8; ++ks) { const bf16x8 bq = frag_row(TQ, LDT, 32 * tb, 16 * ks, F.lane);
#pragma unroll
        for (int j = 0; j < 2; ++j) qk[j] = MFMA32(frag_row(TK, LDT, 32 * (sb0 + j), 16 * ks, F.lane), bq, qk[j]); }
}
__device__ __forceinline__ void pv_mfma(Frame& F, const LAS unsigned char* TP, const LAS unsigned char* TV, f32x16 (&o)[2]) {
    const int tb = F.wave >> 1, eb0 = (F.wave & 1) * 2;
#pragma unroll 1
    for (int ks = 0; ks < 8; ++ks) { const bf16x8 ap = frag_row(TP, LDT, 32 * tb, 16 * ks, F.lane);
#pragma unroll
        for (int j = 0; j < 2; ++j) o[j] = MFMA32(ap, frag_tr(TV, LDT, 16 * ks, 32 * (eb0 + j), F.lane), o[j]); }
}
__device__ __forceinline__ void qs_prefetch(Frame& F, const bf16* ST, bf16x8 (&b)[2][8]) {
    const int eb0 = (F.wave & 1) * 2, hh = F.lane >> 5;
#pragma unroll
    for (int j = 0; j < 2; ++j)
#pragma unroll
        for (int ks = 0; ks < 8; ++ks) b[j][ks] = *(const bf16x8*)(ST + (size_t)(32 * (eb0 + j) + (F.lane & 31)) * 128 + 16 * ks + 8 * hh);
}
__device__ __forceinline__ void qs_mfma(Frame& F, const LAS unsigned char* TQ, const bf16x8 (&b)[2][8], f32x16 (&o)[2]) {
    const int tb = F.wave >> 1;
#pragma unroll
    for (int ks = 0; ks < 8; ++ks) { const bf16x8 aq = frag_row(TQ, LDT, 32 * tb, 16 * ks, F.lane);
#pragma unroll
        for (int j = 0; j < 2; ++j) o[j] = MFMA32(aq, b[j][ks], o[j]); }
}
__device__ __forceinline__ void hs_to_lds(Frame& F, LAS unsigned char* HS, const f32x16 (&hs)[2]) {
    const int tb = F.wave >> 1, eb0 = (F.wave & 1) * 2, hh = F.lane >> 5;
#pragma unroll
    for (int j = 0; j < 2; ++j)
#pragma unroll
        for (int i = 0; i < 16; ++i) *(LAS float*)(HS + (32 * tb + crow(i, hh)) * 528 + (32 * (eb0 + j) + (F.lane & 31)) * 4) = hs[j][i];
}
template <int GATE> __device__ __forceinline__ void head_out(Frame& F, const LAS unsigned char* HS, const float* gain, const bf16* gsrc  , bf16* ydst  ) {
    const int t = F.tid >> 2, seg = F.tid & 3;
    float v[32]; float ss = 0.f;
#pragma unroll
    for (int k = 0; k < 8; ++k) { const f32x4 x = *(const LAS f32x4*)(HS + t * 528 + (32 * seg + 4 * k) * 4); v[4 * k] = x.x; v[4 * k + 1] = x.y; v[4 * k + 2] = x.z; v[4 * k + 3] = x.w; ss += (x.x * x.x + x.y * x.y) + (x.z * x.z + x.w * x.w); }
    ss += __shfl_xor(ss, 1); ss += __shfl_xor(ss, 2);
    const float r = rsqrtf(ss * (1.f / 128.f) + EPS);
#pragma unroll
    for (int k = 0; k < 4; ++k) { float g[8]; unpack8(*(const v4u*)(gsrc + (size_t)t * NPROJ + 32 * seg + 8 * k), g); float o[8];
#pragma unroll
        for (int j = 0; j < 8; ++j) { const float gg = GATE == 0 ? sigmoidf_(g[j]) : siluf_(g[j]); o[j] = v[8 * k + j] * r * gain[32 * seg + 8 * k + j] * gg; }
        *(v4u*)(ydst + (size_t)t * D + 32 * seg + 8 * k) = pack8(o, 1.f); }
}

__device__ __forceinline__ void mlstm_gates(Frame& F, KArgs& A, int l, int cp, int h) {
    if (F.tid < 128) { const float* g = WSP(const float, WS_GATES) + (size_t)(cp * 128 + F.tid) * 32;
        SCA(0)[F.tid] = g[h] + INP(I_MIB)[(l * 2 + 0) * 4 + h]; SCA(1)[F.tid] = g[4 + h] + INP(I_MIB)[(l * 2 + 1) * 4 + h];
        SCA(2)[F.tid] = logsigmoidf_(g[8 + h] + INP(I_MFB)[(l * 2 + 0) * 4 + h]); SCA(3)[F.tid] = logsigmoidf_(g[12 + h] + INP(I_MFB)[(l * 2 + 1) * 4 + h]); }
    BAR();
    if (F.wave == 0) wave_scan128<false>(SCA(2), SCA(4), F.lane, false, 0.f);
    if (F.wave == 1) wave_scan128<false>(SCA(3), SCA(5), F.lane, true, 0.f);
    BAR();
}
__device__ __forceinline__ void mlstm_local_item(Frame F, KArgs& A, int l, int cp, int h) {
    mlstm_gates(F, A, l, cp, h);
    if (F.wave < 2) { const int d = F.wave; const LAS float* bc = SCA(4 + d); const LAS float* ig = SCA(d); const float tot = d == 0 ? bc[127] : bc[0];
        const int s0 = 2 * F.lane; const float g0 = tot - bc[s0] + ig[s0], g1 = tot - bc[s0 + 1] + ig[s0 + 1];
        const float mx = wave_max(fmaxf(g0, g1));
        SCA(6 + d)[s0] = __expf(g0 - mx); SCA(6 + d)[s0 + 1] = __expf(g1 - mx);
        if (F.lane == 0) { float* sc = WSP(float, WS_MLSC) + ((cp * 2 + d) * 4 + h) * 2; sc[0] = tot; sc[1] = mx; } }
    BAR();
    const bf16* P = WSP(const bf16, WS_PROJ) + (size_t)cp * 128 * NPROJ;
    load_qk<2>(F, F.lds, F.lds + TS, P + PC_MK + h * 128, SCA(6), SCA(7), 0.08838834764831845f, false, 0);
    load_tile128(F, F.lds + 2 * TS, P + PC_MV + h * 128);
    BAR();
    kv_state_mfma(F, F.lds, F.lds + TS, F.lds + 2 * TS, WSP(bf16, WS_MLCLOC) + (size_t)((cp * 2 + 0) * 4 + h) * 16384, WSP(bf16, WS_MLCLOC) + (size_t)((cp * 2 + 1) * 4 + h) * 16384);
    if (F.tid < 256) { const int d = F.tid >> 7, dk = F.tid & 127; const LAS unsigned char* T = F.lds + d * TS; float s = 0.f;
        for (int r = 0; r < 128; ++r) s += bf2f(*(const LAS unsigned short*)(T + r * LDT + dk * 2));
        WSP(float, WS_MLNLOC)[((cp * 2 + d) * 4 + h) * 128 + dk] = s; }
    BAR();
}
__device__ __forceinline__ void mlstm_out_item(Frame F, KArgs& A, int l, int cp, int h) {
    const Seq sq = seq_of(cp);
    mlstm_gates(F, A, l, cp, h);
    const float min_f = WSP(const float, WS_MLMIN)[(cp * 2 + 0) * 4 + h], min_b = WSP(const float, WS_MLMIN)[(cp * 2 + 1) * 4 + h];
    if (F.tid < 256) { const int d = F.tid >> 7, s = F.tid & 127; SCA(6 + d)[s] = SCA(d)[s] - SCA(4 + d)[s]; }
    BAR();
    if (F.wave == 0) wave_scan128<true>(SCA(6), SCA(8), F.lane, false, min_f);
    if (F.wave == 1) wave_scan128<true>(SCA(7), SCA(9), F.lane, true, min_b);
    const bf16* P = WSP(const bf16, WS_PROJ) + (size_t)cp * 128 * NPROJ;
    LAS unsigned char* TQ = F.lds; LAS unsigned char* TK = F.lds + TS; LAS unsigned char* TV = F.lds + 2 * TS; LAS unsigned char* TP = F.lds + 3 * TS;
    load_tile128(F, TQ, P + PC_MQ + h * 128);
    load_qk<1>(F, TK, nullptr, P + PC_MK + h * 128, nullptr, nullptr, 0.08838834764831845f, false, 0);
    load_tile128(F, TV, P + PC_MV + h * 128);
    BAR();
    f32x16 hs[2] = {ZERO16, ZERO16};
    const int tb = F.wave >> 1, sb0 = (F.wave & 1) * 2, hh = F.lane >> 5, t = 32 * tb + (F.lane & 31);
#pragma unroll 1
    for (int d = 0; d < 2; ++d) {
        const LAS float* av = SCA(6 + d); const float Mt = SCA(8 + d)[t]; const float m_in = d == 0 ? min_f : min_b;
        if (F.tid < 128) SCA(12)[F.tid] = WSP(const float, WS_MLNIN)[((cp * 2 + d) * 4 + h) * 128 + F.tid];
        f32x16 qk[2]; qkT_mfma(F, TQ, TK, qk);
#pragma unroll
        for (int j = 0; j < 2; ++j)
#pragma unroll
            for (int i4 = 0; i4 < 4; ++i4) { const int sb = 32 * (sb0 + j) + 8 * i4 + 4 * hh; float p[4];
#pragma unroll
                for (int i = 0; i < 4; ++i) { const int s = sb + i; const bool ok = d == 0 ? (s <= t) : (s >= t); p[i] = ok ? qk[j][4 * i4 + i] * __expf(av[s] - Mt) : 0.f; }
                *(LAS u32x2*)(TP + t * LDT + sb * 2) = (u32x2){pk2(p[0], p[1]), pk2(p[2], p[3])}; }
        const bool has_state = sq.lat || (d == 0 ? sq.c > 0 : sq.c < sq.nch - 1);
        bf16x8 bst[2][8]; if (has_state) qs_prefetch(F, WSP(const bf16, WS_MLCIN) + (size_t)((cp * 2 + d) * 4 + h) * 16384, bst);
        BAR();
        if (F.tid < 128) { const int tt = F.tid; float ds = 0.f, qn = 0.f;
#pragma unroll 4
            for (int k = 0; k < 16; ++k) { float x[8]; unpack8(*(const LAS v4u*)(TP + tt * LDT + 16 * k), x); float q[8]; unpack8(*(const LAS v4u*)(TQ + tt * LDT + 16 * k), q);
#pragma unroll
                for (int j = 0; j < 8; ++j) { ds += x[j]; qn += q[j] * SCA(12)[8 * k + j]; } }
            const float Mtt = SCA(8 + d)[tt], wint = __expf(m_in - Mtt), den = ds + wint * qn, dd = fmaxf(fabsf(den), __expf(-(SCA(4 + d)[tt] + Mtt)));
            SCA(10)[tt] = wint / dd; SCA(11)[tt] = 1.f / dd; }
        { f32x16 num[2] = {ZERO16, ZERO16};
          pv_mfma(F, TP, TV, num);
          BAR();
#pragma unroll
          for (int j = 0; j < 2; ++j)
#pragma unroll
            for (int i = 0; i < 16; ++i) hs[j][i] += SCA(11)[32 * tb + crow(i, hh)] * num[j][i]; }
        if (has_state) { f32x16 qc[2] = {ZERO16, ZERO16};
          qs_mfma(F, TQ, bst, qc);
#pragma unroll
          for (int j = 0; j < 2; ++j)
#pragma unroll
            for (int i = 0; i < 16; ++i) hs[j][i] += SCA(10)[32 * tb + crow(i, hh)] * qc[j][i]; }
    }
    BAR();
    hs_to_lds(F, F.lds, hs);
    BAR();
    head_out<0>(F, F.lds, INP(I_MNORM) + (size_t)l * GWID + h * 128, P + PC_MO + h * 128, WSP(bf16, WS_Y) + (size_t)cp * 128 * D + 512 + h * 128);
    BAR();
}

__device__ __forceinline__ void ret_local_item(Frame F, KArgs& A, int l, int cp, int h) {
    const float lgf = -__expf(INP(I_RRATE)[(l * 2 + 0) * 4 + h]), lgb = -__expf(INP(I_RRATE)[(l * 2 + 1) * 4 + h]);
    if (F.tid < 128) { SCA(6)[F.tid] = __expf((127.f - (float)F.tid) * lgf); SCA(7)[F.tid] = __expf((float)F.tid * lgb); }
    BAR();
    const Seq sq = seq_of(cp);
    const bf16* P = WSP(const bf16, WS_PROJ) + (size_t)cp * 128 * NPROJ;
    load_qk<2>(F, F.lds, F.lds + TS, P + PC_RK + h * 128, SCA(6), SCA(7), 0.08838834764831845f, sq.lat != 0, sq.c * 128);
    load_tile128(F, F.lds + 2 * TS, P + PC_RV + h * 128);
    BAR();
    kv_state_mfma(F, F.lds, F.lds + TS, F.lds + 2 * TS, WSP(bf16, WS_RTLOC) + (size_t)((cp * 2 + 0) * 4 + h) * 16384, WSP(bf16, WS_RTLOC) + (size_t)((cp * 2 + 1) * 4 + h) * 16384);
    BAR();
}
__device__ __forceinline__ void ret_out_item(Frame F, KArgs& A, int l, int cp, int h) {
    const float lgf = -__expf(INP(I_RRATE)[(l * 2 + 0) * 4 + h]), lgb = -__expf(INP(I_RRATE)[(l * 2 + 1) * 4 + h]);
    if (F.tid < 128) { SCA(10)[F.tid] = __expf(((float)F.tid + 1.f) * lgf); SCA(11)[F.tid] = __expf((128.f - (float)F.tid) * lgb); }
    const Seq sq = seq_of(cp);
    const bf16* P = WSP(const bf16, WS_PROJ) + (size_t)cp * 128 * NPROJ;
    LAS unsigned char* TQ = F.lds; LAS unsigned char* TK = F.lds + TS; LAS unsigned char* TV = F.lds + 2 * TS; LAS unsigned char* TP = F.lds + 3 * TS;
    load_qk<1>(F, TQ, nullptr, P + PC_RQ + h * 128, nullptr, nullptr, 1.f, sq.lat != 0, sq.c * 128);
    load_qk<1>(F, TK, nullptr, P + PC_RK + h * 128, nullptr, nullptr, 0.08838834764831845f, sq.lat != 0, sq.c * 128);
    load_tile128(F, TV, P + PC_RV + h * 128);
    BAR();
    f32x16 qk[2]; qkT_mfma(F, TQ, TK, qk);
    const int tb = F.wave >> 1, sb0 = (F.wave & 1) * 2, hh = F.lane >> 5, t = 32 * tb + (F.lane & 31);
#pragma unroll
    for (int j = 0; j < 2; ++j)
#pragma unroll
        for (int i4 = 0; i4 < 4; ++i4) { const int sb = 32 * (sb0 + j) + 8 * i4 + 4 * hh; float p[4];
#pragma unroll
            for (int i = 0; i < 4; ++i) { const int s = sb + i; const float df = (float)(t - s);
                const float dm = (s <= t ? __expf(df * lgf) : 0.f) + (s >= t ? __expf(-df * lgb) : 0.f); p[i] = qk[j][4 * i4 + i] * dm; }
            *(LAS u32x2*)(TP + t * LDT + sb * 2) = (u32x2){pk2(p[0], p[1]), pk2(p[2], p[3])}; }
    BAR();
    f32x16 y[2] = {ZERO16, ZERO16};
    pv_mfma(F, TP, TV, y);
#pragma unroll 1
    for (int d = 0; d < 2; ++d) { f32x16 qs[2] = {ZERO16, ZERO16};
        if (!sq.lat && (d == 0 ? sq.c == 0 : sq.c == sq.nch - 1)) continue;
        bf16x8 bst[2][8]; qs_prefetch(F, WSP(const bf16, WS_RTIN) + (size_t)((cp * 2 + d) * 4 + h) * 16384, bst);
        qs_mfma(F, TQ, bst, qs);
#pragma unroll
        for (int j = 0; j < 2; ++j)
#pragma unroll
            for (int i = 0; i < 16; ++i) y[j][i] += SCA(10 + d)[32 * tb + crow(i, hh)] * qs[j][i]; }
    BAR();
    hs_to_lds(F, F.lds, y);
    BAR();
    head_out<1>(F, F.lds, INP(I_RNORM) + (size_t)l * GWID + h * 128, P + PC_RG + h * 128, WSP(bf16, WS_Y) + (size_t)cp * 128 * D + 1024 + h * 128);
    BAR();
}
template <bool WMODE> __device__ __forceinline__ float ssd_scalars(Frame& F, KArgs& A, int l, int cp, int g) {
    const int d = F.wave >> 2, rr = F.wave & 3, head = g * 4 + rr;
    const float bias = INP(I_DTB)[(l * 2 + d) * 8 + head], arate = -__expf(INP(I_ALOG)[(l * 2 + d) * 8 + head]);
    const float* gp = WSP(const float, WS_GATES) + (size_t)(cp * 128) * 32 + 16 + d * 8 + head;
    const int i0 = d ? 127 - 2 * F.lane : 2 * F.lane, i1 = d ? i0 - 1 : i0 + 1;
    const float dt0 = softplusf_(gp[(size_t)i0 * 32] + bias), dt1 = softplusf_(gp[(size_t)i1 * 32] + bias);
    const float a0 = dt0 * arate, a1 = dt1 * arate;
    float inc = a0 + a1;
#pragma unroll
    for (int o = 1; o < 64; o <<= 1) { const float t = __shfl_up(inc, o); if (F.lane >= o) inc += t; }
    const float c1 = inc, c0 = inc - a1, tot = __shfl(inc, 63);
    LAS float* cum = SCA(16 + d * 4 + rr); LAS float* dtw = SCA(24 + d * 4 + rr);
    cum[i0] = c0; cum[i1] = c1;
    if (WMODE) { dtw[i0] = __expf(tot - c0) * dt0; dtw[i1] = __expf(tot - c1) * dt1; } else { dtw[i0] = dt0; dtw[i1] = dt1; }
    return tot;
}
__device__ __forceinline__ void seq_bounds(int cp, int& lo, int& hi) { if (cp < 64) { lo = (cp >> 1) * 256; hi = lo + 256; } else { lo = MC + ((cp - 64) >> 5) * 4096; hi = lo + 4096; } }
__device__ __forceinline__ void ssd_local_item(Frame F, KArgs& A, int l, int cp, int g) {
    const float tot = ssd_scalars<true>(F, A, l, cp, g);
    if (F.lane == 0) WSP(float, WS_SDSC)[(cp * 2 + (F.wave >> 2)) * 8 + g * 4 + (F.wave & 3)] = tot;
    int lo, hi; seq_bounds(cp, lo, hi);
    LAS unsigned char* TB = F.lds;
    load_conv<1>(F, A, l, TB, nullptr, LDT, 512 + g * 128, 16, cp * 128, lo, hi, nullptr, nullptr, true);
    load_conv<0>(F, A, l, nullptr, nullptr, LDT, 768 + g * 128, 16, cp * 128, lo, hi, nullptr, nullptr, true);
    BAR();
#pragma unroll 1
    for (int hr = 0; hr < 2; ++hr) {
#pragma unroll 1
        for (int r2 = 0; r2 < 2; ++r2) { const int rr = hr * 2 + r2;
            load_conv<2>(F, A, l, F.lds + TS + (r2 * 2 + 0) * TSX, F.lds + TS + (r2 * 2 + 1) * TSX, LDX, g * 256 + rr * 64, 8, cp * 128, lo, hi, SCA(24 + 0 * 4 + rr), SCA(24 + 1 * 4 + rr), true); }
        BAR();
        const int r2 = F.wave >> 2, d = (F.wave >> 1) & 1, pb = F.wave & 1, hh = F.lane >> 5, head = g * 4 + hr * 2 + r2;
        const LAS unsigned char* TX = F.lds + TS + (r2 * 2 + d) * TSX;
        f32x16 acc[4] = {ZERO16, ZERO16, ZERO16, ZERO16};
#pragma unroll 1
        for (int ks = 0; ks < 8; ++ks) { const bf16x8 a = frag_tr(TX, LDX, 16 * ks, 32 * pb, F.lane);
#pragma unroll
            for (int nb = 0; nb < 4; ++nb) acc[nb] = MFMA32(a, frag_tr(TB, LDT, 16 * ks, 32 * nb, F.lane), acc[nb]); }
        bf16* o = WSP(bf16, WS_SDLOC) + (size_t)((cp * 2 + d) * 8 + head) * 8192;
#pragma unroll
        for (int nb = 0; nb < 4; ++nb)
#pragma unroll
            for (int i = 0; i < 16; ++i) o[(32 * pb + crow(i, hh)) * 128 + 32 * nb + (F.lane & 31)] = (bf16)f2bf(acc[nb][i]);
        BAR();
    }
}
__device__ __forceinline__ void ssd_out_item(Frame F, KArgs& A, int l, int cp, bf16* Ybase) {
    const Seq sq = seq_of(cp);
    LAS unsigned char* TC = F.lds; LAS unsigned char* TB = F.lds + TS; LAS unsigned char* TP = F.lds + 2 * TS; LAS unsigned char* TX = F.lds + 3 * TS;
    LAS float* SSQ = SCA(14);
    if (F.tid < 128) SSQ[F.tid] = 0.f;
    const int tb = F.wave >> 1, sb0 = (F.wave & 1) * 2, pb = F.wave & 1, hh = F.lane >> 5, t = 32 * tb + (F.lane & 31);
    const bf16* Pz = WSP(const bf16, WS_PROJ) + (size_t)cp * 128 * NPROJ + PC_DZ;
    bf16* Yd = Ybase + (size_t)cp * 128 * D + 1536;
#pragma unroll 1
    for (int g = 0; g < 2; ++g) {
        (void)ssd_scalars<false>(F, A, l, cp, g);
        load_xbcc(F, TC, LDT, 768 + g * 128, 16, cp * 128);
        load_xbcc(F, TB, LDT, 512 + g * 128, 16, cp * 128);
        BAR();
        f32x16 cb[2] = {ZERO16, ZERO16};
#pragma unroll 1
        for (int ks = 0; ks < 8; ++ks) { const bf16x8 bq = frag_row(TC, LDT, 32 * tb, 16 * ks, F.lane);
#pragma unroll
            for (int j = 0; j < 2; ++j) cb[j] = MFMA32(frag_row(TB, LDT, 32 * (sb0 + j), 16 * ks, F.lane), bq, cb[j]); }
#pragma unroll 1
        for (int rr = 0; rr < 4; ++rr) {
            const int head = g * 4 + rr;
            load_xbcc(F, TX, LDX, g * 256 + rr * 64, 8, cp * 128);
            f32x16 y = ZERO16;
#pragma unroll 1
            for (int d = 0; d < 2; ++d) {
                const LAS float* cum = SCA(16 + d * 4 + rr); const LAS float* dtv = SCA(24 + d * 4 + rr); const float ct = cum[t];
#pragma unroll
                for (int j = 0; j < 2; ++j)
#pragma unroll
                    for (int i4 = 0; i4 < 4; ++i4) { const int sb = 32 * (sb0 + j) + 8 * i4 + 4 * hh; float p[4];
#pragma unroll
                        for (int i = 0; i < 4; ++i) { const int s = sb + i; const bool ok = d == 0 ? (s <= t) : (s >= t); p[i] = ok ? cb[j][4 * i4 + i] * __expf(ct - cum[s]) * dtv[s] : 0.f; }
                        *(LAS u32x2*)(TP + t * LDT + sb * 2) = (u32x2){pk2(p[0], p[1]), pk2(p[2], p[3])}; }
                const bool has_state = sq.lat || (d == 0 ? sq.c > 0 : sq.c < sq.nch - 1);
                bf16x8 bh[8];
                if (has_state) { const bf16* hin = WSP(const bf16, WS_SDIN) + (size_t)((cp * 2 + d) * 8 + head) * 8192;
#pragma unroll
                  for (int ks = 0; ks < 8; ++ks) bh[ks] = *(const bf16x8*)(hin + (size_t)(32 * pb + (F.lane & 31)) * 128 + 16 * ks + 8 * hh); }
                BAR();
                f32x16 pv = ZERO16, ch = ZERO16;
#pragma unroll 2
                for (int ks = 0; ks < 8; ++ks)
                    pv = MFMA32(frag_row(TP, LDT, 32 * tb, 16 * ks, F.lane), frag_tr(TX, LDX, 16 * ks, 32 * pb, F.lane), pv);
                if (has_state) {
#pragma unroll
                    for (int ks = 0; ks < 8; ++ks) ch = MFMA32(frag_row(TC, LDT, 32 * tb, 16 * ks, F.lane), bh[ks], ch); }
#pragma unroll
                for (int i = 0; i < 16; ++i) y[i] += pv[i] + __expf(cum[32 * tb + crow(i, hh)]) * ch[i];
                BAR();
            }
#pragma unroll
            for (int i = 0; i < 16; ++i) *(LAS float*)(TP + (32 * tb + crow(i, hh)) * LDT + (32 * pb + (F.lane & 31)) * 4) = y[i];
            BAR();
            { const int tt = F.tid >> 2, seg = F.tid & 3; const float Dh = INP(I_SSDD)[l * 8 + head];
                float z[16], x[16], o[16]; float ss = 0.f;
                { float t8[8]; unpack8(*(const v4u*)(Pz + (size_t)tt * NPROJ + head * 64 + 16 * seg), t8); for (int j = 0; j < 8; ++j) z[j] = t8[j];
                  unpack8(*(const v4u*)(Pz + (size_t)tt * NPROJ + head * 64 + 16 * seg + 8), t8); for (int j = 0; j < 8; ++j) z[8 + j] = t8[j];
                  unpack8(*(const LAS v4u*)(TX + tt * LDX + 32 * seg), t8); for (int j = 0; j < 8; ++j) x[j] = t8[j];
                  unpack8(*(const LAS v4u*)(TX + tt * LDX + 32 * seg + 16), t8); for (int j = 0; j < 8; ++j) x[8 + j] = t8[j]; }
#pragma unroll
                for (int k = 0; k < 4; ++k) { const f32x4 yv = *(const LAS f32x4*)(TP + tt * LDT + (16 * seg + 4 * k) * 4);
                    const float yy[4] = {yv.x, yv.y, yv.z, yv.w};
#pragma unroll
                    for (int j = 0; j < 4; ++j) { const float v = (yy[j] + Dh * x[4 * k + j]) * siluf_(z[4 * k + j]); o[4 * k + j] = v; ss += v * v; } }
                ss += __shfl_xor(ss, 1); ss += __shfl_xor(ss, 2);
                if (seg == 0) SSQ[tt] += ss;
                float o0[8], o1[8];
#pragma unroll
                for (int j = 0; j < 8; ++j) { o0[j] = o[j]; o1[j] = o[8 + j]; }
                *(v4u*)(Yd + (size_t)tt * D + head * 64 + 16 * seg) = pack8(o0, 1.f); *(v4u*)(Yd + (size_t)tt * D + head * 64 + 16 * seg + 8) = pack8(o1, 1.f); }
            BAR();
        }
    }
    __builtin_amdgcn_fence(__ATOMIC_RELEASE, "workgroup"); asm volatile("s_waitcnt vmcnt(0)" ::: "memory"); __syncthreads(); __builtin_amdgcn_fence(__ATOMIC_ACQUIRE, "workgroup");
    { const int tt = F.tid >> 2, seg = F.tid & 3; const float r = rsqrtf(SSQ[tt] * (1.f / 512.f) + EPS); const float* gn = INP(I_SNORM) + (size_t)l * GWID + 128 * seg;
#pragma unroll 4
        for (int k = 0; k < 16; ++k) { bf16* p = Yd + (size_t)tt * D + 128 * seg + 8 * k; float v[8];
            unpack8(__builtin_nontemporal_load((const v4u*)p), v);
#pragma unroll
            for (int j = 0; j < 8; ++j) v[j] = v[j] * r * gn[8 * k + j];
            *(v4u*)p = pack8(v, 1.f); } }
    BAR();
}
template <int PASS> __device__ __forceinline__ void s5_item(Frame F, KArgs& A, int l, int cp, int gq) {
    const Seq sq = seq_of(cp);
    const int g = gq * 8 + F.wave, p = F.lane, hh = F.lane >> 5;
    LAS unsigned char* TU = F.lds; LAS unsigned char* BU = F.lds + TS + F.wave * 8704;
    load_tile128(F, TU, WSP(const bf16, WS_PROJ) + (size_t)cp * 128 * NPROJ + PC_S5U + gq * 128);
    BAR();
    typedef float f32x4v __attribute__((ext_vector_type(4)));
    f32x4v yacc[4][2];
    if (PASS == 1) {
#pragma unroll
        for (int a = 0; a < 4; ++a) { yacc[a][0] = (f32x4v){0.f, 0.f, 0.f, 0.f}; yacc[a][1] = (f32x4v){0.f, 0.f, 0.f, 0.f}; } }
#pragma unroll 1
    for (int d = 0; d < 2; ++d) {
        const unsigned char* tab = s5tab(F, l, d, g);
        const float lr = ((const float*)tab)[2 * p], li = ((const float*)tab)[2 * p + 1];
        float hr = 0.f, hi = 0.f;
        if (PASS == 1) {
            if (sq.lat) { const size_t o = (size_t)(((sq.b * 4 + l) * 2 + d) * 32 + g) * 64 + p; hr = INP(I_SS5R)[o]; hi = INP(I_SS5I)[o]; }
            const float l8r = ((const float*)(tab + 512))[2 * p], l8i = ((const float*)(tab + 512))[2 * p + 1];
            const int n = d == 0 ? sq.c : sq.nch - 1 - sq.c;
            for (int k0 = 0; k0 < n; k0 += 8) {
                f32x2 e[8];
#pragma unroll
                for (int j = 0; j < 8; ++j) { const int k = (k0 + j < n) ? k0 + j : n - 1, cc = d == 0 ? k : sq.nch - 1 - k;
                    e[j] = *(const f32x2*)(WSP(const float, WS_S5LOC) + ((size_t)(((sq.cp0 + cc) * 2 + d) * 32 + g) * 64 + p) * 2); }
#pragma unroll
                for (int j = 0; j < 8; ++j) if (k0 + j < n) { const float nr = l8r * hr - l8i * hi + e[j].x, ni = l8r * hi + l8i * hr + e[j].y; hr = nr; hi = ni; }
            }
        }
        const bf16* bb = (const bf16*)(tab + 1024); const bf16* ct = (const bf16*)(tab + 5120);
        typedef short v8s __attribute__((ext_vector_type(8)));
        const int r16 = F.lane & 15, g4 = F.lane >> 4;
        bf16x8 bbf[4]; v8s ctf[4];
#pragma unroll
        for (int nb = 0; nb < 4; ++nb) bbf[nb] = *(const bf16x8*)(bb + (size_t)(32 * nb + (F.lane & 31)) * 16 + 8 * hh);
        if (PASS == 1) {
#pragma unroll
            for (int ks = 0; ks < 4; ++ks) ctf[ks] = *(const v8s*)(ct + r16 * 128 + 32 * ks + 8 * g4); }
#pragma unroll 1
        for (int tbi = 0; tbi < 4; ++tbi) {
            const int tb = d == 0 ? tbi : 3 - tbi;
            const bf16x8 bu = frag_row(TU, LDT, 32 * tb, 16 * F.wave, F.lane);
#pragma unroll
            for (int nb = 0; nb < 4; ++nb) {
                const f32x16 acc = MFMA32(bbf[nb], bu, ZERO16);
#pragma unroll
                for (int i4 = 0; i4 < 4; ++i4) *(LAS u32x2*)(BU + (F.lane & 31) * LDT + (32 * nb + 8 * i4 + 4 * hh) * 2) = (u32x2){pk2(acc[4 * i4], acc[4 * i4 + 1]), pk2(acc[4 * i4 + 2], acc[4 * i4 + 3])};
            }
            asm volatile("s_waitcnt lgkmcnt(0)" ::: "memory");
            unsigned w[32];
#pragma unroll
            for (int st = 0; st < 32; ++st) { const int tl = d == 0 ? st : 31 - st; w[st] = *(const LAS unsigned*)(BU + tl * LDT + p * 4); }
#pragma unroll
            for (int st = 0; st < 32; ++st) { const float br = bflo(w[st]), bi = bfhi(w[st]);
                const float nr = lr * hr - li * hi + br, ni = lr * hi + li * hr + bi; hr = nr; hi = ni;
                if (PASS == 1) w[st] = pk2(hr, hi); }
            if (PASS == 1) {
#pragma unroll
                for (int st = 0; st < 32; ++st) { const int tl = d == 0 ? st : 31 - st; *(LAS unsigned*)(BU + tl * LDT + p * 4) = w[st]; }
                asm volatile("s_waitcnt lgkmcnt(0)" ::: "memory");
                f32x4v y0 = (f32x4v){0.f, 0.f, 0.f, 0.f}, y1 = y0;
#pragma unroll
                for (int ks = 0; ks < 4; ++ks) {
                    y0 = __builtin_amdgcn_mfma_f32_16x16x32_bf16(*(const LAS v8s*)(BU + r16 * LDT + (32 * ks + 8 * g4) * 2), ctf[ks], y0, 0, 0, 0);
                    y1 = __builtin_amdgcn_mfma_f32_16x16x32_bf16(*(const LAS v8s*)(BU + (16 + r16) * LDT + (32 * ks + 8 * g4) * 2), ctf[ks], y1, 0, 0, 0); }
                if (tb == 0) { yacc[0][0] += y0; yacc[0][1] += y1; } else if (tb == 1) { yacc[1][0] += y0; yacc[1][1] += y1; } else if (tb == 2) { yacc[2][0] += y0; yacc[2][1] += y1; } else { yacc[3][0] += y0; yacc[3][1] += y1; }
                asm volatile("s_waitcnt lgkmcnt(0)" ::: "memory");
            }
        }
        if (PASS == 0) { *(f32x2*)(WSP(float, WS_S5LOC) + ((size_t)((cp * 2 + d) * 32 + g) * 64 + p) * 2) = (f32x2){hr, hi}; }
        else if (!sq.lat && ((d == 0 && sq.c == sq.nch - 1) || (d == 1 && sq.c == 0))) { const size_t o = (size_t)(((sq.b * 4 + l) * 2 + d) * 32 + g) * 64 + p; F.out[O_S5R + o] = hr; F.out[O_S5I + o] = hi; }
    }
    if (PASS == 1) {
        const int r16 = F.lane & 15, g4 = F.lane >> 4; const float Dc = INP(I_S5D)[(size_t)l * GWID + g * 16 + r16];
#pragma unroll
        for (int tb = 0; tb < 4; ++tb)
#pragma unroll
            for (int ts = 0; ts < 2; ++ts)
#pragma unroll
                for (int i = 0; i < 4; ++i) { const int t = 32 * tb + 16 * ts + 4 * g4 + i; LAS unsigned short* up = (LAS unsigned short*)(TU + t * LDT + (16 * F.wave + r16) * 2);
                    const float x = yacc[tb][ts][i] + Dc * bf2f(*up);
                    const float u2 = 1.5957691216057308f * (x + 0.044715f * x * x * x); const float ge = x - x / (1.f + __expf(u2));
                    *up = (unsigned short)f2bf(ge); }
        BAR();
        bf16* ya = WSP(bf16, WS_YA) + (size_t)cp * 128 * GWID + gq * 128;
#pragma unroll
        for (int it = 0; it < 4; ++it) { const int i = F.tid + NT * it, r = i >> 4, c = i & 15; *(v4u*)(ya + (size_t)r * GWID + c * 8) = *(const LAS v4u*)(TU + r * LDT + c * 16); }
    }
    BAR();
}

template <bool LAT> __device__ __forceinline__ void carry_unit(Frame F, KArgs& A, int l, int u) {
    const int sd = u / 96, rem = u % 96, sidx = sd >> 1, d = sd & 1;
    constexpr int lat = LAT ? 1 : 0, nch = LAT ? 32 : 2, NB = LAT ? 8 : 2;
    const int b = LAT ? sidx : sidx - 4, cp0 = LAT ? 64 + 32 * b : 2 * b;
    int type, head, slice;
    if (rem < 32) { type = 0; head = rem >> 3; slice = rem & 7; } else if (rem < 64) { type = 1; head = (rem - 32) >> 3; slice = (rem - 32) & 7; } else { type = 2; head = (rem - 64) >> 2; slice = (rem - 64) & 3; }
    const int e0 = slice * 2048 + F.tid * 4;
    const int nh = type == 2 ? 8 : 4, esz = type == 2 ? 8192 : 16384;
    const bf16* loc = type == 0 ? WSP(const bf16, WS_MLCLOC) : (type == 1 ? WSP(const bf16, WS_RTLOC) : WSP(const bf16, WS_SDLOC));
    bf16* inb = type == 0 ? WSP(bf16, WS_MLCIN) : (type == 1 ? WSP(bf16, WS_RTIN) : WSP(bf16, WS_SDIN));
    float zf = 0.f; asm volatile("" : "+v"(zf));
    float v[4] = {zf, zf, zf, zf}, nv[4] = {zf, zf, zf, zf}, m = 0.f;
    const bool do_n = (type == 0 && slice == 0 && F.tid < 32);
    if (LAT) {
        if (type == 2) { const f32x4 s = *(const f32x4*)(INP(I_SSSD) + (size_t)(((b * 4 + l) * 2 + d) * 8 + head) * 8192 + e0); v[0] = s.x; v[1] = s.y; v[2] = s.z; v[3] = s.w; }
        else { const float* s = (type == 0 ? INP(I_SMC) : INP(I_SRET)) + (size_t)(((b * 4 + l) * 2 + d) * 4 + head) * 16384; const int dv = e0 >> 7, dk = e0 & 127;
#pragma unroll
            for (int j = 0; j < 4; ++j) v[j] = s[(dk + j) * 128 + dv]; }
        if (type == 0) { m = INP(I_SMM)[((b * 4 + l) * 2 + d) * 4 + head];
            if (do_n) { const f32x4 s = *(const f32x4*)(INP(I_SMN) + (size_t)(((b * 4 + l) * 2 + d) * 4 + head) * 128 + F.tid * 4); nv[0] = s.x; nv[1] = s.y; nv[2] = s.z; nv[3] = s.w; } }
    }
    const float rdec = type == 1 ? __expf(-128.f * __expf(INP(I_RRATE)[(l * 2 + d) * 4 + head])) : 1.f;
#pragma unroll 1
    for (int ci0 = 0; ci0 < nch; ci0 += NB) {
        u32x2 lc[NB]; f32x4 ln[NB]; float s0[NB], s1[NB];
#pragma unroll
        for (int j = 0; j < NB; ++j) { ln[j] = (f32x4){zf, zf, zf, zf}; s0[j] = zf; s1[j] = zf; }
#pragma unroll
        for (int j = 0; j < NB; ++j) {
            const int ci = ci0 + j, cp = cp0 + (d == 0 ? ci : nch - 1 - ci);
            lc[j] = *(const u32x2*)(loc + (size_t)((cp * 2 + d) * nh + head) * esz + e0);
            if (type == 0) { const float* sc = WSP(const float, WS_MLSC) + ((cp * 2 + d) * 4 + head) * 2; s0[j] = sc[0]; s1[j] = sc[1];
                if (do_n) ln[j] = *(const f32x4*)(WSP(const float, WS_MLNLOC) + ((cp * 2 + d) * 4 + head) * 128 + F.tid * 4); }
            else if (type == 2) s0[j] = WSP(const float, WS_SDSC)[(cp * 2 + d) * 8 + head];
        }
#pragma unroll
        for (int j = 0; j < NB; ++j) {
            const int ci = ci0 + j, cp = cp0 + (d == 0 ? ci : nch - 1 - ci);
            const size_t so = (size_t)((cp * 2 + d) * nh + head) * esz + e0;
            if (LAT || ci > 0) *(u32x2*)(inb + so) = (u32x2){pk2(v[0], v[1]), pk2(v[2], v[3])};
            float dec, wl = 1.f;
            if (type == 0) {
                const float Bt = s0[j], ml = s1[j];
                if (slice == 0 && F.tid == 0) WSP(float, WS_MLMIN)[(cp * 2 + d) * 4 + head] = m;
                if (do_n) *(f32x4*)(WSP(float, WS_MLNIN) + ((cp * 2 + d) * 4 + head) * 128 + F.tid * 4) = (f32x4){nv[0], nv[1], nv[2], nv[3]};
                const float mn = fmaxf(Bt + m, ml); dec = __expf(Bt + m - mn); wl = __expf(ml - mn); m = mn;
                if (do_n) { nv[0] = dec * nv[0] + wl * ln[j].x; nv[1] = dec * nv[1] + wl * ln[j].y; nv[2] = dec * nv[2] + wl * ln[j].z; nv[3] = dec * nv[3] + wl * ln[j].w; }
            } else if (type == 1) dec = rdec;
            else dec = __expf(s0[j]);
            v[0] = dec * v[0] + wl * bflo(lc[j].x); v[1] = dec * v[1] + wl * bfhi(lc[j].x); v[2] = dec * v[2] + wl * bflo(lc[j].y); v[3] = dec * v[3] + wl * bfhi(lc[j].y);
        }
    }
    if (!lat) {
        if (type == 2) *(f32x4*)(F.out + O_SSD + (size_t)(((b * 4 + l) * 2 + d) * 8 + head) * 8192 + e0) = (f32x4){v[0], v[1], v[2], v[3]};
        else {
            LAS float* tr = (LAS float*)F.lds;
            const int dvl = F.tid >> 5, dk = (F.tid & 31) * 4;
#pragma unroll
            for (int j = 0; j < 4; ++j) tr[dvl * 129 + dk + j] = v[j];
            BAR();
            const int dk2 = F.tid >> 2, q = F.tid & 3;
            float* o = F.out + (type == 0 ? O_MC : O_RET) + (size_t)(((b * 4 + l) * 2 + d) * 4 + head) * 16384 + (size_t)dk2 * 128 + slice * 16 + 4 * q;
            *(f32x4*)o = (f32x4){tr[(4 * q) * 129 + dk2], tr[(4 * q + 1) * 129 + dk2], tr[(4 * q + 2) * 129 + dk2], tr[(4 * q + 3) * 129 + dk2]};
            if (type == 0) { if (do_n) *(f32x4*)(F.out + O_MN + (size_t)(((b * 4 + l) * 2 + d) * 4 + head) * 128 + F.tid * 4) = (f32x4){nv[0], nv[1], nv[2], nv[3]};
                if (slice == 0 && F.tid == 0) F.out[O_MM + ((b * 4 + l) * 2 + d) * 4 + head] = m; }
            BAR();
        }
    }
}
constexpr int CW_Q = 16384;
struct OneUnit { pg8::Unit u; __device__ __forceinline__ bool next(int i, pg8::Unit& o) const { if (i) return false; o = u; return true; }
    __device__ __forceinline__ void a_ready(const pg8::Unit&) const {} __device__ __forceinline__ void done(const pg8::Unit&) const {} };
#define QUEUE_LOOP(F0_, qidx, total, ...) do { \
    unsigned* qc_ = (unsigned*)(F0_.ws + WS_CTL) + CW_Q + 64 * (qidx); volatile LAS int* qs_ = (volatile LAS int*)(F0_.lds + MISC_OFF + 64); \
    if (F0_.tid == 0) qs_[0] = (int)__hip_atomic_fetch_add(qc_, 1u, __ATOMIC_RELAXED, __HIP_MEMORY_SCOPE_AGENT); \
    __syncthreads(); \
    int it = qs_[0], par_ = 1; \
    while (it < (total)) { \
        int nx_ = 0; if (F0_.tid == 0) nx_ = (int)__hip_atomic_fetch_add(qc_, 1u, __ATOMIC_RELAXED, __HIP_MEMORY_SCOPE_AGENT); \
        { __VA_ARGS__ } \
        if (F0_.tid == 0) qs_[par_] = nx_; \
        __syncthreads(); \
        it = qs_[par_]; par_ ^= 1; \
    } } while (0)
#ifndef PROBE_ITEM
#define PROBE_ITEM -1
#endif
#define PR(t) (PROBE_ITEM == (t) ? 2 : 1)
#define QSPLIT(NT_, C0, C1, C2, C3, T0) int ty_ = 0, loc_ = it, dup_ = 0; { const int cnt_[4] = {C0, C1, C2, C3}; \
    _Pragma("unroll") for (int j_ = 0; j_ < NT_; ++j_) { const int span_ = cnt_[j_] * PR(T0 + j_); if (ty_ == j_) { if (loc_ >= span_) { loc_ -= span_; ty_ = j_ + 1; } else { dup_ = loc_ / cnt_[j_]; loc_ = loc_ % cnt_[j_]; } } } }
#ifndef PROBE_REPEAT
#define PROBE_REPEAT -1
#endif
constexpr int N_PHASES = 2 + 9 * NLAYER;
__global__ void __launch_bounds__(NT, 2) hymba_fwd(Args A) {
    extern __shared__ __attribute__((aligned(16))) unsigned char lds_raw[];
    Frame F0;
    F0.lds = (LAS unsigned char*)lds_raw;
    F0.tid = threadIdx.x; F0.lane = 0; F0.wave = __builtin_amdgcn_readfirstlane(F0.tid >> 6);
    F0.G = gridDim.x; F0.bid = blockIdx.x; F0.out = A.out; F0.ws = A.ws;
    volatile LAS unsigned* MISC = (volatile LAS unsigned*)(F0.lds + MISC_OFF);
    if (F0.tid < 64) MISC[F0.tid] = 0u;
    __syncthreads();
    unsigned* barw = (unsigned*)(F0.ws + WS_CTL) + CW_BAR;
    XcdBarrier bar = xcd_barrier_post(barw, MISC + 8);
    const int lo = A.ph_lo, hi = A.ph_hi;
#define KA (*kargs())
#define IN(k) (lo <= (k) && (k) < hi)
#define SEAM(k) do { if (IN(k) && IN((k) + 1)) xcd_barrier(bar); } while (0)

    if (IN(0)) for (int rep_ = 0; rep_ < (PROBE_REPEAT == 100 ? 2 : 1); ++rep_) { Frame F = fresh(F0); p0_prologue(F, KA); } SEAM(0);

#pragma unroll 1
    for (int l = 0; l < NLAYER; ++l) {
        const int pb = 1 + 9 * l;
        if (l == 0) { if (IN(pb + 0)) { Frame F = fresh(F0); norm0_phase(F, KA); shw_phase(F); } SEAM(pb + 0); }
        if (IN(pb + 1)) for (int rep_ = 0; rep_ < (PROBE_REPEAT == 1 ? 2 : 1); ++rep_) { Frame F = fresh(F0);
            pg8::Gemm g{WSP(const pg8::bf16_t, WS_H), WSP(const pg8::bf16_t, WS_W1T) + (size_t)l * NPAD * D, M, NPROJ, D}; pg8::StaticOrder S; S.init(M, NPROJ, F.G, F.bid);
            epi::EpiProj E{WSP(pg8::bf16_t, WS_PROJ), WSP(const float, WS_SSQB), WSP(const float, WS_SHW1) + (size_t)l * 5 * NPAD};
            pg8::gemm_phase<epi::EpiProj, pg8::StaticOrder, true, true>(F.lds, g, S, E);
            __syncthreads(); gates_phase(F, l);
        } SEAM(pb + 1);
        if (IN(pb + 2)) { Frame F = fresh(F0);
            QUEUE_LOOP(F, l * 3 + 0, 384 * PR(0) + 768 * PR(1) + 768 * PR(2) + 768 * PR(3), {
                QSPLIT(4, 384, 768, 768, 768, 0);
                if (ty_ == 0) ssd_local_item(fresh(F), KA, l, loc_ >> 1, loc_ & 1);
                else if (ty_ == 1) mlstm_local_item(fresh(F), KA, l, loc_ >> 2, loc_ & 3);
                else if (ty_ == 2) ret_local_item(fresh(F), KA, l, loc_ >> 2, loc_ & 3);
                else s5_item<0>(fresh(F), KA, l, loc_ >> 2, loc_ & 3);
            });
        } SEAM(pb + 2);
        if (IN(pb + 3)) { Frame F = fresh(F0);
            QUEUE_LOOP(F, l * 3 + 1, 768 * PR(4) + 768 * PR(5) + 768 * PR(6), {
                QSPLIT(3, 768, 768, 768, 0, 4);
                if (ty_ == 0) carry_unit<true>(fresh(F), KA, l, loc_);
                else if (ty_ == 1) s5_item<1>(fresh(F), KA, l, loc_ >> 2, loc_ & 3);
                else { for (int j = 0; j < 8; ++j) carry_unit<false>(fresh(F), KA, l, 768 + loc_ * 8 + j); }
            });
        } SEAM(pb + 3);
        if (IN(pb + 4)) { Frame F = fresh(F0);
            QUEUE_LOOP(F, l * 3 + 2, 192 * PR(7) + 192 * PR(8) + 768 * PR(9) + 768 * PR(10), {
                QSPLIT(4, 192, 192, 768, 768, 7);
                if (ty_ == 0) ssd_out_item(fresh(F), KA, l, loc_, dup_ ? WSP(bf16, WS_MLCLOC) : WSP(bf16, WS_Y));
                else if (ty_ == 1) { Frame Fg = fresh(F);
                    pg8::Gemm g{WSP(const pg8::bf16_t, WS_YA), WSP(const pg8::bf16_t, WS_WGT) + (size_t)l * GWID * GWID, M, GWID, GWID}; OneUnit S; S.u.pm = loc_ >> 1; S.u.pn = loc_ & 1;
                    epi::EpiGlu E{WSP(const pg8::bf16_t, WS_YA), WSP(pg8::bf16_t, WS_Y)};
                    pg8::gemm_phase<epi::EpiGlu, OneUnit, false, true>(Fg.lds, g, S, E); __syncthreads(); }
                else if (ty_ == 2) mlstm_out_item(fresh(F), KA, l, loc_ >> 2, loc_ & 3);
                else ret_out_item(fresh(F), KA, l, loc_ >> 2, loc_ & 3);
            });
        } SEAM(pb + 4);
        if (IN(pb + 5)) { Frame F = fresh(F0);
            pg8::Gemm g{WSP(const pg8::bf16_t, WS_Y), WSP(const pg8::bf16_t, WS_WOT) + (size_t)l * D * D, M, D, D}; pg8::StaticOrder S; S.init(M, D, F.G, F.bid);
            KArgs& A_ = KA; epi::EpiRes E{(const float*)(const GAS float*)A_.in[I_XP], (const float*)(const GAS float*)A_.in[I_XS], WSP(pg8::bf16_t, WS_XB), WSP(const float, WS_MOD) + (size_t)(l * 5) * (6 * D) + 2 * D, l == 0 ? 1 : 0,
                          1, WSP(pg8::bf16_t, WS_H), WSP(float, WS_SSQA), (const float*)(const GAS float*)A_.in[I_NORM2] + (size_t)l * D, WSP(const float, WS_MOD) + (size_t)(l * 5) * (6 * D) + 4 * D, F.lds + 131072};
            pg8::gemm_phase<epi::EpiRes, pg8::StaticOrder, true, true>(F.lds, g, S, E);
        } SEAM(pb + 5);
        if (IN(pb + 7)) for (int rep_ = 0; rep_ < (PROBE_REPEAT == 7 ? 2 : 1); ++rep_) { Frame F = fresh(F0);
            pg8::Gemm g{WSP(const pg8::bf16_t, WS_H), WSP(const pg8::bf16_t, WS_WM1T) + (size_t)l * DFF * D, M, DFF, D}; pg8::StaticOrder S; S.init(M, DFF, F.G, F.bid);
            epi::EpiRelu2 E{WSP(pg8::bf16_t, WS_HID), WSP(const float, WS_SSQA), WSP(const float, WS_SHW2) + (size_t)l * 5 * DFF};
            pg8::gemm_phase<epi::EpiRelu2, pg8::StaticOrder, true, true>(F.lds, g, S, E);
        } SEAM(pb + 7);
        if (IN(pb + 8)) { Frame F = fresh(F0);
            pg8::Gemm g{WSP(const pg8::bf16_t, WS_HID), WSP(const pg8::bf16_t, WS_WM2T) + (size_t)l * D * DFF, M, D, DFF}; pg8::StaticOrder S; S.init(M, D, F.G, F.bid);
            KArgs& A_ = KA; epi::EpiRes E{(const float*)(const GAS float*)A_.in[I_XP], (const float*)(const GAS float*)A_.in[I_XS], WSP(pg8::bf16_t, WS_XB), WSP(const float, WS_MOD) + (size_t)(l * 5) * (6 * D) + 5 * D, 0,
                          l < NLAYER - 1 ? 1 : 0, WSP(pg8::bf16_t, WS_H), WSP(float, WS_SSQB), (const float*)(const GAS float*)A_.in[I_NORM1] + (size_t)(l + 1) * D, WSP(const float, WS_MOD) + (size_t)((l + 1) * 5) * (6 * D) + 1 * D, F.lds + 131072};
            pg8::gemm_phase<epi::EpiRes, pg8::StaticOrder, true, true>(F.lds, g, S, E);
        } SEAM(pb + 8);
    }
    if (IN(N_PHASES - 1)) { Frame F = fresh(F0); final_norm_phase(F, KA); }
#undef IN
#undef SEAM
}

#ifndef MK_LAUNCH_PER_PHASE
#define MK_LAUNCH_PER_PHASE 0
#endif
extern "C" void kernel_launch(void* const* d_in, const int* in_sizes, int n_in, void* d_out, int out_size, void* d_ws, size_t ws_size, hipStream_t stream) {
    static int grid = 0;
    if (grid == 0) {
        if (n_in != N_IN || (size_t)out_size != O_END || ws_size < WS_END) { fprintf(stderr, "kernel_launch: shape mismatch: n_in %d out %d ws %zu (need %zu)\n", n_in, out_size, ws_size, (size_t)WS_END); grid = -1; return; }
        int dev = 0, cus = 0, per_cu = 0;
        if (hipGetDevice(&dev) != hipSuccess || hipDeviceGetAttribute(&cus, hipDeviceAttributeMultiprocessorCount, dev) != hipSuccess) { grid = -1; return; }
        if (hipFuncSetAttribute((const void*)hymba_fwd, hipFuncAttributeMaxDynamicSharedMemorySize, LDS_BYTES) != hipSuccess) { fprintf(stderr, "kernel_launch: hipFuncSetAttribute failed\n"); grid = -1; return; }
        if (hipOccupancyMaxActiveBlocksPerMultiprocessor(&per_cu, (const void*)hymba_fwd, NT, LDS_BYTES) != hipSuccess || per_cu < 1) fprintf(stderr, "kernel_launch: occupancy query says %d\n", per_cu);
        (void)hipGetLastError();
        grid = cus;
    }
    if (grid < 0) return;
    (void)hipMemsetAsync((char*)d_ws + WS_CTL, 0, CTL_ZERO_BYTES, stream);
    Args a{};
    for (int i = 0; i < N_IN; ++i) a.in[i] = (const float*)d_in[i];
    a.out = (float*)d_out; a.ws = (unsigned char*)d_ws;
#if MK_LAUNCH_PER_PHASE
    for (int p = 0; p < N_PHASES; ++p) { a.ph_lo = p; a.ph_hi = p + 1; hipLaunchKernelGGL(hymba_fwd, dim3(grid), dim3(NT), LDS_BYTES, stream, a); }
#else
    a.ph_lo = 0; a.ph_hi = N_PHASES;
    hipLaunchKernelGGL(hymba_fwd, dim3(grid), dim3(NT), LDS_BYTES, stream, a);
#endif
    const hipError_t le = hipPeekAtLastError();
    if (le != hipSuccess) fprintf(stderr, "kernel_launch: launch failed: %s\n", hipGetErrorName(le));
}
```

```cpp
#include <hip/hip_runtime.h>
#include <cstdio>
#include <cstdint>
namespace pg8 {
#define PG8_LAS __attribute__((address_space(3)))
typedef unsigned short bf16_t;
typedef short bf16x8 __attribute__((ext_vector_type(8)));
typedef float f32x4 __attribute__((ext_vector_type(4)));
typedef unsigned u32x4 __attribute__((ext_vector_type(4)));
constexpr int BM = 256, BK = 64, HALF = 128, HTB = HALF * BK * 2  , STAGE_BYTES = 8 * HTB, NXCD = 8, WGM = 8;

__host__ __device__ __forceinline__ int lds_byte(int r, int c) { const int st = (r >> 4) * 2 + (c >> 5), rr = r & 15, cc = c & 31, ob = rr * 64 + cc * 2; return st * 1024 + (ob ^ (((ob >> 9) & 1) << 5)); }
__host__ __device__ __forceinline__ void stage_rc(int b, int& R, int& C) { const int st = b / 1024, sb = b % 1024, swz = sb ^ (((sb >> 9) & 1) << 5); R = (st >> 1) * 16 + swz / 64; C = (st & 1) * 32 + (swz % 64) / 2; }
__host__ __device__ __forceinline__ int perm32(int rho) { const int n = rho >> 4, i = rho & 15; return 8 * (i >> 2) + 4 * n + (i & 3); }

struct Unit { int pm, pn; };
struct Gemm { const bf16_t* A; const bf16_t* Bt; int M, N, K; };

struct StaticOrder {
    int nM, nN, nwg, G, c;
    __host__ __device__ void init(int M, int N, int G_, int c_) { nM = M / BM; nN = N / BM; nwg = nM * nN; G = G_; c = c_; }
    __host__ __device__ bool next(int i, Unit& u) const {
        const long L = (long)i * G + c; if (L >= nwg) return false;
        int wgid = (int)L; { const int q = nwg / NXCD, r = nwg % NXCD, xcd = wgid % NXCD, off = wgid / NXCD; wgid = (xcd < r ? xcd * (q + 1) : r * (q + 1) + (xcd - r) * q) + off; }
        const int nig = WGM * nN, gid = wgid / nig, fm = gid * WGM, gsz = (nM - fm) < WGM ? (nM - fm) : WGM;
        u.pm = fm + ((wgid % nig) % gsz); u.pn = (wgid % nig) / gsz; return true;
    }
    __device__ __forceinline__ void a_ready(const Unit&) const {}
    __device__ __forceinline__ void done(const Unit&) const {}
};

__device__ __forceinline__ unsigned cvt_pk_bf16(float lo, float hi) { unsigned r; asm volatile("v_cvt_pk_bf16_f32 %0, %1, %2" : "=v"(r) : "v"(lo), "v"(hi)); return r; }
typedef float f32x2 __attribute__((ext_vector_type(2)));
template <class Epi, class Sched, bool ALIGN_EPI = false, bool SP2 = false>
__device__ __forceinline__ void gemm_phase(PG8_LAS unsigned char* lds, const Gemm g, const Sched& S, const Epi& E, int tid_in) {
    int tid_ = tid_in; asm volatile("" : "+v"(tid_));
    const int tid = tid_, wid = __builtin_amdgcn_readfirstlane(tid >> 6), lane = tid & 63, wr = wid >> 2, wc = wid & 3, fr = lane & 15, fq = lane >> 4;
    const int K = g.K, nt = K / BK;
    unsigned voffA[2], voffB[2];
#pragma unroll
    for (int i = 0; i < 2; ++i) { int R, C; stage_rc(tid * 16 + i * 8192, R, C); const int Rb = Epi::PERM ? ((R & ~31) + perm32(R & 31)) : R;
        voffA[i] = (unsigned)(R * K + C) * 2u; voffB[i] = (unsigned)(Rb * K + C) * 2u; }
    const size_t kstep = (size_t)(BK * 2);
    const size_t hstep = (size_t)HALF * K * 2;
    const size_t tstep = 2 * hstep;
    const unsigned ldsw = (unsigned)wid * 1024u;
    const int aoff = lds_byte(wr * 64 + fr, fq * 8), boff = lds_byte(wc * 32 + fr, fq * 8);
#define PG8_SA(b, h) (((b) * 2 + (h)) * HTB)
#define PG8_SB(b, h) ((4 + (b) * 2 + (h)) * HTB)
#define PG8_STAGE(bufoff, gbase, voff) do { _Pragma("unroll") for (int _i = 0; _i < 2; ++_i) \
        __builtin_amdgcn_global_load_lds((const unsigned*)((const char*)(gbase) + (voff)[_i]), (PG8_LAS unsigned*)(lds + (bufoff) + ldsw + _i * 8192), 16, 0, 0); } while (0)
#define PG8_LDA(dst, b, h) do { _Pragma("unroll") for (int m = 0; m < 4; ++m) _Pragma("unroll") for (int k = 0; k < 2; ++k) dst[m][k] = *(const PG8_LAS bf16x8*)(lds + PG8_SA(b, h) + aoff + m * 2048 + k * 1024); } while (0)
#define PG8_LDB(dst, b, h) do { _Pragma("unroll") for (int n = 0; n < 2; ++n) _Pragma("unroll") for (int k = 0; k < 2; ++k) dst[n][k] = *(const PG8_LAS bf16x8*)(lds + PG8_SB(b, h) + boff + n * 2048 + k * 1024); } while (0)
#define PG8_MMA(ai, bj, At, Bt) do { __builtin_amdgcn_s_setprio(1); _Pragma("unroll") for (int m = 0; m < 4; ++m) _Pragma("unroll") for (int n = 0; n < 2; ++n) _Pragma("unroll") for (int k = 0; k < 2; ++k) \
        acc[ai][bj][m][n] = __builtin_amdgcn_mfma_f32_16x16x32_bf16(Bt[n][k], At[m][k], acc[ai][bj][m][n], 0, 0, 0); __builtin_amdgcn_s_setprio(0); } while (0)
#define PG8_WAIT_V(n) asm volatile("s_waitcnt vmcnt(" #n ")" ::: "memory")
#define PG8_WAIT_L(n) asm volatile("s_waitcnt lgkmcnt(" #n ")" ::: "memory")
#define PG8_BAR __builtin_amdgcn_s_barrier()
#define PG8_SCHED __builtin_amdgcn_sched_barrier(0)
    Unit cur, nxt; int ui = 0;
    if (!S.next(0, cur)) return;
    f32x4 acc[2][2][4][2];
#pragma unroll
    for (int a = 0; a < 2; ++a)
#pragma unroll
        for (int b = 0; b < 2; ++b)
#pragma unroll
            for (int m = 0; m < 4; ++m)
#pragma unroll
                for (int n = 0; n < 2; ++n) acc[a][b][m][n] = (f32x4){0.f, 0.f, 0.f, 0.f};
    bf16x8 At[4][2], B0[2][2], B1[2][2];
    const char* cA = (const char*)g.A + (size_t)cur.pm * tstep; const char* cB = (const char*)g.Bt + (size_t)cur.pn * tstep;
    S.a_ready(cur);
    if constexpr (SP2) {
        PG8_STAGE(PG8_SB(0, 0), cB, voffB); PG8_STAGE(PG8_SB(0, 1), cB + hstep, voffB); PG8_STAGE(PG8_SA(0, 0), cA, voffA); PG8_STAGE(PG8_SA(0, 1), cA + hstep, voffA);
        if (wr == 1) PG8_BAR;
        PG8_WAIT_V(2); PG8_BAR;
        PG8_STAGE(PG8_SB(1, 0), cB + kstep, voffB); PG8_STAGE(PG8_SA(1, 0), cA + kstep, voffA); PG8_STAGE(PG8_SB(1, 1), cB + hstep + kstep, voffB);
        PG8_WAIT_V(6); PG8_BAR;
    } else {
        PG8_STAGE(PG8_SB(0, 0), cB, voffB); PG8_STAGE(PG8_SA(0, 0), cA, voffA); PG8_STAGE(PG8_SB(0, 1), cB + hstep, voffB); PG8_STAGE(PG8_SA(0, 1), cA + hstep, voffA);
        if (wr == 1) PG8_BAR;
        PG8_WAIT_V(4); PG8_BAR;
        PG8_STAGE(PG8_SB(1, 0), cB + kstep, voffB); PG8_STAGE(PG8_SA(1, 0), cA + kstep, voffA); PG8_STAGE(PG8_SB(1, 1), cB + hstep + kstep, voffB);
        PG8_WAIT_V(6); PG8_BAR;
    }
    for (;;) {
        const bool has_next = S.next(ui + 1, nxt);
        const char* nA = has_next ? (const char*)g.A + (size_t)nxt.pm * tstep : cA; const char* nB = has_next ? (const char*)g.Bt + (size_t)nxt.pn * tstep : cB;
        for (int t = 0; t < nt; t += 2) {
            const bool last = (t == nt - 2);
            const char* a1 = cA + (size_t)(t + 1) * kstep;
            const char* a2 = last ? nA : cA + (size_t)(t + 2) * kstep; const char* b2 = last ? nB : cB + (size_t)(t + 2) * kstep;
            const char* a3 = a2 + kstep; const char* b3 = b2 + kstep;
            if (last && has_next) S.a_ready(nxt);
            if constexpr (SP2) {
            PG8_LDB(B0, 0, 0); PG8_LDB(B1, 0, 1); PG8_SCHED; PG8_LDA(At, 0, 0); PG8_STAGE(PG8_SA(1, 1), a1 + hstep, voffA);
            PG8_WAIT_V(8); PG8_WAIT_L(0); PG8_BAR; PG8_MMA(0, 0, At, B0); PG8_MMA(0, 1, At, B1); PG8_BAR; PG8_SCHED;
            PG8_LDA(At, 0, 1); PG8_STAGE(PG8_SB(0, 0), b2, voffB); PG8_STAGE(PG8_SB(0, 1), b2 + hstep, voffB); PG8_STAGE(PG8_SA(0, 0), a2, voffA);
            PG8_WAIT_V(8); PG8_WAIT_L(0); PG8_BAR; PG8_MMA(1, 0, At, B0); PG8_MMA(1, 1, At, B1); PG8_BAR; PG8_SCHED;
            PG8_LDB(B0, 1, 0); PG8_LDB(B1, 1, 1); PG8_SCHED; PG8_LDA(At, 1, 0); PG8_STAGE(PG8_SA(0, 1), a2 + hstep, voffA);
            PG8_WAIT_V(8); PG8_WAIT_L(0); PG8_BAR; PG8_MMA(0, 0, At, B0); PG8_MMA(0, 1, At, B1); PG8_BAR; PG8_SCHED;
            PG8_LDA(At, 1, 1); PG8_STAGE(PG8_SB(1, 0), b3, voffB); PG8_STAGE(PG8_SB(1, 1), b3 + hstep, voffB); PG8_STAGE(PG8_SA(1, 0), a3, voffA);
            PG8_WAIT_V(8); PG8_WAIT_L(0); PG8_BAR; PG8_MMA(1, 0, At, B0); PG8_MMA(1, 1, At, B1); PG8_BAR; PG8_SCHED;
            } else {
            PG8_LDB(B0, 0, 0); PG8_SCHED; PG8_LDA(At, 0, 0); PG8_STAGE(PG8_SA(1, 1), a1 + hstep, voffA);
            PG8_WAIT_L(8); PG8_BAR; PG8_WAIT_L(0); PG8_MMA(0, 0, At, B0); PG8_BAR; PG8_SCHED;
            PG8_LDB(B1, 0, 1); PG8_STAGE(PG8_SB(0, 0), b2, voffB);
            PG8_BAR; PG8_WAIT_L(0); PG8_MMA(0, 1, At, B1); PG8_BAR;
            PG8_LDA(At, 0, 1); PG8_STAGE(PG8_SA(0, 0), a2, voffA);
            PG8_BAR; PG8_WAIT_L(0); PG8_MMA(1, 0, At, B0); PG8_BAR; PG8_SCHED;
            PG8_STAGE(PG8_SB(0, 1), b2 + hstep, voffB);
            PG8_WAIT_V(6); PG8_BAR; PG8_MMA(1, 1, At, B1); PG8_BAR;
            PG8_LDB(B0, 1, 0); PG8_SCHED; PG8_LDA(At, 1, 0); PG8_STAGE(PG8_SA(0, 1), a2 + hstep, voffA);
            PG8_WAIT_L(8); PG8_BAR; PG8_WAIT_L(0); PG8_MMA(0, 0, At, B0); PG8_BAR; PG8_SCHED;
            PG8_LDB(B1, 1, 1); PG8_STAGE(PG8_SB(1, 0), b3, voffB);
            PG8_BAR; PG8_WAIT_L(0); PG8_MMA(0, 1, At, B1); PG8_BAR;
            PG8_LDA(At, 1, 1); PG8_STAGE(PG8_SA(1, 0), a3, voffA);
            PG8_BAR; PG8_WAIT_L(0); PG8_MMA(1, 0, At, B0); PG8_BAR; PG8_SCHED;
            PG8_STAGE(PG8_SB(1, 1), b3 + hstep, voffB);
            PG8_WAIT_V(6); PG8_BAR; PG8_MMA(1, 1, At, B1); PG8_BAR;
            }
        }
        if constexpr (ALIGN_EPI) { if (wr == 0) PG8_BAR; }
        if constexpr (!Epi::AFTER_DRAIN) { E(acc, cur, wr, wc, fr, fq); S.done(cur); }
        if (!has_next) break;
#pragma unroll
        for (int a = 0; a < 2; ++a)
#pragma unroll
            for (int b = 0; b < 2; ++b)
#pragma unroll
                for (int m = 0; m < 4; ++m)
#pragma unroll
                    for (int n = 0; n < 2; ++n) acc[a][b][m][n] = (f32x4){0.f, 0.f, 0.f, 0.f};
        cur = nxt; cA = nA; cB = nB; ++ui;
        if constexpr (ALIGN_EPI) { if (wr == 1) PG8_BAR; }
    }
    PG8_WAIT_V(0);
    if constexpr (!ALIGN_EPI) { if (wr == 0) PG8_BAR; }
    PG8_BAR;
    if constexpr (Epi::AFTER_DRAIN) { E.fused(acc, cur, wr, wc, fr, fq, lds, wid, lane); S.done(cur); }
#undef PG8_SA
#undef PG8_SB
#undef PG8_STAGE
#undef PG8_LDA
#undef PG8_LDB
#undef PG8_MMA
#undef PG8_WAIT_V
#undef PG8_WAIT_L
#undef PG8_BAR
#undef PG8_SCHED
}
}
#define GAS __attribute__((address_space(1)))
#define LAS __attribute__((address_space(3)))
typedef unsigned short bf16;
typedef unsigned v4u __attribute__((ext_vector_type(4)));
typedef float f32x4 __attribute__((ext_vector_type(4)));
typedef short bf16x8 __attribute__((ext_vector_type(8)));
typedef GAS unsigned gu32;
typedef GAS unsigned long long gu64;
#define RLX_AGENT __ATOMIC_RELAXED, __HIP_MEMORY_SCOPE_AGENT
#define LDS_WAIT() asm volatile("s_waitcnt lgkmcnt(0)" ::: "memory")
#define VM_WAIT() asm volatile("s_waitcnt vmcnt(0)" ::: "memory")
__device__ __forceinline__ unsigned long long rt() { return __builtin_amdgcn_s_memrealtime(); }
__device__ __forceinline__ unsigned f2bf(float f) { unsigned u = __builtin_bit_cast(unsigned, f); return (u + 0x7fffu + ((u >> 16) & 1u)) >> 16; }
__device__ __forceinline__ unsigned pk2(float lo, float hi) { return f2bf(lo) | (f2bf(hi) << 16); }
#define XB_TMO      128
#define XB_XCNT(j)  (256  + 64 * (j))
#define XB_XSUB(j)  (1280 + 64 * (j))
#define XB_XGEN(j)  (2304 + 64 * (j))
#define XB_TOP      3328
#define XB_TOPGEN   3392
#define XCD_BAR_WORDS 3456
#define XB_SPIN_CAP (1u << 18)

__device__ __forceinline__ unsigned xb_ld(unsigned* p)              { return __hip_atomic_load(p, __ATOMIC_RELAXED, __HIP_MEMORY_SCOPE_AGENT); }
__device__ __forceinline__ unsigned xb_add(unsigned* p, unsigned v) { return __hip_atomic_fetch_add(p, v, __ATOMIC_RELAXED, __HIP_MEMORY_SCOPE_AGENT); }
__device__ __forceinline__ unsigned xb_xcc_id() { return (unsigned)__builtin_amdgcn_s_getreg((3 << 11) | 20) & 0xFu; }
#define XB_SPIN(cond, bar) do { unsigned _sp = 0; while (cond) { __builtin_amdgcn_s_sleep(1); \
    if ((++_sp & 255u) == 0u) { if (xb_ld(&(bar)[XB_TMO])) break; if (_sp > XB_SPIN_CAP) { atomicAdd(&(bar)[XB_TMO], 1u); break; } } } } while (0)

struct XcdBarrier {
    unsigned wave0;
    unsigned* bar; unsigned x;
    volatile LAS unsigned* st;
};

__device__ __forceinline__ bool xb_lane0() { return __builtin_amdgcn_mbcnt_hi(~0u, __builtin_amdgcn_mbcnt_lo(~0u, 0u)) == 0u; }
__device__ __forceinline__ XcdBarrier xcd_barrier_post(unsigned* bar, volatile LAS unsigned* st, unsigned wave0) {
    XcdBarrier b; b.wave0 = wave0; b.bar = bar; b.x = xb_xcc_id(); b.st = st;
    if (wave0 && xb_lane0()) (void)xb_add(&bar[XB_XCNT(b.x)], 1u);
    return b;
}
__device__ __forceinline__ void xcd_barrier_complete(unsigned* bar, unsigned x, unsigned& nloc, unsigned& nx) {
    const unsigned G = gridDim.x * gridDim.y * gridDim.z;
    unsigned sum, cnt, mine, sp = 0u;
    for (;;) {
        sum = 0u; cnt = 0u; mine = 0u;
#pragma unroll
        for (unsigned j = 0; j < 16; ++j) { const unsigned c = xb_ld(&bar[XB_XCNT(j)]); sum += c; cnt += (c > 0u) ? 1u : 0u; mine = (j == x) ? c : mine; }
        if (sum == G) break;
        __builtin_amdgcn_s_sleep(1);
        if ((++sp & 255u) == 0u) { if (xb_ld(&bar[XB_TMO])) break; if (sp > XB_SPIN_CAP) { atomicAdd(&bar[XB_TMO], 1u); break; } }
    }
    nloc = mine > 0u ? mine : 1u; nx = cnt > 0u ? cnt : 1u;
}

__device__ __forceinline__ void xcd_barrier(const XcdBarrier& b) {
    asm volatile("s_waitcnt vmcnt(0)" ::: "memory");
    __syncthreads();
    if (b.wave0 && xb_lane0()) {
        unsigned* bar = b.bar;
        __builtin_amdgcn_s_waitcnt(0);
        unsigned nloc = b.st[0], nx = b.st[1];
        if (nloc == 0u) { xcd_barrier_complete(bar, b.x, nloc, nx); b.st[0] = nloc; b.st[1] = nx; }
        const unsigned old = xb_add(&bar[XB_XSUB(b.x)], 1u);
        const unsigned gen = old / nloc;
        if (old + 1u == (gen + 1u) * nloc) {
            __builtin_amdgcn_fence(__ATOMIC_RELEASE, "agent");
            asm volatile("s_waitcnt vmcnt(0)" ::: "memory");
            const unsigned og = xb_add(&bar[XB_TOP], 1u);
            const unsigned tg = og / nx;
            if (og + 1u == (tg + 1u) * nx) xb_add(&bar[XB_TOPGEN], 1u);
            else XB_SPIN(xb_ld(&bar[XB_TOPGEN]) == tg, bar);
            __builtin_amdgcn_fence(__ATOMIC_ACQUIRE, "agent");
            xb_add(&bar[XB_XGEN(b.x)], 1u);
            asm volatile("s_waitcnt vmcnt(0)" ::: "memory");
        } else {
            XB_SPIN(xb_ld(&bar[XB_XGEN(b.x)]) == gen, bar);
            __builtin_amdgcn_fence(__ATOMIC_ACQUIRE, "agent");
            asm volatile("s_waitcnt vmcnt(0)" ::: "memory");
        }
    }
    __syncthreads();
}
constexpr int NWAVES = 8, NT = 512;
constexpr int D = 2048, NLAYER = 4;
constexpr int MC = 32 * 256, ML = 4 * 4096, M = MC + ML;
constexpr int DIN = 6176, NPROJ = 6144, NPAD = 6400, DFF = 8192, GWID = 512;
constexpr int NCP = M / 128;
constexpr float EPS = 1e-6f;
constexpr int PC_S5U = 0, PC_MQ = 512, PC_MK = 1024, PC_MV = 1536, PC_MO = 2048, PC_RQ = 2560, PC_RK = 3072, PC_RV = 3584, PC_RG = 4096, PC_DZ = 4608, PC_DX = 5120, PC_DB = 5632, PC_DC = 5888;
enum { I_XP = 0, I_XS, I_C, I_SS5R, I_SS5I, I_SMC, I_SMN, I_SMM, I_SRET, I_SSSD, I_CCTX, I_NORM1, I_WADA, I_BADA, I_WIN, I_S5LR, I_S5LI, I_S5DT, I_S5BR, I_S5BI, I_S5CR, I_S5CI, I_S5D, I_S5GLU,
       I_MIB, I_MFB, I_MNORM, I_RRATE, I_RNORM, I_CONVW, I_CONVB, I_DTB, I_ALOG, I_SSDD, I_SNORM, I_WOUT, I_NORM2, I_WM1, I_WM2, I_FNORM, N_IN };
constexpr size_t O_YP = 0, O_YS = (size_t)MC * D, O_S5R = (size_t)M * D, O_S5I = O_S5R + 524288, O_MC = O_S5I + 524288, O_MN = O_MC + 16777216, O_MM = O_MN + 131072, O_RET = O_MM + 1024, O_SSD = O_RET + 16777216, O_END = O_SSD + 16777216;

constexpr size_t MiB = 1u << 20;
constexpr size_t WS_CTL = 0, CTL_ZERO_BYTES = 1 * MiB;
constexpr size_t WS_MOD = 1 * MiB;
constexpr size_t WS_S5T = 2 * MiB;
constexpr size_t WS_ROPE = 5 * MiB;
constexpr size_t WS_GATES = 6 * MiB;
constexpr size_t WS_MLNLOC = 9 * MiB;
constexpr size_t WS_MLNIN = 10 * MiB;
constexpr size_t WS_MLSC = 11 * MiB;
constexpr size_t WS_MLMIN = 11 * MiB + 65536;
constexpr size_t WS_SDSC = 11 * MiB + 131072;
constexpr size_t WS_SSQA = 5 * MiB + 65536;
constexpr size_t WS_SSQB = 11 * MiB + 262144;
constexpr size_t WS_SHW1 = 18 * MiB;
constexpr size_t WS_SHW2 = 19 * MiB;
constexpr size_t WS_S5LOC = 12 * MiB;
constexpr size_t WS_WGT = 20 * MiB;
constexpr size_t WS_W1T = 22 * MiB;
constexpr size_t WS_WOT = 122 * MiB;
constexpr size_t WS_WM1T = 154 * MiB;
constexpr size_t WS_WM2T = 282 * MiB;
constexpr size_t WS_H = 410 * MiB;
constexpr size_t WS_Y = 506 * MiB;
constexpr size_t WS_YA = 602 * MiB;
constexpr size_t WS_MLCIN = 626 * MiB;
constexpr size_t WS_RTIN = 674 * MiB;
constexpr size_t WS_SDIN = 722 * MiB;
constexpr size_t WS_PROJ = 770 * MiB;
constexpr size_t WS_MLCLOC = 1058 * MiB;
constexpr size_t WS_HID = 770 * MiB;
constexpr size_t WS_RTLOC = 1106 * MiB;
constexpr size_t WS_SDLOC = 1154 * MiB;
constexpr size_t WS_XBCC = 1202 * MiB;
constexpr size_t WS_XB = 1250 * MiB;
constexpr size_t WS_END = 1346 * MiB;
constexpr int CW_TMO = 0, CW_BAR = 4096;

constexpr int LDT = 272;
constexpr int TS = 128 * LDT;
constexpr int LDX = 144;
constexpr int TSX = 128 * LDX;
constexpr int SCAL_OFF = 4 * TS;
constexpr int MISC_OFF = 163840 - 256;
constexpr int LDS_BYTES = 163840;
#define SCA(i) ((LAS float*)(F.lds + SCAL_OFF + (i) * 512))
typedef float f32x16 __attribute__((ext_vector_type(16)));
typedef float f32x2 __attribute__((ext_vector_type(2)));
typedef short s16x4 __attribute__((ext_vector_type(4)));
typedef unsigned u32x2 __attribute__((ext_vector_type(2)));
struct Args { const float* in[N_IN]; float* out; unsigned char* ws; int ph_lo, ph_hi; };
struct Frame {
    LAS unsigned char* lds;
    float* out; unsigned char* ws;
    int tid, lane, wave, G, bid;
};
__device__ __forceinline__ int lane_id() { return (int)__builtin_amdgcn_mbcnt_hi(~0u, __builtin_amdgcn_mbcnt_lo(~0u, 0u)); }
typedef const __attribute__((address_space(4))) Args KArgs;
__device__ __forceinline__ KArgs* kargs() { KArgs* p = (KArgs*)__builtin_amdgcn_kernarg_segment_ptr(); asm volatile("" : "+s"(p)); return p; }
__device__ __forceinline__ Frame fresh(const Frame& F) { Frame R = F; unsigned long long l = (unsigned long long)(size_t)R.lds; unsigned ll = (unsigned)l; asm volatile("" : "+s"(ll), "+s"(R.wave), "+s"(R.G), "+s"(R.bid)); R.lane = lane_id(); asm volatile("" : "+v"(R.lane)); R.tid = R.wave * 64 + R.lane; R.lds = (LAS unsigned char*)(size_t)ll; KArgs* ka = kargs(); R.out = (float*)(GAS float*)ka->out; R.ws = (unsigned char*)(GAS unsigned char*)ka->ws; return R; }
#define INP(i) ((const float*)(const GAS float*)(A.in[i]))
#define BAR() __syncthreads()
#ifndef PROBE_IMASK
#define PROBE_IMASK 0
#endif
#define ITS(k) do { if ((PROBE_IMASK >> (k)) & 1) { if (F.tid == 0 && F.bid == 0) ((volatile LAS unsigned long long*)(F.lds + MISC_OFF + 128))[0] = __builtin_amdgcn_s_memrealtime(); } } while (0)
#define ITE(k) do { if ((PROBE_IMASK >> (k)) & 1) { if (F.tid == 0 && F.bid == 0) { volatile LAS unsigned long long* p_ = (volatile LAS unsigned long long*)(F.lds + MISC_OFF + 128); p_[1] += __builtin_amdgcn_s_memrealtime() - p_[0]; } } } while (0)
#define WSP(T, off) ((T*)(F.ws + (off)))
__device__ __forceinline__ float bf2f(unsigned short b) { return __uint_as_float((unsigned)b << 16); }
__device__ __forceinline__ float bflo(unsigned w) { return __uint_as_float(w << 16); }
__device__ __forceinline__ float bfhi(unsigned w) { return __uint_as_float(w & 0xffff0000u); }
__device__ __forceinline__ void unpack8(const v4u a, float (&x)[8]) { x[0] = bflo(a.x); x[1] = bfhi(a.x); x[2] = bflo(a.y); x[3] = bfhi(a.y); x[4] = bflo(a.z); x[5] = bfhi(a.z); x[6] = bflo(a.w); x[7] = bfhi(a.w); }
__device__ __forceinline__ v4u pack8(const float (&x)[8], float w) { v4u o; o.x = pk2(x[0] * w, x[1] * w); o.y = pk2(x[2] * w, x[3] * w); o.z = pk2(x[4] * w, x[5] * w); o.w = pk2(x[6] * w, x[7] * w); return o; }
__device__ __forceinline__ float sigmoidf_(float x) { return 1.f / (1.f + __expf(-x)); }
__device__ __forceinline__ float siluf_(float x) { return x * sigmoidf_(x); }
__device__ __forceinline__ float wave_sum(float v) {
#pragma unroll
    for (int o = 1; o < 64; o <<= 1) v += __shfl_xor(v, o);
    return v;
}
__device__ __forceinline__ float wave_max(float v) {
#pragma unroll
    for (int o = 1; o < 64; o <<= 1) v = fmaxf(v, __shfl_xor(v, o));
    return v;
}
template <bool MAX> __device__ __forceinline__ void wave_scan128(const LAS float* in, LAS float* out, int lane, bool rev, float init) {
    const int i0 = rev ? 127 - 2 * lane : 2 * lane, i1 = rev ? i0 - 1 : i0 + 1;
    float e0 = in[i0], e1 = in[i1];
    if (lane == 0) e0 = MAX ? fmaxf(e0, init) : e0 + init;
    float inc = MAX ? fmaxf(e0, e1) : e0 + e1;
#pragma unroll
    for (int o = 1; o < 64; o <<= 1) { const float t = __shfl_up(inc, o); if (lane >= o) inc = MAX ? fmaxf(inc, t) : inc + t; }
    float exc = __shfl_up(inc, 1);
    const float o0 = (lane == 0) ? e0 : (MAX ? fmaxf(exc, e0) : exc + e0);
    out[i0] = o0; out[i1] = inc;
}
__device__ __forceinline__ s16x4 lds_tr(const LAS unsigned char* p) {
    typedef short v4i16_t __attribute__((ext_vector_type(4)));
    return __builtin_bit_cast(s16x4, __builtin_amdgcn_ds_read_tr16_b64_v4i16((LAS v4i16_t*)p));
}
__device__ __forceinline__ bf16x8 frag_row(const LAS unsigned char* base, int ld, int r0, int k0, int lane) {
    return *(const LAS bf16x8*)(base + (r0 + (lane & 31)) * ld + (k0 + 8 * (lane >> 5)) * 2);
}
__device__ __forceinline__ bf16x8 frag_tr(const LAS unsigned char* base, int ld, int k0, int c0, int lane) {
    const int h = lane >> 5, blk = (lane >> 4) & 1, q = (lane & 15) >> 2, p = lane & 3;
    const LAS unsigned char* a = base + (k0 + 8 * h + q) * ld + (c0 + 16 * blk + 4 * p) * 2;
    const s16x4 lo = lds_tr(a), hi = lds_tr(a + 4 * ld);
    return (bf16x8){lo[0], lo[1], lo[2], lo[3], hi[0], hi[1], hi[2], hi[3]};
}
__device__ __forceinline__ bf16x8 frag_trp(const LAS unsigned char* base, int ld, int k0, int c0, int lane) {
    const int h = lane >> 5, blk = (lane >> 4) & 1, q = (lane & 15) >> 2, p = lane & 3;
    const LAS unsigned char* a = base + (k0 + 4 * h + q) * ld + (c0 + 16 * blk + 4 * p) * 2;
    const s16x4 lo = lds_tr(a), hi = lds_tr(a + 8 * ld);
    return (bf16x8){lo[0], lo[1], lo[2], lo[3], hi[0], hi[1], hi[2], hi[3]};
}
#define MFMA32(a, b, c) __builtin_amdgcn_mfma_f32_32x32x16_bf16((a), (b), (c), 0, 0, 0)
#define ZERO16 ((f32x16){0.f,0.f,0.f,0.f,0.f,0.f,0.f,0.f,0.f,0.f,0.f,0.f,0.f,0.f,0.f,0.f})
__device__ __forceinline__ int crow(int i, int hh) { return (i & 3) + 8 * (i >> 2) + 4 * hh; }

#define PT(cp, col) (WSP(const bf16, WS_PROJ) + ((size_t)(cp) * 48 + ((col) >> 7)) * 16384 + ((col) & 127))
#define XT(cp, ch) (WSP(bf16, WS_XBCC) + ((size_t)(cp) * 8 + ((ch) >> 7)) * 16384 + ((ch) & 127))
__device__ __forceinline__ const float* x_in_row(const Frame& F, KArgs& A, int l, int r) {
    if (l == 0) return r < MC ? INP(I_XP) + (size_t)r * D : INP(I_XS) + (size_t)(r - MC) * D;
    return F.out + (size_t)r * D;
}
__device__ __forceinline__ int mod_row(int r) { return r < MC ? 0 : 1 + (r - MC) / 4096; }
__device__ __forceinline__ const float* mod_ptr(const Frame& F, int l, int mrow, int part) { return WSP(const float, WS_MOD) + ((size_t)(l * 5 + mrow) * 6 + part) * D; }
struct Seq { int cp0, nch, c, b, lat; };
__device__ __forceinline__ Seq seq_of(int cp) { Seq s; if (cp < 64) { s.lat = 0; s.b = cp >> 1; s.cp0 = cp & ~1; s.nch = 2; s.c = cp & 1; } else { s.lat = 1; s.b = (cp - 64) >> 5; s.cp0 = 64 + (s.b << 5); s.nch = 32; s.c = (cp - 64) & 31; } return s; }
__device__ __forceinline__ int w1_newcol(int n) { return n < 2560 ? n : (n < 2576 ? n - 2560 + 6144 : (n < 6160 ? n - 16 : n)); }
template <bool MAPW1> __device__ __forceinline__ void p0_transpose_item(const float* W, int K, int N, bf16* WT, LAS float* scr, int item, int lane) {
    const int nblk = N / 32, kb = item / nblk, nb = item % nblk, k0 = 64 * kb, n0 = 32 * nb;
#pragma unroll 8
    for (int i = 0; i < 32; ++i) { const int kk = 2 * i + (lane >> 5); scr[kk * 33 + (lane & 31)] = W[(size_t)(k0 + kk) * N + n0 + (lane & 31)]; }
    LDS_WAIT(); asm volatile("" ::: "memory");
    const int c = lane & 7;
#pragma unroll
    for (int j = 0; j < 4; ++j) { const int n = (lane >> 3) + 8 * j; const LAS float* s = scr + (8 * c) * 33 + n;
        v4u o; o.x = pk2(s[0 * 33], s[1 * 33]); o.y = pk2(s[2 * 33], s[3 * 33]); o.z = pk2(s[4 * 33], s[5 * 33]); o.w = pk2(s[6 * 33], s[7 * 33]);
        const int nr = MAPW1 ? w1_newcol(n0 + n) : (n0 + n);
        *(GAS v4u*)(WT + (size_t)nr * K + k0 + 8 * c) = o; }
    LDS_WAIT(); asm volatile("" ::: "memory");
}
constexpr int S5T_STRIDE = 9216;
__device__ __forceinline__ unsigned char* s5tab(const Frame& F, int l, int d, int g) { return F.ws + WS_S5T + (size_t)((l * 2 + d) * 32 + g) * S5T_STRIDE; }

__device__ __forceinline__ void p0_prologue(Frame& F, KArgs& A) {
    {
        LAS float* scr = (LAS float*)(F.lds + F.wave * 16384);
        const int gw = F.bid * NWAVES + F.wave, NGW = F.G * NWAVES;
        constexpr int I_1 = (D / 64) * (DIN / 32), I_G = (GWID / 64) * (GWID / 32), I_O = (D / 64) * (D / 32), I_M1 = (D / 64) * (DFF / 32), I_M2 = (DFF / 64) * (D / 32);
        constexpr int PER_L = I_1 + I_G + I_O + I_M1 + I_M2;
        for (int it = gw; it < NLAYER * PER_L; it += NGW) {
            const int l = it / PER_L; int r = it % PER_L;
            if (r < I_1) { p0_transpose_item<true>(INP(I_WIN) + (size_t)l * D * DIN, D, DIN, WSP(bf16, WS_W1T) + (size_t)l * NPAD * D, scr, r, F.lane); continue; } r -= I_1;
            if (r < I_G) { p0_transpose_item<false>(INP(I_S5GLU) + (size_t)l * GWID * GWID, GWID, GWID, WSP(bf16, WS_WGT) + (size_t)l * GWID * GWID, scr, r, F.lane); continue; } r -= I_G;
            if (r < I_O) { p0_transpose_item<false>(INP(I_WOUT) + (size_t)l * D * D, D, D, WSP(bf16, WS_WOT) + (size_t)l * D * D, scr, r, F.lane); continue; } r -= I_O;
            if (r < I_M1) { p0_transpose_item<false>(INP(I_WM1) + (size_t)l * D * DFF, D, DFF, WSP(bf16, WS_WM1T) + (size_t)l * DFF * D, scr, r, F.lane); continue; } r -= I_M1;
            p0_transpose_item<false>(INP(I_WM2) + (size_t)l * DFF * D, DFF, D, WSP(bf16, WS_WM2T) + (size_t)l * D * DFF, scr, r, F.lane);
        }
        const int gt = F.bid * NT + F.tid, NGT = F.G * NT;
        for (int i = gt; i < NLAYER * 224 * 256; i += NGT) { const int l = i / (224 * 256), r = i % (224 * 256);
            *(GAS v4u*)(WSP(bf16, WS_W1T) + ((size_t)l * NPAD + DIN) * D + (size_t)r * 8) = (v4u){0u, 0u, 0u, 0u}; }
        for (int i = gt; i < NLAYER * 2 * 32 * 64; i += NGT) {
            const int p = i & 63, g = (i >> 6) & 31, d = (i >> 11) & 1, l = i >> 12;
            const int ldg = (l * 2 + d) * 32 + g;
            const double lre = INP(I_S5LR)[ldg * 64 + p], lim = INP(I_S5LI)[ldg * 64 + p], dt = exp((double)INP(I_S5DT)[ldg]);
            const double er = exp(lre * dt), br = er * cos(lim * dt), bi = er * sin(lim * dt);
            const double e128 = exp(128.0 * lre * dt), b128r = e128 * cos(128.0 * lim * dt), b128i = e128 * sin(128.0 * lim * dt);
            const double nr = br - 1.0, ni = bi, den = lre * lre + lim * lim;
            const double cr = (nr * lre + ni * lim) / den, ci = (ni * lre - nr * lim) / den;
            unsigned char* tb = s5tab(F, l, d, g);
            float* lam = (float*)tb; lam[2 * p] = (float)br; lam[2 * p + 1] = (float)bi;
            float* l128 = (float*)(tb + 512); l128[2 * p] = (float)b128r; l128[2 * p + 1] = (float)b128i;
            bf16* bb = (bf16*)(tb + 1024); bf16* ct = (bf16*)(tb + 5120);
            for (int c = 0; c < 16; ++c) {
                const double Br = INP(I_S5BR)[(size_t)(ldg * 64 + p) * 16 + c], Bi = INP(I_S5BI)[(size_t)(ldg * 64 + p) * 16 + c];
                bb[(2 * p) * 16 + c] = (bf16)f2bf((float)(cr * Br - ci * Bi));
                bb[(2 * p + 1) * 16 + c] = (bf16)f2bf((float)(cr * Bi + ci * Br));
                ct[c * 128 + 2 * p] = (bf16)f2bf(INP(I_S5CR)[(size_t)(ldg * 16 + c) * 64 + p]);
                ct[c * 128 + 2 * p + 1] = (bf16)f2bf(-INP(I_S5CI)[(size_t)(ldg * 16 + c) * 64 + p]);
            }
        }
        for (int i = gt; i < 64 * 32; i += NGT) { const int pos = i >> 5, k = i & 31; const double f = pow(10000.0, -(double)k / 32.0), a = pos * f;
            WSP(f32x2, WS_ROPE)[i] = (f32x2){(float)cos(a), (float)sin(a)}; }
    }
    __syncthreads();
    {
        LAS float* sc = (LAS float*)F.lds;
        LAS float* red = (LAS float*)(F.lds + 65536);
        for (int i = F.tid; i < 5 * D; i += NT) { const int r = i / D, k = i % D; const float v = r == 0 ? INP(I_CCTX)[k] : INP(I_C)[(r - 1) * D + k]; sc[i] = siluf_(v); }
        __syncthreads();
        for (int it = F.bid; it < NLAYER * 96; it += F.G) {
            const int l = it / 96, c0 = (it % 96) * 128;
            const float* W = INP(I_WADA) + (size_t)l * D * (6 * D);
            float acc[5][4];
#pragma unroll
            for (int r = 0; r < 5; ++r)
#pragma unroll
                for (int j = 0; j < 4; ++j) acc[r][j] = 0.f;
            const int cl = F.lane & 31, kp = F.lane >> 5;
#pragma unroll 4
            for (int kk = 0; kk < 128; ++kk) {
                const int k = F.wave * 256 + 2 * kk + kp;
                const f32x4 w = *(const f32x4*)(W + (size_t)k * (6 * D) + c0 + 4 * cl);
#pragma unroll
                for (int r = 0; r < 5; ++r) { const float s = sc[r * D + k]; acc[r][0] += s * w.x; acc[r][1] += s * w.y; acc[r][2] += s * w.z; acc[r][3] += s * w.w; }
            }
#pragma unroll
            for (int r = 0; r < 5; ++r)
#pragma unroll
                for (int j = 0; j < 4; ++j) { acc[r][j] += __shfl_xor(acc[r][j], 32); }
            if (kp == 0) {
#pragma unroll
                for (int r = 0; r < 5; ++r)
#pragma unroll
                    for (int j = 0; j < 4; ++j) red[(F.wave * 5 + r) * 128 + 4 * cl + j] = acc[r][j];
            }
            __syncthreads();
            for (int i = F.tid; i < 5 * 128; i += NT) { const int r = i >> 7, j = i & 127; float s = 0.f;
#pragma unroll
                for (int w = 0; w < 8; ++w) s += red[(w * 5 + r) * 128 + j];
                WSP(float, WS_MOD)[(size_t)(l * 5 + r) * (6 * D) + c0 + j] = s + INP(I_BADA)[(size_t)l * (6 * D) + c0 + j]; }
            __syncthreads();
        }
    }
}

__device__ __forceinline__ void norm0_phase(Frame& F, KArgs& A) {
    const int gw = F.bid * NWAVES + F.wave, NGW = F.G * NWAVES;
    const float* gain = INP(I_NORM1);
    for (int m = gw; m < M; m += NGW) {
        const float* xr = x_in_row(F, A, 0, m);
        const float* scp = mod_ptr(F, 0, mod_row(m), 1);
        f32x4 v[8]; float s = 0.f;
#pragma unroll
        for (int j = 0; j < 8; ++j) { v[j] = *(const f32x4*)(xr + 4 * F.lane + 256 * j); s += (v[j].x * v[j].x + v[j].y * v[j].y) + (v[j].z * v[j].z + v[j].w * v[j].w); }
        s = wave_sum(s);
        if (F.lane < 8) WSP(float, WS_SSQB)[(size_t)m * 8 + F.lane] = F.lane == 0 ? s : 0.f;
        bf16* orow = WSP(bf16, WS_H) + (size_t)m * D;
#pragma unroll
        for (int j = 0; j < 8; ++j) { const int c = 4 * F.lane + 256 * j;
            const f32x4 g4 = *(const f32x4*)(gain + c), s4 = *(const f32x4*)(scp + c);
            *(u32x2*)(orow + c) = (u32x2){pk2(v[j].x * g4.x * (1.f + s4.x), v[j].y * g4.y * (1.f + s4.y)), pk2(v[j].z * g4.z * (1.f + s4.z), v[j].w * g4.w * (1.f + s4.w))}; }
    }
}
__device__ __forceinline__ void shw_phase(Frame& F) {
    LAS float* sh = (LAS float*)F.lds;
    const int gw = F.bid * NWAVES + F.wave, NGW = F.G * NWAVES;
    for (int grp = 0; grp < 2 * NLAYER; ++grp) {
        const int l = grp >> 1, which = grp & 1;
        __syncthreads();
        for (int i = F.tid; i < 5 * D; i += NT) sh[i] = WSP(const float, WS_MOD)[((size_t)(l * 5 + i / D) * 6 + (which ? 3 : 0)) * D + (i % D)];
        __syncthreads();
        const int N = which ? DFF : DIN, NS = which ? DFF : NPAD;
        const bf16* Wt = which ? WSP(const bf16, WS_WM1T) + (size_t)l * DFF * D : WSP(const bf16, WS_W1T) + (size_t)l * NPAD * D;
        float* o = which ? WSP(float, WS_SHW2) + (size_t)l * 5 * DFF : WSP(float, WS_SHW1) + (size_t)l * 5 * NPAD;
        for (int n = gw; n < N; n += NGW) {
            float acc[5] = {0.f, 0.f, 0.f, 0.f, 0.f};
#pragma unroll
            for (int j = 0; j < 4; ++j) { const int k = 8 * F.lane + 512 * j; float w[8]; unpack8(*(const v4u*)(Wt + (size_t)n * D + k), w);
#pragma unroll
                for (int r = 0; r < 5; ++r) { const f32x4 a0 = *(const LAS f32x4*)(sh + r * D + k), a1 = *(const LAS f32x4*)(sh + r * D + k + 4);
                    acc[r] += (w[0] * a0.x + w[1] * a0.y) + (w[2] * a0.z + w[3] * a0.w) + (w[4] * a1.x + w[5] * a1.y) + (w[6] * a1.z + w[7] * a1.w); } }
#pragma unroll
            for (int r = 0; r < 5; ++r) { const float s = wave_sum(acc[r]); if (F.lane == 0) o[(size_t)r * NS + n] = s; }
        }
    }
    __syncthreads();
}
__device__ __forceinline__ void final_norm_phase(Frame& F, KArgs& A) {
    const int gw = F.bid * NWAVES + F.wave, NGW = F.G * NWAVES;
    const float* gain = INP(I_FNORM);
    for (int m = gw; m < M; m += NGW) {
        const bf16* xr = WSP(const bf16, WS_XB) + (size_t)m * D; float* orow = F.out + (size_t)m * D;
        float v[4][8]; float s = 0.f;
#pragma unroll
        for (int j = 0; j < 4; ++j) { unpack8(*(const v4u*)(xr + 8 * F.lane + 512 * j), v[j]);
#pragma unroll
            for (int k = 0; k < 8; ++k) s += v[j][k] * v[j][k]; }
        const float rstd = rsqrtf(wave_sum(s) * (1.f / D) + EPS);
#pragma unroll
        for (int j = 0; j < 4; ++j) { const int c = 8 * F.lane + 512 * j; const f32x4 g0 = *(const f32x4*)(gain + c), g1 = *(const f32x4*)(gain + c + 4);
            *(f32x4*)(orow + c) = (f32x4){v[j][0] * rstd * g0.x, v[j][1] * rstd * g0.y, v[j][2] * rstd * g0.z, v[j][3] * rstd * g0.w};
            *(f32x4*)(orow + c + 4) = (f32x4){v[j][4] * rstd * g1.x, v[j][5] * rstd * g1.y, v[j][6] * rstd * g1.z, v[j][7] * rstd * g1.w}; }
    }
}

__device__ __forceinline__ void gates_phase(Frame& F, int l) {
    const bf16* XA = WSP(const bf16, WS_H); const bf16* Wg = WSP(const bf16, WS_W1T) + ((size_t)l * NPAD + NPROJ) * D;
    const float* shw = WSP(const float, WS_SHW1) + (size_t)l * 5 * NPAD + NPROJ;
    const int hh = F.lane >> 5, r = F.lane & 31, k0 = F.wave * 256;
    LAS float* red = (LAS float*)F.lds;
    bf16x8 bw[16];
#pragma unroll
    for (int ks = 0; ks < 16; ++ks) bw[ks] = *(const bf16x8*)(Wg + (size_t)r * D + k0 + 16 * ks + 8 * hh);
    for (int rb = F.bid; rb < M / 32; rb += F.G) {
        f32x16 acc = ZERO16;
#pragma unroll
        for (int half = 0; half < 2; ++half) { bf16x8 a[8];
#pragma unroll
            for (int j = 0; j < 8; ++j) a[j] = *(const bf16x8*)(XA + (size_t)(32 * rb + r) * D + k0 + 16 * (8 * half + j) + 8 * hh);
#pragma unroll
            for (int j = 0; j < 8; ++j) acc = MFMA32(a[j], bw[8 * half + j], acc); }
#pragma unroll
        for (int i = 0; i < 16; ++i) red[(F.wave * 32 + crow(i, hh)) * 33 + r] = acc[i];
        BAR();
#pragma unroll
        for (int q = 0; q < 2; ++q) { const int idx = F.tid * 2 + q, row = idx >> 5, col = idx & 31; float s = 0.f;
#pragma unroll
            for (int w = 0; w < 8; ++w) s += red[(w * 32 + row) * 33 + col];
            const int grow = 32 * rb + row; const float* part = WSP(const float, WS_SSQB) + (size_t)grow * 8;
            const float ssq = ((part[0] + part[1]) + (part[2] + part[3])) + ((part[4] + part[5]) + (part[6] + part[7]));
            WSP(float, WS_GATES)[(size_t)grow * 32 + col] = s * rsqrtf(ssq * (1.f / D) + EPS) + shw[(size_t)mod_row(grow) * NPAD + col]; }
        BAR();
    }
}
namespace epi {
__device__ __forceinline__ float rstd_of(const float* part, int r) { const pg8::f32x4 a = *(const pg8::f32x4*)(part + (size_t)r * 8), b = *(const pg8::f32x4*)(part + (size_t)r * 8 + 4);
    return rsqrtf((((a[0] + a[1]) + (a[2] + a[3])) + ((b[0] + b[1]) + (b[2] + b[3]))) * (1.f / D) + EPS); }
using pg8::Unit; using pg8::f32x4; using pg8::u32x4; using pg8::bf16_t; using pg8::cvt_pk_bf16;
constexpr int BMq = 256, HALFq = 128;
struct EpiProj {
    static constexpr bool PERM = true, AFTER_DRAIN = false;
    bf16_t* P; const float* ssq; const float* shw0;
    __device__ __forceinline__ void operator()(const f32x4 (&acc)[2][2][4][2], const Unit& u, int wr, int wc, int fr_, int fq_) const {
        int ln_ = (int)__builtin_amdgcn_mbcnt_hi(~0u, __builtin_amdgcn_mbcnt_lo(~0u, 0u)); asm volatile("" : "+v"(ln_)); const int fr = ln_ & 15, fq = ln_ >> 4; (void)fr_; (void)fq_;
        const int row0 = u.pm * BMq + wr * 64 + fr, rowt = u.pm * BMq, col0 = u.pn * BMq + wc * 32 + 8 * fq;
        const float* shw = shw0 + (size_t)(rowt < MC ? 0 : 1 + (rowt - MC) / 4096) * NPAD + col0;
        f32x4 sh[2][2];
#pragma unroll
        for (int bj = 0; bj < 2; ++bj) { sh[bj][0] = *(const f32x4*)(shw + bj * HALFq); sh[bj][1] = *(const f32x4*)(shw + bj * HALFq + 4); }
#pragma unroll
        for (int ai = 0; ai < 2; ++ai)
#pragma unroll
            for (int m = 0; m < 4; ++m) { const int r = row0 + ai * HALFq + m * 16; bf16_t* rowp = P + (((size_t)(r >> 7) * 48 + (col0 >> 7)) * 128 + (r & 127)) * 128 + (col0 & 127); const float rs = rstd_of(ssq, r);
#pragma unroll
                for (int bj = 0; bj < 2; ++bj) { const f32x4 v0 = acc[ai][bj][m][0] * rs + sh[bj][0], v1 = acc[ai][bj][m][1] * rs + sh[bj][1];
                    u32x4 w; w.x = cvt_pk_bf16(v0[0], v0[1]); w.y = cvt_pk_bf16(v0[2], v0[3]); w.z = cvt_pk_bf16(v1[0], v1[1]); w.w = cvt_pk_bf16(v1[2], v1[3]);
                    *(u32x4*)(rowp + bj * 16384) = w; } }
    }
};
struct EpiGlu {
    static constexpr bool PERM = true, AFTER_DRAIN = false;
    const bf16_t* YA; bf16_t* Y;
    __device__ __forceinline__ void operator()(const f32x4 (&acc)[2][2][4][2], const Unit& u, int wr, int wc, int fr_, int fq_) const {
        int ln_ = (int)__builtin_amdgcn_mbcnt_hi(~0u, __builtin_amdgcn_mbcnt_lo(~0u, 0u)); asm volatile("" : "+v"(ln_)); const int fr = ln_ & 15, fq = ln_ >> 4; (void)fr_; (void)fq_;
        const int row0 = u.pm * BMq + wr * 64 + fr, col0 = u.pn * BMq + wc * 32 + 8 * fq;
#pragma unroll
        for (int ai = 0; ai < 2; ++ai)
#pragma unroll
            for (int m = 0; m < 4; ++m) { const int r = row0 + ai * HALFq + m * 16;
#pragma unroll
                for (int bj = 0; bj < 2; ++bj) { const f32x4 v0 = acc[ai][bj][m][0], v1 = acc[ai][bj][m][1];
                    const u32x4 a = *(const u32x4*)(YA + (size_t)r * GWID + col0 + bj * HALFq);
                    float y[8] = {bflo(a.x), bfhi(a.x), bflo(a.y), bfhi(a.y), bflo(a.z), bfhi(a.z), bflo(a.w), bfhi(a.w)};
                    const float g[8] = {v0[0], v0[1], v0[2], v0[3], v1[0], v1[1], v1[2], v1[3]};
#pragma unroll
                    for (int k = 0; k < 8; ++k) y[k] = y[k] * sigmoidf_(g[k]);
                    u32x4 w; w.x = cvt_pk_bf16(y[0], y[1]); w.y = cvt_pk_bf16(y[2], y[3]); w.z = cvt_pk_bf16(y[4], y[5]); w.w = cvt_pk_bf16(y[6], y[7]);
                    *(u32x4*)(Y + (size_t)r * D + col0 + bj * HALFq) = w; } }
    }
};
struct EpiRes {
    static constexpr bool PERM = true, AFTER_DRAIN = false;
    const float* xp; const float* xs; bf16_t* XB; const float* gate0; int first;
    int NEXT; bf16_t* XA; float* ssq; const float* gn; const float* scn0; PG8_LAS unsigned char* scr;
    __device__ __forceinline__ void operator()(const f32x4 (&acc)[2][2][4][2], const Unit& u, int wr, int wc, int fr_, int fq_) const {
        int ln_ = (int)__builtin_amdgcn_mbcnt_hi(~0u, __builtin_amdgcn_mbcnt_lo(~0u, 0u)); asm volatile("" : "+v"(ln_)); const int fr = ln_ & 15, fq = ln_ >> 4; (void)fr_; (void)fq_;
        const int rowt = u.pm * BMq, col0 = u.pn * BMq + wc * 32 + 8 * fq;
        const int mrow = rowt < MC ? 0 : 1 + (rowt - MC) / 4096;
        const float* gate = gate0 + (size_t)mrow * (6 * D);
        const float* basef = rowt < MC ? xp + (size_t)rowt * D : xs + (size_t)(rowt - MC) * D;
        bf16_t* xb = XB + (size_t)rowt * D;
        float ss[2][4];
#pragma unroll
        for (int ai = 0; ai < 2; ++ai)
#pragma unroll
            for (int m = 0; m < 4; ++m) ss[ai][m] = 0.f;
#pragma unroll
        for (int bj = 0; bj < 2; ++bj) { const int c = col0 + bj * HALFq; const f32x4 g0 = *(const f32x4*)(gate + c), g1 = *(const f32x4*)(gate + c + 4);
            f32x4 a0 = (f32x4){0.f, 0.f, 0.f, 0.f}, a1 = a0;
            if (NEXT) { const float* scn = scn0 + (size_t)mrow * (6 * D); a0 = *(const f32x4*)(gn + c) * (*(const f32x4*)(scn + c) + 1.f); a1 = *(const f32x4*)(gn + c + 4) * (*(const f32x4*)(scn + c + 4) + 1.f); }
#pragma unroll
            for (int ai = 0; ai < 2; ++ai)
#pragma unroll
                for (int m = 0; m < 4; ++m) { const size_t off = (size_t)(wr * 64 + fr + ai * HALFq + m * 16) * D + c;
                    f32x4 b0, b1;
                    if (first) { b0 = *(const f32x4*)(basef + off); b1 = *(const f32x4*)(basef + off + 4); }
                    else { const u32x4 w = *(const u32x4*)(xb + off); b0 = (f32x4){bflo(w.x), bfhi(w.x), bflo(w.y), bfhi(w.y)}; b1 = (f32x4){bflo(w.z), bfhi(w.z), bflo(w.w), bfhi(w.w)}; }
                    const f32x4 x0 = b0 + g0 * acc[ai][bj][m][0], x1 = b1 + g1 * acc[ai][bj][m][1];
                    u32x4 xw; xw.x = cvt_pk_bf16(x0[0], x0[1]); xw.y = cvt_pk_bf16(x0[2], x0[3]); xw.z = cvt_pk_bf16(x1[0], x1[1]); xw.w = cvt_pk_bf16(x1[2], x1[3]);
                    *(u32x4*)(xb + off) = xw;
                    if (NEXT) { const f32x4 r0 = (f32x4){bflo(xw.x), bfhi(xw.x), bflo(xw.y), bfhi(xw.y)}, r1 = (f32x4){bflo(xw.z), bfhi(xw.z), bflo(xw.w), bfhi(xw.w)};
                        ss[ai][m] += (r0[0] * r0[0] + r0[1] * r0[1]) + (r0[2] * r0[2] + r0[3] * r0[3]) + (r1[0] * r1[0] + r1[1] * r1[1]) + (r1[2] * r1[2] + r1[3] * r1[3]);
                        const f32x4 y0 = r0 * a0, y1 = r1 * a1; u32x4 w; w.x = cvt_pk_bf16(y0[0], y0[1]); w.y = cvt_pk_bf16(y0[2], y0[3]); w.z = cvt_pk_bf16(y1[0], y1[1]); w.w = cvt_pk_bf16(y1[2], y1[3]);
                        *(u32x4*)(XA + (size_t)rowt * D + off) = w; }
                    if (m & 1) asm volatile("" ::: "memory"); } }
        if (NEXT) {
            PG8_LAS float* P4 = (PG8_LAS float*)scr;
#pragma unroll
            for (int ai = 0; ai < 2; ++ai)
#pragma unroll
                for (int m = 0; m < 4; ++m) { float s = ss[ai][m]; s += __shfl_xor(s, 16); s += __shfl_xor(s, 32);
                    if (fq == 0) P4[(ai * HALFq + wr * 64 + m * 16 + fr) * 4 + wc] = s; }
            asm volatile("s_waitcnt lgkmcnt(0)\n\ts_barrier" ::: "memory");
            { const int tid = (wr * 4 + wc) * 64 + fq * 16 + fr;
              if (tid < 256) { const f32x4 p = *(const PG8_LAS f32x4*)(P4 + tid * 4); ssq[(size_t)(rowt + tid) * 8 + u.pn] = (p[0] + p[1]) + (p[2] + p[3]); } }
            asm volatile("s_waitcnt lgkmcnt(0)\n\ts_barrier" ::: "memory");
        }
    }
};
struct EpiRelu2 {
    static constexpr bool PERM = true, AFTER_DRAIN = false;
    bf16_t* O; const float* ssq; const float* shw0;
    __device__ __forceinline__ void operator()(const f32x4 (&acc)[2][2][4][2], const Unit& u, int wr, int wc, int fr_, int fq_) const {
        int ln_ = (int)__builtin_amdgcn_mbcnt_hi(~0u, __builtin_amdgcn_mbcnt_lo(~0u, 0u)); asm volatile("" : "+v"(ln_)); const int fr = ln_ & 15, fq = ln_ >> 4; (void)fr_; (void)fq_;
        const int row0 = u.pm * BMq + wr * 64 + fr, col0 = u.pn * BMq + wc * 32 + 8 * fq, rowt = u.pm * BMq;
        const float* shw = shw0 + (size_t)(rowt < MC ? 0 : 1 + (rowt - MC) / 4096) * DFF + col0;
        f32x4 sh[2][2];
#pragma unroll
        for (int bj = 0; bj < 2; ++bj) { sh[bj][0] = *(const f32x4*)(shw + bj * HALFq); sh[bj][1] = *(const f32x4*)(shw + bj * HALFq + 4); }
#pragma unroll
        for (int ai = 0; ai < 2; ++ai)
#pragma unroll
            for (int m = 0; m < 4; ++m) { const int r = row0 + ai * HALFq + m * 16; bf16_t* rowp = O + (size_t)r * DFF + col0; const float rs = rstd_of(ssq, r);
#pragma unroll
                for (int bj = 0; bj < 2; ++bj) { f32x4 v0 = acc[ai][bj][m][0] * rs + sh[bj][0], v1 = acc[ai][bj][m][1] * rs + sh[bj][1];
#pragma unroll
                    for (int k = 0; k < 4; ++k) { const float a = fmaxf(v0[k], 0.f), b = fmaxf(v1[k], 0.f); v0[k] = a * a; v1[k] = b * b; }
                    u32x4 w; w.x = cvt_pk_bf16(v0[0], v0[1]); w.y = cvt_pk_bf16(v0[2], v0[3]); w.z = cvt_pk_bf16(v1[0], v1[1]); w.w = cvt_pk_bf16(v1[2], v1[3]);
                    *(u32x4*)(rowp + bj * HALFq) = w; } }
    }
};
}
__device__ __forceinline__ float logsigmoidf_(float x) { return fminf(x, 0.f) - __logf(1.f + __expf(-fabsf(x))); }
__device__ __forceinline__ float softplusf_(float x) { return fmaxf(x, 0.f) + __logf(1.f + __expf(-fabsf(x))); }
__device__ __forceinline__ void load_tile128(Frame& F, LAS unsigned char* dst, const bf16* src) {
#pragma unroll
    for (int it = 0; it < 4; ++it) { const int i = F.tid + NT * it, r = i >> 4, c = i & 15;
        *(LAS v4u*)(dst + r * LDT + c * 16) = *(const v4u*)(src + (size_t)r * 128 + c * 8); }
}
__device__ __forceinline__ void qk_issue(Frame& F, const bf16* src, v4u (&r)[4]) {
#pragma unroll
    for (int it = 0; it < 2; ++it) { const int i = F.tid + NT * it, rw = i >> 3, c = i & 7;
        r[2 * it] = *(const v4u*)(src + (size_t)rw * 128 + c * 8); r[2 * it + 1] = *(const v4u*)(src + (size_t)rw * 128 + 64 + c * 8); }
}
template <int NDST> __device__ __forceinline__ void qk_commit(Frame& F, LAS unsigned char* dst0, LAS unsigned char* dst1, const v4u (&rg)[4], const LAS float* w0, const LAS float* w1, float scale, bool rope, int tpos0) {
#pragma unroll
    for (int it = 0; it < 2; ++it) {
        const int i = F.tid + NT * it, r = i >> 3, c = i & 7;
        float x1[8], x2[8];
        unpack8(rg[2 * it], x1); unpack8(rg[2 * it + 1], x2);
        if (rope) {
            const int tp = tpos0 + r, pos = c < 4 ? (tp >> 6) : (tp & 63);
            const f32x2* rt = WSP(const f32x2, WS_ROPE) + pos * 32 + ((8 * c) & 31);
#pragma unroll
            for (int j = 0; j < 8; ++j) { const f32x2 cs = rt[j]; const float a = x1[j], b = x2[j]; x1[j] = a * cs.x - b * cs.y; x2[j] = a * cs.y + b * cs.x; }
        }
        const float s0 = scale * (w0 ? w0[r] : 1.f);
        *(LAS v4u*)(dst0 + r * LDT + c * 16) = pack8(x1, s0); *(LAS v4u*)(dst0 + r * LDT + 128 + c * 16) = pack8(x2, s0);
        if (NDST == 2) { const float s1 = scale * w1[r];
            *(LAS v4u*)(dst1 + r * LDT + c * 16) = pack8(x1, s1); *(LAS v4u*)(dst1 + r * LDT + 128 + c * 16) = pack8(x2, s1); }
    }
}
template <int NDST> __device__ __forceinline__ void load_qk(Frame& F, LAS unsigned char* dst0, LAS unsigned char* dst1, const bf16* src, const LAS float* w0, const LAS float* w1, float scale, bool rope, int tpos0) {
    v4u r[4]; qk_issue(F, src, r); qk_commit<NDST>(F, dst0, dst1, r, w0, w1, scale, rope, tpos0);
}
template <int NDST> __device__ __forceinline__ void load_conv(Frame& F, KArgs& A, int l, LAS unsigned char* dst0, LAS unsigned char* dst1, int ldd, int ch0, int nc8, int row0, int seq_lo, int seq_hi,
                                                               const LAS float* w0, const LAS float* w1, bool to_global) {
    const float* cw = INP(I_CONVW) + (size_t)l * 5 * 1024 + ch0; const float* cb = INP(I_CONVB) + (size_t)l * 1024 + ch0;
    for (int i = F.tid; i < 128 * nc8; i += NT) {
        const int r = i / nc8, c = i % nc8, row = row0 + r;
        float acc[8];
        { const f32x4 b0 = *(const f32x4*)(cb + 8 * c), b1 = *(const f32x4*)(cb + 8 * c + 4); acc[0] = b0.x; acc[1] = b0.y; acc[2] = b0.z; acc[3] = b0.w; acc[4] = b1.x; acc[5] = b1.y; acc[6] = b1.z; acc[7] = b1.w; }
#pragma unroll
        for (int k = 0; k < 5; ++k) { const int rr = row + k - 2;
            if (rr >= seq_lo && rr < seq_hi) { float x[8]; unpack8(*(const v4u*)(PT(rr >> 7, PC_DX + ch0 + 8 * c) + (size_t)(rr & 127) * 128), x);
                const f32x4 w0v = *(const f32x4*)(cw + k * 1024 + 8 * c), w1v = *(const f32x4*)(cw + k * 1024 + 8 * c + 4);
                acc[0] += x[0] * w0v.x; acc[1] += x[1] * w0v.y; acc[2] += x[2] * w0v.z; acc[3] += x[3] * w0v.w; acc[4] += x[4] * w1v.x; acc[5] += x[5] * w1v.y; acc[6] += x[6] * w1v.z; acc[7] += x[7] * w1v.w; } }
#pragma unroll
        for (int j = 0; j < 8; ++j) acc[j] = siluf_(acc[j]);
        if (to_global) *(v4u*)(XT(row >> 7, ch0 + 8 * c) + (size_t)(row & 127) * 128) = pack8(acc, 1.f);
        if (NDST >= 1) *(LAS v4u*)(dst0 + r * ldd + c * 16) = pack8(acc, w0 ? w0[r] : 1.f);
        if (NDST == 2) *(LAS v4u*)(dst1 + r * ldd + c * 16) = pack8(acc, w1[r]);
    }
}
__device__ __forceinline__ void load_xbcc(Frame& F, LAS unsigned char* dst, int ldd, int ch0, int nc8, int row0) {
    const bf16* P = XT(row0 >> 7, ch0);
    for (int i = F.tid; i < 128 * nc8; i += NT) { const int r = i / nc8, c = i % nc8; *(LAS v4u*)(dst + r * ldd + c * 16) = *(const v4u*)(P + (size_t)r * 128 + 8 * c); }
}
__device__ __forceinline__ void kv_state_mfma(Frame& F, const LAS unsigned char* TKf, const LAS unsigned char* TKb, const LAS unsigned char* TV, bf16* outF, bf16* outB) {
    const int dvb = F.wave >> 1, dkb0 = (F.wave & 1) * 2, hh = F.lane >> 5;
    f32x16 acc[2][2] = {{ZERO16, ZERO16}, {ZERO16, ZERO16}};
#pragma unroll 1
    for (int ks = 0; ks < 8; ++ks) {
        const bf16x8 a = frag_tr(TV, LDT, 16 * ks, 32 * dvb, F.lane);
#pragma unroll
        for (int j = 0; j < 2; ++j) { acc[0][j] = MFMA32(a, frag_tr(TKf, LDT, 16 * ks, 32 * (dkb0 + j), F.lane), acc[0][j]); acc[1][j] = MFMA32(a, frag_tr(TKb, LDT, 16 * ks, 32 * (dkb0 + j), F.lane), acc[1][j]); }
    }
#pragma unroll
    for (int j = 0; j < 2; ++j)
#pragma unroll
        for (int i = 0; i < 16; ++i) { const int o = (32 * dvb + crow(i, hh)) * 128 + 32 * (dkb0 + j) + (F.lane & 31); outF[o] = (bf16)f2bf(acc[0][j][i]); outB[o] = (bf16)f2bf(acc[1][j][i]); }
}
__device__ __forceinline__ void qkT_mfma(Frame& F, const LAS unsigned char* TQ, const LAS unsigned char* TK, f32x16 (&qk)[2]) {
    const int tb = F.wave >> 1, sb0 = (F.wave & 1) * 2;
    qk[0] = ZERO16; qk[1] = ZERO16;
#pragma unroll 1
    for (int ks = 0; ks < 8; ++ks) { const bf16x8 bq = frag_row(TQ, LDT, 32 * tb, 16 * ks, F.lane);
#pragma unroll
        for (int j = 0; j < 2; ++j) qk[j] = MFMA32(frag_row(TK, LDT, 32 * (sb0 + j), 16 * ks, F.lane), bq, qk[j]); }
}
__device__ __forceinline__ void pv_mfma(Frame& F, const LAS unsigned char* TP, const LAS unsigned char* TV, f32x16 (&o)[2]) {
    const int tb = F.wave >> 1, eb0 = (F.wave & 1) * 2;
#pragma unroll 1
    for (int ks = 0; ks < 8; ++ks) { const bf16x8 ap = frag_row(TP, LDT, 32 * tb, 16 * ks, F.lane);
#pragma unroll
        for (int j = 0; j < 2; ++j) o[j] = MFMA32(ap, frag_tr(TV, LDT, 16 * ks, 32 * (eb0 + j), F.lane), o[j]); }
}
__device__ __forceinline__ void qs_prefetch(Frame& F, const bf16* ST, bf16x8 (&b)[2][8]) {
    const int eb0 = (F.wave & 1) * 2, hh = F.lane >> 5;
#pragma unroll
    for (int j = 0; j < 2; ++j)
#pragma unroll
        for (int ks = 0; ks < 8; ++ks) b[j][ks] = *(const bf16x8*)(ST + (size_t)(32 * (eb0 + j) + (F.lane & 31)) * 128 + 16 * ks + 8 * hh);
}
__device__ __forceinline__ void qs_mfma(Frame& F, const LAS unsigned char* TQ, const bf16x8 (&b)[2][8], f32x16 (&o)[2]) {
    const int tb = F.wave >> 1;
#pragma unroll
    for (int ks = 0; ks < 8; ++ks) { const bf16x8 aq = frag_row(TQ, LDT, 32 * tb, 16 * ks, F.lane);
#pragma unroll
        for (int j = 0; j < 2; ++j) o[j] = MFMA32(aq, b[j][ks], o[j]); }
}
__device__ __forceinline__ void hs_to_lds(Frame& F, LAS unsigned char* HS, const f32x16 (&hs)[2]) {
    const int tb = F.wave >> 1, eb0 = (F.wave & 1) * 2, hh = F.lane >> 5;
#pragma unroll
    for (int j = 0; j < 2; ++j)
#pragma unroll
        for (int i = 0; i < 16; ++i) *(LAS float*)(HS + (32 * tb + crow(i, hh)) * 528 + (32 * (eb0 + j) + (F.lane & 31)) * 4) = hs[j][i];
}
template <int GATE> __device__ __forceinline__ void head_out(Frame& F, const LAS unsigned char* HS, const float* gain, const bf16* gsrc  , bf16* ydst  ) {
    const int t = F.tid >> 2, seg = F.tid & 3;
    float v[32]; float ss = 0.f;
#pragma unroll
    for (int k = 0; k < 8; ++k) { const f32x4 x = *(const LAS f32x4*)(HS + t * 528 + (32 * seg + 4 * k) * 4); v[4 * k] = x.x; v[4 * k + 1] = x.y; v[4 * k + 2] = x.z; v[4 * k + 3] = x.w; ss += (x.x * x.x + x.y * x.y) + (x.z * x.z + x.w * x.w); }
    ss += __shfl_xor(ss, 1); ss += __shfl_xor(ss, 2);
    const float r = rsqrtf(ss * (1.f / 128.f) + EPS);
#pragma unroll
    for (int k = 0; k < 4; ++k) { float g[8]; unpack8(*(const v4u*)(gsrc + (size_t)t * 128 + 32 * seg + 8 * k), g); float o[8];
#pragma unroll
        for (int j = 0; j < 8; ++j) { const float gg = GATE == 0 ? sigmoidf_(g[j]) : siluf_(g[j]); o[j] = v[8 * k + j] * r * gain[32 * seg + 8 * k + j] * gg; }
        *(v4u*)(ydst + (size_t)t * D + 32 * seg + 8 * k) = pack8(o, 1.f); }
}

__device__ __forceinline__ void tile_issue(Frame& F, const bf16* src, v4u (&r)[4]) {
#pragma unroll
    for (int it = 0; it < 4; ++it) { const int i = F.tid + NT * it; r[it] = *(const v4u*)(src + (size_t)(i >> 4) * 128 + (i & 15) * 8); }
}
__device__ __forceinline__ void tile_commit(Frame& F, LAS unsigned char* dst, const v4u (&r)[4], float scale) {
#pragma unroll
    for (int it = 0; it < 4; ++it) { const int i = F.tid + NT * it; v4u v = r[it];
        if (scale != 1.f) { float x[8]; unpack8(v, x); v = pack8(x, scale); }
        *(LAS v4u*)(dst + (i >> 4) * LDT + (i & 15) * 16) = v; }
}
template <int GATE> __device__ __forceinline__ void head_out_r(Frame& F, const LAS unsigned char* HS, const float* gain, const v4u (&og)[4], bf16* ydst) {
    const int t = F.tid >> 2, seg = F.tid & 3;
    float v[32]; float ss = 0.f;
#pragma unroll
    for (int k = 0; k < 8; ++k) { const f32x4 x = *(const LAS f32x4*)(HS + t * 528 + (32 * seg + 4 * k) * 4); v[4 * k] = x.x; v[4 * k + 1] = x.y; v[4 * k + 2] = x.z; v[4 * k + 3] = x.w; ss += (x.x * x.x + x.y * x.y) + (x.z * x.z + x.w * x.w); }
    ss += __shfl_xor(ss, 1); ss += __shfl_xor(ss, 2);
    const float r = rsqrtf(ss * (1.f / 128.f) + EPS);
#pragma unroll
    for (int k = 0; k < 4; ++k) { float g[8]; unpack8(og[k], g); float o[8]; const f32x4 g0 = *(const f32x4*)(gain + 32 * seg + 8 * k), g1 = *(const f32x4*)(gain + 32 * seg + 8 * k + 4);
        const float gn[8] = {g0.x, g0.y, g0.z, g0.w, g1.x, g1.y, g1.z, g1.w};
#pragma unroll
        for (int j = 0; j < 8; ++j) { const float gg = GATE == 0 ? sigmoidf_(g[j]) : siluf_(g[j]); o[j] = v[8 * k + j] * r * gn[j] * gg; }
        *(v4u*)(ydst + (size_t)t * D + 32 * seg + 8 * k) = pack8(o, 1.f); }
}
__device__ __forceinline__ void mlstm_gates(Frame& F, KArgs& A, int l, int cp, int h) {
    if (F.tid < 128) { const float* g = WSP(const float, WS_GATES) + (size_t)(cp * 128 + F.tid) * 32;
        SCA(0)[F.tid] = g[h] + INP(I_MIB)[(l * 2 + 0) * 4 + h]; SCA(1)[F.tid] = g[4 + h] + INP(I_MIB)[(l * 2 + 1) * 4 + h];
        SCA(2)[F.tid] = logsigmoidf_(g[8 + h] + INP(I_MFB)[(l * 2 + 0) * 4 + h]); SCA(3)[F.tid] = logsigmoidf_(g[12 + h] + INP(I_MFB)[(l * 2 + 1) * 4 + h]); }
    BAR();
    if (F.wave == 0) wave_scan128<false>(SCA(2), SCA(4), F.lane, false, 0.f);
    if (F.wave == 1) wave_scan128<false>(SCA(3), SCA(5), F.lane, true, 0.f);
    BAR();
}
__device__ __forceinline__ void mlstm_local_item(Frame F, KArgs& A, int l, int cp, int h) {
    v4u rk[4], rv[4]; qk_issue(F, PT(cp, PC_MK + h * 128), rk); tile_issue(F, PT(cp, PC_MV + h * 128), rv);
    mlstm_gates(F, A, l, cp, h);
    if (F.wave < 2) { const int d = F.wave; const LAS float* bc = SCA(4 + d); const LAS float* ig = SCA(d); const float tot = d == 0 ? bc[127] : bc[0];
        const int s0 = 2 * F.lane; const float g0 = tot - bc[s0] + ig[s0], g1 = tot - bc[s0 + 1] + ig[s0 + 1];
        const float mx = wave_max(fmaxf(g0, g1));
        SCA(6 + d)[s0] = __expf(g0 - mx); SCA(6 + d)[s0 + 1] = __expf(g1 - mx);
        if (F.lane == 0) { float* sc = WSP(float, WS_MLSC) + ((cp * 2 + d) * 4 + h) * 2; sc[0] = tot; sc[1] = mx; } }
    BAR();
    qk_commit<2>(F, F.lds, F.lds + TS, rk, SCA(6), SCA(7), 0.08838834764831845f, false, 0);
    tile_commit(F, F.lds + 2 * TS, rv, 1.f);
    BAR();
    kv_state_mfma(F, F.lds, F.lds + TS, F.lds + 2 * TS, WSP(bf16, WS_MLCLOC) + (size_t)((cp * 2 + 0) * 4 + h) * 16384, WSP(bf16, WS_MLCLOC) + (size_t)((cp * 2 + 1) * 4 + h) * 16384);
    if (F.tid < 256) { const int d = F.tid >> 7, dk = F.tid & 127; const LAS unsigned char* T = F.lds + d * TS; float s = 0.f;
        for (int r = 0; r < 128; ++r) s += bf2f(*(const LAS unsigned short*)(T + r * LDT + dk * 2));
        WSP(float, WS_MLNLOC)[((cp * 2 + d) * 4 + h) * 128 + dk] = s; }
    BAR();
}
__device__ __forceinline__ void mlstm_out_item(Frame F, KArgs& A, int l, int cp, int h) {
    const Seq sq = seq_of(cp);
    LAS unsigned char* TQ = F.lds; LAS unsigned char* TK = F.lds + TS; LAS unsigned char* TV = F.lds + 2 * TS; LAS unsigned char* TP = F.lds + 3 * TS;
    ITS(0);
    v4u rq[4], rk[4], rv[4], og[4];
    tile_issue(F, PT(cp, PC_MQ + h * 128), rq); tile_issue(F, PT(cp, PC_MK + h * 128), rk); tile_issue(F, PT(cp, PC_MV + h * 128), rv);
    { const int t = F.tid >> 2, seg = F.tid & 3;
#pragma unroll
      for (int k = 0; k < 4; ++k) og[k] = *(const v4u*)(PT(cp, PC_MO + h * 128) + (size_t)t * 128 + 32 * seg + 8 * k); }
    const float min_f = WSP(const float, WS_MLMIN)[(cp * 2 + 0) * 4 + h], min_b = WSP(const float, WS_MLMIN)[(cp * 2 + 1) * 4 + h];
    float nin = 0.f; if (F.tid < 256) nin = WSP(const float, WS_MLNIN)[((cp * 2 + (F.tid >> 7)) * 4 + h) * 128 + (F.tid & 127)];
    mlstm_gates(F, A, l, cp, h);
    if (F.tid < 256) { const int d = F.tid >> 7, s = F.tid & 127; SCA(6 + d)[s] = SCA(d)[s] - SCA(4 + d)[s]; SCA(12 + d)[s] = nin; }
    tile_commit(F, TQ, rq, 1.f); tile_commit(F, TK, rk, 0.08838834764831845f); tile_commit(F, TV, rv, 1.f);
    BAR();
    if (F.wave == 0) wave_scan128<true>(SCA(6), SCA(8), F.lane, false, min_f);
    if (F.wave == 1) wave_scan128<true>(SCA(7), SCA(9), F.lane, true, min_b);
    BAR();
    ITE(0);
    f32x16 hs[2] = {ZERO16, ZERO16};
    const int tb = F.wave >> 1, sb0 = (F.wave & 1) * 2, hh = F.lane >> 5, t = 32 * tb + (F.lane & 31);
#pragma unroll 1
    for (int d = 0; d < 2; ++d) {
        const LAS float* av = SCA(6 + d); const float Mt = SCA(8 + d)[t]; const float m_in = d == 0 ? min_f : min_b;
        ITS(2);
        const bool has_state = sq.lat || (d == 0 ? sq.c > 0 : sq.c < sq.nch - 1);
        bf16x8 bst[2][8]; if (has_state) qs_prefetch(F, WSP(const bf16, WS_MLCIN) + (size_t)((cp * 2 + d) * 4 + h) * 16384, bst);
        f32x16 qk[2]; qkT_mfma(F, TQ, TK, qk);
#pragma unroll
        for (int j = 0; j < 2; ++j)
#pragma unroll
            for (int i4 = 0; i4 < 4; ++i4) { const int sb = 32 * (sb0 + j) + 8 * i4 + 4 * hh; float p[4];
#pragma unroll
                for (int i = 0; i < 4; ++i) { const int s = sb + i; const bool ok = d == 0 ? (s <= t) : (s >= t); p[i] = ok ? qk[j][4 * i4 + i] * __expf(av[s] - Mt) : 0.f; }
                *(LAS u32x2*)(TP + t * LDT + sb * 2) = (u32x2){pk2(p[0], p[1]), pk2(p[2], p[3])}; }
        ITE(2); ITS(3);
        BAR();
        {
            const int tt = F.tid >> 2, seg = F.tid & 3; float ds = 0.f, qn = 0.f;
#pragma unroll
            for (int k = 0; k < 4; ++k) { float x[8]; unpack8(*(const LAS v4u*)(TP + tt * LDT + 64 * seg + 16 * k), x); float q[8]; unpack8(*(const LAS v4u*)(TQ + tt * LDT + 64 * seg + 16 * k), q);
                const f32x4 n0 = *(const LAS f32x4*)(SCA(12 + d) + 32 * seg + 8 * k), n1 = *(const LAS f32x4*)(SCA(12 + d) + 32 * seg + 8 * k + 4);
                ds += ((x[0] + x[1]) + (x[2] + x[3])) + ((x[4] + x[5]) + (x[6] + x[7]));
                qn += (q[0] * n0.x + q[1] * n0.y) + (q[2] * n0.z + q[3] * n0.w) + (q[4] * n1.x + q[5] * n1.y) + (q[6] * n1.z + q[7] * n1.w); }
            ds += __shfl_xor(ds, 1); ds += __shfl_xor(ds, 2); qn += __shfl_xor(qn, 1); qn += __shfl_xor(qn, 2);
            if (seg == 0) { const float Mtt = SCA(8 + d)[tt], wint = __expf(m_in - Mtt), den = ds + wint * qn, dd = fmaxf(fabsf(den), __expf(-(SCA(4 + d)[tt] + Mtt)));
                SCA(10)[tt] = wint / dd; SCA(11)[tt] = 1.f / dd; } }
        { f32x16 num[2] = {ZERO16, ZERO16};
          pv_mfma(F, TP, TV, num);
          BAR(); ITE(3); ITS(4);
#pragma unroll
          for (int j = 0; j < 2; ++j)
#pragma unroll
            for (int i = 0; i < 16; ++i) hs[j][i] += SCA(11)[32 * tb + crow(i, hh)] * num[j][i]; }
        if (has_state) { f32x16 qc[2] = {ZERO16, ZERO16};
          qs_mfma(F, TQ, bst, qc);
#pragma unroll
          for (int j = 0; j < 2; ++j)
#pragma unroll
            for (int i = 0; i < 16; ++i) hs[j][i] += SCA(10)[32 * tb + crow(i, hh)] * qc[j][i]; }
        ITE(4);
    }
    ITS(5);
    BAR();
    hs_to_lds(F, F.lds, hs);
    BAR();
    head_out_r<0>(F, F.lds, INP(I_MNORM) + (size_t)l * GWID + h * 128, og, WSP(bf16, WS_Y) + (size_t)cp * 128 * D + 512 + h * 128);
    BAR(); ITE(5);
}

__device__ __forceinline__ void ret_local_item(Frame F, KArgs& A, int l, int cp, int h) {
    const float lgf = -__expf(INP(I_RRATE)[(l * 2 + 0) * 4 + h]), lgb = -__expf(INP(I_RRATE)[(l * 2 + 1) * 4 + h]);
    v4u rk[4], rv[4]; qk_issue(F, PT(cp, PC_RK + h * 128), rk); tile_issue(F, PT(cp, PC_RV + h * 128), rv);
    if (F.tid < 128) { SCA(6)[F.tid] = __expf((127.f - (float)F.tid) * lgf); SCA(7)[F.tid] = __expf((float)F.tid * lgb); }
    BAR();
    const Seq sq = seq_of(cp);
    qk_commit<2>(F, F.lds, F.lds + TS, rk, SCA(6), SCA(7), 0.08838834764831845f, sq.lat != 0, sq.c * 128);
    tile_commit(F, F.lds + 2 * TS, rv, 1.f);
    BAR();
    kv_state_mfma(F, F.lds, F.lds + TS, F.lds + 2 * TS, WSP(bf16, WS_RTLOC) + (size_t)((cp * 2 + 0) * 4 + h) * 16384, WSP(bf16, WS_RTLOC) + (size_t)((cp * 2 + 1) * 4 + h) * 16384);
    BAR();
}
__device__ __forceinline__ void ret_out_item(Frame F, KArgs& A, int l, int cp, int h) {
    const float lgf = -__expf(INP(I_RRATE)[(l * 2 + 0) * 4 + h]), lgb = -__expf(INP(I_RRATE)[(l * 2 + 1) * 4 + h]);
    if (F.tid < 128) { SCA(10)[F.tid] = __expf(((float)F.tid + 1.f) * lgf); SCA(11)[F.tid] = __expf((128.f - (float)F.tid) * lgb); }
    const Seq sq = seq_of(cp);
    LAS unsigned char* TQ = F.lds; LAS unsigned char* TK = F.lds + TS; LAS unsigned char* TV = F.lds + 2 * TS; LAS unsigned char* TP = F.lds + 3 * TS;
    v4u rq[4], rk[4], rv[4], og[4];
    qk_issue(F, PT(cp, PC_RQ + h * 128), rq); qk_issue(F, PT(cp, PC_RK + h * 128), rk); tile_issue(F, PT(cp, PC_RV + h * 128), rv);
    { const int t_ = F.tid >> 2, seg_ = F.tid & 3;
#pragma unroll
      for (int k = 0; k < 4; ++k) og[k] = *(const v4u*)(PT(cp, PC_RG + h * 128) + (size_t)t_ * 128 + 32 * seg_ + 8 * k); }
    qk_commit<1>(F, TQ, nullptr, rq, nullptr, nullptr, 1.f, sq.lat != 0, sq.c * 128);
    qk_commit<1>(F, TK, nullptr, rk, nullptr, nullptr, 0.08838834764831845f, sq.lat != 0, sq.c * 128);
    tile_commit(F, TV, rv, 1.f);
    BAR();
    f32x16 qk[2]; qkT_mfma(F, TQ, TK, qk);
    const int tb = F.wave >> 1, sb0 = (F.wave & 1) * 2, hh = F.lane >> 5, t = 32 * tb + (F.lane & 31);
#pragma unroll
    for (int j = 0; j < 2; ++j)
#pragma unroll
        for (int i4 = 0; i4 < 4; ++i4) { const int sb = 32 * (sb0 + j) + 8 * i4 + 4 * hh; float p[4];
#pragma unroll
            for (int i = 0; i < 4; ++i) { const int s = sb + i; const float df = (float)(t - s);
                const float dm = (s <= t ? __expf(df * lgf) : 0.f) + (s >= t ? __expf(-df * lgb) : 0.f); p[i] = qk[j][4 * i4 + i] * dm; }
            *(LAS u32x2*)(TP + t * LDT + sb * 2) = (u32x2){pk2(p[0], p[1]), pk2(p[2], p[3])}; }
    BAR();
    f32x16 y[2] = {ZERO16, ZERO16};
    pv_mfma(F, TP, TV, y);
#pragma unroll 1
    for (int d = 0; d < 2; ++d) { f32x16 qs[2] = {ZERO16, ZERO16};
        if (!sq.lat && (d == 0 ? sq.c == 0 : sq.c == sq.nch - 1)) continue;
        bf16x8 bst[2][8]; qs_prefetch(F, WSP(const bf16, WS_RTIN) + (size_t)((cp * 2 + d) * 4 + h) * 16384, bst);
        qs_mfma(F, TQ, bst, qs);
#pragma unroll
        for (int j = 0; j < 2; ++j)
#pragma unroll
            for (int i = 0; i < 16; ++i) y[j][i] += SCA(10 + d)[32 * tb + crow(i, hh)] * qs[j][i]; }
    BAR();
    hs_to_lds(F, F.lds, y);
    BAR();
    head_out_r<1>(F, F.lds, INP(I_RNORM) + (size_t)l * GWID + h * 128, og, WSP(bf16, WS_Y) + (size_t)cp * 128 * D + 1024 + h * 128);
    BAR();
}
template <bool WMODE> __device__ __forceinline__ float ssd_scalars(Frame& F, KArgs& A, int l, int cp, int g) {
    const int d = F.wave >> 2, rr = F.wave & 3, head = g * 4 + rr;
    const float bias = INP(I_DTB)[(l * 2 + d) * 8 + head], arate = -__expf(INP(I_ALOG)[(l * 2 + d) * 8 + head]);
    const float* gp = WSP(const float, WS_GATES) + (size_t)(cp * 128) * 32 + 16 + d * 8 + head;
    const int i0 = d ? 127 - 2 * F.lane : 2 * F.lane, i1 = d ? i0 - 1 : i0 + 1;
    const float dt0 = softplusf_(gp[(size_t)i0 * 32] + bias), dt1 = softplusf_(gp[(size_t)i1 * 32] + bias);
    const float a0 = dt0 * arate, a1 = dt1 * arate;
    float inc = a0 + a1;
#pragma unroll
    for (int o = 1; o < 64; o <<= 1) { const float t = __shfl_up(inc, o); if (F.lane >= o) inc += t; }
    const float c1 = inc, c0 = inc - a1, tot = __shfl(inc, 63);
    LAS float* cum = SCA(16 + d * 4 + rr); LAS float* dtw = SCA(24 + d * 4 + rr);
    cum[i0] = c0; cum[i1] = c1;
    if (WMODE) { dtw[i0] = __expf(tot - c0) * dt0; dtw[i1] = __expf(tot - c1) * dt1; } else { dtw[i0] = dt0; dtw[i1] = dt1; }
    return tot;
}
__device__ __forceinline__ void seq_bounds(int cp, int& lo, int& hi) { if (cp < 64) { lo = (cp >> 1) * 256; hi = lo + 256; } else { lo = MC + ((cp - 64) >> 5) * 4096; hi = lo + 4096; } }
__device__ __forceinline__ void ssd_local_item(Frame F, KArgs& A, int l, int cp, int g) {
    const float tot = ssd_scalars<true>(F, A, l, cp, g);
    if (F.lane == 0) WSP(float, WS_SDSC)[(cp * 2 + (F.wave >> 2)) * 8 + g * 4 + (F.wave & 3)] = tot;
    int lo, hi; seq_bounds(cp, lo, hi);
    LAS unsigned char* TB = F.lds;
    load_conv<1>(F, A, l, TB, nullptr, LDT, 512 + g * 128, 16, cp * 128, lo, hi, nullptr, nullptr, true);
    load_conv<0>(F, A, l, nullptr, nullptr, LDT, 768 + g * 128, 16, cp * 128, lo, hi, nullptr, nullptr, true);
    BAR();
#pragma unroll 1
    for (int hr = 0; hr < 2; ++hr) {
#pragma unroll 1
        for (int r2 = 0; r2 < 2; ++r2) { const int rr = hr * 2 + r2;
            load_conv<2>(F, A, l, F.lds + TS + (r2 * 2 + 0) * TSX, F.lds + TS + (r2 * 2 + 1) * TSX, LDX, g * 256 + rr * 64, 8, cp * 128, lo, hi, SCA(24 + 0 * 4 + rr), SCA(24 + 1 * 4 + rr), true); }
        BAR();
        const int r2 = F.wave >> 2, d = (F.wave >> 1) & 1, pb = F.wave & 1, hh = F.lane >> 5, head = g * 4 + hr * 2 + r2;
        const LAS unsigned char* TX = F.lds + TS + (r2 * 2 + d) * TSX;
        f32x16 acc[4] = {ZERO16, ZERO16, ZERO16, ZERO16};
#pragma unroll 1
        for (int ks = 0; ks < 8; ++ks) { const bf16x8 a = frag_tr(TX, LDX, 16 * ks, 32 * pb, F.lane);
#pragma unroll
            for (int nb = 0; nb < 4; ++nb) acc[nb] = MFMA32(a, frag_tr(TB, LDT, 16 * ks, 32 * nb, F.lane), acc[nb]); }
        bf16* o = WSP(bf16, WS_SDLOC) + (size_t)((cp * 2 + d) * 8 + head) * 8192;
#pragma unroll
        for (int nb = 0; nb < 4; ++nb)
#pragma unroll
            for (int i = 0; i < 16; ++i) o[(32 * pb + crow(i, hh)) * 128 + 32 * nb + (F.lane & 31)] = (bf16)f2bf(acc[nb][i]);
        BAR();
    }
}
__device__ __forceinline__ void ssd_out_item(Frame F, KArgs& A, int l, int cp, bf16* Ybase) {
    const Seq sq = seq_of(cp);
    LAS unsigned char* TC = F.lds; LAS unsigned char* TB = F.lds + TS; LAS unsigned char* TX2 = F.lds + 2 * TS; LAS unsigned char* YI = F.lds + 3 * TS;
    LAS float* SSQ = SCA(14);
    if (F.tid < 128) SSQ[F.tid] = 0.f;
    const int tb = F.wave >> 1, ph = F.wave & 1, hh = F.lane >> 5, t = 32 * tb + (F.lane & 31);
    bf16* Yd = Ybase + (size_t)cp * 128 * D + 1536;
#pragma unroll 1
    for (int g = 0; g < 2; ++g) {
        (void)ssd_scalars<false>(F, A, l, cp, g);
        load_xbcc(F, TC, LDT, 768 + g * 128, 16, cp * 128);
        load_xbcc(F, TB, LDT, 512 + g * 128, 16, cp * 128);
        load_xbcc(F, TX2, LDT, g * 256, 16, cp * 128);
        BAR();
        f32x16 cb[4] = {ZERO16, ZERO16, ZERO16, ZERO16};
#pragma unroll 1
        for (int ks = 0; ks < 8; ++ks) { const bf16x8 bq = frag_row(TC, LDT, 32 * tb, 16 * ks, F.lane);
#pragma unroll
            for (int sb = 0; sb < 4; ++sb) cb[sb] = MFMA32(frag_row(TB, LDT, 32 * sb, 16 * ks, F.lane), bq, cb[sb]); }
#pragma unroll 1
        for (int hr = 0; hr < 2; ++hr) {
            if (hr == 1) { load_xbcc(F, TX2, LDT, g * 256 + 128, 16, cp * 128); BAR(); }
            f32x16 y2[2];
#pragma unroll
            for (int r2 = 0; r2 < 2; ++r2) {
                const int rr = hr * 2 + r2, head = g * 4 + rr;
                f32x16 y = ZERO16;
#pragma unroll 1
                for (int d = 0; d < 2; ++d) {
                    const LAS float* cum = SCA(16 + d * 4 + rr); const LAS float* dtv = SCA(24 + d * 4 + rr); const float ct = cum[t];
                    const bool has_state = sq.lat || (d == 0 ? sq.c > 0 : sq.c < sq.nch - 1);
                    bf16x8 bh[8];
                    if (has_state) { const bf16* hin = WSP(const bf16, WS_SDIN) + (size_t)((cp * 2 + d) * 8 + head) * 8192;
#pragma unroll
                        for (int ks = 0; ks < 8; ++ks) bh[ks] = *(const bf16x8*)(hin + (size_t)(32 * ph + (F.lane & 31)) * 128 + 16 * ks + 8 * hh); }
#pragma unroll
                    for (int sb = 0; sb < 4; ++sb) if (d == 0 ? sb <= tb : sb >= tb) {
#pragma unroll
                        for (int sp = 0; sp < 2; ++sp) { float p[8];
#pragma unroll
                            for (int j = 0; j < 8; ++j) { const int s = 32 * sb + crow(8 * sp + j, hh); const bool ok = d == 0 ? (s <= t) : (s >= t); p[j] = ok ? cb[sb][8 * sp + j] * __expf(ct - cum[s]) * dtv[s] : 0.f; }
                            y = MFMA32(__builtin_bit_cast(bf16x8, pack8(p, 1.f)), frag_trp(TX2, LDT, 32 * sb + 16 * sp, r2 * 64 + 32 * ph, F.lane), y); } }
                    if (has_state) { f32x16 ch = ZERO16;
#pragma unroll
                        for (int ks = 0; ks < 8; ++ks) ch = MFMA32(frag_row(TC, LDT, 32 * tb, 16 * ks, F.lane), bh[ks], ch);
#pragma unroll
                        for (int i = 0; i < 16; ++i) y[i] += __expf(cum[32 * tb + crow(i, hh)]) * ch[i]; }
                }
                y2[r2] = y;
            }
#pragma unroll
            for (int r2 = 0; r2 < 2; ++r2)
#pragma unroll
                for (int i = 0; i < 16; ++i) *(LAS unsigned short*)(YI + (32 * tb + crow(i, hh)) * LDT + (r2 * 64 + 32 * ph + (F.lane & 31)) * 2) = (unsigned short)f2bf(y2[r2][i]);
            BAR();
            { const int tt = F.tid >> 2, seg = F.tid & 3, head = g * 4 + hr * 2 + (seg >> 1), pc = (seg & 1) * 32; const float Dh = INP(I_SSDD)[l * 8 + head]; float ss = 0.f;
#pragma unroll
                for (int k = 0; k < 4; ++k) { float yv[8], x[8], z[8], o[8];
                    unpack8(*(const LAS v4u*)(YI + tt * LDT + (seg * 32 + 8 * k) * 2), yv); unpack8(*(const LAS v4u*)(TX2 + tt * LDT + (seg * 32 + 8 * k) * 2), x);
                    unpack8(*(const v4u*)(PT(cp, PC_DZ + head * 64 + pc) + (size_t)tt * 128 + 8 * k), z);
#pragma unroll
                    for (int j = 0; j < 8; ++j) { const float v = (yv[j] + Dh * x[j]) * siluf_(z[j]); o[j] = v; ss += v * v; }
                    *(v4u*)(Yd + (size_t)tt * D + head * 64 + pc + 8 * k) = pack8(o, 1.f); }
                ss += __shfl_xor(ss, 1); ss += __shfl_xor(ss, 2);
                if (seg == 0) SSQ[tt] += ss; }
            BAR();
        }
    }
    __builtin_amdgcn_fence(__ATOMIC_RELEASE, "workgroup"); asm volatile("s_waitcnt vmcnt(0)" ::: "memory"); __syncthreads(); __builtin_amdgcn_fence(__ATOMIC_ACQUIRE, "workgroup");
    { const int tt = F.tid >> 2, seg = F.tid & 3; const float r = rsqrtf(SSQ[tt] * (1.f / 512.f) + EPS); const float* gn = INP(I_SNORM) + (size_t)l * GWID + 128 * seg;
#pragma unroll 4
        for (int k = 0; k < 16; ++k) { bf16* p = Yd + (size_t)tt * D + 128 * seg + 8 * k; float v[8];
            unpack8(*(const v4u*)p, v);
#pragma unroll
            for (int j = 0; j < 8; ++j) v[j] = v[j] * r * gn[8 * k + j];
            *(v4u*)p = pack8(v, 1.f); } }
    BAR();
}
template <int PASS> __device__ __forceinline__ void s5_item(Frame F, KArgs& A, int l, int cp, int gq) {
    const Seq sq = seq_of(cp);
    const int g = gq * 8 + F.wave, p = F.lane, hh = F.lane >> 5;
    LAS unsigned char* TU = F.lds; LAS unsigned char* BU = F.lds + TS + F.wave * 8704;
    load_tile128(F, TU, PT(cp, PC_S5U + gq * 128));
    BAR();
    typedef float f32x4v __attribute__((ext_vector_type(4)));
    f32x4v yacc[4][2];
    if (PASS == 1) {
#pragma unroll
        for (int a = 0; a < 4; ++a) { yacc[a][0] = (f32x4v){0.f, 0.f, 0.f, 0.f}; yacc[a][1] = (f32x4v){0.f, 0.f, 0.f, 0.f}; } }
#pragma unroll 1
    for (int d = 0; d < 2; ++d) {
        const unsigned char* tab = s5tab(F, l, d, g);
        const float lr = ((const float*)tab)[2 * p], li = ((const float*)tab)[2 * p + 1];
        float hr = 0.f, hi = 0.f;
        if (PASS == 1) {
            if (sq.lat) { const size_t o = (size_t)(((sq.b * 4 + l) * 2 + d) * 32 + g) * 64 + p; hr = INP(I_SS5R)[o]; hi = INP(I_SS5I)[o]; }
            const float l8r = ((const float*)(tab + 512))[2 * p], l8i = ((const float*)(tab + 512))[2 * p + 1];
            const int n = d == 0 ? sq.c : sq.nch - 1 - sq.c;
            for (int k0 = 0; k0 < n; k0 += 8) {
                f32x2 e[8];
#pragma unroll
                for (int j = 0; j < 8; ++j) { const int k = (k0 + j < n) ? k0 + j : n - 1, cc = d == 0 ? k : sq.nch - 1 - k;
                    e[j] = *(const f32x2*)(WSP(const float, WS_S5LOC) + ((size_t)(((sq.cp0 + cc) * 2 + d) * 32 + g) * 64 + p) * 2); }
#pragma unroll
                for (int j = 0; j < 8; ++j) if (k0 + j < n) { const float nr = l8r * hr - l8i * hi + e[j].x, ni = l8r * hi + l8i * hr + e[j].y; hr = nr; hi = ni; }
            }
        }
        const bf16* bb = (const bf16*)(tab + 1024); const bf16* ct = (const bf16*)(tab + 5120);
        typedef short v8s __attribute__((ext_vector_type(8)));
        const int r16 = F.lane & 15, g4 = F.lane >> 4;
        bf16x8 bbf[4]; v8s ctf[4];
#pragma unroll
        for (int nb = 0; nb < 4; ++nb) bbf[nb] = *(const bf16x8*)(bb + (size_t)(32 * nb + (F.lane & 31)) * 16 + 8 * hh);
        if (PASS == 1) {
#pragma unroll
            for (int ks = 0; ks < 4; ++ks) ctf[ks] = *(const v8s*)(ct + r16 * 128 + 32 * ks + 8 * g4); }
#pragma unroll 1
        for (int tbi = 0; tbi < 4; ++tbi) {
            const int tb = d == 0 ? tbi : 3 - tbi;
            const bf16x8 bu = frag_row(TU, LDT, 32 * tb, 16 * F.wave, F.lane);
#pragma unroll
            for (int nb = 0; nb < 4; ++nb) {
                const f32x16 acc = MFMA32(bbf[nb], bu, ZERO16);
#pragma unroll
                for (int i4 = 0; i4 < 4; ++i4) *(LAS u32x2*)(BU + (F.lane & 31) * LDT + (32 * nb + 8 * i4 + 4 * hh) * 2) = (u32x2){pk2(acc[4 * i4], acc[4 * i4 + 1]), pk2(acc[4 * i4 + 2], acc[4 * i4 + 3])};
            }
            asm volatile("s_waitcnt lgkmcnt(0)" ::: "memory");
            unsigned w[32];
#pragma unroll
            for (int st = 0; st < 32; ++st) { const int tl = d == 0 ? st : 31 - st; w[st] = *(const LAS unsigned*)(BU + tl * LDT + p * 4); }
#pragma unroll
            for (int st = 0; st < 32; ++st) { const float br = bflo(w[st]), bi = bfhi(w[st]);
                const float nr = lr * hr - li * hi + br, ni = lr * hi + li * hr + bi; hr = nr; hi = ni;
                if (PASS == 1) w[st] = pk2(hr, hi); }
            if (PASS == 1) {
#pragma unroll
                for (int st = 0; st < 32; ++st) { const int tl = d == 0 ? st : 31 - st; *(LAS unsigned*)(BU + tl * LDT + p * 4) = w[st]; }
                asm volatile("s_waitcnt lgkmcnt(0)" ::: "memory");
                f32x4v y0 = (f32x4v){0.f, 0.f, 0.f, 0.f}, y1 = y0;
#pragma unroll
                for (int ks = 0; ks < 4; ++ks) {
                    y0 = __builtin_amdgcn_mfma_f32_16x16x32_bf16(*(const LAS v8s*)(BU + r16 * LDT + (32 * ks + 8 * g4) * 2), ctf[ks], y0, 0, 0, 0);
                    y1 = __builtin_amdgcn_mfma_f32_16x16x32_bf16(*(const LAS v8s*)(BU + (16 + r16) * LDT + (32 * ks + 8 * g4) * 2), ctf[ks], y1, 0, 0, 0); }
                if (tb == 0) { yacc[0][0] += y0; yacc[0][1] += y1; } else if (tb == 1) { yacc[1][0] += y0; yacc[1][1] += y1; } else if (tb == 2) { yacc[2][0] += y0; yacc[2][1] += y1; } else { yacc[3][0] += y0; yacc[3][1] += y1; }
                asm volatile("s_waitcnt lgkmcnt(0)" ::: "memory");
            }
        }
        if (PASS == 0) { *(f32x2*)(WSP(float, WS_S5LOC) + ((size_t)((cp * 2 + d) * 32 + g) * 64 + p) * 2) = (f32x2){hr, hi}; }
        else if (!sq.lat && ((d == 0 && sq.c == sq.nch - 1) || (d == 1 && sq.c == 0))) { const size_t o = (size_t)(((sq.b * 4 + l) * 2 + d) * 32 + g) * 64 + p; F.out[O_S5R + o] = hr; F.out[O_S5I + o] = hi; }
    }
    if (PASS == 1) {
        const int r16 = F.lane & 15, g4 = F.lane >> 4; const float Dc = INP(I_S5D)[(size_t)l * GWID + g * 16 + r16];
#pragma unroll
        for (int tb = 0; tb < 4; ++tb)
#pragma unroll
            for (int ts = 0; ts < 2; ++ts)
#pragma unroll
                for (int i = 0; i < 4; ++i) { const int t = 32 * tb + 16 * ts + 4 * g4 + i; LAS unsigned short* up = (LAS unsigned short*)(TU + t * LDT + (16 * F.wave + r16) * 2);
                    const float x = yacc[tb][ts][i] + Dc * bf2f(*up);
                    const float u2 = 1.5957691216057308f * (x + 0.044715f * x * x * x); const float ge = x - x / (1.f + __expf(u2));
                    *up = (unsigned short)f2bf(ge); }
        BAR();
        bf16* ya = WSP(bf16, WS_YA) + (size_t)cp * 128 * GWID + gq * 128;
#pragma unroll
        for (int it = 0; it < 4; ++it) { const int i = F.tid + NT * it, r = i >> 4, c = i & 15; *(v4u*)(ya + (size_t)r * GWID + c * 8) = *(const LAS v4u*)(TU + r * LDT + c * 16); }
    }
    BAR();
}

template <bool LAT> __device__ __forceinline__ void carry_unit(Frame F, KArgs& A, int l, int u) {
    const int sd = u / 96, rem = u % 96, sidx = sd >> 1, d = sd & 1;
    constexpr int lat = LAT ? 1 : 0, nch = LAT ? 32 : 2, NB = LAT ? 8 : 2;
    const int b = LAT ? sidx : sidx - 4, cp0 = LAT ? 64 + 32 * b : 2 * b;
    int type, head, slice;
    if (rem < 32) { type = 0; head = rem >> 3; slice = rem & 7; } else if (rem < 64) { type = 1; head = (rem - 32) >> 3; slice = (rem - 32) & 7; } else { type = 2; head = (rem - 64) >> 2; slice = (rem - 64) & 3; }
    const int e0 = slice * 2048 + F.tid * 4;
    const int nh = type == 2 ? 8 : 4, esz = type == 2 ? 8192 : 16384;
    const bf16* loc = type == 0 ? WSP(const bf16, WS_MLCLOC) : (type == 1 ? WSP(const bf16, WS_RTLOC) : WSP(const bf16, WS_SDLOC));
    bf16* inb = type == 0 ? WSP(bf16, WS_MLCIN) : (type == 1 ? WSP(bf16, WS_RTIN) : WSP(bf16, WS_SDIN));
    float zf = 0.f; asm volatile("" : "+v"(zf));
    float v[4] = {zf, zf, zf, zf}, nv[4] = {zf, zf, zf, zf}, m = 0.f;
    const bool do_n = (type == 0 && slice == 0 && F.tid < 32);
    if (LAT) {
        if (type == 2) { const f32x4 s = *(const f32x4*)(INP(I_SSSD) + (size_t)(((b * 4 + l) * 2 + d) * 8 + head) * 8192 + e0); v[0] = s.x; v[1] = s.y; v[2] = s.z; v[3] = s.w; }
        else { const float* s = (type == 0 ? INP(I_SMC) : INP(I_SRET)) + (size_t)(((b * 4 + l) * 2 + d) * 4 + head) * 16384; const int dv = e0 >> 7, dk = e0 & 127;
#pragma unroll
            for (int j = 0; j < 4; ++j) v[j] = s[(dk + j) * 128 + dv]; }
        if (type == 0) { m = INP(I_SMM)[((b * 4 + l) * 2 + d) * 4 + head];
            if (do_n) { const f32x4 s = *(const f32x4*)(INP(I_SMN) + (size_t)(((b * 4 + l) * 2 + d) * 4 + head) * 128 + F.tid * 4); nv[0] = s.x; nv[1] = s.y; nv[2] = s.z; nv[3] = s.w; } }
    }
    const float rdec = type == 1 ? __expf(-128.f * __expf(INP(I_RRATE)[(l * 2 + d) * 4 + head])) : 1.f;
#pragma unroll 1
    for (int ci0 = 0; ci0 < nch; ci0 += NB) {
        u32x2 lc[NB]; f32x4 ln[NB]; float s0[NB], s1[NB];
#pragma unroll
        for (int j = 0; j < NB; ++j) { ln[j] = (f32x4){zf, zf, zf, zf}; s0[j] = zf; s1[j] = zf; }
#pragma unroll
        for (int j = 0; j < NB; ++j) {
            const int ci = ci0 + j, cp = cp0 + (d == 0 ? ci : nch - 1 - ci);
            lc[j] = *(const u32x2*)(loc + (size_t)((cp * 2 + d) * nh + head) * esz + e0);
            if (type == 0) { const float* sc = WSP(const float, WS_MLSC) + ((cp * 2 + d) * 4 + head) * 2; s0[j] = sc[0]; s1[j] = sc[1];
                if (do_n) ln[j] = *(const f32x4*)(WSP(const float, WS_MLNLOC) + ((cp * 2 + d) * 4 + head) * 128 + F.tid * 4); }
            else if (type == 2) s0[j] = WSP(const float, WS_SDSC)[(cp * 2 + d) * 8 + head];
        }
#pragma unroll
        for (int j = 0; j < NB; ++j) {
            const int ci = ci0 + j, cp = cp0 + (d == 0 ? ci : nch - 1 - ci);
            const size_t so = (size_t)((cp * 2 + d) * nh + head) * esz + e0;
            if (LAT || ci > 0) *(u32x2*)(inb + so) = (u32x2){pk2(v[0], v[1]), pk2(v[2], v[3])};
            float dec, wl = 1.f;
            if (type == 0) {
                const float Bt = s0[j], ml = s1[j];
                if (slice == 0 && F.tid == 0) WSP(float, WS_MLMIN)[(cp * 2 + d) * 4 + head] = m;
                if (do_n) *(f32x4*)(WSP(float, WS_MLNIN) + ((cp * 2 + d) * 4 + head) * 128 + F.tid * 4) = (f32x4){nv[0], nv[1], nv[2], nv[3]};
                const float mn = fmaxf(Bt + m, ml); dec = __expf(Bt + m - mn); wl = __expf(ml - mn); m = mn;
                if (do_n) { nv[0] = dec * nv[0] + wl * ln[j].x; nv[1] = dec * nv[1] + wl * ln[j].y; nv[2] = dec * nv[2] + wl * ln[j].z; nv[3] = dec * nv[3] + wl * ln[j].w; }
            } else if (type == 1) dec = rdec;
            else dec = __expf(s0[j]);
            v[0] = dec * v[0] + wl * bflo(lc[j].x); v[1] = dec * v[1] + wl * bfhi(lc[j].x); v[2] = dec * v[2] + wl * bflo(lc[j].y); v[3] = dec * v[3] + wl * bfhi(lc[j].y);
        }
    }
    if (!lat) {
        if (type == 2) *(f32x4*)(F.out + O_SSD + (size_t)(((b * 4 + l) * 2 + d) * 8 + head) * 8192 + e0) = (f32x4){v[0], v[1], v[2], v[3]};
        else {
            LAS float* tr = (LAS float*)F.lds;
            const int dvl = F.tid >> 5, dk = (F.tid & 31) * 4;
#pragma unroll
            for (int j = 0; j < 4; ++j) tr[dvl * 129 + dk + j] = v[j];
            BAR();
            const int dk2 = F.tid >> 2, q = F.tid & 3;
            float* o = F.out + (type == 0 ? O_MC : O_RET) + (size_t)(((b * 4 + l) * 2 + d) * 4 + head) * 16384 + (size_t)dk2 * 128 + slice * 16 + 4 * q;
            *(f32x4*)o = (f32x4){tr[(4 * q) * 129 + dk2], tr[(4 * q + 1) * 129 + dk2], tr[(4 * q + 2) * 129 + dk2], tr[(4 * q + 3) * 129 + dk2]};
            if (type == 0) { if (do_n) *(f32x4*)(F.out + O_MN + (size_t)(((b * 4 + l) * 2 + d) * 4 + head) * 128 + F.tid * 4) = (f32x4){nv[0], nv[1], nv[2], nv[3]};
                if (slice == 0 && F.tid == 0) F.out[O_MM + ((b * 4 + l) * 2 + d) * 4 + head] = m; }
            BAR();
        }
    }
}

struct CtxLd { u32x2 lc[2]; f32x4 ln[2]; float s0[2], s1[2]; };
struct CtxU { int d, b, cp0, type, head, slice, e0, nh, esz; bool do_n; };
__device__ __forceinline__ CtxU ctx_decode(const Frame& F, int u) {
    CtxU c; const int sd = u / 96, rem = u % 96, sidx = sd >> 1; c.d = sd & 1; c.b = sidx - 4; c.cp0 = 2 * c.b;
    if (rem < 32) { c.type = 0; c.head = rem >> 3; c.slice = rem & 7; } else if (rem < 64) { c.type = 1; c.head = (rem - 32) >> 3; c.slice = (rem - 32) & 7; } else { c.type = 2; c.head = (rem - 64) >> 2; c.slice = (rem - 64) & 3; }
    c.e0 = c.slice * 2048 + F.tid * 4; c.nh = c.type == 2 ? 8 : 4; c.esz = c.type == 2 ? 8192 : 16384; c.do_n = (c.type == 0 && c.slice == 0 && F.tid < 32);
    return c;
}
__device__ __forceinline__ void carry_ctx_load(const Frame& F, int u, CtxLd& L, float zf) {
    const CtxU c = ctx_decode(F, u);
    const bf16* loc = c.type == 0 ? WSP(const bf16, WS_MLCLOC) : (c.type == 1 ? WSP(const bf16, WS_RTLOC) : WSP(const bf16, WS_SDLOC));
#pragma unroll
    for (int j = 0; j < 2; ++j) { const int cp = c.cp0 + (c.d == 0 ? j : 1 - j);
        L.ln[j] = (f32x4){zf, zf, zf, zf}; L.s0[j] = zf; L.s1[j] = zf;
        L.lc[j] = *(const u32x2*)(loc + (size_t)((cp * 2 + c.d) * c.nh + c.head) * c.esz + c.e0);
        if (c.type == 0) { const float* sc = WSP(const float, WS_MLSC) + ((cp * 2 + c.d) * 4 + c.head) * 2; L.s0[j] = sc[0]; L.s1[j] = sc[1];
            if (c.do_n) L.ln[j] = *(const f32x4*)(WSP(const float, WS_MLNLOC) + ((cp * 2 + c.d) * 4 + c.head) * 128 + F.tid * 4); }
        else if (c.type == 2) L.s0[j] = WSP(const float, WS_SDSC)[(cp * 2 + c.d) * 8 + c.head]; }
}
__device__ __forceinline__ void carry_ctx_finish(Frame& F, KArgs& A, int l, int u, const CtxLd& L, float zf) {
    const CtxU c = ctx_decode(F, u);
    bf16* inb = c.type == 0 ? WSP(bf16, WS_MLCIN) : (c.type == 1 ? WSP(bf16, WS_RTIN) : WSP(bf16, WS_SDIN));
    float v[4] = {zf, zf, zf, zf}, nv[4] = {zf, zf, zf, zf}, m = 0.f;
    const float rdec = c.type == 1 ? __expf(-128.f * __expf(INP(I_RRATE)[(l * 2 + c.d) * 4 + c.head])) : 1.f;
#pragma unroll
    for (int j = 0; j < 2; ++j) { const int cp = c.cp0 + (c.d == 0 ? j : 1 - j);
        if (j > 0) *(u32x2*)(inb + (size_t)((cp * 2 + c.d) * c.nh + c.head) * c.esz + c.e0) = (u32x2){pk2(v[0], v[1]), pk2(v[2], v[3])};
        float dec, wl = 1.f;
        if (c.type == 0) {
            if (c.slice == 0 && F.tid == 0) WSP(float, WS_MLMIN)[(cp * 2 + c.d) * 4 + c.head] = m;
            if (c.do_n) *(f32x4*)(WSP(float, WS_MLNIN) + ((cp * 2 + c.d) * 4 + c.head) * 128 + F.tid * 4) = (f32x4){nv[0], nv[1], nv[2], nv[3]};
            const float mn = fmaxf(L.s0[j] + m, L.s1[j]); dec = __expf(L.s0[j] + m - mn); wl = __expf(L.s1[j] - mn); m = mn;
            if (c.do_n) { nv[0] = dec * nv[0] + wl * L.ln[j].x; nv[1] = dec * nv[1] + wl * L.ln[j].y; nv[2] = dec * nv[2] + wl * L.ln[j].z; nv[3] = dec * nv[3] + wl * L.ln[j].w; }
        } else if (c.type == 1) dec = rdec;
        else dec = __expf(L.s0[j]);
        v[0] = dec * v[0] + wl * bflo(L.lc[j].x); v[1] = dec * v[1] + wl * bfhi(L.lc[j].x); v[2] = dec * v[2] + wl * bflo(L.lc[j].y); v[3] = dec * v[3] + wl * bfhi(L.lc[j].y); }
    const int b = c.b, d = c.d, head = c.head, slice = c.slice, e0 = c.e0;
    if (c.type == 2) *(f32x4*)(F.out + O_SSD + (size_t)(((b * 4 + l) * 2 + d) * 8 + head) * 8192 + e0) = (f32x4){v[0], v[1], v[2], v[3]};
    else {
        LAS float* tr = (LAS float*)F.lds;
        const int dvl = F.tid >> 5, dk = (F.tid & 31) * 4;
#pragma unroll
        for (int j = 0; j < 4; ++j) tr[dvl * 129 + dk + j] = v[j];
        BAR();
        const int dk2 = F.tid >> 2, q = F.tid & 3;
        float* o = F.out + (c.type == 0 ? O_MC : O_RET) + (size_t)(((b * 4 + l) * 2 + d) * 4 + head) * 16384 + (size_t)dk2 * 128 + slice * 16 + 4 * q;
        *(f32x4*)o = (f32x4){tr[(4 * q) * 129 + dk2], tr[(4 * q + 1) * 129 + dk2], tr[(4 * q + 2) * 129 + dk2], tr[(4 * q + 3) * 129 + dk2]};
        if (c.type == 0) { if (c.do_n) *(f32x4*)(F.out + O_MN + (size_t)(((b * 4 + l) * 2 + d) * 4 + head) * 128 + F.tid * 4) = (f32x4){nv[0], nv[1], nv[2], nv[3]};
            if (slice == 0 && F.tid == 0) F.out[O_MM + ((b * 4 + l) * 2 + d) * 4 + head] = m; }
        BAR();
    }
}
__device__ __forceinline__ void carry_ctx_batch(Frame F, KArgs& A, int l, int u0) {
    float zf = 0.f; asm volatile("" : "+v"(zf));
    CtxLd L[8];
#pragma unroll
    for (int j = 0; j < 8; ++j) carry_ctx_load(F, u0 + j, L[j], zf);
#pragma unroll
    for (int j = 0; j < 8; ++j) carry_ctx_finish(F, A, l, u0 + j, L[j], zf);
}
constexpr int CW_Q = 16384;
struct OneUnit { pg8::Unit u; __device__ __forceinline__ bool next(int i, pg8::Unit& o) const { if (i) return false; o = u; return true; }
    __device__ __forceinline__ void a_ready(const pg8::Unit&) const {} __device__ __forceinline__ void done(const pg8::Unit&) const {} };
#define QUEUE_LOOP(F0_, qidx, total, ...) do { \
    unsigned* qc_ = (unsigned*)(F0_.ws + WS_CTL) + CW_Q + 64 * (qidx); volatile LAS int* qs_ = (volatile LAS int*)(F0_.lds + MISC_OFF + 64); \
    if (F0_.tid == 0) qs_[0] = (int)__hip_atomic_fetch_add(qc_, 1u, __ATOMIC_RELAXED, __HIP_MEMORY_SCOPE_AGENT); \
    __syncthreads(); \
    int it = qs_[0], par_ = 1; \
    while (it < (total)) { \
        int nx_ = 0; if (F0_.tid == 0) nx_ = (int)__hip_atomic_fetch_add(qc_, 1u, __ATOMIC_RELAXED, __HIP_MEMORY_SCOPE_AGENT); \
        { __VA_ARGS__ } \
        if (F0_.tid == 0) qs_[par_] = nx_; \
        BAR();     \
        it = qs_[par_]; par_ ^= 1; \
    } } while (0)
#ifndef PROBE_ITEM
#define PROBE_ITEM -1
#endif
#define PR(t) (PROBE_ITEM == (t) ? 2 : 1)
#define QSPLIT(NT_, C0, C1, C2, C3, T0) int ty_ = 0, loc_ = it, dup_ = 0; { const int cnt_[4] = {C0, C1, C2, C3}; \
    _Pragma("unroll") for (int j_ = 0; j_ < NT_; ++j_) { const int span_ = cnt_[j_] * PR(T0 + j_); if (ty_ == j_) { if (loc_ >= span_) { loc_ -= span_; ty_ = j_ + 1; } else { dup_ = loc_ / cnt_[j_]; loc_ = loc_ % cnt_[j_]; } } } }
#ifndef PROBE_TMASK
#define PROBE_TMASK 0
#endif
#ifndef PROBE_TAMP
#define PROBE_TAMP 4
#endif
#define TSTART(k) do { if (PROBE_TMASK & (1 << (k))) pt0_ = __builtin_amdgcn_s_memrealtime(); } while (0)
#define TEND(k) do { if (PROBE_TMASK & (1 << (k))) ptacc_ += __builtin_amdgcn_s_memrealtime() - pt0_; } while (0)
#ifndef PROBE_REPEAT
#define PROBE_REPEAT -1
#endif
constexpr int N_PHASES = 2 + 9 * NLAYER;
__global__ void __launch_bounds__(NT, 2) hymba_fwd(Args A) {
    extern __shared__ __attribute__((aligned(16))) unsigned char lds_raw[];
    Frame F0;
    F0.lds = (LAS unsigned char*)lds_raw;
    F0.tid = threadIdx.x; F0.lane = 0; F0.wave = __builtin_amdgcn_readfirstlane(F0.tid >> 6);
    F0.G = gridDim.x; F0.bid = blockIdx.x; F0.out = A.out; F0.ws = A.ws;
    volatile LAS unsigned* MISC = (volatile LAS unsigned*)(F0.lds + MISC_OFF);
    if (F0.tid < 64) MISC[F0.tid] = 0u;
    __syncthreads();
    unsigned* barw = (unsigned*)(F0.ws + WS_CTL) + CW_BAR;
    XcdBarrier bar = xcd_barrier_post(barw, MISC + 8, F0.wave == 0 ? 1u : 0u);
    const int lo = A.ph_lo, hi = A.ph_hi;
    unsigned long long pt0_ = 0, ptacc_ = 0;
#define KA (*kargs())
#define IN(k) (lo <= (k) && (k) < hi)
#define SEAM(k) do { if (IN(k) && IN((k) + 1)) xcd_barrier(bar); } while (0)

    TSTART(9); if (IN(0)) for (int rep_ = 0; rep_ < (PROBE_REPEAT == 100 ? 2 : 1); ++rep_) { Frame F = fresh(F0); p0_prologue(F, KA); } SEAM(0); TEND(9);

    TSTART(10); if (IN(1)) { Frame F = fresh(F0); norm0_phase(F, KA); shw_phase(F); } SEAM(1); TEND(10);

#pragma unroll 1
    for (int l = 0; l < NLAYER; ++l) {
        const int pb = 1 + 9 * l;
        TSTART(1); if (IN(pb + 1)) for (int rep_ = 0; rep_ < (PROBE_REPEAT == 1 ? 2 : 1); ++rep_) { Frame F = fresh(F0);
            pg8::Gemm g{WSP(const pg8::bf16_t, WS_H), WSP(const pg8::bf16_t, WS_W1T) + (size_t)l * NPAD * D, M, NPROJ, D}; pg8::StaticOrder S; S.init(M, NPROJ, F.G, F.bid);
            epi::EpiProj E{WSP(pg8::bf16_t, WS_PROJ), WSP(const float, WS_SSQB), WSP(const float, WS_SHW1) + (size_t)l * 5 * NPAD};
            pg8::gemm_phase<epi::EpiProj, pg8::StaticOrder, true, true>(F.lds, g, S, E, F.tid);
            __syncthreads(); gates_phase(F, l);
        } SEAM(pb + 1); TEND(1);
        TSTART(2); if (IN(pb + 2)) { Frame F = fresh(F0);
            QUEUE_LOOP(F, l * 3 + 0, 384 * PR(0) + 768 * PR(1) + 768 * PR(2) + 768 * PR(3), {
                QSPLIT(4, 384, 768, 768, 768, 0);
                if (ty_ == 0) { TSTART(11); ssd_local_item(fresh(F), KA, l, loc_ >> 1, loc_ & 1); TEND(11); }
                else if (ty_ == 1) { TSTART(12); mlstm_local_item(fresh(F), KA, l, loc_ >> 2, loc_ & 3); TEND(12); }
                else if (ty_ == 2) { TSTART(13); ret_local_item(fresh(F), KA, l, loc_ >> 2, loc_ & 3); TEND(13); }
                else { TSTART(14); s5_item<0>(fresh(F), KA, l, loc_ >> 2, loc_ & 3); TEND(14); }
            });
        } SEAM(pb + 2); TEND(2);
        TSTART(3); if (IN(pb + 3)) { Frame F = fresh(F0);
            QUEUE_LOOP(F, l * 3 + 1, 768 * PR(4) + 768 * PR(5) + 768 * PR(6), {
                QSPLIT(3, 768, 768, 768, 0, 4);
                if (ty_ == 0) { TSTART(15); carry_unit<true>(fresh(F), KA, l, loc_); TEND(15); }
                else if (ty_ == 1) { TSTART(16); s5_item<1>(fresh(F), KA, l, loc_ >> 2, loc_ & 3); TEND(16); }
                else { TSTART(17); carry_ctx_batch(fresh(F), KA, l, 768 + loc_ * 8); TEND(17); }
            });
        } SEAM(pb + 3); TEND(3);
        TSTART(4); if (IN(pb + 4)) { Frame F = fresh(F0);
            QUEUE_LOOP(F, l * 3 + 2, 192 * PR(7) + 192 * PR(8) + 768 * PR(9) + 768 * PR(10), {
                QSPLIT(4, 192, 192, 768, 768, 7);
                if (ty_ == 0) { TSTART(18); ssd_out_item(fresh(F), KA, l, loc_, dup_ ? WSP(bf16, WS_MLCLOC) : WSP(bf16, WS_Y)); TEND(18); }
                else if (ty_ == 1) { TSTART(19); Frame Fg = fresh(F);
                    pg8::Gemm g{WSP(const pg8::bf16_t, WS_YA), WSP(const pg8::bf16_t, WS_WGT) + (size_t)l * GWID * GWID, M, GWID, GWID}; OneUnit S; S.u.pm = loc_ >> 1; S.u.pn = loc_ & 1;
                    epi::EpiGlu E{WSP(const pg8::bf16_t, WS_YA), WSP(pg8::bf16_t, WS_Y)};
                    pg8::gemm_phase<epi::EpiGlu, OneUnit, false, true>(Fg.lds, g, S, E, Fg.tid); __syncthreads(); TEND(19); }
                else if (ty_ == 2) { TSTART(20); mlstm_out_item(fresh(F), KA, l, loc_ >> 2, loc_ & 3); TEND(20); }
                else { TSTART(21); ret_out_item(fresh(F), KA, l, loc_ >> 2, loc_ & 3); TEND(21); }
            });
        } SEAM(pb + 4); TEND(4);
        TSTART(5); if (IN(pb + 5)) { Frame F = fresh(F0);
            pg8::Gemm g{WSP(const pg8::bf16_t, WS_Y), WSP(const pg8::bf16_t, WS_WOT) + (size_t)l * D * D, M, D, D}; pg8::StaticOrder S; S.init(M, D, F.G, F.bid);
            KArgs& A_ = KA; epi::EpiRes E{(const float*)(const GAS float*)A_.in[I_XP], (const float*)(const GAS float*)A_.in[I_XS], WSP(pg8::bf16_t, WS_XB), WSP(const float, WS_MOD) + (size_t)(l * 5) * (6 * D) + 2 * D, l == 0 ? 1 : 0,
                          1, WSP(pg8::bf16_t, WS_H), WSP(float, WS_SSQA), (const float*)(const GAS float*)A_.in[I_NORM2] + (size_t)l * D, WSP(const float, WS_MOD) + (size_t)(l * 5) * (6 * D) + 4 * D, F.lds + 131072};
            pg8::gemm_phase<epi::EpiRes, pg8::StaticOrder, true, true>(F.lds, g, S, E, F.tid);
        } SEAM(pb + 5); TEND(5);
        TSTART(7); if (IN(pb + 7)) for (int rep_ = 0; rep_ < (PROBE_REPEAT == 7 ? 2 : 1); ++rep_) { Frame F = fresh(F0);
            pg8::Gemm g{WSP(const pg8::bf16_t, WS_H), WSP(const pg8::bf16_t, WS_WM1T) + (size_t)l * DFF * D, M, DFF, D}; pg8::StaticOrder S; S.init(M, DFF, F.G, F.bid);
            epi::EpiRelu2 E{WSP(pg8::bf16_t, WS_HID), WSP(const float, WS_SSQA), WSP(const float, WS_SHW2) + (size_t)l * 5 * DFF};
            pg8::gemm_phase<epi::EpiRelu2, pg8::StaticOrder, true, true>(F.lds, g, S, E, F.tid);
        } SEAM(pb + 7); TEND(7);
        TSTART(8); if (IN(pb + 8)) { Frame F = fresh(F0);
            pg8::Gemm g{WSP(const pg8::bf16_t, WS_HID), WSP(const pg8::bf16_t, WS_WM2T) + (size_t)l * D * DFF, M, D, DFF}; pg8::StaticOrder S; S.init(M, D, F.G, F.bid);
            KArgs& A_ = KA; epi::EpiRes E{(const float*)(const GAS float*)A_.in[I_XP], (const float*)(const GAS float*)A_.in[I_XS], WSP(pg8::bf16_t, WS_XB), WSP(const float, WS_MOD) + (size_t)(l * 5) * (6 * D) + 5 * D, 0,
                          l < NLAYER - 1 ? 1 : 0, WSP(pg8::bf16_t, WS_H), WSP(float, WS_SSQB), (const float*)(const GAS float*)A_.in[I_NORM1] + (size_t)(l + 1) * D, WSP(const float, WS_MOD) + (size_t)((l + 1) * 5) * (6 * D) + 1 * D, F.lds + 131072};
            pg8::gemm_phase<epi::EpiRes, pg8::StaticOrder, true, true>(F.lds, g, S, E, F.tid);
        } SEAM(pb + 8); TEND(8);
    }
    if (IN(N_PHASES - 1)) { Frame F = fresh(F0); final_norm_phase(F, KA); }
    if (PROBE_IMASK != 0 && F0.bid == 0 && F0.wave == 0 && lane_id() == 0) { const unsigned long long acc_ = ((volatile LAS unsigned long long*)(F0.lds + MISC_OFF + 128))[1], te_ = __builtin_amdgcn_s_memrealtime();
        while (__builtin_amdgcn_s_memrealtime() - te_ < (unsigned long long)PROBE_TAMP * acc_) __builtin_amdgcn_s_sleep(32); }
    if (PROBE_TMASK != 0 && F0.bid == 0) { const unsigned long long te_ = __builtin_amdgcn_s_memrealtime(); while (__builtin_amdgcn_s_memrealtime() - te_ < (unsigned long long)PROBE_TAMP * ptacc_) __builtin_amdgcn_s_sleep(32); }
#undef IN
#undef SEAM
}

#ifndef MK_LAUNCH_PER_PHASE
#define MK_LAUNCH_PER_PHASE 0
#endif
extern "C" void kernel_launch(void* const* d_in, const int* in_sizes, int n_in, void* d_out, int out_size, void* d_ws, size_t ws_size, hipStream_t stream) {
    static int grid = 0;
    if (grid == 0) {
        if (n_in != N_IN || (size_t)out_size != O_END || ws_size < WS_END) { fprintf(stderr, "kernel_launch: shape mismatch: n_in %d out %d ws %zu (need %zu)\n", n_in, out_size, ws_size, (size_t)WS_END); grid = -1; return; }
        int dev = 0, cus = 0, per_cu = 0;
        if (hipGetDevice(&dev) != hipSuccess || hipDeviceGetAttribute(&cus, hipDeviceAttributeMultiprocessorCount, dev) != hipSuccess) { grid = -1; return; }
        if (hipFuncSetAttribute((const void*)hymba_fwd, hipFuncAttributeMaxDynamicSharedMemorySize, LDS_BYTES) != hipSuccess) { fprintf(stderr, "kernel_launch: hipFuncSetAttribute failed\n"); grid = -1; return; }
        if (hipOccupancyMaxActiveBlocksPerMultiprocessor(&per_cu, (const void*)hymba_fwd, NT, LDS_BYTES) != hipSuccess || per_cu < 1) fprintf(stderr, "kernel_launch: occupancy query says %d\n", per_cu);
        (void)hipGetLastError();
        grid = cus;
    }
    if (grid < 0) return;
    (void)hipMemsetAsync((char*)d_ws + WS_CTL, 0, CTL_ZERO_BYTES, stream);
    Args a{};
    for (int i = 0; i < N_IN; ++i) a.in[i] = (const float*)d_in[i];
    a.out = (float*)d_out; a.ws = (unsigned char*)d_ws;
#if MK_LAUNCH_PER_PHASE
    for (int p = 0; p < N_PHASES; ++p) { a.ph_lo = p; a.ph_hi = p + 1; hipLaunchKernelGGL(hymba_fwd, dim3(grid), dim3(NT), LDS_BYTES, stream, a); }
#else
    a.ph_lo = 0; a.ph_hi = N_PHASES;
    hipLaunchKernelGGL(hymba_fwd, dim3(grid), dim3(NT), LDS_BYTES, stream, a);
#endif
    const hipError_t le = hipPeekAtLastError();
    if (le != hipSuccess) fprintf(stderr, "kernel_launch: launch failed: %s\n", hipGetErrorName(le));
}
```

```cpp
#include <hip/hip_runtime.h>
#include <cstdio>
#include <cstdint>
namespace pg8 {
#define PG8_LAS __attribute__((address_space(3)))
typedef unsigned short bf16_t;
typedef short bf16x8 __attribute__((ext_vector_type(8)));
typedef float f32x4 __attribute__((ext_vector_type(4)));
typedef unsigned u32x4 __attribute__((ext_vector_type(4)));
constexpr int BM = 256, BK = 64, HALF = 128, HTB = HALF * BK * 2  , STAGE_BYTES = 8 * HTB, NXCD = 8, WGM = 8;

__host__ __device__ __forceinline__ int lds_byte(int r, int c) { const int st = (r >> 4) * 2 + (c >> 5), rr = r & 15, cc = c & 31, ob = rr * 64 + cc * 2; return st * 1024 + (ob ^ (((ob >> 9) & 1) << 5)); }
__host__ __device__ __forceinline__ void stage_rc(int b, int& R, int& C) { const int st = b / 1024, sb = b % 1024, swz = sb ^ (((sb >> 9) & 1) << 5); R = (st >> 1) * 16 + swz / 64; C = (st & 1) * 32 + (swz % 64) / 2; }
__host__ __device__ __forceinline__ int perm32(int rho) { const int n = rho >> 4, i = rho & 15; return 8 * (i >> 2) + 4 * n + (i & 3); }

struct Unit { int pm, pn; };
struct Gemm { const bf16_t* A; const bf16_t* Bt; int M, N, K; };

struct StaticOrder {
    int nM, nN, nwg, G, c;
    __host__ __device__ void init(int M, int N, int G_, int c_) { nM = M / BM; nN = N / BM; nwg = nM * nN; G = G_; c = c_; }
    __host__ __device__ bool next(int i, Unit& u) const {
        const long L = (long)i * G + c; if (L >= nwg) return false;
        int wgid = (int)L; { const int q = nwg / NXCD, r = nwg % NXCD, xcd = wgid % NXCD, off = wgid / NXCD; wgid = (xcd < r ? xcd * (q + 1) : r * (q + 1) + (xcd - r) * q) + off; }
        const int nig = WGM * nN, gid = wgid / nig, fm = gid * WGM, gsz = (nM - fm) < WGM ? (nM - fm) : WGM;
        u.pm = fm + ((wgid % nig) % gsz); u.pn = (wgid % nig) / gsz; return true;
    }
    __device__ __forceinline__ void a_ready(const Unit&) const {}
    __device__ __forceinline__ void done(const Unit&) const {}
};

__device__ __forceinline__ unsigned cvt_pk_bf16(float lo, float hi) { unsigned r; asm volatile("v_cvt_pk_bf16_f32 %0, %1, %2" : "=v"(r) : "v"(lo), "v"(hi)); return r; }
typedef float f32x2 __attribute__((ext_vector_type(2)));
template <class Epi, class Sched, bool ALIGN_EPI = false, bool SP2 = false>
__device__ __forceinline__ void gemm_phase(PG8_LAS unsigned char* lds, const Gemm g, const Sched& S, const Epi& E, int tid_in) {
    int tid_ = tid_in; asm volatile("" : "+v"(tid_));
    const int tid = tid_, wid = __builtin_amdgcn_readfirstlane(tid >> 6), lane = tid & 63, wr = wid >> 2, wc = wid & 3, fr = lane & 15, fq = lane >> 4;
    const int K = g.K, nt = K / BK;
    unsigned voffA[2], voffB[2];
#pragma unroll
    for (int i = 0; i < 2; ++i) { int R, C; stage_rc(tid * 16 + i * 8192, R, C); const int Rb = Epi::PERM ? ((R & ~31) + perm32(R & 31)) : R;
        voffA[i] = (unsigned)(R * K + C) * 2u; voffB[i] = (unsigned)(Rb * K + C) * 2u; }
    const size_t kstep = (size_t)(BK * 2);
    const size_t hstep = (size_t)HALF * K * 2;
    const size_t tstep = 2 * hstep;
    const unsigned ldsw = (unsigned)wid * 1024u;
    const int aoff = lds_byte(wr * 64 + fr, fq * 8), boff = lds_byte(wc * 32 + fr, fq * 8);
#define PG8_SA(b, h) (((b) * 2 + (h)) * HTB)
#define PG8_SB(b, h) ((4 + (b) * 2 + (h)) * HTB)
#define PG8_STAGE(bufoff, gbase, voff) do { _Pragma("unroll") for (int _i = 0; _i < 2; ++_i) \
        __builtin_amdgcn_global_load_lds((const unsigned*)((const char*)(gbase) + (voff)[_i]), (PG8_LAS unsigned*)(lds + (bufoff) + ldsw + _i * 8192), 16, 0, 0); } while (0)
#define PG8_LDA(dst, b, h) do { _Pragma("unroll") for (int m = 0; m < 4; ++m) _Pragma("unroll") for (int k = 0; k < 2; ++k) dst[m][k] = *(const PG8_LAS bf16x8*)(lds + PG8_SA(b, h) + aoff + m * 2048 + k * 1024); } while (0)
#define PG8_LDB(dst, b, h) do { _Pragma("unroll") for (int n = 0; n < 2; ++n) _Pragma("unroll") for (int k = 0; k < 2; ++k) dst[n][k] = *(const PG8_LAS bf16x8*)(lds + PG8_SB(b, h) + boff + n * 2048 + k * 1024); } while (0)
#define PG8_MMA(ai, bj, At, Bt) do { __builtin_amdgcn_s_setprio(1); _Pragma("unroll") for (int m = 0; m < 4; ++m) _Pragma("unroll") for (int n = 0; n < 2; ++n) _Pragma("unroll") for (int k = 0; k < 2; ++k) \
        acc[ai][bj][m][n] = __builtin_amdgcn_mfma_f32_16x16x32_bf16(Bt[n][k], At[m][k], acc[ai][bj][m][n], 0, 0, 0); __builtin_amdgcn_s_setprio(0); } while (0)
#define PG8_WAIT_V(n) asm volatile("s_waitcnt vmcnt(" #n ")" ::: "memory")
#define PG8_WAIT_L(n) asm volatile("s_waitcnt lgkmcnt(" #n ")" ::: "memory")
#define PG8_BAR __builtin_amdgcn_s_barrier()
#define PG8_SCHED __builtin_amdgcn_sched_barrier(0)
    Unit cur, nxt; int ui = 0;
    if (!S.next(0, cur)) return;
    f32x4 acc[2][2][4][2];
#pragma unroll
    for (int a = 0; a < 2; ++a)
#pragma unroll
        for (int b = 0; b < 2; ++b)
#pragma unroll
            for (int m = 0; m < 4; ++m)
#pragma unroll
                for (int n = 0; n < 2; ++n) acc[a][b][m][n] = (f32x4){0.f, 0.f, 0.f, 0.f};
    bf16x8 At[4][2], B0[2][2], B1[2][2];
    const char* cA = (const char*)g.A + (size_t)cur.pm * tstep; const char* cB = (const char*)g.Bt + (size_t)cur.pn * tstep;
    S.a_ready(cur);
    if constexpr (SP2) {
        PG8_STAGE(PG8_SB(0, 0), cB, voffB); PG8_STAGE(PG8_SB(0, 1), cB + hstep, voffB); PG8_STAGE(PG8_SA(0, 0), cA, voffA); PG8_STAGE(PG8_SA(0, 1), cA + hstep, voffA);
        if (wr == 1) PG8_BAR;
        PG8_WAIT_V(2); PG8_BAR;
        PG8_STAGE(PG8_SB(1, 0), cB + kstep, voffB); PG8_STAGE(PG8_SA(1, 0), cA + kstep, voffA); PG8_STAGE(PG8_SB(1, 1), cB + hstep + kstep, voffB);
        PG8_WAIT_V(6); PG8_BAR;
    } else {
        PG8_STAGE(PG8_SB(0, 0), cB, voffB); PG8_STAGE(PG8_SA(0, 0), cA, voffA); PG8_STAGE(PG8_SB(0, 1), cB + hstep, voffB); PG8_STAGE(PG8_SA(0, 1), cA + hstep, voffA);
        if (wr == 1) PG8_BAR;
        PG8_WAIT_V(4); PG8_BAR;
        PG8_STAGE(PG8_SB(1, 0), cB + kstep, voffB); PG8_STAGE(PG8_SA(1, 0), cA + kstep, voffA); PG8_STAGE(PG8_SB(1, 1), cB + hstep + kstep, voffB);
        PG8_WAIT_V(6); PG8_BAR;
    }
    for (;;) {
        const bool has_next = S.next(ui + 1, nxt);
        const char* nA = has_next ? (const char*)g.A + (size_t)nxt.pm * tstep : cA; const char* nB = has_next ? (const char*)g.Bt + (size_t)nxt.pn * tstep : cB;
        for (int t = 0; t < nt; t += 2) {
            const bool last = (t == nt - 2);
            const char* a1 = cA + (size_t)(t + 1) * kstep;
            const char* a2 = last ? nA : cA + (size_t)(t + 2) * kstep; const char* b2 = last ? nB : cB + (size_t)(t + 2) * kstep;
            const char* a3 = a2 + kstep; const char* b3 = b2 + kstep;
            if (last && has_next) S.a_ready(nxt);
            if constexpr (SP2) {
            PG8_LDB(B0, 0, 0); PG8_LDB(B1, 0, 1); PG8_SCHED; PG8_LDA(At, 0, 0); PG8_STAGE(PG8_SA(1, 1), a1 + hstep, voffA);
            PG8_WAIT_V(8); PG8_WAIT_L(0); PG8_BAR; PG8_MMA(0, 0, At, B0); PG8_MMA(0, 1, At, B1); PG8_BAR; PG8_SCHED;
            PG8_LDA(At, 0, 1); PG8_STAGE(PG8_SB(0, 0), b2, voffB); PG8_STAGE(PG8_SB(0, 1), b2 + hstep, voffB); PG8_STAGE(PG8_SA(0, 0), a2, voffA);
            PG8_WAIT_V(8); PG8_WAIT_L(0); PG8_BAR; PG8_MMA(1, 0, At, B0); PG8_MMA(1, 1, At, B1); PG8_BAR; PG8_SCHED;
            PG8_LDB(B0, 1, 0); PG8_LDB(B1, 1, 1); PG8_SCHED; PG8_LDA(At, 1, 0); PG8_STAGE(PG8_SA(0, 1), a2 + hstep, voffA);
            PG8_WAIT_V(8); PG8_WAIT_L(0); PG8_BAR; PG8_MMA(0, 0, At, B0); PG8_MMA(0, 1, At, B1); PG8_BAR; PG8_SCHED;
            PG8_LDA(At, 1, 1); PG8_STAGE(PG8_SB(1, 0), b3, voffB); PG8_STAGE(PG8_SB(1, 1), b3 + hstep, voffB); PG8_STAGE(PG8_SA(1, 0), a3, voffA);
            PG8_WAIT_V(8); PG8_WAIT_L(0); PG8_BAR; PG8_MMA(1, 0, At, B0); PG8_MMA(1, 1, At, B1); PG8_BAR; PG8_SCHED;
            } else {
            PG8_LDB(B0, 0, 0); PG8_SCHED; PG8_LDA(At, 0, 0); PG8_STAGE(PG8_SA(1, 1), a1 + hstep, voffA);
            PG8_WAIT_L(8); PG8_BAR; PG8_WAIT_L(0); PG8_MMA(0, 0, At, B0); PG8_BAR; PG8_SCHED;
            PG8_LDB(B1, 0, 1); PG8_STAGE(PG8_SB(0, 0), b2, voffB);
            PG8_BAR; PG8_WAIT_L(0); PG8_MMA(0, 1, At, B1); PG8_BAR;
            PG8_LDA(At, 0, 1); PG8_STAGE(PG8_SA(0, 0), a2, voffA);
            PG8_BAR; PG8_WAIT_L(0); PG8_MMA(1, 0, At, B0); PG8_BAR; PG8_SCHED;
            PG8_STAGE(PG8_SB(0, 1), b2 + hstep, voffB);
            PG8_WAIT_V(6); PG8_BAR; PG8_MMA(1, 1, At, B1); PG8_BAR;
            PG8_LDB(B0, 1, 0); PG8_SCHED; PG8_LDA(At, 1, 0); PG8_STAGE(PG8_SA(0, 1), a2 + hstep, voffA);
            PG8_WAIT_L(8); PG8_BAR; PG8_WAIT_L(0); PG8_MMA(0, 0, At, B0); PG8_BAR; PG8_SCHED;
            PG8_LDB(B1, 1, 1); PG8_STAGE(PG8_SB(1, 0), b3, voffB);
            PG8_BAR; PG8_WAIT_L(0); PG8_MMA(0, 1, At, B1); PG8_BAR;
            PG8_LDA(At, 1, 1); PG8_STAGE(PG8_SA(1, 0), a3, voffA);
            PG8_BAR; PG8_WAIT_L(0); PG8_MMA(1, 0, At, B0); PG8_BAR; PG8_SCHED;
            PG8_STAGE(PG8_SB(1, 1), b3 + hstep, voffB);
            PG8_WAIT_V(6); PG8_BAR; PG8_MMA(1, 1, At, B1); PG8_BAR;
            }
        }
        if constexpr (ALIGN_EPI) { if (wr == 0) PG8_BAR; }
        if constexpr (!Epi::AFTER_DRAIN) { E(acc, cur, wr, wc, fr, fq); S.done(cur); }
        if (!has_next) break;
#pragma unroll
        for (int a = 0; a < 2; ++a)
#pragma unroll
            for (int b = 0; b < 2; ++b)
#pragma unroll
                for (int m = 0; m < 4; ++m)
#pragma unroll
                    for (int n = 0; n < 2; ++n) acc[a][b][m][n] = (f32x4){0.f, 0.f, 0.f, 0.f};
        cur = nxt; cA = nA; cB = nB; ++ui;
        if constexpr (ALIGN_EPI) { if (wr == 1) PG8_BAR; }
    }
    PG8_WAIT_V(0);
    if constexpr (!ALIGN_EPI) { if (wr == 0) PG8_BAR; }
    PG8_BAR;
    if constexpr (Epi::AFTER_DRAIN) { E.fused(acc, cur, wr, wc, fr, fq, lds, wid, lane); S.done(cur); }
#undef PG8_SA
#undef PG8_SB
#undef PG8_STAGE
#undef PG8_LDA
#undef PG8_LDB
#undef PG8_MMA
#undef PG8_WAIT_V
#undef PG8_WAIT_L
#undef PG8_BAR
#undef PG8_SCHED
}
}
#define GAS __attribute__((address_space(1)))
#define LAS __attribute__((address_space(3)))
typedef unsigned short bf16;
typedef unsigned v4u __attribute__((ext_vector_type(4)));
typedef float f32x4 __attribute__((ext_vector_type(4)));
typedef short bf16x8 __attribute__((ext_vector_type(8)));
typedef GAS unsigned gu32;
typedef GAS unsigned long long gu64;
#define RLX_AGENT __ATOMIC_RELAXED, __HIP_MEMORY_SCOPE_AGENT
#define LDS_WAIT() asm volatile("s_waitcnt lgkmcnt(0)" ::: "memory")
#define VM_WAIT() asm volatile("s_waitcnt vmcnt(0)" ::: "memory")
__device__ __forceinline__ unsigned long long rt() { return __builtin_amdgcn_s_memrealtime(); }
typedef __bf16 hwbf16x2_t __attribute__((ext_vector_type(2)));
typedef float hwf32x2_t __attribute__((ext_vector_type(2)));
__device__ __forceinline__ unsigned pk2(float lo, float hi) { const hwf32x2_t v = {lo, hi}; const hwbf16x2_t b = __builtin_convertvector(v, hwbf16x2_t); return __builtin_bit_cast(unsigned, b); }
__device__ __forceinline__ unsigned f2bf(float f) { return pk2(f, 0.f) & 0xffffu; }
#define XB_TMO      128
#define XB_XCNT(j)  (256  + 64 * (j))
#define XB_XSUB(j)  (1280 + 64 * (j))
#define XB_XGEN(j)  (2304 + 64 * (j))
#define XB_TOP      3328
#define XB_TOPGEN   3392
#define XCD_BAR_WORDS 3456
#define XB_SPIN_CAP (1u << 18)

__device__ __forceinline__ unsigned xb_ld(unsigned* p)              { return __hip_atomic_load(p, __ATOMIC_RELAXED, __HIP_MEMORY_SCOPE_AGENT); }
__device__ __forceinline__ unsigned xb_add(unsigned* p, unsigned v) { return __hip_atomic_fetch_add(p, v, __ATOMIC_RELAXED, __HIP_MEMORY_SCOPE_AGENT); }
__device__ __forceinline__ unsigned xb_xcc_id() { return (unsigned)__builtin_amdgcn_s_getreg((3 << 11) | 20) & 0xFu; }
#define XB_SPIN(cond, bar) do { unsigned _sp = 0; while (cond) { __builtin_amdgcn_s_sleep(1); \
    if ((++_sp & 255u) == 0u) { if (xb_ld(&(bar)[XB_TMO])) break; if (_sp > XB_SPIN_CAP) { atomicAdd(&(bar)[XB_TMO], 1u); break; } } } } while (0)

struct XcdBarrier {
    unsigned wave0;
    unsigned* bar; unsigned x;
    volatile LAS unsigned* st;
};

__device__ __forceinline__ bool xb_lane0() { return __builtin_amdgcn_mbcnt_hi(~0u, __builtin_amdgcn_mbcnt_lo(~0u, 0u)) == 0u; }
__device__ __forceinline__ XcdBarrier xcd_barrier_post(unsigned* bar, volatile LAS unsigned* st, unsigned wave0) {
    XcdBarrier b; b.wave0 = wave0; b.bar = bar; b.x = xb_xcc_id(); b.st = st;
    if (wave0 && xb_lane0()) (void)xb_add(&bar[XB_XCNT(b.x)], 1u);
    return b;
}
__device__ __forceinline__ void xcd_barrier_complete(unsigned* bar, unsigned x, unsigned& nloc, unsigned& nx) {
    const unsigned G = gridDim.x * gridDim.y * gridDim.z;
    unsigned sum, cnt, mine, sp = 0u;
    for (;;) {
        sum = 0u; cnt = 0u; mine = 0u;
#pragma unroll
        for (unsigned j = 0; j < 16; ++j) { const unsigned c = xb_ld(&bar[XB_XCNT(j)]); sum += c; cnt += (c > 0u) ? 1u : 0u; mine = (j == x) ? c : mine; }
        if (sum == G) break;
        __builtin_amdgcn_s_sleep(1);
        if ((++sp & 255u) == 0u) { if (xb_ld(&bar[XB_TMO])) break; if (sp > XB_SPIN_CAP) { atomicAdd(&bar[XB_TMO], 1u); break; } }
    }
    nloc = mine > 0u ? mine : 1u; nx = cnt > 0u ? cnt : 1u;
}

__device__ __forceinline__ void xcd_barrier(const XcdBarrier& b) {
    asm volatile("s_waitcnt vmcnt(0)" ::: "memory");
    __syncthreads();
    if (b.wave0 && xb_lane0()) {
        unsigned* bar = b.bar;
        __builtin_amdgcn_s_waitcnt(0);
        unsigned nloc = b.st[0], nx = b.st[1];
        if (nloc == 0u) { xcd_barrier_complete(bar, b.x, nloc, nx); b.st[0] = nloc; b.st[1] = nx; }
        const unsigned old = xb_add(&bar[XB_XSUB(b.x)], 1u);
        const unsigned gen = old / nloc;
        if (old + 1u == (gen + 1u) * nloc) {
            __builtin_amdgcn_fence(__ATOMIC_RELEASE, "agent");
            asm volatile("s_waitcnt vmcnt(0)" ::: "memory");
            const unsigned og = xb_add(&bar[XB_TOP], 1u);
            const unsigned tg = og / nx;
            if (og + 1u == (tg + 1u) * nx) xb_add(&bar[XB_TOPGEN], 1u);
            else XB_SPIN(xb_ld(&bar[XB_TOPGEN]) == tg, bar);
            __builtin_amdgcn_fence(__ATOMIC_ACQUIRE, "agent");
            xb_add(&bar[XB_XGEN(b.x)], 1u);
            asm volatile("s_waitcnt vmcnt(0)" ::: "memory");
        } else {
            XB_SPIN(xb_ld(&bar[XB_XGEN(b.x)]) == gen, bar);
            __builtin_amdgcn_fence(__ATOMIC_ACQUIRE, "agent");
            asm volatile("s_waitcnt vmcnt(0)" ::: "memory");
        }
    }
    __syncthreads();
}
constexpr int NWAVES = 8, NT = 512;
constexpr int D = 2048, NLAYER = 4;
constexpr int MC = 32 * 256, ML = 4 * 4096, M = MC + ML;
constexpr int DIN = 6176, NPROJ = 6144, NPAD = 6400, DFF = 8192, GWID = 512;
constexpr int NCP = M / 128;
constexpr float EPS = 1e-6f;
constexpr int PC_S5U = 0, PC_MQ = 512, PC_MK = 1024, PC_MV = 1536, PC_MO = 2048, PC_RQ = 2560, PC_RK = 3072, PC_RV = 3584, PC_RG = 4096, PC_DZ = 4608, PC_DX = 5120, PC_DB = 5632, PC_DC = 5888;
enum { I_XP = 0, I_XS, I_C, I_SS5R, I_SS5I, I_SMC, I_SMN, I_SMM, I_SRET, I_SSSD, I_CCTX, I_NORM1, I_WADA, I_BADA, I_WIN, I_S5LR, I_S5LI, I_S5DT, I_S5BR, I_S5BI, I_S5CR, I_S5CI, I_S5D, I_S5GLU,
       I_MIB, I_MFB, I_MNORM, I_RRATE, I_RNORM, I_CONVW, I_CONVB, I_DTB, I_ALOG, I_SSDD, I_SNORM, I_WOUT, I_NORM2, I_WM1, I_WM2, I_FNORM, N_IN };
constexpr size_t O_YP = 0, O_YS = (size_t)MC * D, O_S5R = (size_t)M * D, O_S5I = O_S5R + 524288, O_MC = O_S5I + 524288, O_MN = O_MC + 16777216, O_MM = O_MN + 131072, O_RET = O_MM + 1024, O_SSD = O_RET + 16777216, O_END = O_SSD + 16777216;

constexpr size_t MiB = 1u << 20;
constexpr size_t WS_CTL = 0, CTL_ZERO_BYTES = 1 * MiB;
constexpr size_t WS_MOD = 1 * MiB;
constexpr size_t WS_S5T = 2 * MiB;
constexpr size_t WS_ROPE = 5 * MiB;
constexpr size_t WS_GATES = 6 * MiB;
constexpr size_t WS_MLNLOC = 9 * MiB;
constexpr size_t WS_MLNIN = 10 * MiB;
constexpr size_t WS_MLSC = 11 * MiB;
constexpr size_t WS_MLMIN = 11 * MiB + 65536;
constexpr size_t WS_SDSC = 11 * MiB + 131072;
constexpr size_t WS_SSQA = 5 * MiB + 65536;
constexpr size_t WS_SSQB = 11 * MiB + 262144;
constexpr size_t WS_SHW1 = 18 * MiB;
constexpr size_t WS_SHW2 = 19 * MiB;
constexpr size_t WS_S5LOC = 12 * MiB;
constexpr size_t WS_WGT = 20 * MiB;
constexpr size_t WS_W1T = 22 * MiB;
constexpr size_t WS_WOT = 122 * MiB;
constexpr size_t WS_WM1T = 154 * MiB;
constexpr size_t WS_WM2T = 282 * MiB;
constexpr size_t WS_H = 410 * MiB;
constexpr size_t WS_Y = 506 * MiB;
constexpr size_t WS_YA = 602 * MiB;
constexpr size_t WS_MLCIN = 626 * MiB;
constexpr size_t WS_RTIN = 674 * MiB;
constexpr size_t WS_SDIN = 722 * MiB;
constexpr size_t WS_PROJ = 770 * MiB;
constexpr size_t WS_MLCLOC = 1058 * MiB;
constexpr size_t WS_HID = 770 * MiB;
constexpr size_t WS_RTLOC = 1106 * MiB;
constexpr size_t WS_SDLOC = 1154 * MiB;
constexpr size_t WS_XBCC = 1202 * MiB;
constexpr size_t WS_XB = 1250 * MiB;
constexpr size_t WS_END = 1346 * MiB;
constexpr int CW_TMO = 0, CW_BAR = 4096;

constexpr int LDT = 272;
constexpr int TS = 128 * LDT;
constexpr int LDX = 144;
constexpr int TSX = 128 * LDX;
constexpr int SCAL_OFF = 4 * TS;
constexpr int MISC_OFF = 163840 - 256;
constexpr int LDS_BYTES = 163840;
#define SCA(i) ((LAS float*)(F.lds + SCAL_OFF + (i) * 512))
typedef float f32x16 __attribute__((ext_vector_type(16)));
typedef float f32x2 __attribute__((ext_vector_type(2)));
typedef short s16x4 __attribute__((ext_vector_type(4)));
typedef unsigned u32x2 __attribute__((ext_vector_type(2)));
struct Args { const float* in[N_IN]; float* out; unsigned char* ws; int ph_lo, ph_hi; };
struct Frame {
    LAS unsigned char* lds;
    float* out; unsigned char* ws;
    int tid, lane, wave, G, bid;
};
__device__ __forceinline__ int lane_id() { return (int)__builtin_amdgcn_mbcnt_hi(~0u, __builtin_amdgcn_mbcnt_lo(~0u, 0u)); }
typedef const __attribute__((address_space(4))) Args KArgs;
__device__ __forceinline__ KArgs* kargs() { KArgs* p = (KArgs*)__builtin_amdgcn_kernarg_segment_ptr(); asm volatile("" : "+s"(p)); return p; }
__device__ __forceinline__ Frame fresh(const Frame& F) { Frame R = F; unsigned long long l = (unsigned long long)(size_t)R.lds; unsigned ll = (unsigned)l; asm volatile("" : "+s"(ll), "+s"(R.wave), "+s"(R.G), "+s"(R.bid)); R.lane = lane_id(); asm volatile("" : "+v"(R.lane)); R.tid = R.wave * 64 + R.lane; R.lds = (LAS unsigned char*)(size_t)ll; KArgs* ka = kargs(); R.out = (float*)(GAS float*)ka->out; R.ws = (unsigned char*)(GAS unsigned char*)ka->ws; return R; }
#define INP(i) ((const float*)(const GAS float*)(A.in[i]))
#define BAR() __syncthreads()
#ifndef PROBE_IMASK
#define PROBE_IMASK 0
#endif
#define ITS(k) do { if ((PROBE_IMASK >> (k)) & 1) { if (F.tid == 0 && F.bid == 0) ((volatile LAS unsigned long long*)(F.lds + MISC_OFF + 128))[0] = __builtin_amdgcn_s_memrealtime(); } } while (0)
#define ITE(k) do { if ((PROBE_IMASK >> (k)) & 1) { if (F.tid == 0 && F.bid == 0) { volatile LAS unsigned long long* p_ = (volatile LAS unsigned long long*)(F.lds + MISC_OFF + 128); p_[1] += __builtin_amdgcn_s_memrealtime() - p_[0]; } } } while (0)
#define WSP(T, off) ((T*)(F.ws + (off)))
__device__ __forceinline__ float bf2f(unsigned short b) { return __uint_as_float((unsigned)b << 16); }
__device__ __forceinline__ float bflo(unsigned w) { return __uint_as_float(w << 16); }
__device__ __forceinline__ float bfhi(unsigned w) { return __uint_as_float(w & 0xffff0000u); }
__device__ __forceinline__ void unpack8(const v4u a, float (&x)[8]) { x[0] = bflo(a.x); x[1] = bfhi(a.x); x[2] = bflo(a.y); x[3] = bfhi(a.y); x[4] = bflo(a.z); x[5] = bfhi(a.z); x[6] = bflo(a.w); x[7] = bfhi(a.w); }
__device__ __forceinline__ v4u pack8(const float (&x)[8], float w) { v4u o; o.x = pk2(x[0] * w, x[1] * w); o.y = pk2(x[2] * w, x[3] * w); o.z = pk2(x[4] * w, x[5] * w); o.w = pk2(x[6] * w, x[7] * w); return o; }
__device__ __forceinline__ float sigmoidf_(float x) { return __builtin_amdgcn_rcpf(1.f + __expf(-x)); }
__device__ __forceinline__ float siluf_(float x) { return x * sigmoidf_(x); }
__device__ __forceinline__ float wave_sum(float v) {
#pragma unroll
    for (int o = 1; o < 64; o <<= 1) v += __shfl_xor(v, o);
    return v;
}
__device__ __forceinline__ float wave_max(float v) {
#pragma unroll
    for (int o = 1; o < 64; o <<= 1) v = fmaxf(v, __shfl_xor(v, o));
    return v;
}
template <bool MAX> __device__ __forceinline__ void wave_scan128(const LAS float* in, LAS float* out, int lane, bool rev, float init) {
    const int i0 = rev ? 127 - 2 * lane : 2 * lane, i1 = rev ? i0 - 1 : i0 + 1;
    float e0 = in[i0], e1 = in[i1];
    if (lane == 0) e0 = MAX ? fmaxf(e0, init) : e0 + init;
    float inc = MAX ? fmaxf(e0, e1) : e0 + e1;
#pragma unroll
    for (int o = 1; o < 64; o <<= 1) { const float t = __shfl_up(inc, o); if (lane >= o) inc = MAX ? fmaxf(inc, t) : inc + t; }
    float exc = __shfl_up(inc, 1);
    const float o0 = (lane == 0) ? e0 : (MAX ? fmaxf(exc, e0) : exc + e0);
    out[i0] = o0; out[i1] = inc;
}
__device__ __forceinline__ s16x4 lds_tr(const LAS unsigned char* p) {
    typedef short v4i16_t __attribute__((ext_vector_type(4)));
    return __builtin_bit_cast(s16x4, __builtin_amdgcn_ds_read_tr16_b64_v4i16((LAS v4i16_t*)p));
}
__device__ __forceinline__ bf16x8 frag_row(const LAS unsigned char* base, int ld, int r0, int k0, int lane) {
    return *(const LAS bf16x8*)(base + (r0 + (lane & 31)) * ld + (k0 + 8 * (lane >> 5)) * 2);
}
__device__ __forceinline__ bf16x8 frag_tr(const LAS unsigned char* base, int ld, int k0, int c0, int lane) {
    const int h = lane >> 5, blk = (lane >> 4) & 1, q = (lane & 15) >> 2, p = lane & 3;
    const LAS unsigned char* a = base + (k0 + 8 * h + q) * ld + (c0 + 16 * blk + 4 * p) * 2;
    const s16x4 lo = lds_tr(a), hi = lds_tr(a + 4 * ld);
    return (bf16x8){lo[0], lo[1], lo[2], lo[3], hi[0], hi[1], hi[2], hi[3]};
}
__device__ __forceinline__ bf16x8 frag_trp(const LAS unsigned char* base, int ld, int k0, int c0, int lane) {
    const int h = lane >> 5, blk = (lane >> 4) & 1, q = (lane & 15) >> 2, p = lane & 3;
    const LAS unsigned char* a = base + (k0 + 4 * h + q) * ld + (c0 + 16 * blk + 4 * p) * 2;
    const s16x4 lo = lds_tr(a), hi = lds_tr(a + 8 * ld);
    return (bf16x8){lo[0], lo[1], lo[2], lo[3], hi[0], hi[1], hi[2], hi[3]};
}
#define MFMA32(a, b, c) __builtin_amdgcn_mfma_f32_32x32x16_bf16((a), (b), (c), 0, 0, 0)
#define ZERO16 ((f32x16){0.f,0.f,0.f,0.f,0.f,0.f,0.f,0.f,0.f,0.f,0.f,0.f,0.f,0.f,0.f,0.f})
__device__ __forceinline__ int crow(int i, int hh) { return (i & 3) + 8 * (i >> 2) + 4 * hh; }

#define PT(cp, col) (WSP(const bf16, WS_PROJ) + ((size_t)(cp) * 48 + ((col) >> 7)) * 16384 + ((col) & 127))
#define XT(cp, ch) (WSP(bf16, WS_XBCC) + ((size_t)(cp) * 8 + ((ch) >> 7)) * 16384 + ((ch) & 127))
__device__ __forceinline__ const float* x_in_row(const Frame& F, KArgs& A, int l, int r) {
    if (l == 0) return r < MC ? INP(I_XP) + (size_t)r * D : INP(I_XS) + (size_t)(r - MC) * D;
    return F.out + (size_t)r * D;
}
__device__ __forceinline__ int mod_row(int r) { return r < MC ? 0 : 1 + (r - MC) / 4096; }
__device__ __forceinline__ const float* mod_ptr(const Frame& F, int l, int mrow, int part) { return WSP(const float, WS_MOD) + ((size_t)(l * 5 + mrow) * 6 + part) * D; }
struct Seq { int cp0, nch, c, b, lat; };
__device__ __forceinline__ Seq seq_of(int cp) { Seq s; if (cp < 64) { s.lat = 0; s.b = cp >> 1; s.cp0 = cp & ~1; s.nch = 2; s.c = cp & 1; } else { s.lat = 1; s.b = (cp - 64) >> 5; s.cp0 = 64 + (s.b << 5); s.nch = 32; s.c = (cp - 64) & 31; } return s; }
__device__ __forceinline__ int w1_newcol(int n) { return n < 2560 ? n : (n < 2576 ? n - 2560 + 6144 : (n < 6160 ? n - 16 : n)); }
template <bool MAPW1> __device__ __forceinline__ void p0_transpose_item(const float* W, int K, int N, bf16* WT, LAS float* scr, int item, int lane) {
    const int nblk = N / 32, kb = item / nblk, nb = item % nblk, k0 = 64 * kb, n0 = 32 * nb;
#pragma unroll 8
    for (int i = 0; i < 32; ++i) { const int kk = 2 * i + (lane >> 5); scr[kk * 33 + (lane & 31)] = W[(size_t)(k0 + kk) * N + n0 + (lane & 31)]; }
    LDS_WAIT(); asm volatile("" ::: "memory");
    const int c = lane & 7;
#pragma unroll
    for (int j = 0; j < 4; ++j) { const int n = (lane >> 3) + 8 * j; const LAS float* s = scr + (8 * c) * 33 + n;
        v4u o; o.x = pk2(s[0 * 33], s[1 * 33]); o.y = pk2(s[2 * 33], s[3 * 33]); o.z = pk2(s[4 * 33], s[5 * 33]); o.w = pk2(s[6 * 33], s[7 * 33]);
        const int nr = MAPW1 ? w1_newcol(n0 + n) : (n0 + n);
        *(GAS v4u*)(WT + (size_t)nr * K + k0 + 8 * c) = o; }
    LDS_WAIT(); asm volatile("" ::: "memory");
}
constexpr int S5T_STRIDE = 9216;
__device__ __forceinline__ unsigned char* s5tab(const Frame& F, int l, int d, int g) { return F.ws + WS_S5T + (size_t)((l * 2 + d) * 32 + g) * S5T_STRIDE; }

__device__ __forceinline__ void p0_prologue(Frame& F, KArgs& A) {
    {
        LAS float* scr = (LAS float*)(F.lds + F.wave * 16384);
        const int gw = F.bid * NWAVES + F.wave, NGW = F.G * NWAVES;
        constexpr int I_1 = (D / 64) * (DIN / 32), I_G = (GWID / 64) * (GWID / 32), I_O = (D / 64) * (D / 32), I_M1 = (D / 64) * (DFF / 32), I_M2 = (DFF / 64) * (D / 32);
        constexpr int PER_L = I_1 + I_G + I_O + I_M1 + I_M2;
        for (int it = gw; it < NLAYER * PER_L; it += NGW) {
            const int l = it / PER_L; int r = it % PER_L;
            if (r < I_1) { p0_transpose_item<true>(INP(I_WIN) + (size_t)l * D * DIN, D, DIN, WSP(bf16, WS_W1T) + (size_t)l * NPAD * D, scr, r, F.lane); continue; } r -= I_1;
            if (r < I_G) { p0_transpose_item<false>(INP(I_S5GLU) + (size_t)l * GWID * GWID, GWID, GWID, WSP(bf16, WS_WGT) + (size_t)l * GWID * GWID, scr, r, F.lane); continue; } r -= I_G;
            if (r < I_O) { p0_transpose_item<false>(INP(I_WOUT) + (size_t)l * D * D, D, D, WSP(bf16, WS_WOT) + (size_t)l * D * D, scr, r, F.lane); continue; } r -= I_O;
            if (r < I_M1) { p0_transpose_item<false>(INP(I_WM1) + (size_t)l * D * DFF, D, DFF, WSP(bf16, WS_WM1T) + (size_t)l * DFF * D, scr, r, F.lane); continue; } r -= I_M1;
            p0_transpose_item<false>(INP(I_WM2) + (size_t)l * DFF * D, DFF, D, WSP(bf16, WS_WM2T) + (size_t)l * D * DFF, scr, r, F.lane);
        }
        const int gt = F.bid * NT + F.tid, NGT = F.G * NT;
        for (int i = gt; i < NLAYER * 224 * 256; i += NGT) { const int l = i / (224 * 256), r = i % (224 * 256);
            *(GAS v4u*)(WSP(bf16, WS_W1T) + ((size_t)l * NPAD + DIN) * D + (size_t)r * 8) = (v4u){0u, 0u, 0u, 0u}; }
        for (int i = gt; i < NLAYER * 2 * 32 * 64; i += NGT) {
            const int p = i & 63, g = (i >> 6) & 31, d = (i >> 11) & 1, l = i >> 12;
            const int ldg = (l * 2 + d) * 32 + g;
            const double lre = INP(I_S5LR)[ldg * 64 + p], lim = INP(I_S5LI)[ldg * 64 + p], dt = exp((double)INP(I_S5DT)[ldg]);
            const double er = exp(lre * dt), br = er * cos(lim * dt), bi = er * sin(lim * dt);
            const double e128 = exp(128.0 * lre * dt), b128r = e128 * cos(128.0 * lim * dt), b128i = e128 * sin(128.0 * lim * dt);
            const double nr = br - 1.0, ni = bi, den = lre * lre + lim * lim;
            const double cr = (nr * lre + ni * lim) / den, ci = (ni * lre - nr * lim) / den;
            unsigned char* tb = s5tab(F, l, d, g);
            float* lam = (float*)tb; lam[2 * p] = (float)br; lam[2 * p + 1] = (float)bi;
            float* l128 = (float*)(tb + 512); l128[2 * p] = (float)b128r; l128[2 * p + 1] = (float)b128i;
            bf16* bb = (bf16*)(tb + 1024); bf16* ct = (bf16*)(tb + 5120);
            for (int c = 0; c < 16; ++c) {
                const double Br = INP(I_S5BR)[(size_t)(ldg * 64 + p) * 16 + c], Bi = INP(I_S5BI)[(size_t)(ldg * 64 + p) * 16 + c];
                bb[(2 * p) * 16 + c] = (bf16)f2bf((float)(cr * Br - ci * Bi));
                bb[(2 * p + 1) * 16 + c] = (bf16)f2bf((float)(cr * Bi + ci * Br));
                ct[c * 128 + 2 * p] = (bf16)f2bf(INP(I_S5CR)[(size_t)(ldg * 16 + c) * 64 + p]);
                ct[c * 128 + 2 * p + 1] = (bf16)f2bf(-INP(I_S5CI)[(size_t)(ldg * 16 + c) * 64 + p]);
            }
        }
        for (int i = gt; i < 64 * 32; i += NGT) { const int pos = i >> 5, k = i & 31; const double f = pow(10000.0, -(double)k / 32.0), a = pos * f;
            WSP(f32x2, WS_ROPE)[i] = (f32x2){(float)cos(a), (float)sin(a)}; }
    }
    __syncthreads();
    {
        LAS float* sc = (LAS float*)F.lds;
        LAS float* red = (LAS float*)(F.lds + 65536);
        for (int i = F.tid; i < 5 * D; i += NT) { const int r = i / D, k = i % D; const float v = r == 0 ? INP(I_CCTX)[k] : INP(I_C)[(r - 1) * D + k]; sc[i] = siluf_(v); }
        __syncthreads();
        for (int it = F.bid; it < NLAYER * 96; it += F.G) {
            const int l = it / 96, c0 = (it % 96) * 128;
            const float* W = INP(I_WADA) + (size_t)l * D * (6 * D);
            float acc[5][4];
#pragma unroll
            for (int r = 0; r < 5; ++r)
#pragma unroll
                for (int j = 0; j < 4; ++j) acc[r][j] = 0.f;
            const int cl = F.lane & 31, kp = F.lane >> 5;
#pragma unroll 4
            for (int kk = 0; kk < 128; ++kk) {
                const int k = F.wave * 256 + 2 * kk + kp;
                const f32x4 w = *(const f32x4*)(W + (size_t)k * (6 * D) + c0 + 4 * cl);
#pragma unroll
                for (int r = 0; r < 5; ++r) { const float s = sc[r * D + k]; acc[r][0] += s * w.x; acc[r][1] += s * w.y; acc[r][2] += s * w.z; acc[r][3] += s * w.w; }
            }
#pragma unroll
            for (int r = 0; r < 5; ++r)
#pragma unroll
                for (int j = 0; j < 4; ++j) { acc[r][j] += __shfl_xor(acc[r][j], 32); }
            if (kp == 0) {
#pragma unroll
                for (int r = 0; r < 5; ++r)
#pragma unroll
                    for (int j = 0; j < 4; ++j) red[(F.wave * 5 + r) * 128 + 4 * cl + j] = acc[r][j];
            }
            __syncthreads();
            for (int i = F.tid; i < 5 * 128; i += NT) { const int r = i >> 7, j = i & 127; float s = 0.f;
#pragma unroll
                for (int w = 0; w < 8; ++w) s += red[(w * 5 + r) * 128 + j];
                WSP(float, WS_MOD)[(size_t)(l * 5 + r) * (6 * D) + c0 + j] = s + INP(I_BADA)[(size_t)l * (6 * D) + c0 + j]; }
            __syncthreads();
        }
    }
}

__device__ __forceinline__ void norm0_phase(Frame& F, KArgs& A) {
    const int gw = F.bid * NWAVES + F.wave, NGW = F.G * NWAVES;
    const float* gain = INP(I_NORM1);
    for (int m = gw; m < M; m += NGW) {
        const float* xr = x_in_row(F, A, 0, m);
        const float* scp = mod_ptr(F, 0, mod_row(m), 1);
        f32x4 v[8]; float s = 0.f;
#pragma unroll
        for (int j = 0; j < 8; ++j) { v[j] = *(const f32x4*)(xr + 4 * F.lane + 256 * j); s += (v[j].x * v[j].x + v[j].y * v[j].y) + (v[j].z * v[j].z + v[j].w * v[j].w); }
        s = wave_sum(s);
        if (F.lane < 8) WSP(float, WS_SSQB)[(size_t)m * 8 + F.lane] = F.lane == 0 ? s : 0.f;
        bf16* orow = WSP(bf16, WS_H) + (size_t)m * D;
#pragma unroll
        for (int j = 0; j < 8; ++j) { const int c = 4 * F.lane + 256 * j;
            const f32x4 g4 = *(const f32x4*)(gain + c), s4 = *(const f32x4*)(scp + c);
            *(u32x2*)(orow + c) = (u32x2){pk2(v[j].x * g4.x * (1.f + s4.x), v[j].y * g4.y * (1.f + s4.y)), pk2(v[j].z * g4.z * (1.f + s4.z), v[j].w * g4.w * (1.f + s4.w))}; }
    }
}
__device__ __forceinline__ void shw_phase(Frame& F) {
    LAS float* sh = (LAS float*)F.lds;
    const int gw = F.bid * NWAVES + F.wave, NGW = F.G * NWAVES;
    for (int grp = 0; grp < 2 * NLAYER; ++grp) {
        const int l = grp >> 1, which = grp & 1;
        __syncthreads();
        for (int i = F.tid; i < 5 * D; i += NT) sh[i] = WSP(const float, WS_MOD)[((size_t)(l * 5 + i / D) * 6 + (which ? 3 : 0)) * D + (i % D)];
        __syncthreads();
        const int N = which ? DFF : DIN, NS = which ? DFF : NPAD;
        const bf16* Wt = which ? WSP(const bf16, WS_WM1T) + (size_t)l * DFF * D : WSP(const bf16, WS_W1T) + (size_t)l * NPAD * D;
        float* o = which ? WSP(float, WS_SHW2) + (size_t)l * 5 * DFF : WSP(float, WS_SHW1) + (size_t)l * 5 * NPAD;
        for (int n = gw; n < N; n += NGW) {
            float acc[5] = {0.f, 0.f, 0.f, 0.f, 0.f};
#pragma unroll
            for (int j = 0; j < 4; ++j) { const int k = 8 * F.lane + 512 * j; float w[8]; unpack8(*(const v4u*)(Wt + (size_t)n * D + k), w);
#pragma unroll
                for (int r = 0; r < 5; ++r) { const f32x4 a0 = *(const LAS f32x4*)(sh + r * D + k), a1 = *(const LAS f32x4*)(sh + r * D + k + 4);
                    acc[r] += (w[0] * a0.x + w[1] * a0.y) + (w[2] * a0.z + w[3] * a0.w) + (w[4] * a1.x + w[5] * a1.y) + (w[6] * a1.z + w[7] * a1.w); } }
#pragma unroll
            for (int r = 0; r < 5; ++r) { const float s = wave_sum(acc[r]); if (F.lane == 0) o[(size_t)r * NS + n] = s; }
        }
    }
    __syncthreads();
}
__device__ __forceinline__ void final_norm_phase(Frame& F, KArgs& A) {
    const int gw = F.bid * NWAVES + F.wave, NGW = F.G * NWAVES;
    const float* gain = INP(I_FNORM);
    for (int m = gw; m < M; m += NGW) {
        const bf16* xr = WSP(const bf16, WS_XB) + (size_t)m * D; float* orow = F.out + (size_t)m * D;
        float v[4][8]; float s = 0.f;
#pragma unroll
        for (int j = 0; j < 4; ++j) { unpack8(*(const v4u*)(xr + 8 * F.lane + 512 * j), v[j]);
#pragma unroll
            for (int k = 0; k < 8; ++k) s += v[j][k] * v[j][k]; }
        const float rstd = rsqrtf(wave_sum(s) * (1.f / D) + EPS);
#pragma unroll
        for (int j = 0; j < 4; ++j) { const int c = 8 * F.lane + 512 * j; const f32x4 g0 = *(const f32x4*)(gain + c), g1 = *(const f32x4*)(gain + c + 4);
            *(f32x4*)(orow + c) = (f32x4){v[j][0] * rstd * g0.x, v[j][1] * rstd * g0.y, v[j][2] * rstd * g0.z, v[j][3] * rstd * g0.w};
            *(f32x4*)(orow + c + 4) = (f32x4){v[j][4] * rstd * g1.x, v[j][5] * rstd * g1.y, v[j][6] * rstd * g1.z, v[j][7] * rstd * g1.w}; }
    }
}

__device__ __forceinline__ void gates_phase(Frame& F, int l) {
    const bf16* XA = WSP(const bf16, WS_H); const bf16* Wg = WSP(const bf16, WS_W1T) + ((size_t)l * NPAD + NPROJ) * D;
    const float* shw = WSP(const float, WS_SHW1) + (size_t)l * 5 * NPAD + NPROJ;
    const int hh = F.lane >> 5, r = F.lane & 31, k0 = F.wave * 256;
    LAS float* red = (LAS float*)F.lds;
    bf16x8 bw[16];
#pragma unroll
    for (int ks = 0; ks < 16; ++ks) bw[ks] = *(const bf16x8*)(Wg + (size_t)r * D + k0 + 16 * ks + 8 * hh);
    for (int rb = F.bid; rb < M / 32; rb += F.G) {
        f32x16 acc = ZERO16;
#pragma unroll
        for (int half = 0; half < 2; ++half) { bf16x8 a[8];
#pragma unroll
            for (int j = 0; j < 8; ++j) a[j] = *(const bf16x8*)(XA + (size_t)(32 * rb + r) * D + k0 + 16 * (8 * half + j) + 8 * hh);
#pragma unroll
            for (int j = 0; j < 8; ++j) acc = MFMA32(a[j], bw[8 * half + j], acc); }
#pragma unroll
        for (int i = 0; i < 16; ++i) red[(F.wave * 32 + crow(i, hh)) * 33 + r] = acc[i];
        BAR();
#pragma unroll
        for (int q = 0; q < 2; ++q) { const int idx = F.tid * 2 + q, row = idx >> 5, col = idx & 31; float s = 0.f;
#pragma unroll
            for (int w = 0; w < 8; ++w) s += red[(w * 32 + row) * 33 + col];
            const int grow = 32 * rb + row; const float* part = WSP(const float, WS_SSQB) + (size_t)grow * 8;
            const float ssq = ((part[0] + part[1]) + (part[2] + part[3])) + ((part[4] + part[5]) + (part[6] + part[7]));
            WSP(float, WS_GATES)[(size_t)grow * 32 + col] = s * rsqrtf(ssq * (1.f / D) + EPS) + shw[(size_t)mod_row(grow) * NPAD + col]; }
        BAR();
    }
}
namespace epi {
__device__ __forceinline__ float rstd_of(const float* part, int r) { const pg8::f32x4 a = *(const pg8::f32x4*)(part + (size_t)r * 8), b = *(const pg8::f32x4*)(part + (size_t)r * 8 + 4);
    return rsqrtf((((a[0] + a[1]) + (a[2] + a[3])) + ((b[0] + b[1]) + (b[2] + b[3]))) * (1.f / D) + EPS); }
using pg8::Unit; using pg8::f32x4; using pg8::u32x4; using pg8::bf16_t; using pg8::cvt_pk_bf16;
constexpr int BMq = 256, HALFq = 128;
struct EpiProj {
    static constexpr bool PERM = true, AFTER_DRAIN = false;
    bf16_t* P; const float* ssq; const float* shw0;
    __device__ __forceinline__ void operator()(const f32x4 (&acc)[2][2][4][2], const Unit& u, int wr, int wc, int fr_, int fq_) const {
        int ln_ = (int)__builtin_amdgcn_mbcnt_hi(~0u, __builtin_amdgcn_mbcnt_lo(~0u, 0u)); asm volatile("" : "+v"(ln_)); const int fr = ln_ & 15, fq = ln_ >> 4; (void)fr_; (void)fq_;
        const int row0 = u.pm * BMq + wr * 64 + fr, rowt = u.pm * BMq, col0 = u.pn * BMq + wc * 32 + 8 * fq;
        const float* shw = shw0 + (size_t)(rowt < MC ? 0 : 1 + (rowt - MC) / 4096) * NPAD + col0;
        f32x4 sh[2][2];
#pragma unroll
        for (int bj = 0; bj < 2; ++bj) { sh[bj][0] = *(const f32x4*)(shw + bj * HALFq); sh[bj][1] = *(const f32x4*)(shw + bj * HALFq + 4); }
#pragma unroll
        for (int ai = 0; ai < 2; ++ai)
#pragma unroll
            for (int m = 0; m < 4; ++m) { const int r = row0 + ai * HALFq + m * 16; bf16_t* rowp = P + (((size_t)(r >> 7) * 48 + (col0 >> 7)) * 128 + (r & 127)) * 128 + (col0 & 127); const float rs = rstd_of(ssq, r);
#pragma unroll
                for (int bj = 0; bj < 2; ++bj) { const f32x4 v0 = acc[ai][bj][m][0] * rs + sh[bj][0], v1 = acc[ai][bj][m][1] * rs + sh[bj][1];
                    u32x4 w; w.x = cvt_pk_bf16(v0[0], v0[1]); w.y = cvt_pk_bf16(v0[2], v0[3]); w.z = cvt_pk_bf16(v1[0], v1[1]); w.w = cvt_pk_bf16(v1[2], v1[3]);
                    *(u32x4*)(rowp + bj * 16384) = w; } }
    }
};
struct EpiGlu {
    static constexpr bool PERM = true, AFTER_DRAIN = false;
    const bf16_t* YA; bf16_t* Y;
    __device__ __forceinline__ void operator()(const f32x4 (&acc)[2][2][4][2], const Unit& u, int wr, int wc, int fr_, int fq_) const {
        int ln_ = (int)__builtin_amdgcn_mbcnt_hi(~0u, __builtin_amdgcn_mbcnt_lo(~0u, 0u)); asm volatile("" : "+v"(ln_)); const int fr = ln_ & 15, fq = ln_ >> 4; (void)fr_; (void)fq_;
        const int row0 = u.pm * BMq + wr * 64 + fr, col0 = u.pn * BMq + wc * 32 + 8 * fq;
#pragma unroll
        for (int ai = 0; ai < 2; ++ai)
#pragma unroll
            for (int m = 0; m < 4; ++m) { const int r = row0 + ai * HALFq + m * 16;
#pragma unroll
                for (int bj = 0; bj < 2; ++bj) { const f32x4 v0 = acc[ai][bj][m][0], v1 = acc[ai][bj][m][1];
                    const u32x4 a = *(const u32x4*)(YA + (size_t)r * GWID + col0 + bj * HALFq);
                    float y[8] = {bflo(a.x), bfhi(a.x), bflo(a.y), bfhi(a.y), bflo(a.z), bfhi(a.z), bflo(a.w), bfhi(a.w)};
                    const float g[8] = {v0[0], v0[1], v0[2], v0[3], v1[0], v1[1], v1[2], v1[3]};
#pragma unroll
                    for (int k = 0; k < 8; ++k) y[k] = y[k] * sigmoidf_(g[k]);
                    u32x4 w; w.x = cvt_pk_bf16(y[0], y[1]); w.y = cvt_pk_bf16(y[2], y[3]); w.z = cvt_pk_bf16(y[4], y[5]); w.w = cvt_pk_bf16(y[6], y[7]);
                    *(u32x4*)(Y + (size_t)r * D + col0 + bj * HALFq) = w; } }
    }
};
struct EpiRes {
    static constexpr bool PERM = true, AFTER_DRAIN = false;
    const float* xp; const float* xs; bf16_t* XB; const float* gate0; int first;
    int NEXT; bf16_t* XA; float* ssq; const float* gn; const float* scn0; PG8_LAS unsigned char* scr;
    __device__ __forceinline__ void operator()(const f32x4 (&acc)[2][2][4][2], const Unit& u, int wr, int wc, int fr_, int fq_) const {
        int ln_ = (int)__builtin_amdgcn_mbcnt_hi(~0u, __builtin_amdgcn_mbcnt_lo(~0u, 0u)); asm volatile("" : "+v"(ln_)); const int fr = ln_ & 15, fq = ln_ >> 4; (void)fr_; (void)fq_;
        const int rowt = u.pm * BMq, col0 = u.pn * BMq + wc * 32 + 8 * fq;
        const int mrow = rowt < MC ? 0 : 1 + (rowt - MC) / 4096;
        const float* gate = gate0 + (size_t)mrow * (6 * D);
        const float* basef = rowt < MC ? xp + (size_t)rowt * D : xs + (size_t)(rowt - MC) * D;
        bf16_t* xb = XB + (size_t)rowt * D;
        float ss[2][4];
#pragma unroll
        for (int ai = 0; ai < 2; ++ai)
#pragma unroll
            for (int m = 0; m < 4; ++m) ss[ai][m] = 0.f;
#pragma unroll
        for (int bj = 0; bj < 2; ++bj) { const int c = col0 + bj * HALFq; const f32x4 g0 = *(const f32x4*)(gate + c), g1 = *(const f32x4*)(gate + c + 4);
            f32x4 a0 = (f32x4){0.f, 0.f, 0.f, 0.f}, a1 = a0;
            if (NEXT) { const float* scn = scn0 + (size_t)mrow * (6 * D); a0 = *(const f32x4*)(gn + c) * (*(const f32x4*)(scn + c) + 1.f); a1 = *(const f32x4*)(gn + c + 4) * (*(const f32x4*)(scn + c + 4) + 1.f); }
#pragma unroll
            for (int ai = 0; ai < 2; ++ai)
#pragma unroll
                for (int m = 0; m < 4; ++m) { const size_t off = (size_t)(wr * 64 + fr + ai * HALFq + m * 16) * D + c;
                    f32x4 b0, b1;
                    if (first) { b0 = *(const f32x4*)(basef + off); b1 = *(const f32x4*)(basef + off + 4); }
                    else { const u32x4 w = *(const u32x4*)(xb + off); b0 = (f32x4){bflo(w.x), bfhi(w.x), bflo(w.y), bfhi(w.y)}; b1 = (f32x4){bflo(w.z), bfhi(w.z), bflo(w.w), bfhi(w.w)}; }
                    const f32x4 x0 = b0 + g0 * acc[ai][bj][m][0], x1 = b1 + g1 * acc[ai][bj][m][1];
                    u32x4 xw; xw.x = cvt_pk_bf16(x0[0], x0[1]); xw.y = cvt_pk_bf16(x0[2], x0[3]); xw.z = cvt_pk_bf16(x1[0], x1[1]); xw.w = cvt_pk_bf16(x1[2], x1[3]);
                    *(u32x4*)(xb + off) = xw;
                    if (NEXT) { const f32x4 r0 = (f32x4){bflo(xw.x), bfhi(xw.x), bflo(xw.y), bfhi(xw.y)}, r1 = (f32x4){bflo(xw.z), bfhi(xw.z), bflo(xw.w), bfhi(xw.w)};
                        ss[ai][m] += (r0[0] * r0[0] + r0[1] * r0[1]) + (r0[2] * r0[2] + r0[3] * r0[3]) + (r1[0] * r1[0] + r1[1] * r1[1]) + (r1[2] * r1[2] + r1[3] * r1[3]);
                        const f32x4 y0 = r0 * a0, y1 = r1 * a1; u32x4 w; w.x = cvt_pk_bf16(y0[0], y0[1]); w.y = cvt_pk_bf16(y0[2], y0[3]); w.z = cvt_pk_bf16(y1[0], y1[1]); w.w = cvt_pk_bf16(y1[2], y1[3]);
                        *(u32x4*)(XA + (size_t)rowt * D + off) = w; }
                    if (m & 1) asm volatile("" ::: "memory"); } }
        if (NEXT) {
            PG8_LAS float* P4 = (PG8_LAS float*)scr;
#pragma unroll
            for (int ai = 0; ai < 2; ++ai)
#pragma unroll
                for (int m = 0; m < 4; ++m) { float s = ss[ai][m]; s += __shfl_xor(s, 16); s += __shfl_xor(s, 32);
                    if (fq == 0) P4[(ai * HALFq + wr * 64 + m * 16 + fr) * 4 + wc] = s; }
            asm volatile("s_waitcnt lgkmcnt(0)\n\ts_barrier" ::: "memory");
            { const int tid = (wr * 4 + wc) * 64 + fq * 16 + fr;
              if (tid < 256) { const f32x4 p = *(const PG8_LAS f32x4*)(P4 + tid * 4); ssq[(size_t)(rowt + tid) * 8 + u.pn] = (p[0] + p[1]) + (p[2] + p[3]); } }
            asm volatile("s_waitcnt lgkmcnt(0)\n\ts_barrier" ::: "memory");
        }
    }
};
struct EpiRelu2 {
    static constexpr bool PERM = true, AFTER_DRAIN = false;
    bf16_t* O; const float* ssq; const float* shw0;
    __device__ __forceinline__ void operator()(const f32x4 (&acc)[2][2][4][2], const Unit& u, int wr, int wc, int fr_, int fq_) const {
        int ln_ = (int)__builtin_amdgcn_mbcnt_hi(~0u, __builtin_amdgcn_mbcnt_lo(~0u, 0u)); asm volatile("" : "+v"(ln_)); const int fr = ln_ & 15, fq = ln_ >> 4; (void)fr_; (void)fq_;
        const int row0 = u.pm * BMq + wr * 64 + fr, col0 = u.pn * BMq + wc * 32 + 8 * fq, rowt = u.pm * BMq;
        const float* shw = shw0 + (size_t)(rowt < MC ? 0 : 1 + (rowt - MC) / 4096) * DFF + col0;
        f32x4 sh[2][2];
#pragma unroll
        for (int bj = 0; bj < 2; ++bj) { sh[bj][0] = *(const f32x4*)(shw + bj * HALFq); sh[bj][1] = *(const f32x4*)(shw + bj * HALFq + 4); }
#pragma unroll
        for (int ai = 0; ai < 2; ++ai)
#pragma unroll
            for (int m = 0; m < 4; ++m) { const int r = row0 + ai * HALFq + m * 16; bf16_t* rowp = O + (size_t)r * DFF + col0; const float rs = rstd_of(ssq, r);
#pragma unroll
                for (int bj = 0; bj < 2; ++bj) { f32x4 v0 = acc[ai][bj][m][0] * rs + sh[bj][0], v1 = acc[ai][bj][m][1] * rs + sh[bj][1];
#pragma unroll
                    for (int k = 0; k < 4; ++k) { const float a = fmaxf(v0[k], 0.f), b = fmaxf(v1[k], 0.f); v0[k] = a * a; v1[k] = b * b; }
                    u32x4 w; w.x = cvt_pk_bf16(v0[0], v0[1]); w.y = cvt_pk_bf16(v0[2], v0[3]); w.z = cvt_pk_bf16(v1[0], v1[1]); w.w = cvt_pk_bf16(v1[2], v1[3]);
                    *(u32x4*)(rowp + bj * HALFq) = w; } }
    }
};
}
__device__ __forceinline__ float logsigmoidf_(float x) { return fminf(x, 0.f) - __logf(1.f + __expf(-fabsf(x))); }
__device__ __forceinline__ float softplusf_(float x) { return fmaxf(x, 0.f) + __logf(1.f + __expf(-fabsf(x))); }
__device__ __forceinline__ void load_tile128(Frame& F, LAS unsigned char* dst, const bf16* src) {
#pragma unroll
    for (int it = 0; it < 4; ++it) { const int i = F.tid + NT * it, r = i >> 4, c = i & 15;
        *(LAS v4u*)(dst + r * LDT + c * 16) = *(const v4u*)(src + (size_t)r * 128 + c * 8); }
}
__device__ __forceinline__ void qk_issue(Frame& F, const bf16* src, v4u (&r)[4]) {
#pragma unroll
    for (int it = 0; it < 2; ++it) { const int i = F.tid + NT * it, rw = i >> 3, c = i & 7;
        r[2 * it] = *(const v4u*)(src + (size_t)rw * 128 + c * 8); r[2 * it + 1] = *(const v4u*)(src + (size_t)rw * 128 + 64 + c * 8); }
}
template <int NDST> __device__ __forceinline__ void qk_commit(Frame& F, LAS unsigned char* dst0, LAS unsigned char* dst1, const v4u (&rg)[4], const LAS float* w0, const LAS float* w1, float scale, bool rope, int tpos0) {
#pragma unroll
    for (int it = 0; it < 2; ++it) {
        const int i = F.tid + NT * it, r = i >> 3, c = i & 7;
        float x1[8], x2[8];
        unpack8(rg[2 * it], x1); unpack8(rg[2 * it + 1], x2);
        if (rope) {
            const int tp = tpos0 + r, pos = c < 4 ? (tp >> 6) : (tp & 63);
            const f32x2* rt = WSP(const f32x2, WS_ROPE) + pos * 32 + ((8 * c) & 31);
#pragma unroll
            for (int j = 0; j < 8; ++j) { const f32x2 cs = rt[j]; const float a = x1[j], b = x2[j]; x1[j] = a * cs.x - b * cs.y; x2[j] = a * cs.y + b * cs.x; }
        }
        const float s0 = scale * (w0 ? w0[r] : 1.f);
        *(LAS v4u*)(dst0 + r * LDT + c * 16) = pack8(x1, s0); *(LAS v4u*)(dst0 + r * LDT + 128 + c * 16) = pack8(x2, s0);
        if (NDST == 2) { const float s1 = scale * w1[r];
            *(LAS v4u*)(dst1 + r * LDT + c * 16) = pack8(x1, s1); *(LAS v4u*)(dst1 + r * LDT + 128 + c * 16) = pack8(x2, s1); }
    }
}
template <int NDST> __device__ __forceinline__ void load_qk(Frame& F, LAS unsigned char* dst0, LAS unsigned char* dst1, const bf16* src, const LAS float* w0, const LAS float* w1, float scale, bool rope, int tpos0) {
    v4u r[4]; qk_issue(F, src, r); qk_commit<NDST>(F, dst0, dst1, r, w0, w1, scale, rope, tpos0);
}
template <int NDST, int nc8> __device__ __forceinline__ void load_conv(Frame& F, KArgs& A, int l, LAS unsigned char* dst0, LAS unsigned char* dst1, int ldd, int ch0, int row0, int seq_lo, int seq_hi,
                                                               const LAS float* w0, const LAS float* w1, bool to_global) {
    const float* cw = INP(I_CONVW) + (size_t)l * 5 * 1024 + ch0; const float* cb = INP(I_CONVB) + (size_t)l * 1024 + ch0;
    for (int i = F.tid; i < 128 * nc8; i += NT) {
        const int r = i / nc8, c = i % nc8, row = row0 + r;
        float acc[8];
        { const f32x4 b0 = *(const f32x4*)(cb + 8 * c), b1 = *(const f32x4*)(cb + 8 * c + 4); acc[0] = b0.x; acc[1] = b0.y; acc[2] = b0.z; acc[3] = b0.w; acc[4] = b1.x; acc[5] = b1.y; acc[6] = b1.z; acc[7] = b1.w; }
#pragma unroll
        for (int k = 0; k < 5; ++k) { const int rr = row + k - 2;
            if (rr >= seq_lo && rr < seq_hi) { float x[8]; unpack8(*(const v4u*)(PT(rr >> 7, PC_DX + ch0 + 8 * c) + (size_t)(rr & 127) * 128), x);
                const f32x4 w0v = *(const f32x4*)(cw + k * 1024 + 8 * c), w1v = *(const f32x4*)(cw + k * 1024 + 8 * c + 4);
                acc[0] += x[0] * w0v.x; acc[1] += x[1] * w0v.y; acc[2] += x[2] * w0v.z; acc[3] += x[3] * w0v.w; acc[4] += x[4] * w1v.x; acc[5] += x[5] * w1v.y; acc[6] += x[6] * w1v.z; acc[7] += x[7] * w1v.w; } }
#pragma unroll
        for (int j = 0; j < 8; ++j) acc[j] = siluf_(acc[j]);
        if (to_global) *(v4u*)(XT(row >> 7, ch0 + 8 * c) + (size_t)(row & 127) * 128) = pack8(acc, 1.f);
        if (NDST >= 1) *(LAS v4u*)(dst0 + r * ldd + c * 16) = pack8(acc, w0 ? w0[r] : 1.f);
        if (NDST == 2) *(LAS v4u*)(dst1 + r * ldd + c * 16) = pack8(acc, w1[r]);
    }
}
template <int nc8> __device__ __forceinline__ void load_xbcc(Frame& F, LAS unsigned char* dst, int ldd, int ch0, int row0) {
    const bf16* P = XT(row0 >> 7, ch0);
    for (int i = F.tid; i < 128 * nc8; i += NT) { const int r = i / nc8, c = i % nc8; *(LAS v4u*)(dst + r * ldd + c * 16) = *(const v4u*)(P + (size_t)r * 128 + 8 * c); }
}
__device__ __forceinline__ void kv_state_mfma(Frame& F, const LAS unsigned char* TKf, const LAS unsigned char* TKb, const LAS unsigned char* TV, bf16* outF, bf16* outB) {
    const int dvb = F.wave >> 1, dkb0 = (F.wave & 1) * 2, hh = F.lane >> 5;
    f32x16 acc[2][2] = {{ZERO16, ZERO16}, {ZERO16, ZERO16}};
#pragma unroll 1
    for (int ks = 0; ks < 8; ++ks) {
        const bf16x8 a = frag_tr(TV, LDT, 16 * ks, 32 * dvb, F.lane);
#pragma unroll
        for (int j = 0; j < 2; ++j) { acc[0][j] = MFMA32(a, frag_tr(TKf, LDT, 16 * ks, 32 * (dkb0 + j), F.lane), acc[0][j]); acc[1][j] = MFMA32(a, frag_tr(TKb, LDT, 16 * ks, 32 * (dkb0 + j), F.lane), acc[1][j]); }
    }
#pragma unroll
    for (int j = 0; j < 2; ++j)
#pragma unroll
        for (int i = 0; i < 16; ++i) { const int o = (32 * dvb + crow(i, hh)) * 128 + 32 * (dkb0 + j) + (F.lane & 31); outF[o] = (bf16)f2bf(acc[0][j][i]); outB[o] = (bf16)f2bf(acc[1][j][i]); }
}
__device__ __forceinline__ void qkT_mfma(Frame& F, const LAS unsigned char* TQ, const LAS unsigned char* TK, f32x16 (&qk)[2]) {
    const int tb = F.wave >> 1, sb0 = (F.wave & 1) * 2;
    qk[0] = ZERO16; qk[1] = ZERO16;
#pragma unroll 1
    for (int ks = 0; ks < 8; ++ks) { const bf16x8 bq = frag_row(TQ, LDT, 32 * tb, 16 * ks, F.lane);
#pragma unroll
        for (int j = 0; j < 2; ++j) qk[j] = MFMA32(frag_row(TK, LDT, 32 * (sb0 + j), 16 * ks, F.lane), bq, qk[j]); }
}
__device__ __forceinline__ void pv_mfma(Frame& F, const LAS unsigned char* TP, const LAS unsigned char* TV, f32x16 (&o)[2]) {
    const int tb = F.wave >> 1, eb0 = (F.wave & 1) * 2;
#pragma unroll 1
    for (int ks = 0; ks < 8; ++ks) { const bf16x8 ap = frag_row(TP, LDT, 32 * tb, 16 * ks, F.lane);
#pragma unroll
        for (int j = 0; j < 2; ++j) o[j] = MFMA32(ap, frag_tr(TV, LDT, 16 * ks, 32 * (eb0 + j), F.lane), o[j]); }
}
__device__ __forceinline__ void qs_prefetch(Frame& F, const bf16* ST, bf16x8 (&b)[2][8]) {
    const int eb0 = (F.wave & 1) * 2, hh = F.lane >> 5;
#pragma unroll
    for (int j = 0; j < 2; ++j)
#pragma unroll
        for (int ks = 0; ks < 8; ++ks) b[j][ks] = *(const bf16x8*)(ST + (size_t)(32 * (eb0 + j) + (F.lane & 31)) * 128 + 16 * ks + 8 * hh);
}
__device__ __forceinline__ void qs_mfma(Frame& F, const LAS unsigned char* TQ, const bf16x8 (&b)[2][8], f32x16 (&o)[2]) {
    const int tb = F.wave >> 1;
#pragma unroll
    for (int ks = 0; ks < 8; ++ks) { const bf16x8 aq = frag_row(TQ, LDT, 32 * tb, 16 * ks, F.lane);
#pragma unroll
        for (int j = 0; j < 2; ++j) o[j] = MFMA32(aq, b[j][ks], o[j]); }
}
__device__ __forceinline__ void hs_to_lds(Frame& F, LAS unsigned char* HS, const f32x16 (&hs)[2]) {
    const int tb = F.wave >> 1, eb0 = (F.wave & 1) * 2, hh = F.lane >> 5;
#pragma unroll
    for (int j = 0; j < 2; ++j)
#pragma unroll
        for (int i = 0; i < 16; ++i) *(LAS float*)(HS + (32 * tb + crow(i, hh)) * 528 + (32 * (eb0 + j) + (F.lane & 31)) * 4) = hs[j][i];
}
template <int GATE> __device__ __forceinline__ void head_out(Frame& F, const LAS unsigned char* HS, const float* gain, const bf16* gsrc  , bf16* ydst  ) {
    const int t = F.tid >> 2, seg = F.tid & 3;
    float v[32]; float ss = 0.f;
#pragma unroll
    for (int k = 0; k < 8; ++k) { const f32x4 x = *(const LAS f32x4*)(HS + t * 528 + (32 * seg + 4 * k) * 4); v[4 * k] = x.x; v[4 * k + 1] = x.y; v[4 * k + 2] = x.z; v[4 * k + 3] = x.w; ss += (x.x * x.x + x.y * x.y) + (x.z * x.z + x.w * x.w); }
    ss += __shfl_xor(ss, 1); ss += __shfl_xor(ss, 2);
    const float r = rsqrtf(ss * (1.f / 128.f) + EPS);
#pragma unroll
    for (int k = 0; k < 4; ++k) { float g[8]; unpack8(*(const v4u*)(gsrc + (size_t)t * 128 + 32 * seg + 8 * k), g); float o[8];
#pragma unroll
        for (int j = 0; j < 8; ++j) { const float gg = GATE == 0 ? sigmoidf_(g[j]) : siluf_(g[j]); o[j] = v[8 * k + j] * r * gain[32 * seg + 8 * k + j] * gg; }
        *(v4u*)(ydst + (size_t)t * D + 32 * seg + 8 * k) = pack8(o, 1.f); }
}

__device__ __forceinline__ void tile_issue(Frame& F, const bf16* src, v4u (&r)[4]) {
#pragma unroll
    for (int it = 0; it < 4; ++it) { const int i = F.tid + NT * it; r[it] = *(const v4u*)(src + (size_t)(i >> 4) * 128 + (i & 15) * 8); }
}
__device__ __forceinline__ void tile_commit(Frame& F, LAS unsigned char* dst, const v4u (&r)[4], float scale) {
#pragma unroll
    for (int it = 0; it < 4; ++it) { const int i = F.tid + NT * it; v4u v = r[it];
        if (scale != 1.f) { float x[8]; unpack8(v, x); v = pack8(x, scale); }
        *(LAS v4u*)(dst + (i >> 4) * LDT + (i & 15) * 16) = v; }
}
template <int GATE> __device__ __forceinline__ void head_out_r(Frame& F, const LAS unsigned char* HS, const float* gain, const v4u (&og)[4], bf16* ydst) {
    const int t = F.tid >> 2, seg = F.tid & 3;
    float v[32]; float ss = 0.f;
#pragma unroll
    for (int k = 0; k < 8; ++k) { const f32x4 x = *(const LAS f32x4*)(HS + t * 528 + (32 * seg + 4 * k) * 4); v[4 * k] = x.x; v[4 * k + 1] = x.y; v[4 * k + 2] = x.z; v[4 * k + 3] = x.w; ss += (x.x * x.x + x.y * x.y) + (x.z * x.z + x.w * x.w); }
    ss += __shfl_xor(ss, 1); ss += __shfl_xor(ss, 2);
    const float r = rsqrtf(ss * (1.f / 128.f) + EPS);
#pragma unroll
    for (int k = 0; k < 4; ++k) { float g[8]; unpack8(og[k], g); float o[8]; const f32x4 g0 = *(const f32x4*)(gain + 32 * seg + 8 * k), g1 = *(const f32x4*)(gain + 32 * seg + 8 * k + 4);
        const float gn[8] = {g0.x, g0.y, g0.z, g0.w, g1.x, g1.y, g1.z, g1.w};
#pragma unroll
        for (int j = 0; j < 8; ++j) { const float gg = GATE == 0 ? sigmoidf_(g[j]) : siluf_(g[j]); o[j] = v[8 * k + j] * r * gn[j] * gg; }
        *(v4u*)(ydst + (size_t)t * D + 32 * seg + 8 * k) = pack8(o, 1.f); }
}
__device__ __forceinline__ void mlstm_gates(Frame& F, KArgs& A, int l, int cp, int h) {
    if (F.tid < 128) { const float* g = WSP(const float, WS_GATES) + (size_t)(cp * 128 + F.tid) * 32;
        SCA(0)[F.tid] = g[h] + INP(I_MIB)[(l * 2 + 0) * 4 + h]; SCA(1)[F.tid] = g[4 + h] + INP(I_MIB)[(l * 2 + 1) * 4 + h];
        SCA(2)[F.tid] = logsigmoidf_(g[8 + h] + INP(I_MFB)[(l * 2 + 0) * 4 + h]); SCA(3)[F.tid] = logsigmoidf_(g[12 + h] + INP(I_MFB)[(l * 2 + 1) * 4 + h]); }
    BAR();
    if (F.wave == 0) wave_scan128<false>(SCA(2), SCA(4), F.lane, false, 0.f);
    if (F.wave == 1) wave_scan128<false>(SCA(3), SCA(5), F.lane, true, 0.f);
    BAR();
}
__device__ __forceinline__ void mlstm_local_item(Frame F, KArgs& A, int l, int cp, int h) {
    v4u rk[4], rv[4]; qk_issue(F, PT(cp, PC_MK + h * 128), rk); tile_issue(F, PT(cp, PC_MV + h * 128), rv);
    mlstm_gates(F, A, l, cp, h);
    if (F.wave < 2) { const int d = F.wave; const LAS float* bc = SCA(4 + d); const LAS float* ig = SCA(d); const float tot = d == 0 ? bc[127] : bc[0];
        const int s0 = 2 * F.lane; const float g0 = tot - bc[s0] + ig[s0], g1 = tot - bc[s0 + 1] + ig[s0 + 1];
        const float mx = wave_max(fmaxf(g0, g1));
        SCA(6 + d)[s0] = __expf(g0 - mx); SCA(6 + d)[s0 + 1] = __expf(g1 - mx);
        if (F.lane == 0) { float* sc = WSP(float, WS_MLSC) + ((cp * 2 + d) * 4 + h) * 2; sc[0] = tot; sc[1] = mx; } }
    BAR();
    qk_commit<2>(F, F.lds, F.lds + TS, rk, SCA(6), SCA(7), 0.08838834764831845f, false, 0);
    tile_commit(F, F.lds + 2 * TS, rv, 1.f);
    BAR();
    kv_state_mfma(F, F.lds, F.lds + TS, F.lds + 2 * TS, WSP(bf16, WS_MLCLOC) + (size_t)((cp * 2 + 0) * 4 + h) * 16384, WSP(bf16, WS_MLCLOC) + (size_t)((cp * 2 + 1) * 4 + h) * 16384);
    if (F.tid < 256) { const int d = F.tid >> 7, dk = F.tid & 127; const LAS unsigned char* T = F.lds + d * TS; float s = 0.f;
        for (int r = 0; r < 128; ++r) s += bf2f(*(const LAS unsigned short*)(T + r * LDT + dk * 2));
        WSP(float, WS_MLNLOC)[((cp * 2 + d) * 4 + h) * 128 + dk] = s; }
    BAR();
}
__device__ __forceinline__ void mlstm_out_item(Frame F, KArgs& A, int l, int cp, int h) {
    const Seq sq = seq_of(cp);
    LAS unsigned char* TQ = F.lds; LAS unsigned char* TK = F.lds + TS; LAS unsigned char* TV = F.lds + 2 * TS; LAS unsigned char* TP = F.lds + 3 * TS;
    ITS(0);
    v4u rq[4], rk[4], rv[4], og[4];
    tile_issue(F, PT(cp, PC_MQ + h * 128), rq); tile_issue(F, PT(cp, PC_MK + h * 128), rk); tile_issue(F, PT(cp, PC_MV + h * 128), rv);
    { const int t = F.tid >> 2, seg = F.tid & 3;
#pragma unroll
      for (int k = 0; k < 4; ++k) og[k] = *(const v4u*)(PT(cp, PC_MO + h * 128) + (size_t)t * 128 + 32 * seg + 8 * k); }
    const float min_f = WSP(const float, WS_MLMIN)[(cp * 2 + 0) * 4 + h], min_b = WSP(const float, WS_MLMIN)[(cp * 2 + 1) * 4 + h];
    float nin = 0.f; if (F.tid < 256) nin = WSP(const float, WS_MLNIN)[((cp * 2 + (F.tid >> 7)) * 4 + h) * 128 + (F.tid & 127)];
    mlstm_gates(F, A, l, cp, h);
    if (F.tid < 256) { const int d = F.tid >> 7, s = F.tid & 127; SCA(6 + d)[s] = SCA(d)[s] - SCA(4 + d)[s]; SCA(12 + d)[s] = nin; }
    tile_commit(F, TQ, rq, 1.f); tile_commit(F, TK, rk, 0.08838834764831845f); tile_commit(F, TV, rv, 1.f);
    BAR();
    if (F.wave == 0) wave_scan128<true>(SCA(6), SCA(8), F.lane, false, min_f);
    if (F.wave == 1) wave_scan128<true>(SCA(7), SCA(9), F.lane, true, min_b);
    BAR();
    ITE(0);
    f32x16 hs[2] = {ZERO16, ZERO16};
    const int tb = F.wave >> 1, sb0 = (F.wave & 1) * 2, hh = F.lane >> 5, t = 32 * tb + (F.lane & 31);
#pragma unroll 1
    for (int d = 0; d < 2; ++d) {
        const LAS float* av = SCA(6 + d); const float Mt = SCA(8 + d)[t]; const float m_in = d == 0 ? min_f : min_b;
        ITS(2);
        const bool has_state = sq.lat || (d == 0 ? sq.c > 0 : sq.c < sq.nch - 1);
        bf16x8 bst[2][8]; if (has_state) qs_prefetch(F, WSP(const bf16, WS_MLCIN) + (size_t)((cp * 2 + d) * 4 + h) * 16384, bst);
#ifndef PROBE_REP2
#define PROBE_REP2 1
#endif
#pragma unroll 1
        for (int rep2_ = 0; rep2_ < PROBE_REP2; ++rep2_) {
        f32x16 qk[2]; qkT_mfma(F, TQ, TK, qk);
#pragma unroll
        for (int j = 0; j < 2; ++j)
#pragma unroll
            for (int i4 = 0; i4 < 4; ++i4) { const int sb = 32 * (sb0 + j) + 8 * i4 + 4 * hh; float p[4]; const f32x4 a4 = *(const LAS f32x4*)(av + sb);
#pragma unroll
                for (int i = 0; i < 4; ++i) { const int s = sb + i; const bool ok = d == 0 ? (s <= t) : (s >= t); p[i] = ok ? qk[j][4 * i4 + i] * __expf(a4[i] - Mt) : 0.f; }
                *(LAS u32x2*)(TP + t * LDT + sb * 2) = (u32x2){pk2(p[0], p[1]), pk2(p[2], p[3])}; }
        }
        ITE(2); ITS(3);
        BAR();
        {
            const int tt = F.tid >> 2, seg = F.tid & 3; float ds = 0.f, qn = 0.f;
#pragma unroll
            for (int k = 0; k < 4; ++k) { float x[8]; unpack8(*(const LAS v4u*)(TP + tt * LDT + 64 * seg + 16 * k), x); float q[8]; unpack8(*(const LAS v4u*)(TQ + tt * LDT + 64 * seg + 16 * k), q);
                const f32x4 n0 = *(const LAS f32x4*)(SCA(12 + d) + 32 * seg + 8 * k), n1 = *(const LAS f32x4*)(SCA(12 + d) + 32 * seg + 8 * k + 4);
                ds += ((x[0] + x[1]) + (x[2] + x[3])) + ((x[4] + x[5]) + (x[6] + x[7]));
                qn += (q[0] * n0.x + q[1] * n0.y) + (q[2] * n0.z + q[3] * n0.w) + (q[4] * n1.x + q[5] * n1.y) + (q[6] * n1.z + q[7] * n1.w); }
            ds += __shfl_xor(ds, 1); ds += __shfl_xor(ds, 2); qn += __shfl_xor(qn, 1); qn += __shfl_xor(qn, 2);
            if (seg == 0) { const float Mtt = SCA(8 + d)[tt], wint = __expf(m_in - Mtt), den = ds + wint * qn, dd = fmaxf(fabsf(den), __expf(-(SCA(4 + d)[tt] + Mtt)));
                const float rdd = __builtin_amdgcn_rcpf(dd); SCA(10)[tt] = wint * rdd; SCA(11)[tt] = rdd; } }
        { f32x16 num[2] = {ZERO16, ZERO16};
          pv_mfma(F, TP, TV, num);
          BAR(); ITE(3); ITS(4);
#pragma unroll
          for (int j = 0; j < 2; ++j)
#pragma unroll
            for (int k4 = 0; k4 < 4; ++k4) { const f32x4 f4 = *(const LAS f32x4*)(SCA(11) + 32 * tb + 8 * k4 + 4 * hh);
#pragma unroll
                for (int i = 0; i < 4; ++i) hs[j][4 * k4 + i] += f4[i] * num[j][4 * k4 + i]; } }
        if (has_state) { f32x16 qc[2] = {ZERO16, ZERO16};
          qs_mfma(F, TQ, bst, qc);
#pragma unroll
          for (int j = 0; j < 2; ++j)
#pragma unroll
            for (int k4 = 0; k4 < 4; ++k4) { const f32x4 f4 = *(const LAS f32x4*)(SCA(10) + 32 * tb + 8 * k4 + 4 * hh);
#pragma unroll
                for (int i = 0; i < 4; ++i) hs[j][4 * k4 + i] += f4[i] * qc[j][4 * k4 + i]; } }
        ITE(4);
    }
    ITS(5);
    BAR();
    hs_to_lds(F, F.lds, hs);
    BAR();
    head_out_r<0>(F, F.lds, INP(I_MNORM) + (size_t)l * GWID + h * 128, og, WSP(bf16, WS_Y) + (size_t)cp * 128 * D + 512 + h * 128);
    BAR(); ITE(5);
}

__device__ __forceinline__ void ret_local_item(Frame F, KArgs& A, int l, int cp, int h) {
    const float lgf = -__expf(INP(I_RRATE)[(l * 2 + 0) * 4 + h]), lgb = -__expf(INP(I_RRATE)[(l * 2 + 1) * 4 + h]);
    v4u rk[4], rv[4]; qk_issue(F, PT(cp, PC_RK + h * 128), rk); tile_issue(F, PT(cp, PC_RV + h * 128), rv);
    if (F.tid < 128) { SCA(6)[F.tid] = __expf((127.f - (float)F.tid) * lgf); SCA(7)[F.tid] = __expf((float)F.tid * lgb); }
    BAR();
    const Seq sq = seq_of(cp);
    qk_commit<2>(F, F.lds, F.lds + TS, rk, SCA(6), SCA(7), 0.08838834764831845f, sq.lat != 0, sq.c * 128);
    tile_commit(F, F.lds + 2 * TS, rv, 1.f);
    BAR();
    kv_state_mfma(F, F.lds, F.lds + TS, F.lds + 2 * TS, WSP(bf16, WS_RTLOC) + (size_t)((cp * 2 + 0) * 4 + h) * 16384, WSP(bf16, WS_RTLOC) + (size_t)((cp * 2 + 1) * 4 + h) * 16384);
    BAR();
}
__device__ __forceinline__ void ret_out_item(Frame F, KArgs& A, int l, int cp, int h) {
    const float lgf = -__expf(INP(I_RRATE)[(l * 2 + 0) * 4 + h]), lgb = -__expf(INP(I_RRATE)[(l * 2 + 1) * 4 + h]);
    if (F.tid < 128) { SCA(10)[F.tid] = __expf(((float)F.tid + 1.f) * lgf); SCA(11)[F.tid] = __expf((128.f - (float)F.tid) * lgb); }
    const Seq sq = seq_of(cp);
    LAS unsigned char* TQ = F.lds; LAS unsigned char* TK = F.lds + TS; LAS unsigned char* TV = F.lds + 2 * TS; LAS unsigned char* TP = F.lds + 3 * TS;
    v4u rq[4], rk[4], rv[4], og[4];
    qk_issue(F, PT(cp, PC_RQ + h * 128), rq); qk_issue(F, PT(cp, PC_RK + h * 128), rk); tile_issue(F, PT(cp, PC_RV + h * 128), rv);
    { const int t_ = F.tid >> 2, seg_ = F.tid & 3;
#pragma unroll
      for (int k = 0; k < 4; ++k) og[k] = *(const v4u*)(PT(cp, PC_RG + h * 128) + (size_t)t_ * 128 + 32 * seg_ + 8 * k); }
    qk_commit<1>(F, TQ, nullptr, rq, nullptr, nullptr, 1.f, sq.lat != 0, sq.c * 128);
    qk_commit<1>(F, TK, nullptr, rk, nullptr, nullptr, 0.08838834764831845f, sq.lat != 0, sq.c * 128);
    tile_commit(F, TV, rv, 1.f);
    BAR();
    f32x16 qk[2]; qkT_mfma(F, TQ, TK, qk);
    const int tb = F.wave >> 1, sb0 = (F.wave & 1) * 2, hh = F.lane >> 5, t = 32 * tb + (F.lane & 31);
#pragma unroll
    for (int j = 0; j < 2; ++j)
#pragma unroll
        for (int i4 = 0; i4 < 4; ++i4) { const int sb = 32 * (sb0 + j) + 8 * i4 + 4 * hh; float p[4];
#pragma unroll
            for (int i = 0; i < 4; ++i) { const int s = sb + i; const float df = (float)(t - s);
                const float dm = (s <= t ? __expf(df * lgf) : 0.f) + (s >= t ? __expf(-df * lgb) : 0.f); p[i] = qk[j][4 * i4 + i] * dm; }
            *(LAS u32x2*)(TP + t * LDT + sb * 2) = (u32x2){pk2(p[0], p[1]), pk2(p[2], p[3])}; }
    BAR();
    f32x16 y[2] = {ZERO16, ZERO16};
    pv_mfma(F, TP, TV, y);
#pragma unroll 1
    for (int d = 0; d < 2; ++d) { f32x16 qs[2] = {ZERO16, ZERO16};
        if (!sq.lat && (d == 0 ? sq.c == 0 : sq.c == sq.nch - 1)) continue;
        bf16x8 bst[2][8]; qs_prefetch(F, WSP(const bf16, WS_RTIN) + (size_t)((cp * 2 + d) * 4 + h) * 16384, bst);
        qs_mfma(F, TQ, bst, qs);
#pragma unroll
        for (int j = 0; j < 2; ++j)
#pragma unroll
            for (int k4 = 0; k4 < 4; ++k4) { const f32x4 f4 = *(const LAS f32x4*)(SCA(10 + d) + 32 * tb + 8 * k4 + 4 * hh);
#pragma unroll
                for (int i = 0; i < 4; ++i) y[j][4 * k4 + i] += f4[i] * qs[j][4 * k4 + i]; } }
    BAR();
    hs_to_lds(F, F.lds, y);
    BAR();
    head_out_r<1>(F, F.lds, INP(I_RNORM) + (size_t)l * GWID + h * 128, og, WSP(bf16, WS_Y) + (size_t)cp * 128 * D + 1024 + h * 128);
    BAR();
}
template <bool WMODE> __device__ __forceinline__ float ssd_scalars(Frame& F, KArgs& A, int l, int cp, int g) {
    const int d = F.wave >> 2, rr = F.wave & 3, head = g * 4 + rr;
    const float bias = INP(I_DTB)[(l * 2 + d) * 8 + head], arate = -__expf(INP(I_ALOG)[(l * 2 + d) * 8 + head]);
    const float* gp = WSP(const float, WS_GATES) + (size_t)(cp * 128) * 32 + 16 + d * 8 + head;
    const int i0 = d ? 127 - 2 * F.lane : 2 * F.lane, i1 = d ? i0 - 1 : i0 + 1;
    const float dt0 = softplusf_(gp[(size_t)i0 * 32] + bias), dt1 = softplusf_(gp[(size_t)i1 * 32] + bias);
    const float a0 = dt0 * arate, a1 = dt1 * arate;
    float inc = a0 + a1;
#pragma unroll
    for (int o = 1; o < 64; o <<= 1) { const float t = __shfl_up(inc, o); if (F.lane >= o) inc += t; }
    const float c1 = inc, c0 = inc - a1, tot = __shfl(inc, 63);
    LAS float* cum = SCA(16 + d * 4 + rr); LAS float* dtw = SCA(24 + d * 4 + rr);
    cum[i0] = c0; cum[i1] = c1;
    if (WMODE) { dtw[i0] = __expf(tot - c0) * dt0; dtw[i1] = __expf(tot - c1) * dt1; } else { dtw[i0] = dt0; dtw[i1] = dt1; }
    return tot;
}
__device__ __forceinline__ void seq_bounds(int cp, int& lo, int& hi) { if (cp < 64) { lo = (cp >> 1) * 256; hi = lo + 256; } else { lo = MC + ((cp - 64) >> 5) * 4096; hi = lo + 4096; } }
__device__ __forceinline__ void ssd_local_item(Frame F, KArgs& A, int l, int cp, int g) {
    const float tot = ssd_scalars<true>(F, A, l, cp, g);
    if (F.lane == 0) WSP(float, WS_SDSC)[(cp * 2 + (F.wave >> 2)) * 8 + g * 4 + (F.wave & 3)] = tot;
    int lo, hi; seq_bounds(cp, lo, hi);
    LAS unsigned char* TB = F.lds;
    load_conv<1, 16>(F, A, l, TB, nullptr, LDT, 512 + g * 128, cp * 128, lo, hi, nullptr, nullptr, true);
    load_conv<0, 16>(F, A, l, nullptr, nullptr, LDT, 768 + g * 128, cp * 128, lo, hi, nullptr, nullptr, true);
    BAR();
#pragma unroll 1
    for (int hr = 0; hr < 2; ++hr) {
#pragma unroll 1
        for (int r2 = 0; r2 < 2; ++r2) { const int rr = hr * 2 + r2;
            load_conv<2, 8>(F, A, l, F.lds + TS + (r2 * 2 + 0) * TSX, F.lds + TS + (r2 * 2 + 1) * TSX, LDX, g * 256 + rr * 64, cp * 128, lo, hi, SCA(24 + 0 * 4 + rr), SCA(24 + 1 * 4 + rr), true); }
        BAR();
        const int r2 = F.wave >> 2, d = (F.wave >> 1) & 1, pb = F.wave & 1, hh = F.lane >> 5, head = g * 4 + hr * 2 + r2;
        const LAS unsigned char* TX = F.lds + TS + (r2 * 2 + d) * TSX;
        f32x16 acc[4] = {ZERO16, ZERO16, ZERO16, ZERO16};
#pragma unroll 1
        for (int ks = 0; ks < 8; ++ks) { const bf16x8 a = frag_tr(TX, LDX, 16 * ks, 32 * pb, F.lane);
#pragma unroll
            for (int nb = 0; nb < 4; ++nb) acc[nb] = MFMA32(a, frag_tr(TB, LDT, 16 * ks, 32 * nb, F.lane), acc[nb]); }
        bf16* o = WSP(bf16, WS_SDLOC) + (size_t)((cp * 2 + d) * 8 + head) * 8192;
#pragma unroll
        for (int nb = 0; nb < 4; ++nb)
#pragma unroll
            for (int i = 0; i < 16; ++i) o[(32 * pb + crow(i, hh)) * 128 + 32 * nb + (F.lane & 31)] = (bf16)f2bf(acc[nb][i]);
        BAR();
    }
}
__device__ __forceinline__ void ssd_out_item(Frame F, KArgs& A, int l, int cp, bf16* Ybase) {
    const Seq sq = seq_of(cp);
    LAS unsigned char* TC = F.lds; LAS unsigned char* TB = F.lds + TS; LAS unsigned char* TX2 = F.lds + 2 * TS; LAS unsigned char* YI = F.lds + 3 * TS;
    LAS float* SSQ = SCA(14);
    if (F.tid < 128) SSQ[F.tid] = 0.f;
    const int tb = F.wave >> 1, ph = F.wave & 1, hh = F.lane >> 5, t = 32 * tb + (F.lane & 31);
    bf16* Yd = Ybase + (size_t)cp * 128 * D + 1536;
#pragma unroll 1
    for (int g = 0; g < 2; ++g) {
        (void)ssd_scalars<false>(F, A, l, cp, g);
        load_xbcc<16>(F, TC, LDT, 768 + g * 128, cp * 128);
        load_xbcc<16>(F, TB, LDT, 512 + g * 128, cp * 128);
        load_xbcc<16>(F, TX2, LDT, g * 256, cp * 128);
        BAR();
        f32x16 cb[4] = {ZERO16, ZERO16, ZERO16, ZERO16};
#pragma unroll 1
        for (int ks = 0; ks < 8; ++ks) { const bf16x8 bq = frag_row(TC, LDT, 32 * tb, 16 * ks, F.lane);
#pragma unroll
            for (int sb = 0; sb < 4; ++sb) cb[sb] = MFMA32(frag_row(TB, LDT, 32 * sb, 16 * ks, F.lane), bq, cb[sb]); }
#pragma unroll 1
        for (int hr = 0; hr < 2; ++hr) {
            if (hr == 1) { load_xbcc<16>(F, TX2, LDT, g * 256 + 128, cp * 128); BAR(); }
            f32x16 y2[2];
#pragma unroll
            for (int r2 = 0; r2 < 2; ++r2) {
                const int rr = hr * 2 + r2, head = g * 4 + rr;
                f32x16 y = ZERO16;
#pragma unroll 1
                for (int d = 0; d < 2; ++d) {
                    const LAS float* cum = SCA(16 + d * 4 + rr); const LAS float* dtv = SCA(24 + d * 4 + rr); const float ct = cum[t];
                    const bool has_state = sq.lat || (d == 0 ? sq.c > 0 : sq.c < sq.nch - 1);
                    bf16x8 bh[8];
                    if (has_state) { const bf16* hin = WSP(const bf16, WS_SDIN) + (size_t)((cp * 2 + d) * 8 + head) * 8192;
#pragma unroll
                        for (int ks = 0; ks < 8; ++ks) bh[ks] = *(const bf16x8*)(hin + (size_t)(32 * ph + (F.lane & 31)) * 128 + 16 * ks + 8 * hh); }
#pragma unroll
                    for (int sb = 0; sb < 4; ++sb) if (d == 0 ? sb <= tb : sb >= tb) {
#pragma unroll
                        for (int sp = 0; sp < 2; ++sp) { float p[8];
#pragma unroll
                            for (int jh = 0; jh < 2; ++jh) { const int s0 = 32 * sb + 16 * sp + 8 * jh + 4 * hh; const f32x4 c4 = *(const LAS f32x4*)(cum + s0), d4 = *(const LAS f32x4*)(dtv + s0);
#pragma unroll
                                for (int j = 0; j < 4; ++j) { const int s = s0 + j; const bool ok = d == 0 ? (s <= t) : (s >= t); p[4 * jh + j] = ok ? cb[sb][8 * sp + 4 * jh + j] * __expf(ct - c4[j]) * d4[j] : 0.f; } }
                            y = MFMA32(__builtin_bit_cast(bf16x8, pack8(p, 1.f)), frag_trp(TX2, LDT, 32 * sb + 16 * sp, r2 * 64 + 32 * ph, F.lane), y); } }
                    if (has_state) { f32x16 ch = ZERO16;
#pragma unroll
                        for (int ks = 0; ks < 8; ++ks) ch = MFMA32(frag_row(TC, LDT, 32 * tb, 16 * ks, F.lane), bh[ks], ch);
#pragma unroll
                        for (int k4 = 0; k4 < 4; ++k4) { const f32x4 c4 = *(const LAS f32x4*)(cum + 32 * tb + 8 * k4 + 4 * hh);
#pragma unroll
                            for (int i = 0; i < 4; ++i) y[4 * k4 + i] += __expf(c4[i]) * ch[4 * k4 + i]; } }
                }
                y2[r2] = y;
            }
#pragma unroll
            for (int r2 = 0; r2 < 2; ++r2)
#pragma unroll
                for (int i = 0; i < 16; ++i) *(LAS unsigned short*)(YI + (32 * tb + crow(i, hh)) * LDT + (r2 * 64 + 32 * ph + (F.lane & 31)) * 2) = (unsigned short)f2bf(y2[r2][i]);
            BAR();
            { const int tt = F.tid >> 2, seg = F.tid & 3, head = g * 4 + hr * 2 + (seg >> 1), pc = (seg & 1) * 32; const float Dh = INP(I_SSDD)[l * 8 + head]; float ss = 0.f;
#pragma unroll
                for (int k = 0; k < 4; ++k) { float yv[8], x[8], z[8], o[8];
                    unpack8(*(const LAS v4u*)(YI + tt * LDT + (seg * 32 + 8 * k) * 2), yv); unpack8(*(const LAS v4u*)(TX2 + tt * LDT + (seg * 32 + 8 * k) * 2), x);
                    unpack8(*(const v4u*)(PT(cp, PC_DZ + head * 64 + pc) + (size_t)tt * 128 + 8 * k), z);
#pragma unroll
                    for (int j = 0; j < 8; ++j) { const float v = (yv[j] + Dh * x[j]) * siluf_(z[j]); o[j] = v; ss += v * v; }
                    *(v4u*)(Yd + (size_t)tt * D + head * 64 + pc + 8 * k) = pack8(o, 1.f); }
                ss += __shfl_xor(ss, 1); ss += __shfl_xor(ss, 2);
                if (seg == 0) SSQ[tt] += ss; }
            BAR();
        }
    }
    __builtin_amdgcn_fence(__ATOMIC_RELEASE, "workgroup"); asm volatile("s_waitcnt vmcnt(0)" ::: "memory"); __syncthreads(); __builtin_amdgcn_fence(__ATOMIC_ACQUIRE, "workgroup");
    { const int tt = F.tid >> 2, seg = F.tid & 3; const float r = rsqrtf(SSQ[tt] * (1.f / 512.f) + EPS); const float* gn = INP(I_SNORM) + (size_t)l * GWID + 128 * seg;
#pragma unroll 4
        for (int k = 0; k < 16; ++k) { bf16* p = Yd + (size_t)tt * D + 128 * seg + 8 * k; float v[8];
            unpack8(*(const v4u*)p, v);
#pragma unroll
            for (int j = 0; j < 8; ++j) v[j] = v[j] * r * gn[8 * k + j];
            *(v4u*)p = pack8(v, 1.f); } }
    BAR();
}
template <int PASS> __device__ __forceinline__ void s5_item(Frame F, KArgs& A, int l, int cp, int gq) {
    const Seq sq = seq_of(cp);
    const int g = gq * 8 + F.wave, p = F.lane, hh = F.lane >> 5;
    LAS unsigned char* TU = F.lds; LAS unsigned char* BU = F.lds + TS + F.wave * 8704;
    if (PASS == 1) ITS(8);
    typedef short v8s __attribute__((ext_vector_type(8)));
    typedef float f32x4v __attribute__((ext_vector_type(4)));
    const int r16 = F.lane & 15, g4 = F.lane >> 4;
    v4u ru[4]; tile_issue(F, PT(cp, PC_S5U + gq * 128), ru);
    f32x2 lam[2], l8[2], h0[2]; bf16x8 bbf[2][4]; v8s ctf[2][4];
#pragma unroll
    for (int d = 0; d < 2; ++d) {
        const unsigned char* tab = s5tab(F, l, d, g);
        lam[d] = ((const f32x2*)tab)[p]; l8[d] = ((const f32x2*)(tab + 512))[p]; h0[d] = (f32x2){0.f, 0.f};
        if (PASS == 1 && sq.lat) { const size_t o = (size_t)(((sq.b * 4 + l) * 2 + d) * 32 + g) * 64 + p; h0[d] = (f32x2){INP(I_SS5R)[o], INP(I_SS5I)[o]}; }
        const bf16* bb = (const bf16*)(tab + 1024); const bf16* ct = (const bf16*)(tab + 5120);
#pragma unroll
        for (int nb = 0; nb < 4; ++nb) bbf[d][nb] = *(const bf16x8*)(bb + (size_t)(32 * nb + (F.lane & 31)) * 16 + 8 * hh);
        if (PASS == 1 && d == 0) {
#pragma unroll
            for (int ks = 0; ks < 4; ++ks) ctf[0][ks] = *(const v8s*)(ct + r16 * 128 + 32 * ks + 8 * g4); }
    }
    if (PASS == 1) {
        f32x2 e[31];
#pragma unroll
        for (int j = 0; j < 31; ++j) if (j < sq.nch - 1) { const int cc = j < sq.c ? j : j + 1, dd = j < sq.c ? 0 : 1;
            e[j] = *(const f32x2*)(WSP(const float, WS_S5LOC) + ((size_t)(((sq.cp0 + cc) * 2 + dd) * 32 + g) * 64 + p) * 2); }
#pragma unroll
        for (int j = 0; j < 31; ++j) if (j < sq.c) { const float nr = l8[0].x * h0[0].x - l8[0].y * h0[0].y + e[j].x, ni = l8[0].x * h0[0].y + l8[0].y * h0[0].x + e[j].y; h0[0] = (f32x2){nr, ni}; }
#pragma unroll
        for (int j = 30; j >= 0; --j) if (j >= sq.c && j < sq.nch - 1) { const float nr = l8[1].x * h0[1].x - l8[1].y * h0[1].y + e[j].x, ni = l8[1].x * h0[1].y + l8[1].y * h0[1].x + e[j].y; h0[1] = (f32x2){nr, ni}; }
    }
    tile_commit(F, TU, ru, 1.f);
    BAR();
    if (PASS == 1) { ITE(8); ITS(9); }
    f32x4v yacc[4][2];
    if (PASS == 1) {
#pragma unroll
        for (int a = 0; a < 4; ++a) { yacc[a][0] = (f32x4v){0.f, 0.f, 0.f, 0.f}; yacc[a][1] = (f32x4v){0.f, 0.f, 0.f, 0.f}; } }
#pragma unroll
    for (int d = 0; d < 2; ++d) {
        const float lr = lam[d].x, li = lam[d].y;
        float hr = h0[d].x, hi = h0[d].y;
        if (PASS == 1 && d == 1) { const bf16* ct = (const bf16*)(s5tab(F, l, 1, g) + 5120);
#pragma unroll
            for (int ks = 0; ks < 4; ++ks) ctf[1][ks] = *(const v8s*)(ct + r16 * 128 + 32 * ks + 8 * g4); }
#pragma unroll 1
        for (int tbi = 0; tbi < 4; ++tbi) {
            const int tb = d == 0 ? tbi : 3 - tbi;
            const bf16x8 bu = frag_row(TU, LDT, 32 * tb, 16 * F.wave, F.lane);
#pragma unroll
            for (int nb = 0; nb < 4; ++nb) {
                const f32x16 acc = MFMA32(bbf[d][nb], bu, ZERO16);
#pragma unroll
                for (int i4 = 0; i4 < 4; ++i4) *(LAS u32x2*)(BU + (F.lane & 31) * LDT + (32 * nb + 8 * i4 + 4 * hh) * 2) = (u32x2){pk2(acc[4 * i4], acc[4 * i4 + 1]), pk2(acc[4 * i4 + 2], acc[4 * i4 + 3])};
            }
            asm volatile("s_waitcnt lgkmcnt(0)" ::: "memory");
            unsigned w[32];
#pragma unroll
            for (int st = 0; st < 32; ++st) { const int tl = d == 0 ? st : 31 - st; w[st] = *(const LAS unsigned*)(BU + tl * LDT + p * 4); }
#pragma unroll
            for (int st = 0; st < 32; ++st) { const float br = bflo(w[st]), bi = bfhi(w[st]);
                const float nr = lr * hr - li * hi + br, ni = lr * hi + li * hr + bi; hr = nr; hi = ni;
                if (PASS == 1) w[st] = pk2(hr, hi); }
            if (PASS == 1) {
#pragma unroll
                for (int st = 0; st < 32; ++st) { const int tl = d == 0 ? st : 31 - st; *(LAS unsigned*)(BU + tl * LDT + p * 4) = w[st]; }
                asm volatile("s_waitcnt lgkmcnt(0)" ::: "memory");
                f32x4v y0 = (f32x4v){0.f, 0.f, 0.f, 0.f}, y1 = y0;
#pragma unroll
                for (int ks = 0; ks < 4; ++ks) {
                    y0 = __builtin_amdgcn_mfma_f32_16x16x32_bf16(*(const LAS v8s*)(BU + r16 * LDT + (32 * ks + 8 * g4) * 2), ctf[d][ks], y0, 0, 0, 0);
                    y1 = __builtin_amdgcn_mfma_f32_16x16x32_bf16(*(const LAS v8s*)(BU + (16 + r16) * LDT + (32 * ks + 8 * g4) * 2), ctf[d][ks], y1, 0, 0, 0); }
                if (tb == 0) { yacc[0][0] += y0; yacc[0][1] += y1; } else if (tb == 1) { yacc[1][0] += y0; yacc[1][1] += y1; } else if (tb == 2) { yacc[2][0] += y0; yacc[2][1] += y1; } else { yacc[3][0] += y0; yacc[3][1] += y1; }
                asm volatile("s_waitcnt lgkmcnt(0)" ::: "memory");
            }
        }
        if (PASS == 0) { *(f32x2*)(WSP(float, WS_S5LOC) + ((size_t)((cp * 2 + d) * 32 + g) * 64 + p) * 2) = (f32x2){hr, hi}; }
        else if (!sq.lat && ((d == 0 && sq.c == sq.nch - 1) || (d == 1 && sq.c == 0))) { const size_t o = (size_t)(((sq.b * 4 + l) * 2 + d) * 32 + g) * 64 + p; F.out[O_S5R + o] = hr; F.out[O_S5I + o] = hi; }
    }
    if (PASS == 1) { ITE(9); ITS(10); }
    if (PASS == 1) {
        const float Dc = INP(I_S5D)[(size_t)l * GWID + g * 16 + r16];
#pragma unroll
        for (int tb = 0; tb < 4; ++tb)
#pragma unroll
            for (int ts = 0; ts < 2; ++ts)
#pragma unroll
                for (int i = 0; i < 4; ++i) { const int t = 32 * tb + 16 * ts + 4 * g4 + i; LAS unsigned short* up = (LAS unsigned short*)(TU + t * LDT + (16 * F.wave + r16) * 2);
                    const float x = yacc[tb][ts][i] + Dc * bf2f(*up);
                    const float u2 = 1.5957691216057308f * (x + 0.044715f * x * x * x); const float ge = x - x * __builtin_amdgcn_rcpf(1.f + __expf(u2));
                    *up = (unsigned short)f2bf(ge); }
        BAR();
        bf16* ya = WSP(bf16, WS_YA) + (size_t)cp * 128 * GWID + gq * 128;
#pragma unroll
        for (int it = 0; it < 4; ++it) { const int i = F.tid + NT * it, r = i >> 4, c = i & 15; *(v4u*)(ya + (size_t)r * GWID + c * 8) = *(const LAS v4u*)(TU + r * LDT + c * 16); }
    }
    BAR();
    if (PASS == 1) ITE(10);
}

template <bool LAT> __device__ __forceinline__ void carry_unit(Frame F, KArgs& A, int l, int u) {
    const int sd = u / 96, rem = u % 96, sidx = sd >> 1, d = sd & 1;
    constexpr int lat = LAT ? 1 : 0, nch = LAT ? 32 : 2, NB = LAT ? 8 : 2;
    const int b = LAT ? sidx : sidx - 4, cp0 = LAT ? 64 + 32 * b : 2 * b;
    int type, head, slice;
    if (rem < 32) { type = 0; head = rem >> 3; slice = rem & 7; } else if (rem < 64) { type = 1; head = (rem - 32) >> 3; slice = (rem - 32) & 7; } else { type = 2; head = (rem - 64) >> 2; slice = (rem - 64) & 3; }
    const int e0 = slice * 2048 + F.tid * 4;
    const int nh = type == 2 ? 8 : 4, esz = type == 2 ? 8192 : 16384;
    const bf16* loc = type == 0 ? WSP(const bf16, WS_MLCLOC) : (type == 1 ? WSP(const bf16, WS_RTLOC) : WSP(const bf16, WS_SDLOC));
    bf16* inb = type == 0 ? WSP(bf16, WS_MLCIN) : (type == 1 ? WSP(bf16, WS_RTIN) : WSP(bf16, WS_SDIN));
    float zf = 0.f; asm volatile("" : "+v"(zf));
    float v[4] = {zf, zf, zf, zf}, nv[4] = {zf, zf, zf, zf}, m = 0.f;
    const bool do_n = (type == 0 && slice == 0 && F.tid < 32);
    if (LAT) {
        if (type == 2) { const f32x4 s = *(const f32x4*)(INP(I_SSSD) + (size_t)(((b * 4 + l) * 2 + d) * 8 + head) * 8192 + e0); v[0] = s.x; v[1] = s.y; v[2] = s.z; v[3] = s.w; }
        else { const float* s = (type == 0 ? INP(I_SMC) : INP(I_SRET)) + (size_t)(((b * 4 + l) * 2 + d) * 4 + head) * 16384; const int dv = e0 >> 7, dk = e0 & 127;
#pragma unroll
            for (int j = 0; j < 4; ++j) v[j] = s[(dk + j) * 128 + dv]; }
        if (type == 0) { m = INP(I_SMM)[((b * 4 + l) * 2 + d) * 4 + head];
            if (do_n) { const f32x4 s = *(const f32x4*)(INP(I_SMN) + (size_t)(((b * 4 + l) * 2 + d) * 4 + head) * 128 + F.tid * 4); nv[0] = s.x; nv[1] = s.y; nv[2] = s.z; nv[3] = s.w; } }
    }
    const float rdec = type == 1 ? __expf(-128.f * __expf(INP(I_RRATE)[(l * 2 + d) * 4 + head])) : 1.f;
#pragma unroll 1
    for (int ci0 = 0; ci0 < nch; ci0 += NB) {
        u32x2 lc[NB]; f32x4 ln[NB]; float s0[NB], s1[NB];
#pragma unroll
        for (int j = 0; j < NB; ++j) { ln[j] = (f32x4){zf, zf, zf, zf}; s0[j] = zf; s1[j] = zf; }
#pragma unroll
        for (int j = 0; j < NB; ++j) {
            const int ci = ci0 + j, cp = cp0 + (d == 0 ? ci : nch - 1 - ci);
            lc[j] = *(const u32x2*)(loc + (size_t)((cp * 2 + d) * nh + head) * esz + e0);
            if (type == 0) { const float* sc = WSP(const float, WS_MLSC) + ((cp * 2 + d) * 4 + head) * 2; s0[j] = sc[0]; s1[j] = sc[1];
                if (do_n) ln[j] = *(const f32x4*)(WSP(const float, WS_MLNLOC) + ((cp * 2 + d) * 4 + head) * 128 + F.tid * 4); }
            else if (type == 2) s0[j] = WSP(const float, WS_SDSC)[(cp * 2 + d) * 8 + head];
        }
#pragma unroll
        for (int j = 0; j < NB; ++j) {
            const int ci = ci0 + j, cp = cp0 + (d == 0 ? ci : nch - 1 - ci);
            const size_t so = (size_t)((cp * 2 + d) * nh + head) * esz + e0;
            if (LAT || ci > 0) *(u32x2*)(inb + so) = (u32x2){pk2(v[0], v[1]), pk2(v[2], v[3])};
            float dec, wl = 1.f;
            if (type == 0) {
                const float Bt = s0[j], ml = s1[j];
                if (slice == 0 && F.tid == 0) WSP(float, WS_MLMIN)[(cp * 2 + d) * 4 + head] = m;
                if (do_n) *(f32x4*)(WSP(float, WS_MLNIN) + ((cp * 2 + d) * 4 + head) * 128 + F.tid * 4) = (f32x4){nv[0], nv[1], nv[2], nv[3]};
                const float mn = fmaxf(Bt + m, ml); dec = __expf(Bt + m - mn); wl = __expf(ml - mn); m = mn;
                if (do_n) { nv[0] = dec * nv[0] + wl * ln[j].x; nv[1] = dec * nv[1] + wl * ln[j].y; nv[2] = dec * nv[2] + wl * ln[j].z; nv[3] = dec * nv[3] + wl * ln[j].w; }
            } else if (type == 1) dec = rdec;
            else dec = __expf(s0[j]);
            v[0] = dec * v[0] + wl * bflo(lc[j].x); v[1] = dec * v[1] + wl * bfhi(lc[j].x); v[2] = dec * v[2] + wl * bflo(lc[j].y); v[3] = dec * v[3] + wl * bfhi(lc[j].y);
        }
    }
    if (!lat) {
        if (type == 2) *(f32x4*)(F.out + O_SSD + (size_t)(((b * 4 + l) * 2 + d) * 8 + head) * 8192 + e0) = (f32x4){v[0], v[1], v[2], v[3]};
        else {
            LAS float* tr = (LAS float*)F.lds;
            const int dvl = F.tid >> 5, dk = (F.tid & 31) * 4;
#pragma unroll
            for (int j = 0; j < 4; ++j) tr[dvl * 129 + dk + j] = v[j];
            BAR();
            const int dk2 = F.tid >> 2, q = F.tid & 3;
            float* o = F.out + (type == 0 ? O_MC : O_RET) + (size_t)(((b * 4 + l) * 2 + d) * 4 + head) * 16384 + (size_t)dk2 * 128 + slice * 16 + 4 * q;
            *(f32x4*)o = (f32x4){tr[(4 * q) * 129 + dk2], tr[(4 * q + 1) * 129 + dk2], tr[(4 * q + 2) * 129 + dk2], tr[(4 * q + 3) * 129 + dk2]};
            if (type == 0) { if (do_n) *(f32x4*)(F.out + O_MN + (size_t)(((b * 4 + l) * 2 + d) * 4 + head) * 128 + F.tid * 4) = (f32x4){nv[0], nv[1], nv[2], nv[3]};
                if (slice == 0 && F.tid == 0) F.out[O_MM + ((b * 4 + l) * 2 + d) * 4 + head] = m; }
            BAR();
        }
    }
}

struct CtxLd { u32x2 lc[2]; f32x4 ln[2]; float s0[2], s1[2]; };
struct CtxU { int d, b, cp0, type, head, slice, e0, nh, esz; bool do_n; };
__device__ __forceinline__ CtxU ctx_decode(const Frame& F, int u) {
    CtxU c; const int sd = u / 96, rem = u % 96, sidx = sd >> 1; c.d = sd & 1; c.b = sidx - 4; c.cp0 = 2 * c.b;
    if (rem < 32) { c.type = 0; c.head = rem >> 3; c.slice = rem & 7; } else if (rem < 64) { c.type = 1; c.head = (rem - 32) >> 3; c.slice = (rem - 32) & 7; } else { c.type = 2; c.head = (rem - 64) >> 2; c.slice = (rem - 64) & 3; }
    c.e0 = c.slice * 2048 + F.tid * 4; c.nh = c.type == 2 ? 8 : 4; c.esz = c.type == 2 ? 8192 : 16384; c.do_n = (c.type == 0 && c.slice == 0 && F.tid < 32);
    return c;
}
__device__ __forceinline__ void carry_ctx_load(const Frame& F, int u, CtxLd& L, float zf) {
    const CtxU c = ctx_decode(F, u);
    const bf16* loc = c.type == 0 ? WSP(const bf16, WS_MLCLOC) : (c.type == 1 ? WSP(const bf16, WS_RTLOC) : WSP(const bf16, WS_SDLOC));
#pragma unroll
    for (int j = 0; j < 2; ++j) { const int cp = c.cp0 + (c.d == 0 ? j : 1 - j);
        L.ln[j] = (f32x4){zf, zf, zf, zf}; L.s0[j] = zf; L.s1[j] = zf;
        L.lc[j] = *(const u32x2*)(loc + (size_t)((cp * 2 + c.d) * c.nh + c.head) * c.esz + c.e0);
        if (c.type == 0) { const float* sc = WSP(const float, WS_MLSC) + ((cp * 2 + c.d) * 4 + c.head) * 2; L.s0[j] = sc[0]; L.s1[j] = sc[1];
            if (c.do_n) L.ln[j] = *(const f32x4*)(WSP(const float, WS_MLNLOC) + ((cp * 2 + c.d) * 4 + c.head) * 128 + F.tid * 4); }
        else if (c.type == 2) L.s0[j] = WSP(const float, WS_SDSC)[(cp * 2 + c.d) * 8 + c.head]; }
}
__device__ __forceinline__ void carry_ctx_finish(Frame& F, KArgs& A, int l, int u, const CtxLd& L, float zf) {
    const CtxU c = ctx_decode(F, u);
    bf16* inb = c.type == 0 ? WSP(bf16, WS_MLCIN) : (c.type == 1 ? WSP(bf16, WS_RTIN) : WSP(bf16, WS_SDIN));
    float v[4] = {zf, zf, zf, zf}, nv[4] = {zf, zf, zf, zf}, m = 0.f;
    const float rdec = c.type == 1 ? __expf(-128.f * __expf(INP(I_RRATE)[(l * 2 + c.d) * 4 + c.head])) : 1.f;
#pragma unroll
    for (int j = 0; j < 2; ++j) { const int cp = c.cp0 + (c.d == 0 ? j : 1 - j);
        if (j > 0) *(u32x2*)(inb + (size_t)((cp * 2 + c.d) * c.nh + c.head) * c.esz + c.e0) = (u32x2){pk2(v[0], v[1]), pk2(v[2], v[3])};
        float dec, wl = 1.f;
        if (c.type == 0) {
            if (c.slice == 0 && F.tid == 0) WSP(float, WS_MLMIN)[(cp * 2 + c.d) * 4 + c.head] = m;
            if (c.do_n) *(f32x4*)(WSP(float, WS_MLNIN) + ((cp * 2 + c.d) * 4 + c.head) * 128 + F.tid * 4) = (f32x4){nv[0], nv[1], nv[2], nv[3]};
            const float mn = fmaxf(L.s0[j] + m, L.s1[j]); dec = __expf(L.s0[j] + m - mn); wl = __expf(L.s1[j] - mn); m = mn;
            if (c.do_n) { nv[0] = dec * nv[0] + wl * L.ln[j].x; nv[1] = dec * nv[1] + wl * L.ln[j].y; nv[2] = dec * nv[2] + wl * L.ln[j].z; nv[3] = dec * nv[3] + wl * L.ln[j].w; }
        } else if (c.type == 1) dec = rdec;
        else dec = __expf(L.s0[j]);
        v[0] = dec * v[0] + wl * bflo(L.lc[j].x); v[1] = dec * v[1] + wl * bfhi(L.lc[j].x); v[2] = dec * v[2] + wl * bflo(L.lc[j].y); v[3] = dec * v[3] + wl * bfhi(L.lc[j].y); }
    const int b = c.b, d = c.d, head = c.head, slice = c.slice, e0 = c.e0;
    if (c.type == 2) *(f32x4*)(F.out + O_SSD + (size_t)(((b * 4 + l) * 2 + d) * 8 + head) * 8192 + e0) = (f32x4){v[0], v[1], v[2], v[3]};
    else {
        LAS float* tr = (LAS float*)F.lds;
        const int dvl = F.tid >> 5, dk = (F.tid & 31) * 4;
#pragma unroll
        for (int j = 0; j < 4; ++j) tr[dvl * 129 + dk + j] = v[j];
        BAR();
        const int dk2 = F.tid >> 2, q = F.tid & 3;
        float* o = F.out + (c.type == 0 ? O_MC : O_RET) + (size_t)(((b * 4 + l) * 2 + d) * 4 + head) * 16384 + (size_t)dk2 * 128 + slice * 16 + 4 * q;
        *(f32x4*)o = (f32x4){tr[(4 * q) * 129 + dk2], tr[(4 * q + 1) * 129 + dk2], tr[(4 * q + 2) * 129 + dk2], tr[(4 * q + 3) * 129 + dk2]};
        if (c.type == 0) { if (c.do_n) *(f32x4*)(F.out + O_MN + (size_t)(((b * 4 + l) * 2 + d) * 4 + head) * 128 + F.tid * 4) = (f32x4){nv[0], nv[1], nv[2], nv[3]};
            if (slice == 0 && F.tid == 0) F.out[O_MM + ((b * 4 + l) * 2 + d) * 4 + head] = m; }
        BAR();
    }
}
__device__ __forceinline__ void carry_ctx_batch(Frame F, KArgs& A, int l, int u0) {
    float zf = 0.f; asm volatile("" : "+v"(zf));
    CtxLd L[8];
#pragma unroll
    for (int j = 0; j < 8; ++j) carry_ctx_load(F, u0 + j, L[j], zf);
#pragma unroll
    for (int j = 0; j < 8; ++j) carry_ctx_finish(F, A, l, u0 + j, L[j], zf);
}
constexpr int CW_Q = 16384;
struct OneUnit { pg8::Unit u; __device__ __forceinline__ bool next(int i, pg8::Unit& o) const { if (i) return false; o = u; return true; }
    __device__ __forceinline__ void a_ready(const pg8::Unit&) const {} __device__ __forceinline__ void done(const pg8::Unit&) const {} };
#define QUEUE_LOOP(F0_, qidx, total, ...) do { \
    unsigned* qc_ = (unsigned*)(F0_.ws + WS_CTL) + CW_Q + 64 * (qidx); volatile LAS int* qs_ = (volatile LAS int*)(F0_.lds + MISC_OFF + 64); \
    if (F0_.tid == 0) qs_[0] = (int)__hip_atomic_fetch_add(qc_, 1u, __ATOMIC_RELAXED, __HIP_MEMORY_SCOPE_AGENT); \
    __syncthreads(); \
    int it = qs_[0], par_ = 1; \
    while (it < (total)) { \
        int nx_ = 0; if (F0_.tid == 0) nx_ = (int)__hip_atomic_fetch_add(qc_, 1u, __ATOMIC_RELAXED, __HIP_MEMORY_SCOPE_AGENT); \
        { __VA_ARGS__ } \
        if (F0_.tid == 0) qs_[par_] = nx_; \
        BAR();     \
        it = qs_[par_]; par_ ^= 1; \
    } } while (0)
#ifndef PROBE_ITEM
#define PROBE_ITEM -1
#endif
#define PR(t) (PROBE_ITEM == (t) ? 2 : 1)
#define QSPLIT(NT_, C0, C1, C2, C3, T0) int ty_ = 0, loc_ = it, dup_ = 0; { const int cnt_[4] = {C0, C1, C2, C3}; \
    _Pragma("unroll") for (int j_ = 0; j_ < NT_; ++j_) { const int span_ = cnt_[j_] * PR(T0 + j_); if (ty_ == j_) { if (loc_ >= span_) { loc_ -= span_; ty_ = j_ + 1; } else { dup_ = loc_ / cnt_[j_]; loc_ = loc_ % cnt_[j_]; } } } }
#ifndef PROBE_TMASK
#define PROBE_TMASK 0
#endif
#ifndef PROBE_TAMP
#define PROBE_TAMP 4
#endif
#define TSTART(k) do { if (PROBE_TMASK & (1 << (k))) pt0_ = __builtin_amdgcn_s_memrealtime(); } while (0)
#define TEND(k) do { if (PROBE_TMASK & (1 << (k))) ptacc_ += __builtin_amdgcn_s_memrealtime() - pt0_; } while (0)
#ifndef PROBE_REPEAT
#define PROBE_REPEAT -1
#endif
constexpr int N_PHASES = 2 + 9 * NLAYER;
__global__ void __launch_bounds__(NT, 2) hymba_fwd(Args A) {
    extern __shared__ __attribute__((aligned(16))) unsigned char lds_raw[];
    Frame F0;
    F0.lds = (LAS unsigned char*)lds_raw;
    F0.tid = threadIdx.x; F0.lane = 0; F0.wave = __builtin_amdgcn_readfirstlane(F0.tid >> 6);
    F0.G = gridDim.x; F0.bid = blockIdx.x; F0.out = A.out; F0.ws = A.ws;
    volatile LAS unsigned* MISC = (volatile LAS unsigned*)(F0.lds + MISC_OFF);
    if (F0.tid < 64) MISC[F0.tid] = 0u;
    __syncthreads();
    unsigned* barw = (unsigned*)(F0.ws + WS_CTL) + CW_BAR;
    XcdBarrier bar = xcd_barrier_post(barw, MISC + 8, F0.wave == 0 ? 1u : 0u);
    const int lo = A.ph_lo, hi = A.ph_hi;
    unsigned long long pt0_ = 0, ptacc_ = 0;
#define KA (*kargs())
#define IN(k) (lo <= (k) && (k) < hi)
#define SEAM(k) do { if (IN(k) && IN((k) + 1)) xcd_barrier(bar); } while (0)

    TSTART(9); if (IN(0)) for (int rep_ = 0; rep_ < (PROBE_REPEAT == 100 ? 2 : 1); ++rep_) { Frame F = fresh(F0); p0_prologue(F, KA); } SEAM(0); TEND(9);

    TSTART(10); if (IN(1)) { Frame F = fresh(F0); norm0_phase(F, KA); shw_phase(F); } SEAM(1); TEND(10);

#pragma unroll 1
    for (int l = 0; l < NLAYER; ++l) {
        const int pb = 1 + 9 * l;
        TSTART(1); if (IN(pb + 1)) for (int rep_ = 0; rep_ < (PROBE_REPEAT == 1 ? 2 : 1); ++rep_) { Frame F = fresh(F0);
            pg8::Gemm g{WSP(const pg8::bf16_t, WS_H), WSP(const pg8::bf16_t, WS_W1T) + (size_t)l * NPAD * D, M, NPROJ, D}; pg8::StaticOrder S; S.init(M, NPROJ, F.G, F.bid);
            epi::EpiProj E{WSP(pg8::bf16_t, WS_PROJ), WSP(const float, WS_SSQB), WSP(const float, WS_SHW1) + (size_t)l * 5 * NPAD};
            pg8::gemm_phase<epi::EpiProj, pg8::StaticOrder, true, true>(F.lds, g, S, E, F.tid);
            __syncthreads(); gates_phase(F, l);
        } SEAM(pb + 1); TEND(1);
        TSTART(2); if (IN(pb + 2)) { Frame F = fresh(F0);
            QUEUE_LOOP(F, l * 3 + 0, 384 * PR(0) + 768 * PR(1) + 768 * PR(2) + 768 * PR(3), {
                QSPLIT(4, 384, 768, 768, 768, 0);
                if (ty_ == 0) { TSTART(11); ssd_local_item(fresh(F), KA, l, loc_ >> 1, loc_ & 1); TEND(11); }
                else if (ty_ == 1) { TSTART(12); mlstm_local_item(fresh(F), KA, l, loc_ >> 2, loc_ & 3); TEND(12); }
                else if (ty_ == 2) { TSTART(13); ret_local_item(fresh(F), KA, l, loc_ >> 2, loc_ & 3); TEND(13); }
                else { TSTART(14); s5_item<0>(fresh(F), KA, l, loc_ >> 2, loc_ & 3); TEND(14); }
            });
        } SEAM(pb + 2); TEND(2);
        TSTART(3); if (IN(pb + 3)) { Frame F = fresh(F0);
            QUEUE_LOOP(F, l * 3 + 1, 768 * PR(4) + 768 * PR(5) + 768 * PR(6), {
                QSPLIT(3, 768, 768, 768, 0, 4);
                if (ty_ == 0) { TSTART(15); carry_unit<true>(fresh(F), KA, l, loc_); TEND(15); }
                else if (ty_ == 1) { TSTART(16); s5_item<1>(fresh(F), KA, l, loc_ >> 2, loc_ & 3); TEND(16); }
                else { TSTART(17); carry_ctx_batch(fresh(F), KA, l, 768 + loc_ * 8); TEND(17); }
            });
        } SEAM(pb + 3); TEND(3);
        TSTART(4); if (IN(pb + 4)) { Frame F = fresh(F0);
            QUEUE_LOOP(F, l * 3 + 2, 192 * PR(7) + 192 * PR(8) + 768 * PR(9) + 768 * PR(10), {
                QSPLIT(4, 192, 192, 768, 768, 7);
                if (ty_ == 0) { TSTART(18); ssd_out_item(fresh(F), KA, l, loc_, dup_ ? WSP(bf16, WS_MLCLOC) : WSP(bf16, WS_Y)); TEND(18); }
                else if (ty_ == 1) { TSTART(19); Frame Fg = fresh(F);
                    pg8::Gemm g{WSP(const pg8::bf16_t, WS_YA), WSP(const pg8::bf16_t, WS_WGT) + (size_t)l * GWID * GWID, M, GWID, GWID}; OneUnit S; S.u.pm = loc_ >> 1; S.u.pn = loc_ & 1;
                    epi::EpiGlu E{WSP(const pg8::bf16_t, WS_YA), WSP(pg8::bf16_t, WS_Y)};
                    pg8::gemm_phase<epi::EpiGlu, OneUnit, false, true>(Fg.lds, g, S, E, Fg.tid); __syncthreads(); TEND(19); }
                else if (ty_ == 2) { TSTART(20); mlstm_out_item(fresh(F), KA, l, loc_ >> 2, loc_ & 3); TEND(20); }
                else { TSTART(21); ret_out_item(fresh(F), KA, l, loc_ >> 2, loc_ & 3); TEND(21); }
            });
        } SEAM(pb + 4); TEND(4);
        TSTART(5); if (IN(pb + 5)) { Frame F = fresh(F0);
            pg8::Gemm g{WSP(const pg8::bf16_t, WS_Y), WSP(const pg8::bf16_t, WS_WOT) + (size_t)l * D * D, M, D, D}; pg8::StaticOrder S; S.init(M, D, F.G, F.bid);
            KArgs& A_ = KA; epi::EpiRes E{(const float*)(const GAS float*)A_.in[I_XP], (const float*)(const GAS float*)A_.in[I_XS], WSP(pg8::bf16_t, WS_XB), WSP(const float, WS_MOD) + (size_t)(l * 5) * (6 * D) + 2 * D, l == 0 ? 1 : 0,
                          1, WSP(pg8::bf16_t, WS_H), WSP(float, WS_SSQA), (const float*)(const GAS float*)A_.in[I_NORM2] + (size_t)l * D, WSP(const float, WS_MOD) + (size_t)(l * 5) * (6 * D) + 4 * D, F.lds + 131072};
            pg8::gemm_phase<epi::EpiRes, pg8::StaticOrder, true, true>(F.lds, g, S, E, F.tid);
        } SEAM(pb + 5); TEND(5);
        TSTART(7); if (IN(pb + 7)) for (int rep_ = 0; rep_ < (PROBE_REPEAT == 7 ? 2 : 1); ++rep_) { Frame F = fresh(F0);
            pg8::Gemm g{WSP(const pg8::bf16_t, WS_H), WSP(const pg8::bf16_t, WS_WM1T) + (size_t)l * DFF * D, M, DFF, D}; pg8::StaticOrder S; S.init(M, DFF, F.G, F.bid);
            epi::EpiRelu2 E{WSP(pg8::bf16_t, WS_HID), WSP(const float, WS_SSQA), WSP(const float, WS_SHW2) + (size_t)l * 5 * DFF};
            pg8::gemm_phase<epi::EpiRelu2, pg8::StaticOrder, true, true>(F.lds, g, S, E, F.tid);
        } SEAM(pb + 7); TEND(7);
        TSTART(8); if (IN(pb + 8)) { Frame F = fresh(F0);
            pg8::Gemm g{WSP(const pg8::bf16_t, WS_HID), WSP(const pg8::bf16_t, WS_WM2T) + (size_t)l * D * DFF, M, D, DFF}; pg8::StaticOrder S; S.init(M, D, F.G, F.bid);
            KArgs& A_ = KA; epi::EpiRes E{(const float*)(const GAS float*)A_.in[I_XP], (const float*)(const GAS float*)A_.in[I_XS], WSP(pg8::bf16_t, WS_XB), WSP(const float, WS_MOD) + (size_t)(l * 5) * (6 * D) + 5 * D, 0,
                          l < NLAYER - 1 ? 1 : 0, WSP(pg8::bf16_t, WS_H), WSP(float, WS_SSQB), (const float*)(const GAS float*)A_.in[I_NORM1] + (size_t)(l + 1) * D, WSP(const float, WS_MOD) + (size_t)((l + 1) * 5) * (6 * D) + 1 * D, F.lds + 131072};
            pg8::gemm_phase<epi::EpiRes, pg8::StaticOrder, true, true>(F.lds, g, S, E, F.tid);
        } SEAM(pb + 8); TEND(8);
    }
    if (IN(N_PHASES - 1)) { Frame F = fresh(F0); final_norm_phase(F, KA); }
    if (PROBE_IMASK != 0 && F0.bid == 0 && F0.wave == 0 && lane_id() == 0) { const unsigned long long acc_ = ((volatile LAS unsigned long long*)(F0.lds + MISC_OFF + 128))[1], te_ = __builtin_amdgcn_s_memrealtime();
        while (__builtin_amdgcn_s_memrealtime() - te_ < (unsigned long long)PROBE_TAMP * acc_) __builtin_amdgcn_s_sleep(32); }
    if (PROBE_TMASK != 0 && F0.bid == 0) { const unsigned long long te_ = __builtin_amdgcn_s_memrealtime(); while (__builtin_amdgcn_s_memrealtime() - te_ < (unsigned long long)PROBE_TAMP * ptacc_) __builtin_amdgcn_s_sleep(32); }
#undef IN
#undef SEAM
}

#ifndef MK_LAUNCH_PER_PHASE
#define MK_LAUNCH_PER_PHASE 0
#endif
extern "C" void kernel_launch(void* const* d_in, const int* in_sizes, int n_in, void* d_out, int out_size, void* d_ws, size_t ws_size, hipStream_t stream) {
    static int grid = 0;
    if (grid == 0) {
        if (n_in != N_IN || (size_t)out_size != O_END || ws_size < WS_END) { fprintf(stderr, "kernel_launch: shape mismatch: n_in %d out %d ws %zu (need %zu)\n", n_in, out_size, ws_size, (size_t)WS_END); grid = -1; return; }
        int dev = 0, cus = 0, per_cu = 0;
        if (hipGetDevice(&dev) != hipSuccess || hipDeviceGetAttribute(&cus, hipDeviceAttributeMultiprocessorCount, dev) != hipSuccess) { grid = -1; return; }
        if (hipFuncSetAttribute((const void*)hymba_fwd, hipFuncAttributeMaxDynamicSharedMemorySize, LDS_BYTES) != hipSuccess) { fprintf(stderr, "kernel_launch: hipFuncSetAttribute failed\n"); grid = -1; return; }
        if (hipOccupancyMaxActiveBlocksPerMultiprocessor(&per_cu, (const void*)hymba_fwd, NT, LDS_BYTES) != hipSuccess || per_cu < 1) fprintf(stderr, "kernel_launch: occupancy query says %d\n", per_cu);
        (void)hipGetLastError();
        grid = cus;
    }
    if (grid < 0) return;
    (void)hipMemsetAsync((char*)d_ws + WS_CTL, 0, CTL_ZERO_BYTES, stream);
    Args a{};
    for (int i = 0; i < N_IN; ++i) a.in[i] = (const float*)d_in[i];
    a.out = (float*)d_out; a.ws = (unsigned char*)d_ws;
#if MK_LAUNCH_PER_PHASE
    for (int p = 0; p < N_PHASES; ++p) { a.ph_lo = p; a.ph_hi = p + 1; hipLaunchKernelGGL(hymba_fwd, dim3(grid), dim3(NT), LDS_BYTES, stream, a); }
#else
    a.ph_lo = 0; a.ph_hi = N_PHASES;
    hipLaunchKernelGGL(hymba_fwd, dim3(grid), dim3(NT), LDS_BYTES, stream, a);
#endif
    const hipError_t le = hipPeekAtLastError();
    if (le != hipSuccess) fprintf(stderr, "kernel_launch: launch failed: %s\n", hipGetErrorName(le));
}
```

```cpp
#include <hip/hip_runtime.h>
#include <cstdio>
#include <cstdint>
namespace pg8 {
#define PG8_LAS __attribute__((address_space(3)))
typedef unsigned short bf16_t;
typedef short bf16x8 __attribute__((ext_vector_type(8)));
typedef float f32x4 __attribute__((ext_vector_type(4)));
typedef unsigned u32x4 __attribute__((ext_vector_type(4)));
constexpr int BM = 256, BK = 64, HALF = 128, HTB = HALF * BK * 2  , STAGE_BYTES = 8 * HTB, NXCD = 8, WGM = 8;

__host__ __device__ __forceinline__ int lds_byte(int r, int c) { const int st = (r >> 4) * 2 + (c >> 5), rr = r & 15, cc = c & 31, ob = rr * 64 + cc * 2; return st * 1024 + (ob ^ (((ob >> 9) & 1) << 5)); }
__host__ __device__ __forceinline__ void stage_rc(int b, int& R, int& C) { const int st = b / 1024, sb = b % 1024, swz = sb ^ (((sb >> 9) & 1) << 5); R = (st >> 1) * 16 + swz / 64; C = (st & 1) * 32 + (swz % 64) / 2; }
__host__ __device__ __forceinline__ int perm32(int rho) { const int n = rho >> 4, i = rho & 15; return 8 * (i >> 2) + 4 * n + (i & 3); }

struct Unit { int pm, pn; };
struct Gemm { const bf16_t* A; const bf16_t* Bt; int M, N, K; };

struct StaticOrder {
    int nM, nN, nwg, G, c;
    __host__ __device__ void init(int M, int N, int G_, int c_) { nM = M / BM; nN = N / BM; nwg = nM * nN; G = G_; c = c_; }
    __host__ __device__ bool next(int i, Unit& u) const {
        const long L = (long)i * G + c; if (L >= nwg) return false;
        int wgid = (int)L; { const int q = nwg / NXCD, r = nwg % NXCD, xcd = wgid % NXCD, off = wgid / NXCD; wgid = (xcd < r ? xcd * (q + 1) : r * (q + 1) + (xcd - r) * q) + off; }
        const int nig = WGM * nN, gid = wgid / nig, fm = gid * WGM, gsz = (nM - fm) < WGM ? (nM - fm) : WGM;
        u.pm = fm + ((wgid % nig) % gsz); u.pn = (wgid % nig) / gsz; return true;
    }
    __device__ __forceinline__ void a_ready(const Unit&) const {}
    __device__ __forceinline__ void done(const Unit&) const {}
};

__device__ __forceinline__ unsigned cvt_pk_bf16(float lo, float hi) { unsigned r; asm volatile("v_cvt_pk_bf16_f32 %0, %1, %2" : "=v"(r) : "v"(lo), "v"(hi)); return r; }
typedef float f32x2 __attribute__((ext_vector_type(2)));
template <class Epi, class Sched, bool ALIGN_EPI = false, bool SP2 = false>
__device__ __forceinline__ void gemm_phase(PG8_LAS unsigned char* lds, const Gemm g, const Sched& S, const Epi& E, int tid_in) {
    int tid_ = tid_in; asm volatile("" : "+v"(tid_));
    const int tid = tid_, wid = __builtin_amdgcn_readfirstlane(tid >> 6), lane = tid & 63, wr = wid >> 2, wc = wid & 3, fr = lane & 15, fq = lane >> 4;
    const int K = g.K, nt = K / BK;
    unsigned voffA[2], voffB[2];
#pragma unroll
    for (int i = 0; i < 2; ++i) { int R, C; stage_rc(tid * 16 + i * 8192, R, C); const int Rb = Epi::PERM ? ((R & ~31) + perm32(R & 31)) : R;
        voffA[i] = (unsigned)(R * K + C) * 2u; voffB[i] = (unsigned)(Rb * K + C) * 2u; }
    const size_t kstep = (size_t)(BK * 2);
    const size_t hstep = (size_t)HALF * K * 2;
    const size_t tstep = 2 * hstep;
    const unsigned ldsw = (unsigned)wid * 1024u;
    const int aoff = lds_byte(wr * 64 + fr, fq * 8), boff = lds_byte(wc * 32 + fr, fq * 8);
#define PG8_SA(b, h) (((b) * 2 + (h)) * HTB)
#define PG8_SB(b, h) ((4 + (b) * 2 + (h)) * HTB)
#define PG8_STAGE(bufoff, gbase, voff) do { _Pragma("unroll") for (int _i = 0; _i < 2; ++_i) \
        __builtin_amdgcn_global_load_lds((const unsigned*)((const char*)(gbase) + (voff)[_i]), (PG8_LAS unsigned*)(lds + (bufoff) + ldsw + _i * 8192), 16, 0, 0); } while (0)
#define PG8_LDA(dst, b, h) do { _Pragma("unroll") for (int m = 0; m < 4; ++m) _Pragma("unroll") for (int k = 0; k < 2; ++k) dst[m][k] = *(const PG8_LAS bf16x8*)(lds + PG8_SA(b, h) + aoff + m * 2048 + k * 1024); } while (0)
#define PG8_LDB(dst, b, h) do { _Pragma("unroll") for (int n = 0; n < 2; ++n) _Pragma("unroll") for (int k = 0; k < 2; ++k) dst[n][k] = *(const PG8_LAS bf16x8*)(lds + PG8_SB(b, h) + boff + n * 2048 + k * 1024); } while (0)
#define PG8_MMA(ai, bj, At, Bt) do { __builtin_amdgcn_s_setprio(1); _Pragma("unroll") for (int m = 0; m < 4; ++m) _Pragma("unroll") for (int n = 0; n < 2; ++n) _Pragma("unroll") for (int k = 0; k < 2; ++k) \
        acc[ai][bj][m][n] = __builtin_amdgcn_mfma_f32_16x16x32_bf16(Bt[n][k], At[m][k], acc[ai][bj][m][n], 0, 0, 0); __builtin_amdgcn_s_setprio(0); } while (0)
#define PG8_WAIT_V(n) asm volatile("s_waitcnt vmcnt(" #n ")" ::: "memory")
#define PG8_WAIT_L(n) asm volatile("s_waitcnt lgkmcnt(" #n ")" ::: "memory")
#define PG8_BAR __builtin_amdgcn_s_barrier()
#define PG8_SCHED __builtin_amdgcn_sched_barrier(0)
    Unit cur, nxt; int ui = 0;
    if (!S.next(0, cur)) return;
    f32x4 acc[2][2][4][2];
#pragma unroll
    for (int a = 0; a < 2; ++a)
#pragma unroll
        for (int b = 0; b < 2; ++b)
#pragma unroll
            for (int m = 0; m < 4; ++m)
#pragma unroll
                for (int n = 0; n < 2; ++n) acc[a][b][m][n] = (f32x4){0.f, 0.f, 0.f, 0.f};
    bf16x8 At[4][2], B0[2][2], B1[2][2];
    const char* cA = (const char*)g.A + (size_t)cur.pm * tstep; const char* cB = (const char*)g.Bt + (size_t)cur.pn * tstep;
    S.a_ready(cur);
    if constexpr (SP2) {
        PG8_STAGE(PG8_SB(0, 0), cB, voffB); PG8_STAGE(PG8_SB(0, 1), cB + hstep, voffB); PG8_STAGE(PG8_SA(0, 0), cA, voffA); PG8_STAGE(PG8_SA(0, 1), cA + hstep, voffA);
        if (wr == 1) PG8_BAR;
        PG8_WAIT_V(2); PG8_BAR;
        PG8_STAGE(PG8_SB(1, 0), cB + kstep, voffB); PG8_STAGE(PG8_SA(1, 0), cA + kstep, voffA); PG8_STAGE(PG8_SB(1, 1), cB + hstep + kstep, voffB);
        PG8_WAIT_V(6); PG8_BAR;
    } else {
        PG8_STAGE(PG8_SB(0, 0), cB, voffB); PG8_STAGE(PG8_SA(0, 0), cA, voffA); PG8_STAGE(PG8_SB(0, 1), cB + hstep, voffB); PG8_STAGE(PG8_SA(0, 1), cA + hstep, voffA);
        if (wr == 1) PG8_BAR;
        PG8_WAIT_V(4); PG8_BAR;
        PG8_STAGE(PG8_SB(1, 0), cB + kstep, voffB); PG8_STAGE(PG8_SA(1, 0), cA + kstep, voffA); PG8_STAGE(PG8_SB(1, 1), cB + hstep + kstep, voffB);
        PG8_WAIT_V(6); PG8_BAR;
    }
    for (;;) {
        const bool has_next = S.next(ui + 1, nxt);
        const char* nA = has_next ? (const char*)g.A + (size_t)nxt.pm * tstep : cA; const char* nB = has_next ? (const char*)g.Bt + (size_t)nxt.pn * tstep : cB;
        for (int t = 0; t < nt; t += 2) {
            const bool last = (t == nt - 2);
            const char* a1 = cA + (size_t)(t + 1) * kstep;
            const char* a2 = last ? nA : cA + (size_t)(t + 2) * kstep; const char* b2 = last ? nB : cB + (size_t)(t + 2) * kstep;
            const char* a3 = a2 + kstep; const char* b3 = b2 + kstep;
            if (last && has_next) S.a_ready(nxt);
            if constexpr (SP2) {
            PG8_LDB(B0, 0, 0); PG8_LDB(B1, 0, 1); PG8_SCHED; PG8_LDA(At, 0, 0); PG8_STAGE(PG8_SA(1, 1), a1 + hstep, voffA);
            PG8_WAIT_V(8); PG8_WAIT_L(0); PG8_BAR; PG8_MMA(0, 0, At, B0); PG8_MMA(0, 1, At, B1); PG8_BAR; PG8_SCHED;
            PG8_LDA(At, 0, 1); PG8_STAGE(PG8_SB(0, 0), b2, voffB); PG8_STAGE(PG8_SB(0, 1), b2 + hstep, voffB); PG8_STAGE(PG8_SA(0, 0), a2, voffA);
            PG8_WAIT_V(8); PG8_WAIT_L(0); PG8_BAR; PG8_MMA(1, 0, At, B0); PG8_MMA(1, 1, At, B1); PG8_BAR; PG8_SCHED;
            PG8_LDB(B0, 1, 0); PG8_LDB(B1, 1, 1); PG8_SCHED; PG8_LDA(At, 1, 0); PG8_STAGE(PG8_SA(0, 1), a2 + hstep, voffA);
            PG8_WAIT_V(8); PG8_WAIT_L(0); PG8_BAR; PG8_MMA(0, 0, At, B0); PG8_MMA(0, 1, At, B1); PG8_BAR; PG8_SCHED;
            PG8_LDA(At, 1, 1); PG8_STAGE(PG8_SB(1, 0), b3, voffB); PG8_STAGE(PG8_SB(1, 1), b3 + hstep, voffB); PG8_STAGE(PG8_SA(1, 0), a3, voffA);
            PG8_WAIT_V(8); PG8_WAIT_L(0); PG8_BAR; PG8_MMA(1, 0, At, B0); PG8_MMA(1, 1, At, B1); PG8_BAR; PG8_SCHED;
            } else {
            PG8_LDB(B0, 0, 0); PG8_SCHED; PG8_LDA(At, 0, 0); PG8_STAGE(PG8_SA(1, 1), a1 + hstep, voffA);
            PG8_WAIT_L(8); PG8_BAR; PG8_WAIT_L(0); PG8_MMA(0, 0, At, B0); PG8_BAR; PG8_SCHED;
            PG8_LDB(B1, 0, 1); PG8_STAGE(PG8_SB(0, 0), b2, voffB);
            PG8_BAR; PG8_WAIT_L(0); PG8_MMA(0, 1, At, B1); PG8_BAR;
            PG8_LDA(At, 0, 1); PG8_STAGE(PG8_SA(0, 0), a2, voffA);
            PG8_BAR; PG8_WAIT_L(0); PG8_MMA(1, 0, At, B0); PG8_BAR; PG8_SCHED;
            PG8_STAGE(PG8_SB(0, 1), b2 + hstep, voffB);
            PG8_WAIT_V(6); PG8_BAR; PG8_MMA(1, 1, At, B1); PG8_BAR;
            PG8_LDB(B0, 1, 0); PG8_SCHED; PG8_LDA(At, 1, 0); PG8_STAGE(PG8_SA(0, 1), a2 + hstep, voffA);
            PG8_WAIT_L(8); PG8_BAR; PG8_WAIT_L(0); PG8_MMA(0, 0, At, B0); PG8_BAR; PG8_SCHED;
            PG8_LDB(B1, 1, 1); PG8_STAGE(PG8_SB(1, 0), b3, voffB);
            PG8_BAR; PG8_WAIT_L(0); PG8_MMA(0, 1, At, B1); PG8_BAR;
            PG8_LDA(At, 1, 1); PG8_STAGE(PG8_SA(1, 0), a3, voffA);
            PG8_BAR; PG8_WAIT_L(0); PG8_MMA(1, 0, At, B0); PG8_BAR; PG8_SCHED;
            PG8_STAGE(PG8_SB(1, 1), b3 + hstep, voffB);
            PG8_WAIT_V(6); PG8_BAR; PG8_MMA(1, 1, At, B1); PG8_BAR;
            }
        }
        if constexpr (ALIGN_EPI) { if (wr == 0) PG8_BAR; }
        if constexpr (!Epi::AFTER_DRAIN) { E(acc, cur, wr, wc, fr, fq); S.done(cur); }
        if (!has_next) break;
#pragma unroll
        for (int a = 0; a < 2; ++a)
#pragma unroll
            for (int b = 0; b < 2; ++b)
#pragma unroll
                for (int m = 0; m < 4; ++m)
#pragma unroll
                    for (int n = 0; n < 2; ++n) acc[a][b][m][n] = (f32x4){0.f, 0.f, 0.f, 0.f};
        cur = nxt; cA = nA; cB = nB; ++ui;
        if constexpr (ALIGN_EPI) { if (wr == 1) PG8_BAR; }
    }
    PG8_WAIT_V(0);
    if constexpr (!ALIGN_EPI) { if (wr == 0) PG8_BAR; }
    PG8_BAR;
    if constexpr (Epi::AFTER_DRAIN) { E.fused(acc, cur, wr, wc, fr, fq, lds, wid, lane); S.done(cur); }
#undef PG8_SA
#undef PG8_SB
#undef PG8_STAGE
#undef PG8_LDA
#undef PG8_LDB
#undef PG8_MMA
#undef PG8_WAIT_V
#undef PG8_WAIT_L
#undef PG8_BAR
#undef PG8_SCHED
}
}
#define GAS __attribute__((address_space(1)))
#define LAS __attribute__((address_space(3)))
typedef unsigned short bf16;
typedef unsigned v4u __attribute__((ext_vector_type(4)));
typedef float f32x4 __attribute__((ext_vector_type(4)));
typedef short bf16x8 __attribute__((ext_vector_type(8)));
typedef GAS unsigned gu32;
typedef GAS unsigned long long gu64;
#define RLX_AGENT __ATOMIC_RELAXED, __HIP_MEMORY_SCOPE_AGENT
#define LDS_WAIT() asm volatile("s_waitcnt lgkmcnt(0)" ::: "memory")
#define VM_WAIT() asm volatile("s_waitcnt vmcnt(0)" ::: "memory")
__device__ __forceinline__ unsigned long long rt() { return __builtin_amdgcn_s_memrealtime(); }
typedef __bf16 hwbf16x2_t __attribute__((ext_vector_type(2)));
typedef float hwf32x2_t __attribute__((ext_vector_type(2)));
__device__ __forceinline__ unsigned pk2(float lo, float hi) { const hwf32x2_t v = {lo, hi}; const hwbf16x2_t b = __builtin_convertvector(v, hwbf16x2_t); return __builtin_bit_cast(unsigned, b); }
__device__ __forceinline__ unsigned f2bf(float f) { return pk2(f, 0.f) & 0xffffu; }
#define XB_TMO      128
#define XB_XCNT(j)  (256  + 64 * (j))
#define XB_XSUB(j)  (1280 + 64 * (j))
#define XB_XGEN(j)  (2304 + 64 * (j))
#define XB_TOP      3328
#define XB_TOPGEN   3392
#define XCD_BAR_WORDS 3456
#define XB_SPIN_CAP (1u << 18)

__device__ __forceinline__ unsigned xb_ld(unsigned* p)              { return __hip_atomic_load(p, __ATOMIC_RELAXED, __HIP_MEMORY_SCOPE_AGENT); }
__device__ __forceinline__ unsigned xb_add(unsigned* p, unsigned v) { return __hip_atomic_fetch_add(p, v, __ATOMIC_RELAXED, __HIP_MEMORY_SCOPE_AGENT); }
__device__ __forceinline__ unsigned xb_xcc_id() { return (unsigned)__builtin_amdgcn_s_getreg((3 << 11) | 20) & 0xFu; }
#define XB_SPIN(cond, bar) do { unsigned _sp = 0; while (cond) { __builtin_amdgcn_s_sleep(1); \
    if ((++_sp & 255u) == 0u) { if (xb_ld(&(bar)[XB_TMO])) break; if (_sp > XB_SPIN_CAP) { atomicAdd(&(bar)[XB_TMO], 1u); break; } } } } while (0)

struct XcdBarrier {
    unsigned wave0;
    unsigned* bar; unsigned x;
    volatile LAS unsigned* st;
};

__device__ __forceinline__ bool xb_lane0() { return __builtin_amdgcn_mbcnt_hi(~0u, __builtin_amdgcn_mbcnt_lo(~0u, 0u)) == 0u; }
__device__ __forceinline__ XcdBarrier xcd_barrier_post(unsigned* bar, volatile LAS unsigned* st, unsigned wave0) {
    XcdBarrier b; b.wave0 = wave0; b.bar = bar; b.x = xb_xcc_id(); b.st = st;
    if (wave0 && xb_lane0()) (void)xb_add(&bar[XB_XCNT(b.x)], 1u);
    return b;
}
__device__ __forceinline__ void xcd_barrier_complete(unsigned* bar, unsigned x, unsigned& nloc, unsigned& nx) {
    const unsigned G = gridDim.x * gridDim.y * gridDim.z;
    unsigned sum, cnt, mine, sp = 0u;
    for (;;) {
        sum = 0u; cnt = 0u; mine = 0u;
#pragma unroll
        for (unsigned j = 0; j < 16; ++j) { const unsigned c = xb_ld(&bar[XB_XCNT(j)]); sum += c; cnt += (c > 0u) ? 1u : 0u; mine = (j == x) ? c : mine; }
        if (sum == G) break;
        __builtin_amdgcn_s_sleep(1);
        if ((++sp & 255u) == 0u) { if (xb_ld(&bar[XB_TMO])) break; if (sp > XB_SPIN_CAP) { atomicAdd(&bar[XB_TMO], 1u); break; } }
    }
    nloc = mine > 0u ? mine : 1u; nx = cnt > 0u ? cnt : 1u;
}

__device__ __forceinline__ void xcd_barrier(const XcdBarrier& b) {
    asm volatile("s_waitcnt vmcnt(0)" ::: "memory");
    __syncthreads();
    if (b.wave0 && xb_lane0()) {
        unsigned* bar = b.bar;
        __builtin_amdgcn_s_waitcnt(0);
        unsigned nloc = b.st[0], nx = b.st[1];
        if (nloc == 0u) { xcd_barrier_complete(bar, b.x, nloc, nx); b.st[0] = nloc; b.st[1] = nx; }
        const unsigned old = xb_add(&bar[XB_XSUB(b.x)], 1u);
        const unsigned gen = old / nloc;
        if (old + 1u == (gen + 1u) * nloc) {
            __builtin_amdgcn_fence(__ATOMIC_RELEASE, "agent");
            asm volatile("s_waitcnt vmcnt(0)" ::: "memory");
            const unsigned og = xb_add(&bar[XB_TOP], 1u);
            const unsigned tg = og / nx;
            if (og + 1u == (tg + 1u) * nx) xb_add(&bar[XB_TOPGEN], 1u);
            else XB_SPIN(xb_ld(&bar[XB_TOPGEN]) == tg, bar);
            __builtin_amdgcn_fence(__ATOMIC_ACQUIRE, "agent");
            xb_add(&bar[XB_XGEN(b.x)], 1u);
            asm volatile("s_waitcnt vmcnt(0)" ::: "memory");
        } else {
            XB_SPIN(xb_ld(&bar[XB_XGEN(b.x)]) == gen, bar);
            __builtin_amdgcn_fence(__ATOMIC_ACQUIRE, "agent");
            asm volatile("s_waitcnt vmcnt(0)" ::: "memory");
        }
    }
    __syncthreads();
}
constexpr int NWAVES = 8, NT = 512;
constexpr int D = 2048, NLAYER = 4;
constexpr int MC = 32 * 256, ML = 4 * 4096, M = MC + ML;
constexpr int DIN = 6176, NPROJ = 6144, NPAD = 6400, DFF = 8192, GWID = 512;
constexpr int NCP = M / 128;
constexpr float EPS = 1e-6f;
constexpr int PC_S5U = 0, PC_MQ = 512, PC_MK = 1024, PC_MV = 1536, PC_MO = 2048, PC_RQ = 2560, PC_RK = 3072, PC_RV = 3584, PC_RG = 4096, PC_DZ = 4608, PC_DX = 5120, PC_DB = 5632, PC_DC = 5888;
enum { I_XP = 0, I_XS, I_C, I_SS5R, I_SS5I, I_SMC, I_SMN, I_SMM, I_SRET, I_SSSD, I_CCTX, I_NORM1, I_WADA, I_BADA, I_WIN, I_S5LR, I_S5LI, I_S5DT, I_S5BR, I_S5BI, I_S5CR, I_S5CI, I_S5D, I_S5GLU,
       I_MIB, I_MFB, I_MNORM, I_RRATE, I_RNORM, I_CONVW, I_CONVB, I_DTB, I_ALOG, I_SSDD, I_SNORM, I_WOUT, I_NORM2, I_WM1, I_WM2, I_FNORM, N_IN };
constexpr size_t O_YP = 0, O_YS = (size_t)MC * D, O_S5R = (size_t)M * D, O_S5I = O_S5R + 524288, O_MC = O_S5I + 524288, O_MN = O_MC + 16777216, O_MM = O_MN + 131072, O_RET = O_MM + 1024, O_SSD = O_RET + 16777216, O_END = O_SSD + 16777216;

constexpr size_t MiB = 1u << 20;
constexpr size_t WS_CTL = 0, CTL_ZERO_BYTES = 1 * MiB;
constexpr size_t WS_MOD = 1 * MiB;
constexpr size_t WS_S5T = 2 * MiB;
constexpr size_t WS_ROPE = 5 * MiB;
constexpr size_t WS_GATES = 6 * MiB;
constexpr size_t WS_MLNLOC = 9 * MiB;
constexpr size_t WS_MLNIN = 10 * MiB;
constexpr size_t WS_MLSC = 11 * MiB;
constexpr size_t WS_MLMIN = 11 * MiB + 65536;
constexpr size_t WS_SDSC = 11 * MiB + 131072;
constexpr size_t WS_SSQA = 5 * MiB + 65536;
constexpr size_t WS_SSQB = 11 * MiB + 262144;
constexpr size_t WS_SHW1 = 18 * MiB;
constexpr size_t WS_SHW2 = 19 * MiB;
constexpr size_t WS_S5LOC = 12 * MiB;
constexpr size_t WS_WGT = 20 * MiB;
constexpr size_t WS_W1T = 22 * MiB;
constexpr size_t WS_WOT = 122 * MiB;
constexpr size_t WS_WM1T = 154 * MiB;
constexpr size_t WS_WM2T = 282 * MiB;
constexpr size_t WS_H = 410 * MiB;
constexpr size_t WS_Y = 506 * MiB;
constexpr size_t WS_YA = 602 * MiB;
constexpr size_t WS_MLCIN = 626 * MiB;
constexpr size_t WS_RTIN = 674 * MiB;
constexpr size_t WS_SDIN = 722 * MiB;
constexpr size_t WS_PROJ = 770 * MiB;
constexpr size_t WS_MLCLOC = 1058 * MiB;
constexpr size_t WS_HID = 770 * MiB;
constexpr size_t WS_RTLOC = 1106 * MiB;
constexpr size_t WS_SDLOC = 1154 * MiB;
constexpr size_t WS_XBCC = 1202 * MiB;
constexpr size_t WS_XB = 1250 * MiB;
constexpr size_t WS_END = 1346 * MiB;
constexpr int CW_TMO = 0, CW_BAR = 4096;

constexpr int LDT = 272;
constexpr int TS = 128 * LDT;
constexpr int LDX = 144;
constexpr int TSX = 128 * LDX;
constexpr int SCAL_OFF = 4 * TS;
constexpr int MISC_OFF = 163840 - 256;
constexpr int LDS_BYTES = 163840;
#define SCA(i) ((LAS float*)(F.lds + SCAL_OFF + (i) * 512))
typedef float f32x16 __attribute__((ext_vector_type(16)));
typedef float f32x2 __attribute__((ext_vector_type(2)));
typedef short s16x4 __attribute__((ext_vector_type(4)));
typedef unsigned u32x2 __attribute__((ext_vector_type(2)));
struct Args { const float* in[N_IN]; float* out; unsigned char* ws; int ph_lo, ph_hi; };
struct Frame {
    LAS unsigned char* lds;
    float* out; unsigned char* ws;
    int tid, lane, wave, G, bid;
};
__device__ __forceinline__ int lane_id() { return (int)__builtin_amdgcn_mbcnt_hi(~0u, __builtin_amdgcn_mbcnt_lo(~0u, 0u)); }
typedef const __attribute__((address_space(4))) Args KArgs;
__device__ __forceinline__ KArgs* kargs() { KArgs* p = (KArgs*)__builtin_amdgcn_kernarg_segment_ptr(); asm volatile("" : "+s"(p)); return p; }
__device__ __forceinline__ Frame fresh(const Frame& F) { Frame R = F; unsigned long long l = (unsigned long long)(size_t)R.lds; unsigned ll = (unsigned)l; asm volatile("" : "+s"(ll), "+s"(R.wave), "+s"(R.G), "+s"(R.bid)); R.lane = lane_id(); asm volatile("" : "+v"(R.lane)); R.tid = R.wave * 64 + R.lane; R.lds = (LAS unsigned char*)(size_t)ll; KArgs* ka = kargs(); R.out = (float*)(GAS float*)ka->out; R.ws = (unsigned char*)(GAS unsigned char*)ka->ws; return R; }
#define INP(i) ((const float*)(const GAS float*)(A.in[i]))
#define BAR() __syncthreads()
#ifndef PROBE_IMASK
#define PROBE_IMASK 0
#endif
#define ITS(k) do { if ((PROBE_IMASK >> (k)) & 1) { if (F.tid == 0 && F.bid == 0) ((volatile LAS unsigned long long*)(F.lds + MISC_OFF + 128))[0] = __builtin_amdgcn_s_memrealtime(); } } while (0)
#define ITE(k) do { if ((PROBE_IMASK >> (k)) & 1) { if (F.tid == 0 && F.bid == 0) { volatile LAS unsigned long long* p_ = (volatile LAS unsigned long long*)(F.lds + MISC_OFF + 128); p_[1] += __builtin_amdgcn_s_memrealtime() - p_[0]; } } } while (0)
#define WSP(T, off) ((T*)(F.ws + (off)))
__device__ __forceinline__ float bf2f(unsigned short b) { return __uint_as_float((unsigned)b << 16); }
__device__ __forceinline__ float bflo(unsigned w) { return __uint_as_float(w << 16); }
__device__ __forceinline__ float bfhi(unsigned w) { return __uint_as_float(w & 0xffff0000u); }
__device__ __forceinline__ void unpack8(const v4u a, float (&x)[8]) { x[0] = bflo(a.x); x[1] = bfhi(a.x); x[2] = bflo(a.y); x[3] = bfhi(a.y); x[4] = bflo(a.z); x[5] = bfhi(a.z); x[6] = bflo(a.w); x[7] = bfhi(a.w); }
__device__ __forceinline__ v4u pack8(const float (&x)[8], float w) { v4u o; o.x = pk2(x[0] * w, x[1] * w); o.y = pk2(x[2] * w, x[3] * w); o.z = pk2(x[4] * w, x[5] * w); o.w = pk2(x[6] * w, x[7] * w); return o; }
__device__ __forceinline__ float sigmoidf_(float x) { return __builtin_amdgcn_rcpf(1.f + __expf(-x)); }
__device__ __forceinline__ float siluf_(float x) { return x * sigmoidf_(x); }
__device__ __forceinline__ float lshfl(float v, int src_lane) { return __builtin_bit_cast(float, __builtin_amdgcn_ds_bpermute(src_lane << 2, __builtin_bit_cast(int, v))); }
__device__ __forceinline__ float lshfl_xor(float v, int m, int lane) { return lshfl(v, lane ^ m); }
__device__ __forceinline__ float lshfl_up(float v, int o, int lane) { return lshfl(v, lane >= o ? lane - o : lane); }
__device__ __forceinline__ float wave_sum(float v) {
#pragma unroll
    for (int o = 1; o < 64; o <<= 1) v += __shfl_xor(v, o);
    return v;
}
__device__ __forceinline__ float wave_max(float v) {
#pragma unroll
    for (int o = 1; o < 64; o <<= 1) v = fmaxf(v, __shfl_xor(v, o));
    return v;
}
__device__ __forceinline__ float wave_sum_l(float v, int lane) {
#pragma unroll
    for (int o = 1; o < 64; o <<= 1) v += lshfl_xor(v, o, lane);
    return v;
}
__device__ __forceinline__ float wave_max_l(float v, int lane) {
#pragma unroll
    for (int o = 1; o < 64; o <<= 1) v = fmaxf(v, lshfl_xor(v, o, lane));
    return v;
}
template <bool MAX> __device__ __forceinline__ void wave_scan128(const LAS float* in, LAS float* out, int lane, bool rev, float init) {
    const int i0 = rev ? 127 - 2 * lane : 2 * lane, i1 = rev ? i0 - 1 : i0 + 1;
    float e0 = in[i0], e1 = in[i1];
    if (lane == 0) e0 = MAX ? fmaxf(e0, init) : e0 + init;
    float inc = MAX ? fmaxf(e0, e1) : e0 + e1;
#pragma unroll
    for (int o = 1; o < 64; o <<= 1) { const float t = __shfl_up(inc, o); if (lane >= o) inc = MAX ? fmaxf(inc, t) : inc + t; }
    float exc = __shfl_up(inc, 1);
    const float o0 = (lane == 0) ? e0 : (MAX ? fmaxf(exc, e0) : exc + e0);
    out[i0] = o0; out[i1] = inc;
}
__device__ __forceinline__ s16x4 lds_tr(const LAS unsigned char* p) {
    typedef short v4i16_t __attribute__((ext_vector_type(4)));
    return __builtin_bit_cast(s16x4, __builtin_amdgcn_ds_read_tr16_b64_v4i16((LAS v4i16_t*)p));
}
__device__ __forceinline__ bf16x8 frag_row(const LAS unsigned char* base, int ld, int r0, int k0, int lane) {
    return *(const LAS bf16x8*)(base + (r0 + (lane & 31)) * ld + (k0 + 8 * (lane >> 5)) * 2);
}
__device__ __forceinline__ bf16x8 frag_tr(const LAS unsigned char* base, int ld, int k0, int c0, int lane) {
    const int h = lane >> 5, blk = (lane >> 4) & 1, q = (lane & 15) >> 2, p = lane & 3;
    const LAS unsigned char* a = base + (k0 + 8 * h + q) * ld + (c0 + 16 * blk + 4 * p) * 2;
    const s16x4 lo = lds_tr(a), hi = lds_tr(a + 4 * ld);
    return (bf16x8){lo[0], lo[1], lo[2], lo[3], hi[0], hi[1], hi[2], hi[3]};
}
__device__ __forceinline__ bf16x8 frag_trp(const LAS unsigned char* base, int ld, int k0, int c0, int lane) {
    const int h = lane >> 5, blk = (lane >> 4) & 1, q = (lane & 15) >> 2, p = lane & 3;
    const LAS unsigned char* a = base + (k0 + 4 * h + q) * ld + (c0 + 16 * blk + 4 * p) * 2;
    const s16x4 lo = lds_tr(a), hi = lds_tr(a + 8 * ld);
    return (bf16x8){lo[0], lo[1], lo[2], lo[3], hi[0], hi[1], hi[2], hi[3]};
}
#define MFMA32(a, b, c) __builtin_amdgcn_mfma_f32_32x32x16_bf16((a), (b), (c), 0, 0, 0)
#define ZERO16 ((f32x16){0.f,0.f,0.f,0.f,0.f,0.f,0.f,0.f,0.f,0.f,0.f,0.f,0.f,0.f,0.f,0.f})
__device__ __forceinline__ int crow(int i, int hh) { return (i & 3) + 8 * (i >> 2) + 4 * hh; }

#define PT(cp, col) (WSP(const bf16, WS_PROJ) + ((size_t)(cp) * 48 + ((col) >> 7)) * 16384 + ((col) & 127))
#define XT(cp, ch) (WSP(bf16, WS_XBCC) + ((size_t)(cp) * 8 + ((ch) >> 7)) * 16384 + ((ch) & 127))
__device__ __forceinline__ const float* x_in_row(const Frame& F, KArgs& A, int l, int r) {
    if (l == 0) return r < MC ? INP(I_XP) + (size_t)r * D : INP(I_XS) + (size_t)(r - MC) * D;
    return F.out + (size_t)r * D;
}
__device__ __forceinline__ int mod_row(int r) { return r < MC ? 0 : 1 + (r - MC) / 4096; }
__device__ __forceinline__ const float* mod_ptr(const Frame& F, int l, int mrow, int part) { return WSP(const float, WS_MOD) + ((size_t)(l * 5 + mrow) * 6 + part) * D; }
struct Seq { int cp0, nch, c, b, lat; };
__device__ __forceinline__ Seq seq_of(int cp) { Seq s; if (cp < 64) { s.lat = 0; s.b = cp >> 1; s.cp0 = cp & ~1; s.nch = 2; s.c = cp & 1; } else { s.lat = 1; s.b = (cp - 64) >> 5; s.cp0 = 64 + (s.b << 5); s.nch = 32; s.c = (cp - 64) & 31; } return s; }
__device__ __forceinline__ int w1_newcol(int n) { return n < 2560 ? n : (n < 2576 ? n - 2560 + 6144 : (n < 6160 ? n - 16 : n)); }
template <bool MAPW1> __device__ __forceinline__ void p0_transpose_item(const float* W, int K, int N, bf16* WT, LAS float* scr, int item, int lane) {
    const int nblk = N / 32, kb = item / nblk, nb = item % nblk, k0 = 64 * kb, n0 = 32 * nb;
#pragma unroll 8
    for (int i = 0; i < 32; ++i) { const int kk = 2 * i + (lane >> 5); scr[kk * 33 + (lane & 31)] = W[(size_t)(k0 + kk) * N + n0 + (lane & 31)]; }
    LDS_WAIT(); asm volatile("" ::: "memory");
    const int c = lane & 7;
#pragma unroll
    for (int j = 0; j < 4; ++j) { const int n = (lane >> 3) + 8 * j; const LAS float* s = scr + (8 * c) * 33 + n;
        v4u o; o.x = pk2(s[0 * 33], s[1 * 33]); o.y = pk2(s[2 * 33], s[3 * 33]); o.z = pk2(s[4 * 33], s[5 * 33]); o.w = pk2(s[6 * 33], s[7 * 33]);
        const int nr = MAPW1 ? w1_newcol(n0 + n) : (n0 + n);
        *(GAS v4u*)(WT + (size_t)nr * K + k0 + 8 * c) = o; }
    LDS_WAIT(); asm volatile("" ::: "memory");
}
constexpr int S5T_STRIDE = 9216;
__device__ __forceinline__ unsigned char* s5tab(const Frame& F, int l, int d, int g) { return F.ws + WS_S5T + (size_t)((l * 2 + d) * 32 + g) * S5T_STRIDE; }

__device__ __forceinline__ void p0_prologue(Frame& F, KArgs& A) {
    {
        LAS float* scr = (LAS float*)(F.lds + F.wave * 16384);
        const int gw = F.bid * NWAVES + F.wave, NGW = F.G * NWAVES;
        constexpr int I_1 = (D / 64) * (DIN / 32), I_G = (GWID / 64) * (GWID / 32), I_O = (D / 64) * (D / 32), I_M1 = (D / 64) * (DFF / 32), I_M2 = (DFF / 64) * (D / 32);
        constexpr int PER_L = I_1 + I_G + I_O + I_M1 + I_M2;
        for (int it = gw; it < NLAYER * PER_L; it += NGW) {
            const int l = it / PER_L; int r = it % PER_L;
            if (r < I_1) { p0_transpose_item<true>(INP(I_WIN) + (size_t)l * D * DIN, D, DIN, WSP(bf16, WS_W1T) + (size_t)l * NPAD * D, scr, r, F.lane); continue; } r -= I_1;
            if (r < I_G) { p0_transpose_item<false>(INP(I_S5GLU) + (size_t)l * GWID * GWID, GWID, GWID, WSP(bf16, WS_WGT) + (size_t)l * GWID * GWID, scr, r, F.lane); continue; } r -= I_G;
            if (r < I_O) { p0_transpose_item<false>(INP(I_WOUT) + (size_t)l * D * D, D, D, WSP(bf16, WS_WOT) + (size_t)l * D * D, scr, r, F.lane); continue; } r -= I_O;
            if (r < I_M1) { p0_transpose_item<false>(INP(I_WM1) + (size_t)l * D * DFF, D, DFF, WSP(bf16, WS_WM1T) + (size_t)l * DFF * D, scr, r, F.lane); continue; } r -= I_M1;
            p0_transpose_item<false>(INP(I_WM2) + (size_t)l * DFF * D, DFF, D, WSP(bf16, WS_WM2T) + (size_t)l * D * DFF, scr, r, F.lane);
        }
        const int gt = F.bid * NT + F.tid, NGT = F.G * NT;
        for (int i = gt; i < NLAYER * 224 * 256; i += NGT) { const int l = i / (224 * 256), r = i % (224 * 256);
            *(GAS v4u*)(WSP(bf16, WS_W1T) + ((size_t)l * NPAD + DIN) * D + (size_t)r * 8) = (v4u){0u, 0u, 0u, 0u}; }
        for (int i = gt; i < NLAYER * 2 * 32 * 64; i += NGT) {
            const int p = i & 63, g = (i >> 6) & 31, d = (i >> 11) & 1, l = i >> 12;
            const int ldg = (l * 2 + d) * 32 + g;
            const double lre = INP(I_S5LR)[ldg * 64 + p], lim = INP(I_S5LI)[ldg * 64 + p], dt = exp((double)INP(I_S5DT)[ldg]);
            const double er = exp(lre * dt), br = er * cos(lim * dt), bi = er * sin(lim * dt);
            const double e128 = exp(128.0 * lre * dt), b128r = e128 * cos(128.0 * lim * dt), b128i = e128 * sin(128.0 * lim * dt);
            const double nr = br - 1.0, ni = bi, den = lre * lre + lim * lim;
            const double cr = (nr * lre + ni * lim) / den, ci = (ni * lre - nr * lim) / den;
            unsigned char* tb = s5tab(F, l, d, g);
            float* lam = (float*)tb; lam[2 * p] = (float)br; lam[2 * p + 1] = (float)bi;
            float* l128 = (float*)(tb + 512); l128[2 * p] = (float)b128r; l128[2 * p + 1] = (float)b128i;
            bf16* bb = (bf16*)(tb + 1024); bf16* ct = (bf16*)(tb + 5120);
            for (int c = 0; c < 16; ++c) {
                const double Br = INP(I_S5BR)[(size_t)(ldg * 64 + p) * 16 + c], Bi = INP(I_S5BI)[(size_t)(ldg * 64 + p) * 16 + c];
                bb[(2 * p) * 16 + c] = (bf16)f2bf((float)(cr * Br - ci * Bi));
                bb[(2 * p + 1) * 16 + c] = (bf16)f2bf((float)(cr * Bi + ci * Br));
                ct[c * 128 + 2 * p] = (bf16)f2bf(INP(I_S5CR)[(size_t)(ldg * 16 + c) * 64 + p]);
                ct[c * 128 + 2 * p + 1] = (bf16)f2bf(-INP(I_S5CI)[(size_t)(ldg * 16 + c) * 64 + p]);
            }
        }
        for (int i = gt; i < 64 * 32; i += NGT) { const int pos = i >> 5, k = i & 31; const double f = pow(10000.0, -(double)k / 32.0), a = pos * f;
            WSP(f32x2, WS_ROPE)[i] = (f32x2){(float)cos(a), (float)sin(a)}; }
    }
    __syncthreads();
    {
        LAS float* sc = (LAS float*)F.lds;
        LAS float* red = (LAS float*)(F.lds + 65536);
        for (int i = F.tid; i < 5 * D; i += NT) { const int r = i / D, k = i % D; const float v = r == 0 ? INP(I_CCTX)[k] : INP(I_C)[(r - 1) * D + k]; sc[i] = siluf_(v); }
        __syncthreads();
        for (int it = F.bid; it < NLAYER * 96; it += F.G) {
            const int l = it / 96, c0 = (it % 96) * 128;
            const float* W = INP(I_WADA) + (size_t)l * D * (6 * D);
            float acc[5][4];
#pragma unroll
            for (int r = 0; r < 5; ++r)
#pragma unroll
                for (int j = 0; j < 4; ++j) acc[r][j] = 0.f;
            const int cl = F.lane & 31, kp = F.lane >> 5;
#pragma unroll 4
            for (int kk = 0; kk < 128; ++kk) {
                const int k = F.wave * 256 + 2 * kk + kp;
                const f32x4 w = *(const f32x4*)(W + (size_t)k * (6 * D) + c0 + 4 * cl);
#pragma unroll
                for (int r = 0; r < 5; ++r) { const float s = sc[r * D + k]; acc[r][0] += s * w.x; acc[r][1] += s * w.y; acc[r][2] += s * w.z; acc[r][3] += s * w.w; }
            }
#pragma unroll
            for (int r = 0; r < 5; ++r)
#pragma unroll
                for (int j = 0; j < 4; ++j) { acc[r][j] += __shfl_xor(acc[r][j], 32); }
            if (kp == 0) {
#pragma unroll
                for (int r = 0; r < 5; ++r)
#pragma unroll
                    for (int j = 0; j < 4; ++j) red[(F.wave * 5 + r) * 128 + 4 * cl + j] = acc[r][j];
            }
            __syncthreads();
            for (int i = F.tid; i < 5 * 128; i += NT) { const int r = i >> 7, j = i & 127; float s = 0.f;
#pragma unroll
                for (int w = 0; w < 8; ++w) s += red[(w * 5 + r) * 128 + j];
                WSP(float, WS_MOD)[(size_t)(l * 5 + r) * (6 * D) + c0 + j] = s + INP(I_BADA)[(size_t)l * (6 * D) + c0 + j]; }
            __syncthreads();
        }
    }
}

__device__ __forceinline__ void norm0_phase(Frame& F, KArgs& A) {
    const int gw = F.bid * NWAVES + F.wave, NGW = F.G * NWAVES;
    const float* gain = INP(I_NORM1);
    for (int m = gw; m < M; m += NGW) {
        const float* xr = x_in_row(F, A, 0, m);
        const float* scp = mod_ptr(F, 0, mod_row(m), 1);
        f32x4 v[8]; float s = 0.f;
#pragma unroll
        for (int j = 0; j < 8; ++j) { v[j] = *(const f32x4*)(xr + 4 * F.lane + 256 * j); s += (v[j].x * v[j].x + v[j].y * v[j].y) + (v[j].z * v[j].z + v[j].w * v[j].w); }
        s = wave_sum(s);
        if (F.lane < 8) WSP(float, WS_SSQB)[(size_t)m * 8 + F.lane] = F.lane == 0 ? s : 0.f;
        bf16* orow = WSP(bf16, WS_H) + (size_t)m * D;
#pragma unroll
        for (int j = 0; j < 8; ++j) { const int c = 4 * F.lane + 256 * j;
            const f32x4 g4 = *(const f32x4*)(gain + c), s4 = *(const f32x4*)(scp + c);
            *(u32x2*)(orow + c) = (u32x2){pk2(v[j].x * g4.x * (1.f + s4.x), v[j].y * g4.y * (1.f + s4.y)), pk2(v[j].z * g4.z * (1.f + s4.z), v[j].w * g4.w * (1.f + s4.w))}; }
    }
}
__device__ __forceinline__ void shw_phase(Frame& F) {
    LAS float* red = (LAS float*)F.lds;
    const int hh = F.lane >> 5, r = F.lane & 31, k0 = F.wave * 256;
    constexpr int NB1 = DIN / 32, NB2 = DFF / 32, PER_L = NB1 + NB2;
    for (int task = F.bid; task < NLAYER * PER_L; task += F.G) {
        const int l = task / PER_L, t2 = task % PER_L, which = t2 >= NB1 ? 1 : 0, nb = which ? t2 - NB1 : t2;
        const int NS = which ? DFF : NPAD;
        const bf16* Wt = (which ? WSP(const bf16, WS_WM1T) + (size_t)l * DFF * D : WSP(const bf16, WS_W1T) + (size_t)l * NPAD * D) + (size_t)(32 * nb + r) * D + k0 + 8 * hh;
        const float* sh = WSP(const float, WS_MOD) + ((size_t)(l * 5 + (r < 5 ? r : 0)) * 6 + (which ? 3 : 0)) * D + k0 + 8 * hh;
        bf16x8 bw[16];
#pragma unroll
        for (int ks = 0; ks < 16; ++ks) bw[ks] = *(const bf16x8*)(Wt + 16 * ks);
        f32x16 acc = ZERO16;
#pragma unroll
        for (int ks = 0; ks < 16; ++ks) { v4u a = (v4u){0u, 0u, 0u, 0u};
            if (r < 5) { const f32x4 s0 = *(const f32x4*)(sh + 16 * ks), s1 = *(const f32x4*)(sh + 16 * ks + 4); a = (v4u){pk2(s0.x, s0.y), pk2(s0.z, s0.w), pk2(s1.x, s1.y), pk2(s1.z, s1.w)}; }
            acc = MFMA32(__builtin_bit_cast(bf16x8, a), bw[ks], acc); }
        if (hh == 0) { red[(F.wave * 5 + 0) * 32 + r] = acc[0]; red[(F.wave * 5 + 1) * 32 + r] = acc[1]; red[(F.wave * 5 + 2) * 32 + r] = acc[2]; red[(F.wave * 5 + 3) * 32 + r] = acc[3]; }
        else red[(F.wave * 5 + 4) * 32 + r] = acc[0];
        __syncthreads();
        if (F.tid < 160) { const int row = F.tid >> 5, col = F.tid & 31; float s = 0.f;
#pragma unroll
            for (int w = 0; w < 8; ++w) s += red[(w * 5 + row) * 32 + col];
            (which ? WSP(float, WS_SHW2) + (size_t)l * 5 * DFF : WSP(float, WS_SHW1) + (size_t)l * 5 * NPAD)[(size_t)row * NS + 32 * nb + col] = s; }
        __syncthreads();
    }
}
__device__ __forceinline__ void final_norm_phase(Frame& F, KArgs& A) {
    const int gw = F.bid * NWAVES + F.wave, NGW = F.G * NWAVES;
    const float* gain = INP(I_FNORM);
    for (int m = gw; m < M; m += NGW) {
        const bf16* xr = WSP(const bf16, WS_XB) + (size_t)m * D; float* orow = F.out + (size_t)m * D;
        float v[4][8]; float s = 0.f;
#pragma unroll
        for (int j = 0; j < 4; ++j) { unpack8(*(const v4u*)(xr + 8 * F.lane + 512 * j), v[j]);
#pragma unroll
            for (int k = 0; k < 8; ++k) s += v[j][k] * v[j][k]; }
        const float rstd = rsqrtf(wave_sum(s) * (1.f / D) + EPS);
#pragma unroll
        for (int j = 0; j < 4; ++j) { const int c = 8 * F.lane + 512 * j; const f32x4 g0 = *(const f32x4*)(gain + c), g1 = *(const f32x4*)(gain + c + 4);
            *(f32x4*)(orow + c) = (f32x4){v[j][0] * rstd * g0.x, v[j][1] * rstd * g0.y, v[j][2] * rstd * g0.z, v[j][3] * rstd * g0.w};
            *(f32x4*)(orow + c + 4) = (f32x4){v[j][4] * rstd * g1.x, v[j][5] * rstd * g1.y, v[j][6] * rstd * g1.z, v[j][7] * rstd * g1.w}; }
    }
}

__device__ __forceinline__ void gates_phase(Frame& F, int l) {
    const bf16* XA = WSP(const bf16, WS_H); const bf16* Wg = WSP(const bf16, WS_W1T) + ((size_t)l * NPAD + NPROJ) * D;
    const float* shw = WSP(const float, WS_SHW1) + (size_t)l * 5 * NPAD + NPROJ;
    const int hh = F.lane >> 5, r = F.lane & 31, k0 = F.wave * 256;
    LAS float* red = (LAS float*)F.lds;
    bf16x8 bw[16];
#pragma unroll
    for (int ks = 0; ks < 16; ++ks) bw[ks] = *(const bf16x8*)(Wg + (size_t)r * D + k0 + 16 * ks + 8 * hh);
    for (int rb = F.bid; rb < M / 32; rb += F.G) {
        f32x16 acc = ZERO16;
#pragma unroll
        for (int half = 0; half < 2; ++half) { bf16x8 a[8];
#pragma unroll
            for (int j = 0; j < 8; ++j) a[j] = *(const bf16x8*)(XA + (size_t)(32 * rb + r) * D + k0 + 16 * (8 * half + j) + 8 * hh);
#pragma unroll
            for (int j = 0; j < 8; ++j) acc = MFMA32(a[j], bw[8 * half + j], acc); }
#pragma unroll
        for (int i = 0; i < 16; ++i) red[(F.wave * 32 + crow(i, hh)) * 33 + r] = acc[i];
        BAR();
#pragma unroll
        for (int q = 0; q < 2; ++q) { const int idx = F.tid * 2 + q, row = idx >> 5, col = idx & 31; float s = 0.f;
#pragma unroll
            for (int w = 0; w < 8; ++w) s += red[(w * 32 + row) * 33 + col];
            const int grow = 32 * rb + row; const float* part = WSP(const float, WS_SSQB) + (size_t)grow * 8;
            const float ssq = ((part[0] + part[1]) + (part[2] + part[3])) + ((part[4] + part[5]) + (part[6] + part[7]));
            WSP(float, WS_GATES)[(size_t)grow * 32 + col] = s * rsqrtf(ssq * (1.f / D) + EPS) + shw[(size_t)mod_row(grow) * NPAD + col]; }
        BAR();
    }
}
namespace epi {
__device__ __forceinline__ float rstd_of(const float* part, int r) { const pg8::f32x4 a = *(const pg8::f32x4*)(part + (size_t)r * 8), b = *(const pg8::f32x4*)(part + (size_t)r * 8 + 4);
    return rsqrtf((((a[0] + a[1]) + (a[2] + a[3])) + ((b[0] + b[1]) + (b[2] + b[3]))) * (1.f / D) + EPS); }
using pg8::Unit; using pg8::f32x4; using pg8::u32x4; using pg8::bf16_t; using pg8::cvt_pk_bf16;
constexpr int BMq = 256, HALFq = 128;
struct EpiProj {
    static constexpr bool PERM = true, AFTER_DRAIN = false;
    bf16_t* P; const float* ssq; const float* shw0;
    __device__ __forceinline__ void operator()(const f32x4 (&acc)[2][2][4][2], const Unit& u, int wr, int wc, int fr_, int fq_) const {
        int ln_ = (int)__builtin_amdgcn_mbcnt_hi(~0u, __builtin_amdgcn_mbcnt_lo(~0u, 0u)); asm volatile("" : "+v"(ln_)); const int fr = ln_ & 15, fq = ln_ >> 4; (void)fr_; (void)fq_;
        const int row0 = u.pm * BMq + wr * 64 + fr, rowt = u.pm * BMq, col0 = u.pn * BMq + wc * 32 + 8 * fq;
        const float* shw = shw0 + (size_t)(rowt < MC ? 0 : 1 + (rowt - MC) / 4096) * NPAD + col0;
        f32x4 sh[2][2];
#pragma unroll
        for (int bj = 0; bj < 2; ++bj) { sh[bj][0] = *(const f32x4*)(shw + bj * HALFq); sh[bj][1] = *(const f32x4*)(shw + bj * HALFq + 4); }
#pragma unroll
        for (int ai = 0; ai < 2; ++ai)
#pragma unroll
            for (int m = 0; m < 4; ++m) { const int r = row0 + ai * HALFq + m * 16; bf16_t* rowp = P + (((size_t)(r >> 7) * 48 + (col0 >> 7)) * 128 + (r & 127)) * 128 + (col0 & 127); const float rs = rstd_of(ssq, r);
#pragma unroll
                for (int bj = 0; bj < 2; ++bj) { const f32x4 v0 = acc[ai][bj][m][0] * rs + sh[bj][0], v1 = acc[ai][bj][m][1] * rs + sh[bj][1];
                    u32x4 w; w.x = cvt_pk_bf16(v0[0], v0[1]); w.y = cvt_pk_bf16(v0[2], v0[3]); w.z = cvt_pk_bf16(v1[0], v1[1]); w.w = cvt_pk_bf16(v1[2], v1[3]);
                    *(u32x4*)(rowp + bj * 16384) = w; } }
    }
};
struct EpiGlu {
    static constexpr bool PERM = true, AFTER_DRAIN = false;
    const bf16_t* YA; bf16_t* Y;
    __device__ __forceinline__ void operator()(const f32x4 (&acc)[2][2][4][2], const Unit& u, int wr, int wc, int fr_, int fq_) const {
        int ln_ = (int)__builtin_amdgcn_mbcnt_hi(~0u, __builtin_amdgcn_mbcnt_lo(~0u, 0u)); asm volatile("" : "+v"(ln_)); const int fr = ln_ & 15, fq = ln_ >> 4; (void)fr_; (void)fq_;
        const int row0 = u.pm * BMq + wr * 64 + fr, col0 = u.pn * BMq + wc * 32 + 8 * fq;
#pragma unroll
        for (int ai = 0; ai < 2; ++ai)
#pragma unroll
            for (int m = 0; m < 4; ++m) { const int r = row0 + ai * HALFq + m * 16;
#pragma unroll
                for (int bj = 0; bj < 2; ++bj) { const f32x4 v0 = acc[ai][bj][m][0], v1 = acc[ai][bj][m][1];
                    const u32x4 a = *(const u32x4*)(YA + (size_t)r * GWID + col0 + bj * HALFq);
                    float y[8] = {bflo(a.x), bfhi(a.x), bflo(a.y), bfhi(a.y), bflo(a.z), bfhi(a.z), bflo(a.w), bfhi(a.w)};
                    const float g[8] = {v0[0], v0[1], v0[2], v0[3], v1[0], v1[1], v1[2], v1[3]};
#pragma unroll
                    for (int k = 0; k < 8; ++k) y[k] = y[k] * sigmoidf_(g[k]);
                    u32x4 w; w.x = cvt_pk_bf16(y[0], y[1]); w.y = cvt_pk_bf16(y[2], y[3]); w.z = cvt_pk_bf16(y[4], y[5]); w.w = cvt_pk_bf16(y[6], y[7]);
                    *(u32x4*)(Y + (size_t)r * D + col0 + bj * HALFq) = w; } }
    }
};
struct EpiRes {
    static constexpr bool PERM = true, AFTER_DRAIN = false;
    const float* xp; const float* xs; bf16_t* XB; const float* gate0; int first;
    int NEXT; bf16_t* XA; float* ssq; const float* gn; const float* scn0; PG8_LAS unsigned char* scr;
    __device__ __forceinline__ void operator()(const f32x4 (&acc)[2][2][4][2], const Unit& u, int wr, int wc, int fr_, int fq_) const {
        int ln_ = (int)__builtin_amdgcn_mbcnt_hi(~0u, __builtin_amdgcn_mbcnt_lo(~0u, 0u)); asm volatile("" : "+v"(ln_)); const int fr = ln_ & 15, fq = ln_ >> 4; (void)fr_; (void)fq_;
        const int rowt = u.pm * BMq, col0 = u.pn * BMq + wc * 32 + 8 * fq;
        const int mrow = rowt < MC ? 0 : 1 + (rowt - MC) / 4096;
        const float* gate = gate0 + (size_t)mrow * (6 * D);
        const float* basef = rowt < MC ? xp + (size_t)rowt * D : xs + (size_t)(rowt - MC) * D;
        bf16_t* xb = XB + (size_t)rowt * D;
        float ss[2][4];
#pragma unroll
        for (int ai = 0; ai < 2; ++ai)
#pragma unroll
            for (int m = 0; m < 4; ++m) ss[ai][m] = 0.f;
#pragma unroll
        for (int bj = 0; bj < 2; ++bj) { const int c = col0 + bj * HALFq; const f32x4 g0 = *(const f32x4*)(gate + c), g1 = *(const f32x4*)(gate + c + 4);
            f32x4 a0 = (f32x4){0.f, 0.f, 0.f, 0.f}, a1 = a0;
            if (NEXT) { const float* scn = scn0 + (size_t)mrow * (6 * D); a0 = *(const f32x4*)(gn + c) * (*(const f32x4*)(scn + c) + 1.f); a1 = *(const f32x4*)(gn + c + 4) * (*(const f32x4*)(scn + c + 4) + 1.f); }
#pragma unroll
            for (int ai = 0; ai < 2; ++ai)
#pragma unroll
                for (int m = 0; m < 4; ++m) { const size_t off = (size_t)(wr * 64 + fr + ai * HALFq + m * 16) * D + c;
                    f32x4 b0, b1;
                    if (first) { b0 = *(const f32x4*)(basef + off); b1 = *(const f32x4*)(basef + off + 4); }
                    else { const u32x4 w = *(const u32x4*)(xb + off); b0 = (f32x4){bflo(w.x), bfhi(w.x), bflo(w.y), bfhi(w.y)}; b1 = (f32x4){bflo(w.z), bfhi(w.z), bflo(w.w), bfhi(w.w)}; }
                    const f32x4 x0 = b0 + g0 * acc[ai][bj][m][0], x1 = b1 + g1 * acc[ai][bj][m][1];
                    u32x4 xw; xw.x = cvt_pk_bf16(x0[0], x0[1]); xw.y = cvt_pk_bf16(x0[2], x0[3]); xw.z = cvt_pk_bf16(x1[0], x1[1]); xw.w = cvt_pk_bf16(x1[2], x1[3]);
                    *(u32x4*)(xb + off) = xw;
                    if (NEXT) { const f32x4 r0 = (f32x4){bflo(xw.x), bfhi(xw.x), bflo(xw.y), bfhi(xw.y)}, r1 = (f32x4){bflo(xw.z), bfhi(xw.z), bflo(xw.w), bfhi(xw.w)};
                        ss[ai][m] += (r0[0] * r0[0] + r0[1] * r0[1]) + (r0[2] * r0[2] + r0[3] * r0[3]) + (r1[0] * r1[0] + r1[1] * r1[1]) + (r1[2] * r1[2] + r1[3] * r1[3]);
                        const f32x4 y0 = r0 * a0, y1 = r1 * a1; u32x4 w; w.x = cvt_pk_bf16(y0[0], y0[1]); w.y = cvt_pk_bf16(y0[2], y0[3]); w.z = cvt_pk_bf16(y1[0], y1[1]); w.w = cvt_pk_bf16(y1[2], y1[3]);
                        *(u32x4*)(XA + (size_t)rowt * D + off) = w; }
                    if (m & 1) asm volatile("" ::: "memory"); } }
        if (NEXT) {
            PG8_LAS float* P4 = (PG8_LAS float*)scr;
#pragma unroll
            for (int ai = 0; ai < 2; ++ai)
#pragma unroll
                for (int m = 0; m < 4; ++m) { float s = ss[ai][m]; s += __shfl_xor(s, 16); s += __shfl_xor(s, 32);
                    if (fq == 0) P4[(ai * HALFq + wr * 64 + m * 16 + fr) * 4 + wc] = s; }
            asm volatile("s_waitcnt lgkmcnt(0)\n\ts_barrier" ::: "memory");
            { const int tid = (wr * 4 + wc) * 64 + fq * 16 + fr;
              if (tid < 256) { const f32x4 p = *(const PG8_LAS f32x4*)(P4 + tid * 4); ssq[(size_t)(rowt + tid) * 8 + u.pn] = (p[0] + p[1]) + (p[2] + p[3]); } }
            asm volatile("s_waitcnt lgkmcnt(0)\n\ts_barrier" ::: "memory");
        }
    }
};
struct EpiRelu2 {
    static constexpr bool PERM = true, AFTER_DRAIN = false;
    bf16_t* O; const float* ssq; const float* shw0;
    __device__ __forceinline__ void operator()(const f32x4 (&acc)[2][2][4][2], const Unit& u, int wr, int wc, int fr_, int fq_) const {
        int ln_ = (int)__builtin_amdgcn_mbcnt_hi(~0u, __builtin_amdgcn_mbcnt_lo(~0u, 0u)); asm volatile("" : "+v"(ln_)); const int fr = ln_ & 15, fq = ln_ >> 4; (void)fr_; (void)fq_;
        const int row0 = u.pm * BMq + wr * 64 + fr, col0 = u.pn * BMq + wc * 32 + 8 * fq, rowt = u.pm * BMq;
        const float* shw = shw0 + (size_t)(rowt < MC ? 0 : 1 + (rowt - MC) / 4096) * DFF + col0;
        f32x4 sh[2][2];
#pragma unroll
        for (int bj = 0; bj < 2; ++bj) { sh[bj][0] = *(const f32x4*)(shw + bj * HALFq); sh[bj][1] = *(const f32x4*)(shw + bj * HALFq + 4); }
#pragma unroll
        for (int ai = 0; ai < 2; ++ai)
#pragma unroll
            for (int m = 0; m < 4; ++m) { const int r = row0 + ai * HALFq + m * 16; bf16_t* rowp = O + (size_t)r * DFF + col0; const float rs = rstd_of(ssq, r);
#pragma unroll
                for (int bj = 0; bj < 2; ++bj) { f32x4 v0 = acc[ai][bj][m][0] * rs + sh[bj][0], v1 = acc[ai][bj][m][1] * rs + sh[bj][1];
#pragma unroll
                    for (int k = 0; k < 4; ++k) { const float a = fmaxf(v0[k], 0.f), b = fmaxf(v1[k], 0.f); v0[k] = a * a; v1[k] = b * b; }
                    u32x4 w; w.x = cvt_pk_bf16(v0[0], v0[1]); w.y = cvt_pk_bf16(v0[2], v0[3]); w.z = cvt_pk_bf16(v1[0], v1[1]); w.w = cvt_pk_bf16(v1[2], v1[3]);
                    *(u32x4*)(rowp + bj * HALFq) = w; } }
    }
};
}
__device__ __forceinline__ float logsigmoidf_(float x) { return fminf(x, 0.f) - __logf(1.f + __expf(-fabsf(x))); }
__device__ __forceinline__ float softplusf_(float x) { return fmaxf(x, 0.f) + __logf(1.f + __expf(-fabsf(x))); }
__device__ __forceinline__ void load_tile128(Frame& F, LAS unsigned char* dst, const bf16* src) {
#pragma unroll
    for (int it = 0; it < 4; ++it) { const int i = F.tid + NT * it, r = i >> 4, c = i & 15;
        *(LAS v4u*)(dst + r * LDT + c * 16) = *(const v4u*)(src + (size_t)r * 128 + c * 8); }
}
__device__ __forceinline__ void qk_issue(Frame& F, const bf16* src, v4u (&r)[4]) {
#pragma unroll
    for (int it = 0; it < 2; ++it) { const int i = F.tid + NT * it, rw = i >> 3, c = i & 7;
        r[2 * it] = *(const v4u*)(src + (size_t)rw * 128 + c * 8); r[2 * it + 1] = *(const v4u*)(src + (size_t)rw * 128 + 64 + c * 8); }
}
template <int NDST> __device__ __forceinline__ void qk_commit(Frame& F, LAS unsigned char* dst0, LAS unsigned char* dst1, const v4u (&rg)[4], const LAS float* w0, const LAS float* w1, float scale, bool rope, int tpos0) {
#pragma unroll
    for (int it = 0; it < 2; ++it) {
        const int i = F.tid + NT * it, r = i >> 3, c = i & 7;
        float x1[8], x2[8];
        unpack8(rg[2 * it], x1); unpack8(rg[2 * it + 1], x2);
        if (rope) {
            const int tp = tpos0 + r, pos = c < 4 ? (tp >> 6) : (tp & 63);
            const f32x2* rt = WSP(const f32x2, WS_ROPE) + pos * 32 + ((8 * c) & 31);
#pragma unroll
            for (int j = 0; j < 8; ++j) { const f32x2 cs = rt[j]; const float a = x1[j], b = x2[j]; x1[j] = a * cs.x - b * cs.y; x2[j] = a * cs.y + b * cs.x; }
        }
        const float s0 = scale * (w0 ? w0[r] : 1.f);
        *(LAS v4u*)(dst0 + r * LDT + c * 16) = pack8(x1, s0); *(LAS v4u*)(dst0 + r * LDT + 128 + c * 16) = pack8(x2, s0);
        if (NDST == 2) { const float s1 = scale * w1[r];
            *(LAS v4u*)(dst1 + r * LDT + c * 16) = pack8(x1, s1); *(LAS v4u*)(dst1 + r * LDT + 128 + c * 16) = pack8(x2, s1); }
    }
}
template <int NDST> __device__ __forceinline__ void load_qk(Frame& F, LAS unsigned char* dst0, LAS unsigned char* dst1, const bf16* src, const LAS float* w0, const LAS float* w1, float scale, bool rope, int tpos0) {
    v4u r[4]; qk_issue(F, src, r); qk_commit<NDST>(F, dst0, dst1, r, w0, w1, scale, rope, tpos0);
}
template <int NDST, int nc8> __device__ __forceinline__ void load_conv(Frame& F, KArgs& A, int l, LAS unsigned char* dst0, LAS unsigned char* dst1, int ldd, int ch0, int row0, int seq_lo, int seq_hi,
                                                               const LAS float* w0, const LAS float* w1, bool to_global) {
    const float* cw = INP(I_CONVW) + (size_t)l * 5 * 1024 + ch0; const float* cb = INP(I_CONVB) + (size_t)l * 1024 + ch0;
    for (int i = F.tid; i < 128 * nc8; i += NT) {
        const int r = i / nc8, c = i % nc8, row = row0 + r;
        float acc[8];
        { const f32x4 b0 = *(const f32x4*)(cb + 8 * c), b1 = *(const f32x4*)(cb + 8 * c + 4); acc[0] = b0.x; acc[1] = b0.y; acc[2] = b0.z; acc[3] = b0.w; acc[4] = b1.x; acc[5] = b1.y; acc[6] = b1.z; acc[7] = b1.w; }
#pragma unroll
        for (int k = 0; k < 5; ++k) { const int rr = row + k - 2;
            if (rr >= seq_lo && rr < seq_hi) { float x[8]; unpack8(*(const v4u*)(PT(rr >> 7, PC_DX + ch0 + 8 * c) + (size_t)(rr & 127) * 128), x);
                const f32x4 w0v = *(const f32x4*)(cw + k * 1024 + 8 * c), w1v = *(const f32x4*)(cw + k * 1024 + 8 * c + 4);
                acc[0] += x[0] * w0v.x; acc[1] += x[1] * w0v.y; acc[2] += x[2] * w0v.z; acc[3] += x[3] * w0v.w; acc[4] += x[4] * w1v.x; acc[5] += x[5] * w1v.y; acc[6] += x[6] * w1v.z; acc[7] += x[7] * w1v.w; } }
#pragma unroll
        for (int j = 0; j < 8; ++j) acc[j] = siluf_(acc[j]);
        if (to_global) *(v4u*)(XT(row >> 7, ch0 + 8 * c) + (size_t)(row & 127) * 128) = pack8(acc, 1.f);
        if (NDST >= 1) *(LAS v4u*)(dst0 + r * ldd + c * 16) = pack8(acc, w0 ? w0[r] : 1.f);
        if (NDST == 2) *(LAS v4u*)(dst1 + r * ldd + c * 16) = pack8(acc, w1[r]);
    }
}
template <int nc8> __device__ __forceinline__ void load_xbcc(Frame& F, LAS unsigned char* dst, int ldd, int ch0, int row0) {
    const bf16* P = XT(row0 >> 7, ch0);
    for (int i = F.tid; i < 128 * nc8; i += NT) { const int r = i / nc8, c = i % nc8; *(LAS v4u*)(dst + r * ldd + c * 16) = *(const v4u*)(P + (size_t)r * 128 + 8 * c); }
}
__device__ __forceinline__ void kv_state_mfma(Frame& F, const LAS unsigned char* TKf, const LAS unsigned char* TKb, const LAS unsigned char* TV, bf16* outF, bf16* outB) {
    const int dvb = F.wave >> 1, dkb0 = (F.wave & 1) * 2, hh = F.lane >> 5;
    f32x16 acc[2][2] = {{ZERO16, ZERO16}, {ZERO16, ZERO16}};
#pragma unroll 1
    for (int ks = 0; ks < 8; ++ks) {
        const bf16x8 a = frag_tr(TV, LDT, 16 * ks, 32 * dvb, F.lane);
#pragma unroll
        for (int j = 0; j < 2; ++j) { acc[0][j] = MFMA32(a, frag_tr(TKf, LDT, 16 * ks, 32 * (dkb0 + j), F.lane), acc[0][j]); acc[1][j] = MFMA32(a, frag_tr(TKb, LDT, 16 * ks, 32 * (dkb0 + j), F.lane), acc[1][j]); }
    }
#pragma unroll
    for (int j = 0; j < 2; ++j)
#pragma unroll
        for (int i = 0; i < 16; ++i) { const int o = (32 * dvb + crow(i, hh)) * 128 + 32 * (dkb0 + j) + (F.lane & 31); outF[o] = (bf16)f2bf(acc[0][j][i]); outB[o] = (bf16)f2bf(acc[1][j][i]); }
}
__device__ __forceinline__ void qkT_mfma(Frame& F, const LAS unsigned char* TQ, const LAS unsigned char* TK, f32x16 (&qk)[2]) {
    const int tb = F.wave >> 1, sb0 = (F.wave & 1) * 2;
    qk[0] = ZERO16; qk[1] = ZERO16;
#pragma unroll 1
    for (int ks = 0; ks < 8; ++ks) { const bf16x8 bq = frag_row(TQ, LDT, 32 * tb, 16 * ks, F.lane);
#pragma unroll
        for (int j = 0; j < 2; ++j) qk[j] = MFMA32(frag_row(TK, LDT, 32 * (sb0 + j), 16 * ks, F.lane), bq, qk[j]); }
}
__device__ __forceinline__ void pv_mfma(Frame& F, const LAS unsigned char* TP, const LAS unsigned char* TV, f32x16 (&o)[2]) {
    const int tb = F.wave >> 1, eb0 = (F.wave & 1) * 2;
#pragma unroll 1
    for (int ks = 0; ks < 8; ++ks) { const bf16x8 ap = frag_row(TP, LDT, 32 * tb, 16 * ks, F.lane);
#pragma unroll
        for (int j = 0; j < 2; ++j) o[j] = MFMA32(ap, frag_tr(TV, LDT, 16 * ks, 32 * (eb0 + j), F.lane), o[j]); }
}
__device__ __forceinline__ void pv_mfma_range(Frame& F, const LAS unsigned char* TP, const LAS unsigned char* TV, f32x16 (&o)[2], int k_lo, int k_hi) {
    const int tb = F.wave >> 1, eb0 = (F.wave & 1) * 2;
#pragma unroll 1
    for (int ks = k_lo; ks < k_hi; ++ks) { const bf16x8 ap = frag_row(TP, LDT, 32 * tb, 16 * ks, F.lane);
#pragma unroll
        for (int j = 0; j < 2; ++j) o[j] = MFMA32(ap, frag_tr(TV, LDT, 16 * ks, 32 * (eb0 + j), F.lane), o[j]); }
}
__device__ __forceinline__ void qs_prefetch(Frame& F, const bf16* ST, bf16x8 (&b)[2][8]) {
    const int eb0 = (F.wave & 1) * 2, hh = F.lane >> 5;
#pragma unroll
    for (int j = 0; j < 2; ++j)
#pragma unroll
        for (int ks = 0; ks < 8; ++ks) b[j][ks] = *(const bf16x8*)(ST + (size_t)(32 * (eb0 + j) + (F.lane & 31)) * 128 + 16 * ks + 8 * hh);
}
__device__ __forceinline__ void qs_mfma(Frame& F, const LAS unsigned char* TQ, const bf16x8 (&b)[2][8], f32x16 (&o)[2]) {
    const int tb = F.wave >> 1;
#pragma unroll
    for (int ks = 0; ks < 8; ++ks) { const bf16x8 aq = frag_row(TQ, LDT, 32 * tb, 16 * ks, F.lane);
#pragma unroll
        for (int j = 0; j < 2; ++j) o[j] = MFMA32(aq, b[j][ks], o[j]); }
}
__device__ __forceinline__ void hs_to_lds(Frame& F, LAS unsigned char* HS, const f32x16 (&hs)[2]) {
    const int tb = F.wave >> 1, eb0 = (F.wave & 1) * 2, hh = F.lane >> 5;
#pragma unroll
    for (int j = 0; j < 2; ++j)
#pragma unroll
        for (int i = 0; i < 16; ++i) *(LAS float*)(HS + (32 * tb + crow(i, hh)) * 528 + (32 * (eb0 + j) + (F.lane & 31)) * 4) = hs[j][i];
}
template <int GATE> __device__ __forceinline__ void head_out(Frame& F, const LAS unsigned char* HS, const float* gain, const bf16* gsrc  , bf16* ydst  ) {
    const int t = F.tid >> 2, seg = F.tid & 3;
    float v[32]; float ss = 0.f;
#pragma unroll
    for (int k = 0; k < 8; ++k) { const f32x4 x = *(const LAS f32x4*)(HS + t * 528 + (32 * seg + 4 * k) * 4); v[4 * k] = x.x; v[4 * k + 1] = x.y; v[4 * k + 2] = x.z; v[4 * k + 3] = x.w; ss += (x.x * x.x + x.y * x.y) + (x.z * x.z + x.w * x.w); }
    ss += __shfl_xor(ss, 1); ss += __shfl_xor(ss, 2);
    const float r = rsqrtf(ss * (1.f / 128.f) + EPS);
#pragma unroll
    for (int k = 0; k < 4; ++k) { float g[8]; unpack8(*(const v4u*)(gsrc + (size_t)t * 128 + 32 * seg + 8 * k), g); float o[8];
#pragma unroll
        for (int j = 0; j < 8; ++j) { const float gg = GATE == 0 ? sigmoidf_(g[j]) : siluf_(g[j]); o[j] = v[8 * k + j] * r * gain[32 * seg + 8 * k + j] * gg; }
        *(v4u*)(ydst + (size_t)t * D + 32 * seg + 8 * k) = pack8(o, 1.f); }
}

__device__ __forceinline__ void tile_issue(Frame& F, const bf16* src, v4u (&r)[4]) {
#pragma unroll
    for (int it = 0; it < 4; ++it) { const int i = F.tid + NT * it; r[it] = *(const v4u*)(src + (size_t)(i >> 4) * 128 + (i & 15) * 8); }
}
__device__ __forceinline__ void tile_commit(Frame& F, LAS unsigned char* dst, const v4u (&r)[4], float scale) {
#pragma unroll
    for (int it = 0; it < 4; ++it) { const int i = F.tid + NT * it; v4u v = r[it];
        if (scale != 1.f) { float x[8]; unpack8(v, x); v = pack8(x, scale); }
        *(LAS v4u*)(dst + (i >> 4) * LDT + (i & 15) * 16) = v; }
}
template <int GATE> __device__ __forceinline__ void head_out_r(Frame& F, const LAS unsigned char* HS, const float* gain, const v4u (&og)[4], bf16* ydst) {
    const int t = F.tid >> 2, seg = F.tid & 3;
    float v[32]; float ss = 0.f;
#pragma unroll
    for (int k = 0; k < 8; ++k) { const f32x4 x = *(const LAS f32x4*)(HS + t * 528 + (32 * seg + 4 * k) * 4); v[4 * k] = x.x; v[4 * k + 1] = x.y; v[4 * k + 2] = x.z; v[4 * k + 3] = x.w; ss += (x.x * x.x + x.y * x.y) + (x.z * x.z + x.w * x.w); }
    ss += __shfl_xor(ss, 1); ss += __shfl_xor(ss, 2);
    const float r = rsqrtf(ss * (1.f / 128.f) + EPS);
#pragma unroll
    for (int k = 0; k < 4; ++k) { float g[8]; unpack8(og[k], g); float o[8]; const f32x4 g0 = *(const f32x4*)(gain + 32 * seg + 8 * k), g1 = *(const f32x4*)(gain + 32 * seg + 8 * k + 4);
        const float gn[8] = {g0.x, g0.y, g0.z, g0.w, g1.x, g1.y, g1.z, g1.w};
#pragma unroll
        for (int j = 0; j < 8; ++j) { const float gg = GATE == 0 ? sigmoidf_(g[j]) : siluf_(g[j]); o[j] = v[8 * k + j] * r * gn[j] * gg; }
        *(v4u*)(ydst + (size_t)t * D + 32 * seg + 8 * k) = pack8(o, 1.f); }
}
__device__ __forceinline__ void mlstm_gates(Frame& F, KArgs& A, int l, int cp, int h) {
    if (F.tid < 128) { const float* g = WSP(const float, WS_GATES) + (size_t)(cp * 128 + F.tid) * 32;
        SCA(0)[F.tid] = g[h] + INP(I_MIB)[(l * 2 + 0) * 4 + h]; SCA(1)[F.tid] = g[4 + h] + INP(I_MIB)[(l * 2 + 1) * 4 + h];
        SCA(2)[F.tid] = logsigmoidf_(g[8 + h] + INP(I_MFB)[(l * 2 + 0) * 4 + h]); SCA(3)[F.tid] = logsigmoidf_(g[12 + h] + INP(I_MFB)[(l * 2 + 1) * 4 + h]); }
    BAR();
    if (F.wave == 0) wave_scan128<false>(SCA(2), SCA(4), F.lane, false, 0.f);
    if (F.wave == 1) wave_scan128<false>(SCA(3), SCA(5), F.lane, true, 0.f);
    BAR();
}
__device__ __forceinline__ void mlstm_local_item(Frame F, KArgs& A, int l, int cp, int h) {
    v4u rk[4], rv[4]; qk_issue(F, PT(cp, PC_MK + h * 128), rk); tile_issue(F, PT(cp, PC_MV + h * 128), rv);
    mlstm_gates(F, A, l, cp, h);
    if (F.wave < 2) { const int d = F.wave; const LAS float* bc = SCA(4 + d); const LAS float* ig = SCA(d); const float tot = d == 0 ? bc[127] : bc[0];
        const int s0 = 2 * F.lane; const float g0 = tot - bc[s0] + ig[s0], g1 = tot - bc[s0 + 1] + ig[s0 + 1];
        const float mx = wave_max(fmaxf(g0, g1));
        SCA(6 + d)[s0] = __expf(g0 - mx); SCA(6 + d)[s0 + 1] = __expf(g1 - mx);
        if (F.lane == 0) { float* sc = WSP(float, WS_MLSC) + ((cp * 2 + d) * 4 + h) * 2; sc[0] = tot; sc[1] = mx; } }
    BAR();
    qk_commit<2>(F, F.lds, F.lds + TS, rk, SCA(6), SCA(7), 0.08838834764831845f, false, 0);
    tile_commit(F, F.lds + 2 * TS, rv, 1.f);
    BAR();
    kv_state_mfma(F, F.lds, F.lds + TS, F.lds + 2 * TS, WSP(bf16, WS_MLCLOC) + (size_t)((cp * 2 + 0) * 4 + h) * 16384, WSP(bf16, WS_MLCLOC) + (size_t)((cp * 2 + 1) * 4 + h) * 16384);
    if (F.tid < 256) { const int d = F.tid >> 7, dk = F.tid & 127; const LAS unsigned char* T = F.lds + d * TS; float s = 0.f;
        for (int r = 0; r < 128; ++r) s += bf2f(*(const LAS unsigned short*)(T + r * LDT + dk * 2));
        WSP(float, WS_MLNLOC)[((cp * 2 + d) * 4 + h) * 128 + dk] = s; }
    BAR();
}
__device__ __forceinline__ void mlstm_out_item(Frame F, KArgs& A, int l, int cp, int h) {
    const Seq sq = seq_of(cp);
    LAS unsigned char* TQ = F.lds; LAS unsigned char* TK = F.lds + TS; LAS unsigned char* TV = F.lds + 2 * TS; LAS unsigned char* TP = F.lds + 3 * TS;
    ITS(0);
    v4u rq[4], rk[4], rv[4], og[4];
    tile_issue(F, PT(cp, PC_MQ + h * 128), rq); tile_issue(F, PT(cp, PC_MK + h * 128), rk); tile_issue(F, PT(cp, PC_MV + h * 128), rv);
    { const int t = F.tid >> 2, seg = F.tid & 3;
#pragma unroll
      for (int k = 0; k < 4; ++k) og[k] = *(const v4u*)(PT(cp, PC_MO + h * 128) + (size_t)t * 128 + 32 * seg + 8 * k); }
    const float min_f = WSP(const float, WS_MLMIN)[(cp * 2 + 0) * 4 + h], min_b = WSP(const float, WS_MLMIN)[(cp * 2 + 1) * 4 + h];
    float nin = 0.f; if (F.tid < 256) nin = WSP(const float, WS_MLNIN)[((cp * 2 + (F.tid >> 7)) * 4 + h) * 128 + (F.tid & 127)];
    mlstm_gates(F, A, l, cp, h);
    if (F.tid < 256) { const int d = F.tid >> 7, s = F.tid & 127; SCA(6 + d)[s] = SCA(d)[s] - SCA(4 + d)[s]; SCA(12 + d)[s] = nin; }
    tile_commit(F, TQ, rq, 1.f); tile_commit(F, TK, rk, 0.08838834764831845f); tile_commit(F, TV, rv, 1.f);
    BAR();
    if (F.wave == 0) wave_scan128<true>(SCA(6), SCA(8), F.lane, false, min_f);
    if (F.wave == 1) wave_scan128<true>(SCA(7), SCA(9), F.lane, true, min_b);
    BAR();
    ITE(0);
    f32x16 hs[2] = {ZERO16, ZERO16};
    const int tb = F.wave >> 1, sb0 = (F.wave & 1) * 2, hh = F.lane >> 5, t = 32 * tb + (F.lane & 31);
#pragma unroll 1
    for (int d = 0; d < 2; ++d) {
        const LAS float* av = SCA(6 + d); const float Mt = SCA(8 + d)[t]; const float m_in = d == 0 ? min_f : min_b;
        ITS(2);
        const bool has_state = sq.lat || (d == 0 ? sq.c > 0 : sq.c < sq.nch - 1);
        bf16x8 bst[2][8]; if (has_state) qs_prefetch(F, WSP(const bf16, WS_MLCIN) + (size_t)((cp * 2 + d) * 4 + h) * 16384, bst);
#ifndef PROBE_REP2
#define PROBE_REP2 1
#endif
#pragma unroll 1
        for (int rep2_ = 0; rep2_ < PROBE_REP2; ++rep2_) {
        f32x16 qk[2]; qkT_mfma(F, TQ, TK, qk);
#pragma unroll
        for (int j = 0; j < 2; ++j) { const int sblk = sb0 + j;
            if (d == 0 ? sblk > tb : sblk < tb) continue;
            const bool diag = sblk == tb;
#pragma unroll
            for (int i4 = 0; i4 < 4; ++i4) { const int sb = 32 * sblk + 8 * i4 + 4 * hh; float p[4]; const f32x4 a4 = *(const LAS f32x4*)(av + sb);
#pragma unroll
                for (int i = 0; i < 4; ++i) p[i] = qk[j][4 * i4 + i] * __expf(a4[i] - Mt);
                if (diag) {
#pragma unroll
                    for (int i = 0; i < 4; ++i) { const int s = sb + i; const bool ok = d == 0 ? (s <= t) : (s >= t); p[i] = ok ? p[i] : 0.f; } }
                *(LAS u32x2*)(TP + t * LDT + sb * 2) = (u32x2){pk2(p[0], p[1]), pk2(p[2], p[3])}; } }
        }
        ITE(2); ITS(3);
        BAR();
        {
            const int tt = F.tid >> 2, seg = F.tid & 3; float ds = 0.f, qn = 0.f;
            const bool pvalid = d == 0 ? seg <= (tt >> 5) : seg >= (tt >> 5);
#pragma unroll
            for (int k = 0; k < 4; ++k) { float x[8]; unpack8(pvalid ? *(const LAS v4u*)(TP + tt * LDT + 64 * seg + 16 * k) : (v4u){0u, 0u, 0u, 0u}, x); float q[8]; unpack8(*(const LAS v4u*)(TQ + tt * LDT + 64 * seg + 16 * k), q);
                const f32x4 n0 = *(const LAS f32x4*)(SCA(12 + d) + 32 * seg + 8 * k), n1 = *(const LAS f32x4*)(SCA(12 + d) + 32 * seg + 8 * k + 4);
                ds += ((x[0] + x[1]) + (x[2] + x[3])) + ((x[4] + x[5]) + (x[6] + x[7]));
                qn += (q[0] * n0.x + q[1] * n0.y) + (q[2] * n0.z + q[3] * n0.w) + (q[4] * n1.x + q[5] * n1.y) + (q[6] * n1.z + q[7] * n1.w); }
            ds += __shfl_xor(ds, 1); ds += __shfl_xor(ds, 2); qn += __shfl_xor(qn, 1); qn += __shfl_xor(qn, 2);
            if (seg == 0) { const float Mtt = SCA(8 + d)[tt], wint = __expf(m_in - Mtt), den = ds + wint * qn, dd = fmaxf(fabsf(den), __expf(-(SCA(4 + d)[tt] + Mtt)));
                const float rdd = __builtin_amdgcn_rcpf(dd); SCA(10)[tt] = wint * rdd; SCA(11)[tt] = rdd; } }
        { f32x16 num[2] = {ZERO16, ZERO16};
          pv_mfma_range(F, TP, TV, num, d == 0 ? 0 : 2 * tb, d == 0 ? 2 * tb + 2 : 8);
          BAR(); ITE(3); ITS(4);
#pragma unroll
          for (int j = 0; j < 2; ++j)
#pragma unroll
            for (int k4 = 0; k4 < 4; ++k4) { const f32x4 f4 = *(const LAS f32x4*)(SCA(11) + 32 * tb + 8 * k4 + 4 * hh);
#pragma unroll
                for (int i = 0; i < 4; ++i) hs[j][4 * k4 + i] += f4[i] * num[j][4 * k4 + i]; } }
        if (has_state) { f32x16 qc[2] = {ZERO16, ZERO16};
          qs_mfma(F, TQ, bst, qc);
#pragma unroll
          for (int j = 0; j < 2; ++j)
#pragma unroll
            for (int k4 = 0; k4 < 4; ++k4) { const f32x4 f4 = *(const LAS f32x4*)(SCA(10) + 32 * tb + 8 * k4 + 4 * hh);
#pragma unroll
                for (int i = 0; i < 4; ++i) hs[j][4 * k4 + i] += f4[i] * qc[j][4 * k4 + i]; } }
        ITE(4);
    }
    ITS(5);
    BAR();
    hs_to_lds(F, F.lds, hs);
    BAR();
    head_out_r<0>(F, F.lds, INP(I_MNORM) + (size_t)l * GWID + h * 128, og, WSP(bf16, WS_Y) + (size_t)cp * 128 * D + 512 + h * 128);
    BAR(); ITE(5);
}

__device__ __forceinline__ void ret_local_item(Frame F, KArgs& A, int l, int cp, int h) {
    const float lgf = -__expf(INP(I_RRATE)[(l * 2 + 0) * 4 + h]), lgb = -__expf(INP(I_RRATE)[(l * 2 + 1) * 4 + h]);
    v4u rk[4], rv[4]; qk_issue(F, PT(cp, PC_RK + h * 128), rk); tile_issue(F, PT(cp, PC_RV + h * 128), rv);
    if (F.tid < 128) { SCA(6)[F.tid] = __expf((127.f - (float)F.tid) * lgf); SCA(7)[F.tid] = __expf((float)F.tid * lgb); }
    BAR();
    const Seq sq = seq_of(cp);
    qk_commit<2>(F, F.lds, F.lds + TS, rk, SCA(6), SCA(7), 0.08838834764831845f, sq.lat != 0, sq.c * 128);
    tile_commit(F, F.lds + 2 * TS, rv, 1.f);
    BAR();
    kv_state_mfma(F, F.lds, F.lds + TS, F.lds + 2 * TS, WSP(bf16, WS_RTLOC) + (size_t)((cp * 2 + 0) * 4 + h) * 16384, WSP(bf16, WS_RTLOC) + (size_t)((cp * 2 + 1) * 4 + h) * 16384);
    BAR();
}
__device__ __forceinline__ void ret_out_item(Frame F, KArgs& A, int l, int cp, int h) {
    const float lgf = -__expf(INP(I_RRATE)[(l * 2 + 0) * 4 + h]), lgb = -__expf(INP(I_RRATE)[(l * 2 + 1) * 4 + h]);
    if (F.tid < 128) { SCA(10)[F.tid] = __expf(((float)F.tid + 1.f) * lgf); SCA(11)[F.tid] = __expf((128.f - (float)F.tid) * lgb); }
    const Seq sq = seq_of(cp);
    LAS unsigned char* TQ = F.lds; LAS unsigned char* TK = F.lds + TS; LAS unsigned char* TV = F.lds + 2 * TS; LAS unsigned char* TP = F.lds + 3 * TS;
    v4u rq[4], rk[4], rv[4], og[4];
    qk_issue(F, PT(cp, PC_RQ + h * 128), rq); qk_issue(F, PT(cp, PC_RK + h * 128), rk); tile_issue(F, PT(cp, PC_RV + h * 128), rv);
    { const int t_ = F.tid >> 2, seg_ = F.tid & 3;
#pragma unroll
      for (int k = 0; k < 4; ++k) og[k] = *(const v4u*)(PT(cp, PC_RG + h * 128) + (size_t)t_ * 128 + 32 * seg_ + 8 * k); }
    qk_commit<1>(F, TQ, nullptr, rq, nullptr, nullptr, 1.f, sq.lat != 0, sq.c * 128);
    qk_commit<1>(F, TK, nullptr, rk, nullptr, nullptr, 0.08838834764831845f, sq.lat != 0, sq.c * 128);
    tile_commit(F, TV, rv, 1.f);
    BAR();
    f32x16 qk[2]; qkT_mfma(F, TQ, TK, qk);
    const int tb = F.wave >> 1, sb0 = (F.wave & 1) * 2, hh = F.lane >> 5, t = 32 * tb + (F.lane & 31);
#pragma unroll
    for (int j = 0; j < 2; ++j)
#pragma unroll
        for (int i4 = 0; i4 < 4; ++i4) { const int sb = 32 * (sb0 + j) + 8 * i4 + 4 * hh; float p[4];
#pragma unroll
            for (int i = 0; i < 4; ++i) { const int s = sb + i; const float df = (float)(t - s);
                float dm;
                if (sb0 + j == tb) dm = (s <= t ? __expf(df * lgf) : 0.f) + (s >= t ? __expf(-df * lgb) : 0.f);
                else dm = __expf(sb0 + j < tb ? df * lgf : -df * lgb);
                p[i] = qk[j][4 * i4 + i] * dm; }
            *(LAS u32x2*)(TP + t * LDT + sb * 2) = (u32x2){pk2(p[0], p[1]), pk2(p[2], p[3])}; }
    BAR();
    f32x16 y[2] = {ZERO16, ZERO16};
    pv_mfma(F, TP, TV, y);
#pragma unroll 1
    for (int d = 0; d < 2; ++d) { f32x16 qs[2] = {ZERO16, ZERO16};
        if (!sq.lat && (d == 0 ? sq.c == 0 : sq.c == sq.nch - 1)) continue;
        bf16x8 bst[2][8]; qs_prefetch(F, WSP(const bf16, WS_RTIN) + (size_t)((cp * 2 + d) * 4 + h) * 16384, bst);
        qs_mfma(F, TQ, bst, qs);
#pragma unroll
        for (int j = 0; j < 2; ++j)
#pragma unroll
            for (int k4 = 0; k4 < 4; ++k4) { const f32x4 f4 = *(const LAS f32x4*)(SCA(10 + d) + 32 * tb + 8 * k4 + 4 * hh);
#pragma unroll
                for (int i = 0; i < 4; ++i) y[j][4 * k4 + i] += f4[i] * qs[j][4 * k4 + i]; } }
    BAR();
    hs_to_lds(F, F.lds, y);
    BAR();
    head_out_r<1>(F, F.lds, INP(I_RNORM) + (size_t)l * GWID + h * 128, og, WSP(bf16, WS_Y) + (size_t)cp * 128 * D + 1024 + h * 128);
    BAR();
}
template <bool WMODE> __device__ __forceinline__ float ssd_scalars(Frame& F, KArgs& A, int l, int cp, int g) {
    const int d = F.wave >> 2, rr = F.wave & 3, head = g * 4 + rr;
    const float bias = INP(I_DTB)[(l * 2 + d) * 8 + head], arate = -__expf(INP(I_ALOG)[(l * 2 + d) * 8 + head]);
    const float* gp = WSP(const float, WS_GATES) + (size_t)(cp * 128) * 32 + 16 + d * 8 + head;
    const int i0 = d ? 127 - 2 * F.lane : 2 * F.lane, i1 = d ? i0 - 1 : i0 + 1;
    const float dt0 = softplusf_(gp[(size_t)i0 * 32] + bias), dt1 = softplusf_(gp[(size_t)i1 * 32] + bias);
    const float a0 = dt0 * arate, a1 = dt1 * arate;
    float inc = a0 + a1;
#pragma unroll
    for (int o = 1; o < 64; o <<= 1) { const float t = __shfl_up(inc, o); if (F.lane >= o) inc += t; }
    const float c1 = inc, c0 = inc - a1, tot = __shfl(inc, 63);
    LAS float* cum = SCA(16 + d * 4 + rr); LAS float* dtw = SCA(24 + d * 4 + rr);
    cum[i0] = c0; cum[i1] = c1;
    if (WMODE) { dtw[i0] = __expf(tot - c0) * dt0; dtw[i1] = __expf(tot - c1) * dt1; } else { dtw[i0] = dt0; dtw[i1] = dt1; }
    return tot;
}
__device__ __forceinline__ void seq_bounds(int cp, int& lo, int& hi) { if (cp < 64) { lo = (cp >> 1) * 256; hi = lo + 256; } else { lo = MC + ((cp - 64) >> 5) * 4096; hi = lo + 4096; } }
__device__ __forceinline__ void ssd_local_item(Frame F, KArgs& A, int l, int cp, int g) {
    const float tot = ssd_scalars<true>(F, A, l, cp, g);
    if (F.lane == 0) WSP(float, WS_SDSC)[(cp * 2 + (F.wave >> 2)) * 8 + g * 4 + (F.wave & 3)] = tot;
    int lo, hi; seq_bounds(cp, lo, hi);
    LAS unsigned char* TB = F.lds;
    load_conv<1, 16>(F, A, l, TB, nullptr, LDT, 512 + g * 128, cp * 128, lo, hi, nullptr, nullptr, true);
    load_conv<0, 16>(F, A, l, nullptr, nullptr, LDT, 768 + g * 128, cp * 128, lo, hi, nullptr, nullptr, true);
    BAR();
#pragma unroll 1
    for (int hr = 0; hr < 2; ++hr) {
#pragma unroll 1
        for (int r2 = 0; r2 < 2; ++r2) { const int rr = hr * 2 + r2;
            load_conv<2, 8>(F, A, l, F.lds + TS + (r2 * 2 + 0) * TSX, F.lds + TS + (r2 * 2 + 1) * TSX, LDX, g * 256 + rr * 64, cp * 128, lo, hi, SCA(24 + 0 * 4 + rr), SCA(24 + 1 * 4 + rr), true); }
        BAR();
        const int r2 = F.wave >> 2, d = (F.wave >> 1) & 1, pb = F.wave & 1, hh = F.lane >> 5, head = g * 4 + hr * 2 + r2;
        const LAS unsigned char* TX = F.lds + TS + (r2 * 2 + d) * TSX;
        f32x16 acc[4] = {ZERO16, ZERO16, ZERO16, ZERO16};
#pragma unroll 1
        for (int ks = 0; ks < 8; ++ks) { const bf16x8 a = frag_tr(TX, LDX, 16 * ks, 32 * pb, F.lane);
#pragma unroll
            for (int nb = 0; nb < 4; ++nb) acc[nb] = MFMA32(a, frag_tr(TB, LDT, 16 * ks, 32 * nb, F.lane), acc[nb]); }
        bf16* o = WSP(bf16, WS_SDLOC) + (size_t)((cp * 2 + d) * 8 + head) * 8192;
#pragma unroll
        for (int nb = 0; nb < 4; ++nb)
#pragma unroll
            for (int i = 0; i < 16; ++i) o[(32 * pb + crow(i, hh)) * 128 + 32 * nb + (F.lane & 31)] = (bf16)f2bf(acc[nb][i]);
        BAR();
    }
}
__device__ __forceinline__ void ssd_out_item(Frame F, KArgs& A, int l, int cp, bf16* Ybase) {
    const Seq sq = seq_of(cp);
    LAS unsigned char* TC = F.lds; LAS unsigned char* TB = F.lds + TS; LAS unsigned char* TX2 = F.lds + 2 * TS; LAS unsigned char* YI = F.lds + 3 * TS;
    LAS float* SSQ = SCA(14);
    if (F.tid < 128) SSQ[F.tid] = 0.f;
    const int tb = F.wave >> 1, ph = F.wave & 1, hh = F.lane >> 5, t = 32 * tb + (F.lane & 31);
    bf16* Yd = Ybase + (size_t)cp * 128 * D + 1536;
#pragma unroll 1
    for (int g = 0; g < 2; ++g) {
        (void)ssd_scalars<false>(F, A, l, cp, g);
        load_xbcc<16>(F, TC, LDT, 768 + g * 128, cp * 128);
        load_xbcc<16>(F, TB, LDT, 512 + g * 128, cp * 128);
        load_xbcc<16>(F, TX2, LDT, g * 256, cp * 128);
        BAR();
        f32x16 cb[4] = {ZERO16, ZERO16, ZERO16, ZERO16};
#pragma unroll 1
        for (int ks = 0; ks < 8; ++ks) { const bf16x8 bq = frag_row(TC, LDT, 32 * tb, 16 * ks, F.lane);
#pragma unroll
            for (int sb = 0; sb < 4; ++sb) cb[sb] = MFMA32(frag_row(TB, LDT, 32 * sb, 16 * ks, F.lane), bq, cb[sb]); }
#pragma unroll 1
        for (int hr = 0; hr < 2; ++hr) {
            if (hr == 1) { load_xbcc<16>(F, TX2, LDT, g * 256 + 128, cp * 128); BAR(); }
            f32x16 y2[2];
#pragma unroll
            for (int r2 = 0; r2 < 2; ++r2) {
                const int rr = hr * 2 + r2, head = g * 4 + rr;
                f32x16 y = ZERO16;
#pragma unroll 1
                for (int d = 0; d < 2; ++d) {
                    const LAS float* cum = SCA(16 + d * 4 + rr); const LAS float* dtv = SCA(24 + d * 4 + rr); const float ct = cum[t];
                    const bool has_state = sq.lat || (d == 0 ? sq.c > 0 : sq.c < sq.nch - 1);
                    bf16x8 bh[8];
                    if (has_state) { const bf16* hin = WSP(const bf16, WS_SDIN) + (size_t)((cp * 2 + d) * 8 + head) * 8192;
#pragma unroll
                        for (int ks = 0; ks < 8; ++ks) bh[ks] = *(const bf16x8*)(hin + (size_t)(32 * ph + (F.lane & 31)) * 128 + 16 * ks + 8 * hh); }
#pragma unroll
                    for (int sb = 0; sb < 4; ++sb) if (d == 0 ? sb <= tb : sb >= tb) {
#pragma unroll
                        for (int sp = 0; sp < 2; ++sp) { float p[8];
#pragma unroll
                            for (int jh = 0; jh < 2; ++jh) { const int s0 = 32 * sb + 16 * sp + 8 * jh + 4 * hh; const f32x4 c4 = *(const LAS f32x4*)(cum + s0), d4 = *(const LAS f32x4*)(dtv + s0);
#pragma unroll
                                for (int j = 0; j < 4; ++j) { const int s = s0 + j; float v = cb[sb][8 * sp + 4 * jh + j] * __expf(ct - c4[j]) * d4[j];
                                    if (sb == tb) { const bool ok = d == 0 ? (s <= t) : (s >= t); v = ok ? v : 0.f; }
                                    p[4 * jh + j] = v; } }
                            y = MFMA32(__builtin_bit_cast(bf16x8, pack8(p, 1.f)), frag_trp(TX2, LDT, 32 * sb + 16 * sp, r2 * 64 + 32 * ph, F.lane), y); } }
                    if (has_state) { f32x16 ch = ZERO16;
#pragma unroll
                        for (int ks = 0; ks < 8; ++ks) ch = MFMA32(frag_row(TC, LDT, 32 * tb, 16 * ks, F.lane), bh[ks], ch);
#pragma unroll
                        for (int k4 = 0; k4 < 4; ++k4) { const f32x4 c4 = *(const LAS f32x4*)(cum + 32 * tb + 8 * k4 + 4 * hh);
#pragma unroll
                            for (int i = 0; i < 4; ++i) y[4 * k4 + i] += __expf(c4[i]) * ch[4 * k4 + i]; } }
                }
                y2[r2] = y;
            }
#pragma unroll
            for (int r2 = 0; r2 < 2; ++r2)
#pragma unroll
                for (int i = 0; i < 16; ++i) *(LAS unsigned short*)(YI + (32 * tb + crow(i, hh)) * LDT + (r2 * 64 + 32 * ph + (F.lane & 31)) * 2) = (unsigned short)f2bf(y2[r2][i]);
            BAR();
            { const int tt = F.tid >> 2, seg = F.tid & 3, head = g * 4 + hr * 2 + (seg >> 1), pc = (seg & 1) * 32; const float Dh = INP(I_SSDD)[l * 8 + head]; float ss = 0.f;
#pragma unroll
                for (int k = 0; k < 4; ++k) { float yv[8], x[8], z[8], o[8];
                    unpack8(*(const LAS v4u*)(YI + tt * LDT + (seg * 32 + 8 * k) * 2), yv); unpack8(*(const LAS v4u*)(TX2 + tt * LDT + (seg * 32 + 8 * k) * 2), x);
                    unpack8(*(const v4u*)(PT(cp, PC_DZ + head * 64 + pc) + (size_t)tt * 128 + 8 * k), z);
#pragma unroll
                    for (int j = 0; j < 8; ++j) { const float v = (yv[j] + Dh * x[j]) * siluf_(z[j]); o[j] = v; ss += v * v; }
                    *(v4u*)(Yd + (size_t)tt * D + head * 64 + pc + 8 * k) = pack8(o, 1.f); }
                ss += __shfl_xor(ss, 1); ss += __shfl_xor(ss, 2);
                if (seg == 0) SSQ[tt] += ss; }
            BAR();
        }
    }
    __builtin_amdgcn_fence(__ATOMIC_RELEASE, "workgroup"); asm volatile("s_waitcnt vmcnt(0)" ::: "memory"); __syncthreads(); __builtin_amdgcn_fence(__ATOMIC_ACQUIRE, "workgroup");
    { const int tt = F.tid >> 2, seg = F.tid & 3; const float r = rsqrtf(SSQ[tt] * (1.f / 512.f) + EPS); const float* gn = INP(I_SNORM) + (size_t)l * GWID + 128 * seg;
#pragma unroll 4
        for (int k = 0; k < 16; ++k) { bf16* p = Yd + (size_t)tt * D + 128 * seg + 8 * k; float v[8];
            unpack8(*(const v4u*)p, v);
#pragma unroll
            for (int j = 0; j < 8; ++j) v[j] = v[j] * r * gn[8 * k + j];
            *(v4u*)p = pack8(v, 1.f); } }
    BAR();
}
template <int PASS> __device__ __forceinline__ void s5_item(Frame F, KArgs& A, int l, int cp, int gq) {
    const Seq sq = seq_of(cp);
    const int g = gq * 8 + F.wave, p = F.lane, hh = F.lane >> 5;
    LAS unsigned char* TU = F.lds; LAS unsigned char* BU = F.lds + TS + F.wave * 8704;
    if (PASS == 1) ITS(8);
    typedef short v8s __attribute__((ext_vector_type(8)));
    typedef float f32x4v __attribute__((ext_vector_type(4)));
    const int r16 = F.lane & 15, g4 = F.lane >> 4;
    v4u ru[4]; tile_issue(F, PT(cp, PC_S5U + gq * 128), ru);
    f32x2 lam[2], l8[2], h0[2]; bf16x8 bbf[2][4]; v8s ctf[2][4];
#pragma unroll
    for (int d = 0; d < 2; ++d) {
        const unsigned char* tab = s5tab(F, l, d, g);
        lam[d] = ((const f32x2*)tab)[p]; l8[d] = ((const f32x2*)(tab + 512))[p]; h0[d] = (f32x2){0.f, 0.f};
        if (PASS == 1 && sq.lat) { const size_t o = (size_t)(((sq.b * 4 + l) * 2 + d) * 32 + g) * 64 + p; h0[d] = (f32x2){INP(I_SS5R)[o], INP(I_SS5I)[o]}; }
        const bf16* bb = (const bf16*)(tab + 1024); const bf16* ct = (const bf16*)(tab + 5120);
#pragma unroll
        for (int nb = 0; nb < 4; ++nb) bbf[d][nb] = *(const bf16x8*)(bb + (size_t)(32 * nb + (F.lane & 31)) * 16 + 8 * hh);
        if (PASS == 1 && d == 0) {
#pragma unroll
            for (int ks = 0; ks < 4; ++ks) ctf[0][ks] = *(const v8s*)(ct + r16 * 128 + 32 * ks + 8 * g4); }
    }
    if (PASS == 1) {
        f32x2 e[31];
#pragma unroll
        for (int j = 0; j < 31; ++j) if (j < sq.nch - 1) { const int cc = j < sq.c ? j : j + 1, dd = j < sq.c ? 0 : 1;
            e[j] = *(const f32x2*)(WSP(const float, WS_S5LOC) + ((size_t)(((sq.cp0 + cc) * 2 + dd) * 32 + g) * 64 + p) * 2); }
#pragma unroll
        for (int j = 0; j < 31; ++j) if (j < sq.c) { const float nr = l8[0].x * h0[0].x - l8[0].y * h0[0].y + e[j].x, ni = l8[0].x * h0[0].y + l8[0].y * h0[0].x + e[j].y; h0[0] = (f32x2){nr, ni}; }
#pragma unroll
        for (int j = 30; j >= 0; --j) if (j >= sq.c && j < sq.nch - 1) { const float nr = l8[1].x * h0[1].x - l8[1].y * h0[1].y + e[j].x, ni = l8[1].x * h0[1].y + l8[1].y * h0[1].x + e[j].y; h0[1] = (f32x2){nr, ni}; }
    }
    tile_commit(F, TU, ru, 1.f);
    BAR();
    if (PASS == 1) { ITE(8); ITS(9); }
    f32x4v yacc[4][2];
    if (PASS == 1) {
#pragma unroll
        for (int a = 0; a < 4; ++a) { yacc[a][0] = (f32x4v){0.f, 0.f, 0.f, 0.f}; yacc[a][1] = (f32x4v){0.f, 0.f, 0.f, 0.f}; } }
#pragma unroll
    for (int d = 0; d < 2; ++d) {
        const float lr = lam[d].x, li = lam[d].y;
        float hr = h0[d].x, hi = h0[d].y;
        if (PASS == 1 && d == 1) { const bf16* ct = (const bf16*)(s5tab(F, l, 1, g) + 5120);
#pragma unroll
            for (int ks = 0; ks < 4; ++ks) ctf[1][ks] = *(const v8s*)(ct + r16 * 128 + 32 * ks + 8 * g4); }
#pragma unroll 1
        for (int tbi = 0; tbi < 4; ++tbi) {
            const int tb = d == 0 ? tbi : 3 - tbi;
            const bf16x8 bu = frag_row(TU, LDT, 32 * tb, 16 * F.wave, F.lane);
#pragma unroll
            for (int nb = 0; nb < 4; ++nb) {
                const f32x16 acc = MFMA32(bbf[d][nb], bu, ZERO16);
#pragma unroll
                for (int i4 = 0; i4 < 4; ++i4) *(LAS u32x2*)(BU + (F.lane & 31) * LDT + (32 * nb + 8 * i4 + 4 * hh) * 2) = (u32x2){pk2(acc[4 * i4], acc[4 * i4 + 1]), pk2(acc[4 * i4 + 2], acc[4 * i4 + 3])};
            }
            asm volatile("s_waitcnt lgkmcnt(0)" ::: "memory");
            unsigned w[32];
#pragma unroll
            for (int st = 0; st < 32; ++st) { const int tl = d == 0 ? st : 31 - st; w[st] = *(const LAS unsigned*)(BU + tl * LDT + p * 4); }
#pragma unroll
            for (int st = 0; st < 32; ++st) { const float br = bflo(w[st]), bi = bfhi(w[st]);
                const float nr = lr * hr - li * hi + br, ni = lr * hi + li * hr + bi; hr = nr; hi = ni;
                if (PASS == 1) w[st] = pk2(hr, hi); }
            if (PASS == 1) {
#pragma unroll
                for (int st = 0; st < 32; ++st) { const int tl = d == 0 ? st : 31 - st; *(LAS unsigned*)(BU + tl * LDT + p * 4) = w[st]; }
                asm volatile("s_waitcnt lgkmcnt(0)" ::: "memory");
                f32x4v y0 = (f32x4v){0.f, 0.f, 0.f, 0.f}, y1 = y0;
#pragma unroll
                for (int ks = 0; ks < 4; ++ks) {
                    y0 = __builtin_amdgcn_mfma_f32_16x16x32_bf16(*(const LAS v8s*)(BU + r16 * LDT + (32 * ks + 8 * g4) * 2), ctf[d][ks], y0, 0, 0, 0);
                    y1 = __builtin_amdgcn_mfma_f32_16x16x32_bf16(*(const LAS v8s*)(BU + (16 + r16) * LDT + (32 * ks + 8 * g4) * 2), ctf[d][ks], y1, 0, 0, 0); }
                if (tb == 0) { yacc[0][0] += y0; yacc[0][1] += y1; } else if (tb == 1) { yacc[1][0] += y0; yacc[1][1] += y1; } else if (tb == 2) { yacc[2][0] += y0; yacc[2][1] += y1; } else { yacc[3][0] += y0; yacc[3][1] += y1; }
                asm volatile("s_waitcnt lgkmcnt(0)" ::: "memory");
            }
        }
        if (PASS == 0) { *(f32x2*)(WSP(float, WS_S5LOC) + ((size_t)((cp * 2 + d) * 32 + g) * 64 + p) * 2) = (f32x2){hr, hi}; }
        else if (!sq.lat && ((d == 0 && sq.c == sq.nch - 1) || (d == 1 && sq.c == 0))) { const size_t o = (size_t)(((sq.b * 4 + l) * 2 + d) * 32 + g) * 64 + p; F.out[O_S5R + o] = hr; F.out[O_S5I + o] = hi; }
    }
    if (PASS == 1) { ITE(9); ITS(10); }
    if (PASS == 1) {
        const float Dc = INP(I_S5D)[(size_t)l * GWID + g * 16 + r16];
#pragma unroll
        for (int tb = 0; tb < 4; ++tb)
#pragma unroll
            for (int ts = 0; ts < 2; ++ts)
#pragma unroll
                for (int i = 0; i < 4; ++i) { const int t = 32 * tb + 16 * ts + 4 * g4 + i; LAS unsigned short* up = (LAS unsigned short*)(TU + t * LDT + (16 * F.wave + r16) * 2);
                    const float x = yacc[tb][ts][i] + Dc * bf2f(*up);
                    const float u2 = 1.5957691216057308f * (x + 0.044715f * x * x * x); const float ge = x - x * __builtin_amdgcn_rcpf(1.f + __expf(u2));
                    *up = (unsigned short)f2bf(ge); }
        BAR();
        bf16* ya = WSP(bf16, WS_YA) + (size_t)cp * 128 * GWID + gq * 128;
#pragma unroll
        for (int it = 0; it < 4; ++it) { const int i = F.tid + NT * it, r = i >> 4, c = i & 15; *(v4u*)(ya + (size_t)r * GWID + c * 8) = *(const LAS v4u*)(TU + r * LDT + c * 16); }
    }
    BAR();
    if (PASS == 1) ITE(10);
}

template <bool LAT> __device__ __forceinline__ void carry_unit(Frame F, KArgs& A, int l, int u) {
    const int sd = u / 96, rem = u % 96, sidx = sd >> 1, d = sd & 1;
    constexpr int lat = LAT ? 1 : 0, nch = LAT ? 32 : 2, NB = LAT ? 16 : 2;
    const int b = LAT ? sidx : sidx - 4, cp0 = LAT ? 64 + 32 * b : 2 * b;
    int type, head, slice;
    if (rem < 32) { type = 0; head = rem >> 3; slice = rem & 7; } else if (rem < 64) { type = 1; head = (rem - 32) >> 3; slice = (rem - 32) & 7; } else { type = 2; head = (rem - 64) >> 2; slice = (rem - 64) & 3; }
    const int e0 = slice * 2048 + F.tid * 4;
    const int nh = type == 2 ? 8 : 4, esz = type == 2 ? 8192 : 16384;
    const bf16* loc = type == 0 ? WSP(const bf16, WS_MLCLOC) : (type == 1 ? WSP(const bf16, WS_RTLOC) : WSP(const bf16, WS_SDLOC));
    bf16* inb = type == 0 ? WSP(bf16, WS_MLCIN) : (type == 1 ? WSP(bf16, WS_RTIN) : WSP(bf16, WS_SDIN));
    float zf = 0.f; asm volatile("" : "+v"(zf));
    float v[4] = {zf, zf, zf, zf}, nv[4] = {zf, zf, zf, zf}, m = 0.f;
    const bool do_n = (type == 0 && slice == 0 && F.tid < 32);
    if (LAT) {
        if (type == 2) { const f32x4 s = *(const f32x4*)(INP(I_SSSD) + (size_t)(((b * 4 + l) * 2 + d) * 8 + head) * 8192 + e0); v[0] = s.x; v[1] = s.y; v[2] = s.z; v[3] = s.w; }
        else { const float* s = (type == 0 ? INP(I_SMC) : INP(I_SRET)) + (size_t)(((b * 4 + l) * 2 + d) * 4 + head) * 16384; const int dv = e0 >> 7, dk = e0 & 127;
#pragma unroll
            for (int j = 0; j < 4; ++j) v[j] = s[(dk + j) * 128 + dv]; }
        if (type == 0) { m = INP(I_SMM)[((b * 4 + l) * 2 + d) * 4 + head];
            if (do_n) { const f32x4 s = *(const f32x4*)(INP(I_SMN) + (size_t)(((b * 4 + l) * 2 + d) * 4 + head) * 128 + F.tid * 4); nv[0] = s.x; nv[1] = s.y; nv[2] = s.z; nv[3] = s.w; } }
    }
    const float rdec = type == 1 ? __expf(-128.f * __expf(INP(I_RRATE)[(l * 2 + d) * 4 + head])) : 1.f;
#pragma unroll 1
    for (int ci0 = 0; ci0 < nch; ci0 += NB) {
        u32x2 lc[NB]; f32x4 ln[NB]; float s0[NB], s1[NB];
#pragma unroll
        for (int j = 0; j < NB; ++j) { ln[j] = (f32x4){zf, zf, zf, zf}; s0[j] = zf; s1[j] = zf; }
#pragma unroll
        for (int j = 0; j < NB; ++j) {
            const int ci = ci0 + j, cp = cp0 + (d == 0 ? ci : nch - 1 - ci);
            lc[j] = *(const u32x2*)(loc + (size_t)((cp * 2 + d) * nh + head) * esz + e0);
            if (type == 0) { const float* sc = WSP(const float, WS_MLSC) + ((cp * 2 + d) * 4 + head) * 2; s0[j] = sc[0]; s1[j] = sc[1];
                if (do_n) ln[j] = *(const f32x4*)(WSP(const float, WS_MLNLOC) + ((cp * 2 + d) * 4 + head) * 128 + F.tid * 4); }
            else if (type == 2) s0[j] = WSP(const float, WS_SDSC)[(cp * 2 + d) * 8 + head];
        }
#pragma unroll
        for (int j = 0; j < NB; ++j) {
            const int ci = ci0 + j, cp = cp0 + (d == 0 ? ci : nch - 1 - ci);
            const size_t so = (size_t)((cp * 2 + d) * nh + head) * esz + e0;
            if (LAT || ci > 0) *(u32x2*)(inb + so) = (u32x2){pk2(v[0], v[1]), pk2(v[2], v[3])};
            float dec, wl = 1.f;
            if (type == 0) {
                const float Bt = s0[j], ml = s1[j];
                if (slice == 0 && F.tid == 0) WSP(float, WS_MLMIN)[(cp * 2 + d) * 4 + head] = m;
                if (do_n) *(f32x4*)(WSP(float, WS_MLNIN) + ((cp * 2 + d) * 4 + head) * 128 + F.tid * 4) = (f32x4){nv[0], nv[1], nv[2], nv[3]};
                const float mn = fmaxf(Bt + m, ml); dec = __expf(Bt + m - mn); wl = __expf(ml - mn); m = mn;
                if (do_n) { nv[0] = dec * nv[0] + wl * ln[j].x; nv[1] = dec * nv[1] + wl * ln[j].y; nv[2] = dec * nv[2] + wl * ln[j].z; nv[3] = dec * nv[3] + wl * ln[j].w; }
            } else if (type == 1) dec = rdec;
            else dec = __expf(s0[j]);
            v[0] = dec * v[0] + wl * bflo(lc[j].x); v[1] = dec * v[1] + wl * bfhi(lc[j].x); v[2] = dec * v[2] + wl * bflo(lc[j].y); v[3] = dec * v[3] + wl * bfhi(lc[j].y);
        }
    }
    if (!lat) {
        if (type == 2) *(f32x4*)(F.out + O_SSD + (size_t)(((b * 4 + l) * 2 + d) * 8 + head) * 8192 + e0) = (f32x4){v[0], v[1], v[2], v[3]};
        else {
            LAS float* tr = (LAS float*)F.lds;
            const int dvl = F.tid >> 5, dk = (F.tid & 31) * 4;
#pragma unroll
            for (int j = 0; j < 4; ++j) tr[dvl * 129 + dk + j] = v[j];
            BAR();
            const int dk2 = F.tid >> 2, q = F.tid & 3;
            float* o = F.out + (type == 0 ? O_MC : O_RET) + (size_t)(((b * 4 + l) * 2 + d) * 4 + head) * 16384 + (size_t)dk2 * 128 + slice * 16 + 4 * q;
            *(f32x4*)o = (f32x4){tr[(4 * q) * 129 + dk2], tr[(4 * q + 1) * 129 + dk2], tr[(4 * q + 2) * 129 + dk2], tr[(4 * q + 3) * 129 + dk2]};
            if (type == 0) { if (do_n) *(f32x4*)(F.out + O_MN + (size_t)(((b * 4 + l) * 2 + d) * 4 + head) * 128 + F.tid * 4) = (f32x4){nv[0], nv[1], nv[2], nv[3]};
                if (slice == 0 && F.tid == 0) F.out[O_MM + ((b * 4 + l) * 2 + d) * 4 + head] = m; }
            BAR();
        }
    }
}

struct CtxLd { u32x2 lc[2]; f32x4 ln[2]; float s0[2], s1[2]; };
struct CtxU { int d, b, cp0, type, head, slice, e0, nh, esz; bool do_n; };
__device__ __forceinline__ CtxU ctx_decode(const Frame& F, int u) {
    CtxU c; const int sd = u / 96, rem = u % 96, sidx = sd >> 1; c.d = sd & 1; c.b = sidx - 4; c.cp0 = 2 * c.b;
    if (rem < 32) { c.type = 0; c.head = rem >> 3; c.slice = rem & 7; } else if (rem < 64) { c.type = 1; c.head = (rem - 32) >> 3; c.slice = (rem - 32) & 7; } else { c.type = 2; c.head = (rem - 64) >> 2; c.slice = (rem - 64) & 3; }
    c.e0 = c.slice * 2048 + F.tid * 4; c.nh = c.type == 2 ? 8 : 4; c.esz = c.type == 2 ? 8192 : 16384; c.do_n = (c.type == 0 && c.slice == 0 && F.tid < 32);
    return c;
}
__device__ __forceinline__ void carry_ctx_load(const Frame& F, int u, CtxLd& L, float zf) {
    const CtxU c = ctx_decode(F, u);
    const bf16* loc = c.type == 0 ? WSP(const bf16, WS_MLCLOC) : (c.type == 1 ? WSP(const bf16, WS_RTLOC) : WSP(const bf16, WS_SDLOC));
#pragma unroll
    for (int j = 0; j < 2; ++j) { const int cp = c.cp0 + (c.d == 0 ? j : 1 - j);
        L.ln[j] = (f32x4){zf, zf, zf, zf}; L.s0[j] = zf; L.s1[j] = zf;
        L.lc[j] = *(const u32x2*)(loc + (size_t)((cp * 2 + c.d) * c.nh + c.head) * c.esz + c.e0);
        if (c.type == 0) { const float* sc = WSP(const float, WS_MLSC) + ((cp * 2 + c.d) * 4 + c.head) * 2; L.s0[j] = sc[0]; L.s1[j] = sc[1];
            if (c.do_n) L.ln[j] = *(const f32x4*)(WSP(const float, WS_MLNLOC) + ((cp * 2 + c.d) * 4 + c.head) * 128 + F.tid * 4); }
        else if (c.type == 2) L.s0[j] = WSP(const float, WS_SDSC)[(cp * 2 + c.d) * 8 + c.head]; }
}
__device__ __forceinline__ void carry_ctx_finish(Frame& F, KArgs& A, int l, int u, const CtxLd& L, float zf) {
    const CtxU c = ctx_decode(F, u);
    bf16* inb = c.type == 0 ? WSP(bf16, WS_MLCIN) : (c.type == 1 ? WSP(bf16, WS_RTIN) : WSP(bf16, WS_SDIN));
    float v[4] = {zf, zf, zf, zf}, nv[4] = {zf, zf, zf, zf}, m = 0.f;
    const float rdec = c.type == 1 ? __expf(-128.f * __expf(INP(I_RRATE)[(l * 2 + c.d) * 4 + c.head])) : 1.f;
#pragma unroll
    for (int j = 0; j < 2; ++j) { const int cp = c.cp0 + (c.d == 0 ? j : 1 - j);
        if (j > 0) *(u32x2*)(inb + (size_t)((cp * 2 + c.d) * c.nh + c.head) * c.esz + c.e0) = (u32x2){pk2(v[0], v[1]), pk2(v[2], v[3])};
        float dec, wl = 1.f;
        if (c.type == 0) {
            if (c.slice == 0 && F.tid == 0) WSP(float, WS_MLMIN)[(cp * 2 + c.d) * 4 + c.head] = m;
            if (c.do_n) *(f32x4*)(WSP(float, WS_MLNIN) + ((cp * 2 + c.d) * 4 + c.head) * 128 + F.tid * 4) = (f32x4){nv[0], nv[1], nv[2], nv[3]};
            const float mn = fmaxf(L.s0[j] + m, L.s1[j]); dec = __expf(L.s0[j] + m - mn); wl = __expf(L.s1[j] - mn); m = mn;
            if (c.do_n) { nv[0] = dec * nv[0] + wl * L.ln[j].x; nv[1] = dec * nv[1] + wl * L.ln[j].y; nv[2] = dec * nv[2] + wl * L.ln[j].z; nv[3] = dec * nv[3] + wl * L.ln[j].w; }
        } else if (c.type == 1) dec = rdec;
        else dec = __expf(L.s0[j]);
        v[0] = dec * v[0] + wl * bflo(L.lc[j].x); v[1] = dec * v[1] + wl * bfhi(L.lc[j].x); v[2] = dec * v[2] + wl * bflo(L.lc[j].y); v[3] = dec * v[3] + wl * bfhi(L.lc[j].y); }
    const int b = c.b, d = c.d, head = c.head, slice = c.slice, e0 = c.e0;
    if (c.type == 2) *(f32x4*)(F.out + O_SSD + (size_t)(((b * 4 + l) * 2 + d) * 8 + head) * 8192 + e0) = (f32x4){v[0], v[1], v[2], v[3]};
    else {
        LAS float* tr = (LAS float*)F.lds;
        const int dvl = F.tid >> 5, dk = (F.tid & 31) * 4;
#pragma unroll
        for (int j = 0; j < 4; ++j) tr[dvl * 129 + dk + j] = v[j];
        BAR();
        const int dk2 = F.tid >> 2, q = F.tid & 3;
        float* o = F.out + (c.type == 0 ? O_MC : O_RET) + (size_t)(((b * 4 + l) * 2 + d) * 4 + head) * 16384 + (size_t)dk2 * 128 + slice * 16 + 4 * q;
        *(f32x4*)o = (f32x4){tr[(4 * q) * 129 + dk2], tr[(4 * q + 1) * 129 + dk2], tr[(4 * q + 2) * 129 + dk2], tr[(4 * q + 3) * 129 + dk2]};
        if (c.type == 0) { if (c.do_n) *(f32x4*)(F.out + O_MN + (size_t)(((b * 4 + l) * 2 + d) * 4 + head) * 128 + F.tid * 4) = (f32x4){nv[0], nv[1], nv[2], nv[3]};
            if (slice == 0 && F.tid == 0) F.out[O_MM + ((b * 4 + l) * 2 + d) * 4 + head] = m; }
        BAR();
    }
}
__device__ __forceinline__ void carry_ctx_batch(Frame F, KArgs& A, int l, int u0) {
    float zf = 0.f; asm volatile("" : "+v"(zf));
    CtxLd L[8];
#pragma unroll
    for (int j = 0; j < 8; ++j) carry_ctx_load(F, u0 + j, L[j], zf);
#pragma unroll
    for (int j = 0; j < 8; ++j) carry_ctx_finish(F, A, l, u0 + j, L[j], zf);
}
constexpr int CW_Q = 16384;
struct OneUnit { pg8::Unit u; __device__ __forceinline__ bool next(int i, pg8::Unit& o) const { if (i) return false; o = u; return true; }
    __device__ __forceinline__ void a_ready(const pg8::Unit&) const {} __device__ __forceinline__ void done(const pg8::Unit&) const {} };
#define QUEUE_LOOP(F0_, qidx, total, ...) do { \
    unsigned* qc_ = (unsigned*)(F0_.ws + WS_CTL) + CW_Q + 64 * (qidx); volatile LAS int* qs_ = (volatile LAS int*)(F0_.lds + MISC_OFF + 64); \
    if (F0_.tid == 0) qs_[0] = (int)__hip_atomic_fetch_add(qc_, 1u, __ATOMIC_RELAXED, __HIP_MEMORY_SCOPE_AGENT); \
    __syncthreads(); \
    int it = qs_[0], par_ = 1; \
    while (it < (total)) { \
        int nx_ = 0; if (F0_.tid == 0) nx_ = (int)__hip_atomic_fetch_add(qc_, 1u, __ATOMIC_RELAXED, __HIP_MEMORY_SCOPE_AGENT); \
        { __VA_ARGS__ } \
        if (F0_.tid == 0) qs_[par_] = nx_; \
        BAR();     \
        it = qs_[par_]; par_ ^= 1; \
    } } while (0)
#ifndef PROBE_ITEM
#define PROBE_ITEM -1
#endif
#define PR(t) (PROBE_ITEM == (t) ? 2 : 1)
#define QSPLIT(NT_, C0, C1, C2, C3, T0) int ty_ = 0, loc_ = it, dup_ = 0; { const int cnt_[4] = {C0, C1, C2, C3}; \
    _Pragma("unroll") for (int j_ = 0; j_ < NT_; ++j_) { const int span_ = cnt_[j_] * PR(T0 + j_); if (ty_ == j_) { if (loc_ >= span_) { loc_ -= span_; ty_ = j_ + 1; } else { dup_ = loc_ / cnt_[j_]; loc_ = loc_ % cnt_[j_]; } } } }
#ifndef PROBE_TMASK
#define PROBE_TMASK 0
#endif
#ifndef PROBE_TAMP
#define PROBE_TAMP 4
#endif
#define TSTART(k) do { if (PROBE_TMASK & (1 << (k))) pt0_ = __builtin_amdgcn_s_memrealtime(); } while (0)
#define TEND(k) do { if (PROBE_TMASK & (1 << (k))) ptacc_ += __builtin_amdgcn_s_memrealtime() - pt0_; } while (0)
#ifndef PROBE_REPEAT
#define PROBE_REPEAT -1
#endif
constexpr int N_PHASES = 2 + 9 * NLAYER;
__global__ void __launch_bounds__(NT, 2) hymba_fwd(Args A) {
    extern __shared__ __attribute__((aligned(16))) unsigned char lds_raw[];
    Frame F0;
    F0.lds = (LAS unsigned char*)lds_raw;
    F0.tid = threadIdx.x; F0.lane = 0; F0.wave = __builtin_amdgcn_readfirstlane(F0.tid >> 6);
    F0.G = gridDim.x; F0.bid = blockIdx.x; F0.out = A.out; F0.ws = A.ws;
    volatile LAS unsigned* MISC = (volatile LAS unsigned*)(F0.lds + MISC_OFF);
    if (F0.tid < 64) MISC[F0.tid] = 0u;
    __syncthreads();
    unsigned* barw = (unsigned*)(F0.ws + WS_CTL) + CW_BAR;
    XcdBarrier bar = xcd_barrier_post(barw, MISC + 8, F0.wave == 0 ? 1u : 0u);
    const int lo = A.ph_lo, hi = A.ph_hi;
    unsigned long long pt0_ = 0, ptacc_ = 0;
#define KA (*kargs())
#define IN(k) (lo <= (k) && (k) < hi)
#define SEAM(k) do { if (IN(k) && IN((k) + 1)) xcd_barrier(bar); } while (0)

    TSTART(9); if (IN(0)) for (int rep_ = 0; rep_ < (PROBE_REPEAT == 100 ? 2 : 1); ++rep_) { Frame F = fresh(F0); p0_prologue(F, KA); } SEAM(0); TEND(9);

    TSTART(10); if (IN(1)) { Frame F = fresh(F0); norm0_phase(F, KA); shw_phase(F); } SEAM(1); TEND(10);

#pragma unroll 1
    for (int l = 0; l < NLAYER; ++l) {
        const int pb = 1 + 9 * l;
        TSTART(1); if (IN(pb + 1)) for (int rep_ = 0; rep_ < (PROBE_REPEAT == 1 ? 2 : 1); ++rep_) { Frame F = fresh(F0);
            pg8::Gemm g{WSP(const pg8::bf16_t, WS_H), WSP(const pg8::bf16_t, WS_W1T) + (size_t)l * NPAD * D, M, NPROJ, D}; pg8::StaticOrder S; S.init(M, NPROJ, F.G, F.bid);
            epi::EpiProj E{WSP(pg8::bf16_t, WS_PROJ), WSP(const float, WS_SSQB), WSP(const float, WS_SHW1) + (size_t)l * 5 * NPAD};
            pg8::gemm_phase<epi::EpiProj, pg8::StaticOrder, true, true>(F.lds, g, S, E, F.tid);
            __syncthreads(); gates_phase(F, l);
        } SEAM(pb + 1); TEND(1);
        TSTART(2); if (IN(pb + 2)) { Frame F = fresh(F0);
            QUEUE_LOOP(F, l * 3 + 0, 384 * PR(0) + 768 * PR(1) + 768 * PR(2) + 768 * PR(3), {
                QSPLIT(4, 384, 768, 768, 768, 0);
                if (ty_ == 0) { TSTART(11); ssd_local_item(fresh(F), KA, l, loc_ >> 1, loc_ & 1); TEND(11); }
                else if (ty_ == 1) { TSTART(12); mlstm_local_item(fresh(F), KA, l, loc_ >> 2, loc_ & 3); TEND(12); }
                else if (ty_ == 2) { TSTART(13); ret_local_item(fresh(F), KA, l, loc_ >> 2, loc_ & 3); TEND(13); }
                else { TSTART(14); s5_item<0>(fresh(F), KA, l, loc_ >> 2, loc_ & 3); TEND(14); }
            });
        } SEAM(pb + 2); TEND(2);
        TSTART(3); if (IN(pb + 3)) { Frame F = fresh(F0);
            QUEUE_LOOP(F, l * 3 + 1, 768 * PR(4) + 768 * PR(5) + 768 * PR(6), {
                QSPLIT(3, 768, 768, 768, 0, 4);
                if (ty_ == 0) { TSTART(15); carry_unit<true>(fresh(F), KA, l, loc_); TEND(15); }
                else if (ty_ == 1) { TSTART(16); s5_item<1>(fresh(F), KA, l, loc_ >> 2, loc_ & 3); TEND(16); }
                else { TSTART(17); carry_ctx_batch(fresh(F), KA, l, 768 + loc_ * 8); TEND(17); }
            });
        } SEAM(pb + 3); TEND(3);
        TSTART(4); if (IN(pb + 4)) { Frame F = fresh(F0);
            QUEUE_LOOP(F, l * 3 + 2, 192 * PR(7) + 192 * PR(8) + 768 * PR(9) + 768 * PR(10), {
                QSPLIT(4, 192, 192, 768, 768, 7);
                if (ty_ == 0) { TSTART(18); ssd_out_item(fresh(F), KA, l, loc_, dup_ ? WSP(bf16, WS_MLCLOC) : WSP(bf16, WS_Y)); TEND(18); }
                else if (ty_ == 1) { TSTART(19); Frame Fg = fresh(F);
                    pg8::Gemm g{WSP(const pg8::bf16_t, WS_YA), WSP(const pg8::bf16_t, WS_WGT) + (size_t)l * GWID * GWID, M, GWID, GWID}; OneUnit S; S.u.pm = loc_ >> 1; S.u.pn = loc_ & 1;
                    epi::EpiGlu E{WSP(const pg8::bf16_t, WS_YA), WSP(pg8::bf16_t, WS_Y)};
                    pg8::gemm_phase<epi::EpiGlu, OneUnit, false, true>(Fg.lds, g, S, E, Fg.tid); __syncthreads(); TEND(19); }
                else if (ty_ == 2) { TSTART(20); mlstm_out_item(fresh(F), KA, l, loc_ >> 2, loc_ & 3); TEND(20); }
                else { TSTART(21); ret_out_item(fresh(F), KA, l, loc_ >> 2, loc_ & 3); TEND(21); }
            });
        } SEAM(pb + 4); TEND(4);
        TSTART(5); if (IN(pb + 5)) { Frame F = fresh(F0);
            pg8::Gemm g{WSP(const pg8::bf16_t, WS_Y), WSP(const pg8::bf16_t, WS_WOT) + (size_t)l * D * D, M, D, D}; pg8::StaticOrder S; S.init(M, D, F.G, F.bid);
            KArgs& A_ = KA; epi::EpiRes E{(const float*)(const GAS float*)A_.in[I_XP], (const float*)(const GAS float*)A_.in[I_XS], WSP(pg8::bf16_t, WS_XB), WSP(const float, WS_MOD) + (size_t)(l * 5) * (6 * D) + 2 * D, l == 0 ? 1 : 0,
                          1, WSP(pg8::bf16_t, WS_H), WSP(float, WS_SSQA), (const float*)(const GAS float*)A_.in[I_NORM2] + (size_t)l * D, WSP(const float, WS_MOD) + (size_t)(l * 5) * (6 * D) + 4 * D, F.lds + 131072};
            pg8::gemm_phase<epi::EpiRes, pg8::StaticOrder, true, true>(F.lds, g, S, E, F.tid);
        } SEAM(pb + 5); TEND(5);
        TSTART(7); if (IN(pb + 7)) for (int rep_ = 0; rep_ < (PROBE_REPEAT == 7 ? 2 : 1); ++rep_) { Frame F = fresh(F0);
            pg8::Gemm g{WSP(const pg8::bf16_t, WS_H), WSP(const pg8::bf16_t, WS_WM1T) + (size_t)l * DFF * D, M, DFF, D}; pg8::StaticOrder S; S.init(M, DFF, F.G, F.bid);
            epi::EpiRelu2 E{WSP(pg8::bf16_t, WS_HID), WSP(const float, WS_SSQA), WSP(const float, WS_SHW2) + (size_t)l * 5 * DFF};
            pg8::gemm_phase<epi::EpiRelu2, pg8::StaticOrder, true, true>(F.lds, g, S, E, F.tid);
        } SEAM(pb + 7); TEND(7);
        TSTART(8); if (IN(pb + 8)) { Frame F = fresh(F0);
            pg8::Gemm g{WSP(const pg8::bf16_t, WS_HID), WSP(const pg8::bf16_t, WS_WM2T) + (size_t)l * D * DFF, M, D, DFF}; pg8::StaticOrder S; S.init(M, D, F.G, F.bid);
            KArgs& A_ = KA; epi::EpiRes E{(const float*)(const GAS float*)A_.in[I_XP], (const float*)(const GAS float*)A_.in[I_XS], WSP(pg8::bf16_t, WS_XB), WSP(const float, WS_MOD) + (size_t)(l * 5) * (6 * D) + 5 * D, 0,
                          l < NLAYER - 1 ? 1 : 0, WSP(pg8::bf16_t, WS_H), WSP(float, WS_SSQB), (const float*)(const GAS float*)A_.in[I_NORM1] + (size_t)(l + 1) * D, WSP(const float, WS_MOD) + (size_t)((l + 1) * 5) * (6 * D) + 1 * D, F.lds + 131072};
            pg8::gemm_phase<epi::EpiRes, pg8::StaticOrder, true, true>(F.lds, g, S, E, F.tid);
        } SEAM(pb + 8); TEND(8);
    }
    if (IN(N_PHASES - 1)) { Frame F = fresh(F0); final_norm_phase(F, KA); }
    if (PROBE_IMASK != 0 && F0.bid == 0 && F0.wave == 0 && lane_id() == 0) { const unsigned long long acc_ = ((volatile LAS unsigned long long*)(F0.lds + MISC_OFF + 128))[1], te_ = __builtin_amdgcn_s_memrealtime();
        while (__builtin_amdgcn_s_memrealtime() - te_ < (unsigned long long)PROBE_TAMP * acc_) __builtin_amdgcn_s_sleep(32); }
    if (PROBE_TMASK != 0 && F0.bid == 0) { const unsigned long long te_ = __builtin_amdgcn_s_memrealtime(); while (__builtin_amdgcn_s_memrealtime() - te_ < (unsigned long long)PROBE_TAMP * ptacc_) __builtin_amdgcn_s_sleep(32); }
#undef IN
#undef SEAM
}

#ifndef MK_LAUNCH_PER_PHASE
#define MK_LAUNCH_PER_PHASE 0
#endif
extern "C" void kernel_launch(void* const* d_in, const int* in_sizes, int n_in, void* d_out, int out_size, void* d_ws, size_t ws_size, hipStream_t stream) {
    static int grid = 0;
    if (grid == 0) {
        if (n_in != N_IN || (size_t)out_size != O_END || ws_size < WS_END) { fprintf(stderr, "kernel_launch: shape mismatch: n_in %d out %d ws %zu (need %zu)\n", n_in, out_size, ws_size, (size_t)WS_END); grid = -1; return; }
        int dev = 0, cus = 0, per_cu = 0;
        if (hipGetDevice(&dev) != hipSuccess || hipDeviceGetAttribute(&cus, hipDeviceAttributeMultiprocessorCount, dev) != hipSuccess) { grid = -1; return; }
        if (hipFuncSetAttribute((const void*)hymba_fwd, hipFuncAttributeMaxDynamicSharedMemorySize, LDS_BYTES) != hipSuccess) { fprintf(stderr, "kernel_launch: hipFuncSetAttribute failed\n"); grid = -1; return; }
        if (hipOccupancyMaxActiveBlocksPerMultiprocessor(&per_cu, (const void*)hymba_fwd, NT, LDS_BYTES) != hipSuccess || per_cu < 1) fprintf(stderr, "kernel_launch: occupancy query says %d\n", per_cu);
        (void)hipGetLastError();
        grid = cus;
    }
    if (grid < 0) return;
    (void)hipMemsetAsync((char*)d_ws + WS_CTL, 0, CTL_ZERO_BYTES, stream);
    Args a{};
    for (int i = 0; i < N_IN; ++i) a.in[i] = (const float*)d_in[i];
    a.out = (float*)d_out; a.ws = (unsigned char*)d_ws;
#if MK_LAUNCH_PER_PHASE
    for (int p = 0; p < N_PHASES; ++p) { a.ph_lo = p; a.ph_hi = p + 1; hipLaunchKernelGGL(hymba_fwd, dim3(grid), dim3(NT), LDS_BYTES, stream, a); }
#else
    a.ph_lo = 0; a.ph_hi = N_PHASES;
    hipLaunchKernelGGL(hymba_fwd, dim3(grid), dim3(NT), LDS_BYTES, stream, a);
#endif
    const hipError_t le = hipPeekAtLastError();
    if (le != hipSuccess) fprintf(stderr, "kernel_launch: launch failed: %s\n", hipGetErrorName(le));
}
```

```cpp
#include <hip/hip_runtime.h>
#include <cstdio>
#include <cstdint>
namespace pg8 {
#define PG8_LAS __attribute__((address_space(3)))
typedef unsigned short bf16_t;
typedef short bf16x8 __attribute__((ext_vector_type(8)));
typedef float f32x4 __attribute__((ext_vector_type(4)));
typedef unsigned u32x4 __attribute__((ext_vector_type(4)));
constexpr int BM = 256, BK = 64, HALF = 128, HTB = HALF * BK * 2  , STAGE_BYTES = 8 * HTB, NXCD = 8, WGM = 8;

__host__ __device__ __forceinline__ int lds_byte(int r, int c) { const int st = (r >> 4) * 2 + (c >> 5), rr = r & 15, cc = c & 31, ob = rr * 64 + cc * 2; return st * 1024 + (ob ^ (((ob >> 9) & 1) << 5)); }
__host__ __device__ __forceinline__ void stage_rc(int b, int& R, int& C) { const int st = b / 1024, sb = b % 1024, swz = sb ^ (((sb >> 9) & 1) << 5); R = (st >> 1) * 16 + swz / 64; C = (st & 1) * 32 + (swz % 64) / 2; }
__host__ __device__ __forceinline__ int perm32(int rho) { const int n = rho >> 4, i = rho & 15; return 8 * (i >> 2) + 4 * n + (i & 3); }

struct Unit { int pm, pn; };
struct Gemm { const bf16_t* A; const bf16_t* Bt; int M, N, K; };

struct StaticOrder {
    int nM, nN, nwg, G, c;
    __host__ __device__ void init(int M, int N, int G_, int c_) { nM = M / BM; nN = N / BM; nwg = nM * nN; G = G_; c = c_; }
    __host__ __device__ bool next(int i, Unit& u) const {
        const long L = (long)i * G + c; if (L >= nwg) return false;
        int wgid = (int)L; { const int q = nwg / NXCD, r = nwg % NXCD, xcd = wgid % NXCD, off = wgid / NXCD; wgid = (xcd < r ? xcd * (q + 1) : r * (q + 1) + (xcd - r) * q) + off; }
        const int nig = WGM * nN, gid = wgid / nig, fm = gid * WGM, gsz = (nM - fm) < WGM ? (nM - fm) : WGM;
        u.pm = fm + ((wgid % nig) % gsz); u.pn = (wgid % nig) / gsz; return true;
    }
    __device__ __forceinline__ void a_ready(const Unit&) const {}
    __device__ __forceinline__ void done(const Unit&) const {}
};

__device__ __forceinline__ unsigned cvt_pk_bf16(float lo, float hi) { unsigned r; asm volatile("v_cvt_pk_bf16_f32 %0, %1, %2" : "=v"(r) : "v"(lo), "v"(hi)); return r; }
typedef float f32x2 __attribute__((ext_vector_type(2)));
template <class Epi, class Sched, bool ALIGN_EPI = false, bool SP2 = false>
__device__ __forceinline__ void gemm_phase(PG8_LAS unsigned char* lds, const Gemm g, const Sched& S, const Epi& E, int tid_in) {
    int tid_ = tid_in; asm volatile("" : "+v"(tid_));
    const int tid = tid_, wid = __builtin_amdgcn_readfirstlane(tid >> 6), lane = tid & 63, wr = wid >> 2, wc = wid & 3, fr = lane & 15, fq = lane >> 4;
    const int K = g.K, nt = K / BK;
    unsigned voffA[2], voffB[2];
#pragma unroll
    for (int i = 0; i < 2; ++i) { int R, C; stage_rc(tid * 16 + i * 8192, R, C); const int Rb = Epi::PERM ? ((R & ~31) + perm32(R & 31)) : R;
        voffA[i] = (unsigned)(R * K + C) * 2u; voffB[i] = (unsigned)(Rb * K + C) * 2u; }
    const size_t kstep = (size_t)(BK * 2);
    const size_t hstep = (size_t)HALF * K * 2;
    const size_t tstep = 2 * hstep;
    const unsigned ldsw = (unsigned)wid * 1024u;
    const int aoff = lds_byte(wr * 64 + fr, fq * 8), boff = lds_byte(wc * 32 + fr, fq * 8);
#define PG8_SA(b, h) (((b) * 2 + (h)) * HTB)
#define PG8_SB(b, h) ((4 + (b) * 2 + (h)) * HTB)
#define PG8_STAGE(bufoff, gbase, voff) do { _Pragma("unroll") for (int _i = 0; _i < 2; ++_i) \
        __builtin_amdgcn_global_load_lds((const unsigned*)((const char*)(gbase) + (voff)[_i]), (PG8_LAS unsigned*)(lds + (bufoff) + ldsw + _i * 8192), 16, 0, 0); } while (0)
#define PG8_LDA(dst, b, h) do { _Pragma("unroll") for (int m = 0; m < 4; ++m) _Pragma("unroll") for (int k = 0; k < 2; ++k) dst[m][k] = *(const PG8_LAS bf16x8*)(lds + PG8_SA(b, h) + aoff + m * 2048 + k * 1024); } while (0)
#define PG8_LDB(dst, b, h) do { _Pragma("unroll") for (int n = 0; n < 2; ++n) _Pragma("unroll") for (int k = 0; k < 2; ++k) dst[n][k] = *(const PG8_LAS bf16x8*)(lds + PG8_SB(b, h) + boff + n * 2048 + k * 1024); } while (0)
#define PG8_MMA(ai, bj, At, Bt) do { __builtin_amdgcn_s_setprio(1); _Pragma("unroll") for (int m = 0; m < 4; ++m) _Pragma("unroll") for (int n = 0; n < 2; ++n) _Pragma("unroll") for (int k = 0; k < 2; ++k) \
        acc[ai][bj][m][n] = __builtin_amdgcn_mfma_f32_16x16x32_bf16(Bt[n][k], At[m][k], acc[ai][bj][m][n], 0, 0, 0); __builtin_amdgcn_s_setprio(0); } while (0)
#define PG8_WAIT_V(n) asm volatile("s_waitcnt vmcnt(" #n ")" ::: "memory")
#define PG8_WAIT_L(n) asm volatile("s_waitcnt lgkmcnt(" #n ")" ::: "memory")
#define PG8_BAR __builtin_amdgcn_s_barrier()
#define PG8_SCHED __builtin_amdgcn_sched_barrier(0)
    Unit cur, nxt; int ui = 0;
    if (!S.next(0, cur)) return;
    f32x4 acc[2][2][4][2];
#pragma unroll
    for (int a = 0; a < 2; ++a)
#pragma unroll
        for (int b = 0; b < 2; ++b)
#pragma unroll
            for (int m = 0; m < 4; ++m)
#pragma unroll
                for (int n = 0; n < 2; ++n) acc[a][b][m][n] = (f32x4){0.f, 0.f, 0.f, 0.f};
    bf16x8 At[4][2], B0[2][2], B1[2][2];
    const char* cA = (const char*)g.A + (size_t)cur.pm * tstep; const char* cB = (const char*)g.Bt + (size_t)cur.pn * tstep;
    S.a_ready(cur);
    if constexpr (SP2) {
        PG8_STAGE(PG8_SB(0, 0), cB, voffB); PG8_STAGE(PG8_SB(0, 1), cB + hstep, voffB); PG8_STAGE(PG8_SA(0, 0), cA, voffA); PG8_STAGE(PG8_SA(0, 1), cA + hstep, voffA);
        if (wr == 1) PG8_BAR;
        PG8_WAIT_V(2); PG8_BAR;
        PG8_STAGE(PG8_SB(1, 0), cB + kstep, voffB); PG8_STAGE(PG8_SA(1, 0), cA + kstep, voffA); PG8_STAGE(PG8_SB(1, 1), cB + hstep + kstep, voffB);
        PG8_WAIT_V(6); PG8_BAR;
    } else {
        PG8_STAGE(PG8_SB(0, 0), cB, voffB); PG8_STAGE(PG8_SA(0, 0), cA, voffA); PG8_STAGE(PG8_SB(0, 1), cB + hstep, voffB); PG8_STAGE(PG8_SA(0, 1), cA + hstep, voffA);
        if (wr == 1) PG8_BAR;
        PG8_WAIT_V(4); PG8_BAR;
        PG8_STAGE(PG8_SB(1, 0), cB + kstep, voffB); PG8_STAGE(PG8_SA(1, 0), cA + kstep, voffA); PG8_STAGE(PG8_SB(1, 1), cB + hstep + kstep, voffB);
        PG8_WAIT_V(6); PG8_BAR;
    }
    for (;;) {
        const bool has_next = S.next(ui + 1, nxt);
        const char* nA = has_next ? (const char*)g.A + (size_t)nxt.pm * tstep : cA; const char* nB = has_next ? (const char*)g.Bt + (size_t)nxt.pn * tstep : cB;
        for (int t = 0; t < nt; t += 2) {
            const bool last = (t == nt - 2);
            const char* a1 = cA + (size_t)(t + 1) * kstep;
            const char* a2 = last ? nA : cA + (size_t)(t + 2) * kstep; const char* b2 = last ? nB : cB + (size_t)(t + 2) * kstep;
            const char* a3 = a2 + kstep; const char* b3 = b2 + kstep;
            if (last && has_next) S.a_ready(nxt);
            if constexpr (SP2) {
            PG8_LDB(B0, 0, 0); PG8_LDB(B1, 0, 1); PG8_SCHED; PG8_LDA(At, 0, 0); PG8_STAGE(PG8_SA(1, 1), a1 + hstep, voffA);
            PG8_WAIT_V(8); PG8_WAIT_L(0); PG8_BAR; PG8_MMA(0, 0, At, B0); PG8_MMA(0, 1, At, B1); PG8_BAR; PG8_SCHED;
            PG8_LDA(At, 0, 1); PG8_STAGE(PG8_SB(0, 0), b2, voffB); PG8_STAGE(PG8_SB(0, 1), b2 + hstep, voffB); PG8_STAGE(PG8_SA(0, 0), a2, voffA);
            PG8_WAIT_V(8); PG8_WAIT_L(0); PG8_BAR; PG8_MMA(1, 0, At, B0); PG8_MMA(1, 1, At, B1); PG8_BAR; PG8_SCHED;
            PG8_LDB(B0, 1, 0); PG8_LDB(B1, 1, 1); PG8_SCHED; PG8_LDA(At, 1, 0); PG8_STAGE(PG8_SA(0, 1), a2 + hstep, voffA);
            PG8_WAIT_V(8); PG8_WAIT_L(0); PG8_BAR; PG8_MMA(0, 0, At, B0); PG8_MMA(0, 1, At, B1); PG8_BAR; PG8_SCHED;
            PG8_LDA(At, 1, 1); PG8_STAGE(PG8_SB(1, 0), b3, voffB); PG8_STAGE(PG8_SB(1, 1), b3 + hstep, voffB); PG8_STAGE(PG8_SA(1, 0), a3, voffA);
            PG8_WAIT_V(8); PG8_WAIT_L(0); PG8_BAR; PG8_MMA(1, 0, At, B0); PG8_MMA(1, 1, At, B1); PG8_BAR; PG8_SCHED;
            } else {
            PG8_LDB(B0, 0, 0); PG8_SCHED; PG8_LDA(At, 0, 0); PG8_STAGE(PG8_SA(1, 1), a1 + hstep, voffA);
            PG8_WAIT_L(8); PG8_BAR; PG8_WAIT_L(0); PG8_MMA(0, 0, At, B0); PG8_BAR; PG8_SCHED;
            PG8_LDB(B1, 0, 1); PG8_STAGE(PG8_SB(0, 0), b2, voffB);
            PG8_BAR; PG8_WAIT_L(0); PG8_MMA(0, 1, At, B1); PG8_BAR;
            PG8_LDA(At, 0, 1); PG8_STAGE(PG8_SA(0, 0), a2, voffA);
            PG8_BAR; PG8_WAIT_L(0); PG8_MMA(1, 0, At, B0); PG8_BAR; PG8_SCHED;
            PG8_STAGE(PG8_SB(0, 1), b2 + hstep, voffB);
            PG8_WAIT_V(6); PG8_BAR; PG8_MMA(1, 1, At, B1); PG8_BAR;
            PG8_LDB(B0, 1, 0); PG8_SCHED; PG8_LDA(At, 1, 0); PG8_STAGE(PG8_SA(0, 1), a2 + hstep, voffA);
            PG8_WAIT_L(8); PG8_BAR; PG8_WAIT_L(0); PG8_MMA(0, 0, At, B0); PG8_BAR; PG8_SCHED;
            PG8_LDB(B1, 1, 1); PG8_STAGE(PG8_SB(1, 0), b3, voffB);
            PG8_BAR; PG8_WAIT_L(0); PG8_MMA(0, 1, At, B1); PG8_BAR;
            PG8_LDA(At, 1, 1); PG8_STAGE(PG8_SA(1, 0), a3, voffA);
            PG8_BAR; PG8_WAIT_L(0); PG8_MMA(1, 0, At, B0); PG8_BAR; PG8_SCHED;
            PG8_STAGE(PG8_SB(1, 1), b3 + hstep, voffB);
            PG8_WAIT_V(6); PG8_BAR; PG8_MMA(1, 1, At, B1); PG8_BAR;
            }
        }
        if constexpr (ALIGN_EPI) { if (wr == 0) PG8_BAR; }
        if constexpr (!Epi::AFTER_DRAIN) { E(acc, cur, wr, wc, fr, fq); S.done(cur); }
        if (!has_next) break;
#pragma unroll
        for (int a = 0; a < 2; ++a)
#pragma unroll
            for (int b = 0; b < 2; ++b)
#pragma unroll
                for (int m = 0; m < 4; ++m)
#pragma unroll
                    for (int n = 0; n < 2; ++n) acc[a][b][m][n] = (f32x4){0.f, 0.f, 0.f, 0.f};
        cur = nxt; cA = nA; cB = nB; ++ui;
        if constexpr (ALIGN_EPI) { if (wr == 1) PG8_BAR; }
    }
    PG8_WAIT_V(0);
    if constexpr (!ALIGN_EPI) { if (wr == 0) PG8_BAR; }
    PG8_BAR;
    if constexpr (Epi::AFTER_DRAIN) { E.fused(acc, cur, wr, wc, fr, fq, lds, wid, lane); S.done(cur); }
#undef PG8_SA
#undef PG8_SB
#undef PG8_STAGE
#undef PG8_LDA
#undef PG8_LDB
#undef PG8_MMA
#undef PG8_WAIT_V
#undef PG8_WAIT_L
#undef PG8_BAR
#undef PG8_SCHED
}
}
#define GAS __attribute__((address_space(1)))
#define LAS __attribute__((address_space(3)))
typedef unsigned short bf16;
typedef unsigned v4u __attribute__((ext_vector_type(4)));
typedef float f32x4 __attribute__((ext_vector_type(4)));
typedef short bf16x8 __attribute__((ext_vector_type(8)));
typedef GAS unsigned gu32;
typedef GAS unsigned long long gu64;
#define RLX_AGENT __ATOMIC_RELAXED, __HIP_MEMORY_SCOPE_AGENT
#define LDS_WAIT() asm volatile("s_waitcnt lgkmcnt(0)" ::: "memory")
#define VM_WAIT() asm volatile("s_waitcnt vmcnt(0)" ::: "memory")
__device__ __forceinline__ unsigned long long rt() { return __builtin_amdgcn_s_memrealtime(); }
typedef __bf16 hwbf16x2_t __attribute__((ext_vector_type(2)));
typedef float hwf32x2_t __attribute__((ext_vector_type(2)));
__device__ __forceinline__ unsigned pk2(float lo, float hi) { const hwf32x2_t v = {lo, hi}; const hwbf16x2_t b = __builtin_convertvector(v, hwbf16x2_t); return __builtin_bit_cast(unsigned, b); }
__device__ __forceinline__ unsigned f2bf(float f) { return pk2(f, 0.f) & 0xffffu; }
#define XB_TMO      128
#define XB_XCNT(j)  (256  + 64 * (j))
#define XB_XSUB(j)  (1280 + 64 * (j))
#define XB_XGEN(j)  (2304 + 64 * (j))
#define XB_TOP      3328
#define XB_TOPGEN   3392
#define XCD_BAR_WORDS 3456
#define XB_SPIN_CAP (1u << 18)

__device__ __forceinline__ unsigned xb_ld(unsigned* p)              { return __hip_atomic_load(p, __ATOMIC_RELAXED, __HIP_MEMORY_SCOPE_AGENT); }
__device__ __forceinline__ unsigned xb_add(unsigned* p, unsigned v) { return __hip_atomic_fetch_add(p, v, __ATOMIC_RELAXED, __HIP_MEMORY_SCOPE_AGENT); }
__device__ __forceinline__ unsigned xb_xcc_id() { return (unsigned)__builtin_amdgcn_s_getreg((3 << 11) | 20) & 0xFu; }
#define XB_SPIN(cond, bar) do { unsigned _sp = 0; while (cond) { __builtin_amdgcn_s_sleep(1); \
    if ((++_sp & 255u) == 0u) { if (xb_ld(&(bar)[XB_TMO])) break; if (_sp > XB_SPIN_CAP) { atomicAdd(&(bar)[XB_TMO], 1u); break; } } } } while (0)

struct XcdBarrier {
    unsigned wave0;
    unsigned* bar; unsigned x;
    volatile LAS unsigned* st;
};

__device__ __forceinline__ bool xb_lane0() { return __builtin_amdgcn_mbcnt_hi(~0u, __builtin_amdgcn_mbcnt_lo(~0u, 0u)) == 0u; }
__device__ __forceinline__ XcdBarrier xcd_barrier_post(unsigned* bar, volatile LAS unsigned* st, unsigned wave0) {
    XcdBarrier b; b.wave0 = wave0; b.bar = bar; b.x = xb_xcc_id(); b.st = st;
    if (wave0 && xb_lane0()) (void)xb_add(&bar[XB_XCNT(b.x)], 1u);
    return b;
}
__device__ __forceinline__ void xcd_barrier_complete(unsigned* bar, unsigned x, unsigned& nloc, unsigned& nx) {
    const unsigned G = gridDim.x * gridDim.y * gridDim.z;
    unsigned sum, cnt, mine, sp = 0u;
    for (;;) {
        sum = 0u; cnt = 0u; mine = 0u;
#pragma unroll
        for (unsigned j = 0; j < 16; ++j) { const unsigned c = xb_ld(&bar[XB_XCNT(j)]); sum += c; cnt += (c > 0u) ? 1u : 0u; mine = (j == x) ? c : mine; }
        if (sum == G) break;
        __builtin_amdgcn_s_sleep(1);
        if ((++sp & 255u) == 0u) { if (xb_ld(&bar[XB_TMO])) break; if (sp > XB_SPIN_CAP) { atomicAdd(&bar[XB_TMO], 1u); break; } }
    }
    nloc = mine > 0u ? mine : 1u; nx = cnt > 0u ? cnt : 1u;
}

__device__ __forceinline__ void xcd_barrier(const XcdBarrier& b) {
    asm volatile("s_waitcnt vmcnt(0)" ::: "memory");
    __syncthreads();
    if (b.wave0 && xb_lane0()) {
        unsigned* bar = b.bar;
        __builtin_amdgcn_s_waitcnt(0);
        unsigned nloc = b.st[0], nx = b.st[1];
        if (nloc == 0u) { xcd_barrier_complete(bar, b.x, nloc, nx); b.st[0] = nloc; b.st[1] = nx; }
        const unsigned old = xb_add(&bar[XB_XSUB(b.x)], 1u);
        const unsigned gen = old / nloc;
        if (old + 1u == (gen + 1u) * nloc) {
            __builtin_amdgcn_fence(__ATOMIC_RELEASE, "agent");
            asm volatile("s_waitcnt vmcnt(0)" ::: "memory");
            const unsigned og = xb_add(&bar[XB_TOP], 1u);
            const unsigned tg = og / nx;
            if (og + 1u == (tg + 1u) * nx) xb_add(&bar[XB_TOPGEN], 1u);
            else XB_SPIN(xb_ld(&bar[XB_TOPGEN]) == tg, bar);
            __builtin_amdgcn_fence(__ATOMIC_ACQUIRE, "agent");
            xb_add(&bar[XB_XGEN(b.x)], 1u);
            asm volatile("s_waitcnt vmcnt(0)" ::: "memory");
        } else {
            XB_SPIN(xb_ld(&bar[XB_XGEN(b.x)]) == gen, bar);
            __builtin_amdgcn_fence(__ATOMIC_ACQUIRE, "agent");
            asm volatile("s_waitcnt vmcnt(0)" ::: "memory");
        }
    }
    __syncthreads();
}
constexpr int NWAVES = 8, NT = 512;
constexpr int D = 2048, NLAYER = 4;
constexpr int MC = 32 * 256, ML = 4 * 4096, M = MC + ML;
constexpr int DIN = 6176, NPROJ = 6144, NPAD = 6400, DFF = 8192, GWID = 512;
constexpr int NCP = M / 128;
constexpr float EPS = 1e-6f;
constexpr int PC_S5U = 0, PC_MQ = 512, PC_MK = 1024, PC_MV = 1536, PC_MO = 2048, PC_RQ = 2560, PC_RK = 3072, PC_RV = 3584, PC_RG = 4096, PC_DZ = 4608, PC_DX = 5120, PC_DB = 5632, PC_DC = 5888;
enum { I_XP = 0, I_XS, I_C, I_SS5R, I_SS5I, I_SMC, I_SMN, I_SMM, I_SRET, I_SSSD, I_CCTX, I_NORM1, I_WADA, I_BADA, I_WIN, I_S5LR, I_S5LI, I_S5DT, I_S5BR, I_S5BI, I_S5CR, I_S5CI, I_S5D, I_S5GLU,
       I_MIB, I_MFB, I_MNORM, I_RRATE, I_RNORM, I_CONVW, I_CONVB, I_DTB, I_ALOG, I_SSDD, I_SNORM, I_WOUT, I_NORM2, I_WM1, I_WM2, I_FNORM, N_IN };
constexpr size_t O_YP = 0, O_YS = (size_t)MC * D, O_S5R = (size_t)M * D, O_S5I = O_S5R + 524288, O_MC = O_S5I + 524288, O_MN = O_MC + 16777216, O_MM = O_MN + 131072, O_RET = O_MM + 1024, O_SSD = O_RET + 16777216, O_END = O_SSD + 16777216;

constexpr size_t MiB = 1u << 20;
constexpr size_t WS_CTL = 0, CTL_ZERO_BYTES = 1 * MiB;
constexpr size_t WS_MOD = 1 * MiB;
constexpr size_t WS_S5T = 2 * MiB;
constexpr size_t WS_ROPE = 5 * MiB;
constexpr size_t WS_GATES = 6 * MiB;
constexpr size_t WS_MLNLOC = 9 * MiB;
constexpr size_t WS_MLNIN = 10 * MiB;
constexpr size_t WS_MLSC = 11 * MiB;
constexpr size_t WS_MLMIN = 11 * MiB + 65536;
constexpr size_t WS_SDSC = 11 * MiB + 131072;
constexpr size_t WS_SSQA = 5 * MiB + 65536;
constexpr size_t WS_SSQB = 11 * MiB + 262144;
constexpr size_t WS_SHW1 = 18 * MiB;
constexpr size_t WS_SHW2 = 19 * MiB;
constexpr size_t WS_S5LOC = 12 * MiB;
constexpr size_t WS_WGT = 20 * MiB;
constexpr size_t WS_W1T = 22 * MiB;
constexpr size_t WS_WOT = 122 * MiB;
constexpr size_t WS_WM1T = 154 * MiB;
constexpr size_t WS_WM2T = 282 * MiB;
constexpr size_t WS_H = 410 * MiB;
constexpr size_t WS_Y = 506 * MiB;
constexpr size_t WS_YA = 602 * MiB;
constexpr size_t WS_MLCIN = 626 * MiB;
constexpr size_t WS_RTIN = 674 * MiB;
constexpr size_t WS_SDIN = 722 * MiB;
constexpr size_t WS_PROJ = 770 * MiB;
constexpr size_t WS_MLCLOC = 1058 * MiB;
constexpr size_t WS_HID = 770 * MiB;
constexpr size_t WS_RTLOC = 1106 * MiB;
constexpr size_t WS_SDLOC = 1154 * MiB;
constexpr size_t WS_XBCC = 1202 * MiB;
constexpr size_t WS_XB = 1250 * MiB;
constexpr size_t WS_END = 1346 * MiB;
constexpr int CW_TMO = 0, CW_BAR = 4096;

constexpr int LDT = 272;
constexpr int TS = 128 * LDT;
constexpr int LDX = 144;
constexpr int TSX = 128 * LDX;
constexpr int SCAL_OFF = 4 * TS;
constexpr int MISC_OFF = 163840 - 256;
constexpr int LDS_BYTES = 163840;
#define SCA(i) ((LAS float*)(F.lds + SCAL_OFF + (i) * 512))
typedef float f32x16 __attribute__((ext_vector_type(16)));
typedef float f32x2 __attribute__((ext_vector_type(2)));
typedef short s16x4 __attribute__((ext_vector_type(4)));
typedef unsigned u32x2 __attribute__((ext_vector_type(2)));
struct Args { const float* in[N_IN]; float* out; unsigned char* ws; int ph_lo, ph_hi; };
struct Frame {
    LAS unsigned char* lds;
    float* out; unsigned char* ws;
    int tid, lane, wave, G, bid;
};
__device__ __forceinline__ int lane_id() { return (int)__builtin_amdgcn_mbcnt_hi(~0u, __builtin_amdgcn_mbcnt_lo(~0u, 0u)); }
typedef const __attribute__((address_space(4))) Args KArgs;
__device__ __forceinline__ KArgs* kargs() { KArgs* p = (KArgs*)__builtin_amdgcn_kernarg_segment_ptr(); asm volatile("" : "+s"(p)); return p; }
__device__ __forceinline__ Frame fresh(const Frame& F) { Frame R = F; unsigned long long l = (unsigned long long)(size_t)R.lds; unsigned ll = (unsigned)l; asm volatile("" : "+s"(ll), "+s"(R.wave), "+s"(R.G), "+s"(R.bid)); R.lane = lane_id(); asm volatile("" : "+v"(R.lane)); R.tid = R.wave * 64 + R.lane; R.lds = (LAS unsigned char*)(size_t)ll; KArgs* ka = kargs(); R.out = (float*)(GAS float*)ka->out; R.ws = (unsigned char*)(GAS unsigned char*)ka->ws; return R; }
#define INP(i) ((const float*)(const GAS float*)(A.in[i]))
#define BAR() __syncthreads()
#ifndef PROBE_IMASK
#define PROBE_IMASK 0
#endif
#define ITS(k) do { if ((PROBE_IMASK >> (k)) & 1) { if (F.tid == 0 && F.bid == 0) ((volatile LAS unsigned long long*)(F.lds + MISC_OFF + 128))[0] = __builtin_amdgcn_s_memrealtime(); } } while (0)
#define ITE(k) do { if ((PROBE_IMASK >> (k)) & 1) { if (F.tid == 0 && F.bid == 0) { volatile LAS unsigned long long* p_ = (volatile LAS unsigned long long*)(F.lds + MISC_OFF + 128); p_[1] += __builtin_amdgcn_s_memrealtime() - p_[0]; } } } while (0)
#define WSP(T, off) ((T*)(F.ws + (off)))
__device__ __forceinline__ float bf2f(unsigned short b) { return __uint_as_float((unsigned)b << 16); }
__device__ __forceinline__ float bflo(unsigned w) { return __uint_as_float(w << 16); }
__device__ __forceinline__ float bfhi(unsigned w) { return __uint_as_float(w & 0xffff0000u); }
__device__ __forceinline__ void unpack8(const v4u a, float (&x)[8]) { x[0] = bflo(a.x); x[1] = bfhi(a.x); x[2] = bflo(a.y); x[3] = bfhi(a.y); x[4] = bflo(a.z); x[5] = bfhi(a.z); x[6] = bflo(a.w); x[7] = bfhi(a.w); }
__device__ __forceinline__ v4u pack8(const float (&x)[8], float w) { v4u o; o.x = pk2(x[0] * w, x[1] * w); o.y = pk2(x[2] * w, x[3] * w); o.z = pk2(x[4] * w, x[5] * w); o.w = pk2(x[6] * w, x[7] * w); return o; }
__device__ __forceinline__ float sigmoidf_(float x) { return __builtin_amdgcn_rcpf(1.f + __expf(-x)); }
__device__ __forceinline__ float siluf_(float x) { return x * sigmoidf_(x); }
__device__ __forceinline__ float lshfl(float v, int src_lane) { return __builtin_bit_cast(float, __builtin_amdgcn_ds_bpermute(src_lane << 2, __builtin_bit_cast(int, v))); }
__device__ __forceinline__ float lshfl_xor(float v, int m, int lane) { return lshfl(v, lane ^ m); }
__device__ __forceinline__ float lshfl_up(float v, int o, int lane) { return lshfl(v, lane >= o ? lane - o : lane); }
__device__ __forceinline__ float wave_sum(float v) {
#pragma unroll
    for (int o = 1; o < 64; o <<= 1) v += __shfl_xor(v, o);
    return v;
}
__device__ __forceinline__ float wave_max(float v) {
#pragma unroll
    for (int o = 1; o < 64; o <<= 1) v = fmaxf(v, __shfl_xor(v, o));
    return v;
}
__device__ __forceinline__ float wave_sum_l(float v, int lane) {
#pragma unroll
    for (int o = 1; o < 64; o <<= 1) v += lshfl_xor(v, o, lane);
    return v;
}
__device__ __forceinline__ float wave_max_l(float v, int lane) {
#pragma unroll
    for (int o = 1; o < 64; o <<= 1) v = fmaxf(v, lshfl_xor(v, o, lane));
    return v;
}
template <bool MAX> __device__ __forceinline__ void wave_scan128(const LAS float* in, LAS float* out, int lane, bool rev, float init) {
    const int i0 = rev ? 127 - 2 * lane : 2 * lane, i1 = rev ? i0 - 1 : i0 + 1;
    float e0 = in[i0], e1 = in[i1];
    if (lane == 0) e0 = MAX ? fmaxf(e0, init) : e0 + init;
    float inc = MAX ? fmaxf(e0, e1) : e0 + e1;
#pragma unroll
    for (int o = 1; o < 64; o <<= 1) { const float t = __shfl_up(inc, o); if (lane >= o) inc = MAX ? fmaxf(inc, t) : inc + t; }
    float exc = __shfl_up(inc, 1);
    const float o0 = (lane == 0) ? e0 : (MAX ? fmaxf(exc, e0) : exc + e0);
    out[i0] = o0; out[i1] = inc;
}
__device__ __forceinline__ s16x4 lds_tr(const LAS unsigned char* p) {
    typedef short v4i16_t __attribute__((ext_vector_type(4)));
    return __builtin_bit_cast(s16x4, __builtin_amdgcn_ds_read_tr16_b64_v4i16((LAS v4i16_t*)p));
}
__device__ __forceinline__ bf16x8 frag_row(const LAS unsigned char* base, int ld, int r0, int k0, int lane) {
    return *(const LAS bf16x8*)(base + (r0 + (lane & 31)) * ld + (k0 + 8 * (lane >> 5)) * 2);
}
__device__ __forceinline__ bf16x8 frag_tr(const LAS unsigned char* base, int ld, int k0, int c0, int lane) {
    const int h = lane >> 5, blk = (lane >> 4) & 1, q = (lane & 15) >> 2, p = lane & 3;
    const LAS unsigned char* a = base + (k0 + 8 * h + q) * ld + (c0 + 16 * blk + 4 * p) * 2;
    const s16x4 lo = lds_tr(a), hi = lds_tr(a + 4 * ld);
    return (bf16x8){lo[0], lo[1], lo[2], lo[3], hi[0], hi[1], hi[2], hi[3]};
}
__device__ __forceinline__ bf16x8 frag_trp(const LAS unsigned char* base, int ld, int k0, int c0, int lane) {
    const int h = lane >> 5, blk = (lane >> 4) & 1, q = (lane & 15) >> 2, p = lane & 3;
    const LAS unsigned char* a = base + (k0 + 4 * h + q) * ld + (c0 + 16 * blk + 4 * p) * 2;
    const s16x4 lo = lds_tr(a), hi = lds_tr(a + 8 * ld);
    return (bf16x8){lo[0], lo[1], lo[2], lo[3], hi[0], hi[1], hi[2], hi[3]};
}
#define MFMA32(a, b, c) __builtin_amdgcn_mfma_f32_32x32x16_bf16((a), (b), (c), 0, 0, 0)
#define ZERO16 ((f32x16){0.f,0.f,0.f,0.f,0.f,0.f,0.f,0.f,0.f,0.f,0.f,0.f,0.f,0.f,0.f,0.f})
__device__ __forceinline__ int crow(int i, int hh) { return (i & 3) + 8 * (i >> 2) + 4 * hh; }

#define PT(cp, col) (WSP(const bf16, WS_PROJ) + ((size_t)(cp) * 48 + ((col) >> 7)) * 16384 + ((col) & 127))
#define XT(cp, ch) (WSP(bf16, WS_XBCC) + ((size_t)(cp) * 8 + ((ch) >> 7)) * 16384 + ((ch) & 127))
__device__ __forceinline__ const float* x_in_row(const Frame& F, KArgs& A, int l, int r) {
    if (l == 0) return r < MC ? INP(I_XP) + (size_t)r * D : INP(I_XS) + (size_t)(r - MC) * D;
    return F.out + (size_t)r * D;
}
__device__ __forceinline__ int mod_row(int r) { return r < MC ? 0 : 1 + (r - MC) / 4096; }
__device__ __forceinline__ const float* mod_ptr(const Frame& F, int l, int mrow, int part) { return WSP(const float, WS_MOD) + ((size_t)(l * 5 + mrow) * 6 + part) * D; }
struct Seq { int cp0, nch, c, b, lat; };
__device__ __forceinline__ Seq seq_of(int cp) { Seq s; if (cp < 64) { s.lat = 0; s.b = cp >> 1; s.cp0 = cp & ~1; s.nch = 2; s.c = cp & 1; } else { s.lat = 1; s.b = (cp - 64) >> 5; s.cp0 = 64 + (s.b << 5); s.nch = 32; s.c = (cp - 64) & 31; } return s; }
__device__ __forceinline__ int w1_newcol(int n) { return n < 2560 ? n : (n < 2576 ? n - 2560 + 6144 : (n < 6160 ? n - 16 : n)); }
template <bool MAPW1> __device__ __forceinline__ void p0_transpose_item(const float* W, int K, int N, bf16* WT, LAS float* scr, int item, int lane) {
    const int nblk = N / 32, kb = item / nblk, nb = item % nblk, k0 = 64 * kb, n0 = 32 * nb;
#pragma unroll 8
    for (int i = 0; i < 32; ++i) { const int kk = 2 * i + (lane >> 5); scr[kk * 33 + (lane & 31)] = W[(size_t)(k0 + kk) * N + n0 + (lane & 31)]; }
    LDS_WAIT(); asm volatile("" ::: "memory");
    const int c = lane & 7;
#pragma unroll
    for (int j = 0; j < 4; ++j) { const int n = (lane >> 3) + 8 * j; const LAS float* s = scr + (8 * c) * 33 + n;
        v4u o; o.x = pk2(s[0 * 33], s[1 * 33]); o.y = pk2(s[2 * 33], s[3 * 33]); o.z = pk2(s[4 * 33], s[5 * 33]); o.w = pk2(s[6 * 33], s[7 * 33]);
        const int nr = MAPW1 ? w1_newcol(n0 + n) : (n0 + n);
        *(GAS v4u*)(WT + (size_t)nr * K + k0 + 8 * c) = o; }
    LDS_WAIT(); asm volatile("" ::: "memory");
}
constexpr int S5T_STRIDE = 9216;
__device__ __forceinline__ unsigned char* s5tab(const Frame& F, int l, int d, int g) { return F.ws + WS_S5T + (size_t)((l * 2 + d) * 32 + g) * S5T_STRIDE; }

__device__ __forceinline__ void p0_prologue(Frame& F, KArgs& A) {
    {
        LAS float* scr = (LAS float*)(F.lds + F.wave * 16384);
        const int gw = F.bid * NWAVES + F.wave, NGW = F.G * NWAVES;
        constexpr int I_1 = (D / 64) * (DIN / 32), I_G = (GWID / 64) * (GWID / 32), I_O = (D / 64) * (D / 32), I_M1 = (D / 64) * (DFF / 32), I_M2 = (DFF / 64) * (D / 32);
        constexpr int PER_L = I_1 + I_G + I_O + I_M1 + I_M2;
        for (int it = gw; it < NLAYER * PER_L; it += NGW) {
            const int l = it / PER_L; int r = it % PER_L;
            if (r < I_1) { p0_transpose_item<true>(INP(I_WIN) + (size_t)l * D * DIN, D, DIN, WSP(bf16, WS_W1T) + (size_t)l * NPAD * D, scr, r, F.lane); continue; } r -= I_1;
            if (r < I_G) { p0_transpose_item<false>(INP(I_S5GLU) + (size_t)l * GWID * GWID, GWID, GWID, WSP(bf16, WS_WGT) + (size_t)l * GWID * GWID, scr, r, F.lane); continue; } r -= I_G;
            if (r < I_O) { p0_transpose_item<false>(INP(I_WOUT) + (size_t)l * D * D, D, D, WSP(bf16, WS_WOT) + (size_t)l * D * D, scr, r, F.lane); continue; } r -= I_O;
            if (r < I_M1) { p0_transpose_item<false>(INP(I_WM1) + (size_t)l * D * DFF, D, DFF, WSP(bf16, WS_WM1T) + (size_t)l * DFF * D, scr, r, F.lane); continue; } r -= I_M1;
            p0_transpose_item<false>(INP(I_WM2) + (size_t)l * DFF * D, DFF, D, WSP(bf16, WS_WM2T) + (size_t)l * D * DFF, scr, r, F.lane);
        }
        const int gt = F.bid * NT + F.tid, NGT = F.G * NT;
        for (int i = gt; i < NLAYER * 224 * 256; i += NGT) { const int l = i / (224 * 256), r = i % (224 * 256);
            *(GAS v4u*)(WSP(bf16, WS_W1T) + ((size_t)l * NPAD + DIN) * D + (size_t)r * 8) = (v4u){0u, 0u, 0u, 0u}; }
        for (int i = gt; i < NLAYER * 2 * 32 * 64; i += NGT) {
            const int p = i & 63, g = (i >> 6) & 31, d = (i >> 11) & 1, l = i >> 12;
            const int ldg = (l * 2 + d) * 32 + g;
            const double lre = INP(I_S5LR)[ldg * 64 + p], lim = INP(I_S5LI)[ldg * 64 + p], dt = exp((double)INP(I_S5DT)[ldg]);
            const double er = exp(lre * dt), br = er * cos(lim * dt), bi = er * sin(lim * dt);
            const double e128 = exp(128.0 * lre * dt), b128r = e128 * cos(128.0 * lim * dt), b128i = e128 * sin(128.0 * lim * dt);
            const double nr = br - 1.0, ni = bi, den = lre * lre + lim * lim;
            const double cr = (nr * lre + ni * lim) / den, ci = (ni * lre - nr * lim) / den;
            unsigned char* tb = s5tab(F, l, d, g);
            float* lam = (float*)tb; lam[2 * p] = (float)br; lam[2 * p + 1] = (float)bi;
            float* l128 = (float*)(tb + 512); l128[2 * p] = (float)b128r; l128[2 * p + 1] = (float)b128i;
            bf16* bb = (bf16*)(tb + 1024); bf16* ct = (bf16*)(tb + 5120);
            for (int c = 0; c < 16; ++c) {
                const double Br = INP(I_S5BR)[(size_t)(ldg * 64 + p) * 16 + c], Bi = INP(I_S5BI)[(size_t)(ldg * 64 + p) * 16 + c];
                bb[(2 * p) * 16 + c] = (bf16)f2bf((float)(cr * Br - ci * Bi));
                bb[(2 * p + 1) * 16 + c] = (bf16)f2bf((float)(cr * Bi + ci * Br));
                ct[c * 128 + 2 * p] = (bf16)f2bf(INP(I_S5CR)[(size_t)(ldg * 16 + c) * 64 + p]);
                ct[c * 128 + 2 * p + 1] = (bf16)f2bf(-INP(I_S5CI)[(size_t)(ldg * 16 + c) * 64 + p]);
            }
        }
        for (int i = gt; i < 64 * 32; i += NGT) { const int pos = i >> 5, k = i & 31; const double f = pow(10000.0, -(double)k / 32.0), a = pos * f;
            WSP(f32x2, WS_ROPE)[i] = (f32x2){(float)cos(a), (float)sin(a)}; }
    }
    __syncthreads();
    {
        LAS float* sc = (LAS float*)F.lds;
        LAS float* red = (LAS float*)(F.lds + 65536);
        for (int i = F.tid; i < 5 * D; i += NT) { const int r = i / D, k = i % D; const float v = r == 0 ? INP(I_CCTX)[k] : INP(I_C)[(r - 1) * D + k]; sc[i] = siluf_(v); }
        __syncthreads();
        for (int it = F.bid; it < NLAYER * 96; it += F.G) {
            const int l = it / 96, c0 = (it % 96) * 128;
            const float* W = INP(I_WADA) + (size_t)l * D * (6 * D);
            float acc[5][4];
#pragma unroll
            for (int r = 0; r < 5; ++r)
#pragma unroll
                for (int j = 0; j < 4; ++j) acc[r][j] = 0.f;
            const int cl = F.lane & 31, kp = F.lane >> 5;
#pragma unroll 4
            for (int kk = 0; kk < 128; ++kk) {
                const int k = F.wave * 256 + 2 * kk + kp;
                const f32x4 w = *(const f32x4*)(W + (size_t)k * (6 * D) + c0 + 4 * cl);
#pragma unroll
                for (int r = 0; r < 5; ++r) { const float s = sc[r * D + k]; acc[r][0] += s * w.x; acc[r][1] += s * w.y; acc[r][2] += s * w.z; acc[r][3] += s * w.w; }
            }
#pragma unroll
            for (int r = 0; r < 5; ++r)
#pragma unroll
                for (int j = 0; j < 4; ++j) { acc[r][j] += __shfl_xor(acc[r][j], 32); }
            if (kp == 0) {
#pragma unroll
                for (int r = 0; r < 5; ++r)
#pragma unroll
                    for (int j = 0; j < 4; ++j) red[(F.wave * 5 + r) * 128 + 4 * cl + j] = acc[r][j];
            }
            __syncthreads();
            for (int i = F.tid; i < 5 * 128; i += NT) { const int r = i >> 7, j = i & 127; float s = 0.f;
#pragma unroll
                for (int w = 0; w < 8; ++w) s += red[(w * 5 + r) * 128 + j];
                WSP(float, WS_MOD)[(size_t)(l * 5 + r) * (6 * D) + c0 + j] = s + INP(I_BADA)[(size_t)l * (6 * D) + c0 + j]; }
            __syncthreads();
        }
    }
}

__device__ __forceinline__ void norm0_phase(Frame& F, KArgs& A) {
    const int gw = F.bid * NWAVES + F.wave, NGW = F.G * NWAVES;
    const float* gain = INP(I_NORM1);
    for (int m = gw; m < M; m += NGW) {
        const float* xr = x_in_row(F, A, 0, m);
        const float* scp = mod_ptr(F, 0, mod_row(m), 1);
        f32x4 v[8]; float s = 0.f;
#pragma unroll
        for (int j = 0; j < 8; ++j) { v[j] = *(const f32x4*)(xr + 4 * F.lane + 256 * j); s += (v[j].x * v[j].x + v[j].y * v[j].y) + (v[j].z * v[j].z + v[j].w * v[j].w); }
        s = wave_sum(s);
        if (F.lane < 8) WSP(float, WS_SSQB)[(size_t)m * 8 + F.lane] = F.lane == 0 ? s : 0.f;
        bf16* orow = WSP(bf16, WS_H) + (size_t)m * D;
#pragma unroll
        for (int j = 0; j < 8; ++j) { const int c = 4 * F.lane + 256 * j;
            const f32x4 g4 = *(const f32x4*)(gain + c), s4 = *(const f32x4*)(scp + c);
            *(u32x2*)(orow + c) = (u32x2){pk2(v[j].x * g4.x * (1.f + s4.x), v[j].y * g4.y * (1.f + s4.y)), pk2(v[j].z * g4.z * (1.f + s4.z), v[j].w * g4.w * (1.f + s4.w))}; }
    }
}
__device__ __forceinline__ void shw_phase(Frame& F) {
    LAS float* red = (LAS float*)F.lds;
    const int hh = F.lane >> 5, r = F.lane & 31, k0 = F.wave * 256;
    constexpr int NB1 = DIN / 32, NB2 = DFF / 32, PER_L = NB1 + NB2;
    for (int task = F.bid; task < NLAYER * PER_L; task += F.G) {
        const int l = task / PER_L, t2 = task % PER_L, which = t2 >= NB1 ? 1 : 0, nb = which ? t2 - NB1 : t2;
        const int NS = which ? DFF : NPAD;
        const bf16* Wt = (which ? WSP(const bf16, WS_WM1T) + (size_t)l * DFF * D : WSP(const bf16, WS_W1T) + (size_t)l * NPAD * D) + (size_t)(32 * nb + r) * D + k0 + 8 * hh;
        const float* sh = WSP(const float, WS_MOD) + ((size_t)(l * 5 + (r < 5 ? r : 0)) * 6 + (which ? 3 : 0)) * D + k0 + 8 * hh;
        bf16x8 bw[16];
#pragma unroll
        for (int ks = 0; ks < 16; ++ks) bw[ks] = *(const bf16x8*)(Wt + 16 * ks);
        f32x16 acc = ZERO16;
#pragma unroll
        for (int ks = 0; ks < 16; ++ks) { v4u a = (v4u){0u, 0u, 0u, 0u};
            if (r < 5) { const f32x4 s0 = *(const f32x4*)(sh + 16 * ks), s1 = *(const f32x4*)(sh + 16 * ks + 4); a = (v4u){pk2(s0.x, s0.y), pk2(s0.z, s0.w), pk2(s1.x, s1.y), pk2(s1.z, s1.w)}; }
            acc = MFMA32(__builtin_bit_cast(bf16x8, a), bw[ks], acc); }
        if (hh == 0) { red[(F.wave * 5 + 0) * 32 + r] = acc[0]; red[(F.wave * 5 + 1) * 32 + r] = acc[1]; red[(F.wave * 5 + 2) * 32 + r] = acc[2]; red[(F.wave * 5 + 3) * 32 + r] = acc[3]; }
        else red[(F.wave * 5 + 4) * 32 + r] = acc[0];
        __syncthreads();
        if (F.tid < 160) { const int row = F.tid >> 5, col = F.tid & 31; float s = 0.f;
#pragma unroll
            for (int w = 0; w < 8; ++w) s += red[(w * 5 + row) * 32 + col];
            (which ? WSP(float, WS_SHW2) + (size_t)l * 5 * DFF : WSP(float, WS_SHW1) + (size_t)l * 5 * NPAD)[(size_t)row * NS + 32 * nb + col] = s; }
        __syncthreads();
    }
}
__device__ __forceinline__ void final_norm_phase(Frame& F, KArgs& A) {
    const int gw = F.bid * NWAVES + F.wave, NGW = F.G * NWAVES;
    const float* gain = INP(I_FNORM);
    for (int m = gw; m < M; m += NGW) {
        const bf16* xr = WSP(const bf16, WS_XB) + (size_t)m * D; float* orow = F.out + (size_t)m * D;
        float v[4][8]; float s = 0.f;
#pragma unroll
        for (int j = 0; j < 4; ++j) { unpack8(*(const v4u*)(xr + 8 * F.lane + 512 * j), v[j]);
#pragma unroll
            for (int k = 0; k < 8; ++k) s += v[j][k] * v[j][k]; }
        const float rstd = rsqrtf(wave_sum(s) * (1.f / D) + EPS);
#pragma unroll
        for (int j = 0; j < 4; ++j) { const int c = 8 * F.lane + 512 * j; const f32x4 g0 = *(const f32x4*)(gain + c), g1 = *(const f32x4*)(gain + c + 4);
            *(f32x4*)(orow + c) = (f32x4){v[j][0] * rstd * g0.x, v[j][1] * rstd * g0.y, v[j][2] * rstd * g0.z, v[j][3] * rstd * g0.w};
            *(f32x4*)(orow + c + 4) = (f32x4){v[j][4] * rstd * g1.x, v[j][5] * rstd * g1.y, v[j][6] * rstd * g1.z, v[j][7] * rstd * g1.w}; }
    }
}

__device__ __forceinline__ void gates_phase(Frame& F, int l) {
    const bf16* XA = WSP(const bf16, WS_H); const bf16* Wg = WSP(const bf16, WS_W1T) + ((size_t)l * NPAD + NPROJ) * D;
    const float* shw = WSP(const float, WS_SHW1) + (size_t)l * 5 * NPAD + NPROJ;
    const int hh = F.lane >> 5, r = F.lane & 31, k0 = F.wave * 256;
    LAS float* red = (LAS float*)F.lds;
    bf16x8 bw[16];
#pragma unroll
    for (int ks = 0; ks < 16; ++ks) bw[ks] = *(const bf16x8*)(Wg + (size_t)r * D + k0 + 16 * ks + 8 * hh);
    for (int rb = F.bid; rb < M / 32; rb += F.G) {
        f32x16 acc = ZERO16;
#pragma unroll
        for (int half = 0; half < 2; ++half) { bf16x8 a[8];
#pragma unroll
            for (int j = 0; j < 8; ++j) a[j] = *(const bf16x8*)(XA + (size_t)(32 * rb + r) * D + k0 + 16 * (8 * half + j) + 8 * hh);
#pragma unroll
            for (int j = 0; j < 8; ++j) acc = MFMA32(a[j], bw[8 * half + j], acc); }
#pragma unroll
        for (int i = 0; i < 16; ++i) red[(F.wave * 32 + crow(i, hh)) * 33 + r] = acc[i];
        BAR();
#pragma unroll
        for (int q = 0; q < 2; ++q) { const int idx = F.tid * 2 + q, row = idx >> 5, col = idx & 31; float s = 0.f;
#pragma unroll
            for (int w = 0; w < 8; ++w) s += red[(w * 32 + row) * 33 + col];
            const int grow = 32 * rb + row; const float* part = WSP(const float, WS_SSQB) + (size_t)grow * 8;
            const float ssq = ((part[0] + part[1]) + (part[2] + part[3])) + ((part[4] + part[5]) + (part[6] + part[7]));
            WSP(float, WS_GATES)[(size_t)grow * 32 + col] = s * rsqrtf(ssq * (1.f / D) + EPS) + shw[(size_t)mod_row(grow) * NPAD + col]; }
        BAR();
    }
}
namespace epi {
__device__ __forceinline__ float rstd_of(const float* part, int r) { const pg8::f32x4 a = *(const pg8::f32x4*)(part + (size_t)r * 8), b = *(const pg8::f32x4*)(part + (size_t)r * 8 + 4);
    return rsqrtf((((a[0] + a[1]) + (a[2] + a[3])) + ((b[0] + b[1]) + (b[2] + b[3]))) * (1.f / D) + EPS); }
using pg8::Unit; using pg8::f32x4; using pg8::u32x4; using pg8::bf16_t; using pg8::cvt_pk_bf16;
constexpr int BMq = 256, HALFq = 128;
struct EpiProj {
    static constexpr bool PERM = true, AFTER_DRAIN = false;
    bf16_t* P; const float* ssq; const float* shw0;
    __device__ __forceinline__ void operator()(const f32x4 (&acc)[2][2][4][2], const Unit& u, int wr, int wc, int fr_, int fq_) const {
        int ln_ = (int)__builtin_amdgcn_mbcnt_hi(~0u, __builtin_amdgcn_mbcnt_lo(~0u, 0u)); asm volatile("" : "+v"(ln_)); const int fr = ln_ & 15, fq = ln_ >> 4; (void)fr_; (void)fq_;
        const int row0 = u.pm * BMq + wr * 64 + fr, rowt = u.pm * BMq, col0 = u.pn * BMq + wc * 32 + 8 * fq;
        const float* shw = shw0 + (size_t)(rowt < MC ? 0 : 1 + (rowt - MC) / 4096) * NPAD + col0;
        f32x4 sh[2][2];
#pragma unroll
        for (int bj = 0; bj < 2; ++bj) { sh[bj][0] = *(const f32x4*)(shw + bj * HALFq); sh[bj][1] = *(const f32x4*)(shw + bj * HALFq + 4); }
#pragma unroll
        for (int ai = 0; ai < 2; ++ai)
#pragma unroll
            for (int m = 0; m < 4; ++m) { const int r = row0 + ai * HALFq + m * 16; bf16_t* rowp = P + (((size_t)(r >> 7) * 48 + (col0 >> 7)) * 128 + (r & 127)) * 128 + (col0 & 127); const float rs = rstd_of(ssq, r);
#pragma unroll
                for (int bj = 0; bj < 2; ++bj) { const f32x4 v0 = acc[ai][bj][m][0] * rs + sh[bj][0], v1 = acc[ai][bj][m][1] * rs + sh[bj][1];
                    u32x4 w; w.x = cvt_pk_bf16(v0[0], v0[1]); w.y = cvt_pk_bf16(v0[2], v0[3]); w.z = cvt_pk_bf16(v1[0], v1[1]); w.w = cvt_pk_bf16(v1[2], v1[3]);
                    *(u32x4*)(rowp + bj * 16384) = w; } }
    }
};
struct EpiGlu {
    static constexpr bool PERM = true, AFTER_DRAIN = false;
    const bf16_t* YA; bf16_t* Y;
    __device__ __forceinline__ void operator()(const f32x4 (&acc)[2][2][4][2], const Unit& u, int wr, int wc, int fr_, int fq_) const {
        int ln_ = (int)__builtin_amdgcn_mbcnt_hi(~0u, __builtin_amdgcn_mbcnt_lo(~0u, 0u)); asm volatile("" : "+v"(ln_)); const int fr = ln_ & 15, fq = ln_ >> 4; (void)fr_; (void)fq_;
        const int row0 = u.pm * BMq + wr * 64 + fr, col0 = u.pn * BMq + wc * 32 + 8 * fq;
#pragma unroll
        for (int ai = 0; ai < 2; ++ai)
#pragma unroll
            for (int m = 0; m < 4; ++m) { const int r = row0 + ai * HALFq + m * 16;
#pragma unroll
                for (int bj = 0; bj < 2; ++bj) { const f32x4 v0 = acc[ai][bj][m][0], v1 = acc[ai][bj][m][1];
                    const u32x4 a = *(const u32x4*)(YA + (size_t)r * GWID + col0 + bj * HALFq);
                    float y[8] = {bflo(a.x), bfhi(a.x), bflo(a.y), bfhi(a.y), bflo(a.z), bfhi(a.z), bflo(a.w), bfhi(a.w)};
                    const float g[8] = {v0[0], v0[1], v0[2], v0[3], v1[0], v1[1], v1[2], v1[3]};
#pragma unroll
                    for (int k = 0; k < 8; ++k) y[k] = y[k] * sigmoidf_(g[k]);
                    u32x4 w; w.x = cvt_pk_bf16(y[0], y[1]); w.y = cvt_pk_bf16(y[2], y[3]); w.z = cvt_pk_bf16(y[4], y[5]); w.w = cvt_pk_bf16(y[6], y[7]);
                    *(u32x4*)(Y + (size_t)r * D + col0 + bj * HALFq) = w; } }
    }
};
struct EpiRes {
    static constexpr bool PERM = true, AFTER_DRAIN = false;
    const float* xp; const float* xs; bf16_t* XB; const float* gate0; int first;
    int NEXT; bf16_t* XA; float* ssq; const float* gn; const float* scn0; PG8_LAS unsigned char* scr;
    __device__ __forceinline__ void operator()(const f32x4 (&acc)[2][2][4][2], const Unit& u, int wr, int wc, int fr_, int fq_) const {
        int ln_ = (int)__builtin_amdgcn_mbcnt_hi(~0u, __builtin_amdgcn_mbcnt_lo(~0u, 0u)); asm volatile("" : "+v"(ln_)); const int fr = ln_ & 15, fq = ln_ >> 4; (void)fr_; (void)fq_;
        const int rowt = u.pm * BMq, col0 = u.pn * BMq + wc * 32 + 8 * fq;
        const int mrow = rowt < MC ? 0 : 1 + (rowt - MC) / 4096;
        const float* gate = gate0 + (size_t)mrow * (6 * D);
        const float* basef = rowt < MC ? xp + (size_t)rowt * D : xs + (size_t)(rowt - MC) * D;
        bf16_t* xb = XB + (size_t)rowt * D;
        float ss[2][4];
#pragma unroll
        for (int ai = 0; ai < 2; ++ai)
#pragma unroll
            for (int m = 0; m < 4; ++m) ss[ai][m] = 0.f;
#pragma unroll
        for (int bj = 0; bj < 2; ++bj) { const int c = col0 + bj * HALFq; const f32x4 g0 = *(const f32x4*)(gate + c), g1 = *(const f32x4*)(gate + c + 4);
            f32x4 a0 = (f32x4){0.f, 0.f, 0.f, 0.f}, a1 = a0;
            if (NEXT) { const float* scn = scn0 + (size_t)mrow * (6 * D); a0 = *(const f32x4*)(gn + c) * (*(const f32x4*)(scn + c) + 1.f); a1 = *(const f32x4*)(gn + c + 4) * (*(const f32x4*)(scn + c + 4) + 1.f); }
#pragma unroll
            for (int ai = 0; ai < 2; ++ai)
#pragma unroll
                for (int m = 0; m < 4; ++m) { const size_t off = (size_t)(wr * 64 + fr + ai * HALFq + m * 16) * D + c;
                    f32x4 b0, b1;
                    if (first) { b0 = *(const f32x4*)(basef + off); b1 = *(const f32x4*)(basef + off + 4); }
                    else { const u32x4 w = *(const u32x4*)(xb + off); b0 = (f32x4){bflo(w.x), bfhi(w.x), bflo(w.y), bfhi(w.y)}; b1 = (f32x4){bflo(w.z), bfhi(w.z), bflo(w.w), bfhi(w.w)}; }
                    const f32x4 x0 = b0 + g0 * acc[ai][bj][m][0], x1 = b1 + g1 * acc[ai][bj][m][1];
                    u32x4 xw; xw.x = cvt_pk_bf16(x0[0], x0[1]); xw.y = cvt_pk_bf16(x0[2], x0[3]); xw.z = cvt_pk_bf16(x1[0], x1[1]); xw.w = cvt_pk_bf16(x1[2], x1[3]);
                    *(u32x4*)(xb + off) = xw;
                    if (NEXT) { const f32x4 r0 = (f32x4){bflo(xw.x), bfhi(xw.x), bflo(xw.y), bfhi(xw.y)}, r1 = (f32x4){bflo(xw.z), bfhi(xw.z), bflo(xw.w), bfhi(xw.w)};
                        ss[ai][m] += (r0[0] * r0[0] + r0[1] * r0[1]) + (r0[2] * r0[2] + r0[3] * r0[3]) + (r1[0] * r1[0] + r1[1] * r1[1]) + (r1[2] * r1[2] + r1[3] * r1[3]);
                        const f32x4 y0 = r0 * a0, y1 = r1 * a1; u32x4 w; w.x = cvt_pk_bf16(y0[0], y0[1]); w.y = cvt_pk_bf16(y0[2], y0[3]); w.z = cvt_pk_bf16(y1[0], y1[1]); w.w = cvt_pk_bf16(y1[2], y1[3]);
                        *(u32x4*)(XA + (size_t)rowt * D + off) = w; }
                    if (m & 1) asm volatile("" ::: "memory"); } }
        if (NEXT) {
            PG8_LAS float* P4 = (PG8_LAS float*)scr;
#pragma unroll
            for (int ai = 0; ai < 2; ++ai)
#pragma unroll
                for (int m = 0; m < 4; ++m) { float s = ss[ai][m]; s += __shfl_xor(s, 16); s += __shfl_xor(s, 32);
                    if (fq == 0) P4[(ai * HALFq + wr * 64 + m * 16 + fr) * 4 + wc] = s; }
            asm volatile("s_waitcnt lgkmcnt(0)\n\ts_barrier" ::: "memory");
            { const int tid = (wr * 4 + wc) * 64 + fq * 16 + fr;
              if (tid < 256) { const f32x4 p = *(const PG8_LAS f32x4*)(P4 + tid * 4); ssq[(size_t)(rowt + tid) * 8 + u.pn] = (p[0] + p[1]) + (p[2] + p[3]); } }
            asm volatile("s_waitcnt lgkmcnt(0)\n\ts_barrier" ::: "memory");
        }
    }
};
struct EpiRelu2 {
    static constexpr bool PERM = true, AFTER_DRAIN = false;
    bf16_t* O; const float* ssq; const float* shw0;
    __device__ __forceinline__ void operator()(const f32x4 (&acc)[2][2][4][2], const Unit& u, int wr, int wc, int fr_, int fq_) const {
        int ln_ = (int)__builtin_amdgcn_mbcnt_hi(~0u, __builtin_amdgcn_mbcnt_lo(~0u, 0u)); asm volatile("" : "+v"(ln_)); const int fr = ln_ & 15, fq = ln_ >> 4; (void)fr_; (void)fq_;
        const int row0 = u.pm * BMq + wr * 64 + fr, col0 = u.pn * BMq + wc * 32 + 8 * fq, rowt = u.pm * BMq;
        const float* shw = shw0 + (size_t)(rowt < MC ? 0 : 1 + (rowt - MC) / 4096) * DFF + col0;
        f32x4 sh[2][2];
#pragma unroll
        for (int bj = 0; bj < 2; ++bj) { sh[bj][0] = *(const f32x4*)(shw + bj * HALFq); sh[bj][1] = *(const f32x4*)(shw + bj * HALFq + 4); }
#pragma unroll
        for (int ai = 0; ai < 2; ++ai)
#pragma unroll
            for (int m = 0; m < 4; ++m) { const int r = row0 + ai * HALFq + m * 16; bf16_t* rowp = O + (size_t)r * DFF + col0; const float rs = rstd_of(ssq, r);
#pragma unroll
                for (int bj = 0; bj < 2; ++bj) { f32x4 v0 = acc[ai][bj][m][0] * rs + sh[bj][0], v1 = acc[ai][bj][m][1] * rs + sh[bj][1];
#pragma unroll
                    for (int k = 0; k < 4; ++k) { const float a = fmaxf(v0[k], 0.f), b = fmaxf(v1[k], 0.f); v0[k] = a * a; v1[k] = b * b; }
                    u32x4 w; w.x = cvt_pk_bf16(v0[0], v0[1]); w.y = cvt_pk_bf16(v0[2], v0[3]); w.z = cvt_pk_bf16(v1[0], v1[1]); w.w = cvt_pk_bf16(v1[2], v1[3]);
                    *(u32x4*)(rowp + bj * HALFq) = w; } }
    }
};
}
__device__ __forceinline__ float logsigmoidf_(float x) { return fminf(x, 0.f) - __logf(1.f + __expf(-fabsf(x))); }
__device__ __forceinline__ float softplusf_(float x) { return fmaxf(x, 0.f) + __logf(1.f + __expf(-fabsf(x))); }
__device__ __forceinline__ void load_tile128(Frame& F, LAS unsigned char* dst, const bf16* src) {
#pragma unroll
    for (int it = 0; it < 4; ++it) { const int i = F.tid + NT * it, r = i >> 4, c = i & 15;
        *(LAS v4u*)(dst + r * LDT + c * 16) = *(const v4u*)(src + (size_t)r * 128 + c * 8); }
}
__device__ __forceinline__ void qk_issue(Frame& F, const bf16* src, v4u (&r)[4]) {
#pragma unroll
    for (int it = 0; it < 2; ++it) { const int i = F.tid + NT * it, rw = i >> 3, c = i & 7;
        r[2 * it] = *(const v4u*)(src + (size_t)rw * 128 + c * 8); r[2 * it + 1] = *(const v4u*)(src + (size_t)rw * 128 + 64 + c * 8); }
}
template <int NDST> __device__ __forceinline__ void qk_commit(Frame& F, LAS unsigned char* dst0, LAS unsigned char* dst1, const v4u (&rg)[4], const LAS float* w0, const LAS float* w1, float scale, bool rope, int tpos0) {
#pragma unroll
    for (int it = 0; it < 2; ++it) {
        const int i = F.tid + NT * it, r = i >> 3, c = i & 7;
        float x1[8], x2[8];
        unpack8(rg[2 * it], x1); unpack8(rg[2 * it + 1], x2);
        if (rope) {
            const int tp = tpos0 + r, pos = c < 4 ? (tp >> 6) : (tp & 63);
            const f32x2* rt = WSP(const f32x2, WS_ROPE) + pos * 32 + ((8 * c) & 31);
#pragma unroll
            for (int j = 0; j < 8; ++j) { const f32x2 cs = rt[j]; const float a = x1[j], b = x2[j]; x1[j] = a * cs.x - b * cs.y; x2[j] = a * cs.y + b * cs.x; }
        }
        const float s0 = scale * (w0 ? w0[r] : 1.f);
        *(LAS v4u*)(dst0 + r * LDT + c * 16) = pack8(x1, s0); *(LAS v4u*)(dst0 + r * LDT + 128 + c * 16) = pack8(x2, s0);
        if (NDST == 2) { const float s1 = scale * w1[r];
            *(LAS v4u*)(dst1 + r * LDT + c * 16) = pack8(x1, s1); *(LAS v4u*)(dst1 + r * LDT + 128 + c * 16) = pack8(x2, s1); }
    }
}
template <int NDST> __device__ __forceinline__ void load_qk(Frame& F, LAS unsigned char* dst0, LAS unsigned char* dst1, const bf16* src, const LAS float* w0, const LAS float* w1, float scale, bool rope, int tpos0) {
    v4u r[4]; qk_issue(F, src, r); qk_commit<NDST>(F, dst0, dst1, r, w0, w1, scale, rope, tpos0);
}
template <int NDST, int nc8> __device__ __forceinline__ void load_conv(Frame& F, KArgs& A, int l, LAS unsigned char* dst0, LAS unsigned char* dst1, int ldd, int ch0, int row0, int seq_lo, int seq_hi,
                                                               const LAS float* w0, const LAS float* w1, bool to_global) {
    const int c = F.tid % nc8;
    const float* cw = INP(I_CONVW) + (size_t)l * 5 * 1024 + ch0 + 8 * c; const float* cb = INP(I_CONVB) + (size_t)l * 1024 + ch0 + 8 * c;
    f32x4 wv[5][2];
#pragma unroll
    for (int k = 0; k < 5; ++k) { wv[k][0] = *(const f32x4*)(cw + k * 1024); wv[k][1] = *(const f32x4*)(cw + k * 1024 + 4); }
    const f32x4 b0 = *(const f32x4*)cb, b1 = *(const f32x4*)(cb + 4);
#pragma unroll 1
    for (int i = F.tid; i < 128 * nc8; i += NT) {
        const int r = i / nc8, row = row0 + r;
        float acc[8] = {b0.x, b0.y, b0.z, b0.w, b1.x, b1.y, b1.z, b1.w};
        v4u xr[5];
#pragma unroll
        for (int k = 0; k < 5; ++k) { const int rr = row + k - 2; xr[k] = (v4u){0u, 0u, 0u, 0u};
            if (rr >= seq_lo && rr < seq_hi) xr[k] = *(const v4u*)(PT(rr >> 7, PC_DX + ch0 + 8 * c) + (size_t)(rr & 127) * 128); }
#pragma unroll
        for (int k = 0; k < 5; ++k) { float x[8]; unpack8(xr[k], x);
            acc[0] += x[0] * wv[k][0].x; acc[1] += x[1] * wv[k][0].y; acc[2] += x[2] * wv[k][0].z; acc[3] += x[3] * wv[k][0].w; acc[4] += x[4] * wv[k][1].x; acc[5] += x[5] * wv[k][1].y; acc[6] += x[6] * wv[k][1].z; acc[7] += x[7] * wv[k][1].w; }
#pragma unroll
        for (int j = 0; j < 8; ++j) acc[j] = siluf_(acc[j]);
        if (to_global) *(v4u*)(XT(row >> 7, ch0 + 8 * c) + (size_t)(row & 127) * 128) = pack8(acc, 1.f);
        if (NDST >= 1) *(LAS v4u*)(dst0 + r * ldd + c * 16) = pack8(acc, w0 ? w0[r] : 1.f);
        if (NDST == 2) *(LAS v4u*)(dst1 + r * ldd + c * 16) = pack8(acc, w1[r]);
    }
}
template <int nc8> __device__ __forceinline__ void load_xbcc(Frame& F, LAS unsigned char* dst, int ldd, int ch0, int row0) {
    const bf16* P = XT(row0 >> 7, ch0);
    for (int i = F.tid; i < 128 * nc8; i += NT) { const int r = i / nc8, c = i % nc8; *(LAS v4u*)(dst + r * ldd + c * 16) = *(const v4u*)(P + (size_t)r * 128 + 8 * c); }
}
__device__ __forceinline__ void kv_state_mfma(Frame& F, const LAS unsigned char* TKf, const LAS unsigned char* TKb, const LAS unsigned char* TV, bf16* outF, bf16* outB) {
    const int dvb = F.wave >> 1, dkb0 = (F.wave & 1) * 2, hh = F.lane >> 5;
    f32x16 acc[2][2] = {{ZERO16, ZERO16}, {ZERO16, ZERO16}};
#pragma unroll 1
    for (int ks = 0; ks < 8; ++ks) {
        const bf16x8 a = frag_tr(TV, LDT, 16 * ks, 32 * dvb, F.lane);
#pragma unroll
        for (int j = 0; j < 2; ++j) { acc[0][j] = MFMA32(a, frag_tr(TKf, LDT, 16 * ks, 32 * (dkb0 + j), F.lane), acc[0][j]); acc[1][j] = MFMA32(a, frag_tr(TKb, LDT, 16 * ks, 32 * (dkb0 + j), F.lane), acc[1][j]); }
    }
#pragma unroll
    for (int j = 0; j < 2; ++j)
#pragma unroll
        for (int i = 0; i < 16; ++i) { const int o = (32 * dvb + crow(i, hh)) * 128 + 32 * (dkb0 + j) + (F.lane & 31); outF[o] = (bf16)f2bf(acc[0][j][i]); outB[o] = (bf16)f2bf(acc[1][j][i]); }
}
__device__ __forceinline__ void qkT_mfma(Frame& F, const LAS unsigned char* TQ, const LAS unsigned char* TK, f32x16 (&qk)[2]) {
    const int tb = F.wave >> 1, sb0 = (F.wave & 1) * 2;
    qk[0] = ZERO16; qk[1] = ZERO16;
#pragma unroll 1
    for (int ks = 0; ks < 8; ++ks) { const bf16x8 bq = frag_row(TQ, LDT, 32 * tb, 16 * ks, F.lane);
#pragma unroll
        for (int j = 0; j < 2; ++j) qk[j] = MFMA32(frag_row(TK, LDT, 32 * (sb0 + j), 16 * ks, F.lane), bq, qk[j]); }
}
__device__ __forceinline__ void pv_mfma(Frame& F, const LAS unsigned char* TP, const LAS unsigned char* TV, f32x16 (&o)[2]) {
    const int tb = F.wave >> 1, eb0 = (F.wave & 1) * 2;
#pragma unroll 1
    for (int ks = 0; ks < 8; ++ks) { const bf16x8 ap = frag_row(TP, LDT, 32 * tb, 16 * ks, F.lane);
#pragma unroll
        for (int j = 0; j < 2; ++j) o[j] = MFMA32(ap, frag_tr(TV, LDT, 16 * ks, 32 * (eb0 + j), F.lane), o[j]); }
}
__device__ __forceinline__ void pv_mfma_range(Frame& F, const LAS unsigned char* TP, const LAS unsigned char* TV, f32x16 (&o)[2], int k_lo, int k_hi) {
    const int tb = F.wave >> 1, eb0 = (F.wave & 1) * 2;
#pragma unroll 1
    for (int ks = k_lo; ks < k_hi; ++ks) { const bf16x8 ap = frag_row(TP, LDT, 32 * tb, 16 * ks, F.lane);
#pragma unroll
        for (int j = 0; j < 2; ++j) o[j] = MFMA32(ap, frag_tr(TV, LDT, 16 * ks, 32 * (eb0 + j), F.lane), o[j]); }
}
__device__ __forceinline__ void qs_prefetch(Frame& F, const bf16* ST, bf16x8 (&b)[2][8]) {
    const int eb0 = (F.wave & 1) * 2, hh = F.lane >> 5;
#pragma unroll
    for (int j = 0; j < 2; ++j)
#pragma unroll
        for (int ks = 0; ks < 8; ++ks) b[j][ks] = *(const bf16x8*)(ST + (size_t)(32 * (eb0 + j) + (F.lane & 31)) * 128 + 16 * ks + 8 * hh);
}
__device__ __forceinline__ void qs_mfma(Frame& F, const LAS unsigned char* TQ, const bf16x8 (&b)[2][8], f32x16 (&o)[2]) {
    const int tb = F.wave >> 1;
#pragma unroll
    for (int ks = 0; ks < 8; ++ks) { const bf16x8 aq = frag_row(TQ, LDT, 32 * tb, 16 * ks, F.lane);
#pragma unroll
        for (int j = 0; j < 2; ++j) o[j] = MFMA32(aq, b[j][ks], o[j]); }
}
__device__ __forceinline__ void hs_to_lds(Frame& F, LAS unsigned char* HS, const f32x16 (&hs)[2]) {
    const int tb = F.wave >> 1, eb0 = (F.wave & 1) * 2, hh = F.lane >> 5;
#pragma unroll
    for (int j = 0; j < 2; ++j)
#pragma unroll
        for (int i = 0; i < 16; ++i) *(LAS float*)(HS + (32 * tb + crow(i, hh)) * 528 + (32 * (eb0 + j) + (F.lane & 31)) * 4) = hs[j][i];
}
template <int GATE> __device__ __forceinline__ void head_out(Frame& F, const LAS unsigned char* HS, const float* gain, const bf16* gsrc  , bf16* ydst  ) {
    const int t = F.tid >> 2, seg = F.tid & 3;
    float v[32]; float ss = 0.f;
#pragma unroll
    for (int k = 0; k < 8; ++k) { const f32x4 x = *(const LAS f32x4*)(HS + t * 528 + (32 * seg + 4 * k) * 4); v[4 * k] = x.x; v[4 * k + 1] = x.y; v[4 * k + 2] = x.z; v[4 * k + 3] = x.w; ss += (x.x * x.x + x.y * x.y) + (x.z * x.z + x.w * x.w); }
    ss += __shfl_xor(ss, 1); ss += __shfl_xor(ss, 2);
    const float r = rsqrtf(ss * (1.f / 128.f) + EPS);
#pragma unroll
    for (int k = 0; k < 4; ++k) { float g[8]; unpack8(*(const v4u*)(gsrc + (size_t)t * 128 + 32 * seg + 8 * k), g); float o[8];
#pragma unroll
        for (int j = 0; j < 8; ++j) { const float gg = GATE == 0 ? sigmoidf_(g[j]) : siluf_(g[j]); o[j] = v[8 * k + j] * r * gain[32 * seg + 8 * k + j] * gg; }
        *(v4u*)(ydst + (size_t)t * D + 32 * seg + 8 * k) = pack8(o, 1.f); }
}

__device__ __forceinline__ void tile_issue(Frame& F, const bf16* src, v4u (&r)[4]) {
#pragma unroll
    for (int it = 0; it < 4; ++it) { const int i = F.tid + NT * it; r[it] = *(const v4u*)(src + (size_t)(i >> 4) * 128 + (i & 15) * 8); }
}
__device__ __forceinline__ void tile_commit(Frame& F, LAS unsigned char* dst, const v4u (&r)[4], float scale) {
#pragma unroll
    for (int it = 0; it < 4; ++it) { const int i = F.tid + NT * it; v4u v = r[it];
        if (scale != 1.f) { float x[8]; unpack8(v, x); v = pack8(x, scale); }
        *(LAS v4u*)(dst + (i >> 4) * LDT + (i & 15) * 16) = v; }
}
template <int GATE> __device__ __forceinline__ void head_out_r(Frame& F, const LAS unsigned char* HS, const float* gain, const v4u (&og)[4], bf16* ydst) {
    const int t = F.tid >> 2, seg = F.tid & 3;
    float v[32]; float ss = 0.f;
#pragma unroll
    for (int k = 0; k < 8; ++k) { const f32x4 x = *(const LAS f32x4*)(HS + t * 528 + (32 * seg + 4 * k) * 4); v[4 * k] = x.x; v[4 * k + 1] = x.y; v[4 * k + 2] = x.z; v[4 * k + 3] = x.w; ss += (x.x * x.x + x.y * x.y) + (x.z * x.z + x.w * x.w); }
    ss += __shfl_xor(ss, 1); ss += __shfl_xor(ss, 2);
    const float r = rsqrtf(ss * (1.f / 128.f) + EPS);
#pragma unroll
    for (int k = 0; k < 4; ++k) { float g[8]; unpack8(og[k], g); float o[8]; const f32x4 g0 = *(const f32x4*)(gain + 32 * seg + 8 * k), g1 = *(const f32x4*)(gain + 32 * seg + 8 * k + 4);
        const float gn[8] = {g0.x, g0.y, g0.z, g0.w, g1.x, g1.y, g1.z, g1.w};
#pragma unroll
        for (int j = 0; j < 8; ++j) { const float gg = GATE == 0 ? sigmoidf_(g[j]) : siluf_(g[j]); o[j] = v[8 * k + j] * r * gn[j] * gg; }
        *(v4u*)(ydst + (size_t)t * D + 32 * seg + 8 * k) = pack8(o, 1.f); }
}
__device__ __forceinline__ void mlstm_gates(Frame& F, KArgs& A, int l, int cp, int h) {
    if (F.tid < 128) { const float* g = WSP(const float, WS_GATES) + (size_t)(cp * 128 + F.tid) * 32;
        SCA(0)[F.tid] = g[h] + INP(I_MIB)[(l * 2 + 0) * 4 + h]; SCA(1)[F.tid] = g[4 + h] + INP(I_MIB)[(l * 2 + 1) * 4 + h];
        SCA(2)[F.tid] = logsigmoidf_(g[8 + h] + INP(I_MFB)[(l * 2 + 0) * 4 + h]); SCA(3)[F.tid] = logsigmoidf_(g[12 + h] + INP(I_MFB)[(l * 2 + 1) * 4 + h]); }
    BAR();
    if (F.wave == 0) wave_scan128<false>(SCA(2), SCA(4), F.lane, false, 0.f);
    if (F.wave == 1) wave_scan128<false>(SCA(3), SCA(5), F.lane, true, 0.f);
    BAR();
}
__device__ __forceinline__ void mlstm_local_item(Frame F, KArgs& A, int l, int cp, int h) {
    v4u rk[4], rv[4]; qk_issue(F, PT(cp, PC_MK + h * 128), rk); tile_issue(F, PT(cp, PC_MV + h * 128), rv);
    mlstm_gates(F, A, l, cp, h);
    if (F.wave < 2) { const int d = F.wave; const LAS float* bc = SCA(4 + d); const LAS float* ig = SCA(d); const float tot = d == 0 ? bc[127] : bc[0];
        const int s0 = 2 * F.lane; const float g0 = tot - bc[s0] + ig[s0], g1 = tot - bc[s0 + 1] + ig[s0 + 1];
        const float mx = wave_max(fmaxf(g0, g1));
        SCA(6 + d)[s0] = __expf(g0 - mx); SCA(6 + d)[s0 + 1] = __expf(g1 - mx);
        if (F.lane == 0) { float* sc = WSP(float, WS_MLSC) + ((cp * 2 + d) * 4 + h) * 2; sc[0] = tot; sc[1] = mx; } }
    BAR();
    qk_commit<2>(F, F.lds, F.lds + TS, rk, SCA(6), SCA(7), 0.08838834764831845f, false, 0);
    tile_commit(F, F.lds + 2 * TS, rv, 1.f);
    BAR();
    kv_state_mfma(F, F.lds, F.lds + TS, F.lds + 2 * TS, WSP(bf16, WS_MLCLOC) + (size_t)((cp * 2 + 0) * 4 + h) * 16384, WSP(bf16, WS_MLCLOC) + (size_t)((cp * 2 + 1) * 4 + h) * 16384);
    if (F.tid < 256) { const int d = F.tid >> 7, dk = F.tid & 127; const LAS unsigned char* T = F.lds + d * TS; float s = 0.f;
        for (int r = 0; r < 128; ++r) s += bf2f(*(const LAS unsigned short*)(T + r * LDT + dk * 2));
        WSP(float, WS_MLNLOC)[((cp * 2 + d) * 4 + h) * 128 + dk] = s; }
    BAR();
}
__device__ __forceinline__ void mlstm_out_item(Frame F, KArgs& A, int l, int cp, int h) {
    const Seq sq = seq_of(cp);
    LAS unsigned char* TQ = F.lds; LAS unsigned char* TK = F.lds + TS; LAS unsigned char* TV = F.lds + 2 * TS; LAS unsigned char* TP = F.lds + 3 * TS;
    ITS(0);
    v4u rq[4], rk[4], rv[4], og[4];
    tile_issue(F, PT(cp, PC_MQ + h * 128), rq); tile_issue(F, PT(cp, PC_MK + h * 128), rk); tile_issue(F, PT(cp, PC_MV + h * 128), rv);
    { const int t = F.tid >> 2, seg = F.tid & 3;
#pragma unroll
      for (int k = 0; k < 4; ++k) og[k] = *(const v4u*)(PT(cp, PC_MO + h * 128) + (size_t)t * 128 + 32 * seg + 8 * k); }
    const float min_f = WSP(const float, WS_MLMIN)[(cp * 2 + 0) * 4 + h], min_b = WSP(const float, WS_MLMIN)[(cp * 2 + 1) * 4 + h];
    float nin = 0.f; if (F.tid < 256) nin = WSP(const float, WS_MLNIN)[((cp * 2 + (F.tid >> 7)) * 4 + h) * 128 + (F.tid & 127)];
    mlstm_gates(F, A, l, cp, h);
    if (F.tid < 256) { const int d = F.tid >> 7, s = F.tid & 127; SCA(6 + d)[s] = SCA(d)[s] - SCA(4 + d)[s]; SCA(12 + d)[s] = nin; }
    tile_commit(F, TQ, rq, 1.f); tile_commit(F, TK, rk, 0.08838834764831845f); tile_commit(F, TV, rv, 1.f);
    BAR();
    if (F.wave == 0) wave_scan128<true>(SCA(6), SCA(8), F.lane, false, min_f);
    if (F.wave == 1) wave_scan128<true>(SCA(7), SCA(9), F.lane, true, min_b);
    BAR();
    ITE(0);
    f32x16 hs[2] = {ZERO16, ZERO16};
    const int tb = F.wave >> 1, sb0 = (F.wave & 1) * 2, hh = F.lane >> 5, t = 32 * tb + (F.lane & 31);
#pragma unroll 1
    for (int d = 0; d < 2; ++d) {
        const LAS float* av = SCA(6 + d); const float Mt = SCA(8 + d)[t]; const float m_in = d == 0 ? min_f : min_b;
        ITS(2);
        const bool has_state = sq.lat || (d == 0 ? sq.c > 0 : sq.c < sq.nch - 1);
        bf16x8 bst[2][8]; if (has_state) qs_prefetch(F, WSP(const bf16, WS_MLCIN) + (size_t)((cp * 2 + d) * 4 + h) * 16384, bst);
#ifndef PROBE_REP2
#define PROBE_REP2 1
#endif
#pragma unroll 1
        for (int rep2_ = 0; rep2_ < PROBE_REP2; ++rep2_) {
        f32x16 qk[2]; qkT_mfma(F, TQ, TK, qk);
#pragma unroll
        for (int j = 0; j < 2; ++j) { const int sblk = sb0 + j;
            if (d == 0 ? sblk > tb : sblk < tb) continue;
            const bool diag = sblk == tb;
#pragma unroll
            for (int i4 = 0; i4 < 4; ++i4) { const int sb = 32 * sblk + 8 * i4 + 4 * hh; float p[4]; const f32x4 a4 = *(const LAS f32x4*)(av + sb);
#pragma unroll
                for (int i = 0; i < 4; ++i) p[i] = qk[j][4 * i4 + i] * __expf(a4[i] - Mt);
                if (diag) {
#pragma unroll
                    for (int i = 0; i < 4; ++i) { const int s = sb + i; const bool ok = d == 0 ? (s <= t) : (s >= t); p[i] = ok ? p[i] : 0.f; } }
                *(LAS u32x2*)(TP + t * LDT + sb * 2) = (u32x2){pk2(p[0], p[1]), pk2(p[2], p[3])}; } }
        }
        ITE(2); ITS(3);
        BAR();
        {
            const int tt = F.tid >> 2, seg = F.tid & 3; float ds = 0.f, qn = 0.f;
            const bool pvalid = d == 0 ? seg <= (tt >> 5) : seg >= (tt >> 5);
#pragma unroll
            for (int k = 0; k < 4; ++k) { float x[8]; unpack8(pvalid ? *(const LAS v4u*)(TP + tt * LDT + 64 * seg + 16 * k) : (v4u){0u, 0u, 0u, 0u}, x); float q[8]; unpack8(*(const LAS v4u*)(TQ + tt * LDT + 64 * seg + 16 * k), q);
                const f32x4 n0 = *(const LAS f32x4*)(SCA(12 + d) + 32 * seg + 8 * k), n1 = *(const LAS f32x4*)(SCA(12 + d) + 32 * seg + 8 * k + 4);
                ds += ((x[0] + x[1]) + (x[2] + x[3])) + ((x[4] + x[5]) + (x[6] + x[7]));
                qn += (q[0] * n0.x + q[1] * n0.y) + (q[2] * n0.z + q[3] * n0.w) + (q[4] * n1.x + q[5] * n1.y) + (q[6] * n1.z + q[7] * n1.w); }
            ds += __shfl_xor(ds, 1); ds += __shfl_xor(ds, 2); qn += __shfl_xor(qn, 1); qn += __shfl_xor(qn, 2);
            if (seg == 0) { const float Mtt = SCA(8 + d)[tt], wint = __expf(m_in - Mtt), den = ds + wint * qn, dd = fmaxf(fabsf(den), __expf(-(SCA(4 + d)[tt] + Mtt)));
                const float rdd = __builtin_amdgcn_rcpf(dd); SCA(10)[tt] = wint * rdd; SCA(11)[tt] = rdd; } }
        { f32x16 num[2] = {ZERO16, ZERO16};
          pv_mfma_range(F, TP, TV, num, d == 0 ? 0 : 2 * tb, d == 0 ? 2 * tb + 2 : 8);
          BAR(); ITE(3); ITS(4);
#pragma unroll
          for (int j = 0; j < 2; ++j)
#pragma unroll
            for (int k4 = 0; k4 < 4; ++k4) { const f32x4 f4 = *(const LAS f32x4*)(SCA(11) + 32 * tb + 8 * k4 + 4 * hh);
#pragma unroll
                for (int i = 0; i < 4; ++i) hs[j][4 * k4 + i] += f4[i] * num[j][4 * k4 + i]; } }
        if (has_state) { f32x16 qc[2] = {ZERO16, ZERO16};
          qs_mfma(F, TQ, bst, qc);
#pragma unroll
          for (int j = 0; j < 2; ++j)
#pragma unroll
            for (int k4 = 0; k4 < 4; ++k4) { const f32x4 f4 = *(const LAS f32x4*)(SCA(10) + 32 * tb + 8 * k4 + 4 * hh);
#pragma unroll
                for (int i = 0; i < 4; ++i) hs[j][4 * k4 + i] += f4[i] * qc[j][4 * k4 + i]; } }
        ITE(4);
    }
    ITS(5);
    BAR();
    hs_to_lds(F, F.lds, hs);
    BAR();
    head_out_r<0>(F, F.lds, INP(I_MNORM) + (size_t)l * GWID + h * 128, og, WSP(bf16, WS_Y) + (size_t)cp * 128 * D + 512 + h * 128);
    BAR(); ITE(5);
}

__device__ __forceinline__ void ret_local_item(Frame F, KArgs& A, int l, int cp, int h) {
    const float lgf = -__expf(INP(I_RRATE)[(l * 2 + 0) * 4 + h]), lgb = -__expf(INP(I_RRATE)[(l * 2 + 1) * 4 + h]);
    v4u rk[4], rv[4]; qk_issue(F, PT(cp, PC_RK + h * 128), rk); tile_issue(F, PT(cp, PC_RV + h * 128), rv);
    if (F.tid < 128) { SCA(6)[F.tid] = __expf((127.f - (float)F.tid) * lgf); SCA(7)[F.tid] = __expf((float)F.tid * lgb); }
    BAR();
    const Seq sq = seq_of(cp);
    qk_commit<2>(F, F.lds, F.lds + TS, rk, SCA(6), SCA(7), 0.08838834764831845f, sq.lat != 0, sq.c * 128);
    tile_commit(F, F.lds + 2 * TS, rv, 1.f);
    BAR();
    kv_state_mfma(F, F.lds, F.lds + TS, F.lds + 2 * TS, WSP(bf16, WS_RTLOC) + (size_t)((cp * 2 + 0) * 4 + h) * 16384, WSP(bf16, WS_RTLOC) + (size_t)((cp * 2 + 1) * 4 + h) * 16384);
    BAR();
}
__device__ __forceinline__ void ret_out_item(Frame F, KArgs& A, int l, int cp, int h) {
    const float lgf = -__expf(INP(I_RRATE)[(l * 2 + 0) * 4 + h]), lgb = -__expf(INP(I_RRATE)[(l * 2 + 1) * 4 + h]);
    if (F.tid < 128) { SCA(10)[F.tid] = __expf(((float)F.tid + 1.f) * lgf); SCA(11)[F.tid] = __expf((128.f - (float)F.tid) * lgb); }
    const Seq sq = seq_of(cp);
    LAS unsigned char* TQ = F.lds; LAS unsigned char* TK = F.lds + TS; LAS unsigned char* TV = F.lds + 2 * TS; LAS unsigned char* TP = F.lds + 3 * TS;
    v4u rq[4], rk[4], rv[4], og[4];
    qk_issue(F, PT(cp, PC_RQ + h * 128), rq); qk_issue(F, PT(cp, PC_RK + h * 128), rk); tile_issue(F, PT(cp, PC_RV + h * 128), rv);
    { const int t_ = F.tid >> 2, seg_ = F.tid & 3;
#pragma unroll
      for (int k = 0; k < 4; ++k) og[k] = *(const v4u*)(PT(cp, PC_RG + h * 128) + (size_t)t_ * 128 + 32 * seg_ + 8 * k); }
    qk_commit<1>(F, TQ, nullptr, rq, nullptr, nullptr, 1.f, sq.lat != 0, sq.c * 128);
    qk_commit<1>(F, TK, nullptr, rk, nullptr, nullptr, 0.08838834764831845f, sq.lat != 0, sq.c * 128);
    tile_commit(F, TV, rv, 1.f);
    BAR();
    f32x16 qk[2]; qkT_mfma(F, TQ, TK, qk);
    const int tb = F.wave >> 1, sb0 = (F.wave & 1) * 2, hh = F.lane >> 5, t = 32 * tb + (F.lane & 31);
#pragma unroll
    for (int j = 0; j < 2; ++j)
#pragma unroll
        for (int i4 = 0; i4 < 4; ++i4) { const int sb = 32 * (sb0 + j) + 8 * i4 + 4 * hh; float p[4];
#pragma unroll
            for (int i = 0; i < 4; ++i) { const int s = sb + i; const float df = (float)(t - s);
                float dm;
                if (sb0 + j == tb) dm = (s <= t ? __expf(df * lgf) : 0.f) + (s >= t ? __expf(-df * lgb) : 0.f);
                else dm = __expf(sb0 + j < tb ? df * lgf : -df * lgb);
                p[i] = qk[j][4 * i4 + i] * dm; }
            *(LAS u32x2*)(TP + t * LDT + sb * 2) = (u32x2){pk2(p[0], p[1]), pk2(p[2], p[3])}; }
    BAR();
    f32x16 y[2] = {ZERO16, ZERO16};
    pv_mfma(F, TP, TV, y);
#pragma unroll 1
    for (int d = 0; d < 2; ++d) { f32x16 qs[2] = {ZERO16, ZERO16};
        if (!sq.lat && (d == 0 ? sq.c == 0 : sq.c == sq.nch - 1)) continue;
        bf16x8 bst[2][8]; qs_prefetch(F, WSP(const bf16, WS_RTIN) + (size_t)((cp * 2 + d) * 4 + h) * 16384, bst);
        qs_mfma(F, TQ, bst, qs);
#pragma unroll
        for (int j = 0; j < 2; ++j)
#pragma unroll
            for (int k4 = 0; k4 < 4; ++k4) { const f32x4 f4 = *(const LAS f32x4*)(SCA(10 + d) + 32 * tb + 8 * k4 + 4 * hh);
#pragma unroll
                for (int i = 0; i < 4; ++i) y[j][4 * k4 + i] += f4[i] * qs[j][4 * k4 + i]; } }
    BAR();
    hs_to_lds(F, F.lds, y);
    BAR();
    head_out_r<1>(F, F.lds, INP(I_RNORM) + (size_t)l * GWID + h * 128, og, WSP(bf16, WS_Y) + (size_t)cp * 128 * D + 1024 + h * 128);
    BAR();
}
template <bool WMODE> __device__ __forceinline__ float ssd_scalars(Frame& F, KArgs& A, int l, int cp, int g) {
    const int d = F.wave >> 2, rr = F.wave & 3, head = g * 4 + rr;
    const float bias = INP(I_DTB)[(l * 2 + d) * 8 + head], arate = -__expf(INP(I_ALOG)[(l * 2 + d) * 8 + head]);
    const float* gp = WSP(const float, WS_GATES) + (size_t)(cp * 128) * 32 + 16 + d * 8 + head;
    const int i0 = d ? 127 - 2 * F.lane : 2 * F.lane, i1 = d ? i0 - 1 : i0 + 1;
    const float dt0 = softplusf_(gp[(size_t)i0 * 32] + bias), dt1 = softplusf_(gp[(size_t)i1 * 32] + bias);
    const float a0 = dt0 * arate, a1 = dt1 * arate;
    float inc = a0 + a1;
#pragma unroll
    for (int o = 1; o < 64; o <<= 1) { const float t = __shfl_up(inc, o); if (F.lane >= o) inc += t; }
    const float c1 = inc, c0 = inc - a1, tot = __shfl(inc, 63);
    LAS float* cum = SCA(16 + d * 4 + rr); LAS float* dtw = SCA(24 + d * 4 + rr);
    cum[i0] = c0; cum[i1] = c1;
    if (WMODE) { dtw[i0] = __expf(tot - c0) * dt0; dtw[i1] = __expf(tot - c1) * dt1; } else { dtw[i0] = dt0; dtw[i1] = dt1; }
    return tot;
}
__device__ __forceinline__ void seq_bounds(int cp, int& lo, int& hi) { if (cp < 64) { lo = (cp >> 1) * 256; hi = lo + 256; } else { lo = MC + ((cp - 64) >> 5) * 4096; hi = lo + 4096; } }
__device__ __forceinline__ void ssd_local_item(Frame F, KArgs& A, int l, int cp, int g) {
    const float tot = ssd_scalars<true>(F, A, l, cp, g);
    if (F.lane == 0) WSP(float, WS_SDSC)[(cp * 2 + (F.wave >> 2)) * 8 + g * 4 + (F.wave & 3)] = tot;
    int lo, hi; seq_bounds(cp, lo, hi);
    LAS unsigned char* TB = F.lds;
    load_conv<1, 16>(F, A, l, TB, nullptr, LDT, 512 + g * 128, cp * 128, lo, hi, nullptr, nullptr, true);
    load_conv<0, 16>(F, A, l, nullptr, nullptr, LDT, 768 + g * 128, cp * 128, lo, hi, nullptr, nullptr, true);
    BAR();
#pragma unroll 1
    for (int hr = 0; hr < 2; ++hr) {
#pragma unroll 1
        for (int r2 = 0; r2 < 2; ++r2) { const int rr = hr * 2 + r2;
            load_conv<2, 8>(F, A, l, F.lds + TS + (r2 * 2 + 0) * TSX, F.lds + TS + (r2 * 2 + 1) * TSX, LDX, g * 256 + rr * 64, cp * 128, lo, hi, SCA(24 + 0 * 4 + rr), SCA(24 + 1 * 4 + rr), true); }
        BAR();
        const int r2 = F.wave >> 2, d = (F.wave >> 1) & 1, pb = F.wave & 1, hh = F.lane >> 5, head = g * 4 + hr * 2 + r2;
        const LAS unsigned char* TX = F.lds + TS + (r2 * 2 + d) * TSX;
        f32x16 acc[4] = {ZERO16, ZERO16, ZERO16, ZERO16};
#pragma unroll 1
        for (int ks = 0; ks < 8; ++ks) { const bf16x8 a = frag_tr(TX, LDX, 16 * ks, 32 * pb, F.lane);
#pragma unroll
            for (int nb = 0; nb < 4; ++nb) acc[nb] = MFMA32(a, frag_tr(TB, LDT, 16 * ks, 32 * nb, F.lane), acc[nb]); }
        bf16* o = WSP(bf16, WS_SDLOC) + (size_t)((cp * 2 + d) * 8 + head) * 8192;
#pragma unroll
        for (int nb = 0; nb < 4; ++nb)
#pragma unroll
            for (int i = 0; i < 16; ++i) o[(32 * pb + crow(i, hh)) * 128 + 32 * nb + (F.lane & 31)] = (bf16)f2bf(acc[nb][i]);
        BAR();
    }
}
__device__ __forceinline__ void ssd_out_item(Frame F, KArgs& A, int l, int cp, bf16* Ybase) {
    const Seq sq = seq_of(cp);
    LAS unsigned char* TC = F.lds; LAS unsigned char* TB = F.lds + TS; LAS unsigned char* TX2 = F.lds + 2 * TS; LAS unsigned char* YI = F.lds + 3 * TS;
    LAS float* SSQ = SCA(14);
    if (F.tid < 128) SSQ[F.tid] = 0.f;
    const int tb = F.wave >> 1, ph = F.wave & 1, hh = F.lane >> 5, t = 32 * tb + (F.lane & 31);
    bf16* Yd = Ybase + (size_t)cp * 128 * D + 1536;
#pragma unroll 1
    for (int g = 0; g < 2; ++g) {
        (void)ssd_scalars<false>(F, A, l, cp, g);
        load_xbcc<16>(F, TC, LDT, 768 + g * 128, cp * 128);
        load_xbcc<16>(F, TB, LDT, 512 + g * 128, cp * 128);
        load_xbcc<16>(F, TX2, LDT, g * 256, cp * 128);
        BAR();
        f32x16 cb[4] = {ZERO16, ZERO16, ZERO16, ZERO16};
#pragma unroll 1
        for (int ks = 0; ks < 8; ++ks) { const bf16x8 bq = frag_row(TC, LDT, 32 * tb, 16 * ks, F.lane);
#pragma unroll
            for (int sb = 0; sb < 4; ++sb) cb[sb] = MFMA32(frag_row(TB, LDT, 32 * sb, 16 * ks, F.lane), bq, cb[sb]); }
#pragma unroll 1
        for (int hr = 0; hr < 2; ++hr) {
            if (hr == 1) { load_xbcc<16>(F, TX2, LDT, g * 256 + 128, cp * 128); BAR(); }
            f32x16 y2[2];
#pragma unroll
            for (int r2 = 0; r2 < 2; ++r2) {
                const int rr = hr * 2 + r2, head = g * 4 + rr;
                f32x16 y = ZERO16;
#pragma unroll 1
                for (int d = 0; d < 2; ++d) {
                    const LAS float* cum = SCA(16 + d * 4 + rr); const LAS float* dtv = SCA(24 + d * 4 + rr); const float ct = cum[t];
                    const bool has_state = sq.lat || (d == 0 ? sq.c > 0 : sq.c < sq.nch - 1);
                    bf16x8 bh[8];
                    if (has_state) { const bf16* hin = WSP(const bf16, WS_SDIN) + (size_t)((cp * 2 + d) * 8 + head) * 8192;
#pragma unroll
                        for (int ks = 0; ks < 8; ++ks) bh[ks] = *(const bf16x8*)(hin + (size_t)(32 * ph + (F.lane & 31)) * 128 + 16 * ks + 8 * hh); }
#pragma unroll
                    for (int sb = 0; sb < 4; ++sb) if (d == 0 ? sb <= tb : sb >= tb) {
#pragma unroll
                        for (int sp = 0; sp < 2; ++sp) { float p[8];
#pragma unroll
                            for (int jh = 0; jh < 2; ++jh) { const int s0 = 32 * sb + 16 * sp + 8 * jh + 4 * hh; const f32x4 c4 = *(const LAS f32x4*)(cum + s0), d4 = *(const LAS f32x4*)(dtv + s0);
#pragma unroll
                                for (int j = 0; j < 4; ++j) { const int s = s0 + j; float v = cb[sb][8 * sp + 4 * jh + j] * __expf(ct - c4[j]) * d4[j];
                                    if (sb == tb) { const bool ok = d == 0 ? (s <= t) : (s >= t); v = ok ? v : 0.f; }
                                    p[4 * jh + j] = v; } }
                            y = MFMA32(__builtin_bit_cast(bf16x8, pack8(p, 1.f)), frag_trp(TX2, LDT, 32 * sb + 16 * sp, r2 * 64 + 32 * ph, F.lane), y); } }
                    if (has_state) { f32x16 ch = ZERO16;
#pragma unroll
                        for (int ks = 0; ks < 8; ++ks) ch = MFMA32(frag_row(TC, LDT, 32 * tb, 16 * ks, F.lane), bh[ks], ch);
#pragma unroll
                        for (int k4 = 0; k4 < 4; ++k4) { const f32x4 c4 = *(const LAS f32x4*)(cum + 32 * tb + 8 * k4 + 4 * hh);
#pragma unroll
                            for (int i = 0; i < 4; ++i) y[4 * k4 + i] += __expf(c4[i]) * ch[4 * k4 + i]; } }
                }
                y2[r2] = y;
            }
#pragma unroll
            for (int r2 = 0; r2 < 2; ++r2)
#pragma unroll
                for (int i = 0; i < 16; ++i) *(LAS unsigned short*)(YI + (32 * tb + crow(i, hh)) * LDT + (r2 * 64 + 32 * ph + (F.lane & 31)) * 2) = (unsigned short)f2bf(y2[r2][i]);
            BAR();
            { const int tt = F.tid >> 2, seg = F.tid & 3, head = g * 4 + hr * 2 + (seg >> 1), pc = (seg & 1) * 32; const float Dh = INP(I_SSDD)[l * 8 + head]; float ss = 0.f;
#pragma unroll
                for (int k = 0; k < 4; ++k) { float yv[8], x[8], z[8], o[8];
                    unpack8(*(const LAS v4u*)(YI + tt * LDT + (seg * 32 + 8 * k) * 2), yv); unpack8(*(const LAS v4u*)(TX2 + tt * LDT + (seg * 32 + 8 * k) * 2), x);
                    unpack8(*(const v4u*)(PT(cp, PC_DZ + head * 64 + pc) + (size_t)tt * 128 + 8 * k), z);
#pragma unroll
                    for (int j = 0; j < 8; ++j) { const float v = (yv[j] + Dh * x[j]) * siluf_(z[j]); o[j] = v; ss += v * v; }
                    *(v4u*)(Yd + (size_t)tt * D + head * 64 + pc + 8 * k) = pack8(o, 1.f); }
                ss += __shfl_xor(ss, 1); ss += __shfl_xor(ss, 2);
                if (seg == 0) SSQ[tt] += ss; }
            BAR();
        }
    }
    __builtin_amdgcn_fence(__ATOMIC_RELEASE, "workgroup"); asm volatile("s_waitcnt vmcnt(0)" ::: "memory"); __syncthreads(); __builtin_amdgcn_fence(__ATOMIC_ACQUIRE, "workgroup");
    { const int tt = F.tid >> 2, seg = F.tid & 3; const float r = rsqrtf(SSQ[tt] * (1.f / 512.f) + EPS); const float* gn = INP(I_SNORM) + (size_t)l * GWID + 128 * seg;
#pragma unroll 4
        for (int k = 0; k < 16; ++k) { bf16* p = Yd + (size_t)tt * D + 128 * seg + 8 * k; float v[8];
            unpack8(*(const v4u*)p, v);
#pragma unroll
            for (int j = 0; j < 8; ++j) v[j] = v[j] * r * gn[8 * k + j];
            *(v4u*)p = pack8(v, 1.f); } }
    BAR();
}
template <int PASS> __device__ __forceinline__ void s5_item(Frame F, KArgs& A, int l, int cp, int gq) {
    const Seq sq = seq_of(cp);
    const int g = gq * 8 + F.wave, p = F.lane, hh = F.lane >> 5;
    LAS unsigned char* TU = F.lds; LAS unsigned char* BU = F.lds + TS + F.wave * 8704;
    if (PASS == 1) ITS(8);
    typedef short v8s __attribute__((ext_vector_type(8)));
    typedef float f32x4v __attribute__((ext_vector_type(4)));
    const int r16 = F.lane & 15, g4 = F.lane >> 4;
    v4u ru[4]; tile_issue(F, PT(cp, PC_S5U + gq * 128), ru);
    f32x2 lam[2], l8[2], h0[2]; bf16x8 bbf[2][4]; v8s ctf[2][4];
#pragma unroll
    for (int d = 0; d < 2; ++d) {
        const unsigned char* tab = s5tab(F, l, d, g);
        lam[d] = ((const f32x2*)tab)[p]; l8[d] = ((const f32x2*)(tab + 512))[p]; h0[d] = (f32x2){0.f, 0.f};
        if (PASS == 1 && sq.lat) { const size_t o = (size_t)(((sq.b * 4 + l) * 2 + d) * 32 + g) * 64 + p; h0[d] = (f32x2){INP(I_SS5R)[o], INP(I_SS5I)[o]}; }
        const bf16* bb = (const bf16*)(tab + 1024); const bf16* ct = (const bf16*)(tab + 5120);
#pragma unroll
        for (int nb = 0; nb < 4; ++nb) bbf[d][nb] = *(const bf16x8*)(bb + (size_t)(32 * nb + (F.lane & 31)) * 16 + 8 * hh);
        if (PASS == 1 && d == 0) {
#pragma unroll
            for (int ks = 0; ks < 4; ++ks) ctf[0][ks] = *(const v8s*)(ct + r16 * 128 + 32 * ks + 8 * g4); }
    }
    if (PASS == 1) {
        f32x2 e[31];
#pragma unroll
        for (int j = 0; j < 31; ++j) if (j < sq.nch - 1) { const int cc = j < sq.c ? j : j + 1, dd = j < sq.c ? 0 : 1;
            e[j] = *(const f32x2*)(WSP(const float, WS_S5LOC) + ((size_t)(((sq.cp0 + cc) * 2 + dd) * 32 + g) * 64 + p) * 2); }
#pragma unroll
        for (int j = 0; j < 31; ++j) if (j < sq.c) { const float nr = l8[0].x * h0[0].x - l8[0].y * h0[0].y + e[j].x, ni = l8[0].x * h0[0].y + l8[0].y * h0[0].x + e[j].y; h0[0] = (f32x2){nr, ni}; }
#pragma unroll
        for (int j = 30; j >= 0; --j) if (j >= sq.c && j < sq.nch - 1) { const float nr = l8[1].x * h0[1].x - l8[1].y * h0[1].y + e[j].x, ni = l8[1].x * h0[1].y + l8[1].y * h0[1].x + e[j].y; h0[1] = (f32x2){nr, ni}; }
    }
    tile_commit(F, TU, ru, 1.f);
    BAR();
    if (PASS == 1) { ITE(8); ITS(9); }
    f32x4v yacc[4][2];
    if (PASS == 1) {
#pragma unroll
        for (int a = 0; a < 4; ++a) { yacc[a][0] = (f32x4v){0.f, 0.f, 0.f, 0.f}; yacc[a][1] = (f32x4v){0.f, 0.f, 0.f, 0.f}; } }
#pragma unroll
    for (int d = 0; d < 2; ++d) {
        const float lr = lam[d].x, li = lam[d].y;
        float hr = h0[d].x, hi = h0[d].y;
        if (PASS == 1 && d == 1) { const bf16* ct = (const bf16*)(s5tab(F, l, 1, g) + 5120);
#pragma unroll
            for (int ks = 0; ks < 4; ++ks) ctf[1][ks] = *(const v8s*)(ct + r16 * 128 + 32 * ks + 8 * g4); }
#pragma unroll 1
        for (int tbi = 0; tbi < 4; ++tbi) {
            const int tb = d == 0 ? tbi : 3 - tbi;
            const bf16x8 bu = frag_row(TU, LDT, 32 * tb, 16 * F.wave, F.lane);
#pragma unroll
            for (int nb = 0; nb < 4; ++nb) {
                const f32x16 acc = MFMA32(bbf[d][nb], bu, ZERO16);
#pragma unroll
                for (int i4 = 0; i4 < 4; ++i4) *(LAS u32x2*)(BU + (F.lane & 31) * LDT + (32 * nb + 8 * i4 + 4 * hh) * 2) = (u32x2){pk2(acc[4 * i4], acc[4 * i4 + 1]), pk2(acc[4 * i4 + 2], acc[4 * i4 + 3])};
            }
            asm volatile("s_waitcnt lgkmcnt(0)" ::: "memory");
            unsigned w[32];
#pragma unroll
            for (int st = 0; st < 32; ++st) { const int tl = d == 0 ? st : 31 - st; w[st] = *(const LAS unsigned*)(BU + tl * LDT + p * 4); }
#pragma unroll
            for (int st = 0; st < 32; ++st) { const float br = bflo(w[st]), bi = bfhi(w[st]);
                const float nr = lr * hr - li * hi + br, ni = lr * hi + li * hr + bi; hr = nr; hi = ni;
                if (PASS == 1) w[st] = pk2(hr, hi); }
            if (PASS == 1) {
#pragma unroll
                for (int st = 0; st < 32; ++st) { const int tl = d == 0 ? st : 31 - st; *(LAS unsigned*)(BU + tl * LDT + p * 4) = w[st]; }
                asm volatile("s_waitcnt lgkmcnt(0)" ::: "memory");
                f32x4v y0 = (f32x4v){0.f, 0.f, 0.f, 0.f}, y1 = y0;
#pragma unroll
                for (int ks = 0; ks < 4; ++ks) {
                    y0 = __builtin_amdgcn_mfma_f32_16x16x32_bf16(*(const LAS v8s*)(BU + r16 * LDT + (32 * ks + 8 * g4) * 2), ctf[d][ks], y0, 0, 0, 0);
                    y1 = __builtin_amdgcn_mfma_f32_16x16x32_bf16(*(const LAS v8s*)(BU + (16 + r16) * LDT + (32 * ks + 8 * g4) * 2), ctf[d][ks], y1, 0, 0, 0); }
                if (tb == 0) { yacc[0][0] += y0; yacc[0][1] += y1; } else if (tb == 1) { yacc[1][0] += y0; yacc[1][1] += y1; } else if (tb == 2) { yacc[2][0] += y0; yacc[2][1] += y1; } else { yacc[3][0] += y0; yacc[3][1] += y1; }
                asm volatile("s_waitcnt lgkmcnt(0)" ::: "memory");
            }
        }
        if (PASS == 0) { *(f32x2*)(WSP(float, WS_S5LOC) + ((size_t)((cp * 2 + d) * 32 + g) * 64 + p) * 2) = (f32x2){hr, hi}; }
        else if (!sq.lat && ((d == 0 && sq.c == sq.nch - 1) || (d == 1 && sq.c == 0))) { const size_t o = (size_t)(((sq.b * 4 + l) * 2 + d) * 32 + g) * 64 + p; F.out[O_S5R + o] = hr; F.out[O_S5I + o] = hi; }
    }
    if (PASS == 1) { ITE(9); ITS(10); }
    if (PASS == 1) {
        const float Dc = INP(I_S5D)[(size_t)l * GWID + g * 16 + r16];
#pragma unroll
        for (int tb = 0; tb < 4; ++tb)
#pragma unroll
            for (int ts = 0; ts < 2; ++ts)
#pragma unroll
                for (int i = 0; i < 4; ++i) { const int t = 32 * tb + 16 * ts + 4 * g4 + i; LAS unsigned short* up = (LAS unsigned short*)(TU + t * LDT + (16 * F.wave + r16) * 2);
                    const float x = yacc[tb][ts][i] + Dc * bf2f(*up);
                    const float u2 = 1.5957691216057308f * (x + 0.044715f * x * x * x); const float ge = x - x * __builtin_amdgcn_rcpf(1.f + __expf(u2));
                    *up = (unsigned short)f2bf(ge); }
        BAR();
        bf16* ya = WSP(bf16, WS_YA) + (size_t)cp * 128 * GWID + gq * 128;
#pragma unroll
        for (int it = 0; it < 4; ++it) { const int i = F.tid + NT * it, r = i >> 4, c = i & 15; *(v4u*)(ya + (size_t)r * GWID + c * 8) = *(const LAS v4u*)(TU + r * LDT + c * 16); }
    }
    BAR();
    if (PASS == 1) ITE(10);
}

template <bool LAT> __device__ __forceinline__ void carry_unit(Frame F, KArgs& A, int l, int u) {
    const int sd = u / 96, rem = u % 96, sidx = sd >> 1, d = sd & 1;
    constexpr int lat = LAT ? 1 : 0, nch = LAT ? 32 : 2, NB = LAT ? 16 : 2;
    const int b = LAT ? sidx : sidx - 4, cp0 = LAT ? 64 + 32 * b : 2 * b;
    int type, head, slice;
    if (rem < 32) { type = 0; head = rem >> 3; slice = rem & 7; } else if (rem < 64) { type = 1; head = (rem - 32) >> 3; slice = (rem - 32) & 7; } else { type = 2; head = (rem - 64) >> 2; slice = (rem - 64) & 3; }
    const int e0 = slice * 2048 + F.tid * 4;
    const int nh = type == 2 ? 8 : 4, esz = type == 2 ? 8192 : 16384;
    const bf16* loc = type == 0 ? WSP(const bf16, WS_MLCLOC) : (type == 1 ? WSP(const bf16, WS_RTLOC) : WSP(const bf16, WS_SDLOC));
    bf16* inb = type == 0 ? WSP(bf16, WS_MLCIN) : (type == 1 ? WSP(bf16, WS_RTIN) : WSP(bf16, WS_SDIN));
    float zf = 0.f; asm volatile("" : "+v"(zf));
    float v[4] = {zf, zf, zf, zf}, nv[4] = {zf, zf, zf, zf}, m = 0.f;
    const bool do_n = (type == 0 && slice == 0 && F.tid < 32);
    if (LAT) {
        if (type == 2) { const f32x4 s = *(const f32x4*)(INP(I_SSSD) + (size_t)(((b * 4 + l) * 2 + d) * 8 + head) * 8192 + e0); v[0] = s.x; v[1] = s.y; v[2] = s.z; v[3] = s.w; }
        else { const float* s = (type == 0 ? INP(I_SMC) : INP(I_SRET)) + (size_t)(((b * 4 + l) * 2 + d) * 4 + head) * 16384; const int dv = e0 >> 7, dk = e0 & 127;
#pragma unroll
            for (int j = 0; j < 4; ++j) v[j] = s[(dk + j) * 128 + dv]; }
        if (type == 0) { m = INP(I_SMM)[((b * 4 + l) * 2 + d) * 4 + head];
            if (do_n) { const f32x4 s = *(const f32x4*)(INP(I_SMN) + (size_t)(((b * 4 + l) * 2 + d) * 4 + head) * 128 + F.tid * 4); nv[0] = s.x; nv[1] = s.y; nv[2] = s.z; nv[3] = s.w; } }
    }
    const float rdec = type == 1 ? __expf(-128.f * __expf(INP(I_RRATE)[(l * 2 + d) * 4 + head])) : 1.f;
#pragma unroll 1
    for (int ci0 = 0; ci0 < nch; ci0 += NB) {
        u32x2 lc[NB]; f32x4 ln[NB]; float s0[NB], s1[NB];
#pragma unroll
        for (int j = 0; j < NB; ++j) { ln[j] = (f32x4){zf, zf, zf, zf}; s0[j] = zf; s1[j] = zf; }
#pragma unroll
        for (int j = 0; j < NB; ++j) {
            const int ci = ci0 + j, cp = cp0 + (d == 0 ? ci : nch - 1 - ci);
            lc[j] = *(const u32x2*)(loc + (size_t)((cp * 2 + d) * nh + head) * esz + e0);
            if (type == 0) { const float* sc = WSP(const float, WS_MLSC) + ((cp * 2 + d) * 4 + head) * 2; s0[j] = sc[0]; s1[j] = sc[1];
                if (do_n) ln[j] = *(const f32x4*)(WSP(const float, WS_MLNLOC) + ((cp * 2 + d) * 4 + head) * 128 + F.tid * 4); }
            else if (type == 2) s0[j] = WSP(const float, WS_SDSC)[(cp * 2 + d) * 8 + head];
        }
#pragma unroll
        for (int j = 0; j < NB; ++j) {
            const int ci = ci0 + j, cp = cp0 + (d == 0 ? ci : nch - 1 - ci);
            const size_t so = (size_t)((cp * 2 + d) * nh + head) * esz + e0;
            if (LAT || ci > 0) *(u32x2*)(inb + so) = (u32x2){pk2(v[0], v[1]), pk2(v[2], v[3])};
            float dec, wl = 1.f;
            if (type == 0) {
                const float Bt = s0[j], ml = s1[j];
                if (slice == 0 && F.tid == 0) WSP(float, WS_MLMIN)[(cp * 2 + d) * 4 + head] = m;
                if (do_n) *(f32x4*)(WSP(float, WS_MLNIN) + ((cp * 2 + d) * 4 + head) * 128 + F.tid * 4) = (f32x4){nv[0], nv[1], nv[2], nv[3]};
                const float mn = fmaxf(Bt + m, ml); dec = __expf(Bt + m - mn); wl = __expf(ml - mn); m = mn;
                if (do_n) { nv[0] = dec * nv[0] + wl * ln[j].x; nv[1] = dec * nv[1] + wl * ln[j].y; nv[2] = dec * nv[2] + wl * ln[j].z; nv[3] = dec * nv[3] + wl * ln[j].w; }
            } else if (type == 1) dec = rdec;
            else dec = __expf(s0[j]);
            v[0] = dec * v[0] + wl * bflo(lc[j].x); v[1] = dec * v[1] + wl * bfhi(lc[j].x); v[2] = dec * v[2] + wl * bflo(lc[j].y); v[3] = dec * v[3] + wl * bfhi(lc[j].y);
        }
    }
    if (!lat) {
        if (type == 2) *(f32x4*)(F.out + O_SSD + (size_t)(((b * 4 + l) * 2 + d) * 8 + head) * 8192 + e0) = (f32x4){v[0], v[1], v[2], v[3]};
        else {
            LAS float* tr = (LAS float*)F.lds;
            const int dvl = F.tid >> 5, dk = (F.tid & 31) * 4;
#pragma unroll
            for (int j = 0; j < 4; ++j) tr[dvl * 129 + dk + j] = v[j];
            BAR();
            const int dk2 = F.tid >> 2, q = F.tid & 3;
            float* o = F.out + (type == 0 ? O_MC : O_RET) + (size_t)(((b * 4 + l) * 2 + d) * 4 + head) * 16384 + (size_t)dk2 * 128 + slice * 16 + 4 * q;
            *(f32x4*)o = (f32x4){tr[(4 * q) * 129 + dk2], tr[(4 * q + 1) * 129 + dk2], tr[(4 * q + 2) * 129 + dk2], tr[(4 * q + 3) * 129 + dk2]};
            if (type == 0) { if (do_n) *(f32x4*)(F.out + O_MN + (size_t)(((b * 4 + l) * 2 + d) * 4 + head) * 128 + F.tid * 4) = (f32x4){nv[0], nv[1], nv[2], nv[3]};
                if (slice == 0 && F.tid == 0) F.out[O_MM + ((b * 4 + l) * 2 + d) * 4 + head] = m; }
            BAR();
        }
    }
}

struct CtxLd { u32x2 lc[2]; f32x4 ln[2]; float s0[2], s1[2]; };
struct CtxU { int d, b, cp0, type, head, slice, e0, nh, esz; bool do_n; };
__device__ __forceinline__ CtxU ctx_decode(const Frame& F, int u) {
    CtxU c; const int sd = u / 96, rem = u % 96, sidx = sd >> 1; c.d = sd & 1; c.b = sidx - 4; c.cp0 = 2 * c.b;
    if (rem < 32) { c.type = 0; c.head = rem >> 3; c.slice = rem & 7; } else if (rem < 64) { c.type = 1; c.head = (rem - 32) >> 3; c.slice = (rem - 32) & 7; } else { c.type = 2; c.head = (rem - 64) >> 2; c.slice = (rem - 64) & 3; }
    c.e0 = c.slice * 2048 + F.tid * 4; c.nh = c.type == 2 ? 8 : 4; c.esz = c.type == 2 ? 8192 : 16384; c.do_n = (c.type == 0 && c.slice == 0 && F.tid < 32);
    return c;
}
__device__ __forceinline__ void carry_ctx_load(const Frame& F, int u, CtxLd& L, float zf) {
    const CtxU c = ctx_decode(F, u);
    const bf16* loc = c.type == 0 ? WSP(const bf16, WS_MLCLOC) : (c.type == 1 ? WSP(const bf16, WS_RTLOC) : WSP(const bf16, WS_SDLOC));
#pragma unroll
    for (int j = 0; j < 2; ++j) { const int cp = c.cp0 + (c.d == 0 ? j : 1 - j);
        L.ln[j] = (f32x4){zf, zf, zf, zf}; L.s0[j] = zf; L.s1[j] = zf;
        L.lc[j] = *(const u32x2*)(loc + (size_t)((cp * 2 + c.d) * c.nh + c.head) * c.esz + c.e0);
        if (c.type == 0) { const float* sc = WSP(const float, WS_MLSC) + ((cp * 2 + c.d) * 4 + c.head) * 2; L.s0[j] = sc[0]; L.s1[j] = sc[1];
            if (c.do_n) L.ln[j] = *(const f32x4*)(WSP(const float, WS_MLNLOC) + ((cp * 2 + c.d) * 4 + c.head) * 128 + F.tid * 4); }
        else if (c.type == 2) L.s0[j] = WSP(const float, WS_SDSC)[(cp * 2 + c.d) * 8 + c.head]; }
}
__device__ __forceinline__ void carry_ctx_finish(Frame& F, KArgs& A, int l, int u, const CtxLd& L, float zf) {
    const CtxU c = ctx_decode(F, u);
    bf16* inb = c.type == 0 ? WSP(bf16, WS_MLCIN) : (c.type == 1 ? WSP(bf16, WS_RTIN) : WSP(bf16, WS_SDIN));
    float v[4] = {zf, zf, zf, zf}, nv[4] = {zf, zf, zf, zf}, m = 0.f;
    const float rdec = c.type == 1 ? __expf(-128.f * __expf(INP(I_RRATE)[(l * 2 + c.d) * 4 + c.head])) : 1.f;
#pragma unroll
    for (int j = 0; j < 2; ++j) { const int cp = c.cp0 + (c.d == 0 ? j : 1 - j);
        if (j > 0) *(u32x2*)(inb + (size_t)((cp * 2 + c.d) * c.nh + c.head) * c.esz + c.e0) = (u32x2){pk2(v[0], v[1]), pk2(v[2], v[3])};
        float dec, wl = 1.f;
        if (c.type == 0) {
            if (c.slice == 0 && F.tid == 0) WSP(float, WS_MLMIN)[(cp * 2 + c.d) * 4 + c.head] = m;
            if (c.do_n) *(f32x4*)(WSP(float, WS_MLNIN) + ((cp * 2 + c.d) * 4 + c.head) * 128 + F.tid * 4) = (f32x4){nv[0], nv[1], nv[2], nv[3]};
            const float mn = fmaxf(L.s0[j] + m, L.s1[j]); dec = __expf(L.s0[j] + m - mn); wl = __expf(L.s1[j] - mn); m = mn;
            if (c.do_n) { nv[0] = dec * nv[0] + wl * L.ln[j].x; nv[1] = dec * nv[1] + wl * L.ln[j].y; nv[2] = dec * nv[2] + wl * L.ln[j].z; nv[3] = dec * nv[3] + wl * L.ln[j].w; }
        } else if (c.type == 1) dec = rdec;
        else dec = __expf(L.s0[j]);
        v[0] = dec * v[0] + wl * bflo(L.lc[j].x); v[1] = dec * v[1] + wl * bfhi(L.lc[j].x); v[2] = dec * v[2] + wl * bflo(L.lc[j].y); v[3] = dec * v[3] + wl * bfhi(L.lc[j].y); }
    const int b = c.b, d = c.d, head = c.head, slice = c.slice, e0 = c.e0;
    if (c.type == 2) *(f32x4*)(F.out + O_SSD + (size_t)(((b * 4 + l) * 2 + d) * 8 + head) * 8192 + e0) = (f32x4){v[0], v[1], v[2], v[3]};
    else {
        LAS float* tr = (LAS float*)F.lds;
        const int dvl = F.tid >> 5, dk = (F.tid & 31) * 4;
#pragma unroll
        for (int j = 0; j < 4; ++j) tr[dvl * 129 + dk + j] = v[j];
        BAR();
        const int dk2 = F.tid >> 2, q = F.tid & 3;
        float* o = F.out + (c.type == 0 ? O_MC : O_RET) + (size_t)(((b * 4 + l) * 2 + d) * 4 + head) * 16384 + (size_t)dk2 * 128 + slice * 16 + 4 * q;
        *(f32x4*)o = (f32x4){tr[(4 * q) * 129 + dk2], tr[(4 * q + 1) * 129 + dk2], tr[(4 * q + 2) * 129 + dk2], tr[(4 * q + 3) * 129 + dk2]};
        if (c.type == 0) { if (c.do_n) *(f32x4*)(F.out + O_MN + (size_t)(((b * 4 + l) * 2 + d) * 4 + head) * 128 + F.tid * 4) = (f32x4){nv[0], nv[1], nv[2], nv[3]};
            if (slice == 0 && F.tid == 0) F.out[O_MM + ((b * 4 + l) * 2 + d) * 4 + head] = m; }
        BAR();
    }
}
__device__ __forceinline__ void carry_ctx_batch(Frame F, KArgs& A, int l, int u0) {
    float zf = 0.f; asm volatile("" : "+v"(zf));
    CtxLd L[8];
#pragma unroll
    for (int j = 0; j < 8; ++j) carry_ctx_load(F, u0 + j, L[j], zf);
#pragma unroll
    for (int j = 0; j < 8; ++j) carry_ctx_finish(F, A, l, u0 + j, L[j], zf);
}
constexpr int CW_Q = 16384;
struct OneUnit { pg8::Unit u; __device__ __forceinline__ bool next(int i, pg8::Unit& o) const { if (i) return false; o = u; return true; }
    __device__ __forceinline__ void a_ready(const pg8::Unit&) const {} __device__ __forceinline__ void done(const pg8::Unit&) const {} };
#define QUEUE_LOOP(F0_, qidx, total, ...) do { \
    unsigned* qc_ = (unsigned*)(F0_.ws + WS_CTL) + CW_Q + 64 * (qidx); volatile LAS int* qs_ = (volatile LAS int*)(F0_.lds + MISC_OFF + 64); \
    if (F0_.tid == 0) qs_[0] = (int)__hip_atomic_fetch_add(qc_, 1u, __ATOMIC_RELAXED, __HIP_MEMORY_SCOPE_AGENT); \
    __syncthreads(); \
    int it = qs_[0], par_ = 1; \
    while (it < (total)) { \
        int nx_ = 0; if (F0_.tid == 0) nx_ = (int)__hip_atomic_fetch_add(qc_, 1u, __ATOMIC_RELAXED, __HIP_MEMORY_SCOPE_AGENT); \
        { __VA_ARGS__ } \
        if (F0_.tid == 0) qs_[par_] = nx_; \
        BAR();     \
        it = qs_[par_]; par_ ^= 1; \
    } } while (0)
#ifndef PROBE_ITEM
#define PROBE_ITEM -1
#endif
#define PR(t) (PROBE_ITEM == (t) ? 2 : 1)
#define QSPLIT(NT_, C0, C1, C2, C3, T0) int ty_ = 0, loc_ = it, dup_ = 0; { const int cnt_[4] = {C0, C1, C2, C3}; \
    _Pragma("unroll") for (int j_ = 0; j_ < NT_; ++j_) { const int span_ = cnt_[j_] * PR(T0 + j_); if (ty_ == j_) { if (loc_ >= span_) { loc_ -= span_; ty_ = j_ + 1; } else { dup_ = loc_ / cnt_[j_]; loc_ = loc_ % cnt_[j_]; } } } }
#ifndef PROBE_TMASK
#define PROBE_TMASK 0
#endif
#ifndef PROBE_TAMP
#define PROBE_TAMP 4
#endif
#define TSTART(k) do { if (PROBE_TMASK & (1 << (k))) pt0_ = __builtin_amdgcn_s_memrealtime(); } while (0)
#define TEND(k) do { if (PROBE_TMASK & (1 << (k))) ptacc_ += __builtin_amdgcn_s_memrealtime() - pt0_; } while (0)
#ifndef PROBE_REPEAT
#define PROBE_REPEAT -1
#endif
constexpr int N_PHASES = 2 + 9 * NLAYER;
__global__ void __launch_bounds__(NT, 2) hymba_fwd(Args A) {
    extern __shared__ __attribute__((aligned(16))) unsigned char lds_raw[];
    Frame F0;
    F0.lds = (LAS unsigned char*)lds_raw;
    F0.tid = threadIdx.x; F0.lane = 0; F0.wave = __builtin_amdgcn_readfirstlane(F0.tid >> 6);
    F0.G = gridDim.x; F0.bid = blockIdx.x; F0.out = A.out; F0.ws = A.ws;
    volatile LAS unsigned* MISC = (volatile LAS unsigned*)(F0.lds + MISC_OFF);
    if (F0.tid < 64) MISC[F0.tid] = 0u;
    __syncthreads();
    unsigned* barw = (unsigned*)(F0.ws + WS_CTL) + CW_BAR;
    XcdBarrier bar = xcd_barrier_post(barw, MISC + 8, F0.wave == 0 ? 1u : 0u);
    const int lo = A.ph_lo, hi = A.ph_hi;
    unsigned long long pt0_ = 0, ptacc_ = 0;
#define KA (*kargs())
#define IN(k) (lo <= (k) && (k) < hi)
#define SEAM(k) do { if (IN(k) && IN((k) + 1)) xcd_barrier(bar); } while (0)

    TSTART(9); if (IN(0)) for (int rep_ = 0; rep_ < (PROBE_REPEAT == 100 ? 2 : 1); ++rep_) { Frame F = fresh(F0); p0_prologue(F, KA); } SEAM(0); TEND(9);

    TSTART(10); if (IN(1)) { Frame F = fresh(F0); norm0_phase(F, KA); shw_phase(F); } SEAM(1); TEND(10);

#pragma unroll 1
    for (int l = 0; l < NLAYER; ++l) {
        const int pb = 1 + 9 * l;
        TSTART(1); if (IN(pb + 1)) for (int rep_ = 0; rep_ < (PROBE_REPEAT == 1 ? 2 : 1); ++rep_) { Frame F = fresh(F0);
            pg8::Gemm g{WSP(const pg8::bf16_t, WS_H), WSP(const pg8::bf16_t, WS_W1T) + (size_t)l * NPAD * D, M, NPROJ, D}; pg8::StaticOrder S; S.init(M, NPROJ, F.G, F.bid);
            epi::EpiProj E{WSP(pg8::bf16_t, WS_PROJ), WSP(const float, WS_SSQB), WSP(const float, WS_SHW1) + (size_t)l * 5 * NPAD};
            pg8::gemm_phase<epi::EpiProj, pg8::StaticOrder, true, true>(F.lds, g, S, E, F.tid);
            __syncthreads(); gates_phase(F, l);
        } SEAM(pb + 1); TEND(1);
        TSTART(2); if (IN(pb + 2)) { Frame F = fresh(F0);
            QUEUE_LOOP(F, l * 3 + 0, 384 * PR(0) + 768 * PR(1) + 768 * PR(2) + 768 * PR(3), {
                QSPLIT(4, 384, 768, 768, 768, 0);
                if (ty_ == 0) { TSTART(11); ssd_local_item(fresh(F), KA, l, loc_ >> 1, loc_ & 1); TEND(11); }
                else if (ty_ == 1) { TSTART(12); mlstm_local_item(fresh(F), KA, l, loc_ >> 2, loc_ & 3); TEND(12); }
                else if (ty_ == 2) { TSTART(13); ret_local_item(fresh(F), KA, l, loc_ >> 2, loc_ & 3); TEND(13); }
                else { TSTART(14); s5_item<0>(fresh(F), KA, l, loc_ >> 2, loc_ & 3); TEND(14); }
            });
        } SEAM(pb + 2); TEND(2);
        TSTART(3); if (IN(pb + 3)) { Frame F = fresh(F0);
            QUEUE_LOOP(F, l * 3 + 1, 768 * PR(4) + 768 * PR(5) + 768 * PR(6), {
                QSPLIT(3, 768, 768, 768, 0, 4);
                if (ty_ == 0) { TSTART(15); carry_unit<true>(fresh(F), KA, l, loc_); TEND(15); }
                else if (ty_ == 1) { TSTART(16); s5_item<1>(fresh(F), KA, l, loc_ >> 2, loc_ & 3); TEND(16); }
                else { TSTART(17); carry_ctx_batch(fresh(F), KA, l, 768 + loc_ * 8); TEND(17); }
            });
        } SEAM(pb + 3); TEND(3);
        TSTART(4); if (IN(pb + 4)) { Frame F = fresh(F0);
            QUEUE_LOOP(F, l * 3 + 2, 192 * PR(7) + 192 * PR(8) + 768 * PR(9) + 768 * PR(10), {
                QSPLIT(4, 192, 192, 768, 768, 7);
                if (ty_ == 0) { TSTART(18); ssd_out_item(fresh(F), KA, l, loc_, dup_ ? WSP(bf16, WS_MLCLOC) : WSP(bf16, WS_Y)); TEND(18); }
                else if (ty_ == 1) { TSTART(19); Frame Fg = fresh(F);
                    pg8::Gemm g{WSP(const pg8::bf16_t, WS_YA), WSP(const pg8::bf16_t, WS_WGT) + (size_t)l * GWID * GWID, M, GWID, GWID}; OneUnit S; S.u.pm = loc_ >> 1; S.u.pn = loc_ & 1;
                    epi::EpiGlu E{WSP(const pg8::bf16_t, WS_YA), WSP(pg8::bf16_t, WS_Y)};
                    pg8::gemm_phase<epi::EpiGlu, OneUnit, false, true>(Fg.lds, g, S, E, Fg.tid); __syncthreads(); TEND(19); }
                else if (ty_ == 2) { TSTART(20); mlstm_out_item(fresh(F), KA, l, loc_ >> 2, loc_ & 3); TEND(20); }
                else { TSTART(21); ret_out_item(fresh(F), KA, l, loc_ >> 2, loc_ & 3); TEND(21); }
            });
        } SEAM(pb + 4); TEND(4);
        TSTART(5); if (IN(pb + 5)) { Frame F = fresh(F0);
            pg8::Gemm g{WSP(const pg8::bf16_t, WS_Y), WSP(const pg8::bf16_t, WS_WOT) + (size_t)l * D * D, M, D, D}; pg8::StaticOrder S; S.init(M, D, F.G, F.bid);
            KArgs& A_ = KA; epi::EpiRes E{(const float*)(const GAS float*)A_.in[I_XP], (const float*)(const GAS float*)A_.in[I_XS], WSP(pg8::bf16_t, WS_XB), WSP(const float, WS_MOD) + (size_t)(l * 5) * (6 * D) + 2 * D, l == 0 ? 1 : 0,
                          1, WSP(pg8::bf16_t, WS_H), WSP(float, WS_SSQA), (const float*)(const GAS float*)A_.in[I_NORM2] + (size_t)l * D, WSP(const float, WS_MOD) + (size_t)(l * 5) * (6 * D) + 4 * D, F.lds + 131072};
            pg8::gemm_phase<epi::EpiRes, pg8::StaticOrder, true, true>(F.lds, g, S, E, F.tid);
        } SEAM(pb + 5); TEND(5);
        TSTART(7); if (IN(pb + 7)) for (int rep_ = 0; rep_ < (PROBE_REPEAT == 7 ? 2 : 1); ++rep_) { Frame F = fresh(F0);
            pg8::Gemm g{WSP(const pg8::bf16_t, WS_H), WSP(const pg8::bf16_t, WS_WM1T) + (size_t)l * DFF * D, M, DFF, D}; pg8::StaticOrder S; S.init(M, DFF, F.G, F.bid);
            epi::EpiRelu2 E{WSP(pg8::bf16_t, WS_HID), WSP(const float, WS_SSQA), WSP(const float, WS_SHW2) + (size_t)l * 5 * DFF};
            pg8::gemm_phase<epi::EpiRelu2, pg8::StaticOrder, true, true>(F.lds, g, S, E, F.tid);
        } SEAM(pb + 7); TEND(7);
        TSTART(8); if (IN(pb + 8)) { Frame F = fresh(F0);
            pg8::Gemm g{WSP(const pg8::bf16_t, WS_HID), WSP(const pg8::bf16_t, WS_WM2T) + (size_t)l * D * DFF, M, D, DFF}; pg8::StaticOrder S; S.init(M, D, F.G, F.bid);
            KArgs& A_ = KA; epi::EpiRes E{(const float*)(const GAS float*)A_.in[I_XP], (const float*)(const GAS float*)A_.in[I_XS], WSP(pg8::bf16_t, WS_XB), WSP(const float, WS_MOD) + (size_t)(l * 5) * (6 * D) + 5 * D, 0,
                          l < NLAYER - 1 ? 1 : 0, WSP(pg8::bf16_t, WS_H), WSP(float, WS_SSQB), (const float*)(const GAS float*)A_.in[I_NORM1] + (size_t)(l + 1) * D, WSP(const float, WS_MOD) + (size_t)((l + 1) * 5) * (6 * D) + 1 * D, F.lds + 131072};
            pg8::gemm_phase<epi::EpiRes, pg8::StaticOrder, true, true>(F.lds, g, S, E, F.tid);
        } SEAM(pb + 8); TEND(8);
    }
    if (IN(N_PHASES - 1)) { Frame F = fresh(F0); final_norm_phase(F, KA); }
    if (PROBE_IMASK != 0 && F0.bid == 0 && F0.wave == 0 && lane_id() == 0) { const unsigned long long acc_ = ((volatile LAS unsigned long long*)(F0.lds + MISC_OFF + 128))[1], te_ = __builtin_amdgcn_s_memrealtime();
        while (__builtin_amdgcn_s_memrealtime() - te_ < (unsigned long long)PROBE_TAMP * acc_) __builtin_amdgcn_s_sleep(32); }
    if (PROBE_TMASK != 0 && F0.bid == 0) { const unsigned long long te_ = __builtin_amdgcn_s_memrealtime(); while (__builtin_amdgcn_s_memrealtime() - te_ < (unsigned long long)PROBE_TAMP * ptacc_) __builtin_amdgcn_s_sleep(32); }
#undef IN
#undef SEAM
}

#ifndef MK_LAUNCH_PER_PHASE
#define MK_LAUNCH_PER_PHASE 0
#endif
extern "C" void kernel_launch(void* const* d_in, const int* in_sizes, int n_in, void* d_out, int out_size, void* d_ws, size_t ws_size, hipStream_t stream) {
    static int grid = 0;
    if (grid == 0) {
        if (n_in != N_IN || (size_t)out_size != O_END || ws_size < WS_END) { fprintf(stderr, "kernel_launch: shape mismatch: n_in %d out %d ws %zu (need %zu)\n", n_in, out_size, ws_size, (size_t)WS_END); grid = -1; return; }
        int dev = 0, cus = 0, per_cu = 0;
        if (hipGetDevice(&dev) != hipSuccess || hipDeviceGetAttribute(&cus, hipDeviceAttributeMultiprocessorCount, dev) != hipSuccess) { grid = -1; return; }
        if (hipFuncSetAttribute((const void*)hymba_fwd, hipFuncAttributeMaxDynamicSharedMemorySize, LDS_BYTES) != hipSuccess) { fprintf(stderr, "kernel_launch: hipFuncSetAttribute failed\n"); grid = -1; return; }
        if (hipOccupancyMaxActiveBlocksPerMultiprocessor(&per_cu, (const void*)hymba_fwd, NT, LDS_BYTES) != hipSuccess || per_cu < 1) fprintf(stderr, "kernel_launch: occupancy query says %d\n", per_cu);
        (void)hipGetLastError();
        grid = cus;
    }
    if (grid < 0) return;
    (void)hipMemsetAsync((char*)d_ws + WS_CTL, 0, CTL_ZERO_BYTES, stream);
    Args a{};
    for (int i = 0; i < N_IN; ++i) a.in[i] = (const float*)d_in[i];
    a.out = (float*)d_out; a.ws = (unsigned char*)d_ws;
#if MK_LAUNCH_PER_PHASE
    for (int p = 0; p < N_PHASES; ++p) { a.ph_lo = p; a.ph_hi = p + 1; hipLaunchKernelGGL(hymba_fwd, dim3(grid), dim3(NT), LDS_BYTES, stream, a); }
#else
    a.ph_lo = 0; a.ph_hi = N_PHASES;
    hipLaunchKernelGGL(hymba_fwd, dim3(grid), dim3(NT), LDS_BYTES, stream, a);
#endif
    const hipError_t le = hipPeekAtLastError();
    if (le != hipSuccess) fprintf(stderr, "kernel_launch: launch failed: %s\n", hipGetErrorName(le));
}
```

```cpp
#include <hip/hip_runtime.h>
#include <cstdio>
#include <cstdint>
namespace pg8 {
#define PG8_LAS __attribute__((address_space(3)))
typedef unsigned short bf16_t;
typedef short bf16x8 __attribute__((ext_vector_type(8)));
typedef float f32x4 __attribute__((ext_vector_type(4)));
typedef unsigned u32x4 __attribute__((ext_vector_type(4)));
constexpr int BM = 256, BK = 64, HALF = 128, HTB = HALF * BK * 2  , STAGE_BYTES = 8 * HTB, NXCD = 8, WGM = 8;

__host__ __device__ __forceinline__ int lds_byte(int r, int c) { const int st = (r >> 4) * 2 + (c >> 5), rr = r & 15, cc = c & 31, ob = rr * 64 + cc * 2; return st * 1024 + (ob ^ (((ob >> 9) & 1) << 5)); }
__host__ __device__ __forceinline__ void stage_rc(int b, int& R, int& C) { const int st = b / 1024, sb = b % 1024, swz = sb ^ (((sb >> 9) & 1) << 5); R = (st >> 1) * 16 + swz / 64; C = (st & 1) * 32 + (swz % 64) / 2; }
__host__ __device__ __forceinline__ int perm32(int rho) { const int n = rho >> 4, i = rho & 15; return 8 * (i >> 2) + 4 * n + (i & 3); }

struct Unit { int pm, pn; };
struct Gemm { const bf16_t* A; const bf16_t* Bt; int M, N, K; };

struct StaticOrder {
    int nM, nN, nwg, G, c;
    __host__ __device__ void init(int M, int N, int G_, int c_) { nM = M / BM; nN = N / BM; nwg = nM * nN; G = G_; c = c_; }
    __host__ __device__ bool next(int i, Unit& u) const {
        const long L = (long)i * G + c; if (L >= nwg) return false;
        int wgid = (int)L; { const int q = nwg / NXCD, r = nwg % NXCD, xcd = wgid % NXCD, off = wgid / NXCD; wgid = (xcd < r ? xcd * (q + 1) : r * (q + 1) + (xcd - r) * q) + off; }
        const int nig = WGM * nN, gid = wgid / nig, fm = gid * WGM, gsz = (nM - fm) < WGM ? (nM - fm) : WGM;
        u.pm = fm + ((wgid % nig) % gsz); u.pn = (wgid % nig) / gsz; return true;
    }
    __device__ __forceinline__ void a_ready(const Unit&) const {}
    __device__ __forceinline__ void done(const Unit&) const {}
};

struct XccOrder {
    StaticOrder so; int mode, x, j, nN;
    __host__ __device__ void init(int M, int N, int G_, int c_, int mode_, int x_, int j_) { so.init(M, N, G_, c_); mode = mode_; x = x_; j = j_; nN = N / BM; }
    __host__ __device__ bool next(int i, Unit& u) const {
        if (!mode) return so.next(i, u);
        const int w = i * 32 + j; if (w >= 12 * nN) return false;
        const int q4 = 4 * nN, pg = w / q4, r = w - pg * q4;
        u.pm = 12 * x + 4 * pg + (r & 3); u.pn = r >> 2; return true;
    }
    __device__ __forceinline__ void a_ready(const Unit&) const {}
    __device__ __forceinline__ void done(const Unit&) const {}
};

__device__ __forceinline__ unsigned cvt_pk_bf16(float lo, float hi) { unsigned r; asm volatile("v_cvt_pk_bf16_f32 %0, %1, %2" : "=v"(r) : "v"(lo), "v"(hi)); return r; }
typedef float f32x2 __attribute__((ext_vector_type(2)));
template <class Epi, class Sched, bool ALIGN_EPI = false, bool SP2 = false>
__device__ __forceinline__ void gemm_phase(PG8_LAS unsigned char* lds, const Gemm g, const Sched& S, const Epi& E, int tid_in) {
    int tid_ = tid_in; asm volatile("" : "+v"(tid_));
    const int tid = tid_, wid = __builtin_amdgcn_readfirstlane(tid >> 6), lane = tid & 63, wr = wid >> 2, wc = wid & 3, fr = lane & 15, fq = lane >> 4;
    const int K = g.K, nt = K / BK;
    unsigned voffA[2], voffB[2];
#pragma unroll
    for (int i = 0; i < 2; ++i) { int R, C; stage_rc(tid * 16 + i * 8192, R, C); const int Rb = Epi::PERM ? ((R & ~31) + perm32(R & 31)) : R;
        voffA[i] = (unsigned)(R * K + C) * 2u; voffB[i] = (unsigned)(Rb * K + C) * 2u; }
    const size_t kstep = (size_t)(BK * 2);
    const size_t hstep = (size_t)HALF * K * 2;
    const size_t tstep = 2 * hstep;
    const unsigned ldsw = (unsigned)wid * 1024u;
    const int aoff = lds_byte(wr * 64 + fr, fq * 8), boff = lds_byte(wc * 32 + fr, fq * 8);
#define PG8_SA(b, h) (((b) * 2 + (h)) * HTB)
#define PG8_SB(b, h) ((4 + (b) * 2 + (h)) * HTB)
#define PG8_STAGE(bufoff, gbase, voff) do { _Pragma("unroll") for (int _i = 0; _i < 2; ++_i) \
        __builtin_amdgcn_global_load_lds((const unsigned*)((const char*)(gbase) + (voff)[_i]), (PG8_LAS unsigned*)(lds + (bufoff) + ldsw + _i * 8192), 16, 0, 0); } while (0)
#define PG8_LDA(dst, b, h) do { _Pragma("unroll") for (int m = 0; m < 4; ++m) _Pragma("unroll") for (int k = 0; k < 2; ++k) dst[m][k] = *(const PG8_LAS bf16x8*)(lds + PG8_SA(b, h) + aoff + m * 2048 + k * 1024); } while (0)
#define PG8_LDB(dst, b, h) do { _Pragma("unroll") for (int n = 0; n < 2; ++n) _Pragma("unroll") for (int k = 0; k < 2; ++k) dst[n][k] = *(const PG8_LAS bf16x8*)(lds + PG8_SB(b, h) + boff + n * 2048 + k * 1024); } while (0)
#define PG8_MMA(ai, bj, At, Bt) do { __builtin_amdgcn_s_setprio(1); _Pragma("unroll") for (int m = 0; m < 4; ++m) _Pragma("unroll") for (int n = 0; n < 2; ++n) _Pragma("unroll") for (int k = 0; k < 2; ++k) \
        acc[ai][bj][m][n] = __builtin_amdgcn_mfma_f32_16x16x32_bf16(Bt[n][k], At[m][k], acc[ai][bj][m][n], 0, 0, 0); __builtin_amdgcn_s_setprio(0); } while (0)
#define PG8_WAIT_V(n) asm volatile("s_waitcnt vmcnt(" #n ")" ::: "memory")
#define PG8_WAIT_L(n) asm volatile("s_waitcnt lgkmcnt(" #n ")" ::: "memory")
#define PG8_BAR __builtin_amdgcn_s_barrier()
#define PG8_SCHED __builtin_amdgcn_sched_barrier(0)
    Unit cur, nxt; int ui = 0;
    if (!S.next(0, cur)) return;
    f32x4 acc[2][2][4][2];
#pragma unroll
    for (int a = 0; a < 2; ++a)
#pragma unroll
        for (int b = 0; b < 2; ++b)
#pragma unroll
            for (int m = 0; m < 4; ++m)
#pragma unroll
                for (int n = 0; n < 2; ++n) acc[a][b][m][n] = (f32x4){0.f, 0.f, 0.f, 0.f};
    bf16x8 At[4][2], B0[2][2], B1[2][2];
    const char* cA = (const char*)g.A + (size_t)cur.pm * tstep; const char* cB = (const char*)g.Bt + (size_t)cur.pn * tstep;
    S.a_ready(cur);
    if constexpr (SP2) {
        PG8_STAGE(PG8_SB(0, 0), cB, voffB); PG8_STAGE(PG8_SB(0, 1), cB + hstep, voffB); PG8_STAGE(PG8_SA(0, 0), cA, voffA); PG8_STAGE(PG8_SA(0, 1), cA + hstep, voffA);
        if (wr == 1) PG8_BAR;
        PG8_WAIT_V(2); PG8_BAR;
        PG8_STAGE(PG8_SB(1, 0), cB + kstep, voffB); PG8_STAGE(PG8_SA(1, 0), cA + kstep, voffA); PG8_STAGE(PG8_SB(1, 1), cB + hstep + kstep, voffB);
        PG8_WAIT_V(6); PG8_BAR;
    } else {
        PG8_STAGE(PG8_SB(0, 0), cB, voffB); PG8_STAGE(PG8_SA(0, 0), cA, voffA); PG8_STAGE(PG8_SB(0, 1), cB + hstep, voffB); PG8_STAGE(PG8_SA(0, 1), cA + hstep, voffA);
        if (wr == 1) PG8_BAR;
        PG8_WAIT_V(4); PG8_BAR;
        PG8_STAGE(PG8_SB(1, 0), cB + kstep, voffB); PG8_STAGE(PG8_SA(1, 0), cA + kstep, voffA); PG8_STAGE(PG8_SB(1, 1), cB + hstep + kstep, voffB);
        PG8_WAIT_V(6); PG8_BAR;
    }
    for (;;) {
        const bool has_next = S.next(ui + 1, nxt);
        const char* nA = has_next ? (const char*)g.A + (size_t)nxt.pm * tstep : cA; const char* nB = has_next ? (const char*)g.Bt + (size_t)nxt.pn * tstep : cB;
        for (int t = 0; t < nt; t += 2) {
            const bool last = (t == nt - 2);
            const char* a1 = cA + (size_t)(t + 1) * kstep;
            const char* a2 = last ? nA : cA + (size_t)(t + 2) * kstep; const char* b2 = last ? nB : cB + (size_t)(t + 2) * kstep;
            const char* a3 = a2 + kstep; const char* b3 = b2 + kstep;
            if (last && has_next) S.a_ready(nxt);
            if constexpr (SP2) {
            PG8_LDB(B0, 0, 0); PG8_LDB(B1, 0, 1); PG8_SCHED; PG8_LDA(At, 0, 0); PG8_STAGE(PG8_SA(1, 1), a1 + hstep, voffA);
            PG8_WAIT_V(8); PG8_WAIT_L(0); PG8_BAR; PG8_MMA(0, 0, At, B0); PG8_MMA(0, 1, At, B1); PG8_BAR; PG8_SCHED;
            PG8_LDA(At, 0, 1); PG8_STAGE(PG8_SB(0, 0), b2, voffB); PG8_STAGE(PG8_SB(0, 1), b2 + hstep, voffB); PG8_STAGE(PG8_SA(0, 0), a2, voffA);
            PG8_WAIT_V(8); PG8_WAIT_L(0); PG8_BAR; PG8_MMA(1, 0, At, B0); PG8_MMA(1, 1, At, B1); PG8_BAR; PG8_SCHED;
            PG8_LDB(B0, 1, 0); PG8_LDB(B1, 1, 1); PG8_SCHED; PG8_LDA(At, 1, 0); PG8_STAGE(PG8_SA(0, 1), a2 + hstep, voffA);
            PG8_WAIT_V(8); PG8_WAIT_L(0); PG8_BAR; PG8_MMA(0, 0, At, B0); PG8_MMA(0, 1, At, B1); PG8_BAR; PG8_SCHED;
            PG8_LDA(At, 1, 1); PG8_STAGE(PG8_SB(1, 0), b3, voffB); PG8_STAGE(PG8_SB(1, 1), b3 + hstep, voffB); PG8_STAGE(PG8_SA(1, 0), a3, voffA);
            PG8_WAIT_V(8); PG8_WAIT_L(0); PG8_BAR; PG8_MMA(1, 0, At, B0); PG8_MMA(1, 1, At, B1); PG8_BAR; PG8_SCHED;
            } else {
            PG8_LDB(B0, 0, 0); PG8_SCHED; PG8_LDA(At, 0, 0); PG8_STAGE(PG8_SA(1, 1), a1 + hstep, voffA);
            PG8_WAIT_L(8); PG8_BAR; PG8_WAIT_L(0); PG8_MMA(0, 0, At, B0); PG8_BAR; PG8_SCHED;
            PG8_LDB(B1, 0, 1); PG8_STAGE(PG8_SB(0, 0), b2, voffB);
            PG8_BAR; PG8_WAIT_L(0); PG8_MMA(0, 1, At, B1); PG8_BAR;
            PG8_LDA(At, 0, 1); PG8_STAGE(PG8_SA(0, 0), a2, voffA);
            PG8_BAR; PG8_WAIT_L(0); PG8_MMA(1, 0, At, B0); PG8_BAR; PG8_SCHED;
            PG8_STAGE(PG8_SB(0, 1), b2 + hstep, voffB);
            PG8_WAIT_V(6); PG8_BAR; PG8_MMA(1, 1, At, B1); PG8_BAR;
            PG8_LDB(B0, 1, 0); PG8_SCHED; PG8_LDA(At, 1, 0); PG8_STAGE(PG8_SA(0, 1), a2 + hstep, voffA);
            PG8_WAIT_L(8); PG8_BAR; PG8_WAIT_L(0); PG8_MMA(0, 0, At, B0); PG8_BAR; PG8_SCHED;
            PG8_LDB(B1, 1, 1); PG8_STAGE(PG8_SB(1, 0), b3, voffB);
            PG8_BAR; PG8_WAIT_L(0); PG8_MMA(0, 1, At, B1); PG8_BAR;
            PG8_LDA(At, 1, 1); PG8_STAGE(PG8_SA(1, 0), a3, voffA);
            PG8_BAR; PG8_WAIT_L(0); PG8_MMA(1, 0, At, B0); PG8_BAR; PG8_SCHED;
            PG8_STAGE(PG8_SB(1, 1), b3 + hstep, voffB);
            PG8_WAIT_V(6); PG8_BAR; PG8_MMA(1, 1, At, B1); PG8_BAR;
            }
        }
        if constexpr (ALIGN_EPI) { if (wr == 0) PG8_BAR; }
        if constexpr (!Epi::AFTER_DRAIN) { E(acc, cur, wr, wc, fr, fq); S.done(cur); }
        if (!has_next) break;
#pragma unroll
        for (int a = 0; a < 2; ++a)
#pragma unroll
            for (int b = 0; b < 2; ++b)
#pragma unroll
                for (int m = 0; m < 4; ++m)
#pragma unroll
                    for (int n = 0; n < 2; ++n) acc[a][b][m][n] = (f32x4){0.f, 0.f, 0.f, 0.f};
        cur = nxt; cA = nA; cB = nB; ++ui;
        if constexpr (ALIGN_EPI) { if (wr == 1) PG8_BAR; }
    }
    PG8_WAIT_V(0);
    if constexpr (!ALIGN_EPI) { if (wr == 0) PG8_BAR; }
    PG8_BAR;
    if constexpr (Epi::AFTER_DRAIN) { E.fused(acc, cur, wr, wc, fr, fq, lds, wid, lane); S.done(cur); }
#undef PG8_SA
#undef PG8_SB
#undef PG8_STAGE
#undef PG8_LDA
#undef PG8_LDB
#undef PG8_MMA
#undef PG8_WAIT_V
#undef PG8_WAIT_L
#undef PG8_BAR
#undef PG8_SCHED
}
}
#define GAS __attribute__((address_space(1)))
#define LAS __attribute__((address_space(3)))
typedef unsigned short bf16;
typedef unsigned v4u __attribute__((ext_vector_type(4)));
typedef float f32x4 __attribute__((ext_vector_type(4)));
typedef short bf16x8 __attribute__((ext_vector_type(8)));
typedef GAS unsigned gu32;
typedef GAS unsigned long long gu64;
#define RLX_AGENT __ATOMIC_RELAXED, __HIP_MEMORY_SCOPE_AGENT
#define LDS_WAIT() asm volatile("s_waitcnt lgkmcnt(0)" ::: "memory")
#define VM_WAIT() asm volatile("s_waitcnt vmcnt(0)" ::: "memory")
__device__ __forceinline__ unsigned long long rt() { return __builtin_amdgcn_s_memrealtime(); }
typedef __bf16 hwbf16x2_t __attribute__((ext_vector_type(2)));
typedef float hwf32x2_t __attribute__((ext_vector_type(2)));
__device__ __forceinline__ unsigned pk2(float lo, float hi) { const hwf32x2_t v = {lo, hi}; const hwbf16x2_t b = __builtin_convertvector(v, hwbf16x2_t); return __builtin_bit_cast(unsigned, b); }
__device__ __forceinline__ unsigned f2bf(float f) { return pk2(f, 0.f) & 0xffffu; }
#define XB_TMO      128
#define XB_XCNT(j)  (256  + 64 * (j))
#define XB_XSUB(j)  (1280 + 64 * (j))
#define XB_XGEN(j)  (2304 + 64 * (j))
#define XB_TOP      3328
#define XB_TOPGEN   3392
#define XCD_BAR_WORDS 3456
#define XB_LSUB(j)  (3456 + 64 * (j))
#define XB_SPIN_CAP (1u << 18)

__device__ __forceinline__ unsigned xb_ld(unsigned* p)              { return __hip_atomic_load(p, __ATOMIC_RELAXED, __HIP_MEMORY_SCOPE_AGENT); }
__device__ __forceinline__ unsigned xb_add(unsigned* p, unsigned v) { return __hip_atomic_fetch_add(p, v, __ATOMIC_RELAXED, __HIP_MEMORY_SCOPE_AGENT); }
__device__ __forceinline__ unsigned xb_xcc_id() { return (unsigned)__builtin_amdgcn_s_getreg((3 << 11) | 20) & 0xFu; }
#define XB_SPIN(cond, bar) do { unsigned _sp = 0; while (cond) { __builtin_amdgcn_s_sleep(1); \
    if ((++_sp & 255u) == 0u) { if (xb_ld(&(bar)[XB_TMO])) break; if (_sp > XB_SPIN_CAP) { atomicAdd(&(bar)[XB_TMO], 1u); break; } } } } while (0)

struct XcdBarrier {
    unsigned wave0;
    unsigned* bar; unsigned x;
    volatile LAS unsigned* st;
};

__device__ __forceinline__ bool xb_lane0() { return __builtin_amdgcn_mbcnt_hi(~0u, __builtin_amdgcn_mbcnt_lo(~0u, 0u)) == 0u; }
__device__ __forceinline__ XcdBarrier xcd_barrier_post(unsigned* bar, volatile LAS unsigned* st, unsigned wave0) {
    XcdBarrier b; b.wave0 = wave0; b.bar = bar; b.x = xb_xcc_id(); b.st = st;
    if (wave0 && xb_lane0()) st[2] = xb_add(&bar[XB_XCNT(b.x)], 1u);
    return b;
}
__device__ __forceinline__ void xcd_barrier_complete(unsigned* bar, unsigned x, unsigned& nloc, unsigned& nx, unsigned& even) {
    const unsigned G = gridDim.x * gridDim.y * gridDim.z;
    unsigned sum, cnt, mine, bad, sp = 0u;
    for (;;) {
        sum = 0u; cnt = 0u; mine = 0u; bad = 0u;
#pragma unroll
        for (unsigned j = 0; j < 16; ++j) { const unsigned c = xb_ld(&bar[XB_XCNT(j)]); sum += c; cnt += (c > 0u) ? 1u : 0u; mine = (j == x) ? c : mine; bad |= (c != (j < 8u ? 32u : 0u)) ? 1u : 0u; }
        if (sum == G) break;
        __builtin_amdgcn_s_sleep(1);
        if ((++sp & 255u) == 0u) { if (xb_ld(&bar[XB_TMO])) break; if (sp > XB_SPIN_CAP) { atomicAdd(&bar[XB_TMO], 1u); break; } }
    }
    nloc = mine > 0u ? mine : 1u; nx = cnt > 0u ? cnt : 1u; even = (sum == G && G == 256u && bad == 0u) ? 2u : 1u;
}

__device__ __forceinline__ void xcd_barrier(const XcdBarrier& b) {
    asm volatile("s_waitcnt vmcnt(0)" ::: "memory");
    __syncthreads();
    if (b.wave0 && xb_lane0()) {
        unsigned* bar = b.bar;
        __builtin_amdgcn_s_waitcnt(0);
        unsigned nloc = b.st[0], nx = b.st[1];
        if (nloc == 0u) { unsigned ev; xcd_barrier_complete(bar, b.x, nloc, nx, ev); b.st[0] = nloc; b.st[1] = nx; b.st[3] = ev; }
        const unsigned old = xb_add(&bar[XB_XSUB(b.x)], 1u);
        const unsigned gen = old / nloc;
        if (old + 1u == (gen + 1u) * nloc) {
            __builtin_amdgcn_fence(__ATOMIC_RELEASE, "agent");
            asm volatile("s_waitcnt vmcnt(0)" ::: "memory");
            const unsigned og = xb_add(&bar[XB_TOP], 1u);
            const unsigned tg = og / nx;
            if (og + 1u == (tg + 1u) * nx) xb_add(&bar[XB_TOPGEN], 1u);
            else XB_SPIN(xb_ld(&bar[XB_TOPGEN]) == tg, bar);
            __builtin_amdgcn_fence(__ATOMIC_ACQUIRE, "agent");
            xb_add(&bar[XB_XGEN(b.x)], 1u);
            asm volatile("s_waitcnt vmcnt(0)" ::: "memory");
        } else {
            XB_SPIN(xb_ld(&bar[XB_XGEN(b.x)]) == gen, bar);
            __builtin_amdgcn_fence(__ATOMIC_ACQUIRE, "agent");
            asm volatile("s_waitcnt vmcnt(0)" ::: "memory");
        }
    }
    __syncthreads();
}

__device__ __forceinline__ void xcc_barrier(const XcdBarrier& b) {
    asm volatile("s_waitcnt vmcnt(0)" ::: "memory");
    __syncthreads();
    if (b.wave0 && xb_lane0()) {
        unsigned* bar = b.bar;
        __builtin_amdgcn_s_waitcnt(0);
        const unsigned nloc = b.st[0];
        const unsigned old = xb_add(&bar[XB_LSUB(b.x)], 1u);
        const unsigned target = (old / nloc + 1u) * nloc;
        XB_SPIN(xb_ld(&bar[XB_LSUB(b.x)]) < target, bar);
        __builtin_amdgcn_fence(__ATOMIC_ACQUIRE, "agent");
        asm volatile("s_waitcnt vmcnt(0)" ::: "memory");
    }
    __syncthreads();
}
constexpr int NWAVES = 8, NT = 512;
constexpr int D = 2048, NLAYER = 4;
constexpr int MC = 32 * 256, ML = 4 * 4096, M = MC + ML;
constexpr int DIN = 6176, NPROJ = 6144, NPAD = 6400, DFF = 8192, GWID = 512;
constexpr int NCP = M / 128;
constexpr float EPS = 1e-6f;
constexpr int PC_S5U = 0, PC_MQ = 512, PC_MK = 1024, PC_MV = 1536, PC_MO = 2048, PC_RQ = 2560, PC_RK = 3072, PC_RV = 3584, PC_RG = 4096, PC_DZ = 4608, PC_DX = 5120, PC_DB = 5632, PC_DC = 5888;
enum { I_XP = 0, I_XS, I_C, I_SS5R, I_SS5I, I_SMC, I_SMN, I_SMM, I_SRET, I_SSSD, I_CCTX, I_NORM1, I_WADA, I_BADA, I_WIN, I_S5LR, I_S5LI, I_S5DT, I_S5BR, I_S5BI, I_S5CR, I_S5CI, I_S5D, I_S5GLU,
       I_MIB, I_MFB, I_MNORM, I_RRATE, I_RNORM, I_CONVW, I_CONVB, I_DTB, I_ALOG, I_SSDD, I_SNORM, I_WOUT, I_NORM2, I_WM1, I_WM2, I_FNORM, N_IN };
constexpr size_t O_YP = 0, O_YS = (size_t)MC * D, O_S5R = (size_t)M * D, O_S5I = O_S5R + 524288, O_MC = O_S5I + 524288, O_MN = O_MC + 16777216, O_MM = O_MN + 131072, O_RET = O_MM + 1024, O_SSD = O_RET + 16777216, O_END = O_SSD + 16777216;

constexpr size_t MiB = 1u << 20;
constexpr size_t WS_CTL = 0, CTL_ZERO_BYTES = 1 * MiB;
constexpr size_t WS_MOD = 1 * MiB;
constexpr size_t WS_S5T = 2 * MiB;
constexpr size_t WS_ROPE = 5 * MiB;
constexpr size_t WS_GATES = 6 * MiB;
constexpr size_t WS_MLNLOC = 9 * MiB;
constexpr size_t WS_MLNIN = 10 * MiB;
constexpr size_t WS_MLSC = 11 * MiB;
constexpr size_t WS_MLMIN = 11 * MiB + 65536;
constexpr size_t WS_SDSC = 11 * MiB + 131072;
constexpr size_t WS_SSQA = 5 * MiB + 65536;
constexpr size_t WS_SSQB = 11 * MiB + 262144;
constexpr size_t WS_SHW1 = 18 * MiB;
constexpr size_t WS_SHW2 = 19 * MiB;
constexpr size_t WS_S5LOC = 12 * MiB;
constexpr size_t WS_WGT = 20 * MiB;
constexpr size_t WS_W1T = 22 * MiB;
constexpr size_t WS_WOT = 122 * MiB;
constexpr size_t WS_WM1T = 154 * MiB;
constexpr size_t WS_WM2T = 282 * MiB;
constexpr size_t WS_H = 410 * MiB;
constexpr size_t WS_Y = 506 * MiB;
constexpr size_t WS_YA = 602 * MiB;
constexpr size_t WS_MLCIN = 626 * MiB;
constexpr size_t WS_RTIN = 674 * MiB;
constexpr size_t WS_SDIN = 722 * MiB;
constexpr size_t WS_PROJ = 770 * MiB;
constexpr size_t WS_MLCLOC = 1058 * MiB;
constexpr size_t WS_HID = 770 * MiB;
constexpr size_t WS_RTLOC = 1106 * MiB;
constexpr size_t WS_SDLOC = 1154 * MiB;
constexpr size_t WS_XBCC = 1202 * MiB;
constexpr size_t WS_XB = 1250 * MiB;
constexpr size_t WS_END = 1346 * MiB;
constexpr int CW_TMO = 0, CW_BAR = 4096;

constexpr int LDT = 272;
constexpr int TS = 128 * LDT;
constexpr int LDX = 144;
constexpr int TSX = 128 * LDX;
constexpr int SCAL_OFF = 4 * TS;
constexpr int MISC_OFF = 163840 - 256;
constexpr int LDS_BYTES = 163840;
#define SCA(i) ((LAS float*)(F.lds + SCAL_OFF + (i) * 512))
typedef float f32x16 __attribute__((ext_vector_type(16)));
typedef float f32x2 __attribute__((ext_vector_type(2)));
typedef short s16x4 __attribute__((ext_vector_type(4)));
typedef unsigned u32x2 __attribute__((ext_vector_type(2)));
struct Args { const float* in[N_IN]; float* out; unsigned char* ws; int ph_lo, ph_hi; };
struct Frame {
    LAS unsigned char* lds;
    float* out; unsigned char* ws;
    int tid, lane, wave, G, bid;
};
__device__ __forceinline__ int lane_id() { return (int)__builtin_amdgcn_mbcnt_hi(~0u, __builtin_amdgcn_mbcnt_lo(~0u, 0u)); }
typedef const __attribute__((address_space(4))) Args KArgs;
__device__ __forceinline__ KArgs* kargs() { KArgs* p = (KArgs*)__builtin_amdgcn_kernarg_segment_ptr(); asm volatile("" : "+s"(p)); return p; }
__device__ __forceinline__ Frame fresh(const Frame& F) { Frame R = F; unsigned long long l = (unsigned long long)(size_t)R.lds; unsigned ll = (unsigned)l; asm volatile("" : "+s"(ll), "+s"(R.wave), "+s"(R.G), "+s"(R.bid)); R.lane = lane_id(); asm volatile("" : "+v"(R.lane)); R.tid = R.wave * 64 + R.lane; R.lds = (LAS unsigned char*)(size_t)ll; KArgs* ka = kargs(); R.out = (float*)(GAS float*)ka->out; R.ws = (unsigned char*)(GAS unsigned char*)ka->ws; return R; }
#define INP(i) ((const float*)(const GAS float*)(A.in[i]))
#define BAR() __syncthreads()
#ifndef PROBE_IMASK
#define PROBE_IMASK 0
#endif
#define ITS(k) do { if ((PROBE_IMASK >> (k)) & 1) { if (F.tid == 0 && F.bid == 0) ((volatile LAS unsigned long long*)(F.lds + MISC_OFF + 128))[0] = __builtin_amdgcn_s_memrealtime(); } } while (0)
#define ITE(k) do { if ((PROBE_IMASK >> (k)) & 1) { if (F.tid == 0 && F.bid == 0) { volatile LAS unsigned long long* p_ = (volatile LAS unsigned long long*)(F.lds + MISC_OFF + 128); p_[1] += __builtin_amdgcn_s_memrealtime() - p_[0]; } } } while (0)
#define WSP(T, off) ((T*)(F.ws + (off)))
__device__ __forceinline__ float bf2f(unsigned short b) { return __uint_as_float((unsigned)b << 16); }
__device__ __forceinline__ float bflo(unsigned w) { return __uint_as_float(w << 16); }
__device__ __forceinline__ float bfhi(unsigned w) { return __uint_as_float(w & 0xffff0000u); }
__device__ __forceinline__ void unpack8(const v4u a, float (&x)[8]) { x[0] = bflo(a.x); x[1] = bfhi(a.x); x[2] = bflo(a.y); x[3] = bfhi(a.y); x[4] = bflo(a.z); x[5] = bfhi(a.z); x[6] = bflo(a.w); x[7] = bfhi(a.w); }
__device__ __forceinline__ v4u pack8(const float (&x)[8], float w) { v4u o; o.x = pk2(x[0] * w, x[1] * w); o.y = pk2(x[2] * w, x[3] * w); o.z = pk2(x[4] * w, x[5] * w); o.w = pk2(x[6] * w, x[7] * w); return o; }
__device__ __forceinline__ float sigmoidf_(float x) { return __builtin_amdgcn_rcpf(1.f + __expf(-x)); }
__device__ __forceinline__ float siluf_(float x) { return x * sigmoidf_(x); }
__device__ __forceinline__ float lshfl(float v, int src_lane) { return __builtin_bit_cast(float, __builtin_amdgcn_ds_bpermute(src_lane << 2, __builtin_bit_cast(int, v))); }
__device__ __forceinline__ float lshfl_xor(float v, int m, int lane) { return lshfl(v, lane ^ m); }
__device__ __forceinline__ float lshfl_up(float v, int o, int lane) { return lshfl(v, lane >= o ? lane - o : lane); }
__device__ __forceinline__ float wave_sum(float v) {
#pragma unroll
    for (int o = 1; o < 64; o <<= 1) v += __shfl_xor(v, o);
    return v;
}
__device__ __forceinline__ float wave_max(float v) {
#pragma unroll
    for (int o = 1; o < 64; o <<= 1) v = fmaxf(v, __shfl_xor(v, o));
    return v;
}
__device__ __forceinline__ float wave_sum_l(float v, int lane) {
#pragma unroll
    for (int o = 1; o < 64; o <<= 1) v += lshfl_xor(v, o, lane);
    return v;
}
__device__ __forceinline__ float wave_max_l(float v, int lane) {
#pragma unroll
    for (int o = 1; o < 64; o <<= 1) v = fmaxf(v, lshfl_xor(v, o, lane));
    return v;
}
template <bool MAX> __device__ __forceinline__ void wave_scan128(const LAS float* in, LAS float* out, int lane, bool rev, float init) {
    const int i0 = rev ? 127 - 2 * lane : 2 * lane, i1 = rev ? i0 - 1 : i0 + 1;
    float e0 = in[i0], e1 = in[i1];
    if (lane == 0) e0 = MAX ? fmaxf(e0, init) : e0 + init;
    float inc = MAX ? fmaxf(e0, e1) : e0 + e1;
#pragma unroll
    for (int o = 1; o < 64; o <<= 1) { const float t = __shfl_up(inc, o); if (lane >= o) inc = MAX ? fmaxf(inc, t) : inc + t; }
    float exc = __shfl_up(inc, 1);
    const float o0 = (lane == 0) ? e0 : (MAX ? fmaxf(exc, e0) : exc + e0);
    out[i0] = o0; out[i1] = inc;
}
__device__ __forceinline__ s16x4 lds_tr(const LAS unsigned char* p) {
    typedef short v4i16_t __attribute__((ext_vector_type(4)));
    return __builtin_bit_cast(s16x4, __builtin_amdgcn_ds_read_tr16_b64_v4i16((LAS v4i16_t*)p));
}
__device__ __forceinline__ bf16x8 frag_row(const LAS unsigned char* base, int ld, int r0, int k0, int lane) {
    return *(const LAS bf16x8*)(base + (r0 + (lane & 31)) * ld + (k0 + 8 * (lane >> 5)) * 2);
}
__device__ __forceinline__ bf16x8 frag_tr(const LAS unsigned char* base, int ld, int k0, int c0, int lane) {
    const int h = lane >> 5, blk = (lane >> 4) & 1, q = (lane & 15) >> 2, p = lane & 3;
    const LAS unsigned char* a = base + (k0 + 8 * h + q) * ld + (c0 + 16 * blk + 4 * p) * 2;
    const s16x4 lo = lds_tr(a), hi = lds_tr(a + 4 * ld);
    return (bf16x8){lo[0], lo[1], lo[2], lo[3], hi[0], hi[1], hi[2], hi[3]};
}
__device__ __forceinline__ bf16x8 frag_trp(const LAS unsigned char* base, int ld, int k0, int c0, int lane) {
    const int h = lane >> 5, blk = (lane >> 4) & 1, q = (lane & 15) >> 2, p = lane & 3;
    const LAS unsigned char* a = base + (k0 + 4 * h + q) * ld + (c0 + 16 * blk + 4 * p) * 2;
    const s16x4 lo = lds_tr(a), hi = lds_tr(a + 8 * ld);
    return (bf16x8){lo[0], lo[1], lo[2], lo[3], hi[0], hi[1], hi[2], hi[3]};
}
#define MFMA32(a, b, c) __builtin_amdgcn_mfma_f32_32x32x16_bf16((a), (b), (c), 0, 0, 0)
#define ZERO16 ((f32x16){0.f,0.f,0.f,0.f,0.f,0.f,0.f,0.f,0.f,0.f,0.f,0.f,0.f,0.f,0.f,0.f})
__device__ __forceinline__ int crow(int i, int hh) { return (i & 3) + 8 * (i >> 2) + 4 * hh; }

#define PT(cp, col) (WSP(const bf16, WS_PROJ) + ((size_t)(cp) * 48 + ((col) >> 7)) * 16384 + ((col) & 127))
#define XT(cp, ch) (WSP(bf16, WS_XBCC) + ((size_t)(cp) * 8 + ((ch) >> 7)) * 16384 + ((ch) & 127))
__device__ __forceinline__ const float* x_in_row(const Frame& F, KArgs& A, int l, int r) {
    if (l == 0) return r < MC ? INP(I_XP) + (size_t)r * D : INP(I_XS) + (size_t)(r - MC) * D;
    return F.out + (size_t)r * D;
}
__device__ __forceinline__ int mod_row(int r) { return r < MC ? 0 : 1 + (r - MC) / 4096; }
__device__ __forceinline__ const float* mod_ptr(const Frame& F, int l, int mrow, int part) { return WSP(const float, WS_MOD) + ((size_t)(l * 5 + mrow) * 6 + part) * D; }
struct Seq { int cp0, nch, c, b, lat; };
__device__ __forceinline__ Seq seq_of(int cp) { Seq s; if (cp < 64) { s.lat = 0; s.b = cp >> 1; s.cp0 = cp & ~1; s.nch = 2; s.c = cp & 1; } else { s.lat = 1; s.b = (cp - 64) >> 5; s.cp0 = 64 + (s.b << 5); s.nch = 32; s.c = (cp - 64) & 31; } return s; }
__device__ __forceinline__ int w1_newcol(int n) { return n < 2560 ? n : (n < 2576 ? n - 2560 + 6144 : (n < 6160 ? n - 16 : n)); }
template <bool MAPW1> __device__ __forceinline__ void p0_transpose_item(const float* W, int K, int N, bf16* WT, LAS float* scr, int item, int lane) {
    const int nblk = N / 32, kb = item / nblk, nb = item % nblk, k0 = 64 * kb, n0 = 32 * nb;
#pragma unroll 8
    for (int i = 0; i < 32; ++i) { const int kk = 2 * i + (lane >> 5); scr[kk * 33 + (lane & 31)] = W[(size_t)(k0 + kk) * N + n0 + (lane & 31)]; }
    LDS_WAIT(); asm volatile("" ::: "memory");
    const int c = lane & 7;
#pragma unroll
    for (int j = 0; j < 4; ++j) { const int n = (lane >> 3) + 8 * j; const LAS float* s = scr + (8 * c) * 33 + n;
        v4u o; o.x = pk2(s[0 * 33], s[1 * 33]); o.y = pk2(s[2 * 33], s[3 * 33]); o.z = pk2(s[4 * 33], s[5 * 33]); o.w = pk2(s[6 * 33], s[7 * 33]);
        const int nr = MAPW1 ? w1_newcol(n0 + n) : (n0 + n);
        *(GAS v4u*)(WT + (size_t)nr * K + k0 + 8 * c) = o; }
    LDS_WAIT(); asm volatile("" ::: "memory");
}
constexpr int S5T_STRIDE = 9216;
__device__ __forceinline__ unsigned char* s5tab(const Frame& F, int l, int d, int g) { return F.ws + WS_S5T + (size_t)((l * 2 + d) * 32 + g) * S5T_STRIDE; }

__device__ __forceinline__ void p0_prologue(Frame& F, KArgs& A) {
    {
        LAS float* scr = (LAS float*)(F.lds + F.wave * 16384);
        const int gw = F.bid * NWAVES + F.wave, NGW = F.G * NWAVES;
        constexpr int I_1 = (D / 64) * (DIN / 32), I_G = (GWID / 64) * (GWID / 32), I_O = (D / 64) * (D / 32), I_M1 = (D / 64) * (DFF / 32), I_M2 = (DFF / 64) * (D / 32);
        constexpr int PER_L = I_1 + I_G + I_O + I_M1 + I_M2;
        for (int it = gw; it < NLAYER * PER_L; it += NGW) {
            const int l = it / PER_L; int r = it % PER_L;
            if (r < I_1) { p0_transpose_item<true>(INP(I_WIN) + (size_t)l * D * DIN, D, DIN, WSP(bf16, WS_W1T) + (size_t)l * NPAD * D, scr, r, F.lane); continue; } r -= I_1;
            if (r < I_G) { p0_transpose_item<false>(INP(I_S5GLU) + (size_t)l * GWID * GWID, GWID, GWID, WSP(bf16, WS_WGT) + (size_t)l * GWID * GWID, scr, r, F.lane); continue; } r -= I_G;
            if (r < I_O) { p0_transpose_item<false>(INP(I_WOUT) + (size_t)l * D * D, D, D, WSP(bf16, WS_WOT) + (size_t)l * D * D, scr, r, F.lane); continue; } r -= I_O;
            if (r < I_M1) { p0_transpose_item<false>(INP(I_WM1) + (size_t)l * D * DFF, D, DFF, WSP(bf16, WS_WM1T) + (size_t)l * DFF * D, scr, r, F.lane); continue; } r -= I_M1;
            p0_transpose_item<false>(INP(I_WM2) + (size_t)l * DFF * D, DFF, D, WSP(bf16, WS_WM2T) + (size_t)l * D * DFF, scr, r, F.lane);
        }
        const int gt = F.bid * NT + F.tid, NGT = F.G * NT;
        for (int i = gt; i < NLAYER * 224 * 256; i += NGT) { const int l = i / (224 * 256), r = i % (224 * 256);
            *(GAS v4u*)(WSP(bf16, WS_W1T) + ((size_t)l * NPAD + DIN) * D + (size_t)r * 8) = (v4u){0u, 0u, 0u, 0u}; }
        for (int i = gt; i < NLAYER * 2 * 32 * 64; i += NGT) {
            const int p = i & 63, g = (i >> 6) & 31, d = (i >> 11) & 1, l = i >> 12;
            const int ldg = (l * 2 + d) * 32 + g;
            const double lre = INP(I_S5LR)[ldg * 64 + p], lim = INP(I_S5LI)[ldg * 64 + p], dt = exp((double)INP(I_S5DT)[ldg]);
            const double er = exp(lre * dt), br = er * cos(lim * dt), bi = er * sin(lim * dt);
            const double e128 = exp(128.0 * lre * dt), b128r = e128 * cos(128.0 * lim * dt), b128i = e128 * sin(128.0 * lim * dt);
            const double nr = br - 1.0, ni = bi, den = lre * lre + lim * lim;
            const double cr = (nr * lre + ni * lim) / den, ci = (ni * lre - nr * lim) / den;
            unsigned char* tb = s5tab(F, l, d, g);
            float* lam = (float*)tb; lam[2 * p] = (float)br; lam[2 * p + 1] = (float)bi;
            float* l128 = (float*)(tb + 512); l128[2 * p] = (float)b128r; l128[2 * p + 1] = (float)b128i;
            bf16* bb = (bf16*)(tb + 1024); bf16* ct = (bf16*)(tb + 5120);
            for (int c = 0; c < 16; ++c) {
                const double Br = INP(I_S5BR)[(size_t)(ldg * 64 + p) * 16 + c], Bi = INP(I_S5BI)[(size_t)(ldg * 64 + p) * 16 + c];
                bb[(2 * p) * 16 + c] = (bf16)f2bf((float)(cr * Br - ci * Bi));
                bb[(2 * p + 1) * 16 + c] = (bf16)f2bf((float)(cr * Bi + ci * Br));
                ct[c * 128 + 2 * p] = (bf16)f2bf(INP(I_S5CR)[(size_t)(ldg * 16 + c) * 64 + p]);
                ct[c * 128 + 2 * p + 1] = (bf16)f2bf(-INP(I_S5CI)[(size_t)(ldg * 16 + c) * 64 + p]);
            }
        }
        for (int i = gt; i < 64 * 32; i += NGT) { const int pos = i >> 5, k = i & 31; const double f = pow(10000.0, -(double)k / 32.0), a = pos * f;
            WSP(f32x2, WS_ROPE)[i] = (f32x2){(float)cos(a), (float)sin(a)}; }
    }
    __syncthreads();
    {
        LAS float* sc = (LAS float*)F.lds;
        LAS float* red = (LAS float*)(F.lds + 65536);
        for (int i = F.tid; i < 5 * D; i += NT) { const int r = i / D, k = i % D; const float v = r == 0 ? INP(I_CCTX)[k] : INP(I_C)[(r - 1) * D + k]; sc[i] = siluf_(v); }
        __syncthreads();
        for (int it = F.bid; it < NLAYER * 96; it += F.G) {
            const int l = it / 96, c0 = (it % 96) * 128;
            const float* W = INP(I_WADA) + (size_t)l * D * (6 * D);
            float acc[5][4];
#pragma unroll
            for (int r = 0; r < 5; ++r)
#pragma unroll
                for (int j = 0; j < 4; ++j) acc[r][j] = 0.f;
            const int cl = F.lane & 31, kp = F.lane >> 5;
#pragma unroll 4
            for (int kk = 0; kk < 128; ++kk) {
                const int k = F.wave * 256 + 2 * kk + kp;
                const f32x4 w = *(const f32x4*)(W + (size_t)k * (6 * D) + c0 + 4 * cl);
#pragma unroll
                for (int r = 0; r < 5; ++r) { const float s = sc[r * D + k]; acc[r][0] += s * w.x; acc[r][1] += s * w.y; acc[r][2] += s * w.z; acc[r][3] += s * w.w; }
            }
#pragma unroll
            for (int r = 0; r < 5; ++r)
#pragma unroll
                for (int j = 0; j < 4; ++j) { acc[r][j] += __shfl_xor(acc[r][j], 32); }
            if (kp == 0) {
#pragma unroll
                for (int r = 0; r < 5; ++r)
#pragma unroll
                    for (int j = 0; j < 4; ++j) red[(F.wave * 5 + r) * 128 + 4 * cl + j] = acc[r][j];
            }
            __syncthreads();
            for (int i = F.tid; i < 5 * 128; i += NT) { const int r = i >> 7, j = i & 127; float s = 0.f;
#pragma unroll
                for (int w = 0; w < 8; ++w) s += red[(w * 5 + r) * 128 + j];
                WSP(float, WS_MOD)[(size_t)(l * 5 + r) * (6 * D) + c0 + j] = s + INP(I_BADA)[(size_t)l * (6 * D) + c0 + j]; }
            __syncthreads();
        }
    }
}

__device__ __forceinline__ void norm0_phase(Frame& F, KArgs& A) {
    const int gw = F.bid * NWAVES + F.wave, NGW = F.G * NWAVES;
    const float* gain = INP(I_NORM1);
    for (int m = gw; m < M; m += NGW) {
        const float* xr = x_in_row(F, A, 0, m);
        const float* scp = mod_ptr(F, 0, mod_row(m), 1);
        f32x4 v[8]; float s = 0.f;
#pragma unroll
        for (int j = 0; j < 8; ++j) { v[j] = *(const f32x4*)(xr + 4 * F.lane + 256 * j); s += (v[j].x * v[j].x + v[j].y * v[j].y) + (v[j].z * v[j].z + v[j].w * v[j].w); }
        s = wave_sum(s);
        if (F.lane < 8) WSP(float, WS_SSQB)[(size_t)m * 8 + F.lane] = F.lane == 0 ? s : 0.f;
        bf16* orow = WSP(bf16, WS_H) + (size_t)m * D;
#pragma unroll
        for (int j = 0; j < 8; ++j) { const int c = 4 * F.lane + 256 * j;
            const f32x4 g4 = *(const f32x4*)(gain + c), s4 = *(const f32x4*)(scp + c);
            *(u32x2*)(orow + c) = (u32x2){pk2(v[j].x * g4.x * (1.f + s4.x), v[j].y * g4.y * (1.f + s4.y)), pk2(v[j].z * g4.z * (1.f + s4.z), v[j].w * g4.w * (1.f + s4.w))}; }
    }
}
__device__ __forceinline__ void shw_phase(Frame& F) {
    LAS float* red = (LAS float*)F.lds;
    const int hh = F.lane >> 5, r = F.lane & 31, k0 = F.wave * 256;
    constexpr int NB1 = DIN / 32, NB2 = DFF / 32, PER_L = NB1 + NB2;
    for (int task = F.bid; task < NLAYER * PER_L; task += F.G) {
        const int l = task / PER_L, t2 = task % PER_L, which = t2 >= NB1 ? 1 : 0, nb = which ? t2 - NB1 : t2;
        const int NS = which ? DFF : NPAD;
        const bf16* Wt = (which ? WSP(const bf16, WS_WM1T) + (size_t)l * DFF * D : WSP(const bf16, WS_W1T) + (size_t)l * NPAD * D) + (size_t)(32 * nb + r) * D + k0 + 8 * hh;
        const float* sh = WSP(const float, WS_MOD) + ((size_t)(l * 5 + (r < 5 ? r : 0)) * 6 + (which ? 3 : 0)) * D + k0 + 8 * hh;
        bf16x8 bw[16];
#pragma unroll
        for (int ks = 0; ks < 16; ++ks) bw[ks] = *(const bf16x8*)(Wt + 16 * ks);
        f32x16 acc = ZERO16;
#pragma unroll
        for (int ks = 0; ks < 16; ++ks) { v4u a = (v4u){0u, 0u, 0u, 0u};
            if (r < 5) { const f32x4 s0 = *(const f32x4*)(sh + 16 * ks), s1 = *(const f32x4*)(sh + 16 * ks + 4); a = (v4u){pk2(s0.x, s0.y), pk2(s0.z, s0.w), pk2(s1.x, s1.y), pk2(s1.z, s1.w)}; }
            acc = MFMA32(__builtin_bit_cast(bf16x8, a), bw[ks], acc); }
        if (hh == 0) { red[(F.wave * 5 + 0) * 32 + r] = acc[0]; red[(F.wave * 5 + 1) * 32 + r] = acc[1]; red[(F.wave * 5 + 2) * 32 + r] = acc[2]; red[(F.wave * 5 + 3) * 32 + r] = acc[3]; }
        else red[(F.wave * 5 + 4) * 32 + r] = acc[0];
        __syncthreads();
        if (F.tid < 160) { const int row = F.tid >> 5, col = F.tid & 31; float s = 0.f;
#pragma unroll
            for (int w = 0; w < 8; ++w) s += red[(w * 5 + row) * 32 + col];
            (which ? WSP(float, WS_SHW2) + (size_t)l * 5 * DFF : WSP(float, WS_SHW1) + (size_t)l * 5 * NPAD)[(size_t)row * NS + 32 * nb + col] = s; }
        __syncthreads();
    }
}
__device__ __forceinline__ void final_norm_phase(Frame& F, KArgs& A) {
    const int gw = F.bid * NWAVES + F.wave, NGW = F.G * NWAVES;
    const float* gain = INP(I_FNORM);
    for (int m = gw; m < M; m += NGW) {
        const bf16* xr = WSP(const bf16, WS_XB) + (size_t)m * D; float* orow = F.out + (size_t)m * D;
        float v[4][8]; float s = 0.f;
#pragma unroll
        for (int j = 0; j < 4; ++j) { unpack8(*(const v4u*)(xr + 8 * F.lane + 512 * j), v[j]);
#pragma unroll
            for (int k = 0; k < 8; ++k) s += v[j][k] * v[j][k]; }
        const float rstd = rsqrtf(wave_sum(s) * (1.f / D) + EPS);
#pragma unroll
        for (int j = 0; j < 4; ++j) { const int c = 8 * F.lane + 512 * j; const f32x4 g0 = *(const f32x4*)(gain + c), g1 = *(const f32x4*)(gain + c + 4);
            *(f32x4*)(orow + c) = (f32x4){v[j][0] * rstd * g0.x, v[j][1] * rstd * g0.y, v[j][2] * rstd * g0.z, v[j][3] * rstd * g0.w};
            *(f32x4*)(orow + c + 4) = (f32x4){v[j][4] * rstd * g1.x, v[j][5] * rstd * g1.y, v[j][6] * rstd * g1.z, v[j][7] * rstd * g1.w}; }
    }
}

__device__ __forceinline__ void gates_phase(Frame& F, int l) {
    const bf16* XA = WSP(const bf16, WS_H); const bf16* Wg = WSP(const bf16, WS_W1T) + ((size_t)l * NPAD + NPROJ) * D;
    const float* shw = WSP(const float, WS_SHW1) + (size_t)l * 5 * NPAD + NPROJ;
    const int hh = F.lane >> 5, r = F.lane & 31, k0 = F.wave * 256;
    LAS float* red = (LAS float*)F.lds;
    bf16x8 bw[16];
#pragma unroll
    for (int ks = 0; ks < 16; ++ks) bw[ks] = *(const bf16x8*)(Wg + (size_t)r * D + k0 + 16 * ks + 8 * hh);
    for (int rb = F.bid; rb < M / 32; rb += F.G) {
        f32x16 acc = ZERO16;
#pragma unroll
        for (int half = 0; half < 2; ++half) { bf16x8 a[8];
#pragma unroll
            for (int j = 0; j < 8; ++j) a[j] = *(const bf16x8*)(XA + (size_t)(32 * rb + r) * D + k0 + 16 * (8 * half + j) + 8 * hh);
#pragma unroll
            for (int j = 0; j < 8; ++j) acc = MFMA32(a[j], bw[8 * half + j], acc); }
#pragma unroll
        for (int i = 0; i < 16; ++i) red[(F.wave * 32 + crow(i, hh)) * 33 + r] = acc[i];
        BAR();
#pragma unroll
        for (int q = 0; q < 2; ++q) { const int idx = F.tid * 2 + q, row = idx >> 5, col = idx & 31; float s = 0.f;
#pragma unroll
            for (int w = 0; w < 8; ++w) s += red[(w * 32 + row) * 33 + col];
            const int grow = 32 * rb + row; const float* part = WSP(const float, WS_SSQB) + (size_t)grow * 8;
            const float ssq = ((part[0] + part[1]) + (part[2] + part[3])) + ((part[4] + part[5]) + (part[6] + part[7]));
            WSP(float, WS_GATES)[(size_t)grow * 32 + col] = s * rsqrtf(ssq * (1.f / D) + EPS) + shw[(size_t)mod_row(grow) * NPAD + col]; }
        BAR();
    }
}
namespace epi {
__device__ __forceinline__ float rstd_of(const float* part, int r) { const pg8::f32x4 a = *(const pg8::f32x4*)(part + (size_t)r * 8), b = *(const pg8::f32x4*)(part + (size_t)r * 8 + 4);
    return rsqrtf((((a[0] + a[1]) + (a[2] + a[3])) + ((b[0] + b[1]) + (b[2] + b[3]))) * (1.f / D) + EPS); }
using pg8::Unit; using pg8::f32x4; using pg8::u32x4; using pg8::bf16_t; using pg8::cvt_pk_bf16;
constexpr int BMq = 256, HALFq = 128;
struct EpiProj {
    static constexpr bool PERM = true, AFTER_DRAIN = false;
    bf16_t* P; const float* ssq; const float* shw0;
    __device__ __forceinline__ void operator()(const f32x4 (&acc)[2][2][4][2], const Unit& u, int wr, int wc, int fr_, int fq_) const {
        int ln_ = (int)__builtin_amdgcn_mbcnt_hi(~0u, __builtin_amdgcn_mbcnt_lo(~0u, 0u)); asm volatile("" : "+v"(ln_)); const int fr = ln_ & 15, fq = ln_ >> 4; (void)fr_; (void)fq_;
        const int row0 = u.pm * BMq + wr * 64 + fr, rowt = u.pm * BMq, col0 = u.pn * BMq + wc * 32 + 8 * fq;
        const float* shw = shw0 + (size_t)(rowt < MC ? 0 : 1 + (rowt - MC) / 4096) * NPAD + col0;
        f32x4 sh[2][2];
#pragma unroll
        for (int bj = 0; bj < 2; ++bj) { sh[bj][0] = *(const f32x4*)(shw + bj * HALFq); sh[bj][1] = *(const f32x4*)(shw + bj * HALFq + 4); }
#pragma unroll
        for (int ai = 0; ai < 2; ++ai)
#pragma unroll
            for (int m = 0; m < 4; ++m) { const int r = row0 + ai * HALFq + m * 16; bf16_t* rowp = P + (((size_t)(r >> 7) * 48 + (col0 >> 7)) * 128 + (r & 127)) * 128 + (col0 & 127); const float rs = rstd_of(ssq, r);
#pragma unroll
                for (int bj = 0; bj < 2; ++bj) { const f32x4 v0 = acc[ai][bj][m][0] * rs + sh[bj][0], v1 = acc[ai][bj][m][1] * rs + sh[bj][1];
                    u32x4 w; w.x = cvt_pk_bf16(v0[0], v0[1]); w.y = cvt_pk_bf16(v0[2], v0[3]); w.z = cvt_pk_bf16(v1[0], v1[1]); w.w = cvt_pk_bf16(v1[2], v1[3]);
                    *(u32x4*)(rowp + bj * 16384) = w; } }
    }
};
struct EpiGlu {
    static constexpr bool PERM = true, AFTER_DRAIN = false;
    const bf16_t* YA; bf16_t* Y;
    __device__ __forceinline__ void operator()(const f32x4 (&acc)[2][2][4][2], const Unit& u, int wr, int wc, int fr_, int fq_) const {
        int ln_ = (int)__builtin_amdgcn_mbcnt_hi(~0u, __builtin_amdgcn_mbcnt_lo(~0u, 0u)); asm volatile("" : "+v"(ln_)); const int fr = ln_ & 15, fq = ln_ >> 4; (void)fr_; (void)fq_;
        const int row0 = u.pm * BMq + wr * 64 + fr, col0 = u.pn * BMq + wc * 32 + 8 * fq;
#pragma unroll
        for (int ai = 0; ai < 2; ++ai)
#pragma unroll
            for (int m = 0; m < 4; ++m) { const int r = row0 + ai * HALFq + m * 16;
#pragma unroll
                for (int bj = 0; bj < 2; ++bj) { const f32x4 v0 = acc[ai][bj][m][0], v1 = acc[ai][bj][m][1];
                    const u32x4 a = *(const u32x4*)(YA + (size_t)r * GWID + col0 + bj * HALFq);
                    float y[8] = {bflo(a.x), bfhi(a.x), bflo(a.y), bfhi(a.y), bflo(a.z), bfhi(a.z), bflo(a.w), bfhi(a.w)};
                    const float g[8] = {v0[0], v0[1], v0[2], v0[3], v1[0], v1[1], v1[2], v1[3]};
#pragma unroll
                    for (int k = 0; k < 8; ++k) y[k] = y[k] * sigmoidf_(g[k]);
                    u32x4 w; w.x = cvt_pk_bf16(y[0], y[1]); w.y = cvt_pk_bf16(y[2], y[3]); w.z = cvt_pk_bf16(y[4], y[5]); w.w = cvt_pk_bf16(y[6], y[7]);
                    *(u32x4*)(Y + (size_t)r * D + col0 + bj * HALFq) = w; } }
    }
};
struct EpiRes {
    static constexpr bool PERM = true, AFTER_DRAIN = false;
    const float* xp; const float* xs; bf16_t* XB; const float* gate0; int first;
    int NEXT; bf16_t* XA; float* ssq; const float* gn; const float* scn0; PG8_LAS unsigned char* scr;
    __device__ __forceinline__ void operator()(const f32x4 (&acc)[2][2][4][2], const Unit& u, int wr, int wc, int fr_, int fq_) const {
        int ln_ = (int)__builtin_amdgcn_mbcnt_hi(~0u, __builtin_amdgcn_mbcnt_lo(~0u, 0u)); asm volatile("" : "+v"(ln_)); const int fr = ln_ & 15, fq = ln_ >> 4; (void)fr_; (void)fq_;
        const int rowt = u.pm * BMq, col0 = u.pn * BMq + wc * 32 + 8 * fq;
        const int mrow = rowt < MC ? 0 : 1 + (rowt - MC) / 4096;
        const float* gate = gate0 + (size_t)mrow * (6 * D);
        const float* basef = rowt < MC ? xp + (size_t)rowt * D : xs + (size_t)(rowt - MC) * D;
        bf16_t* xb = XB + (size_t)rowt * D;
        float ss[2][4];
#pragma unroll
        for (int ai = 0; ai < 2; ++ai)
#pragma unroll
            for (int m = 0; m < 4; ++m) ss[ai][m] = 0.f;
#pragma unroll
        for (int bj = 0; bj < 2; ++bj) { const int c = col0 + bj * HALFq; const f32x4 g0 = *(const f32x4*)(gate + c), g1 = *(const f32x4*)(gate + c + 4);
            f32x4 a0 = (f32x4){0.f, 0.f, 0.f, 0.f}, a1 = a0;
            if (NEXT) { const float* scn = scn0 + (size_t)mrow * (6 * D); a0 = *(const f32x4*)(gn + c) * (*(const f32x4*)(scn + c) + 1.f); a1 = *(const f32x4*)(gn + c + 4) * (*(const f32x4*)(scn + c + 4) + 1.f); }
#pragma unroll
            for (int ai = 0; ai < 2; ++ai)
#pragma unroll
                for (int m = 0; m < 4; ++m) { const size_t off = (size_t)(wr * 64 + fr + ai * HALFq + m * 16) * D + c;
                    f32x4 b0, b1;
                    if (first) { b0 = *(const f32x4*)(basef + off); b1 = *(const f32x4*)(basef + off + 4); }
                    else { const u32x4 w = *(const u32x4*)(xb + off); b0 = (f32x4){bflo(w.x), bfhi(w.x), bflo(w.y), bfhi(w.y)}; b1 = (f32x4){bflo(w.z), bfhi(w.z), bflo(w.w), bfhi(w.w)}; }
                    const f32x4 x0 = b0 + g0 * acc[ai][bj][m][0], x1 = b1 + g1 * acc[ai][bj][m][1];
                    u32x4 xw; xw.x = cvt_pk_bf16(x0[0], x0[1]); xw.y = cvt_pk_bf16(x0[2], x0[3]); xw.z = cvt_pk_bf16(x1[0], x1[1]); xw.w = cvt_pk_bf16(x1[2], x1[3]);
                    *(u32x4*)(xb + off) = xw;
                    if (NEXT) { const f32x4 r0 = (f32x4){bflo(xw.x), bfhi(xw.x), bflo(xw.y), bfhi(xw.y)}, r1 = (f32x4){bflo(xw.z), bfhi(xw.z), bflo(xw.w), bfhi(xw.w)};
                        ss[ai][m] += (r0[0] * r0[0] + r0[1] * r0[1]) + (r0[2] * r0[2] + r0[3] * r0[3]) + (r1[0] * r1[0] + r1[1] * r1[1]) + (r1[2] * r1[2] + r1[3] * r1[3]);
                        const f32x4 y0 = r0 * a0, y1 = r1 * a1; u32x4 w; w.x = cvt_pk_bf16(y0[0], y0[1]); w.y = cvt_pk_bf16(y0[2], y0[3]); w.z = cvt_pk_bf16(y1[0], y1[1]); w.w = cvt_pk_bf16(y1[2], y1[3]);
                        *(u32x4*)(XA + (size_t)rowt * D + off) = w; }
                    if (m & 1) asm volatile("" ::: "memory"); } }
        if (NEXT) {
            PG8_LAS float* P4 = (PG8_LAS float*)scr;
#pragma unroll
            for (int ai = 0; ai < 2; ++ai)
#pragma unroll
                for (int m = 0; m < 4; ++m) { float s = ss[ai][m]; s += __shfl_xor(s, 16); s += __shfl_xor(s, 32);
                    if (fq == 0) P4[(ai * HALFq + wr * 64 + m * 16 + fr) * 4 + wc] = s; }
            asm volatile("s_waitcnt lgkmcnt(0)\n\ts_barrier" ::: "memory");
            { const int tid = (wr * 4 + wc) * 64 + fq * 16 + fr;
              if (tid < 256) { const f32x4 p = *(const PG8_LAS f32x4*)(P4 + tid * 4); ssq[(size_t)(rowt + tid) * 8 + u.pn] = (p[0] + p[1]) + (p[2] + p[3]); } }
            asm volatile("s_waitcnt lgkmcnt(0)\n\ts_barrier" ::: "memory");
        }
    }
};
struct EpiRelu2 {
    static constexpr bool PERM = true, AFTER_DRAIN = false;
    bf16_t* O; const float* ssq; const float* shw0;
    __device__ __forceinline__ void operator()(const f32x4 (&acc)[2][2][4][2], const Unit& u, int wr, int wc, int fr_, int fq_) const {
        int ln_ = (int)__builtin_amdgcn_mbcnt_hi(~0u, __builtin_amdgcn_mbcnt_lo(~0u, 0u)); asm volatile("" : "+v"(ln_)); const int fr = ln_ & 15, fq = ln_ >> 4; (void)fr_; (void)fq_;
        const int row0 = u.pm * BMq + wr * 64 + fr, col0 = u.pn * BMq + wc * 32 + 8 * fq, rowt = u.pm * BMq;
        const float* shw = shw0 + (size_t)(rowt < MC ? 0 : 1 + (rowt - MC) / 4096) * DFF + col0;
        f32x4 sh[2][2];
#pragma unroll
        for (int bj = 0; bj < 2; ++bj) { sh[bj][0] = *(const f32x4*)(shw + bj * HALFq); sh[bj][1] = *(const f32x4*)(shw + bj * HALFq + 4); }
#pragma unroll
        for (int ai = 0; ai < 2; ++ai)
#pragma unroll
            for (int m = 0; m < 4; ++m) { const int r = row0 + ai * HALFq + m * 16; bf16_t* rowp = O + (size_t)r * DFF + col0; const float rs = rstd_of(ssq, r);
#pragma unroll
                for (int bj = 0; bj < 2; ++bj) { f32x4 v0 = acc[ai][bj][m][0] * rs + sh[bj][0], v1 = acc[ai][bj][m][1] * rs + sh[bj][1];
#pragma unroll
                    for (int k = 0; k < 4; ++k) { const float a = fmaxf(v0[k], 0.f), b = fmaxf(v1[k], 0.f); v0[k] = a * a; v1[k] = b * b; }
                    u32x4 w; w.x = cvt_pk_bf16(v0[0], v0[1]); w.y = cvt_pk_bf16(v0[2], v0[3]); w.z = cvt_pk_bf16(v1[0], v1[1]); w.w = cvt_pk_bf16(v1[2], v1[3]);
                    *(u32x4*)(rowp + bj * HALFq) = w; } }
    }
};
}
__device__ __forceinline__ float logsigmoidf_(float x) { return fminf(x, 0.f) - __logf(1.f + __expf(-fabsf(x))); }
__device__ __forceinline__ float softplusf_(float x) { return fmaxf(x, 0.f) + __logf(1.f + __expf(-fabsf(x))); }
__device__ __forceinline__ void load_tile128(Frame& F, LAS unsigned char* dst, const bf16* src) {
#pragma unroll
    for (int it = 0; it < 4; ++it) { const int i = F.tid + NT * it, r = i >> 4, c = i & 15;
        *(LAS v4u*)(dst + r * LDT + c * 16) = *(const v4u*)(src + (size_t)r * 128 + c * 8); }
}
__device__ __forceinline__ void qk_issue(Frame& F, const bf16* src, v4u (&r)[4]) {
#pragma unroll
    for (int it = 0; it < 2; ++it) { const int i = F.tid + NT * it, rw = i >> 3, c = i & 7;
        r[2 * it] = *(const v4u*)(src + (size_t)rw * 128 + c * 8); r[2 * it + 1] = *(const v4u*)(src + (size_t)rw * 128 + 64 + c * 8); }
}
template <int NDST> __device__ __forceinline__ void qk_commit(Frame& F, LAS unsigned char* dst0, LAS unsigned char* dst1, const v4u (&rg)[4], const LAS float* w0, const LAS float* w1, float scale, bool rope, int tpos0) {
#pragma unroll
    for (int it = 0; it < 2; ++it) {
        const int i = F.tid + NT * it, r = i >> 3, c = i & 7;
        float x1[8], x2[8];
        unpack8(rg[2 * it], x1); unpack8(rg[2 * it + 1], x2);
        if (rope) {
            const int tp = tpos0 + r, pos = c < 4 ? (tp >> 6) : (tp & 63);
            const f32x2* rt = WSP(const f32x2, WS_ROPE) + pos * 32 + ((8 * c) & 31);
#pragma unroll
            for (int j = 0; j < 8; ++j) { const f32x2 cs = rt[j]; const float a = x1[j], b = x2[j]; x1[j] = a * cs.x - b * cs.y; x2[j] = a * cs.y + b * cs.x; }
        }
        const float s0 = scale * (w0 ? w0[r] : 1.f);
        *(LAS v4u*)(dst0 + r * LDT + c * 16) = pack8(x1, s0); *(LAS v4u*)(dst0 + r * LDT + 128 + c * 16) = pack8(x2, s0);
        if (NDST == 2) { const float s1 = scale * w1[r];
            *(LAS v4u*)(dst1 + r * LDT + c * 16) = pack8(x1, s1); *(LAS v4u*)(dst1 + r * LDT + 128 + c * 16) = pack8(x2, s1); }
    }
}
template <int NDST> __device__ __forceinline__ void load_qk(Frame& F, LAS unsigned char* dst0, LAS unsigned char* dst1, const bf16* src, const LAS float* w0, const LAS float* w1, float scale, bool rope, int tpos0) {
    v4u r[4]; qk_issue(F, src, r); qk_commit<NDST>(F, dst0, dst1, r, w0, w1, scale, rope, tpos0);
}
template <int NDST, int nc8> __device__ __forceinline__ void load_conv(Frame& F, KArgs& A, int l, LAS unsigned char* dst0, LAS unsigned char* dst1, int ldd, int ch0, int row0, int seq_lo, int seq_hi,
                                                               const LAS float* w0, const LAS float* w1, bool to_global) {
    const int c = F.tid % nc8;
    const float* cw = INP(I_CONVW) + (size_t)l * 5 * 1024 + ch0 + 8 * c; const float* cb = INP(I_CONVB) + (size_t)l * 1024 + ch0 + 8 * c;
    f32x4 wv[5][2];
#pragma unroll
    for (int k = 0; k < 5; ++k) { wv[k][0] = *(const f32x4*)(cw + k * 1024); wv[k][1] = *(const f32x4*)(cw + k * 1024 + 4); }
    const f32x4 b0 = *(const f32x4*)cb, b1 = *(const f32x4*)(cb + 4);
#pragma unroll 1
    for (int i = F.tid; i < 128 * nc8; i += NT) {
        const int r = i / nc8, row = row0 + r;
        float acc[8] = {b0.x, b0.y, b0.z, b0.w, b1.x, b1.y, b1.z, b1.w};
        v4u xr[5];
#pragma unroll
        for (int k = 0; k < 5; ++k) { const int rr = row + k - 2; xr[k] = (v4u){0u, 0u, 0u, 0u};
            if (rr >= seq_lo && rr < seq_hi) xr[k] = *(const v4u*)(PT(rr >> 7, PC_DX + ch0 + 8 * c) + (size_t)(rr & 127) * 128); }
#pragma unroll
        for (int k = 0; k < 5; ++k) { float x[8]; unpack8(xr[k], x);
            acc[0] += x[0] * wv[k][0].x; acc[1] += x[1] * wv[k][0].y; acc[2] += x[2] * wv[k][0].z; acc[3] += x[3] * wv[k][0].w; acc[4] += x[4] * wv[k][1].x; acc[5] += x[5] * wv[k][1].y; acc[6] += x[6] * wv[k][1].z; acc[7] += x[7] * wv[k][1].w; }
#pragma unroll
        for (int j = 0; j < 8; ++j) acc[j] = siluf_(acc[j]);
        if (to_global) *(v4u*)(XT(row >> 7, ch0 + 8 * c) + (size_t)(row & 127) * 128) = pack8(acc, 1.f);
        if (NDST >= 1) *(LAS v4u*)(dst0 + r * ldd + c * 16) = pack8(acc, w0 ? w0[r] : 1.f);
        if (NDST == 2) *(LAS v4u*)(dst1 + r * ldd + c * 16) = pack8(acc, w1[r]);
    }
}
template <int nc8> __device__ __forceinline__ void load_xbcc(Frame& F, LAS unsigned char* dst, int ldd, int ch0, int row0) {
    const bf16* P = XT(row0 >> 7, ch0);
    for (int i = F.tid; i < 128 * nc8; i += NT) { const int r = i / nc8, c = i % nc8; *(LAS v4u*)(dst + r * ldd + c * 16) = *(const v4u*)(P + (size_t)r * 128 + 8 * c); }
}
__device__ __forceinline__ void kv_state_mfma(Frame& F, const LAS unsigned char* TKf, const LAS unsigned char* TKb, const LAS unsigned char* TV, bf16* outF, bf16* outB) {
    const int dvb = F.wave >> 1, dkb0 = (F.wave & 1) * 2, hh = F.lane >> 5;
    f32x16 acc[2][2] = {{ZERO16, ZERO16}, {ZERO16, ZERO16}};
#pragma unroll 1
    for (int ks = 0; ks < 8; ++ks) {
        const bf16x8 a = frag_tr(TV, LDT, 16 * ks, 32 * dvb, F.lane);
#pragma unroll
        for (int j = 0; j < 2; ++j) { acc[0][j] = MFMA32(a, frag_tr(TKf, LDT, 16 * ks, 32 * (dkb0 + j), F.lane), acc[0][j]); acc[1][j] = MFMA32(a, frag_tr(TKb, LDT, 16 * ks, 32 * (dkb0 + j), F.lane), acc[1][j]); }
    }
#pragma unroll
    for (int j = 0; j < 2; ++j)
#pragma unroll
        for (int i = 0; i < 16; ++i) { const int o = (32 * dvb + crow(i, hh)) * 128 + 32 * (dkb0 + j) + (F.lane & 31); outF[o] = (bf16)f2bf(acc[0][j][i]); outB[o] = (bf16)f2bf(acc[1][j][i]); }
}
__device__ __forceinline__ void qkT_mfma(Frame& F, const LAS unsigned char* TQ, const LAS unsigned char* TK, f32x16 (&qk)[2]) {
    const int tb = F.wave >> 1, sb0 = (F.wave & 1) * 2;
    qk[0] = ZERO16; qk[1] = ZERO16;
#pragma unroll 1
    for (int ks = 0; ks < 8; ++ks) { const bf16x8 bq = frag_row(TQ, LDT, 32 * tb, 16 * ks, F.lane);
#pragma unroll
        for (int j = 0; j < 2; ++j) qk[j] = MFMA32(frag_row(TK, LDT, 32 * (sb0 + j), 16 * ks, F.lane), bq, qk[j]); }
}
__device__ __forceinline__ void pv_mfma(Frame& F, const LAS unsigned char* TP, const LAS unsigned char* TV, f32x16 (&o)[2]) {
    const int tb = F.wave >> 1, eb0 = (F.wave & 1) * 2;
#pragma unroll 1
    for (int ks = 0; ks < 8; ++ks) { const bf16x8 ap = frag_row(TP, LDT, 32 * tb, 16 * ks, F.lane);
#pragma unroll
        for (int j = 0; j < 2; ++j) o[j] = MFMA32(ap, frag_tr(TV, LDT, 16 * ks, 32 * (eb0 + j), F.lane), o[j]); }
}
__device__ __forceinline__ void pv_mfma_range(Frame& F, const LAS unsigned char* TP, const LAS unsigned char* TV, f32x16 (&o)[2], int k_lo, int k_hi) {
    const int tb = F.wave >> 1, eb0 = (F.wave & 1) * 2;
#pragma unroll 1
    for (int ks = k_lo; ks < k_hi; ++ks) { const bf16x8 ap = frag_row(TP, LDT, 32 * tb, 16 * ks, F.lane);
#pragma unroll
        for (int j = 0; j < 2; ++j) o[j] = MFMA32(ap, frag_tr(TV, LDT, 16 * ks, 32 * (eb0 + j), F.lane), o[j]); }
}
__device__ __forceinline__ void qs_prefetch(Frame& F, const bf16* ST, bf16x8 (&b)[2][8]) {
    const int eb0 = (F.wave & 1) * 2, hh = F.lane >> 5;
#pragma unroll
    for (int j = 0; j < 2; ++j)
#pragma unroll
        for (int ks = 0; ks < 8; ++ks) b[j][ks] = *(const bf16x8*)(ST + (size_t)(32 * (eb0 + j) + (F.lane & 31)) * 128 + 16 * ks + 8 * hh);
}
__device__ __forceinline__ void qs_mfma(Frame& F, const LAS unsigned char* TQ, const bf16x8 (&b)[2][8], f32x16 (&o)[2]) {
    const int tb = F.wave >> 1;
#pragma unroll
    for (int ks = 0; ks < 8; ++ks) { const bf16x8 aq = frag_row(TQ, LDT, 32 * tb, 16 * ks, F.lane);
#pragma unroll
        for (int j = 0; j < 2; ++j) o[j] = MFMA32(aq, b[j][ks], o[j]); }
}
__device__ __forceinline__ void hs_to_lds(Frame& F, LAS unsigned char* HS, const f32x16 (&hs)[2]) {
    const int tb = F.wave >> 1, eb0 = (F.wave & 1) * 2, hh = F.lane >> 5;
#pragma unroll
    for (int j = 0; j < 2; ++j)
#pragma unroll
        for (int i = 0; i < 16; ++i) *(LAS float*)(HS + (32 * tb + crow(i, hh)) * 528 + (32 * (eb0 + j) + (F.lane & 31)) * 4) = hs[j][i];
}
template <int GATE> __device__ __forceinline__ void head_out(Frame& F, const LAS unsigned char* HS, const float* gain, const bf16* gsrc  , bf16* ydst  ) {
    const int t = F.tid >> 2, seg = F.tid & 3;
    float v[32]; float ss = 0.f;
#pragma unroll
    for (int k = 0; k < 8; ++k) { const f32x4 x = *(const LAS f32x4*)(HS + t * 528 + (32 * seg + 4 * k) * 4); v[4 * k] = x.x; v[4 * k + 1] = x.y; v[4 * k + 2] = x.z; v[4 * k + 3] = x.w; ss += (x.x * x.x + x.y * x.y) + (x.z * x.z + x.w * x.w); }
    ss += __shfl_xor(ss, 1); ss += __shfl_xor(ss, 2);
    const float r = rsqrtf(ss * (1.f / 128.f) + EPS);
#pragma unroll
    for (int k = 0; k < 4; ++k) { float g[8]; unpack8(*(const v4u*)(gsrc + (size_t)t * 128 + 32 * seg + 8 * k), g); float o[8];
#pragma unroll
        for (int j = 0; j < 8; ++j) { const float gg = GATE == 0 ? sigmoidf_(g[j]) : siluf_(g[j]); o[j] = v[8 * k + j] * r * gain[32 * seg + 8 * k + j] * gg; }
        *(v4u*)(ydst + (size_t)t * D + 32 * seg + 8 * k) = pack8(o, 1.f); }
}

__device__ __forceinline__ void tile_issue(Frame& F, const bf16* src, v4u (&r)[4]) {
#pragma unroll
    for (int it = 0; it < 4; ++it) { const int i = F.tid + NT * it; r[it] = *(const v4u*)(src + (size_t)(i >> 4) * 128 + (i & 15) * 8); }
}
__device__ __forceinline__ void tile_commit(Frame& F, LAS unsigned char* dst, const v4u (&r)[4], float scale) {
#pragma unroll
    for (int it = 0; it < 4; ++it) { const int i = F.tid + NT * it; v4u v = r[it];
        if (scale != 1.f) { float x[8]; unpack8(v, x); v = pack8(x, scale); }
        *(LAS v4u*)(dst + (i >> 4) * LDT + (i & 15) * 16) = v; }
}
template <int GATE> __device__ __forceinline__ void head_out_r(Frame& F, const LAS unsigned char* HS, const float* gain, const v4u (&og)[4], bf16* ydst) {
    const int t = F.tid >> 2, seg = F.tid & 3;
    float v[32]; float ss = 0.f;
#pragma unroll
    for (int k = 0; k < 8; ++k) { const f32x4 x = *(const LAS f32x4*)(HS + t * 528 + (32 * seg + 4 * k) * 4); v[4 * k] = x.x; v[4 * k + 1] = x.y; v[4 * k + 2] = x.z; v[4 * k + 3] = x.w; ss += (x.x * x.x + x.y * x.y) + (x.z * x.z + x.w * x.w); }
    ss += __shfl_xor(ss, 1); ss += __shfl_xor(ss, 2);
    const float r = rsqrtf(ss * (1.f / 128.f) + EPS);
#pragma unroll
    for (int k = 0; k < 4; ++k) { float g[8]; unpack8(og[k], g); float o[8]; const f32x4 g0 = *(const f32x4*)(gain + 32 * seg + 8 * k), g1 = *(const f32x4*)(gain + 32 * seg + 8 * k + 4);
        const float gn[8] = {g0.x, g0.y, g0.z, g0.w, g1.x, g1.y, g1.z, g1.w};
#pragma unroll
        for (int j = 0; j < 8; ++j) { const float gg = GATE == 0 ? sigmoidf_(g[j]) : siluf_(g[j]); o[j] = v[8 * k + j] * r * gn[j] * gg; }
        *(v4u*)(ydst + (size_t)t * D + 32 * seg + 8 * k) = pack8(o, 1.f); }
}
__device__ __forceinline__ void mlstm_gates(Frame& F, KArgs& A, int l, int cp, int h) {
    if (F.tid < 128) { const float* g = WSP(const float, WS_GATES) + (size_t)(cp * 128 + F.tid) * 32;
        SCA(0)[F.tid] = g[h] + INP(I_MIB)[(l * 2 + 0) * 4 + h]; SCA(1)[F.tid] = g[4 + h] + INP(I_MIB)[(l * 2 + 1) * 4 + h];
        SCA(2)[F.tid] = logsigmoidf_(g[8 + h] + INP(I_MFB)[(l * 2 + 0) * 4 + h]); SCA(3)[F.tid] = logsigmoidf_(g[12 + h] + INP(I_MFB)[(l * 2 + 1) * 4 + h]); }
    BAR();
    if (F.wave == 0) wave_scan128<false>(SCA(2), SCA(4), F.lane, false, 0.f);
    if (F.wave == 1) wave_scan128<false>(SCA(3), SCA(5), F.lane, true, 0.f);
    BAR();
}
__device__ __forceinline__ void mlstm_local_item(Frame F, KArgs& A, int l, int cp, int h) {
    v4u rk[4], rv[4]; qk_issue(F, PT(cp, PC_MK + h * 128), rk); tile_issue(F, PT(cp, PC_MV + h * 128), rv);
    mlstm_gates(F, A, l, cp, h);
    if (F.wave < 2) { const int d = F.wave; const LAS float* bc = SCA(4 + d); const LAS float* ig = SCA(d); const float tot = d == 0 ? bc[127] : bc[0];
        const int s0 = 2 * F.lane; const float g0 = tot - bc[s0] + ig[s0], g1 = tot - bc[s0 + 1] + ig[s0 + 1];
        const float mx = wave_max(fmaxf(g0, g1));
        SCA(6 + d)[s0] = __expf(g0 - mx); SCA(6 + d)[s0 + 1] = __expf(g1 - mx);
        if (F.lane == 0) { float* sc = WSP(float, WS_MLSC) + ((cp * 2 + d) * 4 + h) * 2; sc[0] = tot; sc[1] = mx; } }
    BAR();
    qk_commit<2>(F, F.lds, F.lds + TS, rk, SCA(6), SCA(7), 0.08838834764831845f, false, 0);
    tile_commit(F, F.lds + 2 * TS, rv, 1.f);
    BAR();
    kv_state_mfma(F, F.lds, F.lds + TS, F.lds + 2 * TS, WSP(bf16, WS_MLCLOC) + (size_t)((cp * 2 + 0) * 4 + h) * 16384, WSP(bf16, WS_MLCLOC) + (size_t)((cp * 2 + 1) * 4 + h) * 16384);
    if (F.tid < 256) { const int d = F.tid >> 7, dk = F.tid & 127; const LAS unsigned char* T = F.lds + d * TS; float s = 0.f;
        for (int r = 0; r < 128; ++r) s += bf2f(*(const LAS unsigned short*)(T + r * LDT + dk * 2));
        WSP(float, WS_MLNLOC)[((cp * 2 + d) * 4 + h) * 128 + dk] = s; }
    BAR();
}
__device__ __forceinline__ void mlstm_out_item(Frame F, KArgs& A, int l, int cp, int h) {
    const Seq sq = seq_of(cp);
    LAS unsigned char* TQ = F.lds; LAS unsigned char* TK = F.lds + TS; LAS unsigned char* TV = F.lds + 2 * TS; LAS unsigned char* TP = F.lds + 3 * TS;
    ITS(0);
    v4u rq[4], rk[4], rv[4], og[4];
    tile_issue(F, PT(cp, PC_MQ + h * 128), rq); tile_issue(F, PT(cp, PC_MK + h * 128), rk); tile_issue(F, PT(cp, PC_MV + h * 128), rv);
    { const int t = F.tid >> 2, seg = F.tid & 3;
#pragma unroll
      for (int k = 0; k < 4; ++k) og[k] = *(const v4u*)(PT(cp, PC_MO + h * 128) + (size_t)t * 128 + 32 * seg + 8 * k); }
    const float min_f = WSP(const float, WS_MLMIN)[(cp * 2 + 0) * 4 + h], min_b = WSP(const float, WS_MLMIN)[(cp * 2 + 1) * 4 + h];
    float nin = 0.f; if (F.tid < 256) nin = WSP(const float, WS_MLNIN)[((cp * 2 + (F.tid >> 7)) * 4 + h) * 128 + (F.tid & 127)];
    mlstm_gates(F, A, l, cp, h);
    if (F.tid < 256) { const int d = F.tid >> 7, s = F.tid & 127; SCA(6 + d)[s] = SCA(d)[s] - SCA(4 + d)[s]; SCA(12 + d)[s] = nin; }
    tile_commit(F, TQ, rq, 1.f); tile_commit(F, TK, rk, 0.08838834764831845f); tile_commit(F, TV, rv, 1.f);
    BAR();
    if (F.wave == 0) wave_scan128<true>(SCA(6), SCA(8), F.lane, false, min_f);
    if (F.wave == 1) wave_scan128<true>(SCA(7), SCA(9), F.lane, true, min_b);
    BAR();
    ITE(0);
    f32x16 hs[2] = {ZERO16, ZERO16};
    const int tb = F.wave >> 1, sb0 = (F.wave & 1) * 2, hh = F.lane >> 5, t = 32 * tb + (F.lane & 31);
#pragma unroll 1
    for (int d = 0; d < 2; ++d) {
        const LAS float* av = SCA(6 + d); const float Mt = SCA(8 + d)[t]; const float m_in = d == 0 ? min_f : min_b;
        ITS(2);
        const bool has_state = sq.lat || (d == 0 ? sq.c > 0 : sq.c < sq.nch - 1);
        bf16x8 bst[2][8]; if (has_state) qs_prefetch(F, WSP(const bf16, WS_MLCIN) + (size_t)((cp * 2 + d) * 4 + h) * 16384, bst);
#ifndef PROBE_REP2
#define PROBE_REP2 1
#endif
#pragma unroll 1
        for (int rep2_ = 0; rep2_ < PROBE_REP2; ++rep2_) {
        f32x16 qk[2]; qkT_mfma(F, TQ, TK, qk);
#pragma unroll
        for (int j = 0; j < 2; ++j) { const int sblk = sb0 + j;
            if (d == 0 ? sblk > tb : sblk < tb) continue;
            const bool diag = sblk == tb;
#pragma unroll
            for (int i4 = 0; i4 < 4; ++i4) { const int sb = 32 * sblk + 8 * i4 + 4 * hh; float p[4]; const f32x4 a4 = *(const LAS f32x4*)(av + sb);
#pragma unroll
                for (int i = 0; i < 4; ++i) p[i] = qk[j][4 * i4 + i] * __expf(a4[i] - Mt);
                if (diag) {
#pragma unroll
                    for (int i = 0; i < 4; ++i) { const int s = sb + i; const bool ok = d == 0 ? (s <= t) : (s >= t); p[i] = ok ? p[i] : 0.f; } }
                *(LAS u32x2*)(TP + t * LDT + sb * 2) = (u32x2){pk2(p[0], p[1]), pk2(p[2], p[3])}; } }
        }
        ITE(2); ITS(3);
        BAR();
        {
            const int tt = F.tid >> 2, seg = F.tid & 3; float ds = 0.f, qn = 0.f;
            const bool pvalid = d == 0 ? seg <= (tt >> 5) : seg >= (tt >> 5);
#pragma unroll
            for (int k = 0; k < 4; ++k) { float x[8]; unpack8(pvalid ? *(const LAS v4u*)(TP + tt * LDT + 64 * seg + 16 * k) : (v4u){0u, 0u, 0u, 0u}, x); float q[8]; unpack8(*(const LAS v4u*)(TQ + tt * LDT + 64 * seg + 16 * k), q);
                const f32x4 n0 = *(const LAS f32x4*)(SCA(12 + d) + 32 * seg + 8 * k), n1 = *(const LAS f32x4*)(SCA(12 + d) + 32 * seg + 8 * k + 4);
                ds += ((x[0] + x[1]) + (x[2] + x[3])) + ((x[4] + x[5]) + (x[6] + x[7]));
                qn += (q[0] * n0.x + q[1] * n0.y) + (q[2] * n0.z + q[3] * n0.w) + (q[4] * n1.x + q[5] * n1.y) + (q[6] * n1.z + q[7] * n1.w); }
            ds += __shfl_xor(ds, 1); ds += __shfl_xor(ds, 2); qn += __shfl_xor(qn, 1); qn += __shfl_xor(qn, 2);
            if (seg == 0) { const float Mtt = SCA(8 + d)[tt], wint = __expf(m_in - Mtt), den = ds + wint * qn, dd = fmaxf(fabsf(den), __expf(-(SCA(4 + d)[tt] + Mtt)));
                const float rdd = __builtin_amdgcn_rcpf(dd); SCA(10)[tt] = wint * rdd; SCA(11)[tt] = rdd; } }
        { f32x16 num[2] = {ZERO16, ZERO16};
          pv_mfma_range(F, TP, TV, num, d == 0 ? 0 : 2 * tb, d == 0 ? 2 * tb + 2 : 8);
          BAR(); ITE(3); ITS(4);
#pragma unroll
          for (int j = 0; j < 2; ++j)
#pragma unroll
            for (int k4 = 0; k4 < 4; ++k4) { const f32x4 f4 = *(const LAS f32x4*)(SCA(11) + 32 * tb + 8 * k4 + 4 * hh);
#pragma unroll
                for (int i = 0; i < 4; ++i) hs[j][4 * k4 + i] += f4[i] * num[j][4 * k4 + i]; } }
        if (has_state) { f32x16 qc[2] = {ZERO16, ZERO16};
          qs_mfma(F, TQ, bst, qc);
#pragma unroll
          for (int j = 0; j < 2; ++j)
#pragma unroll
            for (int k4 = 0; k4 < 4; ++k4) { const f32x4 f4 = *(const LAS f32x4*)(SCA(10) + 32 * tb + 8 * k4 + 4 * hh);
#pragma unroll
                for (int i = 0; i < 4; ++i) hs[j][4 * k4 + i] += f4[i] * qc[j][4 * k4 + i]; } }
        ITE(4);
    }
    ITS(5);
    BAR();
    hs_to_lds(F, F.lds, hs);
    BAR();
    head_out_r<0>(F, F.lds, INP(I_MNORM) + (size_t)l * GWID + h * 128, og, WSP(bf16, WS_Y) + (size_t)cp * 128 * D + 512 + h * 128);
    BAR(); ITE(5);
}

__device__ __forceinline__ void ret_local_item(Frame F, KArgs& A, int l, int cp, int h) {
    const float lgf = -__expf(INP(I_RRATE)[(l * 2 + 0) * 4 + h]), lgb = -__expf(INP(I_RRATE)[(l * 2 + 1) * 4 + h]);
    v4u rk[4], rv[4]; qk_issue(F, PT(cp, PC_RK + h * 128), rk); tile_issue(F, PT(cp, PC_RV + h * 128), rv);
    if (F.tid < 128) { SCA(6)[F.tid] = __expf((127.f - (float)F.tid) * lgf); SCA(7)[F.tid] = __expf((float)F.tid * lgb); }
    BAR();
    const Seq sq = seq_of(cp);
    qk_commit<2>(F, F.lds, F.lds + TS, rk, SCA(6), SCA(7), 0.08838834764831845f, sq.lat != 0, sq.c * 128);
    tile_commit(F, F.lds + 2 * TS, rv, 1.f);
    BAR();
    kv_state_mfma(F, F.lds, F.lds + TS, F.lds + 2 * TS, WSP(bf16, WS_RTLOC) + (size_t)((cp * 2 + 0) * 4 + h) * 16384, WSP(bf16, WS_RTLOC) + (size_t)((cp * 2 + 1) * 4 + h) * 16384);
    BAR();
}
__device__ __forceinline__ void ret_out_item(Frame F, KArgs& A, int l, int cp, int h) {
    const float lgf = -__expf(INP(I_RRATE)[(l * 2 + 0) * 4 + h]), lgb = -__expf(INP(I_RRATE)[(l * 2 + 1) * 4 + h]);
    if (F.tid < 128) { SCA(10)[F.tid] = __expf(((float)F.tid + 1.f) * lgf); SCA(11)[F.tid] = __expf((128.f - (float)F.tid) * lgb); }
    const Seq sq = seq_of(cp);
    LAS unsigned char* TQ = F.lds; LAS unsigned char* TK = F.lds + TS; LAS unsigned char* TV = F.lds + 2 * TS; LAS unsigned char* TP = F.lds + 3 * TS;
    v4u rq[4], rk[4], rv[4], og[4];
    qk_issue(F, PT(cp, PC_RQ + h * 128), rq); qk_issue(F, PT(cp, PC_RK + h * 128), rk); tile_issue(F, PT(cp, PC_RV + h * 128), rv);
    { const int t_ = F.tid >> 2, seg_ = F.tid & 3;
#pragma unroll
      for (int k = 0; k < 4; ++k) og[k] = *(const v4u*)(PT(cp, PC_RG + h * 128) + (size_t)t_ * 128 + 32 * seg_ + 8 * k); }
    qk_commit<1>(F, TQ, nullptr, rq, nullptr, nullptr, 1.f, sq.lat != 0, sq.c * 128);
    qk_commit<1>(F, TK, nullptr, rk, nullptr, nullptr, 0.08838834764831845f, sq.lat != 0, sq.c * 128);
    tile_commit(F, TV, rv, 1.f);
    BAR();
    f32x16 qk[2]; qkT_mfma(F, TQ, TK, qk);
    const int tb = F.wave >> 1, sb0 = (F.wave & 1) * 2, hh = F.lane >> 5, t = 32 * tb + (F.lane & 31);
#pragma unroll
    for (int j = 0; j < 2; ++j)
#pragma unroll
        for (int i4 = 0; i4 < 4; ++i4) { const int sb = 32 * (sb0 + j) + 8 * i4 + 4 * hh; float p[4];
#pragma unroll
            for (int i = 0; i < 4; ++i) { const int s = sb + i; const float df = (float)(t - s);
                float dm;
                if (sb0 + j == tb) dm = (s <= t ? __expf(df * lgf) : 0.f) + (s >= t ? __expf(-df * lgb) : 0.f);
                else dm = __expf(sb0 + j < tb ? df * lgf : -df * lgb);
                p[i] = qk[j][4 * i4 + i] * dm; }
            *(LAS u32x2*)(TP + t * LDT + sb * 2) = (u32x2){pk2(p[0], p[1]), pk2(p[2], p[3])}; }
    BAR();
    f32x16 y[2] = {ZERO16, ZERO16};
    pv_mfma(F, TP, TV, y);
#pragma unroll 1
    for (int d = 0; d < 2; ++d) { f32x16 qs[2] = {ZERO16, ZERO16};
        if (!sq.lat && (d == 0 ? sq.c == 0 : sq.c == sq.nch - 1)) continue;
        bf16x8 bst[2][8]; qs_prefetch(F, WSP(const bf16, WS_RTIN) + (size_t)((cp * 2 + d) * 4 + h) * 16384, bst);
        qs_mfma(F, TQ, bst, qs);
#pragma unroll
        for (int j = 0; j < 2; ++j)
#pragma unroll
            for (int k4 = 0; k4 < 4; ++k4) { const f32x4 f4 = *(const LAS f32x4*)(SCA(10 + d) + 32 * tb + 8 * k4 + 4 * hh);
#pragma unroll
                for (int i = 0; i < 4; ++i) y[j][4 * k4 + i] += f4[i] * qs[j][4 * k4 + i]; } }
    BAR();
    hs_to_lds(F, F.lds, y);
    BAR();
    head_out_r<1>(F, F.lds, INP(I_RNORM) + (size_t)l * GWID + h * 128, og, WSP(bf16, WS_Y) + (size_t)cp * 128 * D + 1024 + h * 128);
    BAR();
}
template <bool WMODE> __device__ __forceinline__ float ssd_scalars(Frame& F, KArgs& A, int l, int cp, int g) {
    const int d = F.wave >> 2, rr = F.wave & 3, head = g * 4 + rr;
    const float bias = INP(I_DTB)[(l * 2 + d) * 8 + head], arate = -__expf(INP(I_ALOG)[(l * 2 + d) * 8 + head]);
    const float* gp = WSP(const float, WS_GATES) + (size_t)(cp * 128) * 32 + 16 + d * 8 + head;
    const int i0 = d ? 127 - 2 * F.lane : 2 * F.lane, i1 = d ? i0 - 1 : i0 + 1;
    const float dt0 = softplusf_(gp[(size_t)i0 * 32] + bias), dt1 = softplusf_(gp[(size_t)i1 * 32] + bias);
    const float a0 = dt0 * arate, a1 = dt1 * arate;
    float inc = a0 + a1;
#pragma unroll
    for (int o = 1; o < 64; o <<= 1) { const float t = __shfl_up(inc, o); if (F.lane >= o) inc += t; }
    const float c1 = inc, c0 = inc - a1, tot = __shfl(inc, 63);
    LAS float* cum = SCA(16 + d * 4 + rr); LAS float* dtw = SCA(24 + d * 4 + rr);
    cum[i0] = c0; cum[i1] = c1;
    if (WMODE) { dtw[i0] = __expf(tot - c0) * dt0; dtw[i1] = __expf(tot - c1) * dt1; } else { dtw[i0] = dt0; dtw[i1] = dt1; }
    return tot;
}
__device__ __forceinline__ void seq_bounds(int cp, int& lo, int& hi) { if (cp < 64) { lo = (cp >> 1) * 256; hi = lo + 256; } else { lo = MC + ((cp - 64) >> 5) * 4096; hi = lo + 4096; } }
__device__ __forceinline__ void ssd_local_item(Frame F, KArgs& A, int l, int cp, int g) {
    const float tot = ssd_scalars<true>(F, A, l, cp, g);
    if (F.lane == 0) WSP(float, WS_SDSC)[(cp * 2 + (F.wave >> 2)) * 8 + g * 4 + (F.wave & 3)] = tot;
    int lo, hi; seq_bounds(cp, lo, hi);
    LAS unsigned char* TB = F.lds;
    load_conv<1, 16>(F, A, l, TB, nullptr, LDT, 512 + g * 128, cp * 128, lo, hi, nullptr, nullptr, true);
    load_conv<0, 16>(F, A, l, nullptr, nullptr, LDT, 768 + g * 128, cp * 128, lo, hi, nullptr, nullptr, true);
    BAR();
#pragma unroll 1
    for (int hr = 0; hr < 2; ++hr) {
#pragma unroll 1
        for (int r2 = 0; r2 < 2; ++r2) { const int rr = hr * 2 + r2;
            load_conv<2, 8>(F, A, l, F.lds + TS + (r2 * 2 + 0) * TSX, F.lds + TS + (r2 * 2 + 1) * TSX, LDX, g * 256 + rr * 64, cp * 128, lo, hi, SCA(24 + 0 * 4 + rr), SCA(24 + 1 * 4 + rr), true); }
        BAR();
        const int r2 = F.wave >> 2, d = (F.wave >> 1) & 1, pb = F.wave & 1, hh = F.lane >> 5, head = g * 4 + hr * 2 + r2;
        const LAS unsigned char* TX = F.lds + TS + (r2 * 2 + d) * TSX;
        f32x16 acc[4] = {ZERO16, ZERO16, ZERO16, ZERO16};
#pragma unroll 1
        for (int ks = 0; ks < 8; ++ks) { const bf16x8 a = frag_tr(TX, LDX, 16 * ks, 32 * pb, F.lane);
#pragma unroll
            for (int nb = 0; nb < 4; ++nb) acc[nb] = MFMA32(a, frag_tr(TB, LDT, 16 * ks, 32 * nb, F.lane), acc[nb]); }
        bf16* o = WSP(bf16, WS_SDLOC) + (size_t)((cp * 2 + d) * 8 + head) * 8192;
#pragma unroll
        for (int nb = 0; nb < 4; ++nb)
#pragma unroll
            for (int i = 0; i < 16; ++i) o[(32 * pb + crow(i, hh)) * 128 + 32 * nb + (F.lane & 31)] = (bf16)f2bf(acc[nb][i]);
        BAR();
    }
}
__device__ __forceinline__ void ssd_out_item(Frame F, KArgs& A, int l, int cp, bf16* Ybase) {
    const Seq sq = seq_of(cp);
    LAS unsigned char* TC = F.lds; LAS unsigned char* TB = F.lds + TS; LAS unsigned char* TX2 = F.lds + 2 * TS; LAS unsigned char* YI = F.lds + 3 * TS;
    LAS float* SSQ = SCA(14);
    if (F.tid < 128) SSQ[F.tid] = 0.f;
    const int tb = F.wave >> 1, ph = F.wave & 1, hh = F.lane >> 5, t = 32 * tb + (F.lane & 31);
    bf16* Yd = Ybase + (size_t)cp * 128 * D + 1536;
#pragma unroll 1
    for (int g = 0; g < 2; ++g) {
        (void)ssd_scalars<false>(F, A, l, cp, g);
        load_xbcc<16>(F, TC, LDT, 768 + g * 128, cp * 128);
        load_xbcc<16>(F, TB, LDT, 512 + g * 128, cp * 128);
        load_xbcc<16>(F, TX2, LDT, g * 256, cp * 128);
        BAR();
        f32x16 cb[4] = {ZERO16, ZERO16, ZERO16, ZERO16};
#pragma unroll 1
        for (int ks = 0; ks < 8; ++ks) { const bf16x8 bq = frag_row(TC, LDT, 32 * tb, 16 * ks, F.lane);
#pragma unroll
            for (int sb = 0; sb < 4; ++sb) cb[sb] = MFMA32(frag_row(TB, LDT, 32 * sb, 16 * ks, F.lane), bq, cb[sb]); }
#pragma unroll 1
        for (int hr = 0; hr < 2; ++hr) {
            if (hr == 1) { load_xbcc<16>(F, TX2, LDT, g * 256 + 128, cp * 128); BAR(); }
            f32x16 y2[2];
#pragma unroll
            for (int r2 = 0; r2 < 2; ++r2) {
                const int rr = hr * 2 + r2, head = g * 4 + rr;
                f32x16 y = ZERO16;
#pragma unroll 1
                for (int d = 0; d < 2; ++d) {
                    const LAS float* cum = SCA(16 + d * 4 + rr); const LAS float* dtv = SCA(24 + d * 4 + rr); const float ct = cum[t];
                    const bool has_state = sq.lat || (d == 0 ? sq.c > 0 : sq.c < sq.nch - 1);
                    bf16x8 bh[8];
                    if (has_state) { const bf16* hin = WSP(const bf16, WS_SDIN) + (size_t)((cp * 2 + d) * 8 + head) * 8192;
#pragma unroll
                        for (int ks = 0; ks < 8; ++ks) bh[ks] = *(const bf16x8*)(hin + (size_t)(32 * ph + (F.lane & 31)) * 128 + 16 * ks + 8 * hh); }
#pragma unroll
                    for (int sb = 0; sb < 4; ++sb) if (d == 0 ? sb <= tb : sb >= tb) {
#pragma unroll
                        for (int sp = 0; sp < 2; ++sp) { float p[8];
#pragma unroll
                            for (int jh = 0; jh < 2; ++jh) { const int s0 = 32 * sb + 16 * sp + 8 * jh + 4 * hh; const f32x4 c4 = *(const LAS f32x4*)(cum + s0), d4 = *(const LAS f32x4*)(dtv + s0);
#pragma unroll
                                for (int j = 0; j < 4; ++j) { const int s = s0 + j; float v = cb[sb][8 * sp + 4 * jh + j] * __expf(ct - c4[j]) * d4[j];
                                    if (sb == tb) { const bool ok = d == 0 ? (s <= t) : (s >= t); v = ok ? v : 0.f; }
                                    p[4 * jh + j] = v; } }
                            y = MFMA32(__builtin_bit_cast(bf16x8, pack8(p, 1.f)), frag_trp(TX2, LDT, 32 * sb + 16 * sp, r2 * 64 + 32 * ph, F.lane), y); } }
                    if (has_state) { f32x16 ch = ZERO16;
#pragma unroll
                        for (int ks = 0; ks < 8; ++ks) ch = MFMA32(frag_row(TC, LDT, 32 * tb, 16 * ks, F.lane), bh[ks], ch);
#pragma unroll
                        for (int k4 = 0; k4 < 4; ++k4) { const f32x4 c4 = *(const LAS f32x4*)(cum + 32 * tb + 8 * k4 + 4 * hh);
#pragma unroll
                            for (int i = 0; i < 4; ++i) y[4 * k4 + i] += __expf(c4[i]) * ch[4 * k4 + i]; } }
                }
                y2[r2] = y;
            }
#pragma unroll
            for (int r2 = 0; r2 < 2; ++r2)
#pragma unroll
                for (int i = 0; i < 16; ++i) *(LAS unsigned short*)(YI + (32 * tb + crow(i, hh)) * LDT + (r2 * 64 + 32 * ph + (F.lane & 31)) * 2) = (unsigned short)f2bf(y2[r2][i]);
            BAR();
            { const int tt = F.tid >> 2, seg = F.tid & 3, head = g * 4 + hr * 2 + (seg >> 1), pc = (seg & 1) * 32; const float Dh = INP(I_SSDD)[l * 8 + head]; float ss = 0.f;
#pragma unroll
                for (int k = 0; k < 4; ++k) { float yv[8], x[8], z[8], o[8];
                    unpack8(*(const LAS v4u*)(YI + tt * LDT + (seg * 32 + 8 * k) * 2), yv); unpack8(*(const LAS v4u*)(TX2 + tt * LDT + (seg * 32 + 8 * k) * 2), x);
                    unpack8(*(const v4u*)(PT(cp, PC_DZ + head * 64 + pc) + (size_t)tt * 128 + 8 * k), z);
#pragma unroll
                    for (int j = 0; j < 8; ++j) { const float v = (yv[j] + Dh * x[j]) * siluf_(z[j]); o[j] = v; ss += v * v; }
                    *(v4u*)(Yd + (size_t)tt * D + head * 64 + pc + 8 * k) = pack8(o, 1.f); }
                ss += __shfl_xor(ss, 1); ss += __shfl_xor(ss, 2);
                if (seg == 0) SSQ[tt] += ss; }
            BAR();
        }
    }
    __builtin_amdgcn_fence(__ATOMIC_RELEASE, "workgroup"); asm volatile("s_waitcnt vmcnt(0)" ::: "memory"); __syncthreads(); __builtin_amdgcn_fence(__ATOMIC_ACQUIRE, "workgroup");
    { const int tt = F.tid >> 2, seg = F.tid & 3; const float r = rsqrtf(SSQ[tt] * (1.f / 512.f) + EPS); const float* gn = INP(I_SNORM) + (size_t)l * GWID + 128 * seg;
#pragma unroll 4
        for (int k = 0; k < 16; ++k) { bf16* p = Yd + (size_t)tt * D + 128 * seg + 8 * k; float v[8];
            unpack8(*(const v4u*)p, v);
#pragma unroll
            for (int j = 0; j < 8; ++j) v[j] = v[j] * r * gn[8 * k + j];
            *(v4u*)p = pack8(v, 1.f); } }
    BAR();
}
template <int PASS> __device__ __forceinline__ void s5_item(Frame F, KArgs& A, int l, int cp, int gq) {
    const Seq sq = seq_of(cp);
    const int g = gq * 8 + F.wave, p = F.lane, hh = F.lane >> 5;
    LAS unsigned char* TU = F.lds; LAS unsigned char* BU = F.lds + TS + F.wave * 8704;
    if (PASS == 1) ITS(8);
    typedef short v8s __attribute__((ext_vector_type(8)));
    typedef float f32x4v __attribute__((ext_vector_type(4)));
    const int r16 = F.lane & 15, g4 = F.lane >> 4;
    v4u ru[4]; tile_issue(F, PT(cp, PC_S5U + gq * 128), ru);
    f32x2 lam[2], l8[2], h0[2]; bf16x8 bbf[2][4]; v8s ctf[2][4];
#pragma unroll
    for (int d = 0; d < 2; ++d) {
        const unsigned char* tab = s5tab(F, l, d, g);
        lam[d] = ((const f32x2*)tab)[p]; l8[d] = ((const f32x2*)(tab + 512))[p]; h0[d] = (f32x2){0.f, 0.f};
        if (PASS == 1 && sq.lat) { const size_t o = (size_t)(((sq.b * 4 + l) * 2 + d) * 32 + g) * 64 + p; h0[d] = (f32x2){INP(I_SS5R)[o], INP(I_SS5I)[o]}; }
        const bf16* bb = (const bf16*)(tab + 1024); const bf16* ct = (const bf16*)(tab + 5120);
#pragma unroll
        for (int nb = 0; nb < 4; ++nb) bbf[d][nb] = *(const bf16x8*)(bb + (size_t)(32 * nb + (F.lane & 31)) * 16 + 8 * hh);
        if (PASS == 1 && d == 0) {
#pragma unroll
            for (int ks = 0; ks < 4; ++ks) ctf[0][ks] = *(const v8s*)(ct + r16 * 128 + 32 * ks + 8 * g4); }
    }
    if (PASS == 1) {
        f32x2 e[31];
#pragma unroll
        for (int j = 0; j < 31; ++j) if (j < sq.nch - 1) { const int cc = j < sq.c ? j : j + 1, dd = j < sq.c ? 0 : 1;
            e[j] = *(const f32x2*)(WSP(const float, WS_S5LOC) + ((size_t)(((sq.cp0 + cc) * 2 + dd) * 32 + g) * 64 + p) * 2); }
#pragma unroll
        for (int j = 0; j < 31; ++j) if (j < sq.c) { const float nr = l8[0].x * h0[0].x - l8[0].y * h0[0].y + e[j].x, ni = l8[0].x * h0[0].y + l8[0].y * h0[0].x + e[j].y; h0[0] = (f32x2){nr, ni}; }
#pragma unroll
        for (int j = 30; j >= 0; --j) if (j >= sq.c && j < sq.nch - 1) { const float nr = l8[1].x * h0[1].x - l8[1].y * h0[1].y + e[j].x, ni = l8[1].x * h0[1].y + l8[1].y * h0[1].x + e[j].y; h0[1] = (f32x2){nr, ni}; }
    }
    tile_commit(F, TU, ru, 1.f);
    BAR();
    if (PASS == 1) { ITE(8); ITS(9); }
    f32x4v yacc[4][2];
    if (PASS == 1) {
#pragma unroll
        for (int a = 0; a < 4; ++a) { yacc[a][0] = (f32x4v){0.f, 0.f, 0.f, 0.f}; yacc[a][1] = (f32x4v){0.f, 0.f, 0.f, 0.f}; } }
#pragma unroll
    for (int d = 0; d < 2; ++d) {
        const float lr = lam[d].x, li = lam[d].y;
        float hr = h0[d].x, hi = h0[d].y;
        if (PASS == 1 && d == 1) { const bf16* ct = (const bf16*)(s5tab(F, l, 1, g) + 5120);
#pragma unroll
            for (int ks = 0; ks < 4; ++ks) ctf[1][ks] = *(const v8s*)(ct + r16 * 128 + 32 * ks + 8 * g4); }
#pragma unroll 1
        for (int tbi = 0; tbi < 4; ++tbi) {
            const int tb = d == 0 ? tbi : 3 - tbi;
            const bf16x8 bu = frag_row(TU, LDT, 32 * tb, 16 * F.wave, F.lane);
#pragma unroll
            for (int nb = 0; nb < 4; ++nb) {
                const f32x16 acc = MFMA32(bbf[d][nb], bu, ZERO16);
#pragma unroll
                for (int i4 = 0; i4 < 4; ++i4) *(LAS u32x2*)(BU + (F.lane & 31) * LDT + (32 * nb + 8 * i4 + 4 * hh) * 2) = (u32x2){pk2(acc[4 * i4], acc[4 * i4 + 1]), pk2(acc[4 * i4 + 2], acc[4 * i4 + 3])};
            }
            asm volatile("s_waitcnt lgkmcnt(0)" ::: "memory");
            unsigned w[32];
#pragma unroll
            for (int st = 0; st < 32; ++st) { const int tl = d == 0 ? st : 31 - st; w[st] = *(const LAS unsigned*)(BU + tl * LDT + p * 4); }
#pragma unroll
            for (int st = 0; st < 32; ++st) { const float br = bflo(w[st]), bi = bfhi(w[st]);
                const float nr = lr * hr - li * hi + br, ni = lr * hi + li * hr + bi; hr = nr; hi = ni;
                if (PASS == 1) w[st] = pk2(hr, hi); }
            if (PASS == 1) {
#pragma unroll
                for (int st = 0; st < 32; ++st) { const int tl = d == 0 ? st : 31 - st; *(LAS unsigned*)(BU + tl * LDT + p * 4) = w[st]; }
                asm volatile("s_waitcnt lgkmcnt(0)" ::: "memory");
                f32x4v y0 = (f32x4v){0.f, 0.f, 0.f, 0.f}, y1 = y0;
#pragma unroll
                for (int ks = 0; ks < 4; ++ks) {
                    y0 = __builtin_amdgcn_mfma_f32_16x16x32_bf16(*(const LAS v8s*)(BU + r16 * LDT + (32 * ks + 8 * g4) * 2), ctf[d][ks], y0, 0, 0, 0);
                    y1 = __builtin_amdgcn_mfma_f32_16x16x32_bf16(*(const LAS v8s*)(BU + (16 + r16) * LDT + (32 * ks + 8 * g4) * 2), ctf[d][ks], y1, 0, 0, 0); }
                if (tb == 0) { yacc[0][0] += y0; yacc[0][1] += y1; } else if (tb == 1) { yacc[1][0] += y0; yacc[1][1] += y1; } else if (tb == 2) { yacc[2][0] += y0; yacc[2][1] += y1; } else { yacc[3][0] += y0; yacc[3][1] += y1; }
                asm volatile("s_waitcnt lgkmcnt(0)" ::: "memory");
            }
        }
        if (PASS == 0) { *(f32x2*)(WSP(float, WS_S5LOC) + ((size_t)((cp * 2 + d) * 32 + g) * 64 + p) * 2) = (f32x2){hr, hi}; }
        else if (!sq.lat && ((d == 0 && sq.c == sq.nch - 1) || (d == 1 && sq.c == 0))) { const size_t o = (size_t)(((sq.b * 4 + l) * 2 + d) * 32 + g) * 64 + p; F.out[O_S5R + o] = hr; F.out[O_S5I + o] = hi; }
    }
    if (PASS == 1) { ITE(9); ITS(10); }
    if (PASS == 1) {
        const float Dc = INP(I_S5D)[(size_t)l * GWID + g * 16 + r16];
#pragma unroll
        for (int tb = 0; tb < 4; ++tb)
#pragma unroll
            for (int ts = 0; ts < 2; ++ts)
#pragma unroll
                for (int i = 0; i < 4; ++i) { const int t = 32 * tb + 16 * ts + 4 * g4 + i; LAS unsigned short* up = (LAS unsigned short*)(TU + t * LDT + (16 * F.wave + r16) * 2);
                    const float x = yacc[tb][ts][i] + Dc * bf2f(*up);
                    const float u2 = 1.5957691216057308f * (x + 0.044715f * x * x * x); const float ge = x - x * __builtin_amdgcn_rcpf(1.f + __expf(u2));
                    *up = (unsigned short)f2bf(ge); }
        BAR();
        bf16* ya = WSP(bf16, WS_YA) + (size_t)cp * 128 * GWID + gq * 128;
#pragma unroll
        for (int it = 0; it < 4; ++it) { const int i = F.tid + NT * it, r = i >> 4, c = i & 15; *(v4u*)(ya + (size_t)r * GWID + c * 8) = *(const LAS v4u*)(TU + r * LDT + c * 16); }
    }
    BAR();
    if (PASS == 1) ITE(10);
}

template <bool LAT> __device__ __forceinline__ void carry_unit(Frame F, KArgs& A, int l, int u) {
    const int sd = u / 96, rem = u % 96, sidx = sd >> 1, d = sd & 1;
    constexpr int lat = LAT ? 1 : 0, nch = LAT ? 32 : 2, NB = LAT ? 16 : 2;
    const int b = LAT ? sidx : sidx - 4, cp0 = LAT ? 64 + 32 * b : 2 * b;
    int type, head, slice;
    if (rem < 32) { type = 0; head = rem >> 3; slice = rem & 7; } else if (rem < 64) { type = 1; head = (rem - 32) >> 3; slice = (rem - 32) & 7; } else { type = 2; head = (rem - 64) >> 2; slice = (rem - 64) & 3; }
    const int e0 = slice * 2048 + F.tid * 4;
    const int nh = type == 2 ? 8 : 4, esz = type == 2 ? 8192 : 16384;
    const bf16* loc = type == 0 ? WSP(const bf16, WS_MLCLOC) : (type == 1 ? WSP(const bf16, WS_RTLOC) : WSP(const bf16, WS_SDLOC));
    bf16* inb = type == 0 ? WSP(bf16, WS_MLCIN) : (type == 1 ? WSP(bf16, WS_RTIN) : WSP(bf16, WS_SDIN));
    float zf = 0.f; asm volatile("" : "+v"(zf));
    float v[4] = {zf, zf, zf, zf}, nv[4] = {zf, zf, zf, zf}, m = 0.f;
    const bool do_n = (type == 0 && slice == 0 && F.tid < 32);
    if (LAT) {
        if (type == 2) { const f32x4 s = *(const f32x4*)(INP(I_SSSD) + (size_t)(((b * 4 + l) * 2 + d) * 8 + head) * 8192 + e0); v[0] = s.x; v[1] = s.y; v[2] = s.z; v[3] = s.w; }
        else { const float* s = (type == 0 ? INP(I_SMC) : INP(I_SRET)) + (size_t)(((b * 4 + l) * 2 + d) * 4 + head) * 16384; const int dv = e0 >> 7, dk = e0 & 127;
#pragma unroll
            for (int j = 0; j < 4; ++j) v[j] = s[(dk + j) * 128 + dv]; }
        if (type == 0) { m = INP(I_SMM)[((b * 4 + l) * 2 + d) * 4 + head];
            if (do_n) { const f32x4 s = *(const f32x4*)(INP(I_SMN) + (size_t)(((b * 4 + l) * 2 + d) * 4 + head) * 128 + F.tid * 4); nv[0] = s.x; nv[1] = s.y; nv[2] = s.z; nv[3] = s.w; } }
    }
    const float rdec = type == 1 ? __expf(-128.f * __expf(INP(I_RRATE)[(l * 2 + d) * 4 + head])) : 1.f;
#pragma unroll 1
    for (int ci0 = 0; ci0 < nch; ci0 += NB) {
        u32x2 lc[NB]; f32x4 ln[NB]; float s0[NB], s1[NB];
#pragma unroll
        for (int j = 0; j < NB; ++j) { ln[j] = (f32x4){zf, zf, zf, zf}; s0[j] = zf; s1[j] = zf; }
#pragma unroll
        for (int j = 0; j < NB; ++j) {
            const int ci = ci0 + j, cp = cp0 + (d == 0 ? ci : nch - 1 - ci);
            lc[j] = *(const u32x2*)(loc + (size_t)((cp * 2 + d) * nh + head) * esz + e0);
            if (type == 0) { const float* sc = WSP(const float, WS_MLSC) + ((cp * 2 + d) * 4 + head) * 2; s0[j] = sc[0]; s1[j] = sc[1];
                if (do_n) ln[j] = *(const f32x4*)(WSP(const float, WS_MLNLOC) + ((cp * 2 + d) * 4 + head) * 128 + F.tid * 4); }
            else if (type == 2) s0[j] = WSP(const float, WS_SDSC)[(cp * 2 + d) * 8 + head];
        }
#pragma unroll
        for (int j = 0; j < NB; ++j) {
            const int ci = ci0 + j, cp = cp0 + (d == 0 ? ci : nch - 1 - ci);
            const size_t so = (size_t)((cp * 2 + d) * nh + head) * esz + e0;
            if (LAT || ci > 0) *(u32x2*)(inb + so) = (u32x2){pk2(v[0], v[1]), pk2(v[2], v[3])};
            float dec, wl = 1.f;
            if (type == 0) {
                const float Bt = s0[j], ml = s1[j];
                if (slice == 0 && F.tid == 0) WSP(float, WS_MLMIN)[(cp * 2 + d) * 4 + head] = m;
                if (do_n) *(f32x4*)(WSP(float, WS_MLNIN) + ((cp * 2 + d) * 4 + head) * 128 + F.tid * 4) = (f32x4){nv[0], nv[1], nv[2], nv[3]};
                const float mn = fmaxf(Bt + m, ml); dec = __expf(Bt + m - mn); wl = __expf(ml - mn); m = mn;
                if (do_n) { nv[0] = dec * nv[0] + wl * ln[j].x; nv[1] = dec * nv[1] + wl * ln[j].y; nv[2] = dec * nv[2] + wl * ln[j].z; nv[3] = dec * nv[3] + wl * ln[j].w; }
            } else if (type == 1) dec = rdec;
            else dec = __expf(s0[j]);
            v[0] = dec * v[0] + wl * bflo(lc[j].x); v[1] = dec * v[1] + wl * bfhi(lc[j].x); v[2] = dec * v[2] + wl * bflo(lc[j].y); v[3] = dec * v[3] + wl * bfhi(lc[j].y);
        }
    }
    if (!lat) {
        if (type == 2) *(f32x4*)(F.out + O_SSD + (size_t)(((b * 4 + l) * 2 + d) * 8 + head) * 8192 + e0) = (f32x4){v[0], v[1], v[2], v[3]};
        else {
            LAS float* tr = (LAS float*)F.lds;
            const int dvl = F.tid >> 5, dk = (F.tid & 31) * 4;
#pragma unroll
            for (int j = 0; j < 4; ++j) tr[dvl * 129 + dk + j] = v[j];
            BAR();
            const int dk2 = F.tid >> 2, q = F.tid & 3;
            float* o = F.out + (type == 0 ? O_MC : O_RET) + (size_t)(((b * 4 + l) * 2 + d) * 4 + head) * 16384 + (size_t)dk2 * 128 + slice * 16 + 4 * q;
            *(f32x4*)o = (f32x4){tr[(4 * q) * 129 + dk2], tr[(4 * q + 1) * 129 + dk2], tr[(4 * q + 2) * 129 + dk2], tr[(4 * q + 3) * 129 + dk2]};
            if (type == 0) { if (do_n) *(f32x4*)(F.out + O_MN + (size_t)(((b * 4 + l) * 2 + d) * 4 + head) * 128 + F.tid * 4) = (f32x4){nv[0], nv[1], nv[2], nv[3]};
                if (slice == 0 && F.tid == 0) F.out[O_MM + ((b * 4 + l) * 2 + d) * 4 + head] = m; }
            BAR();
        }
    }
}

struct CtxLd { u32x2 lc[2]; f32x4 ln[2]; float s0[2], s1[2]; };
struct CtxU { int d, b, cp0, type, head, slice, e0, nh, esz; bool do_n; };
__device__ __forceinline__ CtxU ctx_decode(const Frame& F, int u) {
    CtxU c; const int sd = u / 96, rem = u % 96, sidx = sd >> 1; c.d = sd & 1; c.b = sidx - 4; c.cp0 = 2 * c.b;
    if (rem < 32) { c.type = 0; c.head = rem >> 3; c.slice = rem & 7; } else if (rem < 64) { c.type = 1; c.head = (rem - 32) >> 3; c.slice = (rem - 32) & 7; } else { c.type = 2; c.head = (rem - 64) >> 2; c.slice = (rem - 64) & 3; }
    c.e0 = c.slice * 2048 + F.tid * 4; c.nh = c.type == 2 ? 8 : 4; c.esz = c.type == 2 ? 8192 : 16384; c.do_n = (c.type == 0 && c.slice == 0 && F.tid < 32);
    return c;
}
__device__ __forceinline__ void carry_ctx_load(const Frame& F, int u, CtxLd& L, float zf) {
    const CtxU c = ctx_decode(F, u);
    const bf16* loc = c.type == 0 ? WSP(const bf16, WS_MLCLOC) : (c.type == 1 ? WSP(const bf16, WS_RTLOC) : WSP(const bf16, WS_SDLOC));
#pragma unroll
    for (int j = 0; j < 2; ++j) { const int cp = c.cp0 + (c.d == 0 ? j : 1 - j);
        L.ln[j] = (f32x4){zf, zf, zf, zf}; L.s0[j] = zf; L.s1[j] = zf;
        L.lc[j] = *(const u32x2*)(loc + (size_t)((cp * 2 + c.d) * c.nh + c.head) * c.esz + c.e0);
        if (c.type == 0) { const float* sc = WSP(const float, WS_MLSC) + ((cp * 2 + c.d) * 4 + c.head) * 2; L.s0[j] = sc[0]; L.s1[j] = sc[1];
            if (c.do_n) L.ln[j] = *(const f32x4*)(WSP(const float, WS_MLNLOC) + ((cp * 2 + c.d) * 4 + c.head) * 128 + F.tid * 4); }
        else if (c.type == 2) L.s0[j] = WSP(const float, WS_SDSC)[(cp * 2 + c.d) * 8 + c.head]; }
}
__device__ __forceinline__ void carry_ctx_finish(Frame& F, KArgs& A, int l, int u, const CtxLd& L, float zf) {
    const CtxU c = ctx_decode(F, u);
    bf16* inb = c.type == 0 ? WSP(bf16, WS_MLCIN) : (c.type == 1 ? WSP(bf16, WS_RTIN) : WSP(bf16, WS_SDIN));
    float v[4] = {zf, zf, zf, zf}, nv[4] = {zf, zf, zf, zf}, m = 0.f;
    const float rdec = c.type == 1 ? __expf(-128.f * __expf(INP(I_RRATE)[(l * 2 + c.d) * 4 + c.head])) : 1.f;
#pragma unroll
    for (int j = 0; j < 2; ++j) { const int cp = c.cp0 + (c.d == 0 ? j : 1 - j);
        if (j > 0) *(u32x2*)(inb + (size_t)((cp * 2 + c.d) * c.nh + c.head) * c.esz + c.e0) = (u32x2){pk2(v[0], v[1]), pk2(v[2], v[3])};
        float dec, wl = 1.f;
        if (c.type == 0) {
            if (c.slice == 0 && F.tid == 0) WSP(float, WS_MLMIN)[(cp * 2 + c.d) * 4 + c.head] = m;
            if (c.do_n) *(f32x4*)(WSP(float, WS_MLNIN) + ((cp * 2 + c.d) * 4 + c.head) * 128 + F.tid * 4) = (f32x4){nv[0], nv[1], nv[2], nv[3]};
            const float mn = fmaxf(L.s0[j] + m, L.s1[j]); dec = __expf(L.s0[j] + m - mn); wl = __expf(L.s1[j] - mn); m = mn;
            if (c.do_n) { nv[0] = dec * nv[0] + wl * L.ln[j].x; nv[1] = dec * nv[1] + wl * L.ln[j].y; nv[2] = dec * nv[2] + wl * L.ln[j].z; nv[3] = dec * nv[3] + wl * L.ln[j].w; }
        } else if (c.type == 1) dec = rdec;
        else dec = __expf(L.s0[j]);
        v[0] = dec * v[0] + wl * bflo(L.lc[j].x); v[1] = dec * v[1] + wl * bfhi(L.lc[j].x); v[2] = dec * v[2] + wl * bflo(L.lc[j].y); v[3] = dec * v[3] + wl * bfhi(L.lc[j].y); }
    const int b = c.b, d = c.d, head = c.head, slice = c.slice, e0 = c.e0;
    if (c.type == 2) *(f32x4*)(F.out + O_SSD + (size_t)(((b * 4 + l) * 2 + d) * 8 + head) * 8192 + e0) = (f32x4){v[0], v[1], v[2], v[3]};
    else {
        LAS float* tr = (LAS float*)F.lds;
        const int dvl = F.tid >> 5, dk = (F.tid & 31) * 4;
#pragma unroll
        for (int j = 0; j < 4; ++j) tr[dvl * 129 + dk + j] = v[j];
        BAR();
        const int dk2 = F.tid >> 2, q = F.tid & 3;
        float* o = F.out + (c.type == 0 ? O_MC : O_RET) + (size_t)(((b * 4 + l) * 2 + d) * 4 + head) * 16384 + (size_t)dk2 * 128 + slice * 16 + 4 * q;
        *(f32x4*)o = (f32x4){tr[(4 * q) * 129 + dk2], tr[(4 * q + 1) * 129 + dk2], tr[(4 * q + 2) * 129 + dk2], tr[(4 * q + 3) * 129 + dk2]};
        if (c.type == 0) { if (c.do_n) *(f32x4*)(F.out + O_MN + (size_t)(((b * 4 + l) * 2 + d) * 4 + head) * 128 + F.tid * 4) = (f32x4){nv[0], nv[1], nv[2], nv[3]};
            if (slice == 0 && F.tid == 0) F.out[O_MM + ((b * 4 + l) * 2 + d) * 4 + head] = m; }
        BAR();
    }
}
__device__ __forceinline__ void carry_ctx_batch(Frame F, KArgs& A, int l, int u0) {
    float zf = 0.f; asm volatile("" : "+v"(zf));
    CtxLd L[8];
#pragma unroll
    for (int j = 0; j < 8; ++j) carry_ctx_load(F, u0 + j, L[j], zf);
#pragma unroll
    for (int j = 0; j < 8; ++j) carry_ctx_finish(F, A, l, u0 + j, L[j], zf);
}
constexpr int CW_Q = 16384;
struct OneUnit { pg8::Unit u; __device__ __forceinline__ bool next(int i, pg8::Unit& o) const { if (i) return false; o = u; return true; }
    __device__ __forceinline__ void a_ready(const pg8::Unit&) const {} __device__ __forceinline__ void done(const pg8::Unit&) const {} };
#define QUEUE_LOOP(F0_, qidx, total, ...) do { \
    unsigned* qc_ = (unsigned*)(F0_.ws + WS_CTL) + CW_Q + 64 * (qidx); volatile LAS int* qs_ = (volatile LAS int*)(F0_.lds + MISC_OFF + 64); \
    if (F0_.tid == 0) qs_[0] = (int)__hip_atomic_fetch_add(qc_, 1u, __ATOMIC_RELAXED, __HIP_MEMORY_SCOPE_AGENT); \
    __syncthreads(); \
    int it = qs_[0], par_ = 1; \
    while (it < (total)) { \
        int nx_ = 0; if (F0_.tid == 0) nx_ = (int)__hip_atomic_fetch_add(qc_, 1u, __ATOMIC_RELAXED, __HIP_MEMORY_SCOPE_AGENT); \
        { __VA_ARGS__ } \
        if (F0_.tid == 0) qs_[par_] = nx_; \
        BAR();     \
        it = qs_[par_]; par_ ^= 1; \
    } } while (0)
#ifndef PROBE_ITEM
#define PROBE_ITEM -1
#endif
#define PR(t) (PROBE_ITEM == (t) ? 2 : 1)
#define QSPLIT(NT_, C0, C1, C2, C3, T0) int ty_ = 0, loc_ = it, dup_ = 0; { const int cnt_[4] = {C0, C1, C2, C3}; \
    _Pragma("unroll") for (int j_ = 0; j_ < NT_; ++j_) { const int span_ = cnt_[j_] * PR(T0 + j_); if (ty_ == j_) { if (loc_ >= span_) { loc_ -= span_; ty_ = j_ + 1; } else { dup_ = loc_ / cnt_[j_]; loc_ = loc_ % cnt_[j_]; } } } }
#ifndef PROBE_TMASK
#define PROBE_TMASK 0
#endif
#ifndef PROBE_TAMP
#define PROBE_TAMP 4
#endif
#define TSTART(k) do { if (PROBE_TMASK & (1 << (k))) pt0_ = __builtin_amdgcn_s_memrealtime(); } while (0)
#define TEND(k) do { if (PROBE_TMASK & (1 << (k))) ptacc_ += __builtin_amdgcn_s_memrealtime() - pt0_; } while (0)
#ifndef PROBE_REPEAT
#define PROBE_REPEAT -1
#endif
#ifndef XSTG
#define XSTG 0
#endif
constexpr int N_PHASES = 2 + 9 * NLAYER;
__global__ void __launch_bounds__(NT, 2) hymba_fwd(Args A) {
    extern __shared__ __attribute__((aligned(16))) unsigned char lds_raw[];
    Frame F0;
    F0.lds = (LAS unsigned char*)lds_raw;
    F0.tid = threadIdx.x; F0.lane = 0; F0.wave = __builtin_amdgcn_readfirstlane(F0.tid >> 6);
    F0.G = gridDim.x; F0.bid = blockIdx.x; F0.out = A.out; F0.ws = A.ws;
    volatile LAS unsigned* MISC = (volatile LAS unsigned*)(F0.lds + MISC_OFF);
    if (F0.tid < 64) MISC[F0.tid] = 0u;
    __syncthreads();
    unsigned* barw = (unsigned*)(F0.ws + WS_CTL) + CW_BAR;
    XcdBarrier bar = xcd_barrier_post(barw, MISC + 8, F0.wave == 0 ? 1u : 0u);
    const int lo = A.ph_lo, hi = A.ph_hi;
    unsigned long long pt0_ = 0, ptacc_ = 0;
#define KA (*kargs())
#define IN(k) (lo <= (k) && (k) < hi)
#define SEAM(k) do { if (IN(k) && IN((k) + 1)) xcd_barrier(bar); } while (0)
#define CSEAM(k) do { if (IN(k) && IN((k) + 1)) { if (__builtin_amdgcn_readfirstlane((int)MISC[11]) == 2) xcc_barrier(bar); else xcd_barrier(bar); } } while (0)
#define XCC_ORDER(S_, M_, N_) pg8::XccOrder S_; S_.init(M_, N_, F.G, F.bid, __builtin_amdgcn_readfirstlane((int)MISC[11]) == 2 ? 1 : 0, (int)bar.x, __builtin_amdgcn_readfirstlane((int)MISC[10]))

    TSTART(9); if (IN(0)) for (int rep_ = 0; rep_ < (PROBE_REPEAT == 100 ? 2 : 1); ++rep_) { Frame F = fresh(F0); p0_prologue(F, KA); } SEAM(0); TEND(9);

    TSTART(10); if (IN(1)) { Frame F = fresh(F0); norm0_phase(F, KA); shw_phase(F); } SEAM(1); TEND(10);

#pragma unroll 1
    for (int l = 0; l < NLAYER; ++l) {
        const int pb = 1 + 9 * l;
        TSTART(1); if (IN(pb + 1)) for (int rep_ = 0; rep_ < (PROBE_REPEAT == 1 ? 2 : 1); ++rep_) { Frame F = fresh(F0);
            pg8::Gemm g{WSP(const pg8::bf16_t, WS_H), WSP(const pg8::bf16_t, WS_W1T) + (size_t)l * NPAD * D, M, NPROJ, D}; pg8::StaticOrder S; S.init(M, NPROJ, F.G, F.bid);
            epi::EpiProj E{WSP(pg8::bf16_t, WS_PROJ), WSP(const float, WS_SSQB), WSP(const float, WS_SHW1) + (size_t)l * 5 * NPAD};
            pg8::gemm_phase<epi::EpiProj, pg8::StaticOrder, true, true>(F.lds, g, S, E, F.tid);
            __syncthreads(); gates_phase(F, l);
        } SEAM(pb + 1); TEND(1);
        TSTART(2); if (IN(pb + 2)) { Frame F = fresh(F0);
            QUEUE_LOOP(F, l * 3 + 0, 384 * PR(0) + 768 * PR(1) + 768 * PR(2) + 768 * PR(3), {
                QSPLIT(4, 384, 768, 768, 768, 0);
                if (ty_ == 0) { TSTART(11); ssd_local_item(fresh(F), KA, l, loc_ >> 1, loc_ & 1); TEND(11); }
                else if (ty_ == 1) { TSTART(12); mlstm_local_item(fresh(F), KA, l, loc_ >> 2, loc_ & 3); TEND(12); }
                else if (ty_ == 2) { TSTART(13); ret_local_item(fresh(F), KA, l, loc_ >> 2, loc_ & 3); TEND(13); }
                else { TSTART(14); s5_item<0>(fresh(F), KA, l, loc_ >> 2, loc_ & 3); TEND(14); }
            });
        } SEAM(pb + 2); TEND(2);
        TSTART(3); if (IN(pb + 3)) { Frame F = fresh(F0);
            QUEUE_LOOP(F, l * 3 + 1, 768 * PR(4) + 768 * PR(5) + 768 * PR(6), {
                QSPLIT(3, 768, 768, 768, 0, 4);
                if (ty_ == 0) { TSTART(15); carry_unit<true>(fresh(F), KA, l, loc_); TEND(15); }
                else if (ty_ == 1) { TSTART(16); s5_item<1>(fresh(F), KA, l, loc_ >> 2, loc_ & 3); TEND(16); }
                else { TSTART(17); carry_ctx_batch(fresh(F), KA, l, 768 + loc_ * 8); TEND(17); }
            });
        } SEAM(pb + 3); TEND(3);
        TSTART(4); if (IN(pb + 4)) { Frame F = fresh(F0);
            QUEUE_LOOP(F, l * 3 + 2, 192 * PR(7) + 192 * PR(8) + 768 * PR(9) + 768 * PR(10), {
                QSPLIT(4, 192, 192, 768, 768, 7);
                if (ty_ == 0) { TSTART(18); ssd_out_item(fresh(F), KA, l, loc_, dup_ ? WSP(bf16, WS_MLCLOC) : WSP(bf16, WS_Y)); TEND(18); }
                else if (ty_ == 1) { TSTART(19); Frame Fg = fresh(F);
                    pg8::Gemm g{WSP(const pg8::bf16_t, WS_YA), WSP(const pg8::bf16_t, WS_WGT) + (size_t)l * GWID * GWID, M, GWID, GWID}; OneUnit S; S.u.pm = loc_ >> 1; S.u.pn = loc_ & 1;
                    epi::EpiGlu E{WSP(const pg8::bf16_t, WS_YA), WSP(pg8::bf16_t, WS_Y)};
                    pg8::gemm_phase<epi::EpiGlu, OneUnit, false, true>(Fg.lds, g, S, E, Fg.tid); __syncthreads(); TEND(19); }
                else if (ty_ == 2) { TSTART(20); mlstm_out_item(fresh(F), KA, l, loc_ >> 2, loc_ & 3); TEND(20); }
                else { TSTART(21); ret_out_item(fresh(F), KA, l, loc_ >> 2, loc_ & 3); TEND(21); }
            });
        } SEAM(pb + 4); TEND(4);
        TSTART(5); if (IN(pb + 5)) { Frame F = fresh(F0);
            pg8::Gemm g{WSP(const pg8::bf16_t, WS_Y), WSP(const pg8::bf16_t, WS_WOT) + (size_t)l * D * D, M, D, D}; XCC_ORDER(S, M, D);
            if (XSTG > 0 && S.mode) { const unsigned long long t0_ = __builtin_amdgcn_s_memrealtime(), w_ = (unsigned long long)(S.x * XSTG); while (__builtin_amdgcn_s_memrealtime() - t0_ < w_) __builtin_amdgcn_s_sleep(8); }
            KArgs& A_ = KA; epi::EpiRes E{(const float*)(const GAS float*)A_.in[I_XP], (const float*)(const GAS float*)A_.in[I_XS], WSP(pg8::bf16_t, WS_XB), WSP(const float, WS_MOD) + (size_t)(l * 5) * (6 * D) + 2 * D, l == 0 ? 1 : 0,
                          1, WSP(pg8::bf16_t, WS_H), WSP(float, WS_SSQA), (const float*)(const GAS float*)A_.in[I_NORM2] + (size_t)l * D, WSP(const float, WS_MOD) + (size_t)(l * 5) * (6 * D) + 4 * D, F.lds + 131072};
            pg8::gemm_phase<epi::EpiRes, pg8::XccOrder, true, true>(F.lds, g, S, E, F.tid);
        } CSEAM(pb + 5); TEND(5);
        TSTART(7); if (IN(pb + 7)) for (int rep_ = 0; rep_ < (PROBE_REPEAT == 7 ? 2 : 1); ++rep_) { Frame F = fresh(F0);
            pg8::Gemm g{WSP(const pg8::bf16_t, WS_H), WSP(const pg8::bf16_t, WS_WM1T) + (size_t)l * DFF * D, M, DFF, D}; XCC_ORDER(S, M, DFF);
            epi::EpiRelu2 E{WSP(pg8::bf16_t, WS_HID), WSP(const float, WS_SSQA), WSP(const float, WS_SHW2) + (size_t)l * 5 * DFF};
            pg8::gemm_phase<epi::EpiRelu2, pg8::XccOrder, true, true>(F.lds, g, S, E, F.tid);
        } CSEAM(pb + 7); TEND(7);
        TSTART(8); if (IN(pb + 8)) { Frame F = fresh(F0);
            pg8::Gemm g{WSP(const pg8::bf16_t, WS_HID), WSP(const pg8::bf16_t, WS_WM2T) + (size_t)l * D * DFF, M, D, DFF}; XCC_ORDER(S, M, D);
            KArgs& A_ = KA; epi::EpiRes E{(const float*)(const GAS float*)A_.in[I_XP], (const float*)(const GAS float*)A_.in[I_XS], WSP(pg8::bf16_t, WS_XB), WSP(const float, WS_MOD) + (size_t)(l * 5) * (6 * D) + 5 * D, 0,
                          l < NLAYER - 1 ? 1 : 0, WSP(pg8::bf16_t, WS_H), WSP(float, WS_SSQB), (const float*)(const GAS float*)A_.in[I_NORM1] + (size_t)(l + 1) * D, WSP(const float, WS_MOD) + (size_t)((l + 1) * 5) * (6 * D) + 1 * D, F.lds + 131072};
            pg8::gemm_phase<epi::EpiRes, pg8::XccOrder, true, true>(F.lds, g, S, E, F.tid);
        } SEAM(pb + 8); TEND(8);
    }
    if (IN(N_PHASES - 1)) { Frame F = fresh(F0); final_norm_phase(F, KA); }
    if (PROBE_IMASK != 0 && F0.bid == 0 && F0.wave == 0 && lane_id() == 0) { const unsigned long long acc_ = ((volatile LAS unsigned long long*)(F0.lds + MISC_OFF + 128))[1], te_ = __builtin_amdgcn_s_memrealtime();
        while (__builtin_amdgcn_s_memrealtime() - te_ < (unsigned long long)PROBE_TAMP * acc_) __builtin_amdgcn_s_sleep(32); }
    if (PROBE_TMASK != 0 && F0.bid == 0) { const unsigned long long te_ = __builtin_amdgcn_s_memrealtime(); while (__builtin_amdgcn_s_memrealtime() - te_ < (unsigned long long)PROBE_TAMP * ptacc_) __builtin_amdgcn_s_sleep(32); }
#undef IN
#undef SEAM
}

#ifndef MK_LAUNCH_PER_PHASE
#define MK_LAUNCH_PER_PHASE 0
#endif
extern "C" void kernel_launch(void* const* d_in, const int* in_sizes, int n_in, void* d_out, int out_size, void* d_ws, size_t ws_size, hipStream_t stream) {
    static int grid = 0;
    if (grid == 0) {
        if (n_in != N_IN || (size_t)out_size != O_END || ws_size < WS_END) { fprintf(stderr, "kernel_launch: shape mismatch: n_in %d out %d ws %zu (need %zu)\n", n_in, out_size, ws_size, (size_t)WS_END); grid = -1; return; }
        int dev = 0, cus = 0, per_cu = 0;
        if (hipGetDevice(&dev) != hipSuccess || hipDeviceGetAttribute(&cus, hipDeviceAttributeMultiprocessorCount, dev) != hipSuccess) { grid = -1; return; }
        if (hipFuncSetAttribute((const void*)hymba_fwd, hipFuncAttributeMaxDynamicSharedMemorySize, LDS_BYTES) != hipSuccess) { fprintf(stderr, "kernel_launch: hipFuncSetAttribute failed\n"); grid = -1; return; }
        if (hipOccupancyMaxActiveBlocksPerMultiprocessor(&per_cu, (const void*)hymba_fwd, NT, LDS_BYTES) != hipSuccess || per_cu < 1) fprintf(stderr, "kernel_launch: occupancy query says %d\n", per_cu);
        (void)hipGetLastError();
        grid = cus;
    }
    if (grid < 0) return;
    (void)hipMemsetAsync((char*)d_ws + WS_CTL, 0, CTL_ZERO_BYTES, stream);
    Args a{};
    for (int i = 0; i < N_IN; ++i) a.in[i] = (const float*)d_in[i];
    a.out = (float*)d_out; a.ws = (unsigned char*)d_ws;
#if MK_LAUNCH_PER_PHASE
    for (int p = 0; p < N_PHASES; ++p) { a.ph_lo = p; a.ph_hi = p + 1; hipLaunchKernelGGL(hymba_fwd, dim3(grid), dim3(NT), LDS_BYTES, stream, a); }
#else
    a.ph_lo = 0; a.ph_hi = N_PHASES;
    hipLaunchKernelGGL(hymba_fwd, dim3(grid), dim3(NT), LDS_BYTES, stream, a);
#endif
    const hipError_t le = hipPeekAtLastError();
    if (le != hipSuccess) fprintf(stderr, "kernel_launch: launch failed: %s\n", hipGetErrorName(le));
}
```

```cpp
#include <hip/hip_runtime.h>
#include <cstdio>
#include <cstdint>
namespace pg8 {
#define PG8_LAS __attribute__((address_space(3)))
typedef unsigned short bf16_t;
typedef short bf16x8 __attribute__((ext_vector_type(8)));
typedef float f32x4 __attribute__((ext_vector_type(4)));
typedef unsigned u32x4 __attribute__((ext_vector_type(4)));
constexpr int BM = 256, BK = 64, HALF = 128, HTB = HALF * BK * 2  , STAGE_BYTES = 8 * HTB, NXCD = 8, WGM = 8;

__host__ __device__ __forceinline__ int lds_byte(int r, int c) { const int st = (r >> 4) * 2 + (c >> 5), rr = r & 15, cc = c & 31, ob = rr * 64 + cc * 2; return st * 1024 + (ob ^ (((ob >> 9) & 1) << 5)); }
__host__ __device__ __forceinline__ void stage_rc(int b, int& R, int& C) { const int st = b / 1024, sb = b % 1024, swz = sb ^ (((sb >> 9) & 1) << 5); R = (st >> 1) * 16 + swz / 64; C = (st & 1) * 32 + (swz % 64) / 2; }
__host__ __device__ __forceinline__ int perm32(int rho) { const int n = rho >> 4, i = rho & 15; return 8 * (i >> 2) + 4 * n + (i & 3); }

struct Unit { int pm, pn; };
struct Gemm { const bf16_t* A; const bf16_t* Bt; int M, N, K; };

struct StaticOrder {
    int nM, nN, nwg, G, c;
    __host__ __device__ void init(int M, int N, int G_, int c_) { nM = M / BM; nN = N / BM; nwg = nM * nN; G = G_; c = c_; }
    __host__ __device__ bool next(int i, Unit& u) const {
        const long L = (long)i * G + c; if (L >= nwg) return false;
        int wgid = (int)L; { const int q = nwg / NXCD, r = nwg % NXCD, xcd = wgid % NXCD, off = wgid / NXCD; wgid = (xcd < r ? xcd * (q + 1) : r * (q + 1) + (xcd - r) * q) + off; }
        const int nig = WGM * nN, gid = wgid / nig, fm = gid * WGM, gsz = (nM - fm) < WGM ? (nM - fm) : WGM;
        u.pm = fm + ((wgid % nig) % gsz); u.pn = (wgid % nig) / gsz; return true;
    }
    __device__ __forceinline__ void a_ready(const Unit&) const {}
    __device__ __forceinline__ void done(const Unit&) const {}
};

struct XccOrder {
    StaticOrder so; int mode, x, j, nN;
    __host__ __device__ void init(int M, int N, int G_, int c_, int mode_, int x_, int j_) { so.init(M, N, G_, c_); mode = mode_; x = x_; j = j_; nN = N / BM; }
    __host__ __device__ bool next(int i, Unit& u) const {
        if (!mode) return so.next(i, u);
        const int w = i * 32 + j; if (w >= 12 * nN) return false;
        const int q4 = 4 * nN, pg = w / q4, r = w - pg * q4;
        u.pm = 12 * x + 4 * pg + (r & 3); u.pn = r >> 2; return true;
    }
    __device__ __forceinline__ void a_ready(const Unit&) const {}
    __device__ __forceinline__ void done(const Unit&) const {}
};

__device__ __forceinline__ unsigned cvt_pk_bf16(float lo, float hi) { unsigned r; asm volatile("v_cvt_pk_bf16_f32 %0, %1, %2" : "=v"(r) : "v"(lo), "v"(hi)); return r; }
typedef float f32x2 __attribute__((ext_vector_type(2)));
#ifndef PROBE_KLOOP
#define PROBE_KLOOP 0
#endif
template <class Epi, class Sched, bool ALIGN_EPI = false, bool SP2 = false>
__device__ __forceinline__ void gemm_phase(PG8_LAS unsigned char* lds, const Gemm g, const Sched& S, const Epi& E, int tid_in) {
    int tid_ = tid_in; asm volatile("" : "+v"(tid_));
    const int tid = tid_, wid = __builtin_amdgcn_readfirstlane(tid >> 6), lane = tid & 63, wr = wid >> 2, wc = wid & 3, fr = lane & 15, fq = lane >> 4;
    const int K = g.K, nt = K / BK;
    unsigned voffA[2], voffB[2];
#pragma unroll
    for (int i = 0; i < 2; ++i) { int R, C; stage_rc(tid * 16 + i * 8192, R, C); const int Rb = Epi::PERM ? ((R & ~31) + perm32(R & 31)) : R;
        voffA[i] = (unsigned)(R * K + C) * 2u; voffB[i] = (unsigned)(Rb * K + C) * 2u; }
    const size_t kstep = (size_t)(BK * 2);
    const size_t hstep = (size_t)HALF * K * 2;
    const size_t tstep = 2 * hstep;
    const unsigned ldsw = (unsigned)wid * 1024u;
    const int aoff = lds_byte(wr * 64 + fr, fq * 8), boff = lds_byte(wc * 32 + fr, fq * 8);
#define PG8_SA(b, h) (((b) * 2 + (h)) * HTB)
#define PG8_SB(b, h) ((4 + (b) * 2 + (h)) * HTB)
#define PG8_STAGE(bufoff, gbase, voff) do { _Pragma("unroll") for (int _i = 0; _i < 2; ++_i) \
        __builtin_amdgcn_global_load_lds((const unsigned*)((const char*)(gbase) + (voff)[_i]), (PG8_LAS unsigned*)(lds + (bufoff) + ldsw + _i * 8192), 16, 0, 0); } while (0)
#define PG8_LDA(dst, b, h) do { _Pragma("unroll") for (int m = 0; m < 4; ++m) _Pragma("unroll") for (int k = 0; k < 2; ++k) dst[m][k] = *(const PG8_LAS bf16x8*)(lds + PG8_SA(b, h) + aoff + m * 2048 + k * 1024); } while (0)
#define PG8_LDB(dst, b, h) do { _Pragma("unroll") for (int n = 0; n < 2; ++n) _Pragma("unroll") for (int k = 0; k < 2; ++k) dst[n][k] = *(const PG8_LAS bf16x8*)(lds + PG8_SB(b, h) + boff + n * 2048 + k * 1024); } while (0)
#define PG8_MMA(ai, bj, At, Bt) do { __builtin_amdgcn_s_setprio(1); _Pragma("unroll") for (int m = 0; m < 4; ++m) _Pragma("unroll") for (int n = 0; n < 2; ++n) _Pragma("unroll") for (int k = 0; k < 2; ++k) \
        acc[ai][bj][m][n] = __builtin_amdgcn_mfma_f32_16x16x32_bf16(Bt[n][k], At[m][k], acc[ai][bj][m][n], 0, 0, 0); __builtin_amdgcn_s_setprio(0); } while (0)
#define PG8_WAIT_V(n) asm volatile("s_waitcnt vmcnt(" #n ")" ::: "memory")
#define PG8_WAIT_L(n) asm volatile("s_waitcnt lgkmcnt(" #n ")" ::: "memory")
#define PG8_BAR __builtin_amdgcn_s_barrier()
#define PG8_SCHED __builtin_amdgcn_sched_barrier(0)
    Unit cur, nxt; int ui = 0;
    if (!S.next(0, cur)) return;
    f32x4 acc[2][2][4][2];
#pragma unroll
    for (int a = 0; a < 2; ++a)
#pragma unroll
        for (int b = 0; b < 2; ++b)
#pragma unroll
            for (int m = 0; m < 4; ++m)
#pragma unroll
                for (int n = 0; n < 2; ++n) acc[a][b][m][n] = (f32x4){0.f, 0.f, 0.f, 0.f};
    bf16x8 At[4][2], B0[2][2], B1[2][2];
    const char* cA = (const char*)g.A + (size_t)cur.pm * tstep; const char* cB = (const char*)g.Bt + (size_t)cur.pn * tstep;
    S.a_ready(cur);
    if constexpr (SP2) {
        PG8_STAGE(PG8_SB(0, 0), cB, voffB); PG8_STAGE(PG8_SB(0, 1), cB + hstep, voffB); PG8_STAGE(PG8_SA(0, 0), cA, voffA); PG8_STAGE(PG8_SA(0, 1), cA + hstep, voffA);
        if (wr == 1) PG8_BAR;
        PG8_WAIT_V(2); PG8_BAR;
        PG8_STAGE(PG8_SB(1, 0), cB + kstep, voffB); PG8_STAGE(PG8_SA(1, 0), cA + kstep, voffA); PG8_STAGE(PG8_SB(1, 1), cB + hstep + kstep, voffB);
        PG8_WAIT_V(6); PG8_BAR;
    } else {
        PG8_STAGE(PG8_SB(0, 0), cB, voffB); PG8_STAGE(PG8_SA(0, 0), cA, voffA); PG8_STAGE(PG8_SB(0, 1), cB + hstep, voffB); PG8_STAGE(PG8_SA(0, 1), cA + hstep, voffA);
        if (wr == 1) PG8_BAR;
        PG8_WAIT_V(4); PG8_BAR;
        PG8_STAGE(PG8_SB(1, 0), cB + kstep, voffB); PG8_STAGE(PG8_SA(1, 0), cA + kstep, voffA); PG8_STAGE(PG8_SB(1, 1), cB + hstep + kstep, voffB);
        PG8_WAIT_V(6); PG8_BAR;
    }
    for (;;) {
        const bool has_next = S.next(ui + 1, nxt);
        const char* nA = has_next ? (const char*)g.A + (size_t)nxt.pm * tstep : cA; const char* nB = has_next ? (const char*)g.Bt + (size_t)nxt.pn * tstep : cB;
        for (int t = 0; t < nt; t += 2) {
            const bool last = (t == nt - 2);
            const char* a1 = cA + (size_t)(t + 1) * kstep;
            const char* a2 = last ? nA : cA + (size_t)(t + 2) * kstep; const char* b2 = last ? nB : cB + (size_t)(t + 2) * kstep;
            const char* a3 = a2 + kstep; const char* b3 = b2 + kstep;
            if (last && has_next) S.a_ready(nxt);
#if PROBE_KLOOP == 1
            if (blockIdx.x == 0 && tid == 0) { volatile PG8_LAS unsigned long long* p_ = (volatile PG8_LAS unsigned long long*)(lds + 163584 + 128);
                if (t == 4) p_[0] = __builtin_amdgcn_s_memrealtime(); if (t == nt - 4) p_[1] += __builtin_amdgcn_s_memrealtime() - p_[0]; }
#elif PROBE_KLOOP == 2
            if (blockIdx.x == 0 && tid == 0 && g.N == PROBE_SELN && g.K == PROBE_SELK) { volatile PG8_LAS unsigned long long* p_ = (volatile PG8_LAS unsigned long long*)(lds + 163584 + 128);
                if (t == 4 && ui > 0) p_[1] += __builtin_amdgcn_s_memrealtime() - p_[0]; if (t == nt - 4) p_[0] = __builtin_amdgcn_s_memrealtime(); }
#endif
            if constexpr (SP2) {
            PG8_LDB(B0, 0, 0); PG8_LDB(B1, 0, 1); PG8_SCHED; PG8_LDA(At, 0, 0); PG8_STAGE(PG8_SA(1, 1), a1 + hstep, voffA);
            PG8_WAIT_V(8); PG8_WAIT_L(0); PG8_BAR; PG8_MMA(0, 0, At, B0); PG8_MMA(0, 1, At, B1); PG8_BAR; PG8_SCHED;
            PG8_LDA(At, 0, 1); PG8_STAGE(PG8_SB(0, 0), b2, voffB); PG8_STAGE(PG8_SB(0, 1), b2 + hstep, voffB); PG8_STAGE(PG8_SA(0, 0), a2, voffA);
            PG8_WAIT_V(8); PG8_WAIT_L(0); PG8_BAR; PG8_MMA(1, 0, At, B0); PG8_MMA(1, 1, At, B1); PG8_BAR; PG8_SCHED;
            PG8_LDB(B0, 1, 0); PG8_LDB(B1, 1, 1); PG8_SCHED; PG8_LDA(At, 1, 0); PG8_STAGE(PG8_SA(0, 1), a2 + hstep, voffA);
            PG8_WAIT_V(8); PG8_WAIT_L(0); PG8_BAR; PG8_MMA(0, 0, At, B0); PG8_MMA(0, 1, At, B1); PG8_BAR; PG8_SCHED;
            PG8_LDA(At, 1, 1); PG8_STAGE(PG8_SB(1, 0), b3, voffB); PG8_STAGE(PG8_SB(1, 1), b3 + hstep, voffB); PG8_STAGE(PG8_SA(1, 0), a3, voffA);
            PG8_WAIT_V(8); PG8_WAIT_L(0); PG8_BAR; PG8_MMA(1, 0, At, B0); PG8_MMA(1, 1, At, B1); PG8_BAR; PG8_SCHED;
            } else {
            PG8_LDB(B0, 0, 0); PG8_SCHED; PG8_LDA(At, 0, 0); PG8_STAGE(PG8_SA(1, 1), a1 + hstep, voffA);
            PG8_WAIT_L(8); PG8_BAR; PG8_WAIT_L(0); PG8_MMA(0, 0, At, B0); PG8_BAR; PG8_SCHED;
            PG8_LDB(B1, 0, 1); PG8_STAGE(PG8_SB(0, 0), b2, voffB);
            PG8_BAR; PG8_WAIT_L(0); PG8_MMA(0, 1, At, B1); PG8_BAR;
            PG8_LDA(At, 0, 1); PG8_STAGE(PG8_SA(0, 0), a2, voffA);
            PG8_BAR; PG8_WAIT_L(0); PG8_MMA(1, 0, At, B0); PG8_BAR; PG8_SCHED;
            PG8_STAGE(PG8_SB(0, 1), b2 + hstep, voffB);
            PG8_WAIT_V(6); PG8_BAR; PG8_MMA(1, 1, At, B1); PG8_BAR;
            PG8_LDB(B0, 1, 0); PG8_SCHED; PG8_LDA(At, 1, 0); PG8_STAGE(PG8_SA(0, 1), a2 + hstep, voffA);
            PG8_WAIT_L(8); PG8_BAR; PG8_WAIT_L(0); PG8_MMA(0, 0, At, B0); PG8_BAR; PG8_SCHED;
            PG8_LDB(B1, 1, 1); PG8_STAGE(PG8_SB(1, 0), b3, voffB);
            PG8_BAR; PG8_WAIT_L(0); PG8_MMA(0, 1, At, B1); PG8_BAR;
            PG8_LDA(At, 1, 1); PG8_STAGE(PG8_SA(1, 0), a3, voffA);
            PG8_BAR; PG8_WAIT_L(0); PG8_MMA(1, 0, At, B0); PG8_BAR; PG8_SCHED;
            PG8_STAGE(PG8_SB(1, 1), b3 + hstep, voffB);
            PG8_WAIT_V(6); PG8_BAR; PG8_MMA(1, 1, At, B1); PG8_BAR;
            }
        }
        if constexpr (ALIGN_EPI) { if (wr == 0) PG8_BAR; }
        if constexpr (!Epi::AFTER_DRAIN) { E(acc, cur, wr, wc, fr, fq); S.done(cur); }
        if (!has_next) break;
#pragma unroll
        for (int a = 0; a < 2; ++a)
#pragma unroll
            for (int b = 0; b < 2; ++b)
#pragma unroll
                for (int m = 0; m < 4; ++m)
#pragma unroll
                    for (int n = 0; n < 2; ++n) acc[a][b][m][n] = (f32x4){0.f, 0.f, 0.f, 0.f};
        cur = nxt; cA = nA; cB = nB; ++ui;
        if constexpr (ALIGN_EPI) { if (wr == 1) PG8_BAR; }
    }
    PG8_WAIT_V(0);
    if constexpr (!ALIGN_EPI) { if (wr == 0) PG8_BAR; }
    PG8_BAR;
    if constexpr (Epi::AFTER_DRAIN) { E.fused(acc, cur, wr, wc, fr, fq, lds, wid, lane); S.done(cur); }
#undef PG8_SA
#undef PG8_SB
#undef PG8_STAGE
#undef PG8_LDA
#undef PG8_LDB
#undef PG8_MMA
#undef PG8_WAIT_V
#undef PG8_WAIT_L
#undef PG8_BAR
#undef PG8_SCHED
}
}
#define GAS __attribute__((address_space(1)))
#define LAS __attribute__((address_space(3)))
typedef unsigned short bf16;
typedef unsigned v4u __attribute__((ext_vector_type(4)));
typedef float f32x4 __attribute__((ext_vector_type(4)));
typedef short bf16x8 __attribute__((ext_vector_type(8)));
typedef GAS unsigned gu32;
typedef GAS unsigned long long gu64;
#define RLX_AGENT __ATOMIC_RELAXED, __HIP_MEMORY_SCOPE_AGENT
#define LDS_WAIT() asm volatile("s_waitcnt lgkmcnt(0)" ::: "memory")
#define VM_WAIT() asm volatile("s_waitcnt vmcnt(0)" ::: "memory")
__device__ __forceinline__ unsigned long long rt() { return __builtin_amdgcn_s_memrealtime(); }
typedef __bf16 hwbf16x2_t __attribute__((ext_vector_type(2)));
typedef float hwf32x2_t __attribute__((ext_vector_type(2)));
__device__ __forceinline__ unsigned pk2(float lo, float hi) { const hwf32x2_t v = {lo, hi}; const hwbf16x2_t b = __builtin_convertvector(v, hwbf16x2_t); return __builtin_bit_cast(unsigned, b); }
__device__ __forceinline__ unsigned f2bf(float f) { return pk2(f, 0.f) & 0xffffu; }
#define XB_TMO      128
#define XB_XCNT(j)  (256  + 64 * (j))
#define XB_XSUB(j)  (1280 + 64 * (j))
#define XB_XGEN(j)  (2304 + 64 * (j))
#define XB_TOP      3328
#define XB_TOPGEN   3392
#define XCD_BAR_WORDS 3456
#define XB_LSUB(j)  (3456 + 64 * (j))
#define XB_SPIN_CAP (1u << 18)

__device__ __forceinline__ unsigned xb_ld(unsigned* p)              { return __hip_atomic_load(p, __ATOMIC_RELAXED, __HIP_MEMORY_SCOPE_AGENT); }
__device__ __forceinline__ unsigned xb_add(unsigned* p, unsigned v) { return __hip_atomic_fetch_add(p, v, __ATOMIC_RELAXED, __HIP_MEMORY_SCOPE_AGENT); }
__device__ __forceinline__ unsigned xb_xcc_id() { return (unsigned)__builtin_amdgcn_s_getreg((3 << 11) | 20) & 0xFu; }
#define XB_SPIN(cond, bar) do { unsigned _sp = 0; while (cond) { __builtin_amdgcn_s_sleep(1); \
    if ((++_sp & 255u) == 0u) { if (xb_ld(&(bar)[XB_TMO])) break; if (_sp > XB_SPIN_CAP) { atomicAdd(&(bar)[XB_TMO], 1u); break; } } } } while (0)

struct XcdBarrier {
    unsigned wave0;
    unsigned* bar; unsigned x;
    volatile LAS unsigned* st;
};

__device__ __forceinline__ bool xb_lane0() { return __builtin_amdgcn_mbcnt_hi(~0u, __builtin_amdgcn_mbcnt_lo(~0u, 0u)) == 0u; }
__device__ __forceinline__ XcdBarrier xcd_barrier_post(unsigned* bar, volatile LAS unsigned* st, unsigned wave0) {
    XcdBarrier b; b.wave0 = wave0; b.bar = bar; b.x = xb_xcc_id(); b.st = st;
    if (wave0 && xb_lane0()) st[2] = xb_add(&bar[XB_XCNT(b.x)], 1u);
    return b;
}
__device__ __forceinline__ void xcd_barrier_complete(unsigned* bar, unsigned x, unsigned& nloc, unsigned& nx, unsigned& even) {
    const unsigned G = gridDim.x * gridDim.y * gridDim.z;
    unsigned sum, cnt, mine, bad, sp = 0u;
    for (;;) {
        sum = 0u; cnt = 0u; mine = 0u; bad = 0u;
#pragma unroll
        for (unsigned j = 0; j < 16; ++j) { const unsigned c = xb_ld(&bar[XB_XCNT(j)]); sum += c; cnt += (c > 0u) ? 1u : 0u; mine = (j == x) ? c : mine; bad |= (c != (j < 8u ? 32u : 0u)) ? 1u : 0u; }
        if (sum == G) break;
        __builtin_amdgcn_s_sleep(1);
        if ((++sp & 255u) == 0u) { if (xb_ld(&bar[XB_TMO])) break; if (sp > XB_SPIN_CAP) { atomicAdd(&bar[XB_TMO], 1u); break; } }
    }
    nloc = mine > 0u ? mine : 1u; nx = cnt > 0u ? cnt : 1u; even = (sum == G && G == 256u && bad == 0u) ? 2u : 1u;
}

__device__ __forceinline__ void xcd_barrier(const XcdBarrier& b) {
    asm volatile("s_waitcnt vmcnt(0)" ::: "memory");
    __syncthreads();
    if (b.wave0 && xb_lane0()) {
        unsigned* bar = b.bar;
        __builtin_amdgcn_s_waitcnt(0);
        unsigned nloc = b.st[0], nx = b.st[1];
        if (nloc == 0u) { unsigned ev; xcd_barrier_complete(bar, b.x, nloc, nx, ev); b.st[0] = nloc; b.st[1] = nx; b.st[3] = ev; }
        const unsigned old = xb_add(&bar[XB_XSUB(b.x)], 1u);
        const unsigned gen = old / nloc;
        if (old + 1u == (gen + 1u) * nloc) {
            __builtin_amdgcn_fence(__ATOMIC_RELEASE, "agent");
            asm volatile("s_waitcnt vmcnt(0)" ::: "memory");
            const unsigned og = xb_add(&bar[XB_TOP], 1u);
            const unsigned tg = og / nx;
            if (og + 1u == (tg + 1u) * nx) xb_add(&bar[XB_TOPGEN], 1u);
            else XB_SPIN(xb_ld(&bar[XB_TOPGEN]) == tg, bar);
            __builtin_amdgcn_fence(__ATOMIC_ACQUIRE, "agent");
            xb_add(&bar[XB_XGEN(b.x)], 1u);
            asm volatile("s_waitcnt vmcnt(0)" ::: "memory");
        } else {
            XB_SPIN(xb_ld(&bar[XB_XGEN(b.x)]) == gen, bar);
            __builtin_amdgcn_fence(__ATOMIC_ACQUIRE, "agent");
            asm volatile("s_waitcnt vmcnt(0)" ::: "memory");
        }
    }
    __syncthreads();
}

__device__ __forceinline__ void xcc_barrier(const XcdBarrier& b) {
    asm volatile("s_waitcnt vmcnt(0)" ::: "memory");
    __syncthreads();
    if (b.wave0 && xb_lane0()) {
        unsigned* bar = b.bar;
        __builtin_amdgcn_s_waitcnt(0);
        const unsigned nloc = b.st[0];
        const unsigned old = xb_add(&bar[XB_LSUB(b.x)], 1u);
        const unsigned target = (old / nloc + 1u) * nloc;
        XB_SPIN(xb_ld(&bar[XB_LSUB(b.x)]) < target, bar);
        __builtin_amdgcn_fence(__ATOMIC_ACQUIRE, "agent");
        asm volatile("s_waitcnt vmcnt(0)" ::: "memory");
    }
    __syncthreads();
}
constexpr int NWAVES = 8, NT = 512;
constexpr int D = 2048, NLAYER = 4;
constexpr int MC = 32 * 256, ML = 4 * 4096, M = MC + ML;
constexpr int DIN = 6176, NPROJ = 6144, NPAD = 6400, DFF = 8192, GWID = 512;
constexpr int NCP = M / 128;
constexpr float EPS = 1e-6f;
constexpr int PC_S5U = 0, PC_MQ = 512, PC_MK = 1024, PC_MV = 1536, PC_MO = 2048, PC_RQ = 2560, PC_RK = 3072, PC_RV = 3584, PC_RG = 4096, PC_DZ = 4608, PC_DX = 5120, PC_DB = 5632, PC_DC = 5888;
enum { I_XP = 0, I_XS, I_C, I_SS5R, I_SS5I, I_SMC, I_SMN, I_SMM, I_SRET, I_SSSD, I_CCTX, I_NORM1, I_WADA, I_BADA, I_WIN, I_S5LR, I_S5LI, I_S5DT, I_S5BR, I_S5BI, I_S5CR, I_S5CI, I_S5D, I_S5GLU,
       I_MIB, I_MFB, I_MNORM, I_RRATE, I_RNORM, I_CONVW, I_CONVB, I_DTB, I_ALOG, I_SSDD, I_SNORM, I_WOUT, I_NORM2, I_WM1, I_WM2, I_FNORM, N_IN };
constexpr size_t O_YP = 0, O_YS = (size_t)MC * D, O_S5R = (size_t)M * D, O_S5I = O_S5R + 524288, O_MC = O_S5I + 524288, O_MN = O_MC + 16777216, O_MM = O_MN + 131072, O_RET = O_MM + 1024, O_SSD = O_RET + 16777216, O_END = O_SSD + 16777216;

constexpr size_t MiB = 1u << 20;
constexpr size_t WS_CTL = 0, CTL_ZERO_BYTES = 1 * MiB;
constexpr size_t WS_MOD = 1 * MiB;
constexpr size_t WS_S5T = 2 * MiB;
constexpr size_t WS_ROPE = 5 * MiB;
constexpr size_t WS_GATES = 6 * MiB;
constexpr size_t WS_MLNLOC = 9 * MiB;
constexpr size_t WS_MLNIN = 10 * MiB;
constexpr size_t WS_MLSC = 11 * MiB;
constexpr size_t WS_MLMIN = 11 * MiB + 65536;
constexpr size_t WS_SDSC = 11 * MiB + 131072;
constexpr size_t WS_SSQA = 5 * MiB + 65536;
constexpr size_t WS_SSQB = 11 * MiB + 262144;
constexpr size_t WS_SHW1 = 18 * MiB;
constexpr size_t WS_SHW2 = 19 * MiB;
constexpr size_t WS_S5LOC = 12 * MiB;
constexpr size_t WS_WGT = 20 * MiB;
constexpr size_t WS_W1T = 22 * MiB;
constexpr size_t WS_WOT = 122 * MiB;
constexpr size_t WS_WM1T = 154 * MiB;
constexpr size_t WS_WM2T = 282 * MiB;
constexpr size_t WS_H = 410 * MiB;
constexpr size_t WS_Y = 506 * MiB;
constexpr size_t WS_YA = 602 * MiB;
constexpr size_t WS_MLCIN = 626 * MiB;
constexpr size_t WS_RTIN = 674 * MiB;
constexpr size_t WS_SDIN = 722 * MiB;
constexpr size_t WS_PROJ = 770 * MiB;
constexpr size_t WS_MLCLOC = 1058 * MiB;
constexpr size_t WS_HID = 770 * MiB;
constexpr size_t WS_RTLOC = 1106 * MiB;
constexpr size_t WS_SDLOC = 1154 * MiB;
constexpr size_t WS_XBCC = 1202 * MiB;
constexpr size_t WS_XB = 1250 * MiB;
constexpr size_t WS_END = 1346 * MiB;
constexpr int CW_TMO = 0, CW_BAR = 4096;

constexpr int LDT = 272;
constexpr int TS = 128 * LDT;
constexpr int LDX = 144;
constexpr int TSX = 128 * LDX;
constexpr int SCAL_OFF = 4 * TS;
constexpr int MISC_OFF = 163840 - 256;
constexpr int LDS_BYTES = 163840;
#define SCA(i) ((LAS float*)(F.lds + SCAL_OFF + (i) * 512))
typedef float f32x16 __attribute__((ext_vector_type(16)));
typedef float f32x2 __attribute__((ext_vector_type(2)));
typedef short s16x4 __attribute__((ext_vector_type(4)));
typedef unsigned u32x2 __attribute__((ext_vector_type(2)));
struct Args { const float* in[N_IN]; float* out; unsigned char* ws; int ph_lo, ph_hi; };
struct Frame {
    LAS unsigned char* lds;
    float* out; unsigned char* ws;
    int tid, lane, wave, G, bid;
};
__device__ __forceinline__ int lane_id() { return (int)__builtin_amdgcn_mbcnt_hi(~0u, __builtin_amdgcn_mbcnt_lo(~0u, 0u)); }
typedef const __attribute__((address_space(4))) Args KArgs;
__device__ __forceinline__ KArgs* kargs() { KArgs* p = (KArgs*)__builtin_amdgcn_kernarg_segment_ptr(); asm volatile("" : "+s"(p)); return p; }
__device__ __forceinline__ Frame fresh(const Frame& F) { Frame R = F; unsigned long long l = (unsigned long long)(size_t)R.lds; unsigned ll = (unsigned)l; asm volatile("" : "+s"(ll), "+s"(R.wave), "+s"(R.G), "+s"(R.bid)); R.lane = lane_id(); asm volatile("" : "+v"(R.lane)); R.tid = R.wave * 64 + R.lane; R.lds = (LAS unsigned char*)(size_t)ll; KArgs* ka = kargs(); R.out = (float*)(GAS float*)ka->out; R.ws = (unsigned char*)(GAS unsigned char*)ka->ws; return R; }
#define INP(i) ((const float*)(const GAS float*)(A.in[i]))
#define BAR() __syncthreads()
#ifndef PROBE_IMASK
#define PROBE_IMASK 0
#endif
#define ITS(k) do { if ((PROBE_IMASK >> (k)) & 1) { if (F.tid == 0 && F.bid == 0) ((volatile LAS unsigned long long*)(F.lds + MISC_OFF + 128))[0] = __builtin_amdgcn_s_memrealtime(); } } while (0)
#define ITE(k) do { if ((PROBE_IMASK >> (k)) & 1) { if (F.tid == 0 && F.bid == 0) { volatile LAS unsigned long long* p_ = (volatile LAS unsigned long long*)(F.lds + MISC_OFF + 128); p_[1] += __builtin_amdgcn_s_memrealtime() - p_[0]; } } } while (0)
#define WSP(T, off) ((T*)(F.ws + (off)))
__device__ __forceinline__ float bf2f(unsigned short b) { return __uint_as_float((unsigned)b << 16); }
__device__ __forceinline__ float bflo(unsigned w) { return __uint_as_float(w << 16); }
__device__ __forceinline__ float bfhi(unsigned w) { return __uint_as_float(w & 0xffff0000u); }
__device__ __forceinline__ void unpack8(const v4u a, float (&x)[8]) { x[0] = bflo(a.x); x[1] = bfhi(a.x); x[2] = bflo(a.y); x[3] = bfhi(a.y); x[4] = bflo(a.z); x[5] = bfhi(a.z); x[6] = bflo(a.w); x[7] = bfhi(a.w); }
__device__ __forceinline__ v4u pack8(const float (&x)[8], float w) { v4u o; o.x = pk2(x[0] * w, x[1] * w); o.y = pk2(x[2] * w, x[3] * w); o.z = pk2(x[4] * w, x[5] * w); o.w = pk2(x[6] * w, x[7] * w); return o; }
__device__ __forceinline__ float sigmoidf_(float x) { return __builtin_amdgcn_rcpf(1.f + __expf(-x)); }
__device__ __forceinline__ float siluf_(float x) { return x * sigmoidf_(x); }
__device__ __forceinline__ float lshfl(float v, int src_lane) { return __builtin_bit_cast(float, __builtin_amdgcn_ds_bpermute(src_lane << 2, __builtin_bit_cast(int, v))); }
__device__ __forceinline__ float lshfl_xor(float v, int m, int lane) { return lshfl(v, lane ^ m); }
__device__ __forceinline__ float lshfl_up(float v, int o, int lane) { return lshfl(v, lane >= o ? lane - o : lane); }
__device__ __forceinline__ float wave_sum(float v) {
#pragma unroll
    for (int o = 1; o < 64; o <<= 1) v += __shfl_xor(v, o);
    return v;
}
__device__ __forceinline__ float wave_max(float v) {
#pragma unroll
    for (int o = 1; o < 64; o <<= 1) v = fmaxf(v, __shfl_xor(v, o));
    return v;
}
__device__ __forceinline__ float wave_sum_l(float v, int lane) {
#pragma unroll
    for (int o = 1; o < 64; o <<= 1) v += lshfl_xor(v, o, lane);
    return v;
}
__device__ __forceinline__ float wave_max_l(float v, int lane) {
#pragma unroll
    for (int o = 1; o < 64; o <<= 1) v = fmaxf(v, lshfl_xor(v, o, lane));
    return v;
}
template <bool MAX> __device__ __forceinline__ void wave_scan128(const LAS float* in, LAS float* out, int lane, bool rev, float init) {
    const int i0 = rev ? 127 - 2 * lane : 2 * lane, i1 = rev ? i0 - 1 : i0 + 1;
    float e0 = in[i0], e1 = in[i1];
    if (lane == 0) e0 = MAX ? fmaxf(e0, init) : e0 + init;
    float inc = MAX ? fmaxf(e0, e1) : e0 + e1;
#pragma unroll
    for (int o = 1; o < 64; o <<= 1) { const float t = __shfl_up(inc, o); if (lane >= o) inc = MAX ? fmaxf(inc, t) : inc + t; }
    float exc = __shfl_up(inc, 1);
    const float o0 = (lane == 0) ? e0 : (MAX ? fmaxf(exc, e0) : exc + e0);
    out[i0] = o0; out[i1] = inc;
}
__device__ __forceinline__ s16x4 lds_tr(const LAS unsigned char* p) {
    typedef short v4i16_t __attribute__((ext_vector_type(4)));
    return __builtin_bit_cast(s16x4, __builtin_amdgcn_ds_read_tr16_b64_v4i16((LAS v4i16_t*)p));
}
__device__ __forceinline__ bf16x8 frag_row(const LAS unsigned char* base, int ld, int r0, int k0, int lane) {
    return *(const LAS bf16x8*)(base + (r0 + (lane & 31)) * ld + (k0 + 8 * (lane >> 5)) * 2);
}
__device__ __forceinline__ bf16x8 frag_tr(const LAS unsigned char* base, int ld, int k0, int c0, int lane) {
    const int h = lane >> 5, blk = (lane >> 4) & 1, q = (lane & 15) >> 2, p = lane & 3;
    const LAS unsigned char* a = base + (k0 + 8 * h + q) * ld + (c0 + 16 * blk + 4 * p) * 2;
    const s16x4 lo = lds_tr(a), hi = lds_tr(a + 4 * ld);
    return (bf16x8){lo[0], lo[1], lo[2], lo[3], hi[0], hi[1], hi[2], hi[3]};
}
__device__ __forceinline__ bf16x8 frag_trp(const LAS unsigned char* base, int ld, int k0, int c0, int lane) {
    const int h = lane >> 5, blk = (lane >> 4) & 1, q = (lane & 15) >> 2, p = lane & 3;
    const LAS unsigned char* a = base + (k0 + 4 * h + q) * ld + (c0 + 16 * blk + 4 * p) * 2;
    const s16x4 lo = lds_tr(a), hi = lds_tr(a + 8 * ld);
    return (bf16x8){lo[0], lo[1], lo[2], lo[3], hi[0], hi[1], hi[2], hi[3]};
}
#define MFMA32(a, b, c) __builtin_amdgcn_mfma_f32_32x32x16_bf16((a), (b), (c), 0, 0, 0)
#define ZERO16 ((f32x16){0.f,0.f,0.f,0.f,0.f,0.f,0.f,0.f,0.f,0.f,0.f,0.f,0.f,0.f,0.f,0.f})
__device__ __forceinline__ int crow(int i, int hh) { return (i & 3) + 8 * (i >> 2) + 4 * hh; }

#define PT(cp, col) (WSP(const bf16, WS_PROJ) + ((size_t)(cp) * 48 + ((col) >> 7)) * 16384 + ((col) & 127))
#define XT(cp, ch) (WSP(bf16, WS_XBCC) + ((size_t)(cp) * 8 + ((ch) >> 7)) * 16384 + ((ch) & 127))
__device__ __forceinline__ const float* x_in_row(const Frame& F, KArgs& A, int l, int r) {
    if (l == 0) return r < MC ? INP(I_XP) + (size_t)r * D : INP(I_XS) + (size_t)(r - MC) * D;
    return F.out + (size_t)r * D;
}
__device__ __forceinline__ int mod_row(int r) { return r < MC ? 0 : 1 + (r - MC) / 4096; }
__device__ __forceinline__ const float* mod_ptr(const Frame& F, int l, int mrow, int part) { return WSP(const float, WS_MOD) + ((size_t)(l * 5 + mrow) * 6 + part) * D; }
struct Seq { int cp0, nch, c, b, lat; };
__device__ __forceinline__ Seq seq_of(int cp) { Seq s; if (cp < 64) { s.lat = 0; s.b = cp >> 1; s.cp0 = cp & ~1; s.nch = 2; s.c = cp & 1; } else { s.lat = 1; s.b = (cp - 64) >> 5; s.cp0 = 64 + (s.b << 5); s.nch = 32; s.c = (cp - 64) & 31; } return s; }
__device__ __forceinline__ int w1_newcol(int n) { return n < 2560 ? n : (n < 2576 ? n - 2560 + 6144 : (n < 6160 ? n - 16 : n)); }
template <bool MAPW1> __device__ __forceinline__ void p0_transpose_item(const float* W, int K, int N, bf16* WT, LAS float* scr, int item, int lane) {
    const int nblk = (N + 63) / 64, kb = item / nblk, nb = item % nblk, k0 = 64 * kb, n0 = 64 * nb;
    const int lr = lane >> 4, lc = (lane & 15) * 4; const bool cv = n0 + lc < N;
    f32x4 v[16];
#pragma unroll
    for (int i = 0; i < 16; ++i) v[i] = cv ? *(const f32x4*)(W + (size_t)(k0 + 4 * i + lr) * N + n0 + lc) : (f32x4){0.f, 0.f, 0.f, 0.f};
#pragma unroll
    for (int i = 0; i < 16; ++i) { LAS float* d = scr + (4 * i + lr) * 65 + lc; d[0] = v[i].x; d[1] = v[i].y; d[2] = v[i].z; d[3] = v[i].w; }
    LDS_WAIT(); asm volatile("" ::: "memory");
    const int c = lane & 7;
#pragma unroll
    for (int j = 0; j < 8; ++j) { const int n = (lane >> 3) + 8 * j; const LAS float* s = scr + (8 * c) * 65 + n;
        v4u o; o.x = pk2(s[0 * 65], s[1 * 65]); o.y = pk2(s[2 * 65], s[3 * 65]); o.z = pk2(s[4 * 65], s[5 * 65]); o.w = pk2(s[6 * 65], s[7 * 65]);
        const int nr = MAPW1 ? w1_newcol(n0 + n) : (n0 + n);
        if (n0 + n < N) *(GAS v4u*)(WT + (size_t)nr * K + k0 + 8 * c) = o; }
    LDS_WAIT(); asm volatile("" ::: "memory");
}
constexpr int S5T_STRIDE = 9216;
__device__ __forceinline__ unsigned char* s5tab(const Frame& F, int l, int d, int g) { return F.ws + WS_S5T + (size_t)((l * 2 + d) * 32 + g) * S5T_STRIDE; }

__device__ __forceinline__ void p0_prologue(Frame& F, KArgs& A) {
    {
        LAS float* scr = (LAS float*)(F.lds + F.wave * 16640);
        const int gw = F.bid * NWAVES + F.wave, NGW = F.G * NWAVES;
        constexpr int I_1 = (D / 64) * ((DIN + 63) / 64), I_G = (GWID / 64) * (GWID / 64), I_O = (D / 64) * (D / 64), I_M1 = (D / 64) * (DFF / 64), I_M2 = (DFF / 64) * (D / 64);
        constexpr int PER_L = I_1 + I_G + I_O + I_M1 + I_M2;
        for (int it = gw; it < NLAYER * PER_L; it += NGW) {
            const int l = it / PER_L; int r = it % PER_L;
            if (r < I_1) { p0_transpose_item<true>(INP(I_WIN) + (size_t)l * D * DIN, D, DIN, WSP(bf16, WS_W1T) + (size_t)l * NPAD * D, scr, r, F.lane); continue; } r -= I_1;
            if (r < I_G) { p0_transpose_item<false>(INP(I_S5GLU) + (size_t)l * GWID * GWID, GWID, GWID, WSP(bf16, WS_WGT) + (size_t)l * GWID * GWID, scr, r, F.lane); continue; } r -= I_G;
            if (r < I_O) { p0_transpose_item<false>(INP(I_WOUT) + (size_t)l * D * D, D, D, WSP(bf16, WS_WOT) + (size_t)l * D * D, scr, r, F.lane); continue; } r -= I_O;
            if (r < I_M1) { p0_transpose_item<false>(INP(I_WM1) + (size_t)l * D * DFF, D, DFF, WSP(bf16, WS_WM1T) + (size_t)l * DFF * D, scr, r, F.lane); continue; } r -= I_M1;
            p0_transpose_item<false>(INP(I_WM2) + (size_t)l * DFF * D, DFF, D, WSP(bf16, WS_WM2T) + (size_t)l * D * DFF, scr, r, F.lane);
        }
        const int gt = F.bid * NT + F.tid, NGT = F.G * NT;
        for (int i = gt; i < NLAYER * 224 * 256; i += NGT) { const int l = i / (224 * 256), r = i % (224 * 256);
            *(GAS v4u*)(WSP(bf16, WS_W1T) + ((size_t)l * NPAD + DIN) * D + (size_t)r * 8) = (v4u){0u, 0u, 0u, 0u}; }
        for (int i = gt; i < NLAYER * 2 * 32 * 64; i += NGT) {
            const int p = i & 63, g = (i >> 6) & 31, d = (i >> 11) & 1, l = i >> 12;
            const int ldg = (l * 2 + d) * 32 + g;
            const double lre = INP(I_S5LR)[ldg * 64 + p], lim = INP(I_S5LI)[ldg * 64 + p], dt = exp((double)INP(I_S5DT)[ldg]);
            const double er = exp(lre * dt), br = er * cos(lim * dt), bi = er * sin(lim * dt);
            const double e128 = exp(128.0 * lre * dt), b128r = e128 * cos(128.0 * lim * dt), b128i = e128 * sin(128.0 * lim * dt);
            const double nr = br - 1.0, ni = bi, den = lre * lre + lim * lim;
            const double cr = (nr * lre + ni * lim) / den, ci = (ni * lre - nr * lim) / den;
            unsigned char* tb = s5tab(F, l, d, g);
            float* lam = (float*)tb; lam[2 * p] = (float)br; lam[2 * p + 1] = (float)bi;
            float* l128 = (float*)(tb + 512); l128[2 * p] = (float)b128r; l128[2 * p + 1] = (float)b128i;
            bf16* bb = (bf16*)(tb + 1024); bf16* ct = (bf16*)(tb + 5120);
            for (int c = 0; c < 16; ++c) {
                const double Br = INP(I_S5BR)[(size_t)(ldg * 64 + p) * 16 + c], Bi = INP(I_S5BI)[(size_t)(ldg * 64 + p) * 16 + c];
                bb[(2 * p) * 16 + c] = (bf16)f2bf((float)(cr * Br - ci * Bi));
                bb[(2 * p + 1) * 16 + c] = (bf16)f2bf((float)(cr * Bi + ci * Br));
                ct[c * 128 + 2 * p] = (bf16)f2bf(INP(I_S5CR)[(size_t)(ldg * 16 + c) * 64 + p]);
                ct[c * 128 + 2 * p + 1] = (bf16)f2bf(-INP(I_S5CI)[(size_t)(ldg * 16 + c) * 64 + p]);
            }
        }
        for (int i = gt; i < 64 * 32; i += NGT) { const int pos = i >> 5, k = i & 31; const double f = pow(10000.0, -(double)k / 32.0), a = pos * f;
            WSP(f32x2, WS_ROPE)[i] = (f32x2){(float)cos(a), (float)sin(a)}; }
    }
    __syncthreads();
    {
        LAS float* sc = (LAS float*)F.lds;
        LAS float* red = (LAS float*)(F.lds + 65536);
        for (int i = F.tid; i < 5 * D; i += NT) { const int r = i / D, k = i % D; const float v = r == 0 ? INP(I_CCTX)[k] : INP(I_C)[(r - 1) * D + k]; sc[i] = siluf_(v); }
        __syncthreads();
        for (int it = F.bid; it < NLAYER * 96; it += F.G) {
            const int l = it / 96, c0 = (it % 96) * 128;
            const float* W = INP(I_WADA) + (size_t)l * D * (6 * D);
            float acc[5][4];
#pragma unroll
            for (int r = 0; r < 5; ++r)
#pragma unroll
                for (int j = 0; j < 4; ++j) acc[r][j] = 0.f;
            const int cl = F.lane & 31, kp = F.lane >> 5;
#pragma unroll 4
            for (int kk = 0; kk < 128; ++kk) {
                const int k = F.wave * 256 + 2 * kk + kp;
                const f32x4 w = *(const f32x4*)(W + (size_t)k * (6 * D) + c0 + 4 * cl);
#pragma unroll
                for (int r = 0; r < 5; ++r) { const float s = sc[r * D + k]; acc[r][0] += s * w.x; acc[r][1] += s * w.y; acc[r][2] += s * w.z; acc[r][3] += s * w.w; }
            }
#pragma unroll
            for (int r = 0; r < 5; ++r)
#pragma unroll
                for (int j = 0; j < 4; ++j) { acc[r][j] += __shfl_xor(acc[r][j], 32); }
            if (kp == 0) {
#pragma unroll
                for (int r = 0; r < 5; ++r)
#pragma unroll
                    for (int j = 0; j < 4; ++j) red[(F.wave * 5 + r) * 128 + 4 * cl + j] = acc[r][j];
            }
            __syncthreads();
            for (int i = F.tid; i < 5 * 128; i += NT) { const int r = i >> 7, j = i & 127; float s = 0.f;
#pragma unroll
                for (int w = 0; w < 8; ++w) s += red[(w * 5 + r) * 128 + j];
                WSP(float, WS_MOD)[(size_t)(l * 5 + r) * (6 * D) + c0 + j] = s + INP(I_BADA)[(size_t)l * (6 * D) + c0 + j]; }
            __syncthreads();
        }
    }
}

__device__ __forceinline__ void norm0_phase(Frame& F, KArgs& A) {
    const int gw = F.bid * NWAVES + F.wave, NGW = F.G * NWAVES;
    const float* gain = INP(I_NORM1);
    for (int m = gw; m < M; m += NGW) {
        const float* xr = x_in_row(F, A, 0, m);
        const float* scp = mod_ptr(F, 0, mod_row(m), 1);
        f32x4 v[8]; float s = 0.f;
#pragma unroll
        for (int j = 0; j < 8; ++j) { v[j] = *(const f32x4*)(xr + 4 * F.lane + 256 * j); s += (v[j].x * v[j].x + v[j].y * v[j].y) + (v[j].z * v[j].z + v[j].w * v[j].w); }
        s = wave_sum(s);
        if (F.lane < 8) WSP(float, WS_SSQB)[(size_t)m * 8 + F.lane] = F.lane == 0 ? s : 0.f;
        bf16* orow = WSP(bf16, WS_H) + (size_t)m * D;
#pragma unroll
        for (int j = 0; j < 8; ++j) { const int c = 4 * F.lane + 256 * j;
            const f32x4 g4 = *(const f32x4*)(gain + c), s4 = *(const f32x4*)(scp + c);
            *(u32x2*)(orow + c) = (u32x2){pk2(v[j].x * g4.x * (1.f + s4.x), v[j].y * g4.y * (1.f + s4.y)), pk2(v[j].z * g4.z * (1.f + s4.z), v[j].w * g4.w * (1.f + s4.w))}; }
    }
}
__device__ __forceinline__ void shw_phase(Frame& F) {
    LAS float* red = (LAS float*)F.lds;
    const int hh = F.lane >> 5, r = F.lane & 31, k0 = F.wave * 256;
    constexpr int NB1 = DIN / 32, NB2 = DFF / 32, PER_L = NB1 + NB2;
    for (int task = F.bid; task < NLAYER * PER_L; task += F.G) {
        const int l = task / PER_L, t2 = task % PER_L, which = t2 >= NB1 ? 1 : 0, nb = which ? t2 - NB1 : t2;
        const int NS = which ? DFF : NPAD;
        const bf16* Wt = (which ? WSP(const bf16, WS_WM1T) + (size_t)l * DFF * D : WSP(const bf16, WS_W1T) + (size_t)l * NPAD * D) + (size_t)(32 * nb + r) * D + k0 + 8 * hh;
        const float* sh = WSP(const float, WS_MOD) + ((size_t)(l * 5 + (r < 5 ? r : 0)) * 6 + (which ? 3 : 0)) * D + k0 + 8 * hh;
        bf16x8 bw[16];
#pragma unroll
        for (int ks = 0; ks < 16; ++ks) bw[ks] = *(const bf16x8*)(Wt + 16 * ks);
        f32x16 acc = ZERO16;
#pragma unroll
        for (int ks = 0; ks < 16; ++ks) { v4u a = (v4u){0u, 0u, 0u, 0u};
            if (r < 5) { const f32x4 s0 = *(const f32x4*)(sh + 16 * ks), s1 = *(const f32x4*)(sh + 16 * ks + 4); a = (v4u){pk2(s0.x, s0.y), pk2(s0.z, s0.w), pk2(s1.x, s1.y), pk2(s1.z, s1.w)}; }
            acc = MFMA32(__builtin_bit_cast(bf16x8, a), bw[ks], acc); }
        if (hh == 0) { red[(F.wave * 5 + 0) * 32 + r] = acc[0]; red[(F.wave * 5 + 1) * 32 + r] = acc[1]; red[(F.wave * 5 + 2) * 32 + r] = acc[2]; red[(F.wave * 5 + 3) * 32 + r] = acc[3]; }
        else red[(F.wave * 5 + 4) * 32 + r] = acc[0];
        __syncthreads();
        if (F.tid < 160) { const int row = F.tid >> 5, col = F.tid & 31; float s = 0.f;
#pragma unroll
            for (int w = 0; w < 8; ++w) s += red[(w * 5 + row) * 32 + col];
            (which ? WSP(float, WS_SHW2) + (size_t)l * 5 * DFF : WSP(float, WS_SHW1) + (size_t)l * 5 * NPAD)[(size_t)row * NS + 32 * nb + col] = s; }
        __syncthreads();
    }
}
__device__ __forceinline__ void final_norm_phase(Frame& F, KArgs& A) {
    const int gw = F.bid * NWAVES + F.wave, NGW = F.G * NWAVES;
    const float* gain = INP(I_FNORM);
    for (int m = gw; m < M; m += NGW) {
        const bf16* xr = WSP(const bf16, WS_XB) + (size_t)m * D; float* orow = F.out + (size_t)m * D;
        float v[4][8]; float s = 0.f;
#pragma unroll
        for (int j = 0; j < 4; ++j) { unpack8(*(const v4u*)(xr + 8 * F.lane + 512 * j), v[j]);
#pragma unroll
            for (int k = 0; k < 8; ++k) s += v[j][k] * v[j][k]; }
        const float rstd = rsqrtf(wave_sum(s) * (1.f / D) + EPS);
#pragma unroll
        for (int j = 0; j < 4; ++j) { const int c = 8 * F.lane + 512 * j; const f32x4 g0 = *(const f32x4*)(gain + c), g1 = *(const f32x4*)(gain + c + 4);
            *(f32x4*)(orow + c) = (f32x4){v[j][0] * rstd * g0.x, v[j][1] * rstd * g0.y, v[j][2] * rstd * g0.z, v[j][3] * rstd * g0.w};
            *(f32x4*)(orow + c + 4) = (f32x4){v[j][4] * rstd * g1.x, v[j][5] * rstd * g1.y, v[j][6] * rstd * g1.z, v[j][7] * rstd * g1.w}; }
    }
}

__device__ __forceinline__ void gates_phase(Frame& F, int l) {
    const bf16* XA = WSP(const bf16, WS_H); const bf16* Wg = WSP(const bf16, WS_W1T) + ((size_t)l * NPAD + NPROJ) * D;
    const float* shw = WSP(const float, WS_SHW1) + (size_t)l * 5 * NPAD + NPROJ;
    const int hh = F.lane >> 5, r = F.lane & 31, k0 = F.wave * 256;
    LAS float* red = (LAS float*)F.lds;
    bf16x8 bw[16];
#pragma unroll
    for (int ks = 0; ks < 16; ++ks) bw[ks] = *(const bf16x8*)(Wg + (size_t)r * D + k0 + 16 * ks + 8 * hh);
    for (int rb = F.bid; rb < M / 32; rb += F.G) {
        f32x16 acc = ZERO16;
#pragma unroll
        for (int half = 0; half < 2; ++half) { bf16x8 a[8];
#pragma unroll
            for (int j = 0; j < 8; ++j) a[j] = *(const bf16x8*)(XA + (size_t)(32 * rb + r) * D + k0 + 16 * (8 * half + j) + 8 * hh);
#pragma unroll
            for (int j = 0; j < 8; ++j) acc = MFMA32(a[j], bw[8 * half + j], acc); }
#pragma unroll
        for (int i = 0; i < 16; ++i) red[(F.wave * 32 + crow(i, hh)) * 33 + r] = acc[i];
        BAR();
#pragma unroll
        for (int q = 0; q < 2; ++q) { const int idx = F.tid * 2 + q, row = idx >> 5, col = idx & 31; float s = 0.f;
#pragma unroll
            for (int w = 0; w < 8; ++w) s += red[(w * 32 + row) * 33 + col];
            const int grow = 32 * rb + row; const float* part = WSP(const float, WS_SSQB) + (size_t)grow * 8;
            const float ssq = ((part[0] + part[1]) + (part[2] + part[3])) + ((part[4] + part[5]) + (part[6] + part[7]));
            WSP(float, WS_GATES)[(size_t)grow * 32 + col] = s * rsqrtf(ssq * (1.f / D) + EPS) + shw[(size_t)mod_row(grow) * NPAD + col]; }
        BAR();
    }
}
namespace epi {
__device__ __forceinline__ float rstd_of(const float* part, int r) { const pg8::f32x4 a = *(const pg8::f32x4*)(part + (size_t)r * 8), b = *(const pg8::f32x4*)(part + (size_t)r * 8 + 4);
    return rsqrtf((((a[0] + a[1]) + (a[2] + a[3])) + ((b[0] + b[1]) + (b[2] + b[3]))) * (1.f / D) + EPS); }
using pg8::Unit; using pg8::f32x4; using pg8::u32x4; using pg8::bf16_t; using pg8::cvt_pk_bf16;
constexpr int BMq = 256, HALFq = 128;
struct EpiProj {
    static constexpr bool PERM = true, AFTER_DRAIN = false;
    bf16_t* P; const float* ssq; const float* shw0;
    __device__ __forceinline__ void operator()(const f32x4 (&acc)[2][2][4][2], const Unit& u, int wr, int wc, int fr_, int fq_) const {
        int ln_ = (int)__builtin_amdgcn_mbcnt_hi(~0u, __builtin_amdgcn_mbcnt_lo(~0u, 0u)); asm volatile("" : "+v"(ln_)); const int fr = ln_ & 15, fq = ln_ >> 4; (void)fr_; (void)fq_;
        const int row0 = u.pm * BMq + wr * 64 + fr, rowt = u.pm * BMq, col0 = u.pn * BMq + wc * 32 + 8 * fq;
        const float* shw = shw0 + (size_t)(rowt < MC ? 0 : 1 + (rowt - MC) / 4096) * NPAD + col0;
        f32x4 sh[2][2];
#pragma unroll
        for (int bj = 0; bj < 2; ++bj) { sh[bj][0] = *(const f32x4*)(shw + bj * HALFq); sh[bj][1] = *(const f32x4*)(shw + bj * HALFq + 4); }
        float rsv[2][4];
        {
            const int rl = rowt + wr * 64 + (ln_ >> 4) * 16 + (ln_ & 15); const float r0 = rstd_of(ssq, rl), r1 = rstd_of(ssq, rl + HALFq);
#pragma unroll
            for (int m = 0; m < 4; ++m) { rsv[0][m] = __shfl(r0, m * 16 + fr); rsv[1][m] = __shfl(r1, m * 16 + fr); }
        }
#pragma unroll
        for (int ai = 0; ai < 2; ++ai)
#pragma unroll
            for (int m = 0; m < 4; ++m) { const int r = row0 + ai * HALFq + m * 16; bf16_t* rowp = P + (((size_t)(r >> 7) * 48 + (col0 >> 7)) * 128 + (r & 127)) * 128 + (col0 & 127); const float rs = rsv[ai][m];
#pragma unroll
                for (int bj = 0; bj < 2; ++bj) { const f32x4 v0 = acc[ai][bj][m][0] * rs + sh[bj][0], v1 = acc[ai][bj][m][1] * rs + sh[bj][1];
                    u32x4 w; w.x = cvt_pk_bf16(v0[0], v0[1]); w.y = cvt_pk_bf16(v0[2], v0[3]); w.z = cvt_pk_bf16(v1[0], v1[1]); w.w = cvt_pk_bf16(v1[2], v1[3]);
                    *(u32x4*)(rowp + bj * 16384) = w; } }
    }
};
struct EpiGlu {
    static constexpr bool PERM = true, AFTER_DRAIN = false;
    const bf16_t* YA; bf16_t* Y;
    __device__ __forceinline__ void operator()(const f32x4 (&acc)[2][2][4][2], const Unit& u, int wr, int wc, int fr_, int fq_) const {
        int ln_ = (int)__builtin_amdgcn_mbcnt_hi(~0u, __builtin_amdgcn_mbcnt_lo(~0u, 0u)); asm volatile("" : "+v"(ln_)); const int fr = ln_ & 15, fq = ln_ >> 4; (void)fr_; (void)fq_;
        const int row0 = u.pm * BMq + wr * 64 + fr, col0 = u.pn * BMq + wc * 32 + 8 * fq;
#pragma unroll
        for (int ai = 0; ai < 2; ++ai)
#pragma unroll
            for (int bj = 0; bj < 2; ++bj) { u32x4 ya[4];
#pragma unroll
                for (int m = 0; m < 4; ++m) ya[m] = *(const u32x4*)(YA + (size_t)(row0 + ai * HALFq + m * 16) * GWID + col0 + bj * HALFq);
#pragma unroll
                for (int m = 0; m < 4; ++m) { const int r = row0 + ai * HALFq + m * 16; const f32x4 v0 = acc[ai][bj][m][0], v1 = acc[ai][bj][m][1];
                    const u32x4 a = ya[m];
                    float y[8] = {bflo(a.x), bfhi(a.x), bflo(a.y), bfhi(a.y), bflo(a.z), bfhi(a.z), bflo(a.w), bfhi(a.w)};
                    const float g[8] = {v0[0], v0[1], v0[2], v0[3], v1[0], v1[1], v1[2], v1[3]};
#pragma unroll
                    for (int k = 0; k < 8; ++k) y[k] = y[k] * sigmoidf_(g[k]);
                    u32x4 w; w.x = cvt_pk_bf16(y[0], y[1]); w.y = cvt_pk_bf16(y[2], y[3]); w.z = cvt_pk_bf16(y[4], y[5]); w.w = cvt_pk_bf16(y[6], y[7]);
                    *(u32x4*)(Y + (size_t)r * D + col0 + bj * HALFq) = w; }
                asm volatile("" ::: "memory"); }
    }
};
struct EpiRes {
    static constexpr bool PERM = true, AFTER_DRAIN = false;
    const float* xp; const float* xs; bf16_t* XB; const float* gate0; int first;
    int NEXT; bf16_t* XA; float* ssq; const float* gn; const float* scn0; PG8_LAS unsigned char* scr;
    __device__ __forceinline__ float row_update(const f32x4 b0, const f32x4 b1, const f32x4 c0, const f32x4 c1, const f32x4 g0, const f32x4 g1, const f32x4 a0, const f32x4 a1, bf16_t* xbp, bf16_t* xap) const {
        const f32x4 x0 = b0 + g0 * c0, x1 = b1 + g1 * c1;
        u32x4 xw; xw.x = cvt_pk_bf16(x0[0], x0[1]); xw.y = cvt_pk_bf16(x0[2], x0[3]); xw.z = cvt_pk_bf16(x1[0], x1[1]); xw.w = cvt_pk_bf16(x1[2], x1[3]);
        *(u32x4*)xbp = xw;
        float s = 0.f;
        if (NEXT) { const f32x4 r0 = (f32x4){bflo(xw.x), bfhi(xw.x), bflo(xw.y), bfhi(xw.y)}, r1 = (f32x4){bflo(xw.z), bfhi(xw.z), bflo(xw.w), bfhi(xw.w)};
            s = (r0[0] * r0[0] + r0[1] * r0[1]) + (r0[2] * r0[2] + r0[3] * r0[3]) + (r1[0] * r1[0] + r1[1] * r1[1]) + (r1[2] * r1[2] + r1[3] * r1[3]);
            const f32x4 y0 = r0 * a0, y1 = r1 * a1; u32x4 w; w.x = cvt_pk_bf16(y0[0], y0[1]); w.y = cvt_pk_bf16(y0[2], y0[3]); w.z = cvt_pk_bf16(y1[0], y1[1]); w.w = cvt_pk_bf16(y1[2], y1[3]);
            *(u32x4*)xap = w; }
        return s;
    }
    __device__ __forceinline__ void operator()(const f32x4 (&acc)[2][2][4][2], const Unit& u, int wr, int wc, int fr_, int fq_) const {
        int ln_ = (int)__builtin_amdgcn_mbcnt_hi(~0u, __builtin_amdgcn_mbcnt_lo(~0u, 0u)); asm volatile("" : "+v"(ln_)); const int fr = ln_ & 15, fq = ln_ >> 4; (void)fr_; (void)fq_;
        const int rowt = u.pm * BMq, col0 = u.pn * BMq + wc * 32 + 8 * fq;
        const int mrow = rowt < MC ? 0 : 1 + (rowt - MC) / 4096;
        const float* gate = gate0 + (size_t)mrow * (6 * D);
        const float* basef = rowt < MC ? xp + (size_t)rowt * D : xs + (size_t)(rowt - MC) * D;
        bf16_t* xb = XB + (size_t)rowt * D;
        float ss[2][4];
#pragma unroll
        for (int ai = 0; ai < 2; ++ai)
#pragma unroll
            for (int m = 0; m < 4; ++m) ss[ai][m] = 0.f;
#pragma unroll
        for (int bj = 0; bj < 2; ++bj) { const int c = col0 + bj * HALFq; const f32x4 g0 = *(const f32x4*)(gate + c), g1 = *(const f32x4*)(gate + c + 4);
            f32x4 a0 = (f32x4){0.f, 0.f, 0.f, 0.f}, a1 = a0;
            if (NEXT) { const float* scn = scn0 + (size_t)mrow * (6 * D); a0 = *(const f32x4*)(gn + c) * (*(const f32x4*)(scn + c) + 1.f); a1 = *(const f32x4*)(gn + c + 4) * (*(const f32x4*)(scn + c + 4) + 1.f); }
            if (first) {
#pragma unroll
                for (int ai = 0; ai < 2; ++ai)
#pragma unroll
                    for (int m = 0; m < 4; ++m) { const size_t off = (size_t)(wr * 64 + fr + ai * HALFq + m * 16) * D + c;
                        const f32x4 b0 = *(const f32x4*)(basef + off), b1 = *(const f32x4*)(basef + off + 4);
                        ss[ai][m] += row_update(b0, b1, acc[ai][bj][m][0], acc[ai][bj][m][1], g0, g1, a0, a1, xb + off, XA + (size_t)rowt * D + off);
                        if (m & 1) asm volatile("" ::: "memory"); }
            } else {
#pragma unroll
                for (int ai = 0; ai < 2; ++ai) { u32x4 bw[4];
#pragma unroll
                    for (int m = 0; m < 4; ++m) bw[m] = *(const u32x4*)(xb + (size_t)(wr * 64 + fr + ai * HALFq + m * 16) * D + c);
#pragma unroll
                    for (int m = 0; m < 4; ++m) { const size_t off = (size_t)(wr * 64 + fr + ai * HALFq + m * 16) * D + c; const u32x4 w = bw[m];
                        const f32x4 b0 = (f32x4){bflo(w.x), bfhi(w.x), bflo(w.y), bfhi(w.y)}, b1 = (f32x4){bflo(w.z), bfhi(w.z), bflo(w.w), bfhi(w.w)};
                        ss[ai][m] += row_update(b0, b1, acc[ai][bj][m][0], acc[ai][bj][m][1], g0, g1, a0, a1, xb + off, XA + (size_t)rowt * D + off); }
                    asm volatile("" ::: "memory"); }
            } }
        if (NEXT) {
            PG8_LAS float* P4 = (PG8_LAS float*)scr;
#pragma unroll
            for (int ai = 0; ai < 2; ++ai)
#pragma unroll
                for (int m = 0; m < 4; ++m) { float s = ss[ai][m]; s += __shfl_xor(s, 16); s += __shfl_xor(s, 32);
                    if (fq == 0) P4[(ai * HALFq + wr * 64 + m * 16 + fr) * 4 + wc] = s; }
            asm volatile("s_waitcnt lgkmcnt(0)\n\ts_barrier" ::: "memory");
            { const int tid = (wr * 4 + wc) * 64 + fq * 16 + fr;
              if (tid < 256) { const f32x4 p = *(const PG8_LAS f32x4*)(P4 + tid * 4); ssq[(size_t)(rowt + tid) * 8 + u.pn] = (p[0] + p[1]) + (p[2] + p[3]); } }
            asm volatile("s_waitcnt lgkmcnt(0)\n\ts_barrier" ::: "memory");
        }
    }
};
struct EpiRelu2 {
    static constexpr bool PERM = true, AFTER_DRAIN = false;
    bf16_t* O; const float* ssq; const float* shw0;
    __device__ __forceinline__ void operator()(const f32x4 (&acc)[2][2][4][2], const Unit& u, int wr, int wc, int fr_, int fq_) const {
        int ln_ = (int)__builtin_amdgcn_mbcnt_hi(~0u, __builtin_amdgcn_mbcnt_lo(~0u, 0u)); asm volatile("" : "+v"(ln_)); const int fr = ln_ & 15, fq = ln_ >> 4; (void)fr_; (void)fq_;
        const int row0 = u.pm * BMq + wr * 64 + fr, col0 = u.pn * BMq + wc * 32 + 8 * fq, rowt = u.pm * BMq;
        const float* shw = shw0 + (size_t)(rowt < MC ? 0 : 1 + (rowt - MC) / 4096) * DFF + col0;
        f32x4 sh[2][2];
#pragma unroll
        for (int bj = 0; bj < 2; ++bj) { sh[bj][0] = *(const f32x4*)(shw + bj * HALFq); sh[bj][1] = *(const f32x4*)(shw + bj * HALFq + 4); }
        float rsv[2][4];
        {
            const int rl = rowt + wr * 64 + (ln_ >> 4) * 16 + (ln_ & 15); const float r0 = rstd_of(ssq, rl), r1 = rstd_of(ssq, rl + HALFq);
#pragma unroll
            for (int m = 0; m < 4; ++m) { rsv[0][m] = __shfl(r0, m * 16 + fr); rsv[1][m] = __shfl(r1, m * 16 + fr); }
        }
#pragma unroll
        for (int ai = 0; ai < 2; ++ai)
#pragma unroll
            for (int m = 0; m < 4; ++m) { const int r = row0 + ai * HALFq + m * 16; bf16_t* rowp = O + (size_t)r * DFF + col0; const float rs = rsv[ai][m];
#pragma unroll
                for (int bj = 0; bj < 2; ++bj) { f32x4 v0 = acc[ai][bj][m][0] * rs + sh[bj][0], v1 = acc[ai][bj][m][1] * rs + sh[bj][1];
#pragma unroll
                    for (int k = 0; k < 4; ++k) { const float a = fmaxf(v0[k], 0.f), b = fmaxf(v1[k], 0.f); v0[k] = a * a; v1[k] = b * b; }
                    u32x4 w; w.x = cvt_pk_bf16(v0[0], v0[1]); w.y = cvt_pk_bf16(v0[2], v0[3]); w.z = cvt_pk_bf16(v1[0], v1[1]); w.w = cvt_pk_bf16(v1[2], v1[3]);
                    *(u32x4*)(rowp + bj * HALFq) = w; } }
    }
};
}
__device__ __forceinline__ float logsigmoidf_(float x) { return fminf(x, 0.f) - __logf(1.f + __expf(-fabsf(x))); }
__device__ __forceinline__ float softplusf_(float x) { return fmaxf(x, 0.f) + __logf(1.f + __expf(-fabsf(x))); }
__device__ __forceinline__ void load_tile128(Frame& F, LAS unsigned char* dst, const bf16* src) {
#pragma unroll
    for (int it = 0; it < 4; ++it) { const int i = F.tid + NT * it, r = i >> 4, c = i & 15;
        *(LAS v4u*)(dst + r * LDT + c * 16) = *(const v4u*)(src + (size_t)r * 128 + c * 8); }
}
__device__ __forceinline__ void qk_issue(Frame& F, const bf16* src, v4u (&r)[4]) {
#pragma unroll
    for (int it = 0; it < 2; ++it) { const int i = F.tid + NT * it, rw = i >> 3, c = i & 7;
        r[2 * it] = *(const v4u*)(src + (size_t)rw * 128 + c * 8); r[2 * it + 1] = *(const v4u*)(src + (size_t)rw * 128 + 64 + c * 8); }
}
template <int NDST> __device__ __forceinline__ void qk_commit(Frame& F, LAS unsigned char* dst0, LAS unsigned char* dst1, const v4u (&rg)[4], const LAS float* w0, const LAS float* w1, float scale, bool rope, int tpos0) {
#pragma unroll
    for (int it = 0; it < 2; ++it) {
        const int i = F.tid + NT * it, r = i >> 3, c = i & 7;
        float x1[8], x2[8];
        unpack8(rg[2 * it], x1); unpack8(rg[2 * it + 1], x2);
        if (rope) {
            const int tp = tpos0 + r, pos = c < 4 ? (tp >> 6) : (tp & 63);
            const f32x2* rt = WSP(const f32x2, WS_ROPE) + pos * 32 + ((8 * c) & 31);
#pragma unroll
            for (int j = 0; j < 8; ++j) { const f32x2 cs = rt[j]; const float a = x1[j], b = x2[j]; x1[j] = a * cs.x - b * cs.y; x2[j] = a * cs.y + b * cs.x; }
        }
        const float s0 = scale * (w0 ? w0[r] : 1.f);
        *(LAS v4u*)(dst0 + r * LDT + c * 16) = pack8(x1, s0); *(LAS v4u*)(dst0 + r * LDT + 128 + c * 16) = pack8(x2, s0);
        if (NDST == 2) { const float s1 = scale * w1[r];
            *(LAS v4u*)(dst1 + r * LDT + c * 16) = pack8(x1, s1); *(LAS v4u*)(dst1 + r * LDT + 128 + c * 16) = pack8(x2, s1); }
    }
}
template <int NDST> __device__ __forceinline__ void load_qk(Frame& F, LAS unsigned char* dst0, LAS unsigned char* dst1, const bf16* src, const LAS float* w0, const LAS float* w1, float scale, bool rope, int tpos0) {
    v4u r[4]; qk_issue(F, src, r); qk_commit<NDST>(F, dst0, dst1, r, w0, w1, scale, rope, tpos0);
}
template <int NDST, int nc8> __device__ __forceinline__ void load_conv(Frame& F, KArgs& A, int l, LAS unsigned char* dst0, LAS unsigned char* dst1, int ldd, int ch0, int row0, int seq_lo, int seq_hi,
                                                               const LAS float* w0, const LAS float* w1, bool to_global) {
    const int c = F.tid % nc8;
    const float* cw = INP(I_CONVW) + (size_t)l * 5 * 1024 + ch0 + 8 * c; const float* cb = INP(I_CONVB) + (size_t)l * 1024 + ch0 + 8 * c;
    f32x4 wv[5][2];
#pragma unroll
    for (int k = 0; k < 5; ++k) { wv[k][0] = *(const f32x4*)(cw + k * 1024); wv[k][1] = *(const f32x4*)(cw + k * 1024 + 4); }
    const f32x4 b0 = *(const f32x4*)cb, b1 = *(const f32x4*)(cb + 4);
#pragma unroll 1
    for (int i = F.tid; i < 128 * nc8; i += NT) {
        const int r = i / nc8, row = row0 + r;
        float acc[8] = {b0.x, b0.y, b0.z, b0.w, b1.x, b1.y, b1.z, b1.w};
        v4u xr[5];
#pragma unroll
        for (int k = 0; k < 5; ++k) { const int rr = row + k - 2; xr[k] = (v4u){0u, 0u, 0u, 0u};
            if (rr >= seq_lo && rr < seq_hi) xr[k] = *(const v4u*)(PT(rr >> 7, PC_DX + ch0 + 8 * c) + (size_t)(rr & 127) * 128); }
#pragma unroll
        for (int k = 0; k < 5; ++k) { float x[8]; unpack8(xr[k], x);
            acc[0] += x[0] * wv[k][0].x; acc[1] += x[1] * wv[k][0].y; acc[2] += x[2] * wv[k][0].z; acc[3] += x[3] * wv[k][0].w; acc[4] += x[4] * wv[k][1].x; acc[5] += x[5] * wv[k][1].y; acc[6] += x[6] * wv[k][1].z; acc[7] += x[7] * wv[k][1].w; }
#pragma unroll
        for (int j = 0; j < 8; ++j) acc[j] = siluf_(acc[j]);
        if (to_global) *(v4u*)(XT(row >> 7, ch0 + 8 * c) + (size_t)(row & 127) * 128) = pack8(acc, 1.f);
        if (NDST >= 1) *(LAS v4u*)(dst0 + r * ldd + c * 16) = pack8(acc, w0 ? w0[r] : 1.f);
        if (NDST == 2) *(LAS v4u*)(dst1 + r * ldd + c * 16) = pack8(acc, w1[r]);
    }
}
template <int nc8> __device__ __forceinline__ void load_xbcc(Frame& F, LAS unsigned char* dst, int ldd, int ch0, int row0) {
    const bf16* P = XT(row0 >> 7, ch0);
    for (int i = F.tid; i < 128 * nc8; i += NT) { const int r = i / nc8, c = i % nc8; *(LAS v4u*)(dst + r * ldd + c * 16) = *(const v4u*)(P + (size_t)r * 128 + 8 * c); }
}
__device__ __forceinline__ void kv_state_mfma(Frame& F, const LAS unsigned char* TKf, const LAS unsigned char* TKb, const LAS unsigned char* TV, bf16* outF, bf16* outB) {
    const int dvb = F.wave >> 1, dkb0 = (F.wave & 1) * 2, hh = F.lane >> 5;
    f32x16 acc[2][2] = {{ZERO16, ZERO16}, {ZERO16, ZERO16}};
#pragma unroll 1
    for (int ks = 0; ks < 8; ++ks) {
        const bf16x8 a = frag_tr(TV, LDT, 16 * ks, 32 * dvb, F.lane);
#pragma unroll
        for (int j = 0; j < 2; ++j) { acc[0][j] = MFMA32(a, frag_tr(TKf, LDT, 16 * ks, 32 * (dkb0 + j), F.lane), acc[0][j]); acc[1][j] = MFMA32(a, frag_tr(TKb, LDT, 16 * ks, 32 * (dkb0 + j), F.lane), acc[1][j]); }
    }
#pragma unroll
    for (int j = 0; j < 2; ++j)
#pragma unroll
        for (int i = 0; i < 16; ++i) { const int o = (32 * dvb + crow(i, hh)) * 128 + 32 * (dkb0 + j) + (F.lane & 31); outF[o] = (bf16)f2bf(acc[0][j][i]); outB[o] = (bf16)f2bf(acc[1][j][i]); }
}
__device__ __forceinline__ void qkT_mfma(Frame& F, const LAS unsigned char* TQ, const LAS unsigned char* TK, f32x16 (&qk)[2]) {
    const int tb = F.wave >> 1, sb0 = (F.wave & 1) * 2;
    qk[0] = ZERO16; qk[1] = ZERO16;
#pragma unroll 1
    for (int ks = 0; ks < 8; ++ks) { const bf16x8 bq = frag_row(TQ, LDT, 32 * tb, 16 * ks, F.lane);
#pragma unroll
        for (int j = 0; j < 2; ++j) qk[j] = MFMA32(frag_row(TK, LDT, 32 * (sb0 + j), 16 * ks, F.lane), bq, qk[j]); }
}
__device__ __forceinline__ void pv_mfma(Frame& F, const LAS unsigned char* TP, const LAS unsigned char* TV, f32x16 (&o)[2]) {
    const int tb = F.wave >> 1, eb0 = (F.wave & 1) * 2;
#pragma unroll 1
    for (int ks = 0; ks < 8; ++ks) { const bf16x8 ap = frag_row(TP, LDT, 32 * tb, 16 * ks, F.lane);
#pragma unroll
        for (int j = 0; j < 2; ++j) o[j] = MFMA32(ap, frag_tr(TV, LDT, 16 * ks, 32 * (eb0 + j), F.lane), o[j]); }
}
__device__ __forceinline__ void pv_mfma_range(Frame& F, const LAS unsigned char* TP, const LAS unsigned char* TV, f32x16 (&o)[2], int k_lo, int k_hi) {
    const int tb = F.wave >> 1, eb0 = (F.wave & 1) * 2;
#pragma unroll 1
    for (int ks = k_lo; ks < k_hi; ++ks) { const bf16x8 ap = frag_row(TP, LDT, 32 * tb, 16 * ks, F.lane);
#pragma unroll
        for (int j = 0; j < 2; ++j) o[j] = MFMA32(ap, frag_tr(TV, LDT, 16 * ks, 32 * (eb0 + j), F.lane), o[j]); }
}
__device__ __forceinline__ void qs_prefetch(Frame& F, const bf16* ST, bf16x8 (&b)[2][8]) {
    const int eb0 = (F.wave & 1) * 2, hh = F.lane >> 5;
#pragma unroll
    for (int j = 0; j < 2; ++j)
#pragma unroll
        for (int ks = 0; ks < 8; ++ks) b[j][ks] = *(const bf16x8*)(ST + (size_t)(32 * (eb0 + j) + (F.lane & 31)) * 128 + 16 * ks + 8 * hh);
}
__device__ __forceinline__ void qs_mfma(Frame& F, const LAS unsigned char* TQ, const bf16x8 (&b)[2][8], f32x16 (&o)[2]) {
    const int tb = F.wave >> 1;
#pragma unroll
    for (int ks = 0; ks < 8; ++ks) { const bf16x8 aq = frag_row(TQ, LDT, 32 * tb, 16 * ks, F.lane);
#pragma unroll
        for (int j = 0; j < 2; ++j) o[j] = MFMA32(aq, b[j][ks], o[j]); }
}
__device__ __forceinline__ void hs_to_lds(Frame& F, LAS unsigned char* HS, const f32x16 (&hs)[2]) {
    const int tb = F.wave >> 1, eb0 = (F.wave & 1) * 2, hh = F.lane >> 5;
#pragma unroll
    for (int j = 0; j < 2; ++j)
#pragma unroll
        for (int i = 0; i < 16; ++i) *(LAS float*)(HS + (32 * tb + crow(i, hh)) * 528 + (32 * (eb0 + j) + (F.lane & 31)) * 4) = hs[j][i];
}
template <int GATE> __device__ __forceinline__ void head_out(Frame& F, const LAS unsigned char* HS, const float* gain, const bf16* gsrc  , bf16* ydst  ) {
    const int t = F.tid >> 2, seg = F.tid & 3;
    float v[32]; float ss = 0.f;
#pragma unroll
    for (int k = 0; k < 8; ++k) { const f32x4 x = *(const LAS f32x4*)(HS + t * 528 + (32 * seg + 4 * k) * 4); v[4 * k] = x.x; v[4 * k + 1] = x.y; v[4 * k + 2] = x.z; v[4 * k + 3] = x.w; ss += (x.x * x.x + x.y * x.y) + (x.z * x.z + x.w * x.w); }
    ss += __shfl_xor(ss, 1); ss += __shfl_xor(ss, 2);
    const float r = rsqrtf(ss * (1.f / 128.f) + EPS);
#pragma unroll
    for (int k = 0; k < 4; ++k) { float g[8]; unpack8(*(const v4u*)(gsrc + (size_t)t * 128 + 32 * seg + 8 * k), g); float o[8];
#pragma unroll
        for (int j = 0; j < 8; ++j) { const float gg = GATE == 0 ? sigmoidf_(g[j]) : siluf_(g[j]); o[j] = v[8 * k + j] * r * gain[32 * seg + 8 * k + j] * gg; }
        *(v4u*)(ydst + (size_t)t * D + 32 * seg + 8 * k) = pack8(o, 1.f); }
}

__device__ __forceinline__ void tile_issue(Frame& F, const bf16* src, v4u (&r)[4]) {
#pragma unroll
    for (int it = 0; it < 4; ++it) { const int i = F.tid + NT * it; r[it] = *(const v4u*)(src + (size_t)(i >> 4) * 128 + (i & 15) * 8); }
}
__device__ __forceinline__ void tile_commit(Frame& F, LAS unsigned char* dst, const v4u (&r)[4], float scale) {
#pragma unroll
    for (int it = 0; it < 4; ++it) { const int i = F.tid + NT * it; v4u v = r[it];
        if (scale != 1.f) { float x[8]; unpack8(v, x); v = pack8(x, scale); }
        *(LAS v4u*)(dst + (i >> 4) * LDT + (i & 15) * 16) = v; }
}
template <int GATE> __device__ __forceinline__ void head_out_r(Frame& F, const LAS unsigned char* HS, const float* gain, const v4u (&og)[4], bf16* ydst) {
    const int t = F.tid >> 2, seg = F.tid & 3;
    float v[32]; float ss = 0.f;
#pragma unroll
    for (int k = 0; k < 8; ++k) { const f32x4 x = *(const LAS f32x4*)(HS + t * 528 + (32 * seg + 4 * k) * 4); v[4 * k] = x.x; v[4 * k + 1] = x.y; v[4 * k + 2] = x.z; v[4 * k + 3] = x.w; ss += (x.x * x.x + x.y * x.y) + (x.z * x.z + x.w * x.w); }
    ss += __shfl_xor(ss, 1); ss += __shfl_xor(ss, 2);
    const float r = rsqrtf(ss * (1.f / 128.f) + EPS);
#pragma unroll
    for (int k = 0; k < 4; ++k) { float g[8]; unpack8(og[k], g); float o[8]; const f32x4 g0 = *(const f32x4*)(gain + 32 * seg + 8 * k), g1 = *(const f32x4*)(gain + 32 * seg + 8 * k + 4);
        const float gn[8] = {g0.x, g0.y, g0.z, g0.w, g1.x, g1.y, g1.z, g1.w};
#pragma unroll
        for (int j = 0; j < 8; ++j) { const float gg = GATE == 0 ? sigmoidf_(g[j]) : siluf_(g[j]); o[j] = v[8 * k + j] * r * gn[j] * gg; }
        *(v4u*)(ydst + (size_t)t * D + 32 * seg + 8 * k) = pack8(o, 1.f); }
}
__device__ __forceinline__ void mlstm_gates(Frame& F, KArgs& A, int l, int cp, int h) {
    if (F.tid < 128) { const float* g = WSP(const float, WS_GATES) + (size_t)(cp * 128 + F.tid) * 32;
        SCA(0)[F.tid] = g[h] + INP(I_MIB)[(l * 2 + 0) * 4 + h]; SCA(1)[F.tid] = g[4 + h] + INP(I_MIB)[(l * 2 + 1) * 4 + h];
        SCA(2)[F.tid] = logsigmoidf_(g[8 + h] + INP(I_MFB)[(l * 2 + 0) * 4 + h]); SCA(3)[F.tid] = logsigmoidf_(g[12 + h] + INP(I_MFB)[(l * 2 + 1) * 4 + h]); }
    BAR();
    if (F.wave == 0) wave_scan128<false>(SCA(2), SCA(4), F.lane, false, 0.f);
    if (F.wave == 1) wave_scan128<false>(SCA(3), SCA(5), F.lane, true, 0.f);
    BAR();
}
__device__ __forceinline__ void mlstm_local_item(Frame F, KArgs& A, int l, int cp, int h) {
    v4u rk[4], rv[4]; qk_issue(F, PT(cp, PC_MK + h * 128), rk); tile_issue(F, PT(cp, PC_MV + h * 128), rv);
    mlstm_gates(F, A, l, cp, h);
    if (F.wave < 2) { const int d = F.wave; const LAS float* bc = SCA(4 + d); const LAS float* ig = SCA(d); const float tot = d == 0 ? bc[127] : bc[0];
        const int s0 = 2 * F.lane; const float g0 = tot - bc[s0] + ig[s0], g1 = tot - bc[s0 + 1] + ig[s0 + 1];
        const float mx = wave_max(fmaxf(g0, g1));
        SCA(6 + d)[s0] = __expf(g0 - mx); SCA(6 + d)[s0 + 1] = __expf(g1 - mx);
        if (F.lane == 0) { float* sc = WSP(float, WS_MLSC) + ((cp * 2 + d) * 4 + h) * 2; sc[0] = tot; sc[1] = mx; } }
    BAR();
    qk_commit<2>(F, F.lds, F.lds + TS, rk, SCA(6), SCA(7), 0.08838834764831845f, false, 0);
    tile_commit(F, F.lds + 2 * TS, rv, 1.f);
    BAR();
    kv_state_mfma(F, F.lds, F.lds + TS, F.lds + 2 * TS, WSP(bf16, WS_MLCLOC) + (size_t)((cp * 2 + 0) * 4 + h) * 16384, WSP(bf16, WS_MLCLOC) + (size_t)((cp * 2 + 1) * 4 + h) * 16384);
    if (F.tid < 256) { const int d = F.tid >> 7, dk = F.tid & 127; const LAS unsigned char* T = F.lds + d * TS; float s = 0.f;
        for (int r = 0; r < 128; ++r) s += bf2f(*(const LAS unsigned short*)(T + r * LDT + dk * 2));
        WSP(float, WS_MLNLOC)[((cp * 2 + d) * 4 + h) * 128 + dk] = s; }
    BAR();
}
__device__ __forceinline__ void mlstm_out_item(Frame F, KArgs& A, int l, int cp, int h) {
    const Seq sq = seq_of(cp);
    LAS unsigned char* TQ = F.lds; LAS unsigned char* TK = F.lds + TS; LAS unsigned char* TV = F.lds + 2 * TS; LAS unsigned char* TP = F.lds + 3 * TS;
    ITS(0);
    v4u rq[4], rk[4], rv[4], og[4];
    tile_issue(F, PT(cp, PC_MQ + h * 128), rq); tile_issue(F, PT(cp, PC_MK + h * 128), rk); tile_issue(F, PT(cp, PC_MV + h * 128), rv);
    { const int t = F.tid >> 2, seg = F.tid & 3;
#pragma unroll
      for (int k = 0; k < 4; ++k) og[k] = *(const v4u*)(PT(cp, PC_MO + h * 128) + (size_t)t * 128 + 32 * seg + 8 * k); }
    const float min_f = WSP(const float, WS_MLMIN)[(cp * 2 + 0) * 4 + h], min_b = WSP(const float, WS_MLMIN)[(cp * 2 + 1) * 4 + h];
    float nin = 0.f; if (F.tid < 256) nin = WSP(const float, WS_MLNIN)[((cp * 2 + (F.tid >> 7)) * 4 + h) * 128 + (F.tid & 127)];
    mlstm_gates(F, A, l, cp, h);
    if (F.tid < 256) { const int d = F.tid >> 7, s = F.tid & 127; SCA(6 + d)[s] = SCA(d)[s] - SCA(4 + d)[s]; SCA(12 + d)[s] = nin; }
    tile_commit(F, TQ, rq, 1.f); tile_commit(F, TK, rk, 0.08838834764831845f); tile_commit(F, TV, rv, 1.f);
    BAR();
    if (F.wave == 0) wave_scan128<true>(SCA(6), SCA(8), F.lane, false, min_f);
    if (F.wave == 1) wave_scan128<true>(SCA(7), SCA(9), F.lane, true, min_b);
    BAR();
    ITE(0);
    f32x16 hs[2] = {ZERO16, ZERO16};
    const int tb = F.wave >> 1, sb0 = (F.wave & 1) * 2, hh = F.lane >> 5, t = 32 * tb + (F.lane & 31);
#pragma unroll 1
    for (int d = 0; d < 2; ++d) {
        const LAS float* av = SCA(6 + d); const float Mt = SCA(8 + d)[t]; const float m_in = d == 0 ? min_f : min_b;
        ITS(2);
        const bool has_state = sq.lat || (d == 0 ? sq.c > 0 : sq.c < sq.nch - 1);
        bf16x8 bst[2][8]; if (has_state) qs_prefetch(F, WSP(const bf16, WS_MLCIN) + (size_t)((cp * 2 + d) * 4 + h) * 16384, bst);
#ifndef PROBE_REP2
#define PROBE_REP2 1
#endif
#pragma unroll 1
        for (int rep2_ = 0; rep2_ < PROBE_REP2; ++rep2_) {
        f32x16 qk[2]; qkT_mfma(F, TQ, TK, qk);
#pragma unroll
        for (int j = 0; j < 2; ++j) { const int sblk = sb0 + j;
            if (d == 0 ? sblk > tb : sblk < tb) continue;
            const bool diag = sblk == tb;
#pragma unroll
            for (int i4 = 0; i4 < 4; ++i4) { const int sb = 32 * sblk + 8 * i4 + 4 * hh; float p[4]; const f32x4 a4 = *(const LAS f32x4*)(av + sb);
#pragma unroll
                for (int i = 0; i < 4; ++i) p[i] = qk[j][4 * i4 + i] * __expf(a4[i] - Mt);
                if (diag) {
#pragma unroll
                    for (int i = 0; i < 4; ++i) { const int s = sb + i; const bool ok = d == 0 ? (s <= t) : (s >= t); p[i] = ok ? p[i] : 0.f; } }
                *(LAS u32x2*)(TP + t * LDT + sb * 2) = (u32x2){pk2(p[0], p[1]), pk2(p[2], p[3])}; } }
        }
        ITE(2); ITS(3);
        BAR();
        {
            const int tt = F.tid >> 2, seg = F.tid & 3; float ds = 0.f, qn = 0.f;
            const bool pvalid = d == 0 ? seg <= (tt >> 5) : seg >= (tt >> 5);
#pragma unroll
            for (int k = 0; k < 4; ++k) { float x[8]; unpack8(pvalid ? *(const LAS v4u*)(TP + tt * LDT + 64 * seg + 16 * k) : (v4u){0u, 0u, 0u, 0u}, x); float q[8]; unpack8(*(const LAS v4u*)(TQ + tt * LDT + 64 * seg + 16 * k), q);
                const f32x4 n0 = *(const LAS f32x4*)(SCA(12 + d) + 32 * seg + 8 * k), n1 = *(const LAS f32x4*)(SCA(12 + d) + 32 * seg + 8 * k + 4);
                ds += ((x[0] + x[1]) + (x[2] + x[3])) + ((x[4] + x[5]) + (x[6] + x[7]));
                qn += (q[0] * n0.x + q[1] * n0.y) + (q[2] * n0.z + q[3] * n0.w) + (q[4] * n1.x + q[5] * n1.y) + (q[6] * n1.z + q[7] * n1.w); }
            ds += __shfl_xor(ds, 1); ds += __shfl_xor(ds, 2); qn += __shfl_xor(qn, 1); qn += __shfl_xor(qn, 2);
            if (seg == 0) { const float Mtt = SCA(8 + d)[tt], wint = __expf(m_in - Mtt), den = ds + wint * qn, dd = fmaxf(fabsf(den), __expf(-(SCA(4 + d)[tt] + Mtt)));
                const float rdd = __builtin_amdgcn_rcpf(dd); SCA(10)[tt] = wint * rdd; SCA(11)[tt] = rdd; } }
        { f32x16 num[2] = {ZERO16, ZERO16};
          pv_mfma_range(F, TP, TV, num, d == 0 ? 0 : 2 * tb, d == 0 ? 2 * tb + 2 : 8);
          BAR(); ITE(3); ITS(4);
#pragma unroll
          for (int j = 0; j < 2; ++j)
#pragma unroll
            for (int k4 = 0; k4 < 4; ++k4) { const f32x4 f4 = *(const LAS f32x4*)(SCA(11) + 32 * tb + 8 * k4 + 4 * hh);
#pragma unroll
                for (int i = 0; i < 4; ++i) hs[j][4 * k4 + i] += f4[i] * num[j][4 * k4 + i]; } }
        if (has_state) { f32x16 qc[2] = {ZERO16, ZERO16};
          qs_mfma(F, TQ, bst, qc);
#pragma unroll
          for (int j = 0; j < 2; ++j)
#pragma unroll
            for (int k4 = 0; k4 < 4; ++k4) { const f32x4 f4 = *(const LAS f32x4*)(SCA(10) + 32 * tb + 8 * k4 + 4 * hh);
#pragma unroll
                for (int i = 0; i < 4; ++i) hs[j][4 * k4 + i] += f4[i] * qc[j][4 * k4 + i]; } }
        ITE(4);
    }
    ITS(5);
    BAR();
    hs_to_lds(F, F.lds, hs);
    BAR();
    head_out_r<0>(F, F.lds, INP(I_MNORM) + (size_t)l * GWID + h * 128, og, WSP(bf16, WS_Y) + (size_t)cp * 128 * D + 512 + h * 128);
    BAR(); ITE(5);
}

__device__ __forceinline__ void ret_local_item(Frame F, KArgs& A, int l, int cp, int h) {
    const float lgf = -__expf(INP(I_RRATE)[(l * 2 + 0) * 4 + h]), lgb = -__expf(INP(I_RRATE)[(l * 2 + 1) * 4 + h]);
    v4u rk[4], rv[4]; qk_issue(F, PT(cp, PC_RK + h * 128), rk); tile_issue(F, PT(cp, PC_RV + h * 128), rv);
    if (F.tid < 128) { SCA(6)[F.tid] = __expf((127.f - (float)F.tid) * lgf); SCA(7)[F.tid] = __expf((float)F.tid * lgb); }
    BAR();
    const Seq sq = seq_of(cp);
    qk_commit<2>(F, F.lds, F.lds + TS, rk, SCA(6), SCA(7), 0.08838834764831845f, sq.lat != 0, sq.c * 128);
    tile_commit(F, F.lds + 2 * TS, rv, 1.f);
    BAR();
    kv_state_mfma(F, F.lds, F.lds + TS, F.lds + 2 * TS, WSP(bf16, WS_RTLOC) + (size_t)((cp * 2 + 0) * 4 + h) * 16384, WSP(bf16, WS_RTLOC) + (size_t)((cp * 2 + 1) * 4 + h) * 16384);
    BAR();
}
__device__ __forceinline__ void ret_out_item(Frame F, KArgs& A, int l, int cp, int h) {
    const float lgf = -__expf(INP(I_RRATE)[(l * 2 + 0) * 4 + h]), lgb = -__expf(INP(I_RRATE)[(l * 2 + 1) * 4 + h]);
    if (F.tid < 128) { SCA(10)[F.tid] = __expf(((float)F.tid + 1.f) * lgf); SCA(11)[F.tid] = __expf((128.f - (float)F.tid) * lgb); }
    const Seq sq = seq_of(cp);
    LAS unsigned char* TQ = F.lds; LAS unsigned char* TK = F.lds + TS; LAS unsigned char* TV = F.lds + 2 * TS; LAS unsigned char* TP = F.lds + 3 * TS;
    v4u rq[4], rk[4], rv[4], og[4];
    qk_issue(F, PT(cp, PC_RQ + h * 128), rq); qk_issue(F, PT(cp, PC_RK + h * 128), rk); tile_issue(F, PT(cp, PC_RV + h * 128), rv);
    { const int t_ = F.tid >> 2, seg_ = F.tid & 3;
#pragma unroll
      for (int k = 0; k < 4; ++k) og[k] = *(const v4u*)(PT(cp, PC_RG + h * 128) + (size_t)t_ * 128 + 32 * seg_ + 8 * k); }
    qk_commit<1>(F, TQ, nullptr, rq, nullptr, nullptr, 1.f, sq.lat != 0, sq.c * 128);
    qk_commit<1>(F, TK, nullptr, rk, nullptr, nullptr, 0.08838834764831845f, sq.lat != 0, sq.c * 128);
    tile_commit(F, TV, rv, 1.f);
    BAR();
    f32x16 qk[2]; qkT_mfma(F, TQ, TK, qk);
    const int tb = F.wave >> 1, sb0 = (F.wave & 1) * 2, hh = F.lane >> 5, t = 32 * tb + (F.lane & 31);
#pragma unroll
    for (int j = 0; j < 2; ++j)
#pragma unroll
        for (int i4 = 0; i4 < 4; ++i4) { const int sb = 32 * (sb0 + j) + 8 * i4 + 4 * hh; float p[4];
#pragma unroll
            for (int i = 0; i < 4; ++i) { const int s = sb + i; const float df = (float)(t - s);
                float dm;
                if (sb0 + j == tb) dm = (s <= t ? __expf(df * lgf) : 0.f) + (s >= t ? __expf(-df * lgb) : 0.f);
                else dm = __expf(sb0 + j < tb ? df * lgf : -df * lgb);
                p[i] = qk[j][4 * i4 + i] * dm; }
            *(LAS u32x2*)(TP + t * LDT + sb * 2) = (u32x2){pk2(p[0], p[1]), pk2(p[2], p[3])}; }
    BAR();
    f32x16 y[2] = {ZERO16, ZERO16};
    pv_mfma(F, TP, TV, y);
#pragma unroll 1
    for (int d = 0; d < 2; ++d) { f32x16 qs[2] = {ZERO16, ZERO16};
        if (!sq.lat && (d == 0 ? sq.c == 0 : sq.c == sq.nch - 1)) continue;
        bf16x8 bst[2][8]; qs_prefetch(F, WSP(const bf16, WS_RTIN) + (size_t)((cp * 2 + d) * 4 + h) * 16384, bst);
        qs_mfma(F, TQ, bst, qs);
#pragma unroll
        for (int j = 0; j < 2; ++j)
#pragma unroll
            for (int k4 = 0; k4 < 4; ++k4) { const f32x4 f4 = *(const LAS f32x4*)(SCA(10 + d) + 32 * tb + 8 * k4 + 4 * hh);
#pragma unroll
                for (int i = 0; i < 4; ++i) y[j][4 * k4 + i] += f4[i] * qs[j][4 * k4 + i]; } }
    BAR();
    hs_to_lds(F, F.lds, y);
    BAR();
    head_out_r<1>(F, F.lds, INP(I_RNORM) + (size_t)l * GWID + h * 128, og, WSP(bf16, WS_Y) + (size_t)cp * 128 * D + 1024 + h * 128);
    BAR();
}
template <bool WMODE> __device__ __forceinline__ float ssd_scalars(Frame& F, KArgs& A, int l, int cp, int g) {
    const int d = F.wave >> 2, rr = F.wave & 3, head = g * 4 + rr;
    const float bias = INP(I_DTB)[(l * 2 + d) * 8 + head], arate = -__expf(INP(I_ALOG)[(l * 2 + d) * 8 + head]);
    const float* gp = WSP(const float, WS_GATES) + (size_t)(cp * 128) * 32 + 16 + d * 8 + head;
    const int i0 = d ? 127 - 2 * F.lane : 2 * F.lane, i1 = d ? i0 - 1 : i0 + 1;
    const float dt0 = softplusf_(gp[(size_t)i0 * 32] + bias), dt1 = softplusf_(gp[(size_t)i1 * 32] + bias);
    const float a0 = dt0 * arate, a1 = dt1 * arate;
    float inc = a0 + a1;
#pragma unroll
    for (int o = 1; o < 64; o <<= 1) { const float t = __shfl_up(inc, o); if (F.lane >= o) inc += t; }
    const float c1 = inc, c0 = inc - a1, tot = __shfl(inc, 63);
    LAS float* cum = SCA(16 + d * 4 + rr); LAS float* dtw = SCA(24 + d * 4 + rr);
    cum[i0] = c0; cum[i1] = c1;
    if (WMODE) { dtw[i0] = __expf(tot - c0) * dt0; dtw[i1] = __expf(tot - c1) * dt1; } else { dtw[i0] = dt0; dtw[i1] = dt1; }
    return tot;
}
__device__ __forceinline__ void seq_bounds(int cp, int& lo, int& hi) { if (cp < 64) { lo = (cp >> 1) * 256; hi = lo + 256; } else { lo = MC + ((cp - 64) >> 5) * 4096; hi = lo + 4096; } }
__device__ __forceinline__ void ssd_local_item(Frame F, KArgs& A, int l, int cp, int g) {
    const float tot = ssd_scalars<true>(F, A, l, cp, g);
    if (F.lane == 0) WSP(float, WS_SDSC)[(cp * 2 + (F.wave >> 2)) * 8 + g * 4 + (F.wave & 3)] = tot;
    int lo, hi; seq_bounds(cp, lo, hi);
    LAS unsigned char* TB = F.lds;
    load_conv<1, 16>(F, A, l, TB, nullptr, LDT, 512 + g * 128, cp * 128, lo, hi, nullptr, nullptr, true);
    load_conv<0, 16>(F, A, l, nullptr, nullptr, LDT, 768 + g * 128, cp * 128, lo, hi, nullptr, nullptr, true);
    BAR();
#pragma unroll 1
    for (int hr = 0; hr < 2; ++hr) {
#pragma unroll 1
        for (int r2 = 0; r2 < 2; ++r2) { const int rr = hr * 2 + r2;
            load_conv<2, 8>(F, A, l, F.lds + TS + (r2 * 2 + 0) * TSX, F.lds + TS + (r2 * 2 + 1) * TSX, LDX, g * 256 + rr * 64, cp * 128, lo, hi, SCA(24 + 0 * 4 + rr), SCA(24 + 1 * 4 + rr), true); }
        BAR();
        const int r2 = F.wave >> 2, d = (F.wave >> 1) & 1, pb = F.wave & 1, hh = F.lane >> 5, head = g * 4 + hr * 2 + r2;
        const LAS unsigned char* TX = F.lds + TS + (r2 * 2 + d) * TSX;
        f32x16 acc[4] = {ZERO16, ZERO16, ZERO16, ZERO16};
#pragma unroll 1
        for (int ks = 0; ks < 8; ++ks) { const bf16x8 a = frag_tr(TX, LDX, 16 * ks, 32 * pb, F.lane);
#pragma unroll
            for (int nb = 0; nb < 4; ++nb) acc[nb] = MFMA32(a, frag_tr(TB, LDT, 16 * ks, 32 * nb, F.lane), acc[nb]); }
        bf16* o = WSP(bf16, WS_SDLOC) + (size_t)((cp * 2 + d) * 8 + head) * 8192;
#pragma unroll
        for (int nb = 0; nb < 4; ++nb)
#pragma unroll
            for (int i = 0; i < 16; ++i) o[(32 * pb + crow(i, hh)) * 128 + 32 * nb + (F.lane & 31)] = (bf16)f2bf(acc[nb][i]);
        BAR();
    }
}
__device__ __forceinline__ void ssd_out_item(Frame F, KArgs& A, int l, int cp, bf16* Ybase) {
    const Seq sq = seq_of(cp);
    LAS unsigned char* TC = F.lds; LAS unsigned char* TB = F.lds + TS; LAS unsigned char* TX2 = F.lds + 2 * TS; LAS unsigned char* YI = F.lds + 3 * TS;
    LAS float* SSQ = SCA(14);
    if (F.tid < 128) SSQ[F.tid] = 0.f;
    const int tb = F.wave >> 1, ph = F.wave & 1, hh = F.lane >> 5, t = 32 * tb + (F.lane & 31);
    bf16* Yd = Ybase + (size_t)cp * 128 * D + 1536;
#pragma unroll 1
    for (int g = 0; g < 2; ++g) {
        (void)ssd_scalars<false>(F, A, l, cp, g);
        load_xbcc<16>(F, TC, LDT, 768 + g * 128, cp * 128);
        load_xbcc<16>(F, TB, LDT, 512 + g * 128, cp * 128);
        load_xbcc<16>(F, TX2, LDT, g * 256, cp * 128);
        BAR();
        f32x16 cb[4] = {ZERO16, ZERO16, ZERO16, ZERO16};
#pragma unroll 1
        for (int ks = 0; ks < 8; ++ks) { const bf16x8 bq = frag_row(TC, LDT, 32 * tb, 16 * ks, F.lane);
#pragma unroll
            for (int sb = 0; sb < 4; ++sb) cb[sb] = MFMA32(frag_row(TB, LDT, 32 * sb, 16 * ks, F.lane), bq, cb[sb]); }
#pragma unroll 1
        for (int hr = 0; hr < 2; ++hr) {
            if (hr == 1) { load_xbcc<16>(F, TX2, LDT, g * 256 + 128, cp * 128); BAR(); }
            f32x16 y2[2];
#pragma unroll
            for (int r2 = 0; r2 < 2; ++r2) {
                const int rr = hr * 2 + r2, head = g * 4 + rr;
                f32x16 y = ZERO16;
#pragma unroll 1
                for (int d = 0; d < 2; ++d) {
                    const LAS float* cum = SCA(16 + d * 4 + rr); const LAS float* dtv = SCA(24 + d * 4 + rr); const float ct = cum[t];
                    const bool has_state = sq.lat || (d == 0 ? sq.c > 0 : sq.c < sq.nch - 1);
                    bf16x8 bh[8];
                    if (has_state) { const bf16* hin = WSP(const bf16, WS_SDIN) + (size_t)((cp * 2 + d) * 8 + head) * 8192;
#pragma unroll
                        for (int ks = 0; ks < 8; ++ks) bh[ks] = *(const bf16x8*)(hin + (size_t)(32 * ph + (F.lane & 31)) * 128 + 16 * ks + 8 * hh); }
#pragma unroll
                    for (int sb = 0; sb < 4; ++sb) if (d == 0 ? sb <= tb : sb >= tb) {
#pragma unroll
                        for (int sp = 0; sp < 2; ++sp) { float p[8];
#pragma unroll
                            for (int jh = 0; jh < 2; ++jh) { const int s0 = 32 * sb + 16 * sp + 8 * jh + 4 * hh; const f32x4 c4 = *(const LAS f32x4*)(cum + s0), d4 = *(const LAS f32x4*)(dtv + s0);
#pragma unroll
                                for (int j = 0; j < 4; ++j) { const int s = s0 + j; float v = cb[sb][8 * sp + 4 * jh + j] * __expf(ct - c4[j]) * d4[j];
                                    if (sb == tb) { const bool ok = d == 0 ? (s <= t) : (s >= t); v = ok ? v : 0.f; }
                                    p[4 * jh + j] = v; } }
                            y = MFMA32(__builtin_bit_cast(bf16x8, pack8(p, 1.f)), frag_trp(TX2, LDT, 32 * sb + 16 * sp, r2 * 64 + 32 * ph, F.lane), y); } }
                    if (has_state) { f32x16 ch = ZERO16;
#pragma unroll
                        for (int ks = 0; ks < 8; ++ks) ch = MFMA32(frag_row(TC, LDT, 32 * tb, 16 * ks, F.lane), bh[ks], ch);
#pragma unroll
                        for (int k4 = 0; k4 < 4; ++k4) { const f32x4 c4 = *(const LAS f32x4*)(cum + 32 * tb + 8 * k4 + 4 * hh);
#pragma unroll
                            for (int i = 0; i < 4; ++i) y[4 * k4 + i] += __expf(c4[i]) * ch[4 * k4 + i]; } }
                }
                y2[r2] = y;
            }
#pragma unroll
            for (int r2 = 0; r2 < 2; ++r2)
#pragma unroll
                for (int i = 0; i < 16; ++i) *(LAS unsigned short*)(YI + (32 * tb + crow(i, hh)) * LDT + (r2 * 64 + 32 * ph + (F.lane & 31)) * 2) = (unsigned short)f2bf(y2[r2][i]);
            BAR();
            { const int tt = F.tid >> 2, seg = F.tid & 3, head = g * 4 + hr * 2 + (seg >> 1), pc = (seg & 1) * 32; const float Dh = INP(I_SSDD)[l * 8 + head]; float ss = 0.f;
#pragma unroll
                for (int k = 0; k < 4; ++k) { float yv[8], x[8], z[8], o[8];
                    unpack8(*(const LAS v4u*)(YI + tt * LDT + (seg * 32 + 8 * k) * 2), yv); unpack8(*(const LAS v4u*)(TX2 + tt * LDT + (seg * 32 + 8 * k) * 2), x);
                    unpack8(*(const v4u*)(PT(cp, PC_DZ + head * 64 + pc) + (size_t)tt * 128 + 8 * k), z);
#pragma unroll
                    for (int j = 0; j < 8; ++j) { const float v = (yv[j] + Dh * x[j]) * siluf_(z[j]); o[j] = v; ss += v * v; }
                    *(v4u*)(Yd + (size_t)tt * D + head * 64 + pc + 8 * k) = pack8(o, 1.f); }
                ss += __shfl_xor(ss, 1); ss += __shfl_xor(ss, 2);
                if (seg == 0) SSQ[tt] += ss; }
            BAR();
        }
    }
    __builtin_amdgcn_fence(__ATOMIC_RELEASE, "workgroup"); asm volatile("s_waitcnt vmcnt(0)" ::: "memory"); __syncthreads(); __builtin_amdgcn_fence(__ATOMIC_ACQUIRE, "workgroup");
    { const int tt = F.tid >> 2, seg = F.tid & 3; const float r = rsqrtf(SSQ[tt] * (1.f / 512.f) + EPS); const float* gn = INP(I_SNORM) + (size_t)l * GWID + 128 * seg;
#pragma unroll 4
        for (int k = 0; k < 16; ++k) { bf16* p = Yd + (size_t)tt * D + 128 * seg + 8 * k; float v[8];
            unpack8(*(const v4u*)p, v);
#pragma unroll
            for (int j = 0; j < 8; ++j) v[j] = v[j] * r * gn[8 * k + j];
            *(v4u*)p = pack8(v, 1.f); } }
    BAR();
}
template <int PASS> __device__ __forceinline__ void s5_item(Frame F, KArgs& A, int l, int cp, int gq) {
    const Seq sq = seq_of(cp);
    const int g = gq * 8 + F.wave, p = F.lane, hh = F.lane >> 5;
    LAS unsigned char* TU = F.lds; LAS unsigned char* BU = F.lds + TS + F.wave * 8704;
    if (PASS == 1) ITS(8);
    typedef short v8s __attribute__((ext_vector_type(8)));
    typedef float f32x4v __attribute__((ext_vector_type(4)));
    const int r16 = F.lane & 15, g4 = F.lane >> 4;
    v4u ru[4]; tile_issue(F, PT(cp, PC_S5U + gq * 128), ru);
    f32x2 lam[2], l8[2], h0[2]; bf16x8 bbf[2][4]; v8s ctf[2][4];
#pragma unroll
    for (int d = 0; d < 2; ++d) {
        const unsigned char* tab = s5tab(F, l, d, g);
        lam[d] = ((const f32x2*)tab)[p]; l8[d] = ((const f32x2*)(tab + 512))[p]; h0[d] = (f32x2){0.f, 0.f};
        if (PASS == 1 && sq.lat) { const size_t o = (size_t)(((sq.b * 4 + l) * 2 + d) * 32 + g) * 64 + p; h0[d] = (f32x2){INP(I_SS5R)[o], INP(I_SS5I)[o]}; }
        const bf16* bb = (const bf16*)(tab + 1024); const bf16* ct = (const bf16*)(tab + 5120);
#pragma unroll
        for (int nb = 0; nb < 4; ++nb) bbf[d][nb] = *(const bf16x8*)(bb + (size_t)(32 * nb + (F.lane & 31)) * 16 + 8 * hh);
        if (PASS == 1 && d == 0) {
#pragma unroll
            for (int ks = 0; ks < 4; ++ks) ctf[0][ks] = *(const v8s*)(ct + r16 * 128 + 32 * ks + 8 * g4); }
    }
    if (PASS == 1) {
        f32x2 e[31];
#pragma unroll
        for (int j = 0; j < 31; ++j) if (j < sq.nch - 1) { const int cc = j < sq.c ? j : j + 1, dd = j < sq.c ? 0 : 1;
            e[j] = *(const f32x2*)(WSP(const float, WS_S5LOC) + ((size_t)(((sq.cp0 + cc) * 2 + dd) * 32 + g) * 64 + p) * 2); }
#pragma unroll
        for (int j = 0; j < 31; ++j) if (j < sq.c) { const float nr = l8[0].x * h0[0].x - l8[0].y * h0[0].y + e[j].x, ni = l8[0].x * h0[0].y + l8[0].y * h0[0].x + e[j].y; h0[0] = (f32x2){nr, ni}; }
#pragma unroll
        for (int j = 30; j >= 0; --j) if (j >= sq.c && j < sq.nch - 1) { const float nr = l8[1].x * h0[1].x - l8[1].y * h0[1].y + e[j].x, ni = l8[1].x * h0[1].y + l8[1].y * h0[1].x + e[j].y; h0[1] = (f32x2){nr, ni}; }
    }
    tile_commit(F, TU, ru, 1.f);
    BAR();
    if (PASS == 1) { ITE(8); ITS(9); }
    f32x4v yacc[4][2];
    if (PASS == 1) {
#pragma unroll
        for (int a = 0; a < 4; ++a) { yacc[a][0] = (f32x4v){0.f, 0.f, 0.f, 0.f}; yacc[a][1] = (f32x4v){0.f, 0.f, 0.f, 0.f}; } }
#pragma unroll
    for (int d = 0; d < 2; ++d) {
        const float lr = lam[d].x, li = lam[d].y;
        float hr = h0[d].x, hi = h0[d].y;
        if (PASS == 1 && d == 1) { const bf16* ct = (const bf16*)(s5tab(F, l, 1, g) + 5120);
#pragma unroll
            for (int ks = 0; ks < 4; ++ks) ctf[1][ks] = *(const v8s*)(ct + r16 * 128 + 32 * ks + 8 * g4); }
#pragma unroll 1
        for (int tbi = 0; tbi < 4; ++tbi) {
            const int tb = d == 0 ? tbi : 3 - tbi;
            const bf16x8 bu = frag_row(TU, LDT, 32 * tb, 16 * F.wave, F.lane);
#pragma unroll
            for (int nb = 0; nb < 4; ++nb) {
                const f32x16 acc = MFMA32(bbf[d][nb], bu, ZERO16);
#pragma unroll
                for (int i4 = 0; i4 < 4; ++i4) *(LAS u32x2*)(BU + (F.lane & 31) * LDT + (32 * nb + 8 * i4 + 4 * hh) * 2) = (u32x2){pk2(acc[4 * i4], acc[4 * i4 + 1]), pk2(acc[4 * i4 + 2], acc[4 * i4 + 3])};
            }
            asm volatile("s_waitcnt lgkmcnt(0)" ::: "memory");
            unsigned w[32];
#pragma unroll
            for (int st = 0; st < 32; ++st) { const int tl = d == 0 ? st : 31 - st; w[st] = *(const LAS unsigned*)(BU + tl * LDT + p * 4); }
#pragma unroll
            for (int st = 0; st < 32; ++st) { const float br = bflo(w[st]), bi = bfhi(w[st]);
                const float nr = lr * hr - li * hi + br, ni = lr * hi + li * hr + bi; hr = nr; hi = ni;
                if (PASS == 1) w[st] = pk2(hr, hi); }
            if (PASS == 1) {
#pragma unroll
                for (int st = 0; st < 32; ++st) { const int tl = d == 0 ? st : 31 - st; *(LAS unsigned*)(BU + tl * LDT + p * 4) = w[st]; }
                asm volatile("s_waitcnt lgkmcnt(0)" ::: "memory");
                f32x4v y0 = (f32x4v){0.f, 0.f, 0.f, 0.f}, y1 = y0;
#pragma unroll
                for (int ks = 0; ks < 4; ++ks) {
                    y0 = __builtin_amdgcn_mfma_f32_16x16x32_bf16(*(const LAS v8s*)(BU + r16 * LDT + (32 * ks + 8 * g4) * 2), ctf[d][ks], y0, 0, 0, 0);
                    y1 = __builtin_amdgcn_mfma_f32_16x16x32_bf16(*(const LAS v8s*)(BU + (16 + r16) * LDT + (32 * ks + 8 * g4) * 2), ctf[d][ks], y1, 0, 0, 0); }
                if (tb == 0) { yacc[0][0] += y0; yacc[0][1] += y1; } else if (tb == 1) { yacc[1][0] += y0; yacc[1][1] += y1; } else if (tb == 2) { yacc[2][0] += y0; yacc[2][1] += y1; } else { yacc[3][0] += y0; yacc[3][1] += y1; }
                asm volatile("s_waitcnt lgkmcnt(0)" ::: "memory");
            }
        }
        if (PASS == 0) { *(f32x2*)(WSP(float, WS_S5LOC) + ((size_t)((cp * 2 + d) * 32 + g) * 64 + p) * 2) = (f32x2){hr, hi}; }
        else if (!sq.lat && ((d == 0 && sq.c == sq.nch - 1) || (d == 1 && sq.c == 0))) { const size_t o = (size_t)(((sq.b * 4 + l) * 2 + d) * 32 + g) * 64 + p; F.out[O_S5R + o] = hr; F.out[O_S5I + o] = hi; }
    }
    if (PASS == 1) { ITE(9); ITS(10); }
    if (PASS == 1) {
        const float Dc = INP(I_S5D)[(size_t)l * GWID + g * 16 + r16];
#pragma unroll
        for (int tb = 0; tb < 4; ++tb)
#pragma unroll
            for (int ts = 0; ts < 2; ++ts)
#pragma unroll
                for (int i = 0; i < 4; ++i) { const int t = 32 * tb + 16 * ts + 4 * g4 + i; LAS unsigned short* up = (LAS unsigned short*)(TU + t * LDT + (16 * F.wave + r16) * 2);
                    const float x = yacc[tb][ts][i] + Dc * bf2f(*up);
                    const float u2 = 1.5957691216057308f * (x + 0.044715f * x * x * x); const float ge = x - x * __builtin_amdgcn_rcpf(1.f + __expf(u2));
                    *up = (unsigned short)f2bf(ge); }
        BAR();
        bf16* ya = WSP(bf16, WS_YA) + (size_t)cp * 128 * GWID + gq * 128;
#pragma unroll
        for (int it = 0; it < 4; ++it) { const int i = F.tid + NT * it, r = i >> 4, c = i & 15; *(v4u*)(ya + (size_t)r * GWID + c * 8) = *(const LAS v4u*)(TU + r * LDT + c * 16); }
    }
    BAR();
    if (PASS == 1) ITE(10);
}

template <bool LAT> __device__ __forceinline__ void carry_unit(Frame F, KArgs& A, int l, int u) {
    const int sd = u / 96, rem = u % 96, sidx = sd >> 1, d = sd & 1;
    constexpr int lat = LAT ? 1 : 0, nch = LAT ? 32 : 2, NB = LAT ? 16 : 2;
    const int b = LAT ? sidx : sidx - 4, cp0 = LAT ? 64 + 32 * b : 2 * b;
    int type, head, slice;
    if (rem < 32) { type = 0; head = rem >> 3; slice = rem & 7; } else if (rem < 64) { type = 1; head = (rem - 32) >> 3; slice = (rem - 32) & 7; } else { type = 2; head = (rem - 64) >> 2; slice = (rem - 64) & 3; }
    const int e0 = slice * 2048 + F.tid * 4;
    const int nh = type == 2 ? 8 : 4, esz = type == 2 ? 8192 : 16384;
    const bf16* loc = type == 0 ? WSP(const bf16, WS_MLCLOC) : (type == 1 ? WSP(const bf16, WS_RTLOC) : WSP(const bf16, WS_SDLOC));
    bf16* inb = type == 0 ? WSP(bf16, WS_MLCIN) : (type == 1 ? WSP(bf16, WS_RTIN) : WSP(bf16, WS_SDIN));
    float zf = 0.f; asm volatile("" : "+v"(zf));
    float v[4] = {zf, zf, zf, zf}, nv[4] = {zf, zf, zf, zf}, m = 0.f;
    const bool do_n = (type == 0 && slice == 0 && F.tid < 32);
    if (LAT) {
        if (type == 2) { const f32x4 s = *(const f32x4*)(INP(I_SSSD) + (size_t)(((b * 4 + l) * 2 + d) * 8 + head) * 8192 + e0); v[0] = s.x; v[1] = s.y; v[2] = s.z; v[3] = s.w; }
        else { const float* s = (type == 0 ? INP(I_SMC) : INP(I_SRET)) + (size_t)(((b * 4 + l) * 2 + d) * 4 + head) * 16384; const int dv = e0 >> 7, dk = e0 & 127;
#pragma unroll
            for (int j = 0; j < 4; ++j) v[j] = s[(dk + j) * 128 + dv]; }
        if (type == 0) { m = INP(I_SMM)[((b * 4 + l) * 2 + d) * 4 + head];
            if (do_n) { const f32x4 s = *(const f32x4*)(INP(I_SMN) + (size_t)(((b * 4 + l) * 2 + d) * 4 + head) * 128 + F.tid * 4); nv[0] = s.x; nv[1] = s.y; nv[2] = s.z; nv[3] = s.w; } }
    }
    const float rdec = type == 1 ? __expf(-128.f * __expf(INP(I_RRATE)[(l * 2 + d) * 4 + head])) : 1.f;
#pragma unroll 1
    for (int ci0 = 0; ci0 < nch; ci0 += NB) {
        u32x2 lc[NB]; f32x4 ln[NB]; float s0[NB], s1[NB];
#pragma unroll
        for (int j = 0; j < NB; ++j) { ln[j] = (f32x4){zf, zf, zf, zf}; s0[j] = zf; s1[j] = zf; }
#pragma unroll
        for (int j = 0; j < NB; ++j) {
            const int ci = ci0 + j, cp = cp0 + (d == 0 ? ci : nch - 1 - ci);
            lc[j] = *(const u32x2*)(loc + (size_t)((cp * 2 + d) * nh + head) * esz + e0);
            if (type == 0) { const float* sc = WSP(const float, WS_MLSC) + ((cp * 2 + d) * 4 + head) * 2; s0[j] = sc[0]; s1[j] = sc[1];
                if (do_n) ln[j] = *(const f32x4*)(WSP(const float, WS_MLNLOC) + ((cp * 2 + d) * 4 + head) * 128 + F.tid * 4); }
            else if (type == 2) s0[j] = WSP(const float, WS_SDSC)[(cp * 2 + d) * 8 + head];
        }
#pragma unroll
        for (int j = 0; j < NB; ++j) {
            const int ci = ci0 + j, cp = cp0 + (d == 0 ? ci : nch - 1 - ci);
            const size_t so = (size_t)((cp * 2 + d) * nh + head) * esz + e0;
            if (LAT || ci > 0) *(u32x2*)(inb + so) = (u32x2){pk2(v[0], v[1]), pk2(v[2], v[3])};
            float dec, wl = 1.f;
            if (type == 0) {
                const float Bt = s0[j], ml = s1[j];
                if (slice == 0 && F.tid == 0) WSP(float, WS_MLMIN)[(cp * 2 + d) * 4 + head] = m;
                if (do_n) *(f32x4*)(WSP(float, WS_MLNIN) + ((cp * 2 + d) * 4 + head) * 128 + F.tid * 4) = (f32x4){nv[0], nv[1], nv[2], nv[3]};
                const float mn = fmaxf(Bt + m, ml); dec = __expf(Bt + m - mn); wl = __expf(ml - mn); m = mn;
                if (do_n) { nv[0] = dec * nv[0] + wl * ln[j].x; nv[1] = dec * nv[1] + wl * ln[j].y; nv[2] = dec * nv[2] + wl * ln[j].z; nv[3] = dec * nv[3] + wl * ln[j].w; }
            } else if (type == 1) dec = rdec;
            else dec = __expf(s0[j]);
            v[0] = dec * v[0] + wl * bflo(lc[j].x); v[1] = dec * v[1] + wl * bfhi(lc[j].x); v[2] = dec * v[2] + wl * bflo(lc[j].y); v[3] = dec * v[3] + wl * bfhi(lc[j].y);
        }
    }
    if (!lat) {
        if (type == 2) *(f32x4*)(F.out + O_SSD + (size_t)(((b * 4 + l) * 2 + d) * 8 + head) * 8192 + e0) = (f32x4){v[0], v[1], v[2], v[3]};
        else {
            LAS float* tr = (LAS float*)F.lds;
            const int dvl = F.tid >> 5, dk = (F.tid & 31) * 4;
#pragma unroll
            for (int j = 0; j < 4; ++j) tr[dvl * 129 + dk + j] = v[j];
            BAR();
            const int dk2 = F.tid >> 2, q = F.tid & 3;
            float* o = F.out + (type == 0 ? O_MC : O_RET) + (size_t)(((b * 4 + l) * 2 + d) * 4 + head) * 16384 + (size_t)dk2 * 128 + slice * 16 + 4 * q;
            *(f32x4*)o = (f32x4){tr[(4 * q) * 129 + dk2], tr[(4 * q + 1) * 129 + dk2], tr[(4 * q + 2) * 129 + dk2], tr[(4 * q + 3) * 129 + dk2]};
            if (type == 0) { if (do_n) *(f32x4*)(F.out + O_MN + (size_t)(((b * 4 + l) * 2 + d) * 4 + head) * 128 + F.tid * 4) = (f32x4){nv[0], nv[1], nv[2], nv[3]};
                if (slice == 0 && F.tid == 0) F.out[O_MM + ((b * 4 + l) * 2 + d) * 4 + head] = m; }
            BAR();
        }
    }
}

struct CtxLd { u32x2 lc[2]; f32x4 ln[2]; float s0[2], s1[2]; };
struct CtxU { int d, b, cp0, type, head, slice, e0, nh, esz; bool do_n; };
__device__ __forceinline__ CtxU ctx_decode(const Frame& F, int u) {
    CtxU c; const int sd = u / 96, rem = u % 96, sidx = sd >> 1; c.d = sd & 1; c.b = sidx - 4; c.cp0 = 2 * c.b;
    if (rem < 32) { c.type = 0; c.head = rem >> 3; c.slice = rem & 7; } else if (rem < 64) { c.type = 1; c.head = (rem - 32) >> 3; c.slice = (rem - 32) & 7; } else { c.type = 2; c.head = (rem - 64) >> 2; c.slice = (rem - 64) & 3; }
    c.e0 = c.slice * 2048 + F.tid * 4; c.nh = c.type == 2 ? 8 : 4; c.esz = c.type == 2 ? 8192 : 16384; c.do_n = (c.type == 0 && c.slice == 0 && F.tid < 32);
    return c;
}
__device__ __forceinline__ void carry_ctx_load(const Frame& F, int u, CtxLd& L, float zf) {
    const CtxU c = ctx_decode(F, u);
    const bf16* loc = c.type == 0 ? WSP(const bf16, WS_MLCLOC) : (c.type == 1 ? WSP(const bf16, WS_RTLOC) : WSP(const bf16, WS_SDLOC));
#pragma unroll
    for (int j = 0; j < 2; ++j) { const int cp = c.cp0 + (c.d == 0 ? j : 1 - j);
        L.ln[j] = (f32x4){zf, zf, zf, zf}; L.s0[j] = zf; L.s1[j] = zf;
        L.lc[j] = *(const u32x2*)(loc + (size_t)((cp * 2 + c.d) * c.nh + c.head) * c.esz + c.e0);
        if (c.type == 0) { const float* sc = WSP(const float, WS_MLSC) + ((cp * 2 + c.d) * 4 + c.head) * 2; L.s0[j] = sc[0]; L.s1[j] = sc[1];
            if (c.do_n) L.ln[j] = *(const f32x4*)(WSP(const float, WS_MLNLOC) + ((cp * 2 + c.d) * 4 + c.head) * 128 + F.tid * 4); }
        else if (c.type == 2) L.s0[j] = WSP(const float, WS_SDSC)[(cp * 2 + c.d) * 8 + c.head]; }
}
__device__ __forceinline__ void carry_ctx_finish(Frame& F, KArgs& A, int l, int u, const CtxLd& L, float zf) {
    const CtxU c = ctx_decode(F, u);
    bf16* inb = c.type == 0 ? WSP(bf16, WS_MLCIN) : (c.type == 1 ? WSP(bf16, WS_RTIN) : WSP(bf16, WS_SDIN));
    float v[4] = {zf, zf, zf, zf}, nv[4] = {zf, zf, zf, zf}, m = 0.f;
    const float rdec = c.type == 1 ? __expf(-128.f * __expf(INP(I_RRATE)[(l * 2 + c.d) * 4 + c.head])) : 1.f;
#pragma unroll
    for (int j = 0; j < 2; ++j) { const int cp = c.cp0 + (c.d == 0 ? j : 1 - j);
        if (j > 0) *(u32x2*)(inb + (size_t)((cp * 2 + c.d) * c.nh + c.head) * c.esz + c.e0) = (u32x2){pk2(v[0], v[1]), pk2(v[2], v[3])};
        float dec, wl = 1.f;
        if (c.type == 0) {
            if (c.slice == 0 && F.tid == 0) WSP(float, WS_MLMIN)[(cp * 2 + c.d) * 4 + c.head] = m;
            if (c.do_n) *(f32x4*)(WSP(float, WS_MLNIN) + ((cp * 2 + c.d) * 4 + c.head) * 128 + F.tid * 4) = (f32x4){nv[0], nv[1], nv[2], nv[3]};
            const float mn = fmaxf(L.s0[j] + m, L.s1[j]); dec = __expf(L.s0[j] + m - mn); wl = __expf(L.s1[j] - mn); m = mn;
            if (c.do_n) { nv[0] = dec * nv[0] + wl * L.ln[j].x; nv[1] = dec * nv[1] + wl * L.ln[j].y; nv[2] = dec * nv[2] + wl * L.ln[j].z; nv[3] = dec * nv[3] + wl * L.ln[j].w; }
        } else if (c.type == 1) dec = rdec;
        else dec = __expf(L.s0[j]);
        v[0] = dec * v[0] + wl * bflo(L.lc[j].x); v[1] = dec * v[1] + wl * bfhi(L.lc[j].x); v[2] = dec * v[2] + wl * bflo(L.lc[j].y); v[3] = dec * v[3] + wl * bfhi(L.lc[j].y); }
    const int b = c.b, d = c.d, head = c.head, slice = c.slice, e0 = c.e0;
    if (c.type == 2) *(f32x4*)(F.out + O_SSD + (size_t)(((b * 4 + l) * 2 + d) * 8 + head) * 8192 + e0) = (f32x4){v[0], v[1], v[2], v[3]};
    else {
        LAS float* tr = (LAS float*)F.lds;
        const int dvl = F.tid >> 5, dk = (F.tid & 31) * 4;
#pragma unroll
        for (int j = 0; j < 4; ++j) tr[dvl * 129 + dk + j] = v[j];
        BAR();
        const int dk2 = F.tid >> 2, q = F.tid & 3;
        float* o = F.out + (c.type == 0 ? O_MC : O_RET) + (size_t)(((b * 4 + l) * 2 + d) * 4 + head) * 16384 + (size_t)dk2 * 128 + slice * 16 + 4 * q;
        *(f32x4*)o = (f32x4){tr[(4 * q) * 129 + dk2], tr[(4 * q + 1) * 129 + dk2], tr[(4 * q + 2) * 129 + dk2], tr[(4 * q + 3) * 129 + dk2]};
        if (c.type == 0) { if (c.do_n) *(f32x4*)(F.out + O_MN + (size_t)(((b * 4 + l) * 2 + d) * 4 + head) * 128 + F.tid * 4) = (f32x4){nv[0], nv[1], nv[2], nv[3]};
            if (slice == 0 && F.tid == 0) F.out[O_MM + ((b * 4 + l) * 2 + d) * 4 + head] = m; }
        BAR();
    }
}
__device__ __forceinline__ void carry_ctx_batch(Frame F, KArgs& A, int l, int u0) {
    float zf = 0.f; asm volatile("" : "+v"(zf));
    CtxLd L[8];
#pragma unroll
    for (int j = 0; j < 8; ++j) carry_ctx_load(F, u0 + j, L[j], zf);
#pragma unroll
    for (int j = 0; j < 8; ++j) carry_ctx_finish(F, A, l, u0 + j, L[j], zf);
}
constexpr int CW_Q = 16384;
struct OneUnit { pg8::Unit u; __device__ __forceinline__ bool next(int i, pg8::Unit& o) const { if (i) return false; o = u; return true; }
    __device__ __forceinline__ void a_ready(const pg8::Unit&) const {} __device__ __forceinline__ void done(const pg8::Unit&) const {} };
#define QUEUE_LOOP(F0_, qidx, total, ...) do { \
    unsigned* qc_ = (unsigned*)(F0_.ws + WS_CTL) + CW_Q + 64 * (qidx); volatile LAS int* qs_ = (volatile LAS int*)(F0_.lds + MISC_OFF + 64); \
    if (F0_.tid == 0) qs_[0] = (int)__hip_atomic_fetch_add(qc_, 1u, __ATOMIC_RELAXED, __HIP_MEMORY_SCOPE_AGENT); \
    __syncthreads(); \
    int it = qs_[0], par_ = 1; \
    while (it < (total)) { \
        int nx_ = 0; if (F0_.tid == 0) nx_ = (int)__hip_atomic_fetch_add(qc_, 1u, __ATOMIC_RELAXED, __HIP_MEMORY_SCOPE_AGENT); \
        { __VA_ARGS__ } \
        if (F0_.tid == 0) qs_[par_] = nx_; \
        BAR();     \
        it = qs_[par_]; par_ ^= 1; \
    } } while (0)
#ifndef PROBE_ITEM
#define PROBE_ITEM -1
#endif
#define PR(t) (PROBE_ITEM == (t) ? 2 : 1)
#define QSPLIT(NT_, C0, C1, C2, C3, T0) int ty_ = 0, loc_ = it, dup_ = 0; { const int cnt_[4] = {C0, C1, C2, C3}; \
    _Pragma("unroll") for (int j_ = 0; j_ < NT_; ++j_) { const int span_ = cnt_[j_] * PR(T0 + j_); if (ty_ == j_) { if (loc_ >= span_) { loc_ -= span_; ty_ = j_ + 1; } else { dup_ = loc_ / cnt_[j_]; loc_ = loc_ % cnt_[j_]; } } } }
#ifndef PROBE_TMASK
#define PROBE_TMASK 0
#endif
#ifndef PROBE_TAMP
#define PROBE_TAMP 4
#endif
#define TSTART(k) do { if (PROBE_TMASK & (1 << (k))) pt0_ = __builtin_amdgcn_s_memrealtime(); } while (0)
#define TEND(k) do { if (PROBE_TMASK & (1 << (k))) ptacc_ += __builtin_amdgcn_s_memrealtime() - pt0_; } while (0)
#ifndef PROBE_REPEAT
#define PROBE_REPEAT -1
#endif
#ifndef XSTG
#define XSTG 0
#endif
constexpr int N_PHASES = 2 + 9 * NLAYER;
__global__ void __launch_bounds__(NT, 2) hymba_fwd(Args A) {
    extern __shared__ __attribute__((aligned(16))) unsigned char lds_raw[];
    Frame F0;
    F0.lds = (LAS unsigned char*)lds_raw;
    F0.tid = threadIdx.x; F0.lane = 0; F0.wave = __builtin_amdgcn_readfirstlane(F0.tid >> 6);
    F0.G = gridDim.x; F0.bid = blockIdx.x; F0.out = A.out; F0.ws = A.ws;
    volatile LAS unsigned* MISC = (volatile LAS unsigned*)(F0.lds + MISC_OFF);
    if (F0.tid < 64) MISC[F0.tid] = 0u;
    __syncthreads();
    unsigned* barw = (unsigned*)(F0.ws + WS_CTL) + CW_BAR;
    XcdBarrier bar = xcd_barrier_post(barw, MISC + 8, F0.wave == 0 ? 1u : 0u);
    const int lo = A.ph_lo, hi = A.ph_hi;
    unsigned long long pt0_ = 0, ptacc_ = 0;
#define KA (*kargs())
#define IN(k) (lo <= (k) && (k) < hi)
#define SEAM(k) do { if (IN(k) && IN((k) + 1)) xcd_barrier(bar); } while (0)
#define CSEAM(k) do { if (IN(k) && IN((k) + 1)) { if (__builtin_amdgcn_readfirstlane((int)MISC[11]) == 2) xcc_barrier(bar); else xcd_barrier(bar); } } while (0)
#define XCC_ORDER(S_, M_, N_) pg8::XccOrder S_; S_.init(M_, N_, F.G, F.bid, __builtin_amdgcn_readfirstlane((int)MISC[11]) == 2 ? 1 : 0, (int)bar.x, __builtin_amdgcn_readfirstlane((int)MISC[10]))

    TSTART(9); if (IN(0)) for (int rep_ = 0; rep_ < (PROBE_REPEAT == 100 ? 2 : 1); ++rep_) { Frame F = fresh(F0); p0_prologue(F, KA); } SEAM(0); TEND(9);

    TSTART(10); if (IN(1)) { Frame F = fresh(F0); norm0_phase(F, KA); shw_phase(F); } SEAM(1); TEND(10);

#pragma unroll 1
    for (int l = 0; l < NLAYER; ++l) {
        const int pb = 1 + 9 * l;
        TSTART(1); if (IN(pb + 1)) for (int rep_ = 0; rep_ < (PROBE_REPEAT == 1 ? 2 : 1); ++rep_) { Frame F = fresh(F0);
            pg8::Gemm g{WSP(const pg8::bf16_t, WS_H), WSP(const pg8::bf16_t, WS_W1T) + (size_t)l * NPAD * D, M, NPROJ, D}; pg8::StaticOrder S; S.init(M, NPROJ, F.G, F.bid);
            epi::EpiProj E{WSP(pg8::bf16_t, WS_PROJ), WSP(const float, WS_SSQB), WSP(const float, WS_SHW1) + (size_t)l * 5 * NPAD};
            pg8::gemm_phase<epi::EpiProj, pg8::StaticOrder, true, true>(F.lds, g, S, E, F.tid);
            __syncthreads(); gates_phase(F, l);
        } SEAM(pb + 1); TEND(1);
        TSTART(2); if (IN(pb + 2)) { Frame F = fresh(F0);
            QUEUE_LOOP(F, l * 3 + 0, 384 * PR(0) + 768 * PR(1) + 768 * PR(2) + 768 * PR(3), {
                QSPLIT(4, 384, 768, 768, 768, 0);
                if (ty_ == 0) { TSTART(11); ssd_local_item(fresh(F), KA, l, loc_ >> 1, loc_ & 1); TEND(11); }
                else if (ty_ == 1) { TSTART(12); mlstm_local_item(fresh(F), KA, l, loc_ >> 2, loc_ & 3); TEND(12); }
                else if (ty_ == 2) { TSTART(13); ret_local_item(fresh(F), KA, l, loc_ >> 2, loc_ & 3); TEND(13); }
                else { TSTART(14); s5_item<0>(fresh(F), KA, l, loc_ >> 2, loc_ & 3); TEND(14); }
            });
        } SEAM(pb + 2); TEND(2);
        TSTART(3); if (IN(pb + 3)) { Frame F = fresh(F0);
            QUEUE_LOOP(F, l * 3 + 1, 768 * PR(4) + 768 * PR(5) + 768 * PR(6), {
                QSPLIT(3, 768, 768, 768, 0, 4);
                if (ty_ == 0) { TSTART(15); carry_unit<true>(fresh(F), KA, l, loc_); TEND(15); }
                else if (ty_ == 1) { TSTART(16); s5_item<1>(fresh(F), KA, l, loc_ >> 2, loc_ & 3); TEND(16); }
                else { TSTART(17); carry_ctx_batch(fresh(F), KA, l, 768 + loc_ * 8); TEND(17); }
            });
        } SEAM(pb + 3); TEND(3);
        TSTART(4); if (IN(pb + 4)) { Frame F = fresh(F0);
            QUEUE_LOOP(F, l * 3 + 2, 192 * PR(7) + 192 * PR(8) + 768 * PR(9) + 768 * PR(10), {
                QSPLIT(4, 192, 192, 768, 768, 7);
                if (ty_ == 0) { TSTART(18); ssd_out_item(fresh(F), KA, l, loc_, dup_ ? WSP(bf16, WS_MLCLOC) : WSP(bf16, WS_Y)); TEND(18); }
                else if (ty_ == 1) { TSTART(19); Frame Fg = fresh(F);
                    pg8::Gemm g{WSP(const pg8::bf16_t, WS_YA), WSP(const pg8::bf16_t, WS_WGT) + (size_t)l * GWID * GWID, M, GWID, GWID}; OneUnit S; S.u.pm = loc_ >> 1; S.u.pn = loc_ & 1;
                    epi::EpiGlu E{WSP(const pg8::bf16_t, WS_YA), WSP(pg8::bf16_t, WS_Y)};
                    pg8::gemm_phase<epi::EpiGlu, OneUnit, false, true>(Fg.lds, g, S, E, Fg.tid); __syncthreads(); TEND(19); }
                else if (ty_ == 2) { TSTART(20); mlstm_out_item(fresh(F), KA, l, loc_ >> 2, loc_ & 3); TEND(20); }
                else { TSTART(21); ret_out_item(fresh(F), KA, l, loc_ >> 2, loc_ & 3); TEND(21); }
            });
        } SEAM(pb + 4); TEND(4);
        TSTART(5); if (IN(pb + 5)) { Frame F = fresh(F0);
            pg8::Gemm g{WSP(const pg8::bf16_t, WS_Y), WSP(const pg8::bf16_t, WS_WOT) + (size_t)l * D * D, M, D, D}; XCC_ORDER(S, M, D);
            if (XSTG > 0 && S.mode) { const unsigned long long t0_ = __builtin_amdgcn_s_memrealtime(), w_ = (unsigned long long)((S.j >> 3) * XSTG); while (__builtin_amdgcn_s_memrealtime() - t0_ < w_) __builtin_amdgcn_s_sleep(8); }
            KArgs& A_ = KA; epi::EpiRes E{(const float*)(const GAS float*)A_.in[I_XP], (const float*)(const GAS float*)A_.in[I_XS], WSP(pg8::bf16_t, WS_XB), WSP(const float, WS_MOD) + (size_t)(l * 5) * (6 * D) + 2 * D, l == 0 ? 1 : 0,
                          1, WSP(pg8::bf16_t, WS_H), WSP(float, WS_SSQA), (const float*)(const GAS float*)A_.in[I_NORM2] + (size_t)l * D, WSP(const float, WS_MOD) + (size_t)(l * 5) * (6 * D) + 4 * D, F.lds + 131072};
            pg8::gemm_phase<epi::EpiRes, pg8::XccOrder, true, true>(F.lds, g, S, E, F.tid);
        } CSEAM(pb + 5); TEND(5);
        TSTART(7); if (IN(pb + 7)) for (int rep_ = 0; rep_ < (PROBE_REPEAT == 7 ? 2 : 1); ++rep_) { Frame F = fresh(F0);
            pg8::Gemm g{WSP(const pg8::bf16_t, WS_H), WSP(const pg8::bf16_t, WS_WM1T) + (size_t)l * DFF * D, M, DFF, D}; XCC_ORDER(S, M, DFF);
            epi::EpiRelu2 E{WSP(pg8::bf16_t, WS_HID), WSP(const float, WS_SSQA), WSP(const float, WS_SHW2) + (size_t)l * 5 * DFF};
            pg8::gemm_phase<epi::EpiRelu2, pg8::XccOrder, true, true>(F.lds, g, S, E, F.tid);
        } CSEAM(pb + 7); TEND(7);
        TSTART(8); if (IN(pb + 8)) { Frame F = fresh(F0);
            pg8::Gemm g{WSP(const pg8::bf16_t, WS_HID), WSP(const pg8::bf16_t, WS_WM2T) + (size_t)l * D * DFF, M, D, DFF}; XCC_ORDER(S, M, D);
            KArgs& A_ = KA; epi::EpiRes E{(const float*)(const GAS float*)A_.in[I_XP], (const float*)(const GAS float*)A_.in[I_XS], WSP(pg8::bf16_t, WS_XB), WSP(const float, WS_MOD) + (size_t)(l * 5) * (6 * D) + 5 * D, 0,
                          l < NLAYER - 1 ? 1 : 0, WSP(pg8::bf16_t, WS_H), WSP(float, WS_SSQB), (const float*)(const GAS float*)A_.in[I_NORM1] + (size_t)(l + 1) * D, WSP(const float, WS_MOD) + (size_t)((l + 1) * 5) * (6 * D) + 1 * D, F.lds + 131072};
            pg8::gemm_phase<epi::EpiRes, pg8::XccOrder, true, true>(F.lds, g, S, E, F.tid);
        } SEAM(pb + 8); TEND(8);
    }
    if (IN(N_PHASES - 1)) { Frame F = fresh(F0); final_norm_phase(F, KA); }
    if (PROBE_IMASK != 0 && F0.bid == 0 && F0.wave == 0 && lane_id() == 0) { const unsigned long long acc_ = ((volatile LAS unsigned long long*)(F0.lds + MISC_OFF + 128))[1], te_ = __builtin_amdgcn_s_memrealtime();
        while (__builtin_amdgcn_s_memrealtime() - te_ < (unsigned long long)PROBE_TAMP * acc_) __builtin_amdgcn_s_sleep(32); }
    if (PROBE_TMASK != 0 && F0.bid == 0) { const unsigned long long te_ = __builtin_amdgcn_s_memrealtime(); while (__builtin_amdgcn_s_memrealtime() - te_ < (unsigned long long)PROBE_TAMP * ptacc_) __builtin_amdgcn_s_sleep(32); }
#undef IN
#undef SEAM
}

#ifndef MK_LAUNCH_PER_PHASE
#define MK_LAUNCH_PER_PHASE 0
#endif
extern "C" void kernel_launch(void* const* d_in, const int* in_sizes, int n_in, void* d_out, int out_size, void* d_ws, size_t ws_size, hipStream_t stream) {
    static int grid = 0;
    if (grid == 0) {
        if (n_in != N_IN || (size_t)out_size != O_END || ws_size < WS_END) { fprintf(stderr, "kernel_launch: shape mismatch: n_in %d out %d ws %zu (need %zu)\n", n_in, out_size, ws_size, (size_t)WS_END); grid = -1; return; }
        int dev = 0, cus = 0, per_cu = 0;
        if (hipGetDevice(&dev) != hipSuccess || hipDeviceGetAttribute(&cus, hipDeviceAttributeMultiprocessorCount, dev) != hipSuccess) { grid = -1; return; }
        if (hipFuncSetAttribute((const void*)hymba_fwd, hipFuncAttributeMaxDynamicSharedMemorySize, LDS_BYTES) != hipSuccess) { fprintf(stderr, "kernel_launch: hipFuncSetAttribute failed\n"); grid = -1; return; }
        if (hipOccupancyMaxActiveBlocksPerMultiprocessor(&per_cu, (const void*)hymba_fwd, NT, LDS_BYTES) != hipSuccess || per_cu < 1) fprintf(stderr, "kernel_launch: occupancy query says %d\n", per_cu);
        (void)hipGetLastError();
        grid = cus;
    }
    if (grid < 0) return;
    (void)hipMemsetAsync((char*)d_ws + WS_CTL, 0, CTL_ZERO_BYTES, stream);
    Args a{};
    for (int i = 0; i < N_IN; ++i) a.in[i] = (const float*)d_in[i];
    a.out = (float*)d_out; a.ws = (unsigned char*)d_ws;
#if MK_LAUNCH_PER_PHASE
    for (int p = 0; p < N_PHASES; ++p) { a.ph_lo = p; a.ph_hi = p + 1; hipLaunchKernelGGL(hymba_fwd, dim3(grid), dim3(NT), LDS_BYTES, stream, a); }
#else
    a.ph_lo = 0; a.ph_hi = N_PHASES;
    hipLaunchKernelGGL(hymba_fwd, dim3(grid), dim3(NT), LDS_BYTES, stream, a);
#endif
    const hipError_t le = hipPeekAtLastError();
    if (le != hipSuccess) fprintf(stderr, "kernel_launch: launch failed: %s\n", hipGetErrorName(le));
}
```

```cpp
#include <hip/hip_runtime.h>
#include <cstdio>
#include <cstdint>
namespace pg8 {
#define PG8_LAS __attribute__((address_space(3)))
typedef unsigned short bf16_t;
typedef short bf16x8 __attribute__((ext_vector_type(8)));
typedef float f32x4 __attribute__((ext_vector_type(4)));
typedef unsigned u32x4 __attribute__((ext_vector_type(4)));
constexpr int BM = 256, BK = 64, HALF = 128, HTB = HALF * BK * 2  , STAGE_BYTES = 8 * HTB, NXCD = 8, WGM = 8;

__host__ __device__ __forceinline__ int lds_byte(int r, int c) { const int st = (r >> 4) * 2 + (c >> 5), rr = r & 15, cc = c & 31, ob = rr * 64 + cc * 2; return st * 1024 + (ob ^ (((ob >> 9) & 1) << 5)); }
__host__ __device__ __forceinline__ void stage_rc(int b, int& R, int& C) { const int st = b / 1024, sb = b % 1024, swz = sb ^ (((sb >> 9) & 1) << 5); R = (st >> 1) * 16 + swz / 64; C = (st & 1) * 32 + (swz % 64) / 2; }
__host__ __device__ __forceinline__ int perm32(int rho) { const int n = rho >> 4, i = rho & 15; return 8 * (i >> 2) + 4 * n + (i & 3); }

struct Unit { int pm, pn; };
struct Gemm { const bf16_t* A; const bf16_t* Bt; int M, N, K; };

struct StaticOrder {
    int nM, nN, nwg, G, c;
    __host__ __device__ void init(int M, int N, int G_, int c_) { nM = M / BM; nN = N / BM; nwg = nM * nN; G = G_; c = c_; }
    __host__ __device__ bool next(int i, Unit& u) const {
        const long L = (long)i * G + c; if (L >= nwg) return false;
        int wgid = (int)L; { const int q = nwg / NXCD, r = nwg % NXCD, xcd = wgid % NXCD, off = wgid / NXCD; wgid = (xcd < r ? xcd * (q + 1) : r * (q + 1) + (xcd - r) * q) + off; }
        const int nig = WGM * nN, gid = wgid / nig, fm = gid * WGM, gsz = (nM - fm) < WGM ? (nM - fm) : WGM;
        u.pm = fm + ((wgid % nig) % gsz); u.pn = (wgid % nig) / gsz; return true;
    }
    __device__ __forceinline__ void a_ready(const Unit&) const {}
    __device__ __forceinline__ void done(const Unit&) const {}
};

struct XccOrder {
    StaticOrder so; int mode, x, j, nN;
    __host__ __device__ void init(int M, int N, int G_, int c_, int mode_, int x_, int j_) { so.init(M, N, G_, c_); mode = mode_; x = x_; j = j_; nN = N / BM; }
    __host__ __device__ bool next(int i, Unit& u) const {
        if (!mode) return so.next(i, u);
        const int w = i * 32 + j; if (w >= 12 * nN) return false;
        const int q4 = 4 * nN, pg = w / q4, r = w - pg * q4;
        u.pm = 12 * x + 4 * pg + (r & 3); u.pn = r >> 2; return true;
    }
    __device__ __forceinline__ void a_ready(const Unit&) const {}
    __device__ __forceinline__ void done(const Unit&) const {}
};

__device__ __forceinline__ unsigned cvt_pk_bf16(float lo, float hi) { unsigned r; asm volatile("v_cvt_pk_bf16_f32 %0, %1, %2" : "=v"(r) : "v"(lo), "v"(hi)); return r; }
typedef float f32x2 __attribute__((ext_vector_type(2)));
#ifndef PROBE_KLOOP
#define PROBE_KLOOP 0
#endif
template <class Epi, class Sched, bool ALIGN_EPI = false, bool SP2 = false>
__device__ __forceinline__ void gemm_phase(PG8_LAS unsigned char* lds, const Gemm g, const Sched& S, const Epi& E, int tid_in) {
    int tid_ = tid_in; asm volatile("" : "+v"(tid_));
    const int tid = tid_, wid = __builtin_amdgcn_readfirstlane(tid >> 6), lane = tid & 63, wr = wid >> 2, wc = wid & 3, fr = lane & 15, fq = lane >> 4;
    const int K = g.K, nt = K / BK;
    unsigned voffA[2], voffB[2];
#pragma unroll
    for (int i = 0; i < 2; ++i) { int R, C; stage_rc(tid * 16 + i * 8192, R, C); const int Rb = Epi::PERM ? ((R & ~31) + perm32(R & 31)) : R;
        voffA[i] = (unsigned)(R * K + C) * 2u; voffB[i] = (unsigned)(Rb * K + C) * 2u; }
    const size_t kstep = (size_t)(BK * 2);
    const size_t hstep = (size_t)HALF * K * 2;
    const size_t tstep = 2 * hstep;
    const unsigned ldsw = (unsigned)wid * 1024u;
    const int aoff = lds_byte(wr * 64 + fr, fq * 8), boff = lds_byte(wc * 32 + fr, fq * 8);
#define PG8_SA(b, h) (((b) * 2 + (h)) * HTB)
#define PG8_SB(b, h) ((4 + (b) * 2 + (h)) * HTB)
#define PG8_STAGE(bufoff, gbase, voff) do { _Pragma("unroll") for (int _i = 0; _i < 2; ++_i) \
        __builtin_amdgcn_global_load_lds((const unsigned*)((const char*)(gbase) + (voff)[_i]), (PG8_LAS unsigned*)(lds + (bufoff) + ldsw + _i * 8192), 16, 0, 0); } while (0)
#define PG8_LDA(dst, b, h) do { _Pragma("unroll") for (int m = 0; m < 4; ++m) _Pragma("unroll") for (int k = 0; k < 2; ++k) dst[m][k] = *(const PG8_LAS bf16x8*)(lds + PG8_SA(b, h) + aoff + m * 2048 + k * 1024); } while (0)
#define PG8_LDB(dst, b, h) do { _Pragma("unroll") for (int n = 0; n < 2; ++n) _Pragma("unroll") for (int k = 0; k < 2; ++k) dst[n][k] = *(const PG8_LAS bf16x8*)(lds + PG8_SB(b, h) + boff + n * 2048 + k * 1024); } while (0)
#define PG8_MMA(ai, bj, At, Bt) do { __builtin_amdgcn_s_setprio(1); _Pragma("unroll") for (int m = 0; m < 4; ++m) _Pragma("unroll") for (int n = 0; n < 2; ++n) _Pragma("unroll") for (int k = 0; k < 2; ++k) \
        acc[ai][bj][m][n] = __builtin_amdgcn_mfma_f32_16x16x32_bf16(Bt[n][k], At[m][k], acc[ai][bj][m][n], 0, 0, 0); __builtin_amdgcn_s_setprio(0); } while (0)
#define PG8_WAIT_V(n) asm volatile("s_waitcnt vmcnt(" #n ")" ::: "memory")
#define PG8_WAIT_L(n) asm volatile("s_waitcnt lgkmcnt(" #n ")" ::: "memory")
#define PG8_BAR __builtin_amdgcn_s_barrier()
#define PG8_SCHED __builtin_amdgcn_sched_barrier(0)
    Unit cur, nxt; int ui = 0;
    if (!S.next(0, cur)) return;
    f32x4 acc[2][2][4][2];
#pragma unroll
    for (int a = 0; a < 2; ++a)
#pragma unroll
        for (int b = 0; b < 2; ++b)
#pragma unroll
            for (int m = 0; m < 4; ++m)
#pragma unroll
                for (int n = 0; n < 2; ++n) acc[a][b][m][n] = (f32x4){0.f, 0.f, 0.f, 0.f};
    bf16x8 At[4][2], B0[2][2], B1[2][2];
    const char* cA = (const char*)g.A + (size_t)cur.pm * tstep; const char* cB = (const char*)g.Bt + (size_t)cur.pn * tstep;
    S.a_ready(cur);
    if constexpr (SP2) {
        PG8_STAGE(PG8_SB(0, 0), cB, voffB); PG8_STAGE(PG8_SB(0, 1), cB + hstep, voffB); PG8_STAGE(PG8_SA(0, 0), cA, voffA); PG8_STAGE(PG8_SA(0, 1), cA + hstep, voffA);
        if (wr == 1) PG8_BAR;
        PG8_WAIT_V(2); PG8_BAR;
        PG8_STAGE(PG8_SB(1, 0), cB + kstep, voffB); PG8_STAGE(PG8_SA(1, 0), cA + kstep, voffA); PG8_STAGE(PG8_SB(1, 1), cB + hstep + kstep, voffB);
        PG8_WAIT_V(6); PG8_BAR;
    } else {
        PG8_STAGE(PG8_SB(0, 0), cB, voffB); PG8_STAGE(PG8_SA(0, 0), cA, voffA); PG8_STAGE(PG8_SB(0, 1), cB + hstep, voffB); PG8_STAGE(PG8_SA(0, 1), cA + hstep, voffA);
        if (wr == 1) PG8_BAR;
        PG8_WAIT_V(4); PG8_BAR;
        PG8_STAGE(PG8_SB(1, 0), cB + kstep, voffB); PG8_STAGE(PG8_SA(1, 0), cA + kstep, voffA); PG8_STAGE(PG8_SB(1, 1), cB + hstep + kstep, voffB);
        PG8_WAIT_V(6); PG8_BAR;
    }
    for (;;) {
        const bool has_next = S.next(ui + 1, nxt);
        const char* nA = has_next ? (const char*)g.A + (size_t)nxt.pm * tstep : cA; const char* nB = has_next ? (const char*)g.Bt + (size_t)nxt.pn * tstep : cB;
        for (int t = 0; t < nt; t += 2) {
            const bool last = (t == nt - 2);
            const char* a1 = cA + (size_t)(t + 1) * kstep;
            const char* a2 = last ? nA : cA + (size_t)(t + 2) * kstep; const char* b2 = last ? nB : cB + (size_t)(t + 2) * kstep;
            const char* a3 = a2 + kstep; const char* b3 = b2 + kstep;
            if (last && has_next) S.a_ready(nxt);
#if PROBE_KLOOP == 1
            if (blockIdx.x == 0 && tid == 0) { volatile PG8_LAS unsigned long long* p_ = (volatile PG8_LAS unsigned long long*)(lds + 163584 + 128);
                if (t == 4) p_[0] = __builtin_amdgcn_s_memrealtime(); if (t == nt - 4) p_[1] += __builtin_amdgcn_s_memrealtime() - p_[0]; }
#elif PROBE_KLOOP == 2
            if (blockIdx.x == 0 && tid == 0 && g.N == PROBE_SELN && g.K == PROBE_SELK) { volatile PG8_LAS unsigned long long* p_ = (volatile PG8_LAS unsigned long long*)(lds + 163584 + 128);
                if (t == 4 && ui > 0) p_[1] += __builtin_amdgcn_s_memrealtime() - p_[0]; if (t == nt - 4) p_[0] = __builtin_amdgcn_s_memrealtime(); }
#endif
            if constexpr (SP2) {
            PG8_LDB(B0, 0, 0); PG8_LDB(B1, 0, 1); PG8_SCHED; PG8_LDA(At, 0, 0); PG8_STAGE(PG8_SA(1, 1), a1 + hstep, voffA);
            PG8_WAIT_V(8); PG8_WAIT_L(0); PG8_BAR; PG8_MMA(0, 0, At, B0); PG8_MMA(0, 1, At, B1); PG8_BAR; PG8_SCHED;
            PG8_LDA(At, 0, 1); PG8_STAGE(PG8_SB(0, 0), b2, voffB); PG8_STAGE(PG8_SB(0, 1), b2 + hstep, voffB); PG8_STAGE(PG8_SA(0, 0), a2, voffA);
            PG8_WAIT_V(8); PG8_WAIT_L(0); PG8_BAR; PG8_MMA(1, 0, At, B0); PG8_MMA(1, 1, At, B1); PG8_BAR; PG8_SCHED;
            PG8_LDB(B0, 1, 0); PG8_LDB(B1, 1, 1); PG8_SCHED; PG8_LDA(At, 1, 0); PG8_STAGE(PG8_SA(0, 1), a2 + hstep, voffA);
            PG8_WAIT_V(8); PG8_WAIT_L(0); PG8_BAR; PG8_MMA(0, 0, At, B0); PG8_MMA(0, 1, At, B1); PG8_BAR; PG8_SCHED;
            PG8_LDA(At, 1, 1); PG8_STAGE(PG8_SB(1, 0), b3, voffB); PG8_STAGE(PG8_SB(1, 1), b3 + hstep, voffB); PG8_STAGE(PG8_SA(1, 0), a3, voffA);
            PG8_WAIT_V(8); PG8_WAIT_L(0); PG8_BAR; PG8_MMA(1, 0, At, B0); PG8_MMA(1, 1, At, B1); PG8_BAR; PG8_SCHED;
            } else {
            PG8_LDB(B0, 0, 0); PG8_SCHED; PG8_LDA(At, 0, 0); PG8_STAGE(PG8_SA(1, 1), a1 + hstep, voffA);
            PG8_WAIT_L(8); PG8_BAR; PG8_WAIT_L(0); PG8_MMA(0, 0, At, B0); PG8_BAR; PG8_SCHED;
            PG8_LDB(B1, 0, 1); PG8_STAGE(PG8_SB(0, 0), b2, voffB);
            PG8_BAR; PG8_WAIT_L(0); PG8_MMA(0, 1, At, B1); PG8_BAR;
            PG8_LDA(At, 0, 1); PG8_STAGE(PG8_SA(0, 0), a2, voffA);
            PG8_BAR; PG8_WAIT_L(0); PG8_MMA(1, 0, At, B0); PG8_BAR; PG8_SCHED;
            PG8_STAGE(PG8_SB(0, 1), b2 + hstep, voffB);
            PG8_WAIT_V(6); PG8_BAR; PG8_MMA(1, 1, At, B1); PG8_BAR;
            PG8_LDB(B0, 1, 0); PG8_SCHED; PG8_LDA(At, 1, 0); PG8_STAGE(PG8_SA(0, 1), a2 + hstep, voffA);
            PG8_WAIT_L(8); PG8_BAR; PG8_WAIT_L(0); PG8_MMA(0, 0, At, B0); PG8_BAR; PG8_SCHED;
            PG8_LDB(B1, 1, 1); PG8_STAGE(PG8_SB(1, 0), b3, voffB);
            PG8_BAR; PG8_WAIT_L(0); PG8_MMA(0, 1, At, B1); PG8_BAR;
            PG8_LDA(At, 1, 1); PG8_STAGE(PG8_SA(1, 0), a3, voffA);
            PG8_BAR; PG8_WAIT_L(0); PG8_MMA(1, 0, At, B0); PG8_BAR; PG8_SCHED;
            PG8_STAGE(PG8_SB(1, 1), b3 + hstep, voffB);
            PG8_WAIT_V(6); PG8_BAR; PG8_MMA(1, 1, At, B1); PG8_BAR;
            }
        }
        if constexpr (ALIGN_EPI) { if (wr == 0) PG8_BAR; }
        if constexpr (!Epi::AFTER_DRAIN) { E(acc, cur, wr, wc, fr, fq); S.done(cur); }
        if (!has_next) break;
#pragma unroll
        for (int a = 0; a < 2; ++a)
#pragma unroll
            for (int b = 0; b < 2; ++b)
#pragma unroll
                for (int m = 0; m < 4; ++m)
#pragma unroll
                    for (int n = 0; n < 2; ++n) acc[a][b][m][n] = (f32x4){0.f, 0.f, 0.f, 0.f};
        cur = nxt; cA = nA; cB = nB; ++ui;
        if constexpr (ALIGN_EPI) { if (wr == 1) PG8_BAR; }
    }
    PG8_WAIT_V(0);
    if constexpr (!ALIGN_EPI) { if (wr == 0) PG8_BAR; }
    PG8_BAR;
    if constexpr (Epi::AFTER_DRAIN) { E.fused(acc, cur, wr, wc, fr, fq, lds, wid, lane); S.done(cur); }
#undef PG8_SA
#undef PG8_SB
#undef PG8_STAGE
#undef PG8_LDA
#undef PG8_LDB
#undef PG8_MMA
#undef PG8_WAIT_V
#undef PG8_WAIT_L
#undef PG8_BAR
#undef PG8_SCHED
}
}
#define GAS __attribute__((address_space(1)))
#define LAS __attribute__((address_space(3)))
typedef unsigned short bf16;
typedef unsigned v4u __attribute__((ext_vector_type(4)));
typedef float f32x4 __attribute__((ext_vector_type(4)));
typedef short bf16x8 __attribute__((ext_vector_type(8)));
typedef GAS unsigned gu32;
typedef GAS unsigned long long gu64;
#define RLX_AGENT __ATOMIC_RELAXED, __HIP_MEMORY_SCOPE_AGENT
#define LDS_WAIT() asm volatile("s_waitcnt lgkmcnt(0)" ::: "memory")
#define VM_WAIT() asm volatile("s_waitcnt vmcnt(0)" ::: "memory")
__device__ __forceinline__ unsigned long long rt() { return __builtin_amdgcn_s_memrealtime(); }
typedef __bf16 hwbf16x2_t __attribute__((ext_vector_type(2)));
typedef float hwf32x2_t __attribute__((ext_vector_type(2)));
__device__ __forceinline__ unsigned pk2(float lo, float hi) { const hwf32x2_t v = {lo, hi}; const hwbf16x2_t b = __builtin_convertvector(v, hwbf16x2_t); return __builtin_bit_cast(unsigned, b); }
__device__ __forceinline__ unsigned f2bf(float f) { return pk2(f, 0.f) & 0xffffu; }
#define XB_TMO      128
#define XB_XCNT(j)  (256  + 64 * (j))
#define XB_XSUB(j)  (1280 + 64 * (j))
#define XB_XGEN(j)  (2304 + 64 * (j))
#define XB_TOP      3328
#define XB_TOPGEN   3392
#define XCD_BAR_WORDS 3456
#define XB_LSUB(j)  (3456 + 64 * (j))
#define XB_SPIN_CAP (1u << 18)
#ifndef XB_EARLY_WB
#define XB_EARLY_WB 0
#endif
#ifndef PROBE_FORCE_MODE0
#define PROBE_FORCE_MODE0 0
#endif

__device__ __forceinline__ unsigned xb_ld(unsigned* p)              { return __hip_atomic_load(p, __ATOMIC_RELAXED, __HIP_MEMORY_SCOPE_AGENT); }
__device__ __forceinline__ unsigned xb_add(unsigned* p, unsigned v) { return __hip_atomic_fetch_add(p, v, __ATOMIC_RELAXED, __HIP_MEMORY_SCOPE_AGENT); }
__device__ __forceinline__ unsigned xb_xcc_id() { return (unsigned)__builtin_amdgcn_s_getreg((3 << 11) | 20) & 0xFu; }
#define XB_SPIN(cond, bar) do { unsigned _sp = 0; while (cond) { __builtin_amdgcn_s_sleep(1); \
    if ((++_sp & 255u) == 0u) { if (xb_ld(&(bar)[XB_TMO])) break; if (_sp > XB_SPIN_CAP) { atomicAdd(&(bar)[XB_TMO], 1u); break; } } } } while (0)

struct XcdBarrier {
    unsigned wave0;
    unsigned* bar; unsigned x;
    volatile LAS unsigned* st;
};

__device__ __forceinline__ bool xb_lane0() { return __builtin_amdgcn_mbcnt_hi(~0u, __builtin_amdgcn_mbcnt_lo(~0u, 0u)) == 0u; }
__device__ __forceinline__ XcdBarrier xcd_barrier_post(unsigned* bar, volatile LAS unsigned* st, unsigned wave0) {
    XcdBarrier b; b.wave0 = wave0; b.bar = bar; b.x = xb_xcc_id(); b.st = st;
    if (wave0 && xb_lane0()) st[2] = xb_add(&bar[XB_XCNT(b.x)], 1u);
    return b;
}
__device__ __forceinline__ void xcd_barrier_complete(unsigned* bar, unsigned x, unsigned& nloc, unsigned& nx, unsigned& even) {
    const unsigned G = gridDim.x * gridDim.y * gridDim.z;
    unsigned sum, cnt, mine, bad, sp = 0u;
    for (;;) {
        sum = 0u; cnt = 0u; mine = 0u; bad = 0u;
#pragma unroll
        for (unsigned j = 0; j < 16; ++j) { const unsigned c = xb_ld(&bar[XB_XCNT(j)]); sum += c; cnt += (c > 0u) ? 1u : 0u; mine = (j == x) ? c : mine; bad |= (c != (j < 8u ? 32u : 0u)) ? 1u : 0u; }
        if (sum == G) break;
        __builtin_amdgcn_s_sleep(1);
        if ((++sp & 255u) == 0u) { if (xb_ld(&bar[XB_TMO])) break; if (sp > XB_SPIN_CAP) { atomicAdd(&bar[XB_TMO], 1u); break; } }
    }
    nloc = mine > 0u ? mine : 1u; nx = cnt > 0u ? cnt : 1u; even = (sum == G && G == 256u && bad == 0u && !PROBE_FORCE_MODE0) ? 2u : 1u;
}

__device__ __forceinline__ void xcd_barrier(const XcdBarrier& b) {
    asm volatile("s_waitcnt vmcnt(0)" ::: "memory");
    __syncthreads();
    if (b.wave0 && xb_lane0()) {
        unsigned* bar = b.bar;
        __builtin_amdgcn_s_waitcnt(0);
        unsigned nloc = b.st[0], nx = b.st[1];
        if (nloc == 0u) { unsigned ev; xcd_barrier_complete(bar, b.x, nloc, nx, ev); b.st[0] = nloc; b.st[1] = nx; b.st[3] = ev; }
        const unsigned old = xb_add(&bar[XB_XSUB(b.x)], 1u);
        const unsigned gen = old / nloc;
        if (old + 1u == (gen + 1u) * nloc) {
            __builtin_amdgcn_fence(__ATOMIC_RELEASE, "agent");
            asm volatile("s_waitcnt vmcnt(0)" ::: "memory");
            const unsigned og = xb_add(&bar[XB_TOP], 1u);
            const unsigned tg = og / nx;
            if (og + 1u == (tg + 1u) * nx) xb_add(&bar[XB_TOPGEN], 1u);
            else XB_SPIN(xb_ld(&bar[XB_TOPGEN]) == tg, bar);
            __builtin_amdgcn_fence(__ATOMIC_ACQUIRE, "agent");
            xb_add(&bar[XB_XGEN(b.x)], 1u);
            asm volatile("s_waitcnt vmcnt(0)" ::: "memory");
        } else {
#if XB_EARLY_WB
            { const unsigned k_ = old - gen * nloc; if (k_ == 0u || k_ * 2u == nloc) __builtin_amdgcn_fence(__ATOMIC_RELEASE, "agent"); }
#endif
            XB_SPIN(xb_ld(&bar[XB_XGEN(b.x)]) == gen, bar);
            __builtin_amdgcn_fence(__ATOMIC_ACQUIRE, "agent");
            asm volatile("s_waitcnt vmcnt(0)" ::: "memory");
        }
    }
    __syncthreads();
}

__device__ __forceinline__ void xcc_barrier(const XcdBarrier& b) {
    asm volatile("s_waitcnt vmcnt(0)" ::: "memory");
    __syncthreads();
    if (b.wave0 && xb_lane0()) {
        unsigned* bar = b.bar;
        __builtin_amdgcn_s_waitcnt(0);
        const unsigned nloc = b.st[0];
        const unsigned old = xb_add(&bar[XB_LSUB(b.x)], 1u);
        const unsigned target = (old / nloc + 1u) * nloc;
        XB_SPIN(xb_ld(&bar[XB_LSUB(b.x)]) < target, bar);
        __builtin_amdgcn_fence(__ATOMIC_ACQUIRE, "agent");
        asm volatile("s_waitcnt vmcnt(0)" ::: "memory");
    }
    __syncthreads();
}
constexpr int NWAVES = 8, NT = 512;
constexpr int D = 2048, NLAYER = 4;
constexpr int MC = 32 * 256, ML = 4 * 4096, M = MC + ML;
constexpr int DIN = 6176, NPROJ = 6144, NPAD = 6400, DFF = 8192, GWID = 512;
constexpr int NCP = M / 128;
constexpr float EPS = 1e-6f;
constexpr int PC_S5U = 0, PC_MQ = 512, PC_MK = 1024, PC_MV = 1536, PC_MO = 2048, PC_RQ = 2560, PC_RK = 3072, PC_RV = 3584, PC_RG = 4096, PC_DZ = 4608, PC_DX = 5120, PC_DB = 5632, PC_DC = 5888;
enum { I_XP = 0, I_XS, I_C, I_SS5R, I_SS5I, I_SMC, I_SMN, I_SMM, I_SRET, I_SSSD, I_CCTX, I_NORM1, I_WADA, I_BADA, I_WIN, I_S5LR, I_S5LI, I_S5DT, I_S5BR, I_S5BI, I_S5CR, I_S5CI, I_S5D, I_S5GLU,
       I_MIB, I_MFB, I_MNORM, I_RRATE, I_RNORM, I_CONVW, I_CONVB, I_DTB, I_ALOG, I_SSDD, I_SNORM, I_WOUT, I_NORM2, I_WM1, I_WM2, I_FNORM, N_IN };
constexpr size_t O_YP = 0, O_YS = (size_t)MC * D, O_S5R = (size_t)M * D, O_S5I = O_S5R + 524288, O_MC = O_S5I + 524288, O_MN = O_MC + 16777216, O_MM = O_MN + 131072, O_RET = O_MM + 1024, O_SSD = O_RET + 16777216, O_END = O_SSD + 16777216;

constexpr size_t MiB = 1u << 20;
constexpr size_t WS_CTL = 0, CTL_ZERO_BYTES = 1 * MiB;
constexpr size_t WS_MOD = 1 * MiB;
constexpr size_t WS_S5T = 2 * MiB;
constexpr size_t WS_ROPE = 5 * MiB;
constexpr size_t WS_GATES = 6 * MiB;
constexpr size_t WS_MLNLOC = 9 * MiB;
constexpr size_t WS_MLNIN = 10 * MiB;
constexpr size_t WS_MLSC = 11 * MiB;
constexpr size_t WS_MLMIN = 11 * MiB + 65536;
constexpr size_t WS_SDSC = 11 * MiB + 131072;
constexpr size_t WS_SSQA = 5 * MiB + 65536;
constexpr size_t WS_SSQB = 11 * MiB + 262144;
constexpr size_t WS_SHW1 = 18 * MiB;
constexpr size_t WS_SHW2 = 19 * MiB;
constexpr size_t WS_S5LOC = 12 * MiB;
constexpr size_t WS_WGT = 20 * MiB;
constexpr size_t WS_W1T = 22 * MiB;
constexpr size_t WS_WOT = 122 * MiB;
constexpr size_t WS_WM1T = 154 * MiB;
constexpr size_t WS_WM2T = 282 * MiB;
constexpr size_t WS_H = 410 * MiB;
constexpr size_t WS_Y = 506 * MiB;
constexpr size_t WS_YA = 602 * MiB;
constexpr size_t WS_MLCIN = 626 * MiB;
constexpr size_t WS_RTIN = 674 * MiB;
constexpr size_t WS_SDIN = 722 * MiB;
constexpr size_t WS_PROJ = 770 * MiB;
constexpr size_t WS_MLCLOC = 1058 * MiB;
constexpr size_t WS_HID = 770 * MiB;
constexpr size_t WS_RTLOC = 1106 * MiB;
constexpr size_t WS_SDLOC = 1154 * MiB;
constexpr size_t WS_XBCC = 1202 * MiB;
constexpr size_t WS_XB = 1250 * MiB;
constexpr size_t WS_END = 1346 * MiB;
constexpr int CW_TMO = 0, CW_BAR = 4096;

constexpr int LDT = 272;
constexpr int TS = 128 * LDT;
constexpr int LDX = 144;
constexpr int TSX = 128 * LDX;
constexpr int SCAL_OFF = 4 * TS;
constexpr int MISC_OFF = 163840 - 256;
constexpr int LDS_BYTES = 163840;
#define SCA(i) ((LAS float*)(F.lds + SCAL_OFF + (i) * 512))
typedef float f32x16 __attribute__((ext_vector_type(16)));
typedef float f32x2 __attribute__((ext_vector_type(2)));
typedef short s16x4 __attribute__((ext_vector_type(4)));
typedef unsigned u32x2 __attribute__((ext_vector_type(2)));
struct Args { const float* in[N_IN]; float* out; unsigned char* ws; int ph_lo, ph_hi; };
struct Frame {
    LAS unsigned char* lds;
    float* out; unsigned char* ws;
    int tid, lane, wave, G, bid;
};
__device__ __forceinline__ int lane_id() { return (int)__builtin_amdgcn_mbcnt_hi(~0u, __builtin_amdgcn_mbcnt_lo(~0u, 0u)); }
typedef const __attribute__((address_space(4))) Args KArgs;
__device__ __forceinline__ KArgs* kargs() { KArgs* p = (KArgs*)__builtin_amdgcn_kernarg_segment_ptr(); asm volatile("" : "+s"(p)); return p; }
__device__ __forceinline__ Frame fresh(const Frame& F) { Frame R = F; unsigned long long l = (unsigned long long)(size_t)R.lds; unsigned ll = (unsigned)l; asm volatile("" : "+s"(ll), "+s"(R.wave), "+s"(R.G), "+s"(R.bid)); R.lane = lane_id(); asm volatile("" : "+v"(R.lane)); R.tid = R.wave * 64 + R.lane; R.lds = (LAS unsigned char*)(size_t)ll; KArgs* ka = kargs(); R.out = (float*)(GAS float*)ka->out; R.ws = (unsigned char*)(GAS unsigned char*)ka->ws; return R; }
#define INP(i) ((const float*)(const GAS float*)(A.in[i]))
#define BAR() __syncthreads()
#ifndef PROBE_IMASK
#define PROBE_IMASK 0
#endif
#define ITS(k) do { if ((PROBE_IMASK >> (k)) & 1) { if (F.tid == 0 && F.bid == 0) ((volatile LAS unsigned long long*)(F.lds + MISC_OFF + 128))[0] = __builtin_amdgcn_s_memrealtime(); } } while (0)
#define ITE(k) do { if ((PROBE_IMASK >> (k)) & 1) { if (F.tid == 0 && F.bid == 0) { volatile LAS unsigned long long* p_ = (volatile LAS unsigned long long*)(F.lds + MISC_OFF + 128); p_[1] += __builtin_amdgcn_s_memrealtime() - p_[0]; } } } while (0)
#define WSP(T, off) ((T*)(F.ws + (off)))
__device__ __forceinline__ float bf2f(unsigned short b) { return __uint_as_float((unsigned)b << 16); }
__device__ __forceinline__ float bflo(unsigned w) { return __uint_as_float(w << 16); }
__device__ __forceinline__ float bfhi(unsigned w) { return __uint_as_float(w & 0xffff0000u); }
__device__ __forceinline__ void unpack8(const v4u a, float (&x)[8]) { x[0] = bflo(a.x); x[1] = bfhi(a.x); x[2] = bflo(a.y); x[3] = bfhi(a.y); x[4] = bflo(a.z); x[5] = bfhi(a.z); x[6] = bflo(a.w); x[7] = bfhi(a.w); }
__device__ __forceinline__ v4u pack8(const float (&x)[8], float w) { v4u o; o.x = pk2(x[0] * w, x[1] * w); o.y = pk2(x[2] * w, x[3] * w); o.z = pk2(x[4] * w, x[5] * w); o.w = pk2(x[6] * w, x[7] * w); return o; }
__device__ __forceinline__ float sigmoidf_(float x) { return __builtin_amdgcn_rcpf(1.f + __expf(-x)); }
__device__ __forceinline__ float siluf_(float x) { return x * sigmoidf_(x); }
__device__ __forceinline__ float lshfl(float v, int src_lane) { return __builtin_bit_cast(float, __builtin_amdgcn_ds_bpermute(src_lane << 2, __builtin_bit_cast(int, v))); }
__device__ __forceinline__ float lshfl_xor(float v, int m, int lane) { return lshfl(v, lane ^ m); }
__device__ __forceinline__ float lshfl_up(float v, int o, int lane) { return lshfl(v, lane >= o ? lane - o : lane); }
__device__ __forceinline__ float wave_sum(float v) {
#pragma unroll
    for (int o = 1; o < 64; o <<= 1) v += __shfl_xor(v, o);
    return v;
}
__device__ __forceinline__ float wave_max(float v) {
#pragma unroll
    for (int o = 1; o < 64; o <<= 1) v = fmaxf(v, __shfl_xor(v, o));
    return v;
}
__device__ __forceinline__ float wave_sum_l(float v, int lane) {
#pragma unroll
    for (int o = 1; o < 64; o <<= 1) v += lshfl_xor(v, o, lane);
    return v;
}
__device__ __forceinline__ float wave_max_l(float v, int lane) {
#pragma unroll
    for (int o = 1; o < 64; o <<= 1) v = fmaxf(v, lshfl_xor(v, o, lane));
    return v;
}
template <bool MAX> __device__ __forceinline__ void wave_scan128(const LAS float* in, LAS float* out, int lane, bool rev, float init) {
    const int i0 = rev ? 127 - 2 * lane : 2 * lane, i1 = rev ? i0 - 1 : i0 + 1;
    float e0 = in[i0], e1 = in[i1];
    if (lane == 0) e0 = MAX ? fmaxf(e0, init) : e0 + init;
    float inc = MAX ? fmaxf(e0, e1) : e0 + e1;
#pragma unroll
    for (int o = 1; o < 64; o <<= 1) { const float t = __shfl_up(inc, o); if (lane >= o) inc = MAX ? fmaxf(inc, t) : inc + t; }
    float exc = __shfl_up(inc, 1);
    const float o0 = (lane == 0) ? e0 : (MAX ? fmaxf(exc, e0) : exc + e0);
    out[i0] = o0; out[i1] = inc;
}
__device__ __forceinline__ s16x4 lds_tr(const LAS unsigned char* p) {
    typedef short v4i16_t __attribute__((ext_vector_type(4)));
    return __builtin_bit_cast(s16x4, __builtin_amdgcn_ds_read_tr16_b64_v4i16((LAS v4i16_t*)p));
}
__device__ __forceinline__ bf16x8 frag_row(const LAS unsigned char* base, int ld, int r0, int k0, int lane) {
    return *(const LAS bf16x8*)(base + (r0 + (lane & 31)) * ld + (k0 + 8 * (lane >> 5)) * 2);
}
__device__ __forceinline__ bf16x8 frag_tr(const LAS unsigned char* base, int ld, int k0, int c0, int lane) {
    const int h = lane >> 5, blk = (lane >> 4) & 1, q = (lane & 15) >> 2, p = lane & 3;
    const LAS unsigned char* a = base + (k0 + 8 * h + q) * ld + (c0 + 16 * blk + 4 * p) * 2;
    const s16x4 lo = lds_tr(a), hi = lds_tr(a + 4 * ld);
    return (bf16x8){lo[0], lo[1], lo[2], lo[3], hi[0], hi[1], hi[2], hi[3]};
}
__device__ __forceinline__ bf16x8 frag_trp(const LAS unsigned char* base, int ld, int k0, int c0, int lane) {
    const int h = lane >> 5, blk = (lane >> 4) & 1, q = (lane & 15) >> 2, p = lane & 3;
    const LAS unsigned char* a = base + (k0 + 4 * h + q) * ld + (c0 + 16 * blk + 4 * p) * 2;
    const s16x4 lo = lds_tr(a), hi = lds_tr(a + 8 * ld);
    return (bf16x8){lo[0], lo[1], lo[2], lo[3], hi[0], hi[1], hi[2], hi[3]};
}
#define MFMA32(a, b, c) __builtin_amdgcn_mfma_f32_32x32x16_bf16((a), (b), (c), 0, 0, 0)
#define ZERO16 ((f32x16){0.f,0.f,0.f,0.f,0.f,0.f,0.f,0.f,0.f,0.f,0.f,0.f,0.f,0.f,0.f,0.f})
__device__ __forceinline__ int crow(int i, int hh) { return (i & 3) + 8 * (i >> 2) + 4 * hh; }

#define PT(cp, col) (WSP(const bf16, WS_PROJ) + ((size_t)(cp) * 48 + ((col) >> 7)) * 16384 + ((col) & 127))
#define XT(cp, ch) (WSP(bf16, WS_XBCC) + ((size_t)(cp) * 8 + ((ch) >> 7)) * 16384 + ((ch) & 127))
__device__ __forceinline__ const float* x_in_row(const Frame& F, KArgs& A, int l, int r) {
    if (l == 0) return r < MC ? INP(I_XP) + (size_t)r * D : INP(I_XS) + (size_t)(r - MC) * D;
    return F.out + (size_t)r * D;
}
__device__ __forceinline__ int mod_row(int r) { return r < MC ? 0 : 1 + (r - MC) / 4096; }
__device__ __forceinline__ const float* mod_ptr(const Frame& F, int l, int mrow, int part) { return WSP(const float, WS_MOD) + ((size_t)(l * 5 + mrow) * 6 + part) * D; }
struct Seq { int cp0, nch, c, b, lat; };
__device__ __forceinline__ Seq seq_of(int cp) { Seq s; if (cp < 64) { s.lat = 0; s.b = cp >> 1; s.cp0 = cp & ~1; s.nch = 2; s.c = cp & 1; } else { s.lat = 1; s.b = (cp - 64) >> 5; s.cp0 = 64 + (s.b << 5); s.nch = 32; s.c = (cp - 64) & 31; } return s; }
__device__ __forceinline__ int w1_newcol(int n) { return n < 2560 ? n : (n < 2576 ? n - 2560 + 6144 : (n < 6160 ? n - 16 : n)); }
template <bool MAPW1> __device__ __forceinline__ void p0_transpose_item(const float* W, int K, int N, bf16* WT, LAS float* scr, int item, int lane) {
    const int nblk = (N + 63) / 64, kb = item / nblk, nb = item % nblk, k0 = 64 * kb, n0 = 64 * nb;
    const int lr = lane >> 4, lc = (lane & 15) * 4; const bool cv = n0 + lc < N;
    f32x4 v[16];
#pragma unroll
    for (int i = 0; i < 16; ++i) v[i] = cv ? *(const f32x4*)(W + (size_t)(k0 + 4 * i + lr) * N + n0 + lc) : (f32x4){0.f, 0.f, 0.f, 0.f};
#pragma unroll
    for (int i = 0; i < 16; ++i) { LAS float* d = scr + (4 * i + lr) * 65 + lc; d[0] = v[i].x; d[1] = v[i].y; d[2] = v[i].z; d[3] = v[i].w; }
    LDS_WAIT(); asm volatile("" ::: "memory");
    const int c = lane & 7;
#pragma unroll
    for (int j = 0; j < 8; ++j) { const int n = (lane >> 3) + 8 * j; const LAS float* s = scr + (8 * c) * 65 + n;
        v4u o; o.x = pk2(s[0 * 65], s[1 * 65]); o.y = pk2(s[2 * 65], s[3 * 65]); o.z = pk2(s[4 * 65], s[5 * 65]); o.w = pk2(s[6 * 65], s[7 * 65]);
        const int nr = MAPW1 ? w1_newcol(n0 + n) : (n0 + n);
        if (n0 + n < N) *(GAS v4u*)(WT + (size_t)nr * K + k0 + 8 * c) = o; }
    LDS_WAIT(); asm volatile("" ::: "memory");
}
constexpr int S5T_STRIDE = 9216;
__device__ __forceinline__ unsigned char* s5tab(const Frame& F, int l, int d, int g) { return F.ws + WS_S5T + (size_t)((l * 2 + d) * 32 + g) * S5T_STRIDE; }

__device__ __forceinline__ void p0_prologue(Frame& F, KArgs& A) {
    {
        LAS float* scr = (LAS float*)(F.lds + F.wave * 16640);
        const int gw = F.bid * NWAVES + F.wave, NGW = F.G * NWAVES;
        constexpr int I_1 = (D / 64) * ((DIN + 63) / 64), I_G = (GWID / 64) * (GWID / 64), I_O = (D / 64) * (D / 64), I_M1 = (D / 64) * (DFF / 64), I_M2 = (DFF / 64) * (D / 64);
        constexpr int PER_L = I_1 + I_G + I_O + I_M1 + I_M2;
        for (int it = gw; it < NLAYER * PER_L; it += NGW) {
            const int l = it / PER_L; int r = it % PER_L;
            if (r < I_1) { p0_transpose_item<true>(INP(I_WIN) + (size_t)l * D * DIN, D, DIN, WSP(bf16, WS_W1T) + (size_t)l * NPAD * D, scr, r, F.lane); continue; } r -= I_1;
            if (r < I_G) { p0_transpose_item<false>(INP(I_S5GLU) + (size_t)l * GWID * GWID, GWID, GWID, WSP(bf16, WS_WGT) + (size_t)l * GWID * GWID, scr, r, F.lane); continue; } r -= I_G;
            if (r < I_O) { p0_transpose_item<false>(INP(I_WOUT) + (size_t)l * D * D, D, D, WSP(bf16, WS_WOT) + (size_t)l * D * D, scr, r, F.lane); continue; } r -= I_O;
            if (r < I_M1) { p0_transpose_item<false>(INP(I_WM1) + (size_t)l * D * DFF, D, DFF, WSP(bf16, WS_WM1T) + (size_t)l * DFF * D, scr, r, F.lane); continue; } r -= I_M1;
            p0_transpose_item<false>(INP(I_WM2) + (size_t)l * DFF * D, DFF, D, WSP(bf16, WS_WM2T) + (size_t)l * D * DFF, scr, r, F.lane);
        }
        const int gt = F.bid * NT + F.tid, NGT = F.G * NT;
        for (int i = gt; i < NLAYER * 224 * 256; i += NGT) { const int l = i / (224 * 256), r = i % (224 * 256);
            *(GAS v4u*)(WSP(bf16, WS_W1T) + ((size_t)l * NPAD + DIN) * D + (size_t)r * 8) = (v4u){0u, 0u, 0u, 0u}; }
        for (int i = gt; i < NLAYER * 2 * 32 * 64; i += NGT) {
            const int p = i & 63, g = (i >> 6) & 31, d = (i >> 11) & 1, l = i >> 12;
            const int ldg = (l * 2 + d) * 32 + g;
            const double lre = INP(I_S5LR)[ldg * 64 + p], lim = INP(I_S5LI)[ldg * 64 + p], dt = exp((double)INP(I_S5DT)[ldg]);
            const double er = exp(lre * dt), br = er * cos(lim * dt), bi = er * sin(lim * dt);
            const double e128 = exp(128.0 * lre * dt), b128r = e128 * cos(128.0 * lim * dt), b128i = e128 * sin(128.0 * lim * dt);
            const double nr = br - 1.0, ni = bi, den = lre * lre + lim * lim;
            const double cr = (nr * lre + ni * lim) / den, ci = (ni * lre - nr * lim) / den;
            unsigned char* tb = s5tab(F, l, d, g);
            float* lam = (float*)tb; lam[2 * p] = (float)br; lam[2 * p + 1] = (float)bi;
            float* l128 = (float*)(tb + 512); l128[2 * p] = (float)b128r; l128[2 * p + 1] = (float)b128i;
            bf16* bb = (bf16*)(tb + 1024); bf16* ct = (bf16*)(tb + 5120);
            for (int c = 0; c < 16; ++c) {
                const double Br = INP(I_S5BR)[(size_t)(ldg * 64 + p) * 16 + c], Bi = INP(I_S5BI)[(size_t)(ldg * 64 + p) * 16 + c];
                bb[(2 * p) * 16 + c] = (bf16)f2bf((float)(cr * Br - ci * Bi));
                bb[(2 * p + 1) * 16 + c] = (bf16)f2bf((float)(cr * Bi + ci * Br));
                ct[c * 128 + 2 * p] = (bf16)f2bf(INP(I_S5CR)[(size_t)(ldg * 16 + c) * 64 + p]);
                ct[c * 128 + 2 * p + 1] = (bf16)f2bf(-INP(I_S5CI)[(size_t)(ldg * 16 + c) * 64 + p]);
            }
        }
        for (int i = gt; i < 64 * 32; i += NGT) { const int pos = i >> 5, k = i & 31; const double f = pow(10000.0, -(double)k / 32.0), a = pos * f;
            WSP(f32x2, WS_ROPE)[i] = (f32x2){(float)cos(a), (float)sin(a)}; }
    }
    __syncthreads();
    {
        LAS float* sc = (LAS float*)F.lds;
        LAS float* red = (LAS float*)(F.lds + 65536);
        for (int i = F.tid; i < 5 * D; i += NT) { const int r = i / D, k = i % D; const float v = r == 0 ? INP(I_CCTX)[k] : INP(I_C)[(r - 1) * D + k]; sc[i] = siluf_(v); }
        __syncthreads();
        for (int it = F.bid; it < NLAYER * 96; it += F.G) {
            const int l = it / 96, c0 = (it % 96) * 128;
            const float* W = INP(I_WADA) + (size_t)l * D * (6 * D);
            float acc[5][4];
#pragma unroll
            for (int r = 0; r < 5; ++r)
#pragma unroll
                for (int j = 0; j < 4; ++j) acc[r][j] = 0.f;
            const int cl = F.lane & 31, kp = F.lane >> 5;
#pragma unroll 4
            for (int kk = 0; kk < 128; ++kk) {
                const int k = F.wave * 256 + 2 * kk + kp;
                const f32x4 w = *(const f32x4*)(W + (size_t)k * (6 * D) + c0 + 4 * cl);
#pragma unroll
                for (int r = 0; r < 5; ++r) { const float s = sc[r * D + k]; acc[r][0] += s * w.x; acc[r][1] += s * w.y; acc[r][2] += s * w.z; acc[r][3] += s * w.w; }
            }
#pragma unroll
            for (int r = 0; r < 5; ++r)
#pragma unroll
                for (int j = 0; j < 4; ++j) { acc[r][j] += __shfl_xor(acc[r][j], 32); }
            if (kp == 0) {
#pragma unroll
                for (int r = 0; r < 5; ++r)
#pragma unroll
                    for (int j = 0; j < 4; ++j) red[(F.wave * 5 + r) * 128 + 4 * cl + j] = acc[r][j];
            }
            __syncthreads();
            for (int i = F.tid; i < 5 * 128; i += NT) { const int r = i >> 7, j = i & 127; float s = 0.f;
#pragma unroll
                for (int w = 0; w < 8; ++w) s += red[(w * 5 + r) * 128 + j];
                WSP(float, WS_MOD)[(size_t)(l * 5 + r) * (6 * D) + c0 + j] = s + INP(I_BADA)[(size_t)l * (6 * D) + c0 + j]; }
            __syncthreads();
        }
    }
}

__device__ __forceinline__ void norm0_phase(Frame& F, KArgs& A) {
    const int gw = F.bid * NWAVES + F.wave, NGW = F.G * NWAVES;
    const float* gain = INP(I_NORM1);
    for (int m = gw; m < M; m += NGW) {
        const float* xr = x_in_row(F, A, 0, m);
        const float* scp = mod_ptr(F, 0, mod_row(m), 1);
        f32x4 v[8]; float s = 0.f;
#pragma unroll
        for (int j = 0; j < 8; ++j) { v[j] = *(const f32x4*)(xr + 4 * F.lane + 256 * j); s += (v[j].x * v[j].x + v[j].y * v[j].y) + (v[j].z * v[j].z + v[j].w * v[j].w); }
        s = wave_sum(s);
        if (F.lane < 8) WSP(float, WS_SSQB)[(size_t)m * 8 + F.lane] = F.lane == 0 ? s : 0.f;
        bf16* orow = WSP(bf16, WS_H) + (size_t)m * D;
#pragma unroll
        for (int j = 0; j < 8; ++j) { const int c = 4 * F.lane + 256 * j;
            const f32x4 g4 = *(const f32x4*)(gain + c), s4 = *(const f32x4*)(scp + c);
            *(u32x2*)(orow + c) = (u32x2){pk2(v[j].x * g4.x * (1.f + s4.x), v[j].y * g4.y * (1.f + s4.y)), pk2(v[j].z * g4.z * (1.f + s4.z), v[j].w * g4.w * (1.f + s4.w))}; }
    }
}
__device__ __forceinline__ void shw_phase(Frame& F) {
    LAS float* red = (LAS float*)F.lds;
    const int hh = F.lane >> 5, r = F.lane & 31, k0 = F.wave * 256;
    constexpr int NB1 = DIN / 32, NB2 = DFF / 32, PER_L = NB1 + NB2;
    for (int task = F.bid; task < NLAYER * PER_L; task += F.G) {
        const int l = task / PER_L, t2 = task % PER_L, which = t2 >= NB1 ? 1 : 0, nb = which ? t2 - NB1 : t2;
        const int NS = which ? DFF : NPAD;
        const bf16* Wt = (which ? WSP(const bf16, WS_WM1T) + (size_t)l * DFF * D : WSP(const bf16, WS_W1T) + (size_t)l * NPAD * D) + (size_t)(32 * nb + r) * D + k0 + 8 * hh;
        const float* sh = WSP(const float, WS_MOD) + ((size_t)(l * 5 + (r < 5 ? r : 0)) * 6 + (which ? 3 : 0)) * D + k0 + 8 * hh;
        bf16x8 bw[16];
#pragma unroll
        for (int ks = 0; ks < 16; ++ks) bw[ks] = *(const bf16x8*)(Wt + 16 * ks);
        f32x16 acc = ZERO16;
#pragma unroll
        for (int ks = 0; ks < 16; ++ks) { v4u a = (v4u){0u, 0u, 0u, 0u};
            if (r < 5) { const f32x4 s0 = *(const f32x4*)(sh + 16 * ks), s1 = *(const f32x4*)(sh + 16 * ks + 4); a = (v4u){pk2(s0.x, s0.y), pk2(s0.z, s0.w), pk2(s1.x, s1.y), pk2(s1.z, s1.w)}; }
            acc = MFMA32(__builtin_bit_cast(bf16x8, a), bw[ks], acc); }
        if (hh == 0) { red[(F.wave * 5 + 0) * 32 + r] = acc[0]; red[(F.wave * 5 + 1) * 32 + r] = acc[1]; red[(F.wave * 5 + 2) * 32 + r] = acc[2]; red[(F.wave * 5 + 3) * 32 + r] = acc[3]; }
        else red[(F.wave * 5 + 4) * 32 + r] = acc[0];
        __syncthreads();
        if (F.tid < 160) { const int row = F.tid >> 5, col = F.tid & 31; float s = 0.f;
#pragma unroll
            for (int w = 0; w < 8; ++w) s += red[(w * 5 + row) * 32 + col];
            (which ? WSP(float, WS_SHW2) + (size_t)l * 5 * DFF : WSP(float, WS_SHW1) + (size_t)l * 5 * NPAD)[(size_t)row * NS + 32 * nb + col] = s; }
        __syncthreads();
    }
}
__device__ __forceinline__ void final_norm_phase(Frame& F, KArgs& A) {
    const int gw = F.bid * NWAVES + F.wave, NGW = F.G * NWAVES;
    const float* gain = INP(I_FNORM);
    for (int m = gw; m < M; m += NGW) {
        const bf16* xr = WSP(const bf16, WS_XB) + (size_t)m * D; float* orow = F.out + (size_t)m * D;
        float v[4][8]; float s = 0.f;
#pragma unroll
        for (int j = 0; j < 4; ++j) { unpack8(*(const v4u*)(xr + 8 * F.lane + 512 * j), v[j]);
#pragma unroll
            for (int k = 0; k < 8; ++k) s += v[j][k] * v[j][k]; }
        const float rstd = rsqrtf(wave_sum(s) * (1.f / D) + EPS);
#pragma unroll
        for (int j = 0; j < 4; ++j) { const int c = 8 * F.lane + 512 * j; const f32x4 g0 = *(const f32x4*)(gain + c), g1 = *(const f32x4*)(gain + c + 4);
            *(f32x4*)(orow + c) = (f32x4){v[j][0] * rstd * g0.x, v[j][1] * rstd * g0.y, v[j][2] * rstd * g0.z, v[j][3] * rstd * g0.w};
            *(f32x4*)(orow + c + 4) = (f32x4){v[j][4] * rstd * g1.x, v[j][5] * rstd * g1.y, v[j][6] * rstd * g1.z, v[j][7] * rstd * g1.w}; }
    }
}

__device__ __forceinline__ void gates_phase(Frame& F, int l) {
    const bf16* XA = WSP(const bf16, WS_H); const bf16* Wg = WSP(const bf16, WS_W1T) + ((size_t)l * NPAD + NPROJ) * D;
    const float* shw = WSP(const float, WS_SHW1) + (size_t)l * 5 * NPAD + NPROJ;
    const int hh = F.lane >> 5, r = F.lane & 31, k0 = F.wave * 256;
    LAS float* red = (LAS float*)F.lds;
    bf16x8 bw[16];
#pragma unroll
    for (int ks = 0; ks < 16; ++ks) bw[ks] = *(const bf16x8*)(Wg + (size_t)r * D + k0 + 16 * ks + 8 * hh);
    for (int rb = F.bid; rb < M / 32; rb += F.G) {
        f32x16 acc = ZERO16;
#pragma unroll
        for (int half = 0; half < 2; ++half) { bf16x8 a[8];
#pragma unroll
            for (int j = 0; j < 8; ++j) a[j] = *(const bf16x8*)(XA + (size_t)(32 * rb + r) * D + k0 + 16 * (8 * half + j) + 8 * hh);
#pragma unroll
            for (int j = 0; j < 8; ++j) acc = MFMA32(a[j], bw[8 * half + j], acc); }
#pragma unroll
        for (int i = 0; i < 16; ++i) red[(F.wave * 32 + crow(i, hh)) * 33 + r] = acc[i];
        BAR();
#pragma unroll
        for (int q = 0; q < 2; ++q) { const int idx = F.tid * 2 + q, row = idx >> 5, col = idx & 31; float s = 0.f;
#pragma unroll
            for (int w = 0; w < 8; ++w) s += red[(w * 32 + row) * 33 + col];
            const int grow = 32 * rb + row; const float* part = WSP(const float, WS_SSQB) + (size_t)grow * 8;
            const float ssq = ((part[0] + part[1]) + (part[2] + part[3])) + ((part[4] + part[5]) + (part[6] + part[7]));
            WSP(float, WS_GATES)[(size_t)grow * 32 + col] = s * rsqrtf(ssq * (1.f / D) + EPS) + shw[(size_t)mod_row(grow) * NPAD + col]; }
        BAR();
    }
}
namespace epi {
__device__ __forceinline__ float rstd_of(const float* part, int r) { const pg8::f32x4 a = *(const pg8::f32x4*)(part + (size_t)r * 8), b = *(const pg8::f32x4*)(part + (size_t)r * 8 + 4);
    return rsqrtf((((a[0] + a[1]) + (a[2] + a[3])) + ((b[0] + b[1]) + (b[2] + b[3]))) * (1.f / D) + EPS); }
using pg8::Unit; using pg8::f32x4; using pg8::u32x4; using pg8::bf16_t; using pg8::cvt_pk_bf16;
constexpr int BMq = 256, HALFq = 128;
struct EpiProj {
    static constexpr bool PERM = true, AFTER_DRAIN = false;
    bf16_t* P; const float* ssq; const float* shw0;
    __device__ __forceinline__ void operator()(const f32x4 (&acc)[2][2][4][2], const Unit& u, int wr, int wc, int fr_, int fq_) const {
        int ln_ = (int)__builtin_amdgcn_mbcnt_hi(~0u, __builtin_amdgcn_mbcnt_lo(~0u, 0u)); asm volatile("" : "+v"(ln_)); const int fr = ln_ & 15, fq = ln_ >> 4; (void)fr_; (void)fq_;
        const int row0 = u.pm * BMq + wr * 64 + fr, rowt = u.pm * BMq, col0 = u.pn * BMq + wc * 32 + 8 * fq;
        const float* shw = shw0 + (size_t)(rowt < MC ? 0 : 1 + (rowt - MC) / 4096) * NPAD + col0;
        f32x4 sh[2][2];
#pragma unroll
        for (int bj = 0; bj < 2; ++bj) { sh[bj][0] = *(const f32x4*)(shw + bj * HALFq); sh[bj][1] = *(const f32x4*)(shw + bj * HALFq + 4); }
        float rsv[2][4];
        {
            const int rl = rowt + wr * 64 + (ln_ >> 4) * 16 + (ln_ & 15); const float r0 = rstd_of(ssq, rl), r1 = rstd_of(ssq, rl + HALFq);
#pragma unroll
            for (int m = 0; m < 4; ++m) { rsv[0][m] = __shfl(r0, m * 16 + fr); rsv[1][m] = __shfl(r1, m * 16 + fr); }
        }
#pragma unroll
        for (int ai = 0; ai < 2; ++ai)
#pragma unroll
            for (int m = 0; m < 4; ++m) { const int r = row0 + ai * HALFq + m * 16; bf16_t* rowp = P + (((size_t)(r >> 7) * 48 + (col0 >> 7)) * 128 + (r & 127)) * 128 + (col0 & 127); const float rs = rsv[ai][m];
#pragma unroll
                for (int bj = 0; bj < 2; ++bj) { const f32x4 v0 = acc[ai][bj][m][0] * rs + sh[bj][0], v1 = acc[ai][bj][m][1] * rs + sh[bj][1];
                    u32x4 w; w.x = cvt_pk_bf16(v0[0], v0[1]); w.y = cvt_pk_bf16(v0[2], v0[3]); w.z = cvt_pk_bf16(v1[0], v1[1]); w.w = cvt_pk_bf16(v1[2], v1[3]);
                    *(u32x4*)(rowp + bj * 16384) = w; } }
    }
};
struct EpiGlu {
    static constexpr bool PERM = true, AFTER_DRAIN = false;
    const bf16_t* YA; bf16_t* Y;
    __device__ __forceinline__ void operator()(const f32x4 (&acc)[2][2][4][2], const Unit& u, int wr, int wc, int fr_, int fq_) const {
        int ln_ = (int)__builtin_amdgcn_mbcnt_hi(~0u, __builtin_amdgcn_mbcnt_lo(~0u, 0u)); asm volatile("" : "+v"(ln_)); const int fr = ln_ & 15, fq = ln_ >> 4; (void)fr_; (void)fq_;
        const int row0 = u.pm * BMq + wr * 64 + fr, col0 = u.pn * BMq + wc * 32 + 8 * fq;
#pragma unroll
        for (int ai = 0; ai < 2; ++ai)
#pragma unroll
            for (int bj = 0; bj < 2; ++bj) { u32x4 ya[4];
#pragma unroll
                for (int m = 0; m < 4; ++m) ya[m] = *(const u32x4*)(YA + (size_t)(row0 + ai * HALFq + m * 16) * GWID + col0 + bj * HALFq);
#pragma unroll
                for (int m = 0; m < 4; ++m) { const int r = row0 + ai * HALFq + m * 16; const f32x4 v0 = acc[ai][bj][m][0], v1 = acc[ai][bj][m][1];
                    const u32x4 a = ya[m];
                    float y[8] = {bflo(a.x), bfhi(a.x), bflo(a.y), bfhi(a.y), bflo(a.z), bfhi(a.z), bflo(a.w), bfhi(a.w)};
                    const float g[8] = {v0[0], v0[1], v0[2], v0[3], v1[0], v1[1], v1[2], v1[3]};
#pragma unroll
                    for (int k = 0; k < 8; ++k) y[k] = y[k] * sigmoidf_(g[k]);
                    u32x4 w; w.x = cvt_pk_bf16(y[0], y[1]); w.y = cvt_pk_bf16(y[2], y[3]); w.z = cvt_pk_bf16(y[4], y[5]); w.w = cvt_pk_bf16(y[6], y[7]);
                    *(u32x4*)(Y + (size_t)r * D + col0 + bj * HALFq) = w; }
                asm volatile("" ::: "memory"); }
    }
};
struct EpiRes {
    static constexpr bool PERM = true, AFTER_DRAIN = false;
    const float* xp; const float* xs; bf16_t* XB; const float* gate0; int first;
    int NEXT; bf16_t* XA; float* ssq; const float* gn; const float* scn0; PG8_LAS unsigned char* scr;
    __device__ __forceinline__ float row_update(const f32x4 b0, const f32x4 b1, const f32x4 c0, const f32x4 c1, const f32x4 g0, const f32x4 g1, const f32x4 a0, const f32x4 a1, bf16_t* xbp, bf16_t* xap) const {
        const f32x4 x0 = b0 + g0 * c0, x1 = b1 + g1 * c1;
        u32x4 xw; xw.x = cvt_pk_bf16(x0[0], x0[1]); xw.y = cvt_pk_bf16(x0[2], x0[3]); xw.z = cvt_pk_bf16(x1[0], x1[1]); xw.w = cvt_pk_bf16(x1[2], x1[3]);
        *(u32x4*)xbp = xw;
        float s = 0.f;
        if (NEXT) { const f32x4 r0 = (f32x4){bflo(xw.x), bfhi(xw.x), bflo(xw.y), bfhi(xw.y)}, r1 = (f32x4){bflo(xw.z), bfhi(xw.z), bflo(xw.w), bfhi(xw.w)};
            s = (r0[0] * r0[0] + r0[1] * r0[1]) + (r0[2] * r0[2] + r0[3] * r0[3]) + (r1[0] * r1[0] + r1[1] * r1[1]) + (r1[2] * r1[2] + r1[3] * r1[3]);
            const f32x4 y0 = r0 * a0, y1 = r1 * a1; u32x4 w; w.x = cvt_pk_bf16(y0[0], y0[1]); w.y = cvt_pk_bf16(y0[2], y0[3]); w.z = cvt_pk_bf16(y1[0], y1[1]); w.w = cvt_pk_bf16(y1[2], y1[3]);
            *(u32x4*)xap = w; }
        return s;
    }
    __device__ __forceinline__ void operator()(const f32x4 (&acc)[2][2][4][2], const Unit& u, int wr, int wc, int fr_, int fq_) const {
        int ln_ = (int)__builtin_amdgcn_mbcnt_hi(~0u, __builtin_amdgcn_mbcnt_lo(~0u, 0u)); asm volatile("" : "+v"(ln_)); const int fr = ln_ & 15, fq = ln_ >> 4; (void)fr_; (void)fq_;
        const int rowt = u.pm * BMq, col0 = u.pn * BMq + wc * 32 + 8 * fq;
        const int mrow = rowt < MC ? 0 : 1 + (rowt - MC) / 4096;
        const float* gate = gate0 + (size_t)mrow * (6 * D);
        const float* basef = rowt < MC ? xp + (size_t)rowt * D : xs + (size_t)(rowt - MC) * D;
        bf16_t* xb = XB + (size_t)rowt * D;
        float ss[2][4];
#pragma unroll
        for (int ai = 0; ai < 2; ++ai)
#pragma unroll
            for (int m = 0; m < 4; ++m) ss[ai][m] = 0.f;
#pragma unroll
        for (int bj = 0; bj < 2; ++bj) { const int c = col0 + bj * HALFq; const f32x4 g0 = *(const f32x4*)(gate + c), g1 = *(const f32x4*)(gate + c + 4);
            f32x4 a0 = (f32x4){0.f, 0.f, 0.f, 0.f}, a1 = a0;
            if (NEXT) { const float* scn = scn0 + (size_t)mrow * (6 * D); a0 = *(const f32x4*)(gn + c) * (*(const f32x4*)(scn + c) + 1.f); a1 = *(const f32x4*)(gn + c + 4) * (*(const f32x4*)(scn + c + 4) + 1.f); }
            if (first) {
#pragma unroll
                for (int ai = 0; ai < 2; ++ai)
#pragma unroll
                    for (int m = 0; m < 4; ++m) { const size_t off = (size_t)(wr * 64 + fr + ai * HALFq + m * 16) * D + c;
                        const f32x4 b0 = *(const f32x4*)(basef + off), b1 = *(const f32x4*)(basef + off + 4);
                        ss[ai][m] += row_update(b0, b1, acc[ai][bj][m][0], acc[ai][bj][m][1], g0, g1, a0, a1, xb + off, XA + (size_t)rowt * D + off);
                        if (m & 1) asm volatile("" ::: "memory"); }
            } else {
#pragma unroll
                for (int ai = 0; ai < 2; ++ai) { u32x4 bw[4];
#pragma unroll
                    for (int m = 0; m < 4; ++m) bw[m] = *(const u32x4*)(xb + (size_t)(wr * 64 + fr + ai * HALFq + m * 16) * D + c);
#pragma unroll
                    for (int m = 0; m < 4; ++m) { const size_t off = (size_t)(wr * 64 + fr + ai * HALFq + m * 16) * D + c; const u32x4 w = bw[m];
                        const f32x4 b0 = (f32x4){bflo(w.x), bfhi(w.x), bflo(w.y), bfhi(w.y)}, b1 = (f32x4){bflo(w.z), bfhi(w.z), bflo(w.w), bfhi(w.w)};
                        ss[ai][m] += row_update(b0, b1, acc[ai][bj][m][0], acc[ai][bj][m][1], g0, g1, a0, a1, xb + off, XA + (size_t)rowt * D + off); }
                    asm volatile("" ::: "memory"); }
            } }
        if (NEXT) {
            PG8_LAS float* P4 = (PG8_LAS float*)scr;
#pragma unroll
            for (int ai = 0; ai < 2; ++ai)
#pragma unroll
                for (int m = 0; m < 4; ++m) { float s = ss[ai][m]; s += __shfl_xor(s, 16); s += __shfl_xor(s, 32);
                    if (fq == 0) P4[(ai * HALFq + wr * 64 + m * 16 + fr) * 4 + wc] = s; }
            asm volatile("s_waitcnt lgkmcnt(0)\n\ts_barrier" ::: "memory");
            { const int tid = (wr * 4 + wc) * 64 + fq * 16 + fr;
              if (tid < 256) { const f32x4 p = *(const PG8_LAS f32x4*)(P4 + tid * 4); ssq[(size_t)(rowt + tid) * 8 + u.pn] = (p[0] + p[1]) + (p[2] + p[3]); } }
            asm volatile("s_waitcnt lgkmcnt(0)\n\ts_barrier" ::: "memory");
        }
    }
};
struct EpiRelu2 {
    static constexpr bool PERM = true, AFTER_DRAIN = false;
    bf16_t* O; const float* ssq; const float* shw0;
    __device__ __forceinline__ void operator()(const f32x4 (&acc)[2][2][4][2], const Unit& u, int wr, int wc, int fr_, int fq_) const {
        int ln_ = (int)__builtin_amdgcn_mbcnt_hi(~0u, __builtin_amdgcn_mbcnt_lo(~0u, 0u)); asm volatile("" : "+v"(ln_)); const int fr = ln_ & 15, fq = ln_ >> 4; (void)fr_; (void)fq_;
        const int row0 = u.pm * BMq + wr * 64 + fr, col0 = u.pn * BMq + wc * 32 + 8 * fq, rowt = u.pm * BMq;
        const float* shw = shw0 + (size_t)(rowt < MC ? 0 : 1 + (rowt - MC) / 4096) * DFF + col0;
        f32x4 sh[2][2];
#pragma unroll
        for (int bj = 0; bj < 2; ++bj) { sh[bj][0] = *(const f32x4*)(shw + bj * HALFq); sh[bj][1] = *(const f32x4*)(shw + bj * HALFq + 4); }
        float rsv[2][4];
        {
            const int rl = rowt + wr * 64 + (ln_ >> 4) * 16 + (ln_ & 15); const float r0 = rstd_of(ssq, rl), r1 = rstd_of(ssq, rl + HALFq);
#pragma unroll
            for (int m = 0; m < 4; ++m) { rsv[0][m] = __shfl(r0, m * 16 + fr); rsv[1][m] = __shfl(r1, m * 16 + fr); }
        }
#pragma unroll
        for (int ai = 0; ai < 2; ++ai)
#pragma unroll
            for (int m = 0; m < 4; ++m) { const int r = row0 + ai * HALFq + m * 16; bf16_t* rowp = O + (size_t)r * DFF + col0; const float rs = rsv[ai][m];
#pragma unroll
                for (int bj = 0; bj < 2; ++bj) { f32x4 v0 = acc[ai][bj][m][0] * rs + sh[bj][0], v1 = acc[ai][bj][m][1] * rs + sh[bj][1];
#pragma unroll
                    for (int k = 0; k < 4; ++k) { const float a = fmaxf(v0[k], 0.f), b = fmaxf(v1[k], 0.f); v0[k] = a * a; v1[k] = b * b; }
                    u32x4 w; w.x = cvt_pk_bf16(v0[0], v0[1]); w.y = cvt_pk_bf16(v0[2], v0[3]); w.z = cvt_pk_bf16(v1[0], v1[1]); w.w = cvt_pk_bf16(v1[2], v1[3]);
                    *(u32x4*)(rowp + bj * HALFq) = w; } }
    }
};
}
__device__ __forceinline__ float logsigmoidf_(float x) { return fminf(x, 0.f) - __logf(1.f + __expf(-fabsf(x))); }
__device__ __forceinline__ float softplusf_(float x) { return fmaxf(x, 0.f) + __logf(1.f + __expf(-fabsf(x))); }
__device__ __forceinline__ void load_tile128(Frame& F, LAS unsigned char* dst, const bf16* src) {
#pragma unroll
    for (int it = 0; it < 4; ++it) { const int i = F.tid + NT * it, r = i >> 4, c = i & 15;
        *(LAS v4u*)(dst + r * LDT + c * 16) = *(const v4u*)(src + (size_t)r * 128 + c * 8); }
}
__device__ __forceinline__ void qk_issue(Frame& F, const bf16* src, v4u (&r)[4]) {
#pragma unroll
    for (int it = 0; it < 2; ++it) { const int i = F.tid + NT * it, rw = i >> 3, c = i & 7;
        r[2 * it] = *(const v4u*)(src + (size_t)rw * 128 + c * 8); r[2 * it + 1] = *(const v4u*)(src + (size_t)rw * 128 + 64 + c * 8); }
}
template <int NDST> __device__ __forceinline__ void qk_commit(Frame& F, LAS unsigned char* dst0, LAS unsigned char* dst1, const v4u (&rg)[4], const LAS float* w0, const LAS float* w1, float scale, bool rope, int tpos0) {
#pragma unroll
    for (int it = 0; it < 2; ++it) {
        const int i = F.tid + NT * it, r = i >> 3, c = i & 7;
        float x1[8], x2[8];
        unpack8(rg[2 * it], x1); unpack8(rg[2 * it + 1], x2);
        if (rope) {
            const int tp = tpos0 + r, pos = c < 4 ? (tp >> 6) : (tp & 63);
            const f32x2* rt = WSP(const f32x2, WS_ROPE) + pos * 32 + ((8 * c) & 31);
#pragma unroll
            for (int j = 0; j < 8; ++j) { const f32x2 cs = rt[j]; const float a = x1[j], b = x2[j]; x1[j] = a * cs.x - b * cs.y; x2[j] = a * cs.y + b * cs.x; }
        }
        const float s0 = scale * (w0 ? w0[r] : 1.f);
        *(LAS v4u*)(dst0 + r * LDT + c * 16) = pack8(x1, s0); *(LAS v4u*)(dst0 + r * LDT + 128 + c * 16) = pack8(x2, s0);
        if (NDST == 2) { const float s1 = scale * w1[r];
            *(LAS v4u*)(dst1 + r * LDT + c * 16) = pack8(x1, s1); *(LAS v4u*)(dst1 + r * LDT + 128 + c * 16) = pack8(x2, s1); }
    }
}
template <int NDST> __device__ __forceinline__ void load_qk(Frame& F, LAS unsigned char* dst0, LAS unsigned char* dst1, const bf16* src, const LAS float* w0, const LAS float* w1, float scale, bool rope, int tpos0) {
    v4u r[4]; qk_issue(F, src, r); qk_commit<NDST>(F, dst0, dst1, r, w0, w1, scale, rope, tpos0);
}
template <int NDST, int nc8> __device__ __forceinline__ void load_conv(Frame& F, KArgs& A, int l, LAS unsigned char* dst0, LAS unsigned char* dst1, int ldd, int ch0, int row0, int seq_lo, int seq_hi,
                                                               const LAS float* w0, const LAS float* w1, bool to_global) {
    const int c = F.tid % nc8;
    const float* cw = INP(I_CONVW) + (size_t)l * 5 * 1024 + ch0 + 8 * c; const float* cb = INP(I_CONVB) + (size_t)l * 1024 + ch0 + 8 * c;
    f32x4 wv[5][2];
#pragma unroll
    for (int k = 0; k < 5; ++k) { wv[k][0] = *(const f32x4*)(cw + k * 1024); wv[k][1] = *(const f32x4*)(cw + k * 1024 + 4); }
    const f32x4 b0 = *(const f32x4*)cb, b1 = *(const f32x4*)(cb + 4);
#pragma unroll 1
    for (int i = F.tid; i < 128 * nc8; i += NT) {
        const int r = i / nc8, row = row0 + r;
        float acc[8] = {b0.x, b0.y, b0.z, b0.w, b1.x, b1.y, b1.z, b1.w};
        v4u xr[5];
#pragma unroll
        for (int k = 0; k < 5; ++k) { const int rr = row + k - 2; xr[k] = (v4u){0u, 0u, 0u, 0u};
            if (rr >= seq_lo && rr < seq_hi) xr[k] = *(const v4u*)(PT(rr >> 7, PC_DX + ch0 + 8 * c) + (size_t)(rr & 127) * 128); }
#pragma unroll
        for (int k = 0; k < 5; ++k) { float x[8]; unpack8(xr[k], x);
            acc[0] += x[0] * wv[k][0].x; acc[1] += x[1] * wv[k][0].y; acc[2] += x[2] * wv[k][0].z; acc[3] += x[3] * wv[k][0].w; acc[4] += x[4] * wv[k][1].x; acc[5] += x[5] * wv[k][1].y; acc[6] += x[6] * wv[k][1].z; acc[7] += x[7] * wv[k][1].w; }
#pragma unroll
        for (int j = 0; j < 8; ++j) acc[j] = siluf_(acc[j]);
        if (to_global) *(v4u*)(XT(row >> 7, ch0 + 8 * c) + (size_t)(row & 127) * 128) = pack8(acc, 1.f);
        if (NDST >= 1) *(LAS v4u*)(dst0 + r * ldd + c * 16) = pack8(acc, w0 ? w0[r] : 1.f);
        if (NDST == 2) *(LAS v4u*)(dst1 + r * ldd + c * 16) = pack8(acc, w1[r]);
    }
}
template <int nc8> __device__ __forceinline__ void load_xbcc(Frame& F, LAS unsigned char* dst, int ldd, int ch0, int row0) {
    const bf16* P = XT(row0 >> 7, ch0);
    for (int i = F.tid; i < 128 * nc8; i += NT) { const int r = i / nc8, c = i % nc8; *(LAS v4u*)(dst + r * ldd + c * 16) = *(const v4u*)(P + (size_t)r * 128 + 8 * c); }
}
__device__ __forceinline__ void kv_state_mfma(Frame& F, const LAS unsigned char* TKf, const LAS unsigned char* TKb, const LAS unsigned char* TV, bf16* outF, bf16* outB) {
    const int dvb = F.wave >> 1, dkb0 = (F.wave & 1) * 2, hh = F.lane >> 5;
    f32x16 acc[2][2] = {{ZERO16, ZERO16}, {ZERO16, ZERO16}};
#pragma unroll 1
    for (int ks = 0; ks < 8; ++ks) {
        const bf16x8 a = frag_tr(TV, LDT, 16 * ks, 32 * dvb, F.lane);
#pragma unroll
        for (int j = 0; j < 2; ++j) { acc[0][j] = MFMA32(a, frag_tr(TKf, LDT, 16 * ks, 32 * (dkb0 + j), F.lane), acc[0][j]); acc[1][j] = MFMA32(a, frag_tr(TKb, LDT, 16 * ks, 32 * (dkb0 + j), F.lane), acc[1][j]); }
    }
#pragma unroll
    for (int j = 0; j < 2; ++j)
#pragma unroll
        for (int i = 0; i < 16; ++i) { const int o = (32 * dvb + crow(i, hh)) * 128 + 32 * (dkb0 + j) + (F.lane & 31); outF[o] = (bf16)f2bf(acc[0][j][i]); outB[o] = (bf16)f2bf(acc[1][j][i]); }
}
__device__ __forceinline__ void qkT_mfma(Frame& F, const LAS unsigned char* TQ, const LAS unsigned char* TK, f32x16 (&qk)[2]) {
    const int tb = F.wave >> 1, sb0 = (F.wave & 1) * 2;
    qk[0] = ZERO16; qk[1] = ZERO16;
#pragma unroll 1
    for (int ks = 0; ks < 8; ++ks) { const bf16x8 bq = frag_row(TQ, LDT, 32 * tb, 16 * ks, F.lane);
#pragma unroll
        for (int j = 0; j < 2; ++j) qk[j] = MFMA32(frag_row(TK, LDT, 32 * (sb0 + j), 16 * ks, F.lane), bq, qk[j]); }
}
__device__ __forceinline__ void pv_mfma(Frame& F, const LAS unsigned char* TP, const LAS unsigned char* TV, f32x16 (&o)[2]) {
    const int tb = F.wave >> 1, eb0 = (F.wave & 1) * 2;
#pragma unroll 1
    for (int ks = 0; ks < 8; ++ks) { const bf16x8 ap = frag_row(TP, LDT, 32 * tb, 16 * ks, F.lane);
#pragma unroll
        for (int j = 0; j < 2; ++j) o[j] = MFMA32(ap, frag_tr(TV, LDT, 16 * ks, 32 * (eb0 + j), F.lane), o[j]); }
}
__device__ __forceinline__ void pv_mfma_range(Frame& F, const LAS unsigned char* TP, const LAS unsigned char* TV, f32x16 (&o)[2], int k_lo, int k_hi) {
    const int tb = F.wave >> 1, eb0 = (F.wave & 1) * 2;
#pragma unroll 1
    for (int ks = k_lo; ks < k_hi; ++ks) { const bf16x8 ap = frag_row(TP, LDT, 32 * tb, 16 * ks, F.lane);
#pragma unroll
        for (int j = 0; j < 2; ++j) o[j] = MFMA32(ap, frag_tr(TV, LDT, 16 * ks, 32 * (eb0 + j), F.lane), o[j]); }
}
__device__ __forceinline__ void qs_prefetch(Frame& F, const bf16* ST, bf16x8 (&b)[2][8]) {
    const int eb0 = (F.wave & 1) * 2, hh = F.lane >> 5;
#pragma unroll
    for (int j = 0; j < 2; ++j)
#pragma unroll
        for (int ks = 0; ks < 8; ++ks) b[j][ks] = *(const bf16x8*)(ST + (size_t)(32 * (eb0 + j) + (F.lane & 31)) * 128 + 16 * ks + 8 * hh);
}
__device__ __forceinline__ void qs_mfma(Frame& F, const LAS unsigned char* TQ, const bf16x8 (&b)[2][8], f32x16 (&o)[2]) {
    const int tb = F.wave >> 1;
#pragma unroll
    for (int ks = 0; ks < 8; ++ks) { const bf16x8 aq = frag_row(TQ, LDT, 32 * tb, 16 * ks, F.lane);
#pragma unroll
        for (int j = 0; j < 2; ++j) o[j] = MFMA32(aq, b[j][ks], o[j]); }
}
__device__ __forceinline__ void hs_to_lds(Frame& F, LAS unsigned char* HS, const f32x16 (&hs)[2]) {
    const int tb = F.wave >> 1, eb0 = (F.wave & 1) * 2, hh = F.lane >> 5;
#pragma unroll
    for (int j = 0; j < 2; ++j)
#pragma unroll
        for (int i = 0; i < 16; ++i) *(LAS float*)(HS + (32 * tb + crow(i, hh)) * 528 + (32 * (eb0 + j) + (F.lane & 31)) * 4) = hs[j][i];
}
template <int GATE> __device__ __forceinline__ void head_out(Frame& F, const LAS unsigned char* HS, const float* gain, const bf16* gsrc  , bf16* ydst  ) {
    const int t = F.tid >> 2, seg = F.tid & 3;
    float v[32]; float ss = 0.f;
#pragma unroll
    for (int k = 0; k < 8; ++k) { const f32x4 x = *(const LAS f32x4*)(HS + t * 528 + (32 * seg + 4 * k) * 4); v[4 * k] = x.x; v[4 * k + 1] = x.y; v[4 * k + 2] = x.z; v[4 * k + 3] = x.w; ss += (x.x * x.x + x.y * x.y) + (x.z * x.z + x.w * x.w); }
    ss += __shfl_xor(ss, 1); ss += __shfl_xor(ss, 2);
    const float r = rsqrtf(ss * (1.f / 128.f) + EPS);
#pragma unroll
    for (int k = 0; k < 4; ++k) { float g[8]; unpack8(*(const v4u*)(gsrc + (size_t)t * 128 + 32 * seg + 8 * k), g); float o[8];
#pragma unroll
        for (int j = 0; j < 8; ++j) { const float gg = GATE == 0 ? sigmoidf_(g[j]) : siluf_(g[j]); o[j] = v[8 * k + j] * r * gain[32 * seg + 8 * k + j] * gg; }
        *(v4u*)(ydst + (size_t)t * D + 32 * seg + 8 * k) = pack8(o, 1.f); }
}

__device__ __forceinline__ void tile_issue(Frame& F, const bf16* src, v4u (&r)[4]) {
#pragma unroll
    for (int it = 0; it < 4; ++it) { const int i = F.tid + NT * it; r[it] = *(const v4u*)(src + (size_t)(i >> 4) * 128 + (i & 15) * 8); }
}
__device__ __forceinline__ void tile_commit(Frame& F, LAS unsigned char* dst, const v4u (&r)[4], float scale) {
#pragma unroll
    for (int it = 0; it < 4; ++it) { const int i = F.tid + NT * it; v4u v = r[it];
        if (scale != 1.f) { float x[8]; unpack8(v, x); v = pack8(x, scale); }
        *(LAS v4u*)(dst + (i >> 4) * LDT + (i & 15) * 16) = v; }
}
template <int GATE> __device__ __forceinline__ void head_out_r(Frame& F, const LAS unsigned char* HS, const float* gain, const v4u (&og)[4], bf16* ydst) {
    const int t = F.tid >> 2, seg = F.tid & 3;
    float v[32]; float ss = 0.f;
#pragma unroll
    for (int k = 0; k < 8; ++k) { const f32x4 x = *(const LAS f32x4*)(HS + t * 528 + (32 * seg + 4 * k) * 4); v[4 * k] = x.x; v[4 * k + 1] = x.y; v[4 * k + 2] = x.z; v[4 * k + 3] = x.w; ss += (x.x * x.x + x.y * x.y) + (x.z * x.z + x.w * x.w); }
    ss += __shfl_xor(ss, 1); ss += __shfl_xor(ss, 2);
    const float r = rsqrtf(ss * (1.f / 128.f) + EPS);
#pragma unroll
    for (int k = 0; k < 4; ++k) { float g[8]; unpack8(og[k], g); float o[8]; const f32x4 g0 = *(const f32x4*)(gain + 32 * seg + 8 * k), g1 = *(const f32x4*)(gain + 32 * seg + 8 * k + 4);
        const float gn[8] = {g0.x, g0.y, g0.z, g0.w, g1.x, g1.y, g1.z, g1.w};
#pragma unroll
        for (int j = 0; j < 8; ++j) { const float gg = GATE == 0 ? sigmoidf_(g[j]) : siluf_(g[j]); o[j] = v[8 * k + j] * r * gn[j] * gg; }
        *(v4u*)(ydst + (size_t)t * D + 32 * seg + 8 * k) = pack8(o, 1.f); }
}
__device__ __forceinline__ void mlstm_gates(Frame& F, KArgs& A, int l, int cp, int h) {
    if (F.tid < 128) { const float* g = WSP(const float, WS_GATES) + (size_t)(cp * 128 + F.tid) * 32;
        SCA(0)[F.tid] = g[h] + INP(I_MIB)[(l * 2 + 0) * 4 + h]; SCA(1)[F.tid] = g[4 + h] + INP(I_MIB)[(l * 2 + 1) * 4 + h];
        SCA(2)[F.tid] = logsigmoidf_(g[8 + h] + INP(I_MFB)[(l * 2 + 0) * 4 + h]); SCA(3)[F.tid] = logsigmoidf_(g[12 + h] + INP(I_MFB)[(l * 2 + 1) * 4 + h]); }
    BAR();
    if (F.wave == 0) wave_scan128<false>(SCA(2), SCA(4), F.lane, false, 0.f);
    if (F.wave == 1) wave_scan128<false>(SCA(3), SCA(5), F.lane, true, 0.f);
    BAR();
}
__device__ __forceinline__ void mlstm_local_item(Frame F, KArgs& A, int l, int cp, int h) {
    v4u rk[4], rv[4]; qk_issue(F, PT(cp, PC_MK + h * 128), rk); tile_issue(F, PT(cp, PC_MV + h * 128), rv);
    mlstm_gates(F, A, l, cp, h);
    if (F.wave < 2) { const int d = F.wave; const LAS float* bc = SCA(4 + d); const LAS float* ig = SCA(d); const float tot = d == 0 ? bc[127] : bc[0];
        const int s0 = 2 * F.lane; const float g0 = tot - bc[s0] + ig[s0], g1 = tot - bc[s0 + 1] + ig[s0 + 1];
        const float mx = wave_max(fmaxf(g0, g1));
        SCA(6 + d)[s0] = __expf(g0 - mx); SCA(6 + d)[s0 + 1] = __expf(g1 - mx);
        if (F.lane == 0) { float* sc = WSP(float, WS_MLSC) + ((cp * 2 + d) * 4 + h) * 2; sc[0] = tot; sc[1] = mx; } }
    BAR();
    qk_commit<2>(F, F.lds, F.lds + TS, rk, SCA(6), SCA(7), 0.08838834764831845f, false, 0);
    tile_commit(F, F.lds + 2 * TS, rv, 1.f);
    BAR();
    kv_state_mfma(F, F.lds, F.lds + TS, F.lds + 2 * TS, WSP(bf16, WS_MLCLOC) + (size_t)((cp * 2 + 0) * 4 + h) * 16384, WSP(bf16, WS_MLCLOC) + (size_t)((cp * 2 + 1) * 4 + h) * 16384);
    if (F.tid < 256) { const int d = F.tid >> 7, dk = F.tid & 127; const LAS unsigned char* T = F.lds + d * TS; float s = 0.f;
        for (int r = 0; r < 128; ++r) s += bf2f(*(const LAS unsigned short*)(T + r * LDT + dk * 2));
        WSP(float, WS_MLNLOC)[((cp * 2 + d) * 4 + h) * 128 + dk] = s; }
    BAR();
}
__device__ __forceinline__ void mlstm_out_item(Frame F, KArgs& A, int l, int cp, int h) {
    const Seq sq = seq_of(cp);
    LAS unsigned char* TQ = F.lds; LAS unsigned char* TK = F.lds + TS; LAS unsigned char* TV = F.lds + 2 * TS; LAS unsigned char* TP = F.lds + 3 * TS;
    ITS(0);
    v4u rq[4], rk[4], rv[4], og[4];
    tile_issue(F, PT(cp, PC_MQ + h * 128), rq); tile_issue(F, PT(cp, PC_MK + h * 128), rk); tile_issue(F, PT(cp, PC_MV + h * 128), rv);
    { const int t = F.tid >> 2, seg = F.tid & 3;
#pragma unroll
      for (int k = 0; k < 4; ++k) og[k] = *(const v4u*)(PT(cp, PC_MO + h * 128) + (size_t)t * 128 + 32 * seg + 8 * k); }
    const float min_f = WSP(const float, WS_MLMIN)[(cp * 2 + 0) * 4 + h], min_b = WSP(const float, WS_MLMIN)[(cp * 2 + 1) * 4 + h];
    float nin = 0.f; if (F.tid < 256) nin = WSP(const float, WS_MLNIN)[((cp * 2 + (F.tid >> 7)) * 4 + h) * 128 + (F.tid & 127)];
    mlstm_gates(F, A, l, cp, h);
    if (F.tid < 256) { const int d = F.tid >> 7, s = F.tid & 127; SCA(6 + d)[s] = SCA(d)[s] - SCA(4 + d)[s]; SCA(12 + d)[s] = nin; }
    tile_commit(F, TQ, rq, 1.f); tile_commit(F, TK, rk, 0.08838834764831845f); tile_commit(F, TV, rv, 1.f);
    BAR();
    if (F.wave == 0) wave_scan128<true>(SCA(6), SCA(8), F.lane, false, min_f);
    if (F.wave == 1) wave_scan128<true>(SCA(7), SCA(9), F.lane, true, min_b);
    BAR();
    ITE(0);
    f32x16 hs[2] = {ZERO16, ZERO16};
    const int tb = F.wave >> 1, sb0 = (F.wave & 1) * 2, hh = F.lane >> 5, t = 32 * tb + (F.lane & 31);
#pragma unroll 1
    for (int d = 0; d < 2; ++d) {
        const LAS float* av = SCA(6 + d); const float Mt = SCA(8 + d)[t]; const float m_in = d == 0 ? min_f : min_b;
        ITS(2);
        const bool has_state = sq.lat || (d == 0 ? sq.c > 0 : sq.c < sq.nch - 1);
        bf16x8 bst[2][8]; if (has_state) qs_prefetch(F, WSP(const bf16, WS_MLCIN) + (size_t)((cp * 2 + d) * 4 + h) * 16384, bst);
#ifndef PROBE_REP2
#define PROBE_REP2 1
#endif
#pragma unroll 1
        for (int rep2_ = 0; rep2_ < PROBE_REP2; ++rep2_) {
        f32x16 qk[2]; qkT_mfma(F, TQ, TK, qk);
#pragma unroll
        for (int j = 0; j < 2; ++j) { const int sblk = sb0 + j;
            if (d == 0 ? sblk > tb : sblk < tb) continue;
            const bool diag = sblk == tb;
#pragma unroll
            for (int i4 = 0; i4 < 4; ++i4) { const int sb = 32 * sblk + 8 * i4 + 4 * hh; float p[4]; const f32x4 a4 = *(const LAS f32x4*)(av + sb);
#pragma unroll
                for (int i = 0; i < 4; ++i) p[i] = qk[j][4 * i4 + i] * __expf(a4[i] - Mt);
                if (diag) {
#pragma unroll
                    for (int i = 0; i < 4; ++i) { const int s = sb + i; const bool ok = d == 0 ? (s <= t) : (s >= t); p[i] = ok ? p[i] : 0.f; } }
                *(LAS u32x2*)(TP + t * LDT + sb * 2) = (u32x2){pk2(p[0], p[1]), pk2(p[2], p[3])}; } }
        }
        ITE(2); ITS(3);
        BAR();
        {
            const int tt = F.tid >> 2, seg = F.tid & 3; float ds = 0.f, qn = 0.f;
            const bool pvalid = d == 0 ? seg <= (tt >> 5) : seg >= (tt >> 5);
#pragma unroll
            for (int k = 0; k < 4; ++k) { float x[8]; unpack8(pvalid ? *(const LAS v4u*)(TP + tt * LDT + 64 * seg + 16 * k) : (v4u){0u, 0u, 0u, 0u}, x); float q[8]; unpack8(*(const LAS v4u*)(TQ + tt * LDT + 64 * seg + 16 * k), q);
                const f32x4 n0 = *(const LAS f32x4*)(SCA(12 + d) + 32 * seg + 8 * k), n1 = *(const LAS f32x4*)(SCA(12 + d) + 32 * seg + 8 * k + 4);
                ds += ((x[0] + x[1]) + (x[2] + x[3])) + ((x[4] + x[5]) + (x[6] + x[7]));
                qn += (q[0] * n0.x + q[1] * n0.y) + (q[2] * n0.z + q[3] * n0.w) + (q[4] * n1.x + q[5] * n1.y) + (q[6] * n1.z + q[7] * n1.w); }
            ds += __shfl_xor(ds, 1); ds += __shfl_xor(ds, 2); qn += __shfl_xor(qn, 1); qn += __shfl_xor(qn, 2);
            if (seg == 0) { const float Mtt = SCA(8 + d)[tt], wint = __expf(m_in - Mtt), den = ds + wint * qn, dd = fmaxf(fabsf(den), __expf(-(SCA(4 + d)[tt] + Mtt)));
                const float rdd = __builtin_amdgcn_rcpf(dd); SCA(10)[tt] = wint * rdd; SCA(11)[tt] = rdd; } }
        { f32x16 num[2] = {ZERO16, ZERO16};
          pv_mfma_range(F, TP, TV, num, d == 0 ? 0 : 2 * tb, d == 0 ? 2 * tb + 2 : 8);
          BAR(); ITE(3); ITS(4);
#pragma unroll
          for (int j = 0; j < 2; ++j)
#pragma unroll
            for (int k4 = 0; k4 < 4; ++k4) { const f32x4 f4 = *(const LAS f32x4*)(SCA(11) + 32 * tb + 8 * k4 + 4 * hh);
#pragma unroll
                for (int i = 0; i < 4; ++i) hs[j][4 * k4 + i] += f4[i] * num[j][4 * k4 + i]; } }
        if (has_state) { f32x16 qc[2] = {ZERO16, ZERO16};
          qs_mfma(F, TQ, bst, qc);
#pragma unroll
          for (int j = 0; j < 2; ++j)
#pragma unroll
            for (int k4 = 0; k4 < 4; ++k4) { const f32x4 f4 = *(const LAS f32x4*)(SCA(10) + 32 * tb + 8 * k4 + 4 * hh);
#pragma unroll
                for (int i = 0; i < 4; ++i) hs[j][4 * k4 + i] += f4[i] * qc[j][4 * k4 + i]; } }
        ITE(4);
    }
    ITS(5);
    BAR();
    hs_to_lds(F, F.lds, hs);
    BAR();
    head_out_r<0>(F, F.lds, INP(I_MNORM) + (size_t)l * GWID + h * 128, og, WSP(bf16, WS_Y) + (size_t)cp * 128 * D + 512 + h * 128);
    BAR(); ITE(5);
}

__device__ __forceinline__ void ret_local_item(Frame F, KArgs& A, int l, int cp, int h) {
    const float lgf = -__expf(INP(I_RRATE)[(l * 2 + 0) * 4 + h]), lgb = -__expf(INP(I_RRATE)[(l * 2 + 1) * 4 + h]);
    v4u rk[4], rv[4]; qk_issue(F, PT(cp, PC_RK + h * 128), rk); tile_issue(F, PT(cp, PC_RV + h * 128), rv);
    if (F.tid < 128) { SCA(6)[F.tid] = __expf((127.f - (float)F.tid) * lgf); SCA(7)[F.tid] = __expf((float)F.tid * lgb); }
    BAR();
    const Seq sq = seq_of(cp);
    qk_commit<2>(F, F.lds, F.lds + TS, rk, SCA(6), SCA(7), 0.08838834764831845f, sq.lat != 0, sq.c * 128);
    tile_commit(F, F.lds + 2 * TS, rv, 1.f);
    BAR();
    kv_state_mfma(F, F.lds, F.lds + TS, F.lds + 2 * TS, WSP(bf16, WS_RTLOC) + (size_t)((cp * 2 + 0) * 4 + h) * 16384, WSP(bf16, WS_RTLOC) + (size_t)((cp * 2 + 1) * 4 + h) * 16384);
    BAR();
}
__device__ __forceinline__ void ret_out_item(Frame F, KArgs& A, int l, int cp, int h) {
    const float lgf = -__expf(INP(I_RRATE)[(l * 2 + 0) * 4 + h]), lgb = -__expf(INP(I_RRATE)[(l * 2 + 1) * 4 + h]);
    if (F.tid < 128) { SCA(10)[F.tid] = __expf(((float)F.tid + 1.f) * lgf); SCA(11)[F.tid] = __expf((128.f - (float)F.tid) * lgb); }
    const Seq sq = seq_of(cp);
    LAS unsigned char* TQ = F.lds; LAS unsigned char* TK = F.lds + TS; LAS unsigned char* TV = F.lds + 2 * TS; LAS unsigned char* TP = F.lds + 3 * TS;
    v4u rq[4], rk[4], rv[4], og[4];
    qk_issue(F, PT(cp, PC_RQ + h * 128), rq); qk_issue(F, PT(cp, PC_RK + h * 128), rk); tile_issue(F, PT(cp, PC_RV + h * 128), rv);
    { const int t_ = F.tid >> 2, seg_ = F.tid & 3;
#pragma unroll
      for (int k = 0; k < 4; ++k) og[k] = *(const v4u*)(PT(cp, PC_RG + h * 128) + (size_t)t_ * 128 + 32 * seg_ + 8 * k); }
    qk_commit<1>(F, TQ, nullptr, rq, nullptr, nullptr, 1.f, sq.lat != 0, sq.c * 128);
    qk_commit<1>(F, TK, nullptr, rk, nullptr, nullptr, 0.08838834764831845f, sq.lat != 0, sq.c * 128);
    tile_commit(F, TV, rv, 1.f);
    BAR();
    f32x16 qk[2]; qkT_mfma(F, TQ, TK, qk);
    const int tb = F.wave >> 1, sb0 = (F.wave & 1) * 2, hh = F.lane >> 5, t = 32 * tb + (F.lane & 31);
#pragma unroll
    for (int j = 0; j < 2; ++j)
#pragma unroll
        for (int i4 = 0; i4 < 4; ++i4) { const int sb = 32 * (sb0 + j) + 8 * i4 + 4 * hh; float p[4];
#pragma unroll
            for (int i = 0; i < 4; ++i) { const int s = sb + i; const float df = (float)(t - s);
                float dm;
                if (sb0 + j == tb) dm = (s <= t ? __expf(df * lgf) : 0.f) + (s >= t ? __expf(-df * lgb) : 0.f);
                else dm = __expf(sb0 + j < tb ? df * lgf : -df * lgb);
                p[i] = qk[j][4 * i4 + i] * dm; }
            *(LAS u32x2*)(TP + t * LDT + sb * 2) = (u32x2){pk2(p[0], p[1]), pk2(p[2], p[3])}; }
    BAR();
    f32x16 y[2] = {ZERO16, ZERO16};
    pv_mfma(F, TP, TV, y);
#pragma unroll 1
    for (int d = 0; d < 2; ++d) { f32x16 qs[2] = {ZERO16, ZERO16};
        if (!sq.lat && (d == 0 ? sq.c == 0 : sq.c == sq.nch - 1)) continue;
        bf16x8 bst[2][8]; qs_prefetch(F, WSP(const bf16, WS_RTIN) + (size_t)((cp * 2 + d) * 4 + h) * 16384, bst);
        qs_mfma(F, TQ, bst, qs);
#pragma unroll
        for (int j = 0; j < 2; ++j)
#pragma unroll
            for (int k4 = 0; k4 < 4; ++k4) { const f32x4 f4 = *(const LAS f32x4*)(SCA(10 + d) + 32 * tb + 8 * k4 + 4 * hh);
#pragma unroll
                for (int i = 0; i < 4; ++i) y[j][4 * k4 + i] += f4[i] * qs[j][4 * k4 + i]; } }
    BAR();
    hs_to_lds(F, F.lds, y);
    BAR();
    head_out_r<1>(F, F.lds, INP(I_RNORM) + (size_t)l * GWID + h * 128, og, WSP(bf16, WS_Y) + (size_t)cp * 128 * D + 1024 + h * 128);
    BAR();
}
template <bool WMODE> __device__ __forceinline__ float ssd_scalars(Frame& F, KArgs& A, int l, int cp, int g) {
    const int d = F.wave >> 2, rr = F.wave & 3, head = g * 4 + rr;
    const float bias = INP(I_DTB)[(l * 2 + d) * 8 + head], arate = -__expf(INP(I_ALOG)[(l * 2 + d) * 8 + head]);
    const float* gp = WSP(const float, WS_GATES) + (size_t)(cp * 128) * 32 + 16 + d * 8 + head;
    const int i0 = d ? 127 - 2 * F.lane : 2 * F.lane, i1 = d ? i0 - 1 : i0 + 1;
    const float dt0 = softplusf_(gp[(size_t)i0 * 32] + bias), dt1 = softplusf_(gp[(size_t)i1 * 32] + bias);
    const float a0 = dt0 * arate, a1 = dt1 * arate;
    float inc = a0 + a1;
#pragma unroll
    for (int o = 1; o < 64; o <<= 1) { const float t = __shfl_up(inc, o); if (F.lane >= o) inc += t; }
    const float c1 = inc, c0 = inc - a1, tot = __shfl(inc, 63);
    LAS float* cum = SCA(16 + d * 4 + rr); LAS float* dtw = SCA(24 + d * 4 + rr);
    cum[i0] = c0; cum[i1] = c1;
    if (WMODE) { dtw[i0] = __expf(tot - c0) * dt0; dtw[i1] = __expf(tot - c1) * dt1; } else { dtw[i0] = dt0; dtw[i1] = dt1; }
    return tot;
}
__device__ __forceinline__ void seq_bounds(int cp, int& lo, int& hi) { if (cp < 64) { lo = (cp >> 1) * 256; hi = lo + 256; } else { lo = MC + ((cp - 64) >> 5) * 4096; hi = lo + 4096; } }
__device__ __forceinline__ void ssd_local_item(Frame F, KArgs& A, int l, int cp, int g) {
    const float tot = ssd_scalars<true>(F, A, l, cp, g);
    if (F.lane == 0) WSP(float, WS_SDSC)[(cp * 2 + (F.wave >> 2)) * 8 + g * 4 + (F.wave & 3)] = tot;
    int lo, hi; seq_bounds(cp, lo, hi);
    LAS unsigned char* TB = F.lds;
    load_conv<1, 16>(F, A, l, TB, nullptr, LDT, 512 + g * 128, cp * 128, lo, hi, nullptr, nullptr, true);
    load_conv<0, 16>(F, A, l, nullptr, nullptr, LDT, 768 + g * 128, cp * 128, lo, hi, nullptr, nullptr, true);
    BAR();
#pragma unroll 1
    for (int hr = 0; hr < 2; ++hr) {
#pragma unroll 1
        for (int r2 = 0; r2 < 2; ++r2) { const int rr = hr * 2 + r2;
            load_conv<2, 8>(F, A, l, F.lds + TS + (r2 * 2 + 0) * TSX, F.lds + TS + (r2 * 2 + 1) * TSX, LDX, g * 256 + rr * 64, cp * 128, lo, hi, SCA(24 + 0 * 4 + rr), SCA(24 + 1 * 4 + rr), true); }
        BAR();
        const int r2 = F.wave >> 2, d = (F.wave >> 1) & 1, pb = F.wave & 1, hh = F.lane >> 5, head = g * 4 + hr * 2 + r2;
        const LAS unsigned char* TX = F.lds + TS + (r2 * 2 + d) * TSX;
        f32x16 acc[4] = {ZERO16, ZERO16, ZERO16, ZERO16};
#pragma unroll 1
        for (int ks = 0; ks < 8; ++ks) { const bf16x8 a = frag_tr(TX, LDX, 16 * ks, 32 * pb, F.lane);
#pragma unroll
            for (int nb = 0; nb < 4; ++nb) acc[nb] = MFMA32(a, frag_tr(TB, LDT, 16 * ks, 32 * nb, F.lane), acc[nb]); }
        bf16* o = WSP(bf16, WS_SDLOC) + (size_t)((cp * 2 + d) * 8 + head) * 8192;
#pragma unroll
        for (int nb = 0; nb < 4; ++nb)
#pragma unroll
            for (int i = 0; i < 16; ++i) o[(32 * pb + crow(i, hh)) * 128 + 32 * nb + (F.lane & 31)] = (bf16)f2bf(acc[nb][i]);
        BAR();
    }
}
__device__ __forceinline__ void ssd_out_item(Frame F, KArgs& A, int l, int cp, bf16* Ybase) {
    const Seq sq = seq_of(cp);
    LAS unsigned char* TC = F.lds; LAS unsigned char* TB = F.lds + TS; LAS unsigned char* TX2 = F.lds + 2 * TS; LAS unsigned char* YI = F.lds + 3 * TS;
    LAS float* SSQ = SCA(14);
    if (F.tid < 128) SSQ[F.tid] = 0.f;
    const int tb = F.wave >> 1, ph = F.wave & 1, hh = F.lane >> 5, t = 32 * tb + (F.lane & 31);
    bf16* Yd = Ybase + (size_t)cp * 128 * D + 1536;
#pragma unroll 1
    for (int g = 0; g < 2; ++g) {
        (void)ssd_scalars<false>(F, A, l, cp, g);
        load_xbcc<16>(F, TC, LDT, 768 + g * 128, cp * 128);
        load_xbcc<16>(F, TB, LDT, 512 + g * 128, cp * 128);
        load_xbcc<16>(F, TX2, LDT, g * 256, cp * 128);
        BAR();
        f32x16 cb[4] = {ZERO16, ZERO16, ZERO16, ZERO16};
#pragma unroll 1
        for (int ks = 0; ks < 8; ++ks) { const bf16x8 bq = frag_row(TC, LDT, 32 * tb, 16 * ks, F.lane);
#pragma unroll
            for (int sb = 0; sb < 4; ++sb) cb[sb] = MFMA32(frag_row(TB, LDT, 32 * sb, 16 * ks, F.lane), bq, cb[sb]); }
#pragma unroll 1
        for (int hr = 0; hr < 2; ++hr) {
            if (hr == 1) { load_xbcc<16>(F, TX2, LDT, g * 256 + 128, cp * 128); BAR(); }
            f32x16 y2[2];
#pragma unroll
            for (int r2 = 0; r2 < 2; ++r2) {
                const int rr = hr * 2 + r2, head = g * 4 + rr;
                f32x16 y = ZERO16;
#pragma unroll 1
                for (int d = 0; d < 2; ++d) {
                    const LAS float* cum = SCA(16 + d * 4 + rr); const LAS float* dtv = SCA(24 + d * 4 + rr); const float ct = cum[t];
                    const bool has_state = sq.lat || (d == 0 ? sq.c > 0 : sq.c < sq.nch - 1);
                    bf16x8 bh[8];
                    if (has_state) { const bf16* hin = WSP(const bf16, WS_SDIN) + (size_t)((cp * 2 + d) * 8 + head) * 8192;
#pragma unroll
                        for (int ks = 0; ks < 8; ++ks) bh[ks] = *(const bf16x8*)(hin + (size_t)(32 * ph + (F.lane & 31)) * 128 + 16 * ks + 8 * hh); }
#pragma unroll
                    for (int sb = 0; sb < 4; ++sb) if (d == 0 ? sb <= tb : sb >= tb) {
#pragma unroll
                        for (int sp = 0; sp < 2; ++sp) { float p[8];
#pragma unroll
                            for (int jh = 0; jh < 2; ++jh) { const int s0 = 32 * sb + 16 * sp + 8 * jh + 4 * hh; const f32x4 c4 = *(const LAS f32x4*)(cum + s0), d4 = *(const LAS f32x4*)(dtv + s0);
#pragma unroll
                                for (int j = 0; j < 4; ++j) { const int s = s0 + j; float v = cb[sb][8 * sp + 4 * jh + j] * __expf(ct - c4[j]) * d4[j];
                                    if (sb == tb) { const bool ok = d == 0 ? (s <= t) : (s >= t); v = ok ? v : 0.f; }
                                    p[4 * jh + j] = v; } }
                            y = MFMA32(__builtin_bit_cast(bf16x8, pack8(p, 1.f)), frag_trp(TX2, LDT, 32 * sb + 16 * sp, r2 * 64 + 32 * ph, F.lane), y); } }
                    if (has_state) { f32x16 ch = ZERO16;
#pragma unroll
                        for (int ks = 0; ks < 8; ++ks) ch = MFMA32(frag_row(TC, LDT, 32 * tb, 16 * ks, F.lane), bh[ks], ch);
#pragma unroll
                        for (int k4 = 0; k4 < 4; ++k4) { const f32x4 c4 = *(const LAS f32x4*)(cum + 32 * tb + 8 * k4 + 4 * hh);
#pragma unroll
                            for (int i = 0; i < 4; ++i) y[4 * k4 + i] += __expf(c4[i]) * ch[4 * k4 + i]; } }
                }
                y2[r2] = y;
            }
#pragma unroll
            for (int r2 = 0; r2 < 2; ++r2)
#pragma unroll
                for (int i = 0; i < 16; ++i) *(LAS unsigned short*)(YI + (32 * tb + crow(i, hh)) * LDT + (r2 * 64 + 32 * ph + (F.lane & 31)) * 2) = (unsigned short)f2bf(y2[r2][i]);
            BAR();
            { const int tt = F.tid >> 2, seg = F.tid & 3, head = g * 4 + hr * 2 + (seg >> 1), pc = (seg & 1) * 32; const float Dh = INP(I_SSDD)[l * 8 + head]; float ss = 0.f;
#pragma unroll
                for (int k = 0; k < 4; ++k) { float yv[8], x[8], z[8], o[8];
                    unpack8(*(const LAS v4u*)(YI + tt * LDT + (seg * 32 + 8 * k) * 2), yv); unpack8(*(const LAS v4u*)(TX2 + tt * LDT + (seg * 32 + 8 * k) * 2), x);
                    unpack8(*(const v4u*)(PT(cp, PC_DZ + head * 64 + pc) + (size_t)tt * 128 + 8 * k), z);
#pragma unroll
                    for (int j = 0; j < 8; ++j) { const float v = (yv[j] + Dh * x[j]) * siluf_(z[j]); o[j] = v; ss += v * v; }
                    *(v4u*)(Yd + (size_t)tt * D + head * 64 + pc + 8 * k) = pack8(o, 1.f); }
                ss += __shfl_xor(ss, 1); ss += __shfl_xor(ss, 2);
                if (seg == 0) SSQ[tt] += ss; }
            BAR();
        }
    }
    __builtin_amdgcn_fence(__ATOMIC_RELEASE, "workgroup"); asm volatile("s_waitcnt vmcnt(0)" ::: "memory"); __syncthreads(); __builtin_amdgcn_fence(__ATOMIC_ACQUIRE, "workgroup");
    { const int tt = F.tid >> 2, seg = F.tid & 3; const float r = rsqrtf(SSQ[tt] * (1.f / 512.f) + EPS); const float* gn = INP(I_SNORM) + (size_t)l * GWID + 128 * seg;
#pragma unroll 4
        for (int k = 0; k < 16; ++k) { bf16* p = Yd + (size_t)tt * D + 128 * seg + 8 * k; float v[8];
            unpack8(*(const v4u*)p, v);
#pragma unroll
            for (int j = 0; j < 8; ++j) v[j] = v[j] * r * gn[8 * k + j];
            *(v4u*)p = pack8(v, 1.f); } }
    BAR();
}
template <int PASS> __device__ __forceinline__ void s5_item(Frame F, KArgs& A, int l, int cp, int gq) {
    const Seq sq = seq_of(cp);
    const int g = gq * 8 + F.wave, p = F.lane, hh = F.lane >> 5;
    LAS unsigned char* TU = F.lds; LAS unsigned char* BU = F.lds + TS + F.wave * 8704;
    if (PASS == 1) ITS(8);
    typedef short v8s __attribute__((ext_vector_type(8)));
    typedef float f32x4v __attribute__((ext_vector_type(4)));
    const int r16 = F.lane & 15, g4 = F.lane >> 4;
    v4u ru[4]; tile_issue(F, PT(cp, PC_S5U + gq * 128), ru);
    f32x2 lam[2], l8[2], h0[2]; bf16x8 bbf[2][4]; v8s ctf[2][4];
#pragma unroll
    for (int d = 0; d < 2; ++d) {
        const unsigned char* tab = s5tab(F, l, d, g);
        lam[d] = ((const f32x2*)tab)[p]; l8[d] = ((const f32x2*)(tab + 512))[p]; h0[d] = (f32x2){0.f, 0.f};
        if (PASS == 1 && sq.lat) { const size_t o = (size_t)(((sq.b * 4 + l) * 2 + d) * 32 + g) * 64 + p; h0[d] = (f32x2){INP(I_SS5R)[o], INP(I_SS5I)[o]}; }
        const bf16* bb = (const bf16*)(tab + 1024); const bf16* ct = (const bf16*)(tab + 5120);
#pragma unroll
        for (int nb = 0; nb < 4; ++nb) bbf[d][nb] = *(const bf16x8*)(bb + (size_t)(32 * nb + (F.lane & 31)) * 16 + 8 * hh);
        if (PASS == 1 && d == 0) {
#pragma unroll
            for (int ks = 0; ks < 4; ++ks) ctf[0][ks] = *(const v8s*)(ct + r16 * 128 + 32 * ks + 8 * g4); }
    }
    if (PASS == 1) {
        f32x2 e[31];
#pragma unroll
        for (int j = 0; j < 31; ++j) if (j < sq.nch - 1) { const int cc = j < sq.c ? j : j + 1, dd = j < sq.c ? 0 : 1;
            e[j] = *(const f32x2*)(WSP(const float, WS_S5LOC) + ((size_t)(((sq.cp0 + cc) * 2 + dd) * 32 + g) * 64 + p) * 2); }
#pragma unroll
        for (int j = 0; j < 31; ++j) if (j < sq.c) { const float nr = l8[0].x * h0[0].x - l8[0].y * h0[0].y + e[j].x, ni = l8[0].x * h0[0].y + l8[0].y * h0[0].x + e[j].y; h0[0] = (f32x2){nr, ni}; }
#pragma unroll
        for (int j = 30; j >= 0; --j) if (j >= sq.c && j < sq.nch - 1) { const float nr = l8[1].x * h0[1].x - l8[1].y * h0[1].y + e[j].x, ni = l8[1].x * h0[1].y + l8[1].y * h0[1].x + e[j].y; h0[1] = (f32x2){nr, ni}; }
    }
    tile_commit(F, TU, ru, 1.f);
    BAR();
    if (PASS == 1) { ITE(8); ITS(9); }
    f32x4v yacc[4][2];
    if (PASS == 1) {
#pragma unroll
        for (int a = 0; a < 4; ++a) { yacc[a][0] = (f32x4v){0.f, 0.f, 0.f, 0.f}; yacc[a][1] = (f32x4v){0.f, 0.f, 0.f, 0.f}; } }
#pragma unroll
    for (int d = 0; d < 2; ++d) {
        const f32x2 L1 = (f32x2){lam[d].x, lam[d].x}, L2 = (f32x2){-lam[d].y, lam[d].y};
        f32x2 hc = h0[d];
        if (PASS == 1 && d == 1) { const bf16* ct = (const bf16*)(s5tab(F, l, 1, g) + 5120);
#pragma unroll
            for (int ks = 0; ks < 4; ++ks) ctf[1][ks] = *(const v8s*)(ct + r16 * 128 + 32 * ks + 8 * g4); }
#pragma unroll 1
        for (int tbi = 0; tbi < 4; ++tbi) {
            const int tb = d == 0 ? tbi : 3 - tbi;
            const bf16x8 bu = frag_row(TU, LDT, 32 * tb, 16 * F.wave, F.lane);
#pragma unroll
            for (int nb = 0; nb < 4; ++nb) {
                const f32x16 acc = MFMA32(bbf[d][nb], bu, ZERO16);
#pragma unroll
                for (int i4 = 0; i4 < 4; ++i4) *(LAS u32x2*)(BU + (F.lane & 31) * LDT + (32 * nb + 8 * i4 + 4 * hh) * 2) = (u32x2){pk2(acc[4 * i4], acc[4 * i4 + 1]), pk2(acc[4 * i4 + 2], acc[4 * i4 + 3])};
            }
            asm volatile("s_waitcnt lgkmcnt(0)" ::: "memory");
            unsigned w[32];
#pragma unroll
            for (int st = 0; st < 32; ++st) { const int tl = d == 0 ? st : 31 - st; w[st] = *(const LAS unsigned*)(BU + tl * LDT + p * 4); }
#pragma unroll
            for (int st = 0; st < 32; ++st) { const f32x2 bb2 = (f32x2){bflo(w[st]), bfhi(w[st])};
                const f32x2 t2 = __builtin_elementwise_fma(L1, hc, bb2);
                hc = __builtin_elementwise_fma(L2, __builtin_shufflevector(hc, hc, 1, 0), t2);
                if (PASS == 1) w[st] = pk2(hc.x, hc.y); }
            if (PASS == 1) {
#pragma unroll
                for (int st = 0; st < 32; ++st) { const int tl = d == 0 ? st : 31 - st; *(LAS unsigned*)(BU + tl * LDT + p * 4) = w[st]; }
                asm volatile("s_waitcnt lgkmcnt(0)" ::: "memory");
                f32x4v y0 = (f32x4v){0.f, 0.f, 0.f, 0.f}, y1 = y0;
#pragma unroll
                for (int ks = 0; ks < 4; ++ks) {
                    y0 = __builtin_amdgcn_mfma_f32_16x16x32_bf16(*(const LAS v8s*)(BU + r16 * LDT + (32 * ks + 8 * g4) * 2), ctf[d][ks], y0, 0, 0, 0);
                    y1 = __builtin_amdgcn_mfma_f32_16x16x32_bf16(*(const LAS v8s*)(BU + (16 + r16) * LDT + (32 * ks + 8 * g4) * 2), ctf[d][ks], y1, 0, 0, 0); }
                if (tb == 0) { yacc[0][0] += y0; yacc[0][1] += y1; } else if (tb == 1) { yacc[1][0] += y0; yacc[1][1] += y1; } else if (tb == 2) { yacc[2][0] += y0; yacc[2][1] += y1; } else { yacc[3][0] += y0; yacc[3][1] += y1; }
                asm volatile("s_waitcnt lgkmcnt(0)" ::: "memory");
            }
        }
        if (PASS == 0) { *(f32x2*)(WSP(float, WS_S5LOC) + ((size_t)((cp * 2 + d) * 32 + g) * 64 + p) * 2) = hc; }
        else if (!sq.lat && ((d == 0 && sq.c == sq.nch - 1) || (d == 1 && sq.c == 0))) { const size_t o = (size_t)(((sq.b * 4 + l) * 2 + d) * 32 + g) * 64 + p; F.out[O_S5R + o] = hc.x; F.out[O_S5I + o] = hc.y; }
    }
    if (PASS == 1) { ITE(9); ITS(10); }
    if (PASS == 1) {
        const float Dc = INP(I_S5D)[(size_t)l * GWID + g * 16 + r16];
#pragma unroll
        for (int tb = 0; tb < 4; ++tb)
#pragma unroll
            for (int ts = 0; ts < 2; ++ts)
#pragma unroll
                for (int i = 0; i < 4; ++i) { const int t = 32 * tb + 16 * ts + 4 * g4 + i; LAS unsigned short* up = (LAS unsigned short*)(TU + t * LDT + (16 * F.wave + r16) * 2);
                    const float x = yacc[tb][ts][i] + Dc * bf2f(*up);
                    const float u2 = 1.5957691216057308f * (x + 0.044715f * x * x * x); const float ge = x - x * __builtin_amdgcn_rcpf(1.f + __expf(u2));
                    *up = (unsigned short)f2bf(ge); }
        BAR();
        bf16* ya = WSP(bf16, WS_YA) + (size_t)cp * 128 * GWID + gq * 128;
#pragma unroll
        for (int it = 0; it < 4; ++it) { const int i = F.tid + NT * it, r = i >> 4, c = i & 15; *(v4u*)(ya + (size_t)r * GWID + c * 8) = *(const LAS v4u*)(TU + r * LDT + c * 16); }
    }
    BAR();
    if (PASS == 1) ITE(10);
}

template <bool LAT> __device__ __forceinline__ void carry_unit(Frame F, KArgs& A, int l, int u) {
    const int sd = u / 96, rem = u % 96, sidx = sd >> 1, d = sd & 1;
    constexpr int lat = LAT ? 1 : 0, nch = LAT ? 32 : 2, NB = LAT ? 16 : 2;
    const int b = LAT ? sidx : sidx - 4, cp0 = LAT ? 64 + 32 * b : 2 * b;
    int type, head, slice;
    if (rem < 32) { type = 0; head = rem >> 3; slice = rem & 7; } else if (rem < 64) { type = 1; head = (rem - 32) >> 3; slice = (rem - 32) & 7; } else { type = 2; head = (rem - 64) >> 2; slice = (rem - 64) & 3; }
    const int e0 = slice * 2048 + F.tid * 4;
    const int nh = type == 2 ? 8 : 4, esz = type == 2 ? 8192 : 16384;
    const bf16* loc = type == 0 ? WSP(const bf16, WS_MLCLOC) : (type == 1 ? WSP(const bf16, WS_RTLOC) : WSP(const bf16, WS_SDLOC));
    bf16* inb = type == 0 ? WSP(bf16, WS_MLCIN) : (type == 1 ? WSP(bf16, WS_RTIN) : WSP(bf16, WS_SDIN));
    float zf = 0.f; asm volatile("" : "+v"(zf));
    float v[4] = {zf, zf, zf, zf}, nv[4] = {zf, zf, zf, zf}, m = 0.f;
    const bool do_n = (type == 0 && slice == 0 && F.tid < 32);
    if (LAT) {
        if (type == 2) { const f32x4 s = *(const f32x4*)(INP(I_SSSD) + (size_t)(((b * 4 + l) * 2 + d) * 8 + head) * 8192 + e0); v[0] = s.x; v[1] = s.y; v[2] = s.z; v[3] = s.w; }
        else { const float* s = (type == 0 ? INP(I_SMC) : INP(I_SRET)) + (size_t)(((b * 4 + l) * 2 + d) * 4 + head) * 16384; const int dv = e0 >> 7, dk = e0 & 127;
#pragma unroll
            for (int j = 0; j < 4; ++j) v[j] = s[(dk + j) * 128 + dv]; }
        if (type == 0) { m = INP(I_SMM)[((b * 4 + l) * 2 + d) * 4 + head];
            if (do_n) { const f32x4 s = *(const f32x4*)(INP(I_SMN) + (size_t)(((b * 4 + l) * 2 + d) * 4 + head) * 128 + F.tid * 4); nv[0] = s.x; nv[1] = s.y; nv[2] = s.z; nv[3] = s.w; } }
    }
    const float rdec = type == 1 ? __expf(-128.f * __expf(INP(I_RRATE)[(l * 2 + d) * 4 + head])) : 1.f;
#pragma unroll 1
    for (int ci0 = 0; ci0 < nch; ci0 += NB) {
        u32x2 lc[NB]; f32x4 ln[NB]; float s0[NB], s1[NB];
#pragma unroll
        for (int j = 0; j < NB; ++j) { ln[j] = (f32x4){zf, zf, zf, zf}; s0[j] = zf; s1[j] = zf; }
#pragma unroll
        for (int j = 0; j < NB; ++j) {
            const int ci = ci0 + j, cp = cp0 + (d == 0 ? ci : nch - 1 - ci);
            lc[j] = *(const u32x2*)(loc + (size_t)((cp * 2 + d) * nh + head) * esz + e0);
            if (type == 0) { const float* sc = WSP(const float, WS_MLSC) + ((cp * 2 + d) * 4 + head) * 2; s0[j] = sc[0]; s1[j] = sc[1];
                if (do_n) ln[j] = *(const f32x4*)(WSP(const float, WS_MLNLOC) + ((cp * 2 + d) * 4 + head) * 128 + F.tid * 4); }
            else if (type == 2) s0[j] = WSP(const float, WS_SDSC)[(cp * 2 + d) * 8 + head];
        }
#pragma unroll
        for (int j = 0; j < NB; ++j) {
            const int ci = ci0 + j, cp = cp0 + (d == 0 ? ci : nch - 1 - ci);
            const size_t so = (size_t)((cp * 2 + d) * nh + head) * esz + e0;
            if (LAT || ci > 0) *(u32x2*)(inb + so) = (u32x2){pk2(v[0], v[1]), pk2(v[2], v[3])};
            float dec, wl = 1.f;
            if (type == 0) {
                const float Bt = s0[j], ml = s1[j];
                if (slice == 0 && F.tid == 0) WSP(float, WS_MLMIN)[(cp * 2 + d) * 4 + head] = m;
                if (do_n) *(f32x4*)(WSP(float, WS_MLNIN) + ((cp * 2 + d) * 4 + head) * 128 + F.tid * 4) = (f32x4){nv[0], nv[1], nv[2], nv[3]};
                const float mn = fmaxf(Bt + m, ml); dec = __expf(Bt + m - mn); wl = __expf(ml - mn); m = mn;
                if (do_n) { nv[0] = dec * nv[0] + wl * ln[j].x; nv[1] = dec * nv[1] + wl * ln[j].y; nv[2] = dec * nv[2] + wl * ln[j].z; nv[3] = dec * nv[3] + wl * ln[j].w; }
            } else if (type == 1) dec = rdec;
            else dec = __expf(s0[j]);
            v[0] = dec * v[0] + wl * bflo(lc[j].x); v[1] = dec * v[1] + wl * bfhi(lc[j].x); v[2] = dec * v[2] + wl * bflo(lc[j].y); v[3] = dec * v[3] + wl * bfhi(lc[j].y);
        }
    }
    if (!lat) {
        if (type == 2) *(f32x4*)(F.out + O_SSD + (size_t)(((b * 4 + l) * 2 + d) * 8 + head) * 8192 + e0) = (f32x4){v[0], v[1], v[2], v[3]};
        else {
            LAS float* tr = (LAS float*)F.lds;
            const int dvl = F.tid >> 5, dk = (F.tid & 31) * 4;
#pragma unroll
            for (int j = 0; j < 4; ++j) tr[dvl * 129 + dk + j] = v[j];
            BAR();
            const int dk2 = F.tid >> 2, q = F.tid & 3;
            float* o = F.out + (type == 0 ? O_MC : O_RET) + (size_t)(((b * 4 + l) * 2 + d) * 4 + head) * 16384 + (size_t)dk2 * 128 + slice * 16 + 4 * q;
            *(f32x4*)o = (f32x4){tr[(4 * q) * 129 + dk2], tr[(4 * q + 1) * 129 + dk2], tr[(4 * q + 2) * 129 + dk2], tr[(4 * q + 3) * 129 + dk2]};
            if (type == 0) { if (do_n) *(f32x4*)(F.out + O_MN + (size_t)(((b * 4 + l) * 2 + d) * 4 + head) * 128 + F.tid * 4) = (f32x4){nv[0], nv[1], nv[2], nv[3]};
                if (slice == 0 && F.tid == 0) F.out[O_MM + ((b * 4 + l) * 2 + d) * 4 + head] = m; }
            BAR();
        }
    }
}

struct CtxLd { u32x2 lc[2]; f32x4 ln[2]; float s0[2], s1[2]; };
struct CtxU { int d, b, cp0, type, head, slice, e0, nh, esz; bool do_n; };
__device__ __forceinline__ CtxU ctx_decode(const Frame& F, int u) {
    CtxU c; const int sd = u / 96, rem = u % 96, sidx = sd >> 1; c.d = sd & 1; c.b = sidx - 4; c.cp0 = 2 * c.b;
    if (rem < 32) { c.type = 0; c.head = rem >> 3; c.slice = rem & 7; } else if (rem < 64) { c.type = 1; c.head = (rem - 32) >> 3; c.slice = (rem - 32) & 7; } else { c.type = 2; c.head = (rem - 64) >> 2; c.slice = (rem - 64) & 3; }
    c.e0 = c.slice * 2048 + F.tid * 4; c.nh = c.type == 2 ? 8 : 4; c.esz = c.type == 2 ? 8192 : 16384; c.do_n = (c.type == 0 && c.slice == 0 && F.tid < 32);
    return c;
}
__device__ __forceinline__ void carry_ctx_load(const Frame& F, int u, CtxLd& L, float zf) {
    const CtxU c = ctx_decode(F, u);
    const bf16* loc = c.type == 0 ? WSP(const bf16, WS_MLCLOC) : (c.type == 1 ? WSP(const bf16, WS_RTLOC) : WSP(const bf16, WS_SDLOC));
#pragma unroll
    for (int j = 0; j < 2; ++j) { const int cp = c.cp0 + (c.d == 0 ? j : 1 - j);
        L.ln[j] = (f32x4){zf, zf, zf, zf}; L.s0[j] = zf; L.s1[j] = zf;
        L.lc[j] = *(const u32x2*)(loc + (size_t)((cp * 2 + c.d) * c.nh + c.head) * c.esz + c.e0);
        if (c.type == 0) { const float* sc = WSP(const float, WS_MLSC) + ((cp * 2 + c.d) * 4 + c.head) * 2; L.s0[j] = sc[0]; L.s1[j] = sc[1];
            if (c.do_n) L.ln[j] = *(const f32x4*)(WSP(const float, WS_MLNLOC) + ((cp * 2 + c.d) * 4 + c.head) * 128 + F.tid * 4); }
        else if (c.type == 2) L.s0[j] = WSP(const float, WS_SDSC)[(cp * 2 + c.d) * 8 + c.head]; }
}
__device__ __forceinline__ void carry_ctx_finish(Frame& F, KArgs& A, int l, int u, const CtxLd& L, float zf) {
    const CtxU c = ctx_decode(F, u);
    bf16* inb = c.type == 0 ? WSP(bf16, WS_MLCIN) : (c.type == 1 ? WSP(bf16, WS_RTIN) : WSP(bf16, WS_SDIN));
    float v[4] = {zf, zf, zf, zf}, nv[4] = {zf, zf, zf, zf}, m = 0.f;
    const float rdec = c.type == 1 ? __expf(-128.f * __expf(INP(I_RRATE)[(l * 2 + c.d) * 4 + c.head])) : 1.f;
#pragma unroll
    for (int j = 0; j < 2; ++j) { const int cp = c.cp0 + (c.d == 0 ? j : 1 - j);
        if (j > 0) *(u32x2*)(inb + (size_t)((cp * 2 + c.d) * c.nh + c.head) * c.esz + c.e0) = (u32x2){pk2(v[0], v[1]), pk2(v[2], v[3])};
        float dec, wl = 1.f;
        if (c.type == 0) {
            if (c.slice == 0 && F.tid == 0) WSP(float, WS_MLMIN)[(cp * 2 + c.d) * 4 + c.head] = m;
            if (c.do_n) *(f32x4*)(WSP(float, WS_MLNIN) + ((cp * 2 + c.d) * 4 + c.head) * 128 + F.tid * 4) = (f32x4){nv[0], nv[1], nv[2], nv[3]};
            const float mn = fmaxf(L.s0[j] + m, L.s1[j]); dec = __expf(L.s0[j] + m - mn); wl = __expf(L.s1[j] - mn); m = mn;
            if (c.do_n) { nv[0] = dec * nv[0] + wl * L.ln[j].x; nv[1] = dec * nv[1] + wl * L.ln[j].y; nv[2] = dec * nv[2] + wl * L.ln[j].z; nv[3] = dec * nv[3] + wl * L.ln[j].w; }
        } else if (c.type == 1) dec = rdec;
        else dec = __expf(L.s0[j]);
        v[0] = dec * v[0] + wl * bflo(L.lc[j].x); v[1] = dec * v[1] + wl * bfhi(L.lc[j].x); v[2] = dec * v[2] + wl * bflo(L.lc[j].y); v[3] = dec * v[3] + wl * bfhi(L.lc[j].y); }
    const int b = c.b, d = c.d, head = c.head, slice = c.slice, e0 = c.e0;
    if (c.type == 2) *(f32x4*)(F.out + O_SSD + (size_t)(((b * 4 + l) * 2 + d) * 8 + head) * 8192 + e0) = (f32x4){v[0], v[1], v[2], v[3]};
    else {
        LAS float* tr = (LAS float*)F.lds;
        const int dvl = F.tid >> 5, dk = (F.tid & 31) * 4;
#pragma unroll
        for (int j = 0; j < 4; ++j) tr[dvl * 129 + dk + j] = v[j];
        BAR();
        const int dk2 = F.tid >> 2, q = F.tid & 3;
        float* o = F.out + (c.type == 0 ? O_MC : O_RET) + (size_t)(((b * 4 + l) * 2 + d) * 4 + head) * 16384 + (size_t)dk2 * 128 + slice * 16 + 4 * q;
        *(f32x4*)o = (f32x4){tr[(4 * q) * 129 + dk2], tr[(4 * q + 1) * 129 + dk2], tr[(4 * q + 2) * 129 + dk2], tr[(4 * q + 3) * 129 + dk2]};
        if (c.type == 0) { if (c.do_n) *(f32x4*)(F.out + O_MN + (size_t)(((b * 4 + l) * 2 + d) * 4 + head) * 128 + F.tid * 4) = (f32x4){nv[0], nv[1], nv[2], nv[3]};
            if (slice == 0 && F.tid == 0) F.out[O_MM + ((b * 4 + l) * 2 + d) * 4 + head] = m; }
        BAR();
    }
}
__device__ __forceinline__ void carry_ctx_batch(Frame F, KArgs& A, int l, int u0) {
    float zf = 0.f; asm volatile("" : "+v"(zf));
    CtxLd L[8];
#pragma unroll
    for (int j = 0; j < 8; ++j) carry_ctx_load(F, u0 + j, L[j], zf);
#pragma unroll
    for (int j = 0; j < 8; ++j) carry_ctx_finish(F, A, l, u0 + j, L[j], zf);
}
constexpr int CW_Q = 16384;
struct OneUnit { pg8::Unit u; __device__ __forceinline__ bool next(int i, pg8::Unit& o) const { if (i) return false; o = u; return true; }
    __device__ __forceinline__ void a_ready(const pg8::Unit&) const {} __device__ __forceinline__ void done(const pg8::Unit&) const {} };
#define QUEUE_LOOP(F0_, qidx, total, ...) do { \
    unsigned* qc_ = (unsigned*)(F0_.ws + WS_CTL) + CW_Q + 64 * (qidx); volatile LAS int* qs_ = (volatile LAS int*)(F0_.lds + MISC_OFF + 64); \
    if (F0_.tid == 0) qs_[0] = (int)__hip_atomic_fetch_add(qc_, 1u, __ATOMIC_RELAXED, __HIP_MEMORY_SCOPE_AGENT); \
    __syncthreads(); \
    int it = qs_[0], par_ = 1; \
    while (it < (total)) { \
        int nx_ = 0; if (F0_.tid == 0) nx_ = (int)__hip_atomic_fetch_add(qc_, 1u, __ATOMIC_RELAXED, __HIP_MEMORY_SCOPE_AGENT); \
        { __VA_ARGS__ } \
        if (F0_.tid == 0) qs_[par_] = nx_; \
        BAR();     \
        it = qs_[par_]; par_ ^= 1; \
    } } while (0)
#ifndef PROBE_ITEM
#define PROBE_ITEM -1
#endif
#define PR(t) (PROBE_ITEM == (t) ? 2 : 1)
#define QSPLIT(NT_, C0, C1, C2, C3, T0) int ty_ = 0, loc_ = it, dup_ = 0; { const int cnt_[4] = {C0, C1, C2, C3}; \
    _Pragma("unroll") for (int j_ = 0; j_ < NT_; ++j_) { const int span_ = cnt_[j_] * PR(T0 + j_); if (ty_ == j_) { if (loc_ >= span_) { loc_ -= span_; ty_ = j_ + 1; } else { dup_ = loc_ / cnt_[j_]; loc_ = loc_ % cnt_[j_]; } } } }
#ifndef PROBE_TMASK
#define PROBE_TMASK 0
#endif
#ifndef PROBE_TAMP
#define PROBE_TAMP 4
#endif
#define TSTART(k) do { if (PROBE_TMASK & (1 << (k))) pt0_ = __builtin_amdgcn_s_memrealtime(); } while (0)
#define TEND(k) do { if (PROBE_TMASK & (1 << (k))) ptacc_ += __builtin_amdgcn_s_memrealtime() - pt0_; } while (0)
#ifndef PROBE_REPEAT
#define PROBE_REPEAT -1
#endif
#ifndef XSTG
#define XSTG 0
#endif
constexpr int N_PHASES = 2 + 9 * NLAYER;
__global__ void __launch_bounds__(NT, 2) hymba_fwd(Args A) {
    extern __shared__ __attribute__((aligned(16))) unsigned char lds_raw[];
    Frame F0;
    F0.lds = (LAS unsigned char*)lds_raw;
    F0.tid = threadIdx.x; F0.lane = 0; F0.wave = __builtin_amdgcn_readfirstlane(F0.tid >> 6);
    F0.G = gridDim.x; F0.bid = blockIdx.x; F0.out = A.out; F0.ws = A.ws;
    volatile LAS unsigned* MISC = (volatile LAS unsigned*)(F0.lds + MISC_OFF);
    if (F0.tid < 64) MISC[F0.tid] = 0u;
    __syncthreads();
    unsigned* barw = (unsigned*)(F0.ws + WS_CTL) + CW_BAR;
    XcdBarrier bar = xcd_barrier_post(barw, MISC + 8, F0.wave == 0 ? 1u : 0u);
    const int lo = A.ph_lo, hi = A.ph_hi;
    unsigned long long pt0_ = 0, ptacc_ = 0;
#define KA (*kargs())
#define IN(k) (lo <= (k) && (k) < hi)
#define SEAM(k) do { if (IN(k) && IN((k) + 1)) xcd_barrier(bar); } while (0)
#define CSEAM(k) do { if (IN(k) && IN((k) + 1)) { if (__builtin_amdgcn_readfirstlane((int)MISC[11]) == 2) xcc_barrier(bar); else xcd_barrier(bar); } } while (0)
#define XCC_ORDER(S_, M_, N_) pg8::XccOrder S_; S_.init(M_, N_, F.G, F.bid, __builtin_amdgcn_readfirstlane((int)MISC[11]) == 2 ? 1 : 0, (int)bar.x, __builtin_amdgcn_readfirstlane((int)MISC[10]))

    TSTART(9); if (IN(0)) for (int rep_ = 0; rep_ < (PROBE_REPEAT == 100 ? 2 : 1); ++rep_) { Frame F = fresh(F0); p0_prologue(F, KA); } SEAM(0); TEND(9);

    TSTART(10); if (IN(1)) { Frame F = fresh(F0); norm0_phase(F, KA); shw_phase(F); } SEAM(1); TEND(10);

#pragma unroll 1
    for (int l = 0; l < NLAYER; ++l) {
        const int pb = 1 + 9 * l;
        TSTART(1); if (IN(pb + 1)) for (int rep_ = 0; rep_ < (PROBE_REPEAT == 1 ? 2 : 1); ++rep_) { Frame F = fresh(F0);
            pg8::Gemm g{WSP(const pg8::bf16_t, WS_H), WSP(const pg8::bf16_t, WS_W1T) + (size_t)l * NPAD * D, M, NPROJ, D}; pg8::StaticOrder S; S.init(M, NPROJ, F.G, F.bid);
            epi::EpiProj E{WSP(pg8::bf16_t, WS_PROJ), WSP(const float, WS_SSQB), WSP(const float, WS_SHW1) + (size_t)l * 5 * NPAD};
            pg8::gemm_phase<epi::EpiProj, pg8::StaticOrder, true, true>(F.lds, g, S, E, F.tid);
            __syncthreads(); gates_phase(F, l);
        } SEAM(pb + 1); TEND(1);
        TSTART(2); if (IN(pb + 2)) { Frame F = fresh(F0);
            QUEUE_LOOP(F, l * 3 + 0, 384 * PR(0) + 768 * PR(1) + 768 * PR(2) + 768 * PR(3), {
                QSPLIT(4, 384, 768, 768, 768, 0);
                if (ty_ == 0) { TSTART(11); ssd_local_item(fresh(F), KA, l, loc_ >> 1, loc_ & 1); TEND(11); }
                else if (ty_ == 1) { TSTART(12); mlstm_local_item(fresh(F), KA, l, loc_ >> 2, loc_ & 3); TEND(12); }
                else if (ty_ == 2) { TSTART(13); ret_local_item(fresh(F), KA, l, loc_ >> 2, loc_ & 3); TEND(13); }
                else { TSTART(14); s5_item<0>(fresh(F), KA, l, loc_ >> 2, loc_ & 3); TEND(14); }
            });
        } SEAM(pb + 2); TEND(2);
        TSTART(3); if (IN(pb + 3)) { Frame F = fresh(F0);
            QUEUE_LOOP(F, l * 3 + 1, 768 * PR(4) + 768 * PR(5) + 768 * PR(6), {
                QSPLIT(3, 768, 768, 768, 0, 4);
                if (ty_ == 0) { TSTART(15); carry_unit<true>(fresh(F), KA, l, loc_); TEND(15); }
                else if (ty_ == 1) { TSTART(16); s5_item<1>(fresh(F), KA, l, loc_ >> 2, loc_ & 3); TEND(16); }
                else { TSTART(17); carry_ctx_batch(fresh(F), KA, l, 768 + loc_ * 8); TEND(17); }
            });
        } SEAM(pb + 3); TEND(3);
        TSTART(4); if (IN(pb + 4)) { Frame F = fresh(F0);
            QUEUE_LOOP(F, l * 3 + 2, 192 * PR(7) + 192 * PR(8) + 768 * PR(9) + 768 * PR(10), {
                QSPLIT(4, 192, 192, 768, 768, 7);
                if (ty_ == 0) { TSTART(18); ssd_out_item(fresh(F), KA, l, loc_, dup_ ? WSP(bf16, WS_MLCLOC) : WSP(bf16, WS_Y)); TEND(18); }
                else if (ty_ == 1) { TSTART(19); Frame Fg = fresh(F);
                    pg8::Gemm g{WSP(const pg8::bf16_t, WS_YA), WSP(const pg8::bf16_t, WS_WGT) + (size_t)l * GWID * GWID, M, GWID, GWID}; OneUnit S; S.u.pm = loc_ >> 1; S.u.pn = loc_ & 1;
                    epi::EpiGlu E{WSP(const pg8::bf16_t, WS_YA), WSP(pg8::bf16_t, WS_Y)};
                    pg8::gemm_phase<epi::EpiGlu, OneUnit, false, true>(Fg.lds, g, S, E, Fg.tid); __syncthreads(); TEND(19); }
                else if (ty_ == 2) { TSTART(20); mlstm_out_item(fresh(F), KA, l, loc_ >> 2, loc_ & 3); TEND(20); }
                else { TSTART(21); ret_out_item(fresh(F), KA, l, loc_ >> 2, loc_ & 3); TEND(21); }
            });
        } SEAM(pb + 4); TEND(4);
        TSTART(5); if (IN(pb + 5)) { Frame F = fresh(F0);
            pg8::Gemm g{WSP(const pg8::bf16_t, WS_Y), WSP(const pg8::bf16_t, WS_WOT) + (size_t)l * D * D, M, D, D}; XCC_ORDER(S, M, D);
            if (XSTG > 0 && S.mode) { const unsigned long long t0_ = __builtin_amdgcn_s_memrealtime(), w_ = (unsigned long long)((S.j >> 3) * XSTG); while (__builtin_amdgcn_s_memrealtime() - t0_ < w_) __builtin_amdgcn_s_sleep(8); }
            KArgs& A_ = KA; epi::EpiRes E{(const float*)(const GAS float*)A_.in[I_XP], (const float*)(const GAS float*)A_.in[I_XS], WSP(pg8::bf16_t, WS_XB), WSP(const float, WS_MOD) + (size_t)(l * 5) * (6 * D) + 2 * D, l == 0 ? 1 : 0,
                          1, WSP(pg8::bf16_t, WS_H), WSP(float, WS_SSQA), (const float*)(const GAS float*)A_.in[I_NORM2] + (size_t)l * D, WSP(const float, WS_MOD) + (size_t)(l * 5) * (6 * D) + 4 * D, F.lds + 131072};
            pg8::gemm_phase<epi::EpiRes, pg8::XccOrder, true, true>(F.lds, g, S, E, F.tid);
        } CSEAM(pb + 5); TEND(5);
        TSTART(7); if (IN(pb + 7)) for (int rep_ = 0; rep_ < (PROBE_REPEAT == 7 ? 2 : 1); ++rep_) { Frame F = fresh(F0);
            pg8::Gemm g{WSP(const pg8::bf16_t, WS_H), WSP(const pg8::bf16_t, WS_WM1T) + (size_t)l * DFF * D, M, DFF, D}; XCC_ORDER(S, M, DFF);
            epi::EpiRelu2 E{WSP(pg8::bf16_t, WS_HID), WSP(const float, WS_SSQA), WSP(const float, WS_SHW2) + (size_t)l * 5 * DFF};
            pg8::gemm_phase<epi::EpiRelu2, pg8::XccOrder, true, true>(F.lds, g, S, E, F.tid);
        } CSEAM(pb + 7); TEND(7);
        TSTART(8); if (IN(pb + 8)) { Frame F = fresh(F0);
            pg8::Gemm g{WSP(const pg8::bf16_t, WS_HID), WSP(const pg8::bf16_t, WS_WM2T) + (size_t)l * D * DFF, M, D, DFF}; XCC_ORDER(S, M, D);
            KArgs& A_ = KA; epi::EpiRes E{(const float*)(const GAS float*)A_.in[I_XP], (const float*)(const GAS float*)A_.in[I_XS], WSP(pg8::bf16_t, WS_XB), WSP(const float, WS_MOD) + (size_t)(l * 5) * (6 * D) + 5 * D, 0,
                          l < NLAYER - 1 ? 1 : 0, WSP(pg8::bf16_t, WS_H), WSP(float, WS_SSQB), (const float*)(const GAS float*)A_.in[I_NORM1] + (size_t)(l + 1) * D, WSP(const float, WS_MOD) + (size_t)((l + 1) * 5) * (6 * D) + 1 * D, F.lds + 131072};
            pg8::gemm_phase<epi::EpiRes, pg8::XccOrder, true, true>(F.lds, g, S, E, F.tid);
        } SEAM(pb + 8); TEND(8);
    }
    if (IN(N_PHASES - 1)) { Frame F = fresh(F0); final_norm_phase(F, KA); }
    if (PROBE_IMASK != 0 && F0.bid == 0 && F0.wave == 0 && lane_id() == 0) { const unsigned long long acc_ = ((volatile LAS unsigned long long*)(F0.lds + MISC_OFF + 128))[1], te_ = __builtin_amdgcn_s_memrealtime();
        while (__builtin_amdgcn_s_memrealtime() - te_ < (unsigned long long)PROBE_TAMP * acc_) __builtin_amdgcn_s_sleep(32); }
    if (PROBE_TMASK != 0 && F0.bid == 0) { const unsigned long long te_ = __builtin_amdgcn_s_memrealtime(); while (__builtin_amdgcn_s_memrealtime() - te_ < (unsigned long long)PROBE_TAMP * ptacc_) __builtin_amdgcn_s_sleep(32); }
#undef IN
#undef SEAM
}

#ifndef MK_LAUNCH_PER_PHASE
#define MK_LAUNCH_PER_PHASE 0
#endif
extern "C" void kernel_launch(void* const* d_in, const int* in_sizes, int n_in, void* d_out, int out_size, void* d_ws, size_t ws_size, hipStream_t stream) {
    static int grid = 0;
    if (grid == 0) {
        if (n_in != N_IN || (size_t)out_size != O_END || ws_size < WS_END) { fprintf(stderr, "kernel_launch: shape mismatch: n_in %d out %d ws %zu (need %zu)\n", n_in, out_size, ws_size, (size_t)WS_END); grid = -1; return; }
        int dev = 0, cus = 0, per_cu = 0;
        if (hipGetDevice(&dev) != hipSuccess || hipDeviceGetAttribute(&cus, hipDeviceAttributeMultiprocessorCount, dev) != hipSuccess) { grid = -1; return; }
        if (hipFuncSetAttribute((const void*)hymba_fwd, hipFuncAttributeMaxDynamicSharedMemorySize, LDS_BYTES) != hipSuccess) { fprintf(stderr, "kernel_launch: hipFuncSetAttribute failed\n"); grid = -1; return; }
        if (hipOccupancyMaxActiveBlocksPerMultiprocessor(&per_cu, (const void*)hymba_fwd, NT, LDS_BYTES) != hipSuccess || per_cu < 1) fprintf(stderr, "kernel_launch: occupancy query says %d\n", per_cu);
        (void)hipGetLastError();
        grid = cus;
    }
    if (grid < 0) return;
    (void)hipMemsetAsync((char*)d_ws + WS_CTL, 0, CTL_ZERO_BYTES, stream);
    Args a{};
    for (int i = 0; i < N_IN; ++i) a.in[i] = (const float*)d_in[i];
    a.out = (float*)d_out; a.ws = (unsigned char*)d_ws;
#if MK_LAUNCH_PER_PHASE
    for (int p = 0; p < N_PHASES; ++p) { a.ph_lo = p; a.ph_hi = p + 1; hipLaunchKernelGGL(hymba_fwd, dim3(grid), dim3(NT), LDS_BYTES, stream, a); }
#else
    a.ph_lo = 0; a.ph_hi = N_PHASES;
    hipLaunchKernelGGL(hymba_fwd, dim3(grid), dim3(NT), LDS_BYTES, stream, a);
#endif
    const hipError_t le = hipPeekAtLastError();
    if (le != hipSuccess) fprintf(stderr, "kernel_launch: launch failed: %s\n", hipGetErrorName(le));
}
```

```cpp
#include <hip/hip_runtime.h>
#include <cstdio>
#include <cstdint>
namespace pg8 {
#define PG8_LAS __attribute__((address_space(3)))
typedef unsigned short bf16_t;
typedef short bf16x8 __attribute__((ext_vector_type(8)));
typedef float f32x4 __attribute__((ext_vector_type(4)));
typedef unsigned u32x4 __attribute__((ext_vector_type(4)));
constexpr int BM = 256, BK = 64, HALF = 128, HTB = HALF * BK * 2  , STAGE_BYTES = 8 * HTB, NXCD = 8, WGM = 8;

__host__ __device__ __forceinline__ int lds_byte(int r, int c) { const int st = (r >> 4) * 2 + (c >> 5), rr = r & 15, cc = c & 31, ob = rr * 64 + cc * 2; return st * 1024 + (ob ^ (((ob >> 9) & 1) << 5)); }
__host__ __device__ __forceinline__ void stage_rc(int b, int& R, int& C) { const int st = b / 1024, sb = b % 1024, swz = sb ^ (((sb >> 9) & 1) << 5); R = (st >> 1) * 16 + swz / 64; C = (st & 1) * 32 + (swz % 64) / 2; }
__host__ __device__ __forceinline__ int perm32(int rho) { const int n = rho >> 4, i = rho & 15; return 8 * (i >> 2) + 4 * n + (i & 3); }

struct Unit { int pm, pn; };
struct Gemm { const bf16_t* A; const bf16_t* Bt; int M, N, K; };

struct StaticOrder {
    int nM, nN, nwg, G, c;
    __host__ __device__ void init(int M, int N, int G_, int c_) { nM = M / BM; nN = N / BM; nwg = nM * nN; G = G_; c = c_; }
    __host__ __device__ bool next(int i, Unit& u) const {
        const long L = (long)i * G + c; if (L >= nwg) return false;
        int wgid = (int)L; { const int q = nwg / NXCD, r = nwg % NXCD, xcd = wgid % NXCD, off = wgid / NXCD; wgid = (xcd < r ? xcd * (q + 1) : r * (q + 1) + (xcd - r) * q) + off; }
        const int nig = WGM * nN, gid = wgid / nig, fm = gid * WGM, gsz = (nM - fm) < WGM ? (nM - fm) : WGM;
        u.pm = fm + ((wgid % nig) % gsz); u.pn = (wgid % nig) / gsz; return true;
    }
    __device__ __forceinline__ void a_ready(const Unit&) const {}
    __device__ __forceinline__ void done(const Unit&) const {}
};

struct XccOrder {
    StaticOrder so; int mode, x, j, nN;
    __host__ __device__ void init(int M, int N, int G_, int c_, int mode_, int x_, int j_) { so.init(M, N, G_, c_); mode = mode_; x = x_; j = j_; nN = N / BM; }
    __host__ __device__ bool next(int i, Unit& u) const {
        if (!mode) return so.next(i, u);
        const int w = i * 32 + j; if (w >= 12 * nN) return false;
        const int q4 = 4 * nN, pg = w / q4, r = w - pg * q4;
        u.pm = 12 * x + 4 * pg + (r & 3); u.pn = r >> 2; return true;
    }
    __device__ __forceinline__ void a_ready(const Unit&) const {}
    __device__ __forceinline__ void done(const Unit&) const {}
};

__device__ __forceinline__ unsigned cvt_pk_bf16(float lo, float hi) { unsigned r; asm volatile("v_cvt_pk_bf16_f32 %0, %1, %2" : "=v"(r) : "v"(lo), "v"(hi)); return r; }
typedef float f32x2 __attribute__((ext_vector_type(2)));
#ifndef PROBE_KLOOP
#define PROBE_KLOOP 0
#endif
template <class Epi, class Sched, bool ALIGN_EPI = false, bool SP2 = false>
__device__ __forceinline__ void gemm_phase(PG8_LAS unsigned char* lds, const Gemm g, const Sched& S, const Epi& E, int tid_in) {
    int tid_ = tid_in; asm volatile("" : "+v"(tid_));
    const int tid = tid_, wid = __builtin_amdgcn_readfirstlane(tid >> 6), lane = tid & 63, wr = wid >> 2, wc = wid & 3, fr = lane & 15, fq = lane >> 4;
    const int K = g.K, nt = K / BK;
    unsigned voffA[2], voffB[2];
#pragma unroll
    for (int i = 0; i < 2; ++i) { int R, C; stage_rc(tid * 16 + i * 8192, R, C); const int Rb = Epi::PERM ? ((R & ~31) + perm32(R & 31)) : R;
        voffA[i] = (unsigned)(R * K + C) * 2u; voffB[i] = (unsigned)(Rb * K + C) * 2u; }
    const size_t kstep = (size_t)(BK * 2);
    const size_t hstep = (size_t)HALF * K * 2;
    const size_t tstep = 2 * hstep;
    const unsigned ldsw = (unsigned)wid * 1024u;
    const int aoff = lds_byte(wr * 64 + fr, fq * 8), boff = lds_byte(wc * 32 + fr, fq * 8);
#define PG8_SA(b, h) (((b) * 2 + (h)) * HTB)
#define PG8_SB(b, h) ((4 + (b) * 2 + (h)) * HTB)
#define PG8_STAGE(bufoff, gbase, voff) do { _Pragma("unroll") for (int _i = 0; _i < 2; ++_i) \
        __builtin_amdgcn_global_load_lds((const unsigned*)((const char*)(gbase) + (voff)[_i]), (PG8_LAS unsigned*)(lds + (bufoff) + ldsw + _i * 8192), 16, 0, 0); } while (0)
#define PG8_LDA(dst, b, h) do { _Pragma("unroll") for (int m = 0; m < 4; ++m) _Pragma("unroll") for (int k = 0; k < 2; ++k) dst[m][k] = *(const PG8_LAS bf16x8*)(lds + PG8_SA(b, h) + aoff + m * 2048 + k * 1024); } while (0)
#define PG8_LDB(dst, b, h) do { _Pragma("unroll") for (int n = 0; n < 2; ++n) _Pragma("unroll") for (int k = 0; k < 2; ++k) dst[n][k] = *(const PG8_LAS bf16x8*)(lds + PG8_SB(b, h) + boff + n * 2048 + k * 1024); } while (0)
#define PG8_MMA(ai, bj, At, Bt) do { __builtin_amdgcn_s_setprio(1); _Pragma("unroll") for (int m = 0; m < 4; ++m) _Pragma("unroll") for (int n = 0; n < 2; ++n) _Pragma("unroll") for (int k = 0; k < 2; ++k) \
        acc[ai][bj][m][n] = __builtin_amdgcn_mfma_f32_16x16x32_bf16(Bt[n][k], At[m][k], acc[ai][bj][m][n], 0, 0, 0); __builtin_amdgcn_s_setprio(0); } while (0)
#define PG8_WAIT_V(n) asm volatile("s_waitcnt vmcnt(" #n ")" ::: "memory")
#define PG8_WAIT_L(n) asm volatile("s_waitcnt lgkmcnt(" #n ")" ::: "memory")
#define PG8_BAR __builtin_amdgcn_s_barrier()
#define PG8_SCHED __builtin_amdgcn_sched_barrier(0)
    Unit cur, nxt; int ui = 0;
    if (!S.next(0, cur)) return;
    f32x4 acc[2][2][4][2];
#pragma unroll
    for (int a = 0; a < 2; ++a)
#pragma unroll
        for (int b = 0; b < 2; ++b)
#pragma unroll
            for (int m = 0; m < 4; ++m)
#pragma unroll
                for (int n = 0; n < 2; ++n) acc[a][b][m][n] = (f32x4){0.f, 0.f, 0.f, 0.f};
    bf16x8 At[4][2], B0[2][2], B1[2][2];
    const char* cA = (const char*)g.A + (size_t)cur.pm * tstep; const char* cB = (const char*)g.Bt + (size_t)cur.pn * tstep;
    S.a_ready(cur);
    if constexpr (SP2) {
        PG8_STAGE(PG8_SB(0, 0), cB, voffB); PG8_STAGE(PG8_SB(0, 1), cB + hstep, voffB); PG8_STAGE(PG8_SA(0, 0), cA, voffA); PG8_STAGE(PG8_SA(0, 1), cA + hstep, voffA);
        if (wr == 1) PG8_BAR;
        PG8_WAIT_V(2); PG8_BAR;
        PG8_STAGE(PG8_SB(1, 0), cB + kstep, voffB); PG8_STAGE(PG8_SA(1, 0), cA + kstep, voffA); PG8_STAGE(PG8_SB(1, 1), cB + hstep + kstep, voffB);
        PG8_WAIT_V(6); PG8_BAR;
    } else {
        PG8_STAGE(PG8_SB(0, 0), cB, voffB); PG8_STAGE(PG8_SA(0, 0), cA, voffA); PG8_STAGE(PG8_SB(0, 1), cB + hstep, voffB); PG8_STAGE(PG8_SA(0, 1), cA + hstep, voffA);
        if (wr == 1) PG8_BAR;
        PG8_WAIT_V(4); PG8_BAR;
        PG8_STAGE(PG8_SB(1, 0), cB + kstep, voffB); PG8_STAGE(PG8_SA(1, 0), cA + kstep, voffA); PG8_STAGE(PG8_SB(1, 1), cB + hstep + kstep, voffB);
        PG8_WAIT_V(6); PG8_BAR;
    }
    for (;;) {
        const bool has_next = S.next(ui + 1, nxt);
        const char* nA = has_next ? (const char*)g.A + (size_t)nxt.pm * tstep : cA; const char* nB = has_next ? (const char*)g.Bt + (size_t)nxt.pn * tstep : cB;
        for (int t = 0; t < nt; t += 2) {
            const bool last = (t == nt - 2);
            const char* a1 = cA + (size_t)(t + 1) * kstep;
            const char* a2 = last ? nA : cA + (size_t)(t + 2) * kstep; const char* b2 = last ? nB : cB + (size_t)(t + 2) * kstep;
            const char* a3 = a2 + kstep; const char* b3 = b2 + kstep;
            if (last && has_next) S.a_ready(nxt);
#if PROBE_KLOOP == 1
            if (blockIdx.x == 0 && tid == 0) { volatile PG8_LAS unsigned long long* p_ = (volatile PG8_LAS unsigned long long*)(lds + 163584 + 128);
                if (t == 4) p_[0] = __builtin_amdgcn_s_memrealtime(); if (t == nt - 4) p_[1] += __builtin_amdgcn_s_memrealtime() - p_[0]; }
#elif PROBE_KLOOP == 2
            if (blockIdx.x == 0 && tid == 0 && g.N == PROBE_SELN && g.K == PROBE_SELK) { volatile PG8_LAS unsigned long long* p_ = (volatile PG8_LAS unsigned long long*)(lds + 163584 + 128);
                if (t == 4 && ui > 0) p_[1] += __builtin_amdgcn_s_memrealtime() - p_[0]; if (t == nt - 4) p_[0] = __builtin_amdgcn_s_memrealtime(); }
#endif
            if constexpr (SP2) {
            PG8_LDB(B0, 0, 0); PG8_LDB(B1, 0, 1); PG8_SCHED; PG8_LDA(At, 0, 0); PG8_STAGE(PG8_SA(1, 1), a1 + hstep, voffA);
            PG8_WAIT_V(8); PG8_WAIT_L(0); PG8_BAR; PG8_MMA(0, 0, At, B0); PG8_MMA(0, 1, At, B1); PG8_BAR; PG8_SCHED;
            PG8_LDA(At, 0, 1); PG8_STAGE(PG8_SB(0, 0), b2, voffB); PG8_STAGE(PG8_SB(0, 1), b2 + hstep, voffB); PG8_STAGE(PG8_SA(0, 0), a2, voffA);
            PG8_WAIT_V(8); PG8_WAIT_L(0); PG8_BAR; PG8_MMA(1, 0, At, B0); PG8_MMA(1, 1, At, B1); PG8_BAR; PG8_SCHED;
            PG8_LDB(B0, 1, 0); PG8_LDB(B1, 1, 1); PG8_SCHED; PG8_LDA(At, 1, 0); PG8_STAGE(PG8_SA(0, 1), a2 + hstep, voffA);
            PG8_WAIT_V(8); PG8_WAIT_L(0); PG8_BAR; PG8_MMA(0, 0, At, B0); PG8_MMA(0, 1, At, B1); PG8_BAR; PG8_SCHED;
            PG8_LDA(At, 1, 1); PG8_STAGE(PG8_SB(1, 0), b3, voffB); PG8_STAGE(PG8_SB(1, 1), b3 + hstep, voffB); PG8_STAGE(PG8_SA(1, 0), a3, voffA);
            PG8_WAIT_V(8); PG8_WAIT_L(0); PG8_BAR; PG8_MMA(1, 0, At, B0); PG8_MMA(1, 1, At, B1); PG8_BAR; PG8_SCHED;
            } else {
            PG8_LDB(B0, 0, 0); PG8_SCHED; PG8_LDA(At, 0, 0); PG8_STAGE(PG8_SA(1, 1), a1 + hstep, voffA);
            PG8_WAIT_L(8); PG8_BAR; PG8_WAIT_L(0); PG8_MMA(0, 0, At, B0); PG8_BAR; PG8_SCHED;
            PG8_LDB(B1, 0, 1); PG8_STAGE(PG8_SB(0, 0), b2, voffB);
            PG8_BAR; PG8_WAIT_L(0); PG8_MMA(0, 1, At, B1); PG8_BAR;
            PG8_LDA(At, 0, 1); PG8_STAGE(PG8_SA(0, 0), a2, voffA);
            PG8_BAR; PG8_WAIT_L(0); PG8_MMA(1, 0, At, B0); PG8_BAR; PG8_SCHED;
            PG8_STAGE(PG8_SB(0, 1), b2 + hstep, voffB);
            PG8_WAIT_V(6); PG8_BAR; PG8_MMA(1, 1, At, B1); PG8_BAR;
            PG8_LDB(B0, 1, 0); PG8_SCHED; PG8_LDA(At, 1, 0); PG8_STAGE(PG8_SA(0, 1), a2 + hstep, voffA);
            PG8_WAIT_L(8); PG8_BAR; PG8_WAIT_L(0); PG8_MMA(0, 0, At, B0); PG8_BAR; PG8_SCHED;
            PG8_LDB(B1, 1, 1); PG8_STAGE(PG8_SB(1, 0), b3, voffB);
            PG8_BAR; PG8_WAIT_L(0); PG8_MMA(0, 1, At, B1); PG8_BAR;
            PG8_LDA(At, 1, 1); PG8_STAGE(PG8_SA(1, 0), a3, voffA);
            PG8_BAR; PG8_WAIT_L(0); PG8_MMA(1, 0, At, B0); PG8_BAR; PG8_SCHED;
            PG8_STAGE(PG8_SB(1, 1), b3 + hstep, voffB);
            PG8_WAIT_V(6); PG8_BAR; PG8_MMA(1, 1, At, B1); PG8_BAR;
            }
        }
        if constexpr (ALIGN_EPI) { if (wr == 0) PG8_BAR; }
        if constexpr (!Epi::AFTER_DRAIN) { E(acc, cur, wr, wc, fr, fq); S.done(cur); }
        if (!has_next) break;
#pragma unroll
        for (int a = 0; a < 2; ++a)
#pragma unroll
            for (int b = 0; b < 2; ++b)
#pragma unroll
                for (int m = 0; m < 4; ++m)
#pragma unroll
                    for (int n = 0; n < 2; ++n) acc[a][b][m][n] = (f32x4){0.f, 0.f, 0.f, 0.f};
        cur = nxt; cA = nA; cB = nB; ++ui;
        if constexpr (ALIGN_EPI) { if (wr == 1) PG8_BAR; }
    }
    PG8_WAIT_V(0);
    if constexpr (!ALIGN_EPI) { if (wr == 0) PG8_BAR; }
    PG8_BAR;
    if constexpr (Epi::AFTER_DRAIN) { E.fused(acc, cur, wr, wc, fr, fq, lds, wid, lane); S.done(cur); }
#undef PG8_SA
#undef PG8_SB
#undef PG8_STAGE
#undef PG8_LDA
#undef PG8_LDB
#undef PG8_MMA
#undef PG8_WAIT_V
#undef PG8_WAIT_L
#undef PG8_BAR
#undef PG8_SCHED
}
}
#define GAS __attribute__((address_space(1)))
#define LAS __attribute__((address_space(3)))
typedef unsigned short bf16;
typedef unsigned v4u __attribute__((ext_vector_type(4)));
typedef float f32x4 __attribute__((ext_vector_type(4)));
typedef short bf16x8 __attribute__((ext_vector_type(8)));
typedef GAS unsigned gu32;
typedef GAS unsigned long long gu64;
#define RLX_AGENT __ATOMIC_RELAXED, __HIP_MEMORY_SCOPE_AGENT
#define LDS_WAIT() asm volatile("s_waitcnt lgkmcnt(0)" ::: "memory")
#define VM_WAIT() asm volatile("s_waitcnt vmcnt(0)" ::: "memory")
__device__ __forceinline__ unsigned long long rt() { return __builtin_amdgcn_s_memrealtime(); }
typedef __bf16 hwbf16x2_t __attribute__((ext_vector_type(2)));
typedef float hwf32x2_t __attribute__((ext_vector_type(2)));
__device__ __forceinline__ unsigned pk2(float lo, float hi) { const hwf32x2_t v = {lo, hi}; const hwbf16x2_t b = __builtin_convertvector(v, hwbf16x2_t); return __builtin_bit_cast(unsigned, b); }
__device__ __forceinline__ unsigned f2bf(float f) { return pk2(f, 0.f) & 0xffffu; }
#define XB_TMO      128
#define XB_XCNT(j)  (256  + 64 * (j))
#define XB_XSUB(j)  (1280 + 64 * (j))
#define XB_XGEN(j)  (2304 + 64 * (j))
#define XB_TOP      3328
#define XB_TOPGEN   3392
#define XCD_BAR_WORDS 3456
#define XB_LSUB(j)  (3456 + 64 * (j))
#define XB_SPIN_CAP (1u << 18)
#ifndef XB_EARLY_WB
#define XB_EARLY_WB 0
#endif
#ifndef PROBE_FORCE_MODE0
#define PROBE_FORCE_MODE0 0
#endif

__device__ __forceinline__ unsigned xb_ld(unsigned* p)              { return __hip_atomic_load(p, __ATOMIC_RELAXED, __HIP_MEMORY_SCOPE_AGENT); }
__device__ __forceinline__ unsigned xb_add(unsigned* p, unsigned v) { return __hip_atomic_fetch_add(p, v, __ATOMIC_RELAXED, __HIP_MEMORY_SCOPE_AGENT); }
__device__ __forceinline__ unsigned xb_xcc_id() { return (unsigned)__builtin_amdgcn_s_getreg((3 << 11) | 20) & 0xFu; }
#define XB_SPIN(cond, bar) do { unsigned _sp = 0; while (cond) { __builtin_amdgcn_s_sleep(1); \
    if ((++_sp & 255u) == 0u) { if (xb_ld(&(bar)[XB_TMO])) break; if (_sp > XB_SPIN_CAP) { atomicAdd(&(bar)[XB_TMO], 1u); break; } } } } while (0)

struct XcdBarrier {
    unsigned wave0;
    unsigned* bar; unsigned x;
    volatile LAS unsigned* st;
};

__device__ __forceinline__ bool xb_lane0() { return __builtin_amdgcn_mbcnt_hi(~0u, __builtin_amdgcn_mbcnt_lo(~0u, 0u)) == 0u; }
__device__ __forceinline__ XcdBarrier xcd_barrier_post(unsigned* bar, volatile LAS unsigned* st, unsigned wave0) {
    XcdBarrier b; b.wave0 = wave0; b.bar = bar; b.x = xb_xcc_id(); b.st = st;
    if (wave0 && xb_lane0()) st[2] = xb_add(&bar[XB_XCNT(b.x)], 1u);
    return b;
}
__device__ __forceinline__ void xcd_barrier_complete(unsigned* bar, unsigned x, unsigned& nloc, unsigned& nx, unsigned& even) {
    const unsigned G = gridDim.x * gridDim.y * gridDim.z;
    unsigned sum, cnt, mine, bad, sp = 0u;
    for (;;) {
        sum = 0u; cnt = 0u; mine = 0u; bad = 0u;
#pragma unroll
        for (unsigned j = 0; j < 16; ++j) { const unsigned c = xb_ld(&bar[XB_XCNT(j)]); sum += c; cnt += (c > 0u) ? 1u : 0u; mine = (j == x) ? c : mine; bad |= (c != (j < 8u ? 32u : 0u)) ? 1u : 0u; }
        if (sum == G) break;
        __builtin_amdgcn_s_sleep(1);
        if ((++sp & 255u) == 0u) { if (xb_ld(&bar[XB_TMO])) break; if (sp > XB_SPIN_CAP) { atomicAdd(&bar[XB_TMO], 1u); break; } }
    }
    nloc = mine > 0u ? mine : 1u; nx = cnt > 0u ? cnt : 1u; even = (sum == G && G == 256u && bad == 0u && !PROBE_FORCE_MODE0) ? 2u : 1u;
}

__device__ __forceinline__ void xcd_barrier(const XcdBarrier& b) {
    asm volatile("s_waitcnt vmcnt(0)" ::: "memory");
    __syncthreads();
    if (b.wave0 && xb_lane0()) {
        unsigned* bar = b.bar;
        __builtin_amdgcn_s_waitcnt(0);
        unsigned nloc = b.st[0], nx = b.st[1];
        if (nloc == 0u) { unsigned ev; xcd_barrier_complete(bar, b.x, nloc, nx, ev); b.st[0] = nloc; b.st[1] = nx; b.st[3] = ev; }
        const unsigned old = xb_add(&bar[XB_XSUB(b.x)], 1u);
        const unsigned gen = old / nloc;
        if (old + 1u == (gen + 1u) * nloc) {
            __builtin_amdgcn_fence(__ATOMIC_RELEASE, "agent");
            asm volatile("s_waitcnt vmcnt(0)" ::: "memory");
            const unsigned og = xb_add(&bar[XB_TOP], 1u);
            const unsigned tg = og / nx;
            if (og + 1u == (tg + 1u) * nx) xb_add(&bar[XB_TOPGEN], 1u);
            else XB_SPIN(xb_ld(&bar[XB_TOPGEN]) == tg, bar);
            __builtin_amdgcn_fence(__ATOMIC_ACQUIRE, "agent");
            xb_add(&bar[XB_XGEN(b.x)], 1u);
            asm volatile("s_waitcnt vmcnt(0)" ::: "memory");
        } else {
#if XB_EARLY_WB
            { const unsigned k_ = old - gen * nloc; if (k_ == 0u || k_ * 2u == nloc) __builtin_amdgcn_fence(__ATOMIC_RELEASE, "agent"); }
#endif
            XB_SPIN(xb_ld(&bar[XB_XGEN(b.x)]) == gen, bar);
            __builtin_amdgcn_fence(__ATOMIC_ACQUIRE, "agent");
            asm volatile("s_waitcnt vmcnt(0)" ::: "memory");
        }
    }
    __syncthreads();
}

__device__ __forceinline__ void xcc_barrier(const XcdBarrier& b) {
    asm volatile("s_waitcnt vmcnt(0)" ::: "memory");
    __syncthreads();
    if (b.wave0 && xb_lane0()) {
        unsigned* bar = b.bar;
        __builtin_amdgcn_s_waitcnt(0);
        const unsigned nloc = b.st[0];
        const unsigned old = xb_add(&bar[XB_LSUB(b.x)], 1u);
        const unsigned target = (old / nloc + 1u) * nloc;
        XB_SPIN(xb_ld(&bar[XB_LSUB(b.x)]) < target, bar);
        __builtin_amdgcn_fence(__ATOMIC_ACQUIRE, "agent");
        asm volatile("s_waitcnt vmcnt(0)" ::: "memory");
    }
    __syncthreads();
}
constexpr int NWAVES = 8, NT = 512;
constexpr int D = 2048, NLAYER = 4;
constexpr int MC = 32 * 256, ML = 4 * 4096, M = MC + ML;
constexpr int DIN = 6176, NPROJ = 6144, NPAD = 6400, DFF = 8192, GWID = 512;
constexpr int NCP = M / 128;
constexpr float EPS = 1e-6f;
constexpr int PC_S5U = 0, PC_MQ = 512, PC_MK = 1024, PC_MV = 1536, PC_MO = 2048, PC_RQ = 2560, PC_RK = 3072, PC_RV = 3584, PC_RG = 4096, PC_DZ = 4608, PC_DX = 5120, PC_DB = 5632, PC_DC = 5888;
enum { I_XP = 0, I_XS, I_C, I_SS5R, I_SS5I, I_SMC, I_SMN, I_SMM, I_SRET, I_SSSD, I_CCTX, I_NORM1, I_WADA, I_BADA, I_WIN, I_S5LR, I_S5LI, I_S5DT, I_S5BR, I_S5BI, I_S5CR, I_S5CI, I_S5D, I_S5GLU,
       I_MIB, I_MFB, I_MNORM, I_RRATE, I_RNORM, I_CONVW, I_CONVB, I_DTB, I_ALOG, I_SSDD, I_SNORM, I_WOUT, I_NORM2, I_WM1, I_WM2, I_FNORM, N_IN };
constexpr size_t O_YP = 0, O_YS = (size_t)MC * D, O_S5R = (size_t)M * D, O_S5I = O_S5R + 524288, O_MC = O_S5I + 524288, O_MN = O_MC + 16777216, O_MM = O_MN + 131072, O_RET = O_MM + 1024, O_SSD = O_RET + 16777216, O_END = O_SSD + 16777216;

constexpr size_t MiB = 1u << 20;
constexpr size_t WS_CTL = 0, CTL_ZERO_BYTES = 1 * MiB;
constexpr size_t WS_MOD = 1 * MiB;
constexpr size_t WS_S5T = 2 * MiB;
constexpr size_t WS_ROPE = 5 * MiB;
constexpr size_t WS_GATES = 6 * MiB;
constexpr size_t WS_MLNLOC = 9 * MiB;
constexpr size_t WS_MLNIN = 10 * MiB;
constexpr size_t WS_MLSC = 11 * MiB;
constexpr size_t WS_MLMIN = 11 * MiB + 65536;
constexpr size_t WS_SDSC = 11 * MiB + 131072;
constexpr size_t WS_SSQA = 5 * MiB + 65536;
constexpr size_t WS_SSQB = 11 * MiB + 262144;
constexpr size_t WS_SHW1 = 18 * MiB;
constexpr size_t WS_SHW2 = 19 * MiB;
constexpr size_t WS_S5LOC = 12 * MiB;
constexpr size_t WS_WGT = 20 * MiB;
constexpr size_t WS_W1T = 22 * MiB;
constexpr size_t WS_WOT = 122 * MiB;
constexpr size_t WS_WM1T = 154 * MiB;
constexpr size_t WS_WM2T = 282 * MiB;
constexpr size_t WS_H = 410 * MiB;
constexpr size_t WS_Y = 506 * MiB;
constexpr size_t WS_YA = 602 * MiB;
constexpr size_t WS_MLCIN = 626 * MiB;
constexpr size_t WS_RTIN = 674 * MiB;
constexpr size_t WS_SDIN = 722 * MiB;
constexpr size_t WS_PROJ = 770 * MiB;
constexpr size_t WS_MLCLOC = 1058 * MiB;
constexpr size_t WS_HID = 770 * MiB;
constexpr size_t WS_RTLOC = 1106 * MiB;
constexpr size_t WS_SDLOC = 1154 * MiB;
constexpr size_t WS_XBCC = 1202 * MiB;
constexpr size_t WS_XB = 1250 * MiB;
constexpr size_t WS_END = 1346 * MiB;
constexpr int CW_TMO = 0, CW_BAR = 4096;

constexpr int LDT = 272;
constexpr int TS = 128 * LDT;
constexpr int LDX = 144;
constexpr int TSX = 128 * LDX;
constexpr int SCAL_OFF = 4 * TS;
constexpr int MISC_OFF = 163840 - 256;
constexpr int LDS_BYTES = 163840;
#define SCA(i) ((LAS float*)(F.lds + SCAL_OFF + (i) * 512))
typedef float f32x16 __attribute__((ext_vector_type(16)));
typedef float f32x2 __attribute__((ext_vector_type(2)));
typedef short s16x4 __attribute__((ext_vector_type(4)));
typedef unsigned u32x2 __attribute__((ext_vector_type(2)));
struct Args { const float* in[N_IN]; float* out; unsigned char* ws; int ph_lo, ph_hi; };
struct Frame {
    LAS unsigned char* lds;
    float* out; unsigned char* ws;
    int tid, lane, wave, G, bid;
};
__device__ __forceinline__ int lane_id() { return (int)__builtin_amdgcn_mbcnt_hi(~0u, __builtin_amdgcn_mbcnt_lo(~0u, 0u)); }
typedef const __attribute__((address_space(4))) Args KArgs;
__device__ __forceinline__ KArgs* kargs() { KArgs* p = (KArgs*)__builtin_amdgcn_kernarg_segment_ptr(); asm volatile("" : "+s"(p)); return p; }
__device__ __forceinline__ Frame fresh(const Frame& F) { Frame R = F; unsigned long long l = (unsigned long long)(size_t)R.lds; unsigned ll = (unsigned)l; asm volatile("" : "+s"(ll), "+s"(R.wave), "+s"(R.G), "+s"(R.bid)); R.lane = lane_id(); asm volatile("" : "+v"(R.lane)); R.tid = R.wave * 64 + R.lane; R.lds = (LAS unsigned char*)(size_t)ll; KArgs* ka = kargs(); R.out = (float*)(GAS float*)ka->out; R.ws = (unsigned char*)(GAS unsigned char*)ka->ws; return R; }
#define INP(i) ((const float*)(const GAS float*)(A.in[i]))
#define BAR() __syncthreads()
#ifndef PROBE_IMASK
#define PROBE_IMASK 0
#endif
#define ITS(k) do { if ((PROBE_IMASK >> (k)) & 1) { if (F.tid == 0 && F.bid == 0) ((volatile LAS unsigned long long*)(F.lds + MISC_OFF + 128))[0] = __builtin_amdgcn_s_memrealtime(); } } while (0)
#define ITE(k) do { if ((PROBE_IMASK >> (k)) & 1) { if (F.tid == 0 && F.bid == 0) { volatile LAS unsigned long long* p_ = (volatile LAS unsigned long long*)(F.lds + MISC_OFF + 128); p_[1] += __builtin_amdgcn_s_memrealtime() - p_[0]; } } } while (0)
#define WSP(T, off) ((T*)(F.ws + (off)))
__device__ __forceinline__ float bf2f(unsigned short b) { return __uint_as_float((unsigned)b << 16); }
__device__ __forceinline__ float bflo(unsigned w) { return __uint_as_float(w << 16); }
__device__ __forceinline__ float bfhi(unsigned w) { return __uint_as_float(w & 0xffff0000u); }
__device__ __forceinline__ void unpack8(const v4u a, float (&x)[8]) { x[0] = bflo(a.x); x[1] = bfhi(a.x); x[2] = bflo(a.y); x[3] = bfhi(a.y); x[4] = bflo(a.z); x[5] = bfhi(a.z); x[6] = bflo(a.w); x[7] = bfhi(a.w); }
__device__ __forceinline__ v4u pack8(const float (&x)[8], float w) { v4u o; o.x = pk2(x[0] * w, x[1] * w); o.y = pk2(x[2] * w, x[3] * w); o.z = pk2(x[4] * w, x[5] * w); o.w = pk2(x[6] * w, x[7] * w); return o; }
__device__ __forceinline__ float sigmoidf_(float x) { return __builtin_amdgcn_rcpf(1.f + __expf(-x)); }
__device__ __forceinline__ float siluf_(float x) { return x * sigmoidf_(x); }
__device__ __forceinline__ float lshfl(float v, int src_lane) { return __builtin_bit_cast(float, __builtin_amdgcn_ds_bpermute(src_lane << 2, __builtin_bit_cast(int, v))); }
__device__ __forceinline__ float lshfl_xor(float v, int m, int lane) { return lshfl(v, lane ^ m); }
__device__ __forceinline__ float lshfl_up(float v, int o, int lane) { return lshfl(v, lane >= o ? lane - o : lane); }
__device__ __forceinline__ float wave_sum(float v) {
#pragma unroll
    for (int o = 1; o < 64; o <<= 1) v += __shfl_xor(v, o);
    return v;
}
__device__ __forceinline__ float wave_max(float v) {
#pragma unroll
    for (int o = 1; o < 64; o <<= 1) v = fmaxf(v, __shfl_xor(v, o));
    return v;
}
__device__ __forceinline__ float wave_sum_l(float v, int lane) {
#pragma unroll
    for (int o = 1; o < 64; o <<= 1) v += lshfl_xor(v, o, lane);
    return v;
}
__device__ __forceinline__ float wave_max_l(float v, int lane) {
#pragma unroll
    for (int o = 1; o < 64; o <<= 1) v = fmaxf(v, lshfl_xor(v, o, lane));
    return v;
}
template <bool MAX> __device__ __forceinline__ void wave_scan128(const LAS float* in, LAS float* out, int lane, bool rev, float init) {
    const int i0 = rev ? 127 - 2 * lane : 2 * lane, i1 = rev ? i0 - 1 : i0 + 1;
    float e0 = in[i0], e1 = in[i1];
    if (lane == 0) e0 = MAX ? fmaxf(e0, init) : e0 + init;
    float inc = MAX ? fmaxf(e0, e1) : e0 + e1;
#pragma unroll
    for (int o = 1; o < 64; o <<= 1) { const float t = __shfl_up(inc, o); if (lane >= o) inc = MAX ? fmaxf(inc, t) : inc + t; }
    float exc = __shfl_up(inc, 1);
    const float o0 = (lane == 0) ? e0 : (MAX ? fmaxf(exc, e0) : exc + e0);
    out[i0] = o0; out[i1] = inc;
}
__device__ __forceinline__ s16x4 lds_tr(const LAS unsigned char* p) {
    typedef short v4i16_t __attribute__((ext_vector_type(4)));
    return __builtin_bit_cast(s16x4, __builtin_amdgcn_ds_read_tr16_b64_v4i16((LAS v4i16_t*)p));
}
__device__ __forceinline__ bf16x8 frag_row(const LAS unsigned char* base, int ld, int r0, int k0, int lane) {
    return *(const LAS bf16x8*)(base + (r0 + (lane & 31)) * ld + (k0 + 8 * (lane >> 5)) * 2);
}
__device__ __forceinline__ bf16x8 frag_tr(const LAS unsigned char* base, int ld, int k0, int c0, int lane) {
    const int h = lane >> 5, blk = (lane >> 4) & 1, q = (lane & 15) >> 2, p = lane & 3;
    const LAS unsigned char* a = base + (k0 + 8 * h + q) * ld + (c0 + 16 * blk + 4 * p) * 2;
    const s16x4 lo = lds_tr(a), hi = lds_tr(a + 4 * ld);
    return (bf16x8){lo[0], lo[1], lo[2], lo[3], hi[0], hi[1], hi[2], hi[3]};
}
__device__ __forceinline__ bf16x8 frag_trp(const LAS unsigned char* base, int ld, int k0, int c0, int lane) {
    const int h = lane >> 5, blk = (lane >> 4) & 1, q = (lane & 15) >> 2, p = lane & 3;
    const LAS unsigned char* a = base + (k0 + 4 * h + q) * ld + (c0 + 16 * blk + 4 * p) * 2;
    const s16x4 lo = lds_tr(a), hi = lds_tr(a + 8 * ld);
    return (bf16x8){lo[0], lo[1], lo[2], lo[3], hi[0], hi[1], hi[2], hi[3]};
}
#define MFMA32(a, b, c) __builtin_amdgcn_mfma_f32_32x32x16_bf16((a), (b), (c), 0, 0, 0)
#define ZERO16 ((f32x16){0.f,0.f,0.f,0.f,0.f,0.f,0.f,0.f,0.f,0.f,0.f,0.f,0.f,0.f,0.f,0.f})
__device__ __forceinline__ int crow(int i, int hh) { return (i & 3) + 8 * (i >> 2) + 4 * hh; }

#define PT(cp, col) (WSP(const bf16, WS_PROJ) + ((size_t)(cp) * 48 + ((col) >> 7)) * 16384 + ((col) & 127))
#define XT(cp, ch) (WSP(bf16, WS_XBCC) + ((size_t)(cp) * 8 + ((ch) >> 7)) * 16384 + ((ch) & 127))
__device__ __forceinline__ const float* x_in_row(const Frame& F, KArgs& A, int l, int r) {
    if (l == 0) return r < MC ? INP(I_XP) + (size_t)r * D : INP(I_XS) + (size_t)(r - MC) * D;
    return F.out + (size_t)r * D;
}
__device__ __forceinline__ int mod_row(int r) { return r < MC ? 0 : 1 + (r - MC) / 4096; }
__device__ __forceinline__ const float* mod_ptr(const Frame& F, int l, int mrow, int part) { return WSP(const float, WS_MOD) + ((size_t)(l * 5 + mrow) * 6 + part) * D; }
struct Seq { int cp0, nch, c, b, lat; };
__device__ __forceinline__ Seq seq_of(int cp) { Seq s; if (cp < 64) { s.lat = 0; s.b = cp >> 1; s.cp0 = cp & ~1; s.nch = 2; s.c = cp & 1; } else { s.lat = 1; s.b = (cp - 64) >> 5; s.cp0 = 64 + (s.b << 5); s.nch = 32; s.c = (cp - 64) & 31; } return s; }
__device__ __forceinline__ int w1_newcol(int n) { return n < 2560 ? n : (n < 2576 ? n - 2560 + 6144 : (n < 6160 ? n - 16 : n)); }
template <bool MAPW1> __device__ __forceinline__ void p0_transpose_item(const float* W, int K, int N, bf16* WT, LAS float* scr, int item, int lane) {
    const int nblk = (N + 63) / 64, kb = item / nblk, nb = item % nblk, k0 = 64 * kb, n0 = 64 * nb;
    const int lr = lane >> 4, lc = (lane & 15) * 4; const bool cv = n0 + lc < N;
    f32x4 v[16];
#pragma unroll
    for (int i = 0; i < 16; ++i) v[i] = cv ? *(const f32x4*)(W + (size_t)(k0 + 4 * i + lr) * N + n0 + lc) : (f32x4){0.f, 0.f, 0.f, 0.f};
#pragma unroll
    for (int i = 0; i < 16; ++i) { LAS float* d = scr + (4 * i + lr) * 65 + lc; d[0] = v[i].x; d[1] = v[i].y; d[2] = v[i].z; d[3] = v[i].w; }
    LDS_WAIT(); asm volatile("" ::: "memory");
    const int c = lane & 7;
#pragma unroll
    for (int j = 0; j < 8; ++j) { const int n = (lane >> 3) + 8 * j; const LAS float* s = scr + (8 * c) * 65 + n;
        v4u o; o.x = pk2(s[0 * 65], s[1 * 65]); o.y = pk2(s[2 * 65], s[3 * 65]); o.z = pk2(s[4 * 65], s[5 * 65]); o.w = pk2(s[6 * 65], s[7 * 65]);
        const int nr = MAPW1 ? w1_newcol(n0 + n) : (n0 + n);
        if (n0 + n < N) *(GAS v4u*)(WT + (size_t)nr * K + k0 + 8 * c) = o; }
    LDS_WAIT(); asm volatile("" ::: "memory");
}
constexpr int S5T_STRIDE = 9216;
__device__ __forceinline__ unsigned char* s5tab(const Frame& F, int l, int d, int g) { return F.ws + WS_S5T + (size_t)((l * 2 + d) * 32 + g) * S5T_STRIDE; }

__device__ __forceinline__ void p0_prologue(Frame& F, KArgs& A) {
    {
        LAS float* scr = (LAS float*)(F.lds + F.wave * 16640);
        const int gw = F.bid * NWAVES + F.wave, NGW = F.G * NWAVES;
        constexpr int I_1 = (D / 64) * ((DIN + 63) / 64), I_G = (GWID / 64) * (GWID / 64), I_O = (D / 64) * (D / 64), I_M1 = (D / 64) * (DFF / 64), I_M2 = (DFF / 64) * (D / 64);
        constexpr int PER_L = I_1 + I_G + I_O + I_M1 + I_M2;
        for (int it = gw; it < NLAYER * PER_L; it += NGW) {
            const int l = it / PER_L; int r = it % PER_L;
            if (r < I_1) { p0_transpose_item<true>(INP(I_WIN) + (size_t)l * D * DIN, D, DIN, WSP(bf16, WS_W1T) + (size_t)l * NPAD * D, scr, r, F.lane); continue; } r -= I_1;
            if (r < I_G) { p0_transpose_item<false>(INP(I_S5GLU) + (size_t)l * GWID * GWID, GWID, GWID, WSP(bf16, WS_WGT) + (size_t)l * GWID * GWID, scr, r, F.lane); continue; } r -= I_G;
            if (r < I_O) { p0_transpose_item<false>(INP(I_WOUT) + (size_t)l * D * D, D, D, WSP(bf16, WS_WOT) + (size_t)l * D * D, scr, r, F.lane); continue; } r -= I_O;
            if (r < I_M1) { p0_transpose_item<false>(INP(I_WM1) + (size_t)l * D * DFF, D, DFF, WSP(bf16, WS_WM1T) + (size_t)l * DFF * D, scr, r, F.lane); continue; } r -= I_M1;
            p0_transpose_item<false>(INP(I_WM2) + (size_t)l * DFF * D, DFF, D, WSP(bf16, WS_WM2T) + (size_t)l * D * DFF, scr, r, F.lane);
        }
        const int gt = F.bid * NT + F.tid, NGT = F.G * NT;
        for (int i = gt; i < NLAYER * 224 * 256; i += NGT) { const int l = i / (224 * 256), r = i % (224 * 256);
            *(GAS v4u*)(WSP(bf16, WS_W1T) + ((size_t)l * NPAD + DIN) * D + (size_t)r * 8) = (v4u){0u, 0u, 0u, 0u}; }
        for (int i = gt; i < NLAYER * 2 * 32 * 64; i += NGT) {
            const int p = i & 63, g = (i >> 6) & 31, d = (i >> 11) & 1, l = i >> 12;
            const int ldg = (l * 2 + d) * 32 + g;
            const double lre = INP(I_S5LR)[ldg * 64 + p], lim = INP(I_S5LI)[ldg * 64 + p], dt = exp((double)INP(I_S5DT)[ldg]);
            const double er = exp(lre * dt), br = er * cos(lim * dt), bi = er * sin(lim * dt);
            const double e128 = exp(128.0 * lre * dt), b128r = e128 * cos(128.0 * lim * dt), b128i = e128 * sin(128.0 * lim * dt);
            const double nr = br - 1.0, ni = bi, den = lre * lre + lim * lim;
            const double cr = (nr * lre + ni * lim) / den, ci = (ni * lre - nr * lim) / den;
            unsigned char* tb = s5tab(F, l, d, g);
            float* lam = (float*)tb; lam[2 * p] = (float)br; lam[2 * p + 1] = (float)bi;
            float* l128 = (float*)(tb + 512); l128[2 * p] = (float)b128r; l128[2 * p + 1] = (float)b128i;
            bf16* bb = (bf16*)(tb + 1024); bf16* ct = (bf16*)(tb + 5120);
            for (int c = 0; c < 16; ++c) {
                const double Br = INP(I_S5BR)[(size_t)(ldg * 64 + p) * 16 + c], Bi = INP(I_S5BI)[(size_t)(ldg * 64 + p) * 16 + c];
                bb[(2 * p) * 16 + c] = (bf16)f2bf((float)(cr * Br - ci * Bi));
                bb[(2 * p + 1) * 16 + c] = (bf16)f2bf((float)(cr * Bi + ci * Br));
                ct[c * 128 + 2 * p] = (bf16)f2bf(INP(I_S5CR)[(size_t)(ldg * 16 + c) * 64 + p]);
                ct[c * 128 + 2 * p + 1] = (bf16)f2bf(-INP(I_S5CI)[(size_t)(ldg * 16 + c) * 64 + p]);
            }
        }
        for (int i = gt; i < 64 * 32; i += NGT) { const int pos = i >> 5, k = i & 31; const double f = pow(10000.0, -(double)k / 32.0), a = pos * f;
            WSP(f32x2, WS_ROPE)[i] = (f32x2){(float)cos(a), (float)sin(a)}; }
    }
    __syncthreads();
    {
        LAS float* sc = (LAS float*)F.lds;
        LAS float* red = (LAS float*)(F.lds + 65536);
        for (int i = F.tid; i < 5 * D; i += NT) { const int r = i / D, k = i % D; const float v = r == 0 ? INP(I_CCTX)[k] : INP(I_C)[(r - 1) * D + k]; sc[i] = siluf_(v); }
        __syncthreads();
        for (int it = F.bid; it < NLAYER * 96; it += F.G) {
            const int l = it / 96, c0 = (it % 96) * 128;
            const float* W = INP(I_WADA) + (size_t)l * D * (6 * D);
            float acc[5][4];
#pragma unroll
            for (int r = 0; r < 5; ++r)
#pragma unroll
                for (int j = 0; j < 4; ++j) acc[r][j] = 0.f;
            const int cl = F.lane & 31, kp = F.lane >> 5;
#pragma unroll 4
            for (int kk = 0; kk < 128; ++kk) {
                const int k = F.wave * 256 + 2 * kk + kp;
                const f32x4 w = *(const f32x4*)(W + (size_t)k * (6 * D) + c0 + 4 * cl);
#pragma unroll
                for (int r = 0; r < 5; ++r) { const float s = sc[r * D + k]; acc[r][0] += s * w.x; acc[r][1] += s * w.y; acc[r][2] += s * w.z; acc[r][3] += s * w.w; }
            }
#pragma unroll
            for (int r = 0; r < 5; ++r)
#pragma unroll
                for (int j = 0; j < 4; ++j) { acc[r][j] += __shfl_xor(acc[r][j], 32); }
            if (kp == 0) {
#pragma unroll
                for (int r = 0; r < 5; ++r)
#pragma unroll
                    for (int j = 0; j < 4; ++j) red[(F.wave * 5 + r) * 128 + 4 * cl + j] = acc[r][j];
            }
            __syncthreads();
            for (int i = F.tid; i < 5 * 128; i += NT) { const int r = i >> 7, j = i & 127; float s = 0.f;
#pragma unroll
                for (int w = 0; w < 8; ++w) s += red[(w * 5 + r) * 128 + j];
                WSP(float, WS_MOD)[(size_t)(l * 5 + r) * (6 * D) + c0 + j] = s + INP(I_BADA)[(size_t)l * (6 * D) + c0 + j]; }
            __syncthreads();
        }
    }
}

__device__ __forceinline__ void norm0_phase(Frame& F, KArgs& A) {
    const int gw = F.bid * NWAVES + F.wave, NGW = F.G * NWAVES;
    const float* gain = INP(I_NORM1);
    for (int m = gw; m < M; m += NGW) {
        const float* xr = x_in_row(F, A, 0, m);
        const float* scp = mod_ptr(F, 0, mod_row(m), 1);
        f32x4 v[8]; float s = 0.f;
#pragma unroll
        for (int j = 0; j < 8; ++j) { v[j] = *(const f32x4*)(xr + 4 * F.lane + 256 * j); s += (v[j].x * v[j].x + v[j].y * v[j].y) + (v[j].z * v[j].z + v[j].w * v[j].w); }
        s = wave_sum(s);
        if (F.lane < 8) WSP(float, WS_SSQB)[(size_t)m * 8 + F.lane] = F.lane == 0 ? s : 0.f;
        bf16* orow = WSP(bf16, WS_H) + (size_t)m * D;
#pragma unroll
        for (int j = 0; j < 8; ++j) { const int c = 4 * F.lane + 256 * j;
            const f32x4 g4 = *(const f32x4*)(gain + c), s4 = *(const f32x4*)(scp + c);
            *(u32x2*)(orow + c) = (u32x2){pk2(v[j].x * g4.x * (1.f + s4.x), v[j].y * g4.y * (1.f + s4.y)), pk2(v[j].z * g4.z * (1.f + s4.z), v[j].w * g4.w * (1.f + s4.w))}; }
    }
}
__device__ __forceinline__ void shw_phase(Frame& F) {
    LAS float* red = (LAS float*)F.lds;
    const int hh = F.lane >> 5, r = F.lane & 31, k0 = F.wave * 256;
    constexpr int NB1 = DIN / 32, NB2 = DFF / 32, PER_L = NB1 + NB2;
    for (int task = F.bid; task < NLAYER * PER_L; task += F.G) {
        const int l = task / PER_L, t2 = task % PER_L, which = t2 >= NB1 ? 1 : 0, nb = which ? t2 - NB1 : t2;
        const int NS = which ? DFF : NPAD;
        const bf16* Wt = (which ? WSP(const bf16, WS_WM1T) + (size_t)l * DFF * D : WSP(const bf16, WS_W1T) + (size_t)l * NPAD * D) + (size_t)(32 * nb + r) * D + k0 + 8 * hh;
        const float* sh = WSP(const float, WS_MOD) + ((size_t)(l * 5 + (r < 5 ? r : 0)) * 6 + (which ? 3 : 0)) * D + k0 + 8 * hh;
        bf16x8 bw[16];
#pragma unroll
        for (int ks = 0; ks < 16; ++ks) bw[ks] = *(const bf16x8*)(Wt + 16 * ks);
        f32x16 acc = ZERO16;
#pragma unroll
        for (int ks = 0; ks < 16; ++ks) { v4u a = (v4u){0u, 0u, 0u, 0u};
            if (r < 5) { const f32x4 s0 = *(const f32x4*)(sh + 16 * ks), s1 = *(const f32x4*)(sh + 16 * ks + 4); a = (v4u){pk2(s0.x, s0.y), pk2(s0.z, s0.w), pk2(s1.x, s1.y), pk2(s1.z, s1.w)}; }
            acc = MFMA32(__builtin_bit_cast(bf16x8, a), bw[ks], acc); }
        if (hh == 0) { red[(F.wave * 5 + 0) * 32 + r] = acc[0]; red[(F.wave * 5 + 1) * 32 + r] = acc[1]; red[(F.wave * 5 + 2) * 32 + r] = acc[2]; red[(F.wave * 5 + 3) * 32 + r] = acc[3]; }
        else red[(F.wave * 5 + 4) * 32 + r] = acc[0];
        __syncthreads();
        if (F.tid < 160) { const int row = F.tid >> 5, col = F.tid & 31; float s = 0.f;
#pragma unroll
            for (int w = 0; w < 8; ++w) s += red[(w * 5 + row) * 32 + col];
            (which ? WSP(float, WS_SHW2) + (size_t)l * 5 * DFF : WSP(float, WS_SHW1) + (size_t)l * 5 * NPAD)[(size_t)row * NS + 32 * nb + col] = s; }
        __syncthreads();
    }
}
__device__ __forceinline__ void final_norm_phase(Frame& F, KArgs& A) {
    const int gw = F.bid * NWAVES + F.wave, NGW = F.G * NWAVES;
    const float* gain = INP(I_FNORM);
    for (int m = gw; m < M; m += NGW) {
        const bf16* xr = WSP(const bf16, WS_XB) + (size_t)m * D; float* orow = F.out + (size_t)m * D;
        float v[4][8]; float s = 0.f;
#pragma unroll
        for (int j = 0; j < 4; ++j) { unpack8(*(const v4u*)(xr + 8 * F.lane + 512 * j), v[j]);
#pragma unroll
            for (int k = 0; k < 8; ++k) s += v[j][k] * v[j][k]; }
        const float rstd = rsqrtf(wave_sum(s) * (1.f / D) + EPS);
#pragma unroll
        for (int j = 0; j < 4; ++j) { const int c = 8 * F.lane + 512 * j; const f32x4 g0 = *(const f32x4*)(gain + c), g1 = *(const f32x4*)(gain + c + 4);
            *(f32x4*)(orow + c) = (f32x4){v[j][0] * rstd * g0.x, v[j][1] * rstd * g0.y, v[j][2] * rstd * g0.z, v[j][3] * rstd * g0.w};
            *(f32x4*)(orow + c + 4) = (f32x4){v[j][4] * rstd * g1.x, v[j][5] * rstd * g1.y, v[j][6] * rstd * g1.z, v[j][7] * rstd * g1.w}; }
    }
}

__device__ __forceinline__ void gates_phase(Frame& F, int l) {
    const bf16* XA = WSP(const bf16, WS_H); const bf16* Wg = WSP(const bf16, WS_W1T) + ((size_t)l * NPAD + NPROJ) * D;
    const float* shw = WSP(const float, WS_SHW1) + (size_t)l * 5 * NPAD + NPROJ;
    const int hh = F.lane >> 5, r = F.lane & 31, k0 = F.wave * 256;
    LAS float* red = (LAS float*)F.lds;
    bf16x8 bw[16];
#pragma unroll
    for (int ks = 0; ks < 16; ++ks) bw[ks] = *(const bf16x8*)(Wg + (size_t)r * D + k0 + 16 * ks + 8 * hh);
    for (int rb = F.bid; rb < M / 32; rb += F.G) {
        f32x16 acc = ZERO16;
#pragma unroll
        for (int half = 0; half < 2; ++half) { bf16x8 a[8];
#pragma unroll
            for (int j = 0; j < 8; ++j) a[j] = *(const bf16x8*)(XA + (size_t)(32 * rb + r) * D + k0 + 16 * (8 * half + j) + 8 * hh);
#pragma unroll
            for (int j = 0; j < 8; ++j) acc = MFMA32(a[j], bw[8 * half + j], acc); }
#pragma unroll
        for (int i = 0; i < 16; ++i) red[(F.wave * 32 + crow(i, hh)) * 33 + r] = acc[i];
        BAR();
#pragma unroll
        for (int q = 0; q < 2; ++q) { const int idx = F.tid * 2 + q, row = idx >> 5, col = idx & 31; float s = 0.f;
#pragma unroll
            for (int w = 0; w < 8; ++w) s += red[(w * 32 + row) * 33 + col];
            const int grow = 32 * rb + row; const float* part = WSP(const float, WS_SSQB) + (size_t)grow * 8;
            const float ssq = ((part[0] + part[1]) + (part[2] + part[3])) + ((part[4] + part[5]) + (part[6] + part[7]));
            WSP(float, WS_GATES)[(size_t)grow * 32 + col] = s * rsqrtf(ssq * (1.f / D) + EPS) + shw[(size_t)mod_row(grow) * NPAD + col]; }
        BAR();
    }
}
namespace epi {
__device__ __forceinline__ float rstd_of(const float* part, int r) { const pg8::f32x4 a = *(const pg8::f32x4*)(part + (size_t)r * 8), b = *(const pg8::f32x4*)(part + (size_t)r * 8 + 4);
    return rsqrtf((((a[0] + a[1]) + (a[2] + a[3])) + ((b[0] + b[1]) + (b[2] + b[3]))) * (1.f / D) + EPS); }
using pg8::Unit; using pg8::f32x4; using pg8::u32x4; using pg8::bf16_t; using pg8::cvt_pk_bf16;
constexpr int BMq = 256, HALFq = 128;
struct EpiProj {
    static constexpr bool PERM = true, AFTER_DRAIN = false;
    bf16_t* P; const float* ssq; const float* shw0;
    __device__ __forceinline__ void operator()(const f32x4 (&acc)[2][2][4][2], const Unit& u, int wr, int wc, int fr_, int fq_) const {
        int ln_ = (int)__builtin_amdgcn_mbcnt_hi(~0u, __builtin_amdgcn_mbcnt_lo(~0u, 0u)); asm volatile("" : "+v"(ln_)); const int fr = ln_ & 15, fq = ln_ >> 4; (void)fr_; (void)fq_;
        const int row0 = u.pm * BMq + wr * 64 + fr, rowt = u.pm * BMq, col0 = u.pn * BMq + wc * 32 + 8 * fq;
        const float* shw = shw0 + (size_t)(rowt < MC ? 0 : 1 + (rowt - MC) / 4096) * NPAD + col0;
        f32x4 sh[2][2];
#pragma unroll
        for (int bj = 0; bj < 2; ++bj) { sh[bj][0] = *(const f32x4*)(shw + bj * HALFq); sh[bj][1] = *(const f32x4*)(shw + bj * HALFq + 4); }
        float rsv[2][4];
        {
            const int rl = rowt + wr * 64 + (ln_ >> 4) * 16 + (ln_ & 15); const float r0 = rstd_of(ssq, rl), r1 = rstd_of(ssq, rl + HALFq);
#pragma unroll
            for (int m = 0; m < 4; ++m) { rsv[0][m] = __shfl(r0, m * 16 + fr); rsv[1][m] = __shfl(r1, m * 16 + fr); }
        }
#pragma unroll
        for (int ai = 0; ai < 2; ++ai)
#pragma unroll
            for (int m = 0; m < 4; ++m) { const int r = row0 + ai * HALFq + m * 16; bf16_t* rowp = P + (((size_t)(r >> 7) * 48 + (col0 >> 7)) * 128 + (r & 127)) * 128 + (col0 & 127); const float rs = rsv[ai][m];
#pragma unroll
                for (int bj = 0; bj < 2; ++bj) { const f32x4 v0 = acc[ai][bj][m][0] * rs + sh[bj][0], v1 = acc[ai][bj][m][1] * rs + sh[bj][1];
                    u32x4 w; w.x = cvt_pk_bf16(v0[0], v0[1]); w.y = cvt_pk_bf16(v0[2], v0[3]); w.z = cvt_pk_bf16(v1[0], v1[1]); w.w = cvt_pk_bf16(v1[2], v1[3]);
                    *(u32x4*)(rowp + bj * 16384) = w; } }
    }
};
struct EpiGlu {
    static constexpr bool PERM = true, AFTER_DRAIN = false;
    const bf16_t* YA; bf16_t* Y;
    __device__ __forceinline__ void operator()(const f32x4 (&acc)[2][2][4][2], const Unit& u, int wr, int wc, int fr_, int fq_) const {
        int ln_ = (int)__builtin_amdgcn_mbcnt_hi(~0u, __builtin_amdgcn_mbcnt_lo(~0u, 0u)); asm volatile("" : "+v"(ln_)); const int fr = ln_ & 15, fq = ln_ >> 4; (void)fr_; (void)fq_;
        const int row0 = u.pm * BMq + wr * 64 + fr, col0 = u.pn * BMq + wc * 32 + 8 * fq;
#pragma unroll
        for (int ai = 0; ai < 2; ++ai)
#pragma unroll
            for (int bj = 0; bj < 2; ++bj) { u32x4 ya[4];
#pragma unroll
                for (int m = 0; m < 4; ++m) ya[m] = *(const u32x4*)(YA + (size_t)(row0 + ai * HALFq + m * 16) * GWID + col0 + bj * HALFq);
#pragma unroll
                for (int m = 0; m < 4; ++m) { const int r = row0 + ai * HALFq + m * 16; const f32x4 v0 = acc[ai][bj][m][0], v1 = acc[ai][bj][m][1];
                    const u32x4 a = ya[m];
                    float y[8] = {bflo(a.x), bfhi(a.x), bflo(a.y), bfhi(a.y), bflo(a.z), bfhi(a.z), bflo(a.w), bfhi(a.w)};
                    const float g[8] = {v0[0], v0[1], v0[2], v0[3], v1[0], v1[1], v1[2], v1[3]};
#pragma unroll
                    for (int k = 0; k < 8; ++k) y[k] = y[k] * sigmoidf_(g[k]);
                    u32x4 w; w.x = cvt_pk_bf16(y[0], y[1]); w.y = cvt_pk_bf16(y[2], y[3]); w.z = cvt_pk_bf16(y[4], y[5]); w.w = cvt_pk_bf16(y[6], y[7]);
                    *(u32x4*)(Y + (size_t)r * D + col0 + bj * HALFq) = w; }
                asm volatile("" ::: "memory"); }
    }
};
struct EpiRes {
    static constexpr bool PERM = true, AFTER_DRAIN = false;
    const float* xp; const float* xs; bf16_t* XB; const float* gate0; int first;
    int NEXT; bf16_t* XA; float* ssq; const float* gn; const float* scn0; PG8_LAS unsigned char* scr;
    __device__ __forceinline__ float row_update(const f32x4 b0, const f32x4 b1, const f32x4 c0, const f32x4 c1, const f32x4 g0, const f32x4 g1, const f32x4 a0, const f32x4 a1, bf16_t* xbp, bf16_t* xap) const {
        const f32x4 x0 = b0 + g0 * c0, x1 = b1 + g1 * c1;
        u32x4 xw; xw.x = cvt_pk_bf16(x0[0], x0[1]); xw.y = cvt_pk_bf16(x0[2], x0[3]); xw.z = cvt_pk_bf16(x1[0], x1[1]); xw.w = cvt_pk_bf16(x1[2], x1[3]);
        *(u32x4*)xbp = xw;
        float s = 0.f;
        if (NEXT) { const f32x4 r0 = (f32x4){bflo(xw.x), bfhi(xw.x), bflo(xw.y), bfhi(xw.y)}, r1 = (f32x4){bflo(xw.z), bfhi(xw.z), bflo(xw.w), bfhi(xw.w)};
            s = (r0[0] * r0[0] + r0[1] * r0[1]) + (r0[2] * r0[2] + r0[3] * r0[3]) + (r1[0] * r1[0] + r1[1] * r1[1]) + (r1[2] * r1[2] + r1[3] * r1[3]);
            const f32x4 y0 = r0 * a0, y1 = r1 * a1; u32x4 w; w.x = cvt_pk_bf16(y0[0], y0[1]); w.y = cvt_pk_bf16(y0[2], y0[3]); w.z = cvt_pk_bf16(y1[0], y1[1]); w.w = cvt_pk_bf16(y1[2], y1[3]);
            *(u32x4*)xap = w; }
        return s;
    }
    __device__ __forceinline__ void operator()(const f32x4 (&acc)[2][2][4][2], const Unit& u, int wr, int wc, int fr_, int fq_) const {
        int ln_ = (int)__builtin_amdgcn_mbcnt_hi(~0u, __builtin_amdgcn_mbcnt_lo(~0u, 0u)); asm volatile("" : "+v"(ln_)); const int fr = ln_ & 15, fq = ln_ >> 4; (void)fr_; (void)fq_;
        const int rowt = u.pm * BMq, col0 = u.pn * BMq + wc * 32 + 8 * fq;
        const int mrow = rowt < MC ? 0 : 1 + (rowt - MC) / 4096;
        const float* gate = gate0 + (size_t)mrow * (6 * D);
        const float* basef = rowt < MC ? xp + (size_t)rowt * D : xs + (size_t)(rowt - MC) * D;
        bf16_t* xb = XB + (size_t)rowt * D;
        float ss[2][4];
#pragma unroll
        for (int ai = 0; ai < 2; ++ai)
#pragma unroll
            for (int m = 0; m < 4; ++m) ss[ai][m] = 0.f;
#pragma unroll
        for (int bj = 0; bj < 2; ++bj) { const int c = col0 + bj * HALFq; const f32x4 g0 = *(const f32x4*)(gate + c), g1 = *(const f32x4*)(gate + c + 4);
            f32x4 a0 = (f32x4){0.f, 0.f, 0.f, 0.f}, a1 = a0;
            if (NEXT) { const float* scn = scn0 + (size_t)mrow * (6 * D); a0 = *(const f32x4*)(gn + c) * (*(const f32x4*)(scn + c) + 1.f); a1 = *(const f32x4*)(gn + c + 4) * (*(const f32x4*)(scn + c + 4) + 1.f); }
            if (first) {
#pragma unroll
                for (int ai = 0; ai < 2; ++ai)
#pragma unroll
                    for (int m = 0; m < 4; ++m) { const size_t off = (size_t)(wr * 64 + fr + ai * HALFq + m * 16) * D + c;
                        const f32x4 b0 = *(const f32x4*)(basef + off), b1 = *(const f32x4*)(basef + off + 4);
                        ss[ai][m] += row_update(b0, b1, acc[ai][bj][m][0], acc[ai][bj][m][1], g0, g1, a0, a1, xb + off, XA + (size_t)rowt * D + off);
                        if (m & 1) asm volatile("" ::: "memory"); }
            } else {
#pragma unroll
                for (int ai = 0; ai < 2; ++ai) { u32x4 bw[4];
#pragma unroll
                    for (int m = 0; m < 4; ++m) bw[m] = *(const u32x4*)(xb + (size_t)(wr * 64 + fr + ai * HALFq + m * 16) * D + c);
#pragma unroll
                    for (int m = 0; m < 4; ++m) { const size_t off = (size_t)(wr * 64 + fr + ai * HALFq + m * 16) * D + c; const u32x4 w = bw[m];
                        const f32x4 b0 = (f32x4){bflo(w.x), bfhi(w.x), bflo(w.y), bfhi(w.y)}, b1 = (f32x4){bflo(w.z), bfhi(w.z), bflo(w.w), bfhi(w.w)};
                        ss[ai][m] += row_update(b0, b1, acc[ai][bj][m][0], acc[ai][bj][m][1], g0, g1, a0, a1, xb + off, XA + (size_t)rowt * D + off); }
                    asm volatile("" ::: "memory"); }
            } }
        if (NEXT) {
            PG8_LAS float* P4 = (PG8_LAS float*)scr;
#pragma unroll
            for (int ai = 0; ai < 2; ++ai)
#pragma unroll
                for (int m = 0; m < 4; ++m) { float s = ss[ai][m]; s += __shfl_xor(s, 16); s += __shfl_xor(s, 32);
                    if (fq == 0) P4[(ai * HALFq + wr * 64 + m * 16 + fr) * 4 + wc] = s; }
            asm volatile("s_waitcnt lgkmcnt(0)\n\ts_barrier" ::: "memory");
            { const int tid = (wr * 4 + wc) * 64 + fq * 16 + fr;
              if (tid < 256) { const f32x4 p = *(const PG8_LAS f32x4*)(P4 + tid * 4); ssq[(size_t)(rowt + tid) * 8 + u.pn] = (p[0] + p[1]) + (p[2] + p[3]); } }
            asm volatile("s_waitcnt lgkmcnt(0)\n\ts_barrier" ::: "memory");
        }
    }
};
struct EpiRelu2 {
    static constexpr bool PERM = true, AFTER_DRAIN = false;
    bf16_t* O; const float* ssq; const float* shw0;
    __device__ __forceinline__ void operator()(const f32x4 (&acc)[2][2][4][2], const Unit& u, int wr, int wc, int fr_, int fq_) const {
        int ln_ = (int)__builtin_amdgcn_mbcnt_hi(~0u, __builtin_amdgcn_mbcnt_lo(~0u, 0u)); asm volatile("" : "+v"(ln_)); const int fr = ln_ & 15, fq = ln_ >> 4; (void)fr_; (void)fq_;
        const int row0 = u.pm * BMq + wr * 64 + fr, col0 = u.pn * BMq + wc * 32 + 8 * fq, rowt = u.pm * BMq;
        const float* shw = shw0 + (size_t)(rowt < MC ? 0 : 1 + (rowt - MC) / 4096) * DFF + col0;
        f32x4 sh[2][2];
#pragma unroll
        for (int bj = 0; bj < 2; ++bj) { sh[bj][0] = *(const f32x4*)(shw + bj * HALFq); sh[bj][1] = *(const f32x4*)(shw + bj * HALFq + 4); }
        float rsv[2][4];
        {
            const int rl = rowt + wr * 64 + (ln_ >> 4) * 16 + (ln_ & 15); const float r0 = rstd_of(ssq, rl), r1 = rstd_of(ssq, rl + HALFq);
#pragma unroll
            for (int m = 0; m < 4; ++m) { rsv[0][m] = __shfl(r0, m * 16 + fr); rsv[1][m] = __shfl(r1, m * 16 + fr); }
        }
#pragma unroll
        for (int ai = 0; ai < 2; ++ai)
#pragma unroll
            for (int m = 0; m < 4; ++m) { const int r = row0 + ai * HALFq + m * 16; bf16_t* rowp = O + (size_t)r * DFF + col0; const float rs = rsv[ai][m];
#pragma unroll
                for (int bj = 0; bj < 2; ++bj) { f32x4 v0 = acc[ai][bj][m][0] * rs + sh[bj][0], v1 = acc[ai][bj][m][1] * rs + sh[bj][1];
#pragma unroll
                    for (int k = 0; k < 4; ++k) { const float a = fmaxf(v0[k], 0.f), b = fmaxf(v1[k], 0.f); v0[k] = a * a; v1[k] = b * b; }
                    u32x4 w; w.x = cvt_pk_bf16(v0[0], v0[1]); w.y = cvt_pk_bf16(v0[2], v0[3]); w.z = cvt_pk_bf16(v1[0], v1[1]); w.w = cvt_pk_bf16(v1[2], v1[3]);
                    *(u32x4*)(rowp + bj * HALFq) = w; } }
    }
};
}
__device__ __forceinline__ float logsigmoidf_(float x) { return fminf(x, 0.f) - __logf(1.f + __expf(-fabsf(x))); }
__device__ __forceinline__ float softplusf_(float x) { return fmaxf(x, 0.f) + __logf(1.f + __expf(-fabsf(x))); }
__device__ __forceinline__ void load_tile128(Frame& F, LAS unsigned char* dst, const bf16* src) {
#pragma unroll
    for (int it = 0; it < 4; ++it) { const int i = F.tid + NT * it, r = i >> 4, c = i & 15;
        *(LAS v4u*)(dst + r * LDT + c * 16) = *(const v4u*)(src + (size_t)r * 128 + c * 8); }
}
__device__ __forceinline__ void qk_issue(Frame& F, const bf16* src, v4u (&r)[4]) {
#pragma unroll
    for (int it = 0; it < 2; ++it) { const int i = F.tid + NT * it, rw = i >> 3, c = i & 7;
        r[2 * it] = *(const v4u*)(src + (size_t)rw * 128 + c * 8); r[2 * it + 1] = *(const v4u*)(src + (size_t)rw * 128 + 64 + c * 8); }
}
template <int NDST> __device__ __forceinline__ void qk_commit(Frame& F, LAS unsigned char* dst0, LAS unsigned char* dst1, const v4u (&rg)[4], const LAS float* w0, const LAS float* w1, float scale, bool rope, int tpos0) {
#pragma unroll
    for (int it = 0; it < 2; ++it) {
        const int i = F.tid + NT * it, r = i >> 3, c = i & 7;
        float x1[8], x2[8];
        unpack8(rg[2 * it], x1); unpack8(rg[2 * it + 1], x2);
        if (rope) {
            const int tp = tpos0 + r, pos = c < 4 ? (tp >> 6) : (tp & 63);
            const f32x2* rt = WSP(const f32x2, WS_ROPE) + pos * 32 + ((8 * c) & 31);
#pragma unroll
            for (int j = 0; j < 8; ++j) { const f32x2 cs = rt[j]; const float a = x1[j], b = x2[j]; x1[j] = a * cs.x - b * cs.y; x2[j] = a * cs.y + b * cs.x; }
        }
        const float s0 = scale * (w0 ? w0[r] : 1.f);
        *(LAS v4u*)(dst0 + r * LDT + c * 16) = pack8(x1, s0); *(LAS v4u*)(dst0 + r * LDT + 128 + c * 16) = pack8(x2, s0);
        if (NDST == 2) { const float s1 = scale * w1[r];
            *(LAS v4u*)(dst1 + r * LDT + c * 16) = pack8(x1, s1); *(LAS v4u*)(dst1 + r * LDT + 128 + c * 16) = pack8(x2, s1); }
    }
}
template <int NDST> __device__ __forceinline__ void load_qk(Frame& F, LAS unsigned char* dst0, LAS unsigned char* dst1, const bf16* src, const LAS float* w0, const LAS float* w1, float scale, bool rope, int tpos0) {
    v4u r[4]; qk_issue(F, src, r); qk_commit<NDST>(F, dst0, dst1, r, w0, w1, scale, rope, tpos0);
}
template <int NDST, int nc8> __device__ __forceinline__ void load_conv(Frame& F, KArgs& A, int l, LAS unsigned char* dst0, LAS unsigned char* dst1, int ldd, int ch0, int row0, int seq_lo, int seq_hi,
                                                               const LAS float* w0, const LAS float* w1, bool to_global) {
    const int c = F.tid % nc8;
    const float* cw = INP(I_CONVW) + (size_t)l * 5 * 1024 + ch0 + 8 * c; const float* cb = INP(I_CONVB) + (size_t)l * 1024 + ch0 + 8 * c;
    f32x4 wv[5][2];
#pragma unroll
    for (int k = 0; k < 5; ++k) { wv[k][0] = *(const f32x4*)(cw + k * 1024); wv[k][1] = *(const f32x4*)(cw + k * 1024 + 4); }
    const f32x4 b0 = *(const f32x4*)cb, b1 = *(const f32x4*)(cb + 4);
#pragma unroll 1
    for (int i = F.tid; i < 128 * nc8; i += NT) {
        const int r = i / nc8, row = row0 + r;
        float acc[8] = {b0.x, b0.y, b0.z, b0.w, b1.x, b1.y, b1.z, b1.w};
        v4u xr[5];
#pragma unroll
        for (int k = 0; k < 5; ++k) { const int rr = row + k - 2; xr[k] = (v4u){0u, 0u, 0u, 0u};
            if (rr >= seq_lo && rr < seq_hi) xr[k] = *(const v4u*)(PT(rr >> 7, PC_DX + ch0 + 8 * c) + (size_t)(rr & 127) * 128); }
#pragma unroll
        for (int k = 0; k < 5; ++k) { float x[8]; unpack8(xr[k], x);
            acc[0] += x[0] * wv[k][0].x; acc[1] += x[1] * wv[k][0].y; acc[2] += x[2] * wv[k][0].z; acc[3] += x[3] * wv[k][0].w; acc[4] += x[4] * wv[k][1].x; acc[5] += x[5] * wv[k][1].y; acc[6] += x[6] * wv[k][1].z; acc[7] += x[7] * wv[k][1].w; }
#pragma unroll
        for (int j = 0; j < 8; ++j) acc[j] = siluf_(acc[j]);
        if (to_global) *(v4u*)(XT(row >> 7, ch0 + 8 * c) + (size_t)(row & 127) * 128) = pack8(acc, 1.f);
        if (NDST >= 1) *(LAS v4u*)(dst0 + r * ldd + c * 16) = pack8(acc, w0 ? w0[r] : 1.f);
        if (NDST == 2) *(LAS v4u*)(dst1 + r * ldd + c * 16) = pack8(acc, w1[r]);
    }
}
template <int nc8> __device__ __forceinline__ void load_xbcc(Frame& F, LAS unsigned char* dst, int ldd, int ch0, int row0) {
    const bf16* P = XT(row0 >> 7, ch0);
    for (int i = F.tid; i < 128 * nc8; i += NT) { const int r = i / nc8, c = i % nc8; *(LAS v4u*)(dst + r * ldd + c * 16) = *(const v4u*)(P + (size_t)r * 128 + 8 * c); }
}
__device__ __forceinline__ void kv_state_mfma(Frame& F, const LAS unsigned char* TKf, const LAS unsigned char* TKb, const LAS unsigned char* TV, bf16* outF, bf16* outB) {
    const int dvb = F.wave >> 1, dkb0 = (F.wave & 1) * 2, hh = F.lane >> 5;
    f32x16 acc[2][2] = {{ZERO16, ZERO16}, {ZERO16, ZERO16}};
#pragma unroll 1
    for (int ks = 0; ks < 8; ++ks) {
        const bf16x8 a = frag_tr(TV, LDT, 16 * ks, 32 * dvb, F.lane);
#pragma unroll
        for (int j = 0; j < 2; ++j) { acc[0][j] = MFMA32(a, frag_tr(TKf, LDT, 16 * ks, 32 * (dkb0 + j), F.lane), acc[0][j]); acc[1][j] = MFMA32(a, frag_tr(TKb, LDT, 16 * ks, 32 * (dkb0 + j), F.lane), acc[1][j]); }
    }
#pragma unroll
    for (int j = 0; j < 2; ++j)
#pragma unroll
        for (int i = 0; i < 16; ++i) { const int o = (32 * dvb + crow(i, hh)) * 128 + 32 * (dkb0 + j) + (F.lane & 31); outF[o] = (bf16)f2bf(acc[0][j][i]); outB[o] = (bf16)f2bf(acc[1][j][i]); }
}
__device__ __forceinline__ void qkT_mfma(Frame& F, const LAS unsigned char* TQ, const LAS unsigned char* TK, f32x16 (&qk)[2]) {
    const int tb = F.wave >> 1, sb0 = (F.wave & 1) * 2;
    qk[0] = ZERO16; qk[1] = ZERO16;
#pragma unroll 1
    for (int ks = 0; ks < 8; ++ks) { const bf16x8 bq = frag_row(TQ, LDT, 32 * tb, 16 * ks, F.lane);
#pragma unroll
        for (int j = 0; j < 2; ++j) qk[j] = MFMA32(frag_row(TK, LDT, 32 * (sb0 + j), 16 * ks, F.lane), bq, qk[j]); }
}
__device__ __forceinline__ void pv_mfma(Frame& F, const LAS unsigned char* TP, const LAS unsigned char* TV, f32x16 (&o)[2]) {
    const int tb = F.wave >> 1, eb0 = (F.wave & 1) * 2;
#pragma unroll 1
    for (int ks = 0; ks < 8; ++ks) { const bf16x8 ap = frag_row(TP, LDT, 32 * tb, 16 * ks, F.lane);
#pragma unroll
        for (int j = 0; j < 2; ++j) o[j] = MFMA32(ap, frag_tr(TV, LDT, 16 * ks, 32 * (eb0 + j), F.lane), o[j]); }
}
__device__ __forceinline__ void pv_mfma_range(Frame& F, const LAS unsigned char* TP, const LAS unsigned char* TV, f32x16 (&o)[2], int k_lo, int k_hi) {
    const int tb = F.wave >> 1, eb0 = (F.wave & 1) * 2;
#pragma unroll 1
    for (int ks = k_lo; ks < k_hi; ++ks) { const bf16x8 ap = frag_row(TP, LDT, 32 * tb, 16 * ks, F.lane);
#pragma unroll
        for (int j = 0; j < 2; ++j) o[j] = MFMA32(ap, frag_tr(TV, LDT, 16 * ks, 32 * (eb0 + j), F.lane), o[j]); }
}
__device__ __forceinline__ void qs_prefetch(Frame& F, const bf16* ST, bf16x8 (&b)[2][8]) {
    const int eb0 = (F.wave & 1) * 2, hh = F.lane >> 5;
#pragma unroll
    for (int j = 0; j < 2; ++j)
#pragma unroll
        for (int ks = 0; ks < 8; ++ks) b[j][ks] = *(const bf16x8*)(ST + (size_t)(32 * (eb0 + j) + (F.lane & 31)) * 128 + 16 * ks + 8 * hh);
}
__device__ __forceinline__ void qs_mfma(Frame& F, const LAS unsigned char* TQ, const bf16x8 (&b)[2][8], f32x16 (&o)[2]) {
    const int tb = F.wave >> 1;
#pragma unroll
    for (int ks = 0; ks < 8; ++ks) { const bf16x8 aq = frag_row(TQ, LDT, 32 * tb, 16 * ks, F.lane);
#pragma unroll
        for (int j = 0; j < 2; ++j) o[j] = MFMA32(aq, b[j][ks], o[j]); }
}
__device__ __forceinline__ void hs_to_lds(Frame& F, LAS unsigned char* HS, const f32x16 (&hs)[2]) {
    const int tb = F.wave >> 1, eb0 = (F.wave & 1) * 2, hh = F.lane >> 5;
#pragma unroll
    for (int j = 0; j < 2; ++j)
#pragma unroll
        for (int i = 0; i < 16; ++i) *(LAS float*)(HS + (32 * tb + crow(i, hh)) * 528 + (32 * (eb0 + j) + (F.lane & 31)) * 4) = hs[j][i];
}
template <int GATE> __device__ __forceinline__ void head_out(Frame& F, const LAS unsigned char* HS, const float* gain, const bf16* gsrc  , bf16* ydst  ) {
    const int t = F.tid >> 2, seg = F.tid & 3;
    float v[32]; float ss = 0.f;
#pragma unroll
    for (int k = 0; k < 8; ++k) { const f32x4 x = *(const LAS f32x4*)(HS + t * 528 + (32 * seg + 4 * k) * 4); v[4 * k] = x.x; v[4 * k + 1] = x.y; v[4 * k + 2] = x.z; v[4 * k + 3] = x.w; ss += (x.x * x.x + x.y * x.y) + (x.z * x.z + x.w * x.w); }
    ss += __shfl_xor(ss, 1); ss += __shfl_xor(ss, 2);
    const float r = rsqrtf(ss * (1.f / 128.f) + EPS);
#pragma unroll
    for (int k = 0; k < 4; ++k) { float g[8]; unpack8(*(const v4u*)(gsrc + (size_t)t * 128 + 32 * seg + 8 * k), g); float o[8];
#pragma unroll
        for (int j = 0; j < 8; ++j) { const float gg = GATE == 0 ? sigmoidf_(g[j]) : siluf_(g[j]); o[j] = v[8 * k + j] * r * gain[32 * seg + 8 * k + j] * gg; }
        *(v4u*)(ydst + (size_t)t * D + 32 * seg + 8 * k) = pack8(o, 1.f); }
}

__device__ __forceinline__ void tile_issue(Frame& F, const bf16* src, v4u (&r)[4]) {
#pragma unroll
    for (int it = 0; it < 4; ++it) { const int i = F.tid + NT * it; r[it] = *(const v4u*)(src + (size_t)(i >> 4) * 128 + (i & 15) * 8); }
}
__device__ __forceinline__ void tile_commit(Frame& F, LAS unsigned char* dst, const v4u (&r)[4], float scale) {
#pragma unroll
    for (int it = 0; it < 4; ++it) { const int i = F.tid + NT * it; v4u v = r[it];
        if (scale != 1.f) { float x[8]; unpack8(v, x); v = pack8(x, scale); }
        *(LAS v4u*)(dst + (i >> 4) * LDT + (i & 15) * 16) = v; }
}
template <int GATE> __device__ __forceinline__ void head_out_r(Frame& F, const LAS unsigned char* HS, const float* gain, const v4u (&og)[4], bf16* ydst) {
    const int t = F.tid >> 2, seg = F.tid & 3;
    float v[32]; float ss = 0.f;
#pragma unroll
    for (int k = 0; k < 8; ++k) { const f32x4 x = *(const LAS f32x4*)(HS + t * 528 + (32 * seg + 4 * k) * 4); v[4 * k] = x.x; v[4 * k + 1] = x.y; v[4 * k + 2] = x.z; v[4 * k + 3] = x.w; ss += (x.x * x.x + x.y * x.y) + (x.z * x.z + x.w * x.w); }
    ss += __shfl_xor(ss, 1); ss += __shfl_xor(ss, 2);
    const float r = rsqrtf(ss * (1.f / 128.f) + EPS);
#pragma unroll
    for (int k = 0; k < 4; ++k) { float g[8]; unpack8(og[k], g); float o[8]; const f32x4 g0 = *(const f32x4*)(gain + 32 * seg + 8 * k), g1 = *(const f32x4*)(gain + 32 * seg + 8 * k + 4);
        const float gn[8] = {g0.x, g0.y, g0.z, g0.w, g1.x, g1.y, g1.z, g1.w};
#pragma unroll
        for (int j = 0; j < 8; ++j) { const float gg = GATE == 0 ? sigmoidf_(g[j]) : siluf_(g[j]); o[j] = v[8 * k + j] * r * gn[j] * gg; }
        *(v4u*)(ydst + (size_t)t * D + 32 * seg + 8 * k) = pack8(o, 1.f); }
}
__device__ __forceinline__ void mlstm_gates(Frame& F, KArgs& A, int l, int cp, int h) {
    if (F.tid < 128) { const float* g = WSP(const float, WS_GATES) + (size_t)(cp * 128 + F.tid) * 32;
        SCA(0)[F.tid] = g[h] + INP(I_MIB)[(l * 2 + 0) * 4 + h]; SCA(1)[F.tid] = g[4 + h] + INP(I_MIB)[(l * 2 + 1) * 4 + h];
        SCA(2)[F.tid] = logsigmoidf_(g[8 + h] + INP(I_MFB)[(l * 2 + 0) * 4 + h]); SCA(3)[F.tid] = logsigmoidf_(g[12 + h] + INP(I_MFB)[(l * 2 + 1) * 4 + h]); }
    BAR();
    if (F.wave == 0) wave_scan128<false>(SCA(2), SCA(4), F.lane, false, 0.f);
    if (F.wave == 1) wave_scan128<false>(SCA(3), SCA(5), F.lane, true, 0.f);
    BAR();
}
__device__ __forceinline__ void mlstm_local_item(Frame F, KArgs& A, int l, int cp, int h) {
    v4u rk[4], rv[4]; qk_issue(F, PT(cp, PC_MK + h * 128), rk); tile_issue(F, PT(cp, PC_MV + h * 128), rv);
    mlstm_gates(F, A, l, cp, h);
    if (F.wave < 2) { const int d = F.wave; const LAS float* bc = SCA(4 + d); const LAS float* ig = SCA(d); const float tot = d == 0 ? bc[127] : bc[0];
        const int s0 = 2 * F.lane; const float g0 = tot - bc[s0] + ig[s0], g1 = tot - bc[s0 + 1] + ig[s0 + 1];
        const float mx = wave_max(fmaxf(g0, g1));
        SCA(6 + d)[s0] = __expf(g0 - mx); SCA(6 + d)[s0 + 1] = __expf(g1 - mx);
        if (F.lane == 0) { float* sc = WSP(float, WS_MLSC) + ((cp * 2 + d) * 4 + h) * 2; sc[0] = tot; sc[1] = mx; } }
    BAR();
    qk_commit<2>(F, F.lds, F.lds + TS, rk, SCA(6), SCA(7), 0.08838834764831845f, false, 0);
    tile_commit(F, F.lds + 2 * TS, rv, 1.f);
    BAR();
    kv_state_mfma(F, F.lds, F.lds + TS, F.lds + 2 * TS, WSP(bf16, WS_MLCLOC) + (size_t)((cp * 2 + 0) * 4 + h) * 16384, WSP(bf16, WS_MLCLOC) + (size_t)((cp * 2 + 1) * 4 + h) * 16384);
    if (F.tid < 256) { const int d = F.tid >> 7, dk = F.tid & 127; const LAS unsigned char* T = F.lds + d * TS; float s = 0.f;
        for (int r = 0; r < 128; ++r) s += bf2f(*(const LAS unsigned short*)(T + r * LDT + dk * 2));
        WSP(float, WS_MLNLOC)[((cp * 2 + d) * 4 + h) * 128 + dk] = s; }
    BAR();
}
__device__ __forceinline__ void mlstm_out_item(Frame F, KArgs& A, int l, int cp, int h) {
    const Seq sq = seq_of(cp);
    LAS unsigned char* TQ = F.lds; LAS unsigned char* TK = F.lds + TS; LAS unsigned char* TV = F.lds + 2 * TS; LAS unsigned char* TP = F.lds + 3 * TS;
    ITS(0);
    v4u rq[4], rk[4], rv[4], og[4];
    tile_issue(F, PT(cp, PC_MQ + h * 128), rq); tile_issue(F, PT(cp, PC_MK + h * 128), rk); tile_issue(F, PT(cp, PC_MV + h * 128), rv);
    { const int t = F.tid >> 2, seg = F.tid & 3;
#pragma unroll
      for (int k = 0; k < 4; ++k) og[k] = *(const v4u*)(PT(cp, PC_MO + h * 128) + (size_t)t * 128 + 32 * seg + 8 * k); }
    const float min_f = WSP(const float, WS_MLMIN)[(cp * 2 + 0) * 4 + h], min_b = WSP(const float, WS_MLMIN)[(cp * 2 + 1) * 4 + h];
    float nin = 0.f; if (F.tid < 256) nin = WSP(const float, WS_MLNIN)[((cp * 2 + (F.tid >> 7)) * 4 + h) * 128 + (F.tid & 127)];
    mlstm_gates(F, A, l, cp, h);
    if (F.tid < 256) { const int d = F.tid >> 7, s = F.tid & 127; SCA(6 + d)[s] = SCA(d)[s] - SCA(4 + d)[s]; SCA(12 + d)[s] = nin; }
    tile_commit(F, TQ, rq, 1.f); tile_commit(F, TK, rk, 0.08838834764831845f); tile_commit(F, TV, rv, 1.f);
    BAR();
    if (F.wave == 0) wave_scan128<true>(SCA(6), SCA(8), F.lane, false, min_f);
    if (F.wave == 1) wave_scan128<true>(SCA(7), SCA(9), F.lane, true, min_b);
    BAR();
    ITE(0);
    f32x16 hs[2] = {ZERO16, ZERO16};
    const int tb = F.wave >> 1, sb0 = (F.wave & 1) * 2, hh = F.lane >> 5, t = 32 * tb + (F.lane & 31);
#pragma unroll 1
    for (int d = 0; d < 2; ++d) {
        const LAS float* av = SCA(6 + d); const float Mt = SCA(8 + d)[t]; const float m_in = d == 0 ? min_f : min_b;
        ITS(2);
        const bool has_state = sq.lat || (d == 0 ? sq.c > 0 : sq.c < sq.nch - 1);
        bf16x8 bst[2][8]; if (has_state) qs_prefetch(F, WSP(const bf16, WS_MLCIN) + (size_t)((cp * 2 + d) * 4 + h) * 16384, bst);
#ifndef PROBE_REP2
#define PROBE_REP2 1
#endif
#pragma unroll 1
        for (int rep2_ = 0; rep2_ < PROBE_REP2; ++rep2_) {
        f32x16 qk[2]; qkT_mfma(F, TQ, TK, qk);
#pragma unroll
        for (int j = 0; j < 2; ++j) { const int sblk = sb0 + j;
            if (d == 0 ? sblk > tb : sblk < tb) continue;
            const bool diag = sblk == tb;
#pragma unroll
            for (int i4 = 0; i4 < 4; ++i4) { const int sb = 32 * sblk + 8 * i4 + 4 * hh; float p[4]; const f32x4 a4 = *(const LAS f32x4*)(av + sb);
#pragma unroll
                for (int i = 0; i < 4; ++i) p[i] = qk[j][4 * i4 + i] * __expf(a4[i] - Mt);
                if (diag) {
#pragma unroll
                    for (int i = 0; i < 4; ++i) { const int s = sb + i; const bool ok = d == 0 ? (s <= t) : (s >= t); p[i] = ok ? p[i] : 0.f; } }
                *(LAS u32x2*)(TP + t * LDT + sb * 2) = (u32x2){pk2(p[0], p[1]), pk2(p[2], p[3])}; } }
        }
        ITE(2); ITS(3);
        BAR();
        {
            const int tt = F.tid >> 2, seg = F.tid & 3; float ds = 0.f, qn = 0.f;
            const bool pvalid = d == 0 ? seg <= (tt >> 5) : seg >= (tt >> 5);
#pragma unroll
            for (int k = 0; k < 4; ++k) { float x[8]; unpack8(pvalid ? *(const LAS v4u*)(TP + tt * LDT + 64 * seg + 16 * k) : (v4u){0u, 0u, 0u, 0u}, x); float q[8]; unpack8(*(const LAS v4u*)(TQ + tt * LDT + 64 * seg + 16 * k), q);
                const f32x4 n0 = *(const LAS f32x4*)(SCA(12 + d) + 32 * seg + 8 * k), n1 = *(const LAS f32x4*)(SCA(12 + d) + 32 * seg + 8 * k + 4);
                ds += ((x[0] + x[1]) + (x[2] + x[3])) + ((x[4] + x[5]) + (x[6] + x[7]));
                qn += (q[0] * n0.x + q[1] * n0.y) + (q[2] * n0.z + q[3] * n0.w) + (q[4] * n1.x + q[5] * n1.y) + (q[6] * n1.z + q[7] * n1.w); }
            ds += __shfl_xor(ds, 1); ds += __shfl_xor(ds, 2); qn += __shfl_xor(qn, 1); qn += __shfl_xor(qn, 2);
            if (seg == 0) { const float Mtt = SCA(8 + d)[tt], wint = __expf(m_in - Mtt), den = ds + wint * qn, dd = fmaxf(fabsf(den), __expf(-(SCA(4 + d)[tt] + Mtt)));
                const float rdd = __builtin_amdgcn_rcpf(dd); SCA(10)[tt] = wint * rdd; SCA(11)[tt] = rdd; } }
        { f32x16 num[2] = {ZERO16, ZERO16};
          pv_mfma_range(F, TP, TV, num, d == 0 ? 0 : 2 * tb, d == 0 ? 2 * tb + 2 : 8);
          BAR(); ITE(3); ITS(4);
#pragma unroll
          for (int j = 0; j < 2; ++j)
#pragma unroll
            for (int k4 = 0; k4 < 4; ++k4) { const f32x4 f4 = *(const LAS f32x4*)(SCA(11) + 32 * tb + 8 * k4 + 4 * hh);
#pragma unroll
                for (int i = 0; i < 4; ++i) hs[j][4 * k4 + i] += f4[i] * num[j][4 * k4 + i]; } }
        if (has_state) { f32x16 qc[2] = {ZERO16, ZERO16};
          qs_mfma(F, TQ, bst, qc);
#pragma unroll
          for (int j = 0; j < 2; ++j)
#pragma unroll
            for (int k4 = 0; k4 < 4; ++k4) { const f32x4 f4 = *(const LAS f32x4*)(SCA(10) + 32 * tb + 8 * k4 + 4 * hh);
#pragma unroll
                for (int i = 0; i < 4; ++i) hs[j][4 * k4 + i] += f4[i] * qc[j][4 * k4 + i]; } }
        ITE(4);
    }
    ITS(5);
    BAR();
    hs_to_lds(F, F.lds, hs);
    BAR();
    head_out_r<0>(F, F.lds, INP(I_MNORM) + (size_t)l * GWID + h * 128, og, WSP(bf16, WS_Y) + (size_t)cp * 128 * D + 512 + h * 128);
    BAR(); ITE(5);
}

__device__ __forceinline__ void ret_local_item(Frame F, KArgs& A, int l, int cp, int h) {
    const float lgf = -__expf(INP(I_RRATE)[(l * 2 + 0) * 4 + h]), lgb = -__expf(INP(I_RRATE)[(l * 2 + 1) * 4 + h]);
    v4u rk[4], rv[4]; qk_issue(F, PT(cp, PC_RK + h * 128), rk); tile_issue(F, PT(cp, PC_RV + h * 128), rv);
    if (F.tid < 128) { SCA(6)[F.tid] = __expf((127.f - (float)F.tid) * lgf); SCA(7)[F.tid] = __expf((float)F.tid * lgb); }
    BAR();
    const Seq sq = seq_of(cp);
    qk_commit<2>(F, F.lds, F.lds + TS, rk, SCA(6), SCA(7), 0.08838834764831845f, sq.lat != 0, sq.c * 128);
    tile_commit(F, F.lds + 2 * TS, rv, 1.f);
    BAR();
    kv_state_mfma(F, F.lds, F.lds + TS, F.lds + 2 * TS, WSP(bf16, WS_RTLOC) + (size_t)((cp * 2 + 0) * 4 + h) * 16384, WSP(bf16, WS_RTLOC) + (size_t)((cp * 2 + 1) * 4 + h) * 16384);
    BAR();
}
__device__ __forceinline__ void ret_out_item(Frame F, KArgs& A, int l, int cp, int h) {
    const float lgf = -__expf(INP(I_RRATE)[(l * 2 + 0) * 4 + h]), lgb = -__expf(INP(I_RRATE)[(l * 2 + 1) * 4 + h]);
    if (F.tid < 128) { SCA(10)[F.tid] = __expf(((float)F.tid + 1.f) * lgf); SCA(11)[F.tid] = __expf((128.f - (float)F.tid) * lgb); }
    const Seq sq = seq_of(cp);
    LAS unsigned char* TQ = F.lds; LAS unsigned char* TK = F.lds + TS; LAS unsigned char* TV = F.lds + 2 * TS; LAS unsigned char* TP = F.lds + 3 * TS;
    v4u rq[4], rk[4], rv[4], og[4];
    qk_issue(F, PT(cp, PC_RQ + h * 128), rq); qk_issue(F, PT(cp, PC_RK + h * 128), rk); tile_issue(F, PT(cp, PC_RV + h * 128), rv);
    { const int t_ = F.tid >> 2, seg_ = F.tid & 3;
#pragma unroll
      for (int k = 0; k < 4; ++k) og[k] = *(const v4u*)(PT(cp, PC_RG + h * 128) + (size_t)t_ * 128 + 32 * seg_ + 8 * k); }
    qk_commit<1>(F, TQ, nullptr, rq, nullptr, nullptr, 1.f, sq.lat != 0, sq.c * 128);
    qk_commit<1>(F, TK, nullptr, rk, nullptr, nullptr, 0.08838834764831845f, sq.lat != 0, sq.c * 128);
    tile_commit(F, TV, rv, 1.f);
    BAR();
    f32x16 qk[2]; qkT_mfma(F, TQ, TK, qk);
    const int tb = F.wave >> 1, sb0 = (F.wave & 1) * 2, hh = F.lane >> 5, t = 32 * tb + (F.lane & 31);
#pragma unroll
    for (int j = 0; j < 2; ++j)
#pragma unroll
        for (int i4 = 0; i4 < 4; ++i4) { const int sb = 32 * (sb0 + j) + 8 * i4 + 4 * hh; float p[4];
#pragma unroll
            for (int i = 0; i < 4; ++i) { const int s = sb + i; const float df = (float)(t - s);
                float dm;
                if (sb0 + j == tb) dm = (s <= t ? __expf(df * lgf) : 0.f) + (s >= t ? __expf(-df * lgb) : 0.f);
                else dm = __expf(sb0 + j < tb ? df * lgf : -df * lgb);
                p[i] = qk[j][4 * i4 + i] * dm; }
            *(LAS u32x2*)(TP + t * LDT + sb * 2) = (u32x2){pk2(p[0], p[1]), pk2(p[2], p[3])}; }
    BAR();
    f32x16 y[2] = {ZERO16, ZERO16};
    pv_mfma(F, TP, TV, y);
#pragma unroll 1
    for (int d = 0; d < 2; ++d) { f32x16 qs[2] = {ZERO16, ZERO16};
        if (!sq.lat && (d == 0 ? sq.c == 0 : sq.c == sq.nch - 1)) continue;
        bf16x8 bst[2][8]; qs_prefetch(F, WSP(const bf16, WS_RTIN) + (size_t)((cp * 2 + d) * 4 + h) * 16384, bst);
        qs_mfma(F, TQ, bst, qs);
#pragma unroll
        for (int j = 0; j < 2; ++j)
#pragma unroll
            for (int k4 = 0; k4 < 4; ++k4) { const f32x4 f4 = *(const LAS f32x4*)(SCA(10 + d) + 32 * tb + 8 * k4 + 4 * hh);
#pragma unroll
                for (int i = 0; i < 4; ++i) y[j][4 * k4 + i] += f4[i] * qs[j][4 * k4 + i]; } }
    BAR();
    hs_to_lds(F, F.lds, y);
    BAR();
    head_out_r<1>(F, F.lds, INP(I_RNORM) + (size_t)l * GWID + h * 128, og, WSP(bf16, WS_Y) + (size_t)cp * 128 * D + 1024 + h * 128);
    BAR();
}
template <bool WMODE> __device__ __forceinline__ float ssd_scalars(Frame& F, KArgs& A, int l, int cp, int g) {
    const int d = F.wave >> 2, rr = F.wave & 3, head = g * 4 + rr;
    const float bias = INP(I_DTB)[(l * 2 + d) * 8 + head], arate = -__expf(INP(I_ALOG)[(l * 2 + d) * 8 + head]);
    const float* gp = WSP(const float, WS_GATES) + (size_t)(cp * 128) * 32 + 16 + d * 8 + head;
    const int i0 = d ? 127 - 2 * F.lane : 2 * F.lane, i1 = d ? i0 - 1 : i0 + 1;
    const float dt0 = softplusf_(gp[(size_t)i0 * 32] + bias), dt1 = softplusf_(gp[(size_t)i1 * 32] + bias);
    const float a0 = dt0 * arate, a1 = dt1 * arate;
    float inc = a0 + a1;
#pragma unroll
    for (int o = 1; o < 64; o <<= 1) { const float t = __shfl_up(inc, o); if (F.lane >= o) inc += t; }
    const float c1 = inc, c0 = inc - a1, tot = __shfl(inc, 63);
    LAS float* cum = SCA(16 + d * 4 + rr); LAS float* dtw = SCA(24 + d * 4 + rr);
    cum[i0] = c0; cum[i1] = c1;
    if (WMODE) { dtw[i0] = __expf(tot - c0) * dt0; dtw[i1] = __expf(tot - c1) * dt1; } else { dtw[i0] = dt0; dtw[i1] = dt1; }
    return tot;
}
__device__ __forceinline__ void seq_bounds(int cp, int& lo, int& hi) { if (cp < 64) { lo = (cp >> 1) * 256; hi = lo + 256; } else { lo = MC + ((cp - 64) >> 5) * 4096; hi = lo + 4096; } }
__device__ __forceinline__ void ssd_local_item(Frame F, KArgs& A, int l, int cp, int g) {
    const float tot = ssd_scalars<true>(F, A, l, cp, g);
    if (F.lane == 0) WSP(float, WS_SDSC)[(cp * 2 + (F.wave >> 2)) * 8 + g * 4 + (F.wave & 3)] = tot;
    int lo, hi; seq_bounds(cp, lo, hi);
    LAS unsigned char* TB = F.lds;
    load_conv<1, 16>(F, A, l, TB, nullptr, LDT, 512 + g * 128, cp * 128, lo, hi, nullptr, nullptr, true);
    load_conv<0, 16>(F, A, l, nullptr, nullptr, LDT, 768 + g * 128, cp * 128, lo, hi, nullptr, nullptr, true);
    BAR();
#pragma unroll 1
    for (int hr = 0; hr < 2; ++hr) {
#pragma unroll 1
        for (int r2 = 0; r2 < 2; ++r2) { const int rr = hr * 2 + r2;
            load_conv<2, 8>(F, A, l, F.lds + TS + (r2 * 2 + 0) * TSX, F.lds + TS + (r2 * 2 + 1) * TSX, LDX, g * 256 + rr * 64, cp * 128, lo, hi, SCA(24 + 0 * 4 + rr), SCA(24 + 1 * 4 + rr), true); }
        BAR();
        const int r2 = F.wave >> 2, d = (F.wave >> 1) & 1, pb = F.wave & 1, hh = F.lane >> 5, head = g * 4 + hr * 2 + r2;
        const LAS unsigned char* TX = F.lds + TS + (r2 * 2 + d) * TSX;
        f32x16 acc[4] = {ZERO16, ZERO16, ZERO16, ZERO16};
#pragma unroll 1
        for (int ks = 0; ks < 8; ++ks) { const bf16x8 a = frag_tr(TX, LDX, 16 * ks, 32 * pb, F.lane);
#pragma unroll
            for (int nb = 0; nb < 4; ++nb) acc[nb] = MFMA32(a, frag_tr(TB, LDT, 16 * ks, 32 * nb, F.lane), acc[nb]); }
        bf16* o = WSP(bf16, WS_SDLOC) + (size_t)((cp * 2 + d) * 8 + head) * 8192;
#pragma unroll
        for (int nb = 0; nb < 4; ++nb)
#pragma unroll
            for (int i = 0; i < 16; ++i) o[(32 * pb + crow(i, hh)) * 128 + 32 * nb + (F.lane & 31)] = (bf16)f2bf(acc[nb][i]);
        BAR();
    }
}
__device__ __forceinline__ void ssd_out_item(Frame F, KArgs& A, int l, int cp, bf16* Ybase) {
    const Seq sq = seq_of(cp);
    LAS unsigned char* TC = F.lds; LAS unsigned char* TB = F.lds + TS; LAS unsigned char* TX2 = F.lds + 2 * TS; LAS unsigned char* YI = F.lds + 3 * TS;
    LAS float* SSQ = SCA(14);
    if (F.tid < 128) SSQ[F.tid] = 0.f;
    const int tb = F.wave >> 1, ph = F.wave & 1, hh = F.lane >> 5, t = 32 * tb + (F.lane & 31);
    bf16* Yd = Ybase + (size_t)cp * 128 * D + 1536;
#pragma unroll 1
    for (int g = 0; g < 2; ++g) {
        (void)ssd_scalars<false>(F, A, l, cp, g);
        load_xbcc<16>(F, TC, LDT, 768 + g * 128, cp * 128);
        load_xbcc<16>(F, TB, LDT, 512 + g * 128, cp * 128);
        load_xbcc<16>(F, TX2, LDT, g * 256, cp * 128);
        BAR();
        f32x16 cb[4] = {ZERO16, ZERO16, ZERO16, ZERO16};
#pragma unroll 1
        for (int ks = 0; ks < 8; ++ks) { const bf16x8 bq = frag_row(TC, LDT, 32 * tb, 16 * ks, F.lane);
#pragma unroll
            for (int sb = 0; sb < 4; ++sb) cb[sb] = MFMA32(frag_row(TB, LDT, 32 * sb, 16 * ks, F.lane), bq, cb[sb]); }
#pragma unroll 1
        for (int hr = 0; hr < 2; ++hr) {
            if (hr == 1) { load_xbcc<16>(F, TX2, LDT, g * 256 + 128, cp * 128); BAR(); }
            f32x16 y2[2];
#pragma unroll
            for (int r2 = 0; r2 < 2; ++r2) {
                const int rr = hr * 2 + r2, head = g * 4 + rr;
                f32x16 y = ZERO16;
#pragma unroll 1
                for (int d = 0; d < 2; ++d) {
                    const LAS float* cum = SCA(16 + d * 4 + rr); const LAS float* dtv = SCA(24 + d * 4 + rr); const float ct = cum[t];
                    const bool has_state = sq.lat || (d == 0 ? sq.c > 0 : sq.c < sq.nch - 1);
                    bf16x8 bh[8];
                    if (has_state) { const bf16* hin = WSP(const bf16, WS_SDIN) + (size_t)((cp * 2 + d) * 8 + head) * 8192;
#pragma unroll
                        for (int ks = 0; ks < 8; ++ks) bh[ks] = *(const bf16x8*)(hin + (size_t)(32 * ph + (F.lane & 31)) * 128 + 16 * ks + 8 * hh); }
#pragma unroll
                    for (int sb = 0; sb < 4; ++sb) if (d == 0 ? sb <= tb : sb >= tb) {
#pragma unroll
                        for (int sp = 0; sp < 2; ++sp) { float p[8];
#pragma unroll
                            for (int jh = 0; jh < 2; ++jh) { const int s0 = 32 * sb + 16 * sp + 8 * jh + 4 * hh; const f32x4 c4 = *(const LAS f32x4*)(cum + s0), d4 = *(const LAS f32x4*)(dtv + s0);
#pragma unroll
                                for (int j = 0; j < 4; ++j) { const int s = s0 + j; float v = cb[sb][8 * sp + 4 * jh + j] * __expf(ct - c4[j]) * d4[j];
                                    if (sb == tb) { const bool ok = d == 0 ? (s <= t) : (s >= t); v = ok ? v : 0.f; }
                                    p[4 * jh + j] = v; } }
                            y = MFMA32(__builtin_bit_cast(bf16x8, pack8(p, 1.f)), frag_trp(TX2, LDT, 32 * sb + 16 * sp, r2 * 64 + 32 * ph, F.lane), y); } }
                    if (has_state) { f32x16 ch = ZERO16;
#pragma unroll
                        for (int ks = 0; ks < 8; ++ks) ch = MFMA32(frag_row(TC, LDT, 32 * tb, 16 * ks, F.lane), bh[ks], ch);
#pragma unroll
                        for (int k4 = 0; k4 < 4; ++k4) { const f32x4 c4 = *(const LAS f32x4*)(cum + 32 * tb + 8 * k4 + 4 * hh);
#pragma unroll
                            for (int i = 0; i < 4; ++i) y[4 * k4 + i] += __expf(c4[i]) * ch[4 * k4 + i]; } }
                }
                y2[r2] = y;
            }
#pragma unroll
            for (int r2 = 0; r2 < 2; ++r2)
#pragma unroll
                for (int i = 0; i < 16; ++i) *(LAS unsigned short*)(YI + (32 * tb + crow(i, hh)) * LDT + (r2 * 64 + 32 * ph + (F.lane & 31)) * 2) = (unsigned short)f2bf(y2[r2][i]);
            BAR();
            { const int tt = F.tid >> 2, seg = F.tid & 3, head = g * 4 + hr * 2 + (seg >> 1), pc = (seg & 1) * 32; const float Dh = INP(I_SSDD)[l * 8 + head]; float ss = 0.f;
#pragma unroll
                for (int k = 0; k < 4; ++k) { float yv[8], x[8], z[8], o[8];
                    unpack8(*(const LAS v4u*)(YI + tt * LDT + (seg * 32 + 8 * k) * 2), yv); unpack8(*(const LAS v4u*)(TX2 + tt * LDT + (seg * 32 + 8 * k) * 2), x);
                    unpack8(*(const v4u*)(PT(cp, PC_DZ + head * 64 + pc) + (size_t)tt * 128 + 8 * k), z);
#pragma unroll
                    for (int j = 0; j < 8; ++j) { const float v = (yv[j] + Dh * x[j]) * siluf_(z[j]); o[j] = v; ss += v * v; }
                    *(v4u*)(Yd + (size_t)tt * D + head * 64 + pc + 8 * k) = pack8(o, 1.f); }
                ss += __shfl_xor(ss, 1); ss += __shfl_xor(ss, 2);
                if (seg == 0) SSQ[tt] += ss; }
            BAR();
        }
    }
    __builtin_amdgcn_fence(__ATOMIC_RELEASE, "workgroup"); asm volatile("s_waitcnt vmcnt(0)" ::: "memory"); __syncthreads(); __builtin_amdgcn_fence(__ATOMIC_ACQUIRE, "workgroup");
    { const int tt = F.tid >> 2, seg = F.tid & 3; const float r = rsqrtf(SSQ[tt] * (1.f / 512.f) + EPS); const float* gn = INP(I_SNORM) + (size_t)l * GWID + 128 * seg;
#pragma unroll 4
        for (int k = 0; k < 16; ++k) { bf16* p = Yd + (size_t)tt * D + 128 * seg + 8 * k; float v[8];
            unpack8(*(const v4u*)p, v);
#pragma unroll
            for (int j = 0; j < 8; ++j) v[j] = v[j] * r * gn[8 * k + j];
            *(v4u*)p = pack8(v, 1.f); } }
    BAR();
}
template <int PASS> __device__ __forceinline__ void s5_item(Frame F, KArgs& A, int l, int cp, int gq) {
    const Seq sq = seq_of(cp);
    const int g = gq * 8 + F.wave, p = F.lane, hh = F.lane >> 5;
    LAS unsigned char* TU = F.lds; LAS unsigned char* BU = F.lds + TS + F.wave * 8704;
    if (PASS == 1) ITS(8);
    typedef short v8s __attribute__((ext_vector_type(8)));
    typedef float f32x4v __attribute__((ext_vector_type(4)));
    const int r16 = F.lane & 15, g4 = F.lane >> 4;
    v4u ru[4]; tile_issue(F, PT(cp, PC_S5U + gq * 128), ru);
    f32x2 lam[2], l8[2], h0[2]; bf16x8 bbf[2][4]; v8s ctf[2][4];
#pragma unroll
    for (int d = 0; d < 2; ++d) {
        const unsigned char* tab = s5tab(F, l, d, g);
        lam[d] = ((const f32x2*)tab)[p]; l8[d] = ((const f32x2*)(tab + 512))[p]; h0[d] = (f32x2){0.f, 0.f};
        if (PASS == 1 && sq.lat) { const size_t o = (size_t)(((sq.b * 4 + l) * 2 + d) * 32 + g) * 64 + p; h0[d] = (f32x2){INP(I_SS5R)[o], INP(I_SS5I)[o]}; }
        const bf16* bb = (const bf16*)(tab + 1024); const bf16* ct = (const bf16*)(tab + 5120);
#pragma unroll
        for (int nb = 0; nb < 4; ++nb) bbf[d][nb] = *(const bf16x8*)(bb + (size_t)(32 * nb + (F.lane & 31)) * 16 + 8 * hh);
        if (PASS == 1 && d == 0) {
#pragma unroll
            for (int ks = 0; ks < 4; ++ks) ctf[0][ks] = *(const v8s*)(ct + r16 * 128 + 32 * ks + 8 * g4); }
    }
    if (PASS == 1) {
        f32x2 e[31];
#pragma unroll
        for (int j = 0; j < 31; ++j) if (j < sq.nch - 1) { const int cc = j < sq.c ? j : j + 1, dd = j < sq.c ? 0 : 1;
            e[j] = *(const f32x2*)(WSP(const float, WS_S5LOC) + ((size_t)(((sq.cp0 + cc) * 2 + dd) * 32 + g) * 64 + p) * 2); }
#pragma unroll
        for (int j = 0; j < 31; ++j) if (j < sq.c) h0[0] = __builtin_elementwise_fma((f32x2){-l8[0].y, l8[0].y}, __builtin_shufflevector(h0[0], h0[0], 1, 0), __builtin_elementwise_fma((f32x2){l8[0].x, l8[0].x}, h0[0], e[j]));
#pragma unroll
        for (int j = 30; j >= 0; --j) if (j >= sq.c && j < sq.nch - 1) h0[1] = __builtin_elementwise_fma((f32x2){-l8[1].y, l8[1].y}, __builtin_shufflevector(h0[1], h0[1], 1, 0), __builtin_elementwise_fma((f32x2){l8[1].x, l8[1].x}, h0[1], e[j]));
    }
    tile_commit(F, TU, ru, 1.f);
    BAR();
    if (PASS == 1) { ITE(8); ITS(9); }
    f32x4v yacc[4][2];
    if (PASS == 1) {
#pragma unroll
        for (int a = 0; a < 4; ++a) { yacc[a][0] = (f32x4v){0.f, 0.f, 0.f, 0.f}; yacc[a][1] = (f32x4v){0.f, 0.f, 0.f, 0.f}; } }
#pragma unroll
    for (int d = 0; d < 2; ++d) {
        const f32x2 L1 = (f32x2){lam[d].x, lam[d].x}, L2 = (f32x2){-lam[d].y, lam[d].y};
        f32x2 hc = h0[d];
        if (PASS == 1 && d == 1) { const bf16* ct = (const bf16*)(s5tab(F, l, 1, g) + 5120);
#pragma unroll
            for (int ks = 0; ks < 4; ++ks) ctf[1][ks] = *(const v8s*)(ct + r16 * 128 + 32 * ks + 8 * g4); }
#pragma unroll 1
        for (int tbi = 0; tbi < 4; ++tbi) {
            const int tb = d == 0 ? tbi : 3 - tbi;
            const bf16x8 bu = frag_row(TU, LDT, 32 * tb, 16 * F.wave, F.lane);
#pragma unroll
            for (int nb = 0; nb < 4; ++nb) {
                const f32x16 acc = MFMA32(bbf[d][nb], bu, ZERO16);
#pragma unroll
                for (int i4 = 0; i4 < 4; ++i4) *(LAS u32x2*)(BU + (F.lane & 31) * LDT + (32 * nb + 8 * i4 + 4 * hh) * 2) = (u32x2){pk2(acc[4 * i4], acc[4 * i4 + 1]), pk2(acc[4 * i4 + 2], acc[4 * i4 + 3])};
            }
            asm volatile("s_waitcnt lgkmcnt(0)" ::: "memory");
            unsigned w[32];
#pragma unroll
            for (int st = 0; st < 32; ++st) { const int tl = d == 0 ? st : 31 - st; w[st] = *(const LAS unsigned*)(BU + tl * LDT + p * 4); }
#pragma unroll
            for (int st = 0; st < 32; ++st) { const f32x2 bb2 = (f32x2){bflo(w[st]), bfhi(w[st])};
                const f32x2 t2 = __builtin_elementwise_fma(L1, hc, bb2);
                hc = __builtin_elementwise_fma(L2, __builtin_shufflevector(hc, hc, 1, 0), t2);
                if (PASS == 1) w[st] = pk2(hc.x, hc.y); }
            if (PASS == 1) {
#pragma unroll
                for (int st = 0; st < 32; ++st) { const int tl = d == 0 ? st : 31 - st; *(LAS unsigned*)(BU + tl * LDT + p * 4) = w[st]; }
                asm volatile("s_waitcnt lgkmcnt(0)" ::: "memory");
                f32x4v y0 = (f32x4v){0.f, 0.f, 0.f, 0.f}, y1 = y0;
#pragma unroll
                for (int ks = 0; ks < 4; ++ks) {
                    y0 = __builtin_amdgcn_mfma_f32_16x16x32_bf16(*(const LAS v8s*)(BU + r16 * LDT + (32 * ks + 8 * g4) * 2), ctf[d][ks], y0, 0, 0, 0);
                    y1 = __builtin_amdgcn_mfma_f32_16x16x32_bf16(*(const LAS v8s*)(BU + (16 + r16) * LDT + (32 * ks + 8 * g4) * 2), ctf[d][ks], y1, 0, 0, 0); }
                if (tb == 0) { yacc[0][0] += y0; yacc[0][1] += y1; } else if (tb == 1) { yacc[1][0] += y0; yacc[1][1] += y1; } else if (tb == 2) { yacc[2][0] += y0; yacc[2][1] += y1; } else { yacc[3][0] += y0; yacc[3][1] += y1; }
                asm volatile("s_waitcnt lgkmcnt(0)" ::: "memory");
            }
        }
        if (PASS == 0) { *(f32x2*)(WSP(float, WS_S5LOC) + ((size_t)((cp * 2 + d) * 32 + g) * 64 + p) * 2) = hc; }
        else if (!sq.lat && ((d == 0 && sq.c == sq.nch - 1) || (d == 1 && sq.c == 0))) { const size_t o = (size_t)(((sq.b * 4 + l) * 2 + d) * 32 + g) * 64 + p; F.out[O_S5R + o] = hc.x; F.out[O_S5I + o] = hc.y; }
    }
    if (PASS == 1) { ITE(9); ITS(10); }
    if (PASS == 1) {
        const float Dc = INP(I_S5D)[(size_t)l * GWID + g * 16 + r16];
#pragma unroll
        for (int tb = 0; tb < 4; ++tb)
#pragma unroll
            for (int ts = 0; ts < 2; ++ts)
#pragma unroll
                for (int i = 0; i < 4; ++i) { const int t = 32 * tb + 16 * ts + 4 * g4 + i; LAS unsigned short* up = (LAS unsigned short*)(TU + t * LDT + (16 * F.wave + r16) * 2);
                    const float x = yacc[tb][ts][i] + Dc * bf2f(*up);
                    const float u2 = 1.5957691216057308f * (x + 0.044715f * x * x * x); const float ge = x - x * __builtin_amdgcn_rcpf(1.f + __expf(u2));
                    *up = (unsigned short)f2bf(ge); }
        BAR();
        bf16* ya = WSP(bf16, WS_YA) + (size_t)cp * 128 * GWID + gq * 128;
#pragma unroll
        for (int it = 0; it < 4; ++it) { const int i = F.tid + NT * it, r = i >> 4, c = i & 15; *(v4u*)(ya + (size_t)r * GWID + c * 8) = *(const LAS v4u*)(TU + r * LDT + c * 16); }
    }
    BAR();
    if (PASS == 1) ITE(10);
}

template <bool LAT> __device__ __forceinline__ void carry_unit(Frame F, KArgs& A, int l, int u) {
    const int sd = u / 96, rem = u % 96, sidx = sd >> 1, d = sd & 1;
    constexpr int lat = LAT ? 1 : 0, nch = LAT ? 32 : 2, NB = LAT ? 16 : 2;
    const int b = LAT ? sidx : sidx - 4, cp0 = LAT ? 64 + 32 * b : 2 * b;
    int type, head, slice;
    if (rem < 32) { type = 0; head = rem >> 3; slice = rem & 7; } else if (rem < 64) { type = 1; head = (rem - 32) >> 3; slice = (rem - 32) & 7; } else { type = 2; head = (rem - 64) >> 2; slice = (rem - 64) & 3; }
    const int e0 = slice * 2048 + F.tid * 4;
    const int nh = type == 2 ? 8 : 4, esz = type == 2 ? 8192 : 16384;
    const bf16* loc = type == 0 ? WSP(const bf16, WS_MLCLOC) : (type == 1 ? WSP(const bf16, WS_RTLOC) : WSP(const bf16, WS_SDLOC));
    bf16* inb = type == 0 ? WSP(bf16, WS_MLCIN) : (type == 1 ? WSP(bf16, WS_RTIN) : WSP(bf16, WS_SDIN));
    float zf = 0.f; asm volatile("" : "+v"(zf));
    float v[4] = {zf, zf, zf, zf}, nv[4] = {zf, zf, zf, zf}, m = 0.f;
    const bool do_n = (type == 0 && slice == 0 && F.tid < 32);
    if (LAT) {
        if (type == 2) { const f32x4 s = *(const f32x4*)(INP(I_SSSD) + (size_t)(((b * 4 + l) * 2 + d) * 8 + head) * 8192 + e0); v[0] = s.x; v[1] = s.y; v[2] = s.z; v[3] = s.w; }
        else { const float* s = (type == 0 ? INP(I_SMC) : INP(I_SRET)) + (size_t)(((b * 4 + l) * 2 + d) * 4 + head) * 16384; const int dv = e0 >> 7, dk = e0 & 127;
#pragma unroll
            for (int j = 0; j < 4; ++j) v[j] = s[(dk + j) * 128 + dv]; }
        if (type == 0) { m = INP(I_SMM)[((b * 4 + l) * 2 + d) * 4 + head];
            if (do_n) { const f32x4 s = *(const f32x4*)(INP(I_SMN) + (size_t)(((b * 4 + l) * 2 + d) * 4 + head) * 128 + F.tid * 4); nv[0] = s.x; nv[1] = s.y; nv[2] = s.z; nv[3] = s.w; } }
    }
    const float rdec = type == 1 ? __expf(-128.f * __expf(INP(I_RRATE)[(l * 2 + d) * 4 + head])) : 1.f;
#pragma unroll 1
    for (int ci0 = 0; ci0 < nch; ci0 += NB) {
        u32x2 lc[NB]; f32x4 ln[NB]; float s0[NB], s1[NB];
#pragma unroll
        for (int j = 0; j < NB; ++j) { ln[j] = (f32x4){zf, zf, zf, zf}; s0[j] = zf; s1[j] = zf; }
#pragma unroll
        for (int j = 0; j < NB; ++j) {
            const int ci = ci0 + j, cp = cp0 + (d == 0 ? ci : nch - 1 - ci);
            lc[j] = *(const u32x2*)(loc + (size_t)((cp * 2 + d) * nh + head) * esz + e0);
            if (type == 0) { const float* sc = WSP(const float, WS_MLSC) + ((cp * 2 + d) * 4 + head) * 2; s0[j] = sc[0]; s1[j] = sc[1];
                if (do_n) ln[j] = *(const f32x4*)(WSP(const float, WS_MLNLOC) + ((cp * 2 + d) * 4 + head) * 128 + F.tid * 4); }
            else if (type == 2) s0[j] = WSP(const float, WS_SDSC)[(cp * 2 + d) * 8 + head];
        }
#pragma unroll
        for (int j = 0; j < NB; ++j) {
            const int ci = ci0 + j, cp = cp0 + (d == 0 ? ci : nch - 1 - ci);
            const size_t so = (size_t)((cp * 2 + d) * nh + head) * esz + e0;
            if (LAT || ci > 0) *(u32x2*)(inb + so) = (u32x2){pk2(v[0], v[1]), pk2(v[2], v[3])};
            float dec, wl = 1.f;
            if (type == 0) {
                const float Bt = s0[j], ml = s1[j];
                if (slice == 0 && F.tid == 0) WSP(float, WS_MLMIN)[(cp * 2 + d) * 4 + head] = m;
                if (do_n) *(f32x4*)(WSP(float, WS_MLNIN) + ((cp * 2 + d) * 4 + head) * 128 + F.tid * 4) = (f32x4){nv[0], nv[1], nv[2], nv[3]};
                const float mn = fmaxf(Bt + m, ml); dec = __expf(Bt + m - mn); wl = __expf(ml - mn); m = mn;
                if (do_n) { nv[0] = dec * nv[0] + wl * ln[j].x; nv[1] = dec * nv[1] + wl * ln[j].y; nv[2] = dec * nv[2] + wl * ln[j].z; nv[3] = dec * nv[3] + wl * ln[j].w; }
            } else if (type == 1) dec = rdec;
            else dec = __expf(s0[j]);
            v[0] = dec * v[0] + wl * bflo(lc[j].x); v[1] = dec * v[1] + wl * bfhi(lc[j].x); v[2] = dec * v[2] + wl * bflo(lc[j].y); v[3] = dec * v[3] + wl * bfhi(lc[j].y);
        }
    }
    if (!lat) {
        if (type == 2) *(f32x4*)(F.out + O_SSD + (size_t)(((b * 4 + l) * 2 + d) * 8 + head) * 8192 + e0) = (f32x4){v[0], v[1], v[2], v[3]};
        else {
            LAS float* tr = (LAS float*)F.lds;
            const int dvl = F.tid >> 5, dk = (F.tid & 31) * 4;
#pragma unroll
            for (int j = 0; j < 4; ++j) tr[dvl * 129 + dk + j] = v[j];
            BAR();
            const int dk2 = F.tid >> 2, q = F.tid & 3;
            float* o = F.out + (type == 0 ? O_MC : O_RET) + (size_t)(((b * 4 + l) * 2 + d) * 4 + head) * 16384 + (size_t)dk2 * 128 + slice * 16 + 4 * q;
            *(f32x4*)o = (f32x4){tr[(4 * q) * 129 + dk2], tr[(4 * q + 1) * 129 + dk2], tr[(4 * q + 2) * 129 + dk2], tr[(4 * q + 3) * 129 + dk2]};
            if (type == 0) { if (do_n) *(f32x4*)(F.out + O_MN + (size_t)(((b * 4 + l) * 2 + d) * 4 + head) * 128 + F.tid * 4) = (f32x4){nv[0], nv[1], nv[2], nv[3]};
                if (slice == 0 && F.tid == 0) F.out[O_MM + ((b * 4 + l) * 2 + d) * 4 + head] = m; }
            BAR();
        }
    }
}

struct CtxLd { u32x2 lc[2]; f32x4 ln[2]; float s0[2], s1[2]; };
struct CtxU { int d, b, cp0, type, head, slice, e0, nh, esz; bool do_n; };
__device__ __forceinline__ CtxU ctx_decode(const Frame& F, int u) {
    CtxU c; const int sd = u / 96, rem = u % 96, sidx = sd >> 1; c.d = sd & 1; c.b = sidx - 4; c.cp0 = 2 * c.b;
    if (rem < 32) { c.type = 0; c.head = rem >> 3; c.slice = rem & 7; } else if (rem < 64) { c.type = 1; c.head = (rem - 32) >> 3; c.slice = (rem - 32) & 7; } else { c.type = 2; c.head = (rem - 64) >> 2; c.slice = (rem - 64) & 3; }
    c.e0 = c.slice * 2048 + F.tid * 4; c.nh = c.type == 2 ? 8 : 4; c.esz = c.type == 2 ? 8192 : 16384; c.do_n = (c.type == 0 && c.slice == 0 && F.tid < 32);
    return c;
}
__device__ __forceinline__ void carry_ctx_load(const Frame& F, int u, CtxLd& L, float zf) {
    const CtxU c = ctx_decode(F, u);
    const bf16* loc = c.type == 0 ? WSP(const bf16, WS_MLCLOC) : (c.type == 1 ? WSP(const bf16, WS_RTLOC) : WSP(const bf16, WS_SDLOC));
#pragma unroll
    for (int j = 0; j < 2; ++j) { const int cp = c.cp0 + (c.d == 0 ? j : 1 - j);
        L.ln[j] = (f32x4){zf, zf, zf, zf}; L.s0[j] = zf; L.s1[j] = zf;
        L.lc[j] = *(const u32x2*)(loc + (size_t)((cp * 2 + c.d) * c.nh + c.head) * c.esz + c.e0);
        if (c.type == 0) { const float* sc = WSP(const float, WS_MLSC) + ((cp * 2 + c.d) * 4 + c.head) * 2; L.s0[j] = sc[0]; L.s1[j] = sc[1];
            if (c.do_n) L.ln[j] = *(const f32x4*)(WSP(const float, WS_MLNLOC) + ((cp * 2 + c.d) * 4 + c.head) * 128 + F.tid * 4); }
        else if (c.type == 2) L.s0[j] = WSP(const float, WS_SDSC)[(cp * 2 + c.d) * 8 + c.head]; }
}
__device__ __forceinline__ void carry_ctx_finish(Frame& F, KArgs& A, int l, int u, const CtxLd& L, float zf) {
    const CtxU c = ctx_decode(F, u);
    bf16* inb = c.type == 0 ? WSP(bf16, WS_MLCIN) : (c.type == 1 ? WSP(bf16, WS_RTIN) : WSP(bf16, WS_SDIN));
    float v[4] = {zf, zf, zf, zf}, nv[4] = {zf, zf, zf, zf}, m = 0.f;
    const float rdec = c.type == 1 ? __expf(-128.f * __expf(INP(I_RRATE)[(l * 2 + c.d) * 4 + c.head])) : 1.f;
#pragma unroll
    for (int j = 0; j < 2; ++j) { const int cp = c.cp0 + (c.d == 0 ? j : 1 - j);
        if (j > 0) *(u32x2*)(inb + (size_t)((cp * 2 + c.d) * c.nh + c.head) * c.esz + c.e0) = (u32x2){pk2(v[0], v[1]), pk2(v[2], v[3])};
        float dec, wl = 1.f;
        if (c.type == 0) {
            if (c.slice == 0 && F.tid == 0) WSP(float, WS_MLMIN)[(cp * 2 + c.d) * 4 + c.head] = m;
            if (c.do_n) *(f32x4*)(WSP(float, WS_MLNIN) + ((cp * 2 + c.d) * 4 + c.head) * 128 + F.tid * 4) = (f32x4){nv[0], nv[1], nv[2], nv[3]};
            const float mn = fmaxf(L.s0[j] + m, L.s1[j]); dec = __expf(L.s0[j] + m - mn); wl = __expf(L.s1[j] - mn); m = mn;
            if (c.do_n) { nv[0] = dec * nv[0] + wl * L.ln[j].x; nv[1] = dec * nv[1] + wl * L.ln[j].y; nv[2] = dec * nv[2] + wl * L.ln[j].z; nv[3] = dec * nv[3] + wl * L.ln[j].w; }
        } else if (c.type == 1) dec = rdec;
        else dec = __expf(L.s0[j]);
        v[0] = dec * v[0] + wl * bflo(L.lc[j].x); v[1] = dec * v[1] + wl * bfhi(L.lc[j].x); v[2] = dec * v[2] + wl * bflo(L.lc[j].y); v[3] = dec * v[3] + wl * bfhi(L.lc[j].y); }
    const int b = c.b, d = c.d, head = c.head, slice = c.slice, e0 = c.e0;
    if (c.type == 2) *(f32x4*)(F.out + O_SSD + (size_t)(((b * 4 + l) * 2 + d) * 8 + head) * 8192 + e0) = (f32x4){v[0], v[1], v[2], v[3]};
    else {
        LAS float* tr = (LAS float*)F.lds;
        const int dvl = F.tid >> 5, dk = (F.tid & 31) * 4;
#pragma unroll
        for (int j = 0; j < 4; ++j) tr[dvl * 129 + dk + j] = v[j];
        BAR();
        const int dk2 = F.tid >> 2, q = F.tid & 3;
        float* o = F.out + (c.type == 0 ? O_MC : O_RET) + (size_t)(((b * 4 + l) * 2 + d) * 4 + head) * 16384 + (size_t)dk2 * 128 + slice * 16 + 4 * q;
        *(f32x4*)o = (f32x4){tr[(4 * q) * 129 + dk2], tr[(4 * q + 1) * 129 + dk2], tr[(4 * q + 2) * 129 + dk2], tr[(4 * q + 3) * 129 + dk2]};
        if (c.type == 0) { if (c.do_n) *(f32x4*)(F.out + O_MN + (size_t)(((b * 4 + l) * 2 + d) * 4 + head) * 128 + F.tid * 4) = (f32x4){nv[0], nv[1], nv[2], nv[3]};
            if (slice == 0 && F.tid == 0) F.out[O_MM + ((b * 4 + l) * 2 + d) * 4 + head] = m; }
        BAR();
    }
}
__device__ __forceinline__ void carry_ctx_batch(Frame F, KArgs& A, int l, int u0) {
    float zf = 0.f; asm volatile("" : "+v"(zf));
    CtxLd L[8];
#pragma unroll
    for (int j = 0; j < 8; ++j) carry_ctx_load(F, u0 + j, L[j], zf);
#pragma unroll
    for (int j = 0; j < 8; ++j) carry_ctx_finish(F, A, l, u0 + j, L[j], zf);
}
constexpr int CW_Q = 16384;
struct OneUnit { pg8::Unit u; __device__ __forceinline__ bool next(int i, pg8::Unit& o) const { if (i) return false; o = u; return true; }
    __device__ __forceinline__ void a_ready(const pg8::Unit&) const {} __device__ __forceinline__ void done(const pg8::Unit&) const {} };
#define QUEUE_LOOP(F0_, qidx, total, ...) do { \
    unsigned* qc_ = (unsigned*)(F0_.ws + WS_CTL) + CW_Q + 64 * (qidx); volatile LAS int* qs_ = (volatile LAS int*)(F0_.lds + MISC_OFF + 64); \
    if (F0_.tid == 0) qs_[0] = (int)__hip_atomic_fetch_add(qc_, 1u, __ATOMIC_RELAXED, __HIP_MEMORY_SCOPE_AGENT); \
    __syncthreads(); \
    int it = qs_[0], par_ = 1; \
    while (it < (total)) { \
        int nx_ = 0; if (F0_.tid == 0) nx_ = (int)__hip_atomic_fetch_add(qc_, 1u, __ATOMIC_RELAXED, __HIP_MEMORY_SCOPE_AGENT); \
        { __VA_ARGS__ } \
        if (F0_.tid == 0) qs_[par_] = nx_; \
        BAR();     \
        it = qs_[par_]; par_ ^= 1; \
    } } while (0)
#ifndef PROBE_ITEM
#define PROBE_ITEM -1
#endif
#define PR(t) (PROBE_ITEM == (t) ? 2 : 1)
#define QSPLIT(NT_, C0, C1, C2, C3, T0) int ty_ = 0, loc_ = it, dup_ = 0; { const int cnt_[4] = {C0, C1, C2, C3}; \
    _Pragma("unroll") for (int j_ = 0; j_ < NT_; ++j_) { const int span_ = cnt_[j_] * PR(T0 + j_); if (ty_ == j_) { if (loc_ >= span_) { loc_ -= span_; ty_ = j_ + 1; } else { dup_ = loc_ / cnt_[j_]; loc_ = loc_ % cnt_[j_]; } } } }
#ifndef PROBE_TMASK
#define PROBE_TMASK 0
#endif
#ifndef PROBE_TAMP
#define PROBE_TAMP 4
#endif
#define TSTART(k) do { if (PROBE_TMASK & (1 << (k))) pt0_ = __builtin_amdgcn_s_memrealtime(); } while (0)
#define TEND(k) do { if (PROBE_TMASK & (1 << (k))) ptacc_ += __builtin_amdgcn_s_memrealtime() - pt0_; } while (0)
#ifndef PROBE_REPEAT
#define PROBE_REPEAT -1
#endif
#ifndef XSTG
#define XSTG 0
#endif
constexpr int N_PHASES = 2 + 9 * NLAYER;
__global__ void __launch_bounds__(NT, 2) hymba_fwd(Args A) {
    extern __shared__ __attribute__((aligned(16))) unsigned char lds_raw[];
    Frame F0;
    F0.lds = (LAS unsigned char*)lds_raw;
    F0.tid = threadIdx.x; F0.lane = 0; F0.wave = __builtin_amdgcn_readfirstlane(F0.tid >> 6);
    F0.G = gridDim.x; F0.bid = blockIdx.x; F0.out = A.out; F0.ws = A.ws;
    volatile LAS unsigned* MISC = (volatile LAS unsigned*)(F0.lds + MISC_OFF);
    if (F0.tid < 64) MISC[F0.tid] = 0u;
    __syncthreads();
    unsigned* barw = (unsigned*)(F0.ws + WS_CTL) + CW_BAR;
    XcdBarrier bar = xcd_barrier_post(barw, MISC + 8, F0.wave == 0 ? 1u : 0u);
    const int lo = A.ph_lo, hi = A.ph_hi;
    unsigned long long pt0_ = 0, ptacc_ = 0;
#define KA (*kargs())
#define IN(k) (lo <= (k) && (k) < hi)
#define SEAM(k) do { if (IN(k) && IN((k) + 1)) xcd_barrier(bar); } while (0)
#define CSEAM(k) do { if (IN(k) && IN((k) + 1)) { if (__builtin_amdgcn_readfirstlane((int)MISC[11]) == 2) xcc_barrier(bar); else xcd_barrier(bar); } } while (0)
#define XCC_ORDER(S_, M_, N_) pg8::XccOrder S_; S_.init(M_, N_, F.G, F.bid, __builtin_amdgcn_readfirstlane((int)MISC[11]) == 2 ? 1 : 0, (int)bar.x, __builtin_amdgcn_readfirstlane((int)MISC[10]))

    TSTART(9); if (IN(0)) for (int rep_ = 0; rep_ < (PROBE_REPEAT == 100 ? 2 : 1); ++rep_) { Frame F = fresh(F0); p0_prologue(F, KA); } SEAM(0); TEND(9);

    TSTART(10); if (IN(1)) { Frame F = fresh(F0); norm0_phase(F, KA); shw_phase(F); } SEAM(1); TEND(10);

#pragma unroll 1
    for (int l = 0; l < NLAYER; ++l) {
        const int pb = 1 + 9 * l;
        TSTART(1); if (IN(pb + 1)) for (int rep_ = 0; rep_ < (PROBE_REPEAT == 1 ? 2 : 1); ++rep_) { Frame F = fresh(F0);
            pg8::Gemm g{WSP(const pg8::bf16_t, WS_H), WSP(const pg8::bf16_t, WS_W1T) + (size_t)l * NPAD * D, M, NPROJ, D}; pg8::StaticOrder S; S.init(M, NPROJ, F.G, F.bid);
            epi::EpiProj E{WSP(pg8::bf16_t, WS_PROJ), WSP(const float, WS_SSQB), WSP(const float, WS_SHW1) + (size_t)l * 5 * NPAD};
            pg8::gemm_phase<epi::EpiProj, pg8::StaticOrder, true, true>(F.lds, g, S, E, F.tid);
            __syncthreads(); gates_phase(F, l);
        } SEAM(pb + 1); TEND(1);
        TSTART(2); if (IN(pb + 2)) { Frame F = fresh(F0);
            QUEUE_LOOP(F, l * 3 + 0, 384 * PR(0) + 768 * PR(1) + 768 * PR(2) + 768 * PR(3), {
                QSPLIT(4, 384, 768, 768, 768, 0);
                if (ty_ == 0) { TSTART(11); ssd_local_item(fresh(F), KA, l, loc_ >> 1, loc_ & 1); TEND(11); }
                else if (ty_ == 1) { TSTART(12); mlstm_local_item(fresh(F), KA, l, loc_ >> 2, loc_ & 3); TEND(12); }
                else if (ty_ == 2) { TSTART(13); ret_local_item(fresh(F), KA, l, loc_ >> 2, loc_ & 3); TEND(13); }
                else { TSTART(14); s5_item<0>(fresh(F), KA, l, loc_ >> 2, loc_ & 3); TEND(14); }
            });
        } SEAM(pb + 2); TEND(2);
        TSTART(3); if (IN(pb + 3)) { Frame F = fresh(F0);
            QUEUE_LOOP(F, l * 3 + 1, 768 * PR(4) + 768 * PR(5) + 768 * PR(6), {
                QSPLIT(3, 768, 768, 768, 0, 4);
                if (ty_ == 0) { TSTART(15); carry_unit<true>(fresh(F), KA, l, loc_); TEND(15); }
                else if (ty_ == 1) { TSTART(16); s5_item<1>(fresh(F), KA, l, loc_ >> 2, loc_ & 3); TEND(16); }
                else { TSTART(17); carry_ctx_batch(fresh(F), KA, l, 768 + loc_ * 8); TEND(17); }
            });
        } SEAM(pb + 3); TEND(3);
        TSTART(4); if (IN(pb + 4)) { Frame F = fresh(F0);
            QUEUE_LOOP(F, l * 3 + 2, 192 * PR(7) + 192 * PR(8) + 768 * PR(9) + 768 * PR(10), {
                QSPLIT(4, 192, 192, 768, 768, 7);
                if (ty_ == 0) { TSTART(18); ssd_out_item(fresh(F), KA, l, loc_, dup_ ? WSP(bf16, WS_MLCLOC) : WSP(bf16, WS_Y)); TEND(18); }
                else if (ty_ == 1) { TSTART(19); Frame Fg = fresh(F);
                    pg8::Gemm g{WSP(const pg8::bf16_t, WS_YA), WSP(const pg8::bf16_t, WS_WGT) + (size_t)l * GWID * GWID, M, GWID, GWID}; OneUnit S; S.u.pm = loc_ >> 1; S.u.pn = loc_ & 1;
                    epi::EpiGlu E{WSP(const pg8::bf16_t, WS_YA), WSP(pg8::bf16_t, WS_Y)};
                    pg8::gemm_phase<epi::EpiGlu, OneUnit, false, true>(Fg.lds, g, S, E, Fg.tid); __syncthreads(); TEND(19); }
                else if (ty_ == 2) { TSTART(20); mlstm_out_item(fresh(F), KA, l, loc_ >> 2, loc_ & 3); TEND(20); }
                else { TSTART(21); ret_out_item(fresh(F), KA, l, loc_ >> 2, loc_ & 3); TEND(21); }
            });
        } SEAM(pb + 4); TEND(4);
        TSTART(5); if (IN(pb + 5)) { Frame F = fresh(F0);
            pg8::Gemm g{WSP(const pg8::bf16_t, WS_Y), WSP(const pg8::bf16_t, WS_WOT) + (size_t)l * D * D, M, D, D}; XCC_ORDER(S, M, D);
            if (XSTG > 0 && S.mode) { const unsigned long long t0_ = __builtin_amdgcn_s_memrealtime(), w_ = (unsigned long long)((S.j >> 3) * XSTG); while (__builtin_amdgcn_s_memrealtime() - t0_ < w_) __builtin_amdgcn_s_sleep(8); }
            KArgs& A_ = KA; epi::EpiRes E{(const float*)(const GAS float*)A_.in[I_XP], (const float*)(const GAS float*)A_.in[I_XS], WSP(pg8::bf16_t, WS_XB), WSP(const float, WS_MOD) + (size_t)(l * 5) * (6 * D) + 2 * D, l == 0 ? 1 : 0,
                          1, WSP(pg8::bf16_t, WS_H), WSP(float, WS_SSQA), (const float*)(const GAS float*)A_.in[I_NORM2] + (size_t)l * D, WSP(const float, WS_MOD) + (size_t)(l * 5) * (6 * D) + 4 * D, F.lds + 131072};
            pg8::gemm_phase<epi::EpiRes, pg8::XccOrder, true, true>(F.lds, g, S, E, F.tid);
        } CSEAM(pb + 5); TEND(5);
        TSTART(7); if (IN(pb + 7)) for (int rep_ = 0; rep_ < (PROBE_REPEAT == 7 ? 2 : 1); ++rep_) { Frame F = fresh(F0);
            pg8::Gemm g{WSP(const pg8::bf16_t, WS_H), WSP(const pg8::bf16_t, WS_WM1T) + (size_t)l * DFF * D, M, DFF, D}; XCC_ORDER(S, M, DFF);
            epi::EpiRelu2 E{WSP(pg8::bf16_t, WS_HID), WSP(const float, WS_SSQA), WSP(const float, WS_SHW2) + (size_t)l * 5 * DFF};
            pg8::gemm_phase<epi::EpiRelu2, pg8::XccOrder, true, true>(F.lds, g, S, E, F.tid);
        } CSEAM(pb + 7); TEND(7);
        TSTART(8); if (IN(pb + 8)) { Frame F = fresh(F0);
            pg8::Gemm g{WSP(const pg8::bf16_t, WS_HID), WSP(const pg8::bf16_t, WS_WM2T) + (size_t)l * D * DFF, M, D, DFF}; XCC_ORDER(S, M, D);
            KArgs& A_ = KA; epi::EpiRes E{(const float*)(const GAS float*)A_.in[I_XP], (const float*)(const GAS float*)A_.in[I_XS], WSP(pg8::bf16_t, WS_XB), WSP(const float, WS_MOD) + (size_t)(l * 5) * (6 * D) + 5 * D, 0,
                          l < NLAYER - 1 ? 1 : 0, WSP(pg8::bf16_t, WS_H), WSP(float, WS_SSQB), (const float*)(const GAS float*)A_.in[I_NORM1] + (size_t)(l + 1) * D, WSP(const float, WS_MOD) + (size_t)((l + 1) * 5) * (6 * D) + 1 * D, F.lds + 131072};
            pg8::gemm_phase<epi::EpiRes, pg8::XccOrder, true, true>(F.lds, g, S, E, F.tid);
        } SEAM(pb + 8); TEND(8);
    }
    if (IN(N_PHASES - 1)) { Frame F = fresh(F0); final_norm_phase(F, KA); }
    if (PROBE_IMASK != 0 && F0.bid == 0 && F0.wave == 0 && lane_id() == 0) { const unsigned long long acc_ = ((volatile LAS unsigned long long*)(F0.lds + MISC_OFF + 128))[1], te_ = __builtin_amdgcn_s_memrealtime();
        while (__builtin_amdgcn_s_memrealtime() - te_ < (unsigned long long)PROBE_TAMP * acc_) __builtin_amdgcn_s_sleep(32); }
    if (PROBE_TMASK != 0 && F0.bid == 0) { const unsigned long long te_ = __builtin_amdgcn_s_memrealtime(); while (__builtin_amdgcn_s_memrealtime() - te_ < (unsigned long long)PROBE_TAMP * ptacc_) __builtin_amdgcn_s_sleep(32); }
#undef IN
#undef SEAM
}

#ifndef MK_LAUNCH_PER_PHASE
#define MK_LAUNCH_PER_PHASE 0
#endif
extern "C" void kernel_launch(void* const* d_in, const int* in_sizes, int n_in, void* d_out, int out_size, void* d_ws, size_t ws_size, hipStream_t stream) {
    static int grid = 0;
    if (grid == 0) {
        if (n_in != N_IN || (size_t)out_size != O_END || ws_size < WS_END) { fprintf(stderr, "kernel_launch: shape mismatch: n_in %d out %d ws %zu (need %zu)\n", n_in, out_size, ws_size, (size_t)WS_END); grid = -1; return; }
        int dev = 0, cus = 0, per_cu = 0;
        if (hipGetDevice(&dev) != hipSuccess || hipDeviceGetAttribute(&cus, hipDeviceAttributeMultiprocessorCount, dev) != hipSuccess) { grid = -1; return; }
        if (hipFuncSetAttribute((const void*)hymba_fwd, hipFuncAttributeMaxDynamicSharedMemorySize, LDS_BYTES) != hipSuccess) { fprintf(stderr, "kernel_launch: hipFuncSetAttribute failed\n"); grid = -1; return; }
        if (hipOccupancyMaxActiveBlocksPerMultiprocessor(&per_cu, (const void*)hymba_fwd, NT, LDS_BYTES) != hipSuccess || per_cu < 1) fprintf(stderr, "kernel_launch: occupancy query says %d\n", per_cu);
        (void)hipGetLastError();
        grid = cus;
    }
    if (grid < 0) return;
    (void)hipMemsetAsync((char*)d_ws + WS_CTL, 0, CTL_ZERO_BYTES, stream);
    Args a{};
    for (int i = 0; i < N_IN; ++i) a.in[i] = (const float*)d_in[i];
    a.out = (float*)d_out; a.ws = (unsigned char*)d_ws;
#if MK_LAUNCH_PER_PHASE
    for (int p = 0; p < N_PHASES; ++p) { a.ph_lo = p; a.ph_hi = p + 1; hipLaunchKernelGGL(hymba_fwd, dim3(grid), dim3(NT), LDS_BYTES, stream, a); }
#else
    a.ph_lo = 0; a.ph_hi = N_PHASES;
    hipLaunchKernelGGL(hymba_fwd, dim3(grid), dim3(NT), LDS_BYTES, stream, a);
#endif
    const hipError_t le = hipPeekAtLastError();
    if (le != hipSuccess) fprintf(stderr, "kernel_launch: launch failed: %s\n", hipGetErrorName(le));
}
```
